# Optimizing an MI355X kernel written in HIP

```python
import jax
import jax.numpy as jnp
from jax import lax
import numpy as np

D_MODEL = 1024
BATCH = 16
SEQ = 4096
DEPTH = 4

CTX_LEN = 256
GRID_W = 64

POOL_GROUPS = 4
POOL_GROUP_DIM = D_MODEL // 16
POOL_WIDTH = POOL_GROUPS * POOL_GROUP_DIM
POOL_WINDOWS = (2, 4, 8, 16)

MLSTM_HEADS = 4
MLSTM_HEAD_DIM = D_MODEL // 8
MLSTM_WIDTH = MLSTM_HEADS * MLSTM_HEAD_DIM
MLSTM_CHUNK = 128
QK_CONV_WIDTH = 3

SGU_GROUPS = 4
SGU_GROUP_DIM = D_MODEL // 16
SGU_WIDTH = SGU_GROUPS * SGU_GROUP_DIM
SGU_CHUNK = 128

N_BRANCH = 3
IN_SPLIT_SIZES = (POOL_WIDTH, 2 * MLSTM_WIDTH, MLSTM_WIDTH, MLSTM_WIDTH, 4 * MLSTM_HEADS, 2 * SGU_WIDTH, N_BRANCH * D_MODEL)
IN_COLS = sum(IN_SPLIT_SIZES)
MLSTM_GATE_OFF = POOL_WIDTH + 4 * MLSTM_WIDTH

N_EXPERTS = 32
TOP_K = 4
D_FF = D_MODEL
SWIGLU_LIMIT = 7.0
SWIGLU_ALPHA = 1.702

LN_EPS = 1e-5
HEAD_NORM_EPS = 1e-6
DEEPNORM_ALPHA = (2 * DEPTH) ** 0.25
DEEPNORM_BETA = (8 * DEPTH) ** -0.25

kernel_name = 'pool_mlstm_sgu_moe_flow_block'


def layer_norm_plain(x):
    xf = x.astype(jnp.float32)
    mu = xf.mean(-1, keepdims=True)
    var = jnp.square(xf - mu).mean(-1, keepdims=True)
    return ((xf - mu) * lax.rsqrt(var + LN_EPS)).astype(x.dtype)


def layer_norm(x, g, b):
    return layer_norm_plain(x) * g + b


def modulate(h, shift, scale):
    return h * (1 + scale) + shift


def split_in(z):
    idx = [int(s) for s in np.cumsum(IN_SPLIT_SIZES)[:-1]]
    return jnp.split(z, idx, axis=-1)


def centred_box_mean(x, window):
    length = x.shape[-2]
    xf = x.astype(jnp.float32)
    prefix = jnp.concatenate([jnp.zeros_like(xf[..., :1, :]), jnp.cumsum(xf, axis=-2)], axis=-2)
    t = jnp.arange(length)
    lo = jnp.clip(t - window // 2, 0, length)
    hi = jnp.clip(t + window // 2, 0, length)
    s = jnp.take(prefix, hi, axis=-2) - jnp.take(prefix, lo, axis=-2)
    cnt = (hi - lo).astype(jnp.float32)[:, None]
    return (s / cnt).astype(x.dtype)


def pool_mixer(xp, w_lin, scale):
    grp = xp.reshape(xp.shape[:-1] + (POOL_GROUPS, POOL_GROUP_DIM))
    pooled = jnp.stack([centred_box_mean(grp[..., g, :], w) for g, w in enumerate(POOL_WINDOWS)], axis=-2)
    y = jnp.einsum('...lgc,gcd->...lgd', pooled - grp, w_lin)
    return y.reshape(xp.shape) * scale


def dwconv_centred(x, w, b):
    k = w.shape[0]
    length = x.shape[1]
    left = k // 2
    xp = jnp.pad(x, ((0, 0), (left, k - 1 - left), (0, 0)))
    y = b
    for j in range(k):
        y = y + xp[:, j:j + length, :] * w[j]
    return y


def mlstm_prepare(qk, v, gates, conv_w, conv_b):
    qk = jax.nn.silu(dwconv_centred(qk, conv_w, conv_b))
    q, k = jnp.split(qk, 2, axis=-1)
    b, length, _ = v.shape

    def heads(a):
        return a.reshape(b, length, MLSTM_HEADS, MLSTM_HEAD_DIM).transpose(0, 2, 1, 3).astype(jnp.float32)

    g = gates.astype(jnp.float32).reshape(b, length, 4, MLSTM_HEADS).transpose(2, 0, 3, 1)
    return heads(q), heads(k) * MLSTM_HEAD_DIM ** -0.5, heads(v), g


def mlstm_chunk_scan(q, k, v, log_i, log_f, state):
    b, h, length, dh = q.shape
    nc = length // MLSTM_CHUNK
    lower = jnp.tril(jnp.ones((MLSTM_CHUNK, MLSTM_CHUNK), dtype=bool))

    def chunks(a):
        return jnp.moveaxis(a.reshape((b, h, nc, MLSTM_CHUNK) + a.shape[3:]), 2, 0)

    def step(carry, xs):
        c_mat, n_vec, m = carry
        qc, kc, vc, ic, fc = xs
        bcum = jnp.cumsum(fc, axis=-1)
        dmat = jnp.where(lower, bcum[..., :, None] - bcum[..., None, :] + ic[..., None, :], -jnp.inf)
        inter = bcum + m[..., None]
        m_t = jnp.maximum(inter, dmat.max(-1))
        decay = jnp.exp(inter - m_t)
        scores = jnp.einsum('bhtd,bhsd->bhts', qc, kc) * jnp.exp(dmat - m_t[..., None])
        num = decay[..., None] * jnp.einsum('bhvk,bhtk->bhtv', c_mat, qc) + jnp.einsum('bhts,bhsv->bhtv', scores, vc)
        den = decay * jnp.einsum('bhk,bhtk->bht', n_vec, qc) + scores.sum(-1)
        out = num / jnp.maximum(jnp.abs(den), jnp.exp(-m_t))[..., None]
        total = bcum[..., -1]
        wlog = total[..., None] - bcum + ic
        m_new = jnp.maximum(total + m, wlog.max(-1))
        a = jnp.exp(total + m - m_new)
        wk = jnp.exp(wlog - m_new[..., None])
        c_new = a[..., None, None] * c_mat + jnp.einsum('bhsv,bhsk->bhvk', vc * wk[..., None], kc)
        n_new = a[..., None] * n_vec + jnp.einsum('bhs,bhsk->bhk', wk, kc)
        return (c_new, n_new, m_new), out

    state, hs = lax.scan(step, state, tuple(chunks(a) for a in (q, k, v, log_i, log_f)))
    return jnp.moveaxis(hs, 0, 2).reshape(b, h, length, dh), state


def mlstm_bidirectional(ctx_in, lat_in):
    qc, kc, vc, gc = ctx_in
    ql, kl, vl, gl = lat_in
    b = qc.shape[0]
    zero = (jnp.zeros((b, MLSTM_HEADS, MLSTM_HEAD_DIM, MLSTM_HEAD_DIM), jnp.float32),
            jnp.zeros((b, MLSTM_HEADS, MLSTM_HEAD_DIM), jnp.float32),
            jnp.zeros((b, MLSTM_HEADS), jnp.float32))
    ls = jax.nn.log_sigmoid
    hc_f, st_f = mlstm_chunk_scan(qc, kc, vc, gc[0], ls(gc[1]), zero)
    hl_f, _ = mlstm_chunk_scan(ql, kl, vl, gl[0], ls(gl[1]), st_f)
    fs = lambda a: jnp.flip(a, axis=2)
    fg = lambda a: jnp.flip(a, axis=-1)
    hc_b, st_b = mlstm_chunk_scan(fs(qc), fs(kc), fs(vc), fg(gc[2]), ls(fg(gc[3])), zero)
    hl_b, _ = mlstm_chunk_scan(fs(ql), fs(kl), fs(vl), fg(gl[2]), ls(fg(gl[3])), st_b)
    return hc_f + fs(hc_b), hl_f + fs(hl_b)


def mlstm_output(h, o, norm_g):
    b, _, length, _ = h.shape
    mu = h.mean(-1, keepdims=True)
    var = jnp.square(h - mu).mean(-1, keepdims=True)
    hn = ((h - mu) * lax.rsqrt(var + HEAD_NORM_EPS)).transpose(0, 2, 1, 3).reshape(b, length, MLSTM_WIDTH)
    return (hn * norm_g * jax.nn.sigmoid(o.astype(jnp.float32))).astype(o.dtype)


def sgu_mixer(uv, ln_g, ln_b, w_s, b_s):
    u, v = jnp.split(jax.nn.gelu(uv, approximate=False), 2, axis=-1)
    v = layer_norm(v, ln_g, ln_b)
    b, length, _ = v.shape
    vc = v.reshape(b, length // SGU_CHUNK, SGU_CHUNK, SGU_GROUPS, SGU_GROUP_DIM)
    mixed = jnp.einsum('gts,bnsgc->bntgc', w_s, vc) + b_s.T[:, :, None]
    return u * mixed.reshape(b, length, SGU_WIDTH)


def branch_merge(pool_o, mlstm_o, sgu_o, gate_pre, w_bp, w_bm, w_bs, w_o):
    g = jax.nn.sigmoid(gate_pre.astype(jnp.float32)).astype(pool_o.dtype)
    g_p, g_m, g_s = jnp.split(g, N_BRANCH, axis=-1)
    y = g_p * (pool_o @ w_bp) + g_m * (mlstm_o @ w_bm) + g_s * (sgu_o @ w_bs)
    return y @ w_o


def moe_ffn(h, w_router, b_router, w_gate_up, b_gate_up, w_down, b_down):
    logits = (h @ w_router + b_router).astype(jnp.float32)
    top_val, top_idx = lax.top_k(logits, TOP_K)
    probs = jax.nn.softmax(top_val, axis=-1)
    combine = jnp.einsum('nk,nke->en', probs, jax.nn.one_hot(top_idx, N_EXPERTS, dtype=jnp.float32)).astype(h.dtype)

    def expert(acc, xs):
        wgu, bgu, wd, bd, cw = xs
        gate, up = jnp.split(h @ wgu + bgu, 2, axis=-1)
        gate = jnp.minimum(gate, SWIGLU_LIMIT)
        up = jnp.clip(up, -SWIGLU_LIMIT, SWIGLU_LIMIT)
        glu = gate * jax.nn.sigmoid(SWIGLU_ALPHA * gate)
        y = ((up + 1) * glu) @ wd + bd
        return acc + cw[:, None] * y, None

    out, _ = lax.scan(expert, jnp.zeros_like(h), (w_gate_up, b_gate_up, w_down, b_down, combine))
    return out


def setup_inputs(seed: int = 0) -> dict:
    key = jax.random.key(seed)
    ks = iter(jax.random.split(key, 40))

    def nrm(shape, scale):
        return scale * jax.random.normal(next(ks), shape, jnp.float32)

    L, D, E, F = DEPTH, D_MODEL, N_EXPERTS, D_FF
    f_bias = jnp.linspace(3.0, 6.0, MLSTM_HEADS, dtype=jnp.float32)
    b_in = nrm((L, IN_COLS), 0.02)
    b_in = b_in.at[:, MLSTM_GATE_OFF + MLSTM_HEADS:MLSTM_GATE_OFF + 2 * MLSTM_HEADS].add(f_bias)
    b_in = b_in.at[:, MLSTM_GATE_OFF + 3 * MLSTM_HEADS:MLSTM_GATE_OFF + 4 * MLSTM_HEADS].add(f_bias)
    return {
        'x': nrm((BATCH, SEQ, D), 1.0),
        'c': nrm((BATCH, D), 1.0),
        'ctx': nrm((BATCH, CTX_LEN, D), 1.0),
        'c_ctx': nrm((D,), 1.0),
        'w_ada': nrm((L, D, 6 * D), 0.5 * D ** -0.5),
        'b_ada': nrm((L, 6 * D), 0.02),
        'w_in': nrm((L, D, IN_COLS), D ** -0.5),
        'b_in': b_in,
        'pool_w': nrm((L, POOL_GROUPS, POOL_GROUP_DIM, POOL_GROUP_DIM), POOL_GROUP_DIM ** -0.5),
        'pool_scale': 1.0 + nrm((L, POOL_WIDTH), 0.02),
        'qk_conv_w': nrm((L, QK_CONV_WIDTH, 2 * MLSTM_WIDTH), QK_CONV_WIDTH ** -0.5),
        'qk_conv_b': nrm((L, 2 * MLSTM_WIDTH), 0.02),
        'mlstm_norm_g': 1.0 + nrm((L, MLSTM_WIDTH), 0.02),
        'sgu_ln_g': 1.0 + nrm((L, SGU_WIDTH), 0.02),
        'sgu_ln_b': nrm((L, SGU_WIDTH), 0.02),
        'sgu_w': nrm((L, SGU_GROUPS, SGU_CHUNK, SGU_CHUNK), SGU_CHUNK ** -0.5),
        'sgu_b': 1.0 + nrm((L, SGU_GROUPS, SGU_CHUNK), 0.02),
        'w_br_pool': nrm((L, POOL_WIDTH, D), POOL_WIDTH ** -0.5),
        'w_br_mlstm': nrm((L, MLSTM_WIDTH, D), MLSTM_WIDTH ** -0.5),
        'w_br_sgu': nrm((L, SGU_WIDTH, D), SGU_WIDTH ** -0.5),
        'w_out': nrm((L, D, D), DEEPNORM_BETA * D ** -0.5),
        'ln1_g': 1.0 + nrm((L, D), 0.02),
        'ln1_b': nrm((L, D), 0.02),
        'w_router': nrm((L, D, E), D ** -0.5),
        'b_router': nrm((L, E), 0.01),
        'w_gate_up': nrm((L, E, D, 2 * F), D ** -0.5),
        'b_gate_up': nrm((L, E, 2 * F), 0.02),
        'w_down': nrm((L, E, F, D), DEEPNORM_BETA * F ** -0.5),
        'b_down': nrm((L, E, D), 0.02),
        'ln2_g': 1.0 + nrm((L, D), 0.02),
        'ln2_b': nrm((L, D), 0.02),
    }


def reference(x, c, ctx, c_ctx, w_ada, b_ada, w_in, b_in, pool_w, pool_scale, qk_conv_w, qk_conv_b,
              mlstm_norm_g, sgu_ln_g, sgu_ln_b, sgu_w, sgu_b, w_br_pool, w_br_mlstm, w_br_sgu, w_out,
              ln1_g, ln1_b, w_router, b_router, w_gate_up, b_gate_up, w_down, b_down, ln2_g, ln2_b):
    B, S, D = x.shape
    rows = S // GRID_W
    xl, xc = x, ctx
    for i in range(DEPTH):
        last = i == DEPTH - 1
        sh1_l, sc1_l, g1_l, sh2_l, sc2_l, g2_l = [
            m[:, None, :] for m in jnp.split(jax.nn.silu(c) @ w_ada[i] + b_ada[i], 6, axis=-1)]
        sh1_c, sc1_c, g1_c, sh2_c, sc2_c, g2_c = jnp.split(jax.nn.silu(c_ctx) @ w_ada[i] + b_ada[i], 6, axis=-1)

        z_l = modulate(layer_norm_plain(xl), sh1_l, sc1_l) @ w_in[i] + b_in[i]
        z_c = modulate(layer_norm_plain(xc), sh1_c, sc1_c) @ w_in[i] + b_in[i]
        p_l, qk_l, v_l, o_l, gt_l, uv_l, mg_l = split_in(z_l)
        p_c, qk_c, v_c, o_c, gt_c, uv_c, mg_c = split_in(z_c)

        hm_c, hm_l = mlstm_bidirectional(
            mlstm_prepare(qk_c, v_c, gt_c, qk_conv_w[i], qk_conv_b[i]),
            mlstm_prepare(qk_l, v_l, gt_l, qk_conv_w[i], qk_conv_b[i]))
        merge_w = (w_br_pool[i], w_br_mlstm[i], w_br_sgu[i], w_out[i])
        moe_w = (w_router[i], b_router[i], w_gate_up[i], b_gate_up[i], w_down[i], b_down[i])

        y_l = branch_merge(
            pool_mixer(p_l.reshape(B, rows, GRID_W, POOL_WIDTH), pool_w[i], pool_scale[i]).reshape(B, S, POOL_WIDTH),
            mlstm_output(hm_l, o_l, mlstm_norm_g[i]),
            sgu_mixer(uv_l, sgu_ln_g[i], sgu_ln_b[i], sgu_w[i], sgu_b[i]),
            mg_l, *merge_w)
        xl = layer_norm(DEEPNORM_ALPHA * xl + g1_l * y_l, ln1_g[i], ln1_b[i])
        h_l = modulate(layer_norm_plain(xl), sh2_l, sc2_l).reshape(B * S, D)

        if last:
            f_l = moe_ffn(h_l, *moe_w)
        else:
            y_c = branch_merge(
                pool_mixer(p_c, pool_w[i], pool_scale[i]),
                mlstm_output(hm_c, o_c, mlstm_norm_g[i]),
                sgu_mixer(uv_c, sgu_ln_g[i], sgu_ln_b[i], sgu_w[i], sgu_b[i]),
                mg_c, *merge_w)
            xc = layer_norm(DEEPNORM_ALPHA * xc + g1_c * y_c, ln1_g[i], ln1_b[i])
            h_c = modulate(layer_norm_plain(xc), sh2_c, sc2_c).reshape(-1, D)
            f_all = moe_ffn(jnp.concatenate([h_l, h_c], axis=0), *moe_w)
            f_l, f_c = f_all[:B * S], f_all[B * S:]
            xc = layer_norm(DEEPNORM_ALPHA * xc + g2_c * f_c.reshape(xc.shape), ln2_g[i], ln2_b[i])
        xl = layer_norm(DEEPNORM_ALPHA * xl + g2_l * f_l.reshape(B, S, D), ln2_g[i], ln2_b[i])
    return xl
```

```cpp
#include <hip/hip_runtime.h>
#include <cstdio>
#include <cstdint>

#ifndef MK_N_LAUNCHES
#define MK_N_LAUNCHES 1
#endif

#define LAS __attribute__((address_space(3)))
#define GAS __attribute__((address_space(1)))
typedef unsigned short bf16_t;
typedef short bf16x8 __attribute__((ext_vector_type(8)));
typedef short s16x4 __attribute__((ext_vector_type(4)));
typedef float f32x4 __attribute__((ext_vector_type(4)));
typedef float f32x2 __attribute__((ext_vector_type(2)));
typedef float f32x16 __attribute__((ext_vector_type(16)));
typedef unsigned u32x4 __attribute__((ext_vector_type(4)));
typedef unsigned u32x2 __attribute__((ext_vector_type(2)));
typedef int i32x4 __attribute__((ext_vector_type(4)));
typedef int i32x8 __attribute__((ext_vector_type(8)));

constexpr int D = 1024, NB = 16, SEQ = 4096, CTXL = 256, DEPTH = 4;
constexpr int ML = NB * SEQ;
constexpr int MC = NB * CTXL;
constexpr int MT = ML + MC;
constexpr int NZ = 5888;
constexpr int ZC_P = 0, ZC_QK = 256, ZC_V = 1280, ZC_O = 1792, ZC_UV = 2304, ZC_MG = 2816;
constexpr int NZ_BF = 2816, NZ_F8 = 3072;
constexpr int NEXP = 32, TOPK = 4;
constexpr int NS_MAX = MT * TOPK + NEXP * 256;
constexpr float LN_EPS = 1e-5f, HEAD_EPS = 1e-6f;
constexpr float DN_ALPHA = 1.6817928305074292f;
constexpr int NWAVES = 8, NTHREADS = 512;
constexpr float F8S_ACT = 4.0f, F8S_WGU = 64.0f, F8S_WDN = 64.0f; constexpr int F8E_ACT = 123, F8E_WGU = 123, F8E_WDN = 123;

constexpr size_t MiB = 1u << 20;
constexpr size_t WS_CTL = 0, CTL_ZERO_BYTES = 1 * MiB;
constexpr size_t WS_MOD = 1 * MiB;
constexpr size_t WS_WG = 3 * MiB;
constexpr size_t WS_WSGU = 4 * MiB;
constexpr size_t WS_WPOOL = WS_WSGU + 512 * 1024;
constexpr size_t WS_ROUTE = 5 * MiB;
constexpr size_t WS_WIN = 16 * MiB;
constexpr size_t WS_WBR = 62 * MiB;
constexpr size_t WS_WOUT = 70 * MiB;
constexpr size_t WS_WGU = 78 * MiB;
constexpr size_t WS_WDN = 590 * MiB;
constexpr size_t WS_X = 846 * MiB;
constexpr size_t WS_H = 1118 * MiB;
constexpr size_t WS_Z = 1254 * MiB;
constexpr size_t WS_FS = WS_Z;
constexpr size_t WS_BRA = 2036 * MiB;
constexpr size_t WS_HFB = 2172 * MiB;
constexpr size_t WS_Y = 2444 * MiB;
constexpr size_t WS_T = 2580 * MiB;
constexpr size_t WS_H2 = 2852 * MiB;
constexpr size_t WS_HID = 2988 * MiB;
constexpr size_t WS_ZG = 3548 * MiB;
constexpr size_t WS_H2F8 = 3554 * MiB;
constexpr size_t WS_H8 = 3624 * MiB;
constexpr size_t WS_WIN8 = 3692 * MiB;
constexpr size_t WS_END = 3704 * MiB;
static_assert(WS_Z + (size_t)MT * NZ * 2 <= WS_BRA && WS_FS + (size_t)MT * 4 * 1024 * 2 <= WS_BRA, "Z/FS");
static_assert(WS_HID + (size_t)NS_MAX * 1024 * 2 <= WS_END, "HID");
constexpr size_t RT_EIDX = 0;
constexpr size_t RT_PROB = 2 * MiB;
constexpr size_t RT_TOK = 4 * MiB;
constexpr size_t RT_DEST = 6 * MiB;
constexpr size_t RT_PSLOT = 8 * MiB;
constexpr size_t RT_CNT = 10 * MiB;
constexpr size_t RT_SEG = 10 * MiB + 64 * 1024;
constexpr int CW_BAR = 4096;

constexpr int LDS_BYTES = 163840;
constexpr int MISC_OFF = LDS_BYTES - 256;
constexpr int TAB_OFF = 131072;
constexpr int NW_WT = 0;
constexpr int NW_LG = 66048;
constexpr int NW_END = 99840;
constexpr int NW_PV = NW_END + 256;

__device__ __forceinline__ unsigned f2bf(float f) { unsigned u = __builtin_bit_cast(unsigned, f); return (u + 0x7fffu + ((u >> 16) & 1u)) >> 16; }
__device__ __forceinline__ unsigned pk2(float lo, float hi) { unsigned r; asm volatile("v_cvt_pk_bf16_f32 %0, %1, %2" : "=v"(r) : "v"(lo), "v"(hi)); return r; }
__device__ __forceinline__ unsigned pk4_fp8(float a, float b, float c, float d) { int w = 0; w = __builtin_amdgcn_cvt_pk_fp8_f32(a, b, w, false); w = __builtin_amdgcn_cvt_pk_fp8_f32(c, d, w, true); return (unsigned)w; }
__device__ __forceinline__ float bflo(unsigned w) { return __builtin_bit_cast(float, w << 16); }
__device__ __forceinline__ float bfhi(unsigned w) { return __builtin_bit_cast(float, w & 0xffff0000u); }
__device__ __forceinline__ float bf1(bf16_t h) { return __builtin_bit_cast(float, ((unsigned)h) << 16); }
__device__ __forceinline__ float bperm(int srclane, float v) { return __builtin_bit_cast(float, __builtin_amdgcn_ds_bpermute(srclane << 2, __builtin_bit_cast(int, v))); }
__device__ __forceinline__ float shx(float v, int o, int lane) { return bperm(lane ^ o, v); }
__device__ __forceinline__ float shup(float v, int o, int lane) { return bperm(lane >= o ? lane - o : lane, v); }
__device__ __forceinline__ float wave_sum(float v, int lane) {
#pragma unroll
    for (int o = 1; o < 64; o <<= 1) v += shx(v, o, lane);
    return v;
}
__device__ __forceinline__ float sigmoidf_(float x) { return __builtin_amdgcn_rcpf(1.0f + __builtin_amdgcn_exp2f(x * -1.4426950408889634f)); }
__device__ __forceinline__ float siluf_(float x) { return x * __builtin_amdgcn_rcpf(1.0f + __builtin_amdgcn_exp2f(x * -1.4426950408889634f)); }
#define LDS_WAIT() asm volatile("s_waitcnt lgkmcnt(0)" ::: "memory")
#define VM_WAIT() asm volatile("s_waitcnt vmcnt(0)" ::: "memory")

#define XB_TMO      128
#define XB_XCNT(j)  (256  + 64 * (j))
#define XB_XSUB(j)  (1280 + 64 * (j))
#define XB_XGEN(j)  (2304 + 64 * (j))
#define XB_TOP      3328
#define XB_TOPGEN   3392
#define XCD_BAR_WORDS 3456
#define XB_SPIN_CAP (1u << 18)
__device__ __forceinline__ unsigned xb_ld(unsigned* p)              { return __hip_atomic_load(p, __ATOMIC_RELAXED, __HIP_MEMORY_SCOPE_AGENT); }
__device__ __forceinline__ unsigned xb_add(unsigned* p, unsigned v) { return __hip_atomic_fetch_add(p, v, __ATOMIC_RELAXED, __HIP_MEMORY_SCOPE_AGENT); }
__device__ __forceinline__ unsigned xb_xcc_id() { return (unsigned)__builtin_amdgcn_s_getreg((3 << 11) | 20) & 0xFu; }
#define XB_SPIN(cond, bar) do { unsigned _sp = 0; while (cond) { __builtin_amdgcn_s_sleep(1); \
    if ((++_sp & 255u) == 0u) { if (xb_ld(&(bar)[XB_TMO])) break; if (_sp > XB_SPIN_CAP) { atomicAdd(&(bar)[XB_TMO], 1u); break; } } } } while (0)
struct XcdBarrier { unsigned* bar; unsigned x; volatile LAS unsigned* st; };
__device__ __forceinline__ XcdBarrier xcd_barrier_post(unsigned* bar, volatile LAS unsigned* st) {
    XcdBarrier b; b.bar = bar; b.x = xb_xcc_id(); b.st = st;
    if (threadIdx.x == 0) (void)xb_add(&bar[XB_XCNT(b.x)], 1u);
    return b;
}
__device__ __forceinline__ void xcd_barrier_complete(unsigned* bar, unsigned x, unsigned& nloc, unsigned& nx) {
    const unsigned G = gridDim.x * gridDim.y * gridDim.z;
    unsigned sum, cnt, mine, sp = 0u;
    for (;;) {
        sum = 0u; cnt = 0u; mine = 0u;
#pragma unroll
        for (unsigned j = 0; j < 16; ++j) { const unsigned c = xb_ld(&bar[XB_XCNT(j)]); sum += c; cnt += (c > 0u) ? 1u : 0u; mine = (j == x) ? c : mine; }
        if (sum == G) break;
        __builtin_amdgcn_s_sleep(1);
        if ((++sp & 255u) == 0u) { if (xb_ld(&bar[XB_TMO])) break; if (sp > XB_SPIN_CAP) { atomicAdd(&bar[XB_TMO], 1u); break; } }
    }
    nloc = mine > 0u ? mine : 1u; nx = cnt > 0u ? cnt : 1u;
}
__device__ __forceinline__ void xcd_barrier(const XcdBarrier& b) {
    asm volatile("s_waitcnt vmcnt(0)" ::: "memory");
    __syncthreads();
    if (threadIdx.x == 0) {
        unsigned* bar = b.bar;
        __builtin_amdgcn_s_waitcnt(0);
        unsigned nloc = b.st[0], nx = b.st[1];
        if (nloc == 0u) { xcd_barrier_complete(bar, b.x, nloc, nx); b.st[0] = nloc; b.st[1] = nx; }
        const unsigned old = xb_add(&bar[XB_XSUB(b.x)], 1u);
        const unsigned gen = old / nloc;
        if (old + 1u == (gen + 1u) * nloc) {
            __builtin_amdgcn_fence(__ATOMIC_RELEASE, "agent");
            asm volatile("s_waitcnt vmcnt(0)" ::: "memory");
            const unsigned og = xb_add(&bar[XB_TOP], 1u);
            const unsigned tg = og / nx;
            if (og + 1u == (tg + 1u) * nx) xb_add(&bar[XB_TOPGEN], 1u);
            else XB_SPIN(xb_ld(&bar[XB_TOPGEN]) == tg, bar);
            __builtin_amdgcn_fence(__ATOMIC_ACQUIRE, "agent");
            xb_add(&bar[XB_XGEN(b.x)], 1u);
            asm volatile("s_waitcnt vmcnt(0)" ::: "memory");
        } else {
            XB_SPIN(xb_ld(&bar[XB_XGEN(b.x)]) == gen, bar);
            __builtin_amdgcn_fence(__ATOMIC_ACQUIRE, "agent");
            asm volatile("s_waitcnt vmcnt(0)" ::: "memory");
        }
    }
    __syncthreads();
}

namespace pg8 {
constexpr int BM = 256, BK = 64, HALF = 128, HTB = HALF * BK * 2, STAGE_BYTES = 8 * HTB, NXCD = 8, WGM = 8;
__host__ __device__ __forceinline__ int lds_byte(int r, int c) { const int st = (r >> 4) * 2 + (c >> 5), rr = r & 15, cc = c & 31, ob = rr * 64 + cc * 2; return st * 1024 + (ob ^ (((ob >> 9) & 1) << 5)); }
__host__ __device__ __forceinline__ void stage_rc(int b, int& R, int& C) { const int st = b / 1024, sb = b % 1024, swz = sb ^ (((sb >> 9) & 1) << 5); R = (st >> 1) * 16 + swz / 64; C = (st & 1) * 32 + (swz % 64) / 2; }
__host__ __device__ __forceinline__ int perm32(int rho) { const int n = rho >> 4, i = rho & 15; return 8 * (i >> 2) + 4 * n + (i & 3); }
struct Unit { int pm, pn, sub; };
__device__ __forceinline__ unsigned cvt_pk_bf16(float lo, float hi) { unsigned r; asm volatile("v_cvt_pk_bf16_f32 %0, %1, %2" : "=v"(r) : "v"(lo), "v"(hi)); return r; }
__device__ __forceinline__ f32x2 gelu_pk(f32x2 v) {
    const f32x2 av = __builtin_elementwise_abs(v), d = av * 0.2316418882f + 1.0f;
    f32x2 t; t.x = __builtin_amdgcn_rcpf(d.x); t.y = __builtin_amdgcn_rcpf(d.y);
    f32x2 q = t * 0.5307027145f + (-0.7265760135f); q = q * t + 0.7107068705f; q = q * t + (-0.142248368f); q = q * t + 0.127414796f; q = q * t;
    const f32x2 s = (v * v) * (-0.72134752044f);
    f32x2 e; e.x = __builtin_amdgcn_exp2f(s.x); e.y = __builtin_amdgcn_exp2f(s.y);
    const f32x2 m = v * (q * e), r = v - m;
    f32x2 o; o.x = v.x < 0.f ? m.x : r.x; o.y = v.y < 0.f ? m.y : r.y; return o;
}
template <int NSUB = 1> struct StaticOrder {
    int nM, nN, nwg, G, c;
    __device__ void init(int nM_, int nN_, int G_, int c_) { nM = nM_; nN = nN_; nwg = nM * nN; G = G_; c = c_; }
    __device__ bool next(int i, Unit& u) const {
        const int it = i / NSUB; u.sub = i - it * NSUB;
        const long L = (long)it * G + c; if (L >= nwg) return false;
        int wgid = (int)L; { const int q = nwg / NXCD, r = nwg % NXCD, xcd = wgid % NXCD, off = wgid / NXCD; wgid = (xcd < r ? xcd * (q + 1) : r * (q + 1) + (xcd - r) * q) + off; }
        const int nig = WGM * nN, gid = wgid / nig, fm = gid * WGM, gsz = (nM - fm) < WGM ? (nM - fm) : WGM;
        u.pm = fm + ((wgid % nig) % gsz); u.pn = (wgid % nig) / gsz; return true;
    }
};
constexpr int SIDE_TOK = 131072 + 2048;
constexpr int SIDE_SLOT = 131072 + 10240, SIDE_SLOT_BYTES = 3072;
__device__ __forceinline__ void dma16(unsigned voff, const void* sbase, unsigned ldsaddr) { asm volatile("s_mov_b32 m0, %2\n\tglobal_load_lds_dwordx4 %0, %1" :: "v"(voff), "s"(sbase), "s"(ldsaddr) : "memory", "m0"); }
__device__ __forceinline__ void dma4(unsigned voff, const void* sbase, unsigned ldsaddr) { asm volatile("s_mov_b32 m0, %2\n\tglobal_load_lds_dword %0, %1" :: "v"(voff), "s"(sbase), "s"(ldsaddr) : "memory", "m0"); }
template <class Prob, class Sched, class Epi>
__device__ __forceinline__ void gemm_phase(LAS unsigned char* lds, const int tid, const Prob& P, const Sched& S, const Epi& E) {
    const int wid = __builtin_amdgcn_readfirstlane(tid >> 6), lane = tid & 63, wr = wid >> 2, wc = wid & 3, fr = lane & 15, fq = lane >> 4;
    const int lda = P.lda, ldb = P.ldb;
    unsigned voffB[2], offA[2][2];
#define PG8_TOKSLOT(name) const LAS int* name; { PG8_TID(tl2_); name = (const LAS int*)(lds + SIDE_TOK) + (tl2_ >> 6) * 256 + (tl2_ & 63); }
#define PG8_TID(v_) int v_; asm volatile("v_mbcnt_lo_u32_b32 %0, -1, 0\n\tv_mbcnt_hi_u32_b32 %0, -1, %0" : "=v"(v_)); v_ |= (wid << 6)
#define PG8_RC(R_, C_) int R_[2], C_[2]; { PG8_TID(tl_); _Pragma("unroll") for (int i_ = 0; i_ < 2; ++i_) stage_rc(tl_ * 16 + i_ * 8192, R_[i_], C_[i_]); }
#pragma unroll
    for (int i = 0; i < 2; ++i) { int R, C; stage_rc(tid * 16 + i * 8192, R, C); const int Rb = Epi::PERM ? ((R & ~31) + perm32(R & 31)) : R;
        voffB[i] = (unsigned)(Rb * ldb + C) * 2u;
        offA[0][i] = (unsigned)(R * lda + C) * 2u; offA[1][i] = (unsigned)((R + HALF) * lda + C) * 2u; }
    const size_t kstep = (size_t)(BK * 2);
    const size_t hstep = (size_t)HALF * ldb * 2;
    const unsigned ldsw = (unsigned)wid * 1024u;
    const int aoff = lds_byte(wr * 64 + fr, fq * 8), boff = lds_byte(wc * 32 + fr, fq * 8);
#define PG8_SA(b, h) (((b) * 2 + (h)) * HTB)
#define PG8_SB(b, h) ((4 + (b) * 2 + (h)) * HTB)
    const unsigned ldsb = (unsigned)(size_t)lds;
#define PG8_STAGE(bufoff, gbase, voff) do { _Pragma("unroll") for (int _i = 0; _i < 2; ++_i) \
        asm volatile("s_mov_b32 m0, %2\n\tglobal_load_lds_dwordx4 %0, %1" :: "v"((voff)[_i]), "s"((const char*)(gbase)), "s"(ldsb + (unsigned)(bufoff) + ldsw + (unsigned)(_i * 8192)) : "memory", "m0"); } while (0)
#define PG8_CAT(x0, x1) __builtin_shufflevector(x0, x1, 0, 1, 2, 3, 4, 5, 6, 7)
#define PG8_LDA(dst, b, h) do { if constexpr (Prob::FP8) { _Pragma("unroll") for (int m = 0; m < 4; ++m) dst##8[m] = PG8_CAT(*(const LAS i32x4*)(lds + PG8_SA(b, h) + aoff + m * 2048), *(const LAS i32x4*)(lds + PG8_SA(b, h) + aoff + m * 2048 + 1024)); } \
        else { _Pragma("unroll") for (int m = 0; m < 4; ++m) _Pragma("unroll") for (int k = 0; k < 2; ++k) dst[m][k] = *(const LAS bf16x8*)(lds + PG8_SA(b, h) + aoff + m * 2048 + k * 1024); } } while (0)
#define PG8_LDB(dst, b, h) do { if constexpr (Prob::FP8) { _Pragma("unroll") for (int n = 0; n < 2; ++n) dst##8[n] = PG8_CAT(*(const LAS i32x4*)(lds + PG8_SB(b, h) + boff + n * 2048), *(const LAS i32x4*)(lds + PG8_SB(b, h) + boff + n * 2048 + 1024)); } \
        else { _Pragma("unroll") for (int n = 0; n < 2; ++n) _Pragma("unroll") for (int k = 0; k < 2; ++k) dst[n][k] = *(const LAS bf16x8*)(lds + PG8_SB(b, h) + boff + n * 2048 + k * 1024); } } while (0)
#define PG8_MMA(ai, bj, At, Bt) do { __builtin_amdgcn_s_setprio(1); \
        if constexpr (Prob::FP8) { _Pragma("unroll") for (int m = 0; m < 4; ++m) _Pragma("unroll") for (int n = 0; n < 2; ++n) \
            acc[ai][bj][m][n] = __builtin_amdgcn_mfma_scale_f32_16x16x128_f8f6f4(Bt##8[n], At##8[m], acc[ai][bj][m][n], 0, 0, 0, Prob::SCALE_B, 0, Prob::SCALE_A); } \
        else { _Pragma("unroll") for (int m = 0; m < 4; ++m) _Pragma("unroll") for (int n = 0; n < 2; ++n) _Pragma("unroll") for (int k = 0; k < 2; ++k) \
            acc[ai][bj][m][n] = __builtin_amdgcn_mfma_f32_16x16x32_bf16(Bt[n][k], At[m][k], acc[ai][bj][m][n], 0, 0, 0); } \
        __builtin_amdgcn_s_setprio(0); } while (0)
#define PG8_WAIT_V(n) asm volatile("s_waitcnt vmcnt(" #n ")" ::: "memory")
#define PG8_WAIT_L(n) asm volatile("s_waitcnt lgkmcnt(" #n ")" ::: "memory")
#define PG8_BAR __builtin_amdgcn_s_barrier()
#define PG8_SCHED __builtin_amdgcn_sched_barrier(0)
    Unit cur, nxt; int ui = 0;
    if (!S.next(0, cur)) return;
    f32x4 acc[2][2][4][2];
#pragma unroll
    for (int a = 0; a < 2; ++a)
#pragma unroll
        for (int b = 0; b < 2; ++b)
#pragma unroll
            for (int m = 0; m < 4; ++m)
#pragma unroll
                for (int n = 0; n < 2; ++n) acc[a][b][m][n] = (f32x4){0.f, 0.f, 0.f, 0.f};
    bf16x8 At[4][2], B0[2][2], B1[2][2]; i32x8 At8[4], B08[2], B18[2];
    const char* cA = P.a_base(cur); const char* cB = P.b_base(cur); int nt = P.nt(cur);
    if constexpr (Prob::GATHER) { PG8_RC(Rr, Cc); P.a_rows(cur, Rr, Cc, offA); }
    if constexpr (Epi::SIDE) { PG8_TID(tl4_); E.side(cur, ldsb + SIDE_SLOT, wid, tl4_ & 63); }
    PG8_STAGE(PG8_SB(0, 0), cB, voffB); PG8_STAGE(PG8_SB(0, 1), cB + hstep, voffB); PG8_STAGE(PG8_SA(0, 0), cA, offA[0]); PG8_STAGE(PG8_SA(0, 1), cA, offA[1]);
    if (wr == 1) PG8_BAR;
    PG8_WAIT_V(2); PG8_BAR;
    PG8_STAGE(PG8_SB(1, 0), cB + kstep, voffB); PG8_STAGE(PG8_SA(1, 0), cA + kstep, offA[0]); PG8_STAGE(PG8_SB(1, 1), cB + hstep + kstep, voffB);
    PG8_WAIT_V(6); PG8_BAR;
    for (;;) {
        const bool has_next = S.next(ui + 1, nxt);
        const char* nA = has_next ? P.a_base(nxt) : cA; const char* nB = has_next ? P.b_base(nxt) : cB;
        if constexpr (Prob::GATHER) { if (has_next) { PG8_RC(Rr, Cc); (void)Cc;
#pragma unroll
            for (int h = 0; h < 2; ++h)
#pragma unroll
                for (int i = 0; i < 2; ++i) dma4((unsigned)(nxt.pm * 256 + h * 128 + Rr[i]) * 4u, P.tok, ldsb + SIDE_TOK + (unsigned)wid * 1024u + (unsigned)((h * 2 + i) * 256)); } }
        if constexpr (Epi::SIDE) { if (has_next) { PG8_TID(tl4_); E.side(nxt, ldsb + SIDE_SLOT + (unsigned)(((ui + 1) % 3) * SIDE_SLOT_BYTES), wid, tl4_ & 63); } }
        for (int t = 0; t < nt; t += 2) {
            const bool last = (t == nt - 2);
            if constexpr (Epi::KHOOK) { if (t == Epi::HOOK_T0 || t == Epi::HOOK_T1) {
                asm volatile("" ::: "memory"); PG8_TID(tlh_); const int lnh_ = tlh_ & 63; E.hook(acc, cur, t == Epi::HOOK_T0 ? 0 : 1, wr, wc, lnh_ & 15, lnh_ >> 4); asm volatile("" ::: "memory"); } }
            const char* a1 = cA + (size_t)(t + 1) * kstep;
            const char* a2 = last ? nA : cA + (size_t)(t + 2) * kstep; const char* b2 = last ? nB : cB + (size_t)(t + 2) * kstep;
            const char* a3 = a2 + kstep; const char* b3 = b2 + kstep;
            unsigned o2[2][2];
#pragma unroll
            for (int h = 0; h < 2; ++h)
#pragma unroll
                for (int i = 0; i < 2; ++i) o2[h][i] = offA[h][i];
            if constexpr (Prob::GATHER) { if (last && has_next) { PG8_RC(Rr, Cc); (void)Rr; PG8_TOKSLOT(tokslot); const int ntok[2][2] = {{tokslot[0], tokslot[64]}, {tokslot[128], tokslot[192]}}; P.a_off(ntok, Cc, o2); } }
            PG8_LDB(B0, 0, 0); PG8_LDB(B1, 0, 1); PG8_SCHED; PG8_LDA(At, 0, 0); PG8_STAGE(PG8_SA(1, 1), a1, offA[1]);
            PG8_WAIT_V(8); PG8_WAIT_L(0); PG8_BAR; PG8_MMA(0, 0, At, B0); PG8_MMA(0, 1, At, B1); PG8_BAR; PG8_SCHED;
            PG8_LDA(At, 0, 1); PG8_STAGE(PG8_SB(0, 0), b2, voffB); PG8_STAGE(PG8_SB(0, 1), b2 + hstep, voffB); PG8_STAGE(PG8_SA(0, 0), a2, o2[0]);
            PG8_WAIT_V(8); PG8_WAIT_L(0); PG8_BAR; PG8_MMA(1, 0, At, B0); PG8_MMA(1, 1, At, B1); PG8_BAR; PG8_SCHED;
            PG8_LDB(B0, 1, 0); PG8_LDB(B1, 1, 1); PG8_SCHED; PG8_LDA(At, 1, 0); PG8_STAGE(PG8_SA(0, 1), a2, o2[1]);
            PG8_WAIT_V(8); PG8_WAIT_L(0); PG8_BAR; PG8_MMA(0, 0, At, B0); PG8_MMA(0, 1, At, B1); PG8_BAR; PG8_SCHED;
            PG8_LDA(At, 1, 1); PG8_STAGE(PG8_SB(1, 0), b3, voffB); PG8_STAGE(PG8_SB(1, 1), b3 + hstep, voffB); PG8_STAGE(PG8_SA(1, 0), a3, o2[0]);
            PG8_WAIT_V(8); PG8_WAIT_L(0); PG8_BAR; PG8_MMA(1, 0, At, B0); PG8_MMA(1, 1, At, B1); PG8_BAR; PG8_SCHED;
        }
        if (wr == 0) PG8_BAR;
        { PG8_TID(tl3_); const int ln_ = tl3_ & 63; E(acc, cur, wr, wc, ln_ & 15, ln_ >> 4, lds + SIDE_SLOT + (ui % 3) * SIDE_SLOT_BYTES); }
        if (!has_next) break;
        bool keep = false;
        if constexpr (Epi::CHAIN) keep = E.keep(cur);
        if (!keep) {
#pragma unroll
            for (int a = 0; a < 2; ++a)
#pragma unroll
                for (int b = 0; b < 2; ++b)
#pragma unroll
                    for (int m = 0; m < 4; ++m)
#pragma unroll
                        for (int n = 0; n < 2; ++n) acc[a][b][m][n] = (f32x4){0.f, 0.f, 0.f, 0.f};
        }
        cur = nxt; cA = nA; cB = nB; nt = P.nt(cur); ++ui;
        if constexpr (Prob::GATHER) { PG8_RC(Rr, Cc); (void)Rr; PG8_TOKSLOT(tokslot); const int ntok[2][2] = {{tokslot[0], tokslot[64]}, {tokslot[128], tokslot[192]}}; P.a_off(ntok, Cc, offA); }
        if (wr == 1) PG8_BAR;
    }
    PG8_WAIT_V(0);
    PG8_BAR;
#undef PG8_RC
#undef PG8_TID
#undef PG8_TOKSLOT
#undef PG8_SA
#undef PG8_SB
#undef PG8_STAGE
#undef PG8_LDA
#undef PG8_LDB
#undef PG8_MMA
#undef PG8_CAT
#undef PG8_WAIT_V
#undef PG8_WAIT_L
#undef PG8_BAR
#undef PG8_SCHED
}
}

typedef const float* cfp_t;
typedef const cfp_t __attribute__((address_space(4))) * InTab;
struct Frame {
    LAS unsigned char* lds;
    volatile LAS unsigned* MISC;
    unsigned char* ws;
    InTab in;
    float* out;
    int tid, lane, wave, G, bid;
};
enum { IN_X = 0, IN_C, IN_CTX, IN_CCTX, IN_WADA, IN_BADA, IN_WIN, IN_BIN, IN_POOLW, IN_POOLS, IN_CONVW, IN_CONVB, IN_MNG, IN_SLNG, IN_SLNB, IN_SGUW, IN_SGUB,
       IN_WBP, IN_WBM, IN_WBS, IN_WOUT, IN_LN1G, IN_LN1B, IN_WR, IN_BR, IN_WGU, IN_BGU, IN_WDN, IN_BDN, IN_LN2G, IN_LN2B };
__device__ __forceinline__ int mod_row(int row) { return row < ML ? (row >> 12) : NB; }
__device__ __forceinline__ const float* modp(const Frame& F, int l, int row, int part) { return (const float*)(F.ws + WS_MOD) + ((size_t)(l * 17 + mod_row(row)) * 6 + part) * 1024; }

__device__ __forceinline__ void transpose_item(const float* W, size_t ldw, int k0, int srccol0, bf16_t* dst, size_t ldk, int kd0, LAS float* scr, int lane) {
#pragma unroll 8
    for (int i = 0; i < 32; ++i) { const int kk = 2 * i + (lane >> 5); scr[kk * 33 + (lane & 31)] = __builtin_nontemporal_load(W + (size_t)(k0 + kk) * ldw + srccol0 + (lane & 31)); }
    LDS_WAIT(); asm volatile("" ::: "memory");
    const int c = lane & 7;
#pragma unroll
    for (int j = 0; j < 4; ++j) { const int n = (lane >> 3) + 8 * j; const LAS float* s = scr + (8 * c) * 33 + n;
        u32x4 o; o.x = pk2(s[0 * 33], s[1 * 33]); o.y = pk2(s[2 * 33], s[3 * 33]); o.z = pk2(s[4 * 33], s[5 * 33]); o.w = pk2(s[6 * 33], s[7 * 33]);
        *(u32x4*)(dst + (size_t)n * ldk + kd0 + 8 * c) = o; }
    LDS_WAIT(); asm volatile("" ::: "memory");
}
__device__ __forceinline__ void transpose_item_fp8(const float* W, size_t ldw, int k0, int srccol0, unsigned char* dst, size_t ldk, int kd0, float sc, LAS float* scr, int lane) {
#pragma unroll 8
    for (int i = 0; i < 32; ++i) { const int kk = 2 * i + (lane >> 5); scr[kk * 33 + (lane & 31)] = __builtin_nontemporal_load(W + (size_t)(k0 + kk) * ldw + srccol0 + (lane & 31)); }
    LDS_WAIT(); asm volatile("" ::: "memory");
    const int c = lane & 7;
#pragma unroll
    for (int j = 0; j < 4; ++j) { const int n = (lane >> 3) + 8 * j; const LAS float* s_ = scr + (8 * c) * 33 + n;
        u32x2 o; o.x = pk4_fp8(s_[0 * 33] * sc, s_[1 * 33] * sc, s_[2 * 33] * sc, s_[3 * 33] * sc); o.y = pk4_fp8(s_[4 * 33] * sc, s_[5 * 33] * sc, s_[6 * 33] * sc, s_[7 * 33] * sc);
        *(u32x2*)(dst + (size_t)n * ldk + kd0 + 8 * c) = o; }
    LDS_WAIT(); asm volatile("" ::: "memory");
}
__device__ __forceinline__ void phase_prologue(Frame& F) {
    LAS float* scr = (LAS float*)(F.lds + F.wave * 16384);
    const int gw = F.bid * NWAVES + F.wave, NGW = F.G * NWAVES;
    constexpr int I_IN = 16 * (NZ / 32);
    constexpr int I_BR = (4 + 8 + 4) * 32;
    constexpr int I_OUT = 16 * 32;
    constexpr int I_GU = 16 * 64;
    constexpr int I_DN = 16 * 32;
    constexpr int T_IN = DEPTH * I_IN, T_BR = DEPTH * I_BR, T_OUT = DEPTH * I_OUT, T_GU = DEPTH * NEXP * I_GU, T_DN = DEPTH * NEXP * I_DN;
    constexpr int NITEMS = T_IN + T_BR + T_OUT + T_GU + T_DN;
    for (int it = gw; it < NITEMS; it += NGW) {
        int r = it;
        if (r < T_IN) { const int l = r / I_IN; r %= I_IN; const int kb = r / (NZ / 32), nb = r % (NZ / 32); const int n0 = nb * 32, src = n0 < 2304 ? n0 : n0 + 16;
            if (n0 < NZ_BF) transpose_item(F.in[IN_WIN] + (size_t)l * D * 5904, 5904, kb * 64, src, (bf16_t*)(F.ws + WS_WIN) + ((size_t)l * NZ + n0) * D, D, kb * 64, scr, F.lane);
            else transpose_item_fp8(F.in[IN_WIN] + (size_t)l * D * 5904, 5904, kb * 64, src, (unsigned char*)(F.ws + WS_WIN8) + ((size_t)l * NZ_F8 + (n0 - NZ_BF)) * D, D, kb * 64, F8S_WGU, scr, F.lane);
            continue; }
        r -= T_IN;
        if (r < T_BR) { const int l = r / I_BR; r %= I_BR; const int kb = r / 32, nb = r % 32;
            const float* W; int ksrc;
            if (kb < 4) { W = F.in[IN_WBP] + (size_t)l * 256 * D; ksrc = kb * 64; } else if (kb < 12) { W = F.in[IN_WBM] + (size_t)l * 512 * D; ksrc = (kb - 4) * 64; } else { W = F.in[IN_WBS] + (size_t)l * 256 * D; ksrc = (kb - 12) * 64; }
            transpose_item(W, D, ksrc, nb * 32, (bf16_t*)(F.ws + WS_WBR) + ((size_t)l * D + nb * 32) * D, D, kb * 64, scr, F.lane); continue; }
        r -= T_BR;
        if (r < T_OUT) { const int l = r / I_OUT; r %= I_OUT; const int kb = r / 32, nb = r % 32;
            transpose_item(F.in[IN_WOUT] + (size_t)l * D * D, D, kb * 64, nb * 32, (bf16_t*)(F.ws + WS_WOUT) + ((size_t)l * D + nb * 32) * D, D, kb * 64, scr, F.lane); continue; }
        r -= T_OUT;
        if (r < T_GU) { const int le = r / I_GU; r %= I_GU; const int kb = r / 64, nb = r % 64; const int n0 = nb * 32;
            const int pn = n0 >> 8, c = n0 & 255; const int src = c < 128 ? (128 * pn + c) : (1024 + 128 * pn + c - 128);
            transpose_item_fp8(F.in[IN_WGU] + (size_t)le * D * 2048, 2048, kb * 64, src, (unsigned char*)(F.ws + WS_WGU) + ((size_t)le * 2048 + n0) * D, D, kb * 64, F8S_WGU, scr, F.lane); continue; }
        r -= T_GU;
        { const int le = r / I_DN; r %= I_DN; const int kb = r / 32, nb = r % 32;
            transpose_item_fp8(F.in[IN_WDN] + (size_t)le * D * D, D, kb * 64, nb * 32, (unsigned char*)(F.ws + WS_WDN) + ((size_t)le * D + nb * 32) * D, D, kb * 64, F8S_WDN, scr, F.lane); }
    }
    { const int gt = F.bid * NTHREADS + F.tid, NGT = F.G * NTHREADS;
      for (int i = gt; i < DEPTH * 16 * 1024; i += NGT) { const int l = i >> 14, g = (i >> 10) & 15, k = i & 1023; ((float*)(F.ws + WS_WG))[i] = F.in[IN_WIN][((size_t)l * D + k) * 5904 + 2304 + g]; }
      for (int i = gt; i < DEPTH * 4 * 128 * 128; i += NGT) ((bf16_t*)(F.ws + WS_WSGU))[i] = (bf16_t)f2bf(F.in[IN_SGUW][i]);
      for (int i = gt; i < DEPTH * 4 * 64 * 64; i += NGT) { const int lg = i >> 12, d = (i >> 6) & 63, c = i & 63; ((bf16_t*)(F.ws + WS_WPOOL))[i] = (bf16_t)f2bf(F.in[IN_POOLW][(size_t)lg * 4096 + c * 64 + d]); } }
    __syncthreads();
    { LAS float* sc = (LAS float*)F.lds;
      LAS float* part = (LAS float*)(F.lds + 71680);
      for (int i = F.tid; i < 17 * 1024; i += NTHREADS) { const int r = i >> 10, k = i & 1023; const float v = r < 16 ? F.in[IN_C][r * 1024 + k] : F.in[IN_CCTX][k]; sc[i] = siluf_(v); }
      __syncthreads();
      for (int u = F.bid; u < DEPTH * 48; u += F.G) {
          const int l = u / 48, n0 = (u % 48) * 128, col = F.tid & 127, ks = F.tid >> 7;
          float a[17];
#pragma unroll
          for (int r = 0; r < 17; ++r) a[r] = 0.f;
          const float* W = F.in[IN_WADA] + (size_t)l * D * 6144 + n0 + col;
          for (int k = ks * 256; k < ks * 256 + 256; ++k) { const float w = W[(size_t)k * 6144];
#pragma unroll
              for (int r = 0; r < 17; ++r) a[r] += sc[r * 1024 + k] * w; }
#pragma unroll
          for (int r = 0; r < 17; ++r) part[(ks * 17 + r) * 128 + col] = a[r];
          __syncthreads();
          for (int i = F.tid; i < 17 * 128; i += NTHREADS) { const int r = i >> 7, cc = i & 127;
              const float s = part[(0 * 17 + r) * 128 + cc] + part[(1 * 17 + r) * 128 + cc] + part[(2 * 17 + r) * 128 + cc] + part[(3 * 17 + r) * 128 + cc] + F.in[IN_BADA][l * 6144 + n0 + cc];
              ((float*)(F.ws + WS_MOD))[(size_t)(l * 17 + r) * 6144 + n0 + cc] = s; }
          __syncthreads();
      } }
}

struct RowV { f32x4 v[4]; };
#define RC(lane, j) (8 * (lane) + 512 * ((j) >> 1) + 4 * ((j) & 1))
__device__ __forceinline__ void row_load(RowV& r, const float* p, int lane) {
#pragma unroll
    for (int j = 0; j < 4; ++j) r.v[j] = __builtin_nontemporal_load((const f32x4*)(p + RC(lane, j)));
}
__device__ __forceinline__ void row_load_bf16(RowV& r, const bf16_t* p, int lane) {
#pragma unroll
    for (int h = 0; h < 2; ++h) { const u32x4 w = __builtin_nontemporal_load((const u32x4*)(p + 8 * lane + 512 * h)); r.v[2 * h] = (f32x4){bflo(w.x), bfhi(w.x), bflo(w.y), bfhi(w.y)}; r.v[2 * h + 1] = (f32x4){bflo(w.z), bfhi(w.z), bflo(w.w), bfhi(w.w)}; }
}
__device__ __forceinline__ void row_store(const RowV& r, float* p, int lane) {
#pragma unroll
    for (int j = 0; j < 4; ++j) *(f32x4*)(p + RC(lane, j)) = r.v[j];
}
__device__ __forceinline__ void row_store_nt(const RowV& r, float* p, int lane) {
#pragma unroll
    for (int j = 0; j < 4; ++j) __builtin_nontemporal_store(r.v[j], (f32x4*)(p + RC(lane, j)));
}
__device__ __forceinline__ void row_store_bf16_nt(const RowV& r, bf16_t* p, int lane) {
#pragma unroll
    for (int h = 0; h < 2; ++h) { u32x4 w; w.x = pk2(r.v[2 * h].x, r.v[2 * h].y); w.y = pk2(r.v[2 * h].z, r.v[2 * h].w); w.z = pk2(r.v[2 * h + 1].x, r.v[2 * h + 1].y); w.w = pk2(r.v[2 * h + 1].z, r.v[2 * h + 1].w); __builtin_nontemporal_store(w, (u32x4*)(p + 8 * lane + 512 * h)); }
}
__device__ __forceinline__ void row_store_bf16(const RowV& r, bf16_t* p, int lane) {
#pragma unroll
    for (int h = 0; h < 2; ++h) { u32x4 w; w.x = pk2(r.v[2 * h].x, r.v[2 * h].y); w.y = pk2(r.v[2 * h].z, r.v[2 * h].w); w.z = pk2(r.v[2 * h + 1].x, r.v[2 * h + 1].y); w.w = pk2(r.v[2 * h + 1].z, r.v[2 * h + 1].w); *(u32x4*)(p + 8 * lane + 512 * h) = w; }
}
__device__ __forceinline__ void row_ln_plain(RowV& r, int lane) {
    float s = 0.f;
#pragma unroll
    for (int j = 0; j < 4; ++j) s += (r.v[j].x + r.v[j].y) + (r.v[j].z + r.v[j].w);
    const float mean = wave_sum(s, lane) * (1.f / D); float s2 = 0.f;
#pragma unroll
    for (int j = 0; j < 4; ++j) { r.v[j] = r.v[j] - mean; s2 += (r.v[j].x * r.v[j].x + r.v[j].y * r.v[j].y) + (r.v[j].z * r.v[j].z + r.v[j].w * r.v[j].w); }
    const float rstd = 1.f / sqrtf(wave_sum(s2, lane) * (1.f / D) + LN_EPS);
#pragma unroll
    for (int j = 0; j < 4; ++j) r.v[j] = r.v[j] * rstd;
}
__device__ __forceinline__ void row_affine(RowV& r, const float* g, const float* b, int lane) {
#pragma unroll
    for (int j = 0; j < 4; ++j) { const f32x4 gg = *(const f32x4*)(g + RC(lane, j)), bb = *(const f32x4*)(b + RC(lane, j)); r.v[j] = r.v[j] * gg + bb; }
}
__device__ __forceinline__ void row_modulate(RowV& r, const float* sh, const float* sc, int lane) {
#pragma unroll
    for (int j = 0; j < 4; ++j) { const f32x4 s1 = *(const f32x4*)(sc + RC(lane, j)), s0 = *(const f32x4*)(sh + RC(lane, j)); r.v[j] = r.v[j] * (s1 + 1.0f) + s0; }
}
__device__ __forceinline__ LAS float* pv_slot(const Frame& F, int slot) { return (LAS float*)(F.lds + NW_PV) + slot * 1024; }
__device__ __forceinline__ void pv_fill(Frame& F, int slot, const float* src) { LAS f32x4* d = (LAS f32x4*)pv_slot(F, slot); for (int i = F.tid; i < 256; i += NTHREADS) d[i] = *(const f32x4*)(src + 4 * i); }
__device__ __forceinline__ void row_affine_l(RowV& r, const LAS float* g, const LAS float* b, int lane) {
#pragma unroll
    for (int j = 0; j < 4; ++j) { const f32x4 gg = *(const LAS f32x4*)(g + RC(lane, j)), bb = *(const LAS f32x4*)(b + RC(lane, j)); r.v[j] = r.v[j] * gg + bb; }
}
__device__ __forceinline__ void row_modulate_l(RowV& r, const LAS float* sh, const LAS float* sc, int lane) {
#pragma unroll
    for (int j = 0; j < 4; ++j) { const f32x4 s1 = *(const LAS f32x4*)(sc + RC(lane, j)), s0 = *(const LAS f32x4*)(sh + RC(lane, j)); r.v[j] = r.v[j] * (s1 + 1.0f) + s0; }
}
__device__ __forceinline__ void ln0_row(Frame& F, int row, RowV xr, const LAS float* sh, const LAS float* sc) {
    row_ln_plain(xr, F.lane);
    row_modulate_l(xr, sh, sc, F.lane);
    row_store_bf16(xr, (bf16_t*)(F.ws + WS_H) + (size_t)row * D, F.lane);
    { unsigned char* h8 = (unsigned char*)(F.ws + WS_H8) + (size_t)row * D + 8 * F.lane;
#pragma unroll
      for (int h = 0; h < 2; ++h) { u32x2 w; w.x = pk4_fp8(xr.v[2 * h].x * F8S_ACT, xr.v[2 * h].y * F8S_ACT, xr.v[2 * h].z * F8S_ACT, xr.v[2 * h].w * F8S_ACT); w.y = pk4_fp8(xr.v[2 * h + 1].x * F8S_ACT, xr.v[2 * h + 1].y * F8S_ACT, xr.v[2 * h + 1].z * F8S_ACT, xr.v[2 * h + 1].w * F8S_ACT); *(u32x2*)(h8 + 512 * h) = w; } }
}
__device__ __forceinline__ LAS float* narrow_tile_wave(Frame& F, const bf16_t* A) {
    const int r = F.lane & 31, h = F.lane >> 5;
    f32x16 acc;
#pragma unroll
    for (int i = 0; i < 16; ++i) acc[i] = 0.f;
    const bf16_t* ap = A + (size_t)r * D + 8 * h;
    const LAS unsigned char* bp = F.lds + NW_WT + r * 2064 + 16 * h;
    bf16x8 av[2][16];
#pragma unroll
    for (int ks = 0; ks < 16; ++ks) av[0][ks] = *(const bf16x8*)(ap + ks * 16);
#pragma unroll
    for (int kb = 0; kb < 4; ++kb) {
        if (kb < 3) {
#pragma unroll
            for (int ks = 0; ks < 16; ++ks) av[(kb + 1) & 1][ks] = *(const bf16x8*)(ap + ((kb + 1) * 16 + ks) * 16); }
        __builtin_amdgcn_sched_barrier(0);
#pragma unroll
        for (int ks = 0; ks < 16; ++ks) { const bf16x8 b = *(const LAS bf16x8*)(bp + (kb * 16 + ks) * 32); acc = __builtin_amdgcn_mfma_f32_32x32x16_bf16(av[kb & 1][ks], b, acc, 0, 0, 0); }
        __builtin_amdgcn_sched_barrier(0);
    }
    LAS float* lg = (LAS float*)(F.lds + NW_LG) + F.wave * 1056;
#pragma unroll
    for (int i = 0; i < 16; ++i) lg[((i & 3) + 8 * (i >> 2) + 4 * h) * 33 + r] = acc[i];
    asm volatile("s_waitcnt lgkmcnt(0)" ::: "memory");
    return lg;
}
__device__ __forceinline__ void tile_range(const Frame& F, int mrows, int& t_lo, int& t_hi) { const int nt = mrows / 32; t_lo = (int)(((long)F.bid * nt) / F.G); t_hi = (int)(((long)(F.bid + 1) * nt) / F.G); }
__device__ __forceinline__ void load_wg_lds(Frame& F, int l) {
    const float* src = (const float*)(F.ws + WS_WG) + (size_t)l * 16384;
    for (int i = F.tid; i < 32 * 128; i += NTHREADS) { const int g = i >> 7, c8 = i & 127; u32x4 w = (u32x4){0u, 0u, 0u, 0u};
        if (g < 16) { const f32x4 a = *(const f32x4*)(src + g * 1024 + c8 * 8), b = *(const f32x4*)(src + g * 1024 + c8 * 8 + 4); w.x = pk2(a.x, a.y); w.y = pk2(a.z, a.w); w.z = pk2(b.x, b.y); w.w = pk2(b.z, b.w); }
        *(LAS u32x4*)(F.lds + NW_WT + g * 2064 + c8 * 16) = w; }
    __syncthreads();
}
__device__ __forceinline__ void gates_tail(Frame& F, int l, int t_lo, int t_hi) {
    asm volatile("s_waitcnt vmcnt(0)" ::: "memory"); __syncthreads();
    const int g = F.lane & 15; const float bias = F.in[IN_BIN][l * 5904 + 2304 + g];
    for (int tile = t_lo + F.wave; tile < t_hi; tile += NWAVES) {
        const LAS float* lg = narrow_tile_wave(F, (const bf16_t*)(F.ws + WS_H) + (size_t)tile * 32 * D);
#pragma unroll
        for (int rr = 0; rr < 8; ++rr) { const int row = rr * 4 + (F.lane >> 4); ((float*)(F.ws + WS_ZG))[(size_t)(tile * 32 + row) * 16 + g] = lg[row * 33 + g] + bias; }
        asm volatile("s_waitcnt lgkmcnt(0)" ::: "memory");
    }
}

using pg8::Unit;
struct ProbPlain {
    static constexpr bool GATHER = false, FP8 = false; static constexpr int SCALE_A = 127, SCALE_B = 127; const bf16_t* A; const bf16_t* Bt; int lda, ldb;
    __device__ __forceinline__ int nt(const Unit&) const { return lda / 64; }
    __device__ __forceinline__ const char* a_base(const Unit& u) const { return (const char*)A + (size_t)u.pm * 256 * lda * 2; }
    __device__ __forceinline__ const char* b_base(const Unit& u) const { return (const char*)Bt + (size_t)u.pn * 256 * ldb * 2; }
    __device__ __forceinline__ void a_tok(const Unit&, const int (&)[2], int (&)[2][2]) const {}
    __device__ __forceinline__ void a_off(const int (&)[2][2], const int (&)[2], unsigned (&)[2][2]) const {}
    __device__ __forceinline__ void a_rows(const Unit&, const int (&)[2], const int (&)[2], unsigned (&)[2][2]) const {}
};
struct ProbPlainF8 {
    static constexpr bool GATHER = false, FP8 = true; static constexpr int SCALE_A = F8E_ACT, SCALE_B = F8E_WGU; const bf16_t* A; const bf16_t* Bt; int lda, ldb;
    __device__ __forceinline__ int nt(const Unit&) const { return lda / 64; }
    __device__ __forceinline__ const char* a_base(const Unit& u) const { return (const char*)A + (size_t)u.pm * 256 * lda * 2; }
    __device__ __forceinline__ const char* b_base(const Unit& u) const { return (const char*)Bt + (size_t)u.pn * 256 * ldb * 2; }
    __device__ __forceinline__ void a_tok(const Unit&, const int (&)[2], int (&)[2][2]) const {}
    __device__ __forceinline__ void a_off(const int (&)[2][2], const int (&)[2], unsigned (&)[2][2]) const {}
    __device__ __forceinline__ void a_rows(const Unit&, const int (&)[2], const int (&)[2], unsigned (&)[2][2]) const {}
};
struct ProbBranch {
    static constexpr bool GATHER = false, FP8 = false; static constexpr int SCALE_A = 127, SCALE_B = 127; const bf16_t* A; const bf16_t* Bt; int lda, ldb;
    __device__ __forceinline__ int nt(const Unit& u) const { return u.sub == 1 ? 8 : 4; }
    __device__ __forceinline__ int koff(const Unit& u) const { return u.sub == 0 ? 0 : (u.sub == 1 ? 256 : 768); }
    __device__ __forceinline__ const char* a_base(const Unit& u) const { return (const char*)A + ((size_t)u.pm * 256 * lda + koff(u)) * 2; }
    __device__ __forceinline__ const char* b_base(const Unit& u) const { return (const char*)Bt + ((size_t)u.pn * 256 * ldb + koff(u)) * 2; }
    __device__ __forceinline__ void a_tok(const Unit&, const int (&)[2], int (&)[2][2]) const {}
    __device__ __forceinline__ void a_off(const int (&)[2][2], const int (&)[2], unsigned (&)[2][2]) const {}
    __device__ __forceinline__ void a_rows(const Unit&, const int (&)[2], const int (&)[2], unsigned (&)[2][2]) const {}
};
__device__ __forceinline__ int expert_of(const LAS int* seg, int pm) { return __builtin_amdgcn_readfirstlane((int)((const LAS unsigned char*)(seg + 64))[pm]); }
__device__ __forceinline__ int moe_tables(Frame& F, LAS int* seg) {
    __syncthreads();
    if (F.tid <= NEXP) seg[F.tid] = ((const int*)(F.ws + WS_ROUTE + RT_SEG))[F.tid];
    __syncthreads();
    const int ntile = seg[NEXP] / 256;
    LAS unsigned char* texp = (LAS unsigned char*)(seg + 64);
    for (int t = F.tid; t < ntile; t += NTHREADS) { const int row = t * 256; int e = 0;
#pragma unroll
        for (int i = 1; i < NEXP; ++i) e += (seg[i] <= row) ? 1 : 0;
        texp[t] = (unsigned char)e; }
    __syncthreads();
    return ntile;
}
struct ProbMoe1 {
    static constexpr bool GATHER = true, FP8 = true; static constexpr int SCALE_A = F8E_ACT, SCALE_B = F8E_WGU; const bf16_t* A; const bf16_t* Bt; int lda, ldb; const int* tok; const LAS int* seg;
    __device__ __forceinline__ int nt(const Unit&) const { return lda / 64; }
    __device__ __forceinline__ const char* a_base(const Unit&) const { return (const char*)A; }
    __device__ __forceinline__ const char* b_base(const Unit& u) const { const int e = expert_of(seg, u.pm); return (const char*)Bt + ((size_t)e * 2048 + (size_t)u.pn * 256) * ldb * 2; }
    __device__ __forceinline__ void a_rows(const Unit& u, const int (&R)[2], const int (&C)[2], unsigned (&off)[2][2]) const {
#pragma unroll
        for (int h = 0; h < 2; ++h)
#pragma unroll
            for (int i = 0; i < 2; ++i) { const int t = tok[u.pm * 256 + h * 128 + R[i]]; off[h][i] = (unsigned)(t * lda + C[i]) * 2u; } }
    __device__ __forceinline__ void a_tok(const Unit& u, const int (&R)[2], int (&tk)[2][2]) const {
#pragma unroll
        for (int h = 0; h < 2; ++h)
#pragma unroll
            for (int i = 0; i < 2; ++i) tk[h][i] = tok[u.pm * 256 + h * 128 + R[i]]; }
    __device__ __forceinline__ void a_off(const int (&tk)[2][2], const int (&C)[2], unsigned (&off)[2][2]) const {
#pragma unroll
        for (int h = 0; h < 2; ++h)
#pragma unroll
            for (int i = 0; i < 2; ++i) off[h][i] = (unsigned)(tk[h][i] * lda + C[i]) * 2u; }
};
struct ProbMoe2 {
    static constexpr bool GATHER = false, FP8 = true; static constexpr int SCALE_A = F8E_ACT, SCALE_B = F8E_WDN; const bf16_t* A; const bf16_t* Bt; int lda, ldb; const LAS int* seg;
    __device__ __forceinline__ int nt(const Unit&) const { return lda / 64; }
    __device__ __forceinline__ const char* a_base(const Unit& u) const { return (const char*)A + (size_t)u.pm * 256 * lda * 2; }
    __device__ __forceinline__ const char* b_base(const Unit& u) const { const int e = expert_of(seg, u.pm); return (const char*)Bt + ((size_t)e * 1024 + (size_t)u.pn * 256) * ldb * 2; }
    __device__ __forceinline__ void a_tok(const Unit&, const int (&)[2], int (&)[2][2]) const {}
    __device__ __forceinline__ void a_off(const int (&)[2][2], const int (&)[2], unsigned (&)[2][2]) const {}
    __device__ __forceinline__ void a_rows(const Unit&, const int (&)[2], const int (&)[2], unsigned (&)[2][2]) const {}
};
using pg8::cvt_pk_bf16;
struct EpiInproj {
    static constexpr bool PERM = true, CHAIN = false, SIDE = true, KHOOK = false; bf16_t* Z; const float* bias; int pn0;
    __device__ __forceinline__ void side(const Unit& u0, unsigned slot, int wid, int lane) const { const int pn = u0.pn + pn0; if (wid == 1) pg8::dma16((unsigned)lane * 16u, bias + pn * 256 + (pn >= 9 ? 16 : 0), slot); }
    __device__ __forceinline__ void operator()(const f32x4 (&acc)[2][2][4][2], const Unit& u0, int wr, int wc, int fr, int fq, const LAS unsigned char* sd) const {
        Unit u = u0; u.pn += pn0;
        int row0 = u.pm * 256 + wr * 64 + fr, col0 = u.pn * 256 + wc * 32 + 8 * fq; asm volatile("" : "+v"(row0), "+v"(col0));
        const int act = (u.pn <= 6) ? 0 : ((u.pn == 9 || u.pn == 10) ? 2 : 1);
        f32x4 bv[2][2];
#pragma unroll
        for (int bj = 0; bj < 2; ++bj)
#pragma unroll
            for (int n = 0; n < 2; ++n) bv[bj][n] = *(const LAS f32x4*)(sd + (bj * 128 + wc * 32 + 8 * fq + 4 * n) * 4);
#pragma unroll
        for (int ai = 0; ai < 2; ++ai)
#pragma unroll
            for (int m = 0; m < 4; ++m) { bf16_t* rowp = Z + (size_t)(row0 + ai * 128 + m * 16) * NZ + col0;
#pragma unroll
                for (int bj = 0; bj < 2; ++bj) { f32x4 v0 = acc[ai][bj][m][0] + bv[bj][0], v1 = acc[ai][bj][m][1] + bv[bj][1];
                    if (act == 2) { f32x2 a = pg8::gelu_pk((f32x2){v0[0], v0[1]}), b = pg8::gelu_pk((f32x2){v0[2], v0[3]}), c = pg8::gelu_pk((f32x2){v1[0], v1[1]}), d = pg8::gelu_pk((f32x2){v1[2], v1[3]});
                        v0 = (f32x4){a.x, a.y, b.x, b.y}; v1 = (f32x4){c.x, c.y, d.x, d.y}; }
                    if (act == 1) {
#pragma unroll
                        for (int j = 0; j < 4; ++j) { v0[j] = sigmoidf_(v0[j]); v1[j] = sigmoidf_(v1[j]); } }
                    u32x4 w; w.x = cvt_pk_bf16(v0[0], v0[1]); w.y = cvt_pk_bf16(v0[2], v0[3]); w.z = cvt_pk_bf16(v1[0], v1[1]); w.w = cvt_pk_bf16(v1[2], v1[3]);
                    *(u32x4*)(rowp + bj * 128) = w; } }
    }
};
struct EpiNull {
    static constexpr bool PERM = true, CHAIN = false; bf16_t* Z;
    __device__ __forceinline__ void operator()(const f32x4 (&acc)[2][2][4][2], const Unit& u, int wr, int wc, int fr, int fq) const {
        float sacc = 0.f;
#pragma unroll
        for (int ai = 0; ai < 2; ++ai)
#pragma unroll
            for (int bj = 0; bj < 2; ++bj)
#pragma unroll
                for (int m = 0; m < 4; ++m)
#pragma unroll
                    for (int n = 0; n < 2; ++n) sacc += (acc[ai][bj][m][n][0] + acc[ai][bj][m][n][1]) + (acc[ai][bj][m][n][2] + acc[ai][bj][m][n][3]);
        if (sacc == 1.2345e30f) Z[u.pm + wr + wc + fr + fq] = 0;
    }
};
struct EpiOut {
    static constexpr bool PERM = true, CHAIN = false, SIDE = false, KHOOK = false; bf16_t* T;
    __device__ __forceinline__ void operator()(const f32x4 (&acc)[2][2][4][2], const Unit& u, int wr, int wc, int fr, int fq, const LAS unsigned char*) const {
        int row0 = u.pm * 256 + wr * 64 + fr, col0 = u.pn * 256 + wc * 32 + 8 * fq; asm volatile("" : "+v"(row0), "+v"(col0));
#pragma unroll
        for (int ai = 0; ai < 2; ++ai)
#pragma unroll
            for (int m = 0; m < 4; ++m) { bf16_t* rowp = T + (size_t)(row0 + ai * 128 + m * 16) * D + col0;
#pragma unroll
                for (int bj = 0; bj < 2; ++bj) { const f32x4 v0 = acc[ai][bj][m][0], v1 = acc[ai][bj][m][1];
                    u32x4 w; w.x = cvt_pk_bf16(v0[0], v0[1]); w.y = cvt_pk_bf16(v0[2], v0[3]); w.z = cvt_pk_bf16(v1[0], v1[1]); w.w = cvt_pk_bf16(v1[2], v1[3]);
                    *(u32x4*)(rowp + bj * 128) = w; } }
    }
};
struct EpiBranch {
    static constexpr bool PERM = true, CHAIN = false, SIDE = false, KHOOK = true; static constexpr int HOOK_T0 = 4, HOOK_T1 = 12;
    const bf16_t* Z; bf16_t* Y;
    template <bool FIN> __device__ __forceinline__ void apply(f32x4 (&acc)[2][2][4][2], const Unit& u, int br, int wr, int wc, int fr, int fq) const {
        int row0 = u.pm * 256 + wr * 64 + fr, col0 = u.pn * 256 + wc * 32 + 8 * fq;
        asm volatile("" : "+v"(row0), "+v"(col0));
#pragma unroll
        for (int ai = 0; ai < 2; ++ai) {
            u32x4 ga[4][2], gb[4][2];
#pragma unroll
            for (int m = 0; m < 4; ++m) { const bf16_t* rowp = Z + (size_t)(row0 + ai * 128 + m * 16) * NZ + ZC_MG + br * 1024 + col0;
#pragma unroll
                for (int bj = 0; bj < 2; ++bj) { ga[m][bj] = *(const u32x4*)(rowp + bj * 128); if (!FIN) gb[m][bj] = *(const u32x4*)(rowp + 1024 + bj * 128); } }
#pragma unroll
            for (int m = 0; m < 4; ++m) { const size_t row = (size_t)(row0 + ai * 128 + m * 16);
#pragma unroll
                for (int bj = 0; bj < 2; ++bj) { const u32x4 a = ga[m][bj]; u32x4 b = (u32x4){0x3f803f80u, 0x3f803f80u, 0x3f803f80u, 0x3f803f80u}; if (!FIN) b = gb[m][bj];
                    f32x4 r0, r1;
                    if (FIN) { r0 = (f32x4){bflo(a.x), bfhi(a.x), bflo(a.y), bfhi(a.y)}; r1 = (f32x4){bflo(a.z), bfhi(a.z), bflo(a.w), bfhi(a.w)}; }
                    else { r0[0] = bflo(a.x) * __builtin_amdgcn_rcpf(bflo(b.x)); r0[1] = bfhi(a.x) * __builtin_amdgcn_rcpf(bfhi(b.x)); r0[2] = bflo(a.y) * __builtin_amdgcn_rcpf(bflo(b.y)); r0[3] = bfhi(a.y) * __builtin_amdgcn_rcpf(bfhi(b.y));
                           r1[0] = bflo(a.z) * __builtin_amdgcn_rcpf(bflo(b.z)); r1[1] = bfhi(a.z) * __builtin_amdgcn_rcpf(bfhi(b.z)); r1[2] = bflo(a.w) * __builtin_amdgcn_rcpf(bflo(b.w)); r1[3] = bfhi(a.w) * __builtin_amdgcn_rcpf(bfhi(b.w)); }
                    acc[ai][bj][m][0] = acc[ai][bj][m][0] * r0; acc[ai][bj][m][1] = acc[ai][bj][m][1] * r1;
                    if (FIN) { const f32x4 v0 = acc[ai][bj][m][0], v1 = acc[ai][bj][m][1];
                        u32x4 w; w.x = cvt_pk_bf16(v0[0], v0[1]); w.y = cvt_pk_bf16(v0[2], v0[3]); w.z = cvt_pk_bf16(v1[0], v1[1]); w.w = cvt_pk_bf16(v1[2], v1[3]);
                        *(u32x4*)(Y + row * D + col0 + bj * 128) = w; } } }
            asm volatile("" ::: "memory"); }
    }
    __device__ __forceinline__ void hook(f32x4 (&acc)[2][2][4][2], const Unit& u, int br, int wr, int wc, int fr, int fq) const { apply<false>(acc, u, br, wr, wc, fr, fq); }
    __device__ __forceinline__ void operator()(f32x4 (&acc)[2][2][4][2], const Unit& u, int wr, int wc, int fr, int fq, const LAS unsigned char*) const { apply<true>(acc, u, 2, wr, wc, fr, fq); }
};
struct EpiSwiglu {
    static constexpr bool PERM = true, CHAIN = false, SIDE = true, KHOOK = false; unsigned char* HID; const float* bgu; const LAS int* seg;
    __device__ __forceinline__ void side(const Unit& u, unsigned slot, int wid, int lane) const {
        if (wid == 1) { const int e = expert_of(seg, u.pm); pg8::dma16(lane < 32 ? (unsigned)lane * 16u : 4096u + (unsigned)(lane - 32) * 16u, bgu + (size_t)e * 2048 + u.pn * 128, slot); } }
    __device__ __forceinline__ void operator()(const f32x4 (&acc)[2][2][4][2], const Unit& u, int wr, int wc, int fr, int fq, const LAS unsigned char* sd) const {
        int j0 = u.pn * 128 + wc * 32 + 8 * fq, slot0 = u.pm * 256 + wr * 64 + fr; asm volatile("" : "+v"(j0), "+v"(slot0));
        f32x4 bg[2], bu[2];
#pragma unroll
        for (int n = 0; n < 2; ++n) { bg[n] = *(const LAS f32x4*)(sd + (wc * 32 + 8 * fq + 4 * n) * 4); bu[n] = *(const LAS f32x4*)(sd + (128 + wc * 32 + 8 * fq + 4 * n) * 4); }
#pragma unroll
        for (int ai = 0; ai < 2; ++ai)
#pragma unroll
            for (int m = 0; m < 4; ++m) { const size_t slot = (size_t)(slot0 + ai * 128 + m * 16); float o[8];
#pragma unroll
                for (int n = 0; n < 2; ++n)
#pragma unroll
                    for (int i = 0; i < 4; ++i) { float g = acc[ai][0][m][n][i] + bg[n][i], up = acc[ai][1][m][n][i] + bu[n][i];
                        g = fminf(g, 7.0f); up = fminf(fmaxf(up, -7.0f), 7.0f); o[n * 4 + i] = (up + 1.0f) * g * sigmoidf_(1.702f * g); }
                u32x2 w; w.x = pk4_fp8(o[0] * F8S_ACT, o[1] * F8S_ACT, o[2] * F8S_ACT, o[3] * F8S_ACT); w.y = pk4_fp8(o[4] * F8S_ACT, o[5] * F8S_ACT, o[6] * F8S_ACT, o[7] * F8S_ACT);
                *(u32x2*)(HID + slot * 1024 + j0) = w; }
    }
};
struct EpiDown {
    static constexpr bool PERM = true, CHAIN = false, SIDE = true, KHOOK = false; bf16_t* FS; const float* bdn; const int* dest; const float* pslot; const LAS int* seg;
    __device__ __forceinline__ void side(const Unit& u, unsigned slot, int wid, int lane) const {
        if (wid == 1) { const int e = expert_of(seg, u.pm); pg8::dma16((unsigned)lane * 16u, bdn + (size_t)e * 1024 + u.pn * 256, slot); }
        if (wid == 2) pg8::dma16((unsigned)lane * 16u, dest + (size_t)u.pm * 256, slot + 1024u);
        if (wid == 3) pg8::dma16((unsigned)lane * 16u, pslot + (size_t)u.pm * 256, slot + 2048u); }
    __device__ __forceinline__ void operator()(const f32x4 (&acc)[2][2][4][2], const Unit& u, int wr, int wc, int fr, int fq, const LAS unsigned char* sd) const {
        int col0 = u.pn * 256 + wc * 32 + 8 * fq, slot0 = u.pm * 256 + wr * 64 + fr; asm volatile("" : "+v"(col0), "+v"(slot0));
        f32x4 bv[2][2];
#pragma unroll
        for (int bj = 0; bj < 2; ++bj)
#pragma unroll
            for (int n = 0; n < 2; ++n) bv[bj][n] = *(const LAS f32x4*)(sd + (bj * 128 + wc * 32 + 8 * fq + 4 * n) * 4);
#pragma unroll
        for (int ai = 0; ai < 2; ++ai)
#pragma unroll
            for (int m = 0; m < 4; ++m) { const int rt = ai * 128 + wr * 64 + m * 16 + fr; const int d = *(const LAS int*)(sd + 1024 + rt * 4); const float p = *(const LAS float*)(sd + 2048 + rt * 4);
                if (d >= 0) {
#pragma unroll
                    for (int bj = 0; bj < 2; ++bj) { const f32x4 v0 = (acc[ai][bj][m][0] + bv[bj][0]) * p, v1 = (acc[ai][bj][m][1] + bv[bj][1]) * p;
                        u32x4 w; w.x = cvt_pk_bf16(v0[0], v0[1]); w.y = cvt_pk_bf16(v0[2], v0[3]); w.z = cvt_pk_bf16(v1[0], v1[1]); w.w = cvt_pk_bf16(v1[2], v1[3]);
                        *(u32x4*)(FS + (size_t)d * 1024 + col0 + bj * 128) = w; } }
                asm volatile("" ::: "memory"); }
    }
};

__device__ __forceinline__ const float* xin_row(const Frame& F, int row) { return row < ML ? F.in[IN_X] + (size_t)row * D : F.in[IN_CTX] + (size_t)(row - ML) * D; }
__device__ __forceinline__ void phase_ln0_first(Frame& F) {
    int t_lo, t_hi; tile_range(F, MT, t_lo, t_hi);
    const int r_lo = 32 * t_lo, nrows = 32 * (t_hi - t_lo);
    const int mrA = mod_row(r_lo), mrB = mod_row(r_lo + (nrows > 0 ? nrows - 1 : 0));
    { const float* mb = (const float*)(F.ws + WS_MOD); pv_fill(F, 0, mb + ((size_t)(0 * 17 + mrA) * 6 + 0) * 1024); pv_fill(F, 1, mb + ((size_t)(0 * 17 + mrB) * 6 + 0) * 1024);
      pv_fill(F, 2, mb + ((size_t)(0 * 17 + mrA) * 6 + 1) * 1024); pv_fill(F, 3, mb + ((size_t)(0 * 17 + mrB) * 6 + 1) * 1024); }
    load_wg_lds(F, 0);
    for (int n = F.wave; n < nrows; n += 4 * NWAVES) {
        RowV rv[4];
#pragma unroll
        for (int u = 0; u < 4; ++u) if (n + u * NWAVES < nrows) row_load(rv[u], xin_row(F, r_lo + n + u * NWAVES), F.lane);
#pragma unroll
        for (int u = 0; u < 4; ++u) if (n + u * NWAVES < nrows) { const int row = r_lo + n + u * NWAVES;
            const int sel = (mod_row(row) == mrA) ? 0 : 1; ln0_row(F, row, rv[u], pv_slot(F, 0 + sel), pv_slot(F, 2 + sel)); }
    }
    gates_tail(F, 0, t_lo, t_hi);
    __syncthreads();
}
__device__ __forceinline__ void phase_finalize(Frame& F, int l, int mrows) {
    const int gw = F.bid * NWAVES + F.wave, NGW = F.G * NWAVES;
    const bf16_t* hf = (const bf16_t*)(F.ws + WS_HFB); const bf16_t* hb = hf + (size_t)MT * 512;
    const float* ng = F.in[IN_MNG] + l * 512 + 8 * F.lane;
    const f32x4 g0 = *(const f32x4*)ng, g1 = *(const f32x4*)(ng + 4);
    for (int row = gw; row < mrows; row += NGW) {
        const u32x4 ha = __builtin_nontemporal_load((const u32x4*)(hf + (size_t)row * 512 + 8 * F.lane)), hbv = __builtin_nontemporal_load((const u32x4*)(hb + (size_t)row * 512 + 8 * F.lane));
        f32x4 v0 = (f32x4){bflo(ha.x) + bflo(hbv.x), bfhi(ha.x) + bfhi(hbv.x), bflo(ha.y) + bflo(hbv.y), bfhi(ha.y) + bfhi(hbv.y)}, v1 = (f32x4){bflo(ha.z) + bflo(hbv.z), bfhi(ha.z) + bfhi(hbv.z), bflo(ha.w) + bflo(hbv.w), bfhi(ha.w) + bfhi(hbv.w)};
        float s = (v0.x + v0.y) + (v0.z + v0.w) + (v1.x + v1.y) + (v1.z + v1.w);
#pragma unroll
        for (int o = 1; o < 16; o <<= 1) s += shx(s, o, F.lane);
        const float mu = s * (1.f / 128.f); v0 = v0 - mu; v1 = v1 - mu;
        float q = (v0.x * v0.x + v0.y * v0.y) + (v0.z * v0.z + v0.w * v0.w) + (v1.x * v1.x + v1.y * v1.y) + (v1.z * v1.z + v1.w * v1.w);
#pragma unroll
        for (int o = 1; o < 16; o <<= 1) q += shx(q, o, F.lane);
        const float rstd = 1.f / sqrtf(q * (1.f / 128.f) + HEAD_EPS);
        const u32x4 so = __builtin_nontemporal_load((const u32x4*)((const bf16_t*)(F.ws + WS_Z) + (size_t)row * NZ + ZC_O + 8 * F.lane));
        v0 = v0 * rstd * g0; v1 = v1 * rstd * g1;
        u32x4 w; w.x = pk2(v0.x * bflo(so.x), v0.y * bfhi(so.x)); w.y = pk2(v0.z * bflo(so.y), v0.w * bfhi(so.y)); w.z = pk2(v1.x * bflo(so.z), v1.y * bfhi(so.z)); w.w = pk2(v1.z * bflo(so.w), v1.w * bfhi(so.w));
        *(u32x4*)((bf16_t*)(F.ws + WS_BRA) + (size_t)row * D + 256 + 8 * F.lane) = w;
    }
}
__device__ __forceinline__ void phase_ln1_router(Frame& F, int l, int mrows) {
    LAS int* cnt = (LAS int*)(F.lds + NW_END);
    { const float* wr = F.in[IN_WR] + (size_t)l * D * NEXP;
      for (int i = F.tid; i < NEXP * D; i += NTHREADS) { const int k = i >> 5, e = i & 31; *(LAS bf16_t*)(F.lds + NW_WT + e * 2064 + k * 2) = (bf16_t)f2bf(wr[i]); }
      if (F.tid < NEXP) cnt[F.tid] = 0; }
    const float* brt = F.in[IN_BR] + l * NEXP;
    int t_lo, t_hi; tile_range(F, mrows, t_lo, t_hi);
    const int r_lo = 32 * t_lo, nrows = 32 * (t_hi - t_lo);
    const int mrA = mod_row(r_lo), mrB = mod_row(r_lo + (nrows > 0 ? nrows - 1 : 0));
    { const float* mb = (const float*)(F.ws + WS_MOD); pv_fill(F, 0, F.in[IN_LN1G] + l * D); pv_fill(F, 1, F.in[IN_LN1B] + l * D);
      pv_fill(F, 2, mb + ((size_t)(l * 17 + mrA) * 6 + 2) * 1024); pv_fill(F, 3, mb + ((size_t)(l * 17 + mrB) * 6 + 2) * 1024);
      pv_fill(F, 4, mb + ((size_t)(l * 17 + mrA) * 6 + 3) * 1024); pv_fill(F, 5, mb + ((size_t)(l * 17 + mrB) * 6 + 3) * 1024);
      pv_fill(F, 6, mb + ((size_t)(l * 17 + mrA) * 6 + 4) * 1024); pv_fill(F, 7, mb + ((size_t)(l * 17 + mrB) * 6 + 4) * 1024); }
    __syncthreads();
    { const bf16_t* yb = (const bf16_t*)(F.ws + WS_T) + 8 * F.lane;
      for (int n = F.wave; n < nrows; n += 2 * NWAVES) {
          RowV rv[2]; u32x4 yv2[2][2];
#pragma unroll
          for (int u = 0; u < 2; ++u) if (n + u * NWAVES < nrows) { const int row = r_lo + n + u * NWAVES;
              if (l == 0) row_load(rv[u], xin_row(F, row), F.lane); else row_load_bf16(rv[u], (const bf16_t*)(F.ws + WS_X) + (size_t)row * D, F.lane);
#pragma unroll
              for (int h = 0; h < 2; ++h) yv2[u][h] = __builtin_nontemporal_load((const u32x4*)(yb + (size_t)row * D + 512 * h)); }
#pragma unroll
          for (int u = 0; u < 2; ++u) if (n + u * NWAVES < nrows) { const int row = r_lo + n + u * NWAVES; RowV cur = rv[u];
              const int sel = (mod_row(row) == mrA) ? 0 : 1;
              { const LAS float* g1 = pv_slot(F, 2 + sel);
#pragma unroll
                for (int j = 0; j < 4; ++j) { const f32x4 gg = *(const LAS f32x4*)(g1 + RC(F.lane, j)); const u32x4 yw = yv2[u][j >> 1]; const f32x4 yv = (j & 1) ? (f32x4){bflo(yw.z), bfhi(yw.z), bflo(yw.w), bfhi(yw.w)} : (f32x4){bflo(yw.x), bfhi(yw.x), bflo(yw.y), bfhi(yw.y)}; cur.v[j] = cur.v[j] * DN_ALPHA + gg * yv; } }
              row_ln_plain(cur, F.lane); row_affine_l(cur, pv_slot(F, 0), pv_slot(F, 1), F.lane);
              row_store_bf16_nt(cur, (bf16_t*)(F.ws + WS_X) + (size_t)row * D, F.lane);
              row_ln_plain(cur, F.lane); row_modulate_l(cur, pv_slot(F, 4 + sel), pv_slot(F, 6 + sel), F.lane);
              row_store_bf16(cur, (bf16_t*)(F.ws + WS_H2) + (size_t)row * D, F.lane);
              { unsigned char* h8 = (unsigned char*)(F.ws + WS_H2F8) + (size_t)row * D + 8 * F.lane;
#pragma unroll
                for (int h = 0; h < 2; ++h) { u32x2 w; w.x = pk4_fp8(cur.v[2 * h].x * F8S_ACT, cur.v[2 * h].y * F8S_ACT, cur.v[2 * h].z * F8S_ACT, cur.v[2 * h].w * F8S_ACT); w.y = pk4_fp8(cur.v[2 * h + 1].x * F8S_ACT, cur.v[2 * h + 1].y * F8S_ACT, cur.v[2 * h + 1].z * F8S_ACT, cur.v[2 * h + 1].w * F8S_ACT); *(u32x2*)(h8 + 512 * h) = w; } } }
      } }
    asm volatile("s_waitcnt vmcnt(0)" ::: "memory"); __syncthreads();
    for (int tile = t_lo + F.wave; tile < t_hi; tile += NWAVES) {
        const LAS float* lgw = narrow_tile_wave(F, (const bf16_t*)(F.ws + WS_H2) + (size_t)tile * 32 * D);
        if (F.lane < 32) {
            const LAS float* lgp = lgw + F.lane * 33; const int row = tile * 32 + F.lane;
            float lg[NEXP];
#pragma unroll
            for (int e = 0; e < NEXP; ++e) lg[e] = lgp[e] + brt[e];
            unsigned used = 0u; float bv[4]; int bi[4];
#pragma unroll
            for (int k = 0; k < 4; ++k) { float best = -3.0e38f; int idx = 0;
#pragma unroll
                for (int e = 0; e < NEXP; ++e) { const bool take = (((used >> e) & 1u) == 0u) && (lg[e] > best); best = take ? lg[e] : best; idx = take ? e : idx; }
                used |= 1u << idx; bv[k] = best; bi[k] = idx; }
            const float e1 = __expf(bv[1] - bv[0]), e2 = __expf(bv[2] - bv[0]), e3 = __expf(bv[3] - bv[0]); const float inv = 1.0f / (1.0f + e1 + e2 + e3);
            int* ei = (int*)(F.ws + WS_ROUTE + RT_EIDX) + (size_t)row * 4; float* pr = (float*)(F.ws + WS_ROUTE + RT_PROB) + (size_t)row * 4;
            *(int4*)ei = make_int4(bi[0], bi[1], bi[2], bi[3]); *(f32x4*)pr = (f32x4){inv, e1 * inv, e2 * inv, e3 * inv};
            atomicAdd((int*)&cnt[bi[0]], 1); atomicAdd((int*)&cnt[bi[1]], 1); atomicAdd((int*)&cnt[bi[2]], 1); atomicAdd((int*)&cnt[bi[3]], 1);
        }
        asm volatile("s_waitcnt lgkmcnt(0)" ::: "memory");
    }
    __syncthreads();
    if (F.tid < NEXP) ((int*)(F.ws + WS_ROUTE + RT_CNT))[F.bid * NEXP + F.tid] = cnt[F.tid];
    __syncthreads();
}
__device__ __forceinline__ void phase_slots(Frame& F, int mrows) {
    LAS int* part = (LAS int*)F.lds;
    LAS int* pre = part + 1024;
    LAS int* tot = pre + 32;
    LAS int* seg = tot + 32;
    LAS int* gcnt = seg + 64;
    LAS int* eix = gcnt + 2048;
    LAS int* rnk = eix + 4096;
    const int* cntg = (const int*)(F.ws + WS_ROUTE + RT_CNT);
    int* tokg = (int*)(F.ws + WS_ROUTE + RT_TOK); int* destg = (int*)(F.ws + WS_ROUTE + RT_DEST); float* psl = (float*)(F.ws + WS_ROUTE + RT_PSLOT);
    int t_lo, t_hi; tile_range(F, mrows, t_lo, t_hi);
    const int row_base = t_lo * 32, nent = (t_hi - t_lo) * 128, ngrp = nent / 64;
    { const int e = F.tid & 31, pt = F.tid >> 5; int a = 0, b = 0;
      for (int c = pt; c < F.G; c += 16) { const int v = cntg[c * NEXP + e]; b += v; a += (c < F.bid) ? v : 0; }
      part[pt * 32 + e] = a; part[512 + pt * 32 + e] = b; }
    for (int i = F.tid; i < nent; i += NTHREADS) eix[i] = ((const int*)(F.ws + WS_ROUTE + RT_EIDX))[(size_t)row_base * 4 + i];
    __syncthreads();
    if (F.tid < NEXP) { int a = 0, b = 0;
#pragma unroll
        for (int pt = 0; pt < 16; ++pt) { a += part[pt * 32 + F.tid]; b += part[512 + pt * 32 + F.tid]; }
        pre[F.tid] = a; tot[F.tid] = b; }
    for (int g = F.wave; g < ngrp; g += NWAVES) {
        const int e = eix[g * 64 + F.lane]; int rank = 0, mycnt = 0;
#pragma unroll 4
        for (int ee = 0; ee < NEXP; ++ee) { const unsigned long long m = __ballot(e == ee); if (e == ee) rank = __popcll(m & ((1ull << F.lane) - 1ull)); if (F.lane == ee) mycnt = __popcll(m); }
        rnk[g * 64 + F.lane] = rank; if (F.lane < NEXP) gcnt[g * 32 + F.lane] = mycnt; }
    __syncthreads();
    if (F.tid == 0) { int s = 0; for (int e = 0; e < NEXP; ++e) { seg[e] = s; s += (tot[e] + 255) & ~255; } seg[NEXP] = s; }
    if (F.tid >= 64 && F.tid < 64 + NEXP) { const int e = F.tid - 64; int run = 0; for (int g = 0; g < ngrp; ++g) { const int c = gcnt[g * 32 + e]; gcnt[g * 32 + e] = run; run += c; } }
    __syncthreads();
    { const float* prg = (const float*)(F.ws + WS_ROUTE + RT_PROB) + (size_t)row_base * 4;
      for (int i = F.tid; i < nent; i += NTHREADS) { const int e = eix[i]; const int slot = seg[e] + pre[e] + gcnt[(i >> 6) * 32 + e] + rnk[i];
          tokg[slot] = row_base + (i >> 2); destg[slot] = row_base * 4 + i; psl[slot] = prg[i]; } }
    if (F.bid < NEXP) { const int e = F.bid; for (int sl = seg[e] + tot[e] + F.tid; sl < seg[e + 1]; sl += NTHREADS) { tokg[sl] = 0; destg[sl] = -1; psl[sl] = 0.f; } }
    if (F.bid == 0 && F.tid <= NEXP) ((int*)(F.ws + WS_ROUTE + RT_SEG))[F.tid] = seg[F.tid];
    __syncthreads();
}
struct CombRaw { u32x4 x[2]; u32x4 f[2][4]; };
__device__ __forceinline__ void comb_load(const Frame& F, int row, CombRaw& r) {
    { const bf16_t* xp = (const bf16_t*)(F.ws + WS_X) + (size_t)row * D + 8 * F.lane;
#pragma unroll
      for (int h = 0; h < 2; ++h) r.x[h] = __builtin_nontemporal_load((const u32x4*)(xp + 512 * h)); }
    const bf16_t* fs = (const bf16_t*)(F.ws + WS_FS) + (size_t)row * 4 * 1024 + 8 * F.lane;
#pragma unroll
    for (int h = 0; h < 2; ++h)
#pragma unroll
        for (int k = 0; k < 4; ++k) r.f[h][k] = __builtin_nontemporal_load((const u32x4*)(fs + k * 1024 + 512 * h));
}
__device__ __forceinline__ void phase_combine_ln2(Frame& F, int l, int mrows) {
    const bool lastl = (l == DEPTH - 1);
    int t_lo, t_hi; tile_range(F, mrows, t_lo, t_hi);
    const int r_lo = 32 * t_lo, nrows = 32 * (t_hi - t_lo);
    const int mrA = mod_row(r_lo), mrB = mod_row(r_lo + (nrows > 0 ? nrows - 1 : 0));
    { const float* mb = (const float*)(F.ws + WS_MOD); const int ln = lastl ? l : l + 1; pv_fill(F, 0, F.in[IN_LN2G] + l * D); pv_fill(F, 1, F.in[IN_LN2B] + l * D);
      pv_fill(F, 2, mb + ((size_t)(l * 17 + mrA) * 6 + 5) * 1024); pv_fill(F, 3, mb + ((size_t)(l * 17 + mrB) * 6 + 5) * 1024);
      pv_fill(F, 4, mb + ((size_t)(ln * 17 + mrA) * 6 + 0) * 1024); pv_fill(F, 5, mb + ((size_t)(ln * 17 + mrB) * 6 + 0) * 1024);
      pv_fill(F, 6, mb + ((size_t)(ln * 17 + mrA) * 6 + 1) * 1024); pv_fill(F, 7, mb + ((size_t)(ln * 17 + mrB) * 6 + 1) * 1024); }
    if (!lastl) load_wg_lds(F, l + 1); else __syncthreads();
    for (int n = F.wave; n < nrows; n += 2 * NWAVES) {
        CombRaw rw[2];
#pragma unroll
        for (int u = 0; u < 2; ++u) if (n + u * NWAVES < nrows) comb_load(F, r_lo + n + u * NWAVES, rw[u]);
#pragma unroll
        for (int u = 0; u < 2; ++u) if (n + u * NWAVES < nrows) { const int row = r_lo + n + u * NWAVES;
            const int sel = (mod_row(row) == mrA) ? 0 : 1;
            const LAS float* g2 = pv_slot(F, 2 + sel);
            RowV x;
#pragma unroll
            for (int h = 0; h < 2; ++h) { const u32x4 w = rw[u].x[h]; x.v[2 * h] = (f32x4){bflo(w.x), bfhi(w.x), bflo(w.y), bfhi(w.y)}; x.v[2 * h + 1] = (f32x4){bflo(w.z), bfhi(w.z), bflo(w.w), bfhi(w.w)}; }
#pragma unroll
            for (int j = 0; j < 4; ++j) { f32x4 f = (f32x4){0.f, 0.f, 0.f, 0.f};
#pragma unroll
                for (int k = 0; k < 4; ++k) { const u32x4 w4 = rw[u].f[j >> 1][k]; const unsigned wx = (j & 1) ? w4.z : w4.x, wy = (j & 1) ? w4.w : w4.y; f[0] += bflo(wx); f[1] += bfhi(wx); f[2] += bflo(wy); f[3] += bfhi(wy); }
                const f32x4 gg = *(const LAS f32x4*)(g2 + RC(F.lane, j));
                x.v[j] = x.v[j] * DN_ALPHA + gg * f; }
            row_ln_plain(x, F.lane); row_affine_l(x, pv_slot(F, 0), pv_slot(F, 1), F.lane);
            if (lastl) { row_store_nt(x, F.out + (size_t)row * D, F.lane); }
            else { row_store_bf16_nt(x, (bf16_t*)(F.ws + WS_X) + (size_t)row * D, F.lane); ln0_row(F, row, x, pv_slot(F, 4 + sel), pv_slot(F, 6 + sel)); } }
    }
    if (!lastl) gates_tail(F, l + 1, t_lo, t_hi);
    __syncthreads();
}

#define MFMA32(a, b, c) __builtin_amdgcn_mfma_f32_32x32x16_bf16((a), (b), (c), 0, 0, 0)
#define MFMA16(a, b, c) __builtin_amdgcn_mfma_f32_16x16x32_bf16((a), (b), (c), 0, 0, 0)
__device__ __forceinline__ f32x16 zero16() { f32x16 z;
#pragma unroll
    for (int i = 0; i < 16; ++i) z[i] = 0.f;
    return z; }
__device__ __forceinline__ void pool_tiles(Frame& F, int l, bool with_ctx) {
    LAS unsigned char* Pin = F.lds;
    LAS unsigned char* Dm = F.lds + 40960;
    const bf16_t* Z = (const bf16_t*)(F.ws + WS_Z);
    const bf16_t* Wp = (const bf16_t*)(F.ws + WS_WPOOL) + (size_t)l * 4 * 4096;
    const float* psc = F.in[IN_POOLS] + l * 256;
    bf16_t* BRA = (bf16_t*)(F.ws + WS_BRA);
    const int ntiles = with_ctx ? 1088 : 1024;
    const int r = F.lane & 31, h = F.lane >> 5;
    for (int tile = F.bid; tile < ntiles; tile += F.G) {
        int row0, seq_lo, seq_hi;
        if (tile < 1024) { row0 = tile * 64; seq_lo = row0; seq_hi = row0 + 64; }
        else { const int ct = tile - 1024; seq_lo = ML + (ct >> 2) * 256; seq_hi = seq_lo + 256; row0 = seq_lo + (ct & 3) * 64; }
        for (int idx = F.tid; idx < 80 * 32; idx += NTHREADS) { const int rr = idx >> 5, ck = idx & 31, grow = row0 - 8 + rr;
            if (grow >= seq_lo && grow < seq_hi) *(LAS u32x4*)(Pin + rr * 512 + ck * 16) = __builtin_nontemporal_load((const u32x4*)(Z + (size_t)grow * NZ + ZC_P + ck * 8)); }
        __syncthreads();
        for (int idx = F.tid; idx < 64 * 32; idx += NTHREADS) { const int tok = idx >> 5, ck = idx & 31, g = ck >> 3, hw = 1 << g, t = row0 + tok;
            const int lo = max(t - hw, seq_lo), hi = min(t + hw, seq_hi);
            float s[8];
#pragma unroll
            for (int e = 0; e < 8; ++e) s[e] = 0.f;
            for (int rw = lo; rw < hi; ++rw) { const u32x4 v = *(const LAS u32x4*)(Pin + (rw - row0 + 8) * 512 + ck * 16);
                s[0] += bflo(v.x); s[1] += bfhi(v.x); s[2] += bflo(v.y); s[3] += bfhi(v.y); s[4] += bflo(v.z); s[5] += bfhi(v.z); s[6] += bflo(v.w); s[7] += bfhi(v.w); }
            const float inv = 1.0f / (float)(hi - lo);
            const u32x4 o = *(const LAS u32x4*)(Pin + (tok + 8) * 512 + ck * 16);
            u32x4 w; w.x = pk2(s[0] * inv - bflo(o.x), s[1] * inv - bfhi(o.x)); w.y = pk2(s[2] * inv - bflo(o.y), s[3] * inv - bfhi(o.y));
            w.z = pk2(s[4] * inv - bflo(o.z), s[5] * inv - bfhi(o.z)); w.w = pk2(s[6] * inv - bflo(o.w), s[7] * inv - bfhi(o.w));
            *(LAS u32x4*)(Dm + tok * 528 + ck * 16) = w; }
        __syncthreads();
#pragma unroll 1
        for (int qi = 0; qi < 2; ++qi) { const int q = F.wave + 8 * qi, g = q >> 2, td = (q >> 1) & 1, tt = q & 1;
            f32x16 acc = zero16();
#pragma unroll
            for (int ks = 0; ks < 4; ++ks) { const bf16x8 a = *(const bf16x8*)(Wp + ((size_t)g * 64 + td * 32 + r) * 64 + ks * 16 + 8 * h);
                const bf16x8 b = *(const LAS bf16x8*)(Dm + (tt * 32 + r) * 528 + (g * 64 + ks * 16 + 8 * h) * 2);
                acc = MFMA32(a, b, acc); }
            const size_t orow = (size_t)(row0 + tt * 32 + r);
#pragma unroll
            for (int qq = 0; qq < 4; ++qq) { const int dcol = g * 64 + td * 32 + 8 * qq + 4 * h; const f32x4 sc = *(const f32x4*)(psc + dcol);
                u32x2 w; w.x = pk2(acc[4 * qq] * sc.x, acc[4 * qq + 1] * sc.y); w.y = pk2(acc[4 * qq + 2] * sc.z, acc[4 * qq + 3] * sc.w);
                *(u32x2*)(BRA + orow * D + dcol) = w; } }
        __syncthreads();
    }
}
__device__ __forceinline__ void sgu_chunks(Frame& F, int l, bool with_ctx) {
    LAS unsigned char* Vt = F.lds;
    const bf16_t* Z = (const bf16_t*)(F.ws + WS_Z);
    const bf16_t* Ws = (const bf16_t*)(F.ws + WS_WSGU) + (size_t)l * 4 * 16384;
    const float* lng = F.in[IN_SLNG] + l * 256; const float* lnb = F.in[IN_SLNB] + l * 256; const float* sb = F.in[IN_SGUB] + l * 512;
    bf16_t* BRA = (bf16_t*)(F.ws + WS_BRA);
    const int nchunks = with_ctx ? 544 : 512;
    const int r = F.lane & 31, h = F.lane >> 5;
    for (int ch = F.bid; ch < nchunks; ch += F.G) {
        const int row0 = ch * 128;
        { const int s = F.tid >> 2, q = F.tid & 3; const bf16_t* zp = Z + (size_t)(row0 + s) * NZ + ZC_UV + 256 + q * 64;
          float v[64]; float sum = 0.f;
#pragma unroll
          for (int i = 0; i < 8; ++i) { const u32x4 w = __builtin_nontemporal_load((const u32x4*)(zp + 8 * i));
              v[8 * i] = bflo(w.x); v[8 * i + 1] = bfhi(w.x); v[8 * i + 2] = bflo(w.y); v[8 * i + 3] = bfhi(w.y); v[8 * i + 4] = bflo(w.z); v[8 * i + 5] = bfhi(w.z); v[8 * i + 6] = bflo(w.w); v[8 * i + 7] = bfhi(w.w); }
#pragma unroll
          for (int i = 0; i < 64; ++i) sum += v[i];
          sum += shx(sum, 1, F.lane); sum += shx(sum, 2, F.lane);
          const float mean = sum * (1.f / 256.f); float sq = 0.f;
#pragma unroll
          for (int i = 0; i < 64; ++i) { v[i] -= mean; sq += v[i] * v[i]; }
          sq += shx(sq, 1, F.lane); sq += shx(sq, 2, F.lane);
          const float rstd = 1.f / sqrtf(sq * (1.f / 256.f) + LN_EPS);
#pragma unroll
          for (int i = 0; i < 64; ++i) { const int c = q * 64 + i; const float y = v[i] * rstd * lng[c] + lnb[c]; *(LAS bf16_t*)(Vt + c * 272 + s * 2) = (bf16_t)f2bf(y); } }
        __syncthreads();
        const int tc = F.wave & 1, tt = F.wave >> 1, t = tt * 32 + r;
#pragma unroll 1
        for (int g = 0; g < 4; ++g) {
            f32x16 acc = zero16();
#pragma unroll
            for (int ks = 0; ks < 8; ++ks) { const bf16x8 a = *(const LAS bf16x8*)(Vt + (g * 64 + tc * 32 + r) * 272 + (ks * 16 + 8 * h) * 2);
                const bf16x8 b = *(const bf16x8*)(Ws + ((size_t)g * 128 + t) * 128 + ks * 16 + 8 * h);
                acc = MFMA32(a, b, acc); }
            const float bias = sb[g * 128 + t];
#pragma unroll
            for (int qq = 0; qq < 4; ++qq) { const int c0 = g * 64 + tc * 32 + 8 * qq + 4 * h;
                const u32x2 u = *(const u32x2*)(Z + (size_t)(row0 + t) * NZ + ZC_UV + c0);
                u32x2 w; w.x = pk2(bflo(u.x) * (acc[4 * qq] + bias), bfhi(u.x) * (acc[4 * qq + 1] + bias)); w.y = pk2(bflo(u.y) * (acc[4 * qq + 2] + bias), bfhi(u.y) * (acc[4 * qq + 3] + bias));
                *(u32x2*)(BRA + (size_t)(row0 + t) * D + 768 + c0) = w; } }
        __syncthreads();
    }
}
__device__ __forceinline__ void qk_conv_pass(Frame& F, int l) {
    const bf16_t* Z = (const bf16_t*)(F.ws + WS_Z); bf16_t* QKC = (bf16_t*)(F.ws + WS_H);
    const int chunk = F.tid & 127, rsub = F.tid >> 7, ch0 = chunk * 8;
    float w0[8], w1[8], w2[8], cbv[8];
    { const float* cw = F.in[IN_CONVW] + (size_t)l * 3 * 1024 + ch0; const float* cb = F.in[IN_CONVB] + (size_t)l * 1024 + ch0;
#pragma unroll
      for (int e = 0; e < 8; ++e) { w0[e] = cw[e]; w1[e] = cw[1024 + e]; w2[e] = cw[2048 + e]; cbv[e] = cb[e]; } }
    const float scale = chunk >= 64 ? 0.08838834764831845f : 1.0f;
    for (int row = F.bid * 4 + rsub; row < MT; row += F.G * 4) {
        const int p = row < ML ? (row & 4095) : ((row - ML) & 255), len = row < ML ? 4096 : 256;
        const bf16_t* zr = Z + (size_t)row * NZ + ZC_QK + ch0;
        const u32x4 x1 = *(const u32x4*)zr; u32x4 x0 = (u32x4){0u, 0u, 0u, 0u}, x2 = (u32x4){0u, 0u, 0u, 0u};
        if (p > 0) x0 = *(const u32x4*)(zr - NZ);
        if (p + 1 < len) x2 = *(const u32x4*)(zr + NZ);
        const unsigned xa[4] = {x0.x, x0.y, x0.z, x0.w}, xb[4] = {x1.x, x1.y, x1.z, x1.w}, xc[4] = {x2.x, x2.y, x2.z, x2.w};
        float y[8];
#pragma unroll
        for (int e2 = 0; e2 < 4; ++e2) { y[2 * e2] = cbv[2 * e2] + w0[2 * e2] * bflo(xa[e2]) + w1[2 * e2] * bflo(xb[e2]) + w2[2 * e2] * bflo(xc[e2]);
            y[2 * e2 + 1] = cbv[2 * e2 + 1] + w0[2 * e2 + 1] * bfhi(xa[e2]) + w1[2 * e2 + 1] * bfhi(xb[e2]) + w2[2 * e2 + 1] * bfhi(xc[e2]); }
#pragma unroll
        for (int e = 0; e < 8; ++e) y[e] = siluf_(y[e]) * scale;
        u32x4 w; w.x = pk2(y[0], y[1]); w.y = pk2(y[2], y[3]); w.z = pk2(y[4], y[5]); w.w = pk2(y[6], y[7]);
        *(u32x4*)(QKC + (size_t)row * D + ch0) = w;
    }
}
constexpr int ML_QS = 0, ML_KS = 34816, ML_KW = 69632, ML_VT = 104448, ML_CB = 126208, ML_SC = 147968, ML_SCSZ = 2624;
__device__ __forceinline__ float logsigf_(float x) { return fminf(x, 0.f) - log1pf(__expf(-fabsf(x))); }
__device__ __forceinline__ unsigned swap16(unsigned u) { return __builtin_amdgcn_alignbit(u, u, 16); }
struct MlPre { u32x4 qk[8]; u32x2 v[4]; float g[4]; };
__device__ __forceinline__ void ml_geom(int j, int b, int dir, int& seqbase, int& seqlen, int& pbase) {
    const bool is_ctx = j < 2; int cj = is_ctx ? j : j - 2; const int ncs = is_ctx ? 2 : 32; if (dir) cj = ncs - 1 - cj;
    seqbase = is_ctx ? ML + b * 256 : b * 4096; seqlen = is_ctx ? 256 : 4096; pbase = cj * 128; }
#define ML_BAR() do { asm volatile("s_waitcnt lgkmcnt(0)" ::: "memory"); __builtin_amdgcn_s_barrier(); asm volatile("" ::: "memory"); } while (0)
__device__ __forceinline__ void mlstm_unit(Frame& F, int l, int unit) {
    const int bh = (unit & 7) + 8 * (unit >> 5), sub = (unit >> 3) & 3;
    const int b = bh >> 2, head = bh & 3, dir = sub >> 1, vh = sub & 1;
    LAS unsigned char* QS = F.lds + ML_QS; LAS unsigned char* KS = F.lds + ML_KS; LAS unsigned char* KW = F.lds + ML_KW; LAS unsigned char* VT = F.lds + ML_VT; LAS unsigned char* CB = F.lds + ML_CB;
    const bf16_t* Z = (const bf16_t*)(F.ws + WS_Z); const float* ZG = (const float*)(F.ws + WS_ZG); const bf16_t* QKC = (const bf16_t*)(F.ws + WS_H);
    bf16_t* HF = (bf16_t*)(F.ws + WS_HFB) + (size_t)dir * MT * 512;
    const int wave = F.wave;
    int tl = F.tid;
#define ML_ROLES() const int lane = tl & 63, fr = lane & 15, q4 = lane >> 4; const int isk = (tl >> 4) & 1, ck = tl & 15, i0 = 8 * (tl >> 5), chn = (isk ? 512 : 0) + head * 128 + ck * 8; \
    const int vi0 = 4 * (tl >> 4), vcq = tl & 15, vch = head * 128 + vh * 64 + vcq * 4; (void)fr; (void)q4; (void)vi0; (void)vcq; (void)vch; (void)i0; (void)chn; (void)ck; (void)isk;
    for (int idx = F.tid; idx < 16 * 136; idx += NTHREADS) *(LAS bf16_t*)(VT + (64 + idx / 136) * 272 + (idx % 136) * 2) = (idx < 136) ? (bf16_t)0x3F80 : (bf16_t)0;
    f32x4 cs[5];
#pragma unroll
    for (int vt = 0; vt < 5; ++vt) cs[vt] = (f32x4){0.f, 0.f, 0.f, 0.f};
    float m_state = 0.f;
    MlPre pre;
#define ML_PREFETCH(jj) do { int sb_, sl_, pb_; ml_geom((jj), b, dir, sb_, sl_, pb_); \
        { const int pmin = dir ? pb_ + 120 - i0 : pb_ + i0; const bf16_t* zr = QKC + (size_t)(sb_ + pmin) * D + chn; (void)sl_; \
          _Pragma("unroll") for (int k = 0; k < 8; ++k) pre.qk[k] = *(const u32x4*)(zr + (size_t)k * D); } \
        { const int pminv = dir ? pb_ + 124 - vi0 : pb_ + vi0; const bf16_t* zv = Z + (size_t)(sb_ + pminv) * NZ + ZC_V + vch; \
          _Pragma("unroll") for (int k = 0; k < 4; ++k) pre.v[k] = *(const u32x2*)(zv + (size_t)k * NZ); } \
        if (wave == 0) { const int p0 = dir ? pb_ + 127 - 2 * lane : pb_ + 2 * lane, p1 = dir ? p0 - 1 : p0 + 1; \
          pre.g[0] = ZG[(size_t)(sb_ + p0) * 16 + dir * 8 + head]; pre.g[1] = ZG[(size_t)(sb_ + p0) * 16 + dir * 8 + 4 + head]; \
          pre.g[2] = ZG[(size_t)(sb_ + p1) * 16 + dir * 8 + head]; pre.g[3] = ZG[(size_t)(sb_ + p1) * 16 + dir * 8 + 4 + head]; } } while (0)
#define ML_STEPA(sbuf) do { LAS float* sg_ = (LAS float*)(F.lds + ML_SC + (sbuf) * ML_SCSZ); const int i0g = 2 * lane, i1g = i0g + 1; \
        const float gi0 = pre.g[0], gf0 = pre.g[1], gi1 = pre.g[2], gf1 = pre.g[3]; \
        const float lf0 = logsigf_(gf0), lf1 = logsigf_(gf1); const float s1 = lf0 + lf1; float incl = s1; \
        _Pragma("unroll") for (int o = 1; o < 64; o <<= 1) { const float y_ = shup(incl, o, lane); incl += (lane >= o) ? y_ : 0.f; } \
        const float excl = incl - s1, bc0 = excl + lf0, bc1 = excl + s1; \
        const float g0 = gi0 - bc0, g1 = gi1 - bc1; const float mx1 = fmaxf(g0, g1); float im = mx1; \
        _Pragma("unroll") for (int o = 1; o < 64; o <<= 1) { const float y_ = shup(im, o, lane); im = (lane >= o) ? fmaxf(im, y_) : im; } \
        float em = shup(im, 1, lane); em = (lane == 0) ? -3.0e38f : em; \
        const float M0 = fmaxf(m_state, fmaxf(em, g0)), M1 = fmaxf(m_state, fmaxf(em, mx1)); \
        const float total = bperm(63, bc1), Mlast = bperm(63, M1); \
        sg_[i0g] = g0; sg_[i1g] = g1; sg_[128 + i0g] = M0; sg_[128 + i1g] = M1; \
        sg_[256 + i0g] = __expf(m_state - M0); sg_[256 + i1g] = __expf(m_state - M1); \
        sg_[384 + i0g] = __expf(-(bc0 + M0)); sg_[384 + i1g] = __expf(-(bc1 + M1)); \
        sg_[512 + i0g] = __expf(g0 - Mlast); sg_[512 + i1g] = __expf(g1 - Mlast); \
        if (lane == 0) sg_[640] = __expf(m_state - Mlast); \
        m_state = total + Mlast; } while (0)
    { ML_ROLES(); ML_PREFETCH(0); if (wave == 0) ML_STEPA(0); }
    ML_BAR();
#pragma unroll 1
    for (int j = 0; j < 34; ++j) {
        asm volatile("" : "+v"(tl));
        ML_ROLES();
        int seqbase, seqlen, pbase; ml_geom(j, b, dir, seqbase, seqlen, pbase);
        const LAS float* sc_g = (const LAS float*)(F.lds + ML_SC + (j & 1) * ML_SCSZ); const LAS float* sc_M = sc_g + 128; const LAS float* sc_dec = sc_g + 256; const LAS float* sc_emt = sc_g + 384; const LAS float* sc_wk = sc_g + 512;
        {
#pragma unroll
          for (int k = 0; k < 8; ++k) { const int i = dir ? i0 + 7 - k : i0 + k; *(LAS u32x4*)((isk ? KS : QS) + i * 272 + ck * 16) = pre.qk[k]; }
          if (isk) { u32x4 kt[8]; float ykeep[8];
#pragma unroll
              for (int e = 0; e < 8; ++e) { kt[e] = (u32x4){0u, 0u, 0u, 0u}; ykeep[e] = 0.f; }
#pragma unroll
              for (int k = 0; k < 8; ++k) { const int i = dir ? i0 + 7 - k : i0 + k; const float wk = sc_wk[i];
                  const unsigned xb[4] = {pre.qk[k].x, pre.qk[k].y, pre.qk[k].z, pre.qk[k].w};
#pragma unroll
                  for (int e = 0; e < 8; ++e) { const float yw = ((e & 1) ? bfhi(xb[e >> 1]) : bflo(xb[e >> 1])) * wk;
                      if (k & 1) { const unsigned pw_ = pk2(ykeep[e], yw); if ((k >> 1) == 0) kt[e].x = pw_; else if ((k >> 1) == 1) kt[e].y = pw_; else if ((k >> 1) == 2) kt[e].z = pw_; else kt[e].w = pw_; }
                      else ykeep[e] = yw; } }
#pragma unroll
              for (int e = 0; e < 8; ++e) { u32x4 o = kt[e]; if (dir) o = (u32x4){swap16(kt[e].w), swap16(kt[e].z), swap16(kt[e].y), swap16(kt[e].x)};
                  *(LAS u32x4*)(KW + (ck * 8 + e) * 272 + (((i0 >> 3) ^ (ck & 7)) * 16)) = o; } } }
        { unsigned vv[4][2];
#pragma unroll
          for (int k = 0; k < 4; ++k) { vv[k][0] = pre.v[k].x; vv[k][1] = pre.v[k].y; }
#pragma unroll
          for (int c = 0; c < 4; ++c) {
              unsigned h0 = (c & 1) ? (vv[0][c >> 1] >> 16) : (vv[0][c >> 1] & 0xffffu), h1 = (c & 1) ? (vv[1][c >> 1] >> 16) : (vv[1][c >> 1] & 0xffffu);
              unsigned h2 = (c & 1) ? (vv[2][c >> 1] >> 16) : (vv[2][c >> 1] & 0xffffu), h3 = (c & 1) ? (vv[3][c >> 1] >> 16) : (vv[3][c >> 1] & 0xffffu);
              u32x2 o; if (dir) { o.x = h3 | (h2 << 16); o.y = h1 | (h0 << 16); } else { o.x = h0 | (h1 << 16); o.y = h2 | (h3 << 16); }
              *(LAS u32x2*)(VT + (vcq * 4 + c) * 272 + vi0 * 2) = o; } }
#pragma unroll
        for (int vt = 0; vt < 5; ++vt)
#pragma unroll
            for (int rr = 0; rr < 4; rr += 2) { const unsigned pw_ = pk2(cs[vt][rr], cs[vt][rr + 1]);
                *(LAS bf16_t*)(CB + (16 * vt + 4 * q4 + rr) * 272 + (16 * wave + fr) * 2) = (bf16_t)(pw_ & 0xffffu); *(LAS bf16_t*)(CB + (16 * vt + 4 * q4 + rr + 1) * 272 + (16 * wave + fr) * 2) = (bf16_t)(pw_ >> 16); }
        ML_BAR();
        if (j + 1 < 34) ML_PREFETCH(j + 1);
        const int t = 16 * wave + fr;
        bf16x8 qf[4];
#pragma unroll
        for (int kc = 0; kc < 4; ++kc) qf[kc] = *(const LAS bf16x8*)(QS + t * 272 + (32 * kc + 8 * q4) * 2);
        const float Mt_t = sc_M[t], dec_t = sc_dec[t], emt_t = sc_emt[t];
        f32x4 ps[8];
#pragma unroll
        for (int jp = 0; jp < 4; ++jp) {
            ps[2 * jp] = (f32x4){0.f, 0.f, 0.f, 0.f}; ps[2 * jp + 1] = (f32x4){0.f, 0.f, 0.f, 0.f};
            if (2 * jp <= wave) {
                bf16x8 ka[4], kb[4];
#pragma unroll
                for (int kc = 0; kc < 4; ++kc) { ka[kc] = *(const LAS bf16x8*)(KS + (32 * jp + fr) * 272 + (32 * kc + 8 * q4) * 2); kb[kc] = *(const LAS bf16x8*)(KS + (32 * jp + 16 + fr) * 272 + (32 * kc + 8 * q4) * 2); }
                const f32x4 ga4 = *(const LAS f32x4*)(sc_g + 32 * jp + 4 * q4), gb4 = *(const LAS f32x4*)(sc_g + 32 * jp + 16 + 4 * q4);
                f32x4 acc0 = (f32x4){0.f, 0.f, 0.f, 0.f}, acc1 = (f32x4){0.f, 0.f, 0.f, 0.f};
#pragma unroll
                for (int kc = 0; kc < 4; ++kc) { acc0 = MFMA16(ka[kc], qf[kc], acc0); acc1 = MFMA16(kb[kc], qf[kc], acc1); }
#pragma unroll
                for (int rr = 0; rr < 4; ++rr) { const int s0 = 32 * jp + 4 * q4 + rr, s1 = s0 + 16;
                    ps[2 * jp][rr] = (s0 <= t) ? acc0[rr] * __expf(ga4[rr] - Mt_t) : 0.f; ps[2 * jp + 1][rr] = (s1 <= t) ? acc1[rr] * __expf(gb4[rr] - Mt_t) : 0.f; }
            }
        }
        f32x4 ao[5];
        {
#pragma unroll
          for (int vt = 0; vt < 5; ++vt) ao[vt] = (f32x4){0.f, 0.f, 0.f, 0.f};
#pragma unroll
          for (int kh = 0; kh < 4; kh += 2) { bf16x8 cf[2][5];
#pragma unroll
              for (int k2 = 0; k2 < 2; ++k2)
#pragma unroll
                  for (int vt = 0; vt < 5; ++vt) cf[k2][vt] = *(const LAS bf16x8*)(CB + (16 * vt + fr) * 272 + (32 * (kh + k2) + 8 * q4) * 2);
#pragma unroll
              for (int k2 = 0; k2 < 2; ++k2)
#pragma unroll
                  for (int vt = 0; vt < 5; ++vt) ao[vt] = MFMA16(cf[k2][vt], qf[kh + k2], ao[vt]); }
#pragma unroll
          for (int vt = 0; vt < 5; ++vt) ao[vt] = ao[vt] * dec_t; }
#pragma unroll
        for (int ks = 0; ks < 4; ++ks) {
            if (2 * ks <= wave) {
                s16x4 vlo[5], vhi[5];
#pragma unroll
                for (int vt = 0; vt < 5; ++vt) { vlo[vt] = *(const LAS s16x4*)(VT + (16 * vt + fr) * 272 + (32 * ks + 4 * q4) * 2); vhi[vt] = *(const LAS s16x4*)(VT + (16 * vt + fr) * 272 + (32 * ks + 16 + 4 * q4) * 2); }
                u32x4 pw; pw.x = cvt_pk_bf16(ps[2 * ks][0], ps[2 * ks][1]); pw.y = cvt_pk_bf16(ps[2 * ks][2], ps[2 * ks][3]); pw.z = cvt_pk_bf16(ps[2 * ks + 1][0], ps[2 * ks + 1][1]); pw.w = cvt_pk_bf16(ps[2 * ks + 1][2], ps[2 * ks + 1][3]);
                const bf16x8 pf = __builtin_bit_cast(bf16x8, pw);
#pragma unroll
                for (int vt = 0; vt < 5; ++vt) { const bf16x8 a = __builtin_shufflevector(vlo[vt], vhi[vt], 0, 1, 2, 3, 4, 5, 6, 7); ao[vt] = MFMA16(a, pf, ao[vt]); }
            }
        }
        { const float den = bperm(fr, ao[4][0]); const float inv = 1.0f / fmaxf(fabsf(den), emt_t);
          const int p = dir ? pbase + 127 - t : pbase + t; bf16_t* orow = HF + (size_t)(seqbase + p) * 512 + head * 128 + vh * 64 + 4 * q4;
#pragma unroll
          for (int vt = 0; vt < 4; ++vt) { const f32x4 o = ao[vt] * inv; u32x2 w; w.x = cvt_pk_bf16(o[0], o[1]); w.y = cvt_pk_bf16(o[2], o[3]); *(u32x2*)(orow + 16 * vt) = w; } }
        { const float a_s = sc_g[640];
#pragma unroll
          for (int vt = 0; vt < 5; ++vt) cs[vt] = cs[vt] * a_s;
#pragma unroll
          for (int ks = 0; ks < 4; ks += 2) { bf16x8 bb[2], va[2][5];
#pragma unroll
              for (int k2 = 0; k2 < 2; ++k2) { bb[k2] = *(const LAS bf16x8*)(KW + (16 * wave + fr) * 272 + (((4 * (ks + k2) + q4) ^ (((16 * wave + fr) >> 3) & 7)) * 16));
#pragma unroll
                  for (int vt = 0; vt < 5; ++vt) va[k2][vt] = *(const LAS bf16x8*)(VT + (16 * vt + fr) * 272 + (32 * (ks + k2) + 8 * q4) * 2); }
#pragma unroll
              for (int k2 = 0; k2 < 2; ++k2)
#pragma unroll
                  for (int vt = 0; vt < 5; ++vt) cs[vt] = MFMA16(va[k2][vt], bb[k2], cs[vt]); } }
        if (wave == 0 && j + 1 < 34) ML_STEPA((j + 1) & 1);
        ML_BAR();
    }
#undef ML_PREFETCH
#undef ML_STEPA
#undef ML_ROLES
    __syncthreads();
}
__device__ __forceinline__ void phase_mixers(Frame& F, int l) {
    const bool with_ctx = (l != DEPTH - 1);
#ifndef MIX_MASK
#define MIX_MASK 7
#endif
#ifndef MIXREP
#define MIXREP 0
#endif
    if (MIX_MASK & 1) pool_tiles(F, l, with_ctx);
    if (MIXREP & 1) { __syncthreads(); pool_tiles(F, l, with_ctx); }
    if (MIX_MASK & 2) sgu_chunks(F, l, with_ctx);
    if (MIXREP & 2) { __syncthreads(); sgu_chunks(F, l, with_ctx); }
    (void)0;
    qk_conv_pass(F, l);
}
__device__ __forceinline__ void phase_mlstm(Frame& F, int l) {
    for (int u = F.bid; u < 256; u += F.G) mlstm_unit(F, l, u);
}

struct Args { const float* in[31]; float* out; unsigned char* ws; int g_lo, g_hi, pad0, pad1; };
constexpr int NPH = 11, NGID = 2 + DEPTH * NPH;
__global__ void __launch_bounds__(NTHREADS, 2) fwd_kernel(Args args) {
    extern __shared__ __attribute__((aligned(16))) unsigned char lds_raw[];
    Frame F;
    F.lds = (LAS unsigned char*)lds_raw; F.MISC = (volatile LAS unsigned*)(F.lds + MISC_OFF);
    F.tid = threadIdx.x; F.lane = F.tid & 63; F.wave = __builtin_amdgcn_readfirstlane(F.tid >> 6); F.G = gridDim.x; F.bid = blockIdx.x;
    F.ws = args.ws; F.out = args.out;
    F.in = (InTab)__builtin_amdgcn_kernarg_segment_ptr();
    if (F.tid < 64) F.MISC[F.tid] = 0u;
    __syncthreads();
    const int lo = args.g_lo, hi = args.g_hi;
    const bool multi = (hi - lo) > 1;
    XcdBarrier bar; bar.bar = (unsigned*)(F.ws + WS_CTL) + CW_BAR; bar.x = 0; bar.st = nullptr;
    if (multi) bar = xcd_barrier_post((unsigned*)(F.ws + WS_CTL) + CW_BAR, F.MISC + 8);
#ifndef PHASE_MASK
#define PHASE_MASK 0xFFFF
#endif
#define RUN(g) (lo <= (g) && (g) < hi)
#define RUNP(ty, g) ((((PHASE_MASK) >> (ty)) & 1) && RUN(g))
#ifndef REPEAT_MASK
#define REPEAT_MASK 0
#endif
#define NREP(ty) ((((REPEAT_MASK) >> (ty)) & 1) ? 2 : 1)
#define SEAM(g) do { if (RUN((g) + 1)) xcd_barrier(bar); } while (0)
#define LAUNDER(P) Frame P = F; { int t_; asm volatile("v_mbcnt_lo_u32_b32 %0, -1, 0\n\tv_mbcnt_hi_u32_b32 %0, -1, %0" : "=v"(t_)); t_ |= (F.wave << 6); P.tid = t_; P.lane = t_ & 63; P.wave = __builtin_amdgcn_readfirstlane(t_ >> 6); GAS unsigned char* w_ = (GAS unsigned char*)F.ws; asm volatile("" : "+s"(w_)); P.ws = (unsigned char*)w_; InTab t2_ = F.in; asm volatile("" : "+s"(t2_)); P.in = t2_; }
    if (RUNP(0, 0)) { LAUNDER(P); for (int rep_ = 0; rep_ < NREP(0); ++rep_) { phase_prologue(P); __syncthreads(); } SEAM(0); }
    if (RUNP(1, 1)) { LAUNDER(P); for (int rep_ = 0; rep_ < NREP(1); ++rep_) { phase_ln0_first(P); __syncthreads(); } SEAM(1); }
#pragma unroll 1
    for (int l = 0; l < DEPTH; ++l) {
        const int g0 = 2 + l * NPH;
        const int mrows = (l == DEPTH - 1) ? ML : MT;
        if (RUNP(2, g0 + 0)) {
#undef PHTY
#define PHTY 2
            LAUNDER(P);
            { ProbPlain Pr{(const bf16_t*)(P.ws + WS_H), (const bf16_t*)(P.ws + WS_WIN) + (size_t)l * NZ * D, D, D};
              pg8::StaticOrder<1> S; S.init(MT / 256, NZ_BF / 256, P.G, P.bid);
              EpiInproj E{(bf16_t*)(P.ws + WS_Z), P.in[IN_BIN] + (size_t)l * 5904, 0};
              pg8::gemm_phase(P.lds, P.tid, Pr, S, E); }
            __syncthreads();
            { ProbPlainF8 Pr{(const bf16_t*)(P.ws + WS_H8), (const bf16_t*)(P.ws + WS_WIN8 + (size_t)l * NZ_F8 * D), D / 2, D / 2};
              pg8::StaticOrder<1> S; S.init(MT / 256, NZ_F8 / 256, P.G, P.bid);
              EpiInproj E{(bf16_t*)(P.ws + WS_Z), P.in[IN_BIN] + (size_t)l * 5904, NZ_BF / 256};
              pg8::gemm_phase(P.lds, P.tid, Pr, S, E); }
            SEAM(g0 + 0);
        }
        if (RUNP(3, g0 + 1)) { LAUNDER(P); for (int rep_ = 0; rep_ < NREP(3); ++rep_) { phase_mixers(P, l); __syncthreads(); } SEAM(g0 + 1); }
        if (RUNP(12, g0 + 2)) { LAUNDER(P); for (int rep_ = 0; rep_ < NREP(12); ++rep_) { phase_mlstm(P, l); __syncthreads(); } SEAM(g0 + 2); }
        if (RUNP(4, g0 + 3)) { LAUNDER(P); for (int rep_ = 0; rep_ < NREP(4); ++rep_) phase_finalize(P, l, mrows); SEAM(g0 + 3); }
        if (RUNP(5, g0 + 4)) {
#undef PHTY
#define PHTY 5
            LAUNDER(P);
            ProbPlain Pr{(const bf16_t*)(P.ws + WS_BRA), (const bf16_t*)(P.ws + WS_WBR) + (size_t)l * D * D, D, D};
            pg8::StaticOrder<1> S; S.init(mrows / 256, 4, P.G, P.bid);
            EpiBranch E{(const bf16_t*)(P.ws + WS_Z), (bf16_t*)(P.ws + WS_Y)};
            pg8::gemm_phase(P.lds, P.tid, Pr, S, E); if (NREP(PHTY) == 2) { __syncthreads(); pg8::gemm_phase(P.lds, P.tid, Pr, S, E); }
            SEAM(g0 + 4);
        }
        if (RUNP(6, g0 + 5)) {
#undef PHTY
#define PHTY 6
            LAUNDER(P);
            ProbPlain Pr{(const bf16_t*)(P.ws + WS_Y), (const bf16_t*)(P.ws + WS_WOUT) + (size_t)l * D * D, D, D};
            pg8::StaticOrder<1> S; S.init(mrows / 256, 4, P.G, P.bid);
            EpiOut E{(bf16_t*)(P.ws + WS_T)};
            pg8::gemm_phase(P.lds, P.tid, Pr, S, E); if (NREP(PHTY) == 2) { __syncthreads(); pg8::gemm_phase(P.lds, P.tid, Pr, S, E); }
            SEAM(g0 + 5);
        }
        if (RUNP(7, g0 + 6)) { LAUNDER(P); for (int rep_ = 0; rep_ < NREP(7); ++rep_) phase_ln1_router(P, l, mrows); SEAM(g0 + 6); }
        if (RUNP(8, g0 + 7)) { LAUNDER(P); for (int rep_ = 0; rep_ < NREP(8); ++rep_) phase_slots(P, mrows); SEAM(g0 + 7); }
        if (RUNP(9, g0 + 8)) {
#undef PHTY
#define PHTY 9
            LAUNDER(P);
            LAS int* seg = (LAS int*)(P.lds + TAB_OFF);
            const int ntile = moe_tables(P, seg);
            ProbMoe1 Pr{(const bf16_t*)(P.ws + WS_H2F8), (const bf16_t*)(P.ws + WS_WGU + (size_t)l * NEXP * 2048 * D), D / 2, D / 2, (const int*)(P.ws + WS_ROUTE + RT_TOK), seg};
            pg8::StaticOrder<1> S; S.init(ntile, 8, P.G, P.bid);
            EpiSwiglu E{(unsigned char*)(P.ws + WS_HID), P.in[IN_BGU] + (size_t)l * NEXP * 2048, seg};
            pg8::gemm_phase(P.lds, P.tid, Pr, S, E); if (NREP(PHTY) == 2) { __syncthreads(); pg8::gemm_phase(P.lds, P.tid, Pr, S, E); }
            SEAM(g0 + 8);
        }
        if (RUNP(10, g0 + 9)) {
#undef PHTY
#define PHTY 10
            LAUNDER(P);
            LAS int* seg = (LAS int*)(P.lds + TAB_OFF);
            const int ntile = moe_tables(P, seg);
            ProbMoe2 Pr{(const bf16_t*)(P.ws + WS_HID), (const bf16_t*)(P.ws + WS_WDN + (size_t)l * NEXP * D * D), D / 2, D / 2, seg};
            pg8::StaticOrder<1> S; S.init(ntile, 4, P.G, P.bid);
            EpiDown E{(bf16_t*)(P.ws + WS_FS), P.in[IN_BDN] + (size_t)l * NEXP * D, (const int*)(P.ws + WS_ROUTE + RT_DEST), (const float*)(P.ws + WS_ROUTE + RT_PSLOT), seg};
            pg8::gemm_phase(P.lds, P.tid, Pr, S, E); if (NREP(PHTY) == 2) { __syncthreads(); pg8::gemm_phase(P.lds, P.tid, Pr, S, E); }
            SEAM(g0 + 9);
        }
        if (RUNP(11, g0 + 10)) { LAUNDER(P); phase_combine_ln2(P, l, mrows); SEAM(g0 + 10); }
    }
#undef LAUNDER
#undef RUN
#undef RUNP
#undef SEAM
}

extern "C" void kernel_launch(void* const* d_in, const int* in_sizes, int n_in, void* d_out, int out_size, void* d_ws, size_t ws_size, hipStream_t stream) {
    static int grid = 0;
    if (grid == 0) {
        if (n_in != 31 || out_size != ML * D || ws_size < WS_END) { fprintf(stderr, "kernel_launch: unexpected problem (n_in %d, out %d, ws %zu, need %zu)\n", n_in, out_size, ws_size, (size_t)WS_END); grid = -1; return; }
        int dev = 0, cus = 0, per_cu = 0;
        if (hipGetDevice(&dev) != hipSuccess || hipDeviceGetAttribute(&cus, hipDeviceAttributeMultiprocessorCount, dev) != hipSuccess) { grid = -1; return; }
        if (hipFuncSetAttribute((const void*)fwd_kernel, hipFuncAttributeMaxDynamicSharedMemorySize, LDS_BYTES) != hipSuccess) { fprintf(stderr, "kernel_launch: hipFuncSetAttribute failed\n"); grid = -1; return; }
        if (hipOccupancyMaxActiveBlocksPerMultiprocessor(&per_cu, (const void*)fwd_kernel, NTHREADS, LDS_BYTES) != hipSuccess || per_cu < 1) fprintf(stderr, "kernel_launch: occupancy query reports %d\n", per_cu);
        (void)hipGetLastError();
        grid = cus;
    }
    if (grid < 0) return;
    (void)hipMemsetAsync((char*)d_ws + WS_CTL, 0, CTL_ZERO_BYTES, stream);
    Args a{};
    for (int i = 0; i < 31; ++i) a.in[i] = (const float*)d_in[i];
    a.out = (float*)d_out; a.ws = (unsigned char*)d_ws;
#if MK_N_LAUNCHES == 1
    a.g_lo = 0; a.g_hi = NGID;
    hipLaunchKernelGGL(fwd_kernel, dim3(grid), dim3(NTHREADS), LDS_BYTES, stream, a);
#else
    for (int g = 0; g < NGID; ++g) { a.g_lo = g; a.g_hi = g + 1; hipLaunchKernelGGL(fwd_kernel, dim3(grid), dim3(NTHREADS), LDS_BYTES, stream, a); }
#endif
}
```

```cpp
#include <hip/hip_runtime.h>
#include <cstdio>
#include <cstdint>

#ifndef MK_N_LAUNCHES
#define MK_N_LAUNCHES 1
#endif

#define LAS __attribute__((address_space(3)))
#define GAS __attribute__((address_space(1)))
typedef unsigned short bf16_t;
typedef short bf16x8 __attribute__((ext_vector_type(8)));
typedef short s16x4 __attribute__((ext_vector_type(4)));
typedef float f32x4 __attribute__((ext_vector_type(4)));
typedef float f32x2 __attribute__((ext_vector_type(2)));
typedef float f32x16 __attribute__((ext_vector_type(16)));
typedef unsigned u32x4 __attribute__((ext_vector_type(4)));
typedef unsigned u32x2 __attribute__((ext_vector_type(2)));
typedef int i32x4 __attribute__((ext_vector_type(4)));
typedef int i32x8 __attribute__((ext_vector_type(8)));

constexpr int D = 1024, NB = 16, SEQ = 4096, CTXL = 256, DEPTH = 4;
constexpr int ML = NB * SEQ;
constexpr int MC = NB * CTXL;
constexpr int MT = ML + MC;
constexpr int NZ = 5888;
constexpr int ZC_P = 0, ZC_QK = 256, ZC_V = 1280, ZC_O = 1792, ZC_UV = 2304, ZC_MG = 2816;
constexpr int NZ_BF = 2816, NZ_F8 = 3072;
constexpr int NEXP = 32, TOPK = 4;
constexpr int NS_MAX = MT * TOPK + NEXP * 256;
constexpr float LN_EPS = 1e-5f, HEAD_EPS = 1e-6f;
constexpr float DN_ALPHA = 1.6817928305074292f;
constexpr int NWAVES = 8, NTHREADS = 512;
constexpr float F8S_ACT = 4.0f, F8S_WGU = 64.0f, F8S_WDN = 64.0f; constexpr int F8E_ACT = 123, F8E_WGU = 123, F8E_WDN = 123;

constexpr size_t MiB = 1u << 20;
constexpr size_t WS_CTL = 0, CTL_ZERO_BYTES = 1 * MiB;
constexpr size_t WS_MOD = 1 * MiB;
constexpr size_t WS_WG = 3 * MiB;
constexpr size_t WS_WSGU = 4 * MiB;
constexpr size_t WS_WPOOL = WS_WSGU + 512 * 1024;
constexpr size_t WS_ROUTE = 5 * MiB;
constexpr size_t WS_WIN = 16 * MiB;
constexpr size_t WS_WBR = 62 * MiB;
constexpr size_t WS_WOUT = 70 * MiB;
constexpr size_t WS_WGU = 78 * MiB;
constexpr size_t WS_WDN = 590 * MiB;
constexpr size_t WS_X = 846 * MiB;
constexpr size_t WS_H = 1118 * MiB;
constexpr size_t WS_Z = 1254 * MiB;
constexpr size_t WS_FS = WS_Z;
constexpr float FS_SCALE = 32.0f, FS_CLAMP = 440.0f;
constexpr size_t WS_BRA = 2036 * MiB;
constexpr size_t WS_HFB = 2172 * MiB;
constexpr size_t WS_Y = 2444 * MiB;
constexpr size_t WS_T = 2580 * MiB;
constexpr size_t WS_H2 = 2852 * MiB;
constexpr size_t WS_HID = 2988 * MiB;
constexpr size_t WS_ZG = 3548 * MiB;
constexpr size_t WS_H2F8 = 3554 * MiB;
constexpr size_t WS_H8 = 3624 * MiB;
constexpr size_t WS_WIN8 = 3692 * MiB;
constexpr size_t WS_END = 3704 * MiB;
static_assert(WS_Z + (size_t)MT * NZ * 2 <= WS_BRA && WS_FS + (size_t)MT * 4 * 1024 * 2 <= WS_BRA, "Z/FS");
static_assert(WS_HID + (size_t)NS_MAX * 1024 * 2 <= WS_END, "HID");
constexpr size_t RT_EIDX = 0;
constexpr size_t RT_PROB = 2 * MiB;
constexpr size_t RT_TOK = 4 * MiB;
constexpr size_t RT_DEST = 6 * MiB;
constexpr size_t RT_PSLOT = 8 * MiB;
constexpr size_t RT_CNT = 10 * MiB;
constexpr size_t RT_SEG = 10 * MiB + 64 * 1024;
constexpr int CW_BAR = 4096;

constexpr int LDS_BYTES = 163840;
constexpr int MISC_OFF = LDS_BYTES - 256;
constexpr int TAB_OFF = 131072;
constexpr int NW_WT = 0;
constexpr int NW_LG = 66048;
constexpr int NW_END = 99840;
constexpr int NW_PV = NW_END + 256;

__device__ __forceinline__ unsigned f2bf(float f) { unsigned u = __builtin_bit_cast(unsigned, f); return (u + 0x7fffu + ((u >> 16) & 1u)) >> 16; }
__device__ __forceinline__ unsigned pk2(float lo, float hi) { unsigned r; asm volatile("v_cvt_pk_bf16_f32 %0, %1, %2" : "=v"(r) : "v"(lo), "v"(hi)); return r; }
__device__ __forceinline__ unsigned pk4_fp8(float a, float b, float c, float d) { int w = 0; w = __builtin_amdgcn_cvt_pk_fp8_f32(a, b, w, false); w = __builtin_amdgcn_cvt_pk_fp8_f32(c, d, w, true); return (unsigned)w; }
__device__ __forceinline__ float bflo(unsigned w) { return __builtin_bit_cast(float, w << 16); }
__device__ __forceinline__ float bfhi(unsigned w) { return __builtin_bit_cast(float, w & 0xffff0000u); }
__device__ __forceinline__ float bf1(bf16_t h) { return __builtin_bit_cast(float, ((unsigned)h) << 16); }
__device__ __forceinline__ float bperm(int srclane, float v) { return __builtin_bit_cast(float, __builtin_amdgcn_ds_bpermute(srclane << 2, __builtin_bit_cast(int, v))); }
__device__ __forceinline__ float shx(float v, int o, int lane) { return bperm(lane ^ o, v); }
__device__ __forceinline__ float shup(float v, int o, int lane) { return bperm(lane >= o ? lane - o : lane, v); }
__device__ __forceinline__ float wave_sum(float v, int lane) {
#pragma unroll
    for (int o = 1; o < 64; o <<= 1) v += shx(v, o, lane);
    return v;
}
__device__ __forceinline__ float sigmoidf_(float x) { return __builtin_amdgcn_rcpf(1.0f + __builtin_amdgcn_exp2f(x * -1.4426950408889634f)); }
__device__ __forceinline__ float siluf_(float x) { return x * __builtin_amdgcn_rcpf(1.0f + __builtin_amdgcn_exp2f(x * -1.4426950408889634f)); }
#define LDS_WAIT() asm volatile("s_waitcnt lgkmcnt(0)" ::: "memory")
#define VM_WAIT() asm volatile("s_waitcnt vmcnt(0)" ::: "memory")

#define XB_TMO      128
#define XB_XCNT(j)  (256  + 64 * (j))
#define XB_XSUB(j)  (1280 + 64 * (j))
#define XB_XGEN(j)  (2304 + 64 * (j))
#define XB_TOP      3328
#define XB_TOPGEN   3392
#define XCD_BAR_WORDS 3456
#define XB_SPIN_CAP (1u << 18)
__device__ __forceinline__ unsigned xb_ld(unsigned* p)              { return __hip_atomic_load(p, __ATOMIC_RELAXED, __HIP_MEMORY_SCOPE_AGENT); }
__device__ __forceinline__ unsigned xb_add(unsigned* p, unsigned v) { return __hip_atomic_fetch_add(p, v, __ATOMIC_RELAXED, __HIP_MEMORY_SCOPE_AGENT); }
__device__ __forceinline__ unsigned xb_xcc_id() { return (unsigned)__builtin_amdgcn_s_getreg((3 << 11) | 20) & 0xFu; }
#define XB_SPIN(cond, bar) do { unsigned _sp = 0; while (cond) { __builtin_amdgcn_s_sleep(1); \
    if ((++_sp & 255u) == 0u) { if (xb_ld(&(bar)[XB_TMO])) break; if (_sp > XB_SPIN_CAP) { atomicAdd(&(bar)[XB_TMO], 1u); break; } } } } while (0)
struct XcdBarrier { unsigned* bar; unsigned x; volatile LAS unsigned* st; };
__device__ __forceinline__ XcdBarrier xcd_barrier_post(unsigned* bar, volatile LAS unsigned* st) {
    XcdBarrier b; b.bar = bar; b.x = xb_xcc_id(); b.st = st;
    if (threadIdx.x == 0) (void)xb_add(&bar[XB_XCNT(b.x)], 1u);
    return b;
}
__device__ __forceinline__ void xcd_barrier_complete(unsigned* bar, unsigned x, unsigned& nloc, unsigned& nx) {
    const unsigned G = gridDim.x * gridDim.y * gridDim.z;
    unsigned sum, cnt, mine, sp = 0u;
    for (;;) {
        sum = 0u; cnt = 0u; mine = 0u;
#pragma unroll
        for (unsigned j = 0; j < 16; ++j) { const unsigned c = xb_ld(&bar[XB_XCNT(j)]); sum += c; cnt += (c > 0u) ? 1u : 0u; mine = (j == x) ? c : mine; }
        if (sum == G) break;
        __builtin_amdgcn_s_sleep(1);
        if ((++sp & 255u) == 0u) { if (xb_ld(&bar[XB_TMO])) break; if (sp > XB_SPIN_CAP) { atomicAdd(&bar[XB_TMO], 1u); break; } }
    }
    nloc = mine > 0u ? mine : 1u; nx = cnt > 0u ? cnt : 1u;
}
__device__ __forceinline__ void xcd_barrier(const XcdBarrier& b) {
    asm volatile("s_waitcnt vmcnt(0)" ::: "memory");
    __syncthreads();
    if (threadIdx.x == 0) {
        unsigned* bar = b.bar;
        __builtin_amdgcn_s_waitcnt(0);
        unsigned nloc = b.st[0], nx = b.st[1];
        if (nloc == 0u) { xcd_barrier_complete(bar, b.x, nloc, nx); b.st[0] = nloc; b.st[1] = nx; }
        const unsigned old = xb_add(&bar[XB_XSUB(b.x)], 1u);
        const unsigned gen = old / nloc;
        if (old + 1u == (gen + 1u) * nloc) {
            __builtin_amdgcn_fence(__ATOMIC_RELEASE, "agent");
            asm volatile("s_waitcnt vmcnt(0)" ::: "memory");
            const unsigned og = xb_add(&bar[XB_TOP], 1u);
            const unsigned tg = og / nx;
            if (og + 1u == (tg + 1u) * nx) xb_add(&bar[XB_TOPGEN], 1u);
            else XB_SPIN(xb_ld(&bar[XB_TOPGEN]) == tg, bar);
            __builtin_amdgcn_fence(__ATOMIC_ACQUIRE, "agent");
            xb_add(&bar[XB_XGEN(b.x)], 1u);
            asm volatile("s_waitcnt vmcnt(0)" ::: "memory");
        } else {
            XB_SPIN(xb_ld(&bar[XB_XGEN(b.x)]) == gen, bar);
            __builtin_amdgcn_fence(__ATOMIC_ACQUIRE, "agent");
            asm volatile("s_waitcnt vmcnt(0)" ::: "memory");
        }
    }
    __syncthreads();
}

namespace pg8 {
constexpr int BM = 256, BK = 64, HALF = 128, HTB = HALF * BK * 2, STAGE_BYTES = 8 * HTB, NXCD = 8, WGM = 8;
__host__ __device__ __forceinline__ int lds_byte(int r, int c) { const int st = (r >> 4) * 2 + (c >> 5), rr = r & 15, cc = c & 31, ob = rr * 64 + cc * 2; return st * 1024 + (ob ^ (((ob >> 9) & 1) << 5)); }
__host__ __device__ __forceinline__ void stage_rc(int b, int& R, int& C) { const int st = b / 1024, sb = b % 1024, swz = sb ^ (((sb >> 9) & 1) << 5); R = (st >> 1) * 16 + swz / 64; C = (st & 1) * 32 + (swz % 64) / 2; }
__host__ __device__ __forceinline__ int perm32(int rho) { const int n = rho >> 4, i = rho & 15; return 8 * (i >> 2) + 4 * n + (i & 3); }
struct Unit { int pm, pn, sub; };
__device__ __forceinline__ unsigned cvt_pk_bf16(float lo, float hi) { unsigned r; asm volatile("v_cvt_pk_bf16_f32 %0, %1, %2" : "=v"(r) : "v"(lo), "v"(hi)); return r; }
__device__ __forceinline__ f32x2 gelu_pk(f32x2 v) {
    const f32x2 av = __builtin_elementwise_abs(v), d = av * 0.2316418882f + 1.0f;
    f32x2 t; t.x = __builtin_amdgcn_rcpf(d.x); t.y = __builtin_amdgcn_rcpf(d.y);
    f32x2 q = t * 0.5307027145f + (-0.7265760135f); q = q * t + 0.7107068705f; q = q * t + (-0.142248368f); q = q * t + 0.127414796f; q = q * t;
    const f32x2 s = (v * v) * (-0.72134752044f);
    f32x2 e; e.x = __builtin_amdgcn_exp2f(s.x); e.y = __builtin_amdgcn_exp2f(s.y);
    const f32x2 m = v * (q * e), r = v - m;
    f32x2 o; o.x = v.x < 0.f ? m.x : r.x; o.y = v.y < 0.f ? m.y : r.y; return o;
}
template <int NSUB = 1> struct StaticOrder {
    int nM, nN, nwg, G, c;
    __device__ void init(int nM_, int nN_, int G_, int c_) { nM = nM_; nN = nN_; nwg = nM * nN; G = G_; c = c_; }
    __device__ bool next(int i, Unit& u) const {
        const int it = i / NSUB; u.sub = i - it * NSUB;
        const long L = (long)it * G + c; if (L >= nwg) return false;
        int wgid = (int)L; { const int q = nwg / NXCD, r = nwg % NXCD, xcd = wgid % NXCD, off = wgid / NXCD; wgid = (xcd < r ? xcd * (q + 1) : r * (q + 1) + (xcd - r) * q) + off; }
        const int nig = WGM * nN, gid = wgid / nig, fm = gid * WGM, gsz = (nM - fm) < WGM ? (nM - fm) : WGM;
        u.pm = fm + ((wgid % nig) % gsz); u.pn = (wgid % nig) / gsz; return true;
    }
};
constexpr int SIDE_TOK = 131072 + 2048;
constexpr int SIDE_SLOT = 131072 + 10240, SIDE_SLOT_BYTES = 3072;
__device__ __forceinline__ void dma16(unsigned voff, const void* sbase, unsigned ldsaddr) { asm volatile("s_mov_b32 m0, %2\n\tglobal_load_lds_dwordx4 %0, %1" :: "v"(voff), "s"(sbase), "s"(ldsaddr) : "memory", "m0"); }
__device__ __forceinline__ void dma4(unsigned voff, const void* sbase, unsigned ldsaddr) { asm volatile("s_mov_b32 m0, %2\n\tglobal_load_lds_dword %0, %1" :: "v"(voff), "s"(sbase), "s"(ldsaddr) : "memory", "m0"); }
template <class Prob, class Sched, class Epi>
__device__ __forceinline__ void gemm_phase(LAS unsigned char* lds, const int tid, const Prob& P, const Sched& S, const Epi& E) {
    const int wid = __builtin_amdgcn_readfirstlane(tid >> 6), lane = tid & 63, wr = wid >> 2, wc = wid & 3, fr = lane & 15, fq = lane >> 4;
    const int lda = P.lda, ldb = P.ldb;
    unsigned voffB[2], offA[2][2];
#define PG8_TOKSLOT(name) const LAS int* name; { PG8_TID(tl2_); name = (const LAS int*)(lds + SIDE_TOK) + (tl2_ >> 6) * 256 + (tl2_ & 63); }
#define PG8_TID(v_) int v_; asm volatile("v_mbcnt_lo_u32_b32 %0, -1, 0\n\tv_mbcnt_hi_u32_b32 %0, -1, %0" : "=v"(v_)); v_ |= (wid << 6)
#define PG8_RC(R_, C_) int R_[2], C_[2]; { PG8_TID(tl_); _Pragma("unroll") for (int i_ = 0; i_ < 2; ++i_) stage_rc(tl_ * 16 + i_ * 8192, R_[i_], C_[i_]); }
#pragma unroll
    for (int i = 0; i < 2; ++i) { int R, C; stage_rc(tid * 16 + i * 8192, R, C); const int Rb = Epi::PERM ? ((R & ~31) + perm32(R & 31)) : R;
        voffB[i] = (unsigned)(Rb * ldb + C) * 2u;
        offA[0][i] = (unsigned)(R * lda + C) * 2u; offA[1][i] = (unsigned)((R + HALF) * lda + C) * 2u; }
    const size_t kstep = (size_t)(BK * 2);
    const size_t hstep = (size_t)HALF * ldb * 2;
    const unsigned ldsw = (unsigned)wid * 1024u;
    const int aoff = lds_byte(wr * 64 + fr, fq * 8), boff = lds_byte(wc * 32 + fr, fq * 8);
#define PG8_SA(b, h) (((b) * 2 + (h)) * HTB)
#define PG8_SB(b, h) ((4 + (b) * 2 + (h)) * HTB)
    const unsigned ldsb = (unsigned)(size_t)lds;
#define PG8_STAGE(bufoff, gbase, voff) do { _Pragma("unroll") for (int _i = 0; _i < 2; ++_i) \
        asm volatile("s_mov_b32 m0, %2\n\tglobal_load_lds_dwordx4 %0, %1" :: "v"((voff)[_i]), "s"((const char*)(gbase)), "s"(ldsb + (unsigned)(bufoff) + ldsw + (unsigned)(_i * 8192)) : "memory", "m0"); } while (0)
#define PG8_CAT(x0, x1) __builtin_shufflevector(x0, x1, 0, 1, 2, 3, 4, 5, 6, 7)
#define PG8_LDA(dst, b, h) do { if constexpr (Prob::FP8) { _Pragma("unroll") for (int m = 0; m < 4; ++m) dst##8[m] = PG8_CAT(*(const LAS i32x4*)(lds + PG8_SA(b, h) + aoff + m * 2048), *(const LAS i32x4*)(lds + PG8_SA(b, h) + aoff + m * 2048 + 1024)); } \
        else { _Pragma("unroll") for (int m = 0; m < 4; ++m) _Pragma("unroll") for (int k = 0; k < 2; ++k) dst[m][k] = *(const LAS bf16x8*)(lds + PG8_SA(b, h) + aoff + m * 2048 + k * 1024); } } while (0)
#define PG8_LDB(dst, b, h) do { if constexpr (Prob::FP8) { _Pragma("unroll") for (int n = 0; n < 2; ++n) dst##8[n] = PG8_CAT(*(const LAS i32x4*)(lds + PG8_SB(b, h) + boff + n * 2048), *(const LAS i32x4*)(lds + PG8_SB(b, h) + boff + n * 2048 + 1024)); } \
        else { _Pragma("unroll") for (int n = 0; n < 2; ++n) _Pragma("unroll") for (int k = 0; k < 2; ++k) dst[n][k] = *(const LAS bf16x8*)(lds + PG8_SB(b, h) + boff + n * 2048 + k * 1024); } } while (0)
#define PG8_MMA(ai, bj, At, Bt) do { __builtin_amdgcn_s_setprio(1); \
        if constexpr (Prob::FP8) { _Pragma("unroll") for (int m = 0; m < 4; ++m) _Pragma("unroll") for (int n = 0; n < 2; ++n) \
            acc[ai][bj][m][n] = __builtin_amdgcn_mfma_scale_f32_16x16x128_f8f6f4(Bt##8[n], At##8[m], acc[ai][bj][m][n], 0, 0, 0, Prob::SCALE_B, 0, Prob::SCALE_A); } \
        else { _Pragma("unroll") for (int m = 0; m < 4; ++m) _Pragma("unroll") for (int n = 0; n < 2; ++n) _Pragma("unroll") for (int k = 0; k < 2; ++k) \
            acc[ai][bj][m][n] = __builtin_amdgcn_mfma_f32_16x16x32_bf16(Bt[n][k], At[m][k], acc[ai][bj][m][n], 0, 0, 0); } \
        __builtin_amdgcn_s_setprio(0); } while (0)
#define PG8_WAIT_V(n) asm volatile("s_waitcnt vmcnt(" #n ")" ::: "memory")
#define PG8_WAIT_L(n) asm volatile("s_waitcnt lgkmcnt(" #n ")" ::: "memory")
#define PG8_BAR __builtin_amdgcn_s_barrier()
#define PG8_SCHED __builtin_amdgcn_sched_barrier(0)
    Unit cur, nxt; int ui = 0;
    if (!S.next(0, cur)) return;
    f32x4 acc[2][2][4][2];
#pragma unroll
    for (int a = 0; a < 2; ++a)
#pragma unroll
        for (int b = 0; b < 2; ++b)
#pragma unroll
            for (int m = 0; m < 4; ++m)
#pragma unroll
                for (int n = 0; n < 2; ++n) acc[a][b][m][n] = (f32x4){0.f, 0.f, 0.f, 0.f};
    bf16x8 At[4][2], B0[2][2], B1[2][2]; i32x8 At8[4], B08[2], B18[2];
    const char* cA = P.a_base(cur); const char* cB = P.b_base(cur); int nt = P.nt(cur);
    if constexpr (Prob::GATHER) { PG8_RC(Rr, Cc); P.a_rows(cur, Rr, Cc, offA); }
    if constexpr (Epi::SIDE) { PG8_TID(tl4_); E.side(cur, ldsb + SIDE_SLOT, wid, tl4_ & 63); }
    PG8_STAGE(PG8_SB(0, 0), cB, voffB); PG8_STAGE(PG8_SB(0, 1), cB + hstep, voffB); PG8_STAGE(PG8_SA(0, 0), cA, offA[0]); PG8_STAGE(PG8_SA(0, 1), cA, offA[1]);
    if (wr == 1) PG8_BAR;
    PG8_WAIT_V(2); PG8_BAR;
    PG8_STAGE(PG8_SB(1, 0), cB + kstep, voffB); PG8_STAGE(PG8_SA(1, 0), cA + kstep, offA[0]); PG8_STAGE(PG8_SB(1, 1), cB + hstep + kstep, voffB);
    PG8_WAIT_V(6); PG8_BAR;
    for (;;) {
        const bool has_next = S.next(ui + 1, nxt);
        const char* nA = has_next ? P.a_base(nxt) : cA; const char* nB = has_next ? P.b_base(nxt) : cB;
        if constexpr (Prob::GATHER) { if (has_next) { PG8_RC(Rr, Cc); (void)Cc;
#pragma unroll
            for (int h = 0; h < 2; ++h)
#pragma unroll
                for (int i = 0; i < 2; ++i) dma4((unsigned)(nxt.pm * 256 + h * 128 + Rr[i]) * 4u, P.tok, ldsb + SIDE_TOK + (unsigned)wid * 1024u + (unsigned)((h * 2 + i) * 256)); } }
        if constexpr (Epi::SIDE) { if (has_next) { PG8_TID(tl4_); E.side(nxt, ldsb + SIDE_SLOT + (unsigned)(((ui + 1) % 3) * SIDE_SLOT_BYTES), wid, tl4_ & 63); } }
        for (int t = 0; t < nt; t += 2) {
            const bool last = (t == nt - 2);
            if constexpr (Epi::KHOOK) { if (t == Epi::HOOK_T0 || t == Epi::HOOK_T1) {
                asm volatile("" ::: "memory"); PG8_TID(tlh_); const int lnh_ = tlh_ & 63; E.hook(acc, cur, t == Epi::HOOK_T0 ? 0 : 1, wr, wc, lnh_ & 15, lnh_ >> 4); asm volatile("" ::: "memory"); } }
            const char* a1 = cA + (size_t)(t + 1) * kstep;
            const char* a2 = last ? nA : cA + (size_t)(t + 2) * kstep; const char* b2 = last ? nB : cB + (size_t)(t + 2) * kstep;
            const char* a3 = a2 + kstep; const char* b3 = b2 + kstep;
            unsigned o2[2][2];
#pragma unroll
            for (int h = 0; h < 2; ++h)
#pragma unroll
                for (int i = 0; i < 2; ++i) o2[h][i] = offA[h][i];
            if constexpr (Prob::GATHER) { if (last && has_next) { PG8_RC(Rr, Cc); (void)Rr; PG8_TOKSLOT(tokslot); const int ntok[2][2] = {{tokslot[0], tokslot[64]}, {tokslot[128], tokslot[192]}}; P.a_off(ntok, Cc, o2); } }
            PG8_LDB(B0, 0, 0); PG8_LDB(B1, 0, 1); PG8_SCHED; PG8_LDA(At, 0, 0); PG8_STAGE(PG8_SA(1, 1), a1, offA[1]);
            PG8_WAIT_V(8); PG8_WAIT_L(0); PG8_BAR; PG8_MMA(0, 0, At, B0); PG8_MMA(0, 1, At, B1); PG8_BAR; PG8_SCHED;
            PG8_LDA(At, 0, 1); PG8_STAGE(PG8_SB(0, 0), b2, voffB); PG8_STAGE(PG8_SB(0, 1), b2 + hstep, voffB); PG8_STAGE(PG8_SA(0, 0), a2, o2[0]);
            PG8_WAIT_V(8); PG8_WAIT_L(0); PG8_BAR; PG8_MMA(1, 0, At, B0); PG8_MMA(1, 1, At, B1); PG8_BAR; PG8_SCHED;
            PG8_LDB(B0, 1, 0); PG8_LDB(B1, 1, 1); PG8_SCHED; PG8_LDA(At, 1, 0); PG8_STAGE(PG8_SA(0, 1), a2, o2[1]);
            PG8_WAIT_V(8); PG8_WAIT_L(0); PG8_BAR; PG8_MMA(0, 0, At, B0); PG8_MMA(0, 1, At, B1); PG8_BAR; PG8_SCHED;
            PG8_LDA(At, 1, 1); PG8_STAGE(PG8_SB(1, 0), b3, voffB); PG8_STAGE(PG8_SB(1, 1), b3 + hstep, voffB); PG8_STAGE(PG8_SA(1, 0), a3, o2[0]);
            PG8_WAIT_V(8); PG8_WAIT_L(0); PG8_BAR; PG8_MMA(1, 0, At, B0); PG8_MMA(1, 1, At, B1); PG8_BAR; PG8_SCHED;
        }
        if (wr == 0) PG8_BAR;
        { PG8_TID(tl3_); const int ln_ = tl3_ & 63; E(acc, cur, wr, wc, ln_ & 15, ln_ >> 4, lds + SIDE_SLOT + (ui % 3) * SIDE_SLOT_BYTES); }
        if (!has_next) break;
        bool keep = false;
        if constexpr (Epi::CHAIN) keep = E.keep(cur);
        if (!keep) {
#pragma unroll
            for (int a = 0; a < 2; ++a)
#pragma unroll
                for (int b = 0; b < 2; ++b)
#pragma unroll
                    for (int m = 0; m < 4; ++m)
#pragma unroll
                        for (int n = 0; n < 2; ++n) acc[a][b][m][n] = (f32x4){0.f, 0.f, 0.f, 0.f};
        }
        cur = nxt; cA = nA; cB = nB; nt = P.nt(cur); ++ui;
        if constexpr (Prob::GATHER) { PG8_RC(Rr, Cc); (void)Rr; PG8_TOKSLOT(tokslot); const int ntok[2][2] = {{tokslot[0], tokslot[64]}, {tokslot[128], tokslot[192]}}; P.a_off(ntok, Cc, offA); }
        if (wr == 1) PG8_BAR;
    }
    PG8_WAIT_V(0);
    PG8_BAR;
#undef PG8_RC
#undef PG8_TID
#undef PG8_TOKSLOT
#undef PG8_SA
#undef PG8_SB
#undef PG8_STAGE
#undef PG8_LDA
#undef PG8_LDB
#undef PG8_MMA
#undef PG8_CAT
#undef PG8_WAIT_V
#undef PG8_WAIT_L
#undef PG8_BAR
#undef PG8_SCHED
}
}

typedef const float* cfp_t;
typedef const cfp_t __attribute__((address_space(4))) * InTab;
struct Frame {
    LAS unsigned char* lds;
    volatile LAS unsigned* MISC;
    unsigned char* ws;
    InTab in;
    float* out;
    int tid, lane, wave, G, bid;
};
enum { IN_X = 0, IN_C, IN_CTX, IN_CCTX, IN_WADA, IN_BADA, IN_WIN, IN_BIN, IN_POOLW, IN_POOLS, IN_CONVW, IN_CONVB, IN_MNG, IN_SLNG, IN_SLNB, IN_SGUW, IN_SGUB,
       IN_WBP, IN_WBM, IN_WBS, IN_WOUT, IN_LN1G, IN_LN1B, IN_WR, IN_BR, IN_WGU, IN_BGU, IN_WDN, IN_BDN, IN_LN2G, IN_LN2B };
__device__ __forceinline__ int mod_row(int row) { return row < ML ? (row >> 12) : NB; }
__device__ __forceinline__ const float* modp(const Frame& F, int l, int row, int part) { return (const float*)(F.ws + WS_MOD) + ((size_t)(l * 17 + mod_row(row)) * 6 + part) * 1024; }

__device__ __forceinline__ void transpose_item(const float* W, size_t ldw, int k0, int srccol0, bf16_t* dst, size_t ldk, int kd0, LAS float* scr, int lane) {
#pragma unroll 8
    for (int i = 0; i < 32; ++i) { const int kk = 2 * i + (lane >> 5); scr[kk * 33 + (lane & 31)] = __builtin_nontemporal_load(W + (size_t)(k0 + kk) * ldw + srccol0 + (lane & 31)); }
    LDS_WAIT(); asm volatile("" ::: "memory");
    const int c = lane & 7;
#pragma unroll
    for (int j = 0; j < 4; ++j) { const int n = (lane >> 3) + 8 * j; const LAS float* s = scr + (8 * c) * 33 + n;
        u32x4 o; o.x = pk2(s[0 * 33], s[1 * 33]); o.y = pk2(s[2 * 33], s[3 * 33]); o.z = pk2(s[4 * 33], s[5 * 33]); o.w = pk2(s[6 * 33], s[7 * 33]);
        *(u32x4*)(dst + (size_t)n * ldk + kd0 + 8 * c) = o; }
    LDS_WAIT(); asm volatile("" ::: "memory");
}
__device__ __forceinline__ void transpose_item_fp8(const float* W, size_t ldw, int k0, int srccol0, unsigned char* dst, size_t ldk, int kd0, float sc, LAS float* scr, int lane) {
#pragma unroll 8
    for (int i = 0; i < 32; ++i) { const int kk = 2 * i + (lane >> 5); scr[kk * 33 + (lane & 31)] = __builtin_nontemporal_load(W + (size_t)(k0 + kk) * ldw + srccol0 + (lane & 31)); }
    LDS_WAIT(); asm volatile("" ::: "memory");
    const int c = lane & 7;
#pragma unroll
    for (int j = 0; j < 4; ++j) { const int n = (lane >> 3) + 8 * j; const LAS float* s_ = scr + (8 * c) * 33 + n;
        u32x2 o; o.x = pk4_fp8(s_[0 * 33] * sc, s_[1 * 33] * sc, s_[2 * 33] * sc, s_[3 * 33] * sc); o.y = pk4_fp8(s_[4 * 33] * sc, s_[5 * 33] * sc, s_[6 * 33] * sc, s_[7 * 33] * sc);
        *(u32x2*)(dst + (size_t)n * ldk + kd0 + 8 * c) = o; }
    LDS_WAIT(); asm volatile("" ::: "memory");
}
__device__ __forceinline__ void phase_prologue(Frame& F) {
    LAS float* scr = (LAS float*)(F.lds + F.wave * 16384);
    const int gw = F.bid * NWAVES + F.wave, NGW = F.G * NWAVES;
    constexpr int I_IN = 16 * (NZ / 32);
    constexpr int I_BR = (4 + 8 + 4) * 32;
    constexpr int I_OUT = 16 * 32;
    constexpr int I_GU = 16 * 64;
    constexpr int I_DN = 16 * 32;
    constexpr int T_IN = DEPTH * I_IN, T_BR = DEPTH * I_BR, T_OUT = DEPTH * I_OUT, T_GU = DEPTH * NEXP * I_GU, T_DN = DEPTH * NEXP * I_DN;
    constexpr int NITEMS = T_IN + T_BR + T_OUT + T_GU + T_DN;
    for (int it = gw; it < NITEMS; it += NGW) {
        int r = it;
        if (r < T_IN) { const int l = r / I_IN; r %= I_IN; const int kb = r / (NZ / 32), nb = r % (NZ / 32); const int n0 = nb * 32, src = n0 < 2304 ? n0 : n0 + 16;
            if (n0 < NZ_BF) transpose_item(F.in[IN_WIN] + (size_t)l * D * 5904, 5904, kb * 64, src, (bf16_t*)(F.ws + WS_WIN) + ((size_t)l * NZ + n0) * D, D, kb * 64, scr, F.lane);
            else transpose_item_fp8(F.in[IN_WIN] + (size_t)l * D * 5904, 5904, kb * 64, src, (unsigned char*)(F.ws + WS_WIN8) + ((size_t)l * NZ_F8 + (n0 - NZ_BF)) * D, D, kb * 64, F8S_WGU, scr, F.lane);
            continue; }
        r -= T_IN;
        if (r < T_BR) { const int l = r / I_BR; r %= I_BR; const int kb = r / 32, nb = r % 32;
            const float* W; int ksrc;
            if (kb < 4) { W = F.in[IN_WBP] + (size_t)l * 256 * D; ksrc = kb * 64; } else if (kb < 12) { W = F.in[IN_WBM] + (size_t)l * 512 * D; ksrc = (kb - 4) * 64; } else { W = F.in[IN_WBS] + (size_t)l * 256 * D; ksrc = (kb - 12) * 64; }
            transpose_item(W, D, ksrc, nb * 32, (bf16_t*)(F.ws + WS_WBR) + ((size_t)l * D + nb * 32) * D, D, kb * 64, scr, F.lane); continue; }
        r -= T_BR;
        if (r < T_OUT) { const int l = r / I_OUT; r %= I_OUT; const int kb = r / 32, nb = r % 32;
            transpose_item(F.in[IN_WOUT] + (size_t)l * D * D, D, kb * 64, nb * 32, (bf16_t*)(F.ws + WS_WOUT) + ((size_t)l * D + nb * 32) * D, D, kb * 64, scr, F.lane); continue; }
        r -= T_OUT;
        if (r < T_GU) { const int le = r / I_GU; r %= I_GU; const int kb = r / 64, nb = r % 64; const int n0 = nb * 32;
            const int pn = n0 >> 8, c = n0 & 255; const int src = c < 128 ? (128 * pn + c) : (1024 + 128 * pn + c - 128);
            transpose_item_fp8(F.in[IN_WGU] + (size_t)le * D * 2048, 2048, kb * 64, src, (unsigned char*)(F.ws + WS_WGU) + ((size_t)le * 2048 + n0) * D, D, kb * 64, F8S_WGU, scr, F.lane); continue; }
        r -= T_GU;
        { const int le = r / I_DN; r %= I_DN; const int kb = r / 32, nb = r % 32;
            transpose_item_fp8(F.in[IN_WDN] + (size_t)le * D * D, D, kb * 64, nb * 32, (unsigned char*)(F.ws + WS_WDN) + ((size_t)le * D + nb * 32) * D, D, kb * 64, F8S_WDN, scr, F.lane); }
    }
    { const int gt = F.bid * NTHREADS + F.tid, NGT = F.G * NTHREADS;
      for (int i = gt; i < DEPTH * 16 * 1024; i += NGT) { const int l = i >> 14, g = (i >> 10) & 15, k = i & 1023; ((float*)(F.ws + WS_WG))[i] = F.in[IN_WIN][((size_t)l * D + k) * 5904 + 2304 + g]; }
      for (int i = gt; i < DEPTH * 4 * 128 * 128; i += NGT) ((bf16_t*)(F.ws + WS_WSGU))[i] = (bf16_t)f2bf(F.in[IN_SGUW][i]);
      for (int i = gt; i < DEPTH * 4 * 64 * 64; i += NGT) { const int lg = i >> 12, d = (i >> 6) & 63, c = i & 63; ((bf16_t*)(F.ws + WS_WPOOL))[i] = (bf16_t)f2bf(F.in[IN_POOLW][(size_t)lg * 4096 + c * 64 + d]); } }
    __syncthreads();
    { LAS float* sc = (LAS float*)F.lds;
      LAS float* part = (LAS float*)(F.lds + 71680);
      for (int i = F.tid; i < 17 * 1024; i += NTHREADS) { const int r = i >> 10, k = i & 1023; const float v = r < 16 ? F.in[IN_C][r * 1024 + k] : F.in[IN_CCTX][k]; sc[i] = siluf_(v); }
      __syncthreads();
      for (int u = F.bid; u < DEPTH * 48; u += F.G) {
          const int l = u / 48, n0 = (u % 48) * 128, col = F.tid & 127, ks = F.tid >> 7;
          float a[17];
#pragma unroll
          for (int r = 0; r < 17; ++r) a[r] = 0.f;
          const float* W = F.in[IN_WADA] + (size_t)l * D * 6144 + n0 + col;
          for (int k = ks * 256; k < ks * 256 + 256; ++k) { const float w = W[(size_t)k * 6144];
#pragma unroll
              for (int r = 0; r < 17; ++r) a[r] += sc[r * 1024 + k] * w; }
#pragma unroll
          for (int r = 0; r < 17; ++r) part[(ks * 17 + r) * 128 + col] = a[r];
          __syncthreads();
          for (int i = F.tid; i < 17 * 128; i += NTHREADS) { const int r = i >> 7, cc = i & 127;
              const float s = part[(0 * 17 + r) * 128 + cc] + part[(1 * 17 + r) * 128 + cc] + part[(2 * 17 + r) * 128 + cc] + part[(3 * 17 + r) * 128 + cc] + F.in[IN_BADA][l * 6144 + n0 + cc];
              ((float*)(F.ws + WS_MOD))[(size_t)(l * 17 + r) * 6144 + n0 + cc] = s; }
          __syncthreads();
      } }
}

struct RowV { f32x4 v[4]; };
#define RC(lane, j) (8 * (lane) + 512 * ((j) >> 1) + 4 * ((j) & 1))
__device__ __forceinline__ void row_load(RowV& r, const float* p, int lane) {
#pragma unroll
    for (int j = 0; j < 4; ++j) r.v[j] = __builtin_nontemporal_load((const f32x4*)(p + RC(lane, j)));
}
__device__ __forceinline__ void row_load_bf16(RowV& r, const bf16_t* p, int lane) {
#pragma unroll
    for (int h = 0; h < 2; ++h) { const u32x4 w = __builtin_nontemporal_load((const u32x4*)(p + 8 * lane + 512 * h)); r.v[2 * h] = (f32x4){bflo(w.x), bfhi(w.x), bflo(w.y), bfhi(w.y)}; r.v[2 * h + 1] = (f32x4){bflo(w.z), bfhi(w.z), bflo(w.w), bfhi(w.w)}; }
}
__device__ __forceinline__ void row_store(const RowV& r, float* p, int lane) {
#pragma unroll
    for (int j = 0; j < 4; ++j) *(f32x4*)(p + RC(lane, j)) = r.v[j];
}
__device__ __forceinline__ void row_store_nt(const RowV& r, float* p, int lane) {
#pragma unroll
    for (int j = 0; j < 4; ++j) __builtin_nontemporal_store(r.v[j], (f32x4*)(p + RC(lane, j)));
}
__device__ __forceinline__ void row_store_bf16_nt(const RowV& r, bf16_t* p, int lane) {
#pragma unroll
    for (int h = 0; h < 2; ++h) { u32x4 w; w.x = pk2(r.v[2 * h].x, r.v[2 * h].y); w.y = pk2(r.v[2 * h].z, r.v[2 * h].w); w.z = pk2(r.v[2 * h + 1].x, r.v[2 * h + 1].y); w.w = pk2(r.v[2 * h + 1].z, r.v[2 * h + 1].w); __builtin_nontemporal_store(w, (u32x4*)(p + 8 * lane + 512 * h)); }
}
__device__ __forceinline__ void row_store_bf16(const RowV& r, bf16_t* p, int lane) {
#pragma unroll
    for (int h = 0; h < 2; ++h) { u32x4 w; w.x = pk2(r.v[2 * h].x, r.v[2 * h].y); w.y = pk2(r.v[2 * h].z, r.v[2 * h].w); w.z = pk2(r.v[2 * h + 1].x, r.v[2 * h + 1].y); w.w = pk2(r.v[2 * h + 1].z, r.v[2 * h + 1].w); *(u32x4*)(p + 8 * lane + 512 * h) = w; }
}
__device__ __forceinline__ void row_ln_plain(RowV& r, int lane) {
    float s = 0.f;
#pragma unroll
    for (int j = 0; j < 4; ++j) s += (r.v[j].x + r.v[j].y) + (r.v[j].z + r.v[j].w);
    const float mean = wave_sum(s, lane) * (1.f / D); float s2 = 0.f;
#pragma unroll
    for (int j = 0; j < 4; ++j) { r.v[j] = r.v[j] - mean; s2 += (r.v[j].x * r.v[j].x + r.v[j].y * r.v[j].y) + (r.v[j].z * r.v[j].z + r.v[j].w * r.v[j].w); }
    const float rstd = 1.f / sqrtf(wave_sum(s2, lane) * (1.f / D) + LN_EPS);
#pragma unroll
    for (int j = 0; j < 4; ++j) r.v[j] = r.v[j] * rstd;
}
__device__ __forceinline__ void row_affine(RowV& r, const float* g, const float* b, int lane) {
#pragma unroll
    for (int j = 0; j < 4; ++j) { const f32x4 gg = *(const f32x4*)(g + RC(lane, j)), bb = *(const f32x4*)(b + RC(lane, j)); r.v[j] = r.v[j] * gg + bb; }
}
__device__ __forceinline__ void row_modulate(RowV& r, const float* sh, const float* sc, int lane) {
#pragma unroll
    for (int j = 0; j < 4; ++j) { const f32x4 s1 = *(const f32x4*)(sc + RC(lane, j)), s0 = *(const f32x4*)(sh + RC(lane, j)); r.v[j] = r.v[j] * (s1 + 1.0f) + s0; }
}
__device__ __forceinline__ LAS float* pv_slot(const Frame& F, int slot) { return (LAS float*)(F.lds + NW_PV) + slot * 1024; }
__device__ __forceinline__ void pv_fill(Frame& F, int slot, const float* src) { LAS f32x4* d = (LAS f32x4*)pv_slot(F, slot); for (int i = F.tid; i < 256; i += NTHREADS) d[i] = *(const f32x4*)(src + 4 * i); }
__device__ __forceinline__ void row_affine_l(RowV& r, const LAS float* g, const LAS float* b, int lane) {
#pragma unroll
    for (int j = 0; j < 4; ++j) { const f32x4 gg = *(const LAS f32x4*)(g + RC(lane, j)), bb = *(const LAS f32x4*)(b + RC(lane, j)); r.v[j] = r.v[j] * gg + bb; }
}
__device__ __forceinline__ void row_modulate_l(RowV& r, const LAS float* sh, const LAS float* sc, int lane) {
#pragma unroll
    for (int j = 0; j < 4; ++j) { const f32x4 s1 = *(const LAS f32x4*)(sc + RC(lane, j)), s0 = *(const LAS f32x4*)(sh + RC(lane, j)); r.v[j] = r.v[j] * (s1 + 1.0f) + s0; }
}
__device__ __forceinline__ void ln0_row(Frame& F, int row, RowV xr, const LAS float* sh, const LAS float* sc) {
    row_ln_plain(xr, F.lane);
    row_modulate_l(xr, sh, sc, F.lane);
    row_store_bf16(xr, (bf16_t*)(F.ws + WS_H) + (size_t)row * D, F.lane);
    { unsigned char* h8 = (unsigned char*)(F.ws + WS_H8) + (size_t)row * D + 8 * F.lane;
#pragma unroll
      for (int h = 0; h < 2; ++h) { u32x2 w; w.x = pk4_fp8(xr.v[2 * h].x * F8S_ACT, xr.v[2 * h].y * F8S_ACT, xr.v[2 * h].z * F8S_ACT, xr.v[2 * h].w * F8S_ACT); w.y = pk4_fp8(xr.v[2 * h + 1].x * F8S_ACT, xr.v[2 * h + 1].y * F8S_ACT, xr.v[2 * h + 1].z * F8S_ACT, xr.v[2 * h + 1].w * F8S_ACT); *(u32x2*)(h8 + 512 * h) = w; } }
}
__device__ __forceinline__ LAS float* narrow_tile_wave(Frame& F, const bf16_t* A) {
    const int r = F.lane & 31, h = F.lane >> 5;
    f32x16 acc;
#pragma unroll
    for (int i = 0; i < 16; ++i) acc[i] = 0.f;
    const bf16_t* ap = A + (size_t)r * D + 8 * h;
    const LAS unsigned char* bp = F.lds + NW_WT + r * 2064 + 16 * h;
    bf16x8 av[2][16];
#pragma unroll
    for (int ks = 0; ks < 16; ++ks) av[0][ks] = *(const bf16x8*)(ap + ks * 16);
#pragma unroll
    for (int kb = 0; kb < 4; ++kb) {
        if (kb < 3) {
#pragma unroll
            for (int ks = 0; ks < 16; ++ks) av[(kb + 1) & 1][ks] = *(const bf16x8*)(ap + ((kb + 1) * 16 + ks) * 16); }
        __builtin_amdgcn_sched_barrier(0);
#pragma unroll
        for (int ks = 0; ks < 16; ++ks) { const bf16x8 b = *(const LAS bf16x8*)(bp + (kb * 16 + ks) * 32); acc = __builtin_amdgcn_mfma_f32_32x32x16_bf16(av[kb & 1][ks], b, acc, 0, 0, 0); }
        __builtin_amdgcn_sched_barrier(0);
    }
    LAS float* lg = (LAS float*)(F.lds + NW_LG) + F.wave * 1056;
#pragma unroll
    for (int i = 0; i < 16; ++i) lg[((i & 3) + 8 * (i >> 2) + 4 * h) * 33 + r] = acc[i];
    asm volatile("s_waitcnt lgkmcnt(0)" ::: "memory");
    return lg;
}
__device__ __forceinline__ void tile_range(const Frame& F, int mrows, int& t_lo, int& t_hi) { const int nt = mrows / 32; t_lo = (int)(((long)F.bid * nt) / F.G); t_hi = (int)(((long)(F.bid + 1) * nt) / F.G); }
__device__ __forceinline__ void load_wg_lds(Frame& F, int l) {
    const float* src = (const float*)(F.ws + WS_WG) + (size_t)l * 16384;
    for (int i = F.tid; i < 32 * 128; i += NTHREADS) { const int g = i >> 7, c8 = i & 127; u32x4 w = (u32x4){0u, 0u, 0u, 0u};
        if (g < 16) { const f32x4 a = *(const f32x4*)(src + g * 1024 + c8 * 8), b = *(const f32x4*)(src + g * 1024 + c8 * 8 + 4); w.x = pk2(a.x, a.y); w.y = pk2(a.z, a.w); w.z = pk2(b.x, b.y); w.w = pk2(b.z, b.w); }
        *(LAS u32x4*)(F.lds + NW_WT + g * 2064 + c8 * 16) = w; }
    __syncthreads();
}
__device__ __forceinline__ void gates_tail(Frame& F, int l, int t_lo, int t_hi) {
    asm volatile("s_waitcnt vmcnt(0)" ::: "memory"); __syncthreads();
    const int g = F.lane & 15; const float bias = F.in[IN_BIN][l * 5904 + 2304 + g];
    for (int tile = t_lo + F.wave; tile < t_hi; tile += NWAVES) {
        const LAS float* lg = narrow_tile_wave(F, (const bf16_t*)(F.ws + WS_H) + (size_t)tile * 32 * D);
#pragma unroll
        for (int rr = 0; rr < 8; ++rr) { const int row = rr * 4 + (F.lane >> 4); ((float*)(F.ws + WS_ZG))[(size_t)(tile * 32 + row) * 16 + g] = lg[row * 33 + g] + bias; }
        asm volatile("s_waitcnt lgkmcnt(0)" ::: "memory");
    }
}

using pg8::Unit;
struct ProbPlain {
    static constexpr bool GATHER = false, FP8 = false; static constexpr int SCALE_A = 127, SCALE_B = 127; const bf16_t* A; const bf16_t* Bt; int lda, ldb;
    __device__ __forceinline__ int nt(const Unit&) const { return lda / 64; }
    __device__ __forceinline__ const char* a_base(const Unit& u) const { return (const char*)A + (size_t)u.pm * 256 * lda * 2; }
    __device__ __forceinline__ const char* b_base(const Unit& u) const { return (const char*)Bt + (size_t)u.pn * 256 * ldb * 2; }
    __device__ __forceinline__ void a_tok(const Unit&, const int (&)[2], int (&)[2][2]) const {}
    __device__ __forceinline__ void a_off(const int (&)[2][2], const int (&)[2], unsigned (&)[2][2]) const {}
    __device__ __forceinline__ void a_rows(const Unit&, const int (&)[2], const int (&)[2], unsigned (&)[2][2]) const {}
};
struct ProbPlainF8 {
    static constexpr bool GATHER = false, FP8 = true; static constexpr int SCALE_A = F8E_ACT, SCALE_B = F8E_WGU; const bf16_t* A; const bf16_t* Bt; int lda, ldb;
    __device__ __forceinline__ int nt(const Unit&) const { return lda / 64; }
    __device__ __forceinline__ const char* a_base(const Unit& u) const { return (const char*)A + (size_t)u.pm * 256 * lda * 2; }
    __device__ __forceinline__ const char* b_base(const Unit& u) const { return (const char*)Bt + (size_t)u.pn * 256 * ldb * 2; }
    __device__ __forceinline__ void a_tok(const Unit&, const int (&)[2], int (&)[2][2]) const {}
    __device__ __forceinline__ void a_off(const int (&)[2][2], const int (&)[2], unsigned (&)[2][2]) const {}
    __device__ __forceinline__ void a_rows(const Unit&, const int (&)[2], const int (&)[2], unsigned (&)[2][2]) const {}
};
struct ProbBranch {
    static constexpr bool GATHER = false, FP8 = false; static constexpr int SCALE_A = 127, SCALE_B = 127; const bf16_t* A; const bf16_t* Bt; int lda, ldb;
    __device__ __forceinline__ int nt(const Unit& u) const { return u.sub == 1 ? 8 : 4; }
    __device__ __forceinline__ int koff(const Unit& u) const { return u.sub == 0 ? 0 : (u.sub == 1 ? 256 : 768); }
    __device__ __forceinline__ const char* a_base(const Unit& u) const { return (const char*)A + ((size_t)u.pm * 256 * lda + koff(u)) * 2; }
    __device__ __forceinline__ const char* b_base(const Unit& u) const { return (const char*)Bt + ((size_t)u.pn * 256 * ldb + koff(u)) * 2; }
    __device__ __forceinline__ void a_tok(const Unit&, const int (&)[2], int (&)[2][2]) const {}
    __device__ __forceinline__ void a_off(const int (&)[2][2], const int (&)[2], unsigned (&)[2][2]) const {}
    __device__ __forceinline__ void a_rows(const Unit&, const int (&)[2], const int (&)[2], unsigned (&)[2][2]) const {}
};
__device__ __forceinline__ int expert_of(const LAS int* seg, int pm) { return __builtin_amdgcn_readfirstlane((int)((const LAS unsigned char*)(seg + 64))[pm]); }
__device__ __forceinline__ int moe_tables(Frame& F, LAS int* seg) {
    __syncthreads();
    if (F.tid <= NEXP) seg[F.tid] = ((const int*)(F.ws + WS_ROUTE + RT_SEG))[F.tid];
    __syncthreads();
    const int ntile = seg[NEXP] / 256;
    LAS unsigned char* texp = (LAS unsigned char*)(seg + 64);
    for (int t = F.tid; t < ntile; t += NTHREADS) { const int row = t * 256; int e = 0;
#pragma unroll
        for (int i = 1; i < NEXP; ++i) e += (seg[i] <= row) ? 1 : 0;
        texp[t] = (unsigned char)e; }
    __syncthreads();
    return ntile;
}
struct ProbMoe1 {
    static constexpr bool GATHER = true, FP8 = true; static constexpr int SCALE_A = F8E_ACT, SCALE_B = F8E_WGU; const bf16_t* A; const bf16_t* Bt; int lda, ldb; const int* tok; const LAS int* seg;
    __device__ __forceinline__ int nt(const Unit&) const { return lda / 64; }
    __device__ __forceinline__ const char* a_base(const Unit&) const { return (const char*)A; }
    __device__ __forceinline__ const char* b_base(const Unit& u) const { const int e = expert_of(seg, u.pm); return (const char*)Bt + ((size_t)e * 2048 + (size_t)u.pn * 256) * ldb * 2; }
    __device__ __forceinline__ void a_rows(const Unit& u, const int (&R)[2], const int (&C)[2], unsigned (&off)[2][2]) const {
#pragma unroll
        for (int h = 0; h < 2; ++h)
#pragma unroll
            for (int i = 0; i < 2; ++i) { const int t = tok[u.pm * 256 + h * 128 + R[i]]; off[h][i] = (unsigned)(t * lda + C[i]) * 2u; } }
    __device__ __forceinline__ void a_tok(const Unit& u, const int (&R)[2], int (&tk)[2][2]) const {
#pragma unroll
        for (int h = 0; h < 2; ++h)
#pragma unroll
            for (int i = 0; i < 2; ++i) tk[h][i] = tok[u.pm * 256 + h * 128 + R[i]]; }
    __device__ __forceinline__ void a_off(const int (&tk)[2][2], const int (&C)[2], unsigned (&off)[2][2]) const {
#pragma unroll
        for (int h = 0; h < 2; ++h)
#pragma unroll
            for (int i = 0; i < 2; ++i) off[h][i] = (unsigned)(tk[h][i] * lda + C[i]) * 2u; }
};
struct ProbMoe2 {
    static constexpr bool GATHER = false, FP8 = true; static constexpr int SCALE_A = F8E_ACT, SCALE_B = F8E_WDN; const bf16_t* A; const bf16_t* Bt; int lda, ldb; const LAS int* seg;
    __device__ __forceinline__ int nt(const Unit&) const { return lda / 64; }
    __device__ __forceinline__ const char* a_base(const Unit& u) const { return (const char*)A + (size_t)u.pm * 256 * lda * 2; }
    __device__ __forceinline__ const char* b_base(const Unit& u) const { const int e = expert_of(seg, u.pm); return (const char*)Bt + ((size_t)e * 1024 + (size_t)u.pn * 256) * ldb * 2; }
    __device__ __forceinline__ void a_tok(const Unit&, const int (&)[2], int (&)[2][2]) const {}
    __device__ __forceinline__ void a_off(const int (&)[2][2], const int (&)[2], unsigned (&)[2][2]) const {}
    __device__ __forceinline__ void a_rows(const Unit&, const int (&)[2], const int (&)[2], unsigned (&)[2][2]) const {}
};
using pg8::cvt_pk_bf16;
struct EpiInproj {
    static constexpr bool PERM = true, CHAIN = false, SIDE = true, KHOOK = false; bf16_t* Z; const float* bias; int pn0;
    __device__ __forceinline__ void side(const Unit& u0, unsigned slot, int wid, int lane) const { const int pn = u0.pn + pn0; if (wid == 1) pg8::dma16((unsigned)lane * 16u, bias + pn * 256 + (pn >= 9 ? 16 : 0), slot); }
    __device__ __forceinline__ void operator()(const f32x4 (&acc)[2][2][4][2], const Unit& u0, int wr, int wc, int fr, int fq, const LAS unsigned char* sd) const {
        Unit u = u0; u.pn += pn0;
        int row0 = u.pm * 256 + wr * 64 + fr, col0 = u.pn * 256 + wc * 32 + 8 * fq; asm volatile("" : "+v"(row0), "+v"(col0));
        const int act = (u.pn <= 6) ? 0 : ((u.pn == 9 || u.pn == 10) ? 2 : 1);
        f32x4 bv[2][2];
#pragma unroll
        for (int bj = 0; bj < 2; ++bj)
#pragma unroll
            for (int n = 0; n < 2; ++n) bv[bj][n] = *(const LAS f32x4*)(sd + (bj * 128 + wc * 32 + 8 * fq + 4 * n) * 4);
#pragma unroll
        for (int ai = 0; ai < 2; ++ai)
#pragma unroll
            for (int m = 0; m < 4; ++m) { bf16_t* rowp = Z + (size_t)(row0 + ai * 128 + m * 16) * NZ + col0;
#pragma unroll
                for (int bj = 0; bj < 2; ++bj) { f32x4 v0 = acc[ai][bj][m][0] + bv[bj][0], v1 = acc[ai][bj][m][1] + bv[bj][1];
                    if (act == 2) { f32x2 a = pg8::gelu_pk((f32x2){v0[0], v0[1]}), b = pg8::gelu_pk((f32x2){v0[2], v0[3]}), c = pg8::gelu_pk((f32x2){v1[0], v1[1]}), d = pg8::gelu_pk((f32x2){v1[2], v1[3]});
                        v0 = (f32x4){a.x, a.y, b.x, b.y}; v1 = (f32x4){c.x, c.y, d.x, d.y}; }
                    if (act == 1) {
#pragma unroll
                        for (int j = 0; j < 4; ++j) { v0[j] = sigmoidf_(v0[j]); v1[j] = sigmoidf_(v1[j]); } }
                    u32x4 w; w.x = cvt_pk_bf16(v0[0], v0[1]); w.y = cvt_pk_bf16(v0[2], v0[3]); w.z = cvt_pk_bf16(v1[0], v1[1]); w.w = cvt_pk_bf16(v1[2], v1[3]);
                    *(u32x4*)(rowp + bj * 128) = w; } }
    }
};
struct EpiNull {
    static constexpr bool PERM = true, CHAIN = false; bf16_t* Z;
    __device__ __forceinline__ void operator()(const f32x4 (&acc)[2][2][4][2], const Unit& u, int wr, int wc, int fr, int fq) const {
        float sacc = 0.f;
#pragma unroll
        for (int ai = 0; ai < 2; ++ai)
#pragma unroll
            for (int bj = 0; bj < 2; ++bj)
#pragma unroll
                for (int m = 0; m < 4; ++m)
#pragma unroll
                    for (int n = 0; n < 2; ++n) sacc += (acc[ai][bj][m][n][0] + acc[ai][bj][m][n][1]) + (acc[ai][bj][m][n][2] + acc[ai][bj][m][n][3]);
        if (sacc == 1.2345e30f) Z[u.pm + wr + wc + fr + fq] = 0;
    }
};
struct EpiOut {
    static constexpr bool PERM = true, CHAIN = false, SIDE = false, KHOOK = false; bf16_t* T;
    __device__ __forceinline__ void operator()(const f32x4 (&acc)[2][2][4][2], const Unit& u, int wr, int wc, int fr, int fq, const LAS unsigned char*) const {
        int row0 = u.pm * 256 + wr * 64 + fr, col0 = u.pn * 256 + wc * 32 + 8 * fq; asm volatile("" : "+v"(row0), "+v"(col0));
#pragma unroll
        for (int ai = 0; ai < 2; ++ai)
#pragma unroll
            for (int m = 0; m < 4; ++m) { bf16_t* rowp = T + (size_t)(row0 + ai * 128 + m * 16) * D + col0;
#pragma unroll
                for (int bj = 0; bj < 2; ++bj) { const f32x4 v0 = acc[ai][bj][m][0], v1 = acc[ai][bj][m][1];
                    u32x4 w; w.x = cvt_pk_bf16(v0[0], v0[1]); w.y = cvt_pk_bf16(v0[2], v0[3]); w.z = cvt_pk_bf16(v1[0], v1[1]); w.w = cvt_pk_bf16(v1[2], v1[3]);
                    *(u32x4*)(rowp + bj * 128) = w; } }
    }
};
struct EpiBranch {
    static constexpr bool PERM = true, CHAIN = false, SIDE = false, KHOOK = true; static constexpr int HOOK_T0 = 4, HOOK_T1 = 12;
    const bf16_t* Z; bf16_t* Y;
    template <bool FIN> __device__ __forceinline__ void apply(f32x4 (&acc)[2][2][4][2], const Unit& u, int br, int wr, int wc, int fr, int fq) const {
        int row0 = u.pm * 256 + wr * 64 + fr, col0 = u.pn * 256 + wc * 32 + 8 * fq;
        asm volatile("" : "+v"(row0), "+v"(col0));
#pragma unroll
        for (int ai = 0; ai < 2; ++ai) {
            u32x4 ga[4][2], gb[4][2];
#pragma unroll
            for (int m = 0; m < 4; ++m) { const bf16_t* rowp = Z + (size_t)(row0 + ai * 128 + m * 16) * NZ + ZC_MG + br * 1024 + col0;
#pragma unroll
                for (int bj = 0; bj < 2; ++bj) { ga[m][bj] = *(const u32x4*)(rowp + bj * 128); if (!FIN) gb[m][bj] = *(const u32x4*)(rowp + 1024 + bj * 128); } }
#pragma unroll
            for (int m = 0; m < 4; ++m) { const size_t row = (size_t)(row0 + ai * 128 + m * 16);
#pragma unroll
                for (int bj = 0; bj < 2; ++bj) { const u32x4 a = ga[m][bj]; u32x4 b = (u32x4){0x3f803f80u, 0x3f803f80u, 0x3f803f80u, 0x3f803f80u}; if (!FIN) b = gb[m][bj];
                    f32x4 r0, r1;
                    if (FIN) { r0 = (f32x4){bflo(a.x), bfhi(a.x), bflo(a.y), bfhi(a.y)}; r1 = (f32x4){bflo(a.z), bfhi(a.z), bflo(a.w), bfhi(a.w)}; }
                    else { r0[0] = bflo(a.x) * __builtin_amdgcn_rcpf(bflo(b.x)); r0[1] = bfhi(a.x) * __builtin_amdgcn_rcpf(bfhi(b.x)); r0[2] = bflo(a.y) * __builtin_amdgcn_rcpf(bflo(b.y)); r0[3] = bfhi(a.y) * __builtin_amdgcn_rcpf(bfhi(b.y));
                           r1[0] = bflo(a.z) * __builtin_amdgcn_rcpf(bflo(b.z)); r1[1] = bfhi(a.z) * __builtin_amdgcn_rcpf(bfhi(b.z)); r1[2] = bflo(a.w) * __builtin_amdgcn_rcpf(bflo(b.w)); r1[3] = bfhi(a.w) * __builtin_amdgcn_rcpf(bfhi(b.w)); }
                    acc[ai][bj][m][0] = acc[ai][bj][m][0] * r0; acc[ai][bj][m][1] = acc[ai][bj][m][1] * r1;
                    if (FIN) { const f32x4 v0 = acc[ai][bj][m][0], v1 = acc[ai][bj][m][1];
                        u32x4 w; w.x = cvt_pk_bf16(v0[0], v0[1]); w.y = cvt_pk_bf16(v0[2], v0[3]); w.z = cvt_pk_bf16(v1[0], v1[1]); w.w = cvt_pk_bf16(v1[2], v1[3]);
                        *(u32x4*)(Y + row * D + col0 + bj * 128) = w; } } }
            asm volatile("" ::: "memory"); }
    }
    __device__ __forceinline__ void hook(f32x4 (&acc)[2][2][4][2], const Unit& u, int br, int wr, int wc, int fr, int fq) const { apply<false>(acc, u, br, wr, wc, fr, fq); }
    __device__ __forceinline__ void operator()(f32x4 (&acc)[2][2][4][2], const Unit& u, int wr, int wc, int fr, int fq, const LAS unsigned char*) const { apply<true>(acc, u, 2, wr, wc, fr, fq); }
};
struct EpiSwiglu {
    static constexpr bool PERM = true, CHAIN = false, SIDE = true, KHOOK = false; unsigned char* HID; const float* bgu; const LAS int* seg;
    __device__ __forceinline__ void side(const Unit& u, unsigned slot, int wid, int lane) const {
        if (wid == 1) { const int e = expert_of(seg, u.pm); pg8::dma16(lane < 32 ? (unsigned)lane * 16u : 4096u + (unsigned)(lane - 32) * 16u, bgu + (size_t)e * 2048 + u.pn * 128, slot); } }
    __device__ __forceinline__ void operator()(const f32x4 (&acc)[2][2][4][2], const Unit& u, int wr, int wc, int fr, int fq, const LAS unsigned char* sd) const {
        int j0 = u.pn * 128 + wc * 32 + 8 * fq, slot0 = u.pm * 256 + wr * 64 + fr; asm volatile("" : "+v"(j0), "+v"(slot0));
        f32x4 bg[2], bu[2];
#pragma unroll
        for (int n = 0; n < 2; ++n) { bg[n] = *(const LAS f32x4*)(sd + (wc * 32 + 8 * fq + 4 * n) * 4); bu[n] = *(const LAS f32x4*)(sd + (128 + wc * 32 + 8 * fq + 4 * n) * 4); }
#pragma unroll
        for (int ai = 0; ai < 2; ++ai)
#pragma unroll
            for (int m = 0; m < 4; ++m) { const size_t slot = (size_t)(slot0 + ai * 128 + m * 16); float o[8];
#pragma unroll
                for (int n = 0; n < 2; ++n)
#pragma unroll
                    for (int i = 0; i < 4; ++i) { float g = acc[ai][0][m][n][i] + bg[n][i], up = acc[ai][1][m][n][i] + bu[n][i];
                        g = fminf(g, 7.0f); up = fminf(fmaxf(up, -7.0f), 7.0f); o[n * 4 + i] = (up + 1.0f) * g * sigmoidf_(1.702f * g); }
                u32x2 w; w.x = pk4_fp8(o[0] * F8S_ACT, o[1] * F8S_ACT, o[2] * F8S_ACT, o[3] * F8S_ACT); w.y = pk4_fp8(o[4] * F8S_ACT, o[5] * F8S_ACT, o[6] * F8S_ACT, o[7] * F8S_ACT);
                *(u32x2*)(HID + slot * 1024 + j0) = w; }
    }
};
struct EpiDown {
    static constexpr bool PERM = true, CHAIN = false, SIDE = true, KHOOK = false; unsigned char* FS; const float* bdn; const int* dest; const float* pslot; const LAS int* seg;
    __device__ __forceinline__ void side(const Unit& u, unsigned slot, int wid, int lane) const {
        if (wid == 1) { const int e = expert_of(seg, u.pm); pg8::dma16((unsigned)lane * 16u, bdn + (size_t)e * 1024 + u.pn * 256, slot); }
        if (wid == 2) pg8::dma16((unsigned)lane * 16u, dest + (size_t)u.pm * 256, slot + 1024u);
        if (wid == 3) pg8::dma16((unsigned)lane * 16u, pslot + (size_t)u.pm * 256, slot + 2048u); }
    __device__ __forceinline__ void operator()(const f32x4 (&acc)[2][2][4][2], const Unit& u, int wr, int wc, int fr, int fq, const LAS unsigned char* sd) const {
        int col0 = u.pn * 256 + wc * 32 + 8 * fq, slot0 = u.pm * 256 + wr * 64 + fr; asm volatile("" : "+v"(col0), "+v"(slot0));
        f32x4 bv[2][2];
#pragma unroll
        for (int bj = 0; bj < 2; ++bj)
#pragma unroll
            for (int n = 0; n < 2; ++n) bv[bj][n] = *(const LAS f32x4*)(sd + (bj * 128 + wc * 32 + 8 * fq + 4 * n) * 4);
#pragma unroll
        for (int ai = 0; ai < 2; ++ai)
#pragma unroll
            for (int m = 0; m < 4; ++m) { const int rt = ai * 128 + wr * 64 + m * 16 + fr; const int d = *(const LAS int*)(sd + 1024 + rt * 4); const float p = *(const LAS float*)(sd + 2048 + rt * 4) * FS_SCALE;
                if (d >= 0) {
#pragma unroll
                    for (int bj = 0; bj < 2; ++bj) { f32x4 v0 = (acc[ai][bj][m][0] + bv[bj][0]) * p, v1 = (acc[ai][bj][m][1] + bv[bj][1]) * p;
#pragma unroll
                        for (int i = 0; i < 4; ++i) { v0[i] = __builtin_amdgcn_fmed3f(v0[i], -FS_CLAMP, FS_CLAMP); v1[i] = __builtin_amdgcn_fmed3f(v1[i], -FS_CLAMP, FS_CLAMP); }
                        u32x2 w; w.x = pk4_fp8(v0[0], v0[1], v0[2], v0[3]); w.y = pk4_fp8(v1[0], v1[1], v1[2], v1[3]);
                        *(u32x2*)(FS + (size_t)d * 1024 + col0 + bj * 128) = w; } }
                asm volatile("" ::: "memory"); }
    }
};

__device__ __forceinline__ const float* xin_row(const Frame& F, int row) { return row < ML ? F.in[IN_X] + (size_t)row * D : F.in[IN_CTX] + (size_t)(row - ML) * D; }
__device__ __forceinline__ void phase_ln0_first(Frame& F) {
    int t_lo, t_hi; tile_range(F, MT, t_lo, t_hi);
    const int r_lo = 32 * t_lo, nrows = 32 * (t_hi - t_lo);
    const int mrA = mod_row(r_lo), mrB = mod_row(r_lo + (nrows > 0 ? nrows - 1 : 0));
    { const float* mb = (const float*)(F.ws + WS_MOD); pv_fill(F, 0, mb + ((size_t)(0 * 17 + mrA) * 6 + 0) * 1024); pv_fill(F, 1, mb + ((size_t)(0 * 17 + mrB) * 6 + 0) * 1024);
      pv_fill(F, 2, mb + ((size_t)(0 * 17 + mrA) * 6 + 1) * 1024); pv_fill(F, 3, mb + ((size_t)(0 * 17 + mrB) * 6 + 1) * 1024); }
    load_wg_lds(F, 0);
    for (int n = F.wave; n < nrows; n += 4 * NWAVES) {
        RowV rv[4];
#pragma unroll
        for (int u = 0; u < 4; ++u) if (n + u * NWAVES < nrows) row_load(rv[u], xin_row(F, r_lo + n + u * NWAVES), F.lane);
#pragma unroll
        for (int u = 0; u < 4; ++u) if (n + u * NWAVES < nrows) { const int row = r_lo + n + u * NWAVES;
            const int sel = (mod_row(row) == mrA) ? 0 : 1; ln0_row(F, row, rv[u], pv_slot(F, 0 + sel), pv_slot(F, 2 + sel)); }
    }
    gates_tail(F, 0, t_lo, t_hi);
    __syncthreads();
}
__device__ __forceinline__ void phase_finalize(Frame& F, int l, int mrows) {
    const int gw = F.bid * NWAVES + F.wave, NGW = F.G * NWAVES;
    const bf16_t* hf = (const bf16_t*)(F.ws + WS_HFB); const bf16_t* hb = hf + (size_t)MT * 512;
    const float* ng = F.in[IN_MNG] + l * 512 + 8 * F.lane;
    const f32x4 g0 = *(const f32x4*)ng, g1 = *(const f32x4*)(ng + 4);
    for (int row = gw; row < mrows; row += NGW) {
        const u32x4 ha = __builtin_nontemporal_load((const u32x4*)(hf + (size_t)row * 512 + 8 * F.lane)), hbv = __builtin_nontemporal_load((const u32x4*)(hb + (size_t)row * 512 + 8 * F.lane));
        f32x4 v0 = (f32x4){bflo(ha.x) + bflo(hbv.x), bfhi(ha.x) + bfhi(hbv.x), bflo(ha.y) + bflo(hbv.y), bfhi(ha.y) + bfhi(hbv.y)}, v1 = (f32x4){bflo(ha.z) + bflo(hbv.z), bfhi(ha.z) + bfhi(hbv.z), bflo(ha.w) + bflo(hbv.w), bfhi(ha.w) + bfhi(hbv.w)};
        float s = (v0.x + v0.y) + (v0.z + v0.w) + (v1.x + v1.y) + (v1.z + v1.w);
#pragma unroll
        for (int o = 1; o < 16; o <<= 1) s += shx(s, o, F.lane);
        const float mu = s * (1.f / 128.f); v0 = v0 - mu; v1 = v1 - mu;
        float q = (v0.x * v0.x + v0.y * v0.y) + (v0.z * v0.z + v0.w * v0.w) + (v1.x * v1.x + v1.y * v1.y) + (v1.z * v1.z + v1.w * v1.w);
#pragma unroll
        for (int o = 1; o < 16; o <<= 1) q += shx(q, o, F.lane);
        const float rstd = 1.f / sqrtf(q * (1.f / 128.f) + HEAD_EPS);
        const u32x4 so = __builtin_nontemporal_load((const u32x4*)((const bf16_t*)(F.ws + WS_Z) + (size_t)row * NZ + ZC_O + 8 * F.lane));
        v0 = v0 * rstd * g0; v1 = v1 * rstd * g1;
        u32x4 w; w.x = pk2(v0.x * bflo(so.x), v0.y * bfhi(so.x)); w.y = pk2(v0.z * bflo(so.y), v0.w * bfhi(so.y)); w.z = pk2(v1.x * bflo(so.z), v1.y * bfhi(so.z)); w.w = pk2(v1.z * bflo(so.w), v1.w * bfhi(so.w));
        *(u32x4*)((bf16_t*)(F.ws + WS_BRA) + (size_t)row * D + 256 + 8 * F.lane) = w;
    }
}
__device__ __forceinline__ void phase_ln1_router(Frame& F, int l, int mrows) {
    LAS int* cnt = (LAS int*)(F.lds + NW_END);
    { const float* wr = F.in[IN_WR] + (size_t)l * D * NEXP;
      for (int i = F.tid; i < NEXP * D; i += NTHREADS) { const int k = i >> 5, e = i & 31; *(LAS bf16_t*)(F.lds + NW_WT + e * 2064 + k * 2) = (bf16_t)f2bf(wr[i]); }
      if (F.tid < NEXP) cnt[F.tid] = 0; }
    const float* brt = F.in[IN_BR] + l * NEXP;
    int t_lo, t_hi; tile_range(F, mrows, t_lo, t_hi);
    const int r_lo = 32 * t_lo, nrows = 32 * (t_hi - t_lo);
    const int mrA = mod_row(r_lo), mrB = mod_row(r_lo + (nrows > 0 ? nrows - 1 : 0));
    { const float* mb = (const float*)(F.ws + WS_MOD); pv_fill(F, 0, F.in[IN_LN1G] + l * D); pv_fill(F, 1, F.in[IN_LN1B] + l * D);
      pv_fill(F, 2, mb + ((size_t)(l * 17 + mrA) * 6 + 2) * 1024); pv_fill(F, 3, mb + ((size_t)(l * 17 + mrB) * 6 + 2) * 1024);
      pv_fill(F, 4, mb + ((size_t)(l * 17 + mrA) * 6 + 3) * 1024); pv_fill(F, 5, mb + ((size_t)(l * 17 + mrB) * 6 + 3) * 1024);
      pv_fill(F, 6, mb + ((size_t)(l * 17 + mrA) * 6 + 4) * 1024); pv_fill(F, 7, mb + ((size_t)(l * 17 + mrB) * 6 + 4) * 1024); }
    __syncthreads();
    { const bf16_t* yb = (const bf16_t*)(F.ws + WS_T) + 8 * F.lane;
      for (int n = F.wave; n < nrows; n += 2 * NWAVES) {
          RowV rv[2]; u32x4 yv2[2][2];
#pragma unroll
          for (int u = 0; u < 2; ++u) if (n + u * NWAVES < nrows) { const int row = r_lo + n + u * NWAVES;
              if (l == 0) row_load(rv[u], xin_row(F, row), F.lane); else row_load_bf16(rv[u], (const bf16_t*)(F.ws + WS_X) + (size_t)row * D, F.lane);
#pragma unroll
              for (int h = 0; h < 2; ++h) yv2[u][h] = __builtin_nontemporal_load((const u32x4*)(yb + (size_t)row * D + 512 * h)); }
#pragma unroll
          for (int u = 0; u < 2; ++u) if (n + u * NWAVES < nrows) { const int row = r_lo + n + u * NWAVES; RowV cur = rv[u];
              const int sel = (mod_row(row) == mrA) ? 0 : 1;
              { const LAS float* g1 = pv_slot(F, 2 + sel);
#pragma unroll
                for (int j = 0; j < 4; ++j) { const f32x4 gg = *(const LAS f32x4*)(g1 + RC(F.lane, j)); const u32x4 yw = yv2[u][j >> 1]; const f32x4 yv = (j & 1) ? (f32x4){bflo(yw.z), bfhi(yw.z), bflo(yw.w), bfhi(yw.w)} : (f32x4){bflo(yw.x), bfhi(yw.x), bflo(yw.y), bfhi(yw.y)}; cur.v[j] = cur.v[j] * DN_ALPHA + gg * yv; } }
              row_ln_plain(cur, F.lane); row_affine_l(cur, pv_slot(F, 0), pv_slot(F, 1), F.lane);
              row_store_bf16_nt(cur, (bf16_t*)(F.ws + WS_X) + (size_t)row * D, F.lane);
              row_ln_plain(cur, F.lane); row_modulate_l(cur, pv_slot(F, 4 + sel), pv_slot(F, 6 + sel), F.lane);
              row_store_bf16(cur, (bf16_t*)(F.ws + WS_H2) + (size_t)row * D, F.lane);
              { unsigned char* h8 = (unsigned char*)(F.ws + WS_H2F8) + (size_t)row * D + 8 * F.lane;
#pragma unroll
                for (int h = 0; h < 2; ++h) { u32x2 w; w.x = pk4_fp8(cur.v[2 * h].x * F8S_ACT, cur.v[2 * h].y * F8S_ACT, cur.v[2 * h].z * F8S_ACT, cur.v[2 * h].w * F8S_ACT); w.y = pk4_fp8(cur.v[2 * h + 1].x * F8S_ACT, cur.v[2 * h + 1].y * F8S_ACT, cur.v[2 * h + 1].z * F8S_ACT, cur.v[2 * h + 1].w * F8S_ACT); *(u32x2*)(h8 + 512 * h) = w; } } }
      } }
    asm volatile("s_waitcnt vmcnt(0)" ::: "memory"); __syncthreads();
    for (int tile = t_lo + F.wave; tile < t_hi; tile += NWAVES) {
        const LAS float* lgw = narrow_tile_wave(F, (const bf16_t*)(F.ws + WS_H2) + (size_t)tile * 32 * D);
        if (F.lane < 32) {
            const LAS float* lgp = lgw + F.lane * 33; const int row = tile * 32 + F.lane;
            float lg[NEXP];
#pragma unroll
            for (int e = 0; e < NEXP; ++e) lg[e] = lgp[e] + brt[e];
            unsigned used = 0u; float bv[4]; int bi[4];
#pragma unroll
            for (int k = 0; k < 4; ++k) { float best = -3.0e38f; int idx = 0;
#pragma unroll
                for (int e = 0; e < NEXP; ++e) { const bool take = (((used >> e) & 1u) == 0u) && (lg[e] > best); best = take ? lg[e] : best; idx = take ? e : idx; }
                used |= 1u << idx; bv[k] = best; bi[k] = idx; }
            const float e1 = __expf(bv[1] - bv[0]), e2 = __expf(bv[2] - bv[0]), e3 = __expf(bv[3] - bv[0]); const float inv = 1.0f / (1.0f + e1 + e2 + e3);
            int* ei = (int*)(F.ws + WS_ROUTE + RT_EIDX) + (size_t)row * 4; float* pr = (float*)(F.ws + WS_ROUTE + RT_PROB) + (size_t)row * 4;
            *(int4*)ei = make_int4(bi[0], bi[1], bi[2], bi[3]); *(f32x4*)pr = (f32x4){inv, e1 * inv, e2 * inv, e3 * inv};
            atomicAdd((int*)&cnt[bi[0]], 1); atomicAdd((int*)&cnt[bi[1]], 1); atomicAdd((int*)&cnt[bi[2]], 1); atomicAdd((int*)&cnt[bi[3]], 1);
        }
        asm volatile("s_waitcnt lgkmcnt(0)" ::: "memory");
    }
    __syncthreads();
    if (F.tid < NEXP) ((int*)(F.ws + WS_ROUTE + RT_CNT))[F.bid * NEXP + F.tid] = cnt[F.tid];
    __syncthreads();
}
__device__ __forceinline__ void phase_slots(Frame& F, int mrows) {
    LAS int* part = (LAS int*)F.lds;
    LAS int* pre = part + 1024;
    LAS int* tot = pre + 32;
    LAS int* seg = tot + 32;
    LAS int* gcnt = seg + 64;
    LAS int* eix = gcnt + 2048;
    LAS int* rnk = eix + 4096;
    const int* cntg = (const int*)(F.ws + WS_ROUTE + RT_CNT);
    int* tokg = (int*)(F.ws + WS_ROUTE + RT_TOK); int* destg = (int*)(F.ws + WS_ROUTE + RT_DEST); float* psl = (float*)(F.ws + WS_ROUTE + RT_PSLOT);
    int t_lo, t_hi; tile_range(F, mrows, t_lo, t_hi);
    const int row_base = t_lo * 32, nent = (t_hi - t_lo) * 128, ngrp = nent / 64;
    { const int e = F.tid & 31, pt = F.tid >> 5; int a = 0, b = 0;
      for (int c = pt; c < F.G; c += 16) { const int v = cntg[c * NEXP + e]; b += v; a += (c < F.bid) ? v : 0; }
      part[pt * 32 + e] = a; part[512 + pt * 32 + e] = b; }
    for (int i = F.tid; i < nent; i += NTHREADS) eix[i] = ((const int*)(F.ws + WS_ROUTE + RT_EIDX))[(size_t)row_base * 4 + i];
    __syncthreads();
    if (F.tid < NEXP) { int a = 0, b = 0;
#pragma unroll
        for (int pt = 0; pt < 16; ++pt) { a += part[pt * 32 + F.tid]; b += part[512 + pt * 32 + F.tid]; }
        pre[F.tid] = a; tot[F.tid] = b; }
    for (int g = F.wave; g < ngrp; g += NWAVES) {
        const int e = eix[g * 64 + F.lane]; int rank = 0, mycnt = 0;
#pragma unroll 4
        for (int ee = 0; ee < NEXP; ++ee) { const unsigned long long m = __ballot(e == ee); if (e == ee) rank = __popcll(m & ((1ull << F.lane) - 1ull)); if (F.lane == ee) mycnt = __popcll(m); }
        rnk[g * 64 + F.lane] = rank; if (F.lane < NEXP) gcnt[g * 32 + F.lane] = mycnt; }
    __syncthreads();
    if (F.tid == 0) { int s = 0; for (int e = 0; e < NEXP; ++e) { seg[e] = s; s += (tot[e] + 255) & ~255; } seg[NEXP] = s; }
    if (F.tid >= 64 && F.tid < 64 + NEXP) { const int e = F.tid - 64; int run = 0; for (int g = 0; g < ngrp; ++g) { const int c = gcnt[g * 32 + e]; gcnt[g * 32 + e] = run; run += c; } }
    __syncthreads();
    { const float* prg = (const float*)(F.ws + WS_ROUTE + RT_PROB) + (size_t)row_base * 4;
      for (int i = F.tid; i < nent; i += NTHREADS) { const int e = eix[i]; const int slot = seg[e] + pre[e] + gcnt[(i >> 6) * 32 + e] + rnk[i];
          tokg[slot] = row_base + (i >> 2); destg[slot] = row_base * 4 + i; psl[slot] = prg[i]; } }
    if (F.bid < NEXP) { const int e = F.bid; for (int sl = seg[e] + tot[e] + F.tid; sl < seg[e + 1]; sl += NTHREADS) { tokg[sl] = 0; destg[sl] = -1; psl[sl] = 0.f; } }
    if (F.bid == 0 && F.tid <= NEXP) ((int*)(F.ws + WS_ROUTE + RT_SEG))[F.tid] = seg[F.tid];
    __syncthreads();
}
struct CombRaw { u32x4 x[2]; u32x2 f[2][4]; };
__device__ __forceinline__ void comb_load(const Frame& F, int row, CombRaw& r) {
    { const bf16_t* xp = (const bf16_t*)(F.ws + WS_X) + (size_t)row * D + 8 * F.lane;
#pragma unroll
      for (int h = 0; h < 2; ++h) r.x[h] = __builtin_nontemporal_load((const u32x4*)(xp + 512 * h)); }
    const unsigned char* fs = (const unsigned char*)(F.ws + WS_FS) + (size_t)row * 4 * 1024 + 8 * F.lane;
#pragma unroll
    for (int h = 0; h < 2; ++h)
#pragma unroll
        for (int k = 0; k < 4; ++k) r.f[h][k] = __builtin_nontemporal_load((const u32x2*)(fs + k * 1024 + 512 * h));
}
__device__ __forceinline__ void phase_combine_ln2(Frame& F, int l, int mrows) {
    const bool lastl = (l == DEPTH - 1);
    int t_lo, t_hi; tile_range(F, mrows, t_lo, t_hi);
    const int r_lo = 32 * t_lo, nrows = 32 * (t_hi - t_lo);
    const int mrA = mod_row(r_lo), mrB = mod_row(r_lo + (nrows > 0 ? nrows - 1 : 0));
    { const float* mb = (const float*)(F.ws + WS_MOD); const int ln = lastl ? l : l + 1; pv_fill(F, 0, F.in[IN_LN2G] + l * D); pv_fill(F, 1, F.in[IN_LN2B] + l * D);
      pv_fill(F, 2, mb + ((size_t)(l * 17 + mrA) * 6 + 5) * 1024); pv_fill(F, 3, mb + ((size_t)(l * 17 + mrB) * 6 + 5) * 1024);
      pv_fill(F, 4, mb + ((size_t)(ln * 17 + mrA) * 6 + 0) * 1024); pv_fill(F, 5, mb + ((size_t)(ln * 17 + mrB) * 6 + 0) * 1024);
      pv_fill(F, 6, mb + ((size_t)(ln * 17 + mrA) * 6 + 1) * 1024); pv_fill(F, 7, mb + ((size_t)(ln * 17 + mrB) * 6 + 1) * 1024); }
    if (!lastl) load_wg_lds(F, l + 1); else __syncthreads();
    for (int n = F.wave; n < nrows; n += 2 * NWAVES) {
        CombRaw rw[2];
#pragma unroll
        for (int u = 0; u < 2; ++u) if (n + u * NWAVES < nrows) comb_load(F, r_lo + n + u * NWAVES, rw[u]);
#pragma unroll
        for (int u = 0; u < 2; ++u) if (n + u * NWAVES < nrows) { const int row = r_lo + n + u * NWAVES;
            const int sel = (mod_row(row) == mrA) ? 0 : 1;
            const LAS float* g2 = pv_slot(F, 2 + sel);
            RowV x;
#pragma unroll
            for (int h = 0; h < 2; ++h) { const u32x4 w = rw[u].x[h]; x.v[2 * h] = (f32x4){bflo(w.x), bfhi(w.x), bflo(w.y), bfhi(w.y)}; x.v[2 * h + 1] = (f32x4){bflo(w.z), bfhi(w.z), bflo(w.w), bfhi(w.w)}; }
#pragma unroll
            for (int j = 0; j < 4; ++j) { f32x4 f = (f32x4){0.f, 0.f, 0.f, 0.f};
#pragma unroll
                for (int k = 0; k < 4; ++k) { const u32x2 w2 = rw[u].f[j >> 1][k]; const int wd = (int)((j & 1) ? w2.y : w2.x);
                    const f32x2 lo = __builtin_amdgcn_cvt_pk_f32_fp8(wd, false), hi = __builtin_amdgcn_cvt_pk_f32_fp8(wd, true); f[0] += lo[0]; f[1] += lo[1]; f[2] += hi[0]; f[3] += hi[1]; }
                const f32x4 gg = *(const LAS f32x4*)(g2 + RC(F.lane, j)) * (1.0f / FS_SCALE);
                x.v[j] = x.v[j] * DN_ALPHA + gg * f; }
            row_ln_plain(x, F.lane); row_affine_l(x, pv_slot(F, 0), pv_slot(F, 1), F.lane);
            if (lastl) { row_store_nt(x, F.out + (size_t)row * D, F.lane); }
            else { row_store_bf16_nt(x, (bf16_t*)(F.ws + WS_X) + (size_t)row * D, F.lane); ln0_row(F, row, x, pv_slot(F, 4 + sel), pv_slot(F, 6 + sel)); } }
    }
    if (!lastl) gates_tail(F, l + 1, t_lo, t_hi);
    __syncthreads();
}

#define MFMA32(a, b, c) __builtin_amdgcn_mfma_f32_32x32x16_bf16((a), (b), (c), 0, 0, 0)
#define MFMA16(a, b, c) __builtin_amdgcn_mfma_f32_16x16x32_bf16((a), (b), (c), 0, 0, 0)
__device__ __forceinline__ f32x16 zero16() { f32x16 z;
#pragma unroll
    for (int i = 0; i < 16; ++i) z[i] = 0.f;
    return z; }
__device__ __forceinline__ void pool_tiles(Frame& F, int l, bool with_ctx) {
    LAS unsigned char* Pin = F.lds;
    LAS unsigned char* Dm = F.lds + 40960;
    const bf16_t* Z = (const bf16_t*)(F.ws + WS_Z);
    const bf16_t* Wp = (const bf16_t*)(F.ws + WS_WPOOL) + (size_t)l * 4 * 4096;
    const float* psc = F.in[IN_POOLS] + l * 256;
    bf16_t* BRA = (bf16_t*)(F.ws + WS_BRA);
    const int ntiles = with_ctx ? 1088 : 1024;
    const int r = F.lane & 31, h = F.lane >> 5;
    for (int tile = F.bid; tile < ntiles; tile += F.G) {
        int row0, seq_lo, seq_hi;
        if (tile < 1024) { row0 = tile * 64; seq_lo = row0; seq_hi = row0 + 64; }
        else { const int ct = tile - 1024; seq_lo = ML + (ct >> 2) * 256; seq_hi = seq_lo + 256; row0 = seq_lo + (ct & 3) * 64; }
        for (int idx = F.tid; idx < 80 * 32; idx += NTHREADS) { const int rr = idx >> 5, ck = idx & 31, grow = row0 - 8 + rr;
            if (grow >= seq_lo && grow < seq_hi) *(LAS u32x4*)(Pin + rr * 512 + ck * 16) = __builtin_nontemporal_load((const u32x4*)(Z + (size_t)grow * NZ + ZC_P + ck * 8)); }
        __syncthreads();
        for (int idx = F.tid; idx < 64 * 32; idx += NTHREADS) { const int tok = idx >> 5, ck = idx & 31, g = ck >> 3, hw = 1 << g, t = row0 + tok;
            const int lo = max(t - hw, seq_lo), hi = min(t + hw, seq_hi);
            float s[8];
#pragma unroll
            for (int e = 0; e < 8; ++e) s[e] = 0.f;
            for (int rw = lo; rw < hi; ++rw) { const u32x4 v = *(const LAS u32x4*)(Pin + (rw - row0 + 8) * 512 + ck * 16);
                s[0] += bflo(v.x); s[1] += bfhi(v.x); s[2] += bflo(v.y); s[3] += bfhi(v.y); s[4] += bflo(v.z); s[5] += bfhi(v.z); s[6] += bflo(v.w); s[7] += bfhi(v.w); }
            const float inv = 1.0f / (float)(hi - lo);
            const u32x4 o = *(const LAS u32x4*)(Pin + (tok + 8) * 512 + ck * 16);
            u32x4 w; w.x = pk2(s[0] * inv - bflo(o.x), s[1] * inv - bfhi(o.x)); w.y = pk2(s[2] * inv - bflo(o.y), s[3] * inv - bfhi(o.y));
            w.z = pk2(s[4] * inv - bflo(o.z), s[5] * inv - bfhi(o.z)); w.w = pk2(s[6] * inv - bflo(o.w), s[7] * inv - bfhi(o.w));
            *(LAS u32x4*)(Dm + tok * 528 + ck * 16) = w; }
        __syncthreads();
#pragma unroll 1
        for (int qi = 0; qi < 2; ++qi) { const int q = F.wave + 8 * qi, g = q >> 2, td = (q >> 1) & 1, tt = q & 1;
            f32x16 acc = zero16();
#pragma unroll
            for (int ks = 0; ks < 4; ++ks) { const bf16x8 a = *(const bf16x8*)(Wp + ((size_t)g * 64 + td * 32 + r) * 64 + ks * 16 + 8 * h);
                const bf16x8 b = *(const LAS bf16x8*)(Dm + (tt * 32 + r) * 528 + (g * 64 + ks * 16 + 8 * h) * 2);
                acc = MFMA32(a, b, acc); }
            const size_t orow = (size_t)(row0 + tt * 32 + r);
#pragma unroll
            for (int qq = 0; qq < 4; ++qq) { const int dcol = g * 64 + td * 32 + 8 * qq + 4 * h; const f32x4 sc = *(const f32x4*)(psc + dcol);
                u32x2 w; w.x = pk2(acc[4 * qq] * sc.x, acc[4 * qq + 1] * sc.y); w.y = pk2(acc[4 * qq + 2] * sc.z, acc[4 * qq + 3] * sc.w);
                *(u32x2*)(BRA + orow * D + dcol) = w; } }
        __syncthreads();
    }
}
__device__ __forceinline__ void sgu_chunks(Frame& F, int l, bool with_ctx) {
    LAS unsigned char* Vt = F.lds;
    const bf16_t* Z = (const bf16_t*)(F.ws + WS_Z);
    const bf16_t* Ws = (const bf16_t*)(F.ws + WS_WSGU) + (size_t)l * 4 * 16384;
    const float* lng = F.in[IN_SLNG] + l * 256; const float* lnb = F.in[IN_SLNB] + l * 256; const float* sb = F.in[IN_SGUB] + l * 512;
    bf16_t* BRA = (bf16_t*)(F.ws + WS_BRA);
    const int nchunks = with_ctx ? 544 : 512;
    const int r = F.lane & 31, h = F.lane >> 5;
    for (int ch = F.bid; ch < nchunks; ch += F.G) {
        const int row0 = ch * 128;
        { const int s = F.tid >> 2, q = F.tid & 3; const bf16_t* zp = Z + (size_t)(row0 + s) * NZ + ZC_UV + 256 + q * 64;
          float v[64]; float sum = 0.f;
#pragma unroll
          for (int i = 0; i < 8; ++i) { const u32x4 w = __builtin_nontemporal_load((const u32x4*)(zp + 8 * i));
              v[8 * i] = bflo(w.x); v[8 * i + 1] = bfhi(w.x); v[8 * i + 2] = bflo(w.y); v[8 * i + 3] = bfhi(w.y); v[8 * i + 4] = bflo(w.z); v[8 * i + 5] = bfhi(w.z); v[8 * i + 6] = bflo(w.w); v[8 * i + 7] = bfhi(w.w); }
#pragma unroll
          for (int i = 0; i < 64; ++i) sum += v[i];
          sum += shx(sum, 1, F.lane); sum += shx(sum, 2, F.lane);
          const float mean = sum * (1.f / 256.f); float sq = 0.f;
#pragma unroll
          for (int i = 0; i < 64; ++i) { v[i] -= mean; sq += v[i] * v[i]; }
          sq += shx(sq, 1, F.lane); sq += shx(sq, 2, F.lane);
          const float rstd = 1.f / sqrtf(sq * (1.f / 256.f) + LN_EPS);
#pragma unroll
          for (int i = 0; i < 64; ++i) { const int c = q * 64 + i; const float y = v[i] * rstd * lng[c] + lnb[c]; *(LAS bf16_t*)(Vt + c * 272 + s * 2) = (bf16_t)f2bf(y); } }
        __syncthreads();
        const int tc = F.wave & 1, tt = F.wave >> 1, t = tt * 32 + r;
#pragma unroll 1
        for (int g = 0; g < 4; ++g) {
            f32x16 acc = zero16();
#pragma unroll
            for (int ks = 0; ks < 8; ++ks) { const bf16x8 a = *(const LAS bf16x8*)(Vt + (g * 64 + tc * 32 + r) * 272 + (ks * 16 + 8 * h) * 2);
                const bf16x8 b = *(const bf16x8*)(Ws + ((size_t)g * 128 + t) * 128 + ks * 16 + 8 * h);
                acc = MFMA32(a, b, acc); }
            const float bias = sb[g * 128 + t];
#pragma unroll
            for (int qq = 0; qq < 4; ++qq) { const int c0 = g * 64 + tc * 32 + 8 * qq + 4 * h;
                const u32x2 u = *(const u32x2*)(Z + (size_t)(row0 + t) * NZ + ZC_UV + c0);
                u32x2 w; w.x = pk2(bflo(u.x) * (acc[4 * qq] + bias), bfhi(u.x) * (acc[4 * qq + 1] + bias)); w.y = pk2(bflo(u.y) * (acc[4 * qq + 2] + bias), bfhi(u.y) * (acc[4 * qq + 3] + bias));
                *(u32x2*)(BRA + (size_t)(row0 + t) * D + 768 + c0) = w; } }
        __syncthreads();
    }
}
__device__ __forceinline__ void qk_conv_pass(Frame& F, int l) {
    const bf16_t* Z = (const bf16_t*)(F.ws + WS_Z); bf16_t* QKC = (bf16_t*)(F.ws + WS_H);
    const int chunk = F.tid & 127, rsub = F.tid >> 7, ch0 = chunk * 8;
    float w0[8], w1[8], w2[8], cbv[8];
    { const float* cw = F.in[IN_CONVW] + (size_t)l * 3 * 1024 + ch0; const float* cb = F.in[IN_CONVB] + (size_t)l * 1024 + ch0;
#pragma unroll
      for (int e = 0; e < 8; ++e) { w0[e] = cw[e]; w1[e] = cw[1024 + e]; w2[e] = cw[2048 + e]; cbv[e] = cb[e]; } }
    const float scale = chunk >= 64 ? 0.08838834764831845f : 1.0f;
    for (int row = F.bid * 4 + rsub; row < MT; row += F.G * 4) {
        const int p = row < ML ? (row & 4095) : ((row - ML) & 255), len = row < ML ? 4096 : 256;
        const bf16_t* zr = Z + (size_t)row * NZ + ZC_QK + ch0;
        const u32x4 x1 = *(const u32x4*)zr; u32x4 x0 = (u32x4){0u, 0u, 0u, 0u}, x2 = (u32x4){0u, 0u, 0u, 0u};
        if (p > 0) x0 = *(const u32x4*)(zr - NZ);
        if (p + 1 < len) x2 = *(const u32x4*)(zr + NZ);
        const unsigned xa[4] = {x0.x, x0.y, x0.z, x0.w}, xb[4] = {x1.x, x1.y, x1.z, x1.w}, xc[4] = {x2.x, x2.y, x2.z, x2.w};
        float y[8];
#pragma unroll
        for (int e2 = 0; e2 < 4; ++e2) { y[2 * e2] = cbv[2 * e2] + w0[2 * e2] * bflo(xa[e2]) + w1[2 * e2] * bflo(xb[e2]) + w2[2 * e2] * bflo(xc[e2]);
            y[2 * e2 + 1] = cbv[2 * e2 + 1] + w0[2 * e2 + 1] * bfhi(xa[e2]) + w1[2 * e2 + 1] * bfhi(xb[e2]) + w2[2 * e2 + 1] * bfhi(xc[e2]); }
#pragma unroll
        for (int e = 0; e < 8; ++e) y[e] = siluf_(y[e]) * scale;
        u32x4 w; w.x = pk2(y[0], y[1]); w.y = pk2(y[2], y[3]); w.z = pk2(y[4], y[5]); w.w = pk2(y[6], y[7]);
        *(u32x4*)(QKC + (size_t)row * D + ch0) = w;
    }
}
constexpr int ML_QS = 0, ML_KS = 34816, ML_KW = 69632, ML_VT = 104448, ML_CB = 126208, ML_SC = 147968, ML_SCSZ = 2624;
__device__ __forceinline__ float logsigf_(float x) { return fminf(x, 0.f) - log1pf(__expf(-fabsf(x))); }
__device__ __forceinline__ unsigned swap16(unsigned u) { return __builtin_amdgcn_alignbit(u, u, 16); }
struct MlPre { u32x4 qk[8]; u32x2 v[4]; float g[4]; };
__device__ __forceinline__ void ml_geom(int j, int b, int dir, int& seqbase, int& seqlen, int& pbase) {
    const bool is_ctx = j < 2; int cj = is_ctx ? j : j - 2; const int ncs = is_ctx ? 2 : 32; if (dir) cj = ncs - 1 - cj;
    seqbase = is_ctx ? ML + b * 256 : b * 4096; seqlen = is_ctx ? 256 : 4096; pbase = cj * 128; }
#define ML_BAR() do { asm volatile("s_waitcnt lgkmcnt(0)" ::: "memory"); __builtin_amdgcn_s_barrier(); asm volatile("" ::: "memory"); } while (0)
__device__ __forceinline__ void mlstm_unit(Frame& F, int l, int unit) {
    const int bh = (unit & 7) + 8 * (unit >> 5), sub = (unit >> 3) & 3;
    const int b = bh >> 2, head = bh & 3, dir = sub >> 1, vh = sub & 1;
    LAS unsigned char* QS = F.lds + ML_QS; LAS unsigned char* KS = F.lds + ML_KS; LAS unsigned char* KW = F.lds + ML_KW; LAS unsigned char* VT = F.lds + ML_VT; LAS unsigned char* CB = F.lds + ML_CB;
    const bf16_t* Z = (const bf16_t*)(F.ws + WS_Z); const float* ZG = (const float*)(F.ws + WS_ZG); const bf16_t* QKC = (const bf16_t*)(F.ws + WS_H);
    bf16_t* HF = (bf16_t*)(F.ws + WS_HFB) + (size_t)dir * MT * 512;
    const int wave = F.wave;
    int tl = F.tid;
#define ML_ROLES() const int lane = tl & 63, fr = lane & 15, q4 = lane >> 4; const int isk = (tl >> 4) & 1, ck = tl & 15, i0 = 8 * (tl >> 5), chn = (isk ? 512 : 0) + head * 128 + ck * 8; \
    const int vi0 = 4 * (tl >> 4), vcq = tl & 15, vch = head * 128 + vh * 64 + vcq * 4; (void)fr; (void)q4; (void)vi0; (void)vcq; (void)vch; (void)i0; (void)chn; (void)ck; (void)isk;
    for (int idx = F.tid; idx < 16 * 136; idx += NTHREADS) *(LAS bf16_t*)(VT + (64 + idx / 136) * 272 + (idx % 136) * 2) = (idx < 136) ? (bf16_t)0x3F80 : (bf16_t)0;
    f32x4 cs[5];
#pragma unroll
    for (int vt = 0; vt < 5; ++vt) cs[vt] = (f32x4){0.f, 0.f, 0.f, 0.f};
    float m_state = 0.f;
    MlPre pre;
#define ML_PREFETCH(jj) do { int sb_, sl_, pb_; ml_geom((jj), b, dir, sb_, sl_, pb_); \
        { const int pmin = dir ? pb_ + 120 - i0 : pb_ + i0; const bf16_t* zr = QKC + (size_t)(sb_ + pmin) * D + chn; (void)sl_; \
          _Pragma("unroll") for (int k = 0; k < 8; ++k) pre.qk[k] = *(const u32x4*)(zr + (size_t)k * D); } \
        { const int pminv = dir ? pb_ + 124 - vi0 : pb_ + vi0; const bf16_t* zv = Z + (size_t)(sb_ + pminv) * NZ + ZC_V + vch; \
          _Pragma("unroll") for (int k = 0; k < 4; ++k) pre.v[k] = *(const u32x2*)(zv + (size_t)k * NZ); } \
        if (wave == 0) { const int p0 = dir ? pb_ + 127 - 2 * lane : pb_ + 2 * lane, p1 = dir ? p0 - 1 : p0 + 1; \
          pre.g[0] = ZG[(size_t)(sb_ + p0) * 16 + dir * 8 + head]; pre.g[1] = ZG[(size_t)(sb_ + p0) * 16 + dir * 8 + 4 + head]; \
          pre.g[2] = ZG[(size_t)(sb_ + p1) * 16 + dir * 8 + head]; pre.g[3] = ZG[(size_t)(sb_ + p1) * 16 + dir * 8 + 4 + head]; } } while (0)
#define ML_STEPA(sbuf) do { LAS float* sg_ = (LAS float*)(F.lds + ML_SC + (sbuf) * ML_SCSZ); const int i0g = 2 * lane, i1g = i0g + 1; \
        const float gi0 = pre.g[0], gf0 = pre.g[1], gi1 = pre.g[2], gf1 = pre.g[3]; \
        const float lf0 = logsigf_(gf0), lf1 = logsigf_(gf1); const float s1 = lf0 + lf1; float incl = s1; \
        _Pragma("unroll") for (int o = 1; o < 64; o <<= 1) { const float y_ = shup(incl, o, lane); incl += (lane >= o) ? y_ : 0.f; } \
        const float excl = incl - s1, bc0 = excl + lf0, bc1 = excl + s1; \
        const float g0 = gi0 - bc0, g1 = gi1 - bc1; const float mx1 = fmaxf(g0, g1); float im = mx1; \
        _Pragma("unroll") for (int o = 1; o < 64; o <<= 1) { const float y_ = shup(im, o, lane); im = (lane >= o) ? fmaxf(im, y_) : im; } \
        float em = shup(im, 1, lane); em = (lane == 0) ? -3.0e38f : em; \
        const float M0 = fmaxf(m_state, fmaxf(em, g0)), M1 = fmaxf(m_state, fmaxf(em, mx1)); \
        const float total = bperm(63, bc1), Mlast = bperm(63, M1); \
        sg_[i0g] = g0; sg_[i1g] = g1; sg_[128 + i0g] = M0; sg_[128 + i1g] = M1; \
        sg_[256 + i0g] = __expf(m_state - M0); sg_[256 + i1g] = __expf(m_state - M1); \
        sg_[384 + i0g] = __expf(-(bc0 + M0)); sg_[384 + i1g] = __expf(-(bc1 + M1)); \
        sg_[512 + i0g] = __expf(g0 - Mlast); sg_[512 + i1g] = __expf(g1 - Mlast); \
        if (lane == 0) sg_[640] = __expf(m_state - Mlast); \
        m_state = total + Mlast; } while (0)
    { ML_ROLES(); ML_PREFETCH(0); if (wave == 0) ML_STEPA(0); }
    ML_BAR();
#pragma unroll 1
    for (int j = 0; j < 34; ++j) {
        asm volatile("" : "+v"(tl));
        ML_ROLES();
        int seqbase, seqlen, pbase; ml_geom(j, b, dir, seqbase, seqlen, pbase);
        const LAS float* sc_g = (const LAS float*)(F.lds + ML_SC + (j & 1) * ML_SCSZ); const LAS float* sc_M = sc_g + 128; const LAS float* sc_dec = sc_g + 256; const LAS float* sc_emt = sc_g + 384; const LAS float* sc_wk = sc_g + 512;
        {
#pragma unroll
          for (int k = 0; k < 8; ++k) { const int i = dir ? i0 + 7 - k : i0 + k; *(LAS u32x4*)((isk ? KS : QS) + i * 272 + ck * 16) = pre.qk[k]; }
          if (isk) { u32x4 kt[8]; float ykeep[8];
#pragma unroll
              for (int e = 0; e < 8; ++e) { kt[e] = (u32x4){0u, 0u, 0u, 0u}; ykeep[e] = 0.f; }
#pragma unroll
              for (int k = 0; k < 8; ++k) { const int i = dir ? i0 + 7 - k : i0 + k; const float wk = sc_wk[i];
                  const unsigned xb[4] = {pre.qk[k].x, pre.qk[k].y, pre.qk[k].z, pre.qk[k].w};
#pragma unroll
                  for (int e = 0; e < 8; ++e) { const float yw = ((e & 1) ? bfhi(xb[e >> 1]) : bflo(xb[e >> 1])) * wk;
                      if (k & 1) { const unsigned pw_ = pk2(ykeep[e], yw); if ((k >> 1) == 0) kt[e].x = pw_; else if ((k >> 1) == 1) kt[e].y = pw_; else if ((k >> 1) == 2) kt[e].z = pw_; else kt[e].w = pw_; }
                      else ykeep[e] = yw; } }
#pragma unroll
              for (int e = 0; e < 8; ++e) { u32x4 o = kt[e]; if (dir) o = (u32x4){swap16(kt[e].w), swap16(kt[e].z), swap16(kt[e].y), swap16(kt[e].x)};
                  *(LAS u32x4*)(KW + (ck * 8 + e) * 272 + (((i0 >> 3) ^ (ck & 7)) * 16)) = o; } } }
        { unsigned vv[4][2];
#pragma unroll
          for (int k = 0; k < 4; ++k) { vv[k][0] = pre.v[k].x; vv[k][1] = pre.v[k].y; }
#pragma unroll
          for (int c = 0; c < 4; ++c) {
              unsigned h0 = (c & 1) ? (vv[0][c >> 1] >> 16) : (vv[0][c >> 1] & 0xffffu), h1 = (c & 1) ? (vv[1][c >> 1] >> 16) : (vv[1][c >> 1] & 0xffffu);
              unsigned h2 = (c & 1) ? (vv[2][c >> 1] >> 16) : (vv[2][c >> 1] & 0xffffu), h3 = (c & 1) ? (vv[3][c >> 1] >> 16) : (vv[3][c >> 1] & 0xffffu);
              u32x2 o; if (dir) { o.x = h3 | (h2 << 16); o.y = h1 | (h0 << 16); } else { o.x = h0 | (h1 << 16); o.y = h2 | (h3 << 16); }
              *(LAS u32x2*)(VT + (vcq * 4 + c) * 272 + vi0 * 2) = o; } }
#pragma unroll
        for (int vt = 0; vt < 5; ++vt)
#pragma unroll
            for (int rr = 0; rr < 4; rr += 2) { const unsigned pw_ = pk2(cs[vt][rr], cs[vt][rr + 1]);
                *(LAS bf16_t*)(CB + (16 * vt + 4 * q4 + rr) * 272 + (16 * wave + fr) * 2) = (bf16_t)(pw_ & 0xffffu); *(LAS bf16_t*)(CB + (16 * vt + 4 * q4 + rr + 1) * 272 + (16 * wave + fr) * 2) = (bf16_t)(pw_ >> 16); }
        ML_BAR();
        if (j + 1 < 34) ML_PREFETCH(j + 1);
        const int t = 16 * wave + fr;
        bf16x8 qf[4];
#pragma unroll
        for (int kc = 0; kc < 4; ++kc) qf[kc] = *(const LAS bf16x8*)(QS + t * 272 + (32 * kc + 8 * q4) * 2);
        const float Mt_t = sc_M[t], dec_t = sc_dec[t], emt_t = sc_emt[t];
        f32x4 ps[8];
#pragma unroll
        for (int jp = 0; jp < 4; ++jp) {
            ps[2 * jp] = (f32x4){0.f, 0.f, 0.f, 0.f}; ps[2 * jp + 1] = (f32x4){0.f, 0.f, 0.f, 0.f};
            if (2 * jp <= wave) {
                bf16x8 ka[4], kb[4];
#pragma unroll
                for (int kc = 0; kc < 4; ++kc) { ka[kc] = *(const LAS bf16x8*)(KS + (32 * jp + fr) * 272 + (32 * kc + 8 * q4) * 2); kb[kc] = *(const LAS bf16x8*)(KS + (32 * jp + 16 + fr) * 272 + (32 * kc + 8 * q4) * 2); }
                const f32x4 ga4 = *(const LAS f32x4*)(sc_g + 32 * jp + 4 * q4), gb4 = *(const LAS f32x4*)(sc_g + 32 * jp + 16 + 4 * q4);
                f32x4 acc0 = (f32x4){0.f, 0.f, 0.f, 0.f}, acc1 = (f32x4){0.f, 0.f, 0.f, 0.f};
#pragma unroll
                for (int kc = 0; kc < 4; ++kc) { acc0 = MFMA16(ka[kc], qf[kc], acc0); acc1 = MFMA16(kb[kc], qf[kc], acc1); }
#pragma unroll
                for (int rr = 0; rr < 4; ++rr) { const int s0 = 32 * jp + 4 * q4 + rr, s1 = s0 + 16;
                    ps[2 * jp][rr] = (s0 <= t) ? acc0[rr] * __expf(ga4[rr] - Mt_t) : 0.f; ps[2 * jp + 1][rr] = (s1 <= t) ? acc1[rr] * __expf(gb4[rr] - Mt_t) : 0.f; }
            }
        }
        f32x4 ao[5];
        {
#pragma unroll
          for (int vt = 0; vt < 5; ++vt) ao[vt] = (f32x4){0.f, 0.f, 0.f, 0.f};
#pragma unroll
          for (int kh = 0; kh < 4; kh += 2) { bf16x8 cf[2][5];
#pragma unroll
              for (int k2 = 0; k2 < 2; ++k2)
#pragma unroll
                  for (int vt = 0; vt < 5; ++vt) cf[k2][vt] = *(const LAS bf16x8*)(CB + (16 * vt + fr) * 272 + (32 * (kh + k2) + 8 * q4) * 2);
#pragma unroll
              for (int k2 = 0; k2 < 2; ++k2)
#pragma unroll
                  for (int vt = 0; vt < 5; ++vt) ao[vt] = MFMA16(cf[k2][vt], qf[kh + k2], ao[vt]); }
#pragma unroll
          for (int vt = 0; vt < 5; ++vt) ao[vt] = ao[vt] * dec_t; }
#pragma unroll
        for (int ks = 0; ks < 4; ++ks) {
            if (2 * ks <= wave) {
                s16x4 vlo[5], vhi[5];
#pragma unroll
                for (int vt = 0; vt < 5; ++vt) { vlo[vt] = *(const LAS s16x4*)(VT + (16 * vt + fr) * 272 + (32 * ks + 4 * q4) * 2); vhi[vt] = *(const LAS s16x4*)(VT + (16 * vt + fr) * 272 + (32 * ks + 16 + 4 * q4) * 2); }
                u32x4 pw; pw.x = cvt_pk_bf16(ps[2 * ks][0], ps[2 * ks][1]); pw.y = cvt_pk_bf16(ps[2 * ks][2], ps[2 * ks][3]); pw.z = cvt_pk_bf16(ps[2 * ks + 1][0], ps[2 * ks + 1][1]); pw.w = cvt_pk_bf16(ps[2 * ks + 1][2], ps[2 * ks + 1][3]);
                const bf16x8 pf = __builtin_bit_cast(bf16x8, pw);
#pragma unroll
                for (int vt = 0; vt < 5; ++vt) { const bf16x8 a = __builtin_shufflevector(vlo[vt], vhi[vt], 0, 1, 2, 3, 4, 5, 6, 7); ao[vt] = MFMA16(a, pf, ao[vt]); }
            }
        }
        { const float den = bperm(fr, ao[4][0]); const float inv = 1.0f / fmaxf(fabsf(den), emt_t);
          const int p = dir ? pbase + 127 - t : pbase + t; bf16_t* orow = HF + (size_t)(seqbase + p) * 512 + head * 128 + vh * 64 + 4 * q4;
#pragma unroll
          for (int vt = 0; vt < 4; ++vt) { const f32x4 o = ao[vt] * inv; u32x2 w; w.x = cvt_pk_bf16(o[0], o[1]); w.y = cvt_pk_bf16(o[2], o[3]); *(u32x2*)(orow + 16 * vt) = w; } }
        { const float a_s = sc_g[640];
#pragma unroll
          for (int vt = 0; vt < 5; ++vt) cs[vt] = cs[vt] * a_s;
#pragma unroll
          for (int ks = 0; ks < 4; ks += 2) { bf16x8 bb[2], va[2][5];
#pragma unroll
              for (int k2 = 0; k2 < 2; ++k2) { bb[k2] = *(const LAS bf16x8*)(KW + (16 * wave + fr) * 272 + (((4 * (ks + k2) + q4) ^ (((16 * wave + fr) >> 3) & 7)) * 16));
#pragma unroll
                  for (int vt = 0; vt < 5; ++vt) va[k2][vt] = *(const LAS bf16x8*)(VT + (16 * vt + fr) * 272 + (32 * (ks + k2) + 8 * q4) * 2); }
#pragma unroll
              for (int k2 = 0; k2 < 2; ++k2)
#pragma unroll
                  for (int vt = 0; vt < 5; ++vt) cs[vt] = MFMA16(va[k2][vt], bb[k2], cs[vt]); } }
        if (wave == 0 && j + 1 < 34) ML_STEPA((j + 1) & 1);
        ML_BAR();
    }
#undef ML_PREFETCH
#undef ML_STEPA
#undef ML_ROLES
    __syncthreads();
}
__device__ __forceinline__ void phase_mixers(Frame& F, int l) {
    const bool with_ctx = (l != DEPTH - 1);
#ifndef MIX_MASK
#define MIX_MASK 7
#endif
#ifndef MIXREP
#define MIXREP 0
#endif
    if (MIX_MASK & 1) pool_tiles(F, l, with_ctx);
    if (MIXREP & 1) { __syncthreads(); pool_tiles(F, l, with_ctx); }
    if (MIX_MASK & 2) sgu_chunks(F, l, with_ctx);
    if (MIXREP & 2) { __syncthreads(); sgu_chunks(F, l, with_ctx); }
    (void)0;
    qk_conv_pass(F, l);
}
__device__ __forceinline__ void phase_mlstm(Frame& F, int l) {
    for (int u = F.bid; u < 256; u += F.G) mlstm_unit(F, l, u);
}

struct Args { const float* in[31]; float* out; unsigned char* ws; int g_lo, g_hi, pad0, pad1; };
constexpr int NPH = 11, NGID = 2 + DEPTH * NPH;
__global__ void __launch_bounds__(NTHREADS, 2) fwd_kernel(Args args) {
    extern __shared__ __attribute__((aligned(16))) unsigned char lds_raw[];
    Frame F;
    F.lds = (LAS unsigned char*)lds_raw; F.MISC = (volatile LAS unsigned*)(F.lds + MISC_OFF);
    F.tid = threadIdx.x; F.lane = F.tid & 63; F.wave = __builtin_amdgcn_readfirstlane(F.tid >> 6); F.G = gridDim.x; F.bid = blockIdx.x;
    F.ws = args.ws; F.out = args.out;
    F.in = (InTab)__builtin_amdgcn_kernarg_segment_ptr();
    if (F.tid < 64) F.MISC[F.tid] = 0u;
    __syncthreads();
    const int lo = args.g_lo, hi = args.g_hi;
    const bool multi = (hi - lo) > 1;
    XcdBarrier bar; bar.bar = (unsigned*)(F.ws + WS_CTL) + CW_BAR; bar.x = 0; bar.st = nullptr;
    if (multi) bar = xcd_barrier_post((unsigned*)(F.ws + WS_CTL) + CW_BAR, F.MISC + 8);
#ifndef PHASE_MASK
#define PHASE_MASK 0xFFFF
#endif
#define RUN(g) (lo <= (g) && (g) < hi)
#define RUNP(ty, g) ((((PHASE_MASK) >> (ty)) & 1) && RUN(g))
#ifndef REPEAT_MASK
#define REPEAT_MASK 0
#endif
#define NREP(ty) ((((REPEAT_MASK) >> (ty)) & 1) ? 2 : 1)
#define SEAM(g) do { if (RUN((g) + 1)) xcd_barrier(bar); } while (0)
#define LAUNDER(P) Frame P = F; { int t_; asm volatile("v_mbcnt_lo_u32_b32 %0, -1, 0\n\tv_mbcnt_hi_u32_b32 %0, -1, %0" : "=v"(t_)); t_ |= (F.wave << 6); P.tid = t_; P.lane = t_ & 63; P.wave = __builtin_amdgcn_readfirstlane(t_ >> 6); GAS unsigned char* w_ = (GAS unsigned char*)F.ws; asm volatile("" : "+s"(w_)); P.ws = (unsigned char*)w_; InTab t2_ = F.in; asm volatile("" : "+s"(t2_)); P.in = t2_; }
    if (RUNP(0, 0)) { LAUNDER(P); for (int rep_ = 0; rep_ < NREP(0); ++rep_) { phase_prologue(P); __syncthreads(); } SEAM(0); }
    if (RUNP(1, 1)) { LAUNDER(P); for (int rep_ = 0; rep_ < NREP(1); ++rep_) { phase_ln0_first(P); __syncthreads(); } SEAM(1); }
#pragma unroll 1
    for (int l = 0; l < DEPTH; ++l) {
        const int g0 = 2 + l * NPH;
        const int mrows = (l == DEPTH - 1) ? ML : MT;
        if (RUNP(2, g0 + 0)) {
#undef PHTY
#define PHTY 2
            LAUNDER(P);
            { ProbPlain Pr{(const bf16_t*)(P.ws + WS_H), (const bf16_t*)(P.ws + WS_WIN) + (size_t)l * NZ * D, D, D};
              pg8::StaticOrder<1> S; S.init(MT / 256, NZ_BF / 256, P.G, P.bid);
              EpiInproj E{(bf16_t*)(P.ws + WS_Z), P.in[IN_BIN] + (size_t)l * 5904, 0};
              pg8::gemm_phase(P.lds, P.tid, Pr, S, E); }
            __syncthreads();
            { ProbPlainF8 Pr{(const bf16_t*)(P.ws + WS_H8), (const bf16_t*)(P.ws + WS_WIN8 + (size_t)l * NZ_F8 * D), D / 2, D / 2};
              pg8::StaticOrder<1> S; S.init(MT / 256, NZ_F8 / 256, P.G, P.bid);
              EpiInproj E{(bf16_t*)(P.ws + WS_Z), P.in[IN_BIN] + (size_t)l * 5904, NZ_BF / 256};
              pg8::gemm_phase(P.lds, P.tid, Pr, S, E); }
            SEAM(g0 + 0);
        }
        if (RUNP(3, g0 + 1)) { LAUNDER(P); for (int rep_ = 0; rep_ < NREP(3); ++rep_) { phase_mixers(P, l); __syncthreads(); } SEAM(g0 + 1); }
        if (RUNP(12, g0 + 2)) { LAUNDER(P); for (int rep_ = 0; rep_ < NREP(12); ++rep_) { phase_mlstm(P, l); __syncthreads(); } SEAM(g0 + 2); }
        if (RUNP(4, g0 + 3)) { LAUNDER(P); for (int rep_ = 0; rep_ < NREP(4); ++rep_) phase_finalize(P, l, mrows); SEAM(g0 + 3); }
        if (RUNP(5, g0 + 4)) {
#undef PHTY
#define PHTY 5
            LAUNDER(P);
            ProbPlain Pr{(const bf16_t*)(P.ws + WS_BRA), (const bf16_t*)(P.ws + WS_WBR) + (size_t)l * D * D, D, D};
            pg8::StaticOrder<1> S; S.init(mrows / 256, 4, P.G, P.bid);
            EpiBranch E{(const bf16_t*)(P.ws + WS_Z), (bf16_t*)(P.ws + WS_Y)};
            pg8::gemm_phase(P.lds, P.tid, Pr, S, E); if (NREP(PHTY) == 2) { __syncthreads(); pg8::gemm_phase(P.lds, P.tid, Pr, S, E); }
            SEAM(g0 + 4);
        }
        if (RUNP(6, g0 + 5)) {
#undef PHTY
#define PHTY 6
            LAUNDER(P);
            ProbPlain Pr{(const bf16_t*)(P.ws + WS_Y), (const bf16_t*)(P.ws + WS_WOUT) + (size_t)l * D * D, D, D};
            pg8::StaticOrder<1> S; S.init(mrows / 256, 4, P.G, P.bid);
            EpiOut E{(bf16_t*)(P.ws + WS_T)};
            pg8::gemm_phase(P.lds, P.tid, Pr, S, E); if (NREP(PHTY) == 2) { __syncthreads(); pg8::gemm_phase(P.lds, P.tid, Pr, S, E); }
            SEAM(g0 + 5);
        }
        if (RUNP(7, g0 + 6)) { LAUNDER(P); for (int rep_ = 0; rep_ < NREP(7); ++rep_) phase_ln1_router(P, l, mrows); SEAM(g0 + 6); }
        if (RUNP(8, g0 + 7)) { LAUNDER(P); for (int rep_ = 0; rep_ < NREP(8); ++rep_) phase_slots(P, mrows); SEAM(g0 + 7); }
        if (RUNP(9, g0 + 8)) {
#undef PHTY
#define PHTY 9
            LAUNDER(P);
            LAS int* seg = (LAS int*)(P.lds + TAB_OFF);
            const int ntile = moe_tables(P, seg);
            ProbMoe1 Pr{(const bf16_t*)(P.ws + WS_H2F8), (const bf16_t*)(P.ws + WS_WGU + (size_t)l * NEXP * 2048 * D), D / 2, D / 2, (const int*)(P.ws + WS_ROUTE + RT_TOK), seg};
            pg8::StaticOrder<1> S; S.init(ntile, 8, P.G, P.bid);
            EpiSwiglu E{(unsigned char*)(P.ws + WS_HID), P.in[IN_BGU] + (size_t)l * NEXP * 2048, seg};
            pg8::gemm_phase(P.lds, P.tid, Pr, S, E); if (NREP(PHTY) == 2) { __syncthreads(); pg8::gemm_phase(P.lds, P.tid, Pr, S, E); }
            SEAM(g0 + 8);
        }
        if (RUNP(10, g0 + 9)) {
#undef PHTY
#define PHTY 10
            LAUNDER(P);
            LAS int* seg = (LAS int*)(P.lds + TAB_OFF);
            const int ntile = moe_tables(P, seg);
            ProbMoe2 Pr{(const bf16_t*)(P.ws + WS_HID), (const bf16_t*)(P.ws + WS_WDN + (size_t)l * NEXP * D * D), D / 2, D / 2, seg};
            pg8::StaticOrder<1> S; S.init(ntile, 4, P.G, P.bid);
            EpiDown E{(unsigned char*)(P.ws + WS_FS), P.in[IN_BDN] + (size_t)l * NEXP * D, (const int*)(P.ws + WS_ROUTE + RT_DEST), (const float*)(P.ws + WS_ROUTE + RT_PSLOT), seg};
            pg8::gemm_phase(P.lds, P.tid, Pr, S, E); if (NREP(PHTY) == 2) { __syncthreads(); pg8::gemm_phase(P.lds, P.tid, Pr, S, E); }
            SEAM(g0 + 9);
        }
        if (RUNP(11, g0 + 10)) { LAUNDER(P); phase_combine_ln2(P, l, mrows); SEAM(g0 + 10); }
    }
#undef LAUNDER
#undef RUN
#undef RUNP
#undef SEAM
}

extern "C" void kernel_launch(void* const* d_in, const int* in_sizes, int n_in, void* d_out, int out_size, void* d_ws, size_t ws_size, hipStream_t stream) {
    static int grid = 0;
    if (grid == 0) {
        if (n_in != 31 || out_size != ML * D || ws_size < WS_END) { fprintf(stderr, "kernel_launch: unexpected problem (n_in %d, out %d, ws %zu, need %zu)\n", n_in, out_size, ws_size, (size_t)WS_END); grid = -1; return; }
        int dev = 0, cus = 0, per_cu = 0;
        if (hipGetDevice(&dev) != hipSuccess || hipDeviceGetAttribute(&cus, hipDeviceAttributeMultiprocessorCount, dev) != hipSuccess) { grid = -1; return; }
        if (hipFuncSetAttribute((const void*)fwd_kernel, hipFuncAttributeMaxDynamicSharedMemorySize, LDS_BYTES) != hipSuccess) { fprintf(stderr, "kernel_launch: hipFuncSetAttribute failed\n"); grid = -1; return; }
        if (hipOccupancyMaxActiveBlocksPerMultiprocessor(&per_cu, (const void*)fwd_kernel, NTHREADS, LDS_BYTES) != hipSuccess || per_cu < 1) fprintf(stderr, "kernel_launch: occupancy query reports %d\n", per_cu);
        (void)hipGetLastError();
        grid = cus;
    }
    if (grid < 0) return;
    (void)hipMemsetAsync((char*)d_ws + WS_CTL, 0, CTL_ZERO_BYTES, stream);
    Args a{};
    for (int i = 0; i < 31; ++i) a.in[i] = (const float*)d_in[i];
    a.out = (float*)d_out; a.ws = (unsigned char*)d_ws;
#if MK_N_LAUNCHES == 1
    a.g_lo = 0; a.g_hi = NGID;
    hipLaunchKernelGGL(fwd_kernel, dim3(grid), dim3(NTHREADS), LDS_BYTES, stream, a);
#else
    for (int g = 0; g < NGID; ++g) { a.g_lo = g; a.g_hi = g + 1; hipLaunchKernelGGL(fwd_kernel, dim3(grid), dim3(NTHREADS), LDS_BYTES, stream, a); }
#endif
}
```

```cpp
#include <hip/hip_runtime.h>
#include <cstdio>
#include <cstdint>

#ifndef MK_N_LAUNCHES
#define MK_N_LAUNCHES 1
#endif

#define LAS __attribute__((address_space(3)))
#define GAS __attribute__((address_space(1)))
typedef unsigned short bf16_t;
typedef short bf16x8 __attribute__((ext_vector_type(8)));
typedef short s16x4 __attribute__((ext_vector_type(4)));
typedef float f32x4 __attribute__((ext_vector_type(4)));
typedef float f32x2 __attribute__((ext_vector_type(2)));
typedef float f32x16 __attribute__((ext_vector_type(16)));
typedef unsigned u32x4 __attribute__((ext_vector_type(4)));
typedef unsigned u32x2 __attribute__((ext_vector_type(2)));
typedef int i32x4 __attribute__((ext_vector_type(4)));
typedef int i32x8 __attribute__((ext_vector_type(8)));

constexpr int D = 1024, NB = 16, SEQ = 4096, CTXL = 256, DEPTH = 4;
constexpr int ML = NB * SEQ;
constexpr int MC = NB * CTXL;
constexpr int MT = ML + MC;
constexpr int NZ = 5888;
constexpr int ZC_P = 0, ZC_QK = 256, ZC_V = 1280, ZC_O = 1792, ZC_UV = 2304, ZC_MG = 2816;
constexpr int NZ_BF = 2816, NZ_F8 = 3072;
constexpr int NEXP = 32, TOPK = 4;
constexpr int NS_MAX = MT * TOPK + NEXP * 256;
constexpr float LN_EPS = 1e-5f, HEAD_EPS = 1e-6f;
constexpr float DN_ALPHA = 1.6817928305074292f;
constexpr int NWAVES = 8, NTHREADS = 512;
constexpr float F8S_ACT = 4.0f, F8S_WGU = 64.0f, F8S_WDN = 64.0f; constexpr int F8E_ACT = 123, F8E_WGU = 123, F8E_WDN = 123;

constexpr size_t MiB = 1u << 20;
constexpr size_t WS_CTL = 0, CTL_ZERO_BYTES = 1 * MiB;
constexpr size_t WS_MOD = 1 * MiB;
constexpr size_t WS_WG = 3 * MiB;
constexpr size_t WS_WSGU = 4 * MiB;
constexpr size_t WS_WPOOL = WS_WSGU + 512 * 1024;
constexpr size_t WS_ROUTE = 5 * MiB;
constexpr size_t WS_WIN = 16 * MiB;
constexpr size_t WS_WBR = 62 * MiB;
constexpr size_t WS_WOUT = 70 * MiB;
constexpr size_t WS_WGU = 78 * MiB;
constexpr size_t WS_WDN = 590 * MiB;
constexpr size_t WS_X = 846 * MiB;
constexpr size_t WS_H = 1118 * MiB;
constexpr size_t WS_Z = 1254 * MiB;
constexpr size_t WS_FS = WS_Z;
constexpr float G8_SCALE = 255.0f;
constexpr float FS_SCALE = 32.0f, FS_CLAMP = 440.0f;
constexpr size_t WS_BRA = 2036 * MiB;
constexpr size_t WS_HFB = 2172 * MiB;
constexpr size_t WS_Y = 2444 * MiB;
constexpr size_t WS_T = 2580 * MiB;
constexpr size_t WS_H2 = 2852 * MiB;
constexpr size_t WS_HID = 2988 * MiB;
constexpr size_t WS_ZG = 3548 * MiB;
constexpr size_t WS_H2F8 = 3554 * MiB;
constexpr size_t WS_H8 = 3624 * MiB;
constexpr size_t WS_WIN8 = 3692 * MiB;
constexpr size_t WS_END = 3704 * MiB;
static_assert(WS_Z + (size_t)MT * NZ * 2 <= WS_BRA && WS_FS + (size_t)MT * 4 * 1024 * 2 <= WS_BRA, "Z/FS");
static_assert(WS_HID + (size_t)NS_MAX * 1024 * 2 <= WS_END, "HID");
constexpr size_t RT_EIDX = 0;
constexpr size_t RT_PROB = 2 * MiB;
constexpr size_t RT_TOK = 4 * MiB;
constexpr size_t RT_DEST = 6 * MiB;
constexpr size_t RT_PSLOT = 8 * MiB;
constexpr size_t RT_CNT = 10 * MiB;
constexpr size_t RT_SEG = 10 * MiB + 64 * 1024;
constexpr int CW_BAR = 4096;

constexpr int LDS_BYTES = 163840;
constexpr int MISC_OFF = LDS_BYTES - 256;
constexpr int TAB_OFF = 131072;
constexpr int NW_WT = 0;
constexpr int NW_LG = 66048;
constexpr int NW_END = 99840;
constexpr int NW_PV = NW_END + 256;

__device__ __forceinline__ unsigned f2bf(float f) { unsigned u = __builtin_bit_cast(unsigned, f); return (u + 0x7fffu + ((u >> 16) & 1u)) >> 16; }
__device__ __forceinline__ unsigned pk2(float lo, float hi) { unsigned r; asm volatile("v_cvt_pk_bf16_f32 %0, %1, %2" : "=v"(r) : "v"(lo), "v"(hi)); return r; }
__device__ __forceinline__ unsigned pk4_fp8(float a, float b, float c, float d) { int w = 0; w = __builtin_amdgcn_cvt_pk_fp8_f32(a, b, w, false); w = __builtin_amdgcn_cvt_pk_fp8_f32(c, d, w, true); return (unsigned)w; }
__device__ __forceinline__ unsigned pk4_u8(float a, float b, float c, float d) {
    const unsigned lo = __builtin_amdgcn_perm(__builtin_bit_cast(unsigned, b), __builtin_bit_cast(unsigned, a), 0x0c0c0400u), hi = __builtin_amdgcn_perm(__builtin_bit_cast(unsigned, d), __builtin_bit_cast(unsigned, c), 0x0c0c0400u);
    return lo | (hi << 16); }
__device__ __forceinline__ f32x4 u8x4_f32(unsigned w) { return (f32x4){(float)(w & 0xffu), (float)((w >> 8) & 0xffu), (float)((w >> 16) & 0xffu), (float)(w >> 24)}; }
__device__ __forceinline__ float bflo(unsigned w) { return __builtin_bit_cast(float, w << 16); }
__device__ __forceinline__ float bfhi(unsigned w) { return __builtin_bit_cast(float, w & 0xffff0000u); }
__device__ __forceinline__ float bf1(bf16_t h) { return __builtin_bit_cast(float, ((unsigned)h) << 16); }
__device__ __forceinline__ float bperm(int srclane, float v) { return __builtin_bit_cast(float, __builtin_amdgcn_ds_bpermute(srclane << 2, __builtin_bit_cast(int, v))); }
__device__ __forceinline__ float shx(float v, int o, int lane) { return bperm(lane ^ o, v); }
__device__ __forceinline__ float shup(float v, int o, int lane) { return bperm(lane >= o ? lane - o : lane, v); }
__device__ __forceinline__ float wave_sum(float v, int lane) {
#pragma unroll
    for (int o = 1; o < 64; o <<= 1) v += shx(v, o, lane);
    return v;
}
__device__ __forceinline__ float sigmoidf_(float x) { return __builtin_amdgcn_rcpf(1.0f + __builtin_amdgcn_exp2f(x * -1.4426950408889634f)); }
__device__ __forceinline__ float siluf_(float x) { return x * __builtin_amdgcn_rcpf(1.0f + __builtin_amdgcn_exp2f(x * -1.4426950408889634f)); }
#define LDS_WAIT() asm volatile("s_waitcnt lgkmcnt(0)" ::: "memory")
#define VM_WAIT() asm volatile("s_waitcnt vmcnt(0)" ::: "memory")

#define XB_TMO      128
#define XB_XCNT(j)  (256  + 64 * (j))
#define XB_XSUB(j)  (1280 + 64 * (j))
#define XB_XGEN(j)  (2304 + 64 * (j))
#define XB_TOP      3328
#define XB_TOPGEN   3392
#define XCD_BAR_WORDS 3456
#define XB_SPIN_CAP (1u << 18)
__device__ __forceinline__ unsigned xb_ld(unsigned* p)              { asm volatile("" : "+v"(p)); return __hip_atomic_load(p, __ATOMIC_RELAXED, __HIP_MEMORY_SCOPE_AGENT); }
__device__ __forceinline__ unsigned xb_add(unsigned* p, unsigned v) { asm volatile("" : "+v"(p), "+v"(v)); return __hip_atomic_fetch_add(p, v, __ATOMIC_RELAXED, __HIP_MEMORY_SCOPE_AGENT); }
__device__ __forceinline__ unsigned xb_xcc_id() { return (unsigned)__builtin_amdgcn_s_getreg((3 << 11) | 20) & 0xFu; }
#define XB_SPIN(cond, bar) do { unsigned _sp = 0; while (cond) { __builtin_amdgcn_s_sleep(1); \
    if ((++_sp & 255u) == 0u) { if (xb_ld(&(bar)[XB_TMO])) break; if (_sp > XB_SPIN_CAP) { atomicAdd(&(bar)[XB_TMO], 1u); break; } } } } while (0)
struct XcdBarrier { unsigned* bar; unsigned x; volatile LAS unsigned* st; };
__device__ __forceinline__ XcdBarrier xcd_barrier_post(unsigned* bar, volatile LAS unsigned* st) {
    XcdBarrier b; b.bar = bar; b.x = xb_xcc_id(); b.st = st;
    if (threadIdx.x == 0) (void)xb_add(&bar[XB_XCNT(b.x)], 1u);
    return b;
}
__device__ __forceinline__ void xcd_barrier_complete(unsigned* bar, unsigned x, unsigned& nloc, unsigned& nx) {
    const unsigned G = gridDim.x * gridDim.y * gridDim.z;
    unsigned sum, cnt, mine, sp = 0u;
    for (;;) {
        sum = 0u; cnt = 0u; mine = 0u;
#pragma unroll
        for (unsigned j = 0; j < 16; ++j) { const unsigned c = xb_ld(&bar[XB_XCNT(j)]); sum += c; cnt += (c > 0u) ? 1u : 0u; mine = (j == x) ? c : mine; }
        if (sum == G) break;
        __builtin_amdgcn_s_sleep(1);
        if ((++sp & 255u) == 0u) { if (xb_ld(&bar[XB_TMO])) break; if (sp > XB_SPIN_CAP) { atomicAdd(&bar[XB_TMO], 1u); break; } }
    }
    nloc = mine > 0u ? mine : 1u; nx = cnt > 0u ? cnt : 1u;
}
__device__ __forceinline__ void xcd_barrier(const XcdBarrier& b) {
    asm volatile("s_waitcnt vmcnt(0)" ::: "memory");
    __syncthreads();
    if (threadIdx.x == 0) {
        unsigned* bar = b.bar;
        __builtin_amdgcn_s_waitcnt(0);
        unsigned nloc = b.st[0], nx = b.st[1];
        if (nloc == 0u) { xcd_barrier_complete(bar, b.x, nloc, nx); b.st[0] = nloc; b.st[1] = nx; }
        const unsigned old = xb_add(&bar[XB_XSUB(b.x)], 1u);
        const unsigned gen = old / nloc;
        if (old + 1u == (gen + 1u) * nloc) {
            __builtin_amdgcn_fence(__ATOMIC_RELEASE, "agent");
            asm volatile("s_waitcnt vmcnt(0)" ::: "memory");
            const unsigned og = xb_add(&bar[XB_TOP], 1u);
            const unsigned tg = og / nx;
            if (og + 1u == (tg + 1u) * nx) xb_add(&bar[XB_TOPGEN], 1u);
            else XB_SPIN(xb_ld(&bar[XB_TOPGEN]) == tg, bar);
            __builtin_amdgcn_fence(__ATOMIC_ACQUIRE, "agent");
            xb_add(&bar[XB_XGEN(b.x)], 1u);
            asm volatile("s_waitcnt vmcnt(0)" ::: "memory");
        } else {
            XB_SPIN(xb_ld(&bar[XB_XGEN(b.x)]) == gen, bar);
            __builtin_amdgcn_fence(__ATOMIC_ACQUIRE, "agent");
            asm volatile("s_waitcnt vmcnt(0)" ::: "memory");
        }
    }
    __syncthreads();
}

namespace pg8 {
constexpr int BM = 256, BK = 64, HALF = 128, HTB = HALF * BK * 2, STAGE_BYTES = 8 * HTB, NXCD = 8, WGM = 8;
__host__ __device__ __forceinline__ int lds_byte(int r, int c) { const int st = (r >> 4) * 2 + (c >> 5), rr = r & 15, cc = c & 31, ob = rr * 64 + cc * 2; return st * 1024 + (ob ^ (((ob >> 9) & 1) << 5)); }
__host__ __device__ __forceinline__ void stage_rc(int b, int& R, int& C) { const int st = b / 1024, sb = b % 1024, swz = sb ^ (((sb >> 9) & 1) << 5); R = (st >> 1) * 16 + swz / 64; C = (st & 1) * 32 + (swz % 64) / 2; }
__host__ __device__ __forceinline__ int perm32(int rho) { const int n = rho >> 4, i = rho & 15; return 8 * (i >> 2) + 4 * n + (i & 3); }
struct Unit { int pm, pn, sub; };
__device__ __forceinline__ unsigned cvt_pk_bf16(float lo, float hi) { unsigned r; asm volatile("v_cvt_pk_bf16_f32 %0, %1, %2" : "=v"(r) : "v"(lo), "v"(hi)); return r; }
__device__ __forceinline__ f32x2 gelu_pk(f32x2 v) {
    const f32x2 av = __builtin_elementwise_abs(v), d = av * 0.2316418882f + 1.0f;
    f32x2 t; t.x = __builtin_amdgcn_rcpf(d.x); t.y = __builtin_amdgcn_rcpf(d.y);
    f32x2 q = t * 0.5307027145f + (-0.7265760135f); q = q * t + 0.7107068705f; q = q * t + (-0.142248368f); q = q * t + 0.127414796f; q = q * t;
    const f32x2 s = (v * v) * (-0.72134752044f);
    f32x2 e; e.x = __builtin_amdgcn_exp2f(s.x); e.y = __builtin_amdgcn_exp2f(s.y);
    const f32x2 m = v * (q * e), r = v - m;
    f32x2 o; o.x = v.x < 0.f ? m.x : r.x; o.y = v.y < 0.f ? m.y : r.y; return o;
}
template <int NSUB = 1> struct StaticOrder {
    int nM, nN, nwg, G, c;
    __device__ void init(int nM_, int nN_, int G_, int c_) { nM = nM_; nN = nN_; nwg = nM * nN; G = G_; c = c_; }
    __device__ bool next(int i, Unit& u) const {
        const int it = i / NSUB; u.sub = i - it * NSUB;
        const long L = (long)it * G + c; if (L >= nwg) return false;
        int wgid = (int)L; { const int q = nwg / NXCD, r = nwg % NXCD, xcd = wgid % NXCD, off = wgid / NXCD; wgid = (xcd < r ? xcd * (q + 1) : r * (q + 1) + (xcd - r) * q) + off; }
        const int nig = WGM * nN, gid = wgid / nig, fm = gid * WGM, gsz = (nM - fm) < WGM ? (nM - fm) : WGM;
        u.pm = fm + ((wgid % nig) % gsz); u.pn = (wgid % nig) / gsz; return true;
    }
};
constexpr int SIDE_TOK = 131072 + 2048;
constexpr int SIDE_SLOT = 131072 + 10240, SIDE_SLOT_BYTES = 3072;
__device__ __forceinline__ void dma16(unsigned voff, const void* sbase, unsigned ldsaddr) { asm volatile("s_mov_b32 m0, %2\n\tglobal_load_lds_dwordx4 %0, %1" :: "v"(voff), "s"(sbase), "s"(ldsaddr) : "memory", "m0"); }
__device__ __forceinline__ void dma4(unsigned voff, const void* sbase, unsigned ldsaddr) { asm volatile("s_mov_b32 m0, %2\n\tglobal_load_lds_dword %0, %1" :: "v"(voff), "s"(sbase), "s"(ldsaddr) : "memory", "m0"); }
template <class Prob, class Sched, class Epi>
__device__ __forceinline__ void gemm_phase(LAS unsigned char* lds, const int tid, const Prob& P, const Sched& S, const Epi& E) {
    const int wid = __builtin_amdgcn_readfirstlane(tid >> 6), lane = tid & 63, wr = wid >> 2, wc = wid & 3, fr = lane & 15, fq = lane >> 4;
    const int lda = P.lda, ldb = P.ldb;
    unsigned voffB[2], offA[2][2];
#define PG8_TOKSLOT(name) const LAS int* name; { PG8_TID(tl2_); name = (const LAS int*)(lds + SIDE_TOK) + (tl2_ >> 6) * 256 + (tl2_ & 63); }
#define PG8_TID(v_) int v_; asm volatile("v_mbcnt_lo_u32_b32 %0, -1, 0\n\tv_mbcnt_hi_u32_b32 %0, -1, %0" : "=v"(v_)); v_ |= (wid << 6)
#define PG8_RC(R_, C_) int R_[2], C_[2]; { PG8_TID(tl_); _Pragma("unroll") for (int i_ = 0; i_ < 2; ++i_) stage_rc(tl_ * 16 + i_ * 8192, R_[i_], C_[i_]); }
#pragma unroll
    for (int i = 0; i < 2; ++i) { int R, C; stage_rc(tid * 16 + i * 8192, R, C); const int Rb = Epi::PERM ? ((R & ~31) + perm32(R & 31)) : R;
        voffB[i] = (unsigned)(Rb * ldb + C) * 2u;
        offA[0][i] = (unsigned)(R * lda + C) * 2u; offA[1][i] = (unsigned)((R + HALF) * lda + C) * 2u; }
    const size_t kstep = (size_t)(BK * 2);
    const size_t hstep = (size_t)HALF * ldb * 2;
    const unsigned ldsw = (unsigned)wid * 1024u;
    const int aoff = lds_byte(wr * 64 + fr, fq * 8), boff = lds_byte(wc * 32 + fr, fq * 8);
#define PG8_SA(b, h) (((b) * 2 + (h)) * HTB)
#define PG8_SB(b, h) ((4 + (b) * 2 + (h)) * HTB)
    const unsigned ldsb = (unsigned)(size_t)lds;
#define PG8_STAGE(bufoff, gbase, voff) do { _Pragma("unroll") for (int _i = 0; _i < 2; ++_i) \
        asm volatile("s_mov_b32 m0, %2\n\tglobal_load_lds_dwordx4 %0, %1" :: "v"((voff)[_i]), "s"((const char*)(gbase)), "s"(ldsb + (unsigned)(bufoff) + ldsw + (unsigned)(_i * 8192)) : "memory", "m0"); } while (0)
#define PG8_CAT(x0, x1) __builtin_shufflevector(x0, x1, 0, 1, 2, 3, 4, 5, 6, 7)
#define PG8_LDA(dst, b, h) do { if constexpr (Prob::FP8) { _Pragma("unroll") for (int m = 0; m < 4; ++m) dst##8[m] = PG8_CAT(*(const LAS i32x4*)(lds + PG8_SA(b, h) + aoff + m * 2048), *(const LAS i32x4*)(lds + PG8_SA(b, h) + aoff + m * 2048 + 1024)); } \
        else { _Pragma("unroll") for (int m = 0; m < 4; ++m) _Pragma("unroll") for (int k = 0; k < 2; ++k) dst[m][k] = *(const LAS bf16x8*)(lds + PG8_SA(b, h) + aoff + m * 2048 + k * 1024); } } while (0)
#define PG8_LDB(dst, b, h) do { if constexpr (Prob::FP8) { _Pragma("unroll") for (int n = 0; n < 2; ++n) dst##8[n] = PG8_CAT(*(const LAS i32x4*)(lds + PG8_SB(b, h) + boff + n * 2048), *(const LAS i32x4*)(lds + PG8_SB(b, h) + boff + n * 2048 + 1024)); } \
        else { _Pragma("unroll") for (int n = 0; n < 2; ++n) _Pragma("unroll") for (int k = 0; k < 2; ++k) dst[n][k] = *(const LAS bf16x8*)(lds + PG8_SB(b, h) + boff + n * 2048 + k * 1024); } } while (0)
#define PG8_MMA(ai, bj, At, Bt) do { __builtin_amdgcn_s_setprio(1); \
        if constexpr (Prob::FP8) { _Pragma("unroll") for (int m = 0; m < 4; ++m) _Pragma("unroll") for (int n = 0; n < 2; ++n) \
            acc[ai][bj][m][n] = __builtin_amdgcn_mfma_scale_f32_16x16x128_f8f6f4(Bt##8[n], At##8[m], acc[ai][bj][m][n], 0, 0, 0, sc8_, 0, sc8_); } \
        else { _Pragma("unroll") for (int m = 0; m < 4; ++m) _Pragma("unroll") for (int n = 0; n < 2; ++n) _Pragma("unroll") for (int k = 0; k < 2; ++k) \
            acc[ai][bj][m][n] = __builtin_amdgcn_mfma_f32_16x16x32_bf16(Bt[n][k], At[m][k], acc[ai][bj][m][n], 0, 0, 0); } \
        __builtin_amdgcn_s_setprio(0); } while (0)
#define PG8_WAIT_V(n) asm volatile("s_waitcnt vmcnt(" #n ")" ::: "memory")
#define PG8_WAIT_L(n) asm volatile("s_waitcnt lgkmcnt(" #n ")" ::: "memory")
#define PG8_BAR __builtin_amdgcn_s_barrier()
#define PG8_SCHED __builtin_amdgcn_sched_barrier(0)
    Unit cur, nxt; int ui = 0;
    if (!S.next(0, cur)) return;
    static_assert(Prob::SCALE_A == Prob::SCALE_B, "one scale register serves both operands");
    int sc8_; asm volatile("v_mov_b32 %0, %1" : "=v"(sc8_) : "n"(Prob::SCALE_A));
    f32x4 acc[2][2][4][2];
    float zero_; asm volatile("v_mov_b32 %0, 0" : "=v"(zero_));
#pragma unroll
    for (int a = 0; a < 2; ++a)
#pragma unroll
        for (int b = 0; b < 2; ++b)
#pragma unroll
            for (int m = 0; m < 4; ++m)
#pragma unroll
                for (int n = 0; n < 2; ++n) acc[a][b][m][n] = (f32x4){zero_, zero_, zero_, zero_};
    bf16x8 At[4][2], B0[2][2], B1[2][2]; i32x8 At8[4], B08[2], B18[2];
    const char* cA = P.a_base(cur); const char* cB = P.b_base(cur); int nt = P.nt(cur);
    if constexpr (Prob::GATHER) { PG8_RC(Rr, Cc); P.a_rows(cur, Rr, Cc, offA); }
    if constexpr (Epi::SIDE) { PG8_TID(tl4_); E.side(cur, ldsb + SIDE_SLOT, wid, tl4_ & 63); }
    PG8_STAGE(PG8_SB(0, 0), cB, voffB); PG8_STAGE(PG8_SB(0, 1), cB + hstep, voffB); PG8_STAGE(PG8_SA(0, 0), cA, offA[0]); PG8_STAGE(PG8_SA(0, 1), cA, offA[1]);
    if (wr == 1) PG8_BAR;
    PG8_WAIT_V(2); PG8_BAR;
    PG8_STAGE(PG8_SB(1, 0), cB + kstep, voffB); PG8_STAGE(PG8_SA(1, 0), cA + kstep, offA[0]); PG8_STAGE(PG8_SB(1, 1), cB + hstep + kstep, voffB);
    PG8_WAIT_V(6); PG8_BAR;
    for (;;) {
        const bool has_next = S.next(ui + 1, nxt);
        const char* nA = has_next ? P.a_base(nxt) : cA; const char* nB = has_next ? P.b_base(nxt) : cB;
        if constexpr (Prob::GATHER) { if (has_next) { PG8_RC(Rr, Cc); (void)Cc;
#pragma unroll
            for (int h = 0; h < 2; ++h)
#pragma unroll
                for (int i = 0; i < 2; ++i) dma4((unsigned)(nxt.pm * 256 + h * 128 + Rr[i]) * 4u, P.tok, ldsb + SIDE_TOK + (unsigned)wid * 1024u + (unsigned)((h * 2 + i) * 256)); } }
        if constexpr (Epi::SIDE) { if (has_next) { PG8_TID(tl4_); E.side(nxt, ldsb + SIDE_SLOT + (unsigned)(((ui + 1) % 3) * SIDE_SLOT_BYTES), wid, tl4_ & 63); } }
        for (int t = 0; t < nt; t += 2) {
            const bool last = (t == nt - 2);
            if constexpr (Epi::KHOOK) { if (t == Epi::HOOK_T0 || t == Epi::HOOK_T1) {
                asm volatile("" ::: "memory"); PG8_TID(tlh_); const int lnh_ = tlh_ & 63; E.hook(acc, cur, t == Epi::HOOK_T0 ? 0 : 1, wr, wc, lnh_ & 15, lnh_ >> 4); asm volatile("" ::: "memory"); } }
            const char* a1 = cA + (size_t)(t + 1) * kstep;
            const char* a2 = last ? nA : cA + (size_t)(t + 2) * kstep; const char* b2 = last ? nB : cB + (size_t)(t + 2) * kstep;
            const char* a3 = a2 + kstep; const char* b3 = b2 + kstep;
            PG8_LDB(B0, 0, 0); PG8_LDB(B1, 0, 1); PG8_SCHED; PG8_LDA(At, 0, 0); PG8_STAGE(PG8_SA(1, 1), a1, offA[1]);
            PG8_WAIT_V(8); PG8_WAIT_L(0); PG8_BAR; PG8_MMA(0, 0, At, B0); PG8_MMA(0, 1, At, B1); PG8_BAR; PG8_SCHED;
            if constexpr (Prob::GATHER) { if (last && has_next) { PG8_RC(Rr, Cc); (void)Rr; PG8_TOKSLOT(tokslot); const int ntok[2][2] = {{tokslot[0], tokslot[64]}, {tokslot[128], tokslot[192]}}; P.a_off(ntok, Cc, offA); } }
            PG8_LDA(At, 0, 1); PG8_STAGE(PG8_SB(0, 0), b2, voffB); PG8_STAGE(PG8_SB(0, 1), b2 + hstep, voffB); PG8_STAGE(PG8_SA(0, 0), a2, offA[0]);
            PG8_WAIT_V(8); PG8_WAIT_L(0); PG8_BAR; PG8_MMA(1, 0, At, B0); PG8_MMA(1, 1, At, B1); PG8_BAR; PG8_SCHED;
            PG8_LDB(B0, 1, 0); PG8_LDB(B1, 1, 1); PG8_SCHED; PG8_LDA(At, 1, 0); PG8_STAGE(PG8_SA(0, 1), a2, offA[1]);
            PG8_WAIT_V(8); PG8_WAIT_L(0); PG8_BAR; PG8_MMA(0, 0, At, B0); PG8_MMA(0, 1, At, B1); PG8_BAR; PG8_SCHED;
            PG8_LDA(At, 1, 1); PG8_STAGE(PG8_SB(1, 0), b3, voffB); PG8_STAGE(PG8_SB(1, 1), b3 + hstep, voffB); PG8_STAGE(PG8_SA(1, 0), a3, offA[0]);
            PG8_WAIT_V(8); PG8_WAIT_L(0); PG8_BAR; PG8_MMA(1, 0, At, B0); PG8_MMA(1, 1, At, B1); PG8_BAR; PG8_SCHED;
        }
        if (wr == 0) PG8_BAR;
        { PG8_TID(tl3_); const int ln_ = tl3_ & 63; E(acc, cur, wr, wc, ln_ & 15, ln_ >> 4, lds + SIDE_SLOT + (ui % 3) * SIDE_SLOT_BYTES); }
        if (!has_next) break;
        bool keep = false;
        if constexpr (Epi::CHAIN) keep = E.keep(cur);
        if (!keep) {
            asm volatile("v_mov_b32 %0, 0" : "=v"(zero_));
#pragma unroll
            for (int a = 0; a < 2; ++a)
#pragma unroll
                for (int b = 0; b < 2; ++b)
#pragma unroll
                    for (int m = 0; m < 4; ++m)
#pragma unroll
                        for (int n = 0; n < 2; ++n) acc[a][b][m][n] = (f32x4){zero_, zero_, zero_, zero_};
        }
        cur = nxt; cA = nA; cB = nB; nt = P.nt(cur); ++ui;
        if (wr == 1) PG8_BAR;
    }
    PG8_WAIT_V(0);
    PG8_BAR;
#undef PG8_RC
#undef PG8_TID
#undef PG8_TOKSLOT
#undef PG8_SA
#undef PG8_SB
#undef PG8_STAGE
#undef PG8_LDA
#undef PG8_LDB
#undef PG8_MMA
#undef PG8_CAT
#undef PG8_WAIT_V
#undef PG8_WAIT_L
#undef PG8_BAR
#undef PG8_SCHED
}
}

typedef const float* cfp_t;
typedef const cfp_t __attribute__((address_space(4))) * InTab;
struct Frame {
    LAS unsigned char* lds;
    volatile LAS unsigned* MISC;
    unsigned char* ws;
    InTab in;
    float* out;
    int tid, lane, wave, G, bid;
};
enum { IN_X = 0, IN_C, IN_CTX, IN_CCTX, IN_WADA, IN_BADA, IN_WIN, IN_BIN, IN_POOLW, IN_POOLS, IN_CONVW, IN_CONVB, IN_MNG, IN_SLNG, IN_SLNB, IN_SGUW, IN_SGUB,
       IN_WBP, IN_WBM, IN_WBS, IN_WOUT, IN_LN1G, IN_LN1B, IN_WR, IN_BR, IN_WGU, IN_BGU, IN_WDN, IN_BDN, IN_LN2G, IN_LN2B };
__device__ __forceinline__ int mod_row(int row) { return row < ML ? (row >> 12) : NB; }
__device__ __forceinline__ const float* modp(const Frame& F, int l, int row, int part) { return (const float*)(F.ws + WS_MOD) + ((size_t)(l * 17 + mod_row(row)) * 6 + part) * 1024; }

__device__ __forceinline__ void transpose_item(const float* W, size_t ldw, int k0, int srccol0, bf16_t* dst, size_t ldk, int kd0, LAS float* scr, int lane) {
#pragma unroll 8
    for (int i = 0; i < 32; ++i) { const int kk = 2 * i + (lane >> 5); scr[kk * 33 + (lane & 31)] = __builtin_nontemporal_load(W + (size_t)(k0 + kk) * ldw + srccol0 + (lane & 31)); }
    LDS_WAIT(); asm volatile("" ::: "memory");
    const int c = lane & 7;
#pragma unroll
    for (int j = 0; j < 4; ++j) { const int n = (lane >> 3) + 8 * j; const LAS float* s = scr + (8 * c) * 33 + n;
        u32x4 o; o.x = pk2(s[0 * 33], s[1 * 33]); o.y = pk2(s[2 * 33], s[3 * 33]); o.z = pk2(s[4 * 33], s[5 * 33]); o.w = pk2(s[6 * 33], s[7 * 33]);
        *(u32x4*)(dst + (size_t)n * ldk + kd0 + 8 * c) = o; }
    LDS_WAIT(); asm volatile("" ::: "memory");
}
__device__ __forceinline__ void transpose_item_fp8(const float* W, size_t ldw, int k0, int srccol0, unsigned char* dst, size_t ldk, int kd0, float sc, LAS float* scr, int lane) {
#pragma unroll 8
    for (int i = 0; i < 32; ++i) { const int kk = 2 * i + (lane >> 5); scr[kk * 33 + (lane & 31)] = __builtin_nontemporal_load(W + (size_t)(k0 + kk) * ldw + srccol0 + (lane & 31)); }
    LDS_WAIT(); asm volatile("" ::: "memory");
    const int c = lane & 7;
#pragma unroll
    for (int j = 0; j < 4; ++j) { const int n = (lane >> 3) + 8 * j; const LAS float* s_ = scr + (8 * c) * 33 + n;
        u32x2 o; o.x = pk4_fp8(s_[0 * 33] * sc, s_[1 * 33] * sc, s_[2 * 33] * sc, s_[3 * 33] * sc); o.y = pk4_fp8(s_[4 * 33] * sc, s_[5 * 33] * sc, s_[6 * 33] * sc, s_[7 * 33] * sc);
        *(u32x2*)(dst + (size_t)n * ldk + kd0 + 8 * c) = o; }
    LDS_WAIT(); asm volatile("" ::: "memory");
}
__device__ __forceinline__ void phase_prologue(Frame& F) {
    LAS float* scr = (LAS float*)(F.lds + F.wave * 16384);
    const int gw = F.bid * NWAVES + F.wave, NGW = F.G * NWAVES;
    constexpr int I_IN = 16 * (NZ / 32);
    constexpr int I_BR = (4 + 8 + 4) * 32;
    constexpr int I_OUT = 16 * 32;
    constexpr int I_GU = 16 * 64;
    constexpr int I_DN = 16 * 32;
    constexpr int T_IN = DEPTH * I_IN, T_BR = DEPTH * I_BR, T_OUT = DEPTH * I_OUT, T_GU = DEPTH * NEXP * I_GU, T_DN = DEPTH * NEXP * I_DN;
    constexpr int NITEMS = T_IN + T_BR + T_OUT + T_GU + T_DN;
    for (int it = gw; it < NITEMS; it += NGW) {
        int r = it;
        if (r < T_IN) { const int l = r / I_IN; r %= I_IN; const int kb = r / (NZ / 32), nb = r % (NZ / 32); const int n0 = nb * 32, src = n0 < 2304 ? n0 : n0 + 16;
            if (n0 < NZ_BF) transpose_item(F.in[IN_WIN] + (size_t)l * D * 5904, 5904, kb * 64, src, (bf16_t*)(F.ws + WS_WIN) + ((size_t)l * NZ + n0) * D, D, kb * 64, scr, F.lane);
            else transpose_item_fp8(F.in[IN_WIN] + (size_t)l * D * 5904, 5904, kb * 64, src, (unsigned char*)(F.ws + WS_WIN8) + ((size_t)l * NZ_F8 + (n0 - NZ_BF)) * D, D, kb * 64, F8S_WGU, scr, F.lane);
            continue; }
        r -= T_IN;
        if (r < T_BR) { const int l = r / I_BR; r %= I_BR; const int kb = r / 32, nb = r % 32;
            const float* W; int ksrc;
            if (kb < 4) { W = F.in[IN_WBP] + (size_t)l * 256 * D; ksrc = kb * 64; } else if (kb < 12) { W = F.in[IN_WBM] + (size_t)l * 512 * D; ksrc = (kb - 4) * 64; } else { W = F.in[IN_WBS] + (size_t)l * 256 * D; ksrc = (kb - 12) * 64; }
            transpose_item(W, D, ksrc, nb * 32, (bf16_t*)(F.ws + WS_WBR) + ((size_t)l * D + nb * 32) * D, D, kb * 64, scr, F.lane); continue; }
        r -= T_BR;
        if (r < T_OUT) { const int l = r / I_OUT; r %= I_OUT; const int kb = r / 32, nb = r % 32;
            transpose_item(F.in[IN_WOUT] + (size_t)l * D * D, D, kb * 64, nb * 32, (bf16_t*)(F.ws + WS_WOUT) + ((size_t)l * D + nb * 32) * D, D, kb * 64, scr, F.lane); continue; }
        r -= T_OUT;
        if (r < T_GU) { const int le = r / I_GU; r %= I_GU; const int kb = r / 64, nb = r % 64; const int n0 = nb * 32;
            const int pn = n0 >> 8, c = n0 & 255; const int src = c < 128 ? (128 * pn + c) : (1024 + 128 * pn + c - 128);
            transpose_item_fp8(F.in[IN_WGU] + (size_t)le * D * 2048, 2048, kb * 64, src, (unsigned char*)(F.ws + WS_WGU) + ((size_t)le * 2048 + n0) * D, D, kb * 64, F8S_WGU, scr, F.lane); continue; }
        r -= T_GU;
        { const int le = r / I_DN; r %= I_DN; const int kb = r / 32, nb = r % 32;
            transpose_item_fp8(F.in[IN_WDN] + (size_t)le * D * D, D, kb * 64, nb * 32, (unsigned char*)(F.ws + WS_WDN) + ((size_t)le * D + nb * 32) * D, D, kb * 64, F8S_WDN, scr, F.lane); }
    }
    { const int gt = F.bid * NTHREADS + F.tid, NGT = F.G * NTHREADS;
      for (int i = gt; i < DEPTH * 16 * 1024; i += NGT) { const int l = i >> 14, g = (i >> 10) & 15, k = i & 1023; ((float*)(F.ws + WS_WG))[i] = F.in[IN_WIN][((size_t)l * D + k) * 5904 + 2304 + g]; }
      for (int i = gt; i < DEPTH * 4 * 128 * 128; i += NGT) ((bf16_t*)(F.ws + WS_WSGU))[i] = (bf16_t)f2bf(F.in[IN_SGUW][i]);
      for (int i = gt; i < DEPTH * 4 * 64 * 64; i += NGT) { const int lg = i >> 12, d = (i >> 6) & 63, c = i & 63; ((bf16_t*)(F.ws + WS_WPOOL))[i] = (bf16_t)f2bf(F.in[IN_POOLW][(size_t)lg * 4096 + c * 64 + d]); } }
    __syncthreads();
    { LAS float* sc = (LAS float*)F.lds;
      LAS float* part = (LAS float*)(F.lds + 71680);
      for (int i = F.tid; i < 17 * 1024; i += NTHREADS) { const int r = i >> 10, k = i & 1023; const float v = r < 16 ? F.in[IN_C][r * 1024 + k] : F.in[IN_CCTX][k]; sc[i] = siluf_(v); }
      __syncthreads();
      for (int u = F.bid; u < DEPTH * 48; u += F.G) {
          const int l = u / 48, n0 = (u % 48) * 128, col = F.tid & 127, ks = F.tid >> 7;
          float a[17];
#pragma unroll
          for (int r = 0; r < 17; ++r) a[r] = 0.f;
          const float* W = F.in[IN_WADA] + (size_t)l * D * 6144 + n0 + col;
          for (int k = ks * 256; k < ks * 256 + 256; ++k) { const float w = W[(size_t)k * 6144];
#pragma unroll
              for (int r = 0; r < 17; ++r) a[r] += sc[r * 1024 + k] * w; }
#pragma unroll
          for (int r = 0; r < 17; ++r) part[(ks * 17 + r) * 128 + col] = a[r];
          __syncthreads();
          for (int i = F.tid; i < 17 * 128; i += NTHREADS) { const int r = i >> 7, cc = i & 127;
              const float s = part[(0 * 17 + r) * 128 + cc] + part[(1 * 17 + r) * 128 + cc] + part[(2 * 17 + r) * 128 + cc] + part[(3 * 17 + r) * 128 + cc] + F.in[IN_BADA][l * 6144 + n0 + cc];
              ((float*)(F.ws + WS_MOD))[(size_t)(l * 17 + r) * 6144 + n0 + cc] = s; }
          __syncthreads();
      } }
}

struct RowV { f32x4 v[4]; };
#define RC(lane, j) (8 * (lane) + 512 * ((j) >> 1) + 4 * ((j) & 1))
__device__ __forceinline__ void row_load(RowV& r, const float* p, int lane) {
#pragma unroll
    for (int j = 0; j < 4; ++j) r.v[j] = __builtin_nontemporal_load((const f32x4*)(p + RC(lane, j)));
}
__device__ __forceinline__ void row_load_bf16(RowV& r, const bf16_t* p, int lane) {
#pragma unroll
    for (int h = 0; h < 2; ++h) { const u32x4 w = __builtin_nontemporal_load((const u32x4*)(p + 8 * lane + 512 * h)); r.v[2 * h] = (f32x4){bflo(w.x), bfhi(w.x), bflo(w.y), bfhi(w.y)}; r.v[2 * h + 1] = (f32x4){bflo(w.z), bfhi(w.z), bflo(w.w), bfhi(w.w)}; }
}
__device__ __forceinline__ void row_store(const RowV& r, float* p, int lane) {
#pragma unroll
    for (int j = 0; j < 4; ++j) *(f32x4*)(p + RC(lane, j)) = r.v[j];
}
__device__ __forceinline__ void row_store_nt(const RowV& r, float* p, int lane) {
#pragma unroll
    for (int j = 0; j < 4; ++j) __builtin_nontemporal_store(r.v[j], (f32x4*)(p + RC(lane, j)));
}
__device__ __forceinline__ void row_store_bf16_nt(const RowV& r, bf16_t* p, int lane) {
#pragma unroll
    for (int h = 0; h < 2; ++h) { u32x4 w; w.x = pk2(r.v[2 * h].x, r.v[2 * h].y); w.y = pk2(r.v[2 * h].z, r.v[2 * h].w); w.z = pk2(r.v[2 * h + 1].x, r.v[2 * h + 1].y); w.w = pk2(r.v[2 * h + 1].z, r.v[2 * h + 1].w); __builtin_nontemporal_store(w, (u32x4*)(p + 8 * lane + 512 * h)); }
}
__device__ __forceinline__ void row_store_bf16(const RowV& r, bf16_t* p, int lane) {
#pragma unroll
    for (int h = 0; h < 2; ++h) { u32x4 w; w.x = pk2(r.v[2 * h].x, r.v[2 * h].y); w.y = pk2(r.v[2 * h].z, r.v[2 * h].w); w.z = pk2(r.v[2 * h + 1].x, r.v[2 * h + 1].y); w.w = pk2(r.v[2 * h + 1].z, r.v[2 * h + 1].w); *(u32x4*)(p + 8 * lane + 512 * h) = w; }
}
__device__ __forceinline__ void row_ln_plain(RowV& r, int lane) {
    float s = 0.f;
#pragma unroll
    for (int j = 0; j < 4; ++j) s += (r.v[j].x + r.v[j].y) + (r.v[j].z + r.v[j].w);
    const float mean = wave_sum(s, lane) * (1.f / D); float s2 = 0.f;
#pragma unroll
    for (int j = 0; j < 4; ++j) { r.v[j] = r.v[j] - mean; s2 += (r.v[j].x * r.v[j].x + r.v[j].y * r.v[j].y) + (r.v[j].z * r.v[j].z + r.v[j].w * r.v[j].w); }
    const float rstd = 1.f / sqrtf(wave_sum(s2, lane) * (1.f / D) + LN_EPS);
#pragma unroll
    for (int j = 0; j < 4; ++j) r.v[j] = r.v[j] * rstd;
}
__device__ __forceinline__ void row_affine(RowV& r, const float* g, const float* b, int lane) {
#pragma unroll
    for (int j = 0; j < 4; ++j) { const f32x4 gg = *(const f32x4*)(g + RC(lane, j)), bb = *(const f32x4*)(b + RC(lane, j)); r.v[j] = r.v[j] * gg + bb; }
}
__device__ __forceinline__ void row_modulate(RowV& r, const float* sh, const float* sc, int lane) {
#pragma unroll
    for (int j = 0; j < 4; ++j) { const f32x4 s1 = *(const f32x4*)(sc + RC(lane, j)), s0 = *(const f32x4*)(sh + RC(lane, j)); r.v[j] = r.v[j] * (s1 + 1.0f) + s0; }
}
__device__ __forceinline__ LAS float* pv_slot(const Frame& F, int slot) { return (LAS float*)(F.lds + NW_PV) + slot * 1024; }
__device__ __forceinline__ void pv_fill(Frame& F, int slot, const float* src) { LAS f32x4* d = (LAS f32x4*)pv_slot(F, slot); for (int i = F.tid; i < 256; i += NTHREADS) d[i] = *(const f32x4*)(src + 4 * i); }
__device__ __forceinline__ void row_affine_l(RowV& r, const LAS float* g, const LAS float* b, int lane) {
#pragma unroll
    for (int j = 0; j < 4; ++j) { const f32x4 gg = *(const LAS f32x4*)(g + RC(lane, j)), bb = *(const LAS f32x4*)(b + RC(lane, j)); r.v[j] = r.v[j] * gg + bb; }
}
__device__ __forceinline__ void row_modulate_l(RowV& r, const LAS float* sh, const LAS float* sc, int lane) {
#pragma unroll
    for (int j = 0; j < 4; ++j) { const f32x4 s1 = *(const LAS f32x4*)(sc + RC(lane, j)), s0 = *(const LAS f32x4*)(sh + RC(lane, j)); r.v[j] = r.v[j] * (s1 + 1.0f) + s0; }
}
__device__ __forceinline__ void ln0_row(Frame& F, int row, RowV xr, const LAS float* sh, const LAS float* sc) {
    row_ln_plain(xr, F.lane);
    row_modulate_l(xr, sh, sc, F.lane);
    row_store_bf16(xr, (bf16_t*)(F.ws + WS_H) + (size_t)row * D, F.lane);
    { unsigned char* h8 = (unsigned char*)(F.ws + WS_H8) + (size_t)row * D + 8 * F.lane;
#pragma unroll
      for (int h = 0; h < 2; ++h) { u32x2 w; w.x = pk4_fp8(xr.v[2 * h].x * F8S_ACT, xr.v[2 * h].y * F8S_ACT, xr.v[2 * h].z * F8S_ACT, xr.v[2 * h].w * F8S_ACT); w.y = pk4_fp8(xr.v[2 * h + 1].x * F8S_ACT, xr.v[2 * h + 1].y * F8S_ACT, xr.v[2 * h + 1].z * F8S_ACT, xr.v[2 * h + 1].w * F8S_ACT); *(u32x2*)(h8 + 512 * h) = w; } }
}
__device__ __forceinline__ LAS float* narrow_tile_wave(Frame& F, const bf16_t* A) {
    const int r = F.lane & 31, h = F.lane >> 5;
    f32x16 acc;
#pragma unroll
    for (int i = 0; i < 16; ++i) acc[i] = 0.f;
    const bf16_t* ap = A + (size_t)r * D + 8 * h;
    const LAS unsigned char* bp = F.lds + NW_WT + r * 2064 + 16 * h;
    bf16x8 av[2][16];
#pragma unroll
    for (int ks = 0; ks < 16; ++ks) av[0][ks] = *(const bf16x8*)(ap + ks * 16);
#pragma unroll
    for (int kb = 0; kb < 4; ++kb) {
        if (kb < 3) {
#pragma unroll
            for (int ks = 0; ks < 16; ++ks) av[(kb + 1) & 1][ks] = *(const bf16x8*)(ap + ((kb + 1) * 16 + ks) * 16); }
        __builtin_amdgcn_sched_barrier(0);
#pragma unroll
        for (int ks = 0; ks < 16; ++ks) { const bf16x8 b = *(const LAS bf16x8*)(bp + (kb * 16 + ks) * 32); acc = __builtin_amdgcn_mfma_f32_32x32x16_bf16(av[kb & 1][ks], b, acc, 0, 0, 0); }
        __builtin_amdgcn_sched_barrier(0);
    }
    LAS float* lg = (LAS float*)(F.lds + NW_LG) + F.wave * 1056;
#pragma unroll
    for (int i = 0; i < 16; ++i) lg[((i & 3) + 8 * (i >> 2) + 4 * h) * 33 + r] = acc[i];
    asm volatile("s_waitcnt lgkmcnt(0)" ::: "memory");
    return lg;
}
__device__ __forceinline__ void tile_range(const Frame& F, int mrows, int& t_lo, int& t_hi) { const int nt = mrows / 32; t_lo = (int)(((long)F.bid * nt) / F.G); t_hi = (int)(((long)(F.bid + 1) * nt) / F.G); }
__device__ __forceinline__ void load_wg_lds(Frame& F, int l) {
    const float* src = (const float*)(F.ws + WS_WG) + (size_t)l * 16384;
    for (int i = F.tid; i < 32 * 128; i += NTHREADS) { const int g = i >> 7, c8 = i & 127; u32x4 w = (u32x4){0u, 0u, 0u, 0u};
        if (g < 16) { const f32x4 a = *(const f32x4*)(src + g * 1024 + c8 * 8), b = *(const f32x4*)(src + g * 1024 + c8 * 8 + 4); w.x = pk2(a.x, a.y); w.y = pk2(a.z, a.w); w.z = pk2(b.x, b.y); w.w = pk2(b.z, b.w); }
        *(LAS u32x4*)(F.lds + NW_WT + g * 2064 + c8 * 16) = w; }
    __syncthreads();
}
__device__ __forceinline__ void gates_tail(Frame& F, int l, int t_lo, int t_hi) {
    asm volatile("s_waitcnt vmcnt(0)" ::: "memory"); __syncthreads();
    const int g = F.lane & 15; const float bias = F.in[IN_BIN][l * 5904 + 2304 + g];
    for (int tile = t_lo + F.wave; tile < t_hi; tile += NWAVES) {
        const LAS float* lg = narrow_tile_wave(F, (const bf16_t*)(F.ws + WS_H) + (size_t)tile * 32 * D);
#pragma unroll
        for (int rr = 0; rr < 8; ++rr) { const int row = rr * 4 + (F.lane >> 4); ((float*)(F.ws + WS_ZG))[(size_t)(tile * 32 + row) * 16 + g] = lg[row * 33 + g] + bias; }
        asm volatile("s_waitcnt lgkmcnt(0)" ::: "memory");
    }
}

using pg8::Unit;
struct ProbPlain {
    static constexpr bool GATHER = false, FP8 = false; static constexpr int SCALE_A = 127, SCALE_B = 127; const bf16_t* A; const bf16_t* Bt; int lda, ldb;
    __device__ __forceinline__ int nt(const Unit&) const { return lda / 64; }
    __device__ __forceinline__ const char* a_base(const Unit& u) const { return (const char*)A + (size_t)u.pm * 256 * lda * 2; }
    __device__ __forceinline__ const char* b_base(const Unit& u) const { return (const char*)Bt + (size_t)u.pn * 256 * ldb * 2; }
    __device__ __forceinline__ void a_tok(const Unit&, const int (&)[2], int (&)[2][2]) const {}
    __device__ __forceinline__ void a_off(const int (&)[2][2], const int (&)[2], unsigned (&)[2][2]) const {}
    __device__ __forceinline__ void a_rows(const Unit&, const int (&)[2], const int (&)[2], unsigned (&)[2][2]) const {}
};
struct ProbPlainF8 {
    static constexpr bool GATHER = false, FP8 = true; static constexpr int SCALE_A = F8E_ACT, SCALE_B = F8E_WGU; const bf16_t* A; const bf16_t* Bt; int lda, ldb;
    __device__ __forceinline__ int nt(const Unit&) const { return lda / 64; }
    __device__ __forceinline__ const char* a_base(const Unit& u) const { return (const char*)A + (size_t)u.pm * 256 * lda * 2; }
    __device__ __forceinline__ const char* b_base(const Unit& u) const { return (const char*)Bt + (size_t)u.pn * 256 * ldb * 2; }
    __device__ __forceinline__ void a_tok(const Unit&, const int (&)[2], int (&)[2][2]) const {}
    __device__ __forceinline__ void a_off(const int (&)[2][2], const int (&)[2], unsigned (&)[2][2]) const {}
    __device__ __forceinline__ void a_rows(const Unit&, const int (&)[2], const int (&)[2], unsigned (&)[2][2]) const {}
};
struct ProbBranch {
    static constexpr bool GATHER = false, FP8 = false; static constexpr int SCALE_A = 127, SCALE_B = 127; const bf16_t* A; const bf16_t* Bt; int lda, ldb;
    __device__ __forceinline__ int nt(const Unit& u) const { return u.sub == 1 ? 8 : 4; }
    __device__ __forceinline__ int koff(const Unit& u) const { return u.sub == 0 ? 0 : (u.sub == 1 ? 256 : 768); }
    __device__ __forceinline__ const char* a_base(const Unit& u) const { return (const char*)A + ((size_t)u.pm * 256 * lda + koff(u)) * 2; }
    __device__ __forceinline__ const char* b_base(const Unit& u) const { return (const char*)Bt + ((size_t)u.pn * 256 * ldb + koff(u)) * 2; }
    __device__ __forceinline__ void a_tok(const Unit&, const int (&)[2], int (&)[2][2]) const {}
    __device__ __forceinline__ void a_off(const int (&)[2][2], const int (&)[2], unsigned (&)[2][2]) const {}
    __device__ __forceinline__ void a_rows(const Unit&, const int (&)[2], const int (&)[2], unsigned (&)[2][2]) const {}
};
__device__ __forceinline__ int expert_of(const LAS int* seg, int pm) { return __builtin_amdgcn_readfirstlane((int)((const LAS unsigned char*)(seg + 64))[pm]); }
__device__ __forceinline__ int moe_tables(Frame& F, LAS int* seg) {
    __syncthreads();
    if (F.tid <= NEXP) seg[F.tid] = ((const int*)(F.ws + WS_ROUTE + RT_SEG))[F.tid];
    __syncthreads();
    const int ntile = seg[NEXP] / 256;
    LAS unsigned char* texp = (LAS unsigned char*)(seg + 64);
    for (int t = F.tid; t < ntile; t += NTHREADS) { const int row = t * 256; int e = 0;
#pragma unroll
        for (int i = 1; i < NEXP; ++i) e += (seg[i] <= row) ? 1 : 0;
        texp[t] = (unsigned char)e; }
    __syncthreads();
    return ntile;
}
struct ProbMoe1 {
    static constexpr bool GATHER = true, FP8 = true; static constexpr int SCALE_A = F8E_ACT, SCALE_B = F8E_WGU; const bf16_t* A; const bf16_t* Bt; int lda, ldb; const int* tok; const LAS int* seg;
    __device__ __forceinline__ int nt(const Unit&) const { return lda / 64; }
    __device__ __forceinline__ const char* a_base(const Unit&) const { return (const char*)A; }
    __device__ __forceinline__ const char* b_base(const Unit& u) const { const int e = expert_of(seg, u.pm); return (const char*)Bt + ((size_t)e * 2048 + (size_t)u.pn * 256) * ldb * 2; }
    __device__ __forceinline__ void a_rows(const Unit& u, const int (&R)[2], const int (&C)[2], unsigned (&off)[2][2]) const {
#pragma unroll
        for (int h = 0; h < 2; ++h)
#pragma unroll
            for (int i = 0; i < 2; ++i) { const int t = tok[u.pm * 256 + h * 128 + R[i]]; off[h][i] = (unsigned)(t * lda + C[i]) * 2u; } }
    __device__ __forceinline__ void a_tok(const Unit& u, const int (&R)[2], int (&tk)[2][2]) const {
#pragma unroll
        for (int h = 0; h < 2; ++h)
#pragma unroll
            for (int i = 0; i < 2; ++i) tk[h][i] = tok[u.pm * 256 + h * 128 + R[i]]; }
    __device__ __forceinline__ void a_off(const int (&tk)[2][2], const int (&C)[2], unsigned (&off)[2][2]) const {
#pragma unroll
        for (int h = 0; h < 2; ++h)
#pragma unroll
            for (int i = 0; i < 2; ++i) off[h][i] = (unsigned)(tk[h][i] * lda + C[i]) * 2u; }
};
struct ProbMoe2 {
    static constexpr bool GATHER = false, FP8 = true; static constexpr int SCALE_A = F8E_ACT, SCALE_B = F8E_WDN; const bf16_t* A; const bf16_t* Bt; int lda, ldb; const LAS int* seg;
    __device__ __forceinline__ int nt(const Unit&) const { return lda / 64; }
    __device__ __forceinline__ const char* a_base(const Unit& u) const { return (const char*)A + (size_t)u.pm * 256 * lda * 2; }
    __device__ __forceinline__ const char* b_base(const Unit& u) const { const int e = expert_of(seg, u.pm); return (const char*)Bt + ((size_t)e * 1024 + (size_t)u.pn * 256) * ldb * 2; }
    __device__ __forceinline__ void a_tok(const Unit&, const int (&)[2], int (&)[2][2]) const {}
    __device__ __forceinline__ void a_off(const int (&)[2][2], const int (&)[2], unsigned (&)[2][2]) const {}
    __device__ __forceinline__ void a_rows(const Unit&, const int (&)[2], const int (&)[2], unsigned (&)[2][2]) const {}
};
using pg8::cvt_pk_bf16;
template <bool G8> struct EpiInproj {
    static constexpr bool PERM = true, CHAIN = false, SIDE = true, KHOOK = false; bf16_t* Z; const float* bias; int pn0;
    __device__ __forceinline__ void side(const Unit& u0, unsigned slot, int wid, int lane) const { const int pn = u0.pn + pn0; if (wid == 1) pg8::dma16((unsigned)lane * 16u, bias + pn * 256 + (pn >= 9 ? 16 : 0), slot); }
    __device__ __forceinline__ void operator()(const f32x4 (&acc)[2][2][4][2], const Unit& u0, int wr, int wc, int fr, int fq, const LAS unsigned char* sd) const {
        Unit u = u0; u.pn += pn0;
        int row0 = u.pm * 256 + wr * 64 + fr, col0 = u.pn * 256 + wc * 32 + 8 * fq; asm volatile("" : "+v"(row0), "+v"(col0));
        const int act = (u.pn <= 6) ? 0 : ((u.pn == 9 || u.pn == 10) ? 2 : 1);
        f32x4 bv[2][2];
#pragma unroll
        for (int bj = 0; bj < 2; ++bj)
#pragma unroll
            for (int n = 0; n < 2; ++n) bv[bj][n] = *(const LAS f32x4*)(sd + (bj * 128 + wc * 32 + 8 * fq + 4 * n) * 4);
#pragma unroll
        for (int ai = 0; ai < 2; ++ai)
#pragma unroll
            for (int m = 0; m < 4; ++m) { bf16_t* rowp = Z + (size_t)(row0 + ai * 128 + m * 16) * NZ + col0;
#pragma unroll
                for (int bj = 0; bj < 2; ++bj) { f32x4 v0 = acc[ai][bj][m][0] + bv[bj][0], v1 = acc[ai][bj][m][1] + bv[bj][1];
                    if constexpr (G8) { u32x2 w8;
#pragma unroll
                        for (int j = 0; j < 4; ++j) v0[j] = fmaxf(sigmoidf_(v0[j]) * G8_SCALE, 1.0f) + 12582912.0f;
                        w8.x = pk4_u8(v0[0], v0[1], v0[2], v0[3]); asm volatile("" : "+v"(w8.x));
#pragma unroll
                        for (int j = 0; j < 4; ++j) v1[j] = fmaxf(sigmoidf_(v1[j]) * G8_SCALE, 1.0f) + 12582912.0f;
                        w8.y = pk4_u8(v1[0], v1[1], v1[2], v1[3]);
                        *(u32x2*)((unsigned char*)(Z + (size_t)(row0 + ai * 128 + m * 16) * NZ + NZ_BF) + (col0 - NZ_BF) + bj * 128) = w8; continue; }
                    if (act == 2) { f32x2 a = pg8::gelu_pk((f32x2){v0[0], v0[1]}), b = pg8::gelu_pk((f32x2){v0[2], v0[3]}), c = pg8::gelu_pk((f32x2){v1[0], v1[1]}), d = pg8::gelu_pk((f32x2){v1[2], v1[3]});
                        v0 = (f32x4){a.x, a.y, b.x, b.y}; v1 = (f32x4){c.x, c.y, d.x, d.y}; }
                    if (act == 1) {
#pragma unroll
                        for (int j = 0; j < 4; ++j) { v0[j] = sigmoidf_(v0[j]); v1[j] = sigmoidf_(v1[j]); } }
                    u32x4 w; w.x = cvt_pk_bf16(v0[0], v0[1]); w.y = cvt_pk_bf16(v0[2], v0[3]); w.z = cvt_pk_bf16(v1[0], v1[1]); w.w = cvt_pk_bf16(v1[2], v1[3]);
                    *(u32x4*)(rowp + bj * 128) = w; }
                if constexpr (G8) asm volatile("" ::: "memory"); }
    }
};
struct EpiNull {
    static constexpr bool PERM = true, CHAIN = false; bf16_t* Z;
    __device__ __forceinline__ void operator()(const f32x4 (&acc)[2][2][4][2], const Unit& u, int wr, int wc, int fr, int fq) const {
        float sacc = 0.f;
#pragma unroll
        for (int ai = 0; ai < 2; ++ai)
#pragma unroll
            for (int bj = 0; bj < 2; ++bj)
#pragma unroll
                for (int m = 0; m < 4; ++m)
#pragma unroll
                    for (int n = 0; n < 2; ++n) sacc += (acc[ai][bj][m][n][0] + acc[ai][bj][m][n][1]) + (acc[ai][bj][m][n][2] + acc[ai][bj][m][n][3]);
        if (sacc == 1.2345e30f) Z[u.pm + wr + wc + fr + fq] = 0;
    }
};
struct EpiOut {
    static constexpr bool PERM = true, CHAIN = false, SIDE = false, KHOOK = false; bf16_t* T;
    __device__ __forceinline__ void operator()(const f32x4 (&acc)[2][2][4][2], const Unit& u, int wr, int wc, int fr, int fq, const LAS unsigned char*) const {
        int row0 = u.pm * 256 + wr * 64 + fr, col0 = u.pn * 256 + wc * 32 + 8 * fq; asm volatile("" : "+v"(row0), "+v"(col0));
#pragma unroll
        for (int ai = 0; ai < 2; ++ai)
#pragma unroll
            for (int m = 0; m < 4; ++m) { bf16_t* rowp = T + (size_t)(row0 + ai * 128 + m * 16) * D + col0;
#pragma unroll
                for (int bj = 0; bj < 2; ++bj) { const f32x4 v0 = acc[ai][bj][m][0], v1 = acc[ai][bj][m][1];
                    u32x4 w; w.x = cvt_pk_bf16(v0[0], v0[1]); w.y = cvt_pk_bf16(v0[2], v0[3]); w.z = cvt_pk_bf16(v1[0], v1[1]); w.w = cvt_pk_bf16(v1[2], v1[3]);
                    *(u32x4*)(rowp + bj * 128) = w; } }
    }
};
struct EpiBranch {
    static constexpr bool PERM = true, CHAIN = false, SIDE = false, KHOOK = true; static constexpr int HOOK_T0 = 4, HOOK_T1 = 12;
    const bf16_t* Z; bf16_t* Y;
    template <bool FIN> __device__ __forceinline__ void apply(f32x4 (&acc)[2][2][4][2], const Unit& u, int br, int wr, int wc, int fr, int fq) const {
        int row0 = u.pm * 256 + wr * 64 + fr, col0 = u.pn * 256 + wc * 32 + 8 * fq;
        asm volatile("" : "+v"(row0), "+v"(col0));
#pragma unroll
        for (int ai = 0; ai < 2; ++ai) {
            u32x2 ga[4][2], gb[4][2];
#pragma unroll
            for (int m = 0; m < 4; ++m) { const unsigned char* rowp = (const unsigned char*)(Z + (size_t)(row0 + ai * 128 + m * 16) * NZ + NZ_BF) + br * 1024 + col0;
#pragma unroll
                for (int bj = 0; bj < 2; ++bj) { ga[m][bj] = *(const u32x2*)(rowp + bj * 128); if (!FIN) gb[m][bj] = *(const u32x2*)(rowp + 1024 + bj * 128); } }
#pragma unroll
            for (int m = 0; m < 4; ++m) { const size_t row = (size_t)(row0 + ai * 128 + m * 16);
#pragma unroll
                for (int bj = 0; bj < 2; ++bj) { const u32x2 a = ga[m][bj];
                    f32x4 r0 = u8x4_f32(a.x), r1 = u8x4_f32(a.y);
                    if (FIN) { r0 = r0 * (1.0f / G8_SCALE); r1 = r1 * (1.0f / G8_SCALE); }
                    else { const u32x2 b = gb[m][bj]; const f32x4 q0 = u8x4_f32(b.x), q1 = u8x4_f32(b.y);
#pragma unroll
                        for (int i = 0; i < 4; ++i) { r0[i] *= __builtin_amdgcn_rcpf(q0[i]); r1[i] *= __builtin_amdgcn_rcpf(q1[i]); } }
                    acc[ai][bj][m][0] = acc[ai][bj][m][0] * r0; acc[ai][bj][m][1] = acc[ai][bj][m][1] * r1;
                    if (FIN) { const f32x4 v0 = acc[ai][bj][m][0], v1 = acc[ai][bj][m][1];
                        u32x4 w; w.x = cvt_pk_bf16(v0[0], v0[1]); w.y = cvt_pk_bf16(v0[2], v0[3]); w.z = cvt_pk_bf16(v1[0], v1[1]); w.w = cvt_pk_bf16(v1[2], v1[3]);
                        *(u32x4*)(Y + row * D + col0 + bj * 128) = w; } } }
            asm volatile("" ::: "memory"); }
    }
    __device__ __forceinline__ void hook(f32x4 (&acc)[2][2][4][2], const Unit& u, int br, int wr, int wc, int fr, int fq) const { apply<false>(acc, u, br, wr, wc, fr, fq); }
    __device__ __forceinline__ void operator()(f32x4 (&acc)[2][2][4][2], const Unit& u, int wr, int wc, int fr, int fq, const LAS unsigned char*) const { apply<true>(acc, u, 2, wr, wc, fr, fq); }
};
struct EpiSwiglu {
    static constexpr bool PERM = true, CHAIN = false, SIDE = true, KHOOK = false; unsigned char* HID; const float* bgu; const LAS int* seg;
    __device__ __forceinline__ void side(const Unit& u, unsigned slot, int wid, int lane) const {
        if (wid == 1) { const int e = expert_of(seg, u.pm); pg8::dma16(lane < 32 ? (unsigned)lane * 16u : 4096u + (unsigned)(lane - 32) * 16u, bgu + (size_t)e * 2048 + u.pn * 128, slot); } }
    __device__ __forceinline__ void operator()(const f32x4 (&acc)[2][2][4][2], const Unit& u, int wr, int wc, int fr, int fq, const LAS unsigned char* sd) const {
        int j0 = u.pn * 128 + wc * 32 + 8 * fq, slot0 = u.pm * 256 + wr * 64 + fr; asm volatile("" : "+v"(j0), "+v"(slot0));
        f32x4 bg[2], bu[2];
#pragma unroll
        for (int n = 0; n < 2; ++n) { bg[n] = *(const LAS f32x4*)(sd + (wc * 32 + 8 * fq + 4 * n) * 4); bu[n] = *(const LAS f32x4*)(sd + (128 + wc * 32 + 8 * fq + 4 * n) * 4); }
#pragma unroll
        for (int ai = 0; ai < 2; ++ai)
#pragma unroll
            for (int m = 0; m < 4; ++m) { const size_t slot = (size_t)(slot0 + ai * 128 + m * 16); float o[8];
#pragma unroll
                for (int n = 0; n < 2; ++n)
#pragma unroll
                    for (int i = 0; i < 4; ++i) { float g = acc[ai][0][m][n][i] + bg[n][i], up = acc[ai][1][m][n][i] + bu[n][i];
                        g = fminf(g, 7.0f); up = fminf(fmaxf(up, -7.0f), 7.0f); o[n * 4 + i] = (up + 1.0f) * g * sigmoidf_(1.702f * g); }
                u32x2 w; w.x = pk4_fp8(o[0] * F8S_ACT, o[1] * F8S_ACT, o[2] * F8S_ACT, o[3] * F8S_ACT); w.y = pk4_fp8(o[4] * F8S_ACT, o[5] * F8S_ACT, o[6] * F8S_ACT, o[7] * F8S_ACT);
                *(u32x2*)(HID + slot * 1024 + j0) = w; }
    }
};
struct EpiDown {
    static constexpr bool PERM = true, CHAIN = false, SIDE = true, KHOOK = false; unsigned char* FS; const float* bdn; const int* dest; const float* pslot; const LAS int* seg;
    __device__ __forceinline__ void side(const Unit& u, unsigned slot, int wid, int lane) const {
        if (wid == 1) { const int e = expert_of(seg, u.pm); pg8::dma16((unsigned)lane * 16u, bdn + (size_t)e * 1024 + u.pn * 256, slot); }
        if (wid == 2) pg8::dma16((unsigned)lane * 16u, dest + (size_t)u.pm * 256, slot + 1024u);
        if (wid == 3) pg8::dma16((unsigned)lane * 16u, pslot + (size_t)u.pm * 256, slot + 2048u); }
    __device__ __forceinline__ void operator()(const f32x4 (&acc)[2][2][4][2], const Unit& u, int wr, int wc, int fr, int fq, const LAS unsigned char* sd) const {
        int col0 = u.pn * 256 + wc * 32 + 8 * fq, slot0 = u.pm * 256 + wr * 64 + fr; asm volatile("" : "+v"(col0), "+v"(slot0));
        f32x4 bv[2][2];
#pragma unroll
        for (int bj = 0; bj < 2; ++bj)
#pragma unroll
            for (int n = 0; n < 2; ++n) bv[bj][n] = *(const LAS f32x4*)(sd + (bj * 128 + wc * 32 + 8 * fq + 4 * n) * 4);
#pragma unroll
        for (int ai = 0; ai < 2; ++ai)
#pragma unroll
            for (int m = 0; m < 4; ++m) { const int rt = ai * 128 + wr * 64 + m * 16 + fr; const int d = *(const LAS int*)(sd + 1024 + rt * 4); const float p = *(const LAS float*)(sd + 2048 + rt * 4) * FS_SCALE;
                if (d >= 0) {
#pragma unroll
                    for (int bj = 0; bj < 2; ++bj) { f32x4 v0 = (acc[ai][bj][m][0] + bv[bj][0]) * p, v1 = (acc[ai][bj][m][1] + bv[bj][1]) * p;
#pragma unroll
                        for (int i = 0; i < 4; ++i) { v0[i] = __builtin_amdgcn_fmed3f(v0[i], -FS_CLAMP, FS_CLAMP); v1[i] = __builtin_amdgcn_fmed3f(v1[i], -FS_CLAMP, FS_CLAMP); }
                        u32x2 w; w.x = pk4_fp8(v0[0], v0[1], v0[2], v0[3]); w.y = pk4_fp8(v1[0], v1[1], v1[2], v1[3]);
                        *(u32x2*)(FS + (size_t)d * 1024 + col0 + bj * 128) = w; } }
                asm volatile("" ::: "memory"); }
    }
};

__device__ __forceinline__ const float* xin_row(const Frame& F, int row) { return row < ML ? F.in[IN_X] + (size_t)row * D : F.in[IN_CTX] + (size_t)(row - ML) * D; }
__device__ __forceinline__ void phase_ln0_first(Frame& F) {
    int t_lo, t_hi; tile_range(F, MT, t_lo, t_hi);
    const int r_lo = 32 * t_lo, nrows = 32 * (t_hi - t_lo);
    const int mrA = mod_row(r_lo), mrB = mod_row(r_lo + (nrows > 0 ? nrows - 1 : 0));
    { const float* mb = (const float*)(F.ws + WS_MOD); pv_fill(F, 0, mb + ((size_t)(0 * 17 + mrA) * 6 + 0) * 1024); pv_fill(F, 1, mb + ((size_t)(0 * 17 + mrB) * 6 + 0) * 1024);
      pv_fill(F, 2, mb + ((size_t)(0 * 17 + mrA) * 6 + 1) * 1024); pv_fill(F, 3, mb + ((size_t)(0 * 17 + mrB) * 6 + 1) * 1024); }
    load_wg_lds(F, 0);
    for (int n = F.wave; n < nrows; n += 4 * NWAVES) {
        RowV rv[4];
#pragma unroll
        for (int u = 0; u < 4; ++u) if (n + u * NWAVES < nrows) row_load(rv[u], xin_row(F, r_lo + n + u * NWAVES), F.lane);
#pragma unroll
        for (int u = 0; u < 4; ++u) if (n + u * NWAVES < nrows) { const int row = r_lo + n + u * NWAVES;
            const int sel = (mod_row(row) == mrA) ? 0 : 1; ln0_row(F, row, rv[u], pv_slot(F, 0 + sel), pv_slot(F, 2 + sel)); }
    }
    gates_tail(F, 0, t_lo, t_hi);
    __syncthreads();
}
__device__ __forceinline__ void phase_finalize(Frame& F, int l, int mrows) {
    const int gw = F.bid * NWAVES + F.wave, NGW = F.G * NWAVES;
    const bf16_t* hf = (const bf16_t*)(F.ws + WS_HFB); const bf16_t* hb = hf + (size_t)MT * 512;
    const float* ng = F.in[IN_MNG] + l * 512 + 8 * F.lane;
    const f32x4 g0 = *(const f32x4*)ng, g1 = *(const f32x4*)(ng + 4);
    for (int row = gw; row < mrows; row += NGW) {
        const u32x4 ha = __builtin_nontemporal_load((const u32x4*)(hf + (size_t)row * 512 + 8 * F.lane)), hbv = __builtin_nontemporal_load((const u32x4*)(hb + (size_t)row * 512 + 8 * F.lane));
        f32x4 v0 = (f32x4){bflo(ha.x) + bflo(hbv.x), bfhi(ha.x) + bfhi(hbv.x), bflo(ha.y) + bflo(hbv.y), bfhi(ha.y) + bfhi(hbv.y)}, v1 = (f32x4){bflo(ha.z) + bflo(hbv.z), bfhi(ha.z) + bfhi(hbv.z), bflo(ha.w) + bflo(hbv.w), bfhi(ha.w) + bfhi(hbv.w)};
        float s = (v0.x + v0.y) + (v0.z + v0.w) + (v1.x + v1.y) + (v1.z + v1.w);
#pragma unroll
        for (int o = 1; o < 16; o <<= 1) s += shx(s, o, F.lane);
        const float mu = s * (1.f / 128.f); v0 = v0 - mu; v1 = v1 - mu;
        float q = (v0.x * v0.x + v0.y * v0.y) + (v0.z * v0.z + v0.w * v0.w) + (v1.x * v1.x + v1.y * v1.y) + (v1.z * v1.z + v1.w * v1.w);
#pragma unroll
        for (int o = 1; o < 16; o <<= 1) q += shx(q, o, F.lane);
        const float rstd = 1.f / sqrtf(q * (1.f / 128.f) + HEAD_EPS);
        const u32x4 so = __builtin_nontemporal_load((const u32x4*)((const bf16_t*)(F.ws + WS_Z) + (size_t)row * NZ + ZC_O + 8 * F.lane));
        v0 = v0 * rstd * g0; v1 = v1 * rstd * g1;
        u32x4 w; w.x = pk2(v0.x * bflo(so.x), v0.y * bfhi(so.x)); w.y = pk2(v0.z * bflo(so.y), v0.w * bfhi(so.y)); w.z = pk2(v1.x * bflo(so.z), v1.y * bfhi(so.z)); w.w = pk2(v1.z * bflo(so.w), v1.w * bfhi(so.w));
        *(u32x4*)((bf16_t*)(F.ws + WS_BRA) + (size_t)row * D + 256 + 8 * F.lane) = w;
    }
}
__device__ __forceinline__ void phase_ln1_router(Frame& F, int l, int mrows) {
    LAS int* cnt = (LAS int*)(F.lds + NW_END);
    { const float* wr = F.in[IN_WR] + (size_t)l * D * NEXP;
      for (int i = F.tid; i < NEXP * D; i += NTHREADS) { const int k = i >> 5, e = i & 31; *(LAS bf16_t*)(F.lds + NW_WT + e * 2064 + k * 2) = (bf16_t)f2bf(wr[i]); }
      if (F.tid < NEXP) cnt[F.tid] = 0; }
    const float* brt = F.in[IN_BR] + l * NEXP;
    int t_lo, t_hi; tile_range(F, mrows, t_lo, t_hi);
    const int r_lo = 32 * t_lo, nrows = 32 * (t_hi - t_lo);
    const int mrA = mod_row(r_lo), mrB = mod_row(r_lo + (nrows > 0 ? nrows - 1 : 0));
    { const float* mb = (const float*)(F.ws + WS_MOD); pv_fill(F, 0, F.in[IN_LN1G] + l * D); pv_fill(F, 1, F.in[IN_LN1B] + l * D);
      pv_fill(F, 2, mb + ((size_t)(l * 17 + mrA) * 6 + 2) * 1024); pv_fill(F, 3, mb + ((size_t)(l * 17 + mrB) * 6 + 2) * 1024);
      pv_fill(F, 4, mb + ((size_t)(l * 17 + mrA) * 6 + 3) * 1024); pv_fill(F, 5, mb + ((size_t)(l * 17 + mrB) * 6 + 3) * 1024);
      pv_fill(F, 6, mb + ((size_t)(l * 17 + mrA) * 6 + 4) * 1024); pv_fill(F, 7, mb + ((size_t)(l * 17 + mrB) * 6 + 4) * 1024); }
    __syncthreads();
    { const bf16_t* yb = (const bf16_t*)(F.ws + WS_T) + 8 * F.lane;
      for (int n = F.wave; n < nrows; n += 2 * NWAVES) {
          RowV rv[2]; u32x4 yv2[2][2];
#pragma unroll
          for (int u = 0; u < 2; ++u) if (n + u * NWAVES < nrows) { const int row = r_lo + n + u * NWAVES;
              if (l == 0) row_load(rv[u], xin_row(F, row), F.lane); else row_load_bf16(rv[u], (const bf16_t*)(F.ws + WS_X) + (size_t)row * D, F.lane);
#pragma unroll
              for (int h = 0; h < 2; ++h) yv2[u][h] = __builtin_nontemporal_load((const u32x4*)(yb + (size_t)row * D + 512 * h)); }
#pragma unroll
          for (int u = 0; u < 2; ++u) if (n + u * NWAVES < nrows) { const int row = r_lo + n + u * NWAVES; RowV cur = rv[u];
              const int sel = (mod_row(row) == mrA) ? 0 : 1;
              { const LAS float* g1 = pv_slot(F, 2 + sel);
#pragma unroll
                for (int j = 0; j < 4; ++j) { const f32x4 gg = *(const LAS f32x4*)(g1 + RC(F.lane, j)); const u32x4 yw = yv2[u][j >> 1]; const f32x4 yv = (j & 1) ? (f32x4){bflo(yw.z), bfhi(yw.z), bflo(yw.w), bfhi(yw.w)} : (f32x4){bflo(yw.x), bfhi(yw.x), bflo(yw.y), bfhi(yw.y)}; cur.v[j] = cur.v[j] * DN_ALPHA + gg * yv; } }
              row_ln_plain(cur, F.lane); row_affine_l(cur, pv_slot(F, 0), pv_slot(F, 1), F.lane);
              row_store_bf16_nt(cur, (bf16_t*)(F.ws + WS_X) + (size_t)row * D, F.lane);
              row_ln_plain(cur, F.lane); row_modulate_l(cur, pv_slot(F, 4 + sel), pv_slot(F, 6 + sel), F.lane);
              row_store_bf16(cur, (bf16_t*)(F.ws + WS_H2) + (size_t)row * D, F.lane);
              { unsigned char* h8 = (unsigned char*)(F.ws + WS_H2F8) + (size_t)row * D + 8 * F.lane;
#pragma unroll
                for (int h = 0; h < 2; ++h) { u32x2 w; w.x = pk4_fp8(cur.v[2 * h].x * F8S_ACT, cur.v[2 * h].y * F8S_ACT, cur.v[2 * h].z * F8S_ACT, cur.v[2 * h].w * F8S_ACT); w.y = pk4_fp8(cur.v[2 * h + 1].x * F8S_ACT, cur.v[2 * h + 1].y * F8S_ACT, cur.v[2 * h + 1].z * F8S_ACT, cur.v[2 * h + 1].w * F8S_ACT); *(u32x2*)(h8 + 512 * h) = w; } } }
      } }
    asm volatile("s_waitcnt vmcnt(0)" ::: "memory"); __syncthreads();
    for (int tile = t_lo + F.wave; tile < t_hi; tile += NWAVES) {
        const LAS float* lgw = narrow_tile_wave(F, (const bf16_t*)(F.ws + WS_H2) + (size_t)tile * 32 * D);
        if (F.lane < 32) {
            const LAS float* lgp = lgw + F.lane * 33; const int row = tile * 32 + F.lane;
            float lg[NEXP];
#pragma unroll
            for (int e = 0; e < NEXP; ++e) lg[e] = lgp[e] + brt[e];
            unsigned used = 0u; float bv[4]; int bi[4];
#pragma unroll
            for (int k = 0; k < 4; ++k) { float best = -3.0e38f; int idx = 0;
#pragma unroll
                for (int e = 0; e < NEXP; ++e) { const bool take = (((used >> e) & 1u) == 0u) && (lg[e] > best); best = take ? lg[e] : best; idx = take ? e : idx; }
                used |= 1u << idx; bv[k] = best; bi[k] = idx; }
            const float e1 = __expf(bv[1] - bv[0]), e2 = __expf(bv[2] - bv[0]), e3 = __expf(bv[3] - bv[0]); const float inv = __builtin_amdgcn_rcpf(1.0f + e1 + e2 + e3);
            int* ei = (int*)(F.ws + WS_ROUTE + RT_EIDX) + (size_t)row * 4; float* pr = (float*)(F.ws + WS_ROUTE + RT_PROB) + (size_t)row * 4;
            *(int4*)ei = make_int4(bi[0], bi[1], bi[2], bi[3]); *(f32x4*)pr = (f32x4){inv, e1 * inv, e2 * inv, e3 * inv};
            atomicAdd((int*)&cnt[bi[0]], 1); atomicAdd((int*)&cnt[bi[1]], 1); atomicAdd((int*)&cnt[bi[2]], 1); atomicAdd((int*)&cnt[bi[3]], 1);
        }
        asm volatile("s_waitcnt lgkmcnt(0)" ::: "memory");
    }
    __syncthreads();
    if (F.tid < NEXP) ((int*)(F.ws + WS_ROUTE + RT_CNT))[F.bid * NEXP + F.tid] = cnt[F.tid];
    __syncthreads();
}
__device__ __forceinline__ void phase_slots(Frame& F, int mrows) {
    LAS int* part = (LAS int*)F.lds;
    LAS int* pre = part + 1024;
    LAS int* tot = pre + 32;
    LAS int* seg = tot + 32;
    LAS int* gcnt = seg + 64;
    LAS int* eix = gcnt + 2048;
    LAS int* rnk = eix + 4096;
    const int* cntg = (const int*)(F.ws + WS_ROUTE + RT_CNT);
    int* tokg = (int*)(F.ws + WS_ROUTE + RT_TOK); int* destg = (int*)(F.ws + WS_ROUTE + RT_DEST); float* psl = (float*)(F.ws + WS_ROUTE + RT_PSLOT);
    int t_lo, t_hi; tile_range(F, mrows, t_lo, t_hi);
    const int row_base = t_lo * 32, nent = (t_hi - t_lo) * 128, ngrp = nent / 64;
    { const int e = F.tid & 31, pt = F.tid >> 5; int a = 0, b = 0;
      for (int c = pt; c < F.G; c += 16) { const int v = cntg[c * NEXP + e]; b += v; a += (c < F.bid) ? v : 0; }
      part[pt * 32 + e] = a; part[512 + pt * 32 + e] = b; }
    for (int i = F.tid; i < nent; i += NTHREADS) eix[i] = ((const int*)(F.ws + WS_ROUTE + RT_EIDX))[(size_t)row_base * 4 + i];
    __syncthreads();
    if (F.tid < NEXP) { int a = 0, b = 0;
#pragma unroll
        for (int pt = 0; pt < 16; ++pt) { a += part[pt * 32 + F.tid]; b += part[512 + pt * 32 + F.tid]; }
        pre[F.tid] = a; tot[F.tid] = b; }
    for (int g = F.wave; g < ngrp; g += NWAVES) {
        const int e = eix[g * 64 + F.lane]; int rank = 0, mycnt = 0;
#pragma unroll 4
        for (int ee = 0; ee < NEXP; ++ee) { const unsigned long long m = __ballot(e == ee); if (e == ee) rank = __popcll(m & ((1ull << F.lane) - 1ull)); if (F.lane == ee) mycnt = __popcll(m); }
        rnk[g * 64 + F.lane] = rank; if (F.lane < NEXP) gcnt[g * 32 + F.lane] = mycnt; }
    __syncthreads();
    if (F.tid == 0) { int s = 0; for (int e = 0; e < NEXP; ++e) { seg[e] = s; s += (tot[e] + 255) & ~255; } seg[NEXP] = s; }
    if (F.tid >= 64 && F.tid < 64 + NEXP) { const int e = F.tid - 64; int run = 0; for (int g = 0; g < ngrp; ++g) { const int c = gcnt[g * 32 + e]; gcnt[g * 32 + e] = run; run += c; } }
    __syncthreads();
    { const float* prg = (const float*)(F.ws + WS_ROUTE + RT_PROB) + (size_t)row_base * 4;
      for (int i = F.tid; i < nent; i += NTHREADS) { const int e = eix[i]; const int slot = seg[e] + pre[e] + gcnt[(i >> 6) * 32 + e] + rnk[i];
          tokg[slot] = row_base + (i >> 2); destg[slot] = row_base * 4 + i; psl[slot] = prg[i]; } }
    if (F.bid < NEXP) { const int e = F.bid; for (int sl = seg[e] + tot[e] + F.tid; sl < seg[e + 1]; sl += NTHREADS) { tokg[sl] = 0; destg[sl] = -1; psl[sl] = 0.f; } }
    if (F.bid == 0 && F.tid <= NEXP) ((int*)(F.ws + WS_ROUTE + RT_SEG))[F.tid] = seg[F.tid];
    __syncthreads();
}
struct CombRaw { u32x4 x[2]; u32x2 f[2][4]; };
__device__ __forceinline__ void comb_load(const Frame& F, int row, CombRaw& r) {
    { const bf16_t* xp = (const bf16_t*)(F.ws + WS_X) + (size_t)row * D + 8 * F.lane;
#pragma unroll
      for (int h = 0; h < 2; ++h) r.x[h] = __builtin_nontemporal_load((const u32x4*)(xp + 512 * h)); }
    const unsigned char* fs = (const unsigned char*)(F.ws + WS_FS) + (size_t)row * 4 * 1024 + 8 * F.lane;
#pragma unroll
    for (int h = 0; h < 2; ++h)
#pragma unroll
        for (int k = 0; k < 4; ++k) r.f[h][k] = __builtin_nontemporal_load((const u32x2*)(fs + k * 1024 + 512 * h));
}
__device__ __forceinline__ void phase_combine_ln2(Frame& F, int l, int mrows) {
    const bool lastl = (l == DEPTH - 1);
    int t_lo, t_hi; tile_range(F, mrows, t_lo, t_hi);
    const int r_lo = 32 * t_lo, nrows = 32 * (t_hi - t_lo);
    const int mrA = mod_row(r_lo), mrB = mod_row(r_lo + (nrows > 0 ? nrows - 1 : 0));
    { const float* mb = (const float*)(F.ws + WS_MOD); const int ln = lastl ? l : l + 1; pv_fill(F, 0, F.in[IN_LN2G] + l * D); pv_fill(F, 1, F.in[IN_LN2B] + l * D);
      pv_fill(F, 2, mb + ((size_t)(l * 17 + mrA) * 6 + 5) * 1024); pv_fill(F, 3, mb + ((size_t)(l * 17 + mrB) * 6 + 5) * 1024);
      pv_fill(F, 4, mb + ((size_t)(ln * 17 + mrA) * 6 + 0) * 1024); pv_fill(F, 5, mb + ((size_t)(ln * 17 + mrB) * 6 + 0) * 1024);
      pv_fill(F, 6, mb + ((size_t)(ln * 17 + mrA) * 6 + 1) * 1024); pv_fill(F, 7, mb + ((size_t)(ln * 17 + mrB) * 6 + 1) * 1024); }
    if (!lastl) load_wg_lds(F, l + 1); else __syncthreads();
    for (int n = F.wave; n < nrows; n += 2 * NWAVES) {
        CombRaw rw[2];
#pragma unroll
        for (int u = 0; u < 2; ++u) if (n + u * NWAVES < nrows) comb_load(F, r_lo + n + u * NWAVES, rw[u]);
#pragma unroll
        for (int u = 0; u < 2; ++u) if (n + u * NWAVES < nrows) { const int row = r_lo + n + u * NWAVES;
            const int sel = (mod_row(row) == mrA) ? 0 : 1;
            const LAS float* g2 = pv_slot(F, 2 + sel);
            RowV x;
#pragma unroll
            for (int h = 0; h < 2; ++h) { const u32x4 w = rw[u].x[h]; x.v[2 * h] = (f32x4){bflo(w.x), bfhi(w.x), bflo(w.y), bfhi(w.y)}; x.v[2 * h + 1] = (f32x4){bflo(w.z), bfhi(w.z), bflo(w.w), bfhi(w.w)}; }
#pragma unroll
            for (int j = 0; j < 4; ++j) { f32x4 f = (f32x4){0.f, 0.f, 0.f, 0.f};
#pragma unroll
                for (int k = 0; k < 4; ++k) { const u32x2 w2 = rw[u].f[j >> 1][k]; const int wd = (int)((j & 1) ? w2.y : w2.x);
                    const f32x2 lo = __builtin_amdgcn_cvt_pk_f32_fp8(wd, false), hi = __builtin_amdgcn_cvt_pk_f32_fp8(wd, true); f[0] += lo[0]; f[1] += lo[1]; f[2] += hi[0]; f[3] += hi[1]; }
                const f32x4 gg = *(const LAS f32x4*)(g2 + RC(F.lane, j)) * (1.0f / FS_SCALE);
                x.v[j] = x.v[j] * DN_ALPHA + gg * f; }
            row_ln_plain(x, F.lane); row_affine_l(x, pv_slot(F, 0), pv_slot(F, 1), F.lane);
            if (lastl) { row_store_nt(x, F.out + (size_t)row * D, F.lane); }
            else { row_store_bf16_nt(x, (bf16_t*)(F.ws + WS_X) + (size_t)row * D, F.lane); ln0_row(F, row, x, pv_slot(F, 4 + sel), pv_slot(F, 6 + sel)); } }
    }
    if (!lastl) gates_tail(F, l + 1, t_lo, t_hi);
    __syncthreads();
}

#define MFMA32(a, b, c) __builtin_amdgcn_mfma_f32_32x32x16_bf16((a), (b), (c), 0, 0, 0)
#define MFMA16(a, b, c) __builtin_amdgcn_mfma_f32_16x16x32_bf16((a), (b), (c), 0, 0, 0)
__device__ __forceinline__ f32x16 zero16() { f32x16 z;
#pragma unroll
    for (int i = 0; i < 16; ++i) z[i] = 0.f;
    return z; }
__device__ __forceinline__ void pool_tiles(Frame& F, int l, bool with_ctx) {
    LAS unsigned char* Pin = F.lds;
    LAS unsigned char* Dm = F.lds + 40960;
    const bf16_t* Z = (const bf16_t*)(F.ws + WS_Z);
    const bf16_t* Wp = (const bf16_t*)(F.ws + WS_WPOOL) + (size_t)l * 4 * 4096;
    const float* psc = F.in[IN_POOLS] + l * 256;
    bf16_t* BRA = (bf16_t*)(F.ws + WS_BRA);
    const int ntiles = with_ctx ? 1088 : 1024;
    const int r = F.lane & 31, h = F.lane >> 5;
    for (int tile = F.bid; tile < ntiles; tile += F.G) {
        int row0, seq_lo, seq_hi;
        if (tile < 1024) { row0 = tile * 64; seq_lo = row0; seq_hi = row0 + 64; }
        else { const int ct = tile - 1024; seq_lo = ML + (ct >> 2) * 256; seq_hi = seq_lo + 256; row0 = seq_lo + (ct & 3) * 64; }
        for (int idx = F.tid; idx < 80 * 32; idx += NTHREADS) { const int rr = idx >> 5, ck = idx & 31, grow = row0 - 8 + rr;
            if (grow >= seq_lo && grow < seq_hi) *(LAS u32x4*)(Pin + rr * 512 + ck * 16) = __builtin_nontemporal_load((const u32x4*)(Z + (size_t)grow * NZ + ZC_P + ck * 8)); }
        __syncthreads();
        for (int idx = F.tid; idx < 64 * 32; idx += NTHREADS) { const int tok = idx >> 5, ck = idx & 31, g = ck >> 3, hw = 1 << g, t = row0 + tok;
            const int lo = max(t - hw, seq_lo), hi = min(t + hw, seq_hi);
            float s[8];
#pragma unroll
            for (int e = 0; e < 8; ++e) s[e] = 0.f;
            for (int rw = lo; rw < hi; ++rw) { const u32x4 v = *(const LAS u32x4*)(Pin + (rw - row0 + 8) * 512 + ck * 16);
                s[0] += bflo(v.x); s[1] += bfhi(v.x); s[2] += bflo(v.y); s[3] += bfhi(v.y); s[4] += bflo(v.z); s[5] += bfhi(v.z); s[6] += bflo(v.w); s[7] += bfhi(v.w); }
            const float inv = 1.0f / (float)(hi - lo);
            const u32x4 o = *(const LAS u32x4*)(Pin + (tok + 8) * 512 + ck * 16);
            u32x4 w; w.x = pk2(s[0] * inv - bflo(o.x), s[1] * inv - bfhi(o.x)); w.y = pk2(s[2] * inv - bflo(o.y), s[3] * inv - bfhi(o.y));
            w.z = pk2(s[4] * inv - bflo(o.z), s[5] * inv - bfhi(o.z)); w.w = pk2(s[6] * inv - bflo(o.w), s[7] * inv - bfhi(o.w));
            *(LAS u32x4*)(Dm + tok * 528 + ck * 16) = w; }
        __syncthreads();
#pragma unroll 1
        for (int qi = 0; qi < 2; ++qi) { const int q = F.wave + 8 * qi, g = q >> 2, td = (q >> 1) & 1, tt = q & 1;
            f32x16 acc = zero16();
#pragma unroll
            for (int ks = 0; ks < 4; ++ks) { const bf16x8 a = *(const bf16x8*)(Wp + ((size_t)g * 64 + td * 32 + r) * 64 + ks * 16 + 8 * h);
                const bf16x8 b = *(const LAS bf16x8*)(Dm + (tt * 32 + r) * 528 + (g * 64 + ks * 16 + 8 * h) * 2);
                acc = MFMA32(a, b, acc); }
            const size_t orow = (size_t)(row0 + tt * 32 + r);
#pragma unroll
            for (int qq = 0; qq < 4; ++qq) { const int dcol = g * 64 + td * 32 + 8 * qq + 4 * h; const f32x4 sc = *(const f32x4*)(psc + dcol);
                u32x2 w; w.x = pk2(acc[4 * qq] * sc.x, acc[4 * qq + 1] * sc.y); w.y = pk2(acc[4 * qq + 2] * sc.z, acc[4 * qq + 3] * sc.w);
                *(u32x2*)(BRA + orow * D + dcol) = w; } }
        __syncthreads();
    }
}
__device__ __forceinline__ void sgu_chunks(Frame& F, int l, bool with_ctx) {
    LAS unsigned char* Vt = F.lds;
    const bf16_t* Z = (const bf16_t*)(F.ws + WS_Z);
    const bf16_t* Ws = (const bf16_t*)(F.ws + WS_WSGU) + (size_t)l * 4 * 16384;
    const float* lng = F.in[IN_SLNG] + l * 256; const float* lnb = F.in[IN_SLNB] + l * 256; const float* sb = F.in[IN_SGUB] + l * 512;
    bf16_t* BRA = (bf16_t*)(F.ws + WS_BRA);
    const int nchunks = with_ctx ? 544 : 512;
    const int r = F.lane & 31, h = F.lane >> 5;
    for (int ch = F.bid; ch < nchunks; ch += F.G) {
        const int row0 = ch * 128;
        { const int s = F.tid >> 2, q = F.tid & 3; const bf16_t* zp = Z + (size_t)(row0 + s) * NZ + ZC_UV + 256 + q * 64;
          float v[64]; float sum = 0.f;
#pragma unroll
          for (int i = 0; i < 8; ++i) { const u32x4 w = __builtin_nontemporal_load((const u32x4*)(zp + 8 * i));
              v[8 * i] = bflo(w.x); v[8 * i + 1] = bfhi(w.x); v[8 * i + 2] = bflo(w.y); v[8 * i + 3] = bfhi(w.y); v[8 * i + 4] = bflo(w.z); v[8 * i + 5] = bfhi(w.z); v[8 * i + 6] = bflo(w.w); v[8 * i + 7] = bfhi(w.w); }
#pragma unroll
          for (int i = 0; i < 64; ++i) sum += v[i];
          sum += shx(sum, 1, F.lane); sum += shx(sum, 2, F.lane);
          const float mean = sum * (1.f / 256.f); float sq = 0.f;
#pragma unroll
          for (int i = 0; i < 64; ++i) { v[i] -= mean; sq += v[i] * v[i]; }
          sq += shx(sq, 1, F.lane); sq += shx(sq, 2, F.lane);
          const float rstd = 1.f / sqrtf(sq * (1.f / 256.f) + LN_EPS);
#pragma unroll
          for (int i = 0; i < 64; ++i) { const int c = q * 64 + i; const float y = v[i] * rstd * lng[c] + lnb[c]; *(LAS bf16_t*)(Vt + c * 272 + s * 2) = (bf16_t)f2bf(y); } }
        __syncthreads();
        const int tc = F.wave & 1, tt = F.wave >> 1, t = tt * 32 + r;
#pragma unroll 1
        for (int g = 0; g < 4; ++g) {
            f32x16 acc = zero16();
#pragma unroll
            for (int ks = 0; ks < 8; ++ks) { const bf16x8 a = *(const LAS bf16x8*)(Vt + (g * 64 + tc * 32 + r) * 272 + (ks * 16 + 8 * h) * 2);
                const bf16x8 b = *(const bf16x8*)(Ws + ((size_t)g * 128 + t) * 128 + ks * 16 + 8 * h);
                acc = MFMA32(a, b, acc); }
            const float bias = sb[g * 128 + t];
#pragma unroll
            for (int qq = 0; qq < 4; ++qq) { const int c0 = g * 64 + tc * 32 + 8 * qq + 4 * h;
                const u32x2 u = *(const u32x2*)(Z + (size_t)(row0 + t) * NZ + ZC_UV + c0);
                u32x2 w; w.x = pk2(bflo(u.x) * (acc[4 * qq] + bias), bfhi(u.x) * (acc[4 * qq + 1] + bias)); w.y = pk2(bflo(u.y) * (acc[4 * qq + 2] + bias), bfhi(u.y) * (acc[4 * qq + 3] + bias));
                *(u32x2*)(BRA + (size_t)(row0 + t) * D + 768 + c0) = w; } }
        __syncthreads();
    }
}
__device__ __forceinline__ void qk_conv_pass(Frame& F, int l) {
    const bf16_t* Z = (const bf16_t*)(F.ws + WS_Z); bf16_t* QKC = (bf16_t*)(F.ws + WS_H);
    const int chunk = F.tid & 127, rsub = F.tid >> 7, ch0 = chunk * 8;
    float w0[8], w1[8], w2[8], cbv[8];
    { const float* cw = F.in[IN_CONVW] + (size_t)l * 3 * 1024 + ch0; const float* cb = F.in[IN_CONVB] + (size_t)l * 1024 + ch0;
#pragma unroll
      for (int e = 0; e < 8; ++e) { w0[e] = cw[e]; w1[e] = cw[1024 + e]; w2[e] = cw[2048 + e]; cbv[e] = cb[e]; } }
    const float scale = chunk >= 64 ? 0.08838834764831845f : 1.0f;
    for (int row = F.bid * 4 + rsub; row < MT; row += F.G * 4) {
        const int p = row < ML ? (row & 4095) : ((row - ML) & 255), len = row < ML ? 4096 : 256;
        const bf16_t* zr = Z + (size_t)row * NZ + ZC_QK + ch0;
        const u32x4 x1 = *(const u32x4*)zr; u32x4 x0 = (u32x4){0u, 0u, 0u, 0u}, x2 = (u32x4){0u, 0u, 0u, 0u};
        if (p > 0) x0 = *(const u32x4*)(zr - NZ);
        if (p + 1 < len) x2 = *(const u32x4*)(zr + NZ);
        const unsigned xa[4] = {x0.x, x0.y, x0.z, x0.w}, xb[4] = {x1.x, x1.y, x1.z, x1.w}, xc[4] = {x2.x, x2.y, x2.z, x2.w};
        float y[8];
#pragma unroll
        for (int e2 = 0; e2 < 4; ++e2) { y[2 * e2] = cbv[2 * e2] + w0[2 * e2] * bflo(xa[e2]) + w1[2 * e2] * bflo(xb[e2]) + w2[2 * e2] * bflo(xc[e2]);
            y[2 * e2 + 1] = cbv[2 * e2 + 1] + w0[2 * e2 + 1] * bfhi(xa[e2]) + w1[2 * e2 + 1] * bfhi(xb[e2]) + w2[2 * e2 + 1] * bfhi(xc[e2]); }
#pragma unroll
        for (int e = 0; e < 8; ++e) y[e] = siluf_(y[e]) * scale;
        u32x4 w; w.x = pk2(y[0], y[1]); w.y = pk2(y[2], y[3]); w.z = pk2(y[4], y[5]); w.w = pk2(y[6], y[7]);
        *(u32x4*)(QKC + (size_t)row * D + ch0) = w;
    }
}
constexpr int ML_QS = 0, ML_KS = 34816, ML_KW = 69632, ML_VT = 104448, ML_CB = 126208, ML_SC = 147968, ML_SCSZ = 2624;
__device__ __forceinline__ float logsigf_(float x) { return fminf(x, 0.f) - __logf(1.0f + __expf(-fabsf(x))); }
__device__ __forceinline__ unsigned swap16(unsigned u) { return __builtin_amdgcn_alignbit(u, u, 16); }
struct MlPre { u32x4 qk[8]; u32x2 v[4]; float g[4]; };
__device__ __forceinline__ void ml_geom(int j, int b, int dir, int& seqbase, int& seqlen, int& pbase) {
    const bool is_ctx = j < 2; int cj = is_ctx ? j : j - 2; const int ncs = is_ctx ? 2 : 32; if (dir) cj = ncs - 1 - cj;
    seqbase = is_ctx ? ML + b * 256 : b * 4096; seqlen = is_ctx ? 256 : 4096; pbase = cj * 128; }
#define ML_BAR() do { asm volatile("s_waitcnt lgkmcnt(0)" ::: "memory"); __builtin_amdgcn_s_barrier(); asm volatile("" ::: "memory"); } while (0)
__device__ __forceinline__ void mlstm_unit(Frame& F, int l, int unit) {
    const int bh = (unit & 7) + 8 * (unit >> 5), sub = (unit >> 3) & 3;
    const int b = bh >> 2, head = bh & 3, dir = sub >> 1, vh = sub & 1;
    LAS unsigned char* QS = F.lds + ML_QS; LAS unsigned char* KS = F.lds + ML_KS; LAS unsigned char* KW = F.lds + ML_KW; LAS unsigned char* VT = F.lds + ML_VT; LAS unsigned char* CB = F.lds + ML_CB;
    const bf16_t* Z = (const bf16_t*)(F.ws + WS_Z); const float* ZG = (const float*)(F.ws + WS_ZG); const bf16_t* QKC = (const bf16_t*)(F.ws + WS_H);
    bf16_t* HF = (bf16_t*)(F.ws + WS_HFB) + (size_t)dir * MT * 512;
    const int wave = F.wave;
    int tl = F.tid;
#define ML_ROLES() const int lane = tl & 63, fr = lane & 15, q4 = lane >> 4; const int isk = (tl >> 4) & 1, ck = tl & 15, i0 = 8 * (tl >> 5), chn = (isk ? 512 : 0) + head * 128 + ck * 8; \
    const int vi0 = 4 * (tl >> 4), vcq = tl & 15, vch = head * 128 + vh * 64 + vcq * 4; (void)fr; (void)q4; (void)vi0; (void)vcq; (void)vch; (void)i0; (void)chn; (void)ck; (void)isk;
    for (int idx = F.tid; idx < 16 * 136; idx += NTHREADS) *(LAS bf16_t*)(VT + (64 + idx / 136) * 272 + (idx % 136) * 2) = (idx < 136) ? (bf16_t)0x3F80 : (bf16_t)0;
    f32x4 cs[5];
#pragma unroll
    for (int vt = 0; vt < 5; ++vt) cs[vt] = (f32x4){0.f, 0.f, 0.f, 0.f};
    float m_state = 0.f;
    MlPre pre;
#define ML_PREFETCH(jj) do { int sb_, sl_, pb_; ml_geom((jj), b, dir, sb_, sl_, pb_); \
        { const int pmin = dir ? pb_ + 120 - i0 : pb_ + i0; const bf16_t* zr = QKC + (size_t)(sb_ + pmin) * D + chn; (void)sl_; \
          _Pragma("unroll") for (int k = 0; k < 8; ++k) pre.qk[k] = *(const u32x4*)(zr + (size_t)k * D); } \
        { const int pminv = dir ? pb_ + 124 - vi0 : pb_ + vi0; const bf16_t* zv = Z + (size_t)(sb_ + pminv) * NZ + ZC_V + vch; \
          _Pragma("unroll") for (int k = 0; k < 4; ++k) pre.v[k] = *(const u32x2*)(zv + (size_t)k * NZ); } \
        if (wave == 0) { const int p0 = dir ? pb_ + 127 - 2 * lane : pb_ + 2 * lane, p1 = dir ? p0 - 1 : p0 + 1; \
          pre.g[0] = ZG[(size_t)(sb_ + p0) * 16 + dir * 8 + head]; pre.g[1] = ZG[(size_t)(sb_ + p0) * 16 + dir * 8 + 4 + head]; \
          pre.g[2] = ZG[(size_t)(sb_ + p1) * 16 + dir * 8 + head]; pre.g[3] = ZG[(size_t)(sb_ + p1) * 16 + dir * 8 + 4 + head]; } } while (0)
#define ML_STEPA(sbuf) do { LAS float* sg_ = (LAS float*)(F.lds + ML_SC + (sbuf) * ML_SCSZ); const int i0g = 2 * lane, i1g = i0g + 1; \
        const float gi0 = pre.g[0], gf0 = pre.g[1], gi1 = pre.g[2], gf1 = pre.g[3]; \
        const float lf0 = logsigf_(gf0), lf1 = logsigf_(gf1); const float s1 = lf0 + lf1; float incl = s1; \
        _Pragma("unroll") for (int o = 1; o < 64; o <<= 1) { const float y_ = shup(incl, o, lane); incl += (lane >= o) ? y_ : 0.f; } \
        const float excl = incl - s1, bc0 = excl + lf0, bc1 = excl + s1; \
        const float g0 = gi0 - bc0, g1 = gi1 - bc1; const float mx1 = fmaxf(g0, g1); float im = mx1; \
        _Pragma("unroll") for (int o = 1; o < 64; o <<= 1) { const float y_ = shup(im, o, lane); im = (lane >= o) ? fmaxf(im, y_) : im; } \
        float em = shup(im, 1, lane); em = (lane == 0) ? -3.0e38f : em; \
        const float M0 = fmaxf(m_state, fmaxf(em, g0)), M1 = fmaxf(m_state, fmaxf(em, mx1)); \
        const float total = bperm(63, bc1), Mlast = bperm(63, M1); \
        sg_[i0g] = g0; sg_[i1g] = g1; sg_[128 + i0g] = M0; sg_[128 + i1g] = M1; \
        sg_[256 + i0g] = __expf(m_state - M0); sg_[256 + i1g] = __expf(m_state - M1); \
        sg_[384 + i0g] = __expf(-(bc0 + M0)); sg_[384 + i1g] = __expf(-(bc1 + M1)); \
        sg_[512 + i0g] = __expf(g0 - Mlast); sg_[512 + i1g] = __expf(g1 - Mlast); \
        if (lane == 0) sg_[640] = __expf(m_state - Mlast); \
        m_state = total + Mlast; } while (0)
    { ML_ROLES(); ML_PREFETCH(0); if (wave == 0) ML_STEPA(0); }
    ML_BAR();
#pragma unroll 1
    for (int j = 0; j < 34; ++j) {
        asm volatile("" : "+v"(tl));
        ML_ROLES();
        int seqbase, seqlen, pbase; ml_geom(j, b, dir, seqbase, seqlen, pbase);
        const LAS float* sc_g = (const LAS float*)(F.lds + ML_SC + (j & 1) * ML_SCSZ); const LAS float* sc_M = sc_g + 128; const LAS float* sc_dec = sc_g + 256; const LAS float* sc_emt = sc_g + 384; const LAS float* sc_wk = sc_g + 512;
        {
#pragma unroll
          for (int k = 0; k < 8; ++k) { const int i = dir ? i0 + 7 - k : i0 + k; *(LAS u32x4*)((isk ? KS : QS) + i * 272 + ck * 16) = pre.qk[k]; }
          if (isk) { u32x4 kt[8]; float ykeep[8];
#pragma unroll
              for (int e = 0; e < 8; ++e) { kt[e] = (u32x4){0u, 0u, 0u, 0u}; ykeep[e] = 0.f; }
#pragma unroll
              for (int k = 0; k < 8; ++k) { const int i = dir ? i0 + 7 - k : i0 + k; const float wk = sc_wk[i];
                  const unsigned xb[4] = {pre.qk[k].x, pre.qk[k].y, pre.qk[k].z, pre.qk[k].w};
#pragma unroll
                  for (int e = 0; e < 8; ++e) { const float yw = ((e & 1) ? bfhi(xb[e >> 1]) : bflo(xb[e >> 1])) * wk;
                      if (k & 1) { const unsigned pw_ = pk2(ykeep[e], yw); if ((k >> 1) == 0) kt[e].x = pw_; else if ((k >> 1) == 1) kt[e].y = pw_; else if ((k >> 1) == 2) kt[e].z = pw_; else kt[e].w = pw_; }
                      else ykeep[e] = yw; } }
#pragma unroll
              for (int e = 0; e < 8; ++e) { u32x4 o = kt[e]; if (dir) o = (u32x4){swap16(kt[e].w), swap16(kt[e].z), swap16(kt[e].y), swap16(kt[e].x)};
                  *(LAS u32x4*)(KW + (ck * 8 + e) * 272 + (((i0 >> 3) ^ (ck & 7)) * 16)) = o; } } }
        { unsigned vv[4][2];
#pragma unroll
          for (int k = 0; k < 4; ++k) { vv[k][0] = pre.v[k].x; vv[k][1] = pre.v[k].y; }
#pragma unroll
          for (int c = 0; c < 4; ++c) {
              unsigned h0 = (c & 1) ? (vv[0][c >> 1] >> 16) : (vv[0][c >> 1] & 0xffffu), h1 = (c & 1) ? (vv[1][c >> 1] >> 16) : (vv[1][c >> 1] & 0xffffu);
              unsigned h2 = (c & 1) ? (vv[2][c >> 1] >> 16) : (vv[2][c >> 1] & 0xffffu), h3 = (c & 1) ? (vv[3][c >> 1] >> 16) : (vv[3][c >> 1] & 0xffffu);
              u32x2 o; if (dir) { o.x = h3 | (h2 << 16); o.y = h1 | (h0 << 16); } else { o.x = h0 | (h1 << 16); o.y = h2 | (h3 << 16); }
              *(LAS u32x2*)(VT + (vcq * 4 + c) * 272 + vi0 * 2) = o; } }
#pragma unroll
        for (int vt = 0; vt < 5; ++vt)
#pragma unroll
            for (int rr = 0; rr < 4; rr += 2) { const unsigned pw_ = pk2(cs[vt][rr], cs[vt][rr + 1]);
                *(LAS bf16_t*)(CB + (16 * vt + 4 * q4 + rr) * 272 + (16 * wave + fr) * 2) = (bf16_t)(pw_ & 0xffffu); *(LAS bf16_t*)(CB + (16 * vt + 4 * q4 + rr + 1) * 272 + (16 * wave + fr) * 2) = (bf16_t)(pw_ >> 16); }
        ML_BAR();
        if (j + 1 < 34) ML_PREFETCH(j + 1);
        const int t = 16 * wave + fr;
        bf16x8 qf[4];
#pragma unroll
        for (int kc = 0; kc < 4; ++kc) qf[kc] = *(const LAS bf16x8*)(QS + t * 272 + (32 * kc + 8 * q4) * 2);
        const float Mt_t = sc_M[t], dec_t = sc_dec[t], emt_t = sc_emt[t];
        f32x4 ps[8];
#pragma unroll
        for (int jp = 0; jp < 4; ++jp) {
            ps[2 * jp] = (f32x4){0.f, 0.f, 0.f, 0.f}; ps[2 * jp + 1] = (f32x4){0.f, 0.f, 0.f, 0.f};
            if (2 * jp <= wave) {
                bf16x8 ka[4], kb[4];
#pragma unroll
                for (int kc = 0; kc < 4; ++kc) { ka[kc] = *(const LAS bf16x8*)(KS + (32 * jp + fr) * 272 + (32 * kc + 8 * q4) * 2); kb[kc] = *(const LAS bf16x8*)(KS + (32 * jp + 16 + fr) * 272 + (32 * kc + 8 * q4) * 2); }
                const f32x4 ga4 = *(const LAS f32x4*)(sc_g + 32 * jp + 4 * q4), gb4 = *(const LAS f32x4*)(sc_g + 32 * jp + 16 + 4 * q4);
                f32x4 acc0 = (f32x4){0.f, 0.f, 0.f, 0.f}, acc1 = (f32x4){0.f, 0.f, 0.f, 0.f};
#pragma unroll
                for (int kc = 0; kc < 4; ++kc) { acc0 = MFMA16(ka[kc], qf[kc], acc0); acc1 = MFMA16(kb[kc], qf[kc], acc1); }
#pragma unroll
                for (int rr = 0; rr < 4; ++rr) { const int s0 = 32 * jp + 4 * q4 + rr, s1 = s0 + 16;
                    ps[2 * jp][rr] = (s0 <= t) ? acc0[rr] * __expf(ga4[rr] - Mt_t) : 0.f; ps[2 * jp + 1][rr] = (s1 <= t) ? acc1[rr] * __expf(gb4[rr] - Mt_t) : 0.f; }
            }
        }
        f32x4 ao[5];
        {
#pragma unroll
          for (int vt = 0; vt < 5; ++vt) ao[vt] = (f32x4){0.f, 0.f, 0.f, 0.f};
#pragma unroll
          for (int kh = 0; kh < 4; kh += 2) { bf16x8 cf[2][5];
#pragma unroll
              for (int k2 = 0; k2 < 2; ++k2)
#pragma unroll
                  for (int vt = 0; vt < 5; ++vt) cf[k2][vt] = *(const LAS bf16x8*)(CB + (16 * vt + fr) * 272 + (32 * (kh + k2) + 8 * q4) * 2);
#pragma unroll
              for (int k2 = 0; k2 < 2; ++k2)
#pragma unroll
                  for (int vt = 0; vt < 5; ++vt) ao[vt] = MFMA16(cf[k2][vt], qf[kh + k2], ao[vt]); }
#pragma unroll
          for (int vt = 0; vt < 5; ++vt) ao[vt] = ao[vt] * dec_t; }
#pragma unroll
        for (int ks = 0; ks < 4; ++ks) {
            if (2 * ks <= wave) {
                s16x4 vlo[5], vhi[5];
#pragma unroll
                for (int vt = 0; vt < 5; ++vt) { vlo[vt] = *(const LAS s16x4*)(VT + (16 * vt + fr) * 272 + (32 * ks + 4 * q4) * 2); vhi[vt] = *(const LAS s16x4*)(VT + (16 * vt + fr) * 272 + (32 * ks + 16 + 4 * q4) * 2); }
                u32x4 pw; pw.x = cvt_pk_bf16(ps[2 * ks][0], ps[2 * ks][1]); pw.y = cvt_pk_bf16(ps[2 * ks][2], ps[2 * ks][3]); pw.z = cvt_pk_bf16(ps[2 * ks + 1][0], ps[2 * ks + 1][1]); pw.w = cvt_pk_bf16(ps[2 * ks + 1][2], ps[2 * ks + 1][3]);
                const bf16x8 pf = __builtin_bit_cast(bf16x8, pw);
#pragma unroll
                for (int vt = 0; vt < 5; ++vt) { const bf16x8 a = __builtin_shufflevector(vlo[vt], vhi[vt], 0, 1, 2, 3, 4, 5, 6, 7); ao[vt] = MFMA16(a, pf, ao[vt]); }
            }
        }
        { const float den = bperm(fr, ao[4][0]); const float inv = 1.0f / fmaxf(fabsf(den), emt_t);
          const int p = dir ? pbase + 127 - t : pbase + t; bf16_t* orow = HF + (size_t)(seqbase + p) * 512 + head * 128 + vh * 64 + 4 * q4;
#pragma unroll
          for (int vt = 0; vt < 4; ++vt) { const f32x4 o = ao[vt] * inv; u32x2 w; w.x = cvt_pk_bf16(o[0], o[1]); w.y = cvt_pk_bf16(o[2], o[3]); *(u32x2*)(orow + 16 * vt) = w; } }
        { const float a_s = sc_g[640];
#pragma unroll
          for (int vt = 0; vt < 5; ++vt) cs[vt] = cs[vt] * a_s;
#pragma unroll
          for (int ks = 0; ks < 4; ks += 2) { bf16x8 bb[2], va[2][5];
#pragma unroll
              for (int k2 = 0; k2 < 2; ++k2) { bb[k2] = *(const LAS bf16x8*)(KW + (16 * wave + fr) * 272 + (((4 * (ks + k2) + q4) ^ (((16 * wave + fr) >> 3) & 7)) * 16));
#pragma unroll
                  for (int vt = 0; vt < 5; ++vt) va[k2][vt] = *(const LAS bf16x8*)(VT + (16 * vt + fr) * 272 + (32 * (ks + k2) + 8 * q4) * 2); }
#pragma unroll
              for (int k2 = 0; k2 < 2; ++k2)
#pragma unroll
                  for (int vt = 0; vt < 5; ++vt) cs[vt] = MFMA16(va[k2][vt], bb[k2], cs[vt]); } }
        if (wave == 0 && j + 1 < 34) ML_STEPA((j + 1) & 1);
        ML_BAR();
    }
#undef ML_PREFETCH
#undef ML_STEPA
#undef ML_ROLES
    __syncthreads();
}
__device__ __forceinline__ void phase_mixers(Frame& F, int l) {
    const bool with_ctx = (l != DEPTH - 1);
#ifndef MIX_MASK
#define MIX_MASK 7
#endif
#ifndef MIXREP
#define MIXREP 0
#endif
    if (MIX_MASK & 1) pool_tiles(F, l, with_ctx);
    if (MIXREP & 1) { __syncthreads(); pool_tiles(F, l, with_ctx); }
    if (MIX_MASK & 2) sgu_chunks(F, l, with_ctx);
    if (MIXREP & 2) { __syncthreads(); sgu_chunks(F, l, with_ctx); }
    (void)0;
    qk_conv_pass(F, l);
}
__device__ __forceinline__ void phase_mlstm(Frame& F, int l) {
    for (int u = F.bid; u < 256; u += F.G) mlstm_unit(F, l, u);
}

struct Args { const float* in[31]; float* out; unsigned char* ws; int g_lo, g_hi, pad0, pad1; };
constexpr int NPH = 11, NGID = 2 + DEPTH * NPH;
__global__ void __launch_bounds__(NTHREADS, 2) fwd_kernel(Args args) {
    extern __shared__ __attribute__((aligned(16))) unsigned char lds_raw[];
    Frame F;
    F.lds = (LAS unsigned char*)lds_raw; F.MISC = (volatile LAS unsigned*)(F.lds + MISC_OFF);
    F.tid = threadIdx.x; F.lane = F.tid & 63; F.wave = __builtin_amdgcn_readfirstlane(F.tid >> 6); F.G = gridDim.x; F.bid = blockIdx.x;
    F.ws = args.ws; F.out = args.out;
    F.in = (InTab)__builtin_amdgcn_kernarg_segment_ptr();
    if (F.tid < 64) F.MISC[F.tid] = 0u;
    __syncthreads();
    const int lo = args.g_lo, hi = args.g_hi;
    const bool multi = (hi - lo) > 1;
    XcdBarrier bar; bar.bar = (unsigned*)(F.ws + WS_CTL) + CW_BAR; bar.x = 0; bar.st = nullptr;
    if (multi) bar = xcd_barrier_post((unsigned*)(F.ws + WS_CTL) + CW_BAR, F.MISC + 8);
#ifndef PHASE_MASK
#define PHASE_MASK 0xFFFF
#endif
#define RUN(g) (lo <= (g) && (g) < hi)
#define RUNP(ty, g) ((((PHASE_MASK) >> (ty)) & 1) && RUN(g))
#ifndef REPEAT_MASK
#define REPEAT_MASK 0
#endif
#define NREP(ty) ((((REPEAT_MASK) >> (ty)) & 1) ? 2 : 1)
#define SEAM(g) do { if (RUN((g) + 1)) xcd_barrier(bar); } while (0)
#define LAUNDER(P) Frame P = F; { int t_; asm volatile("v_mbcnt_lo_u32_b32 %0, -1, 0\n\tv_mbcnt_hi_u32_b32 %0, -1, %0" : "=v"(t_)); t_ |= (F.wave << 6); P.tid = t_; P.lane = t_ & 63; P.wave = __builtin_amdgcn_readfirstlane(t_ >> 6); GAS unsigned char* w_ = (GAS unsigned char*)F.ws; asm volatile("" : "+s"(w_)); P.ws = (unsigned char*)w_; InTab t2_ = F.in; asm volatile("" : "+s"(t2_)); P.in = t2_; }
    if (RUNP(0, 0)) { LAUNDER(P); for (int rep_ = 0; rep_ < NREP(0); ++rep_) { phase_prologue(P); __syncthreads(); } SEAM(0); }
    if (RUNP(1, 1)) { LAUNDER(P); for (int rep_ = 0; rep_ < NREP(1); ++rep_) { phase_ln0_first(P); __syncthreads(); } SEAM(1); }
#pragma unroll 1
    for (int l = 0; l < DEPTH; ++l) {
        const int g0 = 2 + l * NPH;
        const int mrows = (l == DEPTH - 1) ? ML : MT;
        if (RUNP(2, g0 + 0)) {
#undef PHTY
#define PHTY 2
            LAUNDER(P);
            { ProbPlain Pr{(const bf16_t*)(P.ws + WS_H), (const bf16_t*)(P.ws + WS_WIN) + (size_t)l * NZ * D, D, D};
              pg8::StaticOrder<1> S; S.init(MT / 256, NZ_BF / 256, P.G, P.bid);
              EpiInproj<false> E{(bf16_t*)(P.ws + WS_Z), P.in[IN_BIN] + (size_t)l * 5904, 0};
              pg8::gemm_phase(P.lds, P.tid, Pr, S, E); }
            __syncthreads();
            { ProbPlainF8 Pr{(const bf16_t*)(P.ws + WS_H8), (const bf16_t*)(P.ws + WS_WIN8 + (size_t)l * NZ_F8 * D), D / 2, D / 2};
              pg8::StaticOrder<1> S; S.init(MT / 256, NZ_F8 / 256, P.G, P.bid);
              EpiInproj<true> E{(bf16_t*)(P.ws + WS_Z), P.in[IN_BIN] + (size_t)l * 5904, NZ_BF / 256};
              pg8::gemm_phase(P.lds, P.tid, Pr, S, E); }
            SEAM(g0 + 0);
        }
        if (RUNP(3, g0 + 1)) { LAUNDER(P); for (int rep_ = 0; rep_ < NREP(3); ++rep_) { phase_mixers(P, l); __syncthreads(); } SEAM(g0 + 1); }
        if (RUNP(12, g0 + 2)) { LAUNDER(P); for (int rep_ = 0; rep_ < NREP(12); ++rep_) { phase_mlstm(P, l); __syncthreads(); } SEAM(g0 + 2); }
        if (RUNP(4, g0 + 3)) { LAUNDER(P); for (int rep_ = 0; rep_ < NREP(4); ++rep_) phase_finalize(P, l, mrows); SEAM(g0 + 3); }
        if (RUNP(5, g0 + 4)) {
#undef PHTY
#define PHTY 5
            LAUNDER(P);
            ProbPlain Pr{(const bf16_t*)(P.ws + WS_BRA), (const bf16_t*)(P.ws + WS_WBR) + (size_t)l * D * D, D, D};
            pg8::StaticOrder<1> S; S.init(mrows / 256, 4, P.G, P.bid);
            EpiBranch E{(const bf16_t*)(P.ws + WS_Z), (bf16_t*)(P.ws + WS_Y)};
            pg8::gemm_phase(P.lds, P.tid, Pr, S, E); if (NREP(PHTY) == 2) { __syncthreads(); pg8::gemm_phase(P.lds, P.tid, Pr, S, E); }
            SEAM(g0 + 4);
        }
        if (RUNP(6, g0 + 5)) {
#undef PHTY
#define PHTY 6
            LAUNDER(P);
            ProbPlain Pr{(const bf16_t*)(P.ws + WS_Y), (const bf16_t*)(P.ws + WS_WOUT) + (size_t)l * D * D, D, D};
            pg8::StaticOrder<1> S; S.init(mrows / 256, 4, P.G, P.bid);
            EpiOut E{(bf16_t*)(P.ws + WS_T)};
            pg8::gemm_phase(P.lds, P.tid, Pr, S, E); if (NREP(PHTY) == 2) { __syncthreads(); pg8::gemm_phase(P.lds, P.tid, Pr, S, E); }
            SEAM(g0 + 5);
        }
        if (RUNP(7, g0 + 6)) { LAUNDER(P); for (int rep_ = 0; rep_ < NREP(7); ++rep_) phase_ln1_router(P, l, mrows); SEAM(g0 + 6); }
        if (RUNP(8, g0 + 7)) { LAUNDER(P); for (int rep_ = 0; rep_ < NREP(8); ++rep_) phase_slots(P, mrows); SEAM(g0 + 7); }
        if (RUNP(9, g0 + 8)) {
#undef PHTY
#define PHTY 9
            LAUNDER(P);
            LAS int* seg = (LAS int*)(P.lds + TAB_OFF);
            const int ntile = moe_tables(P, seg);
            ProbMoe1 Pr{(const bf16_t*)(P.ws + WS_H2F8), (const bf16_t*)(P.ws + WS_WGU + (size_t)l * NEXP * 2048 * D), D / 2, D / 2, (const int*)(P.ws + WS_ROUTE + RT_TOK), seg};
            pg8::StaticOrder<1> S; S.init(ntile, 8, P.G, P.bid);
            EpiSwiglu E{(unsigned char*)(P.ws + WS_HID), P.in[IN_BGU] + (size_t)l * NEXP * 2048, seg};
            pg8::gemm_phase(P.lds, P.tid, Pr, S, E); if (NREP(PHTY) == 2) { __syncthreads(); pg8::gemm_phase(P.lds, P.tid, Pr, S, E); }
            SEAM(g0 + 8);
        }
        if (RUNP(10, g0 + 9)) {
#undef PHTY
#define PHTY 10
            LAUNDER(P);
            LAS int* seg = (LAS int*)(P.lds + TAB_OFF);
            const int ntile = moe_tables(P, seg);
            ProbMoe2 Pr{(const bf16_t*)(P.ws + WS_HID), (const bf16_t*)(P.ws + WS_WDN + (size_t)l * NEXP * D * D), D / 2, D / 2, seg};
            pg8::StaticOrder<1> S; S.init(ntile, 4, P.G, P.bid);
            EpiDown E{(unsigned char*)(P.ws + WS_FS), P.in[IN_BDN] + (size_t)l * NEXP * D, (const int*)(P.ws + WS_ROUTE + RT_DEST), (const float*)(P.ws + WS_ROUTE + RT_PSLOT), seg};
            pg8::gemm_phase(P.lds, P.tid, Pr, S, E); if (NREP(PHTY) == 2) { __syncthreads(); pg8::gemm_phase(P.lds, P.tid, Pr, S, E); }
            SEAM(g0 + 9);
        }
        if (RUNP(11, g0 + 10)) { LAUNDER(P); phase_combine_ln2(P, l, mrows); SEAM(g0 + 10); }
    }
#undef LAUNDER
#undef RUN
#undef RUNP
#undef SEAM
}

extern "C" void kernel_launch(void* const* d_in, const int* in_sizes, int n_in, void* d_out, int out_size, void* d_ws, size_t ws_size, hipStream_t stream) {
    static int grid = 0;
    if (grid == 0) {
        if (n_in != 31 || out_size != ML * D || ws_size < WS_END) { fprintf(stderr, "kernel_launch: unexpected problem (n_in %d, out %d, ws %zu, need %zu)\n", n_in, out_size, ws_size, (size_t)WS_END); grid = -1; return; }
        int dev = 0, cus = 0, per_cu = 0;
        if (hipGetDevice(&dev) != hipSuccess || hipDeviceGetAttribute(&cus, hipDeviceAttributeMultiprocessorCount, dev) != hipSuccess) { grid = -1; return; }
        if (hipFuncSetAttribute((const void*)fwd_kernel, hipFuncAttributeMaxDynamicSharedMemorySize, LDS_BYTES) != hipSuccess) { fprintf(stderr, "kernel_launch: hipFuncSetAttribute failed\n"); grid = -1; return; }
        if (hipOccupancyMaxActiveBlocksPerMultiprocessor(&per_cu, (const void*)fwd_kernel, NTHREADS, LDS_BYTES) != hipSuccess || per_cu < 1) fprintf(stderr, "kernel_launch: occupancy query reports %d\n", per_cu);
        (void)hipGetLastError();
        grid = cus;
    }
    if (grid < 0) return;
    (void)hipMemsetAsync((char*)d_ws + WS_CTL, 0, CTL_ZERO_BYTES, stream);
    Args a{};
    for (int i = 0; i < 31; ++i) a.in[i] = (const float*)d_in[i];
    a.out = (float*)d_out; a.ws = (unsigned char*)d_ws;
#if MK_N_LAUNCHES == 1
    a.g_lo = 0; a.g_hi = NGID;
    hipLaunchKernelGGL(fwd_kernel, dim3(grid), dim3(NTHREADS), LDS_BYTES, stream, a);
#else
    for (int g = 0; g < NGID; ++g) { a.g_lo = g; a.g_hi = g + 1; hipLaunchKernelGGL(fwd_kernel, dim3(grid), dim3(NTHREADS), LDS_BYTES, stream, a); }
#endif
}
```

```cpp
#include <hip/hip_runtime.h>
#include <cstdio>
#include <cstdint>

#ifndef MK_N_LAUNCHES
#define MK_N_LAUNCHES 1
#endif

#define LAS __attribute__((address_space(3)))
#define GAS __attribute__((address_space(1)))
typedef unsigned short bf16_t;
typedef short bf16x8 __attribute__((ext_vector_type(8)));
typedef short s16x4 __attribute__((ext_vector_type(4)));
typedef float f32x4 __attribute__((ext_vector_type(4)));
typedef float f32x2 __attribute__((ext_vector_type(2)));
typedef float f32x16 __attribute__((ext_vector_type(16)));
typedef unsigned u32x4 __attribute__((ext_vector_type(4)));
typedef unsigned u32x2 __attribute__((ext_vector_type(2)));
typedef int i32x4 __attribute__((ext_vector_type(4)));
typedef int i32x8 __attribute__((ext_vector_type(8)));

constexpr int D = 1024, NB = 16, SEQ = 4096, CTXL = 256, DEPTH = 4;
constexpr int ML = NB * SEQ;
constexpr int MC = NB * CTXL;
constexpr int MT = ML + MC;
constexpr int NZ = 5888;
constexpr int ZC_P = 0, ZC_QK = 256, ZC_V = 1280, ZC_O = 1792, ZC_UV = 2304, ZC_MG = 2816;
constexpr int NZ_BF = 1792, NZ_F8 = 4096;
constexpr int ZG_COL = 2816;
constexpr int NEXP = 32, TOPK = 4;
constexpr int NS_MAX = MT * TOPK + NEXP * 256;
constexpr float LN_EPS = 1e-5f, HEAD_EPS = 1e-6f;
constexpr float DN_ALPHA = 1.6817928305074292f;
constexpr int NWAVES = 8, NTHREADS = 512;
constexpr float F8S_ACT = 4.0f, F8S_WGU = 64.0f, F8S_WDN = 64.0f; constexpr int F8E_ACT = 123, F8E_WGU = 123, F8E_WDN = 123;

constexpr size_t MiB = 1u << 20;
constexpr size_t WS_CTL = 0, CTL_ZERO_BYTES = 1 * MiB;
constexpr size_t WS_MOD = 1 * MiB;
constexpr size_t WS_WG = 3 * MiB;
constexpr size_t WS_WSGU = 4 * MiB;
constexpr size_t WS_WPOOL = WS_WSGU + 512 * 1024;
constexpr size_t WS_ROUTE = 5 * MiB;
constexpr size_t WS_WIN = 16 * MiB;
constexpr size_t WS_WBR = 62 * MiB;
constexpr size_t WS_WOUT = 70 * MiB;
constexpr size_t WS_WGU = 78 * MiB;
constexpr size_t WS_WDN = 590 * MiB;
constexpr size_t WS_X = 846 * MiB;
constexpr size_t WS_H = 1118 * MiB;
constexpr size_t WS_Z = 1254 * MiB;
constexpr size_t WS_FS = WS_Z;
constexpr float G8_SCALE = 255.0f;
constexpr float FS_SCALE = 32.0f, FS_CLAMP = 440.0f;
constexpr size_t WS_BRA = 2036 * MiB;
constexpr size_t WS_HFB = 2172 * MiB;
constexpr size_t WS_Y = 2444 * MiB;
constexpr size_t WS_T = 2580 * MiB;
constexpr size_t WS_H2 = 2852 * MiB;
constexpr size_t WS_HID = 2988 * MiB;
constexpr size_t WS_ZG = 3548 * MiB;
constexpr size_t WS_H2F8 = 3554 * MiB;
constexpr size_t WS_H8 = 3624 * MiB;
constexpr size_t WS_WIN8 = 3692 * MiB;
constexpr size_t WS_END = 3708 * MiB;
static_assert(WS_Z + (size_t)MT * NZ * 2 <= WS_BRA && WS_FS + (size_t)MT * 4 * 1024 * 2 <= WS_BRA, "Z/FS");
static_assert(WS_HID + (size_t)NS_MAX * 1024 * 2 <= WS_END, "HID");
constexpr size_t RT_EIDX = 0;
constexpr size_t RT_PROB = 2 * MiB;
constexpr size_t RT_TOK = 4 * MiB;
constexpr size_t RT_DEST = 6 * MiB;
constexpr size_t RT_PSLOT = 8 * MiB;
constexpr size_t RT_CNT = 10 * MiB;
constexpr size_t RT_SEG = 10 * MiB + 64 * 1024;
constexpr int CW_BAR = 4096;

constexpr int LDS_BYTES = 163840;
constexpr int MISC_OFF = LDS_BYTES - 256;
constexpr int TAB_OFF = 131072;
constexpr int NW_WT = 0;
constexpr int NW_LG = 66048;
constexpr int NW_END = 99840;
constexpr int NW_PV = NW_END + 256;

__device__ __forceinline__ unsigned f2bf(float f) { unsigned u = __builtin_bit_cast(unsigned, f); return (u + 0x7fffu + ((u >> 16) & 1u)) >> 16; }
__device__ __forceinline__ unsigned pk2(float lo, float hi) { unsigned r; asm volatile("v_cvt_pk_bf16_f32 %0, %1, %2" : "=v"(r) : "v"(lo), "v"(hi)); return r; }
__device__ __forceinline__ unsigned pk4_fp8(float a, float b, float c, float d) { int w = 0; w = __builtin_amdgcn_cvt_pk_fp8_f32(a, b, w, false); w = __builtin_amdgcn_cvt_pk_fp8_f32(c, d, w, true); return (unsigned)w; }
__device__ __forceinline__ unsigned pk4_u8(float a, float b, float c, float d) {
    const unsigned lo = __builtin_amdgcn_perm(__builtin_bit_cast(unsigned, b), __builtin_bit_cast(unsigned, a), 0x0c0c0400u), hi = __builtin_amdgcn_perm(__builtin_bit_cast(unsigned, d), __builtin_bit_cast(unsigned, c), 0x0c0c0400u);
    return lo | (hi << 16); }
__device__ __forceinline__ f32x4 u8x4_f32(unsigned w) { return (f32x4){(float)(w & 0xffu), (float)((w >> 8) & 0xffu), (float)((w >> 16) & 0xffu), (float)(w >> 24)}; }
__device__ __forceinline__ float bflo(unsigned w) { return __builtin_bit_cast(float, w << 16); }
__device__ __forceinline__ float bfhi(unsigned w) { return __builtin_bit_cast(float, w & 0xffff0000u); }
__device__ __forceinline__ float bf1(bf16_t h) { return __builtin_bit_cast(float, ((unsigned)h) << 16); }
__device__ __forceinline__ float bperm(int srclane, float v) { return __builtin_bit_cast(float, __builtin_amdgcn_ds_bpermute(srclane << 2, __builtin_bit_cast(int, v))); }
__device__ __forceinline__ float shx(float v, int o, int lane) { return bperm(lane ^ o, v); }
__device__ __forceinline__ float shup(float v, int o, int lane) { return bperm(lane >= o ? lane - o : lane, v); }
__device__ __forceinline__ float wave_sum(float v, int lane) {
#pragma unroll
    for (int o = 1; o < 64; o <<= 1) v += shx(v, o, lane);
    return v;
}
__device__ __forceinline__ float sigmoidf_(float x) { return __builtin_amdgcn_rcpf(1.0f + __builtin_amdgcn_exp2f(x * -1.4426950408889634f)); }
__device__ __forceinline__ float siluf_(float x) { return x * __builtin_amdgcn_rcpf(1.0f + __builtin_amdgcn_exp2f(x * -1.4426950408889634f)); }
#define LDS_WAIT() asm volatile("s_waitcnt lgkmcnt(0)" ::: "memory")
#define VM_WAIT() asm volatile("s_waitcnt vmcnt(0)" ::: "memory")

#define XB_TMO      128
#define XB_XCNT(j)  (256  + 64 * (j))
#define XB_XSUB(j)  (1280 + 64 * (j))
#define XB_XGEN(j)  (2304 + 64 * (j))
#define XB_TOP      3328
#define XB_TOPGEN   3392
#define XCD_BAR_WORDS 3456
#define XB_SPIN_CAP (1u << 18)
__device__ __forceinline__ unsigned xb_ld(unsigned* p)              { asm volatile("" : "+v"(p)); return __hip_atomic_load(p, __ATOMIC_RELAXED, __HIP_MEMORY_SCOPE_AGENT); }
__device__ __forceinline__ unsigned xb_add(unsigned* p, unsigned v) { asm volatile("" : "+v"(p), "+v"(v)); return __hip_atomic_fetch_add(p, v, __ATOMIC_RELAXED, __HIP_MEMORY_SCOPE_AGENT); }
__device__ __forceinline__ unsigned xb_xcc_id() { return (unsigned)__builtin_amdgcn_s_getreg((3 << 11) | 20) & 0xFu; }
#define XB_SPIN(cond, bar) do { unsigned _sp = 0; while (cond) { __builtin_amdgcn_s_sleep(1); \
    if ((++_sp & 255u) == 0u) { if (xb_ld(&(bar)[XB_TMO])) break; if (_sp > XB_SPIN_CAP) { atomicAdd(&(bar)[XB_TMO], 1u); break; } } } } while (0)
struct XcdBarrier { unsigned* bar; unsigned x; volatile LAS unsigned* st; };
__device__ __forceinline__ XcdBarrier xcd_barrier_post(unsigned* bar, volatile LAS unsigned* st) {
    XcdBarrier b; b.bar = bar; b.x = xb_xcc_id(); b.st = st;
    if (threadIdx.x == 0) (void)xb_add(&bar[XB_XCNT(b.x)], 1u);
    return b;
}
__device__ __forceinline__ void xcd_barrier_complete(unsigned* bar, unsigned x, unsigned& nloc, unsigned& nx) {
    const unsigned G = gridDim.x * gridDim.y * gridDim.z;
    unsigned sum, cnt, mine, sp = 0u;
    for (;;) {
        sum = 0u; cnt = 0u; mine = 0u;
#pragma unroll
        for (unsigned j = 0; j < 16; ++j) { const unsigned c = xb_ld(&bar[XB_XCNT(j)]); sum += c; cnt += (c > 0u) ? 1u : 0u; mine = (j == x) ? c : mine; }
        if (sum == G) break;
        __builtin_amdgcn_s_sleep(1);
        if ((++sp & 255u) == 0u) { if (xb_ld(&bar[XB_TMO])) break; if (sp > XB_SPIN_CAP) { atomicAdd(&bar[XB_TMO], 1u); break; } }
    }
    nloc = mine > 0u ? mine : 1u; nx = cnt > 0u ? cnt : 1u;
}
__device__ __forceinline__ void xcd_barrier(const XcdBarrier& b) {
    asm volatile("s_waitcnt vmcnt(0)" ::: "memory");
    __syncthreads();
    if (threadIdx.x == 0) {
        unsigned* bar = b.bar;
        __builtin_amdgcn_s_waitcnt(0);
        unsigned nloc = b.st[0], nx = b.st[1];
        if (nloc == 0u) { xcd_barrier_complete(bar, b.x, nloc, nx); b.st[0] = nloc; b.st[1] = nx; }
        const unsigned old = xb_add(&bar[XB_XSUB(b.x)], 1u);
        const unsigned gen = old / nloc;
        if (old + 1u == (gen + 1u) * nloc) {
            __builtin_amdgcn_fence(__ATOMIC_RELEASE, "agent");
            asm volatile("s_waitcnt vmcnt(0)" ::: "memory");
            const unsigned og = xb_add(&bar[XB_TOP], 1u);
            const unsigned tg = og / nx;
            if (og + 1u == (tg + 1u) * nx) xb_add(&bar[XB_TOPGEN], 1u);
            else XB_SPIN(xb_ld(&bar[XB_TOPGEN]) == tg, bar);
            __builtin_amdgcn_fence(__ATOMIC_ACQUIRE, "agent");
            xb_add(&bar[XB_XGEN(b.x)], 1u);
            asm volatile("s_waitcnt vmcnt(0)" ::: "memory");
        } else {
            XB_SPIN(xb_ld(&bar[XB_XGEN(b.x)]) == gen, bar);
            __builtin_amdgcn_fence(__ATOMIC_ACQUIRE, "agent");
            asm volatile("s_waitcnt vmcnt(0)" ::: "memory");
        }
    }
    __syncthreads();
}

namespace pg8 {
constexpr int BM = 256, BK = 64, HALF = 128, HTB = HALF * BK * 2, STAGE_BYTES = 8 * HTB, NXCD = 8, WGM = 8;
__host__ __device__ __forceinline__ int lds_byte(int r, int c) { const int st = (r >> 4) * 2 + (c >> 5), rr = r & 15, cc = c & 31, ob = rr * 64 + cc * 2; return st * 1024 + (ob ^ (((ob >> 9) & 1) << 5)); }
__host__ __device__ __forceinline__ void stage_rc(int b, int& R, int& C) { const int st = b / 1024, sb = b % 1024, swz = sb ^ (((sb >> 9) & 1) << 5); R = (st >> 1) * 16 + swz / 64; C = (st & 1) * 32 + (swz % 64) / 2; }
__host__ __device__ __forceinline__ int perm32(int rho) { const int n = rho >> 4, i = rho & 15; return 8 * (i >> 2) + 4 * n + (i & 3); }
struct Unit { int pm, pn, sub; };
__device__ __forceinline__ unsigned cvt_pk_bf16(float lo, float hi) { unsigned r; asm volatile("v_cvt_pk_bf16_f32 %0, %1, %2" : "=v"(r) : "v"(lo), "v"(hi)); return r; }
__device__ __forceinline__ f32x2 gelu_pk(f32x2 v) {
    const f32x2 av = __builtin_elementwise_abs(v), d = av * 0.2316418882f + 1.0f;
    f32x2 t; t.x = __builtin_amdgcn_rcpf(d.x); t.y = __builtin_amdgcn_rcpf(d.y);
    f32x2 q = t * 0.5307027145f + (-0.7265760135f); q = q * t + 0.7107068705f; q = q * t + (-0.142248368f); q = q * t + 0.127414796f; q = q * t;
    const f32x2 s = (v * v) * (-0.72134752044f);
    f32x2 e; e.x = __builtin_amdgcn_exp2f(s.x); e.y = __builtin_amdgcn_exp2f(s.y);
    const f32x2 m = v * (q * e), r = v - m;
    f32x2 o; o.x = v.x < 0.f ? m.x : r.x; o.y = v.y < 0.f ? m.y : r.y; return o;
}
template <int NSUB = 1> struct StaticOrder {
    int nM, nN, nwg, G, c;
    __device__ void init(int nM_, int nN_, int G_, int c_) { nM = nM_; nN = nN_; nwg = nM * nN; G = G_; c = c_; }
    __device__ bool next(int i, Unit& u) const {
        const int it = i / NSUB; u.sub = i - it * NSUB;
        const long L = (long)it * G + c; if (L >= nwg) return false;
        int wgid = (int)L; { const int q = nwg / NXCD, r = nwg % NXCD, xcd = wgid % NXCD, off = wgid / NXCD; wgid = (xcd < r ? xcd * (q + 1) : r * (q + 1) + (xcd - r) * q) + off; }
        const int nig = WGM * nN, gid = wgid / nig, fm = gid * WGM, gsz = (nM - fm) < WGM ? (nM - fm) : WGM;
        u.pm = fm + ((wgid % nig) % gsz); u.pn = (wgid % nig) / gsz; return true;
    }
};
constexpr int SIDE_TOK = 131072 + 2048;
constexpr int SIDE_SLOT = 131072 + 10240, SIDE_SLOT_BYTES = 3072;
__device__ __forceinline__ void dma16(unsigned voff, const void* sbase, unsigned ldsaddr) { asm volatile("s_mov_b32 m0, %2\n\tglobal_load_lds_dwordx4 %0, %1" :: "v"(voff), "s"(sbase), "s"(ldsaddr) : "memory", "m0"); }
__device__ __forceinline__ void dma4(unsigned voff, const void* sbase, unsigned ldsaddr) { asm volatile("s_mov_b32 m0, %2\n\tglobal_load_lds_dword %0, %1" :: "v"(voff), "s"(sbase), "s"(ldsaddr) : "memory", "m0"); }
template <class Prob, class Sched, class Epi>
__device__ __forceinline__ void gemm_phase(LAS unsigned char* lds, const int tid, const Prob& P, const Sched& S, const Epi& E) {
    const int wid = __builtin_amdgcn_readfirstlane(tid >> 6), lane = tid & 63, wr = wid >> 2, wc = wid & 3, fr = lane & 15, fq = lane >> 4;
    const int lda = P.lda, ldb = P.ldb;
    unsigned voffB[2], offA[2][2];
#define PG8_TOKSLOT(name) const LAS int* name; { PG8_TID(tl2_); name = (const LAS int*)(lds + SIDE_TOK) + (tl2_ >> 6) * 256 + (tl2_ & 63); }
#define PG8_TID(v_) int v_; asm volatile("v_mbcnt_lo_u32_b32 %0, -1, 0\n\tv_mbcnt_hi_u32_b32 %0, -1, %0" : "=v"(v_)); v_ |= (wid << 6)
#define PG8_RC(R_, C_) int R_[2], C_[2]; { PG8_TID(tl_); _Pragma("unroll") for (int i_ = 0; i_ < 2; ++i_) stage_rc(tl_ * 16 + i_ * 8192, R_[i_], C_[i_]); }
#pragma unroll
    for (int i = 0; i < 2; ++i) { int R, C; stage_rc(tid * 16 + i * 8192, R, C); const int Rb = Epi::PERM ? ((R & ~31) + perm32(R & 31)) : R;
        voffB[i] = (unsigned)(Rb * ldb + C) * 2u;
        offA[0][i] = (unsigned)(R * lda + C) * 2u; offA[1][i] = (unsigned)((R + HALF) * lda + C) * 2u; }
    const size_t kstep = (size_t)(BK * 2);
    const size_t hstep = (size_t)HALF * ldb * 2;
    const unsigned ldsw = (unsigned)wid * 1024u;
    const int aoff = lds_byte(wr * 64 + fr, fq * 8), boff = lds_byte(wc * 32 + fr, fq * 8);
#define PG8_SA(b, h) (((b) * 2 + (h)) * HTB)
#define PG8_SB(b, h) ((4 + (b) * 2 + (h)) * HTB)
    const unsigned ldsb = (unsigned)(size_t)lds;
#define PG8_STAGE(bufoff, gbase, voff) do { _Pragma("unroll") for (int _i = 0; _i < 2; ++_i) \
        asm volatile("s_mov_b32 m0, %2\n\tglobal_load_lds_dwordx4 %0, %1" :: "v"((voff)[_i]), "s"((const char*)(gbase)), "s"(ldsb + (unsigned)(bufoff) + ldsw + (unsigned)(_i * 8192)) : "memory", "m0"); } while (0)
#define PG8_CAT(x0, x1) __builtin_shufflevector(x0, x1, 0, 1, 2, 3, 4, 5, 6, 7)
#define PG8_LDA(dst, b, h) do { if constexpr (Prob::FP8) { _Pragma("unroll") for (int m = 0; m < 4; ++m) dst##8[m] = PG8_CAT(*(const LAS i32x4*)(lds + PG8_SA(b, h) + aoff + m * 2048), *(const LAS i32x4*)(lds + PG8_SA(b, h) + aoff + m * 2048 + 1024)); } \
        else { _Pragma("unroll") for (int m = 0; m < 4; ++m) _Pragma("unroll") for (int k = 0; k < 2; ++k) dst[m][k] = *(const LAS bf16x8*)(lds + PG8_SA(b, h) + aoff + m * 2048 + k * 1024); } } while (0)
#define PG8_LDB(dst, b, h) do { if constexpr (Prob::FP8) { _Pragma("unroll") for (int n = 0; n < 2; ++n) dst##8[n] = PG8_CAT(*(const LAS i32x4*)(lds + PG8_SB(b, h) + boff + n * 2048), *(const LAS i32x4*)(lds + PG8_SB(b, h) + boff + n * 2048 + 1024)); } \
        else { _Pragma("unroll") for (int n = 0; n < 2; ++n) _Pragma("unroll") for (int k = 0; k < 2; ++k) dst[n][k] = *(const LAS bf16x8*)(lds + PG8_SB(b, h) + boff + n * 2048 + k * 1024); } } while (0)
#define PG8_MMA(ai, bj, At, Bt) do { __builtin_amdgcn_s_setprio(1); \
        if constexpr (Prob::FP8) { _Pragma("unroll") for (int m = 0; m < 4; ++m) _Pragma("unroll") for (int n = 0; n < 2; ++n) \
            acc[ai][bj][m][n] = __builtin_amdgcn_mfma_scale_f32_16x16x128_f8f6f4(Bt##8[n], At##8[m], acc[ai][bj][m][n], 0, 0, 0, sc8_, 0, sc8_); } \
        else { _Pragma("unroll") for (int m = 0; m < 4; ++m) _Pragma("unroll") for (int n = 0; n < 2; ++n) _Pragma("unroll") for (int k = 0; k < 2; ++k) \
            acc[ai][bj][m][n] = __builtin_amdgcn_mfma_f32_16x16x32_bf16(Bt[n][k], At[m][k], acc[ai][bj][m][n], 0, 0, 0); } \
        __builtin_amdgcn_s_setprio(0); } while (0)
#define PG8_WAIT_V(n) asm volatile("s_waitcnt vmcnt(" #n ")" ::: "memory")
#define PG8_WAIT_L(n) asm volatile("s_waitcnt lgkmcnt(" #n ")" ::: "memory")
#define PG8_BAR __builtin_amdgcn_s_barrier()
#define PG8_SCHED __builtin_amdgcn_sched_barrier(0)
    Unit cur, nxt; int ui = 0;
    if (!S.next(0, cur)) return;
    static_assert(Prob::SCALE_A == Prob::SCALE_B, "one scale register serves both operands");
    int sc8_; asm volatile("v_mov_b32 %0, %1" : "=v"(sc8_) : "n"(Prob::SCALE_A));
    f32x4 acc[2][2][4][2];
    float zero_; asm volatile("v_mov_b32 %0, 0" : "=v"(zero_));
#pragma unroll
    for (int a = 0; a < 2; ++a)
#pragma unroll
        for (int b = 0; b < 2; ++b)
#pragma unroll
            for (int m = 0; m < 4; ++m)
#pragma unroll
                for (int n = 0; n < 2; ++n) acc[a][b][m][n] = (f32x4){zero_, zero_, zero_, zero_};
    bf16x8 At[4][2], B0[2][2], B1[2][2]; i32x8 At8[4], B08[2], B18[2];
    const char* cA = P.a_base(cur); const char* cB = P.b_base(cur); int nt = P.nt(cur);
    if constexpr (Prob::GATHER) { PG8_RC(Rr, Cc); P.a_rows(cur, Rr, Cc, offA); }
    if constexpr (Epi::SIDE) { PG8_TID(tl4_); E.side(cur, ldsb + SIDE_SLOT, wid, tl4_ & 63); }
    PG8_STAGE(PG8_SB(0, 0), cB, voffB); PG8_STAGE(PG8_SB(0, 1), cB + hstep, voffB); PG8_STAGE(PG8_SA(0, 0), cA, offA[0]); PG8_STAGE(PG8_SA(0, 1), cA, offA[1]);
    if (wr == 1) PG8_BAR;
    PG8_WAIT_V(2); PG8_BAR;
    PG8_STAGE(PG8_SB(1, 0), cB + kstep, voffB); PG8_STAGE(PG8_SA(1, 0), cA + kstep, offA[0]); PG8_STAGE(PG8_SB(1, 1), cB + hstep + kstep, voffB);
    PG8_WAIT_V(6); PG8_BAR;
    for (;;) {
        const bool has_next = S.next(ui + 1, nxt);
        const char* nA = has_next ? P.a_base(nxt) : cA; const char* nB = has_next ? P.b_base(nxt) : cB;
        if constexpr (Prob::GATHER) { if (has_next) { PG8_RC(Rr, Cc); (void)Cc;
#pragma unroll
            for (int h = 0; h < 2; ++h)
#pragma unroll
                for (int i = 0; i < 2; ++i) dma4((unsigned)(nxt.pm * 256 + h * 128 + Rr[i]) * 4u, P.tok, ldsb + SIDE_TOK + (unsigned)wid * 1024u + (unsigned)((h * 2 + i) * 256)); } }
        if constexpr (Epi::SIDE) { if (has_next) { PG8_TID(tl4_); E.side(nxt, ldsb + SIDE_SLOT + (unsigned)(((ui + 1) % 3) * SIDE_SLOT_BYTES), wid, tl4_ & 63); } }
        for (int t = 0; t < nt; t += 2) {
            const bool last = (t == nt - 2);
            if constexpr (Epi::KHOOK) { if (t == Epi::HOOK_T0 || t == Epi::HOOK_T1) {
                asm volatile("" ::: "memory"); PG8_TID(tlh_); const int lnh_ = tlh_ & 63; E.hook(acc, cur, t == Epi::HOOK_T0 ? 0 : 1, wr, wc, lnh_ & 15, lnh_ >> 4); asm volatile("" ::: "memory"); } }
            const char* a1 = cA + (size_t)(t + 1) * kstep;
            const char* a2 = last ? nA : cA + (size_t)(t + 2) * kstep; const char* b2 = last ? nB : cB + (size_t)(t + 2) * kstep;
            const char* a3 = a2 + kstep; const char* b3 = b2 + kstep;
            PG8_LDB(B0, 0, 0); PG8_LDB(B1, 0, 1); PG8_SCHED; PG8_LDA(At, 0, 0); PG8_STAGE(PG8_SA(1, 1), a1, offA[1]);
            PG8_WAIT_V(8); PG8_WAIT_L(0); PG8_BAR; PG8_MMA(0, 0, At, B0); PG8_MMA(0, 1, At, B1); PG8_BAR; PG8_SCHED;
            if constexpr (Prob::GATHER) { if (last && has_next) { PG8_RC(Rr, Cc); (void)Rr; PG8_TOKSLOT(tokslot); const int ntok[2][2] = {{tokslot[0], tokslot[64]}, {tokslot[128], tokslot[192]}}; P.a_off(ntok, Cc, offA); } }
            PG8_LDA(At, 0, 1); PG8_STAGE(PG8_SB(0, 0), b2, voffB); PG8_STAGE(PG8_SB(0, 1), b2 + hstep, voffB); PG8_STAGE(PG8_SA(0, 0), a2, offA[0]);
            PG8_WAIT_V(8); PG8_WAIT_L(0); PG8_BAR; PG8_MMA(1, 0, At, B0); PG8_MMA(1, 1, At, B1); PG8_BAR; PG8_SCHED;
            PG8_LDB(B0, 1, 0); PG8_LDB(B1, 1, 1); PG8_SCHED; PG8_LDA(At, 1, 0); PG8_STAGE(PG8_SA(0, 1), a2, offA[1]);
            PG8_WAIT_V(8); PG8_WAIT_L(0); PG8_BAR; PG8_MMA(0, 0, At, B0); PG8_MMA(0, 1, At, B1); PG8_BAR; PG8_SCHED;
            PG8_LDA(At, 1, 1); PG8_STAGE(PG8_SB(1, 0), b3, voffB); PG8_STAGE(PG8_SB(1, 1), b3 + hstep, voffB); PG8_STAGE(PG8_SA(1, 0), a3, offA[0]);
            PG8_WAIT_V(8); PG8_WAIT_L(0); PG8_BAR; PG8_MMA(1, 0, At, B0); PG8_MMA(1, 1, At, B1); PG8_BAR; PG8_SCHED;
        }
        if (wr == 0) PG8_BAR;
        { PG8_TID(tl3_); const int ln_ = tl3_ & 63; E(acc, cur, wr, wc, ln_ & 15, ln_ >> 4, lds + SIDE_SLOT + (ui % 3) * SIDE_SLOT_BYTES); }
        if (!has_next) break;
        bool keep = false;
        if constexpr (Epi::CHAIN) keep = E.keep(cur);
        if (!keep) {
            asm volatile("v_mov_b32 %0, 0" : "=v"(zero_));
#pragma unroll
            for (int a = 0; a < 2; ++a)
#pragma unroll
                for (int b = 0; b < 2; ++b)
#pragma unroll
                    for (int m = 0; m < 4; ++m)
#pragma unroll
                        for (int n = 0; n < 2; ++n) acc[a][b][m][n] = (f32x4){zero_, zero_, zero_, zero_};
        }
        cur = nxt; cA = nA; cB = nB; nt = P.nt(cur); ++ui;
        if (wr == 1) PG8_BAR;
    }
    PG8_WAIT_V(0);
    PG8_BAR;
#undef PG8_RC
#undef PG8_TID
#undef PG8_TOKSLOT
#undef PG8_SA
#undef PG8_SB
#undef PG8_STAGE
#undef PG8_LDA
#undef PG8_LDB
#undef PG8_MMA
#undef PG8_CAT
#undef PG8_WAIT_V
#undef PG8_WAIT_L
#undef PG8_BAR
#undef PG8_SCHED
}
}

typedef const float* cfp_t;
typedef const cfp_t __attribute__((address_space(4))) * InTab;
struct Frame {
    LAS unsigned char* lds;
    volatile LAS unsigned* MISC;
    unsigned char* ws;
    InTab in;
    float* out;
    int tid, lane, wave, G, bid;
};
enum { IN_X = 0, IN_C, IN_CTX, IN_CCTX, IN_WADA, IN_BADA, IN_WIN, IN_BIN, IN_POOLW, IN_POOLS, IN_CONVW, IN_CONVB, IN_MNG, IN_SLNG, IN_SLNB, IN_SGUW, IN_SGUB,
       IN_WBP, IN_WBM, IN_WBS, IN_WOUT, IN_LN1G, IN_LN1B, IN_WR, IN_BR, IN_WGU, IN_BGU, IN_WDN, IN_BDN, IN_LN2G, IN_LN2B };
__device__ __forceinline__ int mod_row(int row) { return row < ML ? (row >> 12) : NB; }
__device__ __forceinline__ const float* modp(const Frame& F, int l, int row, int part) { return (const float*)(F.ws + WS_MOD) + ((size_t)(l * 17 + mod_row(row)) * 6 + part) * 1024; }

__device__ __forceinline__ void transpose_item(const float* W, size_t ldw, int k0, int srccol0, bf16_t* dst, size_t ldk, int kd0, LAS float* scr, int lane) {
#pragma unroll 8
    for (int i = 0; i < 32; ++i) { const int kk = 2 * i + (lane >> 5); scr[kk * 33 + (lane & 31)] = __builtin_nontemporal_load(W + (size_t)(k0 + kk) * ldw + srccol0 + (lane & 31)); }
    LDS_WAIT(); asm volatile("" ::: "memory");
    const int c = lane & 7;
#pragma unroll
    for (int j = 0; j < 4; ++j) { const int n = (lane >> 3) + 8 * j; const LAS float* s = scr + (8 * c) * 33 + n;
        u32x4 o; o.x = pk2(s[0 * 33], s[1 * 33]); o.y = pk2(s[2 * 33], s[3 * 33]); o.z = pk2(s[4 * 33], s[5 * 33]); o.w = pk2(s[6 * 33], s[7 * 33]);
        *(u32x4*)(dst + (size_t)n * ldk + kd0 + 8 * c) = o; }
    LDS_WAIT(); asm volatile("" ::: "memory");
}
__device__ __forceinline__ void transpose_item_fp8(const float* W, size_t ldw, int k0, int srccol0, unsigned char* dst, size_t ldk, int kd0, float sc, LAS float* scr, int lane) {
#pragma unroll 8
    for (int i = 0; i < 32; ++i) { const int kk = 2 * i + (lane >> 5); scr[kk * 33 + (lane & 31)] = __builtin_nontemporal_load(W + (size_t)(k0 + kk) * ldw + srccol0 + (lane & 31)); }
    LDS_WAIT(); asm volatile("" ::: "memory");
    const int c = lane & 7;
#pragma unroll
    for (int j = 0; j < 4; ++j) { const int n = (lane >> 3) + 8 * j; const LAS float* s_ = scr + (8 * c) * 33 + n;
        u32x2 o; o.x = pk4_fp8(s_[0 * 33] * sc, s_[1 * 33] * sc, s_[2 * 33] * sc, s_[3 * 33] * sc); o.y = pk4_fp8(s_[4 * 33] * sc, s_[5 * 33] * sc, s_[6 * 33] * sc, s_[7 * 33] * sc);
        *(u32x2*)(dst + (size_t)n * ldk + kd0 + 8 * c) = o; }
    LDS_WAIT(); asm volatile("" ::: "memory");
}
__device__ __forceinline__ void phase_prologue(Frame& F) {
    LAS float* scr = (LAS float*)(F.lds + F.wave * 16384);
    const int gw = F.bid * NWAVES + F.wave, NGW = F.G * NWAVES;
    constexpr int I_IN = 16 * (NZ / 32);
    constexpr int I_BR = (4 + 8 + 4) * 32;
    constexpr int I_OUT = 16 * 32;
    constexpr int I_GU = 16 * 64;
    constexpr int I_DN = 16 * 32;
    constexpr int T_IN = DEPTH * I_IN, T_BR = DEPTH * I_BR, T_OUT = DEPTH * I_OUT, T_GU = DEPTH * NEXP * I_GU, T_DN = DEPTH * NEXP * I_DN;
    constexpr int NITEMS = T_IN + T_BR + T_OUT + T_GU + T_DN;
    for (int it = gw; it < NITEMS; it += NGW) {
        int r = it;
        if (r < T_IN) { const int l = r / I_IN; r %= I_IN; const int kb = r / (NZ / 32), nb = r % (NZ / 32); const int n0 = nb * 32, src = n0 < 2304 ? n0 : n0 + 16;
            if (n0 < NZ_BF) transpose_item(F.in[IN_WIN] + (size_t)l * D * 5904, 5904, kb * 64, src, (bf16_t*)(F.ws + WS_WIN) + ((size_t)l * NZ + n0) * D, D, kb * 64, scr, F.lane);
            else transpose_item_fp8(F.in[IN_WIN] + (size_t)l * D * 5904, 5904, kb * 64, src, (unsigned char*)(F.ws + WS_WIN8) + ((size_t)l * NZ_F8 + (n0 - NZ_BF)) * D, D, kb * 64, F8S_WGU, scr, F.lane);
            continue; }
        r -= T_IN;
        if (r < T_BR) { const int l = r / I_BR; r %= I_BR; const int kb = r / 32, nb = r % 32;
            const float* W; int ksrc;
            if (kb < 4) { W = F.in[IN_WBP] + (size_t)l * 256 * D; ksrc = kb * 64; } else if (kb < 12) { W = F.in[IN_WBM] + (size_t)l * 512 * D; ksrc = (kb - 4) * 64; } else { W = F.in[IN_WBS] + (size_t)l * 256 * D; ksrc = (kb - 12) * 64; }
            transpose_item(W, D, ksrc, nb * 32, (bf16_t*)(F.ws + WS_WBR) + ((size_t)l * D + nb * 32) * D, D, kb * 64, scr, F.lane); continue; }
        r -= T_BR;
        if (r < T_OUT) { const int l = r / I_OUT; r %= I_OUT; const int kb = r / 32, nb = r % 32;
            transpose_item(F.in[IN_WOUT] + (size_t)l * D * D, D, kb * 64, nb * 32, (bf16_t*)(F.ws + WS_WOUT) + ((size_t)l * D + nb * 32) * D, D, kb * 64, scr, F.lane); continue; }
        r -= T_OUT;
        if (r < T_GU) { const int le = r / I_GU; r %= I_GU; const int kb = r / 64, nb = r % 64; const int n0 = nb * 32;
            const int pn = n0 >> 8, c = n0 & 255; const int src = c < 128 ? (128 * pn + c) : (1024 + 128 * pn + c - 128);
            transpose_item_fp8(F.in[IN_WGU] + (size_t)le * D * 2048, 2048, kb * 64, src, (unsigned char*)(F.ws + WS_WGU) + ((size_t)le * 2048 + n0) * D, D, kb * 64, F8S_WGU, scr, F.lane); continue; }
        r -= T_GU;
        { const int le = r / I_DN; r %= I_DN; const int kb = r / 32, nb = r % 32;
            transpose_item_fp8(F.in[IN_WDN] + (size_t)le * D * D, D, kb * 64, nb * 32, (unsigned char*)(F.ws + WS_WDN) + ((size_t)le * D + nb * 32) * D, D, kb * 64, F8S_WDN, scr, F.lane); }
    }
    { const int gt = F.bid * NTHREADS + F.tid, NGT = F.G * NTHREADS;
      for (int i = gt; i < DEPTH * 16 * 1024; i += NGT) { const int l = i >> 14, g = (i >> 10) & 15, k = i & 1023; ((float*)(F.ws + WS_WG))[i] = F.in[IN_WIN][((size_t)l * D + k) * 5904 + 2304 + g]; }
      for (int i = gt; i < DEPTH * 4 * 128 * 128; i += NGT) ((bf16_t*)(F.ws + WS_WSGU))[i] = (bf16_t)f2bf(F.in[IN_SGUW][i]);
      for (int i = gt; i < DEPTH * 4 * 64 * 64; i += NGT) { const int lg = i >> 12, d = (i >> 6) & 63, c = i & 63; ((bf16_t*)(F.ws + WS_WPOOL))[i] = (bf16_t)f2bf(F.in[IN_POOLW][(size_t)lg * 4096 + c * 64 + d]); } }
    __syncthreads();
    { LAS float* sc = (LAS float*)F.lds;
      LAS float* part = (LAS float*)(F.lds + 71680);
      for (int i = F.tid; i < 17 * 1024; i += NTHREADS) { const int r = i >> 10, k = i & 1023; const float v = r < 16 ? F.in[IN_C][r * 1024 + k] : F.in[IN_CCTX][k]; sc[i] = siluf_(v); }
      __syncthreads();
      for (int u = F.bid; u < DEPTH * 48; u += F.G) {
          const int l = u / 48, n0 = (u % 48) * 128, col = F.tid & 127, ks = F.tid >> 7;
          float a[17];
#pragma unroll
          for (int r = 0; r < 17; ++r) a[r] = 0.f;
          const float* W = F.in[IN_WADA] + (size_t)l * D * 6144 + n0 + col;
          for (int k = ks * 256; k < ks * 256 + 256; ++k) { const float w = W[(size_t)k * 6144];
#pragma unroll
              for (int r = 0; r < 17; ++r) a[r] += sc[r * 1024 + k] * w; }
#pragma unroll
          for (int r = 0; r < 17; ++r) part[(ks * 17 + r) * 128 + col] = a[r];
          __syncthreads();
          for (int i = F.tid; i < 17 * 128; i += NTHREADS) { const int r = i >> 7, cc = i & 127;
              const float s = part[(0 * 17 + r) * 128 + cc] + part[(1 * 17 + r) * 128 + cc] + part[(2 * 17 + r) * 128 + cc] + part[(3 * 17 + r) * 128 + cc] + F.in[IN_BADA][l * 6144 + n0 + cc];
              ((float*)(F.ws + WS_MOD))[(size_t)(l * 17 + r) * 6144 + n0 + cc] = s; }
          __syncthreads();
      } }
}

struct RowV { f32x4 v[4]; };
#define RC(lane, j) (8 * (lane) + 512 * ((j) >> 1) + 4 * ((j) & 1))
__device__ __forceinline__ void row_load(RowV& r, const float* p, int lane) {
#pragma unroll
    for (int j = 0; j < 4; ++j) r.v[j] = __builtin_nontemporal_load((const f32x4*)(p + RC(lane, j)));
}
__device__ __forceinline__ void row_load_bf16(RowV& r, const bf16_t* p, int lane) {
#pragma unroll
    for (int h = 0; h < 2; ++h) { const u32x4 w = __builtin_nontemporal_load((const u32x4*)(p + 8 * lane + 512 * h)); r.v[2 * h] = (f32x4){bflo(w.x), bfhi(w.x), bflo(w.y), bfhi(w.y)}; r.v[2 * h + 1] = (f32x4){bflo(w.z), bfhi(w.z), bflo(w.w), bfhi(w.w)}; }
}
__device__ __forceinline__ void row_store(const RowV& r, float* p, int lane) {
#pragma unroll
    for (int j = 0; j < 4; ++j) *(f32x4*)(p + RC(lane, j)) = r.v[j];
}
__device__ __forceinline__ void row_store_nt(const RowV& r, float* p, int lane) {
#pragma unroll
    for (int j = 0; j < 4; ++j) __builtin_nontemporal_store(r.v[j], (f32x4*)(p + RC(lane, j)));
}
__device__ __forceinline__ void row_store_bf16_nt(const RowV& r, bf16_t* p, int lane) {
#pragma unroll
    for (int h = 0; h < 2; ++h) { u32x4 w; w.x = pk2(r.v[2 * h].x, r.v[2 * h].y); w.y = pk2(r.v[2 * h].z, r.v[2 * h].w); w.z = pk2(r.v[2 * h + 1].x, r.v[2 * h + 1].y); w.w = pk2(r.v[2 * h + 1].z, r.v[2 * h + 1].w); __builtin_nontemporal_store(w, (u32x4*)(p + 8 * lane + 512 * h)); }
}
__device__ __forceinline__ void row_store_bf16(const RowV& r, bf16_t* p, int lane) {
#pragma unroll
    for (int h = 0; h < 2; ++h) { u32x4 w; w.x = pk2(r.v[2 * h].x, r.v[2 * h].y); w.y = pk2(r.v[2 * h].z, r.v[2 * h].w); w.z = pk2(r.v[2 * h + 1].x, r.v[2 * h + 1].y); w.w = pk2(r.v[2 * h + 1].z, r.v[2 * h + 1].w); *(u32x4*)(p + 8 * lane + 512 * h) = w; }
}
__device__ __forceinline__ void row_ln_plain(RowV& r, int lane) {
    float s = 0.f;
#pragma unroll
    for (int j = 0; j < 4; ++j) s += (r.v[j].x + r.v[j].y) + (r.v[j].z + r.v[j].w);
    const float mean = wave_sum(s, lane) * (1.f / D); float s2 = 0.f;
#pragma unroll
    for (int j = 0; j < 4; ++j) { r.v[j] = r.v[j] - mean; s2 += (r.v[j].x * r.v[j].x + r.v[j].y * r.v[j].y) + (r.v[j].z * r.v[j].z + r.v[j].w * r.v[j].w); }
    const float rstd = 1.f / sqrtf(wave_sum(s2, lane) * (1.f / D) + LN_EPS);
#pragma unroll
    for (int j = 0; j < 4; ++j) r.v[j] = r.v[j] * rstd;
}
__device__ __forceinline__ void row_affine(RowV& r, const float* g, const float* b, int lane) {
#pragma unroll
    for (int j = 0; j < 4; ++j) { const f32x4 gg = *(const f32x4*)(g + RC(lane, j)), bb = *(const f32x4*)(b + RC(lane, j)); r.v[j] = r.v[j] * gg + bb; }
}
__device__ __forceinline__ void row_modulate(RowV& r, const float* sh, const float* sc, int lane) {
#pragma unroll
    for (int j = 0; j < 4; ++j) { const f32x4 s1 = *(const f32x4*)(sc + RC(lane, j)), s0 = *(const f32x4*)(sh + RC(lane, j)); r.v[j] = r.v[j] * (s1 + 1.0f) + s0; }
}
__device__ __forceinline__ LAS float* pv_slot(const Frame& F, int slot) { return (LAS float*)(F.lds + NW_PV) + slot * 1024; }
__device__ __forceinline__ void pv_fill(Frame& F, int slot, const float* src) { LAS f32x4* d = (LAS f32x4*)pv_slot(F, slot); for (int i = F.tid; i < 256; i += NTHREADS) d[i] = *(const f32x4*)(src + 4 * i); }
__device__ __forceinline__ void row_affine_l(RowV& r, const LAS float* g, const LAS float* b, int lane) {
#pragma unroll
    for (int j = 0; j < 4; ++j) { const f32x4 gg = *(const LAS f32x4*)(g + RC(lane, j)), bb = *(const LAS f32x4*)(b + RC(lane, j)); r.v[j] = r.v[j] * gg + bb; }
}
__device__ __forceinline__ void row_modulate_l(RowV& r, const LAS float* sh, const LAS float* sc, int lane) {
#pragma unroll
    for (int j = 0; j < 4; ++j) { const f32x4 s1 = *(const LAS f32x4*)(sc + RC(lane, j)), s0 = *(const LAS f32x4*)(sh + RC(lane, j)); r.v[j] = r.v[j] * (s1 + 1.0f) + s0; }
}
__device__ __forceinline__ void ln0_row(Frame& F, int row, RowV xr, const LAS float* sh, const LAS float* sc) {
    row_ln_plain(xr, F.lane);
    row_modulate_l(xr, sh, sc, F.lane);
    row_store_bf16(xr, (bf16_t*)(F.ws + WS_H) + (size_t)row * D, F.lane);
    { unsigned char* h8 = (unsigned char*)(F.ws + WS_H8) + (size_t)row * D + 8 * F.lane;
#pragma unroll
      for (int h = 0; h < 2; ++h) { u32x2 w; w.x = pk4_fp8(xr.v[2 * h].x * F8S_ACT, xr.v[2 * h].y * F8S_ACT, xr.v[2 * h].z * F8S_ACT, xr.v[2 * h].w * F8S_ACT); w.y = pk4_fp8(xr.v[2 * h + 1].x * F8S_ACT, xr.v[2 * h + 1].y * F8S_ACT, xr.v[2 * h + 1].z * F8S_ACT, xr.v[2 * h + 1].w * F8S_ACT); *(u32x2*)(h8 + 512 * h) = w; } }
}
__device__ __forceinline__ LAS float* narrow_tile_wave(Frame& F, const bf16_t* A) {
    const int r = F.lane & 31, h = F.lane >> 5;
    f32x16 acc;
#pragma unroll
    for (int i = 0; i < 16; ++i) acc[i] = 0.f;
    const bf16_t* ap = A + (size_t)r * D + 8 * h;
    const LAS unsigned char* bp = F.lds + NW_WT + r * 2064 + 16 * h;
    bf16x8 av[2][16];
#pragma unroll
    for (int ks = 0; ks < 16; ++ks) av[0][ks] = *(const bf16x8*)(ap + ks * 16);
#pragma unroll
    for (int kb = 0; kb < 4; ++kb) {
        if (kb < 3) {
#pragma unroll
            for (int ks = 0; ks < 16; ++ks) av[(kb + 1) & 1][ks] = *(const bf16x8*)(ap + ((kb + 1) * 16 + ks) * 16); }
        __builtin_amdgcn_sched_barrier(0);
#pragma unroll
        for (int ks = 0; ks < 16; ++ks) { const bf16x8 b = *(const LAS bf16x8*)(bp + (kb * 16 + ks) * 32); acc = __builtin_amdgcn_mfma_f32_32x32x16_bf16(av[kb & 1][ks], b, acc, 0, 0, 0); }
        __builtin_amdgcn_sched_barrier(0);
    }
    LAS float* lg = (LAS float*)(F.lds + NW_LG) + F.wave * 1056;
#pragma unroll
    for (int i = 0; i < 16; ++i) lg[((i & 3) + 8 * (i >> 2) + 4 * h) * 33 + r] = acc[i];
    asm volatile("s_waitcnt lgkmcnt(0)" ::: "memory");
    return lg;
}
__device__ __forceinline__ void tile_range(const Frame& F, int mrows, int& t_lo, int& t_hi) { const int nt = mrows / 32; t_lo = (int)(((long)F.bid * nt) / F.G); t_hi = (int)(((long)(F.bid + 1) * nt) / F.G); }
__device__ __forceinline__ void load_wg_lds(Frame& F, int l) {
    const float* src = (const float*)(F.ws + WS_WG) + (size_t)l * 16384;
    for (int i = F.tid; i < 32 * 128; i += NTHREADS) { const int g = i >> 7, c8 = i & 127; u32x4 w = (u32x4){0u, 0u, 0u, 0u};
        if (g < 16) { const f32x4 a = *(const f32x4*)(src + g * 1024 + c8 * 8), b = *(const f32x4*)(src + g * 1024 + c8 * 8 + 4); w.x = pk2(a.x, a.y); w.y = pk2(a.z, a.w); w.z = pk2(b.x, b.y); w.w = pk2(b.z, b.w); }
        *(LAS u32x4*)(F.lds + NW_WT + g * 2064 + c8 * 16) = w; }
    __syncthreads();
}
__device__ __forceinline__ void gates_tail(Frame& F, int l, int t_lo, int t_hi) {
    asm volatile("s_waitcnt vmcnt(0)" ::: "memory"); __syncthreads();
    const int g = F.lane & 15; const float bias = F.in[IN_BIN][l * 5904 + 2304 + g];
    for (int tile = t_lo + F.wave; tile < t_hi; tile += NWAVES) {
        const LAS float* lg = narrow_tile_wave(F, (const bf16_t*)(F.ws + WS_H) + (size_t)tile * 32 * D);
#pragma unroll
        for (int rr = 0; rr < 8; ++rr) { const int row = rr * 4 + (F.lane >> 4); ((float*)(F.ws + WS_ZG))[(size_t)(tile * 32 + row) * 16 + g] = lg[row * 33 + g] + bias; }
        asm volatile("s_waitcnt lgkmcnt(0)" ::: "memory");
    }
}

using pg8::Unit;
struct ProbPlain {
    static constexpr bool GATHER = false, FP8 = false; static constexpr int SCALE_A = 127, SCALE_B = 127; const bf16_t* A; const bf16_t* Bt; int lda, ldb;
    __device__ __forceinline__ int nt(const Unit&) const { return lda / 64; }
    __device__ __forceinline__ const char* a_base(const Unit& u) const { return (const char*)A + (size_t)u.pm * 256 * lda * 2; }
    __device__ __forceinline__ const char* b_base(const Unit& u) const { return (const char*)Bt + (size_t)u.pn * 256 * ldb * 2; }
    __device__ __forceinline__ void a_tok(const Unit&, const int (&)[2], int (&)[2][2]) const {}
    __device__ __forceinline__ void a_off(const int (&)[2][2], const int (&)[2], unsigned (&)[2][2]) const {}
    __device__ __forceinline__ void a_rows(const Unit&, const int (&)[2], const int (&)[2], unsigned (&)[2][2]) const {}
};
struct ProbPlainF8 {
    static constexpr bool GATHER = false, FP8 = true; static constexpr int SCALE_A = F8E_ACT, SCALE_B = F8E_WGU; const bf16_t* A; const bf16_t* Bt; int lda, ldb;
    __device__ __forceinline__ int nt(const Unit&) const { return lda / 64; }
    __device__ __forceinline__ const char* a_base(const Unit& u) const { return (const char*)A + (size_t)u.pm * 256 * lda * 2; }
    __device__ __forceinline__ const char* b_base(const Unit& u) const { return (const char*)Bt + (size_t)u.pn * 256 * ldb * 2; }
    __device__ __forceinline__ void a_tok(const Unit&, const int (&)[2], int (&)[2][2]) const {}
    __device__ __forceinline__ void a_off(const int (&)[2][2], const int (&)[2], unsigned (&)[2][2]) const {}
    __device__ __forceinline__ void a_rows(const Unit&, const int (&)[2], const int (&)[2], unsigned (&)[2][2]) const {}
};
struct ProbBranch {
    static constexpr bool GATHER = false, FP8 = false; static constexpr int SCALE_A = 127, SCALE_B = 127; const bf16_t* A; const bf16_t* Bt; int lda, ldb;
    __device__ __forceinline__ int nt(const Unit& u) const { return u.sub == 1 ? 8 : 4; }
    __device__ __forceinline__ int koff(const Unit& u) const { return u.sub == 0 ? 0 : (u.sub == 1 ? 256 : 768); }
    __device__ __forceinline__ const char* a_base(const Unit& u) const { return (const char*)A + ((size_t)u.pm * 256 * lda + koff(u)) * 2; }
    __device__ __forceinline__ const char* b_base(const Unit& u) const { return (const char*)Bt + ((size_t)u.pn * 256 * ldb + koff(u)) * 2; }
    __device__ __forceinline__ void a_tok(const Unit&, const int (&)[2], int (&)[2][2]) const {}
    __device__ __forceinline__ void a_off(const int (&)[2][2], const int (&)[2], unsigned (&)[2][2]) const {}
    __device__ __forceinline__ void a_rows(const Unit&, const int (&)[2], const int (&)[2], unsigned (&)[2][2]) const {}
};
__device__ __forceinline__ int expert_of(const LAS int* seg, int pm) { return __builtin_amdgcn_readfirstlane((int)((const LAS unsigned char*)(seg + 64))[pm]); }
__device__ __forceinline__ int moe_tables(Frame& F, LAS int* seg) {
    __syncthreads();
    if (F.tid <= NEXP) seg[F.tid] = ((const int*)(F.ws + WS_ROUTE + RT_SEG))[F.tid];
    __syncthreads();
    const int ntile = seg[NEXP] / 256;
    LAS unsigned char* texp = (LAS unsigned char*)(seg + 64);
    for (int t = F.tid; t < ntile; t += NTHREADS) { const int row = t * 256; int e = 0;
#pragma unroll
        for (int i = 1; i < NEXP; ++i) e += (seg[i] <= row) ? 1 : 0;
        texp[t] = (unsigned char)e; }
    __syncthreads();
    return ntile;
}
struct ProbMoe1 {
    static constexpr bool GATHER = true, FP8 = true; static constexpr int SCALE_A = F8E_ACT, SCALE_B = F8E_WGU; const bf16_t* A; const bf16_t* Bt; int lda, ldb; const int* tok; const LAS int* seg;
    __device__ __forceinline__ int nt(const Unit&) const { return lda / 64; }
    __device__ __forceinline__ const char* a_base(const Unit&) const { return (const char*)A; }
    __device__ __forceinline__ const char* b_base(const Unit& u) const { const int e = expert_of(seg, u.pm); return (const char*)Bt + ((size_t)e * 2048 + (size_t)u.pn * 256) * ldb * 2; }
    __device__ __forceinline__ void a_rows(const Unit& u, const int (&R)[2], const int (&C)[2], unsigned (&off)[2][2]) const {
#pragma unroll
        for (int h = 0; h < 2; ++h)
#pragma unroll
            for (int i = 0; i < 2; ++i) { const int t = tok[u.pm * 256 + h * 128 + R[i]]; off[h][i] = (unsigned)(t * lda + C[i]) * 2u; } }
    __device__ __forceinline__ void a_tok(const Unit& u, const int (&R)[2], int (&tk)[2][2]) const {
#pragma unroll
        for (int h = 0; h < 2; ++h)
#pragma unroll
            for (int i = 0; i < 2; ++i) tk[h][i] = tok[u.pm * 256 + h * 128 + R[i]]; }
    __device__ __forceinline__ void a_off(const int (&tk)[2][2], const int (&C)[2], unsigned (&off)[2][2]) const {
#pragma unroll
        for (int h = 0; h < 2; ++h)
#pragma unroll
            for (int i = 0; i < 2; ++i) off[h][i] = (unsigned)(tk[h][i] * lda + C[i]) * 2u; }
};
struct ProbMoe2 {
    static constexpr bool GATHER = false, FP8 = true; static constexpr int SCALE_A = F8E_ACT, SCALE_B = F8E_WDN; const bf16_t* A; const bf16_t* Bt; int lda, ldb; const LAS int* seg;
    __device__ __forceinline__ int nt(const Unit&) const { return lda / 64; }
    __device__ __forceinline__ const char* a_base(const Unit& u) const { return (const char*)A + (size_t)u.pm * 256 * lda * 2; }
    __device__ __forceinline__ const char* b_base(const Unit& u) const { const int e = expert_of(seg, u.pm); return (const char*)Bt + ((size_t)e * 1024 + (size_t)u.pn * 256) * ldb * 2; }
    __device__ __forceinline__ void a_tok(const Unit&, const int (&)[2], int (&)[2][2]) const {}
    __device__ __forceinline__ void a_off(const int (&)[2][2], const int (&)[2], unsigned (&)[2][2]) const {}
    __device__ __forceinline__ void a_rows(const Unit&, const int (&)[2], const int (&)[2], unsigned (&)[2][2]) const {}
};
using pg8::cvt_pk_bf16;
template <bool G8> struct EpiInproj {
    static constexpr bool PERM = true, CHAIN = false, SIDE = true, KHOOK = false; bf16_t* Z; const float* bias; int pn0;
    __device__ __forceinline__ void side(const Unit& u0, unsigned slot, int wid, int lane) const { const int pn = u0.pn + pn0; if (wid == 1) pg8::dma16((unsigned)lane * 16u, bias + pn * 256 + (pn >= 9 ? 16 : 0), slot); }
    __device__ __forceinline__ void operator()(const f32x4 (&acc)[2][2][4][2], const Unit& u0, int wr, int wc, int fr, int fq, const LAS unsigned char* sd) const {
        Unit u = u0; u.pn += pn0;
        int row0 = u.pm * 256 + wr * 64 + fr, col0 = u.pn * 256 + wc * 32 + 8 * fq; asm volatile("" : "+v"(row0), "+v"(col0));
        const int act = G8 ? ((u.pn == 9 || u.pn == 10) ? 2 : 1) : 0;
        f32x4 bv[2][2];
#pragma unroll
        for (int bj = 0; bj < 2; ++bj)
#pragma unroll
            for (int n = 0; n < 2; ++n) bv[bj][n] = *(const LAS f32x4*)(sd + (bj * 128 + wc * 32 + 8 * fq + 4 * n) * 4);
#pragma unroll
        for (int ai = 0; ai < 2; ++ai)
#pragma unroll
            for (int m = 0; m < 4; ++m) { bf16_t* rowp = Z + (size_t)(row0 + ai * 128 + m * 16) * NZ + col0;
#pragma unroll
                for (int bj = 0; bj < 2; ++bj) { f32x4 v0 = acc[ai][bj][m][0] + bv[bj][0], v1 = acc[ai][bj][m][1] + bv[bj][1];
                    if (G8 && u.pn >= ZG_COL / 256) { u32x2 w8;
#pragma unroll
                        for (int j = 0; j < 4; ++j) v0[j] = fmaxf(sigmoidf_(v0[j]) * G8_SCALE, 1.0f) + 12582912.0f;
                        w8.x = pk4_u8(v0[0], v0[1], v0[2], v0[3]); asm volatile("" : "+v"(w8.x));
#pragma unroll
                        for (int j = 0; j < 4; ++j) v1[j] = fmaxf(sigmoidf_(v1[j]) * G8_SCALE, 1.0f) + 12582912.0f;
                        w8.y = pk4_u8(v1[0], v1[1], v1[2], v1[3]);
                        *(u32x2*)((unsigned char*)(Z + (size_t)(row0 + ai * 128 + m * 16) * NZ + ZG_COL) + (col0 - ZG_COL) + bj * 128) = w8; continue; }
                    if (act == 2) { f32x2 a = pg8::gelu_pk((f32x2){v0[0], v0[1]}), b = pg8::gelu_pk((f32x2){v0[2], v0[3]}), c = pg8::gelu_pk((f32x2){v1[0], v1[1]}), d = pg8::gelu_pk((f32x2){v1[2], v1[3]});
                        v0 = (f32x4){a.x, a.y, b.x, b.y}; v1 = (f32x4){c.x, c.y, d.x, d.y}; }
                    if (act == 1) {
#pragma unroll
                        for (int j = 0; j < 4; ++j) { v0[j] = sigmoidf_(v0[j]); v1[j] = sigmoidf_(v1[j]); } }
                    u32x4 w; w.x = cvt_pk_bf16(v0[0], v0[1]); w.y = cvt_pk_bf16(v0[2], v0[3]); w.z = cvt_pk_bf16(v1[0], v1[1]); w.w = cvt_pk_bf16(v1[2], v1[3]);
                    *(u32x4*)(rowp + bj * 128) = w; }
                if constexpr (G8) asm volatile("" ::: "memory"); }
    }
};
struct EpiNull {
    static constexpr bool PERM = true, CHAIN = false; bf16_t* Z;
    __device__ __forceinline__ void operator()(const f32x4 (&acc)[2][2][4][2], const Unit& u, int wr, int wc, int fr, int fq) const {
        float sacc = 0.f;
#pragma unroll
        for (int ai = 0; ai < 2; ++ai)
#pragma unroll
            for (int bj = 0; bj < 2; ++bj)
#pragma unroll
                for (int m = 0; m < 4; ++m)
#pragma unroll
                    for (int n = 0; n < 2; ++n) sacc += (acc[ai][bj][m][n][0] + acc[ai][bj][m][n][1]) + (acc[ai][bj][m][n][2] + acc[ai][bj][m][n][3]);
        if (sacc == 1.2345e30f) Z[u.pm + wr + wc + fr + fq] = 0;
    }
};
struct EpiOut {
    static constexpr bool PERM = true, CHAIN = false, SIDE = false, KHOOK = false; bf16_t* T;
    __device__ __forceinline__ void operator()(const f32x4 (&acc)[2][2][4][2], const Unit& u, int wr, int wc, int fr, int fq, const LAS unsigned char*) const {
        int row0 = u.pm * 256 + wr * 64 + fr, col0 = u.pn * 256 + wc * 32 + 8 * fq; asm volatile("" : "+v"(row0), "+v"(col0));
#pragma unroll
        for (int ai = 0; ai < 2; ++ai)
#pragma unroll
            for (int m = 0; m < 4; ++m) { bf16_t* rowp = T + (size_t)(row0 + ai * 128 + m * 16) * D + col0;
#pragma unroll
                for (int bj = 0; bj < 2; ++bj) { const f32x4 v0 = acc[ai][bj][m][0], v1 = acc[ai][bj][m][1];
                    u32x4 w; w.x = cvt_pk_bf16(v0[0], v0[1]); w.y = cvt_pk_bf16(v0[2], v0[3]); w.z = cvt_pk_bf16(v1[0], v1[1]); w.w = cvt_pk_bf16(v1[2], v1[3]);
                    *(u32x4*)(rowp + bj * 128) = w; } }
    }
};
struct EpiBranch {
    static constexpr bool PERM = true, CHAIN = false, SIDE = false, KHOOK = true; static constexpr int HOOK_T0 = 4, HOOK_T1 = 12;
    const bf16_t* Z; bf16_t* Y;
    template <bool FIN> __device__ __forceinline__ void apply(f32x4 (&acc)[2][2][4][2], const Unit& u, int br, int wr, int wc, int fr, int fq) const {
        int row0 = u.pm * 256 + wr * 64 + fr, col0 = u.pn * 256 + wc * 32 + 8 * fq;
        asm volatile("" : "+v"(row0), "+v"(col0));
#pragma unroll
        for (int ai = 0; ai < 2; ++ai) {
            u32x2 ga[4][2], gb[4][2];
#pragma unroll
            for (int m = 0; m < 4; ++m) { const unsigned char* rowp = (const unsigned char*)(Z + (size_t)(row0 + ai * 128 + m * 16) * NZ + ZG_COL) + br * 1024 + col0;
#pragma unroll
                for (int bj = 0; bj < 2; ++bj) { ga[m][bj] = *(const u32x2*)(rowp + bj * 128); if (!FIN) gb[m][bj] = *(const u32x2*)(rowp + 1024 + bj * 128); } }
#pragma unroll
            for (int m = 0; m < 4; ++m) { const size_t row = (size_t)(row0 + ai * 128 + m * 16);
#pragma unroll
                for (int bj = 0; bj < 2; ++bj) { const u32x2 a = ga[m][bj];
                    f32x4 r0 = u8x4_f32(a.x), r1 = u8x4_f32(a.y);
                    if (FIN) { r0 = r0 * (1.0f / G8_SCALE); r1 = r1 * (1.0f / G8_SCALE); }
                    else { const u32x2 b = gb[m][bj]; const f32x4 q0 = u8x4_f32(b.x), q1 = u8x4_f32(b.y);
#pragma unroll
                        for (int i = 0; i < 4; ++i) { r0[i] *= __builtin_amdgcn_rcpf(q0[i]); r1[i] *= __builtin_amdgcn_rcpf(q1[i]); } }
                    acc[ai][bj][m][0] = acc[ai][bj][m][0] * r0; acc[ai][bj][m][1] = acc[ai][bj][m][1] * r1;
                    if (FIN) { const f32x4 v0 = acc[ai][bj][m][0], v1 = acc[ai][bj][m][1];
                        u32x4 w; w.x = cvt_pk_bf16(v0[0], v0[1]); w.y = cvt_pk_bf16(v0[2], v0[3]); w.z = cvt_pk_bf16(v1[0], v1[1]); w.w = cvt_pk_bf16(v1[2], v1[3]);
                        *(u32x4*)(Y + row * D + col0 + bj * 128) = w; } } }
            asm volatile("" ::: "memory"); }
    }
    __device__ __forceinline__ void hook(f32x4 (&acc)[2][2][4][2], const Unit& u, int br, int wr, int wc, int fr, int fq) const { apply<false>(acc, u, br, wr, wc, fr, fq); }
    __device__ __forceinline__ void operator()(f32x4 (&acc)[2][2][4][2], const Unit& u, int wr, int wc, int fr, int fq, const LAS unsigned char*) const { apply<true>(acc, u, 2, wr, wc, fr, fq); }
};
struct EpiSwiglu {
    static constexpr bool PERM = true, CHAIN = false, SIDE = true, KHOOK = false; unsigned char* HID; const float* bgu; const LAS int* seg;
    __device__ __forceinline__ void side(const Unit& u, unsigned slot, int wid, int lane) const {
        if (wid == 1) { const int e = expert_of(seg, u.pm); pg8::dma16(lane < 32 ? (unsigned)lane * 16u : 4096u + (unsigned)(lane - 32) * 16u, bgu + (size_t)e * 2048 + u.pn * 128, slot); } }
    __device__ __forceinline__ void operator()(const f32x4 (&acc)[2][2][4][2], const Unit& u, int wr, int wc, int fr, int fq, const LAS unsigned char* sd) const {
        int j0 = u.pn * 128 + wc * 32 + 8 * fq, slot0 = u.pm * 256 + wr * 64 + fr; asm volatile("" : "+v"(j0), "+v"(slot0));
        f32x4 bg[2], bu[2];
#pragma unroll
        for (int n = 0; n < 2; ++n) { bg[n] = *(const LAS f32x4*)(sd + (wc * 32 + 8 * fq + 4 * n) * 4); bu[n] = *(const LAS f32x4*)(sd + (128 + wc * 32 + 8 * fq + 4 * n) * 4); }
#pragma unroll
        for (int ai = 0; ai < 2; ++ai)
#pragma unroll
            for (int m = 0; m < 4; ++m) { const size_t slot = (size_t)(slot0 + ai * 128 + m * 16); float o[8];
#pragma unroll
                for (int n = 0; n < 2; ++n)
#pragma unroll
                    for (int i = 0; i < 4; ++i) { float g = acc[ai][0][m][n][i] + bg[n][i], up = acc[ai][1][m][n][i] + bu[n][i];
                        g = fminf(g, 7.0f); up = fminf(fmaxf(up, -7.0f), 7.0f); o[n * 4 + i] = (up + 1.0f) * g * sigmoidf_(1.702f * g); }
                u32x2 w; w.x = pk4_fp8(o[0] * F8S_ACT, o[1] * F8S_ACT, o[2] * F8S_ACT, o[3] * F8S_ACT); w.y = pk4_fp8(o[4] * F8S_ACT, o[5] * F8S_ACT, o[6] * F8S_ACT, o[7] * F8S_ACT);
                *(u32x2*)(HID + slot * 1024 + j0) = w; }
    }
};
struct EpiDown {
    static constexpr bool PERM = true, CHAIN = false, SIDE = true, KHOOK = false; unsigned char* FS; const float* bdn; const int* dest; const float* pslot; const LAS int* seg;
    __device__ __forceinline__ void side(const Unit& u, unsigned slot, int wid, int lane) const {
        if (wid == 1) { const int e = expert_of(seg, u.pm); pg8::dma16((unsigned)lane * 16u, bdn + (size_t)e * 1024 + u.pn * 256, slot); }
        if (wid == 2) pg8::dma16((unsigned)lane * 16u, dest + (size_t)u.pm * 256, slot + 1024u);
        if (wid == 3) pg8::dma16((unsigned)lane * 16u, pslot + (size_t)u.pm * 256, slot + 2048u); }
    __device__ __forceinline__ void operator()(const f32x4 (&acc)[2][2][4][2], const Unit& u, int wr, int wc, int fr, int fq, const LAS unsigned char* sd) const {
        int col0 = u.pn * 256 + wc * 32 + 8 * fq, slot0 = u.pm * 256 + wr * 64 + fr; asm volatile("" : "+v"(col0), "+v"(slot0));
        f32x4 bv[2][2];
#pragma unroll
        for (int bj = 0; bj < 2; ++bj)
#pragma unroll
            for (int n = 0; n < 2; ++n) bv[bj][n] = *(const LAS f32x4*)(sd + (bj * 128 + wc * 32 + 8 * fq + 4 * n) * 4);
#pragma unroll
        for (int ai = 0; ai < 2; ++ai)
#pragma unroll
            for (int m = 0; m < 4; ++m) { const int rt = ai * 128 + wr * 64 + m * 16 + fr; const int d = *(const LAS int*)(sd + 1024 + rt * 4); const float p = *(const LAS float*)(sd + 2048 + rt * 4) * FS_SCALE;
                if (d >= 0) {
#pragma unroll
                    for (int bj = 0; bj < 2; ++bj) { f32x4 v0 = (acc[ai][bj][m][0] + bv[bj][0]) * p, v1 = (acc[ai][bj][m][1] + bv[bj][1]) * p;
#pragma unroll
                        for (int i = 0; i < 4; ++i) { v0[i] = __builtin_amdgcn_fmed3f(v0[i], -FS_CLAMP, FS_CLAMP); v1[i] = __builtin_amdgcn_fmed3f(v1[i], -FS_CLAMP, FS_CLAMP); }
                        u32x2 w; w.x = pk4_fp8(v0[0], v0[1], v0[2], v0[3]); w.y = pk4_fp8(v1[0], v1[1], v1[2], v1[3]);
                        *(u32x2*)(FS + (size_t)d * 1024 + col0 + bj * 128) = w; } }
                asm volatile("" ::: "memory"); }
    }
};

__device__ __forceinline__ const float* xin_row(const Frame& F, int row) { return row < ML ? F.in[IN_X] + (size_t)row * D : F.in[IN_CTX] + (size_t)(row - ML) * D; }
__device__ __forceinline__ void phase_ln0_first(Frame& F) {
    int t_lo, t_hi; tile_range(F, MT, t_lo, t_hi);
    const int r_lo = 32 * t_lo, nrows = 32 * (t_hi - t_lo);
    const int mrA = mod_row(r_lo), mrB = mod_row(r_lo + (nrows > 0 ? nrows - 1 : 0));
    { const float* mb = (const float*)(F.ws + WS_MOD); pv_fill(F, 0, mb + ((size_t)(0 * 17 + mrA) * 6 + 0) * 1024); pv_fill(F, 1, mb + ((size_t)(0 * 17 + mrB) * 6 + 0) * 1024);
      pv_fill(F, 2, mb + ((size_t)(0 * 17 + mrA) * 6 + 1) * 1024); pv_fill(F, 3, mb + ((size_t)(0 * 17 + mrB) * 6 + 1) * 1024); }
    load_wg_lds(F, 0);
    for (int n = F.wave; n < nrows; n += 4 * NWAVES) {
        RowV rv[4];
#pragma unroll
        for (int u = 0; u < 4; ++u) if (n + u * NWAVES < nrows) row_load(rv[u], xin_row(F, r_lo + n + u * NWAVES), F.lane);
#pragma unroll
        for (int u = 0; u < 4; ++u) if (n + u * NWAVES < nrows) { const int row = r_lo + n + u * NWAVES;
            const int sel = (mod_row(row) == mrA) ? 0 : 1; ln0_row(F, row, rv[u], pv_slot(F, 0 + sel), pv_slot(F, 2 + sel)); }
    }
    gates_tail(F, 0, t_lo, t_hi);
    __syncthreads();
}
__device__ __forceinline__ void phase_finalize(Frame& F, int l, int mrows) {
    const int gw = F.bid * NWAVES + F.wave, NGW = F.G * NWAVES;
    const bf16_t* hf = (const bf16_t*)(F.ws + WS_HFB); const bf16_t* hb = hf + (size_t)MT * 512;
    const float* ng = F.in[IN_MNG] + l * 512 + 8 * F.lane;
    const f32x4 g0 = *(const f32x4*)ng, g1 = *(const f32x4*)(ng + 4);
    for (int row = gw; row < mrows; row += NGW) {
        const u32x4 ha = __builtin_nontemporal_load((const u32x4*)(hf + (size_t)row * 512 + 8 * F.lane)), hbv = __builtin_nontemporal_load((const u32x4*)(hb + (size_t)row * 512 + 8 * F.lane));
        f32x4 v0 = (f32x4){bflo(ha.x) + bflo(hbv.x), bfhi(ha.x) + bfhi(hbv.x), bflo(ha.y) + bflo(hbv.y), bfhi(ha.y) + bfhi(hbv.y)}, v1 = (f32x4){bflo(ha.z) + bflo(hbv.z), bfhi(ha.z) + bfhi(hbv.z), bflo(ha.w) + bflo(hbv.w), bfhi(ha.w) + bfhi(hbv.w)};
        float s = (v0.x + v0.y) + (v0.z + v0.w) + (v1.x + v1.y) + (v1.z + v1.w);
#pragma unroll
        for (int o = 1; o < 16; o <<= 1) s += shx(s, o, F.lane);
        const float mu = s * (1.f / 128.f); v0 = v0 - mu; v1 = v1 - mu;
        float q = (v0.x * v0.x + v0.y * v0.y) + (v0.z * v0.z + v0.w * v0.w) + (v1.x * v1.x + v1.y * v1.y) + (v1.z * v1.z + v1.w * v1.w);
#pragma unroll
        for (int o = 1; o < 16; o <<= 1) q += shx(q, o, F.lane);
        const float rstd = 1.f / sqrtf(q * (1.f / 128.f) + HEAD_EPS);
        const u32x4 so = __builtin_nontemporal_load((const u32x4*)((const bf16_t*)(F.ws + WS_Z) + (size_t)row * NZ + ZC_O + 8 * F.lane));
        v0 = v0 * rstd * g0; v1 = v1 * rstd * g1;
        u32x4 w; w.x = pk2(v0.x * bflo(so.x), v0.y * bfhi(so.x)); w.y = pk2(v0.z * bflo(so.y), v0.w * bfhi(so.y)); w.z = pk2(v1.x * bflo(so.z), v1.y * bfhi(so.z)); w.w = pk2(v1.z * bflo(so.w), v1.w * bfhi(so.w));
        *(u32x4*)((bf16_t*)(F.ws + WS_BRA) + (size_t)row * D + 256 + 8 * F.lane) = w;
    }
}
__device__ __forceinline__ void phase_ln1_router(Frame& F, int l, int mrows) {
    LAS int* cnt = (LAS int*)(F.lds + NW_END);
    { const float* wr = F.in[IN_WR] + (size_t)l * D * NEXP;
      for (int i = F.tid; i < NEXP * D; i += NTHREADS) { const int k = i >> 5, e = i & 31; *(LAS bf16_t*)(F.lds + NW_WT + e * 2064 + k * 2) = (bf16_t)f2bf(wr[i]); }
      if (F.tid < NEXP) cnt[F.tid] = 0; }
    const float* brt = F.in[IN_BR] + l * NEXP;
    int t_lo, t_hi; tile_range(F, mrows, t_lo, t_hi);
    const int r_lo = 32 * t_lo, nrows = 32 * (t_hi - t_lo);
    const int mrA = mod_row(r_lo), mrB = mod_row(r_lo + (nrows > 0 ? nrows - 1 : 0));
    { const float* mb = (const float*)(F.ws + WS_MOD); pv_fill(F, 0, F.in[IN_LN1G] + l * D); pv_fill(F, 1, F.in[IN_LN1B] + l * D);
      pv_fill(F, 2, mb + ((size_t)(l * 17 + mrA) * 6 + 2) * 1024); pv_fill(F, 3, mb + ((size_t)(l * 17 + mrB) * 6 + 2) * 1024);
      pv_fill(F, 4, mb + ((size_t)(l * 17 + mrA) * 6 + 3) * 1024); pv_fill(F, 5, mb + ((size_t)(l * 17 + mrB) * 6 + 3) * 1024);
      pv_fill(F, 6, mb + ((size_t)(l * 17 + mrA) * 6 + 4) * 1024); pv_fill(F, 7, mb + ((size_t)(l * 17 + mrB) * 6 + 4) * 1024); }
    __syncthreads();
    { const bf16_t* yb = (const bf16_t*)(F.ws + WS_T) + 8 * F.lane;
      for (int n = F.wave; n < nrows; n += 2 * NWAVES) {
          RowV rv[2]; u32x4 yv2[2][2];
#pragma unroll
          for (int u = 0; u < 2; ++u) if (n + u * NWAVES < nrows) { const int row = r_lo + n + u * NWAVES;
              if (l == 0) row_load(rv[u], xin_row(F, row), F.lane); else row_load_bf16(rv[u], (const bf16_t*)(F.ws + WS_X) + (size_t)row * D, F.lane);
#pragma unroll
              for (int h = 0; h < 2; ++h) yv2[u][h] = __builtin_nontemporal_load((const u32x4*)(yb + (size_t)row * D + 512 * h)); }
#pragma unroll
          for (int u = 0; u < 2; ++u) if (n + u * NWAVES < nrows) { const int row = r_lo + n + u * NWAVES; RowV cur = rv[u];
              const int sel = (mod_row(row) == mrA) ? 0 : 1;
              { const LAS float* g1 = pv_slot(F, 2 + sel);
#pragma unroll
                for (int j = 0; j < 4; ++j) { const f32x4 gg = *(const LAS f32x4*)(g1 + RC(F.lane, j)); const u32x4 yw = yv2[u][j >> 1]; const f32x4 yv = (j & 1) ? (f32x4){bflo(yw.z), bfhi(yw.z), bflo(yw.w), bfhi(yw.w)} : (f32x4){bflo(yw.x), bfhi(yw.x), bflo(yw.y), bfhi(yw.y)}; cur.v[j] = cur.v[j] * DN_ALPHA + gg * yv; } }
              row_ln_plain(cur, F.lane); row_affine_l(cur, pv_slot(F, 0), pv_slot(F, 1), F.lane);
              row_store_bf16_nt(cur, (bf16_t*)(F.ws + WS_X) + (size_t)row * D, F.lane);
              row_ln_plain(cur, F.lane); row_modulate_l(cur, pv_slot(F, 4 + sel), pv_slot(F, 6 + sel), F.lane);
              row_store_bf16(cur, (bf16_t*)(F.ws + WS_H2) + (size_t)row * D, F.lane);
              { unsigned char* h8 = (unsigned char*)(F.ws + WS_H2F8) + (size_t)row * D + 8 * F.lane;
#pragma unroll
                for (int h = 0; h < 2; ++h) { u32x2 w; w.x = pk4_fp8(cur.v[2 * h].x * F8S_ACT, cur.v[2 * h].y * F8S_ACT, cur.v[2 * h].z * F8S_ACT, cur.v[2 * h].w * F8S_ACT); w.y = pk4_fp8(cur.v[2 * h + 1].x * F8S_ACT, cur.v[2 * h + 1].y * F8S_ACT, cur.v[2 * h + 1].z * F8S_ACT, cur.v[2 * h + 1].w * F8S_ACT); *(u32x2*)(h8 + 512 * h) = w; } } }
      } }
    asm volatile("s_waitcnt vmcnt(0)" ::: "memory"); __syncthreads();
    for (int tile = t_lo + F.wave; tile < t_hi; tile += NWAVES) {
        const LAS float* lgw = narrow_tile_wave(F, (const bf16_t*)(F.ws + WS_H2) + (size_t)tile * 32 * D);
        if (F.lane < 32) {
            const LAS float* lgp = lgw + F.lane * 33; const int row = tile * 32 + F.lane;
            float lg[NEXP];
#pragma unroll
            for (int e = 0; e < NEXP; ++e) lg[e] = lgp[e] + brt[e];
            unsigned used = 0u; float bv[4]; int bi[4];
#pragma unroll
            for (int k = 0; k < 4; ++k) { float best = -3.0e38f; int idx = 0;
#pragma unroll
                for (int e = 0; e < NEXP; ++e) { const bool take = (((used >> e) & 1u) == 0u) && (lg[e] > best); best = take ? lg[e] : best; idx = take ? e : idx; }
                used |= 1u << idx; bv[k] = best; bi[k] = idx; }
            const float e1 = __expf(bv[1] - bv[0]), e2 = __expf(bv[2] - bv[0]), e3 = __expf(bv[3] - bv[0]); const float inv = __builtin_amdgcn_rcpf(1.0f + e1 + e2 + e3);
            int* ei = (int*)(F.ws + WS_ROUTE + RT_EIDX) + (size_t)row * 4; float* pr = (float*)(F.ws + WS_ROUTE + RT_PROB) + (size_t)row * 4;
            *(int4*)ei = make_int4(bi[0], bi[1], bi[2], bi[3]); *(f32x4*)pr = (f32x4){inv, e1 * inv, e2 * inv, e3 * inv};
            atomicAdd((int*)&cnt[bi[0]], 1); atomicAdd((int*)&cnt[bi[1]], 1); atomicAdd((int*)&cnt[bi[2]], 1); atomicAdd((int*)&cnt[bi[3]], 1);
        }
        asm volatile("s_waitcnt lgkmcnt(0)" ::: "memory");
    }
    __syncthreads();
    if (F.tid < NEXP) ((int*)(F.ws + WS_ROUTE + RT_CNT))[F.bid * NEXP + F.tid] = cnt[F.tid];
    __syncthreads();
}
__device__ __forceinline__ void phase_slots(Frame& F, int mrows) {
    LAS int* part = (LAS int*)F.lds;
    LAS int* pre = part + 1024;
    LAS int* tot = pre + 32;
    LAS int* seg = tot + 32;
    LAS int* gcnt = seg + 64;
    LAS int* eix = gcnt + 2048;
    LAS int* rnk = eix + 4096;
    const int* cntg = (const int*)(F.ws + WS_ROUTE + RT_CNT);
    int* tokg = (int*)(F.ws + WS_ROUTE + RT_TOK); int* destg = (int*)(F.ws + WS_ROUTE + RT_DEST); float* psl = (float*)(F.ws + WS_ROUTE + RT_PSLOT);
    int t_lo, t_hi; tile_range(F, mrows, t_lo, t_hi);
    const int row_base = t_lo * 32, nent = (t_hi - t_lo) * 128, ngrp = nent / 64;
    { const int e = F.tid & 31, pt = F.tid >> 5; int a = 0, b = 0;
      for (int c = pt; c < F.G; c += 16) { const int v = cntg[c * NEXP + e]; b += v; a += (c < F.bid) ? v : 0; }
      part[pt * 32 + e] = a; part[512 + pt * 32 + e] = b; }
    for (int i = F.tid; i < nent; i += NTHREADS) eix[i] = ((const int*)(F.ws + WS_ROUTE + RT_EIDX))[(size_t)row_base * 4 + i];
    __syncthreads();
    if (F.tid < NEXP) { int a = 0, b = 0;
#pragma unroll
        for (int pt = 0; pt < 16; ++pt) { a += part[pt * 32 + F.tid]; b += part[512 + pt * 32 + F.tid]; }
        pre[F.tid] = a; tot[F.tid] = b; }
    for (int g = F.wave; g < ngrp; g += NWAVES) {
        const int e = eix[g * 64 + F.lane]; int rank = 0, mycnt = 0;
#pragma unroll 4
        for (int ee = 0; ee < NEXP; ++ee) { const unsigned long long m = __ballot(e == ee); if (e == ee) rank = __popcll(m & ((1ull << F.lane) - 1ull)); if (F.lane == ee) mycnt = __popcll(m); }
        rnk[g * 64 + F.lane] = rank; if (F.lane < NEXP) gcnt[g * 32 + F.lane] = mycnt; }
    __syncthreads();
    if (F.tid == 0) { int s = 0; for (int e = 0; e < NEXP; ++e) { seg[e] = s; s += (tot[e] + 255) & ~255; } seg[NEXP] = s; }
    if (F.tid >= 64 && F.tid < 64 + NEXP) { const int e = F.tid - 64; int run = 0; for (int g = 0; g < ngrp; ++g) { const int c = gcnt[g * 32 + e]; gcnt[g * 32 + e] = run; run += c; } }
    __syncthreads();
    { const float* prg = (const float*)(F.ws + WS_ROUTE + RT_PROB) + (size_t)row_base * 4;
      for (int i = F.tid; i < nent; i += NTHREADS) { const int e = eix[i]; const int slot = seg[e] + pre[e] + gcnt[(i >> 6) * 32 + e] + rnk[i];
          tokg[slot] = row_base + (i >> 2); destg[slot] = row_base * 4 + i; psl[slot] = prg[i]; } }
    if (F.bid < NEXP) { const int e = F.bid; for (int sl = seg[e] + tot[e] + F.tid; sl < seg[e + 1]; sl += NTHREADS) { tokg[sl] = 0; destg[sl] = -1; psl[sl] = 0.f; } }
    if (F.bid == 0 && F.tid <= NEXP) ((int*)(F.ws + WS_ROUTE + RT_SEG))[F.tid] = seg[F.tid];
    __syncthreads();
}
struct CombRaw { u32x4 x[2]; u32x2 f[2][4]; };
__device__ __forceinline__ void comb_load(const Frame& F, int row, CombRaw& r) {
    { const bf16_t* xp = (const bf16_t*)(F.ws + WS_X) + (size_t)row * D + 8 * F.lane;
#pragma unroll
      for (int h = 0; h < 2; ++h) r.x[h] = __builtin_nontemporal_load((const u32x4*)(xp + 512 * h)); }
    const unsigned char* fs = (const unsigned char*)(F.ws + WS_FS) + (size_t)row * 4 * 1024 + 8 * F.lane;
#pragma unroll
    for (int h = 0; h < 2; ++h)
#pragma unroll
        for (int k = 0; k < 4; ++k) r.f[h][k] = __builtin_nontemporal_load((const u32x2*)(fs + k * 1024 + 512 * h));
}
__device__ __forceinline__ void phase_combine_ln2(Frame& F, int l, int mrows) {
    const bool lastl = (l == DEPTH - 1);
    int t_lo, t_hi; tile_range(F, mrows, t_lo, t_hi);
    const int r_lo = 32 * t_lo, nrows = 32 * (t_hi - t_lo);
    const int mrA = mod_row(r_lo), mrB = mod_row(r_lo + (nrows > 0 ? nrows - 1 : 0));
    { const float* mb = (const float*)(F.ws + WS_MOD); const int ln = lastl ? l : l + 1; pv_fill(F, 0, F.in[IN_LN2G] + l * D); pv_fill(F, 1, F.in[IN_LN2B] + l * D);
      pv_fill(F, 2, mb + ((size_t)(l * 17 + mrA) * 6 + 5) * 1024); pv_fill(F, 3, mb + ((size_t)(l * 17 + mrB) * 6 + 5) * 1024);
      pv_fill(F, 4, mb + ((size_t)(ln * 17 + mrA) * 6 + 0) * 1024); pv_fill(F, 5, mb + ((size_t)(ln * 17 + mrB) * 6 + 0) * 1024);
      pv_fill(F, 6, mb + ((size_t)(ln * 17 + mrA) * 6 + 1) * 1024); pv_fill(F, 7, mb + ((size_t)(ln * 17 + mrB) * 6 + 1) * 1024); }
    if (!lastl) load_wg_lds(F, l + 1); else __syncthreads();
    for (int n = F.wave; n < nrows; n += 2 * NWAVES) {
        CombRaw rw[2];
#pragma unroll
        for (int u = 0; u < 2; ++u) if (n + u * NWAVES < nrows) comb_load(F, r_lo + n + u * NWAVES, rw[u]);
#pragma unroll
        for (int u = 0; u < 2; ++u) if (n + u * NWAVES < nrows) { const int row = r_lo + n + u * NWAVES;
            const int sel = (mod_row(row) == mrA) ? 0 : 1;
            const LAS float* g2 = pv_slot(F, 2 + sel);
            RowV x;
#pragma unroll
            for (int h = 0; h < 2; ++h) { const u32x4 w = rw[u].x[h]; x.v[2 * h] = (f32x4){bflo(w.x), bfhi(w.x), bflo(w.y), bfhi(w.y)}; x.v[2 * h + 1] = (f32x4){bflo(w.z), bfhi(w.z), bflo(w.w), bfhi(w.w)}; }
#pragma unroll
            for (int j = 0; j < 4; ++j) { f32x4 f = (f32x4){0.f, 0.f, 0.f, 0.f};
#pragma unroll
                for (int k = 0; k < 4; ++k) { const u32x2 w2 = rw[u].f[j >> 1][k]; const int wd = (int)((j & 1) ? w2.y : w2.x);
                    const f32x2 lo = __builtin_amdgcn_cvt_pk_f32_fp8(wd, false), hi = __builtin_amdgcn_cvt_pk_f32_fp8(wd, true); f[0] += lo[0]; f[1] += lo[1]; f[2] += hi[0]; f[3] += hi[1]; }
                const f32x4 gg = *(const LAS f32x4*)(g2 + RC(F.lane, j)) * (1.0f / FS_SCALE);
                x.v[j] = x.v[j] * DN_ALPHA + gg * f; }
            row_ln_plain(x, F.lane); row_affine_l(x, pv_slot(F, 0), pv_slot(F, 1), F.lane);
            if (lastl) { row_store_nt(x, F.out + (size_t)row * D, F.lane); }
            else { row_store_bf16_nt(x, (bf16_t*)(F.ws + WS_X) + (size_t)row * D, F.lane); ln0_row(F, row, x, pv_slot(F, 4 + sel), pv_slot(F, 6 + sel)); } }
    }
    if (!lastl) gates_tail(F, l + 1, t_lo, t_hi);
    __syncthreads();
}

#define MFMA32(a, b, c) __builtin_amdgcn_mfma_f32_32x32x16_bf16((a), (b), (c), 0, 0, 0)
#define MFMA16(a, b, c) __builtin_amdgcn_mfma_f32_16x16x32_bf16((a), (b), (c), 0, 0, 0)
__device__ __forceinline__ f32x16 zero16() { f32x16 z;
#pragma unroll
    for (int i = 0; i < 16; ++i) z[i] = 0.f;
    return z; }
__device__ __forceinline__ void pool_tiles(Frame& F, int l, bool with_ctx) {
    LAS unsigned char* Pin = F.lds;
    LAS unsigned char* Dm = F.lds + 40960;
    const bf16_t* Z = (const bf16_t*)(F.ws + WS_Z);
    const bf16_t* Wp = (const bf16_t*)(F.ws + WS_WPOOL) + (size_t)l * 4 * 4096;
    const float* psc = F.in[IN_POOLS] + l * 256;
    bf16_t* BRA = (bf16_t*)(F.ws + WS_BRA);
    const int ntiles = with_ctx ? 1088 : 1024;
    const int r = F.lane & 31, h = F.lane >> 5;
    for (int tile = F.bid; tile < ntiles; tile += F.G) {
        int row0, seq_lo, seq_hi;
        if (tile < 1024) { row0 = tile * 64; seq_lo = row0; seq_hi = row0 + 64; }
        else { const int ct = tile - 1024; seq_lo = ML + (ct >> 2) * 256; seq_hi = seq_lo + 256; row0 = seq_lo + (ct & 3) * 64; }
        for (int idx = F.tid; idx < 80 * 32; idx += NTHREADS) { const int rr = idx >> 5, ck = idx & 31, grow = row0 - 8 + rr;
            if (grow >= seq_lo && grow < seq_hi) *(LAS u32x4*)(Pin + rr * 512 + ck * 16) = __builtin_nontemporal_load((const u32x4*)(Z + (size_t)grow * NZ + ZC_P + ck * 8)); }
        __syncthreads();
        for (int idx = F.tid; idx < 64 * 32; idx += NTHREADS) { const int tok = idx >> 5, ck = idx & 31, g = ck >> 3, hw = 1 << g, t = row0 + tok;
            const int lo = max(t - hw, seq_lo), hi = min(t + hw, seq_hi);
            float s[8];
#pragma unroll
            for (int e = 0; e < 8; ++e) s[e] = 0.f;
            for (int rw = lo; rw < hi; ++rw) { const u32x4 v = *(const LAS u32x4*)(Pin + (rw - row0 + 8) * 512 + ck * 16);
                s[0] += bflo(v.x); s[1] += bfhi(v.x); s[2] += bflo(v.y); s[3] += bfhi(v.y); s[4] += bflo(v.z); s[5] += bfhi(v.z); s[6] += bflo(v.w); s[7] += bfhi(v.w); }
            const float inv = 1.0f / (float)(hi - lo);
            const u32x4 o = *(const LAS u32x4*)(Pin + (tok + 8) * 512 + ck * 16);
            u32x4 w; w.x = pk2(s[0] * inv - bflo(o.x), s[1] * inv - bfhi(o.x)); w.y = pk2(s[2] * inv - bflo(o.y), s[3] * inv - bfhi(o.y));
            w.z = pk2(s[4] * inv - bflo(o.z), s[5] * inv - bfhi(o.z)); w.w = pk2(s[6] * inv - bflo(o.w), s[7] * inv - bfhi(o.w));
            *(LAS u32x4*)(Dm + tok * 528 + ck * 16) = w; }
        __syncthreads();
#pragma unroll 1
        for (int qi = 0; qi < 2; ++qi) { const int q = F.wave + 8 * qi, g = q >> 2, td = (q >> 1) & 1, tt = q & 1;
            f32x16 acc = zero16();
#pragma unroll
            for (int ks = 0; ks < 4; ++ks) { const bf16x8 a = *(const bf16x8*)(Wp + ((size_t)g * 64 + td * 32 + r) * 64 + ks * 16 + 8 * h);
                const bf16x8 b = *(const LAS bf16x8*)(Dm + (tt * 32 + r) * 528 + (g * 64 + ks * 16 + 8 * h) * 2);
                acc = MFMA32(a, b, acc); }
            const size_t orow = (size_t)(row0 + tt * 32 + r);
#pragma unroll
            for (int qq = 0; qq < 4; ++qq) { const int dcol = g * 64 + td * 32 + 8 * qq + 4 * h; const f32x4 sc = *(const f32x4*)(psc + dcol);
                u32x2 w; w.x = pk2(acc[4 * qq] * sc.x, acc[4 * qq + 1] * sc.y); w.y = pk2(acc[4 * qq + 2] * sc.z, acc[4 * qq + 3] * sc.w);
                *(u32x2*)(BRA + orow * D + dcol) = w; } }
        __syncthreads();
    }
}
__device__ __forceinline__ void sgu_chunks(Frame& F, int l, bool with_ctx) {
    LAS unsigned char* Vt = F.lds;
    const bf16_t* Z = (const bf16_t*)(F.ws + WS_Z);
    const bf16_t* Ws = (const bf16_t*)(F.ws + WS_WSGU) + (size_t)l * 4 * 16384;
    const float* lng = F.in[IN_SLNG] + l * 256; const float* lnb = F.in[IN_SLNB] + l * 256; const float* sb = F.in[IN_SGUB] + l * 512;
    bf16_t* BRA = (bf16_t*)(F.ws + WS_BRA);
    const int nchunks = with_ctx ? 544 : 512;
    const int r = F.lane & 31, h = F.lane >> 5;
    for (int ch = F.bid; ch < nchunks; ch += F.G) {
        const int row0 = ch * 128;
        { const int s = F.tid >> 2, q = F.tid & 3; const bf16_t* zp = Z + (size_t)(row0 + s) * NZ + ZC_UV + 256 + q * 64;
          float v[64]; float sum = 0.f;
#pragma unroll
          for (int i = 0; i < 8; ++i) { const u32x4 w = __builtin_nontemporal_load((const u32x4*)(zp + 8 * i));
              v[8 * i] = bflo(w.x); v[8 * i + 1] = bfhi(w.x); v[8 * i + 2] = bflo(w.y); v[8 * i + 3] = bfhi(w.y); v[8 * i + 4] = bflo(w.z); v[8 * i + 5] = bfhi(w.z); v[8 * i + 6] = bflo(w.w); v[8 * i + 7] = bfhi(w.w); }
#pragma unroll
          for (int i = 0; i < 64; ++i) sum += v[i];
          sum += shx(sum, 1, F.lane); sum += shx(sum, 2, F.lane);
          const float mean = sum * (1.f / 256.f); float sq = 0.f;
#pragma unroll
          for (int i = 0; i < 64; ++i) { v[i] -= mean; sq += v[i] * v[i]; }
          sq += shx(sq, 1, F.lane); sq += shx(sq, 2, F.lane);
          const float rstd = 1.f / sqrtf(sq * (1.f / 256.f) + LN_EPS);
#pragma unroll
          for (int i = 0; i < 64; ++i) { const int c = q * 64 + i; const float y = v[i] * rstd * lng[c] + lnb[c]; *(LAS bf16_t*)(Vt + c * 272 + s * 2) = (bf16_t)f2bf(y); } }
        __syncthreads();
        const int tc = F.wave & 1, tt = F.wave >> 1, t = tt * 32 + r;
#pragma unroll 1
        for (int g = 0; g < 4; ++g) {
            f32x16 acc = zero16();
#pragma unroll
            for (int ks = 0; ks < 8; ++ks) { const bf16x8 a = *(const LAS bf16x8*)(Vt + (g * 64 + tc * 32 + r) * 272 + (ks * 16 + 8 * h) * 2);
                const bf16x8 b = *(const bf16x8*)(Ws + ((size_t)g * 128 + t) * 128 + ks * 16 + 8 * h);
                acc = MFMA32(a, b, acc); }
            const float bias = sb[g * 128 + t];
#pragma unroll
            for (int qq = 0; qq < 4; ++qq) { const int c0 = g * 64 + tc * 32 + 8 * qq + 4 * h;
                const u32x2 u = *(const u32x2*)(Z + (size_t)(row0 + t) * NZ + ZC_UV + c0);
                u32x2 w; w.x = pk2(bflo(u.x) * (acc[4 * qq] + bias), bfhi(u.x) * (acc[4 * qq + 1] + bias)); w.y = pk2(bflo(u.y) * (acc[4 * qq + 2] + bias), bfhi(u.y) * (acc[4 * qq + 3] + bias));
                *(u32x2*)(BRA + (size_t)(row0 + t) * D + 768 + c0) = w; } }
        __syncthreads();
    }
}
__device__ __forceinline__ void qk_conv_pass(Frame& F, int l) {
    const bf16_t* Z = (const bf16_t*)(F.ws + WS_Z); bf16_t* QKC = (bf16_t*)(F.ws + WS_H);
    const int chunk = F.tid & 127, rsub = F.tid >> 7, ch0 = chunk * 8;
    float w0[8], w1[8], w2[8], cbv[8];
    { const float* cw = F.in[IN_CONVW] + (size_t)l * 3 * 1024 + ch0; const float* cb = F.in[IN_CONVB] + (size_t)l * 1024 + ch0;
#pragma unroll
      for (int e = 0; e < 8; ++e) { w0[e] = cw[e]; w1[e] = cw[1024 + e]; w2[e] = cw[2048 + e]; cbv[e] = cb[e]; } }
    const float scale = chunk >= 64 ? 0.08838834764831845f : 1.0f;
    for (int row = F.bid * 4 + rsub; row < MT; row += F.G * 4) {
        const int p = row < ML ? (row & 4095) : ((row - ML) & 255), len = row < ML ? 4096 : 256;
        const bf16_t* zr = Z + (size_t)row * NZ + ZC_QK + ch0;
        const u32x4 x1 = *(const u32x4*)zr; u32x4 x0 = (u32x4){0u, 0u, 0u, 0u}, x2 = (u32x4){0u, 0u, 0u, 0u};
        if (p > 0) x0 = *(const u32x4*)(zr - NZ);
        if (p + 1 < len) x2 = *(const u32x4*)(zr + NZ);
        const unsigned xa[4] = {x0.x, x0.y, x0.z, x0.w}, xb[4] = {x1.x, x1.y, x1.z, x1.w}, xc[4] = {x2.x, x2.y, x2.z, x2.w};
        float y[8];
#pragma unroll
        for (int e2 = 0; e2 < 4; ++e2) { y[2 * e2] = cbv[2 * e2] + w0[2 * e2] * bflo(xa[e2]) + w1[2 * e2] * bflo(xb[e2]) + w2[2 * e2] * bflo(xc[e2]);
            y[2 * e2 + 1] = cbv[2 * e2 + 1] + w0[2 * e2 + 1] * bfhi(xa[e2]) + w1[2 * e2 + 1] * bfhi(xb[e2]) + w2[2 * e2 + 1] * bfhi(xc[e2]); }
#pragma unroll
        for (int e = 0; e < 8; ++e) y[e] = siluf_(y[e]) * scale;
        u32x4 w; w.x = pk2(y[0], y[1]); w.y = pk2(y[2], y[3]); w.z = pk2(y[4], y[5]); w.w = pk2(y[6], y[7]);
        *(u32x4*)(QKC + (size_t)row * D + ch0) = w;
    }
}
constexpr int ML_QS = 0, ML_KS = 34816, ML_KW = 69632, ML_VT = 104448, ML_CB = 126208, ML_SC = 147968, ML_SCSZ = 2624;
__device__ __forceinline__ float logsigf_(float x) { return fminf(x, 0.f) - __logf(1.0f + __expf(-fabsf(x))); }
__device__ __forceinline__ unsigned swap16(unsigned u) { return __builtin_amdgcn_alignbit(u, u, 16); }
struct MlPre { u32x4 qk[8]; u32x2 v[4]; float g[4]; };
__device__ __forceinline__ void ml_geom(int j, int b, int dir, int& seqbase, int& seqlen, int& pbase) {
    const bool is_ctx = j < 2; int cj = is_ctx ? j : j - 2; const int ncs = is_ctx ? 2 : 32; if (dir) cj = ncs - 1 - cj;
    seqbase = is_ctx ? ML + b * 256 : b * 4096; seqlen = is_ctx ? 256 : 4096; pbase = cj * 128; }
#define ML_BAR() do { asm volatile("s_waitcnt lgkmcnt(0)" ::: "memory"); __builtin_amdgcn_s_barrier(); asm volatile("" ::: "memory"); } while (0)
__device__ __forceinline__ void mlstm_unit(Frame& F, int l, int unit) {
    const int bh = (unit & 7) + 8 * (unit >> 5), sub = (unit >> 3) & 3;
    const int b = bh >> 2, head = bh & 3, dir = sub >> 1, vh = sub & 1;
    LAS unsigned char* QS = F.lds + ML_QS; LAS unsigned char* KS = F.lds + ML_KS; LAS unsigned char* KW = F.lds + ML_KW; LAS unsigned char* VT = F.lds + ML_VT; LAS unsigned char* CB = F.lds + ML_CB;
    const bf16_t* Z = (const bf16_t*)(F.ws + WS_Z); const float* ZG = (const float*)(F.ws + WS_ZG); const bf16_t* QKC = (const bf16_t*)(F.ws + WS_H);
    bf16_t* HF = (bf16_t*)(F.ws + WS_HFB) + (size_t)dir * MT * 512;
    const int wave = F.wave;
    int tl = F.tid;
#define ML_ROLES() const int lane = tl & 63, fr = lane & 15, q4 = lane >> 4; const int isk = (tl >> 4) & 1, ck = tl & 15, i0 = 8 * (tl >> 5), chn = (isk ? 512 : 0) + head * 128 + ck * 8; \
    const int vi0 = 4 * (tl >> 4), vcq = tl & 15, vch = head * 128 + vh * 64 + vcq * 4; (void)fr; (void)q4; (void)vi0; (void)vcq; (void)vch; (void)i0; (void)chn; (void)ck; (void)isk;
    for (int idx = F.tid; idx < 16 * 136; idx += NTHREADS) *(LAS bf16_t*)(VT + (64 + idx / 136) * 272 + (idx % 136) * 2) = (idx < 136) ? (bf16_t)0x3F80 : (bf16_t)0;
    f32x4 cs[5];
#pragma unroll
    for (int vt = 0; vt < 5; ++vt) cs[vt] = (f32x4){0.f, 0.f, 0.f, 0.f};
    float m_state = 0.f;
    MlPre pre;
#define ML_PREFETCH(jj) do { int sb_, sl_, pb_; ml_geom((jj), b, dir, sb_, sl_, pb_); \
        { const int pmin = dir ? pb_ + 120 - i0 : pb_ + i0; const bf16_t* zr = QKC + (size_t)(sb_ + pmin) * D + chn; (void)sl_; \
          _Pragma("unroll") for (int k = 0; k < 8; ++k) pre.qk[k] = *(const u32x4*)(zr + (size_t)k * D); } \
        { const int pminv = dir ? pb_ + 124 - vi0 : pb_ + vi0; const bf16_t* zv = Z + (size_t)(sb_ + pminv) * NZ + ZC_V + vch; \
          _Pragma("unroll") for (int k = 0; k < 4; ++k) pre.v[k] = *(const u32x2*)(zv + (size_t)k * NZ); } \
        if (wave == 0) { const int p0 = dir ? pb_ + 127 - 2 * lane : pb_ + 2 * lane, p1 = dir ? p0 - 1 : p0 + 1; \
          pre.g[0] = ZG[(size_t)(sb_ + p0) * 16 + dir * 8 + head]; pre.g[1] = ZG[(size_t)(sb_ + p0) * 16 + dir * 8 + 4 + head]; \
          pre.g[2] = ZG[(size_t)(sb_ + p1) * 16 + dir * 8 + head]; pre.g[3] = ZG[(size_t)(sb_ + p1) * 16 + dir * 8 + 4 + head]; } } while (0)
#define ML_STEPA(sbuf) do { LAS float* sg_ = (LAS float*)(F.lds + ML_SC + (sbuf) * ML_SCSZ); const int i0g = 2 * lane, i1g = i0g + 1; \
        const float gi0 = pre.g[0], gf0 = pre.g[1], gi1 = pre.g[2], gf1 = pre.g[3]; \
        const float lf0 = logsigf_(gf0), lf1 = logsigf_(gf1); const float s1 = lf0 + lf1; float incl = s1; \
        _Pragma("unroll") for (int o = 1; o < 64; o <<= 1) { const float y_ = shup(incl, o, lane); incl += (lane >= o) ? y_ : 0.f; } \
        const float excl = incl - s1, bc0 = excl + lf0, bc1 = excl + s1; \
        const float g0 = gi0 - bc0, g1 = gi1 - bc1; const float mx1 = fmaxf(g0, g1); float im = mx1; \
        _Pragma("unroll") for (int o = 1; o < 64; o <<= 1) { const float y_ = shup(im, o, lane); im = (lane >= o) ? fmaxf(im, y_) : im; } \
        float em = shup(im, 1, lane); em = (lane == 0) ? -3.0e38f : em; \
        const float M0 = fmaxf(m_state, fmaxf(em, g0)), M1 = fmaxf(m_state, fmaxf(em, mx1)); \
        const float total = bperm(63, bc1), Mlast = bperm(63, M1); \
        sg_[i0g] = g0; sg_[i1g] = g1; sg_[128 + i0g] = M0; sg_[128 + i1g] = M1; \
        sg_[256 + i0g] = __expf(m_state - M0); sg_[256 + i1g] = __expf(m_state - M1); \
        sg_[384 + i0g] = __expf(-(bc0 + M0)); sg_[384 + i1g] = __expf(-(bc1 + M1)); \
        sg_[512 + i0g] = __expf(g0 - Mlast); sg_[512 + i1g] = __expf(g1 - Mlast); \
        if (lane == 0) sg_[640] = __expf(m_state - Mlast); \
        m_state = total + Mlast; } while (0)
    { ML_ROLES(); ML_PREFETCH(0); if (wave == 0) ML_STEPA(0); }
    ML_BAR();
#pragma unroll 1
    for (int j = 0; j < 34; ++j) {
        asm volatile("" : "+v"(tl));
        ML_ROLES();
        int seqbase, seqlen, pbase; ml_geom(j, b, dir, seqbase, seqlen, pbase);
        const LAS float* sc_g = (const LAS float*)(F.lds + ML_SC + (j & 1) * ML_SCSZ); const LAS float* sc_M = sc_g + 128; const LAS float* sc_dec = sc_g + 256; const LAS float* sc_emt = sc_g + 384; const LAS float* sc_wk = sc_g + 512;
        {
#pragma unroll
          for (int k = 0; k < 8; ++k) { const int i = dir ? i0 + 7 - k : i0 + k; *(LAS u32x4*)((isk ? KS : QS) + i * 272 + ck * 16) = pre.qk[k]; }
          if (isk) { u32x4 kt[8]; float ykeep[8];
#pragma unroll
              for (int e = 0; e < 8; ++e) { kt[e] = (u32x4){0u, 0u, 0u, 0u}; ykeep[e] = 0.f; }
#pragma unroll
              for (int k = 0; k < 8; ++k) { const int i = dir ? i0 + 7 - k : i0 + k; const float wk = sc_wk[i];
                  const unsigned xb[4] = {pre.qk[k].x, pre.qk[k].y, pre.qk[k].z, pre.qk[k].w};
#pragma unroll
                  for (int e = 0; e < 8; ++e) { const float yw = ((e & 1) ? bfhi(xb[e >> 1]) : bflo(xb[e >> 1])) * wk;
                      if (k & 1) { const unsigned pw_ = pk2(ykeep[e], yw); if ((k >> 1) == 0) kt[e].x = pw_; else if ((k >> 1) == 1) kt[e].y = pw_; else if ((k >> 1) == 2) kt[e].z = pw_; else kt[e].w = pw_; }
                      else ykeep[e] = yw; } }
#pragma unroll
              for (int e = 0; e < 8; ++e) { u32x4 o = kt[e]; if (dir) o = (u32x4){swap16(kt[e].w), swap16(kt[e].z), swap16(kt[e].y), swap16(kt[e].x)};
                  *(LAS u32x4*)(KW + (ck * 8 + e) * 272 + (((i0 >> 3) ^ (ck & 7)) * 16)) = o; } } }
        { unsigned vv[4][2];
#pragma unroll
          for (int k = 0; k < 4; ++k) { vv[k][0] = pre.v[k].x; vv[k][1] = pre.v[k].y; }
#pragma unroll
          for (int c = 0; c < 4; ++c) {
              unsigned h0 = (c & 1) ? (vv[0][c >> 1] >> 16) : (vv[0][c >> 1] & 0xffffu), h1 = (c & 1) ? (vv[1][c >> 1] >> 16) : (vv[1][c >> 1] & 0xffffu);
              unsigned h2 = (c & 1) ? (vv[2][c >> 1] >> 16) : (vv[2][c >> 1] & 0xffffu), h3 = (c & 1) ? (vv[3][c >> 1] >> 16) : (vv[3][c >> 1] & 0xffffu);
              u32x2 o; if (dir) { o.x = h3 | (h2 << 16); o.y = h1 | (h0 << 16); } else { o.x = h0 | (h1 << 16); o.y = h2 | (h3 << 16); }
              *(LAS u32x2*)(VT + (vcq * 4 + c) * 272 + vi0 * 2) = o; } }
#pragma unroll
        for (int vt = 0; vt < 5; ++vt)
#pragma unroll
            for (int rr = 0; rr < 4; rr += 2) { const unsigned pw_ = pk2(cs[vt][rr], cs[vt][rr + 1]);
                *(LAS bf16_t*)(CB + (16 * vt + 4 * q4 + rr) * 272 + (16 * wave + fr) * 2) = (bf16_t)(pw_ & 0xffffu); *(LAS bf16_t*)(CB + (16 * vt + 4 * q4 + rr + 1) * 272 + (16 * wave + fr) * 2) = (bf16_t)(pw_ >> 16); }
        ML_BAR();
        if (j + 1 < 34) ML_PREFETCH(j + 1);
        const int t = 16 * wave + fr;
        bf16x8 qf[4];
#pragma unroll
        for (int kc = 0; kc < 4; ++kc) qf[kc] = *(const LAS bf16x8*)(QS + t * 272 + (32 * kc + 8 * q4) * 2);
        const float Mt_t = sc_M[t], dec_t = sc_dec[t], emt_t = sc_emt[t];
        f32x4 ps[8];
#pragma unroll
        for (int jp = 0; jp < 4; ++jp) {
            ps[2 * jp] = (f32x4){0.f, 0.f, 0.f, 0.f}; ps[2 * jp + 1] = (f32x4){0.f, 0.f, 0.f, 0.f};
            if (2 * jp <= wave) {
                bf16x8 ka[4], kb[4];
#pragma unroll
                for (int kc = 0; kc < 4; ++kc) { ka[kc] = *(const LAS bf16x8*)(KS + (32 * jp + fr) * 272 + (32 * kc + 8 * q4) * 2); kb[kc] = *(const LAS bf16x8*)(KS + (32 * jp + 16 + fr) * 272 + (32 * kc + 8 * q4) * 2); }
                const f32x4 ga4 = *(const LAS f32x4*)(sc_g + 32 * jp + 4 * q4), gb4 = *(const LAS f32x4*)(sc_g + 32 * jp + 16 + 4 * q4);
                f32x4 acc0 = (f32x4){0.f, 0.f, 0.f, 0.f}, acc1 = (f32x4){0.f, 0.f, 0.f, 0.f};
#pragma unroll
                for (int kc = 0; kc < 4; ++kc) { acc0 = MFMA16(ka[kc], qf[kc], acc0); acc1 = MFMA16(kb[kc], qf[kc], acc1); }
#pragma unroll
                for (int rr = 0; rr < 4; ++rr) { const int s0 = 32 * jp + 4 * q4 + rr, s1 = s0 + 16;
                    ps[2 * jp][rr] = (s0 <= t) ? acc0[rr] * __expf(ga4[rr] - Mt_t) : 0.f; ps[2 * jp + 1][rr] = (s1 <= t) ? acc1[rr] * __expf(gb4[rr] - Mt_t) : 0.f; }
            }
        }
        f32x4 ao[5];
        {
#pragma unroll
          for (int vt = 0; vt < 5; ++vt) ao[vt] = (f32x4){0.f, 0.f, 0.f, 0.f};
#pragma unroll
          for (int kh = 0; kh < 4; kh += 2) { bf16x8 cf[2][5];
#pragma unroll
              for (int k2 = 0; k2 < 2; ++k2)
#pragma unroll
                  for (int vt = 0; vt < 5; ++vt) cf[k2][vt] = *(const LAS bf16x8*)(CB + (16 * vt + fr) * 272 + (32 * (kh + k2) + 8 * q4) * 2);
#pragma unroll
              for (int k2 = 0; k2 < 2; ++k2)
#pragma unroll
                  for (int vt = 0; vt < 5; ++vt) ao[vt] = MFMA16(cf[k2][vt], qf[kh + k2], ao[vt]); }
#pragma unroll
          for (int vt = 0; vt < 5; ++vt) ao[vt] = ao[vt] * dec_t; }
#pragma unroll
        for (int ks = 0; ks < 4; ++ks) {
            if (2 * ks <= wave) {
                s16x4 vlo[5], vhi[5];
#pragma unroll
                for (int vt = 0; vt < 5; ++vt) { vlo[vt] = *(const LAS s16x4*)(VT + (16 * vt + fr) * 272 + (32 * ks + 4 * q4) * 2); vhi[vt] = *(const LAS s16x4*)(VT + (16 * vt + fr) * 272 + (32 * ks + 16 + 4 * q4) * 2); }
                u32x4 pw; pw.x = cvt_pk_bf16(ps[2 * ks][0], ps[2 * ks][1]); pw.y = cvt_pk_bf16(ps[2 * ks][2], ps[2 * ks][3]); pw.z = cvt_pk_bf16(ps[2 * ks + 1][0], ps[2 * ks + 1][1]); pw.w = cvt_pk_bf16(ps[2 * ks + 1][2], ps[2 * ks + 1][3]);
                const bf16x8 pf = __builtin_bit_cast(bf16x8, pw);
#pragma unroll
                for (int vt = 0; vt < 5; ++vt) { const bf16x8 a = __builtin_shufflevector(vlo[vt], vhi[vt], 0, 1, 2, 3, 4, 5, 6, 7); ao[vt] = MFMA16(a, pf, ao[vt]); }
            }
        }
        { const float den = bperm(fr, ao[4][0]); const float inv = 1.0f / fmaxf(fabsf(den), emt_t);
          const int p = dir ? pbase + 127 - t : pbase + t; bf16_t* orow = HF + (size_t)(seqbase + p) * 512 + head * 128 + vh * 64 + 4 * q4;
#pragma unroll
          for (int vt = 0; vt < 4; ++vt) { const f32x4 o = ao[vt] * inv; u32x2 w; w.x = cvt_pk_bf16(o[0], o[1]); w.y = cvt_pk_bf16(o[2], o[3]); *(u32x2*)(orow + 16 * vt) = w; } }
        { const float a_s = sc_g[640];
#pragma unroll
          for (int vt = 0; vt < 5; ++vt) cs[vt] = cs[vt] * a_s;
#pragma unroll
          for (int ks = 0; ks < 4; ks += 2) { bf16x8 bb[2], va[2][5];
#pragma unroll
              for (int k2 = 0; k2 < 2; ++k2) { bb[k2] = *(const LAS bf16x8*)(KW + (16 * wave + fr) * 272 + (((4 * (ks + k2) + q4) ^ (((16 * wave + fr) >> 3) & 7)) * 16));
#pragma unroll
                  for (int vt = 0; vt < 5; ++vt) va[k2][vt] = *(const LAS bf16x8*)(VT + (16 * vt + fr) * 272 + (32 * (ks + k2) + 8 * q4) * 2); }
#pragma unroll
              for (int k2 = 0; k2 < 2; ++k2)
#pragma unroll
                  for (int vt = 0; vt < 5; ++vt) cs[vt] = MFMA16(va[k2][vt], bb[k2], cs[vt]); } }
        if (wave == 0 && j + 1 < 34) ML_STEPA((j + 1) & 1);
        ML_BAR();
    }
#undef ML_PREFETCH
#undef ML_STEPA
#undef ML_ROLES
    __syncthreads();
}
__device__ __forceinline__ void phase_mixers(Frame& F, int l) {
    const bool with_ctx = (l != DEPTH - 1);
#ifndef MIX_MASK
#define MIX_MASK 7
#endif
#ifndef MIXREP
#define MIXREP 0
#endif
    if (MIX_MASK & 1) pool_tiles(F, l, with_ctx);
    if (MIXREP & 1) { __syncthreads(); pool_tiles(F, l, with_ctx); }
    if (MIX_MASK & 2) sgu_chunks(F, l, with_ctx);
    if (MIXREP & 2) { __syncthreads(); sgu_chunks(F, l, with_ctx); }
    (void)0;
    qk_conv_pass(F, l);
}
__device__ __forceinline__ void phase_mlstm(Frame& F, int l) {
    for (int u = F.bid; u < 256; u += F.G) mlstm_unit(F, l, u);
}

struct Args { const float* in[31]; float* out; unsigned char* ws; int g_lo, g_hi, pad0, pad1; };
constexpr int NPH = 11, NGID = 2 + DEPTH * NPH;
__global__ void __launch_bounds__(NTHREADS, 2) fwd_kernel(Args args) {
    extern __shared__ __attribute__((aligned(16))) unsigned char lds_raw[];
    Frame F;
    F.lds = (LAS unsigned char*)lds_raw; F.MISC = (volatile LAS unsigned*)(F.lds + MISC_OFF);
    F.tid = threadIdx.x; F.lane = F.tid & 63; F.wave = __builtin_amdgcn_readfirstlane(F.tid >> 6); F.G = gridDim.x; F.bid = blockIdx.x;
    F.ws = args.ws; F.out = args.out;
    F.in = (InTab)__builtin_amdgcn_kernarg_segment_ptr();
    if (F.tid < 64) F.MISC[F.tid] = 0u;
    __syncthreads();
    const int lo = args.g_lo, hi = args.g_hi;
    const bool multi = (hi - lo) > 1;
    XcdBarrier bar; bar.bar = (unsigned*)(F.ws + WS_CTL) + CW_BAR; bar.x = 0; bar.st = nullptr;
    if (multi) bar = xcd_barrier_post((unsigned*)(F.ws + WS_CTL) + CW_BAR, F.MISC + 8);
#ifndef PHASE_MASK
#define PHASE_MASK 0xFFFF
#endif
#define RUN(g) (lo <= (g) && (g) < hi)
#define RUNP(ty, g) ((((PHASE_MASK) >> (ty)) & 1) && RUN(g))
#ifndef REPEAT_MASK
#define REPEAT_MASK 0
#endif
#define NREP(ty) ((((REPEAT_MASK) >> (ty)) & 1) ? 2 : 1)
#define SEAM(g) do { if (RUN((g) + 1)) xcd_barrier(bar); } while (0)
#define LAUNDER(P) Frame P = F; { int t_; asm volatile("v_mbcnt_lo_u32_b32 %0, -1, 0\n\tv_mbcnt_hi_u32_b32 %0, -1, %0" : "=v"(t_)); t_ |= (F.wave << 6); P.tid = t_; P.lane = t_ & 63; P.wave = __builtin_amdgcn_readfirstlane(t_ >> 6); GAS unsigned char* w_ = (GAS unsigned char*)F.ws; asm volatile("" : "+s"(w_)); P.ws = (unsigned char*)w_; InTab t2_ = F.in; asm volatile("" : "+s"(t2_)); P.in = t2_; }
    if (RUNP(0, 0)) { LAUNDER(P); for (int rep_ = 0; rep_ < NREP(0); ++rep_) { phase_prologue(P); __syncthreads(); } SEAM(0); }
    if (RUNP(1, 1)) { LAUNDER(P); for (int rep_ = 0; rep_ < NREP(1); ++rep_) { phase_ln0_first(P); __syncthreads(); } SEAM(1); }
#pragma unroll 1
    for (int l = 0; l < DEPTH; ++l) {
        const int g0 = 2 + l * NPH;
        const int mrows = (l == DEPTH - 1) ? ML : MT;
        if (RUNP(2, g0 + 0)) {
#undef PHTY
#define PHTY 2
            LAUNDER(P);
            { ProbPlain Pr{(const bf16_t*)(P.ws + WS_H), (const bf16_t*)(P.ws + WS_WIN) + (size_t)l * NZ * D, D, D};
              pg8::StaticOrder<1> S; S.init(MT / 256, NZ_BF / 256, P.G, P.bid);
              EpiInproj<false> E{(bf16_t*)(P.ws + WS_Z), P.in[IN_BIN] + (size_t)l * 5904, 0};
              pg8::gemm_phase(P.lds, P.tid, Pr, S, E); }
            __syncthreads();
            { ProbPlainF8 Pr{(const bf16_t*)(P.ws + WS_H8), (const bf16_t*)(P.ws + WS_WIN8 + (size_t)l * NZ_F8 * D), D / 2, D / 2};
              pg8::StaticOrder<1> S; S.init(MT / 256, NZ_F8 / 256, P.G, P.bid);
              EpiInproj<true> E{(bf16_t*)(P.ws + WS_Z), P.in[IN_BIN] + (size_t)l * 5904, NZ_BF / 256};
              pg8::gemm_phase(P.lds, P.tid, Pr, S, E); }
            SEAM(g0 + 0);
        }
        if (RUNP(3, g0 + 1)) { LAUNDER(P); for (int rep_ = 0; rep_ < NREP(3); ++rep_) { phase_mixers(P, l); __syncthreads(); } SEAM(g0 + 1); }
        if (RUNP(12, g0 + 2)) { LAUNDER(P); for (int rep_ = 0; rep_ < NREP(12); ++rep_) { phase_mlstm(P, l); __syncthreads(); } SEAM(g0 + 2); }
        if (RUNP(4, g0 + 3)) { LAUNDER(P); for (int rep_ = 0; rep_ < NREP(4); ++rep_) phase_finalize(P, l, mrows); SEAM(g0 + 3); }
        if (RUNP(5, g0 + 4)) {
#undef PHTY
#define PHTY 5
            LAUNDER(P);
            ProbPlain Pr{(const bf16_t*)(P.ws + WS_BRA), (const bf16_t*)(P.ws + WS_WBR) + (size_t)l * D * D, D, D};
            pg8::StaticOrder<1> S; S.init(mrows / 256, 4, P.G, P.bid);
            EpiBranch E{(const bf16_t*)(P.ws + WS_Z), (bf16_t*)(P.ws + WS_Y)};
            pg8::gemm_phase(P.lds, P.tid, Pr, S, E); if (NREP(PHTY) == 2) { __syncthreads(); pg8::gemm_phase(P.lds, P.tid, Pr, S, E); }
            SEAM(g0 + 4);
        }
        if (RUNP(6, g0 + 5)) {
#undef PHTY
#define PHTY 6
            LAUNDER(P);
            ProbPlain Pr{(const bf16_t*)(P.ws + WS_Y), (const bf16_t*)(P.ws + WS_WOUT) + (size_t)l * D * D, D, D};
            pg8::StaticOrder<1> S; S.init(mrows / 256, 4, P.G, P.bid);
            EpiOut E{(bf16_t*)(P.ws + WS_T)};
            pg8::gemm_phase(P.lds, P.tid, Pr, S, E); if (NREP(PHTY) == 2) { __syncthreads(); pg8::gemm_phase(P.lds, P.tid, Pr, S, E); }
            SEAM(g0 + 5);
        }
        if (RUNP(7, g0 + 6)) { LAUNDER(P); for (int rep_ = 0; rep_ < NREP(7); ++rep_) phase_ln1_router(P, l, mrows); SEAM(g0 + 6); }
        if (RUNP(8, g0 + 7)) { LAUNDER(P); for (int rep_ = 0; rep_ < NREP(8); ++rep_) phase_slots(P, mrows); SEAM(g0 + 7); }
        if (RUNP(9, g0 + 8)) {
#undef PHTY
#define PHTY 9
            LAUNDER(P);
            LAS int* seg = (LAS int*)(P.lds + TAB_OFF);
            const int ntile = moe_tables(P, seg);
            ProbMoe1 Pr{(const bf16_t*)(P.ws + WS_H2F8), (const bf16_t*)(P.ws + WS_WGU + (size_t)l * NEXP * 2048 * D), D / 2, D / 2, (const int*)(P.ws + WS_ROUTE + RT_TOK), seg};
            pg8::StaticOrder<1> S; S.init(ntile, 8, P.G, P.bid);
            EpiSwiglu E{(unsigned char*)(P.ws + WS_HID), P.in[IN_BGU] + (size_t)l * NEXP * 2048, seg};
            pg8::gemm_phase(P.lds, P.tid, Pr, S, E); if (NREP(PHTY) == 2) { __syncthreads(); pg8::gemm_phase(P.lds, P.tid, Pr, S, E); }
            SEAM(g0 + 8);
        }
        if (RUNP(10, g0 + 9)) {
#undef PHTY
#define PHTY 10
            LAUNDER(P);
            LAS int* seg = (LAS int*)(P.lds + TAB_OFF);
            const int ntile = moe_tables(P, seg);
            ProbMoe2 Pr{(const bf16_t*)(P.ws + WS_HID), (const bf16_t*)(P.ws + WS_WDN + (size_t)l * NEXP * D * D), D / 2, D / 2, seg};
            pg8::StaticOrder<1> S; S.init(ntile, 4, P.G, P.bid);
            EpiDown E{(unsigned char*)(P.ws + WS_FS), P.in[IN_BDN] + (size_t)l * NEXP * D, (const int*)(P.ws + WS_ROUTE + RT_DEST), (const float*)(P.ws + WS_ROUTE + RT_PSLOT), seg};
            pg8::gemm_phase(P.lds, P.tid, Pr, S, E); if (NREP(PHTY) == 2) { __syncthreads(); pg8::gemm_phase(P.lds, P.tid, Pr, S, E); }
            SEAM(g0 + 9);
        }
        if (RUNP(11, g0 + 10)) { LAUNDER(P); phase_combine_ln2(P, l, mrows); SEAM(g0 + 10); }
    }
#undef LAUNDER
#undef RUN
#undef RUNP
#undef SEAM
}

extern "C" void kernel_launch(void* const* d_in, const int* in_sizes, int n_in, void* d_out, int out_size, void* d_ws, size_t ws_size, hipStream_t stream) {
    static int grid = 0;
    if (grid == 0) {
        if (n_in != 31 || out_size != ML * D || ws_size < WS_END) { fprintf(stderr, "kernel_launch: unexpected problem (n_in %d, out %d, ws %zu, need %zu)\n", n_in, out_size, ws_size, (size_t)WS_END); grid = -1; return; }
        int dev = 0, cus = 0, per_cu = 0;
        if (hipGetDevice(&dev) != hipSuccess || hipDeviceGetAttribute(&cus, hipDeviceAttributeMultiprocessorCount, dev) != hipSuccess) { grid = -1; return; }
        if (hipFuncSetAttribute((const void*)fwd_kernel, hipFuncAttributeMaxDynamicSharedMemorySize, LDS_BYTES) != hipSuccess) { fprintf(stderr, "kernel_launch: hipFuncSetAttribute failed\n"); grid = -1; return; }
        if (hipOccupancyMaxActiveBlocksPerMultiprocessor(&per_cu, (const void*)fwd_kernel, NTHREADS, LDS_BYTES) != hipSuccess || per_cu < 1) fprintf(stderr, "kernel_launch: occupancy query reports %d\n", per_cu);
        (void)hipGetLastError();
        grid = cus;
    }
    if (grid < 0) return;
    (void)hipMemsetAsync((char*)d_ws + WS_CTL, 0, CTL_ZERO_BYTES, stream);
    Args a{};
    for (int i = 0; i < 31; ++i) a.in[i] = (const float*)d_in[i];
    a.out = (float*)d_out; a.ws = (unsigned char*)d_ws;
#if MK_N_LAUNCHES == 1
    a.g_lo = 0; a.g_hi = NGID;
    hipLaunchKernelGGL(fwd_kernel, dim3(grid), dim3(NTHREADS), LDS_BYTES, stream, a);
#else
    for (int g = 0; g < NGID; ++g) { a.g_lo = g; a.g_hi = g + 1; hipLaunchKernelGGL(fwd_kernel, dim3(grid), dim3(NTHREADS), LDS_BYTES, stream, a); }
#endif
}
```

```cpp
#include <hip/hip_runtime.h>
#include <cstdio>
#include <cstdint>

#ifndef MK_N_LAUNCHES
#define MK_N_LAUNCHES 1
#endif

#define LAS __attribute__((address_space(3)))
#define GAS __attribute__((address_space(1)))
typedef unsigned short bf16_t;
typedef short bf16x8 __attribute__((ext_vector_type(8)));
typedef short s16x4 __attribute__((ext_vector_type(4)));
typedef float f32x4 __attribute__((ext_vector_type(4)));
typedef float f32x2 __attribute__((ext_vector_type(2)));
typedef float f32x16 __attribute__((ext_vector_type(16)));
typedef unsigned u32x4 __attribute__((ext_vector_type(4)));
typedef unsigned u32x2 __attribute__((ext_vector_type(2)));
typedef int i32x4 __attribute__((ext_vector_type(4)));
typedef int i32x8 __attribute__((ext_vector_type(8)));

constexpr int D = 1024, NB = 16, SEQ = 4096, CTXL = 256, DEPTH = 4;
constexpr int ML = NB * SEQ;
constexpr int MC = NB * CTXL;
constexpr int MT = ML + MC;
constexpr int NZ = 5888;
constexpr int ZC_P = 0, ZC_QK = 256, ZC_V = 1280, ZC_O = 1792, ZC_UV = 2304, ZC_MG = 2816;
constexpr int NZ_BF = 1792, NZ_F8 = 4096;
constexpr int ZG_COL = 2816;
constexpr int NEXP = 32, TOPK = 4;
constexpr int NS_MAX = MT * TOPK + NEXP * 256;
constexpr float LN_EPS = 1e-5f, HEAD_EPS = 1e-6f;
constexpr float DN_ALPHA = 1.6817928305074292f;
constexpr int NWAVES = 8, NTHREADS = 512;
constexpr float F8S_ACT = 4.0f, F8S_WGU = 64.0f, F8S_WDN = 64.0f; constexpr int F8E_ACT = 123, F8E_WGU = 123, F8E_WDN = 123;

constexpr size_t MiB = 1u << 20;
constexpr size_t WS_CTL = 0, CTL_ZERO_BYTES = 1 * MiB;
constexpr size_t WS_MOD = 1 * MiB;
constexpr size_t WS_WG = 3 * MiB;
constexpr size_t WS_WSGU = 4 * MiB;
constexpr size_t WS_WPOOL = WS_WSGU + 512 * 1024;
constexpr size_t WS_ROUTE = 5 * MiB;
constexpr size_t WS_WIN = 16 * MiB;
constexpr size_t WS_WBR = 62 * MiB;
constexpr size_t WS_WOUT = 70 * MiB;
constexpr size_t WS_WGU = 78 * MiB;
constexpr size_t WS_WDN = 590 * MiB;
constexpr size_t WS_X = 846 * MiB;
constexpr size_t WS_H = 1118 * MiB;
constexpr size_t WS_Z = 1254 * MiB;
constexpr size_t WS_FS = WS_Z;
constexpr float G8_SCALE = 255.0f;
constexpr float FS_SCALE = 32.0f, FS_CLAMP = 440.0f;
constexpr size_t WS_BRA = 2036 * MiB;
constexpr size_t WS_HFB = 2172 * MiB;
constexpr size_t WS_Y = 2444 * MiB;
constexpr size_t WS_T = 2580 * MiB;
constexpr size_t WS_H2 = 2852 * MiB;
constexpr size_t WS_HID = 2988 * MiB;
constexpr size_t WS_ZG = 3548 * MiB;
constexpr size_t WS_H2F8 = 3554 * MiB;
constexpr size_t WS_H8 = 3624 * MiB;
constexpr size_t WS_WIN8 = 3692 * MiB;
constexpr size_t WS_END = 3708 * MiB;
static_assert(WS_Z + (size_t)MT * NZ * 2 <= WS_BRA && WS_FS + (size_t)MT * 4 * 1024 * 2 <= WS_BRA, "Z/FS");
static_assert(WS_HID + (size_t)NS_MAX * 1024 * 2 <= WS_END, "HID");
constexpr size_t RT_EIDX = 0;
constexpr size_t RT_PROB = 2 * MiB;
constexpr size_t RT_TOK = 4 * MiB;
constexpr size_t RT_DEST = 6 * MiB;
constexpr size_t RT_PSLOT = 8 * MiB;
constexpr size_t RT_CNT = 10 * MiB;
constexpr size_t RT_SEG = 10 * MiB + 64 * 1024;
constexpr int CW_BAR = 4096;

constexpr int LDS_BYTES = 163840;
constexpr int MISC_OFF = LDS_BYTES - 256;
constexpr int TAB_OFF = 131072;
constexpr int NW_WT = 0;
constexpr int NW_LG = 66048;
constexpr int NW_END = 99840;
constexpr int NW_PV = NW_END + 256;

__device__ __forceinline__ unsigned f2bf(float f) { unsigned u = __builtin_bit_cast(unsigned, f); return (u + 0x7fffu + ((u >> 16) & 1u)) >> 16; }
__device__ __forceinline__ unsigned pk2(float lo, float hi) { unsigned r; asm volatile("v_cvt_pk_bf16_f32 %0, %1, %2" : "=v"(r) : "v"(lo), "v"(hi)); return r; }
__device__ __forceinline__ unsigned pk4_fp8(float a, float b, float c, float d) { int w = 0; w = __builtin_amdgcn_cvt_pk_fp8_f32(a, b, w, false); w = __builtin_amdgcn_cvt_pk_fp8_f32(c, d, w, true); return (unsigned)w; }
__device__ __forceinline__ unsigned pk4_u8(float a, float b, float c, float d) {
    const unsigned lo = __builtin_amdgcn_perm(__builtin_bit_cast(unsigned, b), __builtin_bit_cast(unsigned, a), 0x0c0c0400u), hi = __builtin_amdgcn_perm(__builtin_bit_cast(unsigned, d), __builtin_bit_cast(unsigned, c), 0x0c0c0400u);
    return lo | (hi << 16); }
__device__ __forceinline__ f32x4 u8x4_f32(unsigned w) { return (f32x4){(float)(w & 0xffu), (float)((w >> 8) & 0xffu), (float)((w >> 16) & 0xffu), (float)(w >> 24)}; }
__device__ __forceinline__ float bflo(unsigned w) { return __builtin_bit_cast(float, w << 16); }
__device__ __forceinline__ float bfhi(unsigned w) { return __builtin_bit_cast(float, w & 0xffff0000u); }
__device__ __forceinline__ float bf1(bf16_t h) { return __builtin_bit_cast(float, ((unsigned)h) << 16); }
__device__ __forceinline__ float bperm(int srclane, float v) { return __builtin_bit_cast(float, __builtin_amdgcn_ds_bpermute(srclane << 2, __builtin_bit_cast(int, v))); }
__device__ __forceinline__ float shx(float v, int o, int lane) { return bperm(lane ^ o, v); }
__device__ __forceinline__ float shup(float v, int o, int lane) { return bperm(lane >= o ? lane - o : lane, v); }
__device__ __forceinline__ float wave_sum(float v, int lane) {
#pragma unroll
    for (int o = 1; o < 64; o <<= 1) v += shx(v, o, lane);
    return v;
}
__device__ __forceinline__ float sigmoidf_(float x) { return __builtin_amdgcn_rcpf(1.0f + __builtin_amdgcn_exp2f(x * -1.4426950408889634f)); }
__device__ __forceinline__ float siluf_(float x) { return x * __builtin_amdgcn_rcpf(1.0f + __builtin_amdgcn_exp2f(x * -1.4426950408889634f)); }
#define LDS_WAIT() asm volatile("s_waitcnt lgkmcnt(0)" ::: "memory")
#define VM_WAIT() asm volatile("s_waitcnt vmcnt(0)" ::: "memory")

#define XB_TMO      128
#define XB_XCNT(j)  (256  + 64 * (j))
#define XB_XSUB(j)  (1280 + 64 * (j))
#define XB_XGEN(j)  (2304 + 64 * (j))
#define XB_TOP      3328
#define XB_TOPGEN   3392
#define XCD_BAR_WORDS 3456
#define XB_SPIN_CAP (1u << 18)
__device__ __forceinline__ unsigned xb_ld(unsigned* p)              { asm volatile("" : "+v"(p)); return __hip_atomic_load(p, __ATOMIC_RELAXED, __HIP_MEMORY_SCOPE_AGENT); }
__device__ __forceinline__ unsigned xb_add(unsigned* p, unsigned v) { asm volatile("" : "+v"(p), "+v"(v)); return __hip_atomic_fetch_add(p, v, __ATOMIC_RELAXED, __HIP_MEMORY_SCOPE_AGENT); }
__device__ __forceinline__ unsigned xb_xcc_id() { return (unsigned)__builtin_amdgcn_s_getreg((3 << 11) | 20) & 0xFu; }
#define XB_SPIN(cond, bar) do { unsigned _sp = 0; while (cond) { __builtin_amdgcn_s_sleep(1); \
    if ((++_sp & 255u) == 0u) { if (xb_ld(&(bar)[XB_TMO])) break; if (_sp > XB_SPIN_CAP) { atomicAdd(&(bar)[XB_TMO], 1u); break; } } } } while (0)
struct XcdBarrier { unsigned* bar; unsigned x; volatile LAS unsigned* st; };
__device__ __forceinline__ XcdBarrier xcd_barrier_post(unsigned* bar, volatile LAS unsigned* st) {
    XcdBarrier b; b.bar = bar; b.x = xb_xcc_id(); b.st = st;
    if (threadIdx.x == 0) (void)xb_add(&bar[XB_XCNT(b.x)], 1u);
    return b;
}
__device__ __forceinline__ void xcd_barrier_complete(unsigned* bar, unsigned x, unsigned& nloc, unsigned& nx) {
    const unsigned G = gridDim.x * gridDim.y * gridDim.z;
    unsigned sum, cnt, mine, sp = 0u;
    for (;;) {
        sum = 0u; cnt = 0u; mine = 0u;
#pragma unroll
        for (unsigned j = 0; j < 16; ++j) { const unsigned c = xb_ld(&bar[XB_XCNT(j)]); sum += c; cnt += (c > 0u) ? 1u : 0u; mine = (j == x) ? c : mine; }
        if (sum == G) break;
        __builtin_amdgcn_s_sleep(1);
        if ((++sp & 255u) == 0u) { if (xb_ld(&bar[XB_TMO])) break; if (sp > XB_SPIN_CAP) { atomicAdd(&bar[XB_TMO], 1u); break; } }
    }
    nloc = mine > 0u ? mine : 1u; nx = cnt > 0u ? cnt : 1u;
}
__device__ __forceinline__ void xcd_barrier(const XcdBarrier& b) {
    asm volatile("s_waitcnt vmcnt(0)" ::: "memory");
    __syncthreads();
    if (threadIdx.x == 0) {
        unsigned* bar = b.bar;
        __builtin_amdgcn_s_waitcnt(0);
        unsigned nloc = b.st[0], nx = b.st[1];
        if (nloc == 0u) { xcd_barrier_complete(bar, b.x, nloc, nx); b.st[0] = nloc; b.st[1] = nx; }
        const unsigned old = xb_add(&bar[XB_XSUB(b.x)], 1u);
        const unsigned gen = old / nloc;
        if (old + 1u == (gen + 1u) * nloc) {
            __builtin_amdgcn_fence(__ATOMIC_RELEASE, "agent");
            asm volatile("s_waitcnt vmcnt(0)" ::: "memory");
            const unsigned og = xb_add(&bar[XB_TOP], 1u);
            const unsigned tg = og / nx;
            if (og + 1u == (tg + 1u) * nx) xb_add(&bar[XB_TOPGEN], 1u);
            else XB_SPIN(xb_ld(&bar[XB_TOPGEN]) == tg, bar);
            __builtin_amdgcn_fence(__ATOMIC_ACQUIRE, "agent");
            xb_add(&bar[XB_XGEN(b.x)], 1u);
            asm volatile("s_waitcnt vmcnt(0)" ::: "memory");
        } else {
            XB_SPIN(xb_ld(&bar[XB_XGEN(b.x)]) == gen, bar);
            __builtin_amdgcn_fence(__ATOMIC_ACQUIRE, "agent");
            asm volatile("s_waitcnt vmcnt(0)" ::: "memory");
        }
    }
    __syncthreads();
}

namespace pg8 {
constexpr int BM = 256, BK = 64, HALF = 128, HTB = HALF * BK * 2, STAGE_BYTES = 8 * HTB, NXCD = 8, WGM = 8;
__host__ __device__ __forceinline__ int lds_byte(int r, int c) { const int st = (r >> 4) * 2 + (c >> 5), rr = r & 15, cc = c & 31, ob = rr * 64 + cc * 2; return st * 1024 + (ob ^ (((ob >> 9) & 1) << 5)); }
__host__ __device__ __forceinline__ void stage_rc(int b, int& R, int& C) { const int st = b / 1024, sb = b % 1024, swz = sb ^ (((sb >> 9) & 1) << 5); R = (st >> 1) * 16 + swz / 64; C = (st & 1) * 32 + (swz % 64) / 2; }
__host__ __device__ __forceinline__ int perm32(int rho) { const int n = rho >> 4, i = rho & 15; return 8 * (i >> 2) + 4 * n + (i & 3); }
struct Unit { int pm, pn, sub; };
__device__ __forceinline__ unsigned cvt_pk_bf16(float lo, float hi) { unsigned r; asm volatile("v_cvt_pk_bf16_f32 %0, %1, %2" : "=v"(r) : "v"(lo), "v"(hi)); return r; }
__device__ __forceinline__ f32x2 gelu_pk(f32x2 v) {
    const f32x2 av = __builtin_elementwise_abs(v), d = av * 0.2316418882f + 1.0f;
    f32x2 t; t.x = __builtin_amdgcn_rcpf(d.x); t.y = __builtin_amdgcn_rcpf(d.y);
    f32x2 q = t * 0.5307027145f + (-0.7265760135f); q = q * t + 0.7107068705f; q = q * t + (-0.142248368f); q = q * t + 0.127414796f; q = q * t;
    const f32x2 s = (v * v) * (-0.72134752044f);
    f32x2 e; e.x = __builtin_amdgcn_exp2f(s.x); e.y = __builtin_amdgcn_exp2f(s.y);
    const f32x2 m = v * (q * e), r = v - m;
    f32x2 o; o.x = v.x < 0.f ? m.x : r.x; o.y = v.y < 0.f ? m.y : r.y; return o;
}
template <int NSUB = 1> struct StaticOrder {
    int nM, nN, nwg, G, c;
    __device__ void init(int nM_, int nN_, int G_, int c_) { nM = nM_; nN = nN_; nwg = nM * nN; G = G_; c = c_; }
    __device__ bool next(int i, Unit& u) const {
        const int it = i / NSUB; u.sub = i - it * NSUB;
        const long L = (long)it * G + c; if (L >= nwg) return false;
        int wgid = (int)L; { const int q = nwg / NXCD, r = nwg % NXCD, xcd = wgid % NXCD, off = wgid / NXCD; wgid = (xcd < r ? xcd * (q + 1) : r * (q + 1) + (xcd - r) * q) + off; }
        const int nig = WGM * nN, gid = wgid / nig, fm = gid * WGM, gsz = (nM - fm) < WGM ? (nM - fm) : WGM;
        u.pm = fm + ((wgid % nig) % gsz); u.pn = (wgid % nig) / gsz; return true;
    }
};
constexpr int SIDE_TOK = 131072 + 2048;
constexpr int SIDE_SLOT = 131072 + 10240, SIDE_SLOT_BYTES = 3072;
__device__ __forceinline__ void dma16(unsigned voff, const void* sbase, unsigned ldsaddr) { asm volatile("s_mov_b32 m0, %2\n\tglobal_load_lds_dwordx4 %0, %1" :: "v"(voff), "s"(sbase), "s"(ldsaddr) : "memory", "m0"); }
__device__ __forceinline__ void dma4(unsigned voff, const void* sbase, unsigned ldsaddr) { asm volatile("s_mov_b32 m0, %2\n\tglobal_load_lds_dword %0, %1" :: "v"(voff), "s"(sbase), "s"(ldsaddr) : "memory", "m0"); }
template <class Prob, class Sched, class Epi>
__device__ __forceinline__ void gemm_phase(LAS unsigned char* lds, const int tid, const Prob& P, const Sched& S, const Epi& E) {
    const int wid = __builtin_amdgcn_readfirstlane(tid >> 6), lane = tid & 63, wr = wid >> 2, wc = wid & 3, fr = lane & 15, fq = lane >> 4;
    const int lda = P.lda, ldb = P.ldb;
    unsigned voffB[2], offA[2][2];
#define PG8_TOKSLOT(name) const LAS int* name; { PG8_TID(tl2_); name = (const LAS int*)(lds + SIDE_TOK) + (tl2_ >> 6) * 256 + (tl2_ & 63); }
#define PG8_TID(v_) int v_; asm volatile("v_mbcnt_lo_u32_b32 %0, -1, 0\n\tv_mbcnt_hi_u32_b32 %0, -1, %0" : "=v"(v_)); v_ |= (wid << 6)
#define PG8_RC(R_, C_) int R_[2], C_[2]; { PG8_TID(tl_); _Pragma("unroll") for (int i_ = 0; i_ < 2; ++i_) stage_rc(tl_ * 16 + i_ * 8192, R_[i_], C_[i_]); }
#pragma unroll
    for (int i = 0; i < 2; ++i) { int R, C; stage_rc(tid * 16 + i * 8192, R, C); const int Rb = Epi::PERM ? ((R & ~31) + perm32(R & 31)) : R;
        voffB[i] = (unsigned)(Rb * ldb + C) * 2u;
        offA[0][i] = (unsigned)(R * lda + C) * 2u; offA[1][i] = (unsigned)((R + HALF) * lda + C) * 2u; }
    const size_t kstep = (size_t)(BK * 2);
    const size_t hstep = (size_t)HALF * ldb * 2;
    const unsigned ldsw = (unsigned)wid * 1024u;
    const int aoff = lds_byte(wr * 64 + fr, fq * 8), boff = lds_byte(wc * 32 + fr, fq * 8);
#define PG8_SA(b, h) (((b) * 2 + (h)) * HTB)
#define PG8_SB(b, h) ((4 + (b) * 2 + (h)) * HTB)
    const unsigned ldsb = (unsigned)(size_t)lds;
#define PG8_STAGE(bufoff, gbase, voff) do { _Pragma("unroll") for (int _i = 0; _i < 2; ++_i) \
        asm volatile("s_mov_b32 m0, %2\n\tglobal_load_lds_dwordx4 %0, %1" :: "v"((voff)[_i]), "s"((const char*)(gbase)), "s"(ldsb + (unsigned)(bufoff) + ldsw + (unsigned)(_i * 8192)) : "memory", "m0"); } while (0)
#define PG8_CAT(x0, x1) __builtin_shufflevector(x0, x1, 0, 1, 2, 3, 4, 5, 6, 7)
#define PG8_LDA(dst, b, h) do { if constexpr (Prob::FP8) { _Pragma("unroll") for (int m = 0; m < 4; ++m) dst##8[m] = PG8_CAT(*(const LAS i32x4*)(lds + PG8_SA(b, h) + aoff + m * 2048), *(const LAS i32x4*)(lds + PG8_SA(b, h) + aoff + m * 2048 + 1024)); } \
        else { _Pragma("unroll") for (int m = 0; m < 4; ++m) _Pragma("unroll") for (int k = 0; k < 2; ++k) dst[m][k] = *(const LAS bf16x8*)(lds + PG8_SA(b, h) + aoff + m * 2048 + k * 1024); } } while (0)
#define PG8_LDB(dst, b, h) do { if constexpr (Prob::FP8) { _Pragma("unroll") for (int n = 0; n < 2; ++n) dst##8[n] = PG8_CAT(*(const LAS i32x4*)(lds + PG8_SB(b, h) + boff + n * 2048), *(const LAS i32x4*)(lds + PG8_SB(b, h) + boff + n * 2048 + 1024)); } \
        else { _Pragma("unroll") for (int n = 0; n < 2; ++n) _Pragma("unroll") for (int k = 0; k < 2; ++k) dst[n][k] = *(const LAS bf16x8*)(lds + PG8_SB(b, h) + boff + n * 2048 + k * 1024); } } while (0)
#define PG8_MMA(ai, bj, At, Bt) do { __builtin_amdgcn_s_setprio(1); \
        if constexpr (Prob::FP8) { _Pragma("unroll") for (int m = 0; m < 4; ++m) _Pragma("unroll") for (int n = 0; n < 2; ++n) \
            acc[ai][bj][m][n] = __builtin_amdgcn_mfma_scale_f32_16x16x128_f8f6f4(Bt##8[n], At##8[m], acc[ai][bj][m][n], 0, 0, 0, sc8_, 0, sc8_); } \
        else { _Pragma("unroll") for (int m = 0; m < 4; ++m) _Pragma("unroll") for (int n = 0; n < 2; ++n) _Pragma("unroll") for (int k = 0; k < 2; ++k) \
            acc[ai][bj][m][n] = __builtin_amdgcn_mfma_f32_16x16x32_bf16(Bt[n][k], At[m][k], acc[ai][bj][m][n], 0, 0, 0); } \
        __builtin_amdgcn_s_setprio(0); } while (0)
#define PG8_WAIT_V(n) asm volatile("s_waitcnt vmcnt(" #n ")" ::: "memory")
#define PG8_WAIT_L(n) asm volatile("s_waitcnt lgkmcnt(" #n ")" ::: "memory")
#define PG8_BAR __builtin_amdgcn_s_barrier()
#define PG8_SCHED __builtin_amdgcn_sched_barrier(0)
    Unit cur, nxt; int ui = 0;
    if (!S.next(0, cur)) return;
    static_assert(Prob::SCALE_A == Prob::SCALE_B, "one scale register serves both operands");
    int sc8_; asm volatile("v_mov_b32 %0, %1" : "=v"(sc8_) : "n"(Prob::SCALE_A));
    f32x4 acc[2][2][4][2];
    float zero_; asm volatile("v_mov_b32 %0, 0" : "=v"(zero_));
#pragma unroll
    for (int a = 0; a < 2; ++a)
#pragma unroll
        for (int b = 0; b < 2; ++b)
#pragma unroll
            for (int m = 0; m < 4; ++m)
#pragma unroll
                for (int n = 0; n < 2; ++n) acc[a][b][m][n] = (f32x4){zero_, zero_, zero_, zero_};
    bf16x8 At[4][2], B0[2][2], B1[2][2]; i32x8 At8[4], B08[2], B18[2];
    const char* cA = P.a_base(cur); const char* cB = P.b_base(cur); int nt = P.nt(cur);
    if constexpr (Prob::GATHER) { PG8_RC(Rr, Cc); P.a_rows(cur, Rr, Cc, offA); }
    if constexpr (Epi::SIDE) { PG8_TID(tl4_); E.side(cur, ldsb + SIDE_SLOT, wid, tl4_ & 63); }
    PG8_STAGE(PG8_SB(0, 0), cB, voffB); PG8_STAGE(PG8_SB(0, 1), cB + hstep, voffB); PG8_STAGE(PG8_SA(0, 0), cA, offA[0]); PG8_STAGE(PG8_SA(0, 1), cA, offA[1]);
    if (wr == 1) PG8_BAR;
    PG8_WAIT_V(2); PG8_BAR;
    PG8_STAGE(PG8_SB(1, 0), cB + kstep, voffB); PG8_STAGE(PG8_SA(1, 0), cA + kstep, offA[0]); PG8_STAGE(PG8_SB(1, 1), cB + hstep + kstep, voffB);
    PG8_WAIT_V(6); PG8_BAR;
    for (;;) {
        const bool has_next = S.next(ui + 1, nxt);
        const char* nA = has_next ? P.a_base(nxt) : cA; const char* nB = has_next ? P.b_base(nxt) : cB;
        if constexpr (Prob::GATHER) { if (has_next) { PG8_RC(Rr, Cc); (void)Cc;
#pragma unroll
            for (int h = 0; h < 2; ++h)
#pragma unroll
                for (int i = 0; i < 2; ++i) dma4((unsigned)(nxt.pm * 256 + h * 128 + Rr[i]) * 4u, P.tok, ldsb + SIDE_TOK + (unsigned)wid * 1024u + (unsigned)((h * 2 + i) * 256)); } }
        if constexpr (Epi::SIDE) { if (has_next) { PG8_TID(tl4_); E.side(nxt, ldsb + SIDE_SLOT + (unsigned)(((ui + 1) % 3) * SIDE_SLOT_BYTES), wid, tl4_ & 63); } }
        for (int t = 0; t < nt; t += 2) {
            const bool last = (t == nt - 2);
            if constexpr (Epi::KHOOK) { if (t == Epi::HOOK_T0 || t == Epi::HOOK_T1) {
                asm volatile("" ::: "memory"); PG8_TID(tlh_); const int lnh_ = tlh_ & 63; E.hook(acc, cur, t == Epi::HOOK_T0 ? 0 : 1, wr, wc, lnh_ & 15, lnh_ >> 4); asm volatile("" ::: "memory"); } }
            const char* a1 = cA + (size_t)(t + 1) * kstep;
            const char* a2 = last ? nA : cA + (size_t)(t + 2) * kstep; const char* b2 = last ? nB : cB + (size_t)(t + 2) * kstep;
            const char* a3 = a2 + kstep; const char* b3 = b2 + kstep;
            PG8_LDB(B0, 0, 0); PG8_LDB(B1, 0, 1); PG8_SCHED; PG8_LDA(At, 0, 0); PG8_STAGE(PG8_SA(1, 1), a1, offA[1]);
            PG8_WAIT_V(8); PG8_WAIT_L(0); PG8_BAR; PG8_MMA(0, 0, At, B0); PG8_MMA(0, 1, At, B1); PG8_BAR; PG8_SCHED;
            if constexpr (Prob::GATHER) { if (last && has_next) { PG8_RC(Rr, Cc); (void)Rr; PG8_TOKSLOT(tokslot); const int ntok[2][2] = {{tokslot[0], tokslot[64]}, {tokslot[128], tokslot[192]}}; P.a_off(ntok, Cc, offA); } }
            PG8_LDA(At, 0, 1); PG8_STAGE(PG8_SB(0, 0), b2, voffB); PG8_STAGE(PG8_SB(0, 1), b2 + hstep, voffB); PG8_STAGE(PG8_SA(0, 0), a2, offA[0]);
            PG8_WAIT_V(8); PG8_WAIT_L(0); PG8_BAR; PG8_MMA(1, 0, At, B0); PG8_MMA(1, 1, At, B1); PG8_BAR; PG8_SCHED;
            PG8_LDB(B0, 1, 0); PG8_LDB(B1, 1, 1); PG8_SCHED; PG8_LDA(At, 1, 0); PG8_STAGE(PG8_SA(0, 1), a2, offA[1]);
            PG8_WAIT_V(8); PG8_WAIT_L(0); PG8_BAR; PG8_MMA(0, 0, At, B0); PG8_MMA(0, 1, At, B1); PG8_BAR; PG8_SCHED;
            PG8_LDA(At, 1, 1); PG8_STAGE(PG8_SB(1, 0), b3, voffB); PG8_STAGE(PG8_SB(1, 1), b3 + hstep, voffB); PG8_STAGE(PG8_SA(1, 0), a3, offA[0]);
            PG8_WAIT_V(8); PG8_WAIT_L(0); PG8_BAR; PG8_MMA(1, 0, At, B0); PG8_MMA(1, 1, At, B1); PG8_BAR; PG8_SCHED;
        }
        if (wr == 0) PG8_BAR;
        { PG8_TID(tl3_); const int ln_ = tl3_ & 63; E(acc, cur, wr, wc, ln_ & 15, ln_ >> 4, lds + SIDE_SLOT + (ui % 3) * SIDE_SLOT_BYTES); }
        if (!has_next) break;
        bool keep = false;
        if constexpr (Epi::CHAIN) keep = E.keep(cur);
        if (!keep) {
            asm volatile("v_mov_b32 %0, 0" : "=v"(zero_));
#pragma unroll
            for (int a = 0; a < 2; ++a)
#pragma unroll
                for (int b = 0; b < 2; ++b)
#pragma unroll
                    for (int m = 0; m < 4; ++m)
#pragma unroll
                        for (int n = 0; n < 2; ++n) acc[a][b][m][n] = (f32x4){zero_, zero_, zero_, zero_};
        }
        cur = nxt; cA = nA; cB = nB; nt = P.nt(cur); ++ui;
        if (wr == 1) PG8_BAR;
    }
    PG8_WAIT_V(0);
    PG8_BAR;
#undef PG8_RC
#undef PG8_TID
#undef PG8_TOKSLOT
#undef PG8_SA
#undef PG8_SB
#undef PG8_STAGE
#undef PG8_LDA
#undef PG8_LDB
#undef PG8_MMA
#undef PG8_CAT
#undef PG8_WAIT_V
#undef PG8_WAIT_L
#undef PG8_BAR
#undef PG8_SCHED
}
}

typedef const float* cfp_t;
typedef const cfp_t __attribute__((address_space(4))) * InTab;
struct Frame {
    LAS unsigned char* lds;
    volatile LAS unsigned* MISC;
    unsigned char* ws;
    InTab in;
    float* out;
    int tid, lane, wave, G, bid;
};
enum { IN_X = 0, IN_C, IN_CTX, IN_CCTX, IN_WADA, IN_BADA, IN_WIN, IN_BIN, IN_POOLW, IN_POOLS, IN_CONVW, IN_CONVB, IN_MNG, IN_SLNG, IN_SLNB, IN_SGUW, IN_SGUB,
       IN_WBP, IN_WBM, IN_WBS, IN_WOUT, IN_LN1G, IN_LN1B, IN_WR, IN_BR, IN_WGU, IN_BGU, IN_WDN, IN_BDN, IN_LN2G, IN_LN2B };
__device__ __forceinline__ int mod_row(int row) { return row < ML ? (row >> 12) : NB; }
__device__ __forceinline__ const float* modp(const Frame& F, int l, int row, int part) { return (const float*)(F.ws + WS_MOD) + ((size_t)(l * 17 + mod_row(row)) * 6 + part) * 1024; }

__device__ __forceinline__ void transpose_item(const float* W, size_t ldw, int k0, int srccol0, bf16_t* dst, size_t ldk, int kd0, LAS float* scr, int lane) {
#pragma unroll 8
    for (int i = 0; i < 32; ++i) { const int kk = 2 * i + (lane >> 5); scr[kk * 33 + (lane & 31)] = __builtin_nontemporal_load(W + (size_t)(k0 + kk) * ldw + srccol0 + (lane & 31)); }
    LDS_WAIT(); asm volatile("" ::: "memory");
    const int c = lane & 7;
#pragma unroll
    for (int j = 0; j < 4; ++j) { const int n = (lane >> 3) + 8 * j; const LAS float* s = scr + (8 * c) * 33 + n;
        u32x4 o; o.x = pk2(s[0 * 33], s[1 * 33]); o.y = pk2(s[2 * 33], s[3 * 33]); o.z = pk2(s[4 * 33], s[5 * 33]); o.w = pk2(s[6 * 33], s[7 * 33]);
        *(u32x4*)(dst + (size_t)n * ldk + kd0 + 8 * c) = o; }
    LDS_WAIT(); asm volatile("" ::: "memory");
}
__device__ __forceinline__ void transpose_item_fp8(const float* W, size_t ldw, int k0, int srccol0, unsigned char* dst, size_t ldk, int kd0, float sc, LAS float* scr, int lane) {
#pragma unroll 8
    for (int i = 0; i < 32; ++i) { const int kk = 2 * i + (lane >> 5); scr[kk * 33 + (lane & 31)] = __builtin_nontemporal_load(W + (size_t)(k0 + kk) * ldw + srccol0 + (lane & 31)); }
    LDS_WAIT(); asm volatile("" ::: "memory");
    const int c = lane & 7;
#pragma unroll
    for (int j = 0; j < 4; ++j) { const int n = (lane >> 3) + 8 * j; const LAS float* s_ = scr + (8 * c) * 33 + n;
        u32x2 o; o.x = pk4_fp8(s_[0 * 33] * sc, s_[1 * 33] * sc, s_[2 * 33] * sc, s_[3 * 33] * sc); o.y = pk4_fp8(s_[4 * 33] * sc, s_[5 * 33] * sc, s_[6 * 33] * sc, s_[7 * 33] * sc);
        *(u32x2*)(dst + (size_t)n * ldk + kd0 + 8 * c) = o; }
    LDS_WAIT(); asm volatile("" ::: "memory");
}
__device__ __forceinline__ void phase_prologue(Frame& F) {
    LAS float* scr = (LAS float*)(F.lds + F.wave * 16384);
    const int gw = F.bid * NWAVES + F.wave, NGW = F.G * NWAVES;
    constexpr int I_IN = 16 * (NZ / 32);
    constexpr int I_BR = (4 + 8 + 4) * 32;
    constexpr int I_OUT = 16 * 32;
    constexpr int I_GU = 16 * 64;
    constexpr int I_DN = 16 * 32;
    constexpr int T_IN = DEPTH * I_IN, T_BR = DEPTH * I_BR, T_OUT = DEPTH * I_OUT, T_GU = DEPTH * NEXP * I_GU, T_DN = DEPTH * NEXP * I_DN;
    constexpr int NITEMS = T_IN + T_BR + T_OUT + T_GU + T_DN;
    for (int it = gw; it < NITEMS; it += NGW) {
        int r = it;
        if (r < T_IN) { const int l = r / I_IN; r %= I_IN; const int kb = r / (NZ / 32), nb = r % (NZ / 32); const int n0 = nb * 32, src = n0 < 2304 ? n0 : n0 + 16;
            if (n0 < NZ_BF) transpose_item(F.in[IN_WIN] + (size_t)l * D * 5904, 5904, kb * 64, src, (bf16_t*)(F.ws + WS_WIN) + ((size_t)l * NZ + n0) * D, D, kb * 64, scr, F.lane);
            else transpose_item_fp8(F.in[IN_WIN] + (size_t)l * D * 5904, 5904, kb * 64, src, (unsigned char*)(F.ws + WS_WIN8) + ((size_t)l * NZ_F8 + (n0 - NZ_BF)) * D, D, kb * 64, F8S_WGU, scr, F.lane);
            continue; }
        r -= T_IN;
        if (r < T_BR) { const int l = r / I_BR; r %= I_BR; const int kb = r / 32, nb = r % 32;
            const float* W; int ksrc;
            if (kb < 4) { W = F.in[IN_WBP] + (size_t)l * 256 * D; ksrc = kb * 64; } else if (kb < 12) { W = F.in[IN_WBM] + (size_t)l * 512 * D; ksrc = (kb - 4) * 64; } else { W = F.in[IN_WBS] + (size_t)l * 256 * D; ksrc = (kb - 12) * 64; }
            transpose_item(W, D, ksrc, nb * 32, (bf16_t*)(F.ws + WS_WBR) + ((size_t)l * D + nb * 32) * D, D, kb * 64, scr, F.lane); continue; }
        r -= T_BR;
        if (r < T_OUT) { const int l = r / I_OUT; r %= I_OUT; const int kb = r / 32, nb = r % 32;
            transpose_item(F.in[IN_WOUT] + (size_t)l * D * D, D, kb * 64, nb * 32, (bf16_t*)(F.ws + WS_WOUT) + ((size_t)l * D + nb * 32) * D, D, kb * 64, scr, F.lane); continue; }
        r -= T_OUT;
        if (r < T_GU) { const int le = r / I_GU; r %= I_GU; const int kb = r / 64, nb = r % 64; const int n0 = nb * 32;
            const int pn = n0 >> 8, c = n0 & 255; const int src = c < 128 ? (128 * pn + c) : (1024 + 128 * pn + c - 128);
            transpose_item_fp8(F.in[IN_WGU] + (size_t)le * D * 2048, 2048, kb * 64, src, (unsigned char*)(F.ws + WS_WGU) + ((size_t)le * 2048 + n0) * D, D, kb * 64, F8S_WGU, scr, F.lane); continue; }
        r -= T_GU;
        { const int le = r / I_DN; r %= I_DN; const int kb = r / 32, nb = r % 32;
            transpose_item_fp8(F.in[IN_WDN] + (size_t)le * D * D, D, kb * 64, nb * 32, (unsigned char*)(F.ws + WS_WDN) + ((size_t)le * D + nb * 32) * D, D, kb * 64, F8S_WDN, scr, F.lane); }
    }
    { const int gt = F.bid * NTHREADS + F.tid, NGT = F.G * NTHREADS;
      for (int i = gt; i < DEPTH * 16 * 1024; i += NGT) { const int l = i >> 14, g = (i >> 10) & 15, k = i & 1023; ((float*)(F.ws + WS_WG))[i] = F.in[IN_WIN][((size_t)l * D + k) * 5904 + 2304 + g]; }
      for (int i = gt; i < DEPTH * 4 * 128 * 128; i += NGT) ((bf16_t*)(F.ws + WS_WSGU))[i] = (bf16_t)f2bf(F.in[IN_SGUW][i]);
      for (int i = gt; i < DEPTH * 4 * 64 * 64; i += NGT) { const int lg = i >> 12, d = (i >> 6) & 63, c = i & 63; ((bf16_t*)(F.ws + WS_WPOOL))[i] = (bf16_t)f2bf(F.in[IN_POOLW][(size_t)lg * 4096 + c * 64 + d]); } }
    __syncthreads();
    { LAS float* sc = (LAS float*)F.lds;
      LAS float* part = (LAS float*)(F.lds + 71680);
      for (int i = F.tid; i < 17 * 1024; i += NTHREADS) { const int r = i >> 10, k = i & 1023; const float v = r < 16 ? F.in[IN_C][r * 1024 + k] : F.in[IN_CCTX][k]; sc[i] = siluf_(v); }
      __syncthreads();
      for (int u = F.bid; u < DEPTH * 48; u += F.G) {
          const int l = u / 48, n0 = (u % 48) * 128, col = F.tid & 127, ks = F.tid >> 7;
          float a[17];
#pragma unroll
          for (int r = 0; r < 17; ++r) a[r] = 0.f;
          const float* W = F.in[IN_WADA] + (size_t)l * D * 6144 + n0 + col;
          for (int k = ks * 256; k < ks * 256 + 256; ++k) { const float w = W[(size_t)k * 6144];
#pragma unroll
              for (int r = 0; r < 17; ++r) a[r] += sc[r * 1024 + k] * w; }
#pragma unroll
          for (int r = 0; r < 17; ++r) part[(ks * 17 + r) * 128 + col] = a[r];
          __syncthreads();
          for (int i = F.tid; i < 17 * 128; i += NTHREADS) { const int r = i >> 7, cc = i & 127;
              const float s = part[(0 * 17 + r) * 128 + cc] + part[(1 * 17 + r) * 128 + cc] + part[(2 * 17 + r) * 128 + cc] + part[(3 * 17 + r) * 128 + cc] + F.in[IN_BADA][l * 6144 + n0 + cc];
              ((float*)(F.ws + WS_MOD))[(size_t)(l * 17 + r) * 6144 + n0 + cc] = s; }
          __syncthreads();
      } }
}

struct RowV { f32x4 v[4]; };
#define RC(lane, j) (8 * (lane) + 512 * ((j) >> 1) + 4 * ((j) & 1))
__device__ __forceinline__ void row_load(RowV& r, const float* p, int lane) {
#pragma unroll
    for (int j = 0; j < 4; ++j) r.v[j] = __builtin_nontemporal_load((const f32x4*)(p + RC(lane, j)));
}
__device__ __forceinline__ void row_load_bf16(RowV& r, const bf16_t* p, int lane) {
#pragma unroll
    for (int h = 0; h < 2; ++h) { const u32x4 w = __builtin_nontemporal_load((const u32x4*)(p + 8 * lane + 512 * h)); r.v[2 * h] = (f32x4){bflo(w.x), bfhi(w.x), bflo(w.y), bfhi(w.y)}; r.v[2 * h + 1] = (f32x4){bflo(w.z), bfhi(w.z), bflo(w.w), bfhi(w.w)}; }
}
__device__ __forceinline__ void row_store(const RowV& r, float* p, int lane) {
#pragma unroll
    for (int j = 0; j < 4; ++j) *(f32x4*)(p + RC(lane, j)) = r.v[j];
}
__device__ __forceinline__ void row_store_nt(const RowV& r, float* p, int lane) {
#pragma unroll
    for (int j = 0; j < 4; ++j) __builtin_nontemporal_store(r.v[j], (f32x4*)(p + RC(lane, j)));
}
__device__ __forceinline__ void row_store_bf16_nt(const RowV& r, bf16_t* p, int lane) {
#pragma unroll
    for (int h = 0; h < 2; ++h) { u32x4 w; w.x = pk2(r.v[2 * h].x, r.v[2 * h].y); w.y = pk2(r.v[2 * h].z, r.v[2 * h].w); w.z = pk2(r.v[2 * h + 1].x, r.v[2 * h + 1].y); w.w = pk2(r.v[2 * h + 1].z, r.v[2 * h + 1].w); __builtin_nontemporal_store(w, (u32x4*)(p + 8 * lane + 512 * h)); }
}
__device__ __forceinline__ void row_store_bf16(const RowV& r, bf16_t* p, int lane) {
#pragma unroll
    for (int h = 0; h < 2; ++h) { u32x4 w; w.x = pk2(r.v[2 * h].x, r.v[2 * h].y); w.y = pk2(r.v[2 * h].z, r.v[2 * h].w); w.z = pk2(r.v[2 * h + 1].x, r.v[2 * h + 1].y); w.w = pk2(r.v[2 * h + 1].z, r.v[2 * h + 1].w); *(u32x4*)(p + 8 * lane + 512 * h) = w; }
}
__device__ __forceinline__ void row_ln_plain(RowV& r, int lane) {
    float s = 0.f;
#pragma unroll
    for (int j = 0; j < 4; ++j) s += (r.v[j].x + r.v[j].y) + (r.v[j].z + r.v[j].w);
    const float mean = wave_sum(s, lane) * (1.f / D); float s2 = 0.f;
#pragma unroll
    for (int j = 0; j < 4; ++j) { r.v[j] = r.v[j] - mean; s2 += (r.v[j].x * r.v[j].x + r.v[j].y * r.v[j].y) + (r.v[j].z * r.v[j].z + r.v[j].w * r.v[j].w); }
    const float rstd = 1.f / sqrtf(wave_sum(s2, lane) * (1.f / D) + LN_EPS);
#pragma unroll
    for (int j = 0; j < 4; ++j) r.v[j] = r.v[j] * rstd;
}
__device__ __forceinline__ void row_affine(RowV& r, const float* g, const float* b, int lane) {
#pragma unroll
    for (int j = 0; j < 4; ++j) { const f32x4 gg = *(const f32x4*)(g + RC(lane, j)), bb = *(const f32x4*)(b + RC(lane, j)); r.v[j] = r.v[j] * gg + bb; }
}
__device__ __forceinline__ void row_modulate(RowV& r, const float* sh, const float* sc, int lane) {
#pragma unroll
    for (int j = 0; j < 4; ++j) { const f32x4 s1 = *(const f32x4*)(sc + RC(lane, j)), s0 = *(const f32x4*)(sh + RC(lane, j)); r.v[j] = r.v[j] * (s1 + 1.0f) + s0; }
}
__device__ __forceinline__ LAS float* pv_slot(const Frame& F, int slot) { return (LAS float*)(F.lds + NW_PV) + slot * 1024; }
__device__ __forceinline__ void pv_fill(Frame& F, int slot, const float* src) { LAS f32x4* d = (LAS f32x4*)pv_slot(F, slot); for (int i = F.tid; i < 256; i += NTHREADS) d[i] = *(const f32x4*)(src + 4 * i); }
__device__ __forceinline__ void row_affine_l(RowV& r, const LAS float* g, const LAS float* b, int lane) {
#pragma unroll
    for (int j = 0; j < 4; ++j) { const f32x4 gg = *(const LAS f32x4*)(g + RC(lane, j)), bb = *(const LAS f32x4*)(b + RC(lane, j)); r.v[j] = r.v[j] * gg + bb; }
}
__device__ __forceinline__ void row_modulate_l(RowV& r, const LAS float* sh, const LAS float* sc, int lane) {
#pragma unroll
    for (int j = 0; j < 4; ++j) { const f32x4 s1 = *(const LAS f32x4*)(sc + RC(lane, j)), s0 = *(const LAS f32x4*)(sh + RC(lane, j)); r.v[j] = r.v[j] * (s1 + 1.0f) + s0; }
}
__device__ __forceinline__ void ln0_row(Frame& F, int row, RowV xr, const LAS float* sh, const LAS float* sc) {
    row_ln_plain(xr, F.lane);
    row_modulate_l(xr, sh, sc, F.lane);
    row_store_bf16(xr, (bf16_t*)(F.ws + WS_H) + (size_t)row * D, F.lane);
    { unsigned char* h8 = (unsigned char*)(F.ws + WS_H8) + (size_t)row * D + 8 * F.lane;
#pragma unroll
      for (int h = 0; h < 2; ++h) { u32x2 w; w.x = pk4_fp8(xr.v[2 * h].x * F8S_ACT, xr.v[2 * h].y * F8S_ACT, xr.v[2 * h].z * F8S_ACT, xr.v[2 * h].w * F8S_ACT); w.y = pk4_fp8(xr.v[2 * h + 1].x * F8S_ACT, xr.v[2 * h + 1].y * F8S_ACT, xr.v[2 * h + 1].z * F8S_ACT, xr.v[2 * h + 1].w * F8S_ACT); *(u32x2*)(h8 + 512 * h) = w; } }
}
__device__ __forceinline__ LAS float* narrow_tile_wave(Frame& F, const bf16_t* A) {
    const int r = F.lane & 31, h = F.lane >> 5;
    f32x16 acc;
#pragma unroll
    for (int i = 0; i < 16; ++i) acc[i] = 0.f;
    const bf16_t* ap = A + (size_t)r * D + 8 * h;
    const LAS unsigned char* bp = F.lds + NW_WT + r * 2064 + 16 * h;
    bf16x8 av[2][16];
#pragma unroll
    for (int ks = 0; ks < 16; ++ks) av[0][ks] = *(const bf16x8*)(ap + ks * 16);
#pragma unroll
    for (int kb = 0; kb < 4; ++kb) {
        if (kb < 3) {
#pragma unroll
            for (int ks = 0; ks < 16; ++ks) av[(kb + 1) & 1][ks] = *(const bf16x8*)(ap + ((kb + 1) * 16 + ks) * 16); }
        __builtin_amdgcn_sched_barrier(0);
#pragma unroll
        for (int ks = 0; ks < 16; ++ks) { const bf16x8 b = *(const LAS bf16x8*)(bp + (kb * 16 + ks) * 32); acc = __builtin_amdgcn_mfma_f32_32x32x16_bf16(av[kb & 1][ks], b, acc, 0, 0, 0); }
        __builtin_amdgcn_sched_barrier(0);
    }
    LAS float* lg = (LAS float*)(F.lds + NW_LG) + F.wave * 1056;
#pragma unroll
    for (int i = 0; i < 16; ++i) lg[((i & 3) + 8 * (i >> 2) + 4 * h) * 33 + r] = acc[i];
    asm volatile("s_waitcnt lgkmcnt(0)" ::: "memory");
    return lg;
}
__device__ __forceinline__ void tile_range(const Frame& F, int mrows, int& t_lo, int& t_hi) { const int nt = mrows / 32; t_lo = (int)(((long)F.bid * nt) / F.G); t_hi = (int)(((long)(F.bid + 1) * nt) / F.G); }
__device__ __forceinline__ void load_wg_lds(Frame& F, int l) {
    const float* src = (const float*)(F.ws + WS_WG) + (size_t)l * 16384;
    for (int i = F.tid; i < 32 * 128; i += NTHREADS) { const int g = i >> 7, c8 = i & 127; u32x4 w = (u32x4){0u, 0u, 0u, 0u};
        if (g < 16) { const f32x4 a = *(const f32x4*)(src + g * 1024 + c8 * 8), b = *(const f32x4*)(src + g * 1024 + c8 * 8 + 4); w.x = pk2(a.x, a.y); w.y = pk2(a.z, a.w); w.z = pk2(b.x, b.y); w.w = pk2(b.z, b.w); }
        *(LAS u32x4*)(F.lds + NW_WT + g * 2064 + c8 * 16) = w; }
    __syncthreads();
}
__device__ __forceinline__ void gates_tail(Frame& F, int l, int t_lo, int t_hi) {
    asm volatile("s_waitcnt vmcnt(0)" ::: "memory"); __syncthreads();
    const int g = F.lane & 15; const float bias = F.in[IN_BIN][l * 5904 + 2304 + g];
    for (int tile = t_lo + F.wave; tile < t_hi; tile += NWAVES) {
        const LAS float* lg = narrow_tile_wave(F, (const bf16_t*)(F.ws + WS_H) + (size_t)tile * 32 * D);
#pragma unroll
        for (int rr = 0; rr < 8; ++rr) { const int row = rr * 4 + (F.lane >> 4); ((float*)(F.ws + WS_ZG))[(size_t)(tile * 32 + row) * 16 + g] = lg[row * 33 + g] + bias; }
        asm volatile("s_waitcnt lgkmcnt(0)" ::: "memory");
    }
}

using pg8::Unit;
struct ProbPlain {
    static constexpr bool GATHER = false, FP8 = false; static constexpr int SCALE_A = 127, SCALE_B = 127; const bf16_t* A; const bf16_t* Bt; int lda, ldb;
    __device__ __forceinline__ int nt(const Unit&) const { return lda / 64; }
    __device__ __forceinline__ const char* a_base(const Unit& u) const { return (const char*)A + (size_t)u.pm * 256 * lda * 2; }
    __device__ __forceinline__ const char* b_base(const Unit& u) const { return (const char*)Bt + (size_t)u.pn * 256 * ldb * 2; }
    __device__ __forceinline__ void a_tok(const Unit&, const int (&)[2], int (&)[2][2]) const {}
    __device__ __forceinline__ void a_off(const int (&)[2][2], const int (&)[2], unsigned (&)[2][2]) const {}
    __device__ __forceinline__ void a_rows(const Unit&, const int (&)[2], const int (&)[2], unsigned (&)[2][2]) const {}
};
struct ProbPlainF8 {
    static constexpr bool GATHER = false, FP8 = true; static constexpr int SCALE_A = F8E_ACT, SCALE_B = F8E_WGU; const bf16_t* A; const bf16_t* Bt; int lda, ldb;
    __device__ __forceinline__ int nt(const Unit&) const { return lda / 64; }
    __device__ __forceinline__ const char* a_base(const Unit& u) const { return (const char*)A + (size_t)u.pm * 256 * lda * 2; }
    __device__ __forceinline__ const char* b_base(const Unit& u) const { return (const char*)Bt + (size_t)u.pn * 256 * ldb * 2; }
    __device__ __forceinline__ void a_tok(const Unit&, const int (&)[2], int (&)[2][2]) const {}
    __device__ __forceinline__ void a_off(const int (&)[2][2], const int (&)[2], unsigned (&)[2][2]) const {}
    __device__ __forceinline__ void a_rows(const Unit&, const int (&)[2], const int (&)[2], unsigned (&)[2][2]) const {}
};
struct ProbBranch {
    static constexpr bool GATHER = false, FP8 = false; static constexpr int SCALE_A = 127, SCALE_B = 127; const bf16_t* A; const bf16_t* Bt; int lda, ldb;
    __device__ __forceinline__ int nt(const Unit& u) const { return u.sub == 1 ? 8 : 4; }
    __device__ __forceinline__ int koff(const Unit& u) const { return u.sub == 0 ? 0 : (u.sub == 1 ? 256 : 768); }
    __device__ __forceinline__ const char* a_base(const Unit& u) const { return (const char*)A + ((size_t)u.pm * 256 * lda + koff(u)) * 2; }
    __device__ __forceinline__ const char* b_base(const Unit& u) const { return (const char*)Bt + ((size_t)u.pn * 256 * ldb + koff(u)) * 2; }
    __device__ __forceinline__ void a_tok(const Unit&, const int (&)[2], int (&)[2][2]) const {}
    __device__ __forceinline__ void a_off(const int (&)[2][2], const int (&)[2], unsigned (&)[2][2]) const {}
    __device__ __forceinline__ void a_rows(const Unit&, const int (&)[2], const int (&)[2], unsigned (&)[2][2]) const {}
};
__device__ __forceinline__ int expert_of(const LAS int* seg, int pm) { return __builtin_amdgcn_readfirstlane((int)((const LAS unsigned char*)(seg + 64))[pm]); }
__device__ __forceinline__ int moe_tables(Frame& F, LAS int* seg) {
    __syncthreads();
    if (F.tid <= NEXP) seg[F.tid] = ((const int*)(F.ws + WS_ROUTE + RT_SEG))[F.tid];
    __syncthreads();
    const int ntile = seg[NEXP] / 256;
    LAS unsigned char* texp = (LAS unsigned char*)(seg + 64);
    for (int t = F.tid; t < ntile; t += NTHREADS) { const int row = t * 256; int e = 0;
#pragma unroll
        for (int i = 1; i < NEXP; ++i) e += (seg[i] <= row) ? 1 : 0;
        texp[t] = (unsigned char)e; }
    __syncthreads();
    return ntile;
}
struct ProbMoe1 {
    static constexpr bool GATHER = true, FP8 = true; static constexpr int SCALE_A = F8E_ACT, SCALE_B = F8E_WGU; const bf16_t* A; const bf16_t* Bt; int lda, ldb; const int* tok; const LAS int* seg;
    __device__ __forceinline__ int nt(const Unit&) const { return lda / 64; }
    __device__ __forceinline__ const char* a_base(const Unit&) const { return (const char*)A; }
    __device__ __forceinline__ const char* b_base(const Unit& u) const { const int e = expert_of(seg, u.pm); return (const char*)Bt + ((size_t)e * 2048 + (size_t)u.pn * 256) * ldb * 2; }
    __device__ __forceinline__ void a_rows(const Unit& u, const int (&R)[2], const int (&C)[2], unsigned (&off)[2][2]) const {
#pragma unroll
        for (int h = 0; h < 2; ++h)
#pragma unroll
            for (int i = 0; i < 2; ++i) { const int t = tok[u.pm * 256 + h * 128 + R[i]]; off[h][i] = (unsigned)(t * lda + C[i]) * 2u; } }
    __device__ __forceinline__ void a_tok(const Unit& u, const int (&R)[2], int (&tk)[2][2]) const {
#pragma unroll
        for (int h = 0; h < 2; ++h)
#pragma unroll
            for (int i = 0; i < 2; ++i) tk[h][i] = tok[u.pm * 256 + h * 128 + R[i]]; }
    __device__ __forceinline__ void a_off(const int (&tk)[2][2], const int (&C)[2], unsigned (&off)[2][2]) const {
#pragma unroll
        for (int h = 0; h < 2; ++h)
#pragma unroll
            for (int i = 0; i < 2; ++i) off[h][i] = (unsigned)(tk[h][i] * lda + C[i]) * 2u; }
};
struct ProbMoe2 {
    static constexpr bool GATHER = false, FP8 = true; static constexpr int SCALE_A = F8E_ACT, SCALE_B = F8E_WDN; const bf16_t* A; const bf16_t* Bt; int lda, ldb; const LAS int* seg;
    __device__ __forceinline__ int nt(const Unit&) const { return lda / 64; }
    __device__ __forceinline__ const char* a_base(const Unit& u) const { return (const char*)A + (size_t)u.pm * 256 * lda * 2; }
    __device__ __forceinline__ const char* b_base(const Unit& u) const { const int e = expert_of(seg, u.pm); return (const char*)Bt + ((size_t)e * 1024 + (size_t)u.pn * 256) * ldb * 2; }
    __device__ __forceinline__ void a_tok(const Unit&, const int (&)[2], int (&)[2][2]) const {}
    __device__ __forceinline__ void a_off(const int (&)[2][2], const int (&)[2], unsigned (&)[2][2]) const {}
    __device__ __forceinline__ void a_rows(const Unit&, const int (&)[2], const int (&)[2], unsigned (&)[2][2]) const {}
};
using pg8::cvt_pk_bf16;
template <bool G8> struct EpiInproj {
    static constexpr bool PERM = true, CHAIN = false, SIDE = true, KHOOK = false; bf16_t* Z; const float* bias; int pn0;
    __device__ __forceinline__ void side(const Unit& u0, unsigned slot, int wid, int lane) const { const int pn = u0.pn + pn0; if (wid == 1) pg8::dma16((unsigned)lane * 16u, bias + pn * 256 + (pn >= 9 ? 16 : 0), slot); }
    __device__ __forceinline__ void operator()(const f32x4 (&acc)[2][2][4][2], const Unit& u0, int wr, int wc, int fr, int fq, const LAS unsigned char* sd) const {
        Unit u = u0; u.pn += pn0;
        int row0 = u.pm * 256 + wr * 64 + fr, col0 = u.pn * 256 + wc * 32 + 8 * fq; asm volatile("" : "+v"(row0), "+v"(col0));
        const int act = G8 ? ((u.pn == 9 || u.pn == 10) ? 2 : 1) : 0;
        f32x4 bv[2][2];
#pragma unroll
        for (int bj = 0; bj < 2; ++bj)
#pragma unroll
            for (int n = 0; n < 2; ++n) bv[bj][n] = *(const LAS f32x4*)(sd + (bj * 128 + wc * 32 + 8 * fq + 4 * n) * 4);
#pragma unroll
        for (int ai = 0; ai < 2; ++ai)
#pragma unroll
            for (int m = 0; m < 4; ++m) { bf16_t* rowp = Z + (size_t)(row0 + ai * 128 + m * 16) * NZ + col0;
#pragma unroll
                for (int bj = 0; bj < 2; ++bj) { f32x4 v0 = acc[ai][bj][m][0] + bv[bj][0], v1 = acc[ai][bj][m][1] + bv[bj][1];
                    if (G8 && u.pn >= ZG_COL / 256) { u32x2 w8;
#pragma unroll
                        for (int j = 0; j < 4; ++j) v0[j] = fmaxf(sigmoidf_(v0[j]) * G8_SCALE, 1.0f) + 12582912.0f;
                        w8.x = pk4_u8(v0[0], v0[1], v0[2], v0[3]); asm volatile("" : "+v"(w8.x));
#pragma unroll
                        for (int j = 0; j < 4; ++j) v1[j] = fmaxf(sigmoidf_(v1[j]) * G8_SCALE, 1.0f) + 12582912.0f;
                        w8.y = pk4_u8(v1[0], v1[1], v1[2], v1[3]);
                        *(u32x2*)((unsigned char*)(Z + (size_t)(row0 + ai * 128 + m * 16) * NZ + ZG_COL) + (col0 - ZG_COL) + bj * 128) = w8; continue; }
                    if (act == 2) { f32x2 a = pg8::gelu_pk((f32x2){v0[0], v0[1]}), b = pg8::gelu_pk((f32x2){v0[2], v0[3]}), c = pg8::gelu_pk((f32x2){v1[0], v1[1]}), d = pg8::gelu_pk((f32x2){v1[2], v1[3]});
                        v0 = (f32x4){a.x, a.y, b.x, b.y}; v1 = (f32x4){c.x, c.y, d.x, d.y}; }
                    if (act == 1) {
#pragma unroll
                        for (int j = 0; j < 4; ++j) { v0[j] = sigmoidf_(v0[j]); v1[j] = sigmoidf_(v1[j]); } }
                    u32x4 w; w.x = cvt_pk_bf16(v0[0], v0[1]); w.y = cvt_pk_bf16(v0[2], v0[3]); w.z = cvt_pk_bf16(v1[0], v1[1]); w.w = cvt_pk_bf16(v1[2], v1[3]);
                    *(u32x4*)(rowp + bj * 128) = w; }
                if constexpr (G8) asm volatile("" ::: "memory"); }
    }
};
struct EpiNull {
    static constexpr bool PERM = true, CHAIN = false; bf16_t* Z;
    __device__ __forceinline__ void operator()(const f32x4 (&acc)[2][2][4][2], const Unit& u, int wr, int wc, int fr, int fq) const {
        float sacc = 0.f;
#pragma unroll
        for (int ai = 0; ai < 2; ++ai)
#pragma unroll
            for (int bj = 0; bj < 2; ++bj)
#pragma unroll
                for (int m = 0; m < 4; ++m)
#pragma unroll
                    for (int n = 0; n < 2; ++n) sacc += (acc[ai][bj][m][n][0] + acc[ai][bj][m][n][1]) + (acc[ai][bj][m][n][2] + acc[ai][bj][m][n][3]);
        if (sacc == 1.2345e30f) Z[u.pm + wr + wc + fr + fq] = 0;
    }
};
struct EpiOut {
    static constexpr bool PERM = true, CHAIN = false, SIDE = false, KHOOK = false; bf16_t* T;
    __device__ __forceinline__ void operator()(const f32x4 (&acc)[2][2][4][2], const Unit& u, int wr, int wc, int fr, int fq, const LAS unsigned char*) const {
        int row0 = u.pm * 256 + wr * 64 + fr, col0 = u.pn * 256 + wc * 32 + 8 * fq; asm volatile("" : "+v"(row0), "+v"(col0));
#pragma unroll
        for (int ai = 0; ai < 2; ++ai)
#pragma unroll
            for (int m = 0; m < 4; ++m) { bf16_t* rowp = T + (size_t)(row0 + ai * 128 + m * 16) * D + col0;
#pragma unroll
                for (int bj = 0; bj < 2; ++bj) { const f32x4 v0 = acc[ai][bj][m][0], v1 = acc[ai][bj][m][1];
                    u32x4 w; w.x = cvt_pk_bf16(v0[0], v0[1]); w.y = cvt_pk_bf16(v0[2], v0[3]); w.z = cvt_pk_bf16(v1[0], v1[1]); w.w = cvt_pk_bf16(v1[2], v1[3]);
                    *(u32x4*)(rowp + bj * 128) = w; } }
    }
};
struct EpiBranch {
    static constexpr bool PERM = true, CHAIN = false, SIDE = false, KHOOK = true; static constexpr int HOOK_T0 = 4, HOOK_T1 = 12;
    const bf16_t* Z; bf16_t* Y;
    template <bool FIN> __device__ __forceinline__ void apply(f32x4 (&acc)[2][2][4][2], const Unit& u, int br, int wr, int wc, int fr, int fq) const {
        int row0 = u.pm * 256 + wr * 64 + fr, col0 = u.pn * 256 + wc * 32 + 8 * fq;
        asm volatile("" : "+v"(row0), "+v"(col0));
#pragma unroll
        for (int ai = 0; ai < 2; ++ai) {
            u32x2 ga[4][2], gb[4][2];
#pragma unroll
            for (int m = 0; m < 4; ++m) { const unsigned char* rowp = (const unsigned char*)(Z + (size_t)(row0 + ai * 128 + m * 16) * NZ + ZG_COL) + br * 1024 + col0;
#pragma unroll
                for (int bj = 0; bj < 2; ++bj) { ga[m][bj] = *(const u32x2*)(rowp + bj * 128); if (!FIN) gb[m][bj] = *(const u32x2*)(rowp + 1024 + bj * 128); } }
#pragma unroll
            for (int m = 0; m < 4; ++m) { const size_t row = (size_t)(row0 + ai * 128 + m * 16);
#pragma unroll
                for (int bj = 0; bj < 2; ++bj) { const u32x2 a = ga[m][bj];
                    f32x4 r0 = u8x4_f32(a.x), r1 = u8x4_f32(a.y);
                    if (FIN) { r0 = r0 * (1.0f / G8_SCALE); r1 = r1 * (1.0f / G8_SCALE); }
                    else { const u32x2 b = gb[m][bj]; const f32x4 q0 = u8x4_f32(b.x), q1 = u8x4_f32(b.y);
#pragma unroll
                        for (int i = 0; i < 4; ++i) { r0[i] *= __builtin_amdgcn_rcpf(q0[i]); r1[i] *= __builtin_amdgcn_rcpf(q1[i]); } }
                    acc[ai][bj][m][0] = acc[ai][bj][m][0] * r0; acc[ai][bj][m][1] = acc[ai][bj][m][1] * r1;
                    if (FIN) { const f32x4 v0 = acc[ai][bj][m][0], v1 = acc[ai][bj][m][1];
                        u32x4 w; w.x = cvt_pk_bf16(v0[0], v0[1]); w.y = cvt_pk_bf16(v0[2], v0[3]); w.z = cvt_pk_bf16(v1[0], v1[1]); w.w = cvt_pk_bf16(v1[2], v1[3]);
                        *(u32x4*)(Y + row * D + col0 + bj * 128) = w; } } }
            asm volatile("" ::: "memory"); }
    }
    __device__ __forceinline__ void hook(f32x4 (&acc)[2][2][4][2], const Unit& u, int br, int wr, int wc, int fr, int fq) const { apply<false>(acc, u, br, wr, wc, fr, fq); }
    __device__ __forceinline__ void operator()(f32x4 (&acc)[2][2][4][2], const Unit& u, int wr, int wc, int fr, int fq, const LAS unsigned char*) const { apply<true>(acc, u, 2, wr, wc, fr, fq); }
};
struct EpiSwiglu {
    static constexpr bool PERM = true, CHAIN = false, SIDE = true, KHOOK = false; unsigned char* HID; const float* bgu; const LAS int* seg;
    __device__ __forceinline__ void side(const Unit& u, unsigned slot, int wid, int lane) const {
        if (wid == 1) { const int e = expert_of(seg, u.pm); pg8::dma16(lane < 32 ? (unsigned)lane * 16u : 4096u + (unsigned)(lane - 32) * 16u, bgu + (size_t)e * 2048 + u.pn * 128, slot); } }
    __device__ __forceinline__ void operator()(const f32x4 (&acc)[2][2][4][2], const Unit& u, int wr, int wc, int fr, int fq, const LAS unsigned char* sd) const {
        int j0 = u.pn * 128 + wc * 32 + 8 * fq, slot0 = u.pm * 256 + wr * 64 + fr; asm volatile("" : "+v"(j0), "+v"(slot0));
        f32x4 bg[2], bu[2];
#pragma unroll
        for (int n = 0; n < 2; ++n) { bg[n] = *(const LAS f32x4*)(sd + (wc * 32 + 8 * fq + 4 * n) * 4); bu[n] = *(const LAS f32x4*)(sd + (128 + wc * 32 + 8 * fq + 4 * n) * 4); }
#pragma unroll
        for (int ai = 0; ai < 2; ++ai)
#pragma unroll
            for (int m = 0; m < 4; ++m) { const size_t slot = (size_t)(slot0 + ai * 128 + m * 16); f32x4 o[2];
#pragma unroll
                for (int n = 0; n < 2; ++n) { f32x4 g = acc[ai][0][m][n] + bg[n], up = acc[ai][1][m][n] + bu[n];
#pragma unroll
                    for (int i = 0; i < 4; ++i) { g[i] = fminf(g[i], 7.0f); up[i] = __builtin_amdgcn_fmed3f(up[i], -7.0f, 7.0f); }
                    f32x4 t = g * (-1.702f * 1.4426950408889634f);
#pragma unroll
                    for (int i = 0; i < 4; ++i) t[i] = __builtin_amdgcn_exp2f(t[i]);
                    t = t + 1.0f;
#pragma unroll
                    for (int i = 0; i < 4; ++i) t[i] = __builtin_amdgcn_rcpf(t[i]);
                    o[n] = (up * F8S_ACT + F8S_ACT) * (g * t); }
                u32x2 w; w.x = pk4_fp8(o[0][0], o[0][1], o[0][2], o[0][3]); w.y = pk4_fp8(o[1][0], o[1][1], o[1][2], o[1][3]);
                *(u32x2*)(HID + slot * 1024 + j0) = w; }
    }
};
struct EpiDown {
    static constexpr bool PERM = true, CHAIN = false, SIDE = true, KHOOK = false; unsigned char* FS; const float* bdn; const int* dest; const float* pslot; const LAS int* seg;
    __device__ __forceinline__ void side(const Unit& u, unsigned slot, int wid, int lane) const {
        if (wid == 1) { const int e = expert_of(seg, u.pm); pg8::dma16((unsigned)lane * 16u, bdn + (size_t)e * 1024 + u.pn * 256, slot); }
        if (wid == 2) pg8::dma16((unsigned)lane * 16u, dest + (size_t)u.pm * 256, slot + 1024u);
        if (wid == 3) pg8::dma16((unsigned)lane * 16u, pslot + (size_t)u.pm * 256, slot + 2048u); }
    __device__ __forceinline__ void operator()(const f32x4 (&acc)[2][2][4][2], const Unit& u, int wr, int wc, int fr, int fq, const LAS unsigned char* sd) const {
        int col0 = u.pn * 256 + wc * 32 + 8 * fq, slot0 = u.pm * 256 + wr * 64 + fr; asm volatile("" : "+v"(col0), "+v"(slot0));
        f32x4 bv[2][2];
#pragma unroll
        for (int bj = 0; bj < 2; ++bj)
#pragma unroll
            for (int n = 0; n < 2; ++n) bv[bj][n] = *(const LAS f32x4*)(sd + (bj * 128 + wc * 32 + 8 * fq + 4 * n) * 4);
#pragma unroll
        for (int ai = 0; ai < 2; ++ai)
#pragma unroll
            for (int m = 0; m < 4; ++m) { const int rt = ai * 128 + wr * 64 + m * 16 + fr; const int d = *(const LAS int*)(sd + 1024 + rt * 4); const float p = *(const LAS float*)(sd + 2048 + rt * 4) * FS_SCALE;
                if (d >= 0) {
#pragma unroll
                    for (int bj = 0; bj < 2; ++bj) { f32x4 v0 = (acc[ai][bj][m][0] + bv[bj][0]) * p, v1 = (acc[ai][bj][m][1] + bv[bj][1]) * p;
#pragma unroll
                        for (int i = 0; i < 4; ++i) { v0[i] = __builtin_amdgcn_fmed3f(v0[i], -FS_CLAMP, FS_CLAMP); v1[i] = __builtin_amdgcn_fmed3f(v1[i], -FS_CLAMP, FS_CLAMP); }
                        u32x2 w; w.x = pk4_fp8(v0[0], v0[1], v0[2], v0[3]); w.y = pk4_fp8(v1[0], v1[1], v1[2], v1[3]);
                        *(u32x2*)(FS + (size_t)d * 1024 + col0 + bj * 128) = w; } }
                asm volatile("" ::: "memory"); }
    }
};

__device__ __forceinline__ const float* xin_row(const Frame& F, int row) { return row < ML ? F.in[IN_X] + (size_t)row * D : F.in[IN_CTX] + (size_t)(row - ML) * D; }
__device__ __forceinline__ void phase_ln0_first(Frame& F) {
    int t_lo, t_hi; tile_range(F, MT, t_lo, t_hi);
    const int r_lo = 32 * t_lo, nrows = 32 * (t_hi - t_lo);
    const int mrA = mod_row(r_lo), mrB = mod_row(r_lo + (nrows > 0 ? nrows - 1 : 0));
    { const float* mb = (const float*)(F.ws + WS_MOD); pv_fill(F, 0, mb + ((size_t)(0 * 17 + mrA) * 6 + 0) * 1024); pv_fill(F, 1, mb + ((size_t)(0 * 17 + mrB) * 6 + 0) * 1024);
      pv_fill(F, 2, mb + ((size_t)(0 * 17 + mrA) * 6 + 1) * 1024); pv_fill(F, 3, mb + ((size_t)(0 * 17 + mrB) * 6 + 1) * 1024); }
    load_wg_lds(F, 0);
    for (int n = F.wave; n < nrows; n += 4 * NWAVES) {
        RowV rv[4];
#pragma unroll
        for (int u = 0; u < 4; ++u) if (n + u * NWAVES < nrows) row_load(rv[u], xin_row(F, r_lo + n + u * NWAVES), F.lane);
#pragma unroll
        for (int u = 0; u < 4; ++u) if (n + u * NWAVES < nrows) { const int row = r_lo + n + u * NWAVES;
            const int sel = (mod_row(row) == mrA) ? 0 : 1; ln0_row(F, row, rv[u], pv_slot(F, 0 + sel), pv_slot(F, 2 + sel)); }
    }
    gates_tail(F, 0, t_lo, t_hi);
    __syncthreads();
}
__device__ __forceinline__ void phase_finalize(Frame& F, int l, int mrows) {
    const int gw = F.bid * NWAVES + F.wave, NGW = F.G * NWAVES;
    const bf16_t* hf = (const bf16_t*)(F.ws + WS_HFB); const bf16_t* hb = hf + (size_t)MT * 512;
    const float* ng = F.in[IN_MNG] + l * 512 + 8 * F.lane;
    const f32x4 g0 = *(const f32x4*)ng, g1 = *(const f32x4*)(ng + 4);
    for (int row = gw; row < mrows; row += NGW) {
        const u32x4 ha = __builtin_nontemporal_load((const u32x4*)(hf + (size_t)row * 512 + 8 * F.lane)), hbv = __builtin_nontemporal_load((const u32x4*)(hb + (size_t)row * 512 + 8 * F.lane));
        f32x4 v0 = (f32x4){bflo(ha.x) + bflo(hbv.x), bfhi(ha.x) + bfhi(hbv.x), bflo(ha.y) + bflo(hbv.y), bfhi(ha.y) + bfhi(hbv.y)}, v1 = (f32x4){bflo(ha.z) + bflo(hbv.z), bfhi(ha.z) + bfhi(hbv.z), bflo(ha.w) + bflo(hbv.w), bfhi(ha.w) + bfhi(hbv.w)};
        float s = (v0.x + v0.y) + (v0.z + v0.w) + (v1.x + v1.y) + (v1.z + v1.w);
#pragma unroll
        for (int o = 1; o < 16; o <<= 1) s += shx(s, o, F.lane);
        const float mu = s * (1.f / 128.f); v0 = v0 - mu; v1 = v1 - mu;
        float q = (v0.x * v0.x + v0.y * v0.y) + (v0.z * v0.z + v0.w * v0.w) + (v1.x * v1.x + v1.y * v1.y) + (v1.z * v1.z + v1.w * v1.w);
#pragma unroll
        for (int o = 1; o < 16; o <<= 1) q += shx(q, o, F.lane);
        const float rstd = 1.f / sqrtf(q * (1.f / 128.f) + HEAD_EPS);
        const u32x4 so = __builtin_nontemporal_load((const u32x4*)((const bf16_t*)(F.ws + WS_Z) + (size_t)row * NZ + ZC_O + 8 * F.lane));
        v0 = v0 * rstd * g0; v1 = v1 * rstd * g1;
        u32x4 w; w.x = pk2(v0.x * bflo(so.x), v0.y * bfhi(so.x)); w.y = pk2(v0.z * bflo(so.y), v0.w * bfhi(so.y)); w.z = pk2(v1.x * bflo(so.z), v1.y * bfhi(so.z)); w.w = pk2(v1.z * bflo(so.w), v1.w * bfhi(so.w));
        *(u32x4*)((bf16_t*)(F.ws + WS_BRA) + (size_t)row * D + 256 + 8 * F.lane) = w;
    }
}
__device__ __forceinline__ void phase_ln1_router(Frame& F, int l, int mrows) {
    LAS int* cnt = (LAS int*)(F.lds + NW_END);
    { const float* wr = F.in[IN_WR] + (size_t)l * D * NEXP;
      for (int i = F.tid; i < NEXP * D; i += NTHREADS) { const int k = i >> 5, e = i & 31; *(LAS bf16_t*)(F.lds + NW_WT + e * 2064 + k * 2) = (bf16_t)f2bf(wr[i]); }
      if (F.tid < NEXP) cnt[F.tid] = 0; }
    const float* brt = F.in[IN_BR] + l * NEXP;
    int t_lo, t_hi; tile_range(F, mrows, t_lo, t_hi);
    const int r_lo = 32 * t_lo, nrows = 32 * (t_hi - t_lo);
    const int mrA = mod_row(r_lo), mrB = mod_row(r_lo + (nrows > 0 ? nrows - 1 : 0));
    { const float* mb = (const float*)(F.ws + WS_MOD); pv_fill(F, 0, F.in[IN_LN1G] + l * D); pv_fill(F, 1, F.in[IN_LN1B] + l * D);
      pv_fill(F, 2, mb + ((size_t)(l * 17 + mrA) * 6 + 2) * 1024); pv_fill(F, 3, mb + ((size_t)(l * 17 + mrB) * 6 + 2) * 1024);
      pv_fill(F, 4, mb + ((size_t)(l * 17 + mrA) * 6 + 3) * 1024); pv_fill(F, 5, mb + ((size_t)(l * 17 + mrB) * 6 + 3) * 1024);
      pv_fill(F, 6, mb + ((size_t)(l * 17 + mrA) * 6 + 4) * 1024); pv_fill(F, 7, mb + ((size_t)(l * 17 + mrB) * 6 + 4) * 1024); }
    __syncthreads();
    { const bf16_t* yb = (const bf16_t*)(F.ws + WS_T) + 8 * F.lane;
      for (int n = F.wave; n < nrows; n += 2 * NWAVES) {
          RowV rv[2]; u32x4 yv2[2][2];
#pragma unroll
          for (int u = 0; u < 2; ++u) if (n + u * NWAVES < nrows) { const int row = r_lo + n + u * NWAVES;
              if (l == 0) row_load(rv[u], xin_row(F, row), F.lane); else row_load_bf16(rv[u], (const bf16_t*)(F.ws + WS_X) + (size_t)row * D, F.lane);
#pragma unroll
              for (int h = 0; h < 2; ++h) yv2[u][h] = __builtin_nontemporal_load((const u32x4*)(yb + (size_t)row * D + 512 * h)); }
#pragma unroll
          for (int u = 0; u < 2; ++u) if (n + u * NWAVES < nrows) { const int row = r_lo + n + u * NWAVES; RowV cur = rv[u];
              const int sel = (mod_row(row) == mrA) ? 0 : 1;
              { const LAS float* g1 = pv_slot(F, 2 + sel);
#pragma unroll
                for (int j = 0; j < 4; ++j) { const f32x4 gg = *(const LAS f32x4*)(g1 + RC(F.lane, j)); const u32x4 yw = yv2[u][j >> 1]; const f32x4 yv = (j & 1) ? (f32x4){bflo(yw.z), bfhi(yw.z), bflo(yw.w), bfhi(yw.w)} : (f32x4){bflo(yw.x), bfhi(yw.x), bflo(yw.y), bfhi(yw.y)}; cur.v[j] = cur.v[j] * DN_ALPHA + gg * yv; } }
              row_ln_plain(cur, F.lane); row_affine_l(cur, pv_slot(F, 0), pv_slot(F, 1), F.lane);
              row_store_bf16_nt(cur, (bf16_t*)(F.ws + WS_X) + (size_t)row * D, F.lane);
              row_ln_plain(cur, F.lane); row_modulate_l(cur, pv_slot(F, 4 + sel), pv_slot(F, 6 + sel), F.lane);
              row_store_bf16(cur, (bf16_t*)(F.ws + WS_H2) + (size_t)row * D, F.lane);
              { unsigned char* h8 = (unsigned char*)(F.ws + WS_H2F8) + (size_t)row * D + 8 * F.lane;
#pragma unroll
                for (int h = 0; h < 2; ++h) { u32x2 w; w.x = pk4_fp8(cur.v[2 * h].x * F8S_ACT, cur.v[2 * h].y * F8S_ACT, cur.v[2 * h].z * F8S_ACT, cur.v[2 * h].w * F8S_ACT); w.y = pk4_fp8(cur.v[2 * h + 1].x * F8S_ACT, cur.v[2 * h + 1].y * F8S_ACT, cur.v[2 * h + 1].z * F8S_ACT, cur.v[2 * h + 1].w * F8S_ACT); *(u32x2*)(h8 + 512 * h) = w; } } }
      } }
    asm volatile("s_waitcnt vmcnt(0)" ::: "memory"); __syncthreads();
    for (int tile = t_lo + F.wave; tile < t_hi; tile += NWAVES) {
        const LAS float* lgw = narrow_tile_wave(F, (const bf16_t*)(F.ws + WS_H2) + (size_t)tile * 32 * D);
        if (F.lane < 32) {
            const LAS float* lgp = lgw + F.lane * 33; const int row = tile * 32 + F.lane;
            float lg[NEXP];
#pragma unroll
            for (int e = 0; e < NEXP; ++e) lg[e] = lgp[e] + brt[e];
            unsigned used = 0u; float bv[4]; int bi[4];
#pragma unroll
            for (int k = 0; k < 4; ++k) { float best = -3.0e38f; int idx = 0;
#pragma unroll
                for (int e = 0; e < NEXP; ++e) { const bool take = (((used >> e) & 1u) == 0u) && (lg[e] > best); best = take ? lg[e] : best; idx = take ? e : idx; }
                used |= 1u << idx; bv[k] = best; bi[k] = idx; }
            const float e1 = __expf(bv[1] - bv[0]), e2 = __expf(bv[2] - bv[0]), e3 = __expf(bv[3] - bv[0]); const float inv = __builtin_amdgcn_rcpf(1.0f + e1 + e2 + e3);
            int* ei = (int*)(F.ws + WS_ROUTE + RT_EIDX) + (size_t)row * 4; float* pr = (float*)(F.ws + WS_ROUTE + RT_PROB) + (size_t)row * 4;
            *(int4*)ei = make_int4(bi[0], bi[1], bi[2], bi[3]); *(f32x4*)pr = (f32x4){inv, e1 * inv, e2 * inv, e3 * inv};
            atomicAdd((int*)&cnt[bi[0]], 1); atomicAdd((int*)&cnt[bi[1]], 1); atomicAdd((int*)&cnt[bi[2]], 1); atomicAdd((int*)&cnt[bi[3]], 1);
        }
        asm volatile("s_waitcnt lgkmcnt(0)" ::: "memory");
    }
    __syncthreads();
    if (F.tid < NEXP) ((int*)(F.ws + WS_ROUTE + RT_CNT))[F.bid * NEXP + F.tid] = cnt[F.tid];
    __syncthreads();
}
__device__ __forceinline__ void phase_slots(Frame& F, int mrows) {
    LAS int* part = (LAS int*)F.lds;
    LAS int* pre = part + 1024;
    LAS int* tot = pre + 32;
    LAS int* seg = tot + 32;
    LAS int* gcnt = seg + 64;
    LAS int* eix = gcnt + 2048;
    LAS int* rnk = eix + 4096;
    const int* cntg = (const int*)(F.ws + WS_ROUTE + RT_CNT);
    int* tokg = (int*)(F.ws + WS_ROUTE + RT_TOK); int* destg = (int*)(F.ws + WS_ROUTE + RT_DEST); float* psl = (float*)(F.ws + WS_ROUTE + RT_PSLOT);
    int t_lo, t_hi; tile_range(F, mrows, t_lo, t_hi);
    const int row_base = t_lo * 32, nent = (t_hi - t_lo) * 128, ngrp = nent / 64;
    { const int e = F.tid & 31, pt = F.tid >> 5; int a = 0, b = 0;
      for (int c = pt; c < F.G; c += 16) { const int v = cntg[c * NEXP + e]; b += v; a += (c < F.bid) ? v : 0; }
      part[pt * 32 + e] = a; part[512 + pt * 32 + e] = b; }
    for (int i = F.tid; i < nent; i += NTHREADS) eix[i] = ((const int*)(F.ws + WS_ROUTE + RT_EIDX))[(size_t)row_base * 4 + i];
    __syncthreads();
    if (F.tid < NEXP) { int a = 0, b = 0;
#pragma unroll
        for (int pt = 0; pt < 16; ++pt) { a += part[pt * 32 + F.tid]; b += part[512 + pt * 32 + F.tid]; }
        pre[F.tid] = a; tot[F.tid] = b; }
    for (int g = F.wave; g < ngrp; g += NWAVES) {
        const int e = eix[g * 64 + F.lane]; int rank = 0, mycnt = 0;
#pragma unroll 4
        for (int ee = 0; ee < NEXP; ++ee) { const unsigned long long m = __ballot(e == ee); if (e == ee) rank = __popcll(m & ((1ull << F.lane) - 1ull)); if (F.lane == ee) mycnt = __popcll(m); }
        rnk[g * 64 + F.lane] = rank; if (F.lane < NEXP) gcnt[g * 32 + F.lane] = mycnt; }
    __syncthreads();
    if (F.tid == 0) { int s = 0; for (int e = 0; e < NEXP; ++e) { seg[e] = s; s += (tot[e] + 255) & ~255; } seg[NEXP] = s; }
    if (F.tid >= 64 && F.tid < 64 + NEXP) { const int e = F.tid - 64; int run = 0; for (int g = 0; g < ngrp; ++g) { const int c = gcnt[g * 32 + e]; gcnt[g * 32 + e] = run; run += c; } }
    __syncthreads();
    { const float* prg = (const float*)(F.ws + WS_ROUTE + RT_PROB) + (size_t)row_base * 4;
      for (int i = F.tid; i < nent; i += NTHREADS) { const int e = eix[i]; const int slot = seg[e] + pre[e] + gcnt[(i >> 6) * 32 + e] + rnk[i];
          tokg[slot] = row_base + (i >> 2); destg[slot] = row_base * 4 + i; psl[slot] = prg[i]; } }
    if (F.bid < NEXP) { const int e = F.bid; for (int sl = seg[e] + tot[e] + F.tid; sl < seg[e + 1]; sl += NTHREADS) { tokg[sl] = 0; destg[sl] = -1; psl[sl] = 0.f; } }
    if (F.bid == 0 && F.tid <= NEXP) ((int*)(F.ws + WS_ROUTE + RT_SEG))[F.tid] = seg[F.tid];
    __syncthreads();
}
struct CombRaw { u32x4 x[2]; u32x2 f[2][4]; };
__device__ __forceinline__ void comb_load(const Frame& F, int row, CombRaw& r) {
    { const bf16_t* xp = (const bf16_t*)(F.ws + WS_X) + (size_t)row * D + 8 * F.lane;
#pragma unroll
      for (int h = 0; h < 2; ++h) r.x[h] = __builtin_nontemporal_load((const u32x4*)(xp + 512 * h)); }
    const unsigned char* fs = (const unsigned char*)(F.ws + WS_FS) + (size_t)row * 4 * 1024 + 8 * F.lane;
#pragma unroll
    for (int h = 0; h < 2; ++h)
#pragma unroll
        for (int k = 0; k < 4; ++k) r.f[h][k] = __builtin_nontemporal_load((const u32x2*)(fs + k * 1024 + 512 * h));
}
__device__ __forceinline__ void phase_combine_ln2(Frame& F, int l, int mrows) {
    const bool lastl = (l == DEPTH - 1);
    int t_lo, t_hi; tile_range(F, mrows, t_lo, t_hi);
    const int r_lo = 32 * t_lo, nrows = 32 * (t_hi - t_lo);
    const int mrA = mod_row(r_lo), mrB = mod_row(r_lo + (nrows > 0 ? nrows - 1 : 0));
    { const float* mb = (const float*)(F.ws + WS_MOD); const int ln = lastl ? l : l + 1; pv_fill(F, 0, F.in[IN_LN2G] + l * D); pv_fill(F, 1, F.in[IN_LN2B] + l * D);
      pv_fill(F, 2, mb + ((size_t)(l * 17 + mrA) * 6 + 5) * 1024); pv_fill(F, 3, mb + ((size_t)(l * 17 + mrB) * 6 + 5) * 1024);
      pv_fill(F, 4, mb + ((size_t)(ln * 17 + mrA) * 6 + 0) * 1024); pv_fill(F, 5, mb + ((size_t)(ln * 17 + mrB) * 6 + 0) * 1024);
      pv_fill(F, 6, mb + ((size_t)(ln * 17 + mrA) * 6 + 1) * 1024); pv_fill(F, 7, mb + ((size_t)(ln * 17 + mrB) * 6 + 1) * 1024); }
    if (!lastl) load_wg_lds(F, l + 1); else __syncthreads();
    for (int n = F.wave; n < nrows; n += 2 * NWAVES) {
        CombRaw rw[2];
#pragma unroll
        for (int u = 0; u < 2; ++u) if (n + u * NWAVES < nrows) comb_load(F, r_lo + n + u * NWAVES, rw[u]);
#pragma unroll
        for (int u = 0; u < 2; ++u) if (n + u * NWAVES < nrows) { const int row = r_lo + n + u * NWAVES;
            const int sel = (mod_row(row) == mrA) ? 0 : 1;
            const LAS float* g2 = pv_slot(F, 2 + sel);
            RowV x;
#pragma unroll
            for (int h = 0; h < 2; ++h) { const u32x4 w = rw[u].x[h]; x.v[2 * h] = (f32x4){bflo(w.x), bfhi(w.x), bflo(w.y), bfhi(w.y)}; x.v[2 * h + 1] = (f32x4){bflo(w.z), bfhi(w.z), bflo(w.w), bfhi(w.w)}; }
#pragma unroll
            for (int j = 0; j < 4; ++j) { f32x4 f = (f32x4){0.f, 0.f, 0.f, 0.f};
#pragma unroll
                for (int k = 0; k < 4; ++k) { const u32x2 w2 = rw[u].f[j >> 1][k]; const int wd = (int)((j & 1) ? w2.y : w2.x);
                    const f32x2 lo = __builtin_amdgcn_cvt_pk_f32_fp8(wd, false), hi = __builtin_amdgcn_cvt_pk_f32_fp8(wd, true); f[0] += lo[0]; f[1] += lo[1]; f[2] += hi[0]; f[3] += hi[1]; }
                const f32x4 gg = *(const LAS f32x4*)(g2 + RC(F.lane, j)) * (1.0f / FS_SCALE);
                x.v[j] = x.v[j] * DN_ALPHA + gg * f; }
            row_ln_plain(x, F.lane); row_affine_l(x, pv_slot(F, 0), pv_slot(F, 1), F.lane);
            if (lastl) { row_store_nt(x, F.out + (size_t)row * D, F.lane); }
            else { row_store_bf16_nt(x, (bf16_t*)(F.ws + WS_X) + (size_t)row * D, F.lane); ln0_row(F, row, x, pv_slot(F, 4 + sel), pv_slot(F, 6 + sel)); } }
    }
    if (!lastl) gates_tail(F, l + 1, t_lo, t_hi);
    __syncthreads();
}

#define MFMA32(a, b, c) __builtin_amdgcn_mfma_f32_32x32x16_bf16((a), (b), (c), 0, 0, 0)
#define MFMA16(a, b, c) __builtin_amdgcn_mfma_f32_16x16x32_bf16((a), (b), (c), 0, 0, 0)
__device__ __forceinline__ f32x16 zero16() { f32x16 z;
#pragma unroll
    for (int i = 0; i < 16; ++i) z[i] = 0.f;
    return z; }
__device__ __forceinline__ void pool_tiles(Frame& F, int l, bool with_ctx) {
    LAS unsigned char* Pin = F.lds;
    LAS unsigned char* Dm = F.lds + 40960;
    const bf16_t* Z = (const bf16_t*)(F.ws + WS_Z);
    const bf16_t* Wp = (const bf16_t*)(F.ws + WS_WPOOL) + (size_t)l * 4 * 4096;
    const float* psc = F.in[IN_POOLS] + l * 256;
    bf16_t* BRA = (bf16_t*)(F.ws + WS_BRA);
    const int ntiles = with_ctx ? 1088 : 1024;
    const int r = F.lane & 31, h = F.lane >> 5;
    for (int tile = F.bid; tile < ntiles; tile += F.G) {
        int row0, seq_lo, seq_hi;
        if (tile < 1024) { row0 = tile * 64; seq_lo = row0; seq_hi = row0 + 64; }
        else { const int ct = tile - 1024; seq_lo = ML + (ct >> 2) * 256; seq_hi = seq_lo + 256; row0 = seq_lo + (ct & 3) * 64; }
        for (int idx = F.tid; idx < 80 * 32; idx += NTHREADS) { const int rr = idx >> 5, ck = idx & 31, grow = row0 - 8 + rr;
            if (grow >= seq_lo && grow < seq_hi) *(LAS u32x4*)(Pin + rr * 512 + ck * 16) = __builtin_nontemporal_load((const u32x4*)(Z + (size_t)grow * NZ + ZC_P + ck * 8)); }
        __syncthreads();
        for (int idx = F.tid; idx < 64 * 32; idx += NTHREADS) { const int tok = idx >> 5, ck = idx & 31, g = ck >> 3, hw = 1 << g, t = row0 + tok;
            const int lo = max(t - hw, seq_lo), hi = min(t + hw, seq_hi);
            float s[8];
#pragma unroll
            for (int e = 0; e < 8; ++e) s[e] = 0.f;
            for (int rw = lo; rw < hi; ++rw) { const u32x4 v = *(const LAS u32x4*)(Pin + (rw - row0 + 8) * 512 + ck * 16);
                s[0] += bflo(v.x); s[1] += bfhi(v.x); s[2] += bflo(v.y); s[3] += bfhi(v.y); s[4] += bflo(v.z); s[5] += bfhi(v.z); s[6] += bflo(v.w); s[7] += bfhi(v.w); }
            const float inv = 1.0f / (float)(hi - lo);
            const u32x4 o = *(const LAS u32x4*)(Pin + (tok + 8) * 512 + ck * 16);
            u32x4 w; w.x = pk2(s[0] * inv - bflo(o.x), s[1] * inv - bfhi(o.x)); w.y = pk2(s[2] * inv - bflo(o.y), s[3] * inv - bfhi(o.y));
            w.z = pk2(s[4] * inv - bflo(o.z), s[5] * inv - bfhi(o.z)); w.w = pk2(s[6] * inv - bflo(o.w), s[7] * inv - bfhi(o.w));
            *(LAS u32x4*)(Dm + tok * 528 + ck * 16) = w; }
        __syncthreads();
#pragma unroll 1
        for (int qi = 0; qi < 2; ++qi) { const int q = F.wave + 8 * qi, g = q >> 2, td = (q >> 1) & 1, tt = q & 1;
            f32x16 acc = zero16();
#pragma unroll
            for (int ks = 0; ks < 4; ++ks) { const bf16x8 a = *(const bf16x8*)(Wp + ((size_t)g * 64 + td * 32 + r) * 64 + ks * 16 + 8 * h);
                const bf16x8 b = *(const LAS bf16x8*)(Dm + (tt * 32 + r) * 528 + (g * 64 + ks * 16 + 8 * h) * 2);
                acc = MFMA32(a, b, acc); }
            const size_t orow = (size_t)(row0 + tt * 32 + r);
#pragma unroll
            for (int qq = 0; qq < 4; ++qq) { const int dcol = g * 64 + td * 32 + 8 * qq + 4 * h; const f32x4 sc = *(const f32x4*)(psc + dcol);
                u32x2 w; w.x = pk2(acc[4 * qq] * sc.x, acc[4 * qq + 1] * sc.y); w.y = pk2(acc[4 * qq + 2] * sc.z, acc[4 * qq + 3] * sc.w);
                *(u32x2*)(BRA + orow * D + dcol) = w; } }
        __syncthreads();
    }
}
__device__ __forceinline__ void sgu_chunks(Frame& F, int l, bool with_ctx) {
    LAS unsigned char* Vt = F.lds;
    const bf16_t* Z = (const bf16_t*)(F.ws + WS_Z);
    const bf16_t* Ws = (const bf16_t*)(F.ws + WS_WSGU) + (size_t)l * 4 * 16384;
    const float* lng = F.in[IN_SLNG] + l * 256; const float* lnb = F.in[IN_SLNB] + l * 256; const float* sb = F.in[IN_SGUB] + l * 512;
    bf16_t* BRA = (bf16_t*)(F.ws + WS_BRA);
    const int nchunks = with_ctx ? 544 : 512;
    const int r = F.lane & 31, h = F.lane >> 5;
    for (int ch = F.bid; ch < nchunks; ch += F.G) {
        const int row0 = ch * 128;
        { const int s = F.tid >> 2, q = F.tid & 3; const bf16_t* zp = Z + (size_t)(row0 + s) * NZ + ZC_UV + 256 + q * 64;
          float v[64]; float sum = 0.f;
#pragma unroll
          for (int i = 0; i < 8; ++i) { const u32x4 w = __builtin_nontemporal_load((const u32x4*)(zp + 8 * i));
              v[8 * i] = bflo(w.x); v[8 * i + 1] = bfhi(w.x); v[8 * i + 2] = bflo(w.y); v[8 * i + 3] = bfhi(w.y); v[8 * i + 4] = bflo(w.z); v[8 * i + 5] = bfhi(w.z); v[8 * i + 6] = bflo(w.w); v[8 * i + 7] = bfhi(w.w); }
#pragma unroll
          for (int i = 0; i < 64; ++i) sum += v[i];
          sum += shx(sum, 1, F.lane); sum += shx(sum, 2, F.lane);
          const float mean = sum * (1.f / 256.f); float sq = 0.f;
#pragma unroll
          for (int i = 0; i < 64; ++i) { v[i] -= mean; sq += v[i] * v[i]; }
          sq += shx(sq, 1, F.lane); sq += shx(sq, 2, F.lane);
          const float rstd = 1.f / sqrtf(sq * (1.f / 256.f) + LN_EPS);
#pragma unroll
          for (int i = 0; i < 64; ++i) { const int c = q * 64 + i; const float y = v[i] * rstd * lng[c] + lnb[c]; *(LAS bf16_t*)(Vt + c * 272 + s * 2) = (bf16_t)f2bf(y); } }
        __syncthreads();
        const int tc = F.wave & 1, tt = F.wave >> 1, t = tt * 32 + r;
#pragma unroll 1
        for (int g = 0; g < 4; ++g) {
            f32x16 acc = zero16();
#pragma unroll
            for (int ks = 0; ks < 8; ++ks) { const bf16x8 a = *(const LAS bf16x8*)(Vt + (g * 64 + tc * 32 + r) * 272 + (ks * 16 + 8 * h) * 2);
                const bf16x8 b = *(const bf16x8*)(Ws + ((size_t)g * 128 + t) * 128 + ks * 16 + 8 * h);
                acc = MFMA32(a, b, acc); }
            const float bias = sb[g * 128 + t];
#pragma unroll
            for (int qq = 0; qq < 4; ++qq) { const int c0 = g * 64 + tc * 32 + 8 * qq + 4 * h;
                const u32x2 u = *(const u32x2*)(Z + (size_t)(row0 + t) * NZ + ZC_UV + c0);
                u32x2 w; w.x = pk2(bflo(u.x) * (acc[4 * qq] + bias), bfhi(u.x) * (acc[4 * qq + 1] + bias)); w.y = pk2(bflo(u.y) * (acc[4 * qq + 2] + bias), bfhi(u.y) * (acc[4 * qq + 3] + bias));
                *(u32x2*)(BRA + (size_t)(row0 + t) * D + 768 + c0) = w; } }
        __syncthreads();
    }
}
__device__ __forceinline__ void qk_conv_pass(Frame& F, int l) {
    const bf16_t* Z = (const bf16_t*)(F.ws + WS_Z); bf16_t* QKC = (bf16_t*)(F.ws + WS_H);
    const int chunk = F.tid & 127, rsub = F.tid >> 7, ch0 = chunk * 8;
    float w0[8], w1[8], w2[8], cbv[8];
    { const float* cw = F.in[IN_CONVW] + (size_t)l * 3 * 1024 + ch0; const float* cb = F.in[IN_CONVB] + (size_t)l * 1024 + ch0;
#pragma unroll
      for (int e = 0; e < 8; ++e) { w0[e] = cw[e]; w1[e] = cw[1024 + e]; w2[e] = cw[2048 + e]; cbv[e] = cb[e]; } }
    const float scale = chunk >= 64 ? 0.08838834764831845f : 1.0f;
    for (int row = F.bid * 4 + rsub; row < MT; row += F.G * 4) {
        const int p = row < ML ? (row & 4095) : ((row - ML) & 255), len = row < ML ? 4096 : 256;
        const bf16_t* zr = Z + (size_t)row * NZ + ZC_QK + ch0;
        const u32x4 x1 = *(const u32x4*)zr; u32x4 x0 = (u32x4){0u, 0u, 0u, 0u}, x2 = (u32x4){0u, 0u, 0u, 0u};
        if (p > 0) x0 = *(const u32x4*)(zr - NZ);
        if (p + 1 < len) x2 = *(const u32x4*)(zr + NZ);
        const unsigned xa[4] = {x0.x, x0.y, x0.z, x0.w}, xb[4] = {x1.x, x1.y, x1.z, x1.w}, xc[4] = {x2.x, x2.y, x2.z, x2.w};
        float y[8];
#pragma unroll
        for (int e2 = 0; e2 < 4; ++e2) { y[2 * e2] = cbv[2 * e2] + w0[2 * e2] * bflo(xa[e2]) + w1[2 * e2] * bflo(xb[e2]) + w2[2 * e2] * bflo(xc[e2]);
            y[2 * e2 + 1] = cbv[2 * e2 + 1] + w0[2 * e2 + 1] * bfhi(xa[e2]) + w1[2 * e2 + 1] * bfhi(xb[e2]) + w2[2 * e2 + 1] * bfhi(xc[e2]); }
#pragma unroll
        for (int e = 0; e < 8; ++e) y[e] = siluf_(y[e]) * scale;
        u32x4 w; w.x = pk2(y[0], y[1]); w.y = pk2(y[2], y[3]); w.z = pk2(y[4], y[5]); w.w = pk2(y[6], y[7]);
        *(u32x4*)(QKC + (size_t)row * D + ch0) = w;
    }
}
constexpr int ML_QS = 0, ML_KS = 34816, ML_KW = 69632, ML_VT = 104448, ML_CB = 126208, ML_SC = 147968, ML_SCSZ = 2624;
__device__ __forceinline__ float logsigf_(float x) { return fminf(x, 0.f) - __logf(1.0f + __expf(-fabsf(x))); }
__device__ __forceinline__ unsigned swap16(unsigned u) { return __builtin_amdgcn_alignbit(u, u, 16); }
struct MlPre { u32x4 qk[8]; u32x2 v[4]; float g[4]; };
__device__ __forceinline__ void ml_geom(int j, int b, int dir, int& seqbase, int& seqlen, int& pbase) {
    const bool is_ctx = j < 2; int cj = is_ctx ? j : j - 2; const int ncs = is_ctx ? 2 : 32; if (dir) cj = ncs - 1 - cj;
    seqbase = is_ctx ? ML + b * 256 : b * 4096; seqlen = is_ctx ? 256 : 4096; pbase = cj * 128; }
#define ML_BAR() do { asm volatile("s_waitcnt lgkmcnt(0)" ::: "memory"); __builtin_amdgcn_s_barrier(); asm volatile("" ::: "memory"); } while (0)
__device__ __forceinline__ void mlstm_unit(Frame& F, int l, int unit) {
    const int bh = (unit & 7) + 8 * (unit >> 5), sub = (unit >> 3) & 3;
    const int b = bh >> 2, head = bh & 3, dir = sub >> 1, vh = sub & 1;
    LAS unsigned char* QS = F.lds + ML_QS; LAS unsigned char* KS = F.lds + ML_KS; LAS unsigned char* KW = F.lds + ML_KW; LAS unsigned char* VT = F.lds + ML_VT; LAS unsigned char* CB = F.lds + ML_CB;
    const bf16_t* Z = (const bf16_t*)(F.ws + WS_Z); const float* ZG = (const float*)(F.ws + WS_ZG); const bf16_t* QKC = (const bf16_t*)(F.ws + WS_H);
    bf16_t* HF = (bf16_t*)(F.ws + WS_HFB) + (size_t)dir * MT * 512;
    const int wave = F.wave;
    int tl = F.tid;
#define ML_ROLES() const int lane = tl & 63, fr = lane & 15, q4 = lane >> 4; const int isk = (tl >> 4) & 1, ck = tl & 15, i0 = 8 * (tl >> 5), chn = (isk ? 512 : 0) + head * 128 + ck * 8; \
    const int vi0 = 4 * (tl >> 4), vcq = tl & 15, vch = head * 128 + vh * 64 + vcq * 4; (void)fr; (void)q4; (void)vi0; (void)vcq; (void)vch; (void)i0; (void)chn; (void)ck; (void)isk;
    for (int idx = F.tid; idx < 16 * 136; idx += NTHREADS) *(LAS bf16_t*)(VT + (64 + idx / 136) * 272 + (idx % 136) * 2) = (idx < 136) ? (bf16_t)0x3F80 : (bf16_t)0;
    f32x4 cs[5];
#pragma unroll
    for (int vt = 0; vt < 5; ++vt) cs[vt] = (f32x4){0.f, 0.f, 0.f, 0.f};
    float m_state = 0.f;
    MlPre pre;
#define ML_PREFETCH(jj) do { int sb_, sl_, pb_; ml_geom((jj), b, dir, sb_, sl_, pb_); \
        { const int pmin = dir ? pb_ + 120 - i0 : pb_ + i0; const bf16_t* zr = QKC + (size_t)(sb_ + pmin) * D + chn; (void)sl_; \
          _Pragma("unroll") for (int k = 0; k < 8; ++k) pre.qk[k] = *(const u32x4*)(zr + (size_t)k * D); } \
        { const int pminv = dir ? pb_ + 124 - vi0 : pb_ + vi0; const bf16_t* zv = Z + (size_t)(sb_ + pminv) * NZ + ZC_V + vch; \
          _Pragma("unroll") for (int k = 0; k < 4; ++k) pre.v[k] = *(const u32x2*)(zv + (size_t)k * NZ); } \
        if (wave == 0) { const int p0 = dir ? pb_ + 127 - 2 * lane : pb_ + 2 * lane, p1 = dir ? p0 - 1 : p0 + 1; \
          pre.g[0] = ZG[(size_t)(sb_ + p0) * 16 + dir * 8 + head]; pre.g[1] = ZG[(size_t)(sb_ + p0) * 16 + dir * 8 + 4 + head]; \
          pre.g[2] = ZG[(size_t)(sb_ + p1) * 16 + dir * 8 + head]; pre.g[3] = ZG[(size_t)(sb_ + p1) * 16 + dir * 8 + 4 + head]; } } while (0)
#define ML_STEPA(sbuf) do { LAS float* sg_ = (LAS float*)(F.lds + ML_SC + (sbuf) * ML_SCSZ); const int i0g = 2 * lane, i1g = i0g + 1; \
        const float gi0 = pre.g[0], gf0 = pre.g[1], gi1 = pre.g[2], gf1 = pre.g[3]; \
        const float lf0 = logsigf_(gf0), lf1 = logsigf_(gf1); const float s1 = lf0 + lf1; float incl = s1; \
        _Pragma("unroll") for (int o = 1; o < 64; o <<= 1) { const float y_ = shup(incl, o, lane); incl += (lane >= o) ? y_ : 0.f; } \
        const float excl = incl - s1, bc0 = excl + lf0, bc1 = excl + s1; \
        const float g0 = gi0 - bc0, g1 = gi1 - bc1; const float mx1 = fmaxf(g0, g1); float im = mx1; \
        _Pragma("unroll") for (int o = 1; o < 64; o <<= 1) { const float y_ = shup(im, o, lane); im = (lane >= o) ? fmaxf(im, y_) : im; } \
        float em = shup(im, 1, lane); em = (lane == 0) ? -3.0e38f : em; \
        const float M0 = fmaxf(m_state, fmaxf(em, g0)), M1 = fmaxf(m_state, fmaxf(em, mx1)); \
        const float total = bperm(63, bc1), Mlast = bperm(63, M1); \
        sg_[i0g] = g0; sg_[i1g] = g1; sg_[128 + i0g] = M0; sg_[128 + i1g] = M1; \
        sg_[256 + i0g] = __expf(m_state - M0); sg_[256 + i1g] = __expf(m_state - M1); \
        sg_[384 + i0g] = __expf(-(bc0 + M0)); sg_[384 + i1g] = __expf(-(bc1 + M1)); \
        sg_[512 + i0g] = __expf(g0 - Mlast); sg_[512 + i1g] = __expf(g1 - Mlast); \
        if (lane == 0) sg_[640] = __expf(m_state - Mlast); \
        m_state = total + Mlast; } while (0)
    { ML_ROLES(); ML_PREFETCH(0); if (wave == 0) ML_STEPA(0); }
    ML_BAR();
#pragma unroll 1
    for (int j = 0; j < 34; ++j) {
        asm volatile("" : "+v"(tl));
        ML_ROLES();
        int seqbase, seqlen, pbase; ml_geom(j, b, dir, seqbase, seqlen, pbase);
        const LAS float* sc_g = (const LAS float*)(F.lds + ML_SC + (j & 1) * ML_SCSZ); const LAS float* sc_M = sc_g + 128; const LAS float* sc_dec = sc_g + 256; const LAS float* sc_emt = sc_g + 384; const LAS float* sc_wk = sc_g + 512;
        {
#pragma unroll
          for (int k = 0; k < 8; ++k) { const int i = dir ? i0 + 7 - k : i0 + k; *(LAS u32x4*)((isk ? KS : QS) + i * 272 + ck * 16) = pre.qk[k]; }
          if (isk) { u32x4 kt[8]; float ykeep[8];
#pragma unroll
              for (int e = 0; e < 8; ++e) { kt[e] = (u32x4){0u, 0u, 0u, 0u}; ykeep[e] = 0.f; }
#pragma unroll
              for (int k = 0; k < 8; ++k) { const int i = dir ? i0 + 7 - k : i0 + k; const float wk = sc_wk[i];
                  const unsigned xb[4] = {pre.qk[k].x, pre.qk[k].y, pre.qk[k].z, pre.qk[k].w};
#pragma unroll
                  for (int e = 0; e < 8; ++e) { const float yw = ((e & 1) ? bfhi(xb[e >> 1]) : bflo(xb[e >> 1])) * wk;
                      if (k & 1) { const unsigned pw_ = pk2(ykeep[e], yw); if ((k >> 1) == 0) kt[e].x = pw_; else if ((k >> 1) == 1) kt[e].y = pw_; else if ((k >> 1) == 2) kt[e].z = pw_; else kt[e].w = pw_; }
                      else ykeep[e] = yw; } }
#pragma unroll
              for (int e = 0; e < 8; ++e) { u32x4 o = kt[e]; if (dir) o = (u32x4){swap16(kt[e].w), swap16(kt[e].z), swap16(kt[e].y), swap16(kt[e].x)};
                  *(LAS u32x4*)(KW + (ck * 8 + e) * 272 + (((i0 >> 3) ^ (ck & 7)) * 16)) = o; } } }
        { unsigned vv[4][2];
#pragma unroll
          for (int k = 0; k < 4; ++k) { vv[k][0] = pre.v[k].x; vv[k][1] = pre.v[k].y; }
#pragma unroll
          for (int c = 0; c < 4; ++c) {
              unsigned h0 = (c & 1) ? (vv[0][c >> 1] >> 16) : (vv[0][c >> 1] & 0xffffu), h1 = (c & 1) ? (vv[1][c >> 1] >> 16) : (vv[1][c >> 1] & 0xffffu);
              unsigned h2 = (c & 1) ? (vv[2][c >> 1] >> 16) : (vv[2][c >> 1] & 0xffffu), h3 = (c & 1) ? (vv[3][c >> 1] >> 16) : (vv[3][c >> 1] & 0xffffu);
              u32x2 o; if (dir) { o.x = h3 | (h2 << 16); o.y = h1 | (h0 << 16); } else { o.x = h0 | (h1 << 16); o.y = h2 | (h3 << 16); }
              *(LAS u32x2*)(VT + (vcq * 4 + c) * 272 + vi0 * 2) = o; } }
#pragma unroll
        for (int vt = 0; vt < 5; ++vt)
#pragma unroll
            for (int rr = 0; rr < 4; rr += 2) { const unsigned pw_ = pk2(cs[vt][rr], cs[vt][rr + 1]);
                *(LAS bf16_t*)(CB + (16 * vt + 4 * q4 + rr) * 272 + (16 * wave + fr) * 2) = (bf16_t)(pw_ & 0xffffu); *(LAS bf16_t*)(CB + (16 * vt + 4 * q4 + rr + 1) * 272 + (16 * wave + fr) * 2) = (bf16_t)(pw_ >> 16); }
        ML_BAR();
        if (j + 1 < 34) ML_PREFETCH(j + 1);
        const int t = 16 * wave + fr;
        bf16x8 qf[4];
#pragma unroll
        for (int kc = 0; kc < 4; ++kc) qf[kc] = *(const LAS bf16x8*)(QS + t * 272 + (32 * kc + 8 * q4) * 2);
        const float Mt_t = sc_M[t], dec_t = sc_dec[t], emt_t = sc_emt[t];
        f32x4 ps[8];
#pragma unroll
        for (int jp = 0; jp < 4; ++jp) {
            ps[2 * jp] = (f32x4){0.f, 0.f, 0.f, 0.f}; ps[2 * jp + 1] = (f32x4){0.f, 0.f, 0.f, 0.f};
            if (2 * jp <= wave) {
                bf16x8 ka[4], kb[4];
#pragma unroll
                for (int kc = 0; kc < 4; ++kc) { ka[kc] = *(const LAS bf16x8*)(KS + (32 * jp + fr) * 272 + (32 * kc + 8 * q4) * 2); kb[kc] = *(const LAS bf16x8*)(KS + (32 * jp + 16 + fr) * 272 + (32 * kc + 8 * q4) * 2); }
                const f32x4 ga4 = *(const LAS f32x4*)(sc_g + 32 * jp + 4 * q4), gb4 = *(const LAS f32x4*)(sc_g + 32 * jp + 16 + 4 * q4);
                f32x4 acc0 = (f32x4){0.f, 0.f, 0.f, 0.f}, acc1 = (f32x4){0.f, 0.f, 0.f, 0.f};
#pragma unroll
                for (int kc = 0; kc < 4; ++kc) { acc0 = MFMA16(ka[kc], qf[kc], acc0); acc1 = MFMA16(kb[kc], qf[kc], acc1); }
#pragma unroll
                for (int rr = 0; rr < 4; ++rr) { const int s0 = 32 * jp + 4 * q4 + rr, s1 = s0 + 16;
                    ps[2 * jp][rr] = (s0 <= t) ? acc0[rr] * __expf(ga4[rr] - Mt_t) : 0.f; ps[2 * jp + 1][rr] = (s1 <= t) ? acc1[rr] * __expf(gb4[rr] - Mt_t) : 0.f; }
            }
        }
        f32x4 ao[5];
        {
#pragma unroll
          for (int vt = 0; vt < 5; ++vt) ao[vt] = (f32x4){0.f, 0.f, 0.f, 0.f};
#pragma unroll
          for (int kh = 0; kh < 4; kh += 2) { bf16x8 cf[2][5];
#pragma unroll
              for (int k2 = 0; k2 < 2; ++k2)
#pragma unroll
                  for (int vt = 0; vt < 5; ++vt) cf[k2][vt] = *(const LAS bf16x8*)(CB + (16 * vt + fr) * 272 + (32 * (kh + k2) + 8 * q4) * 2);
#pragma unroll
              for (int k2 = 0; k2 < 2; ++k2)
#pragma unroll
                  for (int vt = 0; vt < 5; ++vt) ao[vt] = MFMA16(cf[k2][vt], qf[kh + k2], ao[vt]); }
#pragma unroll
          for (int vt = 0; vt < 5; ++vt) ao[vt] = ao[vt] * dec_t; }
#pragma unroll
        for (int ks = 0; ks < 4; ++ks) {
            if (2 * ks <= wave) {
                s16x4 vlo[5], vhi[5];
#pragma unroll
                for (int vt = 0; vt < 5; ++vt) { vlo[vt] = *(const LAS s16x4*)(VT + (16 * vt + fr) * 272 + (32 * ks + 4 * q4) * 2); vhi[vt] = *(const LAS s16x4*)(VT + (16 * vt + fr) * 272 + (32 * ks + 16 + 4 * q4) * 2); }
                u32x4 pw; pw.x = cvt_pk_bf16(ps[2 * ks][0], ps[2 * ks][1]); pw.y = cvt_pk_bf16(ps[2 * ks][2], ps[2 * ks][3]); pw.z = cvt_pk_bf16(ps[2 * ks + 1][0], ps[2 * ks + 1][1]); pw.w = cvt_pk_bf16(ps[2 * ks + 1][2], ps[2 * ks + 1][3]);
                const bf16x8 pf = __builtin_bit_cast(bf16x8, pw);
#pragma unroll
                for (int vt = 0; vt < 5; ++vt) { const bf16x8 a = __builtin_shufflevector(vlo[vt], vhi[vt], 0, 1, 2, 3, 4, 5, 6, 7); ao[vt] = MFMA16(a, pf, ao[vt]); }
            }
        }
        { const float den = bperm(fr, ao[4][0]); const float inv = 1.0f / fmaxf(fabsf(den), emt_t);
          const int p = dir ? pbase + 127 - t : pbase + t; bf16_t* orow = HF + (size_t)(seqbase + p) * 512 + head * 128 + vh * 64 + 4 * q4;
#pragma unroll
          for (int vt = 0; vt < 4; ++vt) { const f32x4 o = ao[vt] * inv; u32x2 w; w.x = cvt_pk_bf16(o[0], o[1]); w.y = cvt_pk_bf16(o[2], o[3]); *(u32x2*)(orow + 16 * vt) = w; } }
        { const float a_s = sc_g[640];
#pragma unroll
          for (int vt = 0; vt < 5; ++vt) cs[vt] = cs[vt] * a_s;
#pragma unroll
          for (int ks = 0; ks < 4; ks += 2) { bf16x8 bb[2], va[2][5];
#pragma unroll
              for (int k2 = 0; k2 < 2; ++k2) { bb[k2] = *(const LAS bf16x8*)(KW + (16 * wave + fr) * 272 + (((4 * (ks + k2) + q4) ^ (((16 * wave + fr) >> 3) & 7)) * 16));
#pragma unroll
                  for (int vt = 0; vt < 5; ++vt) va[k2][vt] = *(const LAS bf16x8*)(VT + (16 * vt + fr) * 272 + (32 * (ks + k2) + 8 * q4) * 2); }
#pragma unroll
              for (int k2 = 0; k2 < 2; ++k2)
#pragma unroll
                  for (int vt = 0; vt < 5; ++vt) cs[vt] = MFMA16(va[k2][vt], bb[k2], cs[vt]); } }
        if (wave == 0 && j + 1 < 34) ML_STEPA((j + 1) & 1);
        ML_BAR();
    }
#undef ML_PREFETCH
#undef ML_STEPA
#undef ML_ROLES
    __syncthreads();
}
__device__ __forceinline__ void phase_mixers(Frame& F, int l) {
    const bool with_ctx = (l != DEPTH - 1);
#ifndef MIX_MASK
#define MIX_MASK 7
#endif
#ifndef MIXREP
#define MIXREP 0
#endif
    if (MIX_MASK & 1) pool_tiles(F, l, with_ctx);
    if (MIXREP & 1) { __syncthreads(); pool_tiles(F, l, with_ctx); }
    if (MIX_MASK & 2) sgu_chunks(F, l, with_ctx);
    if (MIXREP & 2) { __syncthreads(); sgu_chunks(F, l, with_ctx); }
    (void)0;
    qk_conv_pass(F, l);
}
__device__ __forceinline__ void phase_mlstm(Frame& F, int l) {
    for (int u = F.bid; u < 256; u += F.G) mlstm_unit(F, l, u);
}

struct Args { const float* in[31]; float* out; unsigned char* ws; int g_lo, g_hi, pad0, pad1; };
constexpr int NPH = 11, NGID = 2 + DEPTH * NPH;
__global__ void __launch_bounds__(NTHREADS, 2) fwd_kernel(Args args) {
    extern __shared__ __attribute__((aligned(16))) unsigned char lds_raw[];
    Frame F;
    F.lds = (LAS unsigned char*)lds_raw; F.MISC = (volatile LAS unsigned*)(F.lds + MISC_OFF);
    F.tid = threadIdx.x; F.lane = F.tid & 63; F.wave = __builtin_amdgcn_readfirstlane(F.tid >> 6); F.G = gridDim.x; F.bid = blockIdx.x;
    F.ws = args.ws; F.out = args.out;
    F.in = (InTab)__builtin_amdgcn_kernarg_segment_ptr();
    if (F.tid < 64) F.MISC[F.tid] = 0u;
    __syncthreads();
    const int lo = args.g_lo, hi = args.g_hi;
    const bool multi = (hi - lo) > 1;
    XcdBarrier bar; bar.bar = (unsigned*)(F.ws + WS_CTL) + CW_BAR; bar.x = 0; bar.st = nullptr;
    if (multi) bar = xcd_barrier_post((unsigned*)(F.ws + WS_CTL) + CW_BAR, F.MISC + 8);
#ifndef PHASE_MASK
#define PHASE_MASK 0xFFFF
#endif
#define RUN(g) (lo <= (g) && (g) < hi)
#define RUNP(ty, g) ((((PHASE_MASK) >> (ty)) & 1) && RUN(g))
#ifndef REPEAT_MASK
#define REPEAT_MASK 0
#endif
#define NREP(ty) ((((REPEAT_MASK) >> (ty)) & 1) ? 2 : 1)
#define SEAM(g) do { if (RUN((g) + 1)) xcd_barrier(bar); } while (0)
#define LAUNDER(P) Frame P = F; { int t_; asm volatile("v_mbcnt_lo_u32_b32 %0, -1, 0\n\tv_mbcnt_hi_u32_b32 %0, -1, %0" : "=v"(t_)); t_ |= (F.wave << 6); P.tid = t_; P.lane = t_ & 63; P.wave = __builtin_amdgcn_readfirstlane(t_ >> 6); GAS unsigned char* w_ = (GAS unsigned char*)F.ws; asm volatile("" : "+s"(w_)); P.ws = (unsigned char*)w_; InTab t2_ = F.in; asm volatile("" : "+s"(t2_)); P.in = t2_; }
    if (RUNP(0, 0)) { LAUNDER(P); for (int rep_ = 0; rep_ < NREP(0); ++rep_) { phase_prologue(P); __syncthreads(); } SEAM(0); }
    if (RUNP(1, 1)) { LAUNDER(P); for (int rep_ = 0; rep_ < NREP(1); ++rep_) { phase_ln0_first(P); __syncthreads(); } SEAM(1); }
#pragma unroll 1
    for (int l = 0; l < DEPTH; ++l) {
        const int g0 = 2 + l * NPH;
        const int mrows = (l == DEPTH - 1) ? ML : MT;
        if (RUNP(2, g0 + 0)) {
#undef PHTY
#define PHTY 2
            LAUNDER(P);
            { ProbPlain Pr{(const bf16_t*)(P.ws + WS_H), (const bf16_t*)(P.ws + WS_WIN) + (size_t)l * NZ * D, D, D};
              pg8::StaticOrder<1> S; S.init(MT / 256, NZ_BF / 256, P.G, P.bid);
              EpiInproj<false> E{(bf16_t*)(P.ws + WS_Z), P.in[IN_BIN] + (size_t)l * 5904, 0};
              pg8::gemm_phase(P.lds, P.tid, Pr, S, E); }
            __syncthreads();
            { ProbPlainF8 Pr{(const bf16_t*)(P.ws + WS_H8), (const bf16_t*)(P.ws + WS_WIN8 + (size_t)l * NZ_F8 * D), D / 2, D / 2};
              pg8::StaticOrder<1> S; S.init(MT / 256, NZ_F8 / 256, P.G, P.bid);
              EpiInproj<true> E{(bf16_t*)(P.ws + WS_Z), P.in[IN_BIN] + (size_t)l * 5904, NZ_BF / 256};
              pg8::gemm_phase(P.lds, P.tid, Pr, S, E); }
            SEAM(g0 + 0);
        }
        if (RUNP(3, g0 + 1)) { LAUNDER(P); for (int rep_ = 0; rep_ < NREP(3); ++rep_) { phase_mixers(P, l); __syncthreads(); } SEAM(g0 + 1); }
        if (RUNP(12, g0 + 2)) { LAUNDER(P); for (int rep_ = 0; rep_ < NREP(12); ++rep_) { phase_mlstm(P, l); __syncthreads(); } SEAM(g0 + 2); }
        if (RUNP(4, g0 + 3)) { LAUNDER(P); for (int rep_ = 0; rep_ < NREP(4); ++rep_) phase_finalize(P, l, mrows); SEAM(g0 + 3); }
        if (RUNP(5, g0 + 4)) {
#undef PHTY
#define PHTY 5
            LAUNDER(P);
            ProbPlain Pr{(const bf16_t*)(P.ws + WS_BRA), (const bf16_t*)(P.ws + WS_WBR) + (size_t)l * D * D, D, D};
            pg8::StaticOrder<1> S; S.init(mrows / 256, 4, P.G, P.bid);
            EpiBranch E{(const bf16_t*)(P.ws + WS_Z), (bf16_t*)(P.ws + WS_Y)};
            pg8::gemm_phase(P.lds, P.tid, Pr, S, E); if (NREP(PHTY) == 2) { __syncthreads(); pg8::gemm_phase(P.lds, P.tid, Pr, S, E); }
            SEAM(g0 + 4);
        }
        if (RUNP(6, g0 + 5)) {
#undef PHTY
#define PHTY 6
            LAUNDER(P);
            ProbPlain Pr{(const bf16_t*)(P.ws + WS_Y), (const bf16_t*)(P.ws + WS_WOUT) + (size_t)l * D * D, D, D};
            pg8::StaticOrder<1> S; S.init(mrows / 256, 4, P.G, P.bid);
            EpiOut E{(bf16_t*)(P.ws + WS_T)};
            pg8::gemm_phase(P.lds, P.tid, Pr, S, E); if (NREP(PHTY) == 2) { __syncthreads(); pg8::gemm_phase(P.lds, P.tid, Pr, S, E); }
            SEAM(g0 + 5);
        }
        if (RUNP(7, g0 + 6)) { LAUNDER(P); for (int rep_ = 0; rep_ < NREP(7); ++rep_) phase_ln1_router(P, l, mrows); SEAM(g0 + 6); }
        if (RUNP(8, g0 + 7)) { LAUNDER(P); for (int rep_ = 0; rep_ < NREP(8); ++rep_) phase_slots(P, mrows); SEAM(g0 + 7); }
        if (RUNP(9, g0 + 8)) {
#undef PHTY
#define PHTY 9
            LAUNDER(P);
            LAS int* seg = (LAS int*)(P.lds + TAB_OFF);
            const int ntile = moe_tables(P, seg);
            ProbMoe1 Pr{(const bf16_t*)(P.ws + WS_H2F8), (const bf16_t*)(P.ws + WS_WGU + (size_t)l * NEXP * 2048 * D), D / 2, D / 2, (const int*)(P.ws + WS_ROUTE + RT_TOK), seg};
            pg8::StaticOrder<1> S; S.init(ntile, 8, P.G, P.bid);
            EpiSwiglu E{(unsigned char*)(P.ws + WS_HID), P.in[IN_BGU] + (size_t)l * NEXP * 2048, seg};
            pg8::gemm_phase(P.lds, P.tid, Pr, S, E); if (NREP(PHTY) == 2) { __syncthreads(); pg8::gemm_phase(P.lds, P.tid, Pr, S, E); }
            SEAM(g0 + 8);
        }
        if (RUNP(10, g0 + 9)) {
#undef PHTY
#define PHTY 10
            LAUNDER(P);
            LAS int* seg = (LAS int*)(P.lds + TAB_OFF);
            const int ntile = moe_tables(P, seg);
            ProbMoe2 Pr{(const bf16_t*)(P.ws + WS_HID), (const bf16_t*)(P.ws + WS_WDN + (size_t)l * NEXP * D * D), D / 2, D / 2, seg};
            pg8::StaticOrder<1> S; S.init(ntile, 4, P.G, P.bid);
            EpiDown E{(unsigned char*)(P.ws + WS_FS), P.in[IN_BDN] + (size_t)l * NEXP * D, (const int*)(P.ws + WS_ROUTE + RT_DEST), (const float*)(P.ws + WS_ROUTE + RT_PSLOT), seg};
            pg8::gemm_phase(P.lds, P.tid, Pr, S, E); if (NREP(PHTY) == 2) { __syncthreads(); pg8::gemm_phase(P.lds, P.tid, Pr, S, E); }
            SEAM(g0 + 9);
        }
        if (RUNP(11, g0 + 10)) { LAUNDER(P); phase_combine_ln2(P, l, mrows); SEAM(g0 + 10); }
    }
#undef LAUNDER
#undef RUN
#undef RUNP
#undef SEAM
}

extern "C" void kernel_launch(void* const* d_in, const int* in_sizes, int n_in, void* d_out, int out_size, void* d_ws, size_t ws_size, hipStream_t stream) {
    static int grid = 0;
    if (grid == 0) {
        if (n_in != 31 || out_size != ML * D || ws_size < WS_END) { fprintf(stderr, "kernel_launch: unexpected problem (n_in %d, out %d, ws %zu, need %zu)\n", n_in, out_size, ws_size, (size_t)WS_END); grid = -1; return; }
        int dev = 0, cus = 0, per_cu = 0;
        if (hipGetDevice(&dev) != hipSuccess || hipDeviceGetAttribute(&cus, hipDeviceAttributeMultiprocessorCount, dev) != hipSuccess) { grid = -1; return; }
        if (hipFuncSetAttribute((const void*)fwd_kernel, hipFuncAttributeMaxDynamicSharedMemorySize, LDS_BYTES) != hipSuccess) { fprintf(stderr, "kernel_launch: hipFuncSetAttribute failed\n"); grid = -1; return; }
        if (hipOccupancyMaxActiveBlocksPerMultiprocessor(&per_cu, (const void*)fwd_kernel, NTHREADS, LDS_BYTES) != hipSuccess || per_cu < 1) fprintf(stderr, "kernel_launch: occupancy query reports %d\n", per_cu);
        (void)hipGetLastError();
        grid = cus;
    }
    if (grid < 0) return;
    (void)hipMemsetAsync((char*)d_ws + WS_CTL, 0, CTL_ZERO_BYTES, stream);
    Args a{};
    for (int i = 0; i < 31; ++i) a.in[i] = (const float*)d_in[i];
    a.out = (float*)d_out; a.ws = (unsigned char*)d_ws;
#if MK_N_LAUNCHES == 1
    a.g_lo = 0; a.g_hi = NGID;
    hipLaunchKernelGGL(fwd_kernel, dim3(grid), dim3(NTHREADS), LDS_BYTES, stream, a);
#else
    for (int g = 0; g < NGID; ++g) { a.g_lo = g; a.g_hi = g + 1; hipLaunchKernelGGL(fwd_kernel, dim3(grid), dim3(NTHREADS), LDS_BYTES, stream, a); }
#endif
}
```

```cpp
#include <hip/hip_runtime.h>
#include <cstdio>
#include <cstdint>

#ifndef MK_N_LAUNCHES
#define MK_N_LAUNCHES 1
#endif

#define LAS __attribute__((address_space(3)))
#define GAS __attribute__((address_space(1)))
typedef unsigned short bf16_t;
typedef short bf16x8 __attribute__((ext_vector_type(8)));
typedef short s16x4 __attribute__((ext_vector_type(4)));
typedef float f32x4 __attribute__((ext_vector_type(4)));
typedef float f32x2 __attribute__((ext_vector_type(2)));
typedef float f32x16 __attribute__((ext_vector_type(16)));
typedef unsigned u32x4 __attribute__((ext_vector_type(4)));
typedef unsigned u32x2 __attribute__((ext_vector_type(2)));
typedef int i32x4 __attribute__((ext_vector_type(4)));
typedef int i32x8 __attribute__((ext_vector_type(8)));

constexpr int D = 1024, NB = 16, SEQ = 4096, CTXL = 256, DEPTH = 4;
constexpr int ML = NB * SEQ;
constexpr int MC = NB * CTXL;
constexpr int MT = ML + MC;
constexpr int NZ = 5888;
constexpr int ZC_P = 0, ZC_QK = 256, ZC_V = 1280, ZC_O = 1792, ZC_UV = 2304, ZC_MG = 2816;
constexpr int NZ_BF = 1792, NZ_F8 = 4096;
constexpr int ZG_COL = 2816;
constexpr int NEXP = 32, TOPK = 4;
constexpr int NS_MAX = MT * TOPK + NEXP * 256;
constexpr float LN_EPS = 1e-5f, HEAD_EPS = 1e-6f;
constexpr float DN_ALPHA = 1.6817928305074292f;
constexpr int NWAVES = 8, NTHREADS = 512;
constexpr float F8S_ACT = 4.0f, F8S_WGU = 64.0f, F8S_WDN = 64.0f; constexpr int F8E_ACT = 123, F8E_WGU = 123, F8E_WDN = 123;

constexpr size_t MiB = 1u << 20;
constexpr size_t WS_CTL = 0, CTL_ZERO_BYTES = 1 * MiB;
constexpr size_t WS_MOD = 1 * MiB;
constexpr size_t WS_WG = 3 * MiB;
constexpr size_t WS_WSGU = 4 * MiB;
constexpr size_t WS_WPOOL = WS_WSGU + 512 * 1024;
constexpr size_t WS_ROUTE = 5 * MiB;
constexpr size_t WS_WIN = 16 * MiB;
constexpr size_t WS_WBR = 62 * MiB;
constexpr size_t WS_WOUT = 70 * MiB;
constexpr size_t WS_WGU = 78 * MiB;
constexpr size_t WS_WDN = 590 * MiB;
constexpr size_t WS_X = 846 * MiB;
constexpr size_t WS_H = 1118 * MiB;
constexpr size_t WS_Z = 1254 * MiB;
constexpr size_t WS_FS = WS_Z;
constexpr float G8_SCALE = 255.0f;
constexpr float FS_SCALE = 32.0f, FS_CLAMP = 440.0f;
constexpr size_t WS_BRA = 2036 * MiB;
constexpr size_t WS_HFB = 2172 * MiB;
constexpr size_t WS_Y = 2444 * MiB;
constexpr size_t WS_T = 2580 * MiB;
constexpr size_t WS_H2 = 2852 * MiB;
constexpr size_t WS_HID = 2988 * MiB;
constexpr size_t WS_ZG = 3548 * MiB;
constexpr size_t WS_H2F8 = 3554 * MiB;
constexpr size_t WS_H8 = 3624 * MiB;
constexpr size_t WS_WIN8 = 3692 * MiB;
constexpr size_t WS_END = 3708 * MiB;
static_assert(WS_Z + (size_t)MT * NZ * 2 <= WS_BRA && WS_FS + (size_t)MT * 4 * 1024 * 2 <= WS_BRA, "Z/FS");
static_assert(WS_HID + (size_t)NS_MAX * 1024 * 2 <= WS_END, "HID");
constexpr size_t RT_EIDX = 0;
constexpr size_t RT_PROB = 2 * MiB;
constexpr size_t RT_TOK = 4 * MiB;
constexpr size_t RT_DEST = 6 * MiB;
constexpr size_t RT_PSLOT = 8 * MiB;
constexpr size_t RT_CNT = 10 * MiB;
constexpr size_t RT_SEG = 10 * MiB + 64 * 1024;
constexpr int CW_BAR = 4096;

constexpr int LDS_BYTES = 163840;
constexpr int MISC_OFF = LDS_BYTES - 256;
constexpr int TAB_OFF = 131072;
constexpr int NW_WT = 0;
constexpr int NW_LG = 66048;
constexpr int NW_END = 99840;
constexpr int NW_PV = NW_END + 256;

__device__ __forceinline__ unsigned f2bf(float f) { unsigned u = __builtin_bit_cast(unsigned, f); return (u + 0x7fffu + ((u >> 16) & 1u)) >> 16; }
__device__ __forceinline__ unsigned pk2(float lo, float hi) { unsigned r; asm volatile("v_cvt_pk_bf16_f32 %0, %1, %2" : "=v"(r) : "v"(lo), "v"(hi)); return r; }
__device__ __forceinline__ unsigned pk4_fp8(float a, float b, float c, float d) { int w = 0; w = __builtin_amdgcn_cvt_pk_fp8_f32(a, b, w, false); w = __builtin_amdgcn_cvt_pk_fp8_f32(c, d, w, true); return (unsigned)w; }
__device__ __forceinline__ unsigned pk4_u8(float a, float b, float c, float d) {
    const unsigned lo = __builtin_amdgcn_perm(__builtin_bit_cast(unsigned, b), __builtin_bit_cast(unsigned, a), 0x0c0c0400u), hi = __builtin_amdgcn_perm(__builtin_bit_cast(unsigned, d), __builtin_bit_cast(unsigned, c), 0x0c0c0400u);
    return lo | (hi << 16); }
__device__ __forceinline__ f32x4 u8x4_f32(unsigned w) { return (f32x4){(float)(w & 0xffu), (float)((w >> 8) & 0xffu), (float)((w >> 16) & 0xffu), (float)(w >> 24)}; }
__device__ __forceinline__ float bflo(unsigned w) { return __builtin_bit_cast(float, w << 16); }
__device__ __forceinline__ float bfhi(unsigned w) { return __builtin_bit_cast(float, w & 0xffff0000u); }
__device__ __forceinline__ float bf1(bf16_t h) { return __builtin_bit_cast(float, ((unsigned)h) << 16); }
__device__ __forceinline__ float bperm(int srclane, float v) { return __builtin_bit_cast(float, __builtin_amdgcn_ds_bpermute(srclane << 2, __builtin_bit_cast(int, v))); }
__device__ __forceinline__ float shx(float v, int o, int lane) { return bperm(lane ^ o, v); }
__device__ __forceinline__ float shup(float v, int o, int lane) { return bperm(lane >= o ? lane - o : lane, v); }
__device__ __forceinline__ float wave_sum(float v, int lane) {
#pragma unroll
    for (int o = 1; o < 64; o <<= 1) v += shx(v, o, lane);
    return v;
}
__device__ __forceinline__ float sigmoidf_(float x) { return __builtin_amdgcn_rcpf(1.0f + __builtin_amdgcn_exp2f(x * -1.4426950408889634f)); }
__device__ __forceinline__ float siluf_(float x) { return x * __builtin_amdgcn_rcpf(1.0f + __builtin_amdgcn_exp2f(x * -1.4426950408889634f)); }
__device__ __forceinline__ f32x4 sigmoid4(f32x4 x) {
    f32x4 t = x * -1.4426950408889634f;
#pragma unroll
    for (int i = 0; i < 4; ++i) t[i] = __builtin_amdgcn_exp2f(t[i]);
    t = t + 1.0f;
#pragma unroll
    for (int i = 0; i < 4; ++i) t[i] = __builtin_amdgcn_rcpf(t[i]);
    return t; }
#define LDS_WAIT() asm volatile("s_waitcnt lgkmcnt(0)" ::: "memory")
#define VM_WAIT() asm volatile("s_waitcnt vmcnt(0)" ::: "memory")

#define XB_TMO      128
#define XB_XCNT(j)  (256  + 64 * (j))
#define XB_XSUB(j)  (1280 + 64 * (j))
#define XB_XGEN(j)  (2304 + 64 * (j))
#define XB_TOP      3328
#define XB_TOPGEN   3392
#define XCD_BAR_WORDS 3456
#define XB_SPIN_CAP (1u << 18)
__device__ __forceinline__ unsigned xb_ld(unsigned* p)              { asm volatile("" : "+v"(p)); return __hip_atomic_load(p, __ATOMIC_RELAXED, __HIP_MEMORY_SCOPE_AGENT); }
__device__ __forceinline__ unsigned xb_add(unsigned* p, unsigned v) { asm volatile("" : "+v"(p), "+v"(v)); return __hip_atomic_fetch_add(p, v, __ATOMIC_RELAXED, __HIP_MEMORY_SCOPE_AGENT); }
__device__ __forceinline__ unsigned xb_xcc_id() { return (unsigned)__builtin_amdgcn_s_getreg((3 << 11) | 20) & 0xFu; }
#define XB_SPIN(cond, bar) do { unsigned _sp = 0; while (cond) { __builtin_amdgcn_s_sleep(1); \
    if ((++_sp & 255u) == 0u) { if (xb_ld(&(bar)[XB_TMO])) break; if (_sp > XB_SPIN_CAP) { atomicAdd(&(bar)[XB_TMO], 1u); break; } } } } while (0)
struct XcdBarrier { unsigned* bar; unsigned x; volatile LAS unsigned* st; };
__device__ __forceinline__ XcdBarrier xcd_barrier_post(unsigned* bar, volatile LAS unsigned* st) {
    XcdBarrier b; b.bar = bar; b.x = xb_xcc_id(); b.st = st;
    if (threadIdx.x == 0) (void)xb_add(&bar[XB_XCNT(b.x)], 1u);
    return b;
}
__device__ __forceinline__ void xcd_barrier_complete(unsigned* bar, unsigned x, unsigned& nloc, unsigned& nx) {
    const unsigned G = gridDim.x * gridDim.y * gridDim.z;
    unsigned sum, cnt, mine, sp = 0u;
    for (;;) {
        sum = 0u; cnt = 0u; mine = 0u;
#pragma unroll
        for (unsigned j = 0; j < 16; ++j) { const unsigned c = xb_ld(&bar[XB_XCNT(j)]); sum += c; cnt += (c > 0u) ? 1u : 0u; mine = (j == x) ? c : mine; }
        if (sum == G) break;
        __builtin_amdgcn_s_sleep(1);
        if ((++sp & 255u) == 0u) { if (xb_ld(&bar[XB_TMO])) break; if (sp > XB_SPIN_CAP) { atomicAdd(&bar[XB_TMO], 1u); break; } }
    }
    nloc = mine > 0u ? mine : 1u; nx = cnt > 0u ? cnt : 1u;
}
__device__ __forceinline__ void xcd_barrier(const XcdBarrier& b) {
    asm volatile("s_waitcnt vmcnt(0)" ::: "memory");
    __syncthreads();
    if (threadIdx.x == 0) {
        unsigned* bar = b.bar;
        __builtin_amdgcn_s_waitcnt(0);
        unsigned nloc = b.st[0], nx = b.st[1];
        if (nloc == 0u) { xcd_barrier_complete(bar, b.x, nloc, nx); b.st[0] = nloc; b.st[1] = nx; }
        const unsigned old = xb_add(&bar[XB_XSUB(b.x)], 1u);
        const unsigned gen = old / nloc;
        if (old + 1u == (gen + 1u) * nloc) {
            __builtin_amdgcn_fence(__ATOMIC_RELEASE, "agent");
            asm volatile("s_waitcnt vmcnt(0)" ::: "memory");
            const unsigned og = xb_add(&bar[XB_TOP], 1u);
            const unsigned tg = og / nx;
            if (og + 1u == (tg + 1u) * nx) xb_add(&bar[XB_TOPGEN], 1u);
            else XB_SPIN(xb_ld(&bar[XB_TOPGEN]) == tg, bar);
            __builtin_amdgcn_fence(__ATOMIC_ACQUIRE, "agent");
            xb_add(&bar[XB_XGEN(b.x)], 1u);
            asm volatile("s_waitcnt vmcnt(0)" ::: "memory");
        } else {
            XB_SPIN(xb_ld(&bar[XB_XGEN(b.x)]) == gen, bar);
            __builtin_amdgcn_fence(__ATOMIC_ACQUIRE, "agent");
            asm volatile("s_waitcnt vmcnt(0)" ::: "memory");
        }
    }
    __syncthreads();
}

namespace pg8 {
constexpr int BM = 256, BK = 64, HALF = 128, HTB = HALF * BK * 2, STAGE_BYTES = 8 * HTB, NXCD = 8, WGM = 8;
__host__ __device__ __forceinline__ int lds_byte(int r, int c) { const int st = (r >> 4) * 2 + (c >> 5), rr = r & 15, cc = c & 31, ob = rr * 64 + cc * 2; return st * 1024 + (ob ^ (((ob >> 9) & 1) << 5)); }
__host__ __device__ __forceinline__ void stage_rc(int b, int& R, int& C) { const int st = b / 1024, sb = b % 1024, swz = sb ^ (((sb >> 9) & 1) << 5); R = (st >> 1) * 16 + swz / 64; C = (st & 1) * 32 + (swz % 64) / 2; }
__host__ __device__ __forceinline__ int perm32(int rho) { const int n = rho >> 4, i = rho & 15; return 8 * (i >> 2) + 4 * n + (i & 3); }
struct Unit { int pm, pn, sub; };
__device__ __forceinline__ unsigned cvt_pk_bf16(float lo, float hi) { unsigned r; asm volatile("v_cvt_pk_bf16_f32 %0, %1, %2" : "=v"(r) : "v"(lo), "v"(hi)); return r; }
__device__ __forceinline__ f32x2 gelu_pk(f32x2 v) {
    const f32x2 av = __builtin_elementwise_abs(v), d = av * 0.2316418882f + 1.0f;
    f32x2 t; t.x = __builtin_amdgcn_rcpf(d.x); t.y = __builtin_amdgcn_rcpf(d.y);
    f32x2 q = t * 0.5307027145f + (-0.7265760135f); q = q * t + 0.7107068705f; q = q * t + (-0.142248368f); q = q * t + 0.127414796f; q = q * t;
    const f32x2 s = (v * v) * (-0.72134752044f);
    f32x2 e; e.x = __builtin_amdgcn_exp2f(s.x); e.y = __builtin_amdgcn_exp2f(s.y);
    const f32x2 m = v * (q * e), r = v - m;
    f32x2 o; o.x = v.x < 0.f ? m.x : r.x; o.y = v.y < 0.f ? m.y : r.y; return o;
}
template <int NSUB = 1> struct StaticOrder {
    int nM, nN, nwg, G, c;
    __device__ void init(int nM_, int nN_, int G_, int c_) { nM = nM_; nN = nN_; nwg = nM * nN; G = G_; c = c_; }
    __device__ bool next(int i, Unit& u) const {
        const int it = i / NSUB; u.sub = i - it * NSUB;
        const long L = (long)it * G + c; if (L >= nwg) return false;
        int wgid = (int)L; { const int q = nwg / NXCD, r = nwg % NXCD, xcd = wgid % NXCD, off = wgid / NXCD; wgid = (xcd < r ? xcd * (q + 1) : r * (q + 1) + (xcd - r) * q) + off; }
        const int nig = WGM * nN, gid = wgid / nig, fm = gid * WGM, gsz = (nM - fm) < WGM ? (nM - fm) : WGM;
        u.pm = fm + ((wgid % nig) % gsz); u.pn = (wgid % nig) / gsz; return true;
    }
};
constexpr int SIDE_TOK = 131072 + 2048;
constexpr int SIDE_SLOT = 131072 + 10240, SIDE_SLOT_BYTES = 3072;
__device__ __forceinline__ void dma16(unsigned voff, const void* sbase, unsigned ldsaddr) { asm volatile("s_mov_b32 m0, %2\n\tglobal_load_lds_dwordx4 %0, %1" :: "v"(voff), "s"(sbase), "s"(ldsaddr) : "memory", "m0"); }
__device__ __forceinline__ void dma4(unsigned voff, const void* sbase, unsigned ldsaddr) { asm volatile("s_mov_b32 m0, %2\n\tglobal_load_lds_dword %0, %1" :: "v"(voff), "s"(sbase), "s"(ldsaddr) : "memory", "m0"); }
template <class Prob, class Sched, class Epi>
__device__ __forceinline__ void gemm_phase(LAS unsigned char* lds, const int tid, const Prob& P, const Sched& S, const Epi& E) {
    const int wid = __builtin_amdgcn_readfirstlane(tid >> 6), lane = tid & 63, wr = wid >> 2, wc = wid & 3, fr = lane & 15, fq = lane >> 4;
    const int lda = P.lda, ldb = P.ldb;
    unsigned voffB[2], offA[2][2];
#define PG8_TOKSLOT(name) const LAS int* name; { PG8_TID(tl2_); name = (const LAS int*)(lds + SIDE_TOK) + (tl2_ >> 6) * 256 + (tl2_ & 63); }
#define PG8_TID(v_) int v_; asm volatile("v_mbcnt_lo_u32_b32 %0, -1, 0\n\tv_mbcnt_hi_u32_b32 %0, -1, %0" : "=v"(v_)); v_ |= (wid << 6)
#define PG8_RC(R_, C_) int R_[2], C_[2]; { PG8_TID(tl_); _Pragma("unroll") for (int i_ = 0; i_ < 2; ++i_) stage_rc(tl_ * 16 + i_ * 8192, R_[i_], C_[i_]); }
#pragma unroll
    for (int i = 0; i < 2; ++i) { int R, C; stage_rc(tid * 16 + i * 8192, R, C); const int Rb = Epi::PERM ? ((R & ~31) + perm32(R & 31)) : R;
        voffB[i] = (unsigned)(Rb * ldb + C) * 2u;
        offA[0][i] = (unsigned)(R * lda + C) * 2u; offA[1][i] = (unsigned)((R + HALF) * lda + C) * 2u; }
    const size_t kstep = (size_t)(BK * 2);
    const size_t hstep = (size_t)HALF * ldb * 2;
    const unsigned ldsw = (unsigned)wid * 1024u;
    const int aoff = lds_byte(wr * 64 + fr, fq * 8), boff = lds_byte(wc * 32 + fr, fq * 8);
#define PG8_SA(b, h) (((b) * 2 + (h)) * HTB)
#define PG8_SB(b, h) ((4 + (b) * 2 + (h)) * HTB)
    const unsigned ldsb = (unsigned)(size_t)lds;
#define PG8_STAGE(bufoff, gbase, voff) do { _Pragma("unroll") for (int _i = 0; _i < 2; ++_i) \
        asm volatile("s_mov_b32 m0, %2\n\tglobal_load_lds_dwordx4 %0, %1" :: "v"((voff)[_i]), "s"((const char*)(gbase)), "s"(ldsb + (unsigned)(bufoff) + ldsw + (unsigned)(_i * 8192)) : "memory", "m0"); } while (0)
#define PG8_CAT(x0, x1) __builtin_shufflevector(x0, x1, 0, 1, 2, 3, 4, 5, 6, 7)
#define PG8_LDA(dst, b, h) do { if constexpr (Prob::FP8) { _Pragma("unroll") for (int m = 0; m < 4; ++m) dst##8[m] = PG8_CAT(*(const LAS i32x4*)(lds + PG8_SA(b, h) + aoff + m * 2048), *(const LAS i32x4*)(lds + PG8_SA(b, h) + aoff + m * 2048 + 1024)); } \
        else { _Pragma("unroll") for (int m = 0; m < 4; ++m) _Pragma("unroll") for (int k = 0; k < 2; ++k) dst[m][k] = *(const LAS bf16x8*)(lds + PG8_SA(b, h) + aoff + m * 2048 + k * 1024); } } while (0)
#define PG8_LDB(dst, b, h) do { if constexpr (Prob::FP8) { _Pragma("unroll") for (int n = 0; n < 2; ++n) dst##8[n] = PG8_CAT(*(const LAS i32x4*)(lds + PG8_SB(b, h) + boff + n * 2048), *(const LAS i32x4*)(lds + PG8_SB(b, h) + boff + n * 2048 + 1024)); } \
        else { _Pragma("unroll") for (int n = 0; n < 2; ++n) _Pragma("unroll") for (int k = 0; k < 2; ++k) dst[n][k] = *(const LAS bf16x8*)(lds + PG8_SB(b, h) + boff + n * 2048 + k * 1024); } } while (0)
#define PG8_MMA(ai, bj, At, Bt) do { __builtin_amdgcn_s_setprio(1); \
        if constexpr (Prob::FP8) { _Pragma("unroll") for (int m = 0; m < 4; ++m) _Pragma("unroll") for (int n = 0; n < 2; ++n) \
            acc[ai][bj][m][n] = __builtin_amdgcn_mfma_scale_f32_16x16x128_f8f6f4(Bt##8[n], At##8[m], acc[ai][bj][m][n], 0, 0, 0, sc8_, 0, sc8_); } \
        else { _Pragma("unroll") for (int m = 0; m < 4; ++m) _Pragma("unroll") for (int n = 0; n < 2; ++n) _Pragma("unroll") for (int k = 0; k < 2; ++k) \
            acc[ai][bj][m][n] = __builtin_amdgcn_mfma_f32_16x16x32_bf16(Bt[n][k], At[m][k], acc[ai][bj][m][n], 0, 0, 0); } \
        __builtin_amdgcn_s_setprio(0); } while (0)
#define PG8_WAIT_V(n) asm volatile("s_waitcnt vmcnt(" #n ")" ::: "memory")
#define PG8_WAIT_L(n) asm volatile("s_waitcnt lgkmcnt(" #n ")" ::: "memory")
#define PG8_BAR __builtin_amdgcn_s_barrier()
#define PG8_SCHED __builtin_amdgcn_sched_barrier(0)
    Unit cur, nxt; int ui = 0;
    if (!S.next(0, cur)) return;
    static_assert(Prob::SCALE_A == Prob::SCALE_B, "one scale register serves both operands");
    int sc8_; asm volatile("v_mov_b32 %0, %1" : "=v"(sc8_) : "n"(Prob::SCALE_A));
    f32x4 acc[2][2][4][2];
    float zero_; asm volatile("v_mov_b32 %0, 0" : "=v"(zero_));
#pragma unroll
    for (int a = 0; a < 2; ++a)
#pragma unroll
        for (int b = 0; b < 2; ++b)
#pragma unroll
            for (int m = 0; m < 4; ++m)
#pragma unroll
                for (int n = 0; n < 2; ++n) acc[a][b][m][n] = (f32x4){zero_, zero_, zero_, zero_};
    bf16x8 At[4][2], B0[2][2], B1[2][2]; i32x8 At8[4], B08[2], B18[2];
    const char* cA = P.a_base(cur); const char* cB = P.b_base(cur); int nt = P.nt(cur);
    if constexpr (Prob::GATHER) { PG8_RC(Rr, Cc); P.a_rows(cur, Rr, Cc, offA); }
    if constexpr (Epi::SIDE) { PG8_TID(tl4_); E.side(cur, ldsb + SIDE_SLOT, wid, tl4_ & 63); }
    PG8_STAGE(PG8_SB(0, 0), cB, voffB); PG8_STAGE(PG8_SB(0, 1), cB + hstep, voffB); PG8_STAGE(PG8_SA(0, 0), cA, offA[0]); PG8_STAGE(PG8_SA(0, 1), cA, offA[1]);
    if (wr == 1) PG8_BAR;
    PG8_WAIT_V(2); PG8_BAR;
    PG8_STAGE(PG8_SB(1, 0), cB + kstep, voffB); PG8_STAGE(PG8_SA(1, 0), cA + kstep, offA[0]); PG8_STAGE(PG8_SB(1, 1), cB + hstep + kstep, voffB);
    PG8_WAIT_V(6); PG8_BAR;
    for (;;) {
        const bool has_next = S.next(ui + 1, nxt);
        const char* nA = has_next ? P.a_base(nxt) : cA; const char* nB = has_next ? P.b_base(nxt) : cB;
        if constexpr (Prob::GATHER) { if (has_next) { PG8_RC(Rr, Cc); (void)Cc;
#pragma unroll
            for (int h = 0; h < 2; ++h)
#pragma unroll
                for (int i = 0; i < 2; ++i) dma4((unsigned)(nxt.pm * 256 + h * 128 + Rr[i]) * 4u, P.tok, ldsb + SIDE_TOK + (unsigned)wid * 1024u + (unsigned)((h * 2 + i) * 256)); } }
        if constexpr (Epi::SIDE) { if (has_next) { PG8_TID(tl4_); E.side(nxt, ldsb + SIDE_SLOT + (unsigned)(((ui + 1) % 3) * SIDE_SLOT_BYTES), wid, tl4_ & 63); } }
        for (int t = 0; t < nt; t += 2) {
            const bool last = (t == nt - 2);
            if constexpr (Epi::KHOOK) { if (t == Epi::HOOK_T0 || t == Epi::HOOK_T1) {
                asm volatile("" ::: "memory"); PG8_TID(tlh_); const int lnh_ = tlh_ & 63; E.hook(acc, cur, t == Epi::HOOK_T0 ? 0 : 1, wr, wc, lnh_ & 15, lnh_ >> 4); asm volatile("" ::: "memory"); } }
            const char* a1 = cA + (size_t)(t + 1) * kstep;
            const char* a2 = last ? nA : cA + (size_t)(t + 2) * kstep; const char* b2 = last ? nB : cB + (size_t)(t + 2) * kstep;
            const char* a3 = a2 + kstep; const char* b3 = b2 + kstep;
            PG8_LDB(B0, 0, 0); PG8_LDB(B1, 0, 1); PG8_SCHED; PG8_LDA(At, 0, 0); PG8_STAGE(PG8_SA(1, 1), a1, offA[1]);
            PG8_WAIT_V(8); PG8_WAIT_L(0); PG8_BAR; PG8_MMA(0, 0, At, B0); PG8_MMA(0, 1, At, B1); PG8_BAR; PG8_SCHED;
            if constexpr (Prob::GATHER) { if (last && has_next) { PG8_RC(Rr, Cc); (void)Rr; PG8_TOKSLOT(tokslot); const int ntok[2][2] = {{tokslot[0], tokslot[64]}, {tokslot[128], tokslot[192]}}; P.a_off(ntok, Cc, offA); } }
            PG8_LDA(At, 0, 1); PG8_STAGE(PG8_SB(0, 0), b2, voffB); PG8_STAGE(PG8_SB(0, 1), b2 + hstep, voffB); PG8_STAGE(PG8_SA(0, 0), a2, offA[0]);
            PG8_WAIT_V(8); PG8_WAIT_L(0); PG8_BAR; PG8_MMA(1, 0, At, B0); PG8_MMA(1, 1, At, B1); PG8_BAR; PG8_SCHED;
            PG8_LDB(B0, 1, 0); PG8_LDB(B1, 1, 1); PG8_SCHED; PG8_LDA(At, 1, 0); PG8_STAGE(PG8_SA(0, 1), a2, offA[1]);
            PG8_WAIT_V(8); PG8_WAIT_L(0); PG8_BAR; PG8_MMA(0, 0, At, B0); PG8_MMA(0, 1, At, B1); PG8_BAR; PG8_SCHED;
            PG8_LDA(At, 1, 1); PG8_STAGE(PG8_SB(1, 0), b3, voffB); PG8_STAGE(PG8_SB(1, 1), b3 + hstep, voffB); PG8_STAGE(PG8_SA(1, 0), a3, offA[0]);
            PG8_WAIT_V(8); PG8_WAIT_L(0); PG8_BAR; PG8_MMA(1, 0, At, B0); PG8_MMA(1, 1, At, B1); PG8_BAR; PG8_SCHED;
        }
        if (wr == 0) PG8_BAR;
        { PG8_TID(tl3_); const int ln_ = tl3_ & 63; E(acc, cur, wr, wc, ln_ & 15, ln_ >> 4, lds + SIDE_SLOT + (ui % 3) * SIDE_SLOT_BYTES); }
        if (!has_next) break;
        bool keep = false;
        if constexpr (Epi::CHAIN) keep = E.keep(cur);
        if (!keep) {
            asm volatile("v_mov_b32 %0, 0" : "=v"(zero_));
#pragma unroll
            for (int a = 0; a < 2; ++a)
#pragma unroll
                for (int b = 0; b < 2; ++b)
#pragma unroll
                    for (int m = 0; m < 4; ++m)
#pragma unroll
                        for (int n = 0; n < 2; ++n) acc[a][b][m][n] = (f32x4){zero_, zero_, zero_, zero_};
        }
        cur = nxt; cA = nA; cB = nB; nt = P.nt(cur); ++ui;
        if (wr == 1) PG8_BAR;
    }
    PG8_WAIT_V(0);
    PG8_BAR;
#undef PG8_RC
#undef PG8_TID
#undef PG8_TOKSLOT
#undef PG8_SA
#undef PG8_SB
#undef PG8_STAGE
#undef PG8_LDA
#undef PG8_LDB
#undef PG8_MMA
#undef PG8_CAT
#undef PG8_WAIT_V
#undef PG8_WAIT_L
#undef PG8_BAR
#undef PG8_SCHED
}
}

typedef const float* cfp_t;
typedef const cfp_t __attribute__((address_space(4))) * InTab;
struct Frame {
    LAS unsigned char* lds;
    volatile LAS unsigned* MISC;
    unsigned char* ws;
    InTab in;
    float* out;
    int tid, lane, wave, G, bid;
};
enum { IN_X = 0, IN_C, IN_CTX, IN_CCTX, IN_WADA, IN_BADA, IN_WIN, IN_BIN, IN_POOLW, IN_POOLS, IN_CONVW, IN_CONVB, IN_MNG, IN_SLNG, IN_SLNB, IN_SGUW, IN_SGUB,
       IN_WBP, IN_WBM, IN_WBS, IN_WOUT, IN_LN1G, IN_LN1B, IN_WR, IN_BR, IN_WGU, IN_BGU, IN_WDN, IN_BDN, IN_LN2G, IN_LN2B };
__device__ __forceinline__ int mod_row(int row) { return row < ML ? (row >> 12) : NB; }
__device__ __forceinline__ const float* modp(const Frame& F, int l, int row, int part) { return (const float*)(F.ws + WS_MOD) + ((size_t)(l * 17 + mod_row(row)) * 6 + part) * 1024; }

__device__ __forceinline__ void transpose_item(const float* W, size_t ldw, int k0, int srccol0, bf16_t* dst, size_t ldk, int kd0, LAS float* scr, int lane) {
#pragma unroll 8
    for (int i = 0; i < 32; ++i) { const int kk = 2 * i + (lane >> 5); scr[kk * 33 + (lane & 31)] = __builtin_nontemporal_load(W + (size_t)(k0 + kk) * ldw + srccol0 + (lane & 31)); }
    LDS_WAIT(); asm volatile("" ::: "memory");
    const int c = lane & 7;
#pragma unroll
    for (int j = 0; j < 4; ++j) { const int n = (lane >> 3) + 8 * j; const LAS float* s = scr + (8 * c) * 33 + n;
        u32x4 o; o.x = pk2(s[0 * 33], s[1 * 33]); o.y = pk2(s[2 * 33], s[3 * 33]); o.z = pk2(s[4 * 33], s[5 * 33]); o.w = pk2(s[6 * 33], s[7 * 33]);
        *(u32x4*)(dst + (size_t)n * ldk + kd0 + 8 * c) = o; }
    LDS_WAIT(); asm volatile("" ::: "memory");
}
__device__ __forceinline__ void transpose_item_fp8(const float* W, size_t ldw, int k0, int srccol0, unsigned char* dst, size_t ldk, int kd0, float sc, LAS float* scr, int lane) {
#pragma unroll 8
    for (int i = 0; i < 32; ++i) { const int kk = 2 * i + (lane >> 5); scr[kk * 33 + (lane & 31)] = __builtin_nontemporal_load(W + (size_t)(k0 + kk) * ldw + srccol0 + (lane & 31)); }
    LDS_WAIT(); asm volatile("" ::: "memory");
    const int c = lane & 7;
#pragma unroll
    for (int j = 0; j < 4; ++j) { const int n = (lane >> 3) + 8 * j; const LAS float* s_ = scr + (8 * c) * 33 + n;
        u32x2 o; o.x = pk4_fp8(s_[0 * 33] * sc, s_[1 * 33] * sc, s_[2 * 33] * sc, s_[3 * 33] * sc); o.y = pk4_fp8(s_[4 * 33] * sc, s_[5 * 33] * sc, s_[6 * 33] * sc, s_[7 * 33] * sc);
        *(u32x2*)(dst + (size_t)n * ldk + kd0 + 8 * c) = o; }
    LDS_WAIT(); asm volatile("" ::: "memory");
}
__device__ __forceinline__ void phase_prologue(Frame& F) {
    LAS float* scr = (LAS float*)(F.lds + F.wave * 16384);
    const int gw = F.bid * NWAVES + F.wave, NGW = F.G * NWAVES;
    constexpr int I_IN = 16 * (NZ / 32);
    constexpr int I_BR = (4 + 8 + 4) * 32;
    constexpr int I_OUT = 16 * 32;
    constexpr int I_GU = 16 * 64;
    constexpr int I_DN = 16 * 32;
    constexpr int T_IN = DEPTH * I_IN, T_BR = DEPTH * I_BR, T_OUT = DEPTH * I_OUT, T_GU = DEPTH * NEXP * I_GU, T_DN = DEPTH * NEXP * I_DN;
    constexpr int NITEMS = T_IN + T_BR + T_OUT + T_GU + T_DN;
    for (int it = gw; it < NITEMS; it += NGW) {
        int r = it;
        if (r < T_IN) { const int l = r / I_IN; r %= I_IN; const int kb = r / (NZ / 32), nb = r % (NZ / 32); const int n0 = nb * 32, src = n0 < 2304 ? n0 : n0 + 16;
            if (n0 < NZ_BF) transpose_item(F.in[IN_WIN] + (size_t)l * D * 5904, 5904, kb * 64, src, (bf16_t*)(F.ws + WS_WIN) + ((size_t)l * NZ + n0) * D, D, kb * 64, scr, F.lane);
            else transpose_item_fp8(F.in[IN_WIN] + (size_t)l * D * 5904, 5904, kb * 64, src, (unsigned char*)(F.ws + WS_WIN8) + ((size_t)l * NZ_F8 + (n0 - NZ_BF)) * D, D, kb * 64, F8S_WGU, scr, F.lane);
            continue; }
        r -= T_IN;
        if (r < T_BR) { const int l = r / I_BR; r %= I_BR; const int kb = r / 32, nb = r % 32;
            const float* W; int ksrc;
            if (kb < 4) { W = F.in[IN_WBP] + (size_t)l * 256 * D; ksrc = kb * 64; } else if (kb < 12) { W = F.in[IN_WBM] + (size_t)l * 512 * D; ksrc = (kb - 4) * 64; } else { W = F.in[IN_WBS] + (size_t)l * 256 * D; ksrc = (kb - 12) * 64; }
            transpose_item(W, D, ksrc, nb * 32, (bf16_t*)(F.ws + WS_WBR) + ((size_t)l * D + nb * 32) * D, D, kb * 64, scr, F.lane); continue; }
        r -= T_BR;
        if (r < T_OUT) { const int l = r / I_OUT; r %= I_OUT; const int kb = r / 32, nb = r % 32;
            transpose_item(F.in[IN_WOUT] + (size_t)l * D * D, D, kb * 64, nb * 32, (bf16_t*)(F.ws + WS_WOUT) + ((size_t)l * D + nb * 32) * D, D, kb * 64, scr, F.lane); continue; }
        r -= T_OUT;
        if (r < T_GU) { const int le = r / I_GU; r %= I_GU; const int kb = r / 64, nb = r % 64; const int n0 = nb * 32;
            const int pn = n0 >> 8, c = n0 & 255; const int src = c < 128 ? (128 * pn + c) : (1024 + 128 * pn + c - 128);
            transpose_item_fp8(F.in[IN_WGU] + (size_t)le * D * 2048, 2048, kb * 64, src, (unsigned char*)(F.ws + WS_WGU) + ((size_t)le * 2048 + n0) * D, D, kb * 64, F8S_WGU, scr, F.lane); continue; }
        r -= T_GU;
        { const int le = r / I_DN; r %= I_DN; const int kb = r / 32, nb = r % 32;
            transpose_item_fp8(F.in[IN_WDN] + (size_t)le * D * D, D, kb * 64, nb * 32, (unsigned char*)(F.ws + WS_WDN) + ((size_t)le * D + nb * 32) * D, D, kb * 64, F8S_WDN, scr, F.lane); }
    }
    { const int gt = F.bid * NTHREADS + F.tid, NGT = F.G * NTHREADS;
      for (int i = gt; i < DEPTH * 16 * 1024; i += NGT) { const int l = i >> 14, g = (i >> 10) & 15, k = i & 1023; ((float*)(F.ws + WS_WG))[i] = F.in[IN_WIN][((size_t)l * D + k) * 5904 + 2304 + g]; }
      for (int i = gt; i < DEPTH * 4 * 128 * 128; i += NGT) ((bf16_t*)(F.ws + WS_WSGU))[i] = (bf16_t)f2bf(F.in[IN_SGUW][i]);
      for (int i = gt; i < DEPTH * 4 * 64 * 64; i += NGT) { const int lg = i >> 12, d = (i >> 6) & 63, c = i & 63; ((bf16_t*)(F.ws + WS_WPOOL))[i] = (bf16_t)f2bf(F.in[IN_POOLW][(size_t)lg * 4096 + c * 64 + d]); } }
    __syncthreads();
    { LAS float* sc = (LAS float*)F.lds;
      LAS float* part = (LAS float*)(F.lds + 71680);
      for (int i = F.tid; i < 17 * 1024; i += NTHREADS) { const int r = i >> 10, k = i & 1023; const float v = r < 16 ? F.in[IN_C][r * 1024 + k] : F.in[IN_CCTX][k]; sc[i] = siluf_(v); }
      __syncthreads();
      for (int u = F.bid; u < DEPTH * 48; u += F.G) {
          const int l = u / 48, n0 = (u % 48) * 128, col = F.tid & 127, ks = F.tid >> 7;
          float a[17];
#pragma unroll
          for (int r = 0; r < 17; ++r) a[r] = 0.f;
          const float* W = F.in[IN_WADA] + (size_t)l * D * 6144 + n0 + col;
          for (int k = ks * 256; k < ks * 256 + 256; ++k) { const float w = W[(size_t)k * 6144];
#pragma unroll
              for (int r = 0; r < 17; ++r) a[r] += sc[r * 1024 + k] * w; }
#pragma unroll
          for (int r = 0; r < 17; ++r) part[(ks * 17 + r) * 128 + col] = a[r];
          __syncthreads();
          for (int i = F.tid; i < 17 * 128; i += NTHREADS) { const int r = i >> 7, cc = i & 127;
              const float s = part[(0 * 17 + r) * 128 + cc] + part[(1 * 17 + r) * 128 + cc] + part[(2 * 17 + r) * 128 + cc] + part[(3 * 17 + r) * 128 + cc] + F.in[IN_BADA][l * 6144 + n0 + cc];
              ((float*)(F.ws + WS_MOD))[(size_t)(l * 17 + r) * 6144 + n0 + cc] = s; }
          __syncthreads();
      } }
}

struct RowV { f32x4 v[4]; };
#define RC(lane, j) (8 * (lane) + 512 * ((j) >> 1) + 4 * ((j) & 1))
__device__ __forceinline__ void row_load(RowV& r, const float* p, int lane) {
#pragma unroll
    for (int j = 0; j < 4; ++j) r.v[j] = __builtin_nontemporal_load((const f32x4*)(p + RC(lane, j)));
}
__device__ __forceinline__ void row_load_bf16(RowV& r, const bf16_t* p, int lane) {
#pragma unroll
    for (int h = 0; h < 2; ++h) { const u32x4 w = __builtin_nontemporal_load((const u32x4*)(p + 8 * lane + 512 * h)); r.v[2 * h] = (f32x4){bflo(w.x), bfhi(w.x), bflo(w.y), bfhi(w.y)}; r.v[2 * h + 1] = (f32x4){bflo(w.z), bfhi(w.z), bflo(w.w), bfhi(w.w)}; }
}
__device__ __forceinline__ void row_store(const RowV& r, float* p, int lane) {
#pragma unroll
    for (int j = 0; j < 4; ++j) *(f32x4*)(p + RC(lane, j)) = r.v[j];
}
__device__ __forceinline__ void row_store_nt(const RowV& r, float* p, int lane) {
#pragma unroll
    for (int j = 0; j < 4; ++j) __builtin_nontemporal_store(r.v[j], (f32x4*)(p + RC(lane, j)));
}
__device__ __forceinline__ void row_store_bf16_nt(const RowV& r, bf16_t* p, int lane) {
#pragma unroll
    for (int h = 0; h < 2; ++h) { u32x4 w; w.x = pk2(r.v[2 * h].x, r.v[2 * h].y); w.y = pk2(r.v[2 * h].z, r.v[2 * h].w); w.z = pk2(r.v[2 * h + 1].x, r.v[2 * h + 1].y); w.w = pk2(r.v[2 * h + 1].z, r.v[2 * h + 1].w); __builtin_nontemporal_store(w, (u32x4*)(p + 8 * lane + 512 * h)); }
}
__device__ __forceinline__ void row_store_bf16(const RowV& r, bf16_t* p, int lane) {
#pragma unroll
    for (int h = 0; h < 2; ++h) { u32x4 w; w.x = pk2(r.v[2 * h].x, r.v[2 * h].y); w.y = pk2(r.v[2 * h].z, r.v[2 * h].w); w.z = pk2(r.v[2 * h + 1].x, r.v[2 * h + 1].y); w.w = pk2(r.v[2 * h + 1].z, r.v[2 * h + 1].w); *(u32x4*)(p + 8 * lane + 512 * h) = w; }
}
__device__ __forceinline__ void row_ln_plain(RowV& r, int lane) {
    float s = 0.f;
#pragma unroll
    for (int j = 0; j < 4; ++j) s += (r.v[j].x + r.v[j].y) + (r.v[j].z + r.v[j].w);
    const float mean = wave_sum(s, lane) * (1.f / D); float s2 = 0.f;
#pragma unroll
    for (int j = 0; j < 4; ++j) { r.v[j] = r.v[j] - mean; s2 += (r.v[j].x * r.v[j].x + r.v[j].y * r.v[j].y) + (r.v[j].z * r.v[j].z + r.v[j].w * r.v[j].w); }
    const float rstd = 1.f / sqrtf(wave_sum(s2, lane) * (1.f / D) + LN_EPS);
#pragma unroll
    for (int j = 0; j < 4; ++j) r.v[j] = r.v[j] * rstd;
}
__device__ __forceinline__ void row_affine(RowV& r, const float* g, const float* b, int lane) {
#pragma unroll
    for (int j = 0; j < 4; ++j) { const f32x4 gg = *(const f32x4*)(g + RC(lane, j)), bb = *(const f32x4*)(b + RC(lane, j)); r.v[j] = r.v[j] * gg + bb; }
}
__device__ __forceinline__ void row_modulate(RowV& r, const float* sh, const float* sc, int lane) {
#pragma unroll
    for (int j = 0; j < 4; ++j) { const f32x4 s1 = *(const f32x4*)(sc + RC(lane, j)), s0 = *(const f32x4*)(sh + RC(lane, j)); r.v[j] = r.v[j] * (s1 + 1.0f) + s0; }
}
__device__ __forceinline__ LAS float* pv_slot(const Frame& F, int slot) { return (LAS float*)(F.lds + NW_PV) + slot * 1024; }
__device__ __forceinline__ void pv_fill(Frame& F, int slot, const float* src) { LAS f32x4* d = (LAS f32x4*)pv_slot(F, slot); for (int i = F.tid; i < 256; i += NTHREADS) d[i] = *(const f32x4*)(src + 4 * i); }
__device__ __forceinline__ void row_affine_l(RowV& r, const LAS float* g, const LAS float* b, int lane) {
#pragma unroll
    for (int j = 0; j < 4; ++j) { const f32x4 gg = *(const LAS f32x4*)(g + RC(lane, j)), bb = *(const LAS f32x4*)(b + RC(lane, j)); r.v[j] = r.v[j] * gg + bb; }
}
__device__ __forceinline__ void row_modulate_l(RowV& r, const LAS float* sh, const LAS float* sc, int lane) {
#pragma unroll
    for (int j = 0; j < 4; ++j) { const f32x4 s1 = *(const LAS f32x4*)(sc + RC(lane, j)), s0 = *(const LAS f32x4*)(sh + RC(lane, j)); r.v[j] = r.v[j] * (s1 + 1.0f) + s0; }
}
__device__ __forceinline__ void ln0_row(Frame& F, int row, RowV xr, const LAS float* sh, const LAS float* sc) {
    row_ln_plain(xr, F.lane);
    row_modulate_l(xr, sh, sc, F.lane);
    row_store_bf16(xr, (bf16_t*)(F.ws + WS_H) + (size_t)row * D, F.lane);
    { unsigned char* h8 = (unsigned char*)(F.ws + WS_H8) + (size_t)row * D + 8 * F.lane;
#pragma unroll
      for (int h = 0; h < 2; ++h) { u32x2 w; w.x = pk4_fp8(xr.v[2 * h].x * F8S_ACT, xr.v[2 * h].y * F8S_ACT, xr.v[2 * h].z * F8S_ACT, xr.v[2 * h].w * F8S_ACT); w.y = pk4_fp8(xr.v[2 * h + 1].x * F8S_ACT, xr.v[2 * h + 1].y * F8S_ACT, xr.v[2 * h + 1].z * F8S_ACT, xr.v[2 * h + 1].w * F8S_ACT); *(u32x2*)(h8 + 512 * h) = w; } }
}
__device__ __forceinline__ LAS float* narrow_tile_wave(Frame& F, const bf16_t* A) {
    const int r = F.lane & 31, h = F.lane >> 5;
    f32x16 acc;
#pragma unroll
    for (int i = 0; i < 16; ++i) acc[i] = 0.f;
    const bf16_t* ap = A + (size_t)r * D + 8 * h;
    const LAS unsigned char* bp = F.lds + NW_WT + r * 2064 + 16 * h;
    bf16x8 av[2][16];
#pragma unroll
    for (int ks = 0; ks < 16; ++ks) av[0][ks] = *(const bf16x8*)(ap + ks * 16);
#pragma unroll
    for (int kb = 0; kb < 4; ++kb) {
        if (kb < 3) {
#pragma unroll
            for (int ks = 0; ks < 16; ++ks) av[(kb + 1) & 1][ks] = *(const bf16x8*)(ap + ((kb + 1) * 16 + ks) * 16); }
        __builtin_amdgcn_sched_barrier(0);
#pragma unroll
        for (int ks = 0; ks < 16; ++ks) { const bf16x8 b = *(const LAS bf16x8*)(bp + (kb * 16 + ks) * 32); acc = __builtin_amdgcn_mfma_f32_32x32x16_bf16(av[kb & 1][ks], b, acc, 0, 0, 0); }
        __builtin_amdgcn_sched_barrier(0);
    }
    LAS float* lg = (LAS float*)(F.lds + NW_LG) + F.wave * 1056;
#pragma unroll
    for (int i = 0; i < 16; ++i) lg[((i & 3) + 8 * (i >> 2) + 4 * h) * 33 + r] = acc[i];
    asm volatile("s_waitcnt lgkmcnt(0)" ::: "memory");
    return lg;
}
__device__ __forceinline__ void tile_range(const Frame& F, int mrows, int& t_lo, int& t_hi) { const int nt = mrows / 32; t_lo = (int)(((long)F.bid * nt) / F.G); t_hi = (int)(((long)(F.bid + 1) * nt) / F.G); }
__device__ __forceinline__ void load_wg_lds(Frame& F, int l) {
    const float* src = (const float*)(F.ws + WS_WG) + (size_t)l * 16384;
    for (int i = F.tid; i < 32 * 128; i += NTHREADS) { const int g = i >> 7, c8 = i & 127; u32x4 w = (u32x4){0u, 0u, 0u, 0u};
        if (g < 16) { const f32x4 a = *(const f32x4*)(src + g * 1024 + c8 * 8), b = *(const f32x4*)(src + g * 1024 + c8 * 8 + 4); w.x = pk2(a.x, a.y); w.y = pk2(a.z, a.w); w.z = pk2(b.x, b.y); w.w = pk2(b.z, b.w); }
        *(LAS u32x4*)(F.lds + NW_WT + g * 2064 + c8 * 16) = w; }
    __syncthreads();
}
__device__ __forceinline__ void gates_tail(Frame& F, int l, int t_lo, int t_hi) {
    asm volatile("s_waitcnt vmcnt(0)" ::: "memory"); __syncthreads();
    const int g = F.lane & 15; const float bias = F.in[IN_BIN][l * 5904 + 2304 + g];
    for (int tile = t_lo + F.wave; tile < t_hi; tile += NWAVES) {
        const LAS float* lg = narrow_tile_wave(F, (const bf16_t*)(F.ws + WS_H) + (size_t)tile * 32 * D);
#pragma unroll
        for (int rr = 0; rr < 8; ++rr) { const int row = rr * 4 + (F.lane >> 4); ((float*)(F.ws + WS_ZG))[(size_t)(tile * 32 + row) * 16 + g] = lg[row * 33 + g] + bias; }
        asm volatile("s_waitcnt lgkmcnt(0)" ::: "memory");
    }
}

using pg8::Unit;
struct ProbPlain {
    static constexpr bool GATHER = false, FP8 = false; static constexpr int SCALE_A = 127, SCALE_B = 127; const bf16_t* A; const bf16_t* Bt; int lda, ldb;
    __device__ __forceinline__ int nt(const Unit&) const { return lda / 64; }
    __device__ __forceinline__ const char* a_base(const Unit& u) const { return (const char*)A + (size_t)u.pm * 256 * lda * 2; }
    __device__ __forceinline__ const char* b_base(const Unit& u) const { return (const char*)Bt + (size_t)u.pn * 256 * ldb * 2; }
    __device__ __forceinline__ void a_tok(const Unit&, const int (&)[2], int (&)[2][2]) const {}
    __device__ __forceinline__ void a_off(const int (&)[2][2], const int (&)[2], unsigned (&)[2][2]) const {}
    __device__ __forceinline__ void a_rows(const Unit&, const int (&)[2], const int (&)[2], unsigned (&)[2][2]) const {}
};
struct ProbPlainF8 {
    static constexpr bool GATHER = false, FP8 = true; static constexpr int SCALE_A = F8E_ACT, SCALE_B = F8E_WGU; const bf16_t* A; const bf16_t* Bt; int lda, ldb;
    __device__ __forceinline__ int nt(const Unit&) const { return lda / 64; }
    __device__ __forceinline__ const char* a_base(const Unit& u) const { return (const char*)A + (size_t)u.pm * 256 * lda * 2; }
    __device__ __forceinline__ const char* b_base(const Unit& u) const { return (const char*)Bt + (size_t)u.pn * 256 * ldb * 2; }
    __device__ __forceinline__ void a_tok(const Unit&, const int (&)[2], int (&)[2][2]) const {}
    __device__ __forceinline__ void a_off(const int (&)[2][2], const int (&)[2], unsigned (&)[2][2]) const {}
    __device__ __forceinline__ void a_rows(const Unit&, const int (&)[2], const int (&)[2], unsigned (&)[2][2]) const {}
};
struct ProbBranch {
    static constexpr bool GATHER = false, FP8 = false; static constexpr int SCALE_A = 127, SCALE_B = 127; const bf16_t* A; const bf16_t* Bt; int lda, ldb;
    __device__ __forceinline__ int nt(const Unit& u) const { return u.sub == 1 ? 8 : 4; }
    __device__ __forceinline__ int koff(const Unit& u) const { return u.sub == 0 ? 0 : (u.sub == 1 ? 256 : 768); }
    __device__ __forceinline__ const char* a_base(const Unit& u) const { return (const char*)A + ((size_t)u.pm * 256 * lda + koff(u)) * 2; }
    __device__ __forceinline__ const char* b_base(const Unit& u) const { return (const char*)Bt + ((size_t)u.pn * 256 * ldb + koff(u)) * 2; }
    __device__ __forceinline__ void a_tok(const Unit&, const int (&)[2], int (&)[2][2]) const {}
    __device__ __forceinline__ void a_off(const int (&)[2][2], const int (&)[2], unsigned (&)[2][2]) const {}
    __device__ __forceinline__ void a_rows(const Unit&, const int (&)[2], const int (&)[2], unsigned (&)[2][2]) const {}
};
__device__ __forceinline__ int expert_of(const LAS int* seg, int pm) { return __builtin_amdgcn_readfirstlane((int)((const LAS unsigned char*)(seg + 64))[pm]); }
__device__ __forceinline__ int moe_tables(Frame& F, LAS int* seg) {
    __syncthreads();
    if (F.tid <= NEXP) seg[F.tid] = ((const int*)(F.ws + WS_ROUTE + RT_SEG))[F.tid];
    __syncthreads();
    const int ntile = seg[NEXP] / 256;
    LAS unsigned char* texp = (LAS unsigned char*)(seg + 64);
    for (int t = F.tid; t < ntile; t += NTHREADS) { const int row = t * 256; int e = 0;
#pragma unroll
        for (int i = 1; i < NEXP; ++i) e += (seg[i] <= row) ? 1 : 0;
        texp[t] = (unsigned char)e; }
    __syncthreads();
    return ntile;
}
struct ProbMoe1 {
    static constexpr bool GATHER = true, FP8 = true; static constexpr int SCALE_A = F8E_ACT, SCALE_B = F8E_WGU; const bf16_t* A; const bf16_t* Bt; int lda, ldb; const int* tok; const LAS int* seg;
    __device__ __forceinline__ int nt(const Unit&) const { return lda / 64; }
    __device__ __forceinline__ const char* a_base(const Unit&) const { return (const char*)A; }
    __device__ __forceinline__ const char* b_base(const Unit& u) const { const int e = expert_of(seg, u.pm); return (const char*)Bt + ((size_t)e * 2048 + (size_t)u.pn * 256) * ldb * 2; }
    __device__ __forceinline__ void a_rows(const Unit& u, const int (&R)[2], const int (&C)[2], unsigned (&off)[2][2]) const {
#pragma unroll
        for (int h = 0; h < 2; ++h)
#pragma unroll
            for (int i = 0; i < 2; ++i) { const int t = tok[u.pm * 256 + h * 128 + R[i]]; off[h][i] = (unsigned)(t * lda + C[i]) * 2u; } }
    __device__ __forceinline__ void a_tok(const Unit& u, const int (&R)[2], int (&tk)[2][2]) const {
#pragma unroll
        for (int h = 0; h < 2; ++h)
#pragma unroll
            for (int i = 0; i < 2; ++i) tk[h][i] = tok[u.pm * 256 + h * 128 + R[i]]; }
    __device__ __forceinline__ void a_off(const int (&tk)[2][2], const int (&C)[2], unsigned (&off)[2][2]) const {
#pragma unroll
        for (int h = 0; h < 2; ++h)
#pragma unroll
            for (int i = 0; i < 2; ++i) off[h][i] = (unsigned)(tk[h][i] * lda + C[i]) * 2u; }
};
struct ProbMoe2 {
    static constexpr bool GATHER = false, FP8 = true; static constexpr int SCALE_A = F8E_ACT, SCALE_B = F8E_WDN; const bf16_t* A; const bf16_t* Bt; int lda, ldb; const LAS int* seg;
    __device__ __forceinline__ int nt(const Unit&) const { return lda / 64; }
    __device__ __forceinline__ const char* a_base(const Unit& u) const { return (const char*)A + (size_t)u.pm * 256 * lda * 2; }
    __device__ __forceinline__ const char* b_base(const Unit& u) const { const int e = expert_of(seg, u.pm); return (const char*)Bt + ((size_t)e * 1024 + (size_t)u.pn * 256) * ldb * 2; }
    __device__ __forceinline__ void a_tok(const Unit&, const int (&)[2], int (&)[2][2]) const {}
    __device__ __forceinline__ void a_off(const int (&)[2][2], const int (&)[2], unsigned (&)[2][2]) const {}
    __device__ __forceinline__ void a_rows(const Unit&, const int (&)[2], const int (&)[2], unsigned (&)[2][2]) const {}
};
using pg8::cvt_pk_bf16;
template <bool G8> struct EpiInproj {
    static constexpr bool PERM = true, CHAIN = false, SIDE = true, KHOOK = false; bf16_t* Z; const float* bias; int pn0;
    __device__ __forceinline__ void side(const Unit& u0, unsigned slot, int wid, int lane) const { const int pn = u0.pn + pn0; if (wid == 1) pg8::dma16((unsigned)lane * 16u, bias + pn * 256 + (pn >= 9 ? 16 : 0), slot); }
    __device__ __forceinline__ void operator()(const f32x4 (&acc)[2][2][4][2], const Unit& u0, int wr, int wc, int fr, int fq, const LAS unsigned char* sd) const {
        Unit u = u0; u.pn += pn0;
        int row0 = u.pm * 256 + wr * 64 + fr, col0 = u.pn * 256 + wc * 32 + 8 * fq; asm volatile("" : "+v"(row0), "+v"(col0));
        const int act = G8 ? ((u.pn == 9 || u.pn == 10) ? 2 : 1) : 0;
        f32x4 bv[2][2];
#pragma unroll
        for (int bj = 0; bj < 2; ++bj)
#pragma unroll
            for (int n = 0; n < 2; ++n) bv[bj][n] = *(const LAS f32x4*)(sd + (bj * 128 + wc * 32 + 8 * fq + 4 * n) * 4);
#pragma unroll
        for (int ai = 0; ai < 2; ++ai)
#pragma unroll
            for (int m = 0; m < 4; ++m) { bf16_t* rowp = Z + (size_t)(row0 + ai * 128 + m * 16) * NZ + col0;
#pragma unroll
                for (int bj = 0; bj < 2; ++bj) { f32x4 v0 = acc[ai][bj][m][0] + bv[bj][0], v1 = acc[ai][bj][m][1] + bv[bj][1];
                    if (G8 && u.pn >= ZG_COL / 256) { u32x2 w8;
                        v0 = sigmoid4(v0) * G8_SCALE; v1 = sigmoid4(v1) * G8_SCALE;
#pragma unroll
                        for (int j = 0; j < 4; ++j) { v0[j] = fmaxf(v0[j], 1.0f); v1[j] = fmaxf(v1[j], 1.0f); }
                        v0 = v0 + 12582912.0f; v1 = v1 + 12582912.0f;
                        w8.x = pk4_u8(v0[0], v0[1], v0[2], v0[3]); w8.y = pk4_u8(v1[0], v1[1], v1[2], v1[3]);
                        *(u32x2*)((unsigned char*)(Z + (size_t)(row0 + ai * 128 + m * 16) * NZ + ZG_COL) + (col0 - ZG_COL) + bj * 128) = w8; continue; }
                    if (act == 2) { f32x2 a = pg8::gelu_pk((f32x2){v0[0], v0[1]}), b = pg8::gelu_pk((f32x2){v0[2], v0[3]}), c = pg8::gelu_pk((f32x2){v1[0], v1[1]}), d = pg8::gelu_pk((f32x2){v1[2], v1[3]});
                        v0 = (f32x4){a.x, a.y, b.x, b.y}; v1 = (f32x4){c.x, c.y, d.x, d.y}; }
                    if (act == 1) { v0 = sigmoid4(v0); v1 = sigmoid4(v1); }
                    u32x4 w; w.x = cvt_pk_bf16(v0[0], v0[1]); w.y = cvt_pk_bf16(v0[2], v0[3]); w.z = cvt_pk_bf16(v1[0], v1[1]); w.w = cvt_pk_bf16(v1[2], v1[3]);
                    *(u32x4*)(rowp + bj * 128) = w; }
                if constexpr (G8) asm volatile("" ::: "memory"); }
    }
};
struct EpiNull {
    static constexpr bool PERM = true, CHAIN = false; bf16_t* Z;
    __device__ __forceinline__ void operator()(const f32x4 (&acc)[2][2][4][2], const Unit& u, int wr, int wc, int fr, int fq) const {
        float sacc = 0.f;
#pragma unroll
        for (int ai = 0; ai < 2; ++ai)
#pragma unroll
            for (int bj = 0; bj < 2; ++bj)
#pragma unroll
                for (int m = 0; m < 4; ++m)
#pragma unroll
                    for (int n = 0; n < 2; ++n) sacc += (acc[ai][bj][m][n][0] + acc[ai][bj][m][n][1]) + (acc[ai][bj][m][n][2] + acc[ai][bj][m][n][3]);
        if (sacc == 1.2345e30f) Z[u.pm + wr + wc + fr + fq] = 0;
    }
};
struct EpiOut {
    static constexpr bool PERM = true, CHAIN = false, SIDE = false, KHOOK = false; bf16_t* T;
    __device__ __forceinline__ void operator()(const f32x4 (&acc)[2][2][4][2], const Unit& u, int wr, int wc, int fr, int fq, const LAS unsigned char*) const {
        int row0 = u.pm * 256 + wr * 64 + fr, col0 = u.pn * 256 + wc * 32 + 8 * fq; asm volatile("" : "+v"(row0), "+v"(col0));
#pragma unroll
        for (int ai = 0; ai < 2; ++ai)
#pragma unroll
            for (int m = 0; m < 4; ++m) { bf16_t* rowp = T + (size_t)(row0 + ai * 128 + m * 16) * D + col0;
#pragma unroll
                for (int bj = 0; bj < 2; ++bj) { const f32x4 v0 = acc[ai][bj][m][0], v1 = acc[ai][bj][m][1];
                    u32x4 w; w.x = cvt_pk_bf16(v0[0], v0[1]); w.y = cvt_pk_bf16(v0[2], v0[3]); w.z = cvt_pk_bf16(v1[0], v1[1]); w.w = cvt_pk_bf16(v1[2], v1[3]);
                    *(u32x4*)(rowp + bj * 128) = w; } }
    }
};
struct EpiBranch {
    static constexpr bool PERM = true, CHAIN = false, SIDE = false, KHOOK = true; static constexpr int HOOK_T0 = 4, HOOK_T1 = 12;
    const bf16_t* Z; bf16_t* Y;
    template <bool FIN> __device__ __forceinline__ void apply(f32x4 (&acc)[2][2][4][2], const Unit& u, int br, int wr, int wc, int fr, int fq) const {
        int row0 = u.pm * 256 + wr * 64 + fr, col0 = u.pn * 256 + wc * 32 + 8 * fq;
        asm volatile("" : "+v"(row0), "+v"(col0));
#pragma unroll
        for (int ai = 0; ai < 2; ++ai) {
            u32x2 ga[4][2], gb[4][2];
#pragma unroll
            for (int m = 0; m < 4; ++m) { const unsigned char* rowp = (const unsigned char*)(Z + (size_t)(row0 + ai * 128 + m * 16) * NZ + ZG_COL) + br * 1024 + col0;
#pragma unroll
                for (int bj = 0; bj < 2; ++bj) { ga[m][bj] = *(const u32x2*)(rowp + bj * 128); if (!FIN) gb[m][bj] = *(const u32x2*)(rowp + 1024 + bj * 128); } }
#pragma unroll
            for (int m = 0; m < 4; ++m) { const size_t row = (size_t)(row0 + ai * 128 + m * 16);
#pragma unroll
                for (int bj = 0; bj < 2; ++bj) { const u32x2 a = ga[m][bj];
                    f32x4 r0 = u8x4_f32(a.x), r1 = u8x4_f32(a.y);
                    if (FIN) { r0 = r0 * (1.0f / G8_SCALE); r1 = r1 * (1.0f / G8_SCALE); }
                    else { const u32x2 b = gb[m][bj]; f32x4 q0 = u8x4_f32(b.x), q1 = u8x4_f32(b.y);
#pragma unroll
                        for (int i = 0; i < 4; ++i) { q0[i] = __builtin_amdgcn_rcpf(q0[i]); q1[i] = __builtin_amdgcn_rcpf(q1[i]); }
                        r0 = r0 * q0; r1 = r1 * q1; }
                    acc[ai][bj][m][0] = acc[ai][bj][m][0] * r0; acc[ai][bj][m][1] = acc[ai][bj][m][1] * r1;
                    if (FIN) { const f32x4 v0 = acc[ai][bj][m][0], v1 = acc[ai][bj][m][1];
                        u32x4 w; w.x = cvt_pk_bf16(v0[0], v0[1]); w.y = cvt_pk_bf16(v0[2], v0[3]); w.z = cvt_pk_bf16(v1[0], v1[1]); w.w = cvt_pk_bf16(v1[2], v1[3]);
                        *(u32x4*)(Y + row * D + col0 + bj * 128) = w; } } }
            asm volatile("" ::: "memory"); }
    }
    __device__ __forceinline__ void hook(f32x4 (&acc)[2][2][4][2], const Unit& u, int br, int wr, int wc, int fr, int fq) const { apply<false>(acc, u, br, wr, wc, fr, fq); }
    __device__ __forceinline__ void operator()(f32x4 (&acc)[2][2][4][2], const Unit& u, int wr, int wc, int fr, int fq, const LAS unsigned char*) const { apply<true>(acc, u, 2, wr, wc, fr, fq); }
};
struct EpiSwiglu {
    static constexpr bool PERM = true, CHAIN = false, SIDE = true, KHOOK = false; unsigned char* HID; const float* bgu; const LAS int* seg;
    __device__ __forceinline__ void side(const Unit& u, unsigned slot, int wid, int lane) const {
        if (wid == 1) { const int e = expert_of(seg, u.pm); pg8::dma16(lane < 32 ? (unsigned)lane * 16u : 4096u + (unsigned)(lane - 32) * 16u, bgu + (size_t)e * 2048 + u.pn * 128, slot); } }
    __device__ __forceinline__ void operator()(const f32x4 (&acc)[2][2][4][2], const Unit& u, int wr, int wc, int fr, int fq, const LAS unsigned char* sd) const {
        int j0 = u.pn * 128 + wc * 32 + 8 * fq, slot0 = u.pm * 256 + wr * 64 + fr; asm volatile("" : "+v"(j0), "+v"(slot0));
        f32x4 bg[2], bu[2];
#pragma unroll
        for (int n = 0; n < 2; ++n) { bg[n] = *(const LAS f32x4*)(sd + (wc * 32 + 8 * fq + 4 * n) * 4); bu[n] = *(const LAS f32x4*)(sd + (128 + wc * 32 + 8 * fq + 4 * n) * 4); }
#pragma unroll
        for (int ai = 0; ai < 2; ++ai)
#pragma unroll
            for (int m = 0; m < 4; ++m) { const size_t slot = (size_t)(slot0 + ai * 128 + m * 16); f32x4 o[2];
#pragma unroll
                for (int n = 0; n < 2; ++n) { f32x4 g = acc[ai][0][m][n] + bg[n], up = acc[ai][1][m][n] + bu[n];
#pragma unroll
                    for (int i = 0; i < 4; ++i) { g[i] = fminf(g[i], 7.0f); up[i] = __builtin_amdgcn_fmed3f(up[i], -7.0f, 7.0f); }
                    f32x4 t = g * (-1.702f * 1.4426950408889634f);
#pragma unroll
                    for (int i = 0; i < 4; ++i) t[i] = __builtin_amdgcn_exp2f(t[i]);
                    t = t + 1.0f;
#pragma unroll
                    for (int i = 0; i < 4; ++i) t[i] = __builtin_amdgcn_rcpf(t[i]);
                    o[n] = (up * F8S_ACT + F8S_ACT) * (g * t); }
                u32x2 w; w.x = pk4_fp8(o[0][0], o[0][1], o[0][2], o[0][3]); w.y = pk4_fp8(o[1][0], o[1][1], o[1][2], o[1][3]);
                *(u32x2*)(HID + slot * 1024 + j0) = w; }
    }
};
struct EpiDown {
    static constexpr bool PERM = true, CHAIN = false, SIDE = true, KHOOK = false; unsigned char* FS; const float* bdn; const int* dest; const float* pslot; const LAS int* seg;
    __device__ __forceinline__ void side(const Unit& u, unsigned slot, int wid, int lane) const {
        if (wid == 1) { const int e = expert_of(seg, u.pm); pg8::dma16((unsigned)lane * 16u, bdn + (size_t)e * 1024 + u.pn * 256, slot); }
        if (wid == 2) pg8::dma16((unsigned)lane * 16u, dest + (size_t)u.pm * 256, slot + 1024u);
        if (wid == 3) pg8::dma16((unsigned)lane * 16u, pslot + (size_t)u.pm * 256, slot + 2048u); }
    __device__ __forceinline__ void operator()(const f32x4 (&acc)[2][2][4][2], const Unit& u, int wr, int wc, int fr, int fq, const LAS unsigned char* sd) const {
        int col0 = u.pn * 256 + wc * 32 + 8 * fq, slot0 = u.pm * 256 + wr * 64 + fr; asm volatile("" : "+v"(col0), "+v"(slot0));
        f32x4 bv[2][2];
#pragma unroll
        for (int bj = 0; bj < 2; ++bj)
#pragma unroll
            for (int n = 0; n < 2; ++n) bv[bj][n] = *(const LAS f32x4*)(sd + (bj * 128 + wc * 32 + 8 * fq + 4 * n) * 4);
#pragma unroll
        for (int ai = 0; ai < 2; ++ai)
#pragma unroll
            for (int m = 0; m < 4; ++m) { const int rt = ai * 128 + wr * 64 + m * 16 + fr; const int d = *(const LAS int*)(sd + 1024 + rt * 4); const float p = *(const LAS float*)(sd + 2048 + rt * 4) * FS_SCALE;
                if (d >= 0) {
#pragma unroll
                    for (int bj = 0; bj < 2; ++bj) { f32x4 v0 = (acc[ai][bj][m][0] + bv[bj][0]) * p, v1 = (acc[ai][bj][m][1] + bv[bj][1]) * p;
#pragma unroll
                        for (int i = 0; i < 4; ++i) { v0[i] = __builtin_amdgcn_fmed3f(v0[i], -FS_CLAMP, FS_CLAMP); v1[i] = __builtin_amdgcn_fmed3f(v1[i], -FS_CLAMP, FS_CLAMP); }
                        u32x2 w; w.x = pk4_fp8(v0[0], v0[1], v0[2], v0[3]); w.y = pk4_fp8(v1[0], v1[1], v1[2], v1[3]);
                        *(u32x2*)(FS + (size_t)d * 1024 + col0 + bj * 128) = w; } }
                asm volatile("" ::: "memory"); }
    }
};

__device__ __forceinline__ const float* xin_row(const Frame& F, int row) { return row < ML ? F.in[IN_X] + (size_t)row * D : F.in[IN_CTX] + (size_t)(row - ML) * D; }
__device__ __forceinline__ void phase_ln0_first(Frame& F) {
    int t_lo, t_hi; tile_range(F, MT, t_lo, t_hi);
    const int r_lo = 32 * t_lo, nrows = 32 * (t_hi - t_lo);
    const int mrA = mod_row(r_lo), mrB = mod_row(r_lo + (nrows > 0 ? nrows - 1 : 0));
    { const float* mb = (const float*)(F.ws + WS_MOD); pv_fill(F, 0, mb + ((size_t)(0 * 17 + mrA) * 6 + 0) * 1024); pv_fill(F, 1, mb + ((size_t)(0 * 17 + mrB) * 6 + 0) * 1024);
      pv_fill(F, 2, mb + ((size_t)(0 * 17 + mrA) * 6 + 1) * 1024); pv_fill(F, 3, mb + ((size_t)(0 * 17 + mrB) * 6 + 1) * 1024); }
    load_wg_lds(F, 0);
    for (int n = F.wave; n < nrows; n += 4 * NWAVES) {
        RowV rv[4];
#pragma unroll
        for (int u = 0; u < 4; ++u) if (n + u * NWAVES < nrows) row_load(rv[u], xin_row(F, r_lo + n + u * NWAVES), F.lane);
#pragma unroll
        for (int u = 0; u < 4; ++u) if (n + u * NWAVES < nrows) { const int row = r_lo + n + u * NWAVES;
            const int sel = (mod_row(row) == mrA) ? 0 : 1; ln0_row(F, row, rv[u], pv_slot(F, 0 + sel), pv_slot(F, 2 + sel)); }
    }
    gates_tail(F, 0, t_lo, t_hi);
    __syncthreads();
}
__device__ __forceinline__ void phase_finalize(Frame& F, int l, int mrows) {
    const int gw = F.bid * NWAVES + F.wave, NGW = F.G * NWAVES;
    const bf16_t* hf = (const bf16_t*)(F.ws + WS_HFB); const bf16_t* hb = hf + (size_t)MT * 512;
    const float* ng = F.in[IN_MNG] + l * 512 + 8 * F.lane;
    const f32x4 g0 = *(const f32x4*)ng, g1 = *(const f32x4*)(ng + 4);
    for (int row = gw; row < mrows; row += NGW) {
        const u32x4 ha = __builtin_nontemporal_load((const u32x4*)(hf + (size_t)row * 512 + 8 * F.lane)), hbv = __builtin_nontemporal_load((const u32x4*)(hb + (size_t)row * 512 + 8 * F.lane));
        f32x4 v0 = (f32x4){bflo(ha.x) + bflo(hbv.x), bfhi(ha.x) + bfhi(hbv.x), bflo(ha.y) + bflo(hbv.y), bfhi(ha.y) + bfhi(hbv.y)}, v1 = (f32x4){bflo(ha.z) + bflo(hbv.z), bfhi(ha.z) + bfhi(hbv.z), bflo(ha.w) + bflo(hbv.w), bfhi(ha.w) + bfhi(hbv.w)};
        float s = (v0.x + v0.y) + (v0.z + v0.w) + (v1.x + v1.y) + (v1.z + v1.w);
#pragma unroll
        for (int o = 1; o < 16; o <<= 1) s += shx(s, o, F.lane);
        const float mu = s * (1.f / 128.f); v0 = v0 - mu; v1 = v1 - mu;
        float q = (v0.x * v0.x + v0.y * v0.y) + (v0.z * v0.z + v0.w * v0.w) + (v1.x * v1.x + v1.y * v1.y) + (v1.z * v1.z + v1.w * v1.w);
#pragma unroll
        for (int o = 1; o < 16; o <<= 1) q += shx(q, o, F.lane);
        const float rstd = 1.f / sqrtf(q * (1.f / 128.f) + HEAD_EPS);
        const u32x4 so = __builtin_nontemporal_load((const u32x4*)((const bf16_t*)(F.ws + WS_Z) + (size_t)row * NZ + ZC_O + 8 * F.lane));
        v0 = v0 * rstd * g0; v1 = v1 * rstd * g1;
        u32x4 w; w.x = pk2(v0.x * bflo(so.x), v0.y * bfhi(so.x)); w.y = pk2(v0.z * bflo(so.y), v0.w * bfhi(so.y)); w.z = pk2(v1.x * bflo(so.z), v1.y * bfhi(so.z)); w.w = pk2(v1.z * bflo(so.w), v1.w * bfhi(so.w));
        *(u32x4*)((bf16_t*)(F.ws + WS_BRA) + (size_t)row * D + 256 + 8 * F.lane) = w;
    }
}
__device__ __forceinline__ void phase_ln1_router(Frame& F, int l, int mrows) {
    LAS int* cnt = (LAS int*)(F.lds + NW_END);
    { const float* wr = F.in[IN_WR] + (size_t)l * D * NEXP;
      for (int i = F.tid; i < NEXP * D; i += NTHREADS) { const int k = i >> 5, e = i & 31; *(LAS bf16_t*)(F.lds + NW_WT + e * 2064 + k * 2) = (bf16_t)f2bf(wr[i]); }
      if (F.tid < NEXP) cnt[F.tid] = 0; }
    const float* brt = F.in[IN_BR] + l * NEXP;
    int t_lo, t_hi; tile_range(F, mrows, t_lo, t_hi);
    const int r_lo = 32 * t_lo, nrows = 32 * (t_hi - t_lo);
    const int mrA = mod_row(r_lo), mrB = mod_row(r_lo + (nrows > 0 ? nrows - 1 : 0));
    { const float* mb = (const float*)(F.ws + WS_MOD); pv_fill(F, 0, F.in[IN_LN1G] + l * D); pv_fill(F, 1, F.in[IN_LN1B] + l * D);
      pv_fill(F, 2, mb + ((size_t)(l * 17 + mrA) * 6 + 2) * 1024); pv_fill(F, 3, mb + ((size_t)(l * 17 + mrB) * 6 + 2) * 1024);
      pv_fill(F, 4, mb + ((size_t)(l * 17 + mrA) * 6 + 3) * 1024); pv_fill(F, 5, mb + ((size_t)(l * 17 + mrB) * 6 + 3) * 1024);
      pv_fill(F, 6, mb + ((size_t)(l * 17 + mrA) * 6 + 4) * 1024); pv_fill(F, 7, mb + ((size_t)(l * 17 + mrB) * 6 + 4) * 1024); }
    __syncthreads();
    { const bf16_t* yb = (const bf16_t*)(F.ws + WS_T) + 8 * F.lane;
      for (int n = F.wave; n < nrows; n += 2 * NWAVES) {
          RowV rv[2]; u32x4 yv2[2][2];
#pragma unroll
          for (int u = 0; u < 2; ++u) if (n + u * NWAVES < nrows) { const int row = r_lo + n + u * NWAVES;
              if (l == 0) row_load(rv[u], xin_row(F, row), F.lane); else row_load_bf16(rv[u], (const bf16_t*)(F.ws + WS_X) + (size_t)row * D, F.lane);
#pragma unroll
              for (int h = 0; h < 2; ++h) yv2[u][h] = __builtin_nontemporal_load((const u32x4*)(yb + (size_t)row * D + 512 * h)); }
#pragma unroll
          for (int u = 0; u < 2; ++u) if (n + u * NWAVES < nrows) { const int row = r_lo + n + u * NWAVES; RowV cur = rv[u];
              const int sel = (mod_row(row) == mrA) ? 0 : 1;
              { const LAS float* g1 = pv_slot(F, 2 + sel);
#pragma unroll
                for (int j = 0; j < 4; ++j) { const f32x4 gg = *(const LAS f32x4*)(g1 + RC(F.lane, j)); const u32x4 yw = yv2[u][j >> 1]; const f32x4 yv = (j & 1) ? (f32x4){bflo(yw.z), bfhi(yw.z), bflo(yw.w), bfhi(yw.w)} : (f32x4){bflo(yw.x), bfhi(yw.x), bflo(yw.y), bfhi(yw.y)}; cur.v[j] = cur.v[j] * DN_ALPHA + gg * yv; } }
              row_ln_plain(cur, F.lane); row_affine_l(cur, pv_slot(F, 0), pv_slot(F, 1), F.lane);
              row_store_bf16_nt(cur, (bf16_t*)(F.ws + WS_X) + (size_t)row * D, F.lane);
              row_ln_plain(cur, F.lane); row_modulate_l(cur, pv_slot(F, 4 + sel), pv_slot(F, 6 + sel), F.lane);
              row_store_bf16(cur, (bf16_t*)(F.ws + WS_H2) + (size_t)row * D, F.lane);
              { unsigned char* h8 = (unsigned char*)(F.ws + WS_H2F8) + (size_t)row * D + 8 * F.lane;
#pragma unroll
                for (int h = 0; h < 2; ++h) { u32x2 w; w.x = pk4_fp8(cur.v[2 * h].x * F8S_ACT, cur.v[2 * h].y * F8S_ACT, cur.v[2 * h].z * F8S_ACT, cur.v[2 * h].w * F8S_ACT); w.y = pk4_fp8(cur.v[2 * h + 1].x * F8S_ACT, cur.v[2 * h + 1].y * F8S_ACT, cur.v[2 * h + 1].z * F8S_ACT, cur.v[2 * h + 1].w * F8S_ACT); *(u32x2*)(h8 + 512 * h) = w; } } }
      } }
    asm volatile("s_waitcnt vmcnt(0)" ::: "memory"); __syncthreads();
    for (int tile = t_lo + F.wave; tile < t_hi; tile += NWAVES) {
        const LAS float* lgw = narrow_tile_wave(F, (const bf16_t*)(F.ws + WS_H2) + (size_t)tile * 32 * D);
        if (F.lane < 32) {
            const LAS float* lgp = lgw + F.lane * 33; const int row = tile * 32 + F.lane;
            float lg[NEXP];
#pragma unroll
            for (int e = 0; e < NEXP; ++e) lg[e] = lgp[e] + brt[e];
            unsigned used = 0u; float bv[4]; int bi[4];
#pragma unroll
            for (int k = 0; k < 4; ++k) { float best = -3.0e38f; int idx = 0;
#pragma unroll
                for (int e = 0; e < NEXP; ++e) { const bool take = (((used >> e) & 1u) == 0u) && (lg[e] > best); best = take ? lg[e] : best; idx = take ? e : idx; }
                used |= 1u << idx; bv[k] = best; bi[k] = idx; }
            const float e1 = __expf(bv[1] - bv[0]), e2 = __expf(bv[2] - bv[0]), e3 = __expf(bv[3] - bv[0]); const float inv = __builtin_amdgcn_rcpf(1.0f + e1 + e2 + e3);
            int* ei = (int*)(F.ws + WS_ROUTE + RT_EIDX) + (size_t)row * 4; float* pr = (float*)(F.ws + WS_ROUTE + RT_PROB) + (size_t)row * 4;
            *(int4*)ei = make_int4(bi[0], bi[1], bi[2], bi[3]); *(f32x4*)pr = (f32x4){inv, e1 * inv, e2 * inv, e3 * inv};
            atomicAdd((int*)&cnt[bi[0]], 1); atomicAdd((int*)&cnt[bi[1]], 1); atomicAdd((int*)&cnt[bi[2]], 1); atomicAdd((int*)&cnt[bi[3]], 1);
        }
        asm volatile("s_waitcnt lgkmcnt(0)" ::: "memory");
    }
    __syncthreads();
    if (F.tid < NEXP) ((int*)(F.ws + WS_ROUTE + RT_CNT))[F.bid * NEXP + F.tid] = cnt[F.tid];
    __syncthreads();
}
__device__ __forceinline__ void phase_slots(Frame& F, int mrows) {
    LAS int* part = (LAS int*)F.lds;
    LAS int* pre = part + 1024;
    LAS int* tot = pre + 32;
    LAS int* seg = tot + 32;
    LAS int* gcnt = seg + 64;
    LAS int* eix = gcnt + 2048;
    LAS int* rnk = eix + 4096;
    const int* cntg = (const int*)(F.ws + WS_ROUTE + RT_CNT);
    int* tokg = (int*)(F.ws + WS_ROUTE + RT_TOK); int* destg = (int*)(F.ws + WS_ROUTE + RT_DEST); float* psl = (float*)(F.ws + WS_ROUTE + RT_PSLOT);
    int t_lo, t_hi; tile_range(F, mrows, t_lo, t_hi);
    const int row_base = t_lo * 32, nent = (t_hi - t_lo) * 128, ngrp = nent / 64;
    { const int e = F.tid & 31, pt = F.tid >> 5; int a = 0, b = 0;
      for (int c = pt; c < F.G; c += 16) { const int v = cntg[c * NEXP + e]; b += v; a += (c < F.bid) ? v : 0; }
      part[pt * 32 + e] = a; part[512 + pt * 32 + e] = b; }
    for (int i = F.tid; i < nent; i += NTHREADS) eix[i] = ((const int*)(F.ws + WS_ROUTE + RT_EIDX))[(size_t)row_base * 4 + i];
    __syncthreads();
    if (F.tid < NEXP) { int a = 0, b = 0;
#pragma unroll
        for (int pt = 0; pt < 16; ++pt) { a += part[pt * 32 + F.tid]; b += part[512 + pt * 32 + F.tid]; }
        pre[F.tid] = a; tot[F.tid] = b; }
    for (int g = F.wave; g < ngrp; g += NWAVES) {
        const int e = eix[g * 64 + F.lane]; int rank = 0, mycnt = 0;
#pragma unroll 4
        for (int ee = 0; ee < NEXP; ++ee) { const unsigned long long m = __ballot(e == ee); if (e == ee) rank = __popcll(m & ((1ull << F.lane) - 1ull)); if (F.lane == ee) mycnt = __popcll(m); }
        rnk[g * 64 + F.lane] = rank; if (F.lane < NEXP) gcnt[g * 32 + F.lane] = mycnt; }
    __syncthreads();
    if (F.tid == 0) { int s = 0; for (int e = 0; e < NEXP; ++e) { seg[e] = s; s += (tot[e] + 255) & ~255; } seg[NEXP] = s; }
    if (F.tid >= 64 && F.tid < 64 + NEXP) { const int e = F.tid - 64; int run = 0; for (int g = 0; g < ngrp; ++g) { const int c = gcnt[g * 32 + e]; gcnt[g * 32 + e] = run; run += c; } }
    __syncthreads();
    { const float* prg = (const float*)(F.ws + WS_ROUTE + RT_PROB) + (size_t)row_base * 4;
      for (int i = F.tid; i < nent; i += NTHREADS) { const int e = eix[i]; const int slot = seg[e] + pre[e] + gcnt[(i >> 6) * 32 + e] + rnk[i];
          tokg[slot] = row_base + (i >> 2); destg[slot] = row_base * 4 + i; psl[slot] = prg[i]; } }
    if (F.bid < NEXP) { const int e = F.bid; for (int sl = seg[e] + tot[e] + F.tid; sl < seg[e + 1]; sl += NTHREADS) { tokg[sl] = 0; destg[sl] = -1; psl[sl] = 0.f; } }
    if (F.bid == 0 && F.tid <= NEXP) ((int*)(F.ws + WS_ROUTE + RT_SEG))[F.tid] = seg[F.tid];
    __syncthreads();
}
struct CombRaw { u32x4 x[2]; u32x2 f[2][4]; };
__device__ __forceinline__ void comb_load(const Frame& F, int row, CombRaw& r) {
    { const bf16_t* xp = (const bf16_t*)(F.ws + WS_X) + (size_t)row * D + 8 * F.lane;
#pragma unroll
      for (int h = 0; h < 2; ++h) r.x[h] = __builtin_nontemporal_load((const u32x4*)(xp + 512 * h)); }
    const unsigned char* fs = (const unsigned char*)(F.ws + WS_FS) + (size_t)row * 4 * 1024 + 8 * F.lane;
#pragma unroll
    for (int h = 0; h < 2; ++h)
#pragma unroll
        for (int k = 0; k < 4; ++k) r.f[h][k] = __builtin_nontemporal_load((const u32x2*)(fs + k * 1024 + 512 * h));
}
__device__ __forceinline__ void phase_combine_ln2(Frame& F, int l, int mrows) {
    const bool lastl = (l == DEPTH - 1);
    int t_lo, t_hi; tile_range(F, mrows, t_lo, t_hi);
    const int r_lo = 32 * t_lo, nrows = 32 * (t_hi - t_lo);
    const int mrA = mod_row(r_lo), mrB = mod_row(r_lo + (nrows > 0 ? nrows - 1 : 0));
    { const float* mb = (const float*)(F.ws + WS_MOD); const int ln = lastl ? l : l + 1; pv_fill(F, 0, F.in[IN_LN2G] + l * D); pv_fill(F, 1, F.in[IN_LN2B] + l * D);
      pv_fill(F, 2, mb + ((size_t)(l * 17 + mrA) * 6 + 5) * 1024); pv_fill(F, 3, mb + ((size_t)(l * 17 + mrB) * 6 + 5) * 1024);
      pv_fill(F, 4, mb + ((size_t)(ln * 17 + mrA) * 6 + 0) * 1024); pv_fill(F, 5, mb + ((size_t)(ln * 17 + mrB) * 6 + 0) * 1024);
      pv_fill(F, 6, mb + ((size_t)(ln * 17 + mrA) * 6 + 1) * 1024); pv_fill(F, 7, mb + ((size_t)(ln * 17 + mrB) * 6 + 1) * 1024); }
    if (!lastl) load_wg_lds(F, l + 1); else __syncthreads();
    for (int n = F.wave; n < nrows; n += 2 * NWAVES) {
        CombRaw rw[2];
#pragma unroll
        for (int u = 0; u < 2; ++u) if (n + u * NWAVES < nrows) comb_load(F, r_lo + n + u * NWAVES, rw[u]);
#pragma unroll
        for (int u = 0; u < 2; ++u) if (n + u * NWAVES < nrows) { const int row = r_lo + n + u * NWAVES;
            const int sel = (mod_row(row) == mrA) ? 0 : 1;
            const LAS float* g2 = pv_slot(F, 2 + sel);
            RowV x;
#pragma unroll
            for (int h = 0; h < 2; ++h) { const u32x4 w = rw[u].x[h]; x.v[2 * h] = (f32x4){bflo(w.x), bfhi(w.x), bflo(w.y), bfhi(w.y)}; x.v[2 * h + 1] = (f32x4){bflo(w.z), bfhi(w.z), bflo(w.w), bfhi(w.w)}; }
#pragma unroll
            for (int j = 0; j < 4; ++j) { f32x4 f = (f32x4){0.f, 0.f, 0.f, 0.f};
#pragma unroll
                for (int k = 0; k < 4; ++k) { const u32x2 w2 = rw[u].f[j >> 1][k]; const int wd = (int)((j & 1) ? w2.y : w2.x);
                    const f32x2 lo = __builtin_amdgcn_cvt_pk_f32_fp8(wd, false), hi = __builtin_amdgcn_cvt_pk_f32_fp8(wd, true); f[0] += lo[0]; f[1] += lo[1]; f[2] += hi[0]; f[3] += hi[1]; }
                const f32x4 gg = *(const LAS f32x4*)(g2 + RC(F.lane, j)) * (1.0f / FS_SCALE);
                x.v[j] = x.v[j] * DN_ALPHA + gg * f; }
            row_ln_plain(x, F.lane); row_affine_l(x, pv_slot(F, 0), pv_slot(F, 1), F.lane);
            if (lastl) { row_store_nt(x, F.out + (size_t)row * D, F.lane); }
            else { row_store_bf16_nt(x, (bf16_t*)(F.ws + WS_X) + (size_t)row * D, F.lane); ln0_row(F, row, x, pv_slot(F, 4 + sel), pv_slot(F, 6 + sel)); } }
    }
    if (!lastl) gates_tail(F, l + 1, t_lo, t_hi);
    __syncthreads();
}

#define MFMA32(a, b, c) __builtin_amdgcn_mfma_f32_32x32x16_bf16((a), (b), (c), 0, 0, 0)
#define MFMA16(a, b, c) __builtin_amdgcn_mfma_f32_16x16x32_bf16((a), (b), (c), 0, 0, 0)
__device__ __forceinline__ f32x16 zero16() { f32x16 z;
#pragma unroll
    for (int i = 0; i < 16; ++i) z[i] = 0.f;
    return z; }
__device__ __forceinline__ void pool_tiles(Frame& F, int l, bool with_ctx) {
    LAS unsigned char* Pin = F.lds;
    LAS unsigned char* Dm = F.lds + 40960;
    const bf16_t* Z = (const bf16_t*)(F.ws + WS_Z);
    const bf16_t* Wp = (const bf16_t*)(F.ws + WS_WPOOL) + (size_t)l * 4 * 4096;
    const float* psc = F.in[IN_POOLS] + l * 256;
    bf16_t* BRA = (bf16_t*)(F.ws + WS_BRA);
    const int ntiles = with_ctx ? 1088 : 1024;
    const int r = F.lane & 31, h = F.lane >> 5;
    for (int tile = F.bid; tile < ntiles; tile += F.G) {
        int row0, seq_lo, seq_hi;
        if (tile < 1024) { row0 = tile * 64; seq_lo = row0; seq_hi = row0 + 64; }
        else { const int ct = tile - 1024; seq_lo = ML + (ct >> 2) * 256; seq_hi = seq_lo + 256; row0 = seq_lo + (ct & 3) * 64; }
        for (int idx = F.tid; idx < 80 * 32; idx += NTHREADS) { const int rr = idx >> 5, ck = idx & 31, grow = row0 - 8 + rr;
            if (grow >= seq_lo && grow < seq_hi) *(LAS u32x4*)(Pin + rr * 512 + ck * 16) = __builtin_nontemporal_load((const u32x4*)(Z + (size_t)grow * NZ + ZC_P + ck * 8)); }
        __syncthreads();
        for (int idx = F.tid; idx < 64 * 32; idx += NTHREADS) { const int tok = idx >> 5, ck = idx & 31, g = ck >> 3, hw = 1 << g, t = row0 + tok;
            const int lo = max(t - hw, seq_lo), hi = min(t + hw, seq_hi);
            float s[8];
#pragma unroll
            for (int e = 0; e < 8; ++e) s[e] = 0.f;
            for (int rw = lo; rw < hi; ++rw) { const u32x4 v = *(const LAS u32x4*)(Pin + (rw - row0 + 8) * 512 + ck * 16);
                s[0] += bflo(v.x); s[1] += bfhi(v.x); s[2] += bflo(v.y); s[3] += bfhi(v.y); s[4] += bflo(v.z); s[5] += bfhi(v.z); s[6] += bflo(v.w); s[7] += bfhi(v.w); }
            const float inv = 1.0f / (float)(hi - lo);
            const u32x4 o = *(const LAS u32x4*)(Pin + (tok + 8) * 512 + ck * 16);
            u32x4 w; w.x = pk2(s[0] * inv - bflo(o.x), s[1] * inv - bfhi(o.x)); w.y = pk2(s[2] * inv - bflo(o.y), s[3] * inv - bfhi(o.y));
            w.z = pk2(s[4] * inv - bflo(o.z), s[5] * inv - bfhi(o.z)); w.w = pk2(s[6] * inv - bflo(o.w), s[7] * inv - bfhi(o.w));
            *(LAS u32x4*)(Dm + tok * 528 + ck * 16) = w; }
        __syncthreads();
#pragma unroll 1
        for (int qi = 0; qi < 2; ++qi) { const int q = F.wave + 8 * qi, g = q >> 2, td = (q >> 1) & 1, tt = q & 1;
            f32x16 acc = zero16();
#pragma unroll
            for (int ks = 0; ks < 4; ++ks) { const bf16x8 a = *(const bf16x8*)(Wp + ((size_t)g * 64 + td * 32 + r) * 64 + ks * 16 + 8 * h);
                const bf16x8 b = *(const LAS bf16x8*)(Dm + (tt * 32 + r) * 528 + (g * 64 + ks * 16 + 8 * h) * 2);
                acc = MFMA32(a, b, acc); }
            const size_t orow = (size_t)(row0 + tt * 32 + r);
#pragma unroll
            for (int qq = 0; qq < 4; ++qq) { const int dcol = g * 64 + td * 32 + 8 * qq + 4 * h; const f32x4 sc = *(const f32x4*)(psc + dcol);
                u32x2 w; w.x = pk2(acc[4 * qq] * sc.x, acc[4 * qq + 1] * sc.y); w.y = pk2(acc[4 * qq + 2] * sc.z, acc[4 * qq + 3] * sc.w);
                *(u32x2*)(BRA + orow * D + dcol) = w; } }
        __syncthreads();
    }
}
__device__ __forceinline__ void sgu_chunks(Frame& F, int l, bool with_ctx) {
    LAS unsigned char* Vt = F.lds;
    const bf16_t* Z = (const bf16_t*)(F.ws + WS_Z);
    const bf16_t* Ws = (const bf16_t*)(F.ws + WS_WSGU) + (size_t)l * 4 * 16384;
    const float* lng = F.in[IN_SLNG] + l * 256; const float* lnb = F.in[IN_SLNB] + l * 256; const float* sb = F.in[IN_SGUB] + l * 512;
    bf16_t* BRA = (bf16_t*)(F.ws + WS_BRA);
    const int nchunks = with_ctx ? 544 : 512;
    const int r = F.lane & 31, h = F.lane >> 5;
    for (int ch = F.bid; ch < nchunks; ch += F.G) {
        const int row0 = ch * 128;
        { const int s = F.tid >> 2, q = F.tid & 3; const bf16_t* zp = Z + (size_t)(row0 + s) * NZ + ZC_UV + 256 + q * 64;
          float v[64]; float sum = 0.f;
#pragma unroll
          for (int i = 0; i < 8; ++i) { const u32x4 w = __builtin_nontemporal_load((const u32x4*)(zp + 8 * i));
              v[8 * i] = bflo(w.x); v[8 * i + 1] = bfhi(w.x); v[8 * i + 2] = bflo(w.y); v[8 * i + 3] = bfhi(w.y); v[8 * i + 4] = bflo(w.z); v[8 * i + 5] = bfhi(w.z); v[8 * i + 6] = bflo(w.w); v[8 * i + 7] = bfhi(w.w); }
#pragma unroll
          for (int i = 0; i < 64; ++i) sum += v[i];
          sum += shx(sum, 1, F.lane); sum += shx(sum, 2, F.lane);
          const float mean = sum * (1.f / 256.f); float sq = 0.f;
#pragma unroll
          for (int i = 0; i < 64; ++i) { v[i] -= mean; sq += v[i] * v[i]; }
          sq += shx(sq, 1, F.lane); sq += shx(sq, 2, F.lane);
          const float rstd = 1.f / sqrtf(sq * (1.f / 256.f) + LN_EPS);
#pragma unroll
          for (int i = 0; i < 64; ++i) { const int c = q * 64 + i; const float y = v[i] * rstd * lng[c] + lnb[c]; *(LAS bf16_t*)(Vt + c * 272 + s * 2) = (bf16_t)f2bf(y); } }
        __syncthreads();
        const int tc = F.wave & 1, tt = F.wave >> 1, t = tt * 32 + r;
#pragma unroll 1
        for (int g = 0; g < 4; ++g) {
            f32x16 acc = zero16();
#pragma unroll
            for (int ks = 0; ks < 8; ++ks) { const bf16x8 a = *(const LAS bf16x8*)(Vt + (g * 64 + tc * 32 + r) * 272 + (ks * 16 + 8 * h) * 2);
                const bf16x8 b = *(const bf16x8*)(Ws + ((size_t)g * 128 + t) * 128 + ks * 16 + 8 * h);
                acc = MFMA32(a, b, acc); }
            const float bias = sb[g * 128 + t];
#pragma unroll
            for (int qq = 0; qq < 4; ++qq) { const int c0 = g * 64 + tc * 32 + 8 * qq + 4 * h;
                const u32x2 u = *(const u32x2*)(Z + (size_t)(row0 + t) * NZ + ZC_UV + c0);
                u32x2 w; w.x = pk2(bflo(u.x) * (acc[4 * qq] + bias), bfhi(u.x) * (acc[4 * qq + 1] + bias)); w.y = pk2(bflo(u.y) * (acc[4 * qq + 2] + bias), bfhi(u.y) * (acc[4 * qq + 3] + bias));
                *(u32x2*)(BRA + (size_t)(row0 + t) * D + 768 + c0) = w; } }
        __syncthreads();
    }
}
__device__ __forceinline__ void qk_conv_pass(Frame& F, int l) {
    const bf16_t* Z = (const bf16_t*)(F.ws + WS_Z); bf16_t* QKC = (bf16_t*)(F.ws + WS_H);
    const int chunk = F.tid & 127, rsub = F.tid >> 7, ch0 = chunk * 8;
    float w0[8], w1[8], w2[8], cbv[8];
    { const float* cw = F.in[IN_CONVW] + (size_t)l * 3 * 1024 + ch0; const float* cb = F.in[IN_CONVB] + (size_t)l * 1024 + ch0;
#pragma unroll
      for (int e = 0; e < 8; ++e) { w0[e] = cw[e]; w1[e] = cw[1024 + e]; w2[e] = cw[2048 + e]; cbv[e] = cb[e]; } }
    const float scale = chunk >= 64 ? 0.08838834764831845f : 1.0f;
    for (int row = F.bid * 4 + rsub; row < MT; row += F.G * 4) {
        const int p = row < ML ? (row & 4095) : ((row - ML) & 255), len = row < ML ? 4096 : 256;
        const bf16_t* zr = Z + (size_t)row * NZ + ZC_QK + ch0;
        const u32x4 x1 = *(const u32x4*)zr; u32x4 x0 = (u32x4){0u, 0u, 0u, 0u}, x2 = (u32x4){0u, 0u, 0u, 0u};
        if (p > 0) x0 = *(const u32x4*)(zr - NZ);
        if (p + 1 < len) x2 = *(const u32x4*)(zr + NZ);
        const unsigned xa[4] = {x0.x, x0.y, x0.z, x0.w}, xb[4] = {x1.x, x1.y, x1.z, x1.w}, xc[4] = {x2.x, x2.y, x2.z, x2.w};
        float y[8];
#pragma unroll
        for (int e2 = 0; e2 < 4; ++e2) { y[2 * e2] = cbv[2 * e2] + w0[2 * e2] * bflo(xa[e2]) + w1[2 * e2] * bflo(xb[e2]) + w2[2 * e2] * bflo(xc[e2]);
            y[2 * e2 + 1] = cbv[2 * e2 + 1] + w0[2 * e2 + 1] * bfhi(xa[e2]) + w1[2 * e2 + 1] * bfhi(xb[e2]) + w2[2 * e2 + 1] * bfhi(xc[e2]); }
#pragma unroll
        for (int e = 0; e < 8; ++e) y[e] = siluf_(y[e]) * scale;
        u32x4 w; w.x = pk2(y[0], y[1]); w.y = pk2(y[2], y[3]); w.z = pk2(y[4], y[5]); w.w = pk2(y[6], y[7]);
        *(u32x4*)(QKC + (size_t)row * D + ch0) = w;
    }
}
constexpr int ML_QS = 0, ML_KS = 34816, ML_KW = 69632, ML_VT = 104448, ML_CB = 126208, ML_SC = 147968, ML_SCSZ = 2624;
__device__ __forceinline__ float logsigf_(float x) { return fminf(x, 0.f) - __logf(1.0f + __expf(-fabsf(x))); }
__device__ __forceinline__ unsigned swap16(unsigned u) { return __builtin_amdgcn_alignbit(u, u, 16); }
struct MlPre { u32x4 qk[8]; u32x2 v[4]; float g[4]; };
__device__ __forceinline__ void ml_geom(int j, int b, int dir, int& seqbase, int& seqlen, int& pbase) {
    const bool is_ctx = j < 2; int cj = is_ctx ? j : j - 2; const int ncs = is_ctx ? 2 : 32; if (dir) cj = ncs - 1 - cj;
    seqbase = is_ctx ? ML + b * 256 : b * 4096; seqlen = is_ctx ? 256 : 4096; pbase = cj * 128; }
#define ML_BAR() do { asm volatile("s_waitcnt lgkmcnt(0)" ::: "memory"); __builtin_amdgcn_s_barrier(); asm volatile("" ::: "memory"); } while (0)
__device__ __forceinline__ void mlstm_unit(Frame& F, int l, int unit) {
    const int bh = (unit & 7) + 8 * (unit >> 5), sub = (unit >> 3) & 3;
    const int b = bh >> 2, head = bh & 3, dir = sub >> 1, vh = sub & 1;
    LAS unsigned char* QS = F.lds + ML_QS; LAS unsigned char* KS = F.lds + ML_KS; LAS unsigned char* KW = F.lds + ML_KW; LAS unsigned char* VT = F.lds + ML_VT; LAS unsigned char* CB = F.lds + ML_CB;
    const bf16_t* Z = (const bf16_t*)(F.ws + WS_Z); const float* ZG = (const float*)(F.ws + WS_ZG); const bf16_t* QKC = (const bf16_t*)(F.ws + WS_H);
    bf16_t* HF = (bf16_t*)(F.ws + WS_HFB) + (size_t)dir * MT * 512;
    const int wave = F.wave;
    int tl = F.tid;
#define ML_ROLES() const int lane = tl & 63, fr = lane & 15, q4 = lane >> 4; const int isk = (tl >> 4) & 1, ck = tl & 15, i0 = 8 * (tl >> 5), chn = (isk ? 512 : 0) + head * 128 + ck * 8; \
    const int vi0 = 4 * (tl >> 4), vcq = tl & 15, vch = head * 128 + vh * 64 + vcq * 4; (void)fr; (void)q4; (void)vi0; (void)vcq; (void)vch; (void)i0; (void)chn; (void)ck; (void)isk;
    for (int idx = F.tid; idx < 16 * 136; idx += NTHREADS) *(LAS bf16_t*)(VT + (64 + idx / 136) * 272 + (idx % 136) * 2) = (idx < 136) ? (bf16_t)0x3F80 : (bf16_t)0;
    f32x4 cs[5];
#pragma unroll
    for (int vt = 0; vt < 5; ++vt) cs[vt] = (f32x4){0.f, 0.f, 0.f, 0.f};
    float m_state = 0.f;
    MlPre pre;
#define ML_PREFETCH(jj) do { int sb_, sl_, pb_; ml_geom((jj), b, dir, sb_, sl_, pb_); \
        { const int pmin = dir ? pb_ + 120 - i0 : pb_ + i0; const bf16_t* zr = QKC + (size_t)(sb_ + pmin) * D + chn; (void)sl_; \
          _Pragma("unroll") for (int k = 0; k < 8; ++k) pre.qk[k] = *(const u32x4*)(zr + (size_t)k * D); } \
        { const int pminv = dir ? pb_ + 124 - vi0 : pb_ + vi0; const bf16_t* zv = Z + (size_t)(sb_ + pminv) * NZ + ZC_V + vch; \
          _Pragma("unroll") for (int k = 0; k < 4; ++k) pre.v[k] = *(const u32x2*)(zv + (size_t)k * NZ); } \
        if (wave == 0) { const int p0 = dir ? pb_ + 127 - 2 * lane : pb_ + 2 * lane, p1 = dir ? p0 - 1 : p0 + 1; \
          pre.g[0] = ZG[(size_t)(sb_ + p0) * 16 + dir * 8 + head]; pre.g[1] = ZG[(size_t)(sb_ + p0) * 16 + dir * 8 + 4 + head]; \
          pre.g[2] = ZG[(size_t)(sb_ + p1) * 16 + dir * 8 + head]; pre.g[3] = ZG[(size_t)(sb_ + p1) * 16 + dir * 8 + 4 + head]; } } while (0)
#define ML_STEPA(sbuf) do { LAS float* sg_ = (LAS float*)(F.lds + ML_SC + (sbuf) * ML_SCSZ); const int i0g = 2 * lane, i1g = i0g + 1; \
        const float gi0 = pre.g[0], gf0 = pre.g[1], gi1 = pre.g[2], gf1 = pre.g[3]; \
        const float lf0 = logsigf_(gf0), lf1 = logsigf_(gf1); const float s1 = lf0 + lf1; float incl = s1; \
        _Pragma("unroll") for (int o = 1; o < 64; o <<= 1) { const float y_ = shup(incl, o, lane); incl += (lane >= o) ? y_ : 0.f; } \
        const float excl = incl - s1, bc0 = excl + lf0, bc1 = excl + s1; \
        const float g0 = gi0 - bc0, g1 = gi1 - bc1; const float mx1 = fmaxf(g0, g1); float im = mx1; \
        _Pragma("unroll") for (int o = 1; o < 64; o <<= 1) { const float y_ = shup(im, o, lane); im = (lane >= o) ? fmaxf(im, y_) : im; } \
        float em = shup(im, 1, lane); em = (lane == 0) ? -3.0e38f : em; \
        const float M0 = fmaxf(m_state, fmaxf(em, g0)), M1 = fmaxf(m_state, fmaxf(em, mx1)); \
        const float total = bperm(63, bc1), Mlast = bperm(63, M1); \
        sg_[i0g] = g0; sg_[i1g] = g1; sg_[128 + i0g] = M0; sg_[128 + i1g] = M1; \
        sg_[256 + i0g] = __expf(m_state - M0); sg_[256 + i1g] = __expf(m_state - M1); \
        sg_[384 + i0g] = __expf(-(bc0 + M0)); sg_[384 + i1g] = __expf(-(bc1 + M1)); \
        sg_[512 + i0g] = __expf(g0 - Mlast); sg_[512 + i1g] = __expf(g1 - Mlast); \
        if (lane == 0) sg_[640] = __expf(m_state - Mlast); \
        m_state = total + Mlast; } while (0)
    { ML_ROLES(); ML_PREFETCH(0); if (wave == 0) ML_STEPA(0); }
    ML_BAR();
#pragma unroll 1
    for (int j = 0; j < 34; ++j) {
        asm volatile("" : "+v"(tl));
        ML_ROLES();
        int seqbase, seqlen, pbase; ml_geom(j, b, dir, seqbase, seqlen, pbase);
        const LAS float* sc_g = (const LAS float*)(F.lds + ML_SC + (j & 1) * ML_SCSZ); const LAS float* sc_M = sc_g + 128; const LAS float* sc_dec = sc_g + 256; const LAS float* sc_emt = sc_g + 384; const LAS float* sc_wk = sc_g + 512;
        {
#pragma unroll
          for (int k = 0; k < 8; ++k) { const int i = dir ? i0 + 7 - k : i0 + k; *(LAS u32x4*)((isk ? KS : QS) + i * 272 + ck * 16) = pre.qk[k]; }
          if (isk) { u32x4 kt[8]; float ykeep[8];
#pragma unroll
              for (int e = 0; e < 8; ++e) { kt[e] = (u32x4){0u, 0u, 0u, 0u}; ykeep[e] = 0.f; }
#pragma unroll
              for (int k = 0; k < 8; ++k) { const int i = dir ? i0 + 7 - k : i0 + k; const float wk = sc_wk[i];
                  const unsigned xb[4] = {pre.qk[k].x, pre.qk[k].y, pre.qk[k].z, pre.qk[k].w};
#pragma unroll
                  for (int e = 0; e < 8; ++e) { const float yw = ((e & 1) ? bfhi(xb[e >> 1]) : bflo(xb[e >> 1])) * wk;
                      if (k & 1) { const unsigned pw_ = pk2(ykeep[e], yw); if ((k >> 1) == 0) kt[e].x = pw_; else if ((k >> 1) == 1) kt[e].y = pw_; else if ((k >> 1) == 2) kt[e].z = pw_; else kt[e].w = pw_; }
                      else ykeep[e] = yw; } }
#pragma unroll
              for (int e = 0; e < 8; ++e) { u32x4 o = kt[e]; if (dir) o = (u32x4){swap16(kt[e].w), swap16(kt[e].z), swap16(kt[e].y), swap16(kt[e].x)};
                  *(LAS u32x4*)(KW + (ck * 8 + e) * 272 + (((i0 >> 3) ^ (ck & 7)) * 16)) = o; } } }
        { unsigned vv[4][2];
#pragma unroll
          for (int k = 0; k < 4; ++k) { vv[k][0] = pre.v[k].x; vv[k][1] = pre.v[k].y; }
#pragma unroll
          for (int c = 0; c < 4; ++c) {
              unsigned h0 = (c & 1) ? (vv[0][c >> 1] >> 16) : (vv[0][c >> 1] & 0xffffu), h1 = (c & 1) ? (vv[1][c >> 1] >> 16) : (vv[1][c >> 1] & 0xffffu);
              unsigned h2 = (c & 1) ? (vv[2][c >> 1] >> 16) : (vv[2][c >> 1] & 0xffffu), h3 = (c & 1) ? (vv[3][c >> 1] >> 16) : (vv[3][c >> 1] & 0xffffu);
              u32x2 o; if (dir) { o.x = h3 | (h2 << 16); o.y = h1 | (h0 << 16); } else { o.x = h0 | (h1 << 16); o.y = h2 | (h3 << 16); }
              *(LAS u32x2*)(VT + (vcq * 4 + c) * 272 + vi0 * 2) = o; } }
#pragma unroll
        for (int vt = 0; vt < 5; ++vt)
#pragma unroll
            for (int rr = 0; rr < 4; rr += 2) { const unsigned pw_ = pk2(cs[vt][rr], cs[vt][rr + 1]);
                *(LAS bf16_t*)(CB + (16 * vt + 4 * q4 + rr) * 272 + (16 * wave + fr) * 2) = (bf16_t)(pw_ & 0xffffu); *(LAS bf16_t*)(CB + (16 * vt + 4 * q4 + rr + 1) * 272 + (16 * wave + fr) * 2) = (bf16_t)(pw_ >> 16); }
        ML_BAR();
        if (j + 1 < 34) ML_PREFETCH(j + 1);
        const int t = 16 * wave + fr;
        bf16x8 qf[4];
#pragma unroll
        for (int kc = 0; kc < 4; ++kc) qf[kc] = *(const LAS bf16x8*)(QS + t * 272 + (32 * kc + 8 * q4) * 2);
        const float Mt_t = sc_M[t], dec_t = sc_dec[t], emt_t = sc_emt[t];
        f32x4 ps[8];
#pragma unroll
        for (int jp = 0; jp < 4; ++jp) {
            ps[2 * jp] = (f32x4){0.f, 0.f, 0.f, 0.f}; ps[2 * jp + 1] = (f32x4){0.f, 0.f, 0.f, 0.f};
            if (2 * jp <= wave) {
                bf16x8 ka[4], kb[4];
#pragma unroll
                for (int kc = 0; kc < 4; ++kc) { ka[kc] = *(const LAS bf16x8*)(KS + (32 * jp + fr) * 272 + (32 * kc + 8 * q4) * 2); kb[kc] = *(const LAS bf16x8*)(KS + (32 * jp + 16 + fr) * 272 + (32 * kc + 8 * q4) * 2); }
                const f32x4 ga4 = *(const LAS f32x4*)(sc_g + 32 * jp + 4 * q4), gb4 = *(const LAS f32x4*)(sc_g + 32 * jp + 16 + 4 * q4);
                f32x4 acc0 = (f32x4){0.f, 0.f, 0.f, 0.f}, acc1 = (f32x4){0.f, 0.f, 0.f, 0.f};
#pragma unroll
                for (int kc = 0; kc < 4; ++kc) { acc0 = MFMA16(ka[kc], qf[kc], acc0); acc1 = MFMA16(kb[kc], qf[kc], acc1); }
#pragma unroll
                for (int rr = 0; rr < 4; ++rr) { const int s0 = 32 * jp + 4 * q4 + rr, s1 = s0 + 16;
                    ps[2 * jp][rr] = (s0 <= t) ? acc0[rr] * __expf(ga4[rr] - Mt_t) : 0.f; ps[2 * jp + 1][rr] = (s1 <= t) ? acc1[rr] * __expf(gb4[rr] - Mt_t) : 0.f; }
            }
        }
        f32x4 ao[5];
        {
#pragma unroll
          for (int vt = 0; vt < 5; ++vt) ao[vt] = (f32x4){0.f, 0.f, 0.f, 0.f};
#pragma unroll
          for (int kh = 0; kh < 4; kh += 2) { bf16x8 cf[2][5];
#pragma unroll
              for (int k2 = 0; k2 < 2; ++k2)
#pragma unroll
                  for (int vt = 0; vt < 5; ++vt) cf[k2][vt] = *(const LAS bf16x8*)(CB + (16 * vt + fr) * 272 + (32 * (kh + k2) + 8 * q4) * 2);
#pragma unroll
              for (int k2 = 0; k2 < 2; ++k2)
#pragma unroll
                  for (int vt = 0; vt < 5; ++vt) ao[vt] = MFMA16(cf[k2][vt], qf[kh + k2], ao[vt]); }
#pragma unroll
          for (int vt = 0; vt < 5; ++vt) ao[vt] = ao[vt] * dec_t; }
#pragma unroll
        for (int ks = 0; ks < 4; ++ks) {
            if (2 * ks <= wave) {
                s16x4 vlo[5], vhi[5];
#pragma unroll
                for (int vt = 0; vt < 5; ++vt) { vlo[vt] = *(const LAS s16x4*)(VT + (16 * vt + fr) * 272 + (32 * ks + 4 * q4) * 2); vhi[vt] = *(const LAS s16x4*)(VT + (16 * vt + fr) * 272 + (32 * ks + 16 + 4 * q4) * 2); }
                u32x4 pw; pw.x = cvt_pk_bf16(ps[2 * ks][0], ps[2 * ks][1]); pw.y = cvt_pk_bf16(ps[2 * ks][2], ps[2 * ks][3]); pw.z = cvt_pk_bf16(ps[2 * ks + 1][0], ps[2 * ks + 1][1]); pw.w = cvt_pk_bf16(ps[2 * ks + 1][2], ps[2 * ks + 1][3]);
                const bf16x8 pf = __builtin_bit_cast(bf16x8, pw);
#pragma unroll
                for (int vt = 0; vt < 5; ++vt) { const bf16x8 a = __builtin_shufflevector(vlo[vt], vhi[vt], 0, 1, 2, 3, 4, 5, 6, 7); ao[vt] = MFMA16(a, pf, ao[vt]); }
            }
        }
        { const float den = bperm(fr, ao[4][0]); const float inv = 1.0f / fmaxf(fabsf(den), emt_t);
          const int p = dir ? pbase + 127 - t : pbase + t; bf16_t* orow = HF + (size_t)(seqbase + p) * 512 + head * 128 + vh * 64 + 4 * q4;
#pragma unroll
          for (int vt = 0; vt < 4; ++vt) { const f32x4 o = ao[vt] * inv; u32x2 w; w.x = cvt_pk_bf16(o[0], o[1]); w.y = cvt_pk_bf16(o[2], o[3]); *(u32x2*)(orow + 16 * vt) = w; } }
        { const float a_s = sc_g[640];
#pragma unroll
          for (int vt = 0; vt < 5; ++vt) cs[vt] = cs[vt] * a_s;
#pragma unroll
          for (int ks = 0; ks < 4; ks += 2) { bf16x8 bb[2], va[2][5];
#pragma unroll
              for (int k2 = 0; k2 < 2; ++k2) { bb[k2] = *(const LAS bf16x8*)(KW + (16 * wave + fr) * 272 + (((4 * (ks + k2) + q4) ^ (((16 * wave + fr) >> 3) & 7)) * 16));
#pragma unroll
                  for (int vt = 0; vt < 5; ++vt) va[k2][vt] = *(const LAS bf16x8*)(VT + (16 * vt + fr) * 272 + (32 * (ks + k2) + 8 * q4) * 2); }
#pragma unroll
              for (int k2 = 0; k2 < 2; ++k2)
#pragma unroll
                  for (int vt = 0; vt < 5; ++vt) cs[vt] = MFMA16(va[k2][vt], bb[k2], cs[vt]); } }
        if (wave == 0 && j + 1 < 34) ML_STEPA((j + 1) & 1);
        ML_BAR();
    }
#undef ML_PREFETCH
#undef ML_STEPA
#undef ML_ROLES
    __syncthreads();
}
__device__ __forceinline__ void phase_mixers(Frame& F, int l) {
    const bool with_ctx = (l != DEPTH - 1);
#ifndef MIX_MASK
#define MIX_MASK 7
#endif
#ifndef MIXREP
#define MIXREP 0
#endif
    if (MIX_MASK & 1) pool_tiles(F, l, with_ctx);
    if (MIXREP & 1) { __syncthreads(); pool_tiles(F, l, with_ctx); }
    if (MIX_MASK & 2) sgu_chunks(F, l, with_ctx);
    if (MIXREP & 2) { __syncthreads(); sgu_chunks(F, l, with_ctx); }
    (void)0;
    qk_conv_pass(F, l);
}
__device__ __forceinline__ void phase_mlstm(Frame& F, int l) {
    for (int u = F.bid; u < 256; u += F.G) mlstm_unit(F, l, u);
}

struct Args { const float* in[31]; float* out; unsigned char* ws; int g_lo, g_hi, pad0, pad1; };
constexpr int NPH = 11, NGID = 2 + DEPTH * NPH;
__global__ void __launch_bounds__(NTHREADS, 2) fwd_kernel(Args args) {
    extern __shared__ __attribute__((aligned(16))) unsigned char lds_raw[];
    Frame F;
    F.lds = (LAS unsigned char*)lds_raw; F.MISC = (volatile LAS unsigned*)(F.lds + MISC_OFF);
    F.tid = threadIdx.x; F.lane = F.tid & 63; F.wave = __builtin_amdgcn_readfirstlane(F.tid >> 6); F.G = gridDim.x; F.bid = blockIdx.x;
    F.ws = args.ws; F.out = args.out;
    F.in = (InTab)__builtin_amdgcn_kernarg_segment_ptr();
    if (F.tid < 64) F.MISC[F.tid] = 0u;
    __syncthreads();
    const int lo = args.g_lo, hi = args.g_hi;
    const bool multi = (hi - lo) > 1;
    XcdBarrier bar; bar.bar = (unsigned*)(F.ws + WS_CTL) + CW_BAR; bar.x = 0; bar.st = nullptr;
    if (multi) bar = xcd_barrier_post((unsigned*)(F.ws + WS_CTL) + CW_BAR, F.MISC + 8);
#ifndef PHASE_MASK
#define PHASE_MASK 0xFFFF
#endif
#define RUN(g) (lo <= (g) && (g) < hi)
#define RUNP(ty, g) ((((PHASE_MASK) >> (ty)) & 1) && RUN(g))
#ifndef REPEAT_MASK
#define REPEAT_MASK 0
#endif
#define NREP(ty) ((((REPEAT_MASK) >> (ty)) & 1) ? 2 : 1)
#define SEAM(g) do { if (RUN((g) + 1)) xcd_barrier(bar); } while (0)
#define LAUNDER(P) Frame P = F; { int t_; asm volatile("v_mbcnt_lo_u32_b32 %0, -1, 0\n\tv_mbcnt_hi_u32_b32 %0, -1, %0" : "=v"(t_)); t_ |= (F.wave << 6); P.tid = t_; P.lane = t_ & 63; P.wave = __builtin_amdgcn_readfirstlane(t_ >> 6); GAS unsigned char* w_ = (GAS unsigned char*)F.ws; asm volatile("" : "+s"(w_)); P.ws = (unsigned char*)w_; InTab t2_ = F.in; asm volatile("" : "+s"(t2_)); P.in = t2_; }
    if (RUNP(0, 0)) { LAUNDER(P); for (int rep_ = 0; rep_ < NREP(0); ++rep_) { phase_prologue(P); __syncthreads(); } SEAM(0); }
    if (RUNP(1, 1)) { LAUNDER(P); for (int rep_ = 0; rep_ < NREP(1); ++rep_) { phase_ln0_first(P); __syncthreads(); } SEAM(1); }
#pragma unroll 1
    for (int l = 0; l < DEPTH; ++l) {
        const int g0 = 2 + l * NPH;
        const int mrows = (l == DEPTH - 1) ? ML : MT;
        if (RUNP(2, g0 + 0)) {
#undef PHTY
#define PHTY 2
            LAUNDER(P);
            { ProbPlain Pr{(const bf16_t*)(P.ws + WS_H), (const bf16_t*)(P.ws + WS_WIN) + (size_t)l * NZ * D, D, D};
              pg8::StaticOrder<1> S; S.init(MT / 256, NZ_BF / 256, P.G, P.bid);
              EpiInproj<false> E{(bf16_t*)(P.ws + WS_Z), P.in[IN_BIN] + (size_t)l * 5904, 0};
              pg8::gemm_phase(P.lds, P.tid, Pr, S, E); }
            __syncthreads();
            { ProbPlainF8 Pr{(const bf16_t*)(P.ws + WS_H8), (const bf16_t*)(P.ws + WS_WIN8 + (size_t)l * NZ_F8 * D), D / 2, D / 2};
              pg8::StaticOrder<1> S; S.init(MT / 256, NZ_F8 / 256, P.G, P.bid);
              EpiInproj<true> E{(bf16_t*)(P.ws + WS_Z), P.in[IN_BIN] + (size_t)l * 5904, NZ_BF / 256};
              pg8::gemm_phase(P.lds, P.tid, Pr, S, E); }
            SEAM(g0 + 0);
        }
        if (RUNP(3, g0 + 1)) { LAUNDER(P); for (int rep_ = 0; rep_ < NREP(3); ++rep_) { phase_mixers(P, l); __syncthreads(); } SEAM(g0 + 1); }
        if (RUNP(12, g0 + 2)) { LAUNDER(P); for (int rep_ = 0; rep_ < NREP(12); ++rep_) { phase_mlstm(P, l); __syncthreads(); } SEAM(g0 + 2); }
        if (RUNP(4, g0 + 3)) { LAUNDER(P); for (int rep_ = 0; rep_ < NREP(4); ++rep_) phase_finalize(P, l, mrows); SEAM(g0 + 3); }
        if (RUNP(5, g0 + 4)) {
#undef PHTY
#define PHTY 5
            LAUNDER(P);
            ProbPlain Pr{(const bf16_t*)(P.ws + WS_BRA), (const bf16_t*)(P.ws + WS_WBR) + (size_t)l * D * D, D, D};
            pg8::StaticOrder<1> S; S.init(mrows / 256, 4, P.G, P.bid);
            EpiBranch E{(const bf16_t*)(P.ws + WS_Z), (bf16_t*)(P.ws + WS_Y)};
            pg8::gemm_phase(P.lds, P.tid, Pr, S, E); if (NREP(PHTY) == 2) { __syncthreads(); pg8::gemm_phase(P.lds, P.tid, Pr, S, E); }
            SEAM(g0 + 4);
        }
        if (RUNP(6, g0 + 5)) {
#undef PHTY
#define PHTY 6
            LAUNDER(P);
            ProbPlain Pr{(const bf16_t*)(P.ws + WS_Y), (const bf16_t*)(P.ws + WS_WOUT) + (size_t)l * D * D, D, D};
            pg8::StaticOrder<1> S; S.init(mrows / 256, 4, P.G, P.bid);
            EpiOut E{(bf16_t*)(P.ws + WS_T)};
            pg8::gemm_phase(P.lds, P.tid, Pr, S, E); if (NREP(PHTY) == 2) { __syncthreads(); pg8::gemm_phase(P.lds, P.tid, Pr, S, E); }
            SEAM(g0 + 5);
        }
        if (RUNP(7, g0 + 6)) { LAUNDER(P); for (int rep_ = 0; rep_ < NREP(7); ++rep_) phase_ln1_router(P, l, mrows); SEAM(g0 + 6); }
        if (RUNP(8, g0 + 7)) { LAUNDER(P); for (int rep_ = 0; rep_ < NREP(8); ++rep_) phase_slots(P, mrows); SEAM(g0 + 7); }
        if (RUNP(9, g0 + 8)) {
#undef PHTY
#define PHTY 9
            LAUNDER(P);
            LAS int* seg = (LAS int*)(P.lds + TAB_OFF);
            const int ntile = moe_tables(P, seg);
            ProbMoe1 Pr{(const bf16_t*)(P.ws + WS_H2F8), (const bf16_t*)(P.ws + WS_WGU + (size_t)l * NEXP * 2048 * D), D / 2, D / 2, (const int*)(P.ws + WS_ROUTE + RT_TOK), seg};
            pg8::StaticOrder<1> S; S.init(ntile, 8, P.G, P.bid);
            EpiSwiglu E{(unsigned char*)(P.ws + WS_HID), P.in[IN_BGU] + (size_t)l * NEXP * 2048, seg};
            pg8::gemm_phase(P.lds, P.tid, Pr, S, E); if (NREP(PHTY) == 2) { __syncthreads(); pg8::gemm_phase(P.lds, P.tid, Pr, S, E); }
            SEAM(g0 + 8);
        }
        if (RUNP(10, g0 + 9)) {
#undef PHTY
#define PHTY 10
            LAUNDER(P);
            LAS int* seg = (LAS int*)(P.lds + TAB_OFF);
            const int ntile = moe_tables(P, seg);
            ProbMoe2 Pr{(const bf16_t*)(P.ws + WS_HID), (const bf16_t*)(P.ws + WS_WDN + (size_t)l * NEXP * D * D), D / 2, D / 2, seg};
            pg8::StaticOrder<1> S; S.init(ntile, 4, P.G, P.bid);
            EpiDown E{(unsigned char*)(P.ws + WS_FS), P.in[IN_BDN] + (size_t)l * NEXP * D, (const int*)(P.ws + WS_ROUTE + RT_DEST), (const float*)(P.ws + WS_ROUTE + RT_PSLOT), seg};
            pg8::gemm_phase(P.lds, P.tid, Pr, S, E); if (NREP(PHTY) == 2) { __syncthreads(); pg8::gemm_phase(P.lds, P.tid, Pr, S, E); }
            SEAM(g0 + 9);
        }
        if (RUNP(11, g0 + 10)) { LAUNDER(P); phase_combine_ln2(P, l, mrows); SEAM(g0 + 10); }
    }
#undef LAUNDER
#undef RUN
#undef RUNP
#undef SEAM
}

extern "C" void kernel_launch(void* const* d_in, const int* in_sizes, int n_in, void* d_out, int out_size, void* d_ws, size_t ws_size, hipStream_t stream) {
    static int grid = 0;
    if (grid == 0) {
        if (n_in != 31 || out_size != ML * D || ws_size < WS_END) { fprintf(stderr, "kernel_launch: unexpected problem (n_in %d, out %d, ws %zu, need %zu)\n", n_in, out_size, ws_size, (size_t)WS_END); grid = -1; return; }
        int dev = 0, cus = 0, per_cu = 0;
        if (hipGetDevice(&dev) != hipSuccess || hipDeviceGetAttribute(&cus, hipDeviceAttributeMultiprocessorCount, dev) != hipSuccess) { grid = -1; return; }
        if (hipFuncSetAttribute((const void*)fwd_kernel, hipFuncAttributeMaxDynamicSharedMemorySize, LDS_BYTES) != hipSuccess) { fprintf(stderr, "kernel_launch: hipFuncSetAttribute failed\n"); grid = -1; return; }
        if (hipOccupancyMaxActiveBlocksPerMultiprocessor(&per_cu, (const void*)fwd_kernel, NTHREADS, LDS_BYTES) != hipSuccess || per_cu < 1) fprintf(stderr, "kernel_launch: occupancy query reports %d\n", per_cu);
        (void)hipGetLastError();
        grid = cus;
    }
    if (grid < 0) return;
    (void)hipMemsetAsync((char*)d_ws + WS_CTL, 0, CTL_ZERO_BYTES, stream);
    Args a{};
    for (int i = 0; i < 31; ++i) a.in[i] = (const float*)d_in[i];
    a.out = (float*)d_out; a.ws = (unsigned char*)d_ws;
#if MK_N_LAUNCHES == 1
    a.g_lo = 0; a.g_hi = NGID;
    hipLaunchKernelGGL(fwd_kernel, dim3(grid), dim3(NTHREADS), LDS_BYTES, stream, a);
#else
    for (int g = 0; g < NGID; ++g) { a.g_lo = g; a.g_hi = g + 1; hipLaunchKernelGGL(fwd_kernel, dim3(grid), dim3(NTHREADS), LDS_BYTES, stream, a); }
#endif
}
```

```cpp
#include <hip/hip_runtime.h>
#include <cstdio>
#include <cstdint>

#ifndef MK_N_LAUNCHES
#define MK_N_LAUNCHES 1
#endif

#define LAS __attribute__((address_space(3)))
#define GAS __attribute__((address_space(1)))
typedef unsigned short bf16_t;
typedef short bf16x8 __attribute__((ext_vector_type(8)));
typedef short s16x4 __attribute__((ext_vector_type(4)));
typedef float f32x4 __attribute__((ext_vector_type(4)));
typedef float f32x2 __attribute__((ext_vector_type(2)));
typedef float f32x16 __attribute__((ext_vector_type(16)));
typedef unsigned u32x4 __attribute__((ext_vector_type(4)));
typedef unsigned u32x2 __attribute__((ext_vector_type(2)));
typedef int i32x4 __attribute__((ext_vector_type(4)));
typedef int i32x8 __attribute__((ext_vector_type(8)));

constexpr int D = 1024, NB = 16, SEQ = 4096, CTXL = 256, DEPTH = 4;
constexpr int ML = NB * SEQ;
constexpr int MC = NB * CTXL;
constexpr int MT = ML + MC;
constexpr int NZ = 5888;
constexpr int ZC_P = 0, ZC_QK = 256, ZC_V = 1280, ZC_O = 1792, ZC_UV = 2304, ZC_MG = 2816;
constexpr int NZ_BF = 256, NZ_F8 = 5632;
constexpr int ZG_COL = 2816;
constexpr int NEXP = 32, TOPK = 4;
constexpr int NS_MAX = MT * TOPK + NEXP * 256;
constexpr float LN_EPS = 1e-5f, HEAD_EPS = 1e-6f;
constexpr float DN_ALPHA = 1.6817928305074292f;
constexpr int NWAVES = 8, NTHREADS = 512;
constexpr float F8S_ACT = 4.0f, F8S_WGU = 64.0f, F8S_WDN = 64.0f; constexpr int F8E_ACT = 123, F8E_WGU = 123, F8E_WDN = 123;

constexpr size_t MiB = 1u << 20;
constexpr size_t WS_CTL = 0, CTL_ZERO_BYTES = 1 * MiB;
constexpr size_t WS_MOD = 1 * MiB;
constexpr size_t WS_WG = 3 * MiB;
constexpr size_t WS_WSGU = 4 * MiB;
constexpr size_t WS_WPOOL = WS_WSGU + 512 * 1024;
constexpr size_t WS_ROUTE = 5 * MiB;
constexpr size_t WS_WIN = 16 * MiB;
constexpr size_t WS_WBR = 62 * MiB;
constexpr size_t WS_WOUT = 70 * MiB;
constexpr size_t WS_WGU = 78 * MiB;
constexpr size_t WS_WDN = 590 * MiB;
constexpr size_t WS_X = 846 * MiB;
constexpr size_t WS_H = 1118 * MiB;
constexpr size_t WS_Z = 1254 * MiB;
constexpr size_t WS_FS = WS_Z;
constexpr float G8_SCALE = 255.0f;
constexpr float FS_SCALE = 32.0f, FS_CLAMP = 440.0f;
constexpr size_t WS_BRA = 2036 * MiB;
constexpr size_t WS_HFB = 2172 * MiB;
constexpr size_t WS_Y = 2444 * MiB;
constexpr size_t WS_T = 2580 * MiB;
constexpr size_t WS_H2 = 2852 * MiB;
constexpr size_t WS_HID = 2988 * MiB;
constexpr size_t WS_ZG = 3548 * MiB;
constexpr size_t WS_H2F8 = 3554 * MiB;
constexpr size_t WS_H8 = 3624 * MiB;
constexpr size_t WS_WIN8 = 3692 * MiB;
constexpr size_t WS_END = 3714 * MiB;
static_assert(WS_Z + (size_t)MT * NZ * 2 <= WS_BRA && WS_FS + (size_t)MT * 4 * 1024 * 2 <= WS_BRA, "Z/FS");
static_assert(WS_HID + (size_t)NS_MAX * 1024 * 2 <= WS_END, "HID");
constexpr size_t RT_EIDX = 0;
constexpr size_t RT_PROB = 2 * MiB;
constexpr size_t RT_TOK = 4 * MiB;
constexpr size_t RT_DEST = 6 * MiB;
constexpr size_t RT_PSLOT = 8 * MiB;
constexpr size_t RT_CNT = 10 * MiB;
constexpr size_t RT_SEG = 10 * MiB + 64 * 1024;
constexpr int CW_BAR = 4096;

constexpr int LDS_BYTES = 163840;
constexpr int MISC_OFF = LDS_BYTES - 256;
constexpr int TAB_OFF = 131072;
constexpr int NW_WT = 0;
constexpr int NW_LG = 66048;
constexpr int NW_END = 99840;
constexpr int NW_PV = NW_END + 256;

__device__ __forceinline__ unsigned f2bf(float f) { unsigned u = __builtin_bit_cast(unsigned, f); return (u + 0x7fffu + ((u >> 16) & 1u)) >> 16; }
__device__ __forceinline__ unsigned pk2(float lo, float hi) { unsigned r; asm volatile("v_cvt_pk_bf16_f32 %0, %1, %2" : "=v"(r) : "v"(lo), "v"(hi)); return r; }
__device__ __forceinline__ unsigned pk4_fp8(float a, float b, float c, float d) { int w = 0; w = __builtin_amdgcn_cvt_pk_fp8_f32(a, b, w, false); w = __builtin_amdgcn_cvt_pk_fp8_f32(c, d, w, true); return (unsigned)w; }
__device__ __forceinline__ unsigned pk4_u8(float a, float b, float c, float d) {
    const unsigned lo = __builtin_amdgcn_perm(__builtin_bit_cast(unsigned, b), __builtin_bit_cast(unsigned, a), 0x0c0c0400u), hi = __builtin_amdgcn_perm(__builtin_bit_cast(unsigned, d), __builtin_bit_cast(unsigned, c), 0x0c0c0400u);
    return lo | (hi << 16); }
__device__ __forceinline__ f32x4 u8x4_f32(unsigned w) { return (f32x4){(float)(w & 0xffu), (float)((w >> 8) & 0xffu), (float)((w >> 16) & 0xffu), (float)(w >> 24)}; }
__device__ __forceinline__ float bflo(unsigned w) { return __builtin_bit_cast(float, w << 16); }
__device__ __forceinline__ float bfhi(unsigned w) { return __builtin_bit_cast(float, w & 0xffff0000u); }
__device__ __forceinline__ float bf1(bf16_t h) { return __builtin_bit_cast(float, ((unsigned)h) << 16); }
__device__ __forceinline__ float bperm(int srclane, float v) { return __builtin_bit_cast(float, __builtin_amdgcn_ds_bpermute(srclane << 2, __builtin_bit_cast(int, v))); }
__device__ __forceinline__ float shx(float v, int o, int lane) { return bperm(lane ^ o, v); }
__device__ __forceinline__ float shup(float v, int o, int lane) { return bperm(lane >= o ? lane - o : lane, v); }
__device__ __forceinline__ float wave_sum(float v, int lane) {
#pragma unroll
    for (int o = 1; o < 64; o <<= 1) v += shx(v, o, lane);
    return v;
}
__device__ __forceinline__ float sigmoidf_(float x) { return __builtin_amdgcn_rcpf(1.0f + __builtin_amdgcn_exp2f(x * -1.4426950408889634f)); }
__device__ __forceinline__ float siluf_(float x) { return x * __builtin_amdgcn_rcpf(1.0f + __builtin_amdgcn_exp2f(x * -1.4426950408889634f)); }
__device__ __forceinline__ f32x4 sigmoid4(f32x4 x) {
    f32x4 t = x * -1.4426950408889634f;
#pragma unroll
    for (int i = 0; i < 4; ++i) t[i] = __builtin_amdgcn_exp2f(t[i]);
    t = t + 1.0f;
#pragma unroll
    for (int i = 0; i < 4; ++i) t[i] = __builtin_amdgcn_rcpf(t[i]);
    return t; }
#define LDS_WAIT() asm volatile("s_waitcnt lgkmcnt(0)" ::: "memory")
#define VM_WAIT() asm volatile("s_waitcnt vmcnt(0)" ::: "memory")

#define XB_TMO      128
#define XB_XCNT(j)  (256  + 64 * (j))
#define XB_XSUB(j)  (1280 + 64 * (j))
#define XB_XGEN(j)  (2304 + 64 * (j))
#define XB_TOP      3328
#define XB_TOPGEN   3392
#define XCD_BAR_WORDS 3456
#define XB_SPIN_CAP (1u << 18)
__device__ __forceinline__ unsigned xb_ld(unsigned* p)              { asm volatile("" : "+v"(p)); return __hip_atomic_load(p, __ATOMIC_RELAXED, __HIP_MEMORY_SCOPE_AGENT); }
__device__ __forceinline__ unsigned xb_add(unsigned* p, unsigned v) { asm volatile("" : "+v"(p), "+v"(v)); return __hip_atomic_fetch_add(p, v, __ATOMIC_RELAXED, __HIP_MEMORY_SCOPE_AGENT); }
__device__ __forceinline__ unsigned xb_xcc_id() { return (unsigned)__builtin_amdgcn_s_getreg((3 << 11) | 20) & 0xFu; }
#define XB_SPIN(cond, bar) do { unsigned _sp = 0; while (cond) { __builtin_amdgcn_s_sleep(1); \
    if ((++_sp & 255u) == 0u) { if (xb_ld(&(bar)[XB_TMO])) break; if (_sp > XB_SPIN_CAP) { atomicAdd(&(bar)[XB_TMO], 1u); break; } } } } while (0)
struct XcdBarrier { unsigned* bar; unsigned x; volatile LAS unsigned* st; };
__device__ __forceinline__ XcdBarrier xcd_barrier_post(unsigned* bar, volatile LAS unsigned* st) {
    XcdBarrier b; b.bar = bar; b.x = xb_xcc_id(); b.st = st;
    if (threadIdx.x == 0) (void)xb_add(&bar[XB_XCNT(b.x)], 1u);
    return b;
}
__device__ __forceinline__ void xcd_barrier_complete(unsigned* bar, unsigned x, unsigned& nloc, unsigned& nx) {
    const unsigned G = gridDim.x * gridDim.y * gridDim.z;
    unsigned sum, cnt, mine, sp = 0u;
    for (;;) {
        sum = 0u; cnt = 0u; mine = 0u;
#pragma unroll
        for (unsigned j = 0; j < 16; ++j) { const unsigned c = xb_ld(&bar[XB_XCNT(j)]); sum += c; cnt += (c > 0u) ? 1u : 0u; mine = (j == x) ? c : mine; }
        if (sum == G) break;
        __builtin_amdgcn_s_sleep(1);
        if ((++sp & 255u) == 0u) { if (xb_ld(&bar[XB_TMO])) break; if (sp > XB_SPIN_CAP) { atomicAdd(&bar[XB_TMO], 1u); break; } }
    }
    nloc = mine > 0u ? mine : 1u; nx = cnt > 0u ? cnt : 1u;
}
__device__ __forceinline__ void xcd_barrier(const XcdBarrier& b) {
    asm volatile("s_waitcnt vmcnt(0)" ::: "memory");
    __syncthreads();
    if (threadIdx.x == 0) {
        unsigned* bar = b.bar;
        __builtin_amdgcn_s_waitcnt(0);
        unsigned nloc = b.st[0], nx = b.st[1];
        if (nloc == 0u) { xcd_barrier_complete(bar, b.x, nloc, nx); b.st[0] = nloc; b.st[1] = nx; }
        const unsigned old = xb_add(&bar[XB_XSUB(b.x)], 1u);
        const unsigned gen = old / nloc;
        if (old + 1u == (gen + 1u) * nloc) {
            __builtin_amdgcn_fence(__ATOMIC_RELEASE, "agent");
            asm volatile("s_waitcnt vmcnt(0)" ::: "memory");
            const unsigned og = xb_add(&bar[XB_TOP], 1u);
            const unsigned tg = og / nx;
            if (og + 1u == (tg + 1u) * nx) xb_add(&bar[XB_TOPGEN], 1u);
            else XB_SPIN(xb_ld(&bar[XB_TOPGEN]) == tg, bar);
            __builtin_amdgcn_fence(__ATOMIC_ACQUIRE, "agent");
            xb_add(&bar[XB_XGEN(b.x)], 1u);
            asm volatile("s_waitcnt vmcnt(0)" ::: "memory");
        } else {
            XB_SPIN(xb_ld(&bar[XB_XGEN(b.x)]) == gen, bar);
            __builtin_amdgcn_fence(__ATOMIC_ACQUIRE, "agent");
            asm volatile("s_waitcnt vmcnt(0)" ::: "memory");
        }
    }
    __syncthreads();
}

namespace pg8 {
constexpr int BM = 256, BK = 64, HALF = 128, HTB = HALF * BK * 2, STAGE_BYTES = 8 * HTB, NXCD = 8, WGM = 8;
__host__ __device__ __forceinline__ int lds_byte(int r, int c) { const int st = (r >> 4) * 2 + (c >> 5), rr = r & 15, cc = c & 31, ob = rr * 64 + cc * 2; return st * 1024 + (ob ^ (((ob >> 9) & 1) << 5)); }
__host__ __device__ __forceinline__ void stage_rc(int b, int& R, int& C) { const int st = b / 1024, sb = b % 1024, swz = sb ^ (((sb >> 9) & 1) << 5); R = (st >> 1) * 16 + swz / 64; C = (st & 1) * 32 + (swz % 64) / 2; }
__host__ __device__ __forceinline__ int perm32(int rho) { const int n = rho >> 4, i = rho & 15; return 8 * (i >> 2) + 4 * n + (i & 3); }
struct Unit { int pm, pn, sub; };
__device__ __forceinline__ unsigned cvt_pk_bf16(float lo, float hi) { unsigned r; asm volatile("v_cvt_pk_bf16_f32 %0, %1, %2" : "=v"(r) : "v"(lo), "v"(hi)); return r; }
__device__ __forceinline__ f32x2 gelu_pk(f32x2 v) {
    const f32x2 av = __builtin_elementwise_abs(v), d = av * 0.2316418882f + 1.0f;
    f32x2 t; t.x = __builtin_amdgcn_rcpf(d.x); t.y = __builtin_amdgcn_rcpf(d.y);
    f32x2 q = t * 0.5307027145f + (-0.7265760135f); q = q * t + 0.7107068705f; q = q * t + (-0.142248368f); q = q * t + 0.127414796f; q = q * t;
    const f32x2 s = (v * v) * (-0.72134752044f);
    f32x2 e; e.x = __builtin_amdgcn_exp2f(s.x); e.y = __builtin_amdgcn_exp2f(s.y);
    const f32x2 m = v * (q * e), r = v - m;
    f32x2 o; o.x = v.x < 0.f ? m.x : r.x; o.y = v.y < 0.f ? m.y : r.y; return o;
}
template <int NSUB = 1> struct StaticOrder {
    int nM, nN, nwg, G, c;
    __device__ void init(int nM_, int nN_, int G_, int c_) { nM = nM_; nN = nN_; nwg = nM * nN; G = G_; c = c_; }
    __device__ bool next(int i, Unit& u) const {
        const int it = i / NSUB; u.sub = i - it * NSUB;
        const long L = (long)it * G + c; if (L >= nwg) return false;
        int wgid = (int)L; { const int q = nwg / NXCD, r = nwg % NXCD, xcd = wgid % NXCD, off = wgid / NXCD; wgid = (xcd < r ? xcd * (q + 1) : r * (q + 1) + (xcd - r) * q) + off; }
        const int nig = WGM * nN, gid = wgid / nig, fm = gid * WGM, gsz = (nM - fm) < WGM ? (nM - fm) : WGM;
        u.pm = fm + ((wgid % nig) % gsz); u.pn = (wgid % nig) / gsz; return true;
    }
};
constexpr int SIDE_TOK = 131072 + 2048;
constexpr int SIDE_SLOT = 131072 + 10240, SIDE_SLOT_BYTES = 3072;
__device__ __forceinline__ void dma16(unsigned voff, const void* sbase, unsigned ldsaddr) { asm volatile("s_mov_b32 m0, %2\n\tglobal_load_lds_dwordx4 %0, %1" :: "v"(voff), "s"(sbase), "s"(ldsaddr) : "memory", "m0"); }
__device__ __forceinline__ void dma4(unsigned voff, const void* sbase, unsigned ldsaddr) { asm volatile("s_mov_b32 m0, %2\n\tglobal_load_lds_dword %0, %1" :: "v"(voff), "s"(sbase), "s"(ldsaddr) : "memory", "m0"); }
template <class Prob, class Sched, class Epi>
__device__ __forceinline__ void gemm_phase(LAS unsigned char* lds, const int tid, const Prob& P, const Sched& S, const Epi& E) {
    const int wid = __builtin_amdgcn_readfirstlane(tid >> 6), lane = tid & 63, wr = wid >> 2, wc = wid & 3, fr = lane & 15, fq = lane >> 4;
    const int lda = P.lda, ldb = P.ldb;
    unsigned voffB[2], offA[2][2];
#define PG8_TOKSLOT(name) const LAS int* name; { PG8_TID(tl2_); name = (const LAS int*)(lds + SIDE_TOK) + (tl2_ >> 6) * 256 + (tl2_ & 63); }
#define PG8_TID(v_) int v_; asm volatile("v_mbcnt_lo_u32_b32 %0, -1, 0\n\tv_mbcnt_hi_u32_b32 %0, -1, %0" : "=v"(v_)); v_ |= (wid << 6)
#define PG8_RC(R_, C_) int R_[2], C_[2]; { PG8_TID(tl_); _Pragma("unroll") for (int i_ = 0; i_ < 2; ++i_) stage_rc(tl_ * 16 + i_ * 8192, R_[i_], C_[i_]); }
#pragma unroll
    for (int i = 0; i < 2; ++i) { int R, C; stage_rc(tid * 16 + i * 8192, R, C); const int Rb = Epi::PERM ? ((R & ~31) + perm32(R & 31)) : R;
        voffB[i] = (unsigned)(Rb * ldb + C) * 2u;
        offA[0][i] = (unsigned)(R * lda + C) * 2u; offA[1][i] = (unsigned)((R + HALF) * lda + C) * 2u; }
    const size_t kstep = (size_t)(BK * 2);
    const size_t hstep = (size_t)HALF * ldb * 2;
    const unsigned ldsw = (unsigned)wid * 1024u;
    const int aoff = lds_byte(wr * 64 + fr, fq * 8), boff = lds_byte(wc * 32 + fr, fq * 8);
#define PG8_SA(b, h) (((b) * 2 + (h)) * HTB)
#define PG8_SB(b, h) ((4 + (b) * 2 + (h)) * HTB)
    const unsigned ldsb = (unsigned)(size_t)lds;
#define PG8_STAGE(bufoff, gbase, voff) do { _Pragma("unroll") for (int _i = 0; _i < 2; ++_i) \
        asm volatile("s_mov_b32 m0, %2\n\tglobal_load_lds_dwordx4 %0, %1" :: "v"((voff)[_i]), "s"((const char*)(gbase)), "s"(ldsb + (unsigned)(bufoff) + ldsw + (unsigned)(_i * 8192)) : "memory", "m0"); } while (0)
#define PG8_CAT(x0, x1) __builtin_shufflevector(x0, x1, 0, 1, 2, 3, 4, 5, 6, 7)
#define PG8_LDA(dst, b, h) do { if constexpr (Prob::FP8) { _Pragma("unroll") for (int m = 0; m < 4; ++m) dst##8[m] = PG8_CAT(*(const LAS i32x4*)(lds + PG8_SA(b, h) + aoff + m * 2048), *(const LAS i32x4*)(lds + PG8_SA(b, h) + aoff + m * 2048 + 1024)); } \
        else { _Pragma("unroll") for (int m = 0; m < 4; ++m) _Pragma("unroll") for (int k = 0; k < 2; ++k) dst[m][k] = *(const LAS bf16x8*)(lds + PG8_SA(b, h) + aoff + m * 2048 + k * 1024); } } while (0)
#define PG8_LDB(dst, b, h) do { if constexpr (Prob::FP8) { _Pragma("unroll") for (int n = 0; n < 2; ++n) dst##8[n] = PG8_CAT(*(const LAS i32x4*)(lds + PG8_SB(b, h) + boff + n * 2048), *(const LAS i32x4*)(lds + PG8_SB(b, h) + boff + n * 2048 + 1024)); } \
        else { _Pragma("unroll") for (int n = 0; n < 2; ++n) _Pragma("unroll") for (int k = 0; k < 2; ++k) dst[n][k] = *(const LAS bf16x8*)(lds + PG8_SB(b, h) + boff + n * 2048 + k * 1024); } } while (0)
#define PG8_MMA(ai, bj, At, Bt) do { __builtin_amdgcn_s_setprio(1); \
        if constexpr (Prob::FP8) { _Pragma("unroll") for (int m = 0; m < 4; ++m) _Pragma("unroll") for (int n = 0; n < 2; ++n) \
            acc[ai][bj][m][n] = __builtin_amdgcn_mfma_scale_f32_16x16x128_f8f6f4(Bt##8[n], At##8[m], acc[ai][bj][m][n], 0, 0, 0, sc8_, 0, sc8_); } \
        else { _Pragma("unroll") for (int m = 0; m < 4; ++m) _Pragma("unroll") for (int n = 0; n < 2; ++n) _Pragma("unroll") for (int k = 0; k < 2; ++k) \
            acc[ai][bj][m][n] = __builtin_amdgcn_mfma_f32_16x16x32_bf16(Bt[n][k], At[m][k], acc[ai][bj][m][n], 0, 0, 0); } \
        __builtin_amdgcn_s_setprio(0); } while (0)
#define PG8_WAIT_V(n) asm volatile("s_waitcnt vmcnt(" #n ")" ::: "memory")
#define PG8_WAIT_L(n) asm volatile("s_waitcnt lgkmcnt(" #n ")" ::: "memory")
#define PG8_BAR __builtin_amdgcn_s_barrier()
#define PG8_SCHED __builtin_amdgcn_sched_barrier(0)
    Unit cur, nxt; int ui = 0;
    if (!S.next(0, cur)) return;
    static_assert(Prob::SCALE_A == Prob::SCALE_B, "one scale register serves both operands");
    int sc8_; asm volatile("v_mov_b32 %0, %1" : "=v"(sc8_) : "n"(Prob::SCALE_A));
    f32x4 acc[2][2][4][2];
    float zero_; asm volatile("v_mov_b32 %0, 0" : "=v"(zero_));
#pragma unroll
    for (int a = 0; a < 2; ++a)
#pragma unroll
        for (int b = 0; b < 2; ++b)
#pragma unroll
            for (int m = 0; m < 4; ++m)
#pragma unroll
                for (int n = 0; n < 2; ++n) acc[a][b][m][n] = (f32x4){zero_, zero_, zero_, zero_};
    bf16x8 At[4][2], B0[2][2], B1[2][2]; i32x8 At8[4], B08[2], B18[2];
    const char* cA = P.a_base(cur); const char* cB = P.b_base(cur); int nt = P.nt(cur);
    if constexpr (Prob::GATHER) { PG8_RC(Rr, Cc); P.a_rows(cur, Rr, Cc, offA); }
    if constexpr (Epi::SIDE) { PG8_TID(tl4_); E.side(cur, ldsb + SIDE_SLOT, wid, tl4_ & 63); }
    PG8_STAGE(PG8_SB(0, 0), cB, voffB); PG8_STAGE(PG8_SB(0, 1), cB + hstep, voffB); PG8_STAGE(PG8_SA(0, 0), cA, offA[0]); PG8_STAGE(PG8_SA(0, 1), cA, offA[1]);
    if (wr == 1) PG8_BAR;
    PG8_WAIT_V(2); PG8_BAR;
    PG8_STAGE(PG8_SB(1, 0), cB + kstep, voffB); PG8_STAGE(PG8_SA(1, 0), cA + kstep, offA[0]); PG8_STAGE(PG8_SB(1, 1), cB + hstep + kstep, voffB);
    PG8_WAIT_V(6); PG8_BAR;
    for (;;) {
        const bool has_next = S.next(ui + 1, nxt);
        const char* nA = has_next ? P.a_base(nxt) : cA; const char* nB = has_next ? P.b_base(nxt) : cB;
        if constexpr (Prob::GATHER) { if (has_next) { PG8_RC(Rr, Cc); (void)Cc;
#pragma unroll
            for (int h = 0; h < 2; ++h)
#pragma unroll
                for (int i = 0; i < 2; ++i) dma4((unsigned)(nxt.pm * 256 + h * 128 + Rr[i]) * 4u, P.tok, ldsb + SIDE_TOK + (unsigned)wid * 1024u + (unsigned)((h * 2 + i) * 256)); } }
        if constexpr (Epi::SIDE) { if (has_next) { PG8_TID(tl4_); E.side(nxt, ldsb + SIDE_SLOT + (unsigned)(((ui + 1) % 3) * SIDE_SLOT_BYTES), wid, tl4_ & 63); } }
        for (int t = 0; t < nt; t += 2) {
            const bool last = (t == nt - 2);
            if constexpr (Epi::KHOOK) { if (t == Epi::HOOK_T0 || t == Epi::HOOK_T1) {
                asm volatile("" ::: "memory"); PG8_TID(tlh_); const int lnh_ = tlh_ & 63; E.hook(acc, cur, t == Epi::HOOK_T0 ? 0 : 1, wr, wc, lnh_ & 15, lnh_ >> 4); asm volatile("" ::: "memory"); } }
            const char* a1 = cA + (size_t)(t + 1) * kstep;
            const char* a2 = last ? nA : cA + (size_t)(t + 2) * kstep; const char* b2 = last ? nB : cB + (size_t)(t + 2) * kstep;
            const char* a3 = a2 + kstep; const char* b3 = b2 + kstep;
            PG8_LDB(B0, 0, 0); PG8_LDB(B1, 0, 1); PG8_SCHED; PG8_LDA(At, 0, 0); PG8_STAGE(PG8_SA(1, 1), a1, offA[1]);
            PG8_WAIT_V(8); PG8_WAIT_L(0); PG8_BAR; PG8_MMA(0, 0, At, B0); PG8_MMA(0, 1, At, B1); PG8_BAR; PG8_SCHED;
            if constexpr (Prob::GATHER) { if (last && has_next) { PG8_RC(Rr, Cc); (void)Rr; PG8_TOKSLOT(tokslot); const int ntok[2][2] = {{tokslot[0], tokslot[64]}, {tokslot[128], tokslot[192]}}; P.a_off(ntok, Cc, offA); } }
            PG8_LDA(At, 0, 1); PG8_STAGE(PG8_SB(0, 0), b2, voffB); PG8_STAGE(PG8_SB(0, 1), b2 + hstep, voffB); PG8_STAGE(PG8_SA(0, 0), a2, offA[0]);
            PG8_WAIT_V(8); PG8_WAIT_L(0); PG8_BAR; PG8_MMA(1, 0, At, B0); PG8_MMA(1, 1, At, B1); PG8_BAR; PG8_SCHED;
            PG8_LDB(B0, 1, 0); PG8_LDB(B1, 1, 1); PG8_SCHED; PG8_LDA(At, 1, 0); PG8_STAGE(PG8_SA(0, 1), a2, offA[1]);
            PG8_WAIT_V(8); PG8_WAIT_L(0); PG8_BAR; PG8_MMA(0, 0, At, B0); PG8_MMA(0, 1, At, B1); PG8_BAR; PG8_SCHED;
            PG8_LDA(At, 1, 1); PG8_STAGE(PG8_SB(1, 0), b3, voffB); PG8_STAGE(PG8_SB(1, 1), b3 + hstep, voffB); PG8_STAGE(PG8_SA(1, 0), a3, offA[0]);
            PG8_WAIT_V(8); PG8_WAIT_L(0); PG8_BAR; PG8_MMA(1, 0, At, B0); PG8_MMA(1, 1, At, B1); PG8_BAR; PG8_SCHED;
        }
        if (wr == 0) PG8_BAR;
        { PG8_TID(tl3_); const int ln_ = tl3_ & 63; E(acc, cur, wr, wc, ln_ & 15, ln_ >> 4, lds + SIDE_SLOT + (ui % 3) * SIDE_SLOT_BYTES); }
        if (!has_next) break;
        bool keep = false;
        if constexpr (Epi::CHAIN) keep = E.keep(cur);
        if (!keep) {
            asm volatile("v_mov_b32 %0, 0" : "=v"(zero_));
#pragma unroll
            for (int a = 0; a < 2; ++a)
#pragma unroll
                for (int b = 0; b < 2; ++b)
#pragma unroll
                    for (int m = 0; m < 4; ++m)
#pragma unroll
                        for (int n = 0; n < 2; ++n) acc[a][b][m][n] = (f32x4){zero_, zero_, zero_, zero_};
        }
        cur = nxt; cA = nA; cB = nB; nt = P.nt(cur); ++ui;
        if (wr == 1) PG8_BAR;
    }
    PG8_WAIT_V(0);
    PG8_BAR;
#undef PG8_RC
#undef PG8_TID
#undef PG8_TOKSLOT
#undef PG8_SA
#undef PG8_SB
#undef PG8_STAGE
#undef PG8_LDA
#undef PG8_LDB
#undef PG8_MMA
#undef PG8_CAT
#undef PG8_WAIT_V
#undef PG8_WAIT_L
#undef PG8_BAR
#undef PG8_SCHED
}
}

typedef const float* cfp_t;
typedef const cfp_t __attribute__((address_space(4))) * InTab;
struct Frame {
    LAS unsigned char* lds;
    volatile LAS unsigned* MISC;
    unsigned char* ws;
    InTab in;
    float* out;
    int tid, lane, wave, G, bid;
};
enum { IN_X = 0, IN_C, IN_CTX, IN_CCTX, IN_WADA, IN_BADA, IN_WIN, IN_BIN, IN_POOLW, IN_POOLS, IN_CONVW, IN_CONVB, IN_MNG, IN_SLNG, IN_SLNB, IN_SGUW, IN_SGUB,
       IN_WBP, IN_WBM, IN_WBS, IN_WOUT, IN_LN1G, IN_LN1B, IN_WR, IN_BR, IN_WGU, IN_BGU, IN_WDN, IN_BDN, IN_LN2G, IN_LN2B };
__device__ __forceinline__ int mod_row(int row) { return row < ML ? (row >> 12) : NB; }
__device__ __forceinline__ const float* modp(const Frame& F, int l, int row, int part) { return (const float*)(F.ws + WS_MOD) + ((size_t)(l * 17 + mod_row(row)) * 6 + part) * 1024; }

__device__ __forceinline__ void transpose_item(const float* W, size_t ldw, int k0, int srccol0, bf16_t* dst, size_t ldk, int kd0, LAS float* scr, int lane) {
#pragma unroll 8
    for (int i = 0; i < 32; ++i) { const int kk = 2 * i + (lane >> 5); scr[kk * 33 + (lane & 31)] = __builtin_nontemporal_load(W + (size_t)(k0 + kk) * ldw + srccol0 + (lane & 31)); }
    LDS_WAIT(); asm volatile("" ::: "memory");
    const int c = lane & 7;
#pragma unroll
    for (int j = 0; j < 4; ++j) { const int n = (lane >> 3) + 8 * j; const LAS float* s = scr + (8 * c) * 33 + n;
        u32x4 o; o.x = pk2(s[0 * 33], s[1 * 33]); o.y = pk2(s[2 * 33], s[3 * 33]); o.z = pk2(s[4 * 33], s[5 * 33]); o.w = pk2(s[6 * 33], s[7 * 33]);
        *(u32x4*)(dst + (size_t)n * ldk + kd0 + 8 * c) = o; }
    LDS_WAIT(); asm volatile("" ::: "memory");
}
__device__ __forceinline__ void transpose_item_fp8(const float* W, size_t ldw, int k0, int srccol0, unsigned char* dst, size_t ldk, int kd0, float sc, LAS float* scr, int lane) {
#pragma unroll 8
    for (int i = 0; i < 32; ++i) { const int kk = 2 * i + (lane >> 5); scr[kk * 33 + (lane & 31)] = __builtin_nontemporal_load(W + (size_t)(k0 + kk) * ldw + srccol0 + (lane & 31)); }
    LDS_WAIT(); asm volatile("" ::: "memory");
    const int c = lane & 7;
#pragma unroll
    for (int j = 0; j < 4; ++j) { const int n = (lane >> 3) + 8 * j; const LAS float* s_ = scr + (8 * c) * 33 + n;
        u32x2 o; o.x = pk4_fp8(s_[0 * 33] * sc, s_[1 * 33] * sc, s_[2 * 33] * sc, s_[3 * 33] * sc); o.y = pk4_fp8(s_[4 * 33] * sc, s_[5 * 33] * sc, s_[6 * 33] * sc, s_[7 * 33] * sc);
        *(u32x2*)(dst + (size_t)n * ldk + kd0 + 8 * c) = o; }
    LDS_WAIT(); asm volatile("" ::: "memory");
}
__device__ __forceinline__ void phase_prologue(Frame& F) {
    LAS float* scr = (LAS float*)(F.lds + F.wave * 16384);
    const int gw = F.bid * NWAVES + F.wave, NGW = F.G * NWAVES;
    constexpr int I_IN = 16 * (NZ / 32);
    constexpr int I_BR = (4 + 8 + 4) * 32;
    constexpr int I_OUT = 16 * 32;
    constexpr int I_GU = 16 * 64;
    constexpr int I_DN = 16 * 32;
    constexpr int T_IN = DEPTH * I_IN, T_BR = DEPTH * I_BR, T_OUT = DEPTH * I_OUT, T_GU = DEPTH * NEXP * I_GU, T_DN = DEPTH * NEXP * I_DN;
    constexpr int NITEMS = T_IN + T_BR + T_OUT + T_GU + T_DN;
    for (int it = gw; it < NITEMS; it += NGW) {
        int r = it;
        if (r < T_IN) { const int l = r / I_IN; r %= I_IN; const int kb = r / (NZ / 32), nb = r % (NZ / 32); const int n0 = nb * 32, src = n0 < 2304 ? n0 : n0 + 16;
            if (n0 < NZ_BF) transpose_item(F.in[IN_WIN] + (size_t)l * D * 5904, 5904, kb * 64, src, (bf16_t*)(F.ws + WS_WIN) + ((size_t)l * NZ + n0) * D, D, kb * 64, scr, F.lane);
            else transpose_item_fp8(F.in[IN_WIN] + (size_t)l * D * 5904, 5904, kb * 64, src, (unsigned char*)(F.ws + WS_WIN8) + ((size_t)l * NZ_F8 + (n0 - NZ_BF)) * D, D, kb * 64, F8S_WGU, scr, F.lane);
            continue; }
        r -= T_IN;
        if (r < T_BR) { const int l = r / I_BR; r %= I_BR; const int kb = r / 32, nb = r % 32;
            const float* W; int ksrc;
            if (kb < 4) { W = F.in[IN_WBP] + (size_t)l * 256 * D; ksrc = kb * 64; } else if (kb < 12) { W = F.in[IN_WBM] + (size_t)l * 512 * D; ksrc = (kb - 4) * 64; } else { W = F.in[IN_WBS] + (size_t)l * 256 * D; ksrc = (kb - 12) * 64; }
            transpose_item(W, D, ksrc, nb * 32, (bf16_t*)(F.ws + WS_WBR) + ((size_t)l * D + nb * 32) * D, D, kb * 64, scr, F.lane); continue; }
        r -= T_BR;
        if (r < T_OUT) { const int l = r / I_OUT; r %= I_OUT; const int kb = r / 32, nb = r % 32;
            transpose_item(F.in[IN_WOUT] + (size_t)l * D * D, D, kb * 64, nb * 32, (bf16_t*)(F.ws + WS_WOUT) + ((size_t)l * D + nb * 32) * D, D, kb * 64, scr, F.lane); continue; }
        r -= T_OUT;
        if (r < T_GU) { const int le = r / I_GU; r %= I_GU; const int kb = r / 64, nb = r % 64; const int n0 = nb * 32;
            const int pn = n0 >> 8, c = n0 & 255; const int src = c < 128 ? (128 * pn + c) : (1024 + 128 * pn + c - 128);
            transpose_item_fp8(F.in[IN_WGU] + (size_t)le * D * 2048, 2048, kb * 64, src, (unsigned char*)(F.ws + WS_WGU) + ((size_t)le * 2048 + n0) * D, D, kb * 64, F8S_WGU, scr, F.lane); continue; }
        r -= T_GU;
        { const int le = r / I_DN; r %= I_DN; const int kb = r / 32, nb = r % 32;
            transpose_item_fp8(F.in[IN_WDN] + (size_t)le * D * D, D, kb * 64, nb * 32, (unsigned char*)(F.ws + WS_WDN) + ((size_t)le * D + nb * 32) * D, D, kb * 64, F8S_WDN, scr, F.lane); }
    }
    { const int gt = F.bid * NTHREADS + F.tid, NGT = F.G * NTHREADS;
      for (int i = gt; i < DEPTH * 16 * 1024; i += NGT) { const int l = i >> 14, g = (i >> 10) & 15, k = i & 1023; ((float*)(F.ws + WS_WG))[i] = F.in[IN_WIN][((size_t)l * D + k) * 5904 + 2304 + g]; }
      for (int i = gt; i < DEPTH * 4 * 128 * 128; i += NGT) ((bf16_t*)(F.ws + WS_WSGU))[i] = (bf16_t)f2bf(F.in[IN_SGUW][i]);
      for (int i = gt; i < DEPTH * 4 * 64 * 64; i += NGT) { const int lg = i >> 12, d = (i >> 6) & 63, c = i & 63; ((bf16_t*)(F.ws + WS_WPOOL))[i] = (bf16_t)f2bf(F.in[IN_POOLW][(size_t)lg * 4096 + c * 64 + d]); } }
    __syncthreads();
    { LAS float* sc = (LAS float*)F.lds;
      LAS float* part = (LAS float*)(F.lds + 71680);
      for (int i = F.tid; i < 17 * 1024; i += NTHREADS) { const int r = i >> 10, k = i & 1023; const float v = r < 16 ? F.in[IN_C][r * 1024 + k] : F.in[IN_CCTX][k]; sc[i] = siluf_(v); }
      __syncthreads();
      for (int u = F.bid; u < DEPTH * 48; u += F.G) {
          const int l = u / 48, n0 = (u % 48) * 128, col = F.tid & 127, ks = F.tid >> 7;
          float a[17];
#pragma unroll
          for (int r = 0; r < 17; ++r) a[r] = 0.f;
          const float* W = F.in[IN_WADA] + (size_t)l * D * 6144 + n0 + col;
          for (int k = ks * 256; k < ks * 256 + 256; ++k) { const float w = W[(size_t)k * 6144];
#pragma unroll
              for (int r = 0; r < 17; ++r) a[r] += sc[r * 1024 + k] * w; }
#pragma unroll
          for (int r = 0; r < 17; ++r) part[(ks * 17 + r) * 128 + col] = a[r];
          __syncthreads();
          for (int i = F.tid; i < 17 * 128; i += NTHREADS) { const int r = i >> 7, cc = i & 127;
              const float s = part[(0 * 17 + r) * 128 + cc] + part[(1 * 17 + r) * 128 + cc] + part[(2 * 17 + r) * 128 + cc] + part[(3 * 17 + r) * 128 + cc] + F.in[IN_BADA][l * 6144 + n0 + cc];
              ((float*)(F.ws + WS_MOD))[(size_t)(l * 17 + r) * 6144 + n0 + cc] = s; }
          __syncthreads();
      } }
}

struct RowV { f32x4 v[4]; };
#define RC(lane, j) (8 * (lane) + 512 * ((j) >> 1) + 4 * ((j) & 1))
__device__ __forceinline__ void row_load(RowV& r, const float* p, int lane) {
#pragma unroll
    for (int j = 0; j < 4; ++j) r.v[j] = __builtin_nontemporal_load((const f32x4*)(p + RC(lane, j)));
}
__device__ __forceinline__ void row_load_bf16(RowV& r, const bf16_t* p, int lane) {
#pragma unroll
    for (int h = 0; h < 2; ++h) { const u32x4 w = __builtin_nontemporal_load((const u32x4*)(p + 8 * lane + 512 * h)); r.v[2 * h] = (f32x4){bflo(w.x), bfhi(w.x), bflo(w.y), bfhi(w.y)}; r.v[2 * h + 1] = (f32x4){bflo(w.z), bfhi(w.z), bflo(w.w), bfhi(w.w)}; }
}
__device__ __forceinline__ void row_store(const RowV& r, float* p, int lane) {
#pragma unroll
    for (int j = 0; j < 4; ++j) *(f32x4*)(p + RC(lane, j)) = r.v[j];
}
__device__ __forceinline__ void row_store_nt(const RowV& r, float* p, int lane) {
#pragma unroll
    for (int j = 0; j < 4; ++j) __builtin_nontemporal_store(r.v[j], (f32x4*)(p + RC(lane, j)));
}
__device__ __forceinline__ void row_store_bf16_nt(const RowV& r, bf16_t* p, int lane) {
#pragma unroll
    for (int h = 0; h < 2; ++h) { u32x4 w; w.x = pk2(r.v[2 * h].x, r.v[2 * h].y); w.y = pk2(r.v[2 * h].z, r.v[2 * h].w); w.z = pk2(r.v[2 * h + 1].x, r.v[2 * h + 1].y); w.w = pk2(r.v[2 * h + 1].z, r.v[2 * h + 1].w); __builtin_nontemporal_store(w, (u32x4*)(p + 8 * lane + 512 * h)); }
}
__device__ __forceinline__ void row_store_bf16(const RowV& r, bf16_t* p, int lane) {
#pragma unroll
    for (int h = 0; h < 2; ++h) { u32x4 w; w.x = pk2(r.v[2 * h].x, r.v[2 * h].y); w.y = pk2(r.v[2 * h].z, r.v[2 * h].w); w.z = pk2(r.v[2 * h + 1].x, r.v[2 * h + 1].y); w.w = pk2(r.v[2 * h + 1].z, r.v[2 * h + 1].w); *(u32x4*)(p + 8 * lane + 512 * h) = w; }
}
__device__ __forceinline__ void row_ln_plain(RowV& r, int lane) {
    float s = 0.f;
#pragma unroll
    for (int j = 0; j < 4; ++j) s += (r.v[j].x + r.v[j].y) + (r.v[j].z + r.v[j].w);
    const float mean = wave_sum(s, lane) * (1.f / D); float s2 = 0.f;
#pragma unroll
    for (int j = 0; j < 4; ++j) { r.v[j] = r.v[j] - mean; s2 += (r.v[j].x * r.v[j].x + r.v[j].y * r.v[j].y) + (r.v[j].z * r.v[j].z + r.v[j].w * r.v[j].w); }
    const float rstd = 1.f / sqrtf(wave_sum(s2, lane) * (1.f / D) + LN_EPS);
#pragma unroll
    for (int j = 0; j < 4; ++j) r.v[j] = r.v[j] * rstd;
}
__device__ __forceinline__ void row_affine(RowV& r, const float* g, const float* b, int lane) {
#pragma unroll
    for (int j = 0; j < 4; ++j) { const f32x4 gg = *(const f32x4*)(g + RC(lane, j)), bb = *(const f32x4*)(b + RC(lane, j)); r.v[j] = r.v[j] * gg + bb; }
}
__device__ __forceinline__ void row_modulate(RowV& r, const float* sh, const float* sc, int lane) {
#pragma unroll
    for (int j = 0; j < 4; ++j) { const f32x4 s1 = *(const f32x4*)(sc + RC(lane, j)), s0 = *(const f32x4*)(sh + RC(lane, j)); r.v[j] = r.v[j] * (s1 + 1.0f) + s0; }
}
__device__ __forceinline__ LAS float* pv_slot(const Frame& F, int slot) { return (LAS float*)(F.lds + NW_PV) + slot * 1024; }
__device__ __forceinline__ void pv_fill(Frame& F, int slot, const float* src) { LAS f32x4* d = (LAS f32x4*)pv_slot(F, slot); for (int i = F.tid; i < 256; i += NTHREADS) d[i] = *(const f32x4*)(src + 4 * i); }
__device__ __forceinline__ void row_affine_l(RowV& r, const LAS float* g, const LAS float* b, int lane) {
#pragma unroll
    for (int j = 0; j < 4; ++j) { const f32x4 gg = *(const LAS f32x4*)(g + RC(lane, j)), bb = *(const LAS f32x4*)(b + RC(lane, j)); r.v[j] = r.v[j] * gg + bb; }
}
__device__ __forceinline__ void row_modulate_l(RowV& r, const LAS float* sh, const LAS float* sc, int lane) {
#pragma unroll
    for (int j = 0; j < 4; ++j) { const f32x4 s1 = *(const LAS f32x4*)(sc + RC(lane, j)), s0 = *(const LAS f32x4*)(sh + RC(lane, j)); r.v[j] = r.v[j] * (s1 + 1.0f) + s0; }
}
__device__ __forceinline__ void ln0_row(Frame& F, int row, RowV xr, const LAS float* sh, const LAS float* sc) {
    row_ln_plain(xr, F.lane);
    row_modulate_l(xr, sh, sc, F.lane);
    row_store_bf16(xr, (bf16_t*)(F.ws + WS_H) + (size_t)row * D, F.lane);
    { unsigned char* h8 = (unsigned char*)(F.ws + WS_H8) + (size_t)row * D + 8 * F.lane;
#pragma unroll
      for (int h = 0; h < 2; ++h) { u32x2 w; w.x = pk4_fp8(xr.v[2 * h].x * F8S_ACT, xr.v[2 * h].y * F8S_ACT, xr.v[2 * h].z * F8S_ACT, xr.v[2 * h].w * F8S_ACT); w.y = pk4_fp8(xr.v[2 * h + 1].x * F8S_ACT, xr.v[2 * h + 1].y * F8S_ACT, xr.v[2 * h + 1].z * F8S_ACT, xr.v[2 * h + 1].w * F8S_ACT); *(u32x2*)(h8 + 512 * h) = w; } }
}
__device__ __forceinline__ LAS float* narrow_tile_wave(Frame& F, const bf16_t* A) {
    const int r = F.lane & 31, h = F.lane >> 5;
    f32x16 acc;
#pragma unroll
    for (int i = 0; i < 16; ++i) acc[i] = 0.f;
    const bf16_t* ap = A + (size_t)r * D + 8 * h;
    const LAS unsigned char* bp = F.lds + NW_WT + r * 2064 + 16 * h;
    bf16x8 av[2][16];
#pragma unroll
    for (int ks = 0; ks < 16; ++ks) av[0][ks] = *(const bf16x8*)(ap + ks * 16);
#pragma unroll
    for (int kb = 0; kb < 4; ++kb) {
        if (kb < 3) {
#pragma unroll
            for (int ks = 0; ks < 16; ++ks) av[(kb + 1) & 1][ks] = *(const bf16x8*)(ap + ((kb + 1) * 16 + ks) * 16); }
        __builtin_amdgcn_sched_barrier(0);
#pragma unroll
        for (int ks = 0; ks < 16; ++ks) { const bf16x8 b = *(const LAS bf16x8*)(bp + (kb * 16 + ks) * 32); acc = __builtin_amdgcn_mfma_f32_32x32x16_bf16(av[kb & 1][ks], b, acc, 0, 0, 0); }
        __builtin_amdgcn_sched_barrier(0);
    }
    LAS float* lg = (LAS float*)(F.lds + NW_LG) + F.wave * 1056;
#pragma unroll
    for (int i = 0; i < 16; ++i) lg[((i & 3) + 8 * (i >> 2) + 4 * h) * 33 + r] = acc[i];
    asm volatile("s_waitcnt lgkmcnt(0)" ::: "memory");
    return lg;
}
__device__ __forceinline__ void tile_range(const Frame& F, int mrows, int& t_lo, int& t_hi) { const int nt = mrows / 32; t_lo = (int)(((long)F.bid * nt) / F.G); t_hi = (int)(((long)(F.bid + 1) * nt) / F.G); }
__device__ __forceinline__ void load_wg_lds(Frame& F, int l) {
    const float* src = (const float*)(F.ws + WS_WG) + (size_t)l * 16384;
    for (int i = F.tid; i < 32 * 128; i += NTHREADS) { const int g = i >> 7, c8 = i & 127; u32x4 w = (u32x4){0u, 0u, 0u, 0u};
        if (g < 16) { const f32x4 a = *(const f32x4*)(src + g * 1024 + c8 * 8), b = *(const f32x4*)(src + g * 1024 + c8 * 8 + 4); w.x = pk2(a.x, a.y); w.y = pk2(a.z, a.w); w.z = pk2(b.x, b.y); w.w = pk2(b.z, b.w); }
        *(LAS u32x4*)(F.lds + NW_WT + g * 2064 + c8 * 16) = w; }
    __syncthreads();
}
__device__ __forceinline__ void gates_tail(Frame& F, int l, int t_lo, int t_hi) {
    asm volatile("s_waitcnt vmcnt(0)" ::: "memory"); __syncthreads();
    const int g = F.lane & 15; const float bias = F.in[IN_BIN][l * 5904 + 2304 + g];
    for (int tile = t_lo + F.wave; tile < t_hi; tile += NWAVES) {
        const LAS float* lg = narrow_tile_wave(F, (const bf16_t*)(F.ws + WS_H) + (size_t)tile * 32 * D);
#pragma unroll
        for (int rr = 0; rr < 8; ++rr) { const int row = rr * 4 + (F.lane >> 4); ((float*)(F.ws + WS_ZG))[(size_t)(tile * 32 + row) * 16 + g] = lg[row * 33 + g] + bias; }
        asm volatile("s_waitcnt lgkmcnt(0)" ::: "memory");
    }
}

using pg8::Unit;
struct ProbPlain {
    static constexpr bool GATHER = false, FP8 = false; static constexpr int SCALE_A = 127, SCALE_B = 127; const bf16_t* A; const bf16_t* Bt; int lda, ldb;
    __device__ __forceinline__ int nt(const Unit&) const { return lda / 64; }
    __device__ __forceinline__ const char* a_base(const Unit& u) const { return (const char*)A + (size_t)u.pm * 256 * lda * 2; }
    __device__ __forceinline__ const char* b_base(const Unit& u) const { return (const char*)Bt + (size_t)u.pn * 256 * ldb * 2; }
    __device__ __forceinline__ void a_tok(const Unit&, const int (&)[2], int (&)[2][2]) const {}
    __device__ __forceinline__ void a_off(const int (&)[2][2], const int (&)[2], unsigned (&)[2][2]) const {}
    __device__ __forceinline__ void a_rows(const Unit&, const int (&)[2], const int (&)[2], unsigned (&)[2][2]) const {}
};
struct ProbPlainF8 {
    static constexpr bool GATHER = false, FP8 = true; static constexpr int SCALE_A = F8E_ACT, SCALE_B = F8E_WGU; const bf16_t* A; const bf16_t* Bt; int lda, ldb;
    __device__ __forceinline__ int nt(const Unit&) const { return lda / 64; }
    __device__ __forceinline__ const char* a_base(const Unit& u) const { return (const char*)A + (size_t)u.pm * 256 * lda * 2; }
    __device__ __forceinline__ const char* b_base(const Unit& u) const { return (const char*)Bt + (size_t)u.pn * 256 * ldb * 2; }
    __device__ __forceinline__ void a_tok(const Unit&, const int (&)[2], int (&)[2][2]) const {}
    __device__ __forceinline__ void a_off(const int (&)[2][2], const int (&)[2], unsigned (&)[2][2]) const {}
    __device__ __forceinline__ void a_rows(const Unit&, const int (&)[2], const int (&)[2], unsigned (&)[2][2]) const {}
};
struct ProbBranch {
    static constexpr bool GATHER = false, FP8 = false; static constexpr int SCALE_A = 127, SCALE_B = 127; const bf16_t* A; const bf16_t* Bt; int lda, ldb;
    __device__ __forceinline__ int nt(const Unit& u) const { return u.sub == 1 ? 8 : 4; }
    __device__ __forceinline__ int koff(const Unit& u) const { return u.sub == 0 ? 0 : (u.sub == 1 ? 256 : 768); }
    __device__ __forceinline__ const char* a_base(const Unit& u) const { return (const char*)A + ((size_t)u.pm * 256 * lda + koff(u)) * 2; }
    __device__ __forceinline__ const char* b_base(const Unit& u) const { return (const char*)Bt + ((size_t)u.pn * 256 * ldb + koff(u)) * 2; }
    __device__ __forceinline__ void a_tok(const Unit&, const int (&)[2], int (&)[2][2]) const {}
    __device__ __forceinline__ void a_off(const int (&)[2][2], const int (&)[2], unsigned (&)[2][2]) const {}
    __device__ __forceinline__ void a_rows(const Unit&, const int (&)[2], const int (&)[2], unsigned (&)[2][2]) const {}
};
__device__ __forceinline__ int expert_of(const LAS int* seg, int pm) { return __builtin_amdgcn_readfirstlane((int)((const LAS unsigned char*)(seg + 64))[pm]); }
__device__ __forceinline__ int moe_tables(Frame& F, LAS int* seg) {
    __syncthreads();
    if (F.tid <= NEXP) seg[F.tid] = ((const int*)(F.ws + WS_ROUTE + RT_SEG))[F.tid];
    __syncthreads();
    const int ntile = seg[NEXP] / 256;
    LAS unsigned char* texp = (LAS unsigned char*)(seg + 64);
    for (int t = F.tid; t < ntile; t += NTHREADS) { const int row = t * 256; int e = 0;
#pragma unroll
        for (int i = 1; i < NEXP; ++i) e += (seg[i] <= row) ? 1 : 0;
        texp[t] = (unsigned char)e; }
    __syncthreads();
    return ntile;
}
struct ProbMoe1 {
    static constexpr bool GATHER = true, FP8 = true; static constexpr int SCALE_A = F8E_ACT, SCALE_B = F8E_WGU; const bf16_t* A; const bf16_t* Bt; int lda, ldb; const int* tok; const LAS int* seg;
    __device__ __forceinline__ int nt(const Unit&) const { return lda / 64; }
    __device__ __forceinline__ const char* a_base(const Unit&) const { return (const char*)A; }
    __device__ __forceinline__ const char* b_base(const Unit& u) const { const int e = expert_of(seg, u.pm); return (const char*)Bt + ((size_t)e * 2048 + (size_t)u.pn * 256) * ldb * 2; }
    __device__ __forceinline__ void a_rows(const Unit& u, const int (&R)[2], const int (&C)[2], unsigned (&off)[2][2]) const {
#pragma unroll
        for (int h = 0; h < 2; ++h)
#pragma unroll
            for (int i = 0; i < 2; ++i) { const int t = tok[u.pm * 256 + h * 128 + R[i]]; off[h][i] = (unsigned)(t * lda + C[i]) * 2u; } }
    __device__ __forceinline__ void a_tok(const Unit& u, const int (&R)[2], int (&tk)[2][2]) const {
#pragma unroll
        for (int h = 0; h < 2; ++h)
#pragma unroll
            for (int i = 0; i < 2; ++i) tk[h][i] = tok[u.pm * 256 + h * 128 + R[i]]; }
    __device__ __forceinline__ void a_off(const int (&tk)[2][2], const int (&C)[2], unsigned (&off)[2][2]) const {
#pragma unroll
        for (int h = 0; h < 2; ++h)
#pragma unroll
            for (int i = 0; i < 2; ++i) off[h][i] = (unsigned)(tk[h][i] * lda + C[i]) * 2u; }
};
struct ProbMoe2 {
    static constexpr bool GATHER = false, FP8 = true; static constexpr int SCALE_A = F8E_ACT, SCALE_B = F8E_WDN; const bf16_t* A; const bf16_t* Bt; int lda, ldb; const LAS int* seg;
    __device__ __forceinline__ int nt(const Unit&) const { return lda / 64; }
    __device__ __forceinline__ const char* a_base(const Unit& u) const { return (const char*)A + (size_t)u.pm * 256 * lda * 2; }
    __device__ __forceinline__ const char* b_base(const Unit& u) const { const int e = expert_of(seg, u.pm); return (const char*)Bt + ((size_t)e * 1024 + (size_t)u.pn * 256) * ldb * 2; }
    __device__ __forceinline__ void a_tok(const Unit&, const int (&)[2], int (&)[2][2]) const {}
    __device__ __forceinline__ void a_off(const int (&)[2][2], const int (&)[2], unsigned (&)[2][2]) const {}
    __device__ __forceinline__ void a_rows(const Unit&, const int (&)[2], const int (&)[2], unsigned (&)[2][2]) const {}
};
using pg8::cvt_pk_bf16;
template <bool G8> struct EpiInproj {
    static constexpr bool PERM = true, CHAIN = false, SIDE = true, KHOOK = false; bf16_t* Z; const float* bias; int pn0;
    __device__ __forceinline__ void side(const Unit& u0, unsigned slot, int wid, int lane) const { const int pn = u0.pn + pn0; if (wid == 1) pg8::dma16((unsigned)lane * 16u, bias + pn * 256 + (pn >= 9 ? 16 : 0), slot); }
    __device__ __forceinline__ void operator()(const f32x4 (&acc)[2][2][4][2], const Unit& u0, int wr, int wc, int fr, int fq, const LAS unsigned char* sd) const {
        Unit u = u0; u.pn += pn0;
        int row0 = u.pm * 256 + wr * 64 + fr, col0 = u.pn * 256 + wc * 32 + 8 * fq; asm volatile("" : "+v"(row0), "+v"(col0));
        const int act = (u.pn <= 6) ? 0 : ((u.pn == 9 || u.pn == 10) ? 2 : 1);
        f32x4 bv[2][2];
#pragma unroll
        for (int bj = 0; bj < 2; ++bj)
#pragma unroll
            for (int n = 0; n < 2; ++n) bv[bj][n] = *(const LAS f32x4*)(sd + (bj * 128 + wc * 32 + 8 * fq + 4 * n) * 4);
#pragma unroll
        for (int ai = 0; ai < 2; ++ai)
#pragma unroll
            for (int m = 0; m < 4; ++m) { bf16_t* rowp = Z + (size_t)(row0 + ai * 128 + m * 16) * NZ + col0;
#pragma unroll
                for (int bj = 0; bj < 2; ++bj) { f32x4 v0 = acc[ai][bj][m][0] + bv[bj][0], v1 = acc[ai][bj][m][1] + bv[bj][1];
                    if (G8 && u.pn >= ZG_COL / 256) { u32x2 w8;
                        v0 = sigmoid4(v0) * G8_SCALE; v1 = sigmoid4(v1) * G8_SCALE;
#pragma unroll
                        for (int j = 0; j < 4; ++j) { v0[j] = fmaxf(v0[j], 1.0f); v1[j] = fmaxf(v1[j], 1.0f); }
                        v0 = v0 + 12582912.0f; v1 = v1 + 12582912.0f;
                        w8.x = pk4_u8(v0[0], v0[1], v0[2], v0[3]); w8.y = pk4_u8(v1[0], v1[1], v1[2], v1[3]);
                        *(u32x2*)((unsigned char*)(Z + (size_t)(row0 + ai * 128 + m * 16) * NZ + ZG_COL) + (col0 - ZG_COL) + bj * 128) = w8; continue; }
                    if (act == 2) { f32x2 a = pg8::gelu_pk((f32x2){v0[0], v0[1]}), b = pg8::gelu_pk((f32x2){v0[2], v0[3]}), c = pg8::gelu_pk((f32x2){v1[0], v1[1]}), d = pg8::gelu_pk((f32x2){v1[2], v1[3]});
                        v0 = (f32x4){a.x, a.y, b.x, b.y}; v1 = (f32x4){c.x, c.y, d.x, d.y}; }
                    if (act == 1) { v0 = sigmoid4(v0); v1 = sigmoid4(v1); }
                    u32x4 w; w.x = cvt_pk_bf16(v0[0], v0[1]); w.y = cvt_pk_bf16(v0[2], v0[3]); w.z = cvt_pk_bf16(v1[0], v1[1]); w.w = cvt_pk_bf16(v1[2], v1[3]);
                    *(u32x4*)(rowp + bj * 128) = w; }
                if constexpr (G8) asm volatile("" ::: "memory"); }
    }
};
struct EpiNull {
    static constexpr bool PERM = true, CHAIN = false; bf16_t* Z;
    __device__ __forceinline__ void operator()(const f32x4 (&acc)[2][2][4][2], const Unit& u, int wr, int wc, int fr, int fq) const {
        float sacc = 0.f;
#pragma unroll
        for (int ai = 0; ai < 2; ++ai)
#pragma unroll
            for (int bj = 0; bj < 2; ++bj)
#pragma unroll
                for (int m = 0; m < 4; ++m)
#pragma unroll
                    for (int n = 0; n < 2; ++n) sacc += (acc[ai][bj][m][n][0] + acc[ai][bj][m][n][1]) + (acc[ai][bj][m][n][2] + acc[ai][bj][m][n][3]);
        if (sacc == 1.2345e30f) Z[u.pm + wr + wc + fr + fq] = 0;
    }
};
struct EpiOut {
    static constexpr bool PERM = true, CHAIN = false, SIDE = false, KHOOK = false; bf16_t* T;
    __device__ __forceinline__ void operator()(const f32x4 (&acc)[2][2][4][2], const Unit& u, int wr, int wc, int fr, int fq, const LAS unsigned char*) const {
        int row0 = u.pm * 256 + wr * 64 + fr, col0 = u.pn * 256 + wc * 32 + 8 * fq; asm volatile("" : "+v"(row0), "+v"(col0));
#pragma unroll
        for (int ai = 0; ai < 2; ++ai)
#pragma unroll
            for (int m = 0; m < 4; ++m) { bf16_t* rowp = T + (size_t)(row0 + ai * 128 + m * 16) * D + col0;
#pragma unroll
                for (int bj = 0; bj < 2; ++bj) { const f32x4 v0 = acc[ai][bj][m][0], v1 = acc[ai][bj][m][1];
                    u32x4 w; w.x = cvt_pk_bf16(v0[0], v0[1]); w.y = cvt_pk_bf16(v0[2], v0[3]); w.z = cvt_pk_bf16(v1[0], v1[1]); w.w = cvt_pk_bf16(v1[2], v1[3]);
                    *(u32x4*)(rowp + bj * 128) = w; } }
    }
};
struct EpiBranch {
    static constexpr bool PERM = true, CHAIN = false, SIDE = false, KHOOK = true; static constexpr int HOOK_T0 = 4, HOOK_T1 = 12;
    const bf16_t* Z; bf16_t* Y;
    template <bool FIN> __device__ __forceinline__ void apply(f32x4 (&acc)[2][2][4][2], const Unit& u, int br, int wr, int wc, int fr, int fq) const {
        int row0 = u.pm * 256 + wr * 64 + fr, col0 = u.pn * 256 + wc * 32 + 8 * fq;
        asm volatile("" : "+v"(row0), "+v"(col0));
#pragma unroll
        for (int ai = 0; ai < 2; ++ai) {
            u32x2 ga[4][2], gb[4][2];
#pragma unroll
            for (int m = 0; m < 4; ++m) { const unsigned char* rowp = (const unsigned char*)(Z + (size_t)(row0 + ai * 128 + m * 16) * NZ + ZG_COL) + br * 1024 + col0;
#pragma unroll
                for (int bj = 0; bj < 2; ++bj) { ga[m][bj] = *(const u32x2*)(rowp + bj * 128); if (!FIN) gb[m][bj] = *(const u32x2*)(rowp + 1024 + bj * 128); } }
#pragma unroll
            for (int m = 0; m < 4; ++m) { const size_t row = (size_t)(row0 + ai * 128 + m * 16);
#pragma unroll
                for (int bj = 0; bj < 2; ++bj) { const u32x2 a = ga[m][bj];
                    f32x4 r0 = u8x4_f32(a.x), r1 = u8x4_f32(a.y);
                    if (FIN) { r0 = r0 * (1.0f / G8_SCALE); r1 = r1 * (1.0f / G8_SCALE); }
                    else { const u32x2 b = gb[m][bj]; f32x4 q0 = u8x4_f32(b.x), q1 = u8x4_f32(b.y);
#pragma unroll
                        for (int i = 0; i < 4; ++i) { q0[i] = __builtin_amdgcn_rcpf(q0[i]); q1[i] = __builtin_amdgcn_rcpf(q1[i]); }
                        r0 = r0 * q0; r1 = r1 * q1; }
                    acc[ai][bj][m][0] = acc[ai][bj][m][0] * r0; acc[ai][bj][m][1] = acc[ai][bj][m][1] * r1;
                    if (FIN) { const f32x4 v0 = acc[ai][bj][m][0], v1 = acc[ai][bj][m][1];
                        u32x4 w; w.x = cvt_pk_bf16(v0[0], v0[1]); w.y = cvt_pk_bf16(v0[2], v0[3]); w.z = cvt_pk_bf16(v1[0], v1[1]); w.w = cvt_pk_bf16(v1[2], v1[3]);
                        *(u32x4*)(Y + row * D + col0 + bj * 128) = w; } } }
            asm volatile("" ::: "memory"); }
    }
    __device__ __forceinline__ void hook(f32x4 (&acc)[2][2][4][2], const Unit& u, int br, int wr, int wc, int fr, int fq) const { apply<false>(acc, u, br, wr, wc, fr, fq); }
    __device__ __forceinline__ void operator()(f32x4 (&acc)[2][2][4][2], const Unit& u, int wr, int wc, int fr, int fq, const LAS unsigned char*) const { apply<true>(acc, u, 2, wr, wc, fr, fq); }
};
struct EpiSwiglu {
    static constexpr bool PERM = true, CHAIN = false, SIDE = true, KHOOK = false; unsigned char* HID; const float* bgu; const LAS int* seg;
    __device__ __forceinline__ void side(const Unit& u, unsigned slot, int wid, int lane) const {
        if (wid == 1) { const int e = expert_of(seg, u.pm); pg8::dma16(lane < 32 ? (unsigned)lane * 16u : 4096u + (unsigned)(lane - 32) * 16u, bgu + (size_t)e * 2048 + u.pn * 128, slot); } }
    __device__ __forceinline__ void operator()(const f32x4 (&acc)[2][2][4][2], const Unit& u, int wr, int wc, int fr, int fq, const LAS unsigned char* sd) const {
        int j0 = u.pn * 128 + wc * 32 + 8 * fq, slot0 = u.pm * 256 + wr * 64 + fr; asm volatile("" : "+v"(j0), "+v"(slot0));
        f32x4 bg[2], bu[2];
#pragma unroll
        for (int n = 0; n < 2; ++n) { bg[n] = *(const LAS f32x4*)(sd + (wc * 32 + 8 * fq + 4 * n) * 4); bu[n] = *(const LAS f32x4*)(sd + (128 + wc * 32 + 8 * fq + 4 * n) * 4); }
#pragma unroll
        for (int ai = 0; ai < 2; ++ai)
#pragma unroll
            for (int m = 0; m < 4; ++m) { const size_t slot = (size_t)(slot0 + ai * 128 + m * 16); f32x4 o[2];
#pragma unroll
                for (int n = 0; n < 2; ++n) { f32x4 g = acc[ai][0][m][n] + bg[n], up = acc[ai][1][m][n] + bu[n];
#pragma unroll
                    for (int i = 0; i < 4; ++i) { g[i] = fminf(g[i], 7.0f); up[i] = __builtin_amdgcn_fmed3f(up[i], -7.0f, 7.0f); }
                    f32x4 t = g * (-1.702f * 1.4426950408889634f);
#pragma unroll
                    for (int i = 0; i < 4; ++i) t[i] = __builtin_amdgcn_exp2f(t[i]);
                    t = t + 1.0f;
#pragma unroll
                    for (int i = 0; i < 4; ++i) t[i] = __builtin_amdgcn_rcpf(t[i]);
                    o[n] = (up * F8S_ACT + F8S_ACT) * (g * t); }
                u32x2 w; w.x = pk4_fp8(o[0][0], o[0][1], o[0][2], o[0][3]); w.y = pk4_fp8(o[1][0], o[1][1], o[1][2], o[1][3]);
                *(u32x2*)(HID + slot * 1024 + j0) = w; }
    }
};
struct EpiDown {
    static constexpr bool PERM = true, CHAIN = false, SIDE = true, KHOOK = false; unsigned char* FS; const float* bdn; const int* dest; const float* pslot; const LAS int* seg;
    __device__ __forceinline__ void side(const Unit& u, unsigned slot, int wid, int lane) const {
        if (wid == 1) { const int e = expert_of(seg, u.pm); pg8::dma16((unsigned)lane * 16u, bdn + (size_t)e * 1024 + u.pn * 256, slot); }
        if (wid == 2) pg8::dma16((unsigned)lane * 16u, dest + (size_t)u.pm * 256, slot + 1024u);
        if (wid == 3) pg8::dma16((unsigned)lane * 16u, pslot + (size_t)u.pm * 256, slot + 2048u); }
    __device__ __forceinline__ void operator()(const f32x4 (&acc)[2][2][4][2], const Unit& u, int wr, int wc, int fr, int fq, const LAS unsigned char* sd) const {
        int col0 = u.pn * 256 + wc * 32 + 8 * fq, slot0 = u.pm * 256 + wr * 64 + fr; asm volatile("" : "+v"(col0), "+v"(slot0));
        f32x4 bv[2][2];
#pragma unroll
        for (int bj = 0; bj < 2; ++bj)
#pragma unroll
            for (int n = 0; n < 2; ++n) bv[bj][n] = *(const LAS f32x4*)(sd + (bj * 128 + wc * 32 + 8 * fq + 4 * n) * 4);
#pragma unroll
        for (int ai = 0; ai < 2; ++ai)
#pragma unroll
            for (int m = 0; m < 4; ++m) { const int rt = ai * 128 + wr * 64 + m * 16 + fr; const int d = *(const LAS int*)(sd + 1024 + rt * 4); const float p = *(const LAS float*)(sd + 2048 + rt * 4) * FS_SCALE;
                if (d >= 0) {
#pragma unroll
                    for (int bj = 0; bj < 2; ++bj) { f32x4 v0 = (acc[ai][bj][m][0] + bv[bj][0]) * p, v1 = (acc[ai][bj][m][1] + bv[bj][1]) * p;
#pragma unroll
                        for (int i = 0; i < 4; ++i) { v0[i] = __builtin_amdgcn_fmed3f(v0[i], -FS_CLAMP, FS_CLAMP); v1[i] = __builtin_amdgcn_fmed3f(v1[i], -FS_CLAMP, FS_CLAMP); }
                        u32x2 w; w.x = pk4_fp8(v0[0], v0[1], v0[2], v0[3]); w.y = pk4_fp8(v1[0], v1[1], v1[2], v1[3]);
                        *(u32x2*)(FS + (size_t)d * 1024 + col0 + bj * 128) = w; } }
                asm volatile("" ::: "memory"); }
    }
};

__device__ __forceinline__ const float* xin_row(const Frame& F, int row) { return row < ML ? F.in[IN_X] + (size_t)row * D : F.in[IN_CTX] + (size_t)(row - ML) * D; }
__device__ __forceinline__ void phase_ln0_first(Frame& F) {
    int t_lo, t_hi; tile_range(F, MT, t_lo, t_hi);
    const int r_lo = 32 * t_lo, nrows = 32 * (t_hi - t_lo);
    const int mrA = mod_row(r_lo), mrB = mod_row(r_lo + (nrows > 0 ? nrows - 1 : 0));
    { const float* mb = (const float*)(F.ws + WS_MOD); pv_fill(F, 0, mb + ((size_t)(0 * 17 + mrA) * 6 + 0) * 1024); pv_fill(F, 1, mb + ((size_t)(0 * 17 + mrB) * 6 + 0) * 1024);
      pv_fill(F, 2, mb + ((size_t)(0 * 17 + mrA) * 6 + 1) * 1024); pv_fill(F, 3, mb + ((size_t)(0 * 17 + mrB) * 6 + 1) * 1024); }
    load_wg_lds(F, 0);
    for (int n = F.wave; n < nrows; n += 4 * NWAVES) {
        RowV rv[4];
#pragma unroll
        for (int u = 0; u < 4; ++u) if (n + u * NWAVES < nrows) row_load(rv[u], xin_row(F, r_lo + n + u * NWAVES), F.lane);
#pragma unroll
        for (int u = 0; u < 4; ++u) if (n + u * NWAVES < nrows) { const int row = r_lo + n + u * NWAVES;
            const int sel = (mod_row(row) == mrA) ? 0 : 1; ln0_row(F, row, rv[u], pv_slot(F, 0 + sel), pv_slot(F, 2 + sel)); }
    }
    gates_tail(F, 0, t_lo, t_hi);
    __syncthreads();
}
__device__ __forceinline__ void phase_finalize(Frame& F, int l, int mrows) {
    const int gw = F.bid * NWAVES + F.wave, NGW = F.G * NWAVES;
    const bf16_t* hf = (const bf16_t*)(F.ws + WS_HFB); const bf16_t* hb = hf + (size_t)MT * 512;
    const float* ng = F.in[IN_MNG] + l * 512 + 8 * F.lane;
    const f32x4 g0 = *(const f32x4*)ng, g1 = *(const f32x4*)(ng + 4);
    for (int row = gw; row < mrows; row += NGW) {
        const u32x4 ha = __builtin_nontemporal_load((const u32x4*)(hf + (size_t)row * 512 + 8 * F.lane)), hbv = __builtin_nontemporal_load((const u32x4*)(hb + (size_t)row * 512 + 8 * F.lane));
        f32x4 v0 = (f32x4){bflo(ha.x) + bflo(hbv.x), bfhi(ha.x) + bfhi(hbv.x), bflo(ha.y) + bflo(hbv.y), bfhi(ha.y) + bfhi(hbv.y)}, v1 = (f32x4){bflo(ha.z) + bflo(hbv.z), bfhi(ha.z) + bfhi(hbv.z), bflo(ha.w) + bflo(hbv.w), bfhi(ha.w) + bfhi(hbv.w)};
        float s = (v0.x + v0.y) + (v0.z + v0.w) + (v1.x + v1.y) + (v1.z + v1.w);
#pragma unroll
        for (int o = 1; o < 16; o <<= 1) s += shx(s, o, F.lane);
        const float mu = s * (1.f / 128.f); v0 = v0 - mu; v1 = v1 - mu;
        float q = (v0.x * v0.x + v0.y * v0.y) + (v0.z * v0.z + v0.w * v0.w) + (v1.x * v1.x + v1.y * v1.y) + (v1.z * v1.z + v1.w * v1.w);
#pragma unroll
        for (int o = 1; o < 16; o <<= 1) q += shx(q, o, F.lane);
        const float rstd = 1.f / sqrtf(q * (1.f / 128.f) + HEAD_EPS);
        const u32x4 so = __builtin_nontemporal_load((const u32x4*)((const bf16_t*)(F.ws + WS_Z) + (size_t)row * NZ + ZC_O + 8 * F.lane));
        v0 = v0 * rstd * g0; v1 = v1 * rstd * g1;
        u32x4 w; w.x = pk2(v0.x * bflo(so.x), v0.y * bfhi(so.x)); w.y = pk2(v0.z * bflo(so.y), v0.w * bfhi(so.y)); w.z = pk2(v1.x * bflo(so.z), v1.y * bfhi(so.z)); w.w = pk2(v1.z * bflo(so.w), v1.w * bfhi(so.w));
        *(u32x4*)((bf16_t*)(F.ws + WS_BRA) + (size_t)row * D + 256 + 8 * F.lane) = w;
    }
}
__device__ __forceinline__ void phase_ln1_router(Frame& F, int l, int mrows) {
    LAS int* cnt = (LAS int*)(F.lds + NW_END);
    { const float* wr = F.in[IN_WR] + (size_t)l * D * NEXP;
      for (int i = F.tid; i < NEXP * D; i += NTHREADS) { const int k = i >> 5, e = i & 31; *(LAS bf16_t*)(F.lds + NW_WT + e * 2064 + k * 2) = (bf16_t)f2bf(wr[i]); }
      if (F.tid < NEXP) cnt[F.tid] = 0; }
    const float* brt = F.in[IN_BR] + l * NEXP;
    int t_lo, t_hi; tile_range(F, mrows, t_lo, t_hi);
    const int r_lo = 32 * t_lo, nrows = 32 * (t_hi - t_lo);
    const int mrA = mod_row(r_lo), mrB = mod_row(r_lo + (nrows > 0 ? nrows - 1 : 0));
    { const float* mb = (const float*)(F.ws + WS_MOD); pv_fill(F, 0, F.in[IN_LN1G] + l * D); pv_fill(F, 1, F.in[IN_LN1B] + l * D);
      pv_fill(F, 2, mb + ((size_t)(l * 17 + mrA) * 6 + 2) * 1024); pv_fill(F, 3, mb + ((size_t)(l * 17 + mrB) * 6 + 2) * 1024);
      pv_fill(F, 4, mb + ((size_t)(l * 17 + mrA) * 6 + 3) * 1024); pv_fill(F, 5, mb + ((size_t)(l * 17 + mrB) * 6 + 3) * 1024);
      pv_fill(F, 6, mb + ((size_t)(l * 17 + mrA) * 6 + 4) * 1024); pv_fill(F, 7, mb + ((size_t)(l * 17 + mrB) * 6 + 4) * 1024); }
    __syncthreads();
    { const bf16_t* yb = (const bf16_t*)(F.ws + WS_T) + 8 * F.lane;
      for (int n = F.wave; n < nrows; n += 2 * NWAVES) {
          RowV rv[2]; u32x4 yv2[2][2];
#pragma unroll
          for (int u = 0; u < 2; ++u) if (n + u * NWAVES < nrows) { const int row = r_lo + n + u * NWAVES;
              if (l == 0) row_load(rv[u], xin_row(F, row), F.lane); else row_load_bf16(rv[u], (const bf16_t*)(F.ws + WS_X) + (size_t)row * D, F.lane);
#pragma unroll
              for (int h = 0; h < 2; ++h) yv2[u][h] = __builtin_nontemporal_load((const u32x4*)(yb + (size_t)row * D + 512 * h)); }
#pragma unroll
          for (int u = 0; u < 2; ++u) if (n + u * NWAVES < nrows) { const int row = r_lo + n + u * NWAVES; RowV cur = rv[u];
              const int sel = (mod_row(row) == mrA) ? 0 : 1;
              { const LAS float* g1 = pv_slot(F, 2 + sel);
#pragma unroll
                for (int j = 0; j < 4; ++j) { const f32x4 gg = *(const LAS f32x4*)(g1 + RC(F.lane, j)); const u32x4 yw = yv2[u][j >> 1]; const f32x4 yv = (j & 1) ? (f32x4){bflo(yw.z), bfhi(yw.z), bflo(yw.w), bfhi(yw.w)} : (f32x4){bflo(yw.x), bfhi(yw.x), bflo(yw.y), bfhi(yw.y)}; cur.v[j] = cur.v[j] * DN_ALPHA + gg * yv; } }
              row_ln_plain(cur, F.lane); row_affine_l(cur, pv_slot(F, 0), pv_slot(F, 1), F.lane);
              row_store_bf16_nt(cur, (bf16_t*)(F.ws + WS_X) + (size_t)row * D, F.lane);
              row_ln_plain(cur, F.lane); row_modulate_l(cur, pv_slot(F, 4 + sel), pv_slot(F, 6 + sel), F.lane);
              row_store_bf16(cur, (bf16_t*)(F.ws + WS_H2) + (size_t)row * D, F.lane);
              { unsigned char* h8 = (unsigned char*)(F.ws + WS_H2F8) + (size_t)row * D + 8 * F.lane;
#pragma unroll
                for (int h = 0; h < 2; ++h) { u32x2 w; w.x = pk4_fp8(cur.v[2 * h].x * F8S_ACT, cur.v[2 * h].y * F8S_ACT, cur.v[2 * h].z * F8S_ACT, cur.v[2 * h].w * F8S_ACT); w.y = pk4_fp8(cur.v[2 * h + 1].x * F8S_ACT, cur.v[2 * h + 1].y * F8S_ACT, cur.v[2 * h + 1].z * F8S_ACT, cur.v[2 * h + 1].w * F8S_ACT); *(u32x2*)(h8 + 512 * h) = w; } } }
      } }
    asm volatile("s_waitcnt vmcnt(0)" ::: "memory"); __syncthreads();
    for (int tile = t_lo + F.wave; tile < t_hi; tile += NWAVES) {
        const LAS float* lgw = narrow_tile_wave(F, (const bf16_t*)(F.ws + WS_H2) + (size_t)tile * 32 * D);
        if (F.lane < 32) {
            const LAS float* lgp = lgw + F.lane * 33; const int row = tile * 32 + F.lane;
            float lg[NEXP];
#pragma unroll
            for (int e = 0; e < NEXP; ++e) lg[e] = lgp[e] + brt[e];
            unsigned used = 0u; float bv[4]; int bi[4];
#pragma unroll
            for (int k = 0; k < 4; ++k) { float best = -3.0e38f; int idx = 0;
#pragma unroll
                for (int e = 0; e < NEXP; ++e) { const bool take = (((used >> e) & 1u) == 0u) && (lg[e] > best); best = take ? lg[e] : best; idx = take ? e : idx; }
                used |= 1u << idx; bv[k] = best; bi[k] = idx; }
            const float e1 = __expf(bv[1] - bv[0]), e2 = __expf(bv[2] - bv[0]), e3 = __expf(bv[3] - bv[0]); const float inv = __builtin_amdgcn_rcpf(1.0f + e1 + e2 + e3);
            int* ei = (int*)(F.ws + WS_ROUTE + RT_EIDX) + (size_t)row * 4; float* pr = (float*)(F.ws + WS_ROUTE + RT_PROB) + (size_t)row * 4;
            *(int4*)ei = make_int4(bi[0], bi[1], bi[2], bi[3]); *(f32x4*)pr = (f32x4){inv, e1 * inv, e2 * inv, e3 * inv};
            atomicAdd((int*)&cnt[bi[0]], 1); atomicAdd((int*)&cnt[bi[1]], 1); atomicAdd((int*)&cnt[bi[2]], 1); atomicAdd((int*)&cnt[bi[3]], 1);
        }
        asm volatile("s_waitcnt lgkmcnt(0)" ::: "memory");
    }
    __syncthreads();
    if (F.tid < NEXP) ((int*)(F.ws + WS_ROUTE + RT_CNT))[F.bid * NEXP + F.tid] = cnt[F.tid];
    __syncthreads();
}
__device__ __forceinline__ void phase_slots(Frame& F, int mrows) {
    LAS int* part = (LAS int*)F.lds;
    LAS int* pre = part + 1024;
    LAS int* tot = pre + 32;
    LAS int* seg = tot + 32;
    LAS int* gcnt = seg + 64;
    LAS int* eix = gcnt + 2048;
    LAS int* rnk = eix + 4096;
    const int* cntg = (const int*)(F.ws + WS_ROUTE + RT_CNT);
    int* tokg = (int*)(F.ws + WS_ROUTE + RT_TOK); int* destg = (int*)(F.ws + WS_ROUTE + RT_DEST); float* psl = (float*)(F.ws + WS_ROUTE + RT_PSLOT);
    int t_lo, t_hi; tile_range(F, mrows, t_lo, t_hi);
    const int row_base = t_lo * 32, nent = (t_hi - t_lo) * 128, ngrp = nent / 64;
    { const int e = F.tid & 31, pt = F.tid >> 5; int a = 0, b = 0;
      for (int c = pt; c < F.G; c += 16) { const int v = cntg[c * NEXP + e]; b += v; a += (c < F.bid) ? v : 0; }
      part[pt * 32 + e] = a; part[512 + pt * 32 + e] = b; }
    for (int i = F.tid; i < nent; i += NTHREADS) eix[i] = ((const int*)(F.ws + WS_ROUTE + RT_EIDX))[(size_t)row_base * 4 + i];
    __syncthreads();
    if (F.tid < NEXP) { int a = 0, b = 0;
#pragma unroll
        for (int pt = 0; pt < 16; ++pt) { a += part[pt * 32 + F.tid]; b += part[512 + pt * 32 + F.tid]; }
        pre[F.tid] = a; tot[F.tid] = b; }
    for (int g = F.wave; g < ngrp; g += NWAVES) {
        const int e = eix[g * 64 + F.lane]; int rank = 0, mycnt = 0;
#pragma unroll 4
        for (int ee = 0; ee < NEXP; ++ee) { const unsigned long long m = __ballot(e == ee); if (e == ee) rank = __popcll(m & ((1ull << F.lane) - 1ull)); if (F.lane == ee) mycnt = __popcll(m); }
        rnk[g * 64 + F.lane] = rank; if (F.lane < NEXP) gcnt[g * 32 + F.lane] = mycnt; }
    __syncthreads();
    if (F.tid == 0) { int s = 0; for (int e = 0; e < NEXP; ++e) { seg[e] = s; s += (tot[e] + 255) & ~255; } seg[NEXP] = s; }
    if (F.tid >= 64 && F.tid < 64 + NEXP) { const int e = F.tid - 64; int run = 0; for (int g = 0; g < ngrp; ++g) { const int c = gcnt[g * 32 + e]; gcnt[g * 32 + e] = run; run += c; } }
    __syncthreads();
    { const float* prg = (const float*)(F.ws + WS_ROUTE + RT_PROB) + (size_t)row_base * 4;
      for (int i = F.tid; i < nent; i += NTHREADS) { const int e = eix[i]; const int slot = seg[e] + pre[e] + gcnt[(i >> 6) * 32 + e] + rnk[i];
          tokg[slot] = row_base + (i >> 2); destg[slot] = row_base * 4 + i; psl[slot] = prg[i]; } }
    if (F.bid < NEXP) { const int e = F.bid; for (int sl = seg[e] + tot[e] + F.tid; sl < seg[e + 1]; sl += NTHREADS) { tokg[sl] = 0; destg[sl] = -1; psl[sl] = 0.f; } }
    if (F.bid == 0 && F.tid <= NEXP) ((int*)(F.ws + WS_ROUTE + RT_SEG))[F.tid] = seg[F.tid];
    __syncthreads();
}
struct CombRaw { u32x4 x[2]; u32x2 f[2][4]; };
__device__ __forceinline__ void comb_load(const Frame& F, int row, CombRaw& r) {
    { const bf16_t* xp = (const bf16_t*)(F.ws + WS_X) + (size_t)row * D + 8 * F.lane;
#pragma unroll
      for (int h = 0; h < 2; ++h) r.x[h] = __builtin_nontemporal_load((const u32x4*)(xp + 512 * h)); }
    const unsigned char* fs = (const unsigned char*)(F.ws + WS_FS) + (size_t)row * 4 * 1024 + 8 * F.lane;
#pragma unroll
    for (int h = 0; h < 2; ++h)
#pragma unroll
        for (int k = 0; k < 4; ++k) r.f[h][k] = __builtin_nontemporal_load((const u32x2*)(fs + k * 1024 + 512 * h));
}
__device__ __forceinline__ void phase_combine_ln2(Frame& F, int l, int mrows) {
    const bool lastl = (l == DEPTH - 1);
    int t_lo, t_hi; tile_range(F, mrows, t_lo, t_hi);
    const int r_lo = 32 * t_lo, nrows = 32 * (t_hi - t_lo);
    const int mrA = mod_row(r_lo), mrB = mod_row(r_lo + (nrows > 0 ? nrows - 1 : 0));
    { const float* mb = (const float*)(F.ws + WS_MOD); const int ln = lastl ? l : l + 1; pv_fill(F, 0, F.in[IN_LN2G] + l * D); pv_fill(F, 1, F.in[IN_LN2B] + l * D);
      pv_fill(F, 2, mb + ((size_t)(l * 17 + mrA) * 6 + 5) * 1024); pv_fill(F, 3, mb + ((size_t)(l * 17 + mrB) * 6 + 5) * 1024);
      pv_fill(F, 4, mb + ((size_t)(ln * 17 + mrA) * 6 + 0) * 1024); pv_fill(F, 5, mb + ((size_t)(ln * 17 + mrB) * 6 + 0) * 1024);
      pv_fill(F, 6, mb + ((size_t)(ln * 17 + mrA) * 6 + 1) * 1024); pv_fill(F, 7, mb + ((size_t)(ln * 17 + mrB) * 6 + 1) * 1024); }
    if (!lastl) load_wg_lds(F, l + 1); else __syncthreads();
    for (int n = F.wave; n < nrows; n += 2 * NWAVES) {
        CombRaw rw[2];
#pragma unroll
        for (int u = 0; u < 2; ++u) if (n + u * NWAVES < nrows) comb_load(F, r_lo + n + u * NWAVES, rw[u]);
#pragma unroll
        for (int u = 0; u < 2; ++u) if (n + u * NWAVES < nrows) { const int row = r_lo + n + u * NWAVES;
            const int sel = (mod_row(row) == mrA) ? 0 : 1;
            const LAS float* g2 = pv_slot(F, 2 + sel);
            RowV x;
#pragma unroll
            for (int h = 0; h < 2; ++h) { const u32x4 w = rw[u].x[h]; x.v[2 * h] = (f32x4){bflo(w.x), bfhi(w.x), bflo(w.y), bfhi(w.y)}; x.v[2 * h + 1] = (f32x4){bflo(w.z), bfhi(w.z), bflo(w.w), bfhi(w.w)}; }
#pragma unroll
            for (int j = 0; j < 4; ++j) { f32x4 f = (f32x4){0.f, 0.f, 0.f, 0.f};
#pragma unroll
                for (int k = 0; k < 4; ++k) { const u32x2 w2 = rw[u].f[j >> 1][k]; const int wd = (int)((j & 1) ? w2.y : w2.x);
                    const f32x2 lo = __builtin_amdgcn_cvt_pk_f32_fp8(wd, false), hi = __builtin_amdgcn_cvt_pk_f32_fp8(wd, true); f[0] += lo[0]; f[1] += lo[1]; f[2] += hi[0]; f[3] += hi[1]; }
                const f32x4 gg = *(const LAS f32x4*)(g2 + RC(F.lane, j)) * (1.0f / FS_SCALE);
                x.v[j] = x.v[j] * DN_ALPHA + gg * f; }
            row_ln_plain(x, F.lane); row_affine_l(x, pv_slot(F, 0), pv_slot(F, 1), F.lane);
            if (lastl) { row_store_nt(x, F.out + (size_t)row * D, F.lane); }
            else { row_store_bf16_nt(x, (bf16_t*)(F.ws + WS_X) + (size_t)row * D, F.lane); ln0_row(F, row, x, pv_slot(F, 4 + sel), pv_slot(F, 6 + sel)); } }
    }
    if (!lastl) gates_tail(F, l + 1, t_lo, t_hi);
    __syncthreads();
}

#define MFMA32(a, b, c) __builtin_amdgcn_mfma_f32_32x32x16_bf16((a), (b), (c), 0, 0, 0)
#define MFMA16(a, b, c) __builtin_amdgcn_mfma_f32_16x16x32_bf16((a), (b), (c), 0, 0, 0)
__device__ __forceinline__ f32x16 zero16() { f32x16 z;
#pragma unroll
    for (int i = 0; i < 16; ++i) z[i] = 0.f;
    return z; }
__device__ __forceinline__ void pool_tiles(Frame& F, int l, bool with_ctx) {
    LAS unsigned char* Pin = F.lds;
    LAS unsigned char* Dm = F.lds + 40960;
    const bf16_t* Z = (const bf16_t*)(F.ws + WS_Z);
    const bf16_t* Wp = (const bf16_t*)(F.ws + WS_WPOOL) + (size_t)l * 4 * 4096;
    const float* psc = F.in[IN_POOLS] + l * 256;
    bf16_t* BRA = (bf16_t*)(F.ws + WS_BRA);
    const int ntiles = with_ctx ? 1088 : 1024;
    const int r = F.lane & 31, h = F.lane >> 5;
    for (int tile = F.bid; tile < ntiles; tile += F.G) {
        int row0, seq_lo, seq_hi;
        if (tile < 1024) { row0 = tile * 64; seq_lo = row0; seq_hi = row0 + 64; }
        else { const int ct = tile - 1024; seq_lo = ML + (ct >> 2) * 256; seq_hi = seq_lo + 256; row0 = seq_lo + (ct & 3) * 64; }
        for (int idx = F.tid; idx < 80 * 32; idx += NTHREADS) { const int rr = idx >> 5, ck = idx & 31, grow = row0 - 8 + rr;
            if (grow >= seq_lo && grow < seq_hi) *(LAS u32x4*)(Pin + rr * 512 + ck * 16) = __builtin_nontemporal_load((const u32x4*)(Z + (size_t)grow * NZ + ZC_P + ck * 8)); }
        __syncthreads();
        for (int idx = F.tid; idx < 64 * 32; idx += NTHREADS) { const int tok = idx >> 5, ck = idx & 31, g = ck >> 3, hw = 1 << g, t = row0 + tok;
            const int lo = max(t - hw, seq_lo), hi = min(t + hw, seq_hi);
            float s[8];
#pragma unroll
            for (int e = 0; e < 8; ++e) s[e] = 0.f;
            for (int rw = lo; rw < hi; ++rw) { const u32x4 v = *(const LAS u32x4*)(Pin + (rw - row0 + 8) * 512 + ck * 16);
                s[0] += bflo(v.x); s[1] += bfhi(v.x); s[2] += bflo(v.y); s[3] += bfhi(v.y); s[4] += bflo(v.z); s[5] += bfhi(v.z); s[6] += bflo(v.w); s[7] += bfhi(v.w); }
            const float inv = 1.0f / (float)(hi - lo);
            const u32x4 o = *(const LAS u32x4*)(Pin + (tok + 8) * 512 + ck * 16);
            u32x4 w; w.x = pk2(s[0] * inv - bflo(o.x), s[1] * inv - bfhi(o.x)); w.y = pk2(s[2] * inv - bflo(o.y), s[3] * inv - bfhi(o.y));
            w.z = pk2(s[4] * inv - bflo(o.z), s[5] * inv - bfhi(o.z)); w.w = pk2(s[6] * inv - bflo(o.w), s[7] * inv - bfhi(o.w));
            *(LAS u32x4*)(Dm + tok * 528 + ck * 16) = w; }
        __syncthreads();
#pragma unroll 1
        for (int qi = 0; qi < 2; ++qi) { const int q = F.wave + 8 * qi, g = q >> 2, td = (q >> 1) & 1, tt = q & 1;
            f32x16 acc = zero16();
#pragma unroll
            for (int ks = 0; ks < 4; ++ks) { const bf16x8 a = *(const bf16x8*)(Wp + ((size_t)g * 64 + td * 32 + r) * 64 + ks * 16 + 8 * h);
                const bf16x8 b = *(const LAS bf16x8*)(Dm + (tt * 32 + r) * 528 + (g * 64 + ks * 16 + 8 * h) * 2);
                acc = MFMA32(a, b, acc); }
            const size_t orow = (size_t)(row0 + tt * 32 + r);
#pragma unroll
            for (int qq = 0; qq < 4; ++qq) { const int dcol = g * 64 + td * 32 + 8 * qq + 4 * h; const f32x4 sc = *(const f32x4*)(psc + dcol);
                u32x2 w; w.x = pk2(acc[4 * qq] * sc.x, acc[4 * qq + 1] * sc.y); w.y = pk2(acc[4 * qq + 2] * sc.z, acc[4 * qq + 3] * sc.w);
                *(u32x2*)(BRA + orow * D + dcol) = w; } }
        __syncthreads();
    }
}
__device__ __forceinline__ void sgu_chunks(Frame& F, int l, bool with_ctx) {
    LAS unsigned char* Vt = F.lds;
    const bf16_t* Z = (const bf16_t*)(F.ws + WS_Z);
    const bf16_t* Ws = (const bf16_t*)(F.ws + WS_WSGU) + (size_t)l * 4 * 16384;
    const float* lng = F.in[IN_SLNG] + l * 256; const float* lnb = F.in[IN_SLNB] + l * 256; const float* sb = F.in[IN_SGUB] + l * 512;
    bf16_t* BRA = (bf16_t*)(F.ws + WS_BRA);
    const int nchunks = with_ctx ? 544 : 512;
    const int r = F.lane & 31, h = F.lane >> 5;
    for (int ch = F.bid; ch < nchunks; ch += F.G) {
        const int row0 = ch * 128;
        { const int s = F.tid >> 2, q = F.tid & 3; const bf16_t* zp = Z + (size_t)(row0 + s) * NZ + ZC_UV + 256 + q * 64;
          float v[64]; float sum = 0.f;
#pragma unroll
          for (int i = 0; i < 8; ++i) { const u32x4 w = __builtin_nontemporal_load((const u32x4*)(zp + 8 * i));
              v[8 * i] = bflo(w.x); v[8 * i + 1] = bfhi(w.x); v[8 * i + 2] = bflo(w.y); v[8 * i + 3] = bfhi(w.y); v[8 * i + 4] = bflo(w.z); v[8 * i + 5] = bfhi(w.z); v[8 * i + 6] = bflo(w.w); v[8 * i + 7] = bfhi(w.w); }
#pragma unroll
          for (int i = 0; i < 64; ++i) sum += v[i];
          sum += shx(sum, 1, F.lane); sum += shx(sum, 2, F.lane);
          const float mean = sum * (1.f / 256.f); float sq = 0.f;
#pragma unroll
          for (int i = 0; i < 64; ++i) { v[i] -= mean; sq += v[i] * v[i]; }
          sq += shx(sq, 1, F.lane); sq += shx(sq, 2, F.lane);
          const float rstd = 1.f / sqrtf(sq * (1.f / 256.f) + LN_EPS);
#pragma unroll
          for (int i = 0; i < 64; ++i) { const int c = q * 64 + i; const float y = v[i] * rstd * lng[c] + lnb[c]; *(LAS bf16_t*)(Vt + c * 272 + s * 2) = (bf16_t)f2bf(y); } }
        __syncthreads();
        const int tc = F.wave & 1, tt = F.wave >> 1, t = tt * 32 + r;
#pragma unroll 1
        for (int g = 0; g < 4; ++g) {
            f32x16 acc = zero16();
#pragma unroll
            for (int ks = 0; ks < 8; ++ks) { const bf16x8 a = *(const LAS bf16x8*)(Vt + (g * 64 + tc * 32 + r) * 272 + (ks * 16 + 8 * h) * 2);
                const bf16x8 b = *(const bf16x8*)(Ws + ((size_t)g * 128 + t) * 128 + ks * 16 + 8 * h);
                acc = MFMA32(a, b, acc); }
            const float bias = sb[g * 128 + t];
#pragma unroll
            for (int qq = 0; qq < 4; ++qq) { const int c0 = g * 64 + tc * 32 + 8 * qq + 4 * h;
                const u32x2 u = *(const u32x2*)(Z + (size_t)(row0 + t) * NZ + ZC_UV + c0);
                u32x2 w; w.x = pk2(bflo(u.x) * (acc[4 * qq] + bias), bfhi(u.x) * (acc[4 * qq + 1] + bias)); w.y = pk2(bflo(u.y) * (acc[4 * qq + 2] + bias), bfhi(u.y) * (acc[4 * qq + 3] + bias));
                *(u32x2*)(BRA + (size_t)(row0 + t) * D + 768 + c0) = w; } }
        __syncthreads();
    }
}
__device__ __forceinline__ void qk_conv_pass(Frame& F, int l) {
    const bf16_t* Z = (const bf16_t*)(F.ws + WS_Z); bf16_t* QKC = (bf16_t*)(F.ws + WS_H);
    const int chunk = F.tid & 127, rsub = F.tid >> 7, ch0 = chunk * 8;
    float w0[8], w1[8], w2[8], cbv[8];
    { const float* cw = F.in[IN_CONVW] + (size_t)l * 3 * 1024 + ch0; const float* cb = F.in[IN_CONVB] + (size_t)l * 1024 + ch0;
#pragma unroll
      for (int e = 0; e < 8; ++e) { w0[e] = cw[e]; w1[e] = cw[1024 + e]; w2[e] = cw[2048 + e]; cbv[e] = cb[e]; } }
    const float scale = chunk >= 64 ? 0.08838834764831845f : 1.0f;
    for (int row = F.bid * 4 + rsub; row < MT; row += F.G * 4) {
        const int p = row < ML ? (row & 4095) : ((row - ML) & 255), len = row < ML ? 4096 : 256;
        const bf16_t* zr = Z + (size_t)row * NZ + ZC_QK + ch0;
        const u32x4 x1 = *(const u32x4*)zr; u32x4 x0 = (u32x4){0u, 0u, 0u, 0u}, x2 = (u32x4){0u, 0u, 0u, 0u};
        if (p > 0) x0 = *(const u32x4*)(zr - NZ);
        if (p + 1 < len) x2 = *(const u32x4*)(zr + NZ);
        const unsigned xa[4] = {x0.x, x0.y, x0.z, x0.w}, xb[4] = {x1.x, x1.y, x1.z, x1.w}, xc[4] = {x2.x, x2.y, x2.z, x2.w};
        float y[8];
#pragma unroll
        for (int e2 = 0; e2 < 4; ++e2) { y[2 * e2] = cbv[2 * e2] + w0[2 * e2] * bflo(xa[e2]) + w1[2 * e2] * bflo(xb[e2]) + w2[2 * e2] * bflo(xc[e2]);
            y[2 * e2 + 1] = cbv[2 * e2 + 1] + w0[2 * e2 + 1] * bfhi(xa[e2]) + w1[2 * e2 + 1] * bfhi(xb[e2]) + w2[2 * e2 + 1] * bfhi(xc[e2]); }
#pragma unroll
        for (int e = 0; e < 8; ++e) y[e] = siluf_(y[e]) * scale;
        u32x4 w; w.x = pk2(y[0], y[1]); w.y = pk2(y[2], y[3]); w.z = pk2(y[4], y[5]); w.w = pk2(y[6], y[7]);
        *(u32x4*)(QKC + (size_t)row * D + ch0) = w;
    }
}
constexpr int ML_QS = 0, ML_KS = 34816, ML_KW = 69632, ML_VT = 104448, ML_CB = 126208, ML_SC = 147968, ML_SCSZ = 2624;
__device__ __forceinline__ float logsigf_(float x) { return fminf(x, 0.f) - __logf(1.0f + __expf(-fabsf(x))); }
__device__ __forceinline__ unsigned swap16(unsigned u) { return __builtin_amdgcn_alignbit(u, u, 16); }
struct MlPre { u32x4 qk[8]; u32x2 v[4]; float g[4]; };
__device__ __forceinline__ void ml_geom(int j, int b, int dir, int& seqbase, int& seqlen, int& pbase) {
    const bool is_ctx = j < 2; int cj = is_ctx ? j : j - 2; const int ncs = is_ctx ? 2 : 32; if (dir) cj = ncs - 1 - cj;
    seqbase = is_ctx ? ML + b * 256 : b * 4096; seqlen = is_ctx ? 256 : 4096; pbase = cj * 128; }
#define ML_BAR() do { asm volatile("s_waitcnt lgkmcnt(0)" ::: "memory"); __builtin_amdgcn_s_barrier(); asm volatile("" ::: "memory"); } while (0)
__device__ __forceinline__ void mlstm_unit(Frame& F, int l, int unit) {
    const int bh = (unit & 7) + 8 * (unit >> 5), sub = (unit >> 3) & 3;
    const int b = bh >> 2, head = bh & 3, dir = sub >> 1, vh = sub & 1;
    LAS unsigned char* QS = F.lds + ML_QS; LAS unsigned char* KS = F.lds + ML_KS; LAS unsigned char* KW = F.lds + ML_KW; LAS unsigned char* VT = F.lds + ML_VT; LAS unsigned char* CB = F.lds + ML_CB;
    const bf16_t* Z = (const bf16_t*)(F.ws + WS_Z); const float* ZG = (const float*)(F.ws + WS_ZG); const bf16_t* QKC = (const bf16_t*)(F.ws + WS_H);
    bf16_t* HF = (bf16_t*)(F.ws + WS_HFB) + (size_t)dir * MT * 512;
    const int wave = F.wave;
    int tl = F.tid;
#define ML_ROLES() const int lane = tl & 63, fr = lane & 15, q4 = lane >> 4; const int isk = (tl >> 4) & 1, ck = tl & 15, i0 = 8 * (tl >> 5), chn = (isk ? 512 : 0) + head * 128 + ck * 8; \
    const int vi0 = 4 * (tl >> 4), vcq = tl & 15, vch = head * 128 + vh * 64 + vcq * 4; (void)fr; (void)q4; (void)vi0; (void)vcq; (void)vch; (void)i0; (void)chn; (void)ck; (void)isk;
    for (int idx = F.tid; idx < 16 * 136; idx += NTHREADS) *(LAS bf16_t*)(VT + (64 + idx / 136) * 272 + (idx % 136) * 2) = (idx < 136) ? (bf16_t)0x3F80 : (bf16_t)0;
    f32x4 cs[5];
#pragma unroll
    for (int vt = 0; vt < 5; ++vt) cs[vt] = (f32x4){0.f, 0.f, 0.f, 0.f};
    float m_state = 0.f;
    MlPre pre;
#define ML_PREFETCH(jj) do { int sb_, sl_, pb_; ml_geom((jj), b, dir, sb_, sl_, pb_); \
        { const int pmin = dir ? pb_ + 120 - i0 : pb_ + i0; const bf16_t* zr = QKC + (size_t)(sb_ + pmin) * D + chn; (void)sl_; \
          _Pragma("unroll") for (int k = 0; k < 8; ++k) pre.qk[k] = *(const u32x4*)(zr + (size_t)k * D); } \
        { const int pminv = dir ? pb_ + 124 - vi0 : pb_ + vi0; const bf16_t* zv = Z + (size_t)(sb_ + pminv) * NZ + ZC_V + vch; \
          _Pragma("unroll") for (int k = 0; k < 4; ++k) pre.v[k] = *(const u32x2*)(zv + (size_t)k * NZ); } \
        if (wave == 0) { const int p0 = dir ? pb_ + 127 - 2 * lane : pb_ + 2 * lane, p1 = dir ? p0 - 1 : p0 + 1; \
          pre.g[0] = ZG[(size_t)(sb_ + p0) * 16 + dir * 8 + head]; pre.g[1] = ZG[(size_t)(sb_ + p0) * 16 + dir * 8 + 4 + head]; \
          pre.g[2] = ZG[(size_t)(sb_ + p1) * 16 + dir * 8 + head]; pre.g[3] = ZG[(size_t)(sb_ + p1) * 16 + dir * 8 + 4 + head]; } } while (0)
#define ML_STEPA(sbuf) do { LAS float* sg_ = (LAS float*)(F.lds + ML_SC + (sbuf) * ML_SCSZ); const int i0g = 2 * lane, i1g = i0g + 1; \
        const float gi0 = pre.g[0], gf0 = pre.g[1], gi1 = pre.g[2], gf1 = pre.g[3]; \
        const float lf0 = logsigf_(gf0), lf1 = logsigf_(gf1); const float s1 = lf0 + lf1; float incl = s1; \
        _Pragma("unroll") for (int o = 1; o < 64; o <<= 1) { const float y_ = shup(incl, o, lane); incl += (lane >= o) ? y_ : 0.f; } \
        const float excl = incl - s1, bc0 = excl + lf0, bc1 = excl + s1; \
        const float g0 = gi0 - bc0, g1 = gi1 - bc1; const float mx1 = fmaxf(g0, g1); float im = mx1; \
        _Pragma("unroll") for (int o = 1; o < 64; o <<= 1) { const float y_ = shup(im, o, lane); im = (lane >= o) ? fmaxf(im, y_) : im; } \
        float em = shup(im, 1, lane); em = (lane == 0) ? -3.0e38f : em; \
        const float M0 = fmaxf(m_state, fmaxf(em, g0)), M1 = fmaxf(m_state, fmaxf(em, mx1)); \
        const float total = bperm(63, bc1), Mlast = bperm(63, M1); \
        sg_[i0g] = g0; sg_[i1g] = g1; sg_[128 + i0g] = M0; sg_[128 + i1g] = M1; \
        sg_[256 + i0g] = __expf(m_state - M0); sg_[256 + i1g] = __expf(m_state - M1); \
        sg_[384 + i0g] = __expf(-(bc0 + M0)); sg_[384 + i1g] = __expf(-(bc1 + M1)); \
        sg_[512 + i0g] = __expf(g0 - Mlast); sg_[512 + i1g] = __expf(g1 - Mlast); \
        if (lane == 0) sg_[640] = __expf(m_state - Mlast); \
        m_state = total + Mlast; } while (0)
    { ML_ROLES(); ML_PREFETCH(0); if (wave == 0) ML_STEPA(0); }
    ML_BAR();
#pragma unroll 1
    for (int j = 0; j < 34; ++j) {
        asm volatile("" : "+v"(tl));
        ML_ROLES();
        int seqbase, seqlen, pbase; ml_geom(j, b, dir, seqbase, seqlen, pbase);
        const LAS float* sc_g = (const LAS float*)(F.lds + ML_SC + (j & 1) * ML_SCSZ); const LAS float* sc_M = sc_g + 128; const LAS float* sc_dec = sc_g + 256; const LAS float* sc_emt = sc_g + 384; const LAS float* sc_wk = sc_g + 512;
        {
#pragma unroll
          for (int k = 0; k < 8; ++k) { const int i = dir ? i0 + 7 - k : i0 + k; *(LAS u32x4*)((isk ? KS : QS) + i * 272 + ck * 16) = pre.qk[k]; }
          if (isk) { u32x4 kt[8]; float ykeep[8];
#pragma unroll
              for (int e = 0; e < 8; ++e) { kt[e] = (u32x4){0u, 0u, 0u, 0u}; ykeep[e] = 0.f; }
#pragma unroll
              for (int k = 0; k < 8; ++k) { const int i = dir ? i0 + 7 - k : i0 + k; const float wk = sc_wk[i];
                  const unsigned xb[4] = {pre.qk[k].x, pre.qk[k].y, pre.qk[k].z, pre.qk[k].w};
#pragma unroll
                  for (int e = 0; e < 8; ++e) { const float yw = ((e & 1) ? bfhi(xb[e >> 1]) : bflo(xb[e >> 1])) * wk;
                      if (k & 1) { const unsigned pw_ = pk2(ykeep[e], yw); if ((k >> 1) == 0) kt[e].x = pw_; else if ((k >> 1) == 1) kt[e].y = pw_; else if ((k >> 1) == 2) kt[e].z = pw_; else kt[e].w = pw_; }
                      else ykeep[e] = yw; } }
#pragma unroll
              for (int e = 0; e < 8; ++e) { u32x4 o = kt[e]; if (dir) o = (u32x4){swap16(kt[e].w), swap16(kt[e].z), swap16(kt[e].y), swap16(kt[e].x)};
                  *(LAS u32x4*)(KW + (ck * 8 + e) * 272 + (((i0 >> 3) ^ (ck & 7)) * 16)) = o; } } }
        { unsigned vv[4][2];
#pragma unroll
          for (int k = 0; k < 4; ++k) { vv[k][0] = pre.v[k].x; vv[k][1] = pre.v[k].y; }
#pragma unroll
          for (int c = 0; c < 4; ++c) {
              unsigned h0 = (c & 1) ? (vv[0][c >> 1] >> 16) : (vv[0][c >> 1] & 0xffffu), h1 = (c & 1) ? (vv[1][c >> 1] >> 16) : (vv[1][c >> 1] & 0xffffu);
              unsigned h2 = (c & 1) ? (vv[2][c >> 1] >> 16) : (vv[2][c >> 1] & 0xffffu), h3 = (c & 1) ? (vv[3][c >> 1] >> 16) : (vv[3][c >> 1] & 0xffffu);
              u32x2 o; if (dir) { o.x = h3 | (h2 << 16); o.y = h1 | (h0 << 16); } else { o.x = h0 | (h1 << 16); o.y = h2 | (h3 << 16); }
              *(LAS u32x2*)(VT + (vcq * 4 + c) * 272 + vi0 * 2) = o; } }
#pragma unroll
        for (int vt = 0; vt < 5; ++vt)
#pragma unroll
            for (int rr = 0; rr < 4; rr += 2) { const unsigned pw_ = pk2(cs[vt][rr], cs[vt][rr + 1]);
                *(LAS bf16_t*)(CB + (16 * vt + 4 * q4 + rr) * 272 + (16 * wave + fr) * 2) = (bf16_t)(pw_ & 0xffffu); *(LAS bf16_t*)(CB + (16 * vt + 4 * q4 + rr + 1) * 272 + (16 * wave + fr) * 2) = (bf16_t)(pw_ >> 16); }
        ML_BAR();
        if (j + 1 < 34) ML_PREFETCH(j + 1);
        const int t = 16 * wave + fr;
        bf16x8 qf[4];
#pragma unroll
        for (int kc = 0; kc < 4; ++kc) qf[kc] = *(const LAS bf16x8*)(QS + t * 272 + (32 * kc + 8 * q4) * 2);
        const float Mt_t = sc_M[t], dec_t = sc_dec[t], emt_t = sc_emt[t];
        f32x4 ps[8];
#pragma unroll
        for (int jp = 0; jp < 4; ++jp) {
            ps[2 * jp] = (f32x4){0.f, 0.f, 0.f, 0.f}; ps[2 * jp + 1] = (f32x4){0.f, 0.f, 0.f, 0.f};
            if (2 * jp <= wave) {
                bf16x8 ka[4], kb[4];
#pragma unroll
                for (int kc = 0; kc < 4; ++kc) { ka[kc] = *(const LAS bf16x8*)(KS + (32 * jp + fr) * 272 + (32 * kc + 8 * q4) * 2); kb[kc] = *(const LAS bf16x8*)(KS + (32 * jp + 16 + fr) * 272 + (32 * kc + 8 * q4) * 2); }
                const f32x4 ga4 = *(const LAS f32x4*)(sc_g + 32 * jp + 4 * q4), gb4 = *(const LAS f32x4*)(sc_g + 32 * jp + 16 + 4 * q4);
                f32x4 acc0 = (f32x4){0.f, 0.f, 0.f, 0.f}, acc1 = (f32x4){0.f, 0.f, 0.f, 0.f};
#pragma unroll
                for (int kc = 0; kc < 4; ++kc) { acc0 = MFMA16(ka[kc], qf[kc], acc0); acc1 = MFMA16(kb[kc], qf[kc], acc1); }
#pragma unroll
                for (int rr = 0; rr < 4; ++rr) { const int s0 = 32 * jp + 4 * q4 + rr, s1 = s0 + 16;
                    ps[2 * jp][rr] = (s0 <= t) ? acc0[rr] * __expf(ga4[rr] - Mt_t) : 0.f; ps[2 * jp + 1][rr] = (s1 <= t) ? acc1[rr] * __expf(gb4[rr] - Mt_t) : 0.f; }
            }
        }
        f32x4 ao[5];
        {
#pragma unroll
          for (int vt = 0; vt < 5; ++vt) ao[vt] = (f32x4){0.f, 0.f, 0.f, 0.f};
#pragma unroll
          for (int kh = 0; kh < 4; kh += 2) { bf16x8 cf[2][5];
#pragma unroll
              for (int k2 = 0; k2 < 2; ++k2)
#pragma unroll
                  for (int vt = 0; vt < 5; ++vt) cf[k2][vt] = *(const LAS bf16x8*)(CB + (16 * vt + fr) * 272 + (32 * (kh + k2) + 8 * q4) * 2);
#pragma unroll
              for (int k2 = 0; k2 < 2; ++k2)
#pragma unroll
                  for (int vt = 0; vt < 5; ++vt) ao[vt] = MFMA16(cf[k2][vt], qf[kh + k2], ao[vt]); }
#pragma unroll
          for (int vt = 0; vt < 5; ++vt) ao[vt] = ao[vt] * dec_t; }
#pragma unroll
        for (int ks = 0; ks < 4; ++ks) {
            if (2 * ks <= wave) {
                s16x4 vlo[5], vhi[5];
#pragma unroll
                for (int vt = 0; vt < 5; ++vt) { vlo[vt] = *(const LAS s16x4*)(VT + (16 * vt + fr) * 272 + (32 * ks + 4 * q4) * 2); vhi[vt] = *(const LAS s16x4*)(VT + (16 * vt + fr) * 272 + (32 * ks + 16 + 4 * q4) * 2); }
                u32x4 pw; pw.x = cvt_pk_bf16(ps[2 * ks][0], ps[2 * ks][1]); pw.y = cvt_pk_bf16(ps[2 * ks][2], ps[2 * ks][3]); pw.z = cvt_pk_bf16(ps[2 * ks + 1][0], ps[2 * ks + 1][1]); pw.w = cvt_pk_bf16(ps[2 * ks + 1][2], ps[2 * ks + 1][3]);
                const bf16x8 pf = __builtin_bit_cast(bf16x8, pw);
#pragma unroll
                for (int vt = 0; vt < 5; ++vt) { const bf16x8 a = __builtin_shufflevector(vlo[vt], vhi[vt], 0, 1, 2, 3, 4, 5, 6, 7); ao[vt] = MFMA16(a, pf, ao[vt]); }
            }
        }
        { const float den = bperm(fr, ao[4][0]); const float inv = 1.0f / fmaxf(fabsf(den), emt_t);
          const int p = dir ? pbase + 127 - t : pbase + t; bf16_t* orow = HF + (size_t)(seqbase + p) * 512 + head * 128 + vh * 64 + 4 * q4;
#pragma unroll
          for (int vt = 0; vt < 4; ++vt) { const f32x4 o = ao[vt] * inv; u32x2 w; w.x = cvt_pk_bf16(o[0], o[1]); w.y = cvt_pk_bf16(o[2], o[3]); *(u32x2*)(orow + 16 * vt) = w; } }
        { const float a_s = sc_g[640];
#pragma unroll
          for (int vt = 0; vt < 5; ++vt) cs[vt] = cs[vt] * a_s;
#pragma unroll
          for (int ks = 0; ks < 4; ks += 2) { bf16x8 bb[2], va[2][5];
#pragma unroll
              for (int k2 = 0; k2 < 2; ++k2) { bb[k2] = *(const LAS bf16x8*)(KW + (16 * wave + fr) * 272 + (((4 * (ks + k2) + q4) ^ (((16 * wave + fr) >> 3) & 7)) * 16));
#pragma unroll
                  for (int vt = 0; vt < 5; ++vt) va[k2][vt] = *(const LAS bf16x8*)(VT + (16 * vt + fr) * 272 + (32 * (ks + k2) + 8 * q4) * 2); }
#pragma unroll
              for (int k2 = 0; k2 < 2; ++k2)
#pragma unroll
                  for (int vt = 0; vt < 5; ++vt) cs[vt] = MFMA16(va[k2][vt], bb[k2], cs[vt]); } }
        if (wave == 0 && j + 1 < 34) ML_STEPA((j + 1) & 1);
        ML_BAR();
    }
#undef ML_PREFETCH
#undef ML_STEPA
#undef ML_ROLES
    __syncthreads();
}
__device__ __forceinline__ void phase_mixers(Frame& F, int l) {
    const bool with_ctx = (l != DEPTH - 1);
#ifndef MIX_MASK
#define MIX_MASK 7
#endif
#ifndef MIXREP
#define MIXREP 0
#endif
    if (MIX_MASK & 1) pool_tiles(F, l, with_ctx);
    if (MIXREP & 1) { __syncthreads(); pool_tiles(F, l, with_ctx); }
    if (MIX_MASK & 2) sgu_chunks(F, l, with_ctx);
    if (MIXREP & 2) { __syncthreads(); sgu_chunks(F, l, with_ctx); }
    (void)0;
    qk_conv_pass(F, l);
}
__device__ __forceinline__ void phase_mlstm(Frame& F, int l) {
    for (int u = F.bid; u < 256; u += F.G) mlstm_unit(F, l, u);
}

struct Args { const float* in[31]; float* out; unsigned char* ws; int g_lo, g_hi, pad0, pad1; };
constexpr int NPH = 11, NGID = 2 + DEPTH * NPH;
__global__ void __launch_bounds__(NTHREADS, 2) fwd_kernel(Args args) {
    extern __shared__ __attribute__((aligned(16))) unsigned char lds_raw[];
    Frame F;
    F.lds = (LAS unsigned char*)lds_raw; F.MISC = (volatile LAS unsigned*)(F.lds + MISC_OFF);
    F.tid = threadIdx.x; F.lane = F.tid & 63; F.wave = __builtin_amdgcn_readfirstlane(F.tid >> 6); F.G = gridDim.x; F.bid = blockIdx.x;
    F.ws = args.ws; F.out = args.out;
    F.in = (InTab)__builtin_amdgcn_kernarg_segment_ptr();
    if (F.tid < 64) F.MISC[F.tid] = 0u;
    __syncthreads();
    const int lo = args.g_lo, hi = args.g_hi;
    const bool multi = (hi - lo) > 1;
    XcdBarrier bar; bar.bar = (unsigned*)(F.ws + WS_CTL) + CW_BAR; bar.x = 0; bar.st = nullptr;
    if (multi) bar = xcd_barrier_post((unsigned*)(F.ws + WS_CTL) + CW_BAR, F.MISC + 8);
#ifndef PHASE_MASK
#define PHASE_MASK 0xFFFF
#endif
#define RUN(g) (lo <= (g) && (g) < hi)
#define RUNP(ty, g) ((((PHASE_MASK) >> (ty)) & 1) && RUN(g))
#ifndef REPEAT_MASK
#define REPEAT_MASK 0
#endif
#define NREP(ty) ((((REPEAT_MASK) >> (ty)) & 1) ? 2 : 1)
#define SEAM(g) do { if (RUN((g) + 1)) xcd_barrier(bar); } while (0)
#define LAUNDER(P) Frame P = F; { int t_; asm volatile("v_mbcnt_lo_u32_b32 %0, -1, 0\n\tv_mbcnt_hi_u32_b32 %0, -1, %0" : "=v"(t_)); t_ |= (F.wave << 6); P.tid = t_; P.lane = t_ & 63; P.wave = __builtin_amdgcn_readfirstlane(t_ >> 6); GAS unsigned char* w_ = (GAS unsigned char*)F.ws; asm volatile("" : "+s"(w_)); P.ws = (unsigned char*)w_; InTab t2_ = F.in; asm volatile("" : "+s"(t2_)); P.in = t2_; }
    if (RUNP(0, 0)) { LAUNDER(P); for (int rep_ = 0; rep_ < NREP(0); ++rep_) { phase_prologue(P); __syncthreads(); } SEAM(0); }
    if (RUNP(1, 1)) { LAUNDER(P); for (int rep_ = 0; rep_ < NREP(1); ++rep_) { phase_ln0_first(P); __syncthreads(); } SEAM(1); }
#pragma unroll 1
    for (int l = 0; l < DEPTH; ++l) {
        const int g0 = 2 + l * NPH;
        const int mrows = (l == DEPTH - 1) ? ML : MT;
        if (RUNP(2, g0 + 0)) {
#undef PHTY
#define PHTY 2
            LAUNDER(P);
            { ProbPlain Pr{(const bf16_t*)(P.ws + WS_H), (const bf16_t*)(P.ws + WS_WIN) + (size_t)l * NZ * D, D, D};
              pg8::StaticOrder<1> S; S.init(MT / 256, NZ_BF / 256, P.G, P.bid);
              EpiInproj<false> E{(bf16_t*)(P.ws + WS_Z), P.in[IN_BIN] + (size_t)l * 5904, 0};
              pg8::gemm_phase(P.lds, P.tid, Pr, S, E); }
            __syncthreads();
            { ProbPlainF8 Pr{(const bf16_t*)(P.ws + WS_H8), (const bf16_t*)(P.ws + WS_WIN8 + (size_t)l * NZ_F8 * D), D / 2, D / 2};
              pg8::StaticOrder<1> S; S.init(MT / 256, NZ_F8 / 256, P.G, P.bid);
              EpiInproj<true> E{(bf16_t*)(P.ws + WS_Z), P.in[IN_BIN] + (size_t)l * 5904, NZ_BF / 256};
              pg8::gemm_phase(P.lds, P.tid, Pr, S, E); }
            SEAM(g0 + 0);
        }
        if (RUNP(3, g0 + 1)) { LAUNDER(P); for (int rep_ = 0; rep_ < NREP(3); ++rep_) { phase_mixers(P, l); __syncthreads(); } SEAM(g0 + 1); }
        if (RUNP(12, g0 + 2)) { LAUNDER(P); for (int rep_ = 0; rep_ < NREP(12); ++rep_) { phase_mlstm(P, l); __syncthreads(); } SEAM(g0 + 2); }
        if (RUNP(4, g0 + 3)) { LAUNDER(P); for (int rep_ = 0; rep_ < NREP(4); ++rep_) phase_finalize(P, l, mrows); SEAM(g0 + 3); }
        if (RUNP(5, g0 + 4)) {
#undef PHTY
#define PHTY 5
            LAUNDER(P);
            ProbPlain Pr{(const bf16_t*)(P.ws + WS_BRA), (const bf16_t*)(P.ws + WS_WBR) + (size_t)l * D * D, D, D};
            pg8::StaticOrder<1> S; S.init(mrows / 256, 4, P.G, P.bid);
            EpiBranch E{(const bf16_t*)(P.ws + WS_Z), (bf16_t*)(P.ws + WS_Y)};
            pg8::gemm_phase(P.lds, P.tid, Pr, S, E); if (NREP(PHTY) == 2) { __syncthreads(); pg8::gemm_phase(P.lds, P.tid, Pr, S, E); }
            SEAM(g0 + 4);
        }
        if (RUNP(6, g0 + 5)) {
#undef PHTY
#define PHTY 6
            LAUNDER(P);
            ProbPlain Pr{(const bf16_t*)(P.ws + WS_Y), (const bf16_t*)(P.ws + WS_WOUT) + (size_t)l * D * D, D, D};
            pg8::StaticOrder<1> S; S.init(mrows / 256, 4, P.G, P.bid);
            EpiOut E{(bf16_t*)(P.ws + WS_T)};
            pg8::gemm_phase(P.lds, P.tid, Pr, S, E); if (NREP(PHTY) == 2) { __syncthreads(); pg8::gemm_phase(P.lds, P.tid, Pr, S, E); }
            SEAM(g0 + 5);
        }
        if (RUNP(7, g0 + 6)) { LAUNDER(P); for (int rep_ = 0; rep_ < NREP(7); ++rep_) phase_ln1_router(P, l, mrows); SEAM(g0 + 6); }
        if (RUNP(8, g0 + 7)) { LAUNDER(P); for (int rep_ = 0; rep_ < NREP(8); ++rep_) phase_slots(P, mrows); SEAM(g0 + 7); }
        if (RUNP(9, g0 + 8)) {
#undef PHTY
#define PHTY 9
            LAUNDER(P);
            LAS int* seg = (LAS int*)(P.lds + TAB_OFF);
            const int ntile = moe_tables(P, seg);
            ProbMoe1 Pr{(const bf16_t*)(P.ws + WS_H2F8), (const bf16_t*)(P.ws + WS_WGU + (size_t)l * NEXP * 2048 * D), D / 2, D / 2, (const int*)(P.ws + WS_ROUTE + RT_TOK), seg};
            pg8::StaticOrder<1> S; S.init(ntile, 8, P.G, P.bid);
            EpiSwiglu E{(unsigned char*)(P.ws + WS_HID), P.in[IN_BGU] + (size_t)l * NEXP * 2048, seg};
            pg8::gemm_phase(P.lds, P.tid, Pr, S, E); if (NREP(PHTY) == 2) { __syncthreads(); pg8::gemm_phase(P.lds, P.tid, Pr, S, E); }
            SEAM(g0 + 8);
        }
        if (RUNP(10, g0 + 9)) {
#undef PHTY
#define PHTY 10
            LAUNDER(P);
            LAS int* seg = (LAS int*)(P.lds + TAB_OFF);
            const int ntile = moe_tables(P, seg);
            ProbMoe2 Pr{(const bf16_t*)(P.ws + WS_HID), (const bf16_t*)(P.ws + WS_WDN + (size_t)l * NEXP * D * D), D / 2, D / 2, seg};
            pg8::StaticOrder<1> S; S.init(ntile, 4, P.G, P.bid);
            EpiDown E{(unsigned char*)(P.ws + WS_FS), P.in[IN_BDN] + (size_t)l * NEXP * D, (const int*)(P.ws + WS_ROUTE + RT_DEST), (const float*)(P.ws + WS_ROUTE + RT_PSLOT), seg};
            pg8::gemm_phase(P.lds, P.tid, Pr, S, E); if (NREP(PHTY) == 2) { __syncthreads(); pg8::gemm_phase(P.lds, P.tid, Pr, S, E); }
            SEAM(g0 + 9);
        }
        if (RUNP(11, g0 + 10)) { LAUNDER(P); phase_combine_ln2(P, l, mrows); SEAM(g0 + 10); }
    }
#undef LAUNDER
#undef RUN
#undef RUNP
#undef SEAM
}

extern "C" void kernel_launch(void* const* d_in, const int* in_sizes, int n_in, void* d_out, int out_size, void* d_ws, size_t ws_size, hipStream_t stream) {
    static int grid = 0;
    if (grid == 0) {
        if (n_in != 31 || out_size != ML * D || ws_size < WS_END) { fprintf(stderr, "kernel_launch: unexpected problem (n_in %d, out %d, ws %zu, need %zu)\n", n_in, out_size, ws_size, (size_t)WS_END); grid = -1; return; }
        int dev = 0, cus = 0, per_cu = 0;
        if (hipGetDevice(&dev) != hipSuccess || hipDeviceGetAttribute(&cus, hipDeviceAttributeMultiprocessorCount, dev) != hipSuccess) { grid = -1; return; }
        if (hipFuncSetAttribute((const void*)fwd_kernel, hipFuncAttributeMaxDynamicSharedMemorySize, LDS_BYTES) != hipSuccess) { fprintf(stderr, "kernel_launch: hipFuncSetAttribute failed\n"); grid = -1; return; }
        if (hipOccupancyMaxActiveBlocksPerMultiprocessor(&per_cu, (const void*)fwd_kernel, NTHREADS, LDS_BYTES) != hipSuccess || per_cu < 1) fprintf(stderr, "kernel_launch: occupancy query reports %d\n", per_cu);
        (void)hipGetLastError();
        grid = cus;
    }
    if (grid < 0) return;
    (void)hipMemsetAsync((char*)d_ws + WS_CTL, 0, CTL_ZERO_BYTES, stream);
    Args a{};
    for (int i = 0; i < 31; ++i) a.in[i] = (const float*)d_in[i];
    a.out = (float*)d_out; a.ws = (unsigned char*)d_ws;
#if MK_N_LAUNCHES == 1
    a.g_lo = 0; a.g_hi = NGID;
    hipLaunchKernelGGL(fwd_kernel, dim3(grid), dim3(NTHREADS), LDS_BYTES, stream, a);
#else
    for (int g = 0; g < NGID; ++g) { a.g_lo = g; a.g_hi = g + 1; hipLaunchKernelGGL(fwd_kernel, dim3(grid), dim3(NTHREADS), LDS_BYTES, stream, a); }
#endif
}
```

```cpp
#include <hip/hip_runtime.h>
#include <cstdio>
#include <cstdint>

#ifndef MK_N_LAUNCHES
#define MK_N_LAUNCHES 1
#endif

#define LAS __attribute__((address_space(3)))
#define GAS __attribute__((address_space(1)))
typedef unsigned short bf16_t;
typedef short bf16x8 __attribute__((ext_vector_type(8)));
typedef short s16x4 __attribute__((ext_vector_type(4)));
typedef float f32x4 __attribute__((ext_vector_type(4)));
typedef float f32x2 __attribute__((ext_vector_type(2)));
typedef float f32x16 __attribute__((ext_vector_type(16)));
typedef unsigned u32x4 __attribute__((ext_vector_type(4)));
typedef unsigned u32x2 __attribute__((ext_vector_type(2)));
typedef int i32x4 __attribute__((ext_vector_type(4)));
typedef int i32x8 __attribute__((ext_vector_type(8)));

constexpr int D = 1024, NB = 16, SEQ = 4096, CTXL = 256, DEPTH = 4;
constexpr int ML = NB * SEQ;
constexpr int MC = NB * CTXL;
constexpr int MT = ML + MC;
constexpr int NZ = 5888;
constexpr int ZC_P = 0, ZC_QK = 256, ZC_V = 1280, ZC_O = 1792, ZC_UV = 2304, ZC_MG = 2816;
constexpr int NZ_BF = 256, NZ_F8 = 5632;
constexpr int ZG_COL = 2816;
constexpr int NEXP = 32, TOPK = 4;
constexpr int NS_MAX = MT * TOPK + NEXP * 256;
constexpr float LN_EPS = 1e-5f, HEAD_EPS = 1e-6f;
constexpr float DN_ALPHA = 1.6817928305074292f;
constexpr int NWAVES = 8, NTHREADS = 512;
constexpr float F8S_ACT = 4.0f, F8S_WGU = 64.0f, F8S_WDN = 64.0f; constexpr int F8E_ACT = 123, F8E_WGU = 123, F8E_WDN = 123;

constexpr size_t MiB = 1u << 20;
constexpr size_t WS_CTL = 0, CTL_ZERO_BYTES = 1 * MiB;
constexpr size_t WS_MOD = 1 * MiB;
constexpr size_t WS_WG = 3 * MiB;
constexpr size_t WS_WSGU = 4 * MiB;
constexpr size_t WS_WPOOL = WS_WSGU + 512 * 1024;
constexpr size_t WS_ROUTE = 5 * MiB;
constexpr size_t WS_WIN = 16 * MiB;
constexpr size_t WS_WBR = 62 * MiB;
constexpr size_t WS_WOUT = 70 * MiB;
constexpr size_t WS_WGU = 78 * MiB;
constexpr size_t WS_WDN = 590 * MiB;
constexpr size_t WS_X = 846 * MiB;
constexpr size_t WS_H = 1118 * MiB;
constexpr size_t WS_Z = 1254 * MiB;
constexpr size_t WS_FS = WS_Z;
constexpr float G8_SCALE = 255.0f;
constexpr float FS_SCALE = 32.0f, FS_CLAMP = 440.0f;
constexpr size_t WS_BRA = 2036 * MiB;
constexpr size_t WS_HFB = 2172 * MiB;
constexpr size_t WS_Y = 2444 * MiB;
constexpr size_t WS_T = 2580 * MiB;
constexpr size_t WS_H2 = 2852 * MiB;
constexpr size_t WS_HID = 2988 * MiB;
constexpr size_t WS_ZG = 3548 * MiB;
constexpr size_t WS_H2F8 = 3554 * MiB;
constexpr size_t WS_H8 = 3624 * MiB;
constexpr size_t WS_WIN8 = 3692 * MiB;
constexpr size_t WS_END = 3714 * MiB;
static_assert(WS_Z + (size_t)MT * NZ * 2 <= WS_BRA && WS_FS + (size_t)MT * 4 * 1024 * 2 <= WS_BRA, "Z/FS");
static_assert(WS_HID + (size_t)NS_MAX * 1024 * 2 <= WS_END, "HID");
constexpr size_t RT_EIDX = 0;
constexpr size_t RT_PROB = 2 * MiB;
constexpr size_t RT_TOK = 4 * MiB;
constexpr size_t RT_DEST = 6 * MiB;
constexpr size_t RT_PSLOT = 8 * MiB;
constexpr size_t RT_CNT = 10 * MiB;
constexpr size_t RT_SEG = 10 * MiB + 64 * 1024;
constexpr int CW_BAR = 4096;

constexpr int LDS_BYTES = 163840;
constexpr int MISC_OFF = LDS_BYTES - 256;
constexpr int TAB_OFF = 131072;
constexpr int NW_WT = 0;
constexpr int NW_LG = 66048;
constexpr int NW_END = 99840;
constexpr int NW_PV = NW_END + 256;

__device__ __forceinline__ unsigned f2bf(float f) { unsigned u = __builtin_bit_cast(unsigned, f); return (u + 0x7fffu + ((u >> 16) & 1u)) >> 16; }
__device__ __forceinline__ unsigned pk2(float lo, float hi) { unsigned r; asm volatile("v_cvt_pk_bf16_f32 %0, %1, %2" : "=v"(r) : "v"(lo), "v"(hi)); return r; }
__device__ __forceinline__ unsigned pk4_fp8(float a, float b, float c, float d) { int w = 0; w = __builtin_amdgcn_cvt_pk_fp8_f32(a, b, w, false); w = __builtin_amdgcn_cvt_pk_fp8_f32(c, d, w, true); return (unsigned)w; }
__device__ __forceinline__ unsigned pk4_u8(float a, float b, float c, float d) {
    const unsigned lo = __builtin_amdgcn_perm(__builtin_bit_cast(unsigned, b), __builtin_bit_cast(unsigned, a), 0x0c0c0400u), hi = __builtin_amdgcn_perm(__builtin_bit_cast(unsigned, d), __builtin_bit_cast(unsigned, c), 0x0c0c0400u);
    return lo | (hi << 16); }
__device__ __forceinline__ f32x4 u8x4_f32(unsigned w) { return (f32x4){(float)(w & 0xffu), (float)((w >> 8) & 0xffu), (float)((w >> 16) & 0xffu), (float)(w >> 24)}; }
__device__ __forceinline__ float bflo(unsigned w) { return __builtin_bit_cast(float, w << 16); }
__device__ __forceinline__ float bfhi(unsigned w) { return __builtin_bit_cast(float, w & 0xffff0000u); }
__device__ __forceinline__ float bf1(bf16_t h) { return __builtin_bit_cast(float, ((unsigned)h) << 16); }
__device__ __forceinline__ float bperm(int srclane, float v) { return __builtin_bit_cast(float, __builtin_amdgcn_ds_bpermute(srclane << 2, __builtin_bit_cast(int, v))); }
__device__ __forceinline__ float shx(float v, int o, int lane) { return bperm(lane ^ o, v); }
__device__ __forceinline__ float shup(float v, int o, int lane) { return bperm(lane >= o ? lane - o : lane, v); }
__device__ __forceinline__ float wave_sum(float v, int lane) {
#pragma unroll
    for (int o = 1; o < 64; o <<= 1) v += shx(v, o, lane);
    return v;
}
__device__ __forceinline__ float sigmoidf_(float x) { return __builtin_amdgcn_rcpf(1.0f + __builtin_amdgcn_exp2f(x * -1.4426950408889634f)); }
__device__ __forceinline__ float siluf_(float x) { return x * __builtin_amdgcn_rcpf(1.0f + __builtin_amdgcn_exp2f(x * -1.4426950408889634f)); }
__device__ __forceinline__ f32x4 sigmoid4(f32x4 x) {
    f32x4 t = x * -1.4426950408889634f;
#pragma unroll
    for (int i = 0; i < 4; ++i) t[i] = __builtin_amdgcn_exp2f(t[i]);
    t = t + 1.0f;
#pragma unroll
    for (int i = 0; i < 4; ++i) t[i] = __builtin_amdgcn_rcpf(t[i]);
    return t; }
#define LDS_WAIT() asm volatile("s_waitcnt lgkmcnt(0)" ::: "memory")
#define VM_WAIT() asm volatile("s_waitcnt vmcnt(0)" ::: "memory")

#define XB_TMO      128
#define XB_XCNT(j)  (256  + 64 * (j))
#define XB_XSUB(j)  (1280 + 64 * (j))
#define XB_XGEN(j)  (2304 + 64 * (j))
#define XB_TOP      3328
#define XB_TOPGEN   3392
#define XCD_BAR_WORDS 3456
#define XB_SPIN_CAP (1u << 18)
__device__ __forceinline__ unsigned xb_ld(unsigned* p)              { asm volatile("" : "+v"(p)); return __hip_atomic_load(p, __ATOMIC_RELAXED, __HIP_MEMORY_SCOPE_AGENT); }
__device__ __forceinline__ unsigned xb_add(unsigned* p, unsigned v) { asm volatile("" : "+v"(p), "+v"(v)); return __hip_atomic_fetch_add(p, v, __ATOMIC_RELAXED, __HIP_MEMORY_SCOPE_AGENT); }
__device__ __forceinline__ unsigned xb_xcc_id() { return (unsigned)__builtin_amdgcn_s_getreg((3 << 11) | 20) & 0xFu; }
#define XB_SPIN(cond, bar) do { unsigned _sp = 0; while (cond) { __builtin_amdgcn_s_sleep(1); \
    if ((++_sp & 255u) == 0u) { if (xb_ld(&(bar)[XB_TMO])) break; if (_sp > XB_SPIN_CAP) { atomicAdd(&(bar)[XB_TMO], 1u); break; } } } } while (0)
struct XcdBarrier { unsigned* bar; unsigned x; volatile LAS unsigned* st; };
__device__ __forceinline__ XcdBarrier xcd_barrier_post(unsigned* bar, volatile LAS unsigned* st) {
    XcdBarrier b; b.bar = bar; b.x = xb_xcc_id(); b.st = st;
    if (threadIdx.x == 0) (void)xb_add(&bar[XB_XCNT(b.x)], 1u);
    return b;
}
__device__ __forceinline__ void xcd_barrier_complete(unsigned* bar, unsigned x, unsigned& nloc, unsigned& nx) {
    const unsigned G = gridDim.x * gridDim.y * gridDim.z;
    unsigned sum, cnt, mine, sp = 0u;
    for (;;) {
        sum = 0u; cnt = 0u; mine = 0u;
#pragma unroll
        for (unsigned j = 0; j < 16; ++j) { const unsigned c = xb_ld(&bar[XB_XCNT(j)]); sum += c; cnt += (c > 0u) ? 1u : 0u; mine = (j == x) ? c : mine; }
        if (sum == G) break;
        __builtin_amdgcn_s_sleep(1);
        if ((++sp & 255u) == 0u) { if (xb_ld(&bar[XB_TMO])) break; if (sp > XB_SPIN_CAP) { atomicAdd(&bar[XB_TMO], 1u); break; } }
    }
    nloc = mine > 0u ? mine : 1u; nx = cnt > 0u ? cnt : 1u;
}
__device__ __forceinline__ void xcd_barrier(const XcdBarrier& b) {
    asm volatile("s_waitcnt vmcnt(0)" ::: "memory");
    __syncthreads();
    if (threadIdx.x == 0) {
        unsigned* bar = b.bar;
        __builtin_amdgcn_s_waitcnt(0);
        unsigned nloc = b.st[0], nx = b.st[1];
        if (nloc == 0u) { xcd_barrier_complete(bar, b.x, nloc, nx); b.st[0] = nloc; b.st[1] = nx; }
        const unsigned old = xb_add(&bar[XB_XSUB(b.x)], 1u);
        const unsigned gen = old / nloc;
        if (old + 1u == (gen + 1u) * nloc) {
            __builtin_amdgcn_fence(__ATOMIC_RELEASE, "agent");
            asm volatile("s_waitcnt vmcnt(0)" ::: "memory");
            const unsigned og = xb_add(&bar[XB_TOP], 1u);
            const unsigned tg = og / nx;
            if (og + 1u == (tg + 1u) * nx) xb_add(&bar[XB_TOPGEN], 1u);
            else XB_SPIN(xb_ld(&bar[XB_TOPGEN]) == tg, bar);
            __builtin_amdgcn_fence(__ATOMIC_ACQUIRE, "agent");
            xb_add(&bar[XB_XGEN(b.x)], 1u);
            asm volatile("s_waitcnt vmcnt(0)" ::: "memory");
        } else {
            XB_SPIN(xb_ld(&bar[XB_XGEN(b.x)]) == gen, bar);
            __builtin_amdgcn_fence(__ATOMIC_ACQUIRE, "agent");
            asm volatile("s_waitcnt vmcnt(0)" ::: "memory");
        }
    }
    __syncthreads();
}

namespace pg8 {
constexpr int BM = 256, BK = 64, HALF = 128, HTB = HALF * BK * 2, STAGE_BYTES = 8 * HTB, NXCD = 8, WGM = 8;
__host__ __device__ __forceinline__ int lds_byte(int r, int c) { const int st = (r >> 4) * 2 + (c >> 5), rr = r & 15, cc = c & 31, ob = rr * 64 + cc * 2; return st * 1024 + (ob ^ (((ob >> 9) & 1) << 5)); }
__host__ __device__ __forceinline__ void stage_rc(int b, int& R, int& C) { const int st = b / 1024, sb = b % 1024, swz = sb ^ (((sb >> 9) & 1) << 5); R = (st >> 1) * 16 + swz / 64; C = (st & 1) * 32 + (swz % 64) / 2; }
__host__ __device__ __forceinline__ int perm32(int rho) { const int n = rho >> 4, i = rho & 15; return 8 * (i >> 2) + 4 * n + (i & 3); }
struct Unit { int pm, pn, sub; };
__device__ __forceinline__ unsigned cvt_pk_bf16(float lo, float hi) { unsigned r; asm volatile("v_cvt_pk_bf16_f32 %0, %1, %2" : "=v"(r) : "v"(lo), "v"(hi)); return r; }
__device__ __forceinline__ f32x2 gelu_pk(f32x2 v) {
    const f32x2 av = __builtin_elementwise_abs(v), d = av * 0.2316418882f + 1.0f;
    f32x2 t; t.x = __builtin_amdgcn_rcpf(d.x); t.y = __builtin_amdgcn_rcpf(d.y);
    f32x2 q = t * 0.5307027145f + (-0.7265760135f); q = q * t + 0.7107068705f; q = q * t + (-0.142248368f); q = q * t + 0.127414796f; q = q * t;
    const f32x2 s = (v * v) * (-0.72134752044f);
    f32x2 e; e.x = __builtin_amdgcn_exp2f(s.x); e.y = __builtin_amdgcn_exp2f(s.y);
    const f32x2 m = v * (q * e), r = v - m;
    f32x2 o; o.x = v.x < 0.f ? m.x : r.x; o.y = v.y < 0.f ? m.y : r.y; return o;
}
template <int NSUB = 1> struct StaticOrder {
    int nM, nN, nwg, G, c;
    __device__ void init(int nM_, int nN_, int G_, int c_) { nM = nM_; nN = nN_; nwg = nM * nN; G = G_; c = c_; }
    __device__ bool next(int i, Unit& u) const {
        const int it = i / NSUB; u.sub = i - it * NSUB;
        const long L = (long)it * G + c; if (L >= nwg) return false;
        int wgid = (int)L; { const int q = nwg / NXCD, r = nwg % NXCD, xcd = wgid % NXCD, off = wgid / NXCD; wgid = (xcd < r ? xcd * (q + 1) : r * (q + 1) + (xcd - r) * q) + off; }
        const int nig = WGM * nN, gid = wgid / nig, fm = gid * WGM, gsz = (nM - fm) < WGM ? (nM - fm) : WGM;
        u.pm = fm + ((wgid % nig) % gsz); u.pn = (wgid % nig) / gsz; return true;
    }
};
constexpr int SIDE_TOK = 131072 + 2048;
constexpr int SIDE_SLOT = 131072 + 10240, SIDE_SLOT_BYTES = 3072;
__device__ __forceinline__ void dma16(unsigned voff, const void* sbase, unsigned ldsaddr) { asm volatile("s_mov_b32 m0, %2\n\tglobal_load_lds_dwordx4 %0, %1" :: "v"(voff), "s"(sbase), "s"(ldsaddr) : "memory", "m0"); }
__device__ __forceinline__ void dma4(unsigned voff, const void* sbase, unsigned ldsaddr) { asm volatile("s_mov_b32 m0, %2\n\tglobal_load_lds_dword %0, %1" :: "v"(voff), "s"(sbase), "s"(ldsaddr) : "memory", "m0"); }
template <class Prob, class Sched, class Epi>
__device__ __forceinline__ void gemm_phase(LAS unsigned char* lds, const int tid, const Prob& P, const Sched& S, const Epi& E) {
    const int wid = __builtin_amdgcn_readfirstlane(tid >> 6), lane = tid & 63, wr = wid >> 2, wc = wid & 3, fr = lane & 15, fq = lane >> 4;
    const int lda = P.lda, ldb = P.ldb;
    unsigned voffB[2], offA[2][2];
#define PG8_TOKSLOT(name) const LAS int* name; { PG8_TID(tl2_); name = (const LAS int*)(lds + SIDE_TOK) + (tl2_ >> 6) * 256 + (tl2_ & 63); }
#define PG8_TID(v_) int v_; asm volatile("v_mbcnt_lo_u32_b32 %0, -1, 0\n\tv_mbcnt_hi_u32_b32 %0, -1, %0" : "=v"(v_)); v_ |= (wid << 6)
#define PG8_RC(R_, C_) int R_[2], C_[2]; { PG8_TID(tl_); _Pragma("unroll") for (int i_ = 0; i_ < 2; ++i_) stage_rc(tl_ * 16 + i_ * 8192, R_[i_], C_[i_]); }
#pragma unroll
    for (int i = 0; i < 2; ++i) { int R, C; stage_rc(tid * 16 + i * 8192, R, C); const int Rb = Epi::PERM ? ((R & ~31) + perm32(R & 31)) : R;
        voffB[i] = (unsigned)(Rb * ldb + C) * 2u;
        offA[0][i] = (unsigned)(R * lda + C) * 2u; offA[1][i] = (unsigned)((R + HALF) * lda + C) * 2u; }
    const size_t kstep = (size_t)(BK * 2);
    const size_t hstep = (size_t)HALF * ldb * 2;
    const unsigned ldsw = (unsigned)wid * 1024u;
    const int aoff = lds_byte(wr * 64 + fr, fq * 8), boff = lds_byte(wc * 32 + fr, fq * 8);
#define PG8_SA(b, h) (((b) * 2 + (h)) * HTB)
#define PG8_SB(b, h) ((4 + (b) * 2 + (h)) * HTB)
    const unsigned ldsb = (unsigned)(size_t)lds;
#define PG8_STAGE(bufoff, gbase, voff) do { _Pragma("unroll") for (int _i = 0; _i < 2; ++_i) \
        asm volatile("s_mov_b32 m0, %2\n\tglobal_load_lds_dwordx4 %0, %1" :: "v"((voff)[_i]), "s"((const char*)(gbase)), "s"(ldsb + (unsigned)(bufoff) + ldsw + (unsigned)(_i * 8192)) : "memory", "m0"); } while (0)
#define PG8_CAT(x0, x1) __builtin_shufflevector(x0, x1, 0, 1, 2, 3, 4, 5, 6, 7)
#define PG8_LDA(dst, b, h) do { if constexpr (Prob::FP8) { _Pragma("unroll") for (int m = 0; m < 4; ++m) dst##8[m] = PG8_CAT(*(const LAS i32x4*)(lds + PG8_SA(b, h) + aoff + m * 2048), *(const LAS i32x4*)(lds + PG8_SA(b, h) + aoff + m * 2048 + 1024)); } \
        else { _Pragma("unroll") for (int m = 0; m < 4; ++m) _Pragma("unroll") for (int k = 0; k < 2; ++k) dst[m][k] = *(const LAS bf16x8*)(lds + PG8_SA(b, h) + aoff + m * 2048 + k * 1024); } } while (0)
#define PG8_LDB(dst, b, h) do { if constexpr (Prob::FP8) { _Pragma("unroll") for (int n = 0; n < 2; ++n) dst##8[n] = PG8_CAT(*(const LAS i32x4*)(lds + PG8_SB(b, h) + boff + n * 2048), *(const LAS i32x4*)(lds + PG8_SB(b, h) + boff + n * 2048 + 1024)); } \
        else { _Pragma("unroll") for (int n = 0; n < 2; ++n) _Pragma("unroll") for (int k = 0; k < 2; ++k) dst[n][k] = *(const LAS bf16x8*)(lds + PG8_SB(b, h) + boff + n * 2048 + k * 1024); } } while (0)
#define PG8_MMA(ai, bj, At, Bt) do { __builtin_amdgcn_s_setprio(1); \
        if constexpr (Prob::FP8) { _Pragma("unroll") for (int m = 0; m < 4; ++m) _Pragma("unroll") for (int n = 0; n < 2; ++n) \
            acc[ai][bj][m][n] = __builtin_amdgcn_mfma_scale_f32_16x16x128_f8f6f4(Bt##8[n], At##8[m], acc[ai][bj][m][n], 0, 0, 0, sc8_, 0, sc8_); } \
        else { _Pragma("unroll") for (int m = 0; m < 4; ++m) _Pragma("unroll") for (int n = 0; n < 2; ++n) _Pragma("unroll") for (int k = 0; k < 2; ++k) \
            acc[ai][bj][m][n] = __builtin_amdgcn_mfma_f32_16x16x32_bf16(Bt[n][k], At[m][k], acc[ai][bj][m][n], 0, 0, 0); } \
        __builtin_amdgcn_s_setprio(0); } while (0)
#define PG8_WAIT_V(n) asm volatile("s_waitcnt vmcnt(" #n ")" ::: "memory")
#define PG8_WAIT_L(n) asm volatile("s_waitcnt lgkmcnt(" #n ")" ::: "memory")
#define PG8_BAR __builtin_amdgcn_s_barrier()
#define PG8_SCHED __builtin_amdgcn_sched_barrier(0)
    Unit cur, nxt; int ui = 0;
    if (!S.next(0, cur)) return;
    static_assert(Prob::SCALE_A == Prob::SCALE_B, "one scale register serves both operands");
    int sc8_; asm volatile("v_mov_b32 %0, %1" : "=v"(sc8_) : "n"(Prob::SCALE_A));
    f32x4 acc[2][2][4][2];
    float zero_; asm volatile("v_mov_b32 %0, 0" : "=v"(zero_));
#pragma unroll
    for (int a = 0; a < 2; ++a)
#pragma unroll
        for (int b = 0; b < 2; ++b)
#pragma unroll
            for (int m = 0; m < 4; ++m)
#pragma unroll
                for (int n = 0; n < 2; ++n) acc[a][b][m][n] = (f32x4){zero_, zero_, zero_, zero_};
    bf16x8 At[4][2], B0[2][2], B1[2][2]; i32x8 At8[4], B08[2], B18[2];
    const char* cA = P.a_base(cur); const char* cB = P.b_base(cur); int nt = P.nt(cur);
    if constexpr (Prob::GATHER) { PG8_RC(Rr, Cc); P.a_rows(cur, Rr, Cc, offA); }
    if constexpr (Epi::SIDE) { PG8_TID(tl4_); E.side(cur, ldsb + SIDE_SLOT, wid, tl4_ & 63); }
    PG8_STAGE(PG8_SB(0, 0), cB, voffB); PG8_STAGE(PG8_SB(0, 1), cB + hstep, voffB); PG8_STAGE(PG8_SA(0, 0), cA, offA[0]); PG8_STAGE(PG8_SA(0, 1), cA, offA[1]);
    if (wr == 1) PG8_BAR;
    PG8_WAIT_V(2); PG8_BAR;
    PG8_STAGE(PG8_SB(1, 0), cB + kstep, voffB); PG8_STAGE(PG8_SA(1, 0), cA + kstep, offA[0]); PG8_STAGE(PG8_SB(1, 1), cB + hstep + kstep, voffB);
    PG8_WAIT_V(6); PG8_BAR;
    for (;;) {
        const bool has_next = S.next(ui + 1, nxt);
        const char* nA = has_next ? P.a_base(nxt) : cA; const char* nB = has_next ? P.b_base(nxt) : cB;
        if constexpr (Prob::GATHER) { if (has_next) { PG8_RC(Rr, Cc); (void)Cc;
#pragma unroll
            for (int h = 0; h < 2; ++h)
#pragma unroll
                for (int i = 0; i < 2; ++i) dma4((unsigned)(nxt.pm * 256 + h * 128 + Rr[i]) * 4u, P.tok, ldsb + SIDE_TOK + (unsigned)wid * 1024u + (unsigned)((h * 2 + i) * 256)); } }
        if constexpr (Epi::SIDE) { if (has_next) { PG8_TID(tl4_); E.side(nxt, ldsb + SIDE_SLOT + (unsigned)(((ui + 1) % 3) * SIDE_SLOT_BYTES), wid, tl4_ & 63); } }
        for (int t = 0; t < nt; t += 2) {
            const bool last = (t == nt - 2);
            if constexpr (Epi::KHOOK) { if (t == Epi::HOOK_T0 || t == Epi::HOOK_T1) {
                asm volatile("" ::: "memory"); PG8_TID(tlh_); const int lnh_ = tlh_ & 63; E.hook(acc, cur, t == Epi::HOOK_T0 ? 0 : 1, wr, wc, lnh_ & 15, lnh_ >> 4); asm volatile("" ::: "memory"); } }
            const char* a1 = cA + (size_t)(t + 1) * kstep;
            const char* a2 = last ? nA : cA + (size_t)(t + 2) * kstep; const char* b2 = last ? nB : cB + (size_t)(t + 2) * kstep;
            const char* a3 = a2 + kstep; const char* b3 = b2 + kstep;
            PG8_LDB(B0, 0, 0); PG8_LDB(B1, 0, 1); PG8_SCHED; PG8_LDA(At, 0, 0); PG8_STAGE(PG8_SA(1, 1), a1, offA[1]);
            PG8_WAIT_V(8); PG8_WAIT_L(0); PG8_BAR; PG8_MMA(0, 0, At, B0); PG8_MMA(0, 1, At, B1); PG8_BAR; PG8_SCHED;
            if constexpr (Prob::GATHER) { if (last && has_next) { PG8_RC(Rr, Cc); (void)Rr; PG8_TOKSLOT(tokslot); const int ntok[2][2] = {{tokslot[0], tokslot[64]}, {tokslot[128], tokslot[192]}}; P.a_off(ntok, Cc, offA); } }
            PG8_LDA(At, 0, 1); PG8_STAGE(PG8_SB(0, 0), b2, voffB); PG8_STAGE(PG8_SB(0, 1), b2 + hstep, voffB); PG8_STAGE(PG8_SA(0, 0), a2, offA[0]);
            PG8_WAIT_V(8); PG8_WAIT_L(0); PG8_BAR; PG8_MMA(1, 0, At, B0); PG8_MMA(1, 1, At, B1); PG8_BAR; PG8_SCHED;
            PG8_LDB(B0, 1, 0); PG8_LDB(B1, 1, 1); PG8_SCHED; PG8_LDA(At, 1, 0); PG8_STAGE(PG8_SA(0, 1), a2, offA[1]);
            PG8_WAIT_V(8); PG8_WAIT_L(0); PG8_BAR; PG8_MMA(0, 0, At, B0); PG8_MMA(0, 1, At, B1); PG8_BAR; PG8_SCHED;
            PG8_LDA(At, 1, 1); PG8_STAGE(PG8_SB(1, 0), b3, voffB); PG8_STAGE(PG8_SB(1, 1), b3 + hstep, voffB); PG8_STAGE(PG8_SA(1, 0), a3, offA[0]);
            PG8_WAIT_V(8); PG8_WAIT_L(0); PG8_BAR; PG8_MMA(1, 0, At, B0); PG8_MMA(1, 1, At, B1); PG8_BAR; PG8_SCHED;
        }
        if (wr == 0) PG8_BAR;
        { PG8_TID(tl3_); const int ln_ = tl3_ & 63; E(acc, cur, wr, wc, ln_ & 15, ln_ >> 4, lds + SIDE_SLOT + (ui % 3) * SIDE_SLOT_BYTES); }
        if (!has_next) break;
        bool keep = false;
        if constexpr (Epi::CHAIN) keep = E.keep(cur);
        if (!keep) {
            asm volatile("v_mov_b32 %0, 0" : "=v"(zero_));
#pragma unroll
            for (int a = 0; a < 2; ++a)
#pragma unroll
                for (int b = 0; b < 2; ++b)
#pragma unroll
                    for (int m = 0; m < 4; ++m)
#pragma unroll
                        for (int n = 0; n < 2; ++n) acc[a][b][m][n] = (f32x4){zero_, zero_, zero_, zero_};
        }
        cur = nxt; cA = nA; cB = nB; nt = P.nt(cur); ++ui;
        if (wr == 1) PG8_BAR;
    }
    PG8_WAIT_V(0);
    PG8_BAR;
#undef PG8_RC
#undef PG8_TID
#undef PG8_TOKSLOT
#undef PG8_SA
#undef PG8_SB
#undef PG8_STAGE
#undef PG8_LDA
#undef PG8_LDB
#undef PG8_MMA
#undef PG8_CAT
#undef PG8_WAIT_V
#undef PG8_WAIT_L
#undef PG8_BAR
#undef PG8_SCHED
}
}

typedef const float* cfp_t;
typedef const cfp_t __attribute__((address_space(4))) * InTab;
struct Frame {
    LAS unsigned char* lds;
    volatile LAS unsigned* MISC;
    unsigned char* ws;
    InTab in;
    float* out;
    int tid, lane, wave, G, bid;
};
enum { IN_X = 0, IN_C, IN_CTX, IN_CCTX, IN_WADA, IN_BADA, IN_WIN, IN_BIN, IN_POOLW, IN_POOLS, IN_CONVW, IN_CONVB, IN_MNG, IN_SLNG, IN_SLNB, IN_SGUW, IN_SGUB,
       IN_WBP, IN_WBM, IN_WBS, IN_WOUT, IN_LN1G, IN_LN1B, IN_WR, IN_BR, IN_WGU, IN_BGU, IN_WDN, IN_BDN, IN_LN2G, IN_LN2B };
__device__ __forceinline__ int mod_row(int row) { return row < ML ? (row >> 12) : NB; }
__device__ __forceinline__ const float* modp(const Frame& F, int l, int row, int part) { return (const float*)(F.ws + WS_MOD) + ((size_t)(l * 17 + mod_row(row)) * 6 + part) * 1024; }

__device__ __forceinline__ void transpose_item(const float* W, size_t ldw, int k0, int srccol0, bf16_t* dst, size_t ldk, int kd0, LAS float* scr, int lane) {
#pragma unroll 8
    for (int i = 0; i < 32; ++i) { const int kk = 2 * i + (lane >> 5); scr[kk * 33 + (lane & 31)] = __builtin_nontemporal_load(W + (size_t)(k0 + kk) * ldw + srccol0 + (lane & 31)); }
    LDS_WAIT(); asm volatile("" ::: "memory");
    const int c = lane & 7;
#pragma unroll
    for (int j = 0; j < 4; ++j) { const int n = (lane >> 3) + 8 * j; const LAS float* s = scr + (8 * c) * 33 + n;
        u32x4 o; o.x = pk2(s[0 * 33], s[1 * 33]); o.y = pk2(s[2 * 33], s[3 * 33]); o.z = pk2(s[4 * 33], s[5 * 33]); o.w = pk2(s[6 * 33], s[7 * 33]);
        *(u32x4*)(dst + (size_t)n * ldk + kd0 + 8 * c) = o; }
    LDS_WAIT(); asm volatile("" ::: "memory");
}
__device__ __forceinline__ void transpose_item_fp8(const float* W, size_t ldw, int k0, int srccol0, unsigned char* dst, size_t ldk, int kd0, float sc, LAS float* scr, int lane) {
#pragma unroll 8
    for (int i = 0; i < 32; ++i) { const int kk = 2 * i + (lane >> 5); scr[kk * 33 + (lane & 31)] = __builtin_nontemporal_load(W + (size_t)(k0 + kk) * ldw + srccol0 + (lane & 31)); }
    LDS_WAIT(); asm volatile("" ::: "memory");
    const int c = lane & 7;
#pragma unroll
    for (int j = 0; j < 4; ++j) { const int n = (lane >> 3) + 8 * j; const LAS float* s_ = scr + (8 * c) * 33 + n;
        u32x2 o; o.x = pk4_fp8(s_[0 * 33] * sc, s_[1 * 33] * sc, s_[2 * 33] * sc, s_[3 * 33] * sc); o.y = pk4_fp8(s_[4 * 33] * sc, s_[5 * 33] * sc, s_[6 * 33] * sc, s_[7 * 33] * sc);
        *(u32x2*)(dst + (size_t)n * ldk + kd0 + 8 * c) = o; }
    LDS_WAIT(); asm volatile("" ::: "memory");
}
__device__ __forceinline__ void phase_prologue(Frame& F) {
    LAS float* scr = (LAS float*)(F.lds + F.wave * 16384);
    const int gw = F.bid * NWAVES + F.wave, NGW = F.G * NWAVES;
    constexpr int I_IN = 16 * (NZ / 32);
    constexpr int I_BR = (4 + 8 + 4) * 32;
    constexpr int I_OUT = 16 * 32;
    constexpr int I_GU = 16 * 64;
    constexpr int I_DN = 16 * 32;
    constexpr int T_IN = DEPTH * I_IN, T_BR = DEPTH * I_BR, T_OUT = DEPTH * I_OUT, T_GU = DEPTH * NEXP * I_GU, T_DN = DEPTH * NEXP * I_DN;
    constexpr int NITEMS = T_IN + T_BR + T_OUT + T_GU + T_DN;
    for (int it = gw; it < NITEMS; it += NGW) {
        int r = it;
        if (r < T_IN) { const int l = r / I_IN; r %= I_IN; const int kb = r / (NZ / 32), nb = r % (NZ / 32); const int n0 = nb * 32, src = n0 < 2304 ? n0 : n0 + 16;
            if (n0 < NZ_BF) transpose_item(F.in[IN_WIN] + (size_t)l * D * 5904, 5904, kb * 64, src, (bf16_t*)(F.ws + WS_WIN) + ((size_t)l * NZ + n0) * D, D, kb * 64, scr, F.lane);
            else transpose_item_fp8(F.in[IN_WIN] + (size_t)l * D * 5904, 5904, kb * 64, src, (unsigned char*)(F.ws + WS_WIN8) + ((size_t)l * NZ_F8 + (n0 - NZ_BF)) * D, D, kb * 64, F8S_WGU, scr, F.lane);
            continue; }
        r -= T_IN;
        if (r < T_BR) { const int l = r / I_BR; r %= I_BR; const int kb = r / 32, nb = r % 32;
            const float* W; int ksrc;
            if (kb < 4) { W = F.in[IN_WBP] + (size_t)l * 256 * D; ksrc = kb * 64; } else if (kb < 12) { W = F.in[IN_WBM] + (size_t)l * 512 * D; ksrc = (kb - 4) * 64; } else { W = F.in[IN_WBS] + (size_t)l * 256 * D; ksrc = (kb - 12) * 64; }
            transpose_item(W, D, ksrc, nb * 32, (bf16_t*)(F.ws + WS_WBR) + ((size_t)l * D + nb * 32) * D, D, kb * 64, scr, F.lane); continue; }
        r -= T_BR;
        if (r < T_OUT) { const int l = r / I_OUT; r %= I_OUT; const int kb = r / 32, nb = r % 32;
            transpose_item(F.in[IN_WOUT] + (size_t)l * D * D, D, kb * 64, nb * 32, (bf16_t*)(F.ws + WS_WOUT) + ((size_t)l * D + nb * 32) * D, D, kb * 64, scr, F.lane); continue; }
        r -= T_OUT;
        if (r < T_GU) { const int le = r / I_GU; r %= I_GU; const int kb = r / 64, nb = r % 64; const int n0 = nb * 32;
            const int pn = n0 >> 8, c = n0 & 255; const int src = c < 128 ? (128 * pn + c) : (1024 + 128 * pn + c - 128);
            transpose_item_fp8(F.in[IN_WGU] + (size_t)le * D * 2048, 2048, kb * 64, src, (unsigned char*)(F.ws + WS_WGU) + ((size_t)le * 2048 + n0) * D, D, kb * 64, F8S_WGU, scr, F.lane); continue; }
        r -= T_GU;
        { const int le = r / I_DN; r %= I_DN; const int kb = r / 32, nb = r % 32;
            transpose_item_fp8(F.in[IN_WDN] + (size_t)le * D * D, D, kb * 64, nb * 32, (unsigned char*)(F.ws + WS_WDN) + ((size_t)le * D + nb * 32) * D, D, kb * 64, F8S_WDN, scr, F.lane); }
    }
    { const int gt = F.bid * NTHREADS + F.tid, NGT = F.G * NTHREADS;
      for (int i = gt; i < DEPTH * 16 * 1024; i += NGT) { const int l = i >> 14, g = (i >> 10) & 15, k = i & 1023; ((float*)(F.ws + WS_WG))[i] = F.in[IN_WIN][((size_t)l * D + k) * 5904 + 2304 + g]; }
      for (int i = gt; i < DEPTH * 4 * 128 * 128; i += NGT) ((bf16_t*)(F.ws + WS_WSGU))[i] = (bf16_t)f2bf(F.in[IN_SGUW][i]);
      for (int i = gt; i < DEPTH * 4 * 64 * 64; i += NGT) { const int lg = i >> 12, d = (i >> 6) & 63, c = i & 63; ((bf16_t*)(F.ws + WS_WPOOL))[i] = (bf16_t)f2bf(F.in[IN_POOLW][(size_t)lg * 4096 + c * 64 + d]); } }
    __syncthreads();
    { LAS float* sc = (LAS float*)F.lds;
      LAS float* part = (LAS float*)(F.lds + 71680);
      for (int i = F.tid; i < 17 * 1024; i += NTHREADS) { const int r = i >> 10, k = i & 1023; const float v = r < 16 ? F.in[IN_C][r * 1024 + k] : F.in[IN_CCTX][k]; sc[i] = siluf_(v); }
      __syncthreads();
      for (int u = F.bid; u < DEPTH * 48; u += F.G) {
          const int l = u / 48, n0 = (u % 48) * 128, col = F.tid & 127, ks = F.tid >> 7;
          float a[17];
#pragma unroll
          for (int r = 0; r < 17; ++r) a[r] = 0.f;
          const float* W = F.in[IN_WADA] + (size_t)l * D * 6144 + n0 + col;
          for (int k = ks * 256; k < ks * 256 + 256; ++k) { const float w = W[(size_t)k * 6144];
#pragma unroll
              for (int r = 0; r < 17; ++r) a[r] += sc[r * 1024 + k] * w; }
#pragma unroll
          for (int r = 0; r < 17; ++r) part[(ks * 17 + r) * 128 + col] = a[r];
          __syncthreads();
          for (int i = F.tid; i < 17 * 128; i += NTHREADS) { const int r = i >> 7, cc = i & 127;
              const float s = part[(0 * 17 + r) * 128 + cc] + part[(1 * 17 + r) * 128 + cc] + part[(2 * 17 + r) * 128 + cc] + part[(3 * 17 + r) * 128 + cc] + F.in[IN_BADA][l * 6144 + n0 + cc];
              ((float*)(F.ws + WS_MOD))[(size_t)(l * 17 + r) * 6144 + n0 + cc] = s; }
          __syncthreads();
      } }
}

struct RowV { f32x4 v[4]; };
#define RC(lane, j) (8 * (lane) + 512 * ((j) >> 1) + 4 * ((j) & 1))
__device__ __forceinline__ void row_load(RowV& r, const float* p, int lane) {
#pragma unroll
    for (int j = 0; j < 4; ++j) r.v[j] = __builtin_nontemporal_load((const f32x4*)(p + RC(lane, j)));
}
__device__ __forceinline__ void row_load_bf16(RowV& r, const bf16_t* p, int lane) {
#pragma unroll
    for (int h = 0; h < 2; ++h) { const u32x4 w = __builtin_nontemporal_load((const u32x4*)(p + 8 * lane + 512 * h)); r.v[2 * h] = (f32x4){bflo(w.x), bfhi(w.x), bflo(w.y), bfhi(w.y)}; r.v[2 * h + 1] = (f32x4){bflo(w.z), bfhi(w.z), bflo(w.w), bfhi(w.w)}; }
}
__device__ __forceinline__ void row_store(const RowV& r, float* p, int lane) {
#pragma unroll
    for (int j = 0; j < 4; ++j) *(f32x4*)(p + RC(lane, j)) = r.v[j];
}
__device__ __forceinline__ void row_store_nt(const RowV& r, float* p, int lane) {
#pragma unroll
    for (int j = 0; j < 4; ++j) __builtin_nontemporal_store(r.v[j], (f32x4*)(p + RC(lane, j)));
}
__device__ __forceinline__ void row_store_bf16_nt(const RowV& r, bf16_t* p, int lane) {
#pragma unroll
    for (int h = 0; h < 2; ++h) { u32x4 w; w.x = pk2(r.v[2 * h].x, r.v[2 * h].y); w.y = pk2(r.v[2 * h].z, r.v[2 * h].w); w.z = pk2(r.v[2 * h + 1].x, r.v[2 * h + 1].y); w.w = pk2(r.v[2 * h + 1].z, r.v[2 * h + 1].w); __builtin_nontemporal_store(w, (u32x4*)(p + 8 * lane + 512 * h)); }
}
__device__ __forceinline__ void row_store_bf16(const RowV& r, bf16_t* p, int lane) {
#pragma unroll
    for (int h = 0; h < 2; ++h) { u32x4 w; w.x = pk2(r.v[2 * h].x, r.v[2 * h].y); w.y = pk2(r.v[2 * h].z, r.v[2 * h].w); w.z = pk2(r.v[2 * h + 1].x, r.v[2 * h + 1].y); w.w = pk2(r.v[2 * h + 1].z, r.v[2 * h + 1].w); *(u32x4*)(p + 8 * lane + 512 * h) = w; }
}
__device__ __forceinline__ void row_ln_plain(RowV& r, int lane) {
    float s = 0.f;
#pragma unroll
    for (int j = 0; j < 4; ++j) s += (r.v[j].x + r.v[j].y) + (r.v[j].z + r.v[j].w);
    const float mean = wave_sum(s, lane) * (1.f / D); float s2 = 0.f;
#pragma unroll
    for (int j = 0; j < 4; ++j) { r.v[j] = r.v[j] - mean; s2 += (r.v[j].x * r.v[j].x + r.v[j].y * r.v[j].y) + (r.v[j].z * r.v[j].z + r.v[j].w * r.v[j].w); }
    const float rstd = 1.f / sqrtf(wave_sum(s2, lane) * (1.f / D) + LN_EPS);
#pragma unroll
    for (int j = 0; j < 4; ++j) r.v[j] = r.v[j] * rstd;
}
__device__ __forceinline__ void row_affine(RowV& r, const float* g, const float* b, int lane) {
#pragma unroll
    for (int j = 0; j < 4; ++j) { const f32x4 gg = *(const f32x4*)(g + RC(lane, j)), bb = *(const f32x4*)(b + RC(lane, j)); r.v[j] = r.v[j] * gg + bb; }
}
__device__ __forceinline__ void row_modulate(RowV& r, const float* sh, const float* sc, int lane) {
#pragma unroll
    for (int j = 0; j < 4; ++j) { const f32x4 s1 = *(const f32x4*)(sc + RC(lane, j)), s0 = *(const f32x4*)(sh + RC(lane, j)); r.v[j] = r.v[j] * (s1 + 1.0f) + s0; }
}
__device__ __forceinline__ LAS float* pv_slot(const Frame& F, int slot) { return (LAS float*)(F.lds + NW_PV) + slot * 1024; }
__device__ __forceinline__ void pv_fill(Frame& F, int slot, const float* src) { LAS f32x4* d = (LAS f32x4*)pv_slot(F, slot); for (int i = F.tid; i < 256; i += NTHREADS) d[i] = *(const f32x4*)(src + 4 * i); }
__device__ __forceinline__ void row_affine_l(RowV& r, const LAS float* g, const LAS float* b, int lane) {
#pragma unroll
    for (int j = 0; j < 4; ++j) { const f32x4 gg = *(const LAS f32x4*)(g + RC(lane, j)), bb = *(const LAS f32x4*)(b + RC(lane, j)); r.v[j] = r.v[j] * gg + bb; }
}
__device__ __forceinline__ void row_modulate_l(RowV& r, const LAS float* sh, const LAS float* sc, int lane) {
#pragma unroll
    for (int j = 0; j < 4; ++j) { const f32x4 s1 = *(const LAS f32x4*)(sc + RC(lane, j)), s0 = *(const LAS f32x4*)(sh + RC(lane, j)); r.v[j] = r.v[j] * (s1 + 1.0f) + s0; }
}
__device__ __forceinline__ void ln0_row(Frame& F, int row, RowV xr, const LAS float* sh, const LAS float* sc) {
    row_ln_plain(xr, F.lane);
    row_modulate_l(xr, sh, sc, F.lane);
    row_store_bf16(xr, (bf16_t*)(F.ws + WS_H) + (size_t)row * D, F.lane);
    { unsigned char* h8 = (unsigned char*)(F.ws + WS_H8) + (size_t)row * D + 8 * F.lane;
#pragma unroll
      for (int h = 0; h < 2; ++h) { u32x2 w; w.x = pk4_fp8(xr.v[2 * h].x * F8S_ACT, xr.v[2 * h].y * F8S_ACT, xr.v[2 * h].z * F8S_ACT, xr.v[2 * h].w * F8S_ACT); w.y = pk4_fp8(xr.v[2 * h + 1].x * F8S_ACT, xr.v[2 * h + 1].y * F8S_ACT, xr.v[2 * h + 1].z * F8S_ACT, xr.v[2 * h + 1].w * F8S_ACT); *(u32x2*)(h8 + 512 * h) = w; } }
}
__device__ __forceinline__ LAS float* narrow_tile_wave(Frame& F, const bf16_t* A) {
    const int r = F.lane & 31, h = F.lane >> 5;
    f32x16 acc;
#pragma unroll
    for (int i = 0; i < 16; ++i) acc[i] = 0.f;
    const bf16_t* ap = A + (size_t)r * D + 8 * h;
    const LAS unsigned char* bp = F.lds + NW_WT + r * 2064 + 16 * h;
    bf16x8 av[2][16];
#pragma unroll
    for (int ks = 0; ks < 16; ++ks) av[0][ks] = *(const bf16x8*)(ap + ks * 16);
#pragma unroll
    for (int kb = 0; kb < 4; ++kb) {
        if (kb < 3) {
#pragma unroll
            for (int ks = 0; ks < 16; ++ks) av[(kb + 1) & 1][ks] = *(const bf16x8*)(ap + ((kb + 1) * 16 + ks) * 16); }
        __builtin_amdgcn_sched_barrier(0);
#pragma unroll
        for (int ks = 0; ks < 16; ++ks) { const bf16x8 b = *(const LAS bf16x8*)(bp + (kb * 16 + ks) * 32); acc = __builtin_amdgcn_mfma_f32_32x32x16_bf16(av[kb & 1][ks], b, acc, 0, 0, 0); }
        __builtin_amdgcn_sched_barrier(0);
    }
    LAS float* lg = (LAS float*)(F.lds + NW_LG) + F.wave * 1056;
#pragma unroll
    for (int i = 0; i < 16; ++i) lg[((i & 3) + 8 * (i >> 2) + 4 * h) * 33 + r] = acc[i];
    asm volatile("s_waitcnt lgkmcnt(0)" ::: "memory");
    return lg;
}
__device__ __forceinline__ void tile_range(const Frame& F, int mrows, int& t_lo, int& t_hi) { const int nt = mrows / 32; t_lo = (int)(((long)F.bid * nt) / F.G); t_hi = (int)(((long)(F.bid + 1) * nt) / F.G); }
__device__ __forceinline__ void load_wg_lds(Frame& F, int l) {
    const float* src = (const float*)(F.ws + WS_WG) + (size_t)l * 16384;
    for (int i = F.tid; i < 32 * 128; i += NTHREADS) { const int g = i >> 7, c8 = i & 127; u32x4 w = (u32x4){0u, 0u, 0u, 0u};
        if (g < 16) { const f32x4 a = *(const f32x4*)(src + g * 1024 + c8 * 8), b = *(const f32x4*)(src + g * 1024 + c8 * 8 + 4); w.x = pk2(a.x, a.y); w.y = pk2(a.z, a.w); w.z = pk2(b.x, b.y); w.w = pk2(b.z, b.w); }
        *(LAS u32x4*)(F.lds + NW_WT + g * 2064 + c8 * 16) = w; }
    __syncthreads();
}
__device__ __forceinline__ void gates_tail(Frame& F, int l, int t_lo, int t_hi) {
    asm volatile("s_waitcnt vmcnt(0)" ::: "memory"); __syncthreads();
    const int g = F.lane & 15; const float bias = F.in[IN_BIN][l * 5904 + 2304 + g];
    for (int tile = t_lo + F.wave; tile < t_hi; tile += NWAVES) {
        const LAS float* lg = narrow_tile_wave(F, (const bf16_t*)(F.ws + WS_H) + (size_t)tile * 32 * D);
#pragma unroll
        for (int rr = 0; rr < 8; ++rr) { const int row = rr * 4 + (F.lane >> 4); ((float*)(F.ws + WS_ZG))[(size_t)(tile * 32 + row) * 16 + g] = lg[row * 33 + g] + bias; }
        asm volatile("s_waitcnt lgkmcnt(0)" ::: "memory");
    }
}

using pg8::Unit;
struct ProbPlain {
    static constexpr bool GATHER = false, FP8 = false; static constexpr int SCALE_A = 127, SCALE_B = 127; const bf16_t* A; const bf16_t* Bt; int lda, ldb;
    __device__ __forceinline__ int nt(const Unit&) const { return lda / 64; }
    __device__ __forceinline__ const char* a_base(const Unit& u) const { return (const char*)A + (size_t)u.pm * 256 * lda * 2; }
    __device__ __forceinline__ const char* b_base(const Unit& u) const { return (const char*)Bt + (size_t)u.pn * 256 * ldb * 2; }
    __device__ __forceinline__ void a_tok(const Unit&, const int (&)[2], int (&)[2][2]) const {}
    __device__ __forceinline__ void a_off(const int (&)[2][2], const int (&)[2], unsigned (&)[2][2]) const {}
    __device__ __forceinline__ void a_rows(const Unit&, const int (&)[2], const int (&)[2], unsigned (&)[2][2]) const {}
};
struct ProbPlainF8 {
    static constexpr bool GATHER = false, FP8 = true; static constexpr int SCALE_A = F8E_ACT, SCALE_B = F8E_WGU; const bf16_t* A; const bf16_t* Bt; int lda, ldb;
    __device__ __forceinline__ int nt(const Unit&) const { return lda / 64; }
    __device__ __forceinline__ const char* a_base(const Unit& u) const { return (const char*)A + (size_t)u.pm * 256 * lda * 2; }
    __device__ __forceinline__ const char* b_base(const Unit& u) const { return (const char*)Bt + (size_t)u.pn * 256 * ldb * 2; }
    __device__ __forceinline__ void a_tok(const Unit&, const int (&)[2], int (&)[2][2]) const {}
    __device__ __forceinline__ void a_off(const int (&)[2][2], const int (&)[2], unsigned (&)[2][2]) const {}
    __device__ __forceinline__ void a_rows(const Unit&, const int (&)[2], const int (&)[2], unsigned (&)[2][2]) const {}
};
struct ProbBranch {
    static constexpr bool GATHER = false, FP8 = false; static constexpr int SCALE_A = 127, SCALE_B = 127; const bf16_t* A; const bf16_t* Bt; int lda, ldb;
    __device__ __forceinline__ int nt(const Unit& u) const { return u.sub == 1 ? 8 : 4; }
    __device__ __forceinline__ int koff(const Unit& u) const { return u.sub == 0 ? 0 : (u.sub == 1 ? 256 : 768); }
    __device__ __forceinline__ const char* a_base(const Unit& u) const { return (const char*)A + ((size_t)u.pm * 256 * lda + koff(u)) * 2; }
    __device__ __forceinline__ const char* b_base(const Unit& u) const { return (const char*)Bt + ((size_t)u.pn * 256 * ldb + koff(u)) * 2; }
    __device__ __forceinline__ void a_tok(const Unit&, const int (&)[2], int (&)[2][2]) const {}
    __device__ __forceinline__ void a_off(const int (&)[2][2], const int (&)[2], unsigned (&)[2][2]) const {}
    __device__ __forceinline__ void a_rows(const Unit&, const int (&)[2], const int (&)[2], unsigned (&)[2][2]) const {}
};
__device__ __forceinline__ int expert_of(const LAS int* seg, int pm) { return __builtin_amdgcn_readfirstlane((int)((const LAS unsigned char*)(seg + 64))[pm]); }
__device__ __forceinline__ int moe_tables(Frame& F, LAS int* seg) {
    __syncthreads();
    if (F.tid <= NEXP) seg[F.tid] = ((const int*)(F.ws + WS_ROUTE + RT_SEG))[F.tid];
    __syncthreads();
    const int ntile = seg[NEXP] / 256;
    LAS unsigned char* texp = (LAS unsigned char*)(seg + 64);
    for (int t = F.tid; t < ntile; t += NTHREADS) { const int row = t * 256; int e = 0;
#pragma unroll
        for (int i = 1; i < NEXP; ++i) e += (seg[i] <= row) ? 1 : 0;
        texp[t] = (unsigned char)e; }
    __syncthreads();
    return ntile;
}
struct ProbMoe1 {
    static constexpr bool GATHER = true, FP8 = true; static constexpr int SCALE_A = F8E_ACT, SCALE_B = F8E_WGU; const bf16_t* A; const bf16_t* Bt; int lda, ldb; const int* tok; const LAS int* seg;
    __device__ __forceinline__ int nt(const Unit&) const { return lda / 64; }
    __device__ __forceinline__ const char* a_base(const Unit&) const { return (const char*)A; }
    __device__ __forceinline__ const char* b_base(const Unit& u) const { const int e = expert_of(seg, u.pm); return (const char*)Bt + ((size_t)e * 2048 + (size_t)u.pn * 256) * ldb * 2; }
    __device__ __forceinline__ void a_rows(const Unit& u, const int (&R)[2], const int (&C)[2], unsigned (&off)[2][2]) const {
#pragma unroll
        for (int h = 0; h < 2; ++h)
#pragma unroll
            for (int i = 0; i < 2; ++i) { const int t = tok[u.pm * 256 + h * 128 + R[i]]; off[h][i] = (unsigned)(t * lda + C[i]) * 2u; } }
    __device__ __forceinline__ void a_tok(const Unit& u, const int (&R)[2], int (&tk)[2][2]) const {
#pragma unroll
        for (int h = 0; h < 2; ++h)
#pragma unroll
            for (int i = 0; i < 2; ++i) tk[h][i] = tok[u.pm * 256 + h * 128 + R[i]]; }
    __device__ __forceinline__ void a_off(const int (&tk)[2][2], const int (&C)[2], unsigned (&off)[2][2]) const {
#pragma unroll
        for (int h = 0; h < 2; ++h)
#pragma unroll
            for (int i = 0; i < 2; ++i) off[h][i] = (unsigned)(tk[h][i] * lda + C[i]) * 2u; }
};
struct ProbMoe2 {
    static constexpr bool GATHER = false, FP8 = true; static constexpr int SCALE_A = F8E_ACT, SCALE_B = F8E_WDN; const bf16_t* A; const bf16_t* Bt; int lda, ldb; const LAS int* seg;
    __device__ __forceinline__ int nt(const Unit&) const { return lda / 64; }
    __device__ __forceinline__ const char* a_base(const Unit& u) const { return (const char*)A + (size_t)u.pm * 256 * lda * 2; }
    __device__ __forceinline__ const char* b_base(const Unit& u) const { const int e = expert_of(seg, u.pm); return (const char*)Bt + ((size_t)e * 1024 + (size_t)u.pn * 256) * ldb * 2; }
    __device__ __forceinline__ void a_tok(const Unit&, const int (&)[2], int (&)[2][2]) const {}
    __device__ __forceinline__ void a_off(const int (&)[2][2], const int (&)[2], unsigned (&)[2][2]) const {}
    __device__ __forceinline__ void a_rows(const Unit&, const int (&)[2], const int (&)[2], unsigned (&)[2][2]) const {}
};
using pg8::cvt_pk_bf16;
template <bool G8> struct EpiInproj {
    static constexpr bool PERM = true, CHAIN = false, SIDE = true, KHOOK = false; bf16_t* Z; const float* bias; int pn0;
    __device__ __forceinline__ void side(const Unit& u0, unsigned slot, int wid, int lane) const { const int pn = u0.pn + pn0; if (wid == 1) pg8::dma16((unsigned)lane * 16u, bias + pn * 256 + (pn >= 9 ? 16 : 0), slot); }
    __device__ __forceinline__ void operator()(const f32x4 (&acc)[2][2][4][2], const Unit& u0, int wr, int wc, int fr, int fq, const LAS unsigned char* sd) const {
        Unit u = u0; u.pn += pn0;
        int row0 = u.pm * 256 + wr * 64 + fr, col0 = u.pn * 256 + wc * 32 + 8 * fq; asm volatile("" : "+v"(row0), "+v"(col0));
        const int act = (u.pn <= 6) ? 0 : ((u.pn == 9 || u.pn == 10) ? 2 : 1);
        f32x4 bv[2][2];
#pragma unroll
        for (int bj = 0; bj < 2; ++bj)
#pragma unroll
            for (int n = 0; n < 2; ++n) bv[bj][n] = *(const LAS f32x4*)(sd + (bj * 128 + wc * 32 + 8 * fq + 4 * n) * 4);
#pragma unroll
        for (int ai = 0; ai < 2; ++ai)
#pragma unroll
            for (int m = 0; m < 4; ++m) { bf16_t* rowp = Z + (size_t)(row0 + ai * 128 + m * 16) * NZ + col0;
#pragma unroll
                for (int bj = 0; bj < 2; ++bj) { f32x4 v0 = acc[ai][bj][m][0] + bv[bj][0], v1 = acc[ai][bj][m][1] + bv[bj][1];
                    if (G8 && u.pn >= ZG_COL / 256) { u32x2 w8;
                        v0 = sigmoid4(v0) * G8_SCALE; v1 = sigmoid4(v1) * G8_SCALE;
#pragma unroll
                        for (int j = 0; j < 4; ++j) { v0[j] = fmaxf(v0[j], 1.0f); v1[j] = fmaxf(v1[j], 1.0f); }
                        v0 = v0 + 12582912.0f; v1 = v1 + 12582912.0f;
                        w8.x = pk4_u8(v0[0], v0[1], v0[2], v0[3]); w8.y = pk4_u8(v1[0], v1[1], v1[2], v1[3]);
                        *(u32x2*)((unsigned char*)(Z + (size_t)(row0 + ai * 128 + m * 16) * NZ + ZG_COL) + (col0 - ZG_COL) + bj * 128) = w8; continue; }
                    if (act == 2) { f32x2 a = pg8::gelu_pk((f32x2){v0[0], v0[1]}), b = pg8::gelu_pk((f32x2){v0[2], v0[3]}), c = pg8::gelu_pk((f32x2){v1[0], v1[1]}), d = pg8::gelu_pk((f32x2){v1[2], v1[3]});
                        v0 = (f32x4){a.x, a.y, b.x, b.y}; v1 = (f32x4){c.x, c.y, d.x, d.y}; }
                    if (act == 1) { v0 = sigmoid4(v0); v1 = sigmoid4(v1); }
                    u32x4 w; w.x = cvt_pk_bf16(v0[0], v0[1]); w.y = cvt_pk_bf16(v0[2], v0[3]); w.z = cvt_pk_bf16(v1[0], v1[1]); w.w = cvt_pk_bf16(v1[2], v1[3]);
                    *(u32x4*)(rowp + bj * 128) = w; }
                if constexpr (G8) asm volatile("" ::: "memory"); }
    }
};
struct EpiNull {
    static constexpr bool PERM = true, CHAIN = false; bf16_t* Z;
    __device__ __forceinline__ void operator()(const f32x4 (&acc)[2][2][4][2], const Unit& u, int wr, int wc, int fr, int fq) const {
        float sacc = 0.f;
#pragma unroll
        for (int ai = 0; ai < 2; ++ai)
#pragma unroll
            for (int bj = 0; bj < 2; ++bj)
#pragma unroll
                for (int m = 0; m < 4; ++m)
#pragma unroll
                    for (int n = 0; n < 2; ++n) sacc += (acc[ai][bj][m][n][0] + acc[ai][bj][m][n][1]) + (acc[ai][bj][m][n][2] + acc[ai][bj][m][n][3]);
        if (sacc == 1.2345e30f) Z[u.pm + wr + wc + fr + fq] = 0;
    }
};
struct EpiOut {
    static constexpr bool PERM = true, CHAIN = false, SIDE = false, KHOOK = false; bf16_t* T;
    __device__ __forceinline__ void operator()(const f32x4 (&acc)[2][2][4][2], const Unit& u, int wr, int wc, int fr, int fq, const LAS unsigned char*) const {
        int row0 = u.pm * 256 + wr * 64 + fr, col0 = u.pn * 256 + wc * 32 + 8 * fq; asm volatile("" : "+v"(row0), "+v"(col0));
#pragma unroll
        for (int ai = 0; ai < 2; ++ai)
#pragma unroll
            for (int m = 0; m < 4; ++m) { bf16_t* rowp = T + (size_t)(row0 + ai * 128 + m * 16) * D + col0;
#pragma unroll
                for (int bj = 0; bj < 2; ++bj) { const f32x4 v0 = acc[ai][bj][m][0], v1 = acc[ai][bj][m][1];
                    u32x4 w; w.x = cvt_pk_bf16(v0[0], v0[1]); w.y = cvt_pk_bf16(v0[2], v0[3]); w.z = cvt_pk_bf16(v1[0], v1[1]); w.w = cvt_pk_bf16(v1[2], v1[3]);
                    *(u32x4*)(rowp + bj * 128) = w; } }
    }
};
struct EpiBranch {
    static constexpr bool PERM = true, CHAIN = false, SIDE = false, KHOOK = true; static constexpr int HOOK_T0 = 4, HOOK_T1 = 12;
    const bf16_t* Z; bf16_t* Y;
    template <bool FIN> __device__ __forceinline__ void apply(f32x4 (&acc)[2][2][4][2], const Unit& u, int br, int wr, int wc, int fr, int fq) const {
        int row0 = u.pm * 256 + wr * 64 + fr, col0 = u.pn * 256 + wc * 32 + 8 * fq;
        asm volatile("" : "+v"(row0), "+v"(col0));
#pragma unroll
        for (int ai = 0; ai < 2; ++ai) {
            u32x2 ga[4][2], gb[4][2];
#pragma unroll
            for (int m = 0; m < 4; ++m) { const unsigned char* rowp = (const unsigned char*)(Z + (size_t)(row0 + ai * 128 + m * 16) * NZ + ZG_COL) + br * 1024 + col0;
#pragma unroll
                for (int bj = 0; bj < 2; ++bj) { ga[m][bj] = *(const u32x2*)(rowp + bj * 128); if (!FIN) gb[m][bj] = *(const u32x2*)(rowp + 1024 + bj * 128); } }
#pragma unroll
            for (int m = 0; m < 4; ++m) { const size_t row = (size_t)(row0 + ai * 128 + m * 16);
#pragma unroll
                for (int bj = 0; bj < 2; ++bj) { const u32x2 a = ga[m][bj];
                    f32x4 r0 = u8x4_f32(a.x), r1 = u8x4_f32(a.y);
                    if (FIN) { r0 = r0 * (1.0f / G8_SCALE); r1 = r1 * (1.0f / G8_SCALE); }
                    else { const u32x2 b = gb[m][bj]; f32x4 q0 = u8x4_f32(b.x), q1 = u8x4_f32(b.y);
#pragma unroll
                        for (int i = 0; i < 4; ++i) { q0[i] = __builtin_amdgcn_rcpf(q0[i]); q1[i] = __builtin_amdgcn_rcpf(q1[i]); }
                        r0 = r0 * q0; r1 = r1 * q1; }
                    acc[ai][bj][m][0] = acc[ai][bj][m][0] * r0; acc[ai][bj][m][1] = acc[ai][bj][m][1] * r1;
                    if (FIN) { const f32x4 v0 = acc[ai][bj][m][0], v1 = acc[ai][bj][m][1];
                        u32x4 w; w.x = cvt_pk_bf16(v0[0], v0[1]); w.y = cvt_pk_bf16(v0[2], v0[3]); w.z = cvt_pk_bf16(v1[0], v1[1]); w.w = cvt_pk_bf16(v1[2], v1[3]);
                        *(u32x4*)(Y + row * D + col0 + bj * 128) = w; } } }
            asm volatile("" ::: "memory"); }
    }
    __device__ __forceinline__ void hook(f32x4 (&acc)[2][2][4][2], const Unit& u, int br, int wr, int wc, int fr, int fq) const { apply<false>(acc, u, br, wr, wc, fr, fq); }
    __device__ __forceinline__ void operator()(f32x4 (&acc)[2][2][4][2], const Unit& u, int wr, int wc, int fr, int fq, const LAS unsigned char*) const { apply<true>(acc, u, 2, wr, wc, fr, fq); }
};
struct EpiSwiglu {
    static constexpr bool PERM = true, CHAIN = false, SIDE = true, KHOOK = false; unsigned char* HID; const float* bgu; const LAS int* seg;
    __device__ __forceinline__ void side(const Unit& u, unsigned slot, int wid, int lane) const {
        if (wid == 1) { const int e = expert_of(seg, u.pm); pg8::dma16(lane < 32 ? (unsigned)lane * 16u : 4096u + (unsigned)(lane - 32) * 16u, bgu + (size_t)e * 2048 + u.pn * 128, slot); } }
    __device__ __forceinline__ void operator()(const f32x4 (&acc)[2][2][4][2], const Unit& u, int wr, int wc, int fr, int fq, const LAS unsigned char* sd) const {
        int j0 = u.pn * 128 + wc * 32 + 8 * fq, slot0 = u.pm * 256 + wr * 64 + fr; asm volatile("" : "+v"(j0), "+v"(slot0));
        f32x4 bg[2], bu[2];
#pragma unroll
        for (int n = 0; n < 2; ++n) { bg[n] = *(const LAS f32x4*)(sd + (wc * 32 + 8 * fq + 4 * n) * 4); bu[n] = *(const LAS f32x4*)(sd + (128 + wc * 32 + 8 * fq + 4 * n) * 4); }
#pragma unroll
        for (int ai = 0; ai < 2; ++ai)
#pragma unroll
            for (int m = 0; m < 4; ++m) { const size_t slot = (size_t)(slot0 + ai * 128 + m * 16); f32x4 o[2];
#pragma unroll
                for (int n = 0; n < 2; ++n) { f32x4 g = acc[ai][0][m][n] + bg[n], up = acc[ai][1][m][n] + bu[n];
#pragma unroll
                    for (int i = 0; i < 4; ++i) { g[i] = fminf(g[i], 7.0f); up[i] = __builtin_amdgcn_fmed3f(up[i], -7.0f, 7.0f); }
                    f32x4 t = g * (-1.702f * 1.4426950408889634f);
#pragma unroll
                    for (int i = 0; i < 4; ++i) t[i] = __builtin_amdgcn_exp2f(t[i]);
                    t = t + 1.0f;
#pragma unroll
                    for (int i = 0; i < 4; ++i) t[i] = __builtin_amdgcn_rcpf(t[i]);
                    o[n] = (up * F8S_ACT + F8S_ACT) * (g * t); }
                u32x2 w; w.x = pk4_fp8(o[0][0], o[0][1], o[0][2], o[0][3]); w.y = pk4_fp8(o[1][0], o[1][1], o[1][2], o[1][3]);
                *(u32x2*)(HID + slot * 1024 + j0) = w; }
    }
};
struct EpiDown {
    static constexpr bool PERM = true, CHAIN = false, SIDE = true, KHOOK = false; unsigned char* FS; const float* bdn; const int* dest; const float* pslot; const LAS int* seg;
    __device__ __forceinline__ void side(const Unit& u, unsigned slot, int wid, int lane) const {
        if (wid == 1) { const int e = expert_of(seg, u.pm); pg8::dma16((unsigned)lane * 16u, bdn + (size_t)e * 1024 + u.pn * 256, slot); }
        if (wid == 2) pg8::dma16((unsigned)lane * 16u, dest + (size_t)u.pm * 256, slot + 1024u);
        if (wid == 3) pg8::dma16((unsigned)lane * 16u, pslot + (size_t)u.pm * 256, slot + 2048u); }
    __device__ __forceinline__ void operator()(const f32x4 (&acc)[2][2][4][2], const Unit& u, int wr, int wc, int fr, int fq, const LAS unsigned char* sd) const {
        int col0 = u.pn * 256 + wc * 32 + 8 * fq, slot0 = u.pm * 256 + wr * 64 + fr; asm volatile("" : "+v"(col0), "+v"(slot0));
        f32x4 bv[2][2];
#pragma unroll
        for (int bj = 0; bj < 2; ++bj)
#pragma unroll
            for (int n = 0; n < 2; ++n) bv[bj][n] = *(const LAS f32x4*)(sd + (bj * 128 + wc * 32 + 8 * fq + 4 * n) * 4);
#pragma unroll
        for (int ai = 0; ai < 2; ++ai)
#pragma unroll
            for (int m = 0; m < 4; ++m) { const int rt = ai * 128 + wr * 64 + m * 16 + fr; const int d = *(const LAS int*)(sd + 1024 + rt * 4); const float p = *(const LAS float*)(sd + 2048 + rt * 4) * FS_SCALE;
                if (d >= 0) {
#pragma unroll
                    for (int bj = 0; bj < 2; ++bj) { f32x4 v0 = (acc[ai][bj][m][0] + bv[bj][0]) * p, v1 = (acc[ai][bj][m][1] + bv[bj][1]) * p;
#pragma unroll
                        for (int i = 0; i < 4; ++i) { v0[i] = __builtin_amdgcn_fmed3f(v0[i], -FS_CLAMP, FS_CLAMP); v1[i] = __builtin_amdgcn_fmed3f(v1[i], -FS_CLAMP, FS_CLAMP); }
                        u32x2 w; w.x = pk4_fp8(v0[0], v0[1], v0[2], v0[3]); w.y = pk4_fp8(v1[0], v1[1], v1[2], v1[3]);
                        *(u32x2*)(FS + (size_t)d * 1024 + col0 + bj * 128) = w; } }
                asm volatile("" ::: "memory"); }
    }
};

__device__ __forceinline__ const float* xin_row(const Frame& F, int row) { return row < ML ? F.in[IN_X] + (size_t)row * D : F.in[IN_CTX] + (size_t)(row - ML) * D; }
__device__ __forceinline__ void phase_ln0_first(Frame& F) {
    int t_lo, t_hi; tile_range(F, MT, t_lo, t_hi);
    const int r_lo = 32 * t_lo, nrows = 32 * (t_hi - t_lo);
    const int mrA = mod_row(r_lo), mrB = mod_row(r_lo + (nrows > 0 ? nrows - 1 : 0));
    { const float* mb = (const float*)(F.ws + WS_MOD); pv_fill(F, 0, mb + ((size_t)(0 * 17 + mrA) * 6 + 0) * 1024); pv_fill(F, 1, mb + ((size_t)(0 * 17 + mrB) * 6 + 0) * 1024);
      pv_fill(F, 2, mb + ((size_t)(0 * 17 + mrA) * 6 + 1) * 1024); pv_fill(F, 3, mb + ((size_t)(0 * 17 + mrB) * 6 + 1) * 1024); }
    load_wg_lds(F, 0);
    for (int n = F.wave; n < nrows; n += 4 * NWAVES) {
        RowV rv[4];
#pragma unroll
        for (int u = 0; u < 4; ++u) if (n + u * NWAVES < nrows) row_load(rv[u], xin_row(F, r_lo + n + u * NWAVES), F.lane);
#pragma unroll
        for (int u = 0; u < 4; ++u) if (n + u * NWAVES < nrows) { const int row = r_lo + n + u * NWAVES;
            const int sel = (mod_row(row) == mrA) ? 0 : 1; ln0_row(F, row, rv[u], pv_slot(F, 0 + sel), pv_slot(F, 2 + sel)); }
    }
    gates_tail(F, 0, t_lo, t_hi);
    __syncthreads();
}
__device__ __forceinline__ void phase_finalize(Frame& F, int l, int mrows) {
    const int gw = F.bid * NWAVES + F.wave, NGW = F.G * NWAVES;
    const bf16_t* hf = (const bf16_t*)(F.ws + WS_HFB); const bf16_t* hb = hf + (size_t)MT * 512;
    const float* ng = F.in[IN_MNG] + l * 512 + 8 * F.lane;
    const f32x4 g0 = *(const f32x4*)ng, g1 = *(const f32x4*)(ng + 4);
    for (int row = gw; row < mrows; row += NGW) {
        const u32x4 ha = __builtin_nontemporal_load((const u32x4*)(hf + (size_t)row * 512 + 8 * F.lane)), hbv = __builtin_nontemporal_load((const u32x4*)(hb + (size_t)row * 512 + 8 * F.lane));
        f32x4 v0 = (f32x4){bflo(ha.x) + bflo(hbv.x), bfhi(ha.x) + bfhi(hbv.x), bflo(ha.y) + bflo(hbv.y), bfhi(ha.y) + bfhi(hbv.y)}, v1 = (f32x4){bflo(ha.z) + bflo(hbv.z), bfhi(ha.z) + bfhi(hbv.z), bflo(ha.w) + bflo(hbv.w), bfhi(ha.w) + bfhi(hbv.w)};
        float s = (v0.x + v0.y) + (v0.z + v0.w) + (v1.x + v1.y) + (v1.z + v1.w);
#pragma unroll
        for (int o = 1; o < 16; o <<= 1) s += shx(s, o, F.lane);
        const float mu = s * (1.f / 128.f); v0 = v0 - mu; v1 = v1 - mu;
        float q = (v0.x * v0.x + v0.y * v0.y) + (v0.z * v0.z + v0.w * v0.w) + (v1.x * v1.x + v1.y * v1.y) + (v1.z * v1.z + v1.w * v1.w);
#pragma unroll
        for (int o = 1; o < 16; o <<= 1) q += shx(q, o, F.lane);
        const float rstd = 1.f / sqrtf(q * (1.f / 128.f) + HEAD_EPS);
        const u32x4 so = __builtin_nontemporal_load((const u32x4*)((const bf16_t*)(F.ws + WS_Z) + (size_t)row * NZ + ZC_O + 8 * F.lane));
        v0 = v0 * rstd * g0; v1 = v1 * rstd * g1;
        u32x4 w; w.x = pk2(v0.x * bflo(so.x), v0.y * bfhi(so.x)); w.y = pk2(v0.z * bflo(so.y), v0.w * bfhi(so.y)); w.z = pk2(v1.x * bflo(so.z), v1.y * bfhi(so.z)); w.w = pk2(v1.z * bflo(so.w), v1.w * bfhi(so.w));
        *(u32x4*)((bf16_t*)(F.ws + WS_BRA) + (size_t)row * D + 256 + 8 * F.lane) = w;
    }
}
__device__ __forceinline__ void phase_ln1_router(Frame& F, int l, int mrows) {
    LAS int* cnt = (LAS int*)(F.lds + NW_END);
    { const float* wr = F.in[IN_WR] + (size_t)l * D * NEXP;
      for (int i = F.tid; i < NEXP * D; i += NTHREADS) { const int k = i >> 5, e = i & 31; *(LAS bf16_t*)(F.lds + NW_WT + e * 2064 + k * 2) = (bf16_t)f2bf(wr[i]); }
      if (F.tid < NEXP) cnt[F.tid] = 0; }
    const float* brt = F.in[IN_BR] + l * NEXP;
    int t_lo, t_hi; tile_range(F, mrows, t_lo, t_hi);
    const int r_lo = 32 * t_lo, nrows = 32 * (t_hi - t_lo);
    const int mrA = mod_row(r_lo), mrB = mod_row(r_lo + (nrows > 0 ? nrows - 1 : 0));
    { const float* mb = (const float*)(F.ws + WS_MOD); pv_fill(F, 0, F.in[IN_LN1G] + l * D); pv_fill(F, 1, F.in[IN_LN1B] + l * D);
      pv_fill(F, 2, mb + ((size_t)(l * 17 + mrA) * 6 + 2) * 1024); pv_fill(F, 3, mb + ((size_t)(l * 17 + mrB) * 6 + 2) * 1024);
      pv_fill(F, 4, mb + ((size_t)(l * 17 + mrA) * 6 + 3) * 1024); pv_fill(F, 5, mb + ((size_t)(l * 17 + mrB) * 6 + 3) * 1024);
      pv_fill(F, 6, mb + ((size_t)(l * 17 + mrA) * 6 + 4) * 1024); pv_fill(F, 7, mb + ((size_t)(l * 17 + mrB) * 6 + 4) * 1024); }
    __syncthreads();
    { const bf16_t* yb = (const bf16_t*)(F.ws + WS_T) + 8 * F.lane;
      RowV rv[2]; u32x4 yv2[2][2];
#pragma unroll
      for (int u = 0; u < 2; ++u) {
#pragma unroll
          for (int j = 0; j < 4; ++j) rv[u].v[j] = (f32x4){0.f, 0.f, 0.f, 0.f};
          yv2[u][0] = yv2[u][1] = (u32x4){0u, 0u, 0u, 0u}; }
#define RT_LOADPAIR(n_, rv_, yv_) do { _Pragma("unroll") for (int u = 0; u < 2; ++u) if ((n_) + u * NWAVES < nrows) { const int row = r_lo + (n_) + u * NWAVES; \
              if (l == 0) row_load(rv_[u], xin_row(F, row), F.lane); else row_load_bf16(rv_[u], (const bf16_t*)(F.ws + WS_X) + (size_t)row * D, F.lane); \
              _Pragma("unroll") for (int h = 0; h < 2; ++h) yv_[u][h] = __builtin_nontemporal_load((const u32x4*)(yb + (size_t)row * D + 512 * h)); } } while (0)
      RT_LOADPAIR(F.wave, rv, yv2);
      for (int n = F.wave; n < nrows; n += 2 * NWAVES) {
          RowV rvn[2]; u32x4 yvn[2][2];
#pragma unroll
          for (int u = 0; u < 2; ++u) { rvn[u] = rv[u]; yvn[u][0] = yv2[u][0]; yvn[u][1] = yv2[u][1]; }
          RT_LOADPAIR(n + 2 * NWAVES, rvn, yvn);
          __builtin_amdgcn_sched_barrier(0);
#pragma unroll
          for (int u = 0; u < 2; ++u) if (n + u * NWAVES < nrows) { const int row = r_lo + n + u * NWAVES; RowV cur = rv[u];
              const int sel = (mod_row(row) == mrA) ? 0 : 1;
              { const LAS float* g1 = pv_slot(F, 2 + sel);
#pragma unroll
                for (int j = 0; j < 4; ++j) { const f32x4 gg = *(const LAS f32x4*)(g1 + RC(F.lane, j)); const u32x4 yw = yv2[u][j >> 1]; const f32x4 yv = (j & 1) ? (f32x4){bflo(yw.z), bfhi(yw.z), bflo(yw.w), bfhi(yw.w)} : (f32x4){bflo(yw.x), bfhi(yw.x), bflo(yw.y), bfhi(yw.y)}; cur.v[j] = cur.v[j] * DN_ALPHA + gg * yv; } }
              row_ln_plain(cur, F.lane); row_affine_l(cur, pv_slot(F, 0), pv_slot(F, 1), F.lane);
              row_store_bf16_nt(cur, (bf16_t*)(F.ws + WS_X) + (size_t)row * D, F.lane);
              row_ln_plain(cur, F.lane); row_modulate_l(cur, pv_slot(F, 4 + sel), pv_slot(F, 6 + sel), F.lane);
              row_store_bf16(cur, (bf16_t*)(F.ws + WS_H2) + (size_t)row * D, F.lane);
              { unsigned char* h8 = (unsigned char*)(F.ws + WS_H2F8) + (size_t)row * D + 8 * F.lane;
#pragma unroll
                for (int h = 0; h < 2; ++h) { u32x2 w; w.x = pk4_fp8(cur.v[2 * h].x * F8S_ACT, cur.v[2 * h].y * F8S_ACT, cur.v[2 * h].z * F8S_ACT, cur.v[2 * h].w * F8S_ACT); w.y = pk4_fp8(cur.v[2 * h + 1].x * F8S_ACT, cur.v[2 * h + 1].y * F8S_ACT, cur.v[2 * h + 1].z * F8S_ACT, cur.v[2 * h + 1].w * F8S_ACT); *(u32x2*)(h8 + 512 * h) = w; } } }
#pragma unroll
          for (int u = 0; u < 2; ++u) { rv[u] = rvn[u]; yv2[u][0] = yvn[u][0]; yv2[u][1] = yvn[u][1]; }
      }
#undef RT_LOADPAIR
    }
    asm volatile("s_waitcnt vmcnt(0)" ::: "memory"); __syncthreads();
    for (int tile = t_lo + F.wave; tile < t_hi; tile += NWAVES) {
        const LAS float* lgw = narrow_tile_wave(F, (const bf16_t*)(F.ws + WS_H2) + (size_t)tile * 32 * D);
        if (F.lane < 32) {
            const LAS float* lgp = lgw + F.lane * 33; const int row = tile * 32 + F.lane;
            float lg[NEXP];
#pragma unroll
            for (int e = 0; e < NEXP; ++e) lg[e] = lgp[e] + brt[e];
            unsigned used = 0u; float bv[4]; int bi[4];
#pragma unroll
            for (int k = 0; k < 4; ++k) { float best = -3.0e38f; int idx = 0;
#pragma unroll
                for (int e = 0; e < NEXP; ++e) { const bool take = (((used >> e) & 1u) == 0u) && (lg[e] > best); best = take ? lg[e] : best; idx = take ? e : idx; }
                used |= 1u << idx; bv[k] = best; bi[k] = idx; }
            const float e1 = __expf(bv[1] - bv[0]), e2 = __expf(bv[2] - bv[0]), e3 = __expf(bv[3] - bv[0]); const float inv = __builtin_amdgcn_rcpf(1.0f + e1 + e2 + e3);
            int* ei = (int*)(F.ws + WS_ROUTE + RT_EIDX) + (size_t)row * 4; float* pr = (float*)(F.ws + WS_ROUTE + RT_PROB) + (size_t)row * 4;
            *(int4*)ei = make_int4(bi[0], bi[1], bi[2], bi[3]); *(f32x4*)pr = (f32x4){inv, e1 * inv, e2 * inv, e3 * inv};
            atomicAdd((int*)&cnt[bi[0]], 1); atomicAdd((int*)&cnt[bi[1]], 1); atomicAdd((int*)&cnt[bi[2]], 1); atomicAdd((int*)&cnt[bi[3]], 1);
        }
        asm volatile("s_waitcnt lgkmcnt(0)" ::: "memory");
    }
    __syncthreads();
    if (F.tid < NEXP) ((int*)(F.ws + WS_ROUTE + RT_CNT))[F.bid * NEXP + F.tid] = cnt[F.tid];
    __syncthreads();
}
__device__ __forceinline__ void phase_slots(Frame& F, int mrows) {
    LAS int* part = (LAS int*)F.lds;
    LAS int* pre = part + 1024;
    LAS int* tot = pre + 32;
    LAS int* seg = tot + 32;
    LAS int* gcnt = seg + 64;
    LAS int* eix = gcnt + 2048;
    LAS int* rnk = eix + 4096;
    const int* cntg = (const int*)(F.ws + WS_ROUTE + RT_CNT);
    int* tokg = (int*)(F.ws + WS_ROUTE + RT_TOK); int* destg = (int*)(F.ws + WS_ROUTE + RT_DEST); float* psl = (float*)(F.ws + WS_ROUTE + RT_PSLOT);
    int t_lo, t_hi; tile_range(F, mrows, t_lo, t_hi);
    const int row_base = t_lo * 32, nent = (t_hi - t_lo) * 128, ngrp = nent / 64;
    { const int e = F.tid & 31, pt = F.tid >> 5; int a = 0, b = 0;
      for (int c = pt; c < F.G; c += 16) { const int v = cntg[c * NEXP + e]; b += v; a += (c < F.bid) ? v : 0; }
      part[pt * 32 + e] = a; part[512 + pt * 32 + e] = b; }
    for (int i = F.tid; i < nent; i += NTHREADS) eix[i] = ((const int*)(F.ws + WS_ROUTE + RT_EIDX))[(size_t)row_base * 4 + i];
    __syncthreads();
    if (F.tid < NEXP) { int a = 0, b = 0;
#pragma unroll
        for (int pt = 0; pt < 16; ++pt) { a += part[pt * 32 + F.tid]; b += part[512 + pt * 32 + F.tid]; }
        pre[F.tid] = a; tot[F.tid] = b; }
    for (int g = F.wave; g < ngrp; g += NWAVES) {
        const int e = eix[g * 64 + F.lane]; int rank = 0, mycnt = 0;
#pragma unroll 4
        for (int ee = 0; ee < NEXP; ++ee) { const unsigned long long m = __ballot(e == ee); if (e == ee) rank = __popcll(m & ((1ull << F.lane) - 1ull)); if (F.lane == ee) mycnt = __popcll(m); }
        rnk[g * 64 + F.lane] = rank; if (F.lane < NEXP) gcnt[g * 32 + F.lane] = mycnt; }
    __syncthreads();
    if (F.tid == 0) { int s = 0; for (int e = 0; e < NEXP; ++e) { seg[e] = s; s += (tot[e] + 255) & ~255; } seg[NEXP] = s; }
    if (F.tid >= 64 && F.tid < 64 + NEXP) { const int e = F.tid - 64; int run = 0; for (int g = 0; g < ngrp; ++g) { const int c = gcnt[g * 32 + e]; gcnt[g * 32 + e] = run; run += c; } }
    __syncthreads();
    { const float* prg = (const float*)(F.ws + WS_ROUTE + RT_PROB) + (size_t)row_base * 4;
      for (int i = F.tid; i < nent; i += NTHREADS) { const int e = eix[i]; const int slot = seg[e] + pre[e] + gcnt[(i >> 6) * 32 + e] + rnk[i];
          tokg[slot] = row_base + (i >> 2); destg[slot] = row_base * 4 + i; psl[slot] = prg[i]; } }
    if (F.bid < NEXP) { const int e = F.bid; for (int sl = seg[e] + tot[e] + F.tid; sl < seg[e + 1]; sl += NTHREADS) { tokg[sl] = 0; destg[sl] = -1; psl[sl] = 0.f; } }
    if (F.bid == 0 && F.tid <= NEXP) ((int*)(F.ws + WS_ROUTE + RT_SEG))[F.tid] = seg[F.tid];
    __syncthreads();
}
struct CombRaw { u32x4 x[2]; u32x2 f[2][4]; };
__device__ __forceinline__ void comb_load(const Frame& F, int row, CombRaw& r) {
    { const bf16_t* xp = (const bf16_t*)(F.ws + WS_X) + (size_t)row * D + 8 * F.lane;
#pragma unroll
      for (int h = 0; h < 2; ++h) r.x[h] = __builtin_nontemporal_load((const u32x4*)(xp + 512 * h)); }
    const unsigned char* fs = (const unsigned char*)(F.ws + WS_FS) + (size_t)row * 4 * 1024 + 8 * F.lane;
#pragma unroll
    for (int h = 0; h < 2; ++h)
#pragma unroll
        for (int k = 0; k < 4; ++k) r.f[h][k] = __builtin_nontemporal_load((const u32x2*)(fs + k * 1024 + 512 * h));
}
__device__ __forceinline__ void phase_combine_ln2(Frame& F, int l, int mrows) {
    const bool lastl = (l == DEPTH - 1);
    int t_lo, t_hi; tile_range(F, mrows, t_lo, t_hi);
    const int r_lo = 32 * t_lo, nrows = 32 * (t_hi - t_lo);
    const int mrA = mod_row(r_lo), mrB = mod_row(r_lo + (nrows > 0 ? nrows - 1 : 0));
    { const float* mb = (const float*)(F.ws + WS_MOD); const int ln = lastl ? l : l + 1; pv_fill(F, 0, F.in[IN_LN2G] + l * D); pv_fill(F, 1, F.in[IN_LN2B] + l * D);
      pv_fill(F, 2, mb + ((size_t)(l * 17 + mrA) * 6 + 5) * 1024); pv_fill(F, 3, mb + ((size_t)(l * 17 + mrB) * 6 + 5) * 1024);
      pv_fill(F, 4, mb + ((size_t)(ln * 17 + mrA) * 6 + 0) * 1024); pv_fill(F, 5, mb + ((size_t)(ln * 17 + mrB) * 6 + 0) * 1024);
      pv_fill(F, 6, mb + ((size_t)(ln * 17 + mrA) * 6 + 1) * 1024); pv_fill(F, 7, mb + ((size_t)(ln * 17 + mrB) * 6 + 1) * 1024); }
    if (!lastl) load_wg_lds(F, l + 1); else __syncthreads();
    for (int n = F.wave; n < nrows; n += 2 * NWAVES) {
        CombRaw rw[2];
#pragma unroll
        for (int u = 0; u < 2; ++u) if (n + u * NWAVES < nrows) comb_load(F, r_lo + n + u * NWAVES, rw[u]);
#pragma unroll
        for (int u = 0; u < 2; ++u) if (n + u * NWAVES < nrows) { const int row = r_lo + n + u * NWAVES;
            const int sel = (mod_row(row) == mrA) ? 0 : 1;
            const LAS float* g2 = pv_slot(F, 2 + sel);
            RowV x;
#pragma unroll
            for (int h = 0; h < 2; ++h) { const u32x4 w = rw[u].x[h]; x.v[2 * h] = (f32x4){bflo(w.x), bfhi(w.x), bflo(w.y), bfhi(w.y)}; x.v[2 * h + 1] = (f32x4){bflo(w.z), bfhi(w.z), bflo(w.w), bfhi(w.w)}; }
#pragma unroll
            for (int j = 0; j < 4; ++j) { f32x4 f = (f32x4){0.f, 0.f, 0.f, 0.f};
#pragma unroll
                for (int k = 0; k < 4; ++k) { const u32x2 w2 = rw[u].f[j >> 1][k]; const int wd = (int)((j & 1) ? w2.y : w2.x);
                    const f32x2 lo = __builtin_amdgcn_cvt_pk_f32_fp8(wd, false), hi = __builtin_amdgcn_cvt_pk_f32_fp8(wd, true); f[0] += lo[0]; f[1] += lo[1]; f[2] += hi[0]; f[3] += hi[1]; }
                const f32x4 gg = *(const LAS f32x4*)(g2 + RC(F.lane, j)) * (1.0f / FS_SCALE);
                x.v[j] = x.v[j] * DN_ALPHA + gg * f; }
            row_ln_plain(x, F.lane); row_affine_l(x, pv_slot(F, 0), pv_slot(F, 1), F.lane);
            if (lastl) { row_store_nt(x, F.out + (size_t)row * D, F.lane); }
            else { row_store_bf16_nt(x, (bf16_t*)(F.ws + WS_X) + (size_t)row * D, F.lane); ln0_row(F, row, x, pv_slot(F, 4 + sel), pv_slot(F, 6 + sel)); } }
    }
    if (!lastl) gates_tail(F, l + 1, t_lo, t_hi);
    __syncthreads();
}

#define MFMA32(a, b, c) __builtin_amdgcn_mfma_f32_32x32x16_bf16((a), (b), (c), 0, 0, 0)
#define MFMA16(a, b, c) __builtin_amdgcn_mfma_f32_16x16x32_bf16((a), (b), (c), 0, 0, 0)
__device__ __forceinline__ f32x16 zero16() { f32x16 z;
#pragma unroll
    for (int i = 0; i < 16; ++i) z[i] = 0.f;
    return z; }
__device__ __forceinline__ void pool_tiles(Frame& F, int l, bool with_ctx) {
    LAS unsigned char* Pin = F.lds;
    LAS unsigned char* Dm = F.lds + 40960;
    const bf16_t* Z = (const bf16_t*)(F.ws + WS_Z);
    const bf16_t* Wp = (const bf16_t*)(F.ws + WS_WPOOL) + (size_t)l * 4 * 4096;
    const float* psc = F.in[IN_POOLS] + l * 256;
    bf16_t* BRA = (bf16_t*)(F.ws + WS_BRA);
    const int ntiles = with_ctx ? 1088 : 1024;
    const int r = F.lane & 31, h = F.lane >> 5;
    for (int tile = F.bid; tile < ntiles; tile += F.G) {
        int row0, seq_lo, seq_hi;
        if (tile < 1024) { row0 = tile * 64; seq_lo = row0; seq_hi = row0 + 64; }
        else { const int ct = tile - 1024; seq_lo = ML + (ct >> 2) * 256; seq_hi = seq_lo + 256; row0 = seq_lo + (ct & 3) * 64; }
        for (int idx = F.tid; idx < 80 * 32; idx += NTHREADS) { const int rr = idx >> 5, ck = idx & 31, grow = row0 - 8 + rr;
            if (grow >= seq_lo && grow < seq_hi) *(LAS u32x4*)(Pin + rr * 512 + ck * 16) = __builtin_nontemporal_load((const u32x4*)(Z + (size_t)grow * NZ + ZC_P + ck * 8)); }
        __syncthreads();
        for (int idx = F.tid; idx < 64 * 32; idx += NTHREADS) { const int tok = idx >> 5, ck = idx & 31, g = ck >> 3, hw = 1 << g, t = row0 + tok;
            const int lo = max(t - hw, seq_lo), hi = min(t + hw, seq_hi);
            float s[8];
#pragma unroll
            for (int e = 0; e < 8; ++e) s[e] = 0.f;
            for (int rw = lo; rw < hi; ++rw) { const u32x4 v = *(const LAS u32x4*)(Pin + (rw - row0 + 8) * 512 + ck * 16);
                s[0] += bflo(v.x); s[1] += bfhi(v.x); s[2] += bflo(v.y); s[3] += bfhi(v.y); s[4] += bflo(v.z); s[5] += bfhi(v.z); s[6] += bflo(v.w); s[7] += bfhi(v.w); }
            const float inv = 1.0f / (float)(hi - lo);
            const u32x4 o = *(const LAS u32x4*)(Pin + (tok + 8) * 512 + ck * 16);
            u32x4 w; w.x = pk2(s[0] * inv - bflo(o.x), s[1] * inv - bfhi(o.x)); w.y = pk2(s[2] * inv - bflo(o.y), s[3] * inv - bfhi(o.y));
            w.z = pk2(s[4] * inv - bflo(o.z), s[5] * inv - bfhi(o.z)); w.w = pk2(s[6] * inv - bflo(o.w), s[7] * inv - bfhi(o.w));
            *(LAS u32x4*)(Dm + tok * 528 + ck * 16) = w; }
        __syncthreads();
#pragma unroll 1
        for (int qi = 0; qi < 2; ++qi) { const int q = F.wave + 8 * qi, g = q >> 2, td = (q >> 1) & 1, tt = q & 1;
            f32x16 acc = zero16();
#pragma unroll
            for (int ks = 0; ks < 4; ++ks) { const bf16x8 a = *(const bf16x8*)(Wp + ((size_t)g * 64 + td * 32 + r) * 64 + ks * 16 + 8 * h);
                const bf16x8 b = *(const LAS bf16x8*)(Dm + (tt * 32 + r) * 528 + (g * 64 + ks * 16 + 8 * h) * 2);
                acc = MFMA32(a, b, acc); }
            const size_t orow = (size_t)(row0 + tt * 32 + r);
#pragma unroll
            for (int qq = 0; qq < 4; ++qq) { const int dcol = g * 64 + td * 32 + 8 * qq + 4 * h; const f32x4 sc = *(const f32x4*)(psc + dcol);
                u32x2 w; w.x = pk2(acc[4 * qq] * sc.x, acc[4 * qq + 1] * sc.y); w.y = pk2(acc[4 * qq + 2] * sc.z, acc[4 * qq + 3] * sc.w);
                *(u32x2*)(BRA + orow * D + dcol) = w; } }
        __syncthreads();
    }
}
__device__ __forceinline__ void sgu_chunks(Frame& F, int l, bool with_ctx) {
    LAS unsigned char* Vt = F.lds;
    const bf16_t* Z = (const bf16_t*)(F.ws + WS_Z);
    const bf16_t* Ws = (const bf16_t*)(F.ws + WS_WSGU) + (size_t)l * 4 * 16384;
    const float* lng = F.in[IN_SLNG] + l * 256; const float* lnb = F.in[IN_SLNB] + l * 256; const float* sb = F.in[IN_SGUB] + l * 512;
    bf16_t* BRA = (bf16_t*)(F.ws + WS_BRA);
    const int nchunks = with_ctx ? 544 : 512;
    const int r = F.lane & 31, h = F.lane >> 5;
    for (int ch = F.bid; ch < nchunks; ch += F.G) {
        const int row0 = ch * 128;
        { const int s = F.tid >> 2, q = F.tid & 3; const bf16_t* zp = Z + (size_t)(row0 + s) * NZ + ZC_UV + 256 + q * 64;
          float v[64]; float sum = 0.f;
#pragma unroll
          for (int i = 0; i < 8; ++i) { const u32x4 w = __builtin_nontemporal_load((const u32x4*)(zp + 8 * i));
              v[8 * i] = bflo(w.x); v[8 * i + 1] = bfhi(w.x); v[8 * i + 2] = bflo(w.y); v[8 * i + 3] = bfhi(w.y); v[8 * i + 4] = bflo(w.z); v[8 * i + 5] = bfhi(w.z); v[8 * i + 6] = bflo(w.w); v[8 * i + 7] = bfhi(w.w); }
#pragma unroll
          for (int i = 0; i < 64; ++i) sum += v[i];
          sum += shx(sum, 1, F.lane); sum += shx(sum, 2, F.lane);
          const float mean = sum * (1.f / 256.f); float sq = 0.f;
#pragma unroll
          for (int i = 0; i < 64; ++i) { v[i] -= mean; sq += v[i] * v[i]; }
          sq += shx(sq, 1, F.lane); sq += shx(sq, 2, F.lane);
          const float rstd = 1.f / sqrtf(sq * (1.f / 256.f) + LN_EPS);
#pragma unroll
          for (int i = 0; i < 64; ++i) { const int c = q * 64 + i; const float y = v[i] * rstd * lng[c] + lnb[c]; *(LAS bf16_t*)(Vt + c * 272 + s * 2) = (bf16_t)f2bf(y); } }
        __syncthreads();
        const int tc = F.wave & 1, tt = F.wave >> 1, t = tt * 32 + r;
#pragma unroll 1
        for (int g = 0; g < 4; ++g) {
            f32x16 acc = zero16();
#pragma unroll
            for (int ks = 0; ks < 8; ++ks) { const bf16x8 a = *(const LAS bf16x8*)(Vt + (g * 64 + tc * 32 + r) * 272 + (ks * 16 + 8 * h) * 2);
                const bf16x8 b = *(const bf16x8*)(Ws + ((size_t)g * 128 + t) * 128 + ks * 16 + 8 * h);
                acc = MFMA32(a, b, acc); }
            const float bias = sb[g * 128 + t];
#pragma unroll
            for (int qq = 0; qq < 4; ++qq) { const int c0 = g * 64 + tc * 32 + 8 * qq + 4 * h;
                const u32x2 u = *(const u32x2*)(Z + (size_t)(row0 + t) * NZ + ZC_UV + c0);
                u32x2 w; w.x = pk2(bflo(u.x) * (acc[4 * qq] + bias), bfhi(u.x) * (acc[4 * qq + 1] + bias)); w.y = pk2(bflo(u.y) * (acc[4 * qq + 2] + bias), bfhi(u.y) * (acc[4 * qq + 3] + bias));
                *(u32x2*)(BRA + (size_t)(row0 + t) * D + 768 + c0) = w; } }
        __syncthreads();
    }
}
__device__ __forceinline__ void qk_conv_pass(Frame& F, int l) {
    const bf16_t* Z = (const bf16_t*)(F.ws + WS_Z); bf16_t* QKC = (bf16_t*)(F.ws + WS_H);
    const int chunk = F.tid & 127, rsub = F.tid >> 7, ch0 = chunk * 8;
    float w0[8], w1[8], w2[8], cbv[8];
    { const float* cw = F.in[IN_CONVW] + (size_t)l * 3 * 1024 + ch0; const float* cb = F.in[IN_CONVB] + (size_t)l * 1024 + ch0;
#pragma unroll
      for (int e = 0; e < 8; ++e) { w0[e] = cw[e]; w1[e] = cw[1024 + e]; w2[e] = cw[2048 + e]; cbv[e] = cb[e]; } }
    const float scale = chunk >= 64 ? 0.08838834764831845f : 1.0f;
    const int ns = F.G * 4, sidx = F.bid * 4 + rsub;
    const int r0 = (int)(((long)sidx * MT) / ns), r1 = (int)(((long)(sidx + 1) * MT) / ns);
    const bf16_t* zb = Z + ZC_QK + ch0;
    const u32x4 zero4 = (u32x4){0u, 0u, 0u, 0u};
    u32x4 xm = zero4, xc = zero4, xn = zero4;
    if (r0 < r1) { xc = *(const u32x4*)(zb + (size_t)r0 * NZ); if (r0 > 0) xm = *(const u32x4*)(zb + (size_t)(r0 - 1) * NZ); if (r0 + 1 < MT) xn = *(const u32x4*)(zb + (size_t)(r0 + 1) * NZ); }
    for (int row = r0; row < r1; ++row) {
        u32x4 xn2 = zero4; if (row + 2 < MT) xn2 = *(const u32x4*)(zb + (size_t)(row + 2) * NZ);
        const int p = row < ML ? (row & 4095) : ((row - ML) & 255), len = row < ML ? 4096 : 256;
        const u32x4 x0 = (p > 0) ? xm : zero4, x1 = xc, x2 = (p + 1 < len) ? xn : zero4;
        const unsigned xa[4] = {x0.x, x0.y, x0.z, x0.w}, xb[4] = {x1.x, x1.y, x1.z, x1.w}, xcc[4] = {x2.x, x2.y, x2.z, x2.w};
        float y[8];
#pragma unroll
        for (int e2 = 0; e2 < 4; ++e2) { y[2 * e2] = cbv[2 * e2] + w0[2 * e2] * bflo(xa[e2]) + w1[2 * e2] * bflo(xb[e2]) + w2[2 * e2] * bflo(xcc[e2]);
            y[2 * e2 + 1] = cbv[2 * e2 + 1] + w0[2 * e2 + 1] * bfhi(xa[e2]) + w1[2 * e2 + 1] * bfhi(xb[e2]) + w2[2 * e2 + 1] * bfhi(xcc[e2]); }
#pragma unroll
        for (int e = 0; e < 8; ++e) y[e] = siluf_(y[e]) * scale;
        u32x4 w; w.x = pk2(y[0], y[1]); w.y = pk2(y[2], y[3]); w.z = pk2(y[4], y[5]); w.w = pk2(y[6], y[7]);
        *(u32x4*)(QKC + (size_t)row * D + ch0) = w;
        xm = xc; xc = xn; xn = xn2;
    }
}
constexpr int ML_QS = 0, ML_KS = 34816, ML_KW = 69632, ML_VT = 104448, ML_CB = 126208, ML_SC = 147968, ML_SCSZ = 2624;
__device__ __forceinline__ float logsigf_(float x) { return fminf(x, 0.f) - __logf(1.0f + __expf(-fabsf(x))); }
__device__ __forceinline__ unsigned swap16(unsigned u) { return __builtin_amdgcn_alignbit(u, u, 16); }
struct MlPre { u32x4 qk[8]; u32x2 v[4]; float g[4]; };
__device__ __forceinline__ void ml_geom(int j, int b, int dir, int& seqbase, int& seqlen, int& pbase) {
    const bool is_ctx = j < 2; int cj = is_ctx ? j : j - 2; const int ncs = is_ctx ? 2 : 32; if (dir) cj = ncs - 1 - cj;
    seqbase = is_ctx ? ML + b * 256 : b * 4096; seqlen = is_ctx ? 256 : 4096; pbase = cj * 128; }
#define ML_BAR() do { asm volatile("s_waitcnt lgkmcnt(0)" ::: "memory"); __builtin_amdgcn_s_barrier(); asm volatile("" ::: "memory"); } while (0)
__device__ __forceinline__ void mlstm_unit(Frame& F, int l, int unit) {
    const int bh = (unit & 7) + 8 * (unit >> 5), sub = (unit >> 3) & 3;
    const int b = bh >> 2, head = bh & 3, dir = sub >> 1, vh = sub & 1;
    LAS unsigned char* QS = F.lds + ML_QS; LAS unsigned char* KS = F.lds + ML_KS; LAS unsigned char* KW = F.lds + ML_KW; LAS unsigned char* VT = F.lds + ML_VT; LAS unsigned char* CB = F.lds + ML_CB;
    const bf16_t* Z = (const bf16_t*)(F.ws + WS_Z); const float* ZG = (const float*)(F.ws + WS_ZG); const bf16_t* QKC = (const bf16_t*)(F.ws + WS_H);
    bf16_t* HF = (bf16_t*)(F.ws + WS_HFB) + (size_t)dir * MT * 512;
    const int wave = F.wave;
    int tl = F.tid;
#define ML_ROLES() const int lane = tl & 63, fr = lane & 15, q4 = lane >> 4; const int isk = (tl >> 4) & 1, ck = tl & 15, i0 = 8 * (tl >> 5), chn = (isk ? 512 : 0) + head * 128 + ck * 8; \
    const int vi0 = 4 * (tl >> 4), vcq = tl & 15, vch = head * 128 + vh * 64 + vcq * 4; (void)fr; (void)q4; (void)vi0; (void)vcq; (void)vch; (void)i0; (void)chn; (void)ck; (void)isk;
    for (int idx = F.tid; idx < 16 * 136; idx += NTHREADS) *(LAS bf16_t*)(VT + (64 + idx / 136) * 272 + (idx % 136) * 2) = (idx < 136) ? (bf16_t)0x3F80 : (bf16_t)0;
    f32x4 cs[5];
#pragma unroll
    for (int vt = 0; vt < 5; ++vt) cs[vt] = (f32x4){0.f, 0.f, 0.f, 0.f};
    float m_state = 0.f;
    MlPre pre;
#define ML_PREFETCH(jj) do { int sb_, sl_, pb_; ml_geom((jj), b, dir, sb_, sl_, pb_); \
        { const int pmin = dir ? pb_ + 120 - i0 : pb_ + i0; const bf16_t* zr = QKC + (size_t)(sb_ + pmin) * D + chn; (void)sl_; \
          _Pragma("unroll") for (int k = 0; k < 8; ++k) pre.qk[k] = *(const u32x4*)(zr + (size_t)k * D); } \
        { const int pminv = dir ? pb_ + 124 - vi0 : pb_ + vi0; const bf16_t* zv = Z + (size_t)(sb_ + pminv) * NZ + ZC_V + vch; \
          _Pragma("unroll") for (int k = 0; k < 4; ++k) pre.v[k] = *(const u32x2*)(zv + (size_t)k * NZ); } \
        if (wave == 0) { const int p0 = dir ? pb_ + 127 - 2 * lane : pb_ + 2 * lane, p1 = dir ? p0 - 1 : p0 + 1; \
          pre.g[0] = ZG[(size_t)(sb_ + p0) * 16 + dir * 8 + head]; pre.g[1] = ZG[(size_t)(sb_ + p0) * 16 + dir * 8 + 4 + head]; \
          pre.g[2] = ZG[(size_t)(sb_ + p1) * 16 + dir * 8 + head]; pre.g[3] = ZG[(size_t)(sb_ + p1) * 16 + dir * 8 + 4 + head]; } } while (0)
#define ML_STEPA(sbuf) do { LAS float* sg_ = (LAS float*)(F.lds + ML_SC + (sbuf) * ML_SCSZ); const int i0g = 2 * lane, i1g = i0g + 1; \
        const float gi0 = pre.g[0], gf0 = pre.g[1], gi1 = pre.g[2], gf1 = pre.g[3]; \
        const float lf0 = logsigf_(gf0), lf1 = logsigf_(gf1); const float s1 = lf0 + lf1; float incl = s1; \
        _Pragma("unroll") for (int o = 1; o < 64; o <<= 1) { const float y_ = shup(incl, o, lane); incl += (lane >= o) ? y_ : 0.f; } \
        const float excl = incl - s1, bc0 = excl + lf0, bc1 = excl + s1; \
        const float g0 = gi0 - bc0, g1 = gi1 - bc1; const float mx1 = fmaxf(g0, g1); float im = mx1; \
        _Pragma("unroll") for (int o = 1; o < 64; o <<= 1) { const float y_ = shup(im, o, lane); im = (lane >= o) ? fmaxf(im, y_) : im; } \
        float em = shup(im, 1, lane); em = (lane == 0) ? -3.0e38f : em; \
        const float M0 = fmaxf(m_state, fmaxf(em, g0)), M1 = fmaxf(m_state, fmaxf(em, mx1)); \
        const float total = bperm(63, bc1), Mlast = bperm(63, M1); \
        sg_[i0g] = g0; sg_[i1g] = g1; sg_[128 + i0g] = M0; sg_[128 + i1g] = M1; \
        sg_[256 + i0g] = __expf(m_state - M0); sg_[256 + i1g] = __expf(m_state - M1); \
        sg_[384 + i0g] = __expf(-(bc0 + M0)); sg_[384 + i1g] = __expf(-(bc1 + M1)); \
        sg_[512 + i0g] = __expf(g0 - Mlast); sg_[512 + i1g] = __expf(g1 - Mlast); \
        if (lane == 0) sg_[640] = __expf(m_state - Mlast); \
        m_state = total + Mlast; } while (0)
    { ML_ROLES(); ML_PREFETCH(0); if (wave == 0) ML_STEPA(0); }
    ML_BAR();
#pragma unroll 1
    for (int j = 0; j < 34; ++j) {
        asm volatile("" : "+v"(tl));
        ML_ROLES();
        int seqbase, seqlen, pbase; ml_geom(j, b, dir, seqbase, seqlen, pbase);
        const LAS float* sc_g = (const LAS float*)(F.lds + ML_SC + (j & 1) * ML_SCSZ); const LAS float* sc_M = sc_g + 128; const LAS float* sc_dec = sc_g + 256; const LAS float* sc_emt = sc_g + 384; const LAS float* sc_wk = sc_g + 512;
        {
#pragma unroll
          for (int k = 0; k < 8; ++k) { const int i = dir ? i0 + 7 - k : i0 + k; *(LAS u32x4*)((isk ? KS : QS) + i * 272 + ck * 16) = pre.qk[k]; }
          if (isk) { u32x4 kt[8]; float ykeep[8];
#pragma unroll
              for (int e = 0; e < 8; ++e) { kt[e] = (u32x4){0u, 0u, 0u, 0u}; ykeep[e] = 0.f; }
#pragma unroll
              for (int k = 0; k < 8; ++k) { const int i = dir ? i0 + 7 - k : i0 + k; const float wk = sc_wk[i];
                  const unsigned xb[4] = {pre.qk[k].x, pre.qk[k].y, pre.qk[k].z, pre.qk[k].w};
#pragma unroll
                  for (int e = 0; e < 8; ++e) { const float yw = ((e & 1) ? bfhi(xb[e >> 1]) : bflo(xb[e >> 1])) * wk;
                      if (k & 1) { const unsigned pw_ = pk2(ykeep[e], yw); if ((k >> 1) == 0) kt[e].x = pw_; else if ((k >> 1) == 1) kt[e].y = pw_; else if ((k >> 1) == 2) kt[e].z = pw_; else kt[e].w = pw_; }
                      else ykeep[e] = yw; } }
#pragma unroll
              for (int e = 0; e < 8; ++e) { u32x4 o = kt[e]; if (dir) o = (u32x4){swap16(kt[e].w), swap16(kt[e].z), swap16(kt[e].y), swap16(kt[e].x)};
                  *(LAS u32x4*)(KW + (ck * 8 + e) * 272 + (((i0 >> 3) ^ (ck & 7)) * 16)) = o; } } }
        { unsigned vv[4][2];
#pragma unroll
          for (int k = 0; k < 4; ++k) { vv[k][0] = pre.v[k].x; vv[k][1] = pre.v[k].y; }
#pragma unroll
          for (int c = 0; c < 4; ++c) {
              unsigned h0 = (c & 1) ? (vv[0][c >> 1] >> 16) : (vv[0][c >> 1] & 0xffffu), h1 = (c & 1) ? (vv[1][c >> 1] >> 16) : (vv[1][c >> 1] & 0xffffu);
              unsigned h2 = (c & 1) ? (vv[2][c >> 1] >> 16) : (vv[2][c >> 1] & 0xffffu), h3 = (c & 1) ? (vv[3][c >> 1] >> 16) : (vv[3][c >> 1] & 0xffffu);
              u32x2 o; if (dir) { o.x = h3 | (h2 << 16); o.y = h1 | (h0 << 16); } else { o.x = h0 | (h1 << 16); o.y = h2 | (h3 << 16); }
              *(LAS u32x2*)(VT + (vcq * 4 + c) * 272 + vi0 * 2) = o; } }
#pragma unroll
        for (int vt = 0; vt < 5; ++vt)
#pragma unroll
            for (int rr = 0; rr < 4; rr += 2) { const unsigned pw_ = pk2(cs[vt][rr], cs[vt][rr + 1]);
                *(LAS bf16_t*)(CB + (16 * vt + 4 * q4 + rr) * 272 + (16 * wave + fr) * 2) = (bf16_t)(pw_ & 0xffffu); *(LAS bf16_t*)(CB + (16 * vt + 4 * q4 + rr + 1) * 272 + (16 * wave + fr) * 2) = (bf16_t)(pw_ >> 16); }
        ML_BAR();
        if (j + 1 < 34) ML_PREFETCH(j + 1);
        const int t = 16 * wave + fr;
        bf16x8 qf[4];
#pragma unroll
        for (int kc = 0; kc < 4; ++kc) qf[kc] = *(const LAS bf16x8*)(QS + t * 272 + (32 * kc + 8 * q4) * 2);
        const float Mt_t = sc_M[t], dec_t = sc_dec[t], emt_t = sc_emt[t];
        f32x4 ps[8];
#pragma unroll
        for (int jp = 0; jp < 4; ++jp) {
            ps[2 * jp] = (f32x4){0.f, 0.f, 0.f, 0.f}; ps[2 * jp + 1] = (f32x4){0.f, 0.f, 0.f, 0.f};
            if (2 * jp <= wave) {
                bf16x8 ka[4], kb[4];
#pragma unroll
                for (int kc = 0; kc < 4; ++kc) { ka[kc] = *(const LAS bf16x8*)(KS + (32 * jp + fr) * 272 + (32 * kc + 8 * q4) * 2); kb[kc] = *(const LAS bf16x8*)(KS + (32 * jp + 16 + fr) * 272 + (32 * kc + 8 * q4) * 2); }
                const f32x4 ga4 = *(const LAS f32x4*)(sc_g + 32 * jp + 4 * q4), gb4 = *(const LAS f32x4*)(sc_g + 32 * jp + 16 + 4 * q4);
                f32x4 acc0 = (f32x4){0.f, 0.f, 0.f, 0.f}, acc1 = (f32x4){0.f, 0.f, 0.f, 0.f};
#pragma unroll
                for (int kc = 0; kc < 4; ++kc) { acc0 = MFMA16(ka[kc], qf[kc], acc0); acc1 = MFMA16(kb[kc], qf[kc], acc1); }
#pragma unroll
                for (int rr = 0; rr < 4; ++rr) { const int s0 = 32 * jp + 4 * q4 + rr, s1 = s0 + 16;
                    ps[2 * jp][rr] = (s0 <= t) ? acc0[rr] * __expf(ga4[rr] - Mt_t) : 0.f; ps[2 * jp + 1][rr] = (s1 <= t) ? acc1[rr] * __expf(gb4[rr] - Mt_t) : 0.f; }
            }
        }
        f32x4 ao[5];
        {
#pragma unroll
          for (int vt = 0; vt < 5; ++vt) ao[vt] = (f32x4){0.f, 0.f, 0.f, 0.f};
#pragma unroll
          for (int kh = 0; kh < 4; kh += 2) { bf16x8 cf[2][5];
#pragma unroll
              for (int k2 = 0; k2 < 2; ++k2)
#pragma unroll
                  for (int vt = 0; vt < 5; ++vt) cf[k2][vt] = *(const LAS bf16x8*)(CB + (16 * vt + fr) * 272 + (32 * (kh + k2) + 8 * q4) * 2);
#pragma unroll
              for (int k2 = 0; k2 < 2; ++k2)
#pragma unroll
                  for (int vt = 0; vt < 5; ++vt) ao[vt] = MFMA16(cf[k2][vt], qf[kh + k2], ao[vt]); }
#pragma unroll
          for (int vt = 0; vt < 5; ++vt) ao[vt] = ao[vt] * dec_t; }
#pragma unroll
        for (int ks = 0; ks < 4; ++ks) {
            if (2 * ks <= wave) {
                s16x4 vlo[5], vhi[5];
#pragma unroll
                for (int vt = 0; vt < 5; ++vt) { vlo[vt] = *(const LAS s16x4*)(VT + (16 * vt + fr) * 272 + (32 * ks + 4 * q4) * 2); vhi[vt] = *(const LAS s16x4*)(VT + (16 * vt + fr) * 272 + (32 * ks + 16 + 4 * q4) * 2); }
                u32x4 pw; pw.x = cvt_pk_bf16(ps[2 * ks][0], ps[2 * ks][1]); pw.y = cvt_pk_bf16(ps[2 * ks][2], ps[2 * ks][3]); pw.z = cvt_pk_bf16(ps[2 * ks + 1][0], ps[2 * ks + 1][1]); pw.w = cvt_pk_bf16(ps[2 * ks + 1][2], ps[2 * ks + 1][3]);
                const bf16x8 pf = __builtin_bit_cast(bf16x8, pw);
#pragma unroll
                for (int vt = 0; vt < 5; ++vt) { const bf16x8 a = __builtin_shufflevector(vlo[vt], vhi[vt], 0, 1, 2, 3, 4, 5, 6, 7); ao[vt] = MFMA16(a, pf, ao[vt]); }
            }
        }
        { const float den = bperm(fr, ao[4][0]); const float inv = 1.0f / fmaxf(fabsf(den), emt_t);
          const int p = dir ? pbase + 127 - t : pbase + t; bf16_t* orow = HF + (size_t)(seqbase + p) * 512 + head * 128 + vh * 64 + 4 * q4;
#pragma unroll
          for (int vt = 0; vt < 4; ++vt) { const f32x4 o = ao[vt] * inv; u32x2 w; w.x = cvt_pk_bf16(o[0], o[1]); w.y = cvt_pk_bf16(o[2], o[3]); *(u32x2*)(orow + 16 * vt) = w; } }
        { const float a_s = sc_g[640];
#pragma unroll
          for (int vt = 0; vt < 5; ++vt) cs[vt] = cs[vt] * a_s;
#pragma unroll
          for (int ks = 0; ks < 4; ks += 2) { bf16x8 bb[2], va[2][5];
#pragma unroll
              for (int k2 = 0; k2 < 2; ++k2) { bb[k2] = *(const LAS bf16x8*)(KW + (16 * wave + fr) * 272 + (((4 * (ks + k2) + q4) ^ (((16 * wave + fr) >> 3) & 7)) * 16));
#pragma unroll
                  for (int vt = 0; vt < 5; ++vt) va[k2][vt] = *(const LAS bf16x8*)(VT + (16 * vt + fr) * 272 + (32 * (ks + k2) + 8 * q4) * 2); }
#pragma unroll
              for (int k2 = 0; k2 < 2; ++k2)
#pragma unroll
                  for (int vt = 0; vt < 5; ++vt) cs[vt] = MFMA16(va[k2][vt], bb[k2], cs[vt]); } }
        if (wave == 0 && j + 1 < 34) ML_STEPA((j + 1) & 1);
        ML_BAR();
    }
#undef ML_PREFETCH
#undef ML_STEPA
#undef ML_ROLES
    __syncthreads();
}
__device__ __forceinline__ void phase_mixers(Frame& F, int l) {
    const bool with_ctx = (l != DEPTH - 1);
#ifndef MIX_MASK
#define MIX_MASK 7
#endif
#ifndef MIXREP
#define MIXREP 0
#endif
    if (MIX_MASK & 1) pool_tiles(F, l, with_ctx);
    if (MIXREP & 1) { __syncthreads(); pool_tiles(F, l, with_ctx); }
    if (MIX_MASK & 2) sgu_chunks(F, l, with_ctx);
    if (MIXREP & 2) { __syncthreads(); sgu_chunks(F, l, with_ctx); }
    (void)0;
    qk_conv_pass(F, l);
}
__device__ __forceinline__ void phase_mlstm(Frame& F, int l) {
    for (int u = F.bid; u < 256; u += F.G) mlstm_unit(F, l, u);
}

struct Args { const float* in[31]; float* out; unsigned char* ws; int g_lo, g_hi, pad0, pad1; };
constexpr int NPH = 11, NGID = 2 + DEPTH * NPH;
__global__ void __launch_bounds__(NTHREADS, 2) fwd_kernel(Args args) {
    extern __shared__ __attribute__((aligned(16))) unsigned char lds_raw[];
    Frame F;
    F.lds = (LAS unsigned char*)lds_raw; F.MISC = (volatile LAS unsigned*)(F.lds + MISC_OFF);
    F.tid = threadIdx.x; F.lane = F.tid & 63; F.wave = __builtin_amdgcn_readfirstlane(F.tid >> 6); F.G = gridDim.x; F.bid = blockIdx.x;
    F.ws = args.ws; F.out = args.out;
    F.in = (InTab)__builtin_amdgcn_kernarg_segment_ptr();
    if (F.tid < 64) F.MISC[F.tid] = 0u;
    __syncthreads();
    const int lo = args.g_lo, hi = args.g_hi;
    const bool multi = (hi - lo) > 1;
    XcdBarrier bar; bar.bar = (unsigned*)(F.ws + WS_CTL) + CW_BAR; bar.x = 0; bar.st = nullptr;
    if (multi) bar = xcd_barrier_post((unsigned*)(F.ws + WS_CTL) + CW_BAR, F.MISC + 8);
#ifndef PHASE_MASK
#define PHASE_MASK 0xFFFF
#endif
#define RUN(g) (lo <= (g) && (g) < hi)
#define RUNP(ty, g) ((((PHASE_MASK) >> (ty)) & 1) && RUN(g))
#ifndef REPEAT_MASK
#define REPEAT_MASK 0
#endif
#define NREP(ty) ((((REPEAT_MASK) >> (ty)) & 1) ? 2 : 1)
#define SEAM(g) do { if (RUN((g) + 1)) xcd_barrier(bar); } while (0)
#define LAUNDER(P) Frame P = F; { int t_; asm volatile("v_mbcnt_lo_u32_b32 %0, -1, 0\n\tv_mbcnt_hi_u32_b32 %0, -1, %0" : "=v"(t_)); t_ |= (F.wave << 6); P.tid = t_; P.lane = t_ & 63; P.wave = __builtin_amdgcn_readfirstlane(t_ >> 6); GAS unsigned char* w_ = (GAS unsigned char*)F.ws; asm volatile("" : "+s"(w_)); P.ws = (unsigned char*)w_; InTab t2_ = F.in; asm volatile("" : "+s"(t2_)); P.in = t2_; }
    if (RUNP(0, 0)) { LAUNDER(P); for (int rep_ = 0; rep_ < NREP(0); ++rep_) { phase_prologue(P); __syncthreads(); } SEAM(0); }
    if (RUNP(1, 1)) { LAUNDER(P); for (int rep_ = 0; rep_ < NREP(1); ++rep_) { phase_ln0_first(P); __syncthreads(); } SEAM(1); }
#pragma unroll 1
    for (int l = 0; l < DEPTH; ++l) {
        const int g0 = 2 + l * NPH;
        const int mrows = (l == DEPTH - 1) ? ML : MT;
        if (RUNP(2, g0 + 0)) {
#undef PHTY
#define PHTY 2
            LAUNDER(P);
            { ProbPlain Pr{(const bf16_t*)(P.ws + WS_H), (const bf16_t*)(P.ws + WS_WIN) + (size_t)l * NZ * D, D, D};
              pg8::StaticOrder<1> S; S.init(MT / 256, NZ_BF / 256, P.G, P.bid);
              EpiInproj<false> E{(bf16_t*)(P.ws + WS_Z), P.in[IN_BIN] + (size_t)l * 5904, 0};
              pg8::gemm_phase(P.lds, P.tid, Pr, S, E); }
            __syncthreads();
            { ProbPlainF8 Pr{(const bf16_t*)(P.ws + WS_H8), (const bf16_t*)(P.ws + WS_WIN8 + (size_t)l * NZ_F8 * D), D / 2, D / 2};
              pg8::StaticOrder<1> S; S.init(MT / 256, NZ_F8 / 256, P.G, P.bid);
              EpiInproj<true> E{(bf16_t*)(P.ws + WS_Z), P.in[IN_BIN] + (size_t)l * 5904, NZ_BF / 256};
              pg8::gemm_phase(P.lds, P.tid, Pr, S, E); }
            SEAM(g0 + 0);
        }
        if (RUNP(3, g0 + 1)) { LAUNDER(P); for (int rep_ = 0; rep_ < NREP(3); ++rep_) { phase_mixers(P, l); __syncthreads(); } SEAM(g0 + 1); }
        if (RUNP(12, g0 + 2)) { LAUNDER(P); for (int rep_ = 0; rep_ < NREP(12); ++rep_) { phase_mlstm(P, l); __syncthreads(); } SEAM(g0 + 2); }
        if (RUNP(4, g0 + 3)) { LAUNDER(P); for (int rep_ = 0; rep_ < NREP(4); ++rep_) phase_finalize(P, l, mrows); SEAM(g0 + 3); }
        if (RUNP(5, g0 + 4)) {
#undef PHTY
#define PHTY 5
            LAUNDER(P);
            ProbPlain Pr{(const bf16_t*)(P.ws + WS_BRA), (const bf16_t*)(P.ws + WS_WBR) + (size_t)l * D * D, D, D};
            pg8::StaticOrder<1> S; S.init(mrows / 256, 4, P.G, P.bid);
            EpiBranch E{(const bf16_t*)(P.ws + WS_Z), (bf16_t*)(P.ws + WS_Y)};
            pg8::gemm_phase(P.lds, P.tid, Pr, S, E); if (NREP(PHTY) == 2) { __syncthreads(); pg8::gemm_phase(P.lds, P.tid, Pr, S, E); }
            SEAM(g0 + 4);
        }
        if (RUNP(6, g0 + 5)) {
#undef PHTY
#define PHTY 6
            LAUNDER(P);
            ProbPlain Pr{(const bf16_t*)(P.ws + WS_Y), (const bf16_t*)(P.ws + WS_WOUT) + (size_t)l * D * D, D, D};
            pg8::StaticOrder<1> S; S.init(mrows / 256, 4, P.G, P.bid);
            EpiOut E{(bf16_t*)(P.ws + WS_T)};
            pg8::gemm_phase(P.lds, P.tid, Pr, S, E); if (NREP(PHTY) == 2) { __syncthreads(); pg8::gemm_phase(P.lds, P.tid, Pr, S, E); }
            SEAM(g0 + 5);
        }
        if (RUNP(7, g0 + 6)) { LAUNDER(P); for (int rep_ = 0; rep_ < NREP(7); ++rep_) phase_ln1_router(P, l, mrows); SEAM(g0 + 6); }
        if (RUNP(8, g0 + 7)) { LAUNDER(P); for (int rep_ = 0; rep_ < NREP(8); ++rep_) phase_slots(P, mrows); SEAM(g0 + 7); }
        if (RUNP(9, g0 + 8)) {
#undef PHTY
#define PHTY 9
            LAUNDER(P);
            LAS int* seg = (LAS int*)(P.lds + TAB_OFF);
            const int ntile = moe_tables(P, seg);
            ProbMoe1 Pr{(const bf16_t*)(P.ws + WS_H2F8), (const bf16_t*)(P.ws + WS_WGU + (size_t)l * NEXP * 2048 * D), D / 2, D / 2, (const int*)(P.ws + WS_ROUTE + RT_TOK), seg};
            pg8::StaticOrder<1> S; S.init(ntile, 8, P.G, P.bid);
            EpiSwiglu E{(unsigned char*)(P.ws + WS_HID), P.in[IN_BGU] + (size_t)l * NEXP * 2048, seg};
            pg8::gemm_phase(P.lds, P.tid, Pr, S, E); if (NREP(PHTY) == 2) { __syncthreads(); pg8::gemm_phase(P.lds, P.tid, Pr, S, E); }
            SEAM(g0 + 8);
        }
        if (RUNP(10, g0 + 9)) {
#undef PHTY
#define PHTY 10
            LAUNDER(P);
            LAS int* seg = (LAS int*)(P.lds + TAB_OFF);
            const int ntile = moe_tables(P, seg);
            ProbMoe2 Pr{(const bf16_t*)(P.ws + WS_HID), (const bf16_t*)(P.ws + WS_WDN + (size_t)l * NEXP * D * D), D / 2, D / 2, seg};
            pg8::StaticOrder<1> S; S.init(ntile, 4, P.G, P.bid);
            EpiDown E{(unsigned char*)(P.ws + WS_FS), P.in[IN_BDN] + (size_t)l * NEXP * D, (const int*)(P.ws + WS_ROUTE + RT_DEST), (const float*)(P.ws + WS_ROUTE + RT_PSLOT), seg};
            pg8::gemm_phase(P.lds, P.tid, Pr, S, E); if (NREP(PHTY) == 2) { __syncthreads(); pg8::gemm_phase(P.lds, P.tid, Pr, S, E); }
            SEAM(g0 + 9);
        }
        if (RUNP(11, g0 + 10)) { LAUNDER(P); phase_combine_ln2(P, l, mrows); SEAM(g0 + 10); }
    }
#undef LAUNDER
#undef RUN
#undef RUNP
#undef SEAM
}

extern "C" void kernel_launch(void* const* d_in, const int* in_sizes, int n_in, void* d_out, int out_size, void* d_ws, size_t ws_size, hipStream_t stream) {
    static int grid = 0;
    if (grid == 0) {
        if (n_in != 31 || out_size != ML * D || ws_size < WS_END) { fprintf(stderr, "kernel_launch: unexpected problem (n_in %d, out %d, ws %zu, need %zu)\n", n_in, out_size, ws_size, (size_t)WS_END); grid = -1; return; }
        int dev = 0, cus = 0, per_cu = 0;
        if (hipGetDevice(&dev) != hipSuccess || hipDeviceGetAttribute(&cus, hipDeviceAttributeMultiprocessorCount, dev) != hipSuccess) { grid = -1; return; }
        if (hipFuncSetAttribute((const void*)fwd_kernel, hipFuncAttributeMaxDynamicSharedMemorySize, LDS_BYTES) != hipSuccess) { fprintf(stderr, "kernel_launch: hipFuncSetAttribute failed\n"); grid = -1; return; }
        if (hipOccupancyMaxActiveBlocksPerMultiprocessor(&per_cu, (const void*)fwd_kernel, NTHREADS, LDS_BYTES) != hipSuccess || per_cu < 1) fprintf(stderr, "kernel_launch: occupancy query reports %d\n", per_cu);
        (void)hipGetLastError();
        grid = cus;
    }
    if (grid < 0) return;
    (void)hipMemsetAsync((char*)d_ws + WS_CTL, 0, CTL_ZERO_BYTES, stream);
    Args a{};
    for (int i = 0; i < 31; ++i) a.in[i] = (const float*)d_in[i];
    a.out = (float*)d_out; a.ws = (unsigned char*)d_ws;
#if MK_N_LAUNCHES == 1
    a.g_lo = 0; a.g_hi = NGID;
    hipLaunchKernelGGL(fwd_kernel, dim3(grid), dim3(NTHREADS), LDS_BYTES, stream, a);
#else
    for (int g = 0; g < NGID; ++g) { a.g_lo = g; a.g_hi = g + 1; hipLaunchKernelGGL(fwd_kernel, dim3(grid), dim3(NTHREADS), LDS_BYTES, stream, a); }
#endif
}
```

```cpp
#include <hip/hip_runtime.h>
#include <cstdio>
#include <cstdint>

#ifndef MK_N_LAUNCHES
#define MK_N_LAUNCHES 1
#endif

#define LAS __attribute__((address_space(3)))
#define GAS __attribute__((address_space(1)))
typedef unsigned short bf16_t;
typedef short bf16x8 __attribute__((ext_vector_type(8)));
typedef short s16x4 __attribute__((ext_vector_type(4)));
typedef float f32x4 __attribute__((ext_vector_type(4)));
typedef float f32x2 __attribute__((ext_vector_type(2)));
typedef float f32x16 __attribute__((ext_vector_type(16)));
typedef unsigned u32x4 __attribute__((ext_vector_type(4)));
typedef unsigned u32x2 __attribute__((ext_vector_type(2)));
typedef int i32x4 __attribute__((ext_vector_type(4)));
typedef int i32x8 __attribute__((ext_vector_type(8)));

constexpr int D = 1024, NB = 16, SEQ = 4096, CTXL = 256, DEPTH = 4;
constexpr int ML = NB * SEQ;
constexpr int MC = NB * CTXL;
constexpr int MT = ML + MC;
constexpr int NZ = 5888;
constexpr int ZC_P = 0, ZC_QK = 256, ZC_V = 1280, ZC_O = 1792, ZC_UV = 2304, ZC_MG = 2816;
constexpr int NZ_BF = 256, NZ_F8 = 5632;
constexpr int ZG_COL = 2816;
constexpr int NEXP = 32, TOPK = 4;
constexpr int NS_MAX = MT * TOPK + NEXP * 256;
constexpr float LN_EPS = 1e-5f, HEAD_EPS = 1e-6f;
constexpr float DN_ALPHA = 1.6817928305074292f;
constexpr int NWAVES = 8, NTHREADS = 512;
constexpr float F8S_ACT = 4.0f, F8S_WGU = 64.0f, F8S_WDN = 64.0f; constexpr int F8E_ACT = 123, F8E_WGU = 123, F8E_WDN = 123;

constexpr size_t MiB = 1u << 20;
constexpr size_t WS_CTL = 0, CTL_ZERO_BYTES = 1 * MiB;
constexpr size_t WS_MOD = 1 * MiB;
constexpr size_t WS_WG = 3 * MiB;
constexpr size_t WS_WSGU = 4 * MiB;
constexpr size_t WS_WPOOL = WS_WSGU + 512 * 1024;
constexpr size_t WS_ROUTE = 5 * MiB;
constexpr size_t WS_WIN = 16 * MiB;
constexpr size_t WS_WBR = 62 * MiB;
constexpr size_t WS_WOUT = 70 * MiB;
constexpr size_t WS_WGU = 78 * MiB;
constexpr size_t WS_WDN = 590 * MiB;
constexpr size_t WS_X = 846 * MiB;
constexpr size_t WS_H = 1118 * MiB;
constexpr size_t WS_Z = 1254 * MiB;
constexpr size_t WS_FS = WS_Z;
constexpr float G8_SCALE = 255.0f;
constexpr float FS_SCALE = 32.0f, FS_CLAMP = 440.0f;
constexpr size_t WS_BRA = 2036 * MiB;
constexpr size_t WS_HFB = 2172 * MiB;
constexpr size_t WS_Y = 2444 * MiB;
constexpr size_t WS_T = 2580 * MiB;
constexpr size_t WS_H2 = 2852 * MiB;
constexpr size_t WS_HID = 2988 * MiB;
constexpr size_t WS_ZG = 3548 * MiB;
constexpr size_t WS_H2F8 = 3554 * MiB;
constexpr size_t WS_H8 = 3624 * MiB;
constexpr size_t WS_WIN8 = 3692 * MiB;
constexpr size_t WS_END = 3714 * MiB;
static_assert(WS_Z + (size_t)MT * NZ * 2 <= WS_BRA && WS_FS + (size_t)MT * 4 * 1024 * 2 <= WS_BRA, "Z/FS");
static_assert(WS_HID + (size_t)NS_MAX * 1024 * 2 <= WS_END, "HID");
constexpr size_t RT_EIDX = 0;
constexpr size_t RT_PROB = 2 * MiB;
constexpr size_t RT_TOK = 4 * MiB;
constexpr size_t RT_DEST = 6 * MiB;
constexpr size_t RT_PSLOT = 8 * MiB;
constexpr size_t RT_CNT = 10 * MiB;
constexpr size_t RT_SEG = 10 * MiB + 64 * 1024;
constexpr int CW_BAR = 4096;

constexpr int LDS_BYTES = 163840;
constexpr int MISC_OFF = LDS_BYTES - 256;
constexpr int TAB_OFF = 131072;
constexpr int NW_WT = 0;
constexpr int NW_LG = 66048;
constexpr int NW_END = 99840;
constexpr int NW_PV = NW_END + 256;

__device__ __forceinline__ unsigned f2bf(float f) { unsigned u = __builtin_bit_cast(unsigned, f); return (u + 0x7fffu + ((u >> 16) & 1u)) >> 16; }
__device__ __forceinline__ unsigned pk2(float lo, float hi) { unsigned r; asm volatile("v_cvt_pk_bf16_f32 %0, %1, %2" : "=v"(r) : "v"(lo), "v"(hi)); return r; }
__device__ __forceinline__ unsigned pk4_fp8(float a, float b, float c, float d) { int w = 0; w = __builtin_amdgcn_cvt_pk_fp8_f32(a, b, w, false); w = __builtin_amdgcn_cvt_pk_fp8_f32(c, d, w, true); return (unsigned)w; }
__device__ __forceinline__ unsigned pk4_u8(float a, float b, float c, float d) {
    const unsigned lo = __builtin_amdgcn_perm(__builtin_bit_cast(unsigned, b), __builtin_bit_cast(unsigned, a), 0x0c0c0400u), hi = __builtin_amdgcn_perm(__builtin_bit_cast(unsigned, d), __builtin_bit_cast(unsigned, c), 0x0c0c0400u);
    return lo | (hi << 16); }
__device__ __forceinline__ f32x4 u8x4_f32(unsigned w) { return (f32x4){(float)(w & 0xffu), (float)((w >> 8) & 0xffu), (float)((w >> 16) & 0xffu), (float)(w >> 24)}; }
__device__ __forceinline__ float bflo(unsigned w) { return __builtin_bit_cast(float, w << 16); }
__device__ __forceinline__ float bfhi(unsigned w) { return __builtin_bit_cast(float, w & 0xffff0000u); }
__device__ __forceinline__ float bf1(bf16_t h) { return __builtin_bit_cast(float, ((unsigned)h) << 16); }
__device__ __forceinline__ float bperm(int srclane, float v) { return __builtin_bit_cast(float, __builtin_amdgcn_ds_bpermute(srclane << 2, __builtin_bit_cast(int, v))); }
__device__ __forceinline__ float shx(float v, int o, int lane) { return bperm(lane ^ o, v); }
__device__ __forceinline__ float shup(float v, int o, int lane) { return bperm(lane >= o ? lane - o : lane, v); }
__device__ __forceinline__ float wave_sum(float v, int lane) {
#pragma unroll
    for (int o = 1; o < 64; o <<= 1) v += shx(v, o, lane);
    return v;
}
__device__ __forceinline__ float sigmoidf_(float x) { return __builtin_amdgcn_rcpf(1.0f + __builtin_amdgcn_exp2f(x * -1.4426950408889634f)); }
__device__ __forceinline__ float siluf_(float x) { return x * __builtin_amdgcn_rcpf(1.0f + __builtin_amdgcn_exp2f(x * -1.4426950408889634f)); }
__device__ __forceinline__ f32x4 sigmoid4(f32x4 x) {
    f32x4 t = x * -1.4426950408889634f;
#pragma unroll
    for (int i = 0; i < 4; ++i) t[i] = __builtin_amdgcn_exp2f(t[i]);
    t = t + 1.0f;
#pragma unroll
    for (int i = 0; i < 4; ++i) t[i] = __builtin_amdgcn_rcpf(t[i]);
    return t; }
#define LDS_WAIT() asm volatile("s_waitcnt lgkmcnt(0)" ::: "memory")
#define VM_WAIT() asm volatile("s_waitcnt vmcnt(0)" ::: "memory")

#define XB_TMO      128
#define XB_XCNT(j)  (256  + 64 * (j))
#define XB_XSUB(j)  (1280 + 64 * (j))
#define XB_XGEN(j)  (2304 + 64 * (j))
#define XB_TOP      3328
#define XB_TOPGEN   3392
#define XCD_BAR_WORDS 3456
#define XB_SPIN_CAP (1u << 18)
__device__ __forceinline__ unsigned xb_ld(unsigned* p)              { asm volatile("" : "+v"(p)); return __hip_atomic_load(p, __ATOMIC_RELAXED, __HIP_MEMORY_SCOPE_AGENT); }
__device__ __forceinline__ unsigned xb_add(unsigned* p, unsigned v) { asm volatile("" : "+v"(p), "+v"(v)); return __hip_atomic_fetch_add(p, v, __ATOMIC_RELAXED, __HIP_MEMORY_SCOPE_AGENT); }
__device__ __forceinline__ unsigned xb_xcc_id() { return (unsigned)__builtin_amdgcn_s_getreg((3 << 11) | 20) & 0xFu; }
#define XB_SPIN(cond, bar) do { unsigned _sp = 0; while (cond) { __builtin_amdgcn_s_sleep(1); \
    if ((++_sp & 255u) == 0u) { if (xb_ld(&(bar)[XB_TMO])) break; if (_sp > XB_SPIN_CAP) { atomicAdd(&(bar)[XB_TMO], 1u); break; } } } } while (0)
struct XcdBarrier { unsigned* bar; unsigned x; volatile LAS unsigned* st; };
__device__ __forceinline__ XcdBarrier xcd_barrier_post(unsigned* bar, volatile LAS unsigned* st) {
    XcdBarrier b; b.bar = bar; b.x = xb_xcc_id(); b.st = st;
    if (threadIdx.x == 0) (void)xb_add(&bar[XB_XCNT(b.x)], 1u);
    return b;
}
__device__ __forceinline__ void xcd_barrier_complete(unsigned* bar, unsigned x, unsigned& nloc, unsigned& nx) {
    const unsigned G = gridDim.x * gridDim.y * gridDim.z;
    unsigned sum, cnt, mine, sp = 0u;
    for (;;) {
        sum = 0u; cnt = 0u; mine = 0u;
#pragma unroll
        for (unsigned j = 0; j < 16; ++j) { const unsigned c = xb_ld(&bar[XB_XCNT(j)]); sum += c; cnt += (c > 0u) ? 1u : 0u; mine = (j == x) ? c : mine; }
        if (sum == G) break;
        __builtin_amdgcn_s_sleep(1);
        if ((++sp & 255u) == 0u) { if (xb_ld(&bar[XB_TMO])) break; if (sp > XB_SPIN_CAP) { atomicAdd(&bar[XB_TMO], 1u); break; } }
    }
    nloc = mine > 0u ? mine : 1u; nx = cnt > 0u ? cnt : 1u;
}
__device__ __forceinline__ void xcd_barrier(const XcdBarrier& b) {
    asm volatile("s_waitcnt vmcnt(0)" ::: "memory");
    __syncthreads();
    if (threadIdx.x == 0) {
        unsigned* bar = b.bar;
        __builtin_amdgcn_s_waitcnt(0);
        unsigned nloc = b.st[0], nx = b.st[1];
        if (nloc == 0u) { xcd_barrier_complete(bar, b.x, nloc, nx); b.st[0] = nloc; b.st[1] = nx; }
        const unsigned old = xb_add(&bar[XB_XSUB(b.x)], 1u);
        const unsigned gen = old / nloc;
        if (old + 1u == (gen + 1u) * nloc) {
            __builtin_amdgcn_fence(__ATOMIC_RELEASE, "agent");
            asm volatile("s_waitcnt vmcnt(0)" ::: "memory");
            const unsigned og = xb_add(&bar[XB_TOP], 1u);
            const unsigned tg = og / nx;
            if (og + 1u == (tg + 1u) * nx) xb_add(&bar[XB_TOPGEN], 1u);
            else XB_SPIN(xb_ld(&bar[XB_TOPGEN]) == tg, bar);
            __builtin_amdgcn_fence(__ATOMIC_ACQUIRE, "agent");
            xb_add(&bar[XB_XGEN(b.x)], 1u);
            asm volatile("s_waitcnt vmcnt(0)" ::: "memory");
        } else {
            XB_SPIN(xb_ld(&bar[XB_XGEN(b.x)]) == gen, bar);
            __builtin_amdgcn_fence(__ATOMIC_ACQUIRE, "agent");
            asm volatile("s_waitcnt vmcnt(0)" ::: "memory");
        }
    }
    __syncthreads();
}

namespace pg8 {
constexpr int BM = 256, BK = 64, HALF = 128, HTB = HALF * BK * 2, STAGE_BYTES = 8 * HTB, NXCD = 8, WGM = 8;
__host__ __device__ __forceinline__ int lds_byte(int r, int c) { const int st = (r >> 4) * 2 + (c >> 5), rr = r & 15, cc = c & 31, ob = rr * 64 + cc * 2; return st * 1024 + (ob ^ (((ob >> 9) & 1) << 5)); }
__host__ __device__ __forceinline__ void stage_rc(int b, int& R, int& C) { const int st = b / 1024, sb = b % 1024, swz = sb ^ (((sb >> 9) & 1) << 5); R = (st >> 1) * 16 + swz / 64; C = (st & 1) * 32 + (swz % 64) / 2; }
__host__ __device__ __forceinline__ int perm32(int rho) { const int n = rho >> 4, i = rho & 15; return 8 * (i >> 2) + 4 * n + (i & 3); }
struct Unit { int pm, pn, sub; };
__device__ __forceinline__ unsigned cvt_pk_bf16(float lo, float hi) { unsigned r; asm volatile("v_cvt_pk_bf16_f32 %0, %1, %2" : "=v"(r) : "v"(lo), "v"(hi)); return r; }
__device__ __forceinline__ f32x2 gelu_pk(f32x2 v) {
    const f32x2 av = __builtin_elementwise_abs(v), d = av * 0.2316418882f + 1.0f;
    f32x2 t; t.x = __builtin_amdgcn_rcpf(d.x); t.y = __builtin_amdgcn_rcpf(d.y);
    f32x2 q = t * 0.5307027145f + (-0.7265760135f); q = q * t + 0.7107068705f; q = q * t + (-0.142248368f); q = q * t + 0.127414796f; q = q * t;
    const f32x2 s = (v * v) * (-0.72134752044f);
    f32x2 e; e.x = __builtin_amdgcn_exp2f(s.x); e.y = __builtin_amdgcn_exp2f(s.y);
    const f32x2 m = v * (q * e), r = v - m;
    f32x2 o; o.x = v.x < 0.f ? m.x : r.x; o.y = v.y < 0.f ? m.y : r.y; return o;
}
template <int NSUB = 1> struct StaticOrder {
    int nM, nN, nwg, G, c;
    __device__ void init(int nM_, int nN_, int G_, int c_) { nM = nM_; nN = nN_; nwg = nM * nN; G = G_; c = c_; }
    __device__ bool next(int i, Unit& u) const {
        const int it = i / NSUB; u.sub = i - it * NSUB;
        const long L = (long)it * G + c; if (L >= nwg) return false;
        int wgid = (int)L; { const int q = nwg / NXCD, r = nwg % NXCD, xcd = wgid % NXCD, off = wgid / NXCD; wgid = (xcd < r ? xcd * (q + 1) : r * (q + 1) + (xcd - r) * q) + off; }
        const int nig = WGM * nN, gid = wgid / nig, fm = gid * WGM, gsz = (nM - fm) < WGM ? (nM - fm) : WGM;
        u.pm = fm + ((wgid % nig) % gsz); u.pn = (wgid % nig) / gsz; return true;
    }
};
constexpr int SIDE_TOK = 131072 + 2048;
constexpr int SIDE_SLOT = 131072 + 10240, SIDE_SLOT_BYTES = 3072;
__device__ __forceinline__ void dma16(unsigned voff, const void* sbase, unsigned ldsaddr) { asm volatile("s_mov_b32 m0, %2\n\tglobal_load_lds_dwordx4 %0, %1" :: "v"(voff), "s"(sbase), "s"(ldsaddr) : "memory", "m0"); }
__device__ __forceinline__ void dma4(unsigned voff, const void* sbase, unsigned ldsaddr) { asm volatile("s_mov_b32 m0, %2\n\tglobal_load_lds_dword %0, %1" :: "v"(voff), "s"(sbase), "s"(ldsaddr) : "memory", "m0"); }
template <class Prob, class Sched, class Epi>
__device__ __forceinline__ void gemm_phase(LAS unsigned char* lds, const int tid, const Prob& P, const Sched& S, const Epi& E) {
    const int wid = __builtin_amdgcn_readfirstlane(tid >> 6), lane = tid & 63, wr = wid >> 2, wc = wid & 3, fr = lane & 15, fq = lane >> 4;
    const int lda = P.lda, ldb = P.ldb;
    unsigned voffB[2], offA[2][2];
#define PG8_TOKSLOT(name) const LAS int* name; { PG8_TID(tl2_); name = (const LAS int*)(lds + SIDE_TOK) + (tl2_ >> 6) * 256 + (tl2_ & 63); }
#define PG8_TID(v_) int v_; asm volatile("v_mbcnt_lo_u32_b32 %0, -1, 0\n\tv_mbcnt_hi_u32_b32 %0, -1, %0" : "=v"(v_)); v_ |= (wid << 6)
#define PG8_RC(R_, C_) int R_[2], C_[2]; { PG8_TID(tl_); _Pragma("unroll") for (int i_ = 0; i_ < 2; ++i_) stage_rc(tl_ * 16 + i_ * 8192, R_[i_], C_[i_]); }
#pragma unroll
    for (int i = 0; i < 2; ++i) { int R, C; stage_rc(tid * 16 + i * 8192, R, C); const int Rb = Epi::PERM ? ((R & ~31) + perm32(R & 31)) : R;
        voffB[i] = (unsigned)(Rb * ldb + C) * 2u;
        offA[0][i] = (unsigned)(R * lda + C) * 2u; offA[1][i] = (unsigned)((R + HALF) * lda + C) * 2u; }
    const size_t kstep = (size_t)(BK * 2);
    const size_t hstep = (size_t)HALF * ldb * 2;
    const unsigned ldsw = (unsigned)wid * 1024u;
    const int aoff = lds_byte(wr * 64 + fr, fq * 8), boff = lds_byte(wc * 32 + fr, fq * 8);
#define PG8_SA(b, h) (((b) * 2 + (h)) * HTB)
#define PG8_SB(b, h) ((4 + (b) * 2 + (h)) * HTB)
    const unsigned ldsb = (unsigned)(size_t)lds;
#define PG8_STAGE(bufoff, gbase, voff) do { _Pragma("unroll") for (int _i = 0; _i < 2; ++_i) \
        asm volatile("s_mov_b32 m0, %2\n\tglobal_load_lds_dwordx4 %0, %1" :: "v"((voff)[_i]), "s"((const char*)(gbase)), "s"(ldsb + (unsigned)(bufoff) + ldsw + (unsigned)(_i * 8192)) : "memory", "m0"); } while (0)
#define PG8_CAT(x0, x1) __builtin_shufflevector(x0, x1, 0, 1, 2, 3, 4, 5, 6, 7)
#define PG8_LDA(dst, b, h) do { if constexpr (Prob::FP8) { _Pragma("unroll") for (int m = 0; m < 4; ++m) dst##8[m] = PG8_CAT(*(const LAS i32x4*)(lds + PG8_SA(b, h) + aoff + m * 2048), *(const LAS i32x4*)(lds + PG8_SA(b, h) + aoff + m * 2048 + 1024)); } \
        else { _Pragma("unroll") for (int m = 0; m < 4; ++m) _Pragma("unroll") for (int k = 0; k < 2; ++k) dst[m][k] = *(const LAS bf16x8*)(lds + PG8_SA(b, h) + aoff + m * 2048 + k * 1024); } } while (0)
#define PG8_LDB(dst, b, h) do { if constexpr (Prob::FP8) { _Pragma("unroll") for (int n = 0; n < 2; ++n) dst##8[n] = PG8_CAT(*(const LAS i32x4*)(lds + PG8_SB(b, h) + boff + n * 2048), *(const LAS i32x4*)(lds + PG8_SB(b, h) + boff + n * 2048 + 1024)); } \
        else { _Pragma("unroll") for (int n = 0; n < 2; ++n) _Pragma("unroll") for (int k = 0; k < 2; ++k) dst[n][k] = *(const LAS bf16x8*)(lds + PG8_SB(b, h) + boff + n * 2048 + k * 1024); } } while (0)
#define PG8_MMA(ai, bj, At, Bt) do { __builtin_amdgcn_s_setprio(1); \
        if constexpr (Prob::FP8) { _Pragma("unroll") for (int m = 0; m < 4; ++m) _Pragma("unroll") for (int n = 0; n < 2; ++n) \
            acc[ai][bj][m][n] = __builtin_amdgcn_mfma_scale_f32_16x16x128_f8f6f4(Bt##8[n], At##8[m], acc[ai][bj][m][n], 0, 0, 0, sc8_, 0, sc8_); } \
        else { _Pragma("unroll") for (int m = 0; m < 4; ++m) _Pragma("unroll") for (int n = 0; n < 2; ++n) _Pragma("unroll") for (int k = 0; k < 2; ++k) \
            acc[ai][bj][m][n] = __builtin_amdgcn_mfma_f32_16x16x32_bf16(Bt[n][k], At[m][k], acc[ai][bj][m][n], 0, 0, 0); } \
        __builtin_amdgcn_s_setprio(0); } while (0)
#define PG8_WAIT_V(n) asm volatile("s_waitcnt vmcnt(" #n ")" ::: "memory")
#define PG8_WAIT_L(n) asm volatile("s_waitcnt lgkmcnt(" #n ")" ::: "memory")
#define PG8_BAR __builtin_amdgcn_s_barrier()
#define PG8_SCHED __builtin_amdgcn_sched_barrier(0)
    Unit cur, nxt; int ui = 0;
    if (!S.next(0, cur)) return;
    static_assert(Prob::SCALE_A == Prob::SCALE_B, "one scale register serves both operands");
    int sc8_; asm volatile("v_mov_b32 %0, %1" : "=v"(sc8_) : "n"(Prob::SCALE_A));
    f32x4 acc[2][2][4][2];
    float zero_; asm volatile("v_mov_b32 %0, 0" : "=v"(zero_));
#pragma unroll
    for (int a = 0; a < 2; ++a)
#pragma unroll
        for (int b = 0; b < 2; ++b)
#pragma unroll
            for (int m = 0; m < 4; ++m)
#pragma unroll
                for (int n = 0; n < 2; ++n) acc[a][b][m][n] = (f32x4){zero_, zero_, zero_, zero_};
    bf16x8 At[4][2], B0[2][2], B1[2][2]; i32x8 At8[4], B08[2], B18[2];
    const char* cA = P.a_base(cur); const char* cB = P.b_base(cur); int nt = P.nt(cur);
    if constexpr (Prob::GATHER) { PG8_RC(Rr, Cc); P.a_rows(cur, Rr, Cc, offA); }
    if constexpr (Epi::SIDE) { PG8_TID(tl4_); E.side(cur, ldsb + SIDE_SLOT, wid, tl4_ & 63); }
    PG8_STAGE(PG8_SB(0, 0), cB, voffB); PG8_STAGE(PG8_SB(0, 1), cB + hstep, voffB); PG8_STAGE(PG8_SA(0, 0), cA, offA[0]); PG8_STAGE(PG8_SA(0, 1), cA, offA[1]);
    if (wr == 1) PG8_BAR;
    PG8_WAIT_V(2); PG8_BAR;
    PG8_STAGE(PG8_SB(1, 0), cB + kstep, voffB); PG8_STAGE(PG8_SA(1, 0), cA + kstep, offA[0]); PG8_STAGE(PG8_SB(1, 1), cB + hstep + kstep, voffB);
    PG8_WAIT_V(6); PG8_BAR;
    for (;;) {
        const bool has_next = S.next(ui + 1, nxt);
        const char* nA = has_next ? P.a_base(nxt) : cA; const char* nB = has_next ? P.b_base(nxt) : cB;
        if constexpr (Prob::GATHER) { if (has_next) { PG8_RC(Rr, Cc); (void)Cc;
#pragma unroll
            for (int h = 0; h < 2; ++h)
#pragma unroll
                for (int i = 0; i < 2; ++i) dma4((unsigned)(nxt.pm * 256 + h * 128 + Rr[i]) * 4u, P.tok, ldsb + SIDE_TOK + (unsigned)wid * 1024u + (unsigned)((h * 2 + i) * 256)); } }
        if constexpr (Epi::SIDE) { if (has_next) { PG8_TID(tl4_); E.side(nxt, ldsb + SIDE_SLOT + (unsigned)(((ui + 1) % 3) * SIDE_SLOT_BYTES), wid, tl4_ & 63); } }
        for (int t = 0; t < nt; t += 2) {
            const bool last = (t == nt - 2);
            if constexpr (Epi::KHOOK) { if (t == Epi::HOOK_T0 || t == Epi::HOOK_T1) {
                asm volatile("" ::: "memory"); PG8_TID(tlh_); const int lnh_ = tlh_ & 63; E.hook(acc, cur, t == Epi::HOOK_T0 ? 0 : 1, wr, wc, lnh_ & 15, lnh_ >> 4); asm volatile("" ::: "memory"); } }
            const char* a1 = cA + (size_t)(t + 1) * kstep;
            const char* a2 = last ? nA : cA + (size_t)(t + 2) * kstep; const char* b2 = last ? nB : cB + (size_t)(t + 2) * kstep;
            const char* a3 = a2 + kstep; const char* b3 = b2 + kstep;
            PG8_LDB(B0, 0, 0); PG8_LDB(B1, 0, 1); PG8_SCHED; PG8_LDA(At, 0, 0); PG8_STAGE(PG8_SA(1, 1), a1, offA[1]);
            PG8_WAIT_V(8); PG8_WAIT_L(0); PG8_BAR; PG8_MMA(0, 0, At, B0); PG8_MMA(0, 1, At, B1); PG8_BAR; PG8_SCHED;
            if constexpr (Prob::GATHER) { if (last && has_next) { PG8_RC(Rr, Cc); (void)Rr; PG8_TOKSLOT(tokslot); const int ntok[2][2] = {{tokslot[0], tokslot[64]}, {tokslot[128], tokslot[192]}}; P.a_off(ntok, Cc, offA); } }
            PG8_LDA(At, 0, 1); PG8_STAGE(PG8_SB(0, 0), b2, voffB); PG8_STAGE(PG8_SB(0, 1), b2 + hstep, voffB); PG8_STAGE(PG8_SA(0, 0), a2, offA[0]);
            PG8_WAIT_V(8); PG8_WAIT_L(0); PG8_BAR; PG8_MMA(1, 0, At, B0); PG8_MMA(1, 1, At, B1); PG8_BAR; PG8_SCHED;
            PG8_LDB(B0, 1, 0); PG8_LDB(B1, 1, 1); PG8_SCHED; PG8_LDA(At, 1, 0); PG8_STAGE(PG8_SA(0, 1), a2, offA[1]);
            PG8_WAIT_V(8); PG8_WAIT_L(0); PG8_BAR; PG8_MMA(0, 0, At, B0); PG8_MMA(0, 1, At, B1); PG8_BAR; PG8_SCHED;
            PG8_LDA(At, 1, 1); PG8_STAGE(PG8_SB(1, 0), b3, voffB); PG8_STAGE(PG8_SB(1, 1), b3 + hstep, voffB); PG8_STAGE(PG8_SA(1, 0), a3, offA[0]);
            PG8_WAIT_V(8); PG8_WAIT_L(0); PG8_BAR; PG8_MMA(1, 0, At, B0); PG8_MMA(1, 1, At, B1); PG8_BAR; PG8_SCHED;
        }
        if (wr == 0) PG8_BAR;
        { PG8_TID(tl3_); const int ln_ = tl3_ & 63; E(acc, cur, wr, wc, ln_ & 15, ln_ >> 4, lds + SIDE_SLOT + (ui % 3) * SIDE_SLOT_BYTES); }
        if (!has_next) break;
        bool keep = false;
        if constexpr (Epi::CHAIN) keep = E.keep(cur);
        if (!keep) {
            asm volatile("v_mov_b32 %0, 0" : "=v"(zero_));
#pragma unroll
            for (int a = 0; a < 2; ++a)
#pragma unroll
                for (int b = 0; b < 2; ++b)
#pragma unroll
                    for (int m = 0; m < 4; ++m)
#pragma unroll
                        for (int n = 0; n < 2; ++n) acc[a][b][m][n] = (f32x4){zero_, zero_, zero_, zero_};
        }
        cur = nxt; cA = nA; cB = nB; nt = P.nt(cur); ++ui;
        if (wr == 1) PG8_BAR;
    }
    PG8_WAIT_V(0);
    PG8_BAR;
#undef PG8_RC
#undef PG8_TID
#undef PG8_TOKSLOT
#undef PG8_SA
#undef PG8_SB
#undef PG8_STAGE
#undef PG8_LDA
#undef PG8_LDB
#undef PG8_MMA
#undef PG8_CAT
#undef PG8_WAIT_V
#undef PG8_WAIT_L
#undef PG8_BAR
#undef PG8_SCHED
}
}

typedef const float* cfp_t;
typedef const cfp_t __attribute__((address_space(4))) * InTab;
struct Frame {
    LAS unsigned char* lds;
    volatile LAS unsigned* MISC;
    unsigned char* ws;
    InTab in;
    float* out;
    int tid, lane, wave, G, bid;
};
enum { IN_X = 0, IN_C, IN_CTX, IN_CCTX, IN_WADA, IN_BADA, IN_WIN, IN_BIN, IN_POOLW, IN_POOLS, IN_CONVW, IN_CONVB, IN_MNG, IN_SLNG, IN_SLNB, IN_SGUW, IN_SGUB,
       IN_WBP, IN_WBM, IN_WBS, IN_WOUT, IN_LN1G, IN_LN1B, IN_WR, IN_BR, IN_WGU, IN_BGU, IN_WDN, IN_BDN, IN_LN2G, IN_LN2B };
__device__ __forceinline__ int mod_row(int row) { return row < ML ? (row >> 12) : NB; }
__device__ __forceinline__ const float* modp(const Frame& F, int l, int row, int part) { return (const float*)(F.ws + WS_MOD) + ((size_t)(l * 17 + mod_row(row)) * 6 + part) * 1024; }

__device__ __forceinline__ void transpose_item(const float* W, size_t ldw, int k0, int srccol0, bf16_t* dst, size_t ldk, int kd0, LAS float* scr, int lane) {
#pragma unroll 8
    for (int i = 0; i < 32; ++i) { const int kk = 2 * i + (lane >> 5); scr[kk * 33 + (lane & 31)] = __builtin_nontemporal_load(W + (size_t)(k0 + kk) * ldw + srccol0 + (lane & 31)); }
    LDS_WAIT(); asm volatile("" ::: "memory");
    const int c = lane & 7;
#pragma unroll
    for (int j = 0; j < 4; ++j) { const int n = (lane >> 3) + 8 * j; const LAS float* s = scr + (8 * c) * 33 + n;
        u32x4 o; o.x = pk2(s[0 * 33], s[1 * 33]); o.y = pk2(s[2 * 33], s[3 * 33]); o.z = pk2(s[4 * 33], s[5 * 33]); o.w = pk2(s[6 * 33], s[7 * 33]);
        *(u32x4*)(dst + (size_t)n * ldk + kd0 + 8 * c) = o; }
    LDS_WAIT(); asm volatile("" ::: "memory");
}
__device__ __forceinline__ void transpose_item_fp8(const float* W, size_t ldw, int k0, int srccol0, unsigned char* dst, size_t ldk, int kd0, float sc, LAS float* scr, int lane) {
#pragma unroll 8
    for (int i = 0; i < 32; ++i) { const int kk = 2 * i + (lane >> 5); scr[kk * 33 + (lane & 31)] = __builtin_nontemporal_load(W + (size_t)(k0 + kk) * ldw + srccol0 + (lane & 31)); }
    LDS_WAIT(); asm volatile("" ::: "memory");
    const int c = lane & 7;
#pragma unroll
    for (int j = 0; j < 4; ++j) { const int n = (lane >> 3) + 8 * j; const LAS float* s_ = scr + (8 * c) * 33 + n;
        u32x2 o; o.x = pk4_fp8(s_[0 * 33] * sc, s_[1 * 33] * sc, s_[2 * 33] * sc, s_[3 * 33] * sc); o.y = pk4_fp8(s_[4 * 33] * sc, s_[5 * 33] * sc, s_[6 * 33] * sc, s_[7 * 33] * sc);
        *(u32x2*)(dst + (size_t)n * ldk + kd0 + 8 * c) = o; }
    LDS_WAIT(); asm volatile("" ::: "memory");
}
__device__ __forceinline__ void phase_prologue(Frame& F) {
    LAS float* scr = (LAS float*)(F.lds + F.wave * 16384);
    const int gw = F.bid * NWAVES + F.wave, NGW = F.G * NWAVES;
    constexpr int I_IN = 16 * (NZ / 32);
    constexpr int I_BR = (4 + 8 + 4) * 32;
    constexpr int I_OUT = 16 * 32;
    constexpr int I_GU = 16 * 64;
    constexpr int I_DN = 16 * 32;
    constexpr int T_IN = DEPTH * I_IN, T_BR = DEPTH * I_BR, T_OUT = DEPTH * I_OUT, T_GU = DEPTH * NEXP * I_GU, T_DN = DEPTH * NEXP * I_DN;
    constexpr int NITEMS = T_IN + T_BR + T_OUT + T_GU + T_DN;
    for (int it = gw; it < NITEMS; it += NGW) {
        int r = it;
        if (r < T_IN) { const int l = r / I_IN; r %= I_IN; const int kb = r / (NZ / 32), nb = r % (NZ / 32); const int n0 = nb * 32, src = n0 < 2304 ? n0 : n0 + 16;
            if (n0 < NZ_BF) transpose_item(F.in[IN_WIN] + (size_t)l * D * 5904, 5904, kb * 64, src, (bf16_t*)(F.ws + WS_WIN) + ((size_t)l * NZ + n0) * D, D, kb * 64, scr, F.lane);
            else transpose_item_fp8(F.in[IN_WIN] + (size_t)l * D * 5904, 5904, kb * 64, src, (unsigned char*)(F.ws + WS_WIN8) + ((size_t)l * NZ_F8 + (n0 - NZ_BF)) * D, D, kb * 64, F8S_WGU, scr, F.lane);
            continue; }
        r -= T_IN;
        if (r < T_BR) { const int l = r / I_BR; r %= I_BR; const int kb = r / 32, nb = r % 32;
            const float* W; int ksrc;
            if (kb < 4) { W = F.in[IN_WBP] + (size_t)l * 256 * D; ksrc = kb * 64; } else if (kb < 12) { W = F.in[IN_WBM] + (size_t)l * 512 * D; ksrc = (kb - 4) * 64; } else { W = F.in[IN_WBS] + (size_t)l * 256 * D; ksrc = (kb - 12) * 64; }
            transpose_item(W, D, ksrc, nb * 32, (bf16_t*)(F.ws + WS_WBR) + ((size_t)l * D + nb * 32) * D, D, kb * 64, scr, F.lane); continue; }
        r -= T_BR;
        if (r < T_OUT) { const int l = r / I_OUT; r %= I_OUT; const int kb = r / 32, nb = r % 32;
            transpose_item(F.in[IN_WOUT] + (size_t)l * D * D, D, kb * 64, nb * 32, (bf16_t*)(F.ws + WS_WOUT) + ((size_t)l * D + nb * 32) * D, D, kb * 64, scr, F.lane); continue; }
        r -= T_OUT;
        if (r < T_GU) { const int le = r / I_GU; r %= I_GU; const int kb = r / 64, nb = r % 64; const int n0 = nb * 32;
            const int pn = n0 >> 8, c = n0 & 255; const int src = c < 128 ? (128 * pn + c) : (1024 + 128 * pn + c - 128);
            transpose_item_fp8(F.in[IN_WGU] + (size_t)le * D * 2048, 2048, kb * 64, src, (unsigned char*)(F.ws + WS_WGU) + ((size_t)le * 2048 + n0) * D, D, kb * 64, F8S_WGU, scr, F.lane); continue; }
        r -= T_GU;
        { const int le = r / I_DN; r %= I_DN; const int kb = r / 32, nb = r % 32;
            transpose_item_fp8(F.in[IN_WDN] + (size_t)le * D * D, D, kb * 64, nb * 32, (unsigned char*)(F.ws + WS_WDN) + ((size_t)le * D + nb * 32) * D, D, kb * 64, F8S_WDN, scr, F.lane); }
    }
    { const int gt = F.bid * NTHREADS + F.tid, NGT = F.G * NTHREADS;
      for (int i = gt; i < DEPTH * 16 * 1024; i += NGT) { const int l = i >> 14, g = (i >> 10) & 15, k = i & 1023; ((float*)(F.ws + WS_WG))[i] = F.in[IN_WIN][((size_t)l * D + k) * 5904 + 2304 + g]; }
      for (int i = gt; i < DEPTH * 4 * 128 * 128; i += NGT) ((bf16_t*)(F.ws + WS_WSGU))[i] = (bf16_t)f2bf(F.in[IN_SGUW][i]);
      for (int i = gt; i < DEPTH * 4 * 64 * 64; i += NGT) { const int lg = i >> 12, d = (i >> 6) & 63, c = i & 63; ((bf16_t*)(F.ws + WS_WPOOL))[i] = (bf16_t)f2bf(F.in[IN_POOLW][(size_t)lg * 4096 + c * 64 + d]); } }
    __syncthreads();
    { LAS float* sc = (LAS float*)F.lds;
      LAS float* part = (LAS float*)(F.lds + 71680);
      for (int i = F.tid; i < 17 * 1024; i += NTHREADS) { const int r = i >> 10, k = i & 1023; const float v = r < 16 ? F.in[IN_C][r * 1024 + k] : F.in[IN_CCTX][k]; sc[i] = siluf_(v); }
      __syncthreads();
      for (int u = F.bid; u < DEPTH * 48; u += F.G) {
          const int l = u / 48, n0 = (u % 48) * 128, col = F.tid & 127, ks = F.tid >> 7;
          float a[17];
#pragma unroll
          for (int r = 0; r < 17; ++r) a[r] = 0.f;
          const float* W = F.in[IN_WADA] + (size_t)l * D * 6144 + n0 + col;
          for (int k = ks * 256; k < ks * 256 + 256; ++k) { const float w = W[(size_t)k * 6144];
#pragma unroll
              for (int r = 0; r < 17; ++r) a[r] += sc[r * 1024 + k] * w; }
#pragma unroll
          for (int r = 0; r < 17; ++r) part[(ks * 17 + r) * 128 + col] = a[r];
          __syncthreads();
          for (int i = F.tid; i < 17 * 128; i += NTHREADS) { const int r = i >> 7, cc = i & 127;
              const float s = part[(0 * 17 + r) * 128 + cc] + part[(1 * 17 + r) * 128 + cc] + part[(2 * 17 + r) * 128 + cc] + part[(3 * 17 + r) * 128 + cc] + F.in[IN_BADA][l * 6144 + n0 + cc];
              ((float*)(F.ws + WS_MOD))[(size_t)(l * 17 + r) * 6144 + n0 + cc] = s; }
          __syncthreads();
      } }
}

struct RowV { f32x4 v[4]; };
#define RC(lane, j) (8 * (lane) + 512 * ((j) >> 1) + 4 * ((j) & 1))
__device__ __forceinline__ void row_load(RowV& r, const float* p, int lane) {
#pragma unroll
    for (int j = 0; j < 4; ++j) r.v[j] = __builtin_nontemporal_load((const f32x4*)(p + RC(lane, j)));
}
__device__ __forceinline__ void row_load_bf16(RowV& r, const bf16_t* p, int lane) {
#pragma unroll
    for (int h = 0; h < 2; ++h) { const u32x4 w = __builtin_nontemporal_load((const u32x4*)(p + 8 * lane + 512 * h)); r.v[2 * h] = (f32x4){bflo(w.x), bfhi(w.x), bflo(w.y), bfhi(w.y)}; r.v[2 * h + 1] = (f32x4){bflo(w.z), bfhi(w.z), bflo(w.w), bfhi(w.w)}; }
}
__device__ __forceinline__ void row_store(const RowV& r, float* p, int lane) {
#pragma unroll
    for (int j = 0; j < 4; ++j) *(f32x4*)(p + RC(lane, j)) = r.v[j];
}
__device__ __forceinline__ void row_store_nt(const RowV& r, float* p, int lane) {
#pragma unroll
    for (int j = 0; j < 4; ++j) __builtin_nontemporal_store(r.v[j], (f32x4*)(p + RC(lane, j)));
}
__device__ __forceinline__ void row_store_bf16_nt(const RowV& r, bf16_t* p, int lane) {
#pragma unroll
    for (int h = 0; h < 2; ++h) { u32x4 w; w.x = pk2(r.v[2 * h].x, r.v[2 * h].y); w.y = pk2(r.v[2 * h].z, r.v[2 * h].w); w.z = pk2(r.v[2 * h + 1].x, r.v[2 * h + 1].y); w.w = pk2(r.v[2 * h + 1].z, r.v[2 * h + 1].w); __builtin_nontemporal_store(w, (u32x4*)(p + 8 * lane + 512 * h)); }
}
__device__ __forceinline__ void row_store_bf16(const RowV& r, bf16_t* p, int lane) {
#pragma unroll
    for (int h = 0; h < 2; ++h) { u32x4 w; w.x = pk2(r.v[2 * h].x, r.v[2 * h].y); w.y = pk2(r.v[2 * h].z, r.v[2 * h].w); w.z = pk2(r.v[2 * h + 1].x, r.v[2 * h + 1].y); w.w = pk2(r.v[2 * h + 1].z, r.v[2 * h + 1].w); *(u32x4*)(p + 8 * lane + 512 * h) = w; }
}
__device__ __forceinline__ void row_ln_plain(RowV& r, int lane) {
    float s = 0.f;
#pragma unroll
    for (int j = 0; j < 4; ++j) s += (r.v[j].x + r.v[j].y) + (r.v[j].z + r.v[j].w);
    const float mean = wave_sum(s, lane) * (1.f / D); float s2 = 0.f;
#pragma unroll
    for (int j = 0; j < 4; ++j) { r.v[j] = r.v[j] - mean; s2 += (r.v[j].x * r.v[j].x + r.v[j].y * r.v[j].y) + (r.v[j].z * r.v[j].z + r.v[j].w * r.v[j].w); }
    const float rstd = 1.f / sqrtf(wave_sum(s2, lane) * (1.f / D) + LN_EPS);
#pragma unroll
    for (int j = 0; j < 4; ++j) r.v[j] = r.v[j] * rstd;
}
__device__ __forceinline__ void row_affine(RowV& r, const float* g, const float* b, int lane) {
#pragma unroll
    for (int j = 0; j < 4; ++j) { const f32x4 gg = *(const f32x4*)(g + RC(lane, j)), bb = *(const f32x4*)(b + RC(lane, j)); r.v[j] = r.v[j] * gg + bb; }
}
__device__ __forceinline__ void row_modulate(RowV& r, const float* sh, const float* sc, int lane) {
#pragma unroll
    for (int j = 0; j < 4; ++j) { const f32x4 s1 = *(const f32x4*)(sc + RC(lane, j)), s0 = *(const f32x4*)(sh + RC(lane, j)); r.v[j] = r.v[j] * (s1 + 1.0f) + s0; }
}
__device__ __forceinline__ LAS float* pv_slot(const Frame& F, int slot) { return (LAS float*)(F.lds + NW_PV) + slot * 1024; }
__device__ __forceinline__ void pv_fill(Frame& F, int slot, const float* src) { LAS f32x4* d = (LAS f32x4*)pv_slot(F, slot); for (int i = F.tid; i < 256; i += NTHREADS) d[i] = *(const f32x4*)(src + 4 * i); }
__device__ __forceinline__ void row_affine_l(RowV& r, const LAS float* g, const LAS float* b, int lane) {
#pragma unroll
    for (int j = 0; j < 4; ++j) { const f32x4 gg = *(const LAS f32x4*)(g + RC(lane, j)), bb = *(const LAS f32x4*)(b + RC(lane, j)); r.v[j] = r.v[j] * gg + bb; }
}
__device__ __forceinline__ void row_modulate_l(RowV& r, const LAS float* sh, const LAS float* sc, int lane) {
#pragma unroll
    for (int j = 0; j < 4; ++j) { const f32x4 s1 = *(const LAS f32x4*)(sc + RC(lane, j)), s0 = *(const LAS f32x4*)(sh + RC(lane, j)); r.v[j] = r.v[j] * (s1 + 1.0f) + s0; }
}
__device__ __forceinline__ void ln0_row(Frame& F, int row, RowV xr, const LAS float* sh, const LAS float* sc) {
    row_ln_plain(xr, F.lane);
    row_modulate_l(xr, sh, sc, F.lane);
    row_store_bf16(xr, (bf16_t*)(F.ws + WS_H) + (size_t)row * D, F.lane);
    { unsigned char* h8 = (unsigned char*)(F.ws + WS_H8) + (size_t)row * D + 8 * F.lane;
#pragma unroll
      for (int h = 0; h < 2; ++h) { u32x2 w; w.x = pk4_fp8(xr.v[2 * h].x * F8S_ACT, xr.v[2 * h].y * F8S_ACT, xr.v[2 * h].z * F8S_ACT, xr.v[2 * h].w * F8S_ACT); w.y = pk4_fp8(xr.v[2 * h + 1].x * F8S_ACT, xr.v[2 * h + 1].y * F8S_ACT, xr.v[2 * h + 1].z * F8S_ACT, xr.v[2 * h + 1].w * F8S_ACT); *(u32x2*)(h8 + 512 * h) = w; } }
}
__device__ __forceinline__ LAS float* narrow_tile_wave(Frame& F, const bf16_t* A) {
    const int r = F.lane & 31, h = F.lane >> 5;
    f32x16 acc;
#pragma unroll
    for (int i = 0; i < 16; ++i) acc[i] = 0.f;
    const bf16_t* ap = A + (size_t)r * D + 8 * h;
    const LAS unsigned char* bp = F.lds + NW_WT + r * 2064 + 16 * h;
    bf16x8 av[2][16];
#pragma unroll
    for (int ks = 0; ks < 16; ++ks) av[0][ks] = *(const bf16x8*)(ap + ks * 16);
#pragma unroll
    for (int kb = 0; kb < 4; ++kb) {
        if (kb < 3) {
#pragma unroll
            for (int ks = 0; ks < 16; ++ks) av[(kb + 1) & 1][ks] = *(const bf16x8*)(ap + ((kb + 1) * 16 + ks) * 16); }
        __builtin_amdgcn_sched_barrier(0);
#pragma unroll
        for (int ks = 0; ks < 16; ++ks) { const bf16x8 b = *(const LAS bf16x8*)(bp + (kb * 16 + ks) * 32); acc = __builtin_amdgcn_mfma_f32_32x32x16_bf16(av[kb & 1][ks], b, acc, 0, 0, 0); }
        __builtin_amdgcn_sched_barrier(0);
    }
    LAS float* lg = (LAS float*)(F.lds + NW_LG) + F.wave * 1056;
#pragma unroll
    for (int i = 0; i < 16; ++i) lg[((i & 3) + 8 * (i >> 2) + 4 * h) * 33 + r] = acc[i];
    asm volatile("s_waitcnt lgkmcnt(0)" ::: "memory");
    return lg;
}
__device__ __forceinline__ void tile_range(const Frame& F, int mrows, int& t_lo, int& t_hi) { const int nt = mrows / 32; t_lo = (int)(((long)F.bid * nt) / F.G); t_hi = (int)(((long)(F.bid + 1) * nt) / F.G); }
__device__ __forceinline__ void load_wg_lds(Frame& F, int l) {
    const float* src = (const float*)(F.ws + WS_WG) + (size_t)l * 16384;
    for (int i = F.tid; i < 32 * 128; i += NTHREADS) { const int g = i >> 7, c8 = i & 127; u32x4 w = (u32x4){0u, 0u, 0u, 0u};
        if (g < 16) { const f32x4 a = *(const f32x4*)(src + g * 1024 + c8 * 8), b = *(const f32x4*)(src + g * 1024 + c8 * 8 + 4); w.x = pk2(a.x, a.y); w.y = pk2(a.z, a.w); w.z = pk2(b.x, b.y); w.w = pk2(b.z, b.w); }
        *(LAS u32x4*)(F.lds + NW_WT + g * 2064 + c8 * 16) = w; }
    __syncthreads();
}
__device__ __forceinline__ void gates_tail(Frame& F, int l, int t_lo, int t_hi) {
    asm volatile("s_waitcnt vmcnt(0)" ::: "memory"); __syncthreads();
    const int g = F.lane & 15; const float bias = F.in[IN_BIN][l * 5904 + 2304 + g];
    for (int tile = t_lo + F.wave; tile < t_hi; tile += NWAVES) {
        const LAS float* lg = narrow_tile_wave(F, (const bf16_t*)(F.ws + WS_H) + (size_t)tile * 32 * D);
#pragma unroll
        for (int rr = 0; rr < 8; ++rr) { const int row = rr * 4 + (F.lane >> 4); ((float*)(F.ws + WS_ZG))[(size_t)(tile * 32 + row) * 16 + g] = lg[row * 33 + g] + bias; }
        asm volatile("s_waitcnt lgkmcnt(0)" ::: "memory");
    }
}

using pg8::Unit;
struct ProbPlain {
    static constexpr bool GATHER = false, FP8 = false; static constexpr int SCALE_A = 127, SCALE_B = 127; const bf16_t* A; const bf16_t* Bt; int lda, ldb;
    __device__ __forceinline__ int nt(const Unit&) const { return lda / 64; }
    __device__ __forceinline__ const char* a_base(const Unit& u) const { return (const char*)A + (size_t)u.pm * 256 * lda * 2; }
    __device__ __forceinline__ const char* b_base(const Unit& u) const { return (const char*)Bt + (size_t)u.pn * 256 * ldb * 2; }
    __device__ __forceinline__ void a_tok(const Unit&, const int (&)[2], int (&)[2][2]) const {}
    __device__ __forceinline__ void a_off(const int (&)[2][2], const int (&)[2], unsigned (&)[2][2]) const {}
    __device__ __forceinline__ void a_rows(const Unit&, const int (&)[2], const int (&)[2], unsigned (&)[2][2]) const {}
};
struct ProbPlainF8 {
    static constexpr bool GATHER = false, FP8 = true; static constexpr int SCALE_A = F8E_ACT, SCALE_B = F8E_WGU; const bf16_t* A; const bf16_t* Bt; int lda, ldb;
    __device__ __forceinline__ int nt(const Unit&) const { return lda / 64; }
    __device__ __forceinline__ const char* a_base(const Unit& u) const { return (const char*)A + (size_t)u.pm * 256 * lda * 2; }
    __device__ __forceinline__ const char* b_base(const Unit& u) const { return (const char*)Bt + (size_t)u.pn * 256 * ldb * 2; }
    __device__ __forceinline__ void a_tok(const Unit&, const int (&)[2], int (&)[2][2]) const {}
    __device__ __forceinline__ void a_off(const int (&)[2][2], const int (&)[2], unsigned (&)[2][2]) const {}
    __device__ __forceinline__ void a_rows(const Unit&, const int (&)[2], const int (&)[2], unsigned (&)[2][2]) const {}
};
struct ProbBranch {
    static constexpr bool GATHER = false, FP8 = false; static constexpr int SCALE_A = 127, SCALE_B = 127; const bf16_t* A; const bf16_t* Bt; int lda, ldb;
    __device__ __forceinline__ int nt(const Unit& u) const { return u.sub == 1 ? 8 : 4; }
    __device__ __forceinline__ int koff(const Unit& u) const { return u.sub == 0 ? 0 : (u.sub == 1 ? 256 : 768); }
    __device__ __forceinline__ const char* a_base(const Unit& u) const { return (const char*)A + ((size_t)u.pm * 256 * lda + koff(u)) * 2; }
    __device__ __forceinline__ const char* b_base(const Unit& u) const { return (const char*)Bt + ((size_t)u.pn * 256 * ldb + koff(u)) * 2; }
    __device__ __forceinline__ void a_tok(const Unit&, const int (&)[2], int (&)[2][2]) const {}
    __device__ __forceinline__ void a_off(const int (&)[2][2], const int (&)[2], unsigned (&)[2][2]) const {}
    __device__ __forceinline__ void a_rows(const Unit&, const int (&)[2], const int (&)[2], unsigned (&)[2][2]) const {}
};
__device__ __forceinline__ int expert_of(const LAS int* seg, int pm) { return __builtin_amdgcn_readfirstlane((int)((const LAS unsigned char*)(seg + 64))[pm]); }
__device__ __forceinline__ int moe_tables(Frame& F, LAS int* seg) {
    __syncthreads();
    if (F.tid <= NEXP) seg[F.tid] = ((const int*)(F.ws + WS_ROUTE + RT_SEG))[F.tid];
    __syncthreads();
    const int ntile = seg[NEXP] / 256;
    LAS unsigned char* texp = (LAS unsigned char*)(seg + 64);
    for (int t = F.tid; t < ntile; t += NTHREADS) { const int row = t * 256; int e = 0;
#pragma unroll
        for (int i = 1; i < NEXP; ++i) e += (seg[i] <= row) ? 1 : 0;
        texp[t] = (unsigned char)e; }
    __syncthreads();
    return ntile;
}
struct ProbMoe1 {
    static constexpr bool GATHER = true, FP8 = true; static constexpr int SCALE_A = F8E_ACT, SCALE_B = F8E_WGU; const bf16_t* A; const bf16_t* Bt; int lda, ldb; const int* tok; const LAS int* seg;
    __device__ __forceinline__ int nt(const Unit&) const { return lda / 64; }
    __device__ __forceinline__ const char* a_base(const Unit&) const { return (const char*)A; }
    __device__ __forceinline__ const char* b_base(const Unit& u) const { const int e = expert_of(seg, u.pm); return (const char*)Bt + ((size_t)e * 2048 + (size_t)u.pn * 256) * ldb * 2; }
    __device__ __forceinline__ void a_rows(const Unit& u, const int (&R)[2], const int (&C)[2], unsigned (&off)[2][2]) const {
#pragma unroll
        for (int h = 0; h < 2; ++h)
#pragma unroll
            for (int i = 0; i < 2; ++i) { const int t = tok[u.pm * 256 + h * 128 + R[i]]; off[h][i] = (unsigned)(t * lda + C[i]) * 2u; } }
    __device__ __forceinline__ void a_tok(const Unit& u, const int (&R)[2], int (&tk)[2][2]) const {
#pragma unroll
        for (int h = 0; h < 2; ++h)
#pragma unroll
            for (int i = 0; i < 2; ++i) tk[h][i] = tok[u.pm * 256 + h * 128 + R[i]]; }
    __device__ __forceinline__ void a_off(const int (&tk)[2][2], const int (&C)[2], unsigned (&off)[2][2]) const {
#pragma unroll
        for (int h = 0; h < 2; ++h)
#pragma unroll
            for (int i = 0; i < 2; ++i) off[h][i] = (unsigned)(tk[h][i] * lda + C[i]) * 2u; }
};
struct ProbMoe2 {
    static constexpr bool GATHER = false, FP8 = true; static constexpr int SCALE_A = F8E_ACT, SCALE_B = F8E_WDN; const bf16_t* A; const bf16_t* Bt; int lda, ldb; const LAS int* seg;
    __device__ __forceinline__ int nt(const Unit&) const { return lda / 64; }
    __device__ __forceinline__ const char* a_base(const Unit& u) const { return (const char*)A + (size_t)u.pm * 256 * lda * 2; }
    __device__ __forceinline__ const char* b_base(const Unit& u) const { const int e = expert_of(seg, u.pm); return (const char*)Bt + ((size_t)e * 1024 + (size_t)u.pn * 256) * ldb * 2; }
    __device__ __forceinline__ void a_tok(const Unit&, const int (&)[2], int (&)[2][2]) const {}
    __device__ __forceinline__ void a_off(const int (&)[2][2], const int (&)[2], unsigned (&)[2][2]) const {}
    __device__ __forceinline__ void a_rows(const Unit&, const int (&)[2], const int (&)[2], unsigned (&)[2][2]) const {}
};
using pg8::cvt_pk_bf16;
template <bool G8> struct EpiInproj {
    static constexpr bool PERM = true, CHAIN = false, SIDE = true, KHOOK = false; bf16_t* Z; const float* bias; int pn0;
    __device__ __forceinline__ void side(const Unit& u0, unsigned slot, int wid, int lane) const { const int pn = u0.pn + pn0; if (wid == 1) pg8::dma16((unsigned)lane * 16u, bias + pn * 256 + (pn >= 9 ? 16 : 0), slot); }
    __device__ __forceinline__ void operator()(const f32x4 (&acc)[2][2][4][2], const Unit& u0, int wr, int wc, int fr, int fq, const LAS unsigned char* sd) const {
        Unit u = u0; u.pn += pn0;
        int row0 = u.pm * 256 + wr * 64 + fr, col0 = u.pn * 256 + wc * 32 + 8 * fq; asm volatile("" : "+v"(row0), "+v"(col0));
        const int act = (u.pn <= 6) ? 0 : ((u.pn == 9 || u.pn == 10) ? 2 : 1);
        f32x4 bv[2][2];
#pragma unroll
        for (int bj = 0; bj < 2; ++bj)
#pragma unroll
            for (int n = 0; n < 2; ++n) bv[bj][n] = *(const LAS f32x4*)(sd + (bj * 128 + wc * 32 + 8 * fq + 4 * n) * 4);
#pragma unroll
        for (int ai = 0; ai < 2; ++ai)
#pragma unroll
            for (int m = 0; m < 4; ++m) { bf16_t* rowp = Z + (size_t)(row0 + ai * 128 + m * 16) * NZ + col0;
#pragma unroll
                for (int bj = 0; bj < 2; ++bj) { f32x4 v0 = acc[ai][bj][m][0] + bv[bj][0], v1 = acc[ai][bj][m][1] + bv[bj][1];
                    if (G8 && u.pn >= ZG_COL / 256) { u32x2 w8;
                        v0 = sigmoid4(v0) * G8_SCALE; v1 = sigmoid4(v1) * G8_SCALE;
#pragma unroll
                        for (int j = 0; j < 4; ++j) { v0[j] = fmaxf(v0[j], 1.0f); v1[j] = fmaxf(v1[j], 1.0f); }
                        v0 = v0 + 12582912.0f; v1 = v1 + 12582912.0f;
                        w8.x = pk4_u8(v0[0], v0[1], v0[2], v0[3]); w8.y = pk4_u8(v1[0], v1[1], v1[2], v1[3]);
                        *(u32x2*)((unsigned char*)(Z + (size_t)(row0 + ai * 128 + m * 16) * NZ + ZG_COL) + (col0 - ZG_COL) + bj * 128) = w8; continue; }
                    if (act == 2) { f32x2 a = pg8::gelu_pk((f32x2){v0[0], v0[1]}), b = pg8::gelu_pk((f32x2){v0[2], v0[3]}), c = pg8::gelu_pk((f32x2){v1[0], v1[1]}), d = pg8::gelu_pk((f32x2){v1[2], v1[3]});
                        v0 = (f32x4){a.x, a.y, b.x, b.y}; v1 = (f32x4){c.x, c.y, d.x, d.y}; }
                    if (act == 1) { v0 = sigmoid4(v0); v1 = sigmoid4(v1); }
                    u32x4 w; w.x = cvt_pk_bf16(v0[0], v0[1]); w.y = cvt_pk_bf16(v0[2], v0[3]); w.z = cvt_pk_bf16(v1[0], v1[1]); w.w = cvt_pk_bf16(v1[2], v1[3]);
                    *(u32x4*)(rowp + bj * 128) = w; }
                if constexpr (G8) asm volatile("" ::: "memory"); }
    }
};
struct EpiNull {
    static constexpr bool PERM = true, CHAIN = false; bf16_t* Z;
    __device__ __forceinline__ void operator()(const f32x4 (&acc)[2][2][4][2], const Unit& u, int wr, int wc, int fr, int fq) const {
        float sacc = 0.f;
#pragma unroll
        for (int ai = 0; ai < 2; ++ai)
#pragma unroll
            for (int bj = 0; bj < 2; ++bj)
#pragma unroll
                for (int m = 0; m < 4; ++m)
#pragma unroll
                    for (int n = 0; n < 2; ++n) sacc += (acc[ai][bj][m][n][0] + acc[ai][bj][m][n][1]) + (acc[ai][bj][m][n][2] + acc[ai][bj][m][n][3]);
        if (sacc == 1.2345e30f) Z[u.pm + wr + wc + fr + fq] = 0;
    }
};
struct EpiOut {
    static constexpr bool PERM = true, CHAIN = false, SIDE = false, KHOOK = false; bf16_t* T;
    __device__ __forceinline__ void operator()(const f32x4 (&acc)[2][2][4][2], const Unit& u, int wr, int wc, int fr, int fq, const LAS unsigned char*) const {
        int row0 = u.pm * 256 + wr * 64 + fr, col0 = u.pn * 256 + wc * 32 + 8 * fq; asm volatile("" : "+v"(row0), "+v"(col0));
#pragma unroll
        for (int ai = 0; ai < 2; ++ai)
#pragma unroll
            for (int m = 0; m < 4; ++m) { bf16_t* rowp = T + (size_t)(row0 + ai * 128 + m * 16) * D + col0;
#pragma unroll
                for (int bj = 0; bj < 2; ++bj) { const f32x4 v0 = acc[ai][bj][m][0], v1 = acc[ai][bj][m][1];
                    u32x4 w; w.x = cvt_pk_bf16(v0[0], v0[1]); w.y = cvt_pk_bf16(v0[2], v0[3]); w.z = cvt_pk_bf16(v1[0], v1[1]); w.w = cvt_pk_bf16(v1[2], v1[3]);
                    *(u32x4*)(rowp + bj * 128) = w; } }
    }
};
struct EpiBranch {
    static constexpr bool PERM = true, CHAIN = false, SIDE = false, KHOOK = true; static constexpr int HOOK_T0 = 4, HOOK_T1 = 12;
    const bf16_t* Z; bf16_t* Y;
    template <bool FIN> __device__ __forceinline__ void apply(f32x4 (&acc)[2][2][4][2], const Unit& u, int br, int wr, int wc, int fr, int fq) const {
        int row0 = u.pm * 256 + wr * 64 + fr, col0 = u.pn * 256 + wc * 32 + 8 * fq;
        asm volatile("" : "+v"(row0), "+v"(col0));
#pragma unroll
        for (int ai = 0; ai < 2; ++ai) {
            u32x2 ga[4][2], gb[4][2];
#pragma unroll
            for (int m = 0; m < 4; ++m) { const unsigned char* rowp = (const unsigned char*)(Z + (size_t)(row0 + ai * 128 + m * 16) * NZ + ZG_COL) + br * 1024 + col0;
#pragma unroll
                for (int bj = 0; bj < 2; ++bj) { ga[m][bj] = *(const u32x2*)(rowp + bj * 128); if (!FIN) gb[m][bj] = *(const u32x2*)(rowp + 1024 + bj * 128); } }
#pragma unroll
            for (int m = 0; m < 4; ++m) { const size_t row = (size_t)(row0 + ai * 128 + m * 16);
#pragma unroll
                for (int bj = 0; bj < 2; ++bj) { const u32x2 a = ga[m][bj];
                    f32x4 r0 = u8x4_f32(a.x), r1 = u8x4_f32(a.y);
                    if (FIN) { r0 = r0 * (1.0f / G8_SCALE); r1 = r1 * (1.0f / G8_SCALE); }
                    else { const u32x2 b = gb[m][bj]; f32x4 q0 = u8x4_f32(b.x), q1 = u8x4_f32(b.y);
#pragma unroll
                        for (int i = 0; i < 4; ++i) { q0[i] = __builtin_amdgcn_rcpf(q0[i]); q1[i] = __builtin_amdgcn_rcpf(q1[i]); }
                        r0 = r0 * q0; r1 = r1 * q1; }
                    acc[ai][bj][m][0] = acc[ai][bj][m][0] * r0; acc[ai][bj][m][1] = acc[ai][bj][m][1] * r1;
                    if (FIN) { const f32x4 v0 = acc[ai][bj][m][0], v1 = acc[ai][bj][m][1];
                        u32x4 w; w.x = cvt_pk_bf16(v0[0], v0[1]); w.y = cvt_pk_bf16(v0[2], v0[3]); w.z = cvt_pk_bf16(v1[0], v1[1]); w.w = cvt_pk_bf16(v1[2], v1[3]);
                        *(u32x4*)(Y + row * D + col0 + bj * 128) = w; } } }
            asm volatile("" ::: "memory"); }
    }
    __device__ __forceinline__ void hook(f32x4 (&acc)[2][2][4][2], const Unit& u, int br, int wr, int wc, int fr, int fq) const { apply<false>(acc, u, br, wr, wc, fr, fq); }
    __device__ __forceinline__ void operator()(f32x4 (&acc)[2][2][4][2], const Unit& u, int wr, int wc, int fr, int fq, const LAS unsigned char*) const { apply<true>(acc, u, 2, wr, wc, fr, fq); }
};
struct EpiSwiglu {
    static constexpr bool PERM = true, CHAIN = false, SIDE = true, KHOOK = false; unsigned char* HID; const float* bgu; const LAS int* seg;
    __device__ __forceinline__ void side(const Unit& u, unsigned slot, int wid, int lane) const {
        if (wid == 1) { const int e = expert_of(seg, u.pm); pg8::dma16(lane < 32 ? (unsigned)lane * 16u : 4096u + (unsigned)(lane - 32) * 16u, bgu + (size_t)e * 2048 + u.pn * 128, slot); } }
    __device__ __forceinline__ void operator()(const f32x4 (&acc)[2][2][4][2], const Unit& u, int wr, int wc, int fr, int fq, const LAS unsigned char* sd) const {
        int j0 = u.pn * 128 + wc * 32 + 8 * fq, slot0 = u.pm * 256 + wr * 64 + fr; asm volatile("" : "+v"(j0), "+v"(slot0));
        f32x4 bg[2], bu[2];
#pragma unroll
        for (int n = 0; n < 2; ++n) { bg[n] = *(const LAS f32x4*)(sd + (wc * 32 + 8 * fq + 4 * n) * 4); bu[n] = *(const LAS f32x4*)(sd + (128 + wc * 32 + 8 * fq + 4 * n) * 4); }
#pragma unroll
        for (int ai = 0; ai < 2; ++ai)
#pragma unroll
            for (int m = 0; m < 4; ++m) { const size_t slot = (size_t)(slot0 + ai * 128 + m * 16); f32x4 o[2];
#pragma unroll
                for (int n = 0; n < 2; ++n) { f32x4 g = acc[ai][0][m][n] + bg[n], up = acc[ai][1][m][n] + bu[n];
#pragma unroll
                    for (int i = 0; i < 4; ++i) { g[i] = fminf(g[i], 7.0f); up[i] = __builtin_amdgcn_fmed3f(up[i], -7.0f, 7.0f); }
                    f32x4 t = g * (-1.702f * 1.4426950408889634f);
#pragma unroll
                    for (int i = 0; i < 4; ++i) t[i] = __builtin_amdgcn_exp2f(t[i]);
                    t = t + 1.0f;
#pragma unroll
                    for (int i = 0; i < 4; ++i) t[i] = __builtin_amdgcn_rcpf(t[i]);
                    o[n] = (up * F8S_ACT + F8S_ACT) * (g * t); }
                u32x2 w; w.x = pk4_fp8(o[0][0], o[0][1], o[0][2], o[0][3]); w.y = pk4_fp8(o[1][0], o[1][1], o[1][2], o[1][3]);
                *(u32x2*)(HID + slot * 1024 + j0) = w; }
    }
};
struct EpiDown {
    static constexpr bool PERM = true, CHAIN = false, SIDE = true, KHOOK = false; unsigned char* FS; const float* bdn; const int* dest; const float* pslot; const LAS int* seg;
    __device__ __forceinline__ void side(const Unit& u, unsigned slot, int wid, int lane) const {
        if (wid == 1) { const int e = expert_of(seg, u.pm); pg8::dma16((unsigned)lane * 16u, bdn + (size_t)e * 1024 + u.pn * 256, slot); }
        if (wid == 2) pg8::dma16((unsigned)lane * 16u, dest + (size_t)u.pm * 256, slot + 1024u);
        if (wid == 3) pg8::dma16((unsigned)lane * 16u, pslot + (size_t)u.pm * 256, slot + 2048u); }
    __device__ __forceinline__ void operator()(const f32x4 (&acc)[2][2][4][2], const Unit& u, int wr, int wc, int fr, int fq, const LAS unsigned char* sd) const {
        int col0 = u.pn * 256 + wc * 32 + 8 * fq, slot0 = u.pm * 256 + wr * 64 + fr; asm volatile("" : "+v"(col0), "+v"(slot0));
        f32x4 bv[2][2];
#pragma unroll
        for (int bj = 0; bj < 2; ++bj)
#pragma unroll
            for (int n = 0; n < 2; ++n) bv[bj][n] = *(const LAS f32x4*)(sd + (bj * 128 + wc * 32 + 8 * fq + 4 * n) * 4);
#pragma unroll
        for (int ai = 0; ai < 2; ++ai)
#pragma unroll
            for (int m = 0; m < 4; ++m) { const int rt = ai * 128 + wr * 64 + m * 16 + fr; const int d = *(const LAS int*)(sd + 1024 + rt * 4); const float p = *(const LAS float*)(sd + 2048 + rt * 4) * FS_SCALE;
                if (d >= 0) {
#pragma unroll
                    for (int bj = 0; bj < 2; ++bj) { f32x4 v0 = (acc[ai][bj][m][0] + bv[bj][0]) * p, v1 = (acc[ai][bj][m][1] + bv[bj][1]) * p;
#pragma unroll
                        for (int i = 0; i < 4; ++i) { v0[i] = __builtin_amdgcn_fmed3f(v0[i], -FS_CLAMP, FS_CLAMP); v1[i] = __builtin_amdgcn_fmed3f(v1[i], -FS_CLAMP, FS_CLAMP); }
                        u32x2 w; w.x = pk4_fp8(v0[0], v0[1], v0[2], v0[3]); w.y = pk4_fp8(v1[0], v1[1], v1[2], v1[3]);
                        *(u32x2*)(FS + (size_t)d * 1024 + col0 + bj * 128) = w; } }
                asm volatile("" ::: "memory"); }
    }
};

__device__ __forceinline__ const float* xin_row(const Frame& F, int row) { return row < ML ? F.in[IN_X] + (size_t)row * D : F.in[IN_CTX] + (size_t)(row - ML) * D; }
__device__ __forceinline__ void phase_ln0_first(Frame& F) {
    int t_lo, t_hi; tile_range(F, MT, t_lo, t_hi);
    const int r_lo = 32 * t_lo, nrows = 32 * (t_hi - t_lo);
    const int mrA = mod_row(r_lo), mrB = mod_row(r_lo + (nrows > 0 ? nrows - 1 : 0));
    { const float* mb = (const float*)(F.ws + WS_MOD); pv_fill(F, 0, mb + ((size_t)(0 * 17 + mrA) * 6 + 0) * 1024); pv_fill(F, 1, mb + ((size_t)(0 * 17 + mrB) * 6 + 0) * 1024);
      pv_fill(F, 2, mb + ((size_t)(0 * 17 + mrA) * 6 + 1) * 1024); pv_fill(F, 3, mb + ((size_t)(0 * 17 + mrB) * 6 + 1) * 1024); }
    load_wg_lds(F, 0);
    for (int n = F.wave; n < nrows; n += 4 * NWAVES) {
        RowV rv[4];
#pragma unroll
        for (int u = 0; u < 4; ++u) if (n + u * NWAVES < nrows) row_load(rv[u], xin_row(F, r_lo + n + u * NWAVES), F.lane);
#pragma unroll
        for (int u = 0; u < 4; ++u) if (n + u * NWAVES < nrows) { const int row = r_lo + n + u * NWAVES;
            const int sel = (mod_row(row) == mrA) ? 0 : 1; ln0_row(F, row, rv[u], pv_slot(F, 0 + sel), pv_slot(F, 2 + sel)); }
    }
    gates_tail(F, 0, t_lo, t_hi);
    __syncthreads();
}
__device__ __forceinline__ void phase_finalize(Frame& F, int l, int mrows) {
    const int gw = F.bid * NWAVES + F.wave, NGW = F.G * NWAVES;
    const bf16_t* hf = (const bf16_t*)(F.ws + WS_HFB); const bf16_t* hb = hf + (size_t)MT * 512;
    const float* ng = F.in[IN_MNG] + l * 512 + 8 * F.lane;
    const f32x4 g0 = *(const f32x4*)ng, g1 = *(const f32x4*)(ng + 4);
    const bf16_t* zo = (const bf16_t*)(F.ws + WS_Z) + ZC_O + 8 * F.lane;
    u32x4 ha = (u32x4){0u, 0u, 0u, 0u}, hbv = ha, so = ha;
    if (gw < mrows) { ha = __builtin_nontemporal_load((const u32x4*)(hf + (size_t)gw * 512 + 8 * F.lane)); hbv = __builtin_nontemporal_load((const u32x4*)(hb + (size_t)gw * 512 + 8 * F.lane)); so = __builtin_nontemporal_load((const u32x4*)(zo + (size_t)gw * NZ)); }
    for (int row = gw; row < mrows; row += NGW) {
        u32x4 han = ha, hbn = hbv, son = so; const int rn = row + NGW;
        if (rn < mrows) { han = __builtin_nontemporal_load((const u32x4*)(hf + (size_t)rn * 512 + 8 * F.lane)); hbn = __builtin_nontemporal_load((const u32x4*)(hb + (size_t)rn * 512 + 8 * F.lane)); son = __builtin_nontemporal_load((const u32x4*)(zo + (size_t)rn * NZ)); }
        __builtin_amdgcn_sched_barrier(0);
        f32x4 v0 = (f32x4){bflo(ha.x) + bflo(hbv.x), bfhi(ha.x) + bfhi(hbv.x), bflo(ha.y) + bflo(hbv.y), bfhi(ha.y) + bfhi(hbv.y)}, v1 = (f32x4){bflo(ha.z) + bflo(hbv.z), bfhi(ha.z) + bfhi(hbv.z), bflo(ha.w) + bflo(hbv.w), bfhi(ha.w) + bfhi(hbv.w)};
        float s = (v0.x + v0.y) + (v0.z + v0.w) + (v1.x + v1.y) + (v1.z + v1.w);
#pragma unroll
        for (int o = 1; o < 16; o <<= 1) s += shx(s, o, F.lane);
        const float mu = s * (1.f / 128.f); v0 = v0 - mu; v1 = v1 - mu;
        float q = (v0.x * v0.x + v0.y * v0.y) + (v0.z * v0.z + v0.w * v0.w) + (v1.x * v1.x + v1.y * v1.y) + (v1.z * v1.z + v1.w * v1.w);
#pragma unroll
        for (int o = 1; o < 16; o <<= 1) q += shx(q, o, F.lane);
        const float rstd = 1.f / sqrtf(q * (1.f / 128.f) + HEAD_EPS);
        v0 = v0 * rstd * g0; v1 = v1 * rstd * g1;
        u32x4 w; w.x = pk2(v0.x * bflo(so.x), v0.y * bfhi(so.x)); w.y = pk2(v0.z * bflo(so.y), v0.w * bfhi(so.y)); w.z = pk2(v1.x * bflo(so.z), v1.y * bfhi(so.z)); w.w = pk2(v1.z * bflo(so.w), v1.w * bfhi(so.w));
        *(u32x4*)((bf16_t*)(F.ws + WS_BRA) + (size_t)row * D + 256 + 8 * F.lane) = w;
        ha = han; hbv = hbn; so = son;
    }
}
__device__ __forceinline__ void phase_ln1_router(Frame& F, int l, int mrows) {
    LAS int* cnt = (LAS int*)(F.lds + NW_END);
    { const float* wr = F.in[IN_WR] + (size_t)l * D * NEXP;
      for (int i = F.tid; i < NEXP * D; i += NTHREADS) { const int k = i >> 5, e = i & 31; *(LAS bf16_t*)(F.lds + NW_WT + e * 2064 + k * 2) = (bf16_t)f2bf(wr[i]); }
      if (F.tid < NEXP) cnt[F.tid] = 0; }
    const float* brt = F.in[IN_BR] + l * NEXP;
    int t_lo, t_hi; tile_range(F, mrows, t_lo, t_hi);
    const int r_lo = 32 * t_lo, nrows = 32 * (t_hi - t_lo);
    const int mrA = mod_row(r_lo), mrB = mod_row(r_lo + (nrows > 0 ? nrows - 1 : 0));
    { const float* mb = (const float*)(F.ws + WS_MOD); pv_fill(F, 0, F.in[IN_LN1G] + l * D); pv_fill(F, 1, F.in[IN_LN1B] + l * D);
      pv_fill(F, 2, mb + ((size_t)(l * 17 + mrA) * 6 + 2) * 1024); pv_fill(F, 3, mb + ((size_t)(l * 17 + mrB) * 6 + 2) * 1024);
      pv_fill(F, 4, mb + ((size_t)(l * 17 + mrA) * 6 + 3) * 1024); pv_fill(F, 5, mb + ((size_t)(l * 17 + mrB) * 6 + 3) * 1024);
      pv_fill(F, 6, mb + ((size_t)(l * 17 + mrA) * 6 + 4) * 1024); pv_fill(F, 7, mb + ((size_t)(l * 17 + mrB) * 6 + 4) * 1024); }
    __syncthreads();
    { const bf16_t* yb = (const bf16_t*)(F.ws + WS_T) + 8 * F.lane;
      RowV rv[2]; u32x4 yv2[2][2];
#pragma unroll
      for (int u = 0; u < 2; ++u) {
#pragma unroll
          for (int j = 0; j < 4; ++j) rv[u].v[j] = (f32x4){0.f, 0.f, 0.f, 0.f};
          yv2[u][0] = yv2[u][1] = (u32x4){0u, 0u, 0u, 0u}; }
#define RT_LOADPAIR(n_, rv_, yv_) do { _Pragma("unroll") for (int u = 0; u < 2; ++u) if ((n_) + u * NWAVES < nrows) { const int row = r_lo + (n_) + u * NWAVES; \
              if (l == 0) row_load(rv_[u], xin_row(F, row), F.lane); else row_load_bf16(rv_[u], (const bf16_t*)(F.ws + WS_X) + (size_t)row * D, F.lane); \
              _Pragma("unroll") for (int h = 0; h < 2; ++h) yv_[u][h] = __builtin_nontemporal_load((const u32x4*)(yb + (size_t)row * D + 512 * h)); } } while (0)
      RT_LOADPAIR(F.wave, rv, yv2);
      for (int n = F.wave; n < nrows; n += 2 * NWAVES) {
          RowV rvn[2]; u32x4 yvn[2][2];
#pragma unroll
          for (int u = 0; u < 2; ++u) { rvn[u] = rv[u]; yvn[u][0] = yv2[u][0]; yvn[u][1] = yv2[u][1]; }
          RT_LOADPAIR(n + 2 * NWAVES, rvn, yvn);
          __builtin_amdgcn_sched_barrier(0);
#pragma unroll
          for (int u = 0; u < 2; ++u) if (n + u * NWAVES < nrows) { const int row = r_lo + n + u * NWAVES; RowV cur = rv[u];
              const int sel = (mod_row(row) == mrA) ? 0 : 1;
              { const LAS float* g1 = pv_slot(F, 2 + sel);
#pragma unroll
                for (int j = 0; j < 4; ++j) { const f32x4 gg = *(const LAS f32x4*)(g1 + RC(F.lane, j)); const u32x4 yw = yv2[u][j >> 1]; const f32x4 yv = (j & 1) ? (f32x4){bflo(yw.z), bfhi(yw.z), bflo(yw.w), bfhi(yw.w)} : (f32x4){bflo(yw.x), bfhi(yw.x), bflo(yw.y), bfhi(yw.y)}; cur.v[j] = cur.v[j] * DN_ALPHA + gg * yv; } }
              row_ln_plain(cur, F.lane); row_affine_l(cur, pv_slot(F, 0), pv_slot(F, 1), F.lane);
              row_store_bf16_nt(cur, (bf16_t*)(F.ws + WS_X) + (size_t)row * D, F.lane);
              row_ln_plain(cur, F.lane); row_modulate_l(cur, pv_slot(F, 4 + sel), pv_slot(F, 6 + sel), F.lane);
              row_store_bf16(cur, (bf16_t*)(F.ws + WS_H2) + (size_t)row * D, F.lane);
              { unsigned char* h8 = (unsigned char*)(F.ws + WS_H2F8) + (size_t)row * D + 8 * F.lane;
#pragma unroll
                for (int h = 0; h < 2; ++h) { u32x2 w; w.x = pk4_fp8(cur.v[2 * h].x * F8S_ACT, cur.v[2 * h].y * F8S_ACT, cur.v[2 * h].z * F8S_ACT, cur.v[2 * h].w * F8S_ACT); w.y = pk4_fp8(cur.v[2 * h + 1].x * F8S_ACT, cur.v[2 * h + 1].y * F8S_ACT, cur.v[2 * h + 1].z * F8S_ACT, cur.v[2 * h + 1].w * F8S_ACT); *(u32x2*)(h8 + 512 * h) = w; } } }
#pragma unroll
          for (int u = 0; u < 2; ++u) { rv[u] = rvn[u]; yv2[u][0] = yvn[u][0]; yv2[u][1] = yvn[u][1]; }
      }
#undef RT_LOADPAIR
    }
    asm volatile("s_waitcnt vmcnt(0)" ::: "memory"); __syncthreads();
    for (int tile = t_lo + F.wave; tile < t_hi; tile += NWAVES) {
        const LAS float* lgw = narrow_tile_wave(F, (const bf16_t*)(F.ws + WS_H2) + (size_t)tile * 32 * D);
        if (F.lane < 32) {
            const LAS float* lgp = lgw + F.lane * 33; const int row = tile * 32 + F.lane;
            float lg[NEXP];
#pragma unroll
            for (int e = 0; e < NEXP; ++e) lg[e] = lgp[e] + brt[e];
            unsigned used = 0u; float bv[4]; int bi[4];
#pragma unroll
            for (int k = 0; k < 4; ++k) { float best = -3.0e38f; int idx = 0;
#pragma unroll
                for (int e = 0; e < NEXP; ++e) { const bool take = (((used >> e) & 1u) == 0u) && (lg[e] > best); best = take ? lg[e] : best; idx = take ? e : idx; }
                used |= 1u << idx; bv[k] = best; bi[k] = idx; }
            const float e1 = __expf(bv[1] - bv[0]), e2 = __expf(bv[2] - bv[0]), e3 = __expf(bv[3] - bv[0]); const float inv = __builtin_amdgcn_rcpf(1.0f + e1 + e2 + e3);
            int* ei = (int*)(F.ws + WS_ROUTE + RT_EIDX) + (size_t)row * 4; float* pr = (float*)(F.ws + WS_ROUTE + RT_PROB) + (size_t)row * 4;
            *(int4*)ei = make_int4(bi[0], bi[1], bi[2], bi[3]); *(f32x4*)pr = (f32x4){inv, e1 * inv, e2 * inv, e3 * inv};
            atomicAdd((int*)&cnt[bi[0]], 1); atomicAdd((int*)&cnt[bi[1]], 1); atomicAdd((int*)&cnt[bi[2]], 1); atomicAdd((int*)&cnt[bi[3]], 1);
        }
        asm volatile("s_waitcnt lgkmcnt(0)" ::: "memory");
    }
    __syncthreads();
    if (F.tid < NEXP) ((int*)(F.ws + WS_ROUTE + RT_CNT))[F.bid * NEXP + F.tid] = cnt[F.tid];
    __syncthreads();
}
__device__ __forceinline__ void phase_slots(Frame& F, int mrows) {
    LAS int* part = (LAS int*)F.lds;
    LAS int* pre = part + 1024;
    LAS int* tot = pre + 32;
    LAS int* seg = tot + 32;
    LAS int* gcnt = seg + 64;
    LAS int* eix = gcnt + 2048;
    LAS int* rnk = eix + 4096;
    const int* cntg = (const int*)(F.ws + WS_ROUTE + RT_CNT);
    int* tokg = (int*)(F.ws + WS_ROUTE + RT_TOK); int* destg = (int*)(F.ws + WS_ROUTE + RT_DEST); float* psl = (float*)(F.ws + WS_ROUTE + RT_PSLOT);
    int t_lo, t_hi; tile_range(F, mrows, t_lo, t_hi);
    const int row_base = t_lo * 32, nent = (t_hi - t_lo) * 128, ngrp = nent / 64;
    { const int e = F.tid & 31, pt = F.tid >> 5; int a = 0, b = 0;
      for (int c = pt; c < F.G; c += 16) { const int v = cntg[c * NEXP + e]; b += v; a += (c < F.bid) ? v : 0; }
      part[pt * 32 + e] = a; part[512 + pt * 32 + e] = b; }
    for (int i = F.tid; i < nent; i += NTHREADS) eix[i] = ((const int*)(F.ws + WS_ROUTE + RT_EIDX))[(size_t)row_base * 4 + i];
    __syncthreads();
    if (F.tid < NEXP) { int a = 0, b = 0;
#pragma unroll
        for (int pt = 0; pt < 16; ++pt) { a += part[pt * 32 + F.tid]; b += part[512 + pt * 32 + F.tid]; }
        pre[F.tid] = a; tot[F.tid] = b; }
    for (int g = F.wave; g < ngrp; g += NWAVES) {
        const int e = eix[g * 64 + F.lane]; int rank = 0, mycnt = 0;
#pragma unroll 4
        for (int ee = 0; ee < NEXP; ++ee) { const unsigned long long m = __ballot(e == ee); if (e == ee) rank = __popcll(m & ((1ull << F.lane) - 1ull)); if (F.lane == ee) mycnt = __popcll(m); }
        rnk[g * 64 + F.lane] = rank; if (F.lane < NEXP) gcnt[g * 32 + F.lane] = mycnt; }
    __syncthreads();
    if (F.tid == 0) { int s = 0; for (int e = 0; e < NEXP; ++e) { seg[e] = s; s += (tot[e] + 255) & ~255; } seg[NEXP] = s; }
    if (F.tid >= 64 && F.tid < 64 + NEXP) { const int e = F.tid - 64; int run = 0; for (int g = 0; g < ngrp; ++g) { const int c = gcnt[g * 32 + e]; gcnt[g * 32 + e] = run; run += c; } }
    __syncthreads();
    { const float* prg = (const float*)(F.ws + WS_ROUTE + RT_PROB) + (size_t)row_base * 4;
      for (int i = F.tid; i < nent; i += NTHREADS) { const int e = eix[i]; const int slot = seg[e] + pre[e] + gcnt[(i >> 6) * 32 + e] + rnk[i];
          tokg[slot] = row_base + (i >> 2); destg[slot] = row_base * 4 + i; psl[slot] = prg[i]; } }
    if (F.bid < NEXP) { const int e = F.bid; for (int sl = seg[e] + tot[e] + F.tid; sl < seg[e + 1]; sl += NTHREADS) { tokg[sl] = 0; destg[sl] = -1; psl[sl] = 0.f; } }
    if (F.bid == 0 && F.tid <= NEXP) ((int*)(F.ws + WS_ROUTE + RT_SEG))[F.tid] = seg[F.tid];
    __syncthreads();
}
struct CombRaw { u32x4 x[2]; u32x2 f[2][4]; };
__device__ __forceinline__ void comb_load(const Frame& F, int row, CombRaw& r) {
    { const bf16_t* xp = (const bf16_t*)(F.ws + WS_X) + (size_t)row * D + 8 * F.lane;
#pragma unroll
      for (int h = 0; h < 2; ++h) r.x[h] = __builtin_nontemporal_load((const u32x4*)(xp + 512 * h)); }
    const unsigned char* fs = (const unsigned char*)(F.ws + WS_FS) + (size_t)row * 4 * 1024 + 8 * F.lane;
#pragma unroll
    for (int h = 0; h < 2; ++h)
#pragma unroll
        for (int k = 0; k < 4; ++k) r.f[h][k] = __builtin_nontemporal_load((const u32x2*)(fs + k * 1024 + 512 * h));
}
__device__ __forceinline__ void phase_combine_ln2(Frame& F, int l, int mrows) {
    const bool lastl = (l == DEPTH - 1);
    int t_lo, t_hi; tile_range(F, mrows, t_lo, t_hi);
    const int r_lo = 32 * t_lo, nrows = 32 * (t_hi - t_lo);
    const int mrA = mod_row(r_lo), mrB = mod_row(r_lo + (nrows > 0 ? nrows - 1 : 0));
    { const float* mb = (const float*)(F.ws + WS_MOD); const int ln = lastl ? l : l + 1; pv_fill(F, 0, F.in[IN_LN2G] + l * D); pv_fill(F, 1, F.in[IN_LN2B] + l * D);
      pv_fill(F, 2, mb + ((size_t)(l * 17 + mrA) * 6 + 5) * 1024); pv_fill(F, 3, mb + ((size_t)(l * 17 + mrB) * 6 + 5) * 1024);
      pv_fill(F, 4, mb + ((size_t)(ln * 17 + mrA) * 6 + 0) * 1024); pv_fill(F, 5, mb + ((size_t)(ln * 17 + mrB) * 6 + 0) * 1024);
      pv_fill(F, 6, mb + ((size_t)(ln * 17 + mrA) * 6 + 1) * 1024); pv_fill(F, 7, mb + ((size_t)(ln * 17 + mrB) * 6 + 1) * 1024); }
    if (!lastl) load_wg_lds(F, l + 1); else __syncthreads();
    for (int n = F.wave; n < nrows; n += 2 * NWAVES) {
        CombRaw rw[2];
#pragma unroll
        for (int u = 0; u < 2; ++u) if (n + u * NWAVES < nrows) comb_load(F, r_lo + n + u * NWAVES, rw[u]);
#pragma unroll
        for (int u = 0; u < 2; ++u) if (n + u * NWAVES < nrows) { const int row = r_lo + n + u * NWAVES;
            const int sel = (mod_row(row) == mrA) ? 0 : 1;
            const LAS float* g2 = pv_slot(F, 2 + sel);
            RowV x;
#pragma unroll
            for (int h = 0; h < 2; ++h) { const u32x4 w = rw[u].x[h]; x.v[2 * h] = (f32x4){bflo(w.x), bfhi(w.x), bflo(w.y), bfhi(w.y)}; x.v[2 * h + 1] = (f32x4){bflo(w.z), bfhi(w.z), bflo(w.w), bfhi(w.w)}; }
#pragma unroll
            for (int j = 0; j < 4; ++j) { f32x4 f = (f32x4){0.f, 0.f, 0.f, 0.f};
#pragma unroll
                for (int k = 0; k < 4; ++k) { const u32x2 w2 = rw[u].f[j >> 1][k]; const int wd = (int)((j & 1) ? w2.y : w2.x);
                    const f32x2 lo = __builtin_amdgcn_cvt_pk_f32_fp8(wd, false), hi = __builtin_amdgcn_cvt_pk_f32_fp8(wd, true); f[0] += lo[0]; f[1] += lo[1]; f[2] += hi[0]; f[3] += hi[1]; }
                const f32x4 gg = *(const LAS f32x4*)(g2 + RC(F.lane, j)) * (1.0f / FS_SCALE);
                x.v[j] = x.v[j] * DN_ALPHA + gg * f; }
            row_ln_plain(x, F.lane); row_affine_l(x, pv_slot(F, 0), pv_slot(F, 1), F.lane);
            if (lastl) { row_store_nt(x, F.out + (size_t)row * D, F.lane); }
            else { row_store_bf16_nt(x, (bf16_t*)(F.ws + WS_X) + (size_t)row * D, F.lane); ln0_row(F, row, x, pv_slot(F, 4 + sel), pv_slot(F, 6 + sel)); } }
    }
    if (!lastl) gates_tail(F, l + 1, t_lo, t_hi);
    __syncthreads();
}

#define MFMA32(a, b, c) __builtin_amdgcn_mfma_f32_32x32x16_bf16((a), (b), (c), 0, 0, 0)
#define MFMA16(a, b, c) __builtin_amdgcn_mfma_f32_16x16x32_bf16((a), (b), (c), 0, 0, 0)
__device__ __forceinline__ f32x16 zero16() { f32x16 z;
#pragma unroll
    for (int i = 0; i < 16; ++i) z[i] = 0.f;
    return z; }
__device__ __forceinline__ void pool_tiles(Frame& F, int l, bool with_ctx) {
    LAS unsigned char* Pin = F.lds;
    LAS unsigned char* Dm = F.lds + 40960;
    const bf16_t* Z = (const bf16_t*)(F.ws + WS_Z);
    const bf16_t* Wp = (const bf16_t*)(F.ws + WS_WPOOL) + (size_t)l * 4 * 4096;
    const float* psc = F.in[IN_POOLS] + l * 256;
    bf16_t* BRA = (bf16_t*)(F.ws + WS_BRA);
    const int ntiles = with_ctx ? 1088 : 1024;
    const int r = F.lane & 31, h = F.lane >> 5;
    for (int tile = F.bid; tile < ntiles; tile += F.G) {
        int row0, seq_lo, seq_hi;
        if (tile < 1024) { row0 = tile * 64; seq_lo = row0; seq_hi = row0 + 64; }
        else { const int ct = tile - 1024; seq_lo = ML + (ct >> 2) * 256; seq_hi = seq_lo + 256; row0 = seq_lo + (ct & 3) * 64; }
        for (int idx = F.tid; idx < 80 * 32; idx += NTHREADS) { const int rr = idx >> 5, ck = idx & 31, grow = row0 - 8 + rr;
            if (grow >= seq_lo && grow < seq_hi) *(LAS u32x4*)(Pin + rr * 512 + ck * 16) = __builtin_nontemporal_load((const u32x4*)(Z + (size_t)grow * NZ + ZC_P + ck * 8)); }
        __syncthreads();
        for (int idx = F.tid; idx < 64 * 32; idx += NTHREADS) { const int tok = idx >> 5, ck = idx & 31, g = ck >> 3, hw = 1 << g, t = row0 + tok;
            const int lo = max(t - hw, seq_lo), hi = min(t + hw, seq_hi);
            float s[8];
#pragma unroll
            for (int e = 0; e < 8; ++e) s[e] = 0.f;
            for (int rw = lo; rw < hi; ++rw) { const u32x4 v = *(const LAS u32x4*)(Pin + (rw - row0 + 8) * 512 + ck * 16);
                s[0] += bflo(v.x); s[1] += bfhi(v.x); s[2] += bflo(v.y); s[3] += bfhi(v.y); s[4] += bflo(v.z); s[5] += bfhi(v.z); s[6] += bflo(v.w); s[7] += bfhi(v.w); }
            const float inv = 1.0f / (float)(hi - lo);
            const u32x4 o = *(const LAS u32x4*)(Pin + (tok + 8) * 512 + ck * 16);
            u32x4 w; w.x = pk2(s[0] * inv - bflo(o.x), s[1] * inv - bfhi(o.x)); w.y = pk2(s[2] * inv - bflo(o.y), s[3] * inv - bfhi(o.y));
            w.z = pk2(s[4] * inv - bflo(o.z), s[5] * inv - bfhi(o.z)); w.w = pk2(s[6] * inv - bflo(o.w), s[7] * inv - bfhi(o.w));
            *(LAS u32x4*)(Dm + tok * 528 + ck * 16) = w; }
        __syncthreads();
#pragma unroll 1
        for (int qi = 0; qi < 2; ++qi) { const int q = F.wave + 8 * qi, g = q >> 2, td = (q >> 1) & 1, tt = q & 1;
            f32x16 acc = zero16();
#pragma unroll
            for (int ks = 0; ks < 4; ++ks) { const bf16x8 a = *(const bf16x8*)(Wp + ((size_t)g * 64 + td * 32 + r) * 64 + ks * 16 + 8 * h);
                const bf16x8 b = *(const LAS bf16x8*)(Dm + (tt * 32 + r) * 528 + (g * 64 + ks * 16 + 8 * h) * 2);
                acc = MFMA32(a, b, acc); }
            const size_t orow = (size_t)(row0 + tt * 32 + r);
#pragma unroll
            for (int qq = 0; qq < 4; ++qq) { const int dcol = g * 64 + td * 32 + 8 * qq + 4 * h; const f32x4 sc = *(const f32x4*)(psc + dcol);
                u32x2 w; w.x = pk2(acc[4 * qq] * sc.x, acc[4 * qq + 1] * sc.y); w.y = pk2(acc[4 * qq + 2] * sc.z, acc[4 * qq + 3] * sc.w);
                *(u32x2*)(BRA + orow * D + dcol) = w; } }
        __syncthreads();
    }
}
__device__ __forceinline__ void sgu_chunks(Frame& F, int l, bool with_ctx) {
    LAS unsigned char* Vt = F.lds;
    const bf16_t* Z = (const bf16_t*)(F.ws + WS_Z);
    const bf16_t* Ws = (const bf16_t*)(F.ws + WS_WSGU) + (size_t)l * 4 * 16384;
    const float* lng = F.in[IN_SLNG] + l * 256; const float* lnb = F.in[IN_SLNB] + l * 256; const float* sb = F.in[IN_SGUB] + l * 512;
    bf16_t* BRA = (bf16_t*)(F.ws + WS_BRA);
    const int nchunks = with_ctx ? 544 : 512;
    const int r = F.lane & 31, h = F.lane >> 5;
    for (int ch = F.bid; ch < nchunks; ch += F.G) {
        const int row0 = ch * 128;
        { const int s = F.tid >> 2, q = F.tid & 3; const bf16_t* zp = Z + (size_t)(row0 + s) * NZ + ZC_UV + 256 + q * 64;
          float v[64]; float sum = 0.f;
#pragma unroll
          for (int i = 0; i < 8; ++i) { const u32x4 w = __builtin_nontemporal_load((const u32x4*)(zp + 8 * i));
              v[8 * i] = bflo(w.x); v[8 * i + 1] = bfhi(w.x); v[8 * i + 2] = bflo(w.y); v[8 * i + 3] = bfhi(w.y); v[8 * i + 4] = bflo(w.z); v[8 * i + 5] = bfhi(w.z); v[8 * i + 6] = bflo(w.w); v[8 * i + 7] = bfhi(w.w); }
#pragma unroll
          for (int i = 0; i < 64; ++i) sum += v[i];
          sum += shx(sum, 1, F.lane); sum += shx(sum, 2, F.lane);
          const float mean = sum * (1.f / 256.f); float sq = 0.f;
#pragma unroll
          for (int i = 0; i < 64; ++i) { v[i] -= mean; sq += v[i] * v[i]; }
          sq += shx(sq, 1, F.lane); sq += shx(sq, 2, F.lane);
          const float rstd = 1.f / sqrtf(sq * (1.f / 256.f) + LN_EPS);
#pragma unroll
          for (int i = 0; i < 64; ++i) { const int c = q * 64 + i; const float y = v[i] * rstd * lng[c] + lnb[c]; *(LAS bf16_t*)(Vt + c * 272 + s * 2) = (bf16_t)f2bf(y); } }
        __syncthreads();
        const int tc = F.wave & 1, tt = F.wave >> 1, t = tt * 32 + r;
#pragma unroll 1
        for (int g = 0; g < 4; ++g) {
            f32x16 acc = zero16();
#pragma unroll
            for (int ks = 0; ks < 8; ++ks) { const bf16x8 a = *(const LAS bf16x8*)(Vt + (g * 64 + tc * 32 + r) * 272 + (ks * 16 + 8 * h) * 2);
                const bf16x8 b = *(const bf16x8*)(Ws + ((size_t)g * 128 + t) * 128 + ks * 16 + 8 * h);
                acc = MFMA32(a, b, acc); }
            const float bias = sb[g * 128 + t];
#pragma unroll
            for (int qq = 0; qq < 4; ++qq) { const int c0 = g * 64 + tc * 32 + 8 * qq + 4 * h;
                const u32x2 u = *(const u32x2*)(Z + (size_t)(row0 + t) * NZ + ZC_UV + c0);
                u32x2 w; w.x = pk2(bflo(u.x) * (acc[4 * qq] + bias), bfhi(u.x) * (acc[4 * qq + 1] + bias)); w.y = pk2(bflo(u.y) * (acc[4 * qq + 2] + bias), bfhi(u.y) * (acc[4 * qq + 3] + bias));
                *(u32x2*)(BRA + (size_t)(row0 + t) * D + 768 + c0) = w; } }
        __syncthreads();
    }
}
__device__ __forceinline__ void qk_conv_pass(Frame& F, int l) {
    const bf16_t* Z = (const bf16_t*)(F.ws + WS_Z); bf16_t* QKC = (bf16_t*)(F.ws + WS_H);
    const int chunk = F.tid & 127, rsub = F.tid >> 7, ch0 = chunk * 8;
    float w0[8], w1[8], w2[8], cbv[8];
    { const float* cw = F.in[IN_CONVW] + (size_t)l * 3 * 1024 + ch0; const float* cb = F.in[IN_CONVB] + (size_t)l * 1024 + ch0;
#pragma unroll
      for (int e = 0; e < 8; ++e) { w0[e] = cw[e]; w1[e] = cw[1024 + e]; w2[e] = cw[2048 + e]; cbv[e] = cb[e]; } }
    const float scale = chunk >= 64 ? 0.08838834764831845f : 1.0f;
    const int ns = F.G * 4, sidx = F.bid * 4 + rsub;
    const int r0 = (int)(((long)sidx * MT) / ns), r1 = (int)(((long)(sidx + 1) * MT) / ns);
    const bf16_t* zb = Z + ZC_QK + ch0;
    const u32x4 zero4 = (u32x4){0u, 0u, 0u, 0u};
    u32x4 xm = zero4, xc = zero4, xn = zero4;
    if (r0 < r1) { xc = *(const u32x4*)(zb + (size_t)r0 * NZ); if (r0 > 0) xm = *(const u32x4*)(zb + (size_t)(r0 - 1) * NZ); if (r0 + 1 < MT) xn = *(const u32x4*)(zb + (size_t)(r0 + 1) * NZ); }
    for (int row = r0; row < r1; ++row) {
        u32x4 xn2 = zero4; if (row + 2 < MT) xn2 = *(const u32x4*)(zb + (size_t)(row + 2) * NZ);
        const int p = row < ML ? (row & 4095) : ((row - ML) & 255), len = row < ML ? 4096 : 256;
        const u32x4 x0 = (p > 0) ? xm : zero4, x1 = xc, x2 = (p + 1 < len) ? xn : zero4;
        const unsigned xa[4] = {x0.x, x0.y, x0.z, x0.w}, xb[4] = {x1.x, x1.y, x1.z, x1.w}, xcc[4] = {x2.x, x2.y, x2.z, x2.w};
        float y[8];
#pragma unroll
        for (int e2 = 0; e2 < 4; ++e2) { y[2 * e2] = cbv[2 * e2] + w0[2 * e2] * bflo(xa[e2]) + w1[2 * e2] * bflo(xb[e2]) + w2[2 * e2] * bflo(xcc[e2]);
            y[2 * e2 + 1] = cbv[2 * e2 + 1] + w0[2 * e2 + 1] * bfhi(xa[e2]) + w1[2 * e2 + 1] * bfhi(xb[e2]) + w2[2 * e2 + 1] * bfhi(xcc[e2]); }
#pragma unroll
        for (int e = 0; e < 8; ++e) y[e] = siluf_(y[e]) * scale;
        u32x4 w; w.x = pk2(y[0], y[1]); w.y = pk2(y[2], y[3]); w.z = pk2(y[4], y[5]); w.w = pk2(y[6], y[7]);
        *(u32x4*)(QKC + (size_t)row * D + ch0) = w;
        xm = xc; xc = xn; xn = xn2;
    }
}
constexpr int ML_QS = 0, ML_KS = 34816, ML_KW = 69632, ML_VT = 104448, ML_CB = 126208, ML_SC = 147968, ML_SCSZ = 2624;
__device__ __forceinline__ float logsigf_(float x) { return fminf(x, 0.f) - __logf(1.0f + __expf(-fabsf(x))); }
__device__ __forceinline__ unsigned swap16(unsigned u) { return __builtin_amdgcn_alignbit(u, u, 16); }
struct MlPre { u32x4 qk[8]; u32x2 v[4]; float g[4]; };
__device__ __forceinline__ void ml_geom(int j, int b, int dir, int& seqbase, int& seqlen, int& pbase) {
    const bool is_ctx = j < 2; int cj = is_ctx ? j : j - 2; const int ncs = is_ctx ? 2 : 32; if (dir) cj = ncs - 1 - cj;
    seqbase = is_ctx ? ML + b * 256 : b * 4096; seqlen = is_ctx ? 256 : 4096; pbase = cj * 128; }
#define ML_BAR() do { asm volatile("s_waitcnt lgkmcnt(0)" ::: "memory"); __builtin_amdgcn_s_barrier(); asm volatile("" ::: "memory"); } while (0)
__device__ __forceinline__ void mlstm_unit(Frame& F, int l, int unit) {
    const int bh = (unit & 7) + 8 * (unit >> 5), sub = (unit >> 3) & 3;
    const int b = bh >> 2, head = bh & 3, dir = sub >> 1, vh = sub & 1;
    LAS unsigned char* QS = F.lds + ML_QS; LAS unsigned char* KS = F.lds + ML_KS; LAS unsigned char* KW = F.lds + ML_KW; LAS unsigned char* VT = F.lds + ML_VT; LAS unsigned char* CB = F.lds + ML_CB;
    const bf16_t* Z = (const bf16_t*)(F.ws + WS_Z); const float* ZG = (const float*)(F.ws + WS_ZG); const bf16_t* QKC = (const bf16_t*)(F.ws + WS_H);
    bf16_t* HF = (bf16_t*)(F.ws + WS_HFB) + (size_t)dir * MT * 512;
    const int wave = F.wave;
    int tl = F.tid;
#define ML_ROLES() const int lane = tl & 63, fr = lane & 15, q4 = lane >> 4; const int isk = (tl >> 4) & 1, ck = tl & 15, i0 = 8 * (tl >> 5), chn = (isk ? 512 : 0) + head * 128 + ck * 8; \
    const int vi0 = 4 * (tl >> 4), vcq = tl & 15, vch = head * 128 + vh * 64 + vcq * 4; (void)fr; (void)q4; (void)vi0; (void)vcq; (void)vch; (void)i0; (void)chn; (void)ck; (void)isk;
    for (int idx = F.tid; idx < 16 * 136; idx += NTHREADS) *(LAS bf16_t*)(VT + (64 + idx / 136) * 272 + (idx % 136) * 2) = (idx < 136) ? (bf16_t)0x3F80 : (bf16_t)0;
    f32x4 cs[5];
#pragma unroll
    for (int vt = 0; vt < 5; ++vt) cs[vt] = (f32x4){0.f, 0.f, 0.f, 0.f};
    float m_state = 0.f;
    MlPre pre;
#define ML_PREFETCH(jj) do { int sb_, sl_, pb_; ml_geom((jj), b, dir, sb_, sl_, pb_); \
        { const int pmin = dir ? pb_ + 120 - i0 : pb_ + i0; const bf16_t* zr = QKC + (size_t)(sb_ + pmin) * D + chn; (void)sl_; \
          _Pragma("unroll") for (int k = 0; k < 8; ++k) pre.qk[k] = *(const u32x4*)(zr + (size_t)k * D); } \
        { const int pminv = dir ? pb_ + 124 - vi0 : pb_ + vi0; const bf16_t* zv = Z + (size_t)(sb_ + pminv) * NZ + ZC_V + vch; \
          _Pragma("unroll") for (int k = 0; k < 4; ++k) pre.v[k] = *(const u32x2*)(zv + (size_t)k * NZ); } \
        if (wave == 0) { const int p0 = dir ? pb_ + 127 - 2 * lane : pb_ + 2 * lane, p1 = dir ? p0 - 1 : p0 + 1; \
          pre.g[0] = ZG[(size_t)(sb_ + p0) * 16 + dir * 8 + head]; pre.g[1] = ZG[(size_t)(sb_ + p0) * 16 + dir * 8 + 4 + head]; \
          pre.g[2] = ZG[(size_t)(sb_ + p1) * 16 + dir * 8 + head]; pre.g[3] = ZG[(size_t)(sb_ + p1) * 16 + dir * 8 + 4 + head]; } } while (0)
#define ML_STEPA(sbuf) do { LAS float* sg_ = (LAS float*)(F.lds + ML_SC + (sbuf) * ML_SCSZ); const int i0g = 2 * lane, i1g = i0g + 1; \
        const float gi0 = pre.g[0], gf0 = pre.g[1], gi1 = pre.g[2], gf1 = pre.g[3]; \
        const float lf0 = logsigf_(gf0), lf1 = logsigf_(gf1); const float s1 = lf0 + lf1; float incl = s1; \
        _Pragma("unroll") for (int o = 1; o < 64; o <<= 1) { const float y_ = shup(incl, o, lane); incl += (lane >= o) ? y_ : 0.f; } \
        const float excl = incl - s1, bc0 = excl + lf0, bc1 = excl + s1; \
        const float g0 = gi0 - bc0, g1 = gi1 - bc1; const float mx1 = fmaxf(g0, g1); float im = mx1; \
        _Pragma("unroll") for (int o = 1; o < 64; o <<= 1) { const float y_ = shup(im, o, lane); im = (lane >= o) ? fmaxf(im, y_) : im; } \
        float em = shup(im, 1, lane); em = (lane == 0) ? -3.0e38f : em; \
        const float M0 = fmaxf(m_state, fmaxf(em, g0)), M1 = fmaxf(m_state, fmaxf(em, mx1)); \
        const float total = bperm(63, bc1), Mlast = bperm(63, M1); \
        sg_[i0g] = g0; sg_[i1g] = g1; sg_[128 + i0g] = M0; sg_[128 + i1g] = M1; \
        sg_[256 + i0g] = __expf(m_state - M0); sg_[256 + i1g] = __expf(m_state - M1); \
        sg_[384 + i0g] = __expf(-(bc0 + M0)); sg_[384 + i1g] = __expf(-(bc1 + M1)); \
        sg_[512 + i0g] = __expf(g0 - Mlast); sg_[512 + i1g] = __expf(g1 - Mlast); \
        if (lane == 0) sg_[640] = __expf(m_state - Mlast); \
        m_state = total + Mlast; } while (0)
    { ML_ROLES(); ML_PREFETCH(0); if (wave == 0) ML_STEPA(0); }
    ML_BAR();
#pragma unroll 1
    for (int j = 0; j < 34; ++j) {
        asm volatile("" : "+v"(tl));
        ML_ROLES();
        int seqbase, seqlen, pbase; ml_geom(j, b, dir, seqbase, seqlen, pbase);
        const LAS float* sc_g = (const LAS float*)(F.lds + ML_SC + (j & 1) * ML_SCSZ); const LAS float* sc_M = sc_g + 128; const LAS float* sc_dec = sc_g + 256; const LAS float* sc_emt = sc_g + 384; const LAS float* sc_wk = sc_g + 512;
        {
#pragma unroll
          for (int k = 0; k < 8; ++k) { const int i = dir ? i0 + 7 - k : i0 + k; *(LAS u32x4*)((isk ? KS : QS) + i * 272 + ck * 16) = pre.qk[k]; }
          if (isk) { u32x4 kt[8]; float ykeep[8];
#pragma unroll
              for (int e = 0; e < 8; ++e) { kt[e] = (u32x4){0u, 0u, 0u, 0u}; ykeep[e] = 0.f; }
#pragma unroll
              for (int k = 0; k < 8; ++k) { const int i = dir ? i0 + 7 - k : i0 + k; const float wk = sc_wk[i];
                  const unsigned xb[4] = {pre.qk[k].x, pre.qk[k].y, pre.qk[k].z, pre.qk[k].w};
#pragma unroll
                  for (int e = 0; e < 8; ++e) { const float yw = ((e & 1) ? bfhi(xb[e >> 1]) : bflo(xb[e >> 1])) * wk;
                      if (k & 1) { const unsigned pw_ = pk2(ykeep[e], yw); if ((k >> 1) == 0) kt[e].x = pw_; else if ((k >> 1) == 1) kt[e].y = pw_; else if ((k >> 1) == 2) kt[e].z = pw_; else kt[e].w = pw_; }
                      else ykeep[e] = yw; } }
#pragma unroll
              for (int e = 0; e < 8; ++e) { u32x4 o = kt[e]; if (dir) o = (u32x4){swap16(kt[e].w), swap16(kt[e].z), swap16(kt[e].y), swap16(kt[e].x)};
                  *(LAS u32x4*)(KW + (ck * 8 + e) * 272 + (((i0 >> 3) ^ (ck & 7)) * 16)) = o; } } }
        { unsigned vv[4][2];
#pragma unroll
          for (int k = 0; k < 4; ++k) { vv[k][0] = pre.v[k].x; vv[k][1] = pre.v[k].y; }
#pragma unroll
          for (int c = 0; c < 4; ++c) {
              unsigned h0 = (c & 1) ? (vv[0][c >> 1] >> 16) : (vv[0][c >> 1] & 0xffffu), h1 = (c & 1) ? (vv[1][c >> 1] >> 16) : (vv[1][c >> 1] & 0xffffu);
              unsigned h2 = (c & 1) ? (vv[2][c >> 1] >> 16) : (vv[2][c >> 1] & 0xffffu), h3 = (c & 1) ? (vv[3][c >> 1] >> 16) : (vv[3][c >> 1] & 0xffffu);
              u32x2 o; if (dir) { o.x = h3 | (h2 << 16); o.y = h1 | (h0 << 16); } else { o.x = h0 | (h1 << 16); o.y = h2 | (h3 << 16); }
              *(LAS u32x2*)(VT + (vcq * 4 + c) * 272 + vi0 * 2) = o; } }
#pragma unroll
        for (int vt = 0; vt < 5; ++vt)
#pragma unroll
            for (int rr = 0; rr < 4; rr += 2) { const unsigned pw_ = pk2(cs[vt][rr], cs[vt][rr + 1]);
                *(LAS bf16_t*)(CB + (16 * vt + 4 * q4 + rr) * 272 + (16 * wave + fr) * 2) = (bf16_t)(pw_ & 0xffffu); *(LAS bf16_t*)(CB + (16 * vt + 4 * q4 + rr + 1) * 272 + (16 * wave + fr) * 2) = (bf16_t)(pw_ >> 16); }
        ML_BAR();
        if (j + 1 < 34) ML_PREFETCH(j + 1);
        const int t = 16 * wave + fr;
        bf16x8 qf[4];
#pragma unroll
        for (int kc = 0; kc < 4; ++kc) qf[kc] = *(const LAS bf16x8*)(QS + t * 272 + (32 * kc + 8 * q4) * 2);
        const float Mt_t = sc_M[t], dec_t = sc_dec[t], emt_t = sc_emt[t];
        f32x4 ps[8];
#pragma unroll
        for (int jp = 0; jp < 4; ++jp) {
            ps[2 * jp] = (f32x4){0.f, 0.f, 0.f, 0.f}; ps[2 * jp + 1] = (f32x4){0.f, 0.f, 0.f, 0.f};
            if (2 * jp <= wave) {
                bf16x8 ka[4], kb[4];
#pragma unroll
                for (int kc = 0; kc < 4; ++kc) { ka[kc] = *(const LAS bf16x8*)(KS + (32 * jp + fr) * 272 + (32 * kc + 8 * q4) * 2); kb[kc] = *(const LAS bf16x8*)(KS + (32 * jp + 16 + fr) * 272 + (32 * kc + 8 * q4) * 2); }
                const f32x4 ga4 = *(const LAS f32x4*)(sc_g + 32 * jp + 4 * q4), gb4 = *(const LAS f32x4*)(sc_g + 32 * jp + 16 + 4 * q4);
                f32x4 acc0 = (f32x4){0.f, 0.f, 0.f, 0.f}, acc1 = (f32x4){0.f, 0.f, 0.f, 0.f};
#pragma unroll
                for (int kc = 0; kc < 4; ++kc) { acc0 = MFMA16(ka[kc], qf[kc], acc0); acc1 = MFMA16(kb[kc], qf[kc], acc1); }
#pragma unroll
                for (int rr = 0; rr < 4; ++rr) { const int s0 = 32 * jp + 4 * q4 + rr, s1 = s0 + 16;
                    ps[2 * jp][rr] = (s0 <= t) ? acc0[rr] * __expf(ga4[rr] - Mt_t) : 0.f; ps[2 * jp + 1][rr] = (s1 <= t) ? acc1[rr] * __expf(gb4[rr] - Mt_t) : 0.f; }
            }
        }
        f32x4 ao[5];
        {
#pragma unroll
          for (int vt = 0; vt < 5; ++vt) ao[vt] = (f32x4){0.f, 0.f, 0.f, 0.f};
#pragma unroll
          for (int kh = 0; kh < 4; kh += 2) { bf16x8 cf[2][5];
#pragma unroll
              for (int k2 = 0; k2 < 2; ++k2)
#pragma unroll
                  for (int vt = 0; vt < 5; ++vt) cf[k2][vt] = *(const LAS bf16x8*)(CB + (16 * vt + fr) * 272 + (32 * (kh + k2) + 8 * q4) * 2);
#pragma unroll
              for (int k2 = 0; k2 < 2; ++k2)
#pragma unroll
                  for (int vt = 0; vt < 5; ++vt) ao[vt] = MFMA16(cf[k2][vt], qf[kh + k2], ao[vt]); }
#pragma unroll
          for (int vt = 0; vt < 5; ++vt) ao[vt] = ao[vt] * dec_t; }
#pragma unroll
        for (int ks = 0; ks < 4; ++ks) {
            if (2 * ks <= wave) {
                s16x4 vlo[5], vhi[5];
#pragma unroll
                for (int vt = 0; vt < 5; ++vt) { vlo[vt] = *(const LAS s16x4*)(VT + (16 * vt + fr) * 272 + (32 * ks + 4 * q4) * 2); vhi[vt] = *(const LAS s16x4*)(VT + (16 * vt + fr) * 272 + (32 * ks + 16 + 4 * q4) * 2); }
                u32x4 pw; pw.x = cvt_pk_bf16(ps[2 * ks][0], ps[2 * ks][1]); pw.y = cvt_pk_bf16(ps[2 * ks][2], ps[2 * ks][3]); pw.z = cvt_pk_bf16(ps[2 * ks + 1][0], ps[2 * ks + 1][1]); pw.w = cvt_pk_bf16(ps[2 * ks + 1][2], ps[2 * ks + 1][3]);
                const bf16x8 pf = __builtin_bit_cast(bf16x8, pw);
#pragma unroll
                for (int vt = 0; vt < 5; ++vt) { const bf16x8 a = __builtin_shufflevector(vlo[vt], vhi[vt], 0, 1, 2, 3, 4, 5, 6, 7); ao[vt] = MFMA16(a, pf, ao[vt]); }
            }
        }
        { const float den = bperm(fr, ao[4][0]); const float inv = 1.0f / fmaxf(fabsf(den), emt_t);
          const int p = dir ? pbase + 127 - t : pbase + t; bf16_t* orow = HF + (size_t)(seqbase + p) * 512 + head * 128 + vh * 64 + 4 * q4;
#pragma unroll
          for (int vt = 0; vt < 4; ++vt) { const f32x4 o = ao[vt] * inv; u32x2 w; w.x = cvt_pk_bf16(o[0], o[1]); w.y = cvt_pk_bf16(o[2], o[3]); *(u32x2*)(orow + 16 * vt) = w; } }
        { const float a_s = sc_g[640];
#pragma unroll
          for (int vt = 0; vt < 5; ++vt) cs[vt] = cs[vt] * a_s;
#pragma unroll
          for (int ks = 0; ks < 4; ks += 2) { bf16x8 bb[2], va[2][5];
#pragma unroll
              for (int k2 = 0; k2 < 2; ++k2) { bb[k2] = *(const LAS bf16x8*)(KW + (16 * wave + fr) * 272 + (((4 * (ks + k2) + q4) ^ (((16 * wave + fr) >> 3) & 7)) * 16));
#pragma unroll
                  for (int vt = 0; vt < 5; ++vt) va[k2][vt] = *(const LAS bf16x8*)(VT + (16 * vt + fr) * 272 + (32 * (ks + k2) + 8 * q4) * 2); }
#pragma unroll
              for (int k2 = 0; k2 < 2; ++k2)
#pragma unroll
                  for (int vt = 0; vt < 5; ++vt) cs[vt] = MFMA16(va[k2][vt], bb[k2], cs[vt]); } }
        if (wave == 0 && j + 1 < 34) ML_STEPA((j + 1) & 1);
        ML_BAR();
    }
#undef ML_PREFETCH
#undef ML_STEPA
#undef ML_ROLES
    __syncthreads();
}
__device__ __forceinline__ void phase_mixers(Frame& F, int l) {
    const bool with_ctx = (l != DEPTH - 1);
#ifndef MIX_MASK
#define MIX_MASK 7
#endif
#ifndef MIXREP
#define MIXREP 0
#endif
    if (MIX_MASK & 1) pool_tiles(F, l, with_ctx);
    if (MIXREP & 1) { __syncthreads(); pool_tiles(F, l, with_ctx); }
    if (MIX_MASK & 2) sgu_chunks(F, l, with_ctx);
    if (MIXREP & 2) { __syncthreads(); sgu_chunks(F, l, with_ctx); }
    (void)0;
    qk_conv_pass(F, l);
}
__device__ __forceinline__ void phase_mlstm(Frame& F, int l) {
    for (int u = F.bid; u < 256; u += F.G) mlstm_unit(F, l, u);
}

struct Args { const float* in[31]; float* out; unsigned char* ws; int g_lo, g_hi, pad0, pad1; };
constexpr int NPH = 11, NGID = 2 + DEPTH * NPH;
__global__ void __launch_bounds__(NTHREADS, 2) fwd_kernel(Args args) {
    extern __shared__ __attribute__((aligned(16))) unsigned char lds_raw[];
    Frame F;
    F.lds = (LAS unsigned char*)lds_raw; F.MISC = (volatile LAS unsigned*)(F.lds + MISC_OFF);
    F.tid = threadIdx.x; F.lane = F.tid & 63; F.wave = __builtin_amdgcn_readfirstlane(F.tid >> 6); F.G = gridDim.x; F.bid = blockIdx.x;
    F.ws = args.ws; F.out = args.out;
    F.in = (InTab)__builtin_amdgcn_kernarg_segment_ptr();
    if (F.tid < 64) F.MISC[F.tid] = 0u;
    __syncthreads();
    const int lo = args.g_lo, hi = args.g_hi;
    const bool multi = (hi - lo) > 1;
    XcdBarrier bar; bar.bar = (unsigned*)(F.ws + WS_CTL) + CW_BAR; bar.x = 0; bar.st = nullptr;
    if (multi) bar = xcd_barrier_post((unsigned*)(F.ws + WS_CTL) + CW_BAR, F.MISC + 8);
#ifndef PHASE_MASK
#define PHASE_MASK 0xFFFF
#endif
#define RUN(g) (lo <= (g) && (g) < hi)
#define RUNP(ty, g) ((((PHASE_MASK) >> (ty)) & 1) && RUN(g))
#ifndef REPEAT_MASK
#define REPEAT_MASK 0
#endif
#define NREP(ty) ((((REPEAT_MASK) >> (ty)) & 1) ? 2 : 1)
#define SEAM(g) do { if (RUN((g) + 1)) xcd_barrier(bar); } while (0)
#define LAUNDER(P) Frame P = F; { int t_; asm volatile("v_mbcnt_lo_u32_b32 %0, -1, 0\n\tv_mbcnt_hi_u32_b32 %0, -1, %0" : "=v"(t_)); t_ |= (F.wave << 6); P.tid = t_; P.lane = t_ & 63; P.wave = __builtin_amdgcn_readfirstlane(t_ >> 6); GAS unsigned char* w_ = (GAS unsigned char*)F.ws; asm volatile("" : "+s"(w_)); P.ws = (unsigned char*)w_; InTab t2_ = F.in; asm volatile("" : "+s"(t2_)); P.in = t2_; }
    if (RUNP(0, 0)) { LAUNDER(P); for (int rep_ = 0; rep_ < NREP(0); ++rep_) { phase_prologue(P); __syncthreads(); } SEAM(0); }
    if (RUNP(1, 1)) { LAUNDER(P); for (int rep_ = 0; rep_ < NREP(1); ++rep_) { phase_ln0_first(P); __syncthreads(); } SEAM(1); }
#pragma unroll 1
    for (int l = 0; l < DEPTH; ++l) {
        const int g0 = 2 + l * NPH;
        const int mrows = (l == DEPTH - 1) ? ML : MT;
        if (RUNP(2, g0 + 0)) {
#undef PHTY
#define PHTY 2
            LAUNDER(P);
            { ProbPlain Pr{(const bf16_t*)(P.ws + WS_H), (const bf16_t*)(P.ws + WS_WIN) + (size_t)l * NZ * D, D, D};
              pg8::StaticOrder<1> S; S.init(MT / 256, NZ_BF / 256, P.G, P.bid);
              EpiInproj<false> E{(bf16_t*)(P.ws + WS_Z), P.in[IN_BIN] + (size_t)l * 5904, 0};
              pg8::gemm_phase(P.lds, P.tid, Pr, S, E); }
            __syncthreads();
            { ProbPlainF8 Pr{(const bf16_t*)(P.ws + WS_H8), (const bf16_t*)(P.ws + WS_WIN8 + (size_t)l * NZ_F8 * D), D / 2, D / 2};
              pg8::StaticOrder<1> S; S.init(MT / 256, NZ_F8 / 256, P.G, P.bid);
              EpiInproj<true> E{(bf16_t*)(P.ws + WS_Z), P.in[IN_BIN] + (size_t)l * 5904, NZ_BF / 256};
              pg8::gemm_phase(P.lds, P.tid, Pr, S, E); }
            SEAM(g0 + 0);
        }
        if (RUNP(3, g0 + 1)) { LAUNDER(P); for (int rep_ = 0; rep_ < NREP(3); ++rep_) { phase_mixers(P, l); __syncthreads(); } SEAM(g0 + 1); }
        if (RUNP(12, g0 + 2)) { LAUNDER(P); for (int rep_ = 0; rep_ < NREP(12); ++rep_) { phase_mlstm(P, l); __syncthreads(); } SEAM(g0 + 2); }
        if (RUNP(4, g0 + 3)) { LAUNDER(P); for (int rep_ = 0; rep_ < NREP(4); ++rep_) phase_finalize(P, l, mrows); SEAM(g0 + 3); }
        if (RUNP(5, g0 + 4)) {
#undef PHTY
#define PHTY 5
            LAUNDER(P);
            ProbPlain Pr{(const bf16_t*)(P.ws + WS_BRA), (const bf16_t*)(P.ws + WS_WBR) + (size_t)l * D * D, D, D};
            pg8::StaticOrder<1> S; S.init(mrows / 256, 4, P.G, P.bid);
            EpiBranch E{(const bf16_t*)(P.ws + WS_Z), (bf16_t*)(P.ws + WS_Y)};
            pg8::gemm_phase(P.lds, P.tid, Pr, S, E); if (NREP(PHTY) == 2) { __syncthreads(); pg8::gemm_phase(P.lds, P.tid, Pr, S, E); }
            SEAM(g0 + 4);
        }
        if (RUNP(6, g0 + 5)) {
#undef PHTY
#define PHTY 6
            LAUNDER(P);
            ProbPlain Pr{(const bf16_t*)(P.ws + WS_Y), (const bf16_t*)(P.ws + WS_WOUT) + (size_t)l * D * D, D, D};
            pg8::StaticOrder<1> S; S.init(mrows / 256, 4, P.G, P.bid);
            EpiOut E{(bf16_t*)(P.ws + WS_T)};
            pg8::gemm_phase(P.lds, P.tid, Pr, S, E); if (NREP(PHTY) == 2) { __syncthreads(); pg8::gemm_phase(P.lds, P.tid, Pr, S, E); }
            SEAM(g0 + 5);
        }
        if (RUNP(7, g0 + 6)) { LAUNDER(P); for (int rep_ = 0; rep_ < NREP(7); ++rep_) phase_ln1_router(P, l, mrows); SEAM(g0 + 6); }
        if (RUNP(8, g0 + 7)) { LAUNDER(P); for (int rep_ = 0; rep_ < NREP(8); ++rep_) phase_slots(P, mrows); SEAM(g0 + 7); }
        if (RUNP(9, g0 + 8)) {
#undef PHTY
#define PHTY 9
            LAUNDER(P);
            LAS int* seg = (LAS int*)(P.lds + TAB_OFF);
            const int ntile = moe_tables(P, seg);
            ProbMoe1 Pr{(const bf16_t*)(P.ws + WS_H2F8), (const bf16_t*)(P.ws + WS_WGU + (size_t)l * NEXP * 2048 * D), D / 2, D / 2, (const int*)(P.ws + WS_ROUTE + RT_TOK), seg};
            pg8::StaticOrder<1> S; S.init(ntile, 8, P.G, P.bid);
            EpiSwiglu E{(unsigned char*)(P.ws + WS_HID), P.in[IN_BGU] + (size_t)l * NEXP * 2048, seg};
            pg8::gemm_phase(P.lds, P.tid, Pr, S, E); if (NREP(PHTY) == 2) { __syncthreads(); pg8::gemm_phase(P.lds, P.tid, Pr, S, E); }
            SEAM(g0 + 8);
        }
        if (RUNP(10, g0 + 9)) {
#undef PHTY
#define PHTY 10
            LAUNDER(P);
            LAS int* seg = (LAS int*)(P.lds + TAB_OFF);
            const int ntile = moe_tables(P, seg);
            ProbMoe2 Pr{(const bf16_t*)(P.ws + WS_HID), (const bf16_t*)(P.ws + WS_WDN + (size_t)l * NEXP * D * D), D / 2, D / 2, seg};
            pg8::StaticOrder<1> S; S.init(ntile, 4, P.G, P.bid);
            EpiDown E{(unsigned char*)(P.ws + WS_FS), P.in[IN_BDN] + (size_t)l * NEXP * D, (const int*)(P.ws + WS_ROUTE + RT_DEST), (const float*)(P.ws + WS_ROUTE + RT_PSLOT), seg};
            pg8::gemm_phase(P.lds, P.tid, Pr, S, E); if (NREP(PHTY) == 2) { __syncthreads(); pg8::gemm_phase(P.lds, P.tid, Pr, S, E); }
            SEAM(g0 + 9);
        }
        if (RUNP(11, g0 + 10)) { LAUNDER(P); phase_combine_ln2(P, l, mrows); SEAM(g0 + 10); }
    }
#undef LAUNDER
#undef RUN
#undef RUNP
#undef SEAM
}

extern "C" void kernel_launch(void* const* d_in, const int* in_sizes, int n_in, void* d_out, int out_size, void* d_ws, size_t ws_size, hipStream_t stream) {
    static int grid = 0;
    if (grid == 0) {
        if (n_in != 31 || out_size != ML * D || ws_size < WS_END) { fprintf(stderr, "kernel_launch: unexpected problem (n_in %d, out %d, ws %zu, need %zu)\n", n_in, out_size, ws_size, (size_t)WS_END); grid = -1; return; }
        int dev = 0, cus = 0, per_cu = 0;
        if (hipGetDevice(&dev) != hipSuccess || hipDeviceGetAttribute(&cus, hipDeviceAttributeMultiprocessorCount, dev) != hipSuccess) { grid = -1; return; }
        if (hipFuncSetAttribute((const void*)fwd_kernel, hipFuncAttributeMaxDynamicSharedMemorySize, LDS_BYTES) != hipSuccess) { fprintf(stderr, "kernel_launch: hipFuncSetAttribute failed\n"); grid = -1; return; }
        if (hipOccupancyMaxActiveBlocksPerMultiprocessor(&per_cu, (const void*)fwd_kernel, NTHREADS, LDS_BYTES) != hipSuccess || per_cu < 1) fprintf(stderr, "kernel_launch: occupancy query reports %d\n", per_cu);
        (void)hipGetLastError();
        grid = cus;
    }
    if (grid < 0) return;
    (void)hipMemsetAsync((char*)d_ws + WS_CTL, 0, CTL_ZERO_BYTES, stream);
    Args a{};
    for (int i = 0; i < 31; ++i) a.in[i] = (const float*)d_in[i];
    a.out = (float*)d_out; a.ws = (unsigned char*)d_ws;
#if MK_N_LAUNCHES == 1
    a.g_lo = 0; a.g_hi = NGID;
    hipLaunchKernelGGL(fwd_kernel, dim3(grid), dim3(NTHREADS), LDS_BYTES, stream, a);
#else
    for (int g = 0; g < NGID; ++g) { a.g_lo = g; a.g_hi = g + 1; hipLaunchKernelGGL(fwd_kernel, dim3(grid), dim3(NTHREADS), LDS_BYTES, stream, a); }
#endif
}
```

```cpp
#include <hip/hip_runtime.h>
#include <cstdio>
#include <cstdint>

#ifndef MK_N_LAUNCHES
#define MK_N_LAUNCHES 1
#endif

#define LAS __attribute__((address_space(3)))
#define GAS __attribute__((address_space(1)))
typedef unsigned short bf16_t;
typedef short bf16x8 __attribute__((ext_vector_type(8)));
typedef short s16x4 __attribute__((ext_vector_type(4)));
typedef float f32x4 __attribute__((ext_vector_type(4)));
typedef float f32x2 __attribute__((ext_vector_type(2)));
typedef float f32x16 __attribute__((ext_vector_type(16)));
typedef unsigned u32x4 __attribute__((ext_vector_type(4)));
typedef unsigned u32x2 __attribute__((ext_vector_type(2)));
typedef int i32x4 __attribute__((ext_vector_type(4)));
typedef int i32x8 __attribute__((ext_vector_type(8)));

constexpr int D = 1024, NB = 16, SEQ = 4096, CTXL = 256, DEPTH = 4;
constexpr int ML = NB * SEQ;
constexpr int MC = NB * CTXL;
constexpr int MT = ML + MC;
constexpr int NZ = 5888;
constexpr int ZC_P = 0, ZC_QK = 256, ZC_V = 1280, ZC_O = 1792, ZC_UV = 2304, ZC_MG = 2816;
constexpr int NZ_BF = 256, NZ_F8 = 5632;
constexpr int ZG_COL = 2816;
constexpr int NEXP = 32, TOPK = 4;
constexpr int NS_MAX = MT * TOPK + NEXP * 256;
constexpr float LN_EPS = 1e-5f, HEAD_EPS = 1e-6f;
constexpr float DN_ALPHA = 1.6817928305074292f;
constexpr int NWAVES = 8, NTHREADS = 512;
constexpr float F8S_ACT = 4.0f, F8S_WGU = 64.0f, F8S_WDN = 64.0f; constexpr int F8E_ACT = 123, F8E_WGU = 123, F8E_WDN = 123;

constexpr size_t MiB = 1u << 20;
constexpr size_t WS_CTL = 0, CTL_ZERO_BYTES = 1 * MiB;
constexpr size_t WS_MOD = 1 * MiB;
constexpr size_t WS_WG = 3 * MiB;
constexpr size_t WS_WSGU = 4 * MiB;
constexpr size_t WS_WPOOL = WS_WSGU + 512 * 1024;
constexpr size_t WS_ROUTE = 5 * MiB;
constexpr size_t WS_WIN = 16 * MiB;
constexpr size_t WS_WBR = 62 * MiB;
constexpr size_t WS_WOUT = 70 * MiB;
constexpr size_t WS_WGU = 78 * MiB;
constexpr size_t WS_WDN = 590 * MiB;
constexpr size_t WS_X = 846 * MiB;
constexpr size_t WS_H = 1118 * MiB;
constexpr size_t WS_Z = 1254 * MiB;
constexpr size_t WS_FS = WS_Z;
constexpr float G8_SCALE = 255.0f;
constexpr float FS_SCALE = 32.0f, FS_CLAMP = 440.0f;
constexpr size_t WS_BRA = 2036 * MiB;
constexpr size_t WS_HFB = 2172 * MiB;
constexpr size_t WS_Y = 2444 * MiB;
constexpr size_t WS_T = 2580 * MiB;
constexpr size_t WS_H2 = 2852 * MiB;
constexpr size_t WS_HID = 2988 * MiB;
constexpr size_t WS_ZG = 3548 * MiB;
constexpr size_t WS_H2F8 = 3554 * MiB;
constexpr size_t WS_H8 = 3624 * MiB;
constexpr size_t WS_WIN8 = 3692 * MiB;
constexpr size_t WS_END = 3714 * MiB;
static_assert(WS_Z + (size_t)MT * NZ * 2 <= WS_BRA && WS_FS + (size_t)MT * 4 * 1024 * 2 <= WS_BRA, "Z/FS");
static_assert(WS_HID + (size_t)NS_MAX * 1024 * 2 <= WS_END, "HID");
constexpr size_t RT_EIDX = 0;
constexpr size_t RT_PROB = 2 * MiB;
constexpr size_t RT_TOK = 4 * MiB;
constexpr size_t RT_DEST = 6 * MiB;
constexpr size_t RT_PSLOT = 8 * MiB;
constexpr size_t RT_CNT = 10 * MiB;
constexpr size_t RT_SEG = 10 * MiB + 64 * 1024;
constexpr int CW_BAR = 4096;

constexpr int LDS_BYTES = 163840;
constexpr int MISC_OFF = LDS_BYTES - 256;
constexpr int TAB_OFF = 131072;
constexpr int NW_WT = 0;
constexpr int NW_LG = 66048;
constexpr int NW_END = 99840;
constexpr int NW_PV = NW_END + 256;

__device__ __forceinline__ unsigned f2bf(float f) { unsigned u = __builtin_bit_cast(unsigned, f); return (u + 0x7fffu + ((u >> 16) & 1u)) >> 16; }
__device__ __forceinline__ unsigned pk2(float lo, float hi) { unsigned r; asm volatile("v_cvt_pk_bf16_f32 %0, %1, %2" : "=v"(r) : "v"(lo), "v"(hi)); return r; }
__device__ __forceinline__ unsigned pk4_fp8(float a, float b, float c, float d) { int w = 0; w = __builtin_amdgcn_cvt_pk_fp8_f32(a, b, w, false); w = __builtin_amdgcn_cvt_pk_fp8_f32(c, d, w, true); return (unsigned)w; }
__device__ __forceinline__ unsigned pk4_u8(float a, float b, float c, float d) {
    const unsigned lo = __builtin_amdgcn_perm(__builtin_bit_cast(unsigned, b), __builtin_bit_cast(unsigned, a), 0x0c0c0400u), hi = __builtin_amdgcn_perm(__builtin_bit_cast(unsigned, d), __builtin_bit_cast(unsigned, c), 0x0c0c0400u);
    return lo | (hi << 16); }
__device__ __forceinline__ f32x4 u8x4_f32(unsigned w) { return (f32x4){(float)(w & 0xffu), (float)((w >> 8) & 0xffu), (float)((w >> 16) & 0xffu), (float)(w >> 24)}; }
__device__ __forceinline__ float bflo(unsigned w) { return __builtin_bit_cast(float, w << 16); }
__device__ __forceinline__ float bfhi(unsigned w) { return __builtin_bit_cast(float, w & 0xffff0000u); }
__device__ __forceinline__ float bf1(bf16_t h) { return __builtin_bit_cast(float, ((unsigned)h) << 16); }
__device__ __forceinline__ float bperm(int srclane, float v) { return __builtin_bit_cast(float, __builtin_amdgcn_ds_bpermute(srclane << 2, __builtin_bit_cast(int, v))); }
__device__ __forceinline__ float shx(float v, int o, int lane) { return bperm(lane ^ o, v); }
__device__ __forceinline__ float shup(float v, int o, int lane) { return bperm(lane >= o ? lane - o : lane, v); }
__device__ __forceinline__ float wave_sum(float v, int lane) {
#pragma unroll
    for (int o = 1; o < 64; o <<= 1) v += shx(v, o, lane);
    return v;
}
__device__ __forceinline__ float sigmoidf_(float x) { return __builtin_amdgcn_rcpf(1.0f + __builtin_amdgcn_exp2f(x * -1.4426950408889634f)); }
__device__ __forceinline__ float siluf_(float x) { return x * __builtin_amdgcn_rcpf(1.0f + __builtin_amdgcn_exp2f(x * -1.4426950408889634f)); }
__device__ __forceinline__ f32x4 sigmoid4(f32x4 x) {
    f32x4 t = x * -1.4426950408889634f;
#pragma unroll
    for (int i = 0; i < 4; ++i) t[i] = __builtin_amdgcn_exp2f(t[i]);
    t = t + 1.0f;
#pragma unroll
    for (int i = 0; i < 4; ++i) t[i] = __builtin_amdgcn_rcpf(t[i]);
    return t; }
#define LDS_WAIT() asm volatile("s_waitcnt lgkmcnt(0)" ::: "memory")
#define VM_WAIT() asm volatile("s_waitcnt vmcnt(0)" ::: "memory")

#define XB_TMO      128
#define XB_XCNT(j)  (256  + 64 * (j))
#define XB_XSUB(j)  (1280 + 64 * (j))
#define XB_XGEN(j)  (2304 + 64 * (j))
#define XB_TOP      3328
#define XB_TOPGEN   3392
#define XCD_BAR_WORDS 3456
#define XB_SPIN_CAP (1u << 18)
__device__ __forceinline__ unsigned xb_ld(unsigned* p)              { asm volatile("" : "+v"(p)); return __hip_atomic_load(p, __ATOMIC_RELAXED, __HIP_MEMORY_SCOPE_AGENT); }
__device__ __forceinline__ unsigned xb_add(unsigned* p, unsigned v) { asm volatile("" : "+v"(p), "+v"(v)); return __hip_atomic_fetch_add(p, v, __ATOMIC_RELAXED, __HIP_MEMORY_SCOPE_AGENT); }
__device__ __forceinline__ unsigned xb_xcc_id() { return (unsigned)__builtin_amdgcn_s_getreg((3 << 11) | 20) & 0xFu; }
#define XB_SPIN(cond, bar) do { unsigned _sp = 0; while (cond) { __builtin_amdgcn_s_sleep(1); \
    if ((++_sp & 255u) == 0u) { if (xb_ld(&(bar)[XB_TMO])) break; if (_sp > XB_SPIN_CAP) { atomicAdd(&(bar)[XB_TMO], 1u); break; } } } } while (0)
struct XcdBarrier { unsigned* bar; unsigned x; volatile LAS unsigned* st; };
__device__ __forceinline__ XcdBarrier xcd_barrier_post(unsigned* bar, volatile LAS unsigned* st) {
    XcdBarrier b; b.bar = bar; b.x = xb_xcc_id(); b.st = st;
    if (threadIdx.x == 0) (void)xb_add(&bar[XB_XCNT(b.x)], 1u);
    return b;
}
__device__ __forceinline__ void xcd_barrier_complete(unsigned* bar, unsigned x, unsigned& nloc, unsigned& nx) {
    const unsigned G = gridDim.x * gridDim.y * gridDim.z;
    unsigned sum, cnt, mine, sp = 0u;
    for (;;) {
        sum = 0u; cnt = 0u; mine = 0u;
#pragma unroll
        for (unsigned j = 0; j < 16; ++j) { const unsigned c = xb_ld(&bar[XB_XCNT(j)]); sum += c; cnt += (c > 0u) ? 1u : 0u; mine = (j == x) ? c : mine; }
        if (sum == G) break;
        __builtin_amdgcn_s_sleep(1);
        if ((++sp & 255u) == 0u) { if (xb_ld(&bar[XB_TMO])) break; if (sp > XB_SPIN_CAP) { atomicAdd(&bar[XB_TMO], 1u); break; } }
    }
    nloc = mine > 0u ? mine : 1u; nx = cnt > 0u ? cnt : 1u;
}
__device__ __forceinline__ void xcd_barrier(const XcdBarrier& b) {
    asm volatile("s_waitcnt vmcnt(0)" ::: "memory");
    __syncthreads();
    if (threadIdx.x == 0) {
        unsigned* bar = b.bar;
        __builtin_amdgcn_s_waitcnt(0);
        unsigned nloc = b.st[0], nx = b.st[1];
        if (nloc == 0u) { xcd_barrier_complete(bar, b.x, nloc, nx); b.st[0] = nloc; b.st[1] = nx; }
        const unsigned old = xb_add(&bar[XB_XSUB(b.x)], 1u);
        const unsigned gen = old / nloc;
        if (old + 1u == (gen + 1u) * nloc) {
            __builtin_amdgcn_fence(__ATOMIC_RELEASE, "agent");
            asm volatile("s_waitcnt vmcnt(0)" ::: "memory");
            const unsigned og = xb_add(&bar[XB_TOP], 1u);
            const unsigned tg = og / nx;
            if (og + 1u == (tg + 1u) * nx) xb_add(&bar[XB_TOPGEN], 1u);
            else XB_SPIN(xb_ld(&bar[XB_TOPGEN]) == tg, bar);
            __builtin_amdgcn_fence(__ATOMIC_ACQUIRE, "agent");
            xb_add(&bar[XB_XGEN(b.x)], 1u);
            asm volatile("s_waitcnt vmcnt(0)" ::: "memory");
        } else {
            XB_SPIN(xb_ld(&bar[XB_XGEN(b.x)]) == gen, bar);
            __builtin_amdgcn_fence(__ATOMIC_ACQUIRE, "agent");
            asm volatile("s_waitcnt vmcnt(0)" ::: "memory");
        }
    }
    __syncthreads();
}

namespace pg8 {
constexpr int BM = 256, BK = 64, HALF = 128, HTB = HALF * BK * 2, STAGE_BYTES = 8 * HTB, NXCD = 8, WGM = 8;
__host__ __device__ __forceinline__ int lds_byte(int r, int c) { const int st = (r >> 4) * 2 + (c >> 5), rr = r & 15, cc = c & 31, ob = rr * 64 + cc * 2; return st * 1024 + (ob ^ (((ob >> 9) & 1) << 5)); }
__host__ __device__ __forceinline__ void stage_rc(int b, int& R, int& C) { const int st = b / 1024, sb = b % 1024, swz = sb ^ (((sb >> 9) & 1) << 5); R = (st >> 1) * 16 + swz / 64; C = (st & 1) * 32 + (swz % 64) / 2; }
__host__ __device__ __forceinline__ int perm32(int rho) { const int n = rho >> 4, i = rho & 15; return 8 * (i >> 2) + 4 * n + (i & 3); }
struct Unit { int pm, pn, sub; };
__device__ __forceinline__ unsigned cvt_pk_bf16(float lo, float hi) { unsigned r; asm volatile("v_cvt_pk_bf16_f32 %0, %1, %2" : "=v"(r) : "v"(lo), "v"(hi)); return r; }
__device__ __forceinline__ f32x2 gelu_pk(f32x2 v) {
    const f32x2 av = __builtin_elementwise_abs(v), d = av * 0.2316418882f + 1.0f;
    f32x2 t; t.x = __builtin_amdgcn_rcpf(d.x); t.y = __builtin_amdgcn_rcpf(d.y);
    f32x2 q = t * 0.5307027145f + (-0.7265760135f); q = q * t + 0.7107068705f; q = q * t + (-0.142248368f); q = q * t + 0.127414796f; q = q * t;
    const f32x2 s = (v * v) * (-0.72134752044f);
    f32x2 e; e.x = __builtin_amdgcn_exp2f(s.x); e.y = __builtin_amdgcn_exp2f(s.y);
    const f32x2 m = v * (q * e), r = v - m;
    f32x2 o; o.x = v.x < 0.f ? m.x : r.x; o.y = v.y < 0.f ? m.y : r.y; return o;
}
template <int NSUB = 1> struct StaticOrder {
    int nM, nN, nwg, G, c;
    __device__ void init(int nM_, int nN_, int G_, int c_) { nM = nM_; nN = nN_; nwg = nM * nN; G = G_; c = c_; }
    __device__ bool next(int i, Unit& u) const {
        const int it = i / NSUB; u.sub = i - it * NSUB;
        const long L = (long)it * G + c; if (L >= nwg) return false;
        int wgid = (int)L; { const int q = nwg / NXCD, r = nwg % NXCD, xcd = wgid % NXCD, off = wgid / NXCD; wgid = (xcd < r ? xcd * (q + 1) : r * (q + 1) + (xcd - r) * q) + off; }
        const int nig = WGM * nN, gid = wgid / nig, fm = gid * WGM, gsz = (nM - fm) < WGM ? (nM - fm) : WGM;
        u.pm = fm + ((wgid % nig) % gsz); u.pn = (wgid % nig) / gsz; return true;
    }
};
constexpr int SIDE_TOK = 131072 + 2048;
constexpr int SIDE_SLOT = 131072 + 10240, SIDE_SLOT_BYTES = 3072;
__device__ __forceinline__ void dma16(unsigned voff, const void* sbase, unsigned ldsaddr) { asm volatile("s_mov_b32 m0, %2\n\tglobal_load_lds_dwordx4 %0, %1" :: "v"(voff), "s"(sbase), "s"(ldsaddr) : "memory", "m0"); }
__device__ __forceinline__ void dma4(unsigned voff, const void* sbase, unsigned ldsaddr) { asm volatile("s_mov_b32 m0, %2\n\tglobal_load_lds_dword %0, %1" :: "v"(voff), "s"(sbase), "s"(ldsaddr) : "memory", "m0"); }
template <class Prob, class Sched, class Epi>
__device__ __forceinline__ void gemm_phase(LAS unsigned char* lds, const int tid, const Prob& P, const Sched& S, const Epi& E) {
    const int wid = __builtin_amdgcn_readfirstlane(tid >> 6), lane = tid & 63, wr = wid >> 2, wc = wid & 3, fr = lane & 15, fq = lane >> 4;
    const int lda = P.lda, ldb = P.ldb;
    unsigned voffB[2], offA[2][2];
#define PG8_TOKSLOT(name) const LAS int* name; { PG8_TID(tl2_); name = (const LAS int*)(lds + SIDE_TOK) + (tl2_ >> 6) * 256 + (tl2_ & 63); }
#define PG8_TID(v_) int v_; asm volatile("v_mbcnt_lo_u32_b32 %0, -1, 0\n\tv_mbcnt_hi_u32_b32 %0, -1, %0" : "=v"(v_)); v_ |= (wid << 6)
#define PG8_RC(R_, C_) int R_[2], C_[2]; { PG8_TID(tl_); _Pragma("unroll") for (int i_ = 0; i_ < 2; ++i_) stage_rc(tl_ * 16 + i_ * 8192, R_[i_], C_[i_]); }
#pragma unroll
    for (int i = 0; i < 2; ++i) { int R, C; stage_rc(tid * 16 + i * 8192, R, C); const int Rb = Epi::PERM ? ((R & ~31) + perm32(R & 31)) : R;
        voffB[i] = (unsigned)(Rb * ldb + C) * 2u;
        offA[0][i] = (unsigned)(R * lda + C) * 2u; offA[1][i] = (unsigned)((R + HALF) * lda + C) * 2u; }
    const size_t kstep = (size_t)(BK * 2);
    const size_t hstep = (size_t)HALF * ldb * 2;
    const unsigned ldsw = (unsigned)wid * 1024u;
    const int aoff = lds_byte(wr * 64 + fr, fq * 8), boff = lds_byte(wc * 32 + fr, fq * 8);
#define PG8_SA(b, h) (((b) * 2 + (h)) * HTB)
#define PG8_SB(b, h) ((4 + (b) * 2 + (h)) * HTB)
    const unsigned ldsb = (unsigned)(size_t)lds;
#define PG8_STAGE(bufoff, gbase, voff) do { _Pragma("unroll") for (int _i = 0; _i < 2; ++_i) \
        asm volatile("s_mov_b32 m0, %2\n\tglobal_load_lds_dwordx4 %0, %1" :: "v"((voff)[_i]), "s"((const char*)(gbase)), "s"(ldsb + (unsigned)(bufoff) + ldsw + (unsigned)(_i * 8192)) : "memory", "m0"); } while (0)
#define PG8_CAT(x0, x1) __builtin_shufflevector(x0, x1, 0, 1, 2, 3, 4, 5, 6, 7)
#define PG8_LDA(dst, b, h) do { if constexpr (Prob::FP8) { _Pragma("unroll") for (int m = 0; m < 4; ++m) dst##8[m] = PG8_CAT(*(const LAS i32x4*)(lds + PG8_SA(b, h) + aoff + m * 2048), *(const LAS i32x4*)(lds + PG8_SA(b, h) + aoff + m * 2048 + 1024)); } \
        else { _Pragma("unroll") for (int m = 0; m < 4; ++m) _Pragma("unroll") for (int k = 0; k < 2; ++k) dst[m][k] = *(const LAS bf16x8*)(lds + PG8_SA(b, h) + aoff + m * 2048 + k * 1024); } } while (0)
#define PG8_LDB(dst, b, h) do { if constexpr (Prob::FP8) { _Pragma("unroll") for (int n = 0; n < 2; ++n) dst##8[n] = PG8_CAT(*(const LAS i32x4*)(lds + PG8_SB(b, h) + boff + n * 2048), *(const LAS i32x4*)(lds + PG8_SB(b, h) + boff + n * 2048 + 1024)); } \
        else { _Pragma("unroll") for (int n = 0; n < 2; ++n) _Pragma("unroll") for (int k = 0; k < 2; ++k) dst[n][k] = *(const LAS bf16x8*)(lds + PG8_SB(b, h) + boff + n * 2048 + k * 1024); } } while (0)
#define PG8_MMA(ai, bj, At, Bt) do { __builtin_amdgcn_s_setprio(1); \
        if constexpr (Prob::FP8) { _Pragma("unroll") for (int m = 0; m < 4; ++m) _Pragma("unroll") for (int n = 0; n < 2; ++n) \
            acc[ai][bj][m][n] = __builtin_amdgcn_mfma_scale_f32_16x16x128_f8f6f4(Bt##8[n], At##8[m], acc[ai][bj][m][n], 0, 0, 0, sc8_, 0, sc8_); } \
        else { _Pragma("unroll") for (int m = 0; m < 4; ++m) _Pragma("unroll") for (int n = 0; n < 2; ++n) _Pragma("unroll") for (int k = 0; k < 2; ++k) \
            acc[ai][bj][m][n] = __builtin_amdgcn_mfma_f32_16x16x32_bf16(Bt[n][k], At[m][k], acc[ai][bj][m][n], 0, 0, 0); } \
        __builtin_amdgcn_s_setprio(0); } while (0)
#define PG8_WAIT_V(n) asm volatile("s_waitcnt vmcnt(" #n ")" ::: "memory")
#define PG8_WAIT_L(n) asm volatile("s_waitcnt lgkmcnt(" #n ")" ::: "memory")
#define PG8_BAR __builtin_amdgcn_s_barrier()
#define PG8_SCHED __builtin_amdgcn_sched_barrier(0)
    Unit cur, nxt; int ui = 0;
    if (!S.next(0, cur)) return;
    static_assert(Prob::SCALE_A == Prob::SCALE_B, "one scale register serves both operands");
    int sc8_; asm volatile("v_mov_b32 %0, %1" : "=v"(sc8_) : "n"(Prob::SCALE_A));
    f32x4 acc[2][2][4][2];
    float zero_; asm volatile("v_mov_b32 %0, 0" : "=v"(zero_));
#pragma unroll
    for (int a = 0; a < 2; ++a)
#pragma unroll
        for (int b = 0; b < 2; ++b)
#pragma unroll
            for (int m = 0; m < 4; ++m)
#pragma unroll
                for (int n = 0; n < 2; ++n) acc[a][b][m][n] = (f32x4){zero_, zero_, zero_, zero_};
    bf16x8 At[4][2], B0[2][2], B1[2][2]; i32x8 At8[4], B08[2], B18[2];
    const char* cA = P.a_base(cur); const char* cB = P.b_base(cur); int nt = P.nt(cur);
    if constexpr (Prob::GATHER) { PG8_RC(Rr, Cc); P.a_rows(cur, Rr, Cc, offA); }
    if constexpr (Epi::SIDE) { PG8_TID(tl4_); E.side(cur, ldsb + SIDE_SLOT, wid, tl4_ & 63); }
    PG8_STAGE(PG8_SB(0, 0), cB, voffB); PG8_STAGE(PG8_SB(0, 1), cB + hstep, voffB); PG8_STAGE(PG8_SA(0, 0), cA, offA[0]); PG8_STAGE(PG8_SA(0, 1), cA, offA[1]);
    if (wr == 1) PG8_BAR;
    PG8_WAIT_V(2); PG8_BAR;
    PG8_STAGE(PG8_SB(1, 0), cB + kstep, voffB); PG8_STAGE(PG8_SA(1, 0), cA + kstep, offA[0]); PG8_STAGE(PG8_SB(1, 1), cB + hstep + kstep, voffB);
    PG8_WAIT_V(6); PG8_BAR;
    for (;;) {
        const bool has_next = S.next(ui + 1, nxt);
        const char* nA = has_next ? P.a_base(nxt) : cA; const char* nB = has_next ? P.b_base(nxt) : cB;
        if constexpr (Prob::GATHER) { if (has_next) { PG8_RC(Rr, Cc); (void)Cc;
#pragma unroll
            for (int h = 0; h < 2; ++h)
#pragma unroll
                for (int i = 0; i < 2; ++i) dma4((unsigned)(nxt.pm * 256 + h * 128 + Rr[i]) * 4u, P.tok, ldsb + SIDE_TOK + (unsigned)wid * 1024u + (unsigned)((h * 2 + i) * 256)); } }
        if constexpr (Epi::SIDE) { if (has_next) { PG8_TID(tl4_); E.side(nxt, ldsb + SIDE_SLOT + (unsigned)(((ui + 1) % 3) * SIDE_SLOT_BYTES), wid, tl4_ & 63); } }
        for (int t = 0; t < nt; t += 2) {
            const bool last = (t == nt - 2);
            if constexpr (Epi::KHOOK) { if (t == Epi::HOOK_T0 || t == Epi::HOOK_T1) {
                asm volatile("" ::: "memory"); PG8_TID(tlh_); const int lnh_ = tlh_ & 63; E.hook(acc, cur, t == Epi::HOOK_T0 ? 0 : 1, wr, wc, lnh_ & 15, lnh_ >> 4); asm volatile("" ::: "memory"); } }
            const char* a1 = cA + (size_t)(t + 1) * kstep;
            const char* a2 = last ? nA : cA + (size_t)(t + 2) * kstep; const char* b2 = last ? nB : cB + (size_t)(t + 2) * kstep;
            const char* a3 = a2 + kstep; const char* b3 = b2 + kstep;
            PG8_LDB(B0, 0, 0); PG8_LDB(B1, 0, 1); PG8_SCHED; PG8_LDA(At, 0, 0); PG8_STAGE(PG8_SA(1, 1), a1, offA[1]);
            PG8_WAIT_V(8); PG8_WAIT_L(0); PG8_BAR; PG8_MMA(0, 0, At, B0); PG8_MMA(0, 1, At, B1); PG8_BAR; PG8_SCHED;
            if constexpr (Prob::GATHER) { if (last && has_next) { PG8_RC(Rr, Cc); (void)Rr; PG8_TOKSLOT(tokslot); const int ntok[2][2] = {{tokslot[0], tokslot[64]}, {tokslot[128], tokslot[192]}}; P.a_off(ntok, Cc, offA); } }
            PG8_LDA(At, 0, 1); PG8_STAGE(PG8_SB(0, 0), b2, voffB); PG8_STAGE(PG8_SB(0, 1), b2 + hstep, voffB); PG8_STAGE(PG8_SA(0, 0), a2, offA[0]);
            PG8_WAIT_V(8); PG8_WAIT_L(0); PG8_BAR; PG8_MMA(1, 0, At, B0); PG8_MMA(1, 1, At, B1); PG8_BAR; PG8_SCHED;
            PG8_LDB(B0, 1, 0); PG8_LDB(B1, 1, 1); PG8_SCHED; PG8_LDA(At, 1, 0); PG8_STAGE(PG8_SA(0, 1), a2, offA[1]);
            PG8_WAIT_V(8); PG8_WAIT_L(0); PG8_BAR; PG8_MMA(0, 0, At, B0); PG8_MMA(0, 1, At, B1); PG8_BAR; PG8_SCHED;
            PG8_LDA(At, 1, 1); PG8_STAGE(PG8_SB(1, 0), b3, voffB); PG8_STAGE(PG8_SB(1, 1), b3 + hstep, voffB); PG8_STAGE(PG8_SA(1, 0), a3, offA[0]);
            PG8_WAIT_V(8); PG8_WAIT_L(0); PG8_BAR; PG8_MMA(1, 0, At, B0); PG8_MMA(1, 1, At, B1); PG8_BAR; PG8_SCHED;
        }
        if (wr == 0) PG8_BAR;
        { PG8_TID(tl3_); const int ln_ = tl3_ & 63; E(acc, cur, wr, wc, ln_ & 15, ln_ >> 4, lds + SIDE_SLOT + (ui % 3) * SIDE_SLOT_BYTES); }
        if (!has_next) break;
        bool keep = false;
        if constexpr (Epi::CHAIN) keep = E.keep(cur);
        if (!keep) {
            asm volatile("v_mov_b32 %0, 0" : "=v"(zero_));
#pragma unroll
            for (int a = 0; a < 2; ++a)
#pragma unroll
                for (int b = 0; b < 2; ++b)
#pragma unroll
                    for (int m = 0; m < 4; ++m)
#pragma unroll
                        for (int n = 0; n < 2; ++n) acc[a][b][m][n] = (f32x4){zero_, zero_, zero_, zero_};
        }
        cur = nxt; cA = nA; cB = nB; nt = P.nt(cur); ++ui;
        if (wr == 1) PG8_BAR;
    }
    PG8_WAIT_V(0);
    PG8_BAR;
#undef PG8_RC
#undef PG8_TID
#undef PG8_TOKSLOT
#undef PG8_SA
#undef PG8_SB
#undef PG8_STAGE
#undef PG8_LDA
#undef PG8_LDB
#undef PG8_MMA
#undef PG8_CAT
#undef PG8_WAIT_V
#undef PG8_WAIT_L
#undef PG8_BAR
#undef PG8_SCHED
}
}

typedef const float* cfp_t;
typedef const cfp_t __attribute__((address_space(4))) * InTab;
struct Frame {
    LAS unsigned char* lds;
    volatile LAS unsigned* MISC;
    unsigned char* ws;
    InTab in;
    float* out;
    int tid, lane, wave, G, bid;
};
enum { IN_X = 0, IN_C, IN_CTX, IN_CCTX, IN_WADA, IN_BADA, IN_WIN, IN_BIN, IN_POOLW, IN_POOLS, IN_CONVW, IN_CONVB, IN_MNG, IN_SLNG, IN_SLNB, IN_SGUW, IN_SGUB,
       IN_WBP, IN_WBM, IN_WBS, IN_WOUT, IN_LN1G, IN_LN1B, IN_WR, IN_BR, IN_WGU, IN_BGU, IN_WDN, IN_BDN, IN_LN2G, IN_LN2B };
__device__ __forceinline__ int mod_row(int row) { return row < ML ? (row >> 12) : NB; }
__device__ __forceinline__ const float* modp(const Frame& F, int l, int row, int part) { return (const float*)(F.ws + WS_MOD) + ((size_t)(l * 17 + mod_row(row)) * 6 + part) * 1024; }

__device__ __forceinline__ void transpose_item(const float* W, size_t ldw, int k0, int srccol0, bf16_t* dst, size_t ldk, int kd0, LAS float* scr, int lane) {
#pragma unroll 8
    for (int i = 0; i < 32; ++i) { const int kk = 2 * i + (lane >> 5); scr[kk * 33 + (lane & 31)] = __builtin_nontemporal_load(W + (size_t)(k0 + kk) * ldw + srccol0 + (lane & 31)); }
    LDS_WAIT(); asm volatile("" ::: "memory");
    const int c = lane & 7;
#pragma unroll
    for (int j = 0; j < 4; ++j) { const int n = (lane >> 3) + 8 * j; const LAS float* s = scr + (8 * c) * 33 + n;
        u32x4 o; o.x = pk2(s[0 * 33], s[1 * 33]); o.y = pk2(s[2 * 33], s[3 * 33]); o.z = pk2(s[4 * 33], s[5 * 33]); o.w = pk2(s[6 * 33], s[7 * 33]);
        *(u32x4*)(dst + (size_t)n * ldk + kd0 + 8 * c) = o; }
    LDS_WAIT(); asm volatile("" ::: "memory");
}
__device__ __forceinline__ void transpose_item_fp8(const float* W, size_t ldw, int k0, int srccol0, unsigned char* dst, size_t ldk, int kd0, float sc, LAS float* scr, int lane) {
#pragma unroll 8
    for (int i = 0; i < 32; ++i) { const int kk = 2 * i + (lane >> 5); scr[kk * 33 + (lane & 31)] = __builtin_nontemporal_load(W + (size_t)(k0 + kk) * ldw + srccol0 + (lane & 31)); }
    LDS_WAIT(); asm volatile("" ::: "memory");
    const int c = lane & 7;
#pragma unroll
    for (int j = 0; j < 4; ++j) { const int n = (lane >> 3) + 8 * j; const LAS float* s_ = scr + (8 * c) * 33 + n;
        u32x2 o; o.x = pk4_fp8(s_[0 * 33] * sc, s_[1 * 33] * sc, s_[2 * 33] * sc, s_[3 * 33] * sc); o.y = pk4_fp8(s_[4 * 33] * sc, s_[5 * 33] * sc, s_[6 * 33] * sc, s_[7 * 33] * sc);
        *(u32x2*)(dst + (size_t)n * ldk + kd0 + 8 * c) = o; }
    LDS_WAIT(); asm volatile("" ::: "memory");
}
__device__ __forceinline__ void phase_prologue(Frame& F) {
    LAS float* scr = (LAS float*)(F.lds + F.wave * 16384);
    const int gw = F.bid * NWAVES + F.wave, NGW = F.G * NWAVES;
    constexpr int I_IN = 16 * (NZ / 32);
    constexpr int I_BR = (4 + 8 + 4) * 32;
    constexpr int I_OUT = 16 * 32;
    constexpr int I_GU = 16 * 64;
    constexpr int I_DN = 16 * 32;
    constexpr int T_IN = DEPTH * I_IN, T_BR = DEPTH * I_BR, T_OUT = DEPTH * I_OUT, T_GU = DEPTH * NEXP * I_GU, T_DN = DEPTH * NEXP * I_DN;
    constexpr int NITEMS = T_IN + T_BR + T_OUT + T_GU + T_DN;
    for (int it = gw; it < NITEMS; it += NGW) {
        int r = it;
        if (r < T_IN) { const int l = r / I_IN; r %= I_IN; const int kb = r / (NZ / 32), nb = r % (NZ / 32); const int n0 = nb * 32, src = n0 < 2304 ? n0 : n0 + 16;
            if (n0 < NZ_BF) transpose_item(F.in[IN_WIN] + (size_t)l * D * 5904, 5904, kb * 64, src, (bf16_t*)(F.ws + WS_WIN) + ((size_t)l * NZ + n0) * D, D, kb * 64, scr, F.lane);
            else transpose_item_fp8(F.in[IN_WIN] + (size_t)l * D * 5904, 5904, kb * 64, src, (unsigned char*)(F.ws + WS_WIN8) + ((size_t)l * NZ_F8 + (n0 - NZ_BF)) * D, D, kb * 64, F8S_WGU, scr, F.lane);
            continue; }
        r -= T_IN;
        if (r < T_BR) { const int l = r / I_BR; r %= I_BR; const int kb = r / 32, nb = r % 32;
            const float* W; int ksrc;
            if (kb < 4) { W = F.in[IN_WBP] + (size_t)l * 256 * D; ksrc = kb * 64; } else if (kb < 12) { W = F.in[IN_WBM] + (size_t)l * 512 * D; ksrc = (kb - 4) * 64; } else { W = F.in[IN_WBS] + (size_t)l * 256 * D; ksrc = (kb - 12) * 64; }
            transpose_item(W, D, ksrc, nb * 32, (bf16_t*)(F.ws + WS_WBR) + ((size_t)l * D + nb * 32) * D, D, kb * 64, scr, F.lane); continue; }
        r -= T_BR;
        if (r < T_OUT) { const int l = r / I_OUT; r %= I_OUT; const int kb = r / 32, nb = r % 32;
            transpose_item(F.in[IN_WOUT] + (size_t)l * D * D, D, kb * 64, nb * 32, (bf16_t*)(F.ws + WS_WOUT) + ((size_t)l * D + nb * 32) * D, D, kb * 64, scr, F.lane); continue; }
        r -= T_OUT;
        if (r < T_GU) { const int le = r / I_GU; r %= I_GU; const int kb = r / 64, nb = r % 64; const int n0 = nb * 32;
            const int pn = n0 >> 8, c = n0 & 255; const int src = c < 128 ? (128 * pn + c) : (1024 + 128 * pn + c - 128);
            transpose_item_fp8(F.in[IN_WGU] + (size_t)le * D * 2048, 2048, kb * 64, src, (unsigned char*)(F.ws + WS_WGU) + ((size_t)le * 2048 + n0) * D, D, kb * 64, F8S_WGU, scr, F.lane); continue; }
        r -= T_GU;
        { const int le = r / I_DN; r %= I_DN; const int kb = r / 32, nb = r % 32;
            transpose_item_fp8(F.in[IN_WDN] + (size_t)le * D * D, D, kb * 64, nb * 32, (unsigned char*)(F.ws + WS_WDN) + ((size_t)le * D + nb * 32) * D, D, kb * 64, F8S_WDN, scr, F.lane); }
    }
    { const int gt = F.bid * NTHREADS + F.tid, NGT = F.G * NTHREADS;
      for (int i = gt; i < DEPTH * 16 * 1024; i += NGT) { const int l = i >> 14, g = (i >> 10) & 15, k = i & 1023; ((float*)(F.ws + WS_WG))[i] = F.in[IN_WIN][((size_t)l * D + k) * 5904 + 2304 + g]; }
      for (int i = gt; i < DEPTH * 4 * 128 * 128; i += NGT) ((bf16_t*)(F.ws + WS_WSGU))[i] = (bf16_t)f2bf(F.in[IN_SGUW][i]);
      for (int i = gt; i < DEPTH * 4 * 64 * 64; i += NGT) { const int lg = i >> 12, d = (i >> 6) & 63, c = i & 63; ((bf16_t*)(F.ws + WS_WPOOL))[i] = (bf16_t)f2bf(F.in[IN_POOLW][(size_t)lg * 4096 + c * 64 + d]); } }
    __syncthreads();
    { LAS float* sc = (LAS float*)F.lds;
      LAS float* part = (LAS float*)(F.lds + 71680);
      for (int i = F.tid; i < 17 * 1024; i += NTHREADS) { const int r = i >> 10, k = i & 1023; const float v = r < 16 ? F.in[IN_C][r * 1024 + k] : F.in[IN_CCTX][k]; sc[i] = siluf_(v); }
      __syncthreads();
      for (int u = F.bid; u < DEPTH * 48; u += F.G) {
          const int l = u / 48, n0 = (u % 48) * 128, col = F.tid & 127, ks = F.tid >> 7;
          float a[17];
#pragma unroll
          for (int r = 0; r < 17; ++r) a[r] = 0.f;
          const float* W = F.in[IN_WADA] + (size_t)l * D * 6144 + n0 + col;
          for (int k = ks * 256; k < ks * 256 + 256; ++k) { const float w = W[(size_t)k * 6144];
#pragma unroll
              for (int r = 0; r < 17; ++r) a[r] += sc[r * 1024 + k] * w; }
#pragma unroll
          for (int r = 0; r < 17; ++r) part[(ks * 17 + r) * 128 + col] = a[r];
          __syncthreads();
          for (int i = F.tid; i < 17 * 128; i += NTHREADS) { const int r = i >> 7, cc = i & 127;
              const float s = part[(0 * 17 + r) * 128 + cc] + part[(1 * 17 + r) * 128 + cc] + part[(2 * 17 + r) * 128 + cc] + part[(3 * 17 + r) * 128 + cc] + F.in[IN_BADA][l * 6144 + n0 + cc];
              ((float*)(F.ws + WS_MOD))[(size_t)(l * 17 + r) * 6144 + n0 + cc] = s; }
          __syncthreads();
      } }
}

struct RowV { f32x4 v[4]; };
#define RC(lane, j) (8 * (lane) + 512 * ((j) >> 1) + 4 * ((j) & 1))
__device__ __forceinline__ void row_load(RowV& r, const float* p, int lane) {
#pragma unroll
    for (int j = 0; j < 4; ++j) r.v[j] = __builtin_nontemporal_load((const f32x4*)(p + RC(lane, j)));
}
__device__ __forceinline__ void row_load_bf16(RowV& r, const bf16_t* p, int lane) {
#pragma unroll
    for (int h = 0; h < 2; ++h) { const u32x4 w = __builtin_nontemporal_load((const u32x4*)(p + 8 * lane + 512 * h)); r.v[2 * h] = (f32x4){bflo(w.x), bfhi(w.x), bflo(w.y), bfhi(w.y)}; r.v[2 * h + 1] = (f32x4){bflo(w.z), bfhi(w.z), bflo(w.w), bfhi(w.w)}; }
}
__device__ __forceinline__ void row_store(const RowV& r, float* p, int lane) {
#pragma unroll
    for (int j = 0; j < 4; ++j) *(f32x4*)(p + RC(lane, j)) = r.v[j];
}
__device__ __forceinline__ void row_store_nt(const RowV& r, float* p, int lane) {
#pragma unroll
    for (int j = 0; j < 4; ++j) __builtin_nontemporal_store(r.v[j], (f32x4*)(p + RC(lane, j)));
}
__device__ __forceinline__ void row_store_bf16_nt(const RowV& r, bf16_t* p, int lane) {
#pragma unroll
    for (int h = 0; h < 2; ++h) { u32x4 w; w.x = pk2(r.v[2 * h].x, r.v[2 * h].y); w.y = pk2(r.v[2 * h].z, r.v[2 * h].w); w.z = pk2(r.v[2 * h + 1].x, r.v[2 * h + 1].y); w.w = pk2(r.v[2 * h + 1].z, r.v[2 * h + 1].w); __builtin_nontemporal_store(w, (u32x4*)(p + 8 * lane + 512 * h)); }
}
__device__ __forceinline__ void row_store_bf16(const RowV& r, bf16_t* p, int lane) {
#pragma unroll
    for (int h = 0; h < 2; ++h) { u32x4 w; w.x = pk2(r.v[2 * h].x, r.v[2 * h].y); w.y = pk2(r.v[2 * h].z, r.v[2 * h].w); w.z = pk2(r.v[2 * h + 1].x, r.v[2 * h + 1].y); w.w = pk2(r.v[2 * h + 1].z, r.v[2 * h + 1].w); *(u32x4*)(p + 8 * lane + 512 * h) = w; }
}
__device__ __forceinline__ void row_ln_plain(RowV& r, int lane) {
    float s = 0.f;
#pragma unroll
    for (int j = 0; j < 4; ++j) s += (r.v[j].x + r.v[j].y) + (r.v[j].z + r.v[j].w);
    const float mean = wave_sum(s, lane) * (1.f / D); float s2 = 0.f;
#pragma unroll
    for (int j = 0; j < 4; ++j) { r.v[j] = r.v[j] - mean; s2 += (r.v[j].x * r.v[j].x + r.v[j].y * r.v[j].y) + (r.v[j].z * r.v[j].z + r.v[j].w * r.v[j].w); }
    const float rstd = 1.f / sqrtf(wave_sum(s2, lane) * (1.f / D) + LN_EPS);
#pragma unroll
    for (int j = 0; j < 4; ++j) r.v[j] = r.v[j] * rstd;
}
__device__ __forceinline__ void row_affine(RowV& r, const float* g, const float* b, int lane) {
#pragma unroll
    for (int j = 0; j < 4; ++j) { const f32x4 gg = *(const f32x4*)(g + RC(lane, j)), bb = *(const f32x4*)(b + RC(lane, j)); r.v[j] = r.v[j] * gg + bb; }
}
__device__ __forceinline__ void row_modulate(RowV& r, const float* sh, const float* sc, int lane) {
#pragma unroll
    for (int j = 0; j < 4; ++j) { const f32x4 s1 = *(const f32x4*)(sc + RC(lane, j)), s0 = *(const f32x4*)(sh + RC(lane, j)); r.v[j] = r.v[j] * (s1 + 1.0f) + s0; }
}
__device__ __forceinline__ LAS float* pv_slot(const Frame& F, int slot) { return (LAS float*)(F.lds + NW_PV) + slot * 1024; }
__device__ __forceinline__ void pv_fill(Frame& F, int slot, const float* src) { LAS f32x4* d = (LAS f32x4*)pv_slot(F, slot); for (int i = F.tid; i < 256; i += NTHREADS) d[i] = *(const f32x4*)(src + 4 * i); }
__device__ __forceinline__ void row_affine_l(RowV& r, const LAS float* g, const LAS float* b, int lane) {
#pragma unroll
    for (int j = 0; j < 4; ++j) { const f32x4 gg = *(const LAS f32x4*)(g + RC(lane, j)), bb = *(const LAS f32x4*)(b + RC(lane, j)); r.v[j] = r.v[j] * gg + bb; }
}
__device__ __forceinline__ void row_modulate_l(RowV& r, const LAS float* sh, const LAS float* sc, int lane) {
#pragma unroll
    for (int j = 0; j < 4; ++j) { const f32x4 s1 = *(const LAS f32x4*)(sc + RC(lane, j)), s0 = *(const LAS f32x4*)(sh + RC(lane, j)); r.v[j] = r.v[j] * (s1 + 1.0f) + s0; }
}
__device__ __forceinline__ void ln0_row(Frame& F, int row, RowV xr, const LAS float* sh, const LAS float* sc) {
    row_ln_plain(xr, F.lane);
    row_modulate_l(xr, sh, sc, F.lane);
    row_store_bf16(xr, (bf16_t*)(F.ws + WS_H) + (size_t)row * D, F.lane);
    { unsigned char* h8 = (unsigned char*)(F.ws + WS_H8) + (size_t)row * D + 8 * F.lane;
#pragma unroll
      for (int h = 0; h < 2; ++h) { u32x2 w; w.x = pk4_fp8(xr.v[2 * h].x * F8S_ACT, xr.v[2 * h].y * F8S_ACT, xr.v[2 * h].z * F8S_ACT, xr.v[2 * h].w * F8S_ACT); w.y = pk4_fp8(xr.v[2 * h + 1].x * F8S_ACT, xr.v[2 * h + 1].y * F8S_ACT, xr.v[2 * h + 1].z * F8S_ACT, xr.v[2 * h + 1].w * F8S_ACT); *(u32x2*)(h8 + 512 * h) = w; } }
}
__device__ __forceinline__ LAS float* narrow_tile_wave(Frame& F, const bf16_t* A) {
    const int r = F.lane & 31, h = F.lane >> 5;
    f32x16 acc;
#pragma unroll
    for (int i = 0; i < 16; ++i) acc[i] = 0.f;
    const bf16_t* ap = A + (size_t)r * D + 8 * h;
    const LAS unsigned char* bp = F.lds + NW_WT + r * 2064 + 16 * h;
    bf16x8 av[2][16];
#pragma unroll
    for (int ks = 0; ks < 16; ++ks) av[0][ks] = *(const bf16x8*)(ap + ks * 16);
#pragma unroll
    for (int kb = 0; kb < 4; ++kb) {
        if (kb < 3) {
#pragma unroll
            for (int ks = 0; ks < 16; ++ks) av[(kb + 1) & 1][ks] = *(const bf16x8*)(ap + ((kb + 1) * 16 + ks) * 16); }
        __builtin_amdgcn_sched_barrier(0);
#pragma unroll
        for (int ks = 0; ks < 16; ++ks) { const bf16x8 b = *(const LAS bf16x8*)(bp + (kb * 16 + ks) * 32); acc = __builtin_amdgcn_mfma_f32_32x32x16_bf16(av[kb & 1][ks], b, acc, 0, 0, 0); }
        __builtin_amdgcn_sched_barrier(0);
    }
    LAS float* lg = (LAS float*)(F.lds + NW_LG) + F.wave * 1056;
#pragma unroll
    for (int i = 0; i < 16; ++i) lg[((i & 3) + 8 * (i >> 2) + 4 * h) * 33 + r] = acc[i];
    asm volatile("s_waitcnt lgkmcnt(0)" ::: "memory");
    return lg;
}
__device__ __forceinline__ void tile_range(const Frame& F, int mrows, int& t_lo, int& t_hi) { const int nt = mrows / 32; t_lo = (int)(((long)F.bid * nt) / F.G); t_hi = (int)(((long)(F.bid + 1) * nt) / F.G); }
__device__ __forceinline__ void load_wg_lds(Frame& F, int l) {
    const float* src = (const float*)(F.ws + WS_WG) + (size_t)l * 16384;
    for (int i = F.tid; i < 32 * 128; i += NTHREADS) { const int g = i >> 7, c8 = i & 127; u32x4 w = (u32x4){0u, 0u, 0u, 0u};
        if (g < 16) { const f32x4 a = *(const f32x4*)(src + g * 1024 + c8 * 8), b = *(const f32x4*)(src + g * 1024 + c8 * 8 + 4); w.x = pk2(a.x, a.y); w.y = pk2(a.z, a.w); w.z = pk2(b.x, b.y); w.w = pk2(b.z, b.w); }
        *(LAS u32x4*)(F.lds + NW_WT + g * 2064 + c8 * 16) = w; }
    __syncthreads();
}
__device__ __forceinline__ void gates_tail(Frame& F, int l, int t_lo, int t_hi) {
    asm volatile("s_waitcnt vmcnt(0)" ::: "memory"); __syncthreads();
    const int g = F.lane & 15; const float bias = F.in[IN_BIN][l * 5904 + 2304 + g];
    for (int tile = t_lo + F.wave; tile < t_hi; tile += NWAVES) {
        const LAS float* lg = narrow_tile_wave(F, (const bf16_t*)(F.ws + WS_H) + (size_t)tile * 32 * D);
#pragma unroll
        for (int rr = 0; rr < 8; ++rr) { const int row = rr * 4 + (F.lane >> 4); ((float*)(F.ws + WS_ZG))[(size_t)(tile * 32 + row) * 16 + g] = lg[row * 33 + g] + bias; }
        asm volatile("s_waitcnt lgkmcnt(0)" ::: "memory");
    }
}

using pg8::Unit;
struct ProbPlain {
    static constexpr bool GATHER = false, FP8 = false; static constexpr int SCALE_A = 127, SCALE_B = 127; const bf16_t* A; const bf16_t* Bt; int lda, ldb;
    __device__ __forceinline__ int nt(const Unit&) const { return lda / 64; }
    __device__ __forceinline__ const char* a_base(const Unit& u) const { return (const char*)A + (size_t)u.pm * 256 * lda * 2; }
    __device__ __forceinline__ const char* b_base(const Unit& u) const { return (const char*)Bt + (size_t)u.pn * 256 * ldb * 2; }
    __device__ __forceinline__ void a_tok(const Unit&, const int (&)[2], int (&)[2][2]) const {}
    __device__ __forceinline__ void a_off(const int (&)[2][2], const int (&)[2], unsigned (&)[2][2]) const {}
    __device__ __forceinline__ void a_rows(const Unit&, const int (&)[2], const int (&)[2], unsigned (&)[2][2]) const {}
};
struct ProbPlainF8 {
    static constexpr bool GATHER = false, FP8 = true; static constexpr int SCALE_A = F8E_ACT, SCALE_B = F8E_WGU; const bf16_t* A; const bf16_t* Bt; int lda, ldb;
    __device__ __forceinline__ int nt(const Unit&) const { return lda / 64; }
    __device__ __forceinline__ const char* a_base(const Unit& u) const { return (const char*)A + (size_t)u.pm * 256 * lda * 2; }
    __device__ __forceinline__ const char* b_base(const Unit& u) const { return (const char*)Bt + (size_t)u.pn * 256 * ldb * 2; }
    __device__ __forceinline__ void a_tok(const Unit&, const int (&)[2], int (&)[2][2]) const {}
    __device__ __forceinline__ void a_off(const int (&)[2][2], const int (&)[2], unsigned (&)[2][2]) const {}
    __device__ __forceinline__ void a_rows(const Unit&, const int (&)[2], const int (&)[2], unsigned (&)[2][2]) const {}
};
struct ProbBranch {
    static constexpr bool GATHER = false, FP8 = false; static constexpr int SCALE_A = 127, SCALE_B = 127; const bf16_t* A; const bf16_t* Bt; int lda, ldb;
    __device__ __forceinline__ int nt(const Unit& u) const { return u.sub == 1 ? 8 : 4; }
    __device__ __forceinline__ int koff(const Unit& u) const { return u.sub == 0 ? 0 : (u.sub == 1 ? 256 : 768); }
    __device__ __forceinline__ const char* a_base(const Unit& u) const { return (const char*)A + ((size_t)u.pm * 256 * lda + koff(u)) * 2; }
    __device__ __forceinline__ const char* b_base(const Unit& u) const { return (const char*)Bt + ((size_t)u.pn * 256 * ldb + koff(u)) * 2; }
    __device__ __forceinline__ void a_tok(const Unit&, const int (&)[2], int (&)[2][2]) const {}
    __device__ __forceinline__ void a_off(const int (&)[2][2], const int (&)[2], unsigned (&)[2][2]) const {}
    __device__ __forceinline__ void a_rows(const Unit&, const int (&)[2], const int (&)[2], unsigned (&)[2][2]) const {}
};
__device__ __forceinline__ int expert_of(const LAS int* seg, int pm) { return __builtin_amdgcn_readfirstlane((int)((const LAS unsigned char*)(seg + 64))[pm]); }
__device__ __forceinline__ int moe_tables(Frame& F, LAS int* seg) {
    __syncthreads();
    if (F.tid <= NEXP) seg[F.tid] = ((const int*)(F.ws + WS_ROUTE + RT_SEG))[F.tid];
    __syncthreads();
    const int ntile = seg[NEXP] / 256;
    LAS unsigned char* texp = (LAS unsigned char*)(seg + 64);
    for (int t = F.tid; t < ntile; t += NTHREADS) { const int row = t * 256; int e = 0;
#pragma unroll
        for (int i = 1; i < NEXP; ++i) e += (seg[i] <= row) ? 1 : 0;
        texp[t] = (unsigned char)e; }
    __syncthreads();
    return ntile;
}
struct ProbMoe1 {
    static constexpr bool GATHER = true, FP8 = true; static constexpr int SCALE_A = F8E_ACT, SCALE_B = F8E_WGU; const bf16_t* A; const bf16_t* Bt; int lda, ldb; const int* tok; const LAS int* seg;
    __device__ __forceinline__ int nt(const Unit&) const { return lda / 64; }
    __device__ __forceinline__ const char* a_base(const Unit&) const { return (const char*)A; }
    __device__ __forceinline__ const char* b_base(const Unit& u) const { const int e = expert_of(seg, u.pm); return (const char*)Bt + ((size_t)e * 2048 + (size_t)u.pn * 256) * ldb * 2; }
    __device__ __forceinline__ void a_rows(const Unit& u, const int (&R)[2], const int (&C)[2], unsigned (&off)[2][2]) const {
#pragma unroll
        for (int h = 0; h < 2; ++h)
#pragma unroll
            for (int i = 0; i < 2; ++i) { const int t = tok[u.pm * 256 + h * 128 + R[i]]; off[h][i] = (unsigned)(t * lda + C[i]) * 2u; } }
    __device__ __forceinline__ void a_tok(const Unit& u, const int (&R)[2], int (&tk)[2][2]) const {
#pragma unroll
        for (int h = 0; h < 2; ++h)
#pragma unroll
            for (int i = 0; i < 2; ++i) tk[h][i] = tok[u.pm * 256 + h * 128 + R[i]]; }
    __device__ __forceinline__ void a_off(const int (&tk)[2][2], const int (&C)[2], unsigned (&off)[2][2]) const {
#pragma unroll
        for (int h = 0; h < 2; ++h)
#pragma unroll
            for (int i = 0; i < 2; ++i) off[h][i] = (unsigned)(tk[h][i] * lda + C[i]) * 2u; }
};
struct ProbMoe2 {
    static constexpr bool GATHER = false, FP8 = true; static constexpr int SCALE_A = F8E_ACT, SCALE_B = F8E_WDN; const bf16_t* A; const bf16_t* Bt; int lda, ldb; const LAS int* seg;
    __device__ __forceinline__ int nt(const Unit&) const { return lda / 64; }
    __device__ __forceinline__ const char* a_base(const Unit& u) const { return (const char*)A + (size_t)u.pm * 256 * lda * 2; }
    __device__ __forceinline__ const char* b_base(const Unit& u) const { const int e = expert_of(seg, u.pm); return (const char*)Bt + ((size_t)e * 1024 + (size_t)u.pn * 256) * ldb * 2; }
    __device__ __forceinline__ void a_tok(const Unit&, const int (&)[2], int (&)[2][2]) const {}
    __device__ __forceinline__ void a_off(const int (&)[2][2], const int (&)[2], unsigned (&)[2][2]) const {}
    __device__ __forceinline__ void a_rows(const Unit&, const int (&)[2], const int (&)[2], unsigned (&)[2][2]) const {}
};
using pg8::cvt_pk_bf16;
template <bool G8> struct EpiInproj {
    static constexpr bool PERM = true, CHAIN = false, SIDE = true, KHOOK = false; bf16_t* Z; const float* bias; int pn0;
    __device__ __forceinline__ void side(const Unit& u0, unsigned slot, int wid, int lane) const { const int pn = u0.pn + pn0; if (wid == 1) pg8::dma16((unsigned)lane * 16u, bias + pn * 256 + (pn >= 9 ? 16 : 0), slot); }
    __device__ __forceinline__ void operator()(const f32x4 (&acc)[2][2][4][2], const Unit& u0, int wr, int wc, int fr, int fq, const LAS unsigned char* sd) const {
        Unit u = u0; u.pn += pn0;
        int row0 = u.pm * 256 + wr * 64 + fr, col0 = u.pn * 256 + wc * 32 + 8 * fq; asm volatile("" : "+v"(row0), "+v"(col0));
        const int act = (u.pn <= 6) ? 0 : ((u.pn == 9 || u.pn == 10) ? 2 : 1);
        f32x4 bv[2][2];
#pragma unroll
        for (int bj = 0; bj < 2; ++bj)
#pragma unroll
            for (int n = 0; n < 2; ++n) bv[bj][n] = *(const LAS f32x4*)(sd + (bj * 128 + wc * 32 + 8 * fq + 4 * n) * 4);
#pragma unroll
        for (int ai = 0; ai < 2; ++ai)
#pragma unroll
            for (int m = 0; m < 4; ++m) { bf16_t* rowp = Z + (size_t)(row0 + ai * 128 + m * 16) * NZ + col0;
#pragma unroll
                for (int bj = 0; bj < 2; ++bj) { f32x4 v0 = acc[ai][bj][m][0] + bv[bj][0], v1 = acc[ai][bj][m][1] + bv[bj][1];
                    if (G8 && u.pn >= ZG_COL / 256) { u32x2 w8;
                        v0 = sigmoid4(v0) * G8_SCALE; v1 = sigmoid4(v1) * G8_SCALE;
#pragma unroll
                        for (int j = 0; j < 4; ++j) { v0[j] = fmaxf(v0[j], 1.0f); v1[j] = fmaxf(v1[j], 1.0f); }
                        v0 = v0 + 12582912.0f; v1 = v1 + 12582912.0f;
                        w8.x = pk4_u8(v0[0], v0[1], v0[2], v0[3]); w8.y = pk4_u8(v1[0], v1[1], v1[2], v1[3]);
                        *(u32x2*)((unsigned char*)(Z + (size_t)(row0 + ai * 128 + m * 16) * NZ + ZG_COL) + (col0 - ZG_COL) + bj * 128) = w8; continue; }
                    if (act == 2) { f32x2 a = pg8::gelu_pk((f32x2){v0[0], v0[1]}), b = pg8::gelu_pk((f32x2){v0[2], v0[3]}), c = pg8::gelu_pk((f32x2){v1[0], v1[1]}), d = pg8::gelu_pk((f32x2){v1[2], v1[3]});
                        v0 = (f32x4){a.x, a.y, b.x, b.y}; v1 = (f32x4){c.x, c.y, d.x, d.y}; }
                    if (act == 1) { v0 = sigmoid4(v0); v1 = sigmoid4(v1); }
                    u32x4 w; w.x = cvt_pk_bf16(v0[0], v0[1]); w.y = cvt_pk_bf16(v0[2], v0[3]); w.z = cvt_pk_bf16(v1[0], v1[1]); w.w = cvt_pk_bf16(v1[2], v1[3]);
                    *(u32x4*)(rowp + bj * 128) = w; }
                if constexpr (G8) asm volatile("" ::: "memory"); }
    }
};
struct EpiNull {
    static constexpr bool PERM = true, CHAIN = false; bf16_t* Z;
    __device__ __forceinline__ void operator()(const f32x4 (&acc)[2][2][4][2], const Unit& u, int wr, int wc, int fr, int fq) const {
        float sacc = 0.f;
#pragma unroll
        for (int ai = 0; ai < 2; ++ai)
#pragma unroll
            for (int bj = 0; bj < 2; ++bj)
#pragma unroll
                for (int m = 0; m < 4; ++m)
#pragma unroll
                    for (int n = 0; n < 2; ++n) sacc += (acc[ai][bj][m][n][0] + acc[ai][bj][m][n][1]) + (acc[ai][bj][m][n][2] + acc[ai][bj][m][n][3]);
        if (sacc == 1.2345e30f) Z[u.pm + wr + wc + fr + fq] = 0;
    }
};
struct EpiOut {
    static constexpr bool PERM = true, CHAIN = false, SIDE = false, KHOOK = false; bf16_t* T;
    __device__ __forceinline__ void operator()(const f32x4 (&acc)[2][2][4][2], const Unit& u, int wr, int wc, int fr, int fq, const LAS unsigned char*) const {
        int row0 = u.pm * 256 + wr * 64 + fr, col0 = u.pn * 256 + wc * 32 + 8 * fq; asm volatile("" : "+v"(row0), "+v"(col0));
#pragma unroll
        for (int ai = 0; ai < 2; ++ai)
#pragma unroll
            for (int m = 0; m < 4; ++m) { bf16_t* rowp = T + (size_t)(row0 + ai * 128 + m * 16) * D + col0;
#pragma unroll
                for (int bj = 0; bj < 2; ++bj) { const f32x4 v0 = acc[ai][bj][m][0], v1 = acc[ai][bj][m][1];
                    u32x4 w; w.x = cvt_pk_bf16(v0[0], v0[1]); w.y = cvt_pk_bf16(v0[2], v0[3]); w.z = cvt_pk_bf16(v1[0], v1[1]); w.w = cvt_pk_bf16(v1[2], v1[3]);
                    *(u32x4*)(rowp + bj * 128) = w; } }
    }
};
struct EpiBranch {
    static constexpr bool PERM = true, CHAIN = false, SIDE = false, KHOOK = true; static constexpr int HOOK_T0 = 4, HOOK_T1 = 12;
    const bf16_t* Z; bf16_t* Y;
    template <bool FIN> __device__ __forceinline__ void apply(f32x4 (&acc)[2][2][4][2], const Unit& u, int br, int wr, int wc, int fr, int fq) const {
        int row0 = u.pm * 256 + wr * 64 + fr, col0 = u.pn * 256 + wc * 32 + 8 * fq;
        asm volatile("" : "+v"(row0), "+v"(col0));
#pragma unroll
        for (int ai = 0; ai < 2; ++ai) {
            u32x2 ga[4][2], gb[4][2];
#pragma unroll
            for (int m = 0; m < 4; ++m) { const unsigned char* rowp = (const unsigned char*)(Z + (size_t)(row0 + ai * 128 + m * 16) * NZ + ZG_COL) + br * 1024 + col0;
#pragma unroll
                for (int bj = 0; bj < 2; ++bj) { ga[m][bj] = *(const u32x2*)(rowp + bj * 128); if (!FIN) gb[m][bj] = *(const u32x2*)(rowp + 1024 + bj * 128); } }
#pragma unroll
            for (int m = 0; m < 4; ++m) { const size_t row = (size_t)(row0 + ai * 128 + m * 16);
#pragma unroll
                for (int bj = 0; bj < 2; ++bj) { const u32x2 a = ga[m][bj];
                    f32x4 r0 = u8x4_f32(a.x), r1 = u8x4_f32(a.y);
                    if (FIN) { r0 = r0 * (1.0f / G8_SCALE); r1 = r1 * (1.0f / G8_SCALE); }
                    else { const u32x2 b = gb[m][bj]; f32x4 q0 = u8x4_f32(b.x), q1 = u8x4_f32(b.y);
#pragma unroll
                        for (int i = 0; i < 4; ++i) { q0[i] = __builtin_amdgcn_rcpf(q0[i]); q1[i] = __builtin_amdgcn_rcpf(q1[i]); }
                        r0 = r0 * q0; r1 = r1 * q1; }
                    acc[ai][bj][m][0] = acc[ai][bj][m][0] * r0; acc[ai][bj][m][1] = acc[ai][bj][m][1] * r1;
                    if (FIN) { const f32x4 v0 = acc[ai][bj][m][0], v1 = acc[ai][bj][m][1];
                        u32x4 w; w.x = cvt_pk_bf16(v0[0], v0[1]); w.y = cvt_pk_bf16(v0[2], v0[3]); w.z = cvt_pk_bf16(v1[0], v1[1]); w.w = cvt_pk_bf16(v1[2], v1[3]);
                        *(u32x4*)(Y + row * D + col0 + bj * 128) = w; } } }
            asm volatile("" ::: "memory"); }
    }
    __device__ __forceinline__ void hook(f32x4 (&acc)[2][2][4][2], const Unit& u, int br, int wr, int wc, int fr, int fq) const { apply<false>(acc, u, br, wr, wc, fr, fq); }
    __device__ __forceinline__ void operator()(f32x4 (&acc)[2][2][4][2], const Unit& u, int wr, int wc, int fr, int fq, const LAS unsigned char*) const { apply<true>(acc, u, 2, wr, wc, fr, fq); }
};
struct EpiSwiglu {
    static constexpr bool PERM = true, CHAIN = false, SIDE = true, KHOOK = false; unsigned char* HID; const float* bgu; const LAS int* seg;
    __device__ __forceinline__ void side(const Unit& u, unsigned slot, int wid, int lane) const {
        if (wid == 1) { const int e = expert_of(seg, u.pm); pg8::dma16(lane < 32 ? (unsigned)lane * 16u : 4096u + (unsigned)(lane - 32) * 16u, bgu + (size_t)e * 2048 + u.pn * 128, slot); } }
    __device__ __forceinline__ void operator()(const f32x4 (&acc)[2][2][4][2], const Unit& u, int wr, int wc, int fr, int fq, const LAS unsigned char* sd) const {
        int j0 = u.pn * 128 + wc * 32 + 8 * fq, slot0 = u.pm * 256 + wr * 64 + fr; asm volatile("" : "+v"(j0), "+v"(slot0));
        f32x4 bg[2], bu[2];
#pragma unroll
        for (int n = 0; n < 2; ++n) { bg[n] = *(const LAS f32x4*)(sd + (wc * 32 + 8 * fq + 4 * n) * 4); bu[n] = *(const LAS f32x4*)(sd + (128 + wc * 32 + 8 * fq + 4 * n) * 4); }
#pragma unroll
        for (int ai = 0; ai < 2; ++ai)
#pragma unroll
            for (int m = 0; m < 4; ++m) { const size_t slot = (size_t)(slot0 + ai * 128 + m * 16); f32x4 o[2];
#pragma unroll
                for (int n = 0; n < 2; ++n) { f32x4 g = acc[ai][0][m][n] + bg[n], up = acc[ai][1][m][n] + bu[n];
#pragma unroll
                    for (int i = 0; i < 4; ++i) { g[i] = fminf(g[i], 7.0f); up[i] = __builtin_amdgcn_fmed3f(up[i], -7.0f, 7.0f); }
                    f32x4 t = g * (-1.702f * 1.4426950408889634f);
#pragma unroll
                    for (int i = 0; i < 4; ++i) t[i] = __builtin_amdgcn_exp2f(t[i]);
                    t = t + 1.0f;
#pragma unroll
                    for (int i = 0; i < 4; ++i) t[i] = __builtin_amdgcn_rcpf(t[i]);
                    o[n] = (up * F8S_ACT + F8S_ACT) * (g * t); }
                u32x2 w; w.x = pk4_fp8(o[0][0], o[0][1], o[0][2], o[0][3]); w.y = pk4_fp8(o[1][0], o[1][1], o[1][2], o[1][3]);
                *(u32x2*)(HID + slot * 1024 + j0) = w; }
    }
};
struct EpiDown {
    static constexpr bool PERM = true, CHAIN = false, SIDE = true, KHOOK = false; unsigned char* FS; const float* bdn; const int* dest; const float* pslot; const LAS int* seg;
    __device__ __forceinline__ void side(const Unit& u, unsigned slot, int wid, int lane) const {
        if (wid == 1) { const int e = expert_of(seg, u.pm); pg8::dma16((unsigned)lane * 16u, bdn + (size_t)e * 1024 + u.pn * 256, slot); }
        if (wid == 2) pg8::dma16((unsigned)lane * 16u, dest + (size_t)u.pm * 256, slot + 1024u);
        if (wid == 3) pg8::dma16((unsigned)lane * 16u, pslot + (size_t)u.pm * 256, slot + 2048u); }
    __device__ __forceinline__ void operator()(const f32x4 (&acc)[2][2][4][2], const Unit& u, int wr, int wc, int fr, int fq, const LAS unsigned char* sd) const {
        int col0 = u.pn * 256 + wc * 32 + 8 * fq, slot0 = u.pm * 256 + wr * 64 + fr; asm volatile("" : "+v"(col0), "+v"(slot0));
        f32x4 bv[2][2];
#pragma unroll
        for (int bj = 0; bj < 2; ++bj)
#pragma unroll
            for (int n = 0; n < 2; ++n) bv[bj][n] = *(const LAS f32x4*)(sd + (bj * 128 + wc * 32 + 8 * fq + 4 * n) * 4);
#pragma unroll
        for (int ai = 0; ai < 2; ++ai)
#pragma unroll
            for (int m = 0; m < 4; ++m) { const int rt = ai * 128 + wr * 64 + m * 16 + fr; const int d = *(const LAS int*)(sd + 1024 + rt * 4); const float p = *(const LAS float*)(sd + 2048 + rt * 4) * FS_SCALE;
                if (d >= 0) {
#pragma unroll
                    for (int bj = 0; bj < 2; ++bj) { f32x4 v0 = (acc[ai][bj][m][0] + bv[bj][0]) * p, v1 = (acc[ai][bj][m][1] + bv[bj][1]) * p;
#pragma unroll
                        for (int i = 0; i < 4; ++i) { v0[i] = __builtin_amdgcn_fmed3f(v0[i], -FS_CLAMP, FS_CLAMP); v1[i] = __builtin_amdgcn_fmed3f(v1[i], -FS_CLAMP, FS_CLAMP); }
                        u32x2 w; w.x = pk4_fp8(v0[0], v0[1], v0[2], v0[3]); w.y = pk4_fp8(v1[0], v1[1], v1[2], v1[3]);
                        *(u32x2*)(FS + (size_t)d * 1024 + col0 + bj * 128) = w; } }
                asm volatile("" ::: "memory"); }
    }
};

__device__ __forceinline__ const float* xin_row(const Frame& F, int row) { return row < ML ? F.in[IN_X] + (size_t)row * D : F.in[IN_CTX] + (size_t)(row - ML) * D; }
__device__ __forceinline__ void phase_ln0_first(Frame& F) {
    int t_lo, t_hi; tile_range(F, MT, t_lo, t_hi);
    const int r_lo = 32 * t_lo, nrows = 32 * (t_hi - t_lo);
    const int mrA = mod_row(r_lo), mrB = mod_row(r_lo + (nrows > 0 ? nrows - 1 : 0));
    { const float* mb = (const float*)(F.ws + WS_MOD); pv_fill(F, 0, mb + ((size_t)(0 * 17 + mrA) * 6 + 0) * 1024); pv_fill(F, 1, mb + ((size_t)(0 * 17 + mrB) * 6 + 0) * 1024);
      pv_fill(F, 2, mb + ((size_t)(0 * 17 + mrA) * 6 + 1) * 1024); pv_fill(F, 3, mb + ((size_t)(0 * 17 + mrB) * 6 + 1) * 1024); }
    load_wg_lds(F, 0);
    for (int n = F.wave; n < nrows; n += 4 * NWAVES) {
        RowV rv[4];
#pragma unroll
        for (int u = 0; u < 4; ++u) if (n + u * NWAVES < nrows) row_load(rv[u], xin_row(F, r_lo + n + u * NWAVES), F.lane);
#pragma unroll
        for (int u = 0; u < 4; ++u) if (n + u * NWAVES < nrows) { const int row = r_lo + n + u * NWAVES;
            const int sel = (mod_row(row) == mrA) ? 0 : 1; ln0_row(F, row, rv[u], pv_slot(F, 0 + sel), pv_slot(F, 2 + sel)); }
    }
    gates_tail(F, 0, t_lo, t_hi);
    __syncthreads();
}
__device__ __forceinline__ void phase_finalize(Frame& F, int l, int mrows) {
    const int gw = F.bid * NWAVES + F.wave, NGW = F.G * NWAVES;
    const bf16_t* hf = (const bf16_t*)(F.ws + WS_HFB); const bf16_t* hb = hf + (size_t)MT * 512;
    const float* ng = F.in[IN_MNG] + l * 512 + 8 * F.lane;
    const f32x4 g0 = *(const f32x4*)ng, g1 = *(const f32x4*)(ng + 4);
    const bf16_t* zo = (const bf16_t*)(F.ws + WS_Z) + ZC_O + 8 * F.lane;
    u32x4 ha = (u32x4){0u, 0u, 0u, 0u}, hbv = ha, so = ha;
    if (gw < mrows) { ha = __builtin_nontemporal_load((const u32x4*)(hf + (size_t)gw * 512 + 8 * F.lane)); hbv = __builtin_nontemporal_load((const u32x4*)(hb + (size_t)gw * 512 + 8 * F.lane)); so = __builtin_nontemporal_load((const u32x4*)(zo + (size_t)gw * NZ)); }
    for (int row = gw; row < mrows; row += NGW) {
        u32x4 han = ha, hbn = hbv, son = so; const int rn = row + NGW;
        if (rn < mrows) { han = __builtin_nontemporal_load((const u32x4*)(hf + (size_t)rn * 512 + 8 * F.lane)); hbn = __builtin_nontemporal_load((const u32x4*)(hb + (size_t)rn * 512 + 8 * F.lane)); son = __builtin_nontemporal_load((const u32x4*)(zo + (size_t)rn * NZ)); }
        __builtin_amdgcn_sched_barrier(0);
        f32x4 v0 = (f32x4){bflo(ha.x) + bflo(hbv.x), bfhi(ha.x) + bfhi(hbv.x), bflo(ha.y) + bflo(hbv.y), bfhi(ha.y) + bfhi(hbv.y)}, v1 = (f32x4){bflo(ha.z) + bflo(hbv.z), bfhi(ha.z) + bfhi(hbv.z), bflo(ha.w) + bflo(hbv.w), bfhi(ha.w) + bfhi(hbv.w)};
        float s = (v0.x + v0.y) + (v0.z + v0.w) + (v1.x + v1.y) + (v1.z + v1.w);
#pragma unroll
        for (int o = 1; o < 16; o <<= 1) s += shx(s, o, F.lane);
        const float mu = s * (1.f / 128.f); v0 = v0 - mu; v1 = v1 - mu;
        float q = (v0.x * v0.x + v0.y * v0.y) + (v0.z * v0.z + v0.w * v0.w) + (v1.x * v1.x + v1.y * v1.y) + (v1.z * v1.z + v1.w * v1.w);
#pragma unroll
        for (int o = 1; o < 16; o <<= 1) q += shx(q, o, F.lane);
        const float rstd = 1.f / sqrtf(q * (1.f / 128.f) + HEAD_EPS);
        v0 = v0 * rstd * g0; v1 = v1 * rstd * g1;
        u32x4 w; w.x = pk2(v0.x * bflo(so.x), v0.y * bfhi(so.x)); w.y = pk2(v0.z * bflo(so.y), v0.w * bfhi(so.y)); w.z = pk2(v1.x * bflo(so.z), v1.y * bfhi(so.z)); w.w = pk2(v1.z * bflo(so.w), v1.w * bfhi(so.w));
        *(u32x4*)((bf16_t*)(F.ws + WS_BRA) + (size_t)row * D + 256 + 8 * F.lane) = w;
        ha = han; hbv = hbn; so = son;
    }
}
__device__ __forceinline__ void phase_ln1_router(Frame& F, int l, int mrows) {
    LAS int* cnt = (LAS int*)(F.lds + NW_END);
    { const float* wr = F.in[IN_WR] + (size_t)l * D * NEXP;
      for (int i = F.tid; i < NEXP * D; i += NTHREADS) { const int k = i >> 5, e = i & 31; *(LAS bf16_t*)(F.lds + NW_WT + e * 2064 + k * 2) = (bf16_t)f2bf(wr[i]); }
      if (F.tid < NEXP) cnt[F.tid] = 0; }
    const float* brt = F.in[IN_BR] + l * NEXP;
    int t_lo, t_hi; tile_range(F, mrows, t_lo, t_hi);
    const int r_lo = 32 * t_lo, nrows = 32 * (t_hi - t_lo);
    const int mrA = mod_row(r_lo), mrB = mod_row(r_lo + (nrows > 0 ? nrows - 1 : 0));
    { const float* mb = (const float*)(F.ws + WS_MOD); pv_fill(F, 0, F.in[IN_LN1G] + l * D); pv_fill(F, 1, F.in[IN_LN1B] + l * D);
      pv_fill(F, 2, mb + ((size_t)(l * 17 + mrA) * 6 + 2) * 1024); pv_fill(F, 3, mb + ((size_t)(l * 17 + mrB) * 6 + 2) * 1024);
      pv_fill(F, 4, mb + ((size_t)(l * 17 + mrA) * 6 + 3) * 1024); pv_fill(F, 5, mb + ((size_t)(l * 17 + mrB) * 6 + 3) * 1024);
      pv_fill(F, 6, mb + ((size_t)(l * 17 + mrA) * 6 + 4) * 1024); pv_fill(F, 7, mb + ((size_t)(l * 17 + mrB) * 6 + 4) * 1024); }
    __syncthreads();
    { const bf16_t* yb = (const bf16_t*)(F.ws + WS_T) + 8 * F.lane;
      RowV rv[2]; u32x4 yv2[2][2];
#pragma unroll
      for (int u = 0; u < 2; ++u) {
#pragma unroll
          for (int j = 0; j < 4; ++j) rv[u].v[j] = (f32x4){0.f, 0.f, 0.f, 0.f};
          yv2[u][0] = yv2[u][1] = (u32x4){0u, 0u, 0u, 0u}; }
#define RT_LOADPAIR(n_, rv_, yv_) do { _Pragma("unroll") for (int u = 0; u < 2; ++u) if ((n_) + u * NWAVES < nrows) { const int row = r_lo + (n_) + u * NWAVES; \
              if (l == 0) row_load(rv_[u], xin_row(F, row), F.lane); else row_load_bf16(rv_[u], (const bf16_t*)(F.ws + WS_X) + (size_t)row * D, F.lane); \
              _Pragma("unroll") for (int h = 0; h < 2; ++h) yv_[u][h] = __builtin_nontemporal_load((const u32x4*)(yb + (size_t)row * D + 512 * h)); } } while (0)
      RT_LOADPAIR(F.wave, rv, yv2);
      for (int n = F.wave; n < nrows; n += 2 * NWAVES) {
          RowV rvn[2]; u32x4 yvn[2][2];
#pragma unroll
          for (int u = 0; u < 2; ++u) { rvn[u] = rv[u]; yvn[u][0] = yv2[u][0]; yvn[u][1] = yv2[u][1]; }
          RT_LOADPAIR(n + 2 * NWAVES, rvn, yvn);
          __builtin_amdgcn_sched_barrier(0);
#pragma unroll
          for (int u = 0; u < 2; ++u) if (n + u * NWAVES < nrows) { const int row = r_lo + n + u * NWAVES; RowV cur = rv[u];
              const int sel = (mod_row(row) == mrA) ? 0 : 1;
              { const LAS float* g1 = pv_slot(F, 2 + sel);
#pragma unroll
                for (int j = 0; j < 4; ++j) { const f32x4 gg = *(const LAS f32x4*)(g1 + RC(F.lane, j)); const u32x4 yw = yv2[u][j >> 1]; const f32x4 yv = (j & 1) ? (f32x4){bflo(yw.z), bfhi(yw.z), bflo(yw.w), bfhi(yw.w)} : (f32x4){bflo(yw.x), bfhi(yw.x), bflo(yw.y), bfhi(yw.y)}; cur.v[j] = cur.v[j] * DN_ALPHA + gg * yv; } }
              row_ln_plain(cur, F.lane); row_affine_l(cur, pv_slot(F, 0), pv_slot(F, 1), F.lane);
              row_store_bf16_nt(cur, (bf16_t*)(F.ws + WS_X) + (size_t)row * D, F.lane);
              row_ln_plain(cur, F.lane); row_modulate_l(cur, pv_slot(F, 4 + sel), pv_slot(F, 6 + sel), F.lane);
              row_store_bf16(cur, (bf16_t*)(F.ws + WS_H2) + (size_t)row * D, F.lane);
              { unsigned char* h8 = (unsigned char*)(F.ws + WS_H2F8) + (size_t)row * D + 8 * F.lane;
#pragma unroll
                for (int h = 0; h < 2; ++h) { u32x2 w; w.x = pk4_fp8(cur.v[2 * h].x * F8S_ACT, cur.v[2 * h].y * F8S_ACT, cur.v[2 * h].z * F8S_ACT, cur.v[2 * h].w * F8S_ACT); w.y = pk4_fp8(cur.v[2 * h + 1].x * F8S_ACT, cur.v[2 * h + 1].y * F8S_ACT, cur.v[2 * h + 1].z * F8S_ACT, cur.v[2 * h + 1].w * F8S_ACT); *(u32x2*)(h8 + 512 * h) = w; } } }
#pragma unroll
          for (int u = 0; u < 2; ++u) { rv[u] = rvn[u]; yv2[u][0] = yvn[u][0]; yv2[u][1] = yvn[u][1]; }
      }
#undef RT_LOADPAIR
    }
    asm volatile("s_waitcnt vmcnt(0)" ::: "memory"); __syncthreads();
    for (int tile = t_lo + F.wave; tile < t_hi; tile += NWAVES) {
        const LAS float* lgw = narrow_tile_wave(F, (const bf16_t*)(F.ws + WS_H2) + (size_t)tile * 32 * D);
        if (F.lane < 32) {
            const LAS float* lgp = lgw + F.lane * 33; const int row = tile * 32 + F.lane;
            float lg[NEXP];
#pragma unroll
            for (int e = 0; e < NEXP; ++e) lg[e] = lgp[e] + brt[e];
            unsigned used = 0u; float bv[4]; int bi[4];
#pragma unroll
            for (int k = 0; k < 4; ++k) { float best = -3.0e38f; int idx = 0;
#pragma unroll
                for (int e = 0; e < NEXP; ++e) { const bool take = (((used >> e) & 1u) == 0u) && (lg[e] > best); best = take ? lg[e] : best; idx = take ? e : idx; }
                used |= 1u << idx; bv[k] = best; bi[k] = idx; }
            const float e1 = __expf(bv[1] - bv[0]), e2 = __expf(bv[2] - bv[0]), e3 = __expf(bv[3] - bv[0]); const float inv = __builtin_amdgcn_rcpf(1.0f + e1 + e2 + e3);
            int* ei = (int*)(F.ws + WS_ROUTE + RT_EIDX) + (size_t)row * 4; float* pr = (float*)(F.ws + WS_ROUTE + RT_PROB) + (size_t)row * 4;
            *(int4*)ei = make_int4(bi[0], bi[1], bi[2], bi[3]); *(f32x4*)pr = (f32x4){inv, e1 * inv, e2 * inv, e3 * inv};
            atomicAdd((int*)&cnt[bi[0]], 1); atomicAdd((int*)&cnt[bi[1]], 1); atomicAdd((int*)&cnt[bi[2]], 1); atomicAdd((int*)&cnt[bi[3]], 1);
        }
        asm volatile("s_waitcnt lgkmcnt(0)" ::: "memory");
    }
    __syncthreads();
    if (F.tid < NEXP) ((int*)(F.ws + WS_ROUTE + RT_CNT))[F.bid * NEXP + F.tid] = cnt[F.tid];
    __syncthreads();
}
__device__ __forceinline__ void phase_slots(Frame& F, int mrows) {
    LAS int* part = (LAS int*)F.lds;
    LAS int* pre = part + 1024;
    LAS int* tot = pre + 32;
    LAS int* seg = tot + 32;
    LAS int* gcnt = seg + 64;
    LAS int* eix = gcnt + 2048;
    LAS int* rnk = eix + 4096;
    const int* cntg = (const int*)(F.ws + WS_ROUTE + RT_CNT);
    int* tokg = (int*)(F.ws + WS_ROUTE + RT_TOK); int* destg = (int*)(F.ws + WS_ROUTE + RT_DEST); float* psl = (float*)(F.ws + WS_ROUTE + RT_PSLOT);
    int t_lo, t_hi; tile_range(F, mrows, t_lo, t_hi);
    const int row_base = t_lo * 32, nent = (t_hi - t_lo) * 128, ngrp = nent / 64;
    { const int e = F.tid & 31, pt = F.tid >> 5; int a = 0, b = 0;
      for (int c = pt; c < F.G; c += 16) { const int v = cntg[c * NEXP + e]; b += v; a += (c < F.bid) ? v : 0; }
      part[pt * 32 + e] = a; part[512 + pt * 32 + e] = b; }
    for (int i = F.tid; i < nent; i += NTHREADS) eix[i] = ((const int*)(F.ws + WS_ROUTE + RT_EIDX))[(size_t)row_base * 4 + i];
    __syncthreads();
    if (F.tid < NEXP) { int a = 0, b = 0;
#pragma unroll
        for (int pt = 0; pt < 16; ++pt) { a += part[pt * 32 + F.tid]; b += part[512 + pt * 32 + F.tid]; }
        pre[F.tid] = a; tot[F.tid] = b; }
    for (int g = F.wave; g < ngrp; g += NWAVES) {
        const int e = eix[g * 64 + F.lane]; int rank = 0, mycnt = 0;
#pragma unroll 4
        for (int ee = 0; ee < NEXP; ++ee) { const unsigned long long m = __ballot(e == ee); if (e == ee) rank = __popcll(m & ((1ull << F.lane) - 1ull)); if (F.lane == ee) mycnt = __popcll(m); }
        rnk[g * 64 + F.lane] = rank; if (F.lane < NEXP) gcnt[g * 32 + F.lane] = mycnt; }
    __syncthreads();
    if (F.tid == 0) { int s = 0; for (int e = 0; e < NEXP; ++e) { seg[e] = s; s += (tot[e] + 255) & ~255; } seg[NEXP] = s; }
    if (F.tid >= 64 && F.tid < 64 + NEXP) { const int e = F.tid - 64; int run = 0; for (int g = 0; g < ngrp; ++g) { const int c = gcnt[g * 32 + e]; gcnt[g * 32 + e] = run; run += c; } }
    __syncthreads();
    { const float* prg = (const float*)(F.ws + WS_ROUTE + RT_PROB) + (size_t)row_base * 4;
      for (int i = F.tid; i < nent; i += NTHREADS) { const int e = eix[i]; const int slot = seg[e] + pre[e] + gcnt[(i >> 6) * 32 + e] + rnk[i];
          tokg[slot] = row_base + (i >> 2); destg[slot] = row_base * 4 + i; psl[slot] = prg[i]; } }
    if (F.bid < NEXP) { const int e = F.bid; for (int sl = seg[e] + tot[e] + F.tid; sl < seg[e + 1]; sl += NTHREADS) { tokg[sl] = 0; destg[sl] = -1; psl[sl] = 0.f; } }
    if (F.bid == 0 && F.tid <= NEXP) ((int*)(F.ws + WS_ROUTE + RT_SEG))[F.tid] = seg[F.tid];
    __syncthreads();
}
struct CombRaw { u32x4 x[2]; u32x2 f[2][4]; };
__device__ __forceinline__ void comb_load(const Frame& F, int row, CombRaw& r) {
    { const bf16_t* xp = (const bf16_t*)(F.ws + WS_X) + (size_t)row * D + 8 * F.lane;
#pragma unroll
      for (int h = 0; h < 2; ++h) r.x[h] = __builtin_nontemporal_load((const u32x4*)(xp + 512 * h)); }
    const unsigned char* fs = (const unsigned char*)(F.ws + WS_FS) + (size_t)row * 4 * 1024 + 8 * F.lane;
#pragma unroll
    for (int h = 0; h < 2; ++h)
#pragma unroll
        for (int k = 0; k < 4; ++k) r.f[h][k] = __builtin_nontemporal_load((const u32x2*)(fs + k * 1024 + 512 * h));
}
__device__ __forceinline__ void phase_combine_ln2(Frame& F, int l, int mrows) {
    const bool lastl = (l == DEPTH - 1);
    int t_lo, t_hi; tile_range(F, mrows, t_lo, t_hi);
    const int r_lo = 32 * t_lo, nrows = 32 * (t_hi - t_lo);
    const int mrA = mod_row(r_lo), mrB = mod_row(r_lo + (nrows > 0 ? nrows - 1 : 0));
    { const float* mb = (const float*)(F.ws + WS_MOD); const int ln = lastl ? l : l + 1; pv_fill(F, 0, F.in[IN_LN2G] + l * D); pv_fill(F, 1, F.in[IN_LN2B] + l * D);
      pv_fill(F, 2, mb + ((size_t)(l * 17 + mrA) * 6 + 5) * 1024); pv_fill(F, 3, mb + ((size_t)(l * 17 + mrB) * 6 + 5) * 1024);
      pv_fill(F, 4, mb + ((size_t)(ln * 17 + mrA) * 6 + 0) * 1024); pv_fill(F, 5, mb + ((size_t)(ln * 17 + mrB) * 6 + 0) * 1024);
      pv_fill(F, 6, mb + ((size_t)(ln * 17 + mrA) * 6 + 1) * 1024); pv_fill(F, 7, mb + ((size_t)(ln * 17 + mrB) * 6 + 1) * 1024); }
    if (!lastl) load_wg_lds(F, l + 1); else __syncthreads();
    for (int n = F.wave; n < nrows; n += 2 * NWAVES) {
        CombRaw rw[2];
#pragma unroll
        for (int u = 0; u < 2; ++u) if (n + u * NWAVES < nrows) comb_load(F, r_lo + n + u * NWAVES, rw[u]);
#pragma unroll
        for (int u = 0; u < 2; ++u) if (n + u * NWAVES < nrows) { const int row = r_lo + n + u * NWAVES;
            const int sel = (mod_row(row) == mrA) ? 0 : 1;
            const LAS float* g2 = pv_slot(F, 2 + sel);
            RowV x;
#pragma unroll
            for (int h = 0; h < 2; ++h) { const u32x4 w = rw[u].x[h]; x.v[2 * h] = (f32x4){bflo(w.x), bfhi(w.x), bflo(w.y), bfhi(w.y)}; x.v[2 * h + 1] = (f32x4){bflo(w.z), bfhi(w.z), bflo(w.w), bfhi(w.w)}; }
#pragma unroll
            for (int j = 0; j < 4; ++j) { f32x4 f = (f32x4){0.f, 0.f, 0.f, 0.f};
#pragma unroll
                for (int k = 0; k < 4; ++k) { const u32x2 w2 = rw[u].f[j >> 1][k]; const int wd = (int)((j & 1) ? w2.y : w2.x);
                    const f32x2 lo = __builtin_amdgcn_cvt_pk_f32_fp8(wd, false), hi = __builtin_amdgcn_cvt_pk_f32_fp8(wd, true); f[0] += lo[0]; f[1] += lo[1]; f[2] += hi[0]; f[3] += hi[1]; }
                const f32x4 gg = *(const LAS f32x4*)(g2 + RC(F.lane, j)) * (1.0f / FS_SCALE);
                x.v[j] = x.v[j] * DN_ALPHA + gg * f; }
            row_ln_plain(x, F.lane); row_affine_l(x, pv_slot(F, 0), pv_slot(F, 1), F.lane);
            if (lastl) { row_store_nt(x, F.out + (size_t)row * D, F.lane); }
            else { row_store_bf16_nt(x, (bf16_t*)(F.ws + WS_X) + (size_t)row * D, F.lane); ln0_row(F, row, x, pv_slot(F, 4 + sel), pv_slot(F, 6 + sel)); } }
    }
    if (!lastl) gates_tail(F, l + 1, t_lo, t_hi);
    __syncthreads();
}

#define MFMA32(a, b, c) __builtin_amdgcn_mfma_f32_32x32x16_bf16((a), (b), (c), 0, 0, 0)
#define MFMA16(a, b, c) __builtin_amdgcn_mfma_f32_16x16x32_bf16((a), (b), (c), 0, 0, 0)
__device__ __forceinline__ f32x16 zero16() { f32x16 z;
#pragma unroll
    for (int i = 0; i < 16; ++i) z[i] = 0.f;
    return z; }
__device__ __forceinline__ void pool_tiles(Frame& F, int l, bool with_ctx) {
    LAS unsigned char* Pin = F.lds;
    LAS unsigned char* Dm = F.lds + 40960;
    const bf16_t* Z = (const bf16_t*)(F.ws + WS_Z);
    const bf16_t* Wp = (const bf16_t*)(F.ws + WS_WPOOL) + (size_t)l * 4 * 4096;
    const float* psc = F.in[IN_POOLS] + l * 256;
    bf16_t* BRA = (bf16_t*)(F.ws + WS_BRA);
    const int ntiles = with_ctx ? 1088 : 1024;
    const int r = F.lane & 31, h = F.lane >> 5;
    for (int tile = F.bid; tile < ntiles; tile += F.G) {
        int row0, seq_lo, seq_hi;
        if (tile < 1024) { row0 = tile * 64; seq_lo = row0; seq_hi = row0 + 64; }
        else { const int ct = tile - 1024; seq_lo = ML + (ct >> 2) * 256; seq_hi = seq_lo + 256; row0 = seq_lo + (ct & 3) * 64; }
        for (int idx = F.tid; idx < 80 * 32; idx += NTHREADS) { const int rr = idx >> 5, ck = idx & 31, grow = row0 - 8 + rr;
            if (grow >= seq_lo && grow < seq_hi) *(LAS u32x4*)(Pin + rr * 512 + ck * 16) = __builtin_nontemporal_load((const u32x4*)(Z + (size_t)grow * NZ + ZC_P + ck * 8)); }
        __syncthreads();
        for (int idx = F.tid; idx < 64 * 32; idx += NTHREADS) { const int tok = idx >> 5, ck = idx & 31, g = ck >> 3, hw = 1 << g, t = row0 + tok;
            const int lo = max(t - hw, seq_lo), hi = min(t + hw, seq_hi);
            float s[8];
#pragma unroll
            for (int e = 0; e < 8; ++e) s[e] = 0.f;
            for (int rw = lo; rw < hi; ++rw) { const u32x4 v = *(const LAS u32x4*)(Pin + (rw - row0 + 8) * 512 + ck * 16);
                s[0] += bflo(v.x); s[1] += bfhi(v.x); s[2] += bflo(v.y); s[3] += bfhi(v.y); s[4] += bflo(v.z); s[5] += bfhi(v.z); s[6] += bflo(v.w); s[7] += bfhi(v.w); }
            const float inv = 1.0f / (float)(hi - lo);
            const u32x4 o = *(const LAS u32x4*)(Pin + (tok + 8) * 512 + ck * 16);
            u32x4 w; w.x = pk2(s[0] * inv - bflo(o.x), s[1] * inv - bfhi(o.x)); w.y = pk2(s[2] * inv - bflo(o.y), s[3] * inv - bfhi(o.y));
            w.z = pk2(s[4] * inv - bflo(o.z), s[5] * inv - bfhi(o.z)); w.w = pk2(s[6] * inv - bflo(o.w), s[7] * inv - bfhi(o.w));
            *(LAS u32x4*)(Dm + tok * 528 + ck * 16) = w; }
        __syncthreads();
#pragma unroll 1
        for (int qi = 0; qi < 2; ++qi) { const int q = F.wave + 8 * qi, g = q >> 2, td = (q >> 1) & 1, tt = q & 1;
            f32x16 acc = zero16();
#pragma unroll
            for (int ks = 0; ks < 4; ++ks) { const bf16x8 a = *(const bf16x8*)(Wp + ((size_t)g * 64 + td * 32 + r) * 64 + ks * 16 + 8 * h);
                const bf16x8 b = *(const LAS bf16x8*)(Dm + (tt * 32 + r) * 528 + (g * 64 + ks * 16 + 8 * h) * 2);
                acc = MFMA32(a, b, acc); }
            const size_t orow = (size_t)(row0 + tt * 32 + r);
#pragma unroll
            for (int qq = 0; qq < 4; ++qq) { const int dcol = g * 64 + td * 32 + 8 * qq + 4 * h; const f32x4 sc = *(const f32x4*)(psc + dcol);
                u32x2 w; w.x = pk2(acc[4 * qq] * sc.x, acc[4 * qq + 1] * sc.y); w.y = pk2(acc[4 * qq + 2] * sc.z, acc[4 * qq + 3] * sc.w);
                *(u32x2*)(BRA + orow * D + dcol) = w; } }
        __syncthreads();
    }
}
__device__ __forceinline__ void sgu_chunks(Frame& F, int l, bool with_ctx) {
    LAS unsigned char* Vt = F.lds;
    const bf16_t* Z = (const bf16_t*)(F.ws + WS_Z);
    const bf16_t* Ws = (const bf16_t*)(F.ws + WS_WSGU) + (size_t)l * 4 * 16384;
    const float* lng = F.in[IN_SLNG] + l * 256; const float* lnb = F.in[IN_SLNB] + l * 256; const float* sb = F.in[IN_SGUB] + l * 512;
    bf16_t* BRA = (bf16_t*)(F.ws + WS_BRA);
    const int nchunks = with_ctx ? 544 : 512;
    const int r = F.lane & 31, h = F.lane >> 5;
    const int tc = F.wave & 1, tt = F.wave >> 1, t = tt * 32 + r;
    for (int ch = F.bid; ch < nchunks; ch += F.G) {
        const int row0 = ch * 128;
        u32x2 ug[4][4]; bf16x8 bcur[8];
#pragma unroll
        for (int g = 0; g < 4; ++g)
#pragma unroll
            for (int qq = 0; qq < 4; ++qq) ug[g][qq] = *(const u32x2*)(Z + (size_t)(row0 + t) * NZ + ZC_UV + g * 64 + tc * 32 + 8 * qq + 4 * h);
#pragma unroll
        for (int ks = 0; ks < 8; ++ks) bcur[ks] = *(const bf16x8*)(Ws + ((size_t)0 * 128 + t) * 128 + ks * 16 + 8 * h);
        { const int s = F.tid >> 2, q = F.tid & 3; const bf16_t* zp = Z + (size_t)(row0 + s) * NZ + ZC_UV + 256 + q * 64;
          float v[64]; float sum = 0.f;
#pragma unroll
          for (int i = 0; i < 8; ++i) { const u32x4 w = __builtin_nontemporal_load((const u32x4*)(zp + 8 * i));
              v[8 * i] = bflo(w.x); v[8 * i + 1] = bfhi(w.x); v[8 * i + 2] = bflo(w.y); v[8 * i + 3] = bfhi(w.y); v[8 * i + 4] = bflo(w.z); v[8 * i + 5] = bfhi(w.z); v[8 * i + 6] = bflo(w.w); v[8 * i + 7] = bfhi(w.w); }
#pragma unroll
          for (int i = 0; i < 64; ++i) sum += v[i];
          sum += shx(sum, 1, F.lane); sum += shx(sum, 2, F.lane);
          const float mean = sum * (1.f / 256.f); float sq = 0.f;
#pragma unroll
          for (int i = 0; i < 64; ++i) { v[i] -= mean; sq += v[i] * v[i]; }
          sq += shx(sq, 1, F.lane); sq += shx(sq, 2, F.lane);
          const float rstd = 1.f / sqrtf(sq * (1.f / 256.f) + LN_EPS);
#pragma unroll
          for (int i = 0; i < 64; ++i) { const int c = q * 64 + i; const float y = v[i] * rstd * lng[c] + lnb[c]; *(LAS bf16_t*)(Vt + c * 272 + s * 2) = (bf16_t)f2bf(y); } }
        __syncthreads();
#pragma unroll
        for (int g = 0; g < 4; ++g) {
            bf16x8 bnx[8];
#pragma unroll
            for (int ks = 0; ks < 8; ++ks) bnx[ks] = bcur[ks];
            if (g < 3) {
#pragma unroll
                for (int ks = 0; ks < 8; ++ks) bnx[ks] = *(const bf16x8*)(Ws + ((size_t)(g + 1) * 128 + t) * 128 + ks * 16 + 8 * h); }
            f32x16 acc = zero16();
#pragma unroll
            for (int ks = 0; ks < 8; ++ks) { const bf16x8 a = *(const LAS bf16x8*)(Vt + (g * 64 + tc * 32 + r) * 272 + (ks * 16 + 8 * h) * 2);
                acc = MFMA32(a, bcur[ks], acc); }
#pragma unroll
            for (int ks = 0; ks < 8; ++ks) bcur[ks] = bnx[ks];
            const float bias = sb[g * 128 + t];
#pragma unroll
            for (int qq = 0; qq < 4; ++qq) { const int c0 = g * 64 + tc * 32 + 8 * qq + 4 * h;
                const u32x2 u = ug[g][qq];
                u32x2 w; w.x = pk2(bflo(u.x) * (acc[4 * qq] + bias), bfhi(u.x) * (acc[4 * qq + 1] + bias)); w.y = pk2(bflo(u.y) * (acc[4 * qq + 2] + bias), bfhi(u.y) * (acc[4 * qq + 3] + bias));
                *(u32x2*)(BRA + (size_t)(row0 + t) * D + 768 + c0) = w; } }
        __syncthreads();
    }
}
__device__ __forceinline__ void qk_conv_pass(Frame& F, int l) {
    const bf16_t* Z = (const bf16_t*)(F.ws + WS_Z); bf16_t* QKC = (bf16_t*)(F.ws + WS_H);
    const int chunk = F.tid & 127, rsub = F.tid >> 7, ch0 = chunk * 8;
    float w0[8], w1[8], w2[8], cbv[8];
    { const float* cw = F.in[IN_CONVW] + (size_t)l * 3 * 1024 + ch0; const float* cb = F.in[IN_CONVB] + (size_t)l * 1024 + ch0;
#pragma unroll
      for (int e = 0; e < 8; ++e) { w0[e] = cw[e]; w1[e] = cw[1024 + e]; w2[e] = cw[2048 + e]; cbv[e] = cb[e]; } }
    const float scale = chunk >= 64 ? 0.08838834764831845f : 1.0f;
    const int ns = F.G * 4, sidx = F.bid * 4 + rsub;
    const int r0 = (int)(((long)sidx * MT) / ns), r1 = (int)(((long)(sidx + 1) * MT) / ns);
    const bf16_t* zb = Z + ZC_QK + ch0;
    const u32x4 zero4 = (u32x4){0u, 0u, 0u, 0u};
    u32x4 xm = zero4, xc = zero4, xn = zero4;
    if (r0 < r1) { xc = *(const u32x4*)(zb + (size_t)r0 * NZ); if (r0 > 0) xm = *(const u32x4*)(zb + (size_t)(r0 - 1) * NZ); if (r0 + 1 < MT) xn = *(const u32x4*)(zb + (size_t)(r0 + 1) * NZ); }
    for (int row = r0; row < r1; ++row) {
        u32x4 xn2 = zero4; if (row + 2 < MT) xn2 = *(const u32x4*)(zb + (size_t)(row + 2) * NZ);
        const int p = row < ML ? (row & 4095) : ((row - ML) & 255), len = row < ML ? 4096 : 256;
        const u32x4 x0 = (p > 0) ? xm : zero4, x1 = xc, x2 = (p + 1 < len) ? xn : zero4;
        const unsigned xa[4] = {x0.x, x0.y, x0.z, x0.w}, xb[4] = {x1.x, x1.y, x1.z, x1.w}, xcc[4] = {x2.x, x2.y, x2.z, x2.w};
        float y[8];
#pragma unroll
        for (int e2 = 0; e2 < 4; ++e2) { y[2 * e2] = cbv[2 * e2] + w0[2 * e2] * bflo(xa[e2]) + w1[2 * e2] * bflo(xb[e2]) + w2[2 * e2] * bflo(xcc[e2]);
            y[2 * e2 + 1] = cbv[2 * e2 + 1] + w0[2 * e2 + 1] * bfhi(xa[e2]) + w1[2 * e2 + 1] * bfhi(xb[e2]) + w2[2 * e2 + 1] * bfhi(xcc[e2]); }
#pragma unroll
        for (int e = 0; e < 8; ++e) y[e] = siluf_(y[e]) * scale;
        u32x4 w; w.x = pk2(y[0], y[1]); w.y = pk2(y[2], y[3]); w.z = pk2(y[4], y[5]); w.w = pk2(y[6], y[7]);
        *(u32x4*)(QKC + (size_t)row * D + ch0) = w;
        xm = xc; xc = xn; xn = xn2;
    }
}
constexpr int ML_QS = 0, ML_KS = 34816, ML_KW = 69632, ML_VT = 104448, ML_CB = 126208, ML_SC = 147968, ML_SCSZ = 2624;
__device__ __forceinline__ float logsigf_(float x) { return fminf(x, 0.f) - __logf(1.0f + __expf(-fabsf(x))); }
__device__ __forceinline__ unsigned swap16(unsigned u) { return __builtin_amdgcn_alignbit(u, u, 16); }
struct MlPre { u32x4 qk[8]; u32x2 v[4]; float g[4]; };
__device__ __forceinline__ void ml_geom(int j, int b, int dir, int& seqbase, int& seqlen, int& pbase) {
    const bool is_ctx = j < 2; int cj = is_ctx ? j : j - 2; const int ncs = is_ctx ? 2 : 32; if (dir) cj = ncs - 1 - cj;
    seqbase = is_ctx ? ML + b * 256 : b * 4096; seqlen = is_ctx ? 256 : 4096; pbase = cj * 128; }
#define ML_BAR() do { asm volatile("s_waitcnt lgkmcnt(0)" ::: "memory"); __builtin_amdgcn_s_barrier(); asm volatile("" ::: "memory"); } while (0)
__device__ __forceinline__ void mlstm_unit(Frame& F, int l, int unit) {
    const int bh = (unit & 7) + 8 * (unit >> 5), sub = (unit >> 3) & 3;
    const int b = bh >> 2, head = bh & 3, dir = sub >> 1, vh = sub & 1;
    LAS unsigned char* QS = F.lds + ML_QS; LAS unsigned char* KS = F.lds + ML_KS; LAS unsigned char* KW = F.lds + ML_KW; LAS unsigned char* VT = F.lds + ML_VT; LAS unsigned char* CB = F.lds + ML_CB;
    const bf16_t* Z = (const bf16_t*)(F.ws + WS_Z); const float* ZG = (const float*)(F.ws + WS_ZG); const bf16_t* QKC = (const bf16_t*)(F.ws + WS_H);
    bf16_t* HF = (bf16_t*)(F.ws + WS_HFB) + (size_t)dir * MT * 512;
    const int wave = F.wave;
    int tl = F.tid;
#define ML_ROLES() const int lane = tl & 63, fr = lane & 15, q4 = lane >> 4; const int isk = (tl >> 4) & 1, ck = tl & 15, i0 = 8 * (tl >> 5), chn = (isk ? 512 : 0) + head * 128 + ck * 8; \
    const int vi0 = 4 * (tl >> 4), vcq = tl & 15, vch = head * 128 + vh * 64 + vcq * 4; (void)fr; (void)q4; (void)vi0; (void)vcq; (void)vch; (void)i0; (void)chn; (void)ck; (void)isk;
    for (int idx = F.tid; idx < 16 * 136; idx += NTHREADS) *(LAS bf16_t*)(VT + (64 + idx / 136) * 272 + (idx % 136) * 2) = (idx < 136) ? (bf16_t)0x3F80 : (bf16_t)0;
    f32x4 cs[5];
#pragma unroll
    for (int vt = 0; vt < 5; ++vt) cs[vt] = (f32x4){0.f, 0.f, 0.f, 0.f};
    float m_state = 0.f;
    MlPre pre;
#define ML_PREFETCH(jj) do { int sb_, sl_, pb_; ml_geom((jj), b, dir, sb_, sl_, pb_); \
        { const int pmin = dir ? pb_ + 120 - i0 : pb_ + i0; const bf16_t* zr = QKC + (size_t)(sb_ + pmin) * D + chn; (void)sl_; \
          _Pragma("unroll") for (int k = 0; k < 8; ++k) pre.qk[k] = *(const u32x4*)(zr + (size_t)k * D); } \
        { const int pminv = dir ? pb_ + 124 - vi0 : pb_ + vi0; const bf16_t* zv = Z + (size_t)(sb_ + pminv) * NZ + ZC_V + vch; \
          _Pragma("unroll") for (int k = 0; k < 4; ++k) pre.v[k] = *(const u32x2*)(zv + (size_t)k * NZ); } \
        if (wave == 0) { const int p0 = dir ? pb_ + 127 - 2 * lane : pb_ + 2 * lane, p1 = dir ? p0 - 1 : p0 + 1; \
          pre.g[0] = ZG[(size_t)(sb_ + p0) * 16 + dir * 8 + head]; pre.g[1] = ZG[(size_t)(sb_ + p0) * 16 + dir * 8 + 4 + head]; \
          pre.g[2] = ZG[(size_t)(sb_ + p1) * 16 + dir * 8 + head]; pre.g[3] = ZG[(size_t)(sb_ + p1) * 16 + dir * 8 + 4 + head]; } } while (0)
#define ML_STEPA(sbuf) do { LAS float* sg_ = (LAS float*)(F.lds + ML_SC + (sbuf) * ML_SCSZ); const int i0g = 2 * lane, i1g = i0g + 1; \
        const float gi0 = pre.g[0], gf0 = pre.g[1], gi1 = pre.g[2], gf1 = pre.g[3]; \
        const float lf0 = logsigf_(gf0), lf1 = logsigf_(gf1); const float s1 = lf0 + lf1; float incl = s1; \
        _Pragma("unroll") for (int o = 1; o < 64; o <<= 1) { const float y_ = shup(incl, o, lane); incl += (lane >= o) ? y_ : 0.f; } \
        const float excl = incl - s1, bc0 = excl + lf0, bc1 = excl + s1; \
        const float g0 = gi0 - bc0, g1 = gi1 - bc1; const float mx1 = fmaxf(g0, g1); float im = mx1; \
        _Pragma("unroll") for (int o = 1; o < 64; o <<= 1) { const float y_ = shup(im, o, lane); im = (lane >= o) ? fmaxf(im, y_) : im; } \
        float em = shup(im, 1, lane); em = (lane == 0) ? -3.0e38f : em; \
        const float M0 = fmaxf(m_state, fmaxf(em, g0)), M1 = fmaxf(m_state, fmaxf(em, mx1)); \
        const float total = bperm(63, bc1), Mlast = bperm(63, M1); \
        sg_[i0g] = g0; sg_[i1g] = g1; sg_[128 + i0g] = M0; sg_[128 + i1g] = M1; \
        sg_[256 + i0g] = __expf(m_state - M0); sg_[256 + i1g] = __expf(m_state - M1); \
        sg_[384 + i0g] = __expf(-(bc0 + M0)); sg_[384 + i1g] = __expf(-(bc1 + M1)); \
        sg_[512 + i0g] = __expf(g0 - Mlast); sg_[512 + i1g] = __expf(g1 - Mlast); \
        if (lane == 0) sg_[640] = __expf(m_state - Mlast); \
        m_state = total + Mlast; } while (0)
    { ML_ROLES(); ML_PREFETCH(0); if (wave == 0) ML_STEPA(0); }
    ML_BAR();
#pragma unroll 1
    for (int j = 0; j < 34; ++j) {
        asm volatile("" : "+v"(tl));
        ML_ROLES();
        int seqbase, seqlen, pbase; ml_geom(j, b, dir, seqbase, seqlen, pbase);
        const LAS float* sc_g = (const LAS float*)(F.lds + ML_SC + (j & 1) * ML_SCSZ); const LAS float* sc_M = sc_g + 128; const LAS float* sc_dec = sc_g + 256; const LAS float* sc_emt = sc_g + 384; const LAS float* sc_wk = sc_g + 512;
        {
#pragma unroll
          for (int k = 0; k < 8; ++k) { const int i = dir ? i0 + 7 - k : i0 + k; *(LAS u32x4*)((isk ? KS : QS) + i * 272 + ck * 16) = pre.qk[k]; }
          if (isk) { u32x4 kt[8]; float ykeep[8];
#pragma unroll
              for (int e = 0; e < 8; ++e) { kt[e] = (u32x4){0u, 0u, 0u, 0u}; ykeep[e] = 0.f; }
#pragma unroll
              for (int k = 0; k < 8; ++k) { const int i = dir ? i0 + 7 - k : i0 + k; const float wk = sc_wk[i];
                  const unsigned xb[4] = {pre.qk[k].x, pre.qk[k].y, pre.qk[k].z, pre.qk[k].w};
#pragma unroll
                  for (int e = 0; e < 8; ++e) { const float yw = ((e & 1) ? bfhi(xb[e >> 1]) : bflo(xb[e >> 1])) * wk;
                      if (k & 1) { const unsigned pw_ = pk2(ykeep[e], yw); if ((k >> 1) == 0) kt[e].x = pw_; else if ((k >> 1) == 1) kt[e].y = pw_; else if ((k >> 1) == 2) kt[e].z = pw_; else kt[e].w = pw_; }
                      else ykeep[e] = yw; } }
#pragma unroll
              for (int e = 0; e < 8; ++e) { u32x4 o = kt[e]; if (dir) o = (u32x4){swap16(kt[e].w), swap16(kt[e].z), swap16(kt[e].y), swap16(kt[e].x)};
                  *(LAS u32x4*)(KW + (ck * 8 + e) * 272 + (((i0 >> 3) ^ (ck & 7)) * 16)) = o; } } }
        { unsigned vv[4][2];
#pragma unroll
          for (int k = 0; k < 4; ++k) { vv[k][0] = pre.v[k].x; vv[k][1] = pre.v[k].y; }
#pragma unroll
          for (int c = 0; c < 4; ++c) {
              unsigned h0 = (c & 1) ? (vv[0][c >> 1] >> 16) : (vv[0][c >> 1] & 0xffffu), h1 = (c & 1) ? (vv[1][c >> 1] >> 16) : (vv[1][c >> 1] & 0xffffu);
              unsigned h2 = (c & 1) ? (vv[2][c >> 1] >> 16) : (vv[2][c >> 1] & 0xffffu), h3 = (c & 1) ? (vv[3][c >> 1] >> 16) : (vv[3][c >> 1] & 0xffffu);
              u32x2 o; if (dir) { o.x = h3 | (h2 << 16); o.y = h1 | (h0 << 16); } else { o.x = h0 | (h1 << 16); o.y = h2 | (h3 << 16); }
              *(LAS u32x2*)(VT + (vcq * 4 + c) * 272 + vi0 * 2) = o; } }
#pragma unroll
        for (int vt = 0; vt < 5; ++vt)
#pragma unroll
            for (int rr = 0; rr < 4; rr += 2) { const unsigned pw_ = pk2(cs[vt][rr], cs[vt][rr + 1]);
                *(LAS bf16_t*)(CB + (16 * vt + 4 * q4 + rr) * 272 + (16 * wave + fr) * 2) = (bf16_t)(pw_ & 0xffffu); *(LAS bf16_t*)(CB + (16 * vt + 4 * q4 + rr + 1) * 272 + (16 * wave + fr) * 2) = (bf16_t)(pw_ >> 16); }
        ML_BAR();
        if (j + 1 < 34) ML_PREFETCH(j + 1);
        const int t = 16 * wave + fr;
        bf16x8 qf[4];
#pragma unroll
        for (int kc = 0; kc < 4; ++kc) qf[kc] = *(const LAS bf16x8*)(QS + t * 272 + (32 * kc + 8 * q4) * 2);
        const float Mt_t = sc_M[t], dec_t = sc_dec[t], emt_t = sc_emt[t];
        f32x4 ps[8];
#pragma unroll
        for (int jp = 0; jp < 4; ++jp) {
            ps[2 * jp] = (f32x4){0.f, 0.f, 0.f, 0.f}; ps[2 * jp + 1] = (f32x4){0.f, 0.f, 0.f, 0.f};
            if (2 * jp <= wave) {
                bf16x8 ka[4], kb[4];
#pragma unroll
                for (int kc = 0; kc < 4; ++kc) { ka[kc] = *(const LAS bf16x8*)(KS + (32 * jp + fr) * 272 + (32 * kc + 8 * q4) * 2); kb[kc] = *(const LAS bf16x8*)(KS + (32 * jp + 16 + fr) * 272 + (32 * kc + 8 * q4) * 2); }
                const f32x4 ga4 = *(const LAS f32x4*)(sc_g + 32 * jp + 4 * q4), gb4 = *(const LAS f32x4*)(sc_g + 32 * jp + 16 + 4 * q4);
                f32x4 acc0 = (f32x4){0.f, 0.f, 0.f, 0.f}, acc1 = (f32x4){0.f, 0.f, 0.f, 0.f};
#pragma unroll
                for (int kc = 0; kc < 4; ++kc) { acc0 = MFMA16(ka[kc], qf[kc], acc0); acc1 = MFMA16(kb[kc], qf[kc], acc1); }
#pragma unroll
                for (int rr = 0; rr < 4; ++rr) { const int s0 = 32 * jp + 4 * q4 + rr, s1 = s0 + 16;
                    ps[2 * jp][rr] = (s0 <= t) ? acc0[rr] * __expf(ga4[rr] - Mt_t) : 0.f; ps[2 * jp + 1][rr] = (s1 <= t) ? acc1[rr] * __expf(gb4[rr] - Mt_t) : 0.f; }
            }
        }
        f32x4 ao[5];
        {
#pragma unroll
          for (int vt = 0; vt < 5; ++vt) ao[vt] = (f32x4){0.f, 0.f, 0.f, 0.f};
#pragma unroll
          for (int kh = 0; kh < 4; kh += 2) { bf16x8 cf[2][5];
#pragma unroll
              for (int k2 = 0; k2 < 2; ++k2)
#pragma unroll
                  for (int vt = 0; vt < 5; ++vt) cf[k2][vt] = *(const LAS bf16x8*)(CB + (16 * vt + fr) * 272 + (32 * (kh + k2) + 8 * q4) * 2);
#pragma unroll
              for (int k2 = 0; k2 < 2; ++k2)
#pragma unroll
                  for (int vt = 0; vt < 5; ++vt) ao[vt] = MFMA16(cf[k2][vt], qf[kh + k2], ao[vt]); }
#pragma unroll
          for (int vt = 0; vt < 5; ++vt) ao[vt] = ao[vt] * dec_t; }
#pragma unroll
        for (int ks = 0; ks < 4; ++ks) {
            if (2 * ks <= wave) {
                s16x4 vlo[5], vhi[5];
#pragma unroll
                for (int vt = 0; vt < 5; ++vt) { vlo[vt] = *(const LAS s16x4*)(VT + (16 * vt + fr) * 272 + (32 * ks + 4 * q4) * 2); vhi[vt] = *(const LAS s16x4*)(VT + (16 * vt + fr) * 272 + (32 * ks + 16 + 4 * q4) * 2); }
                u32x4 pw; pw.x = cvt_pk_bf16(ps[2 * ks][0], ps[2 * ks][1]); pw.y = cvt_pk_bf16(ps[2 * ks][2], ps[2 * ks][3]); pw.z = cvt_pk_bf16(ps[2 * ks + 1][0], ps[2 * ks + 1][1]); pw.w = cvt_pk_bf16(ps[2 * ks + 1][2], ps[2 * ks + 1][3]);
                const bf16x8 pf = __builtin_bit_cast(bf16x8, pw);
#pragma unroll
                for (int vt = 0; vt < 5; ++vt) { const bf16x8 a = __builtin_shufflevector(vlo[vt], vhi[vt], 0, 1, 2, 3, 4, 5, 6, 7); ao[vt] = MFMA16(a, pf, ao[vt]); }
            }
        }
        { const float den = bperm(fr, ao[4][0]); const float inv = 1.0f / fmaxf(fabsf(den), emt_t);
          const int p = dir ? pbase + 127 - t : pbase + t; bf16_t* orow = HF + (size_t)(seqbase + p) * 512 + head * 128 + vh * 64 + 4 * q4;
#pragma unroll
          for (int vt = 0; vt < 4; ++vt) { const f32x4 o = ao[vt] * inv; u32x2 w; w.x = cvt_pk_bf16(o[0], o[1]); w.y = cvt_pk_bf16(o[2], o[3]); *(u32x2*)(orow + 16 * vt) = w; } }
        { const float a_s = sc_g[640];
#pragma unroll
          for (int vt = 0; vt < 5; ++vt) cs[vt] = cs[vt] * a_s;
#pragma unroll
          for (int ks = 0; ks < 4; ks += 2) { bf16x8 bb[2], va[2][5];
#pragma unroll
              for (int k2 = 0; k2 < 2; ++k2) { bb[k2] = *(const LAS bf16x8*)(KW + (16 * wave + fr) * 272 + (((4 * (ks + k2) + q4) ^ (((16 * wave + fr) >> 3) & 7)) * 16));
#pragma unroll
                  for (int vt = 0; vt < 5; ++vt) va[k2][vt] = *(const LAS bf16x8*)(VT + (16 * vt + fr) * 272 + (32 * (ks + k2) + 8 * q4) * 2); }
#pragma unroll
              for (int k2 = 0; k2 < 2; ++k2)
#pragma unroll
                  for (int vt = 0; vt < 5; ++vt) cs[vt] = MFMA16(va[k2][vt], bb[k2], cs[vt]); } }
        if (wave == 0 && j + 1 < 34) ML_STEPA((j + 1) & 1);
        ML_BAR();
    }
#undef ML_PREFETCH
#undef ML_STEPA
#undef ML_ROLES
    __syncthreads();
}
__device__ __forceinline__ void phase_mixers(Frame& F, int l) {
    const bool with_ctx = (l != DEPTH - 1);
#ifndef MIX_MASK
#define MIX_MASK 7
#endif
#ifndef MIXREP
#define MIXREP 0
#endif
    if (MIX_MASK & 1) pool_tiles(F, l, with_ctx);
    if (MIXREP & 1) { __syncthreads(); pool_tiles(F, l, with_ctx); }
    if (MIX_MASK & 2) sgu_chunks(F, l, with_ctx);
    if (MIXREP & 2) { __syncthreads(); sgu_chunks(F, l, with_ctx); }
    (void)0;
    qk_conv_pass(F, l);
}
__device__ __forceinline__ void phase_mlstm(Frame& F, int l) {
    for (int u = F.bid; u < 256; u += F.G) mlstm_unit(F, l, u);
}

struct Args { const float* in[31]; float* out; unsigned char* ws; int g_lo, g_hi, pad0, pad1; };
constexpr int NPH = 11, NGID = 2 + DEPTH * NPH;
__global__ void __launch_bounds__(NTHREADS, 2) fwd_kernel(Args args) {
    extern __shared__ __attribute__((aligned(16))) unsigned char lds_raw[];
    Frame F;
    F.lds = (LAS unsigned char*)lds_raw; F.MISC = (volatile LAS unsigned*)(F.lds + MISC_OFF);
    F.tid = threadIdx.x; F.lane = F.tid & 63; F.wave = __builtin_amdgcn_readfirstlane(F.tid >> 6); F.G = gridDim.x; F.bid = blockIdx.x;
    F.ws = args.ws; F.out = args.out;
    F.in = (InTab)__builtin_amdgcn_kernarg_segment_ptr();
    if (F.tid < 64) F.MISC[F.tid] = 0u;
    __syncthreads();
    const int lo = args.g_lo, hi = args.g_hi;
    const bool multi = (hi - lo) > 1;
    XcdBarrier bar; bar.bar = (unsigned*)(F.ws + WS_CTL) + CW_BAR; bar.x = 0; bar.st = nullptr;
    if (multi) bar = xcd_barrier_post((unsigned*)(F.ws + WS_CTL) + CW_BAR, F.MISC + 8);
#ifndef PHASE_MASK
#define PHASE_MASK 0xFFFF
#endif
#define RUN(g) (lo <= (g) && (g) < hi)
#define RUNP(ty, g) ((((PHASE_MASK) >> (ty)) & 1) && RUN(g))
#ifndef REPEAT_MASK
#define REPEAT_MASK 0
#endif
#define NREP(ty) ((((REPEAT_MASK) >> (ty)) & 1) ? 2 : 1)
#define SEAM(g) do { if (RUN((g) + 1)) xcd_barrier(bar); } while (0)
#define LAUNDER(P) Frame P = F; { int t_; asm volatile("v_mbcnt_lo_u32_b32 %0, -1, 0\n\tv_mbcnt_hi_u32_b32 %0, -1, %0" : "=v"(t_)); t_ |= (F.wave << 6); P.tid = t_; P.lane = t_ & 63; P.wave = __builtin_amdgcn_readfirstlane(t_ >> 6); GAS unsigned char* w_ = (GAS unsigned char*)F.ws; asm volatile("" : "+s"(w_)); P.ws = (unsigned char*)w_; InTab t2_ = F.in; asm volatile("" : "+s"(t2_)); P.in = t2_; }
    if (RUNP(0, 0)) { LAUNDER(P); for (int rep_ = 0; rep_ < NREP(0); ++rep_) { phase_prologue(P); __syncthreads(); } SEAM(0); }
    if (RUNP(1, 1)) { LAUNDER(P); for (int rep_ = 0; rep_ < NREP(1); ++rep_) { phase_ln0_first(P); __syncthreads(); } SEAM(1); }
#pragma unroll 1
    for (int l = 0; l < DEPTH; ++l) {
        const int g0 = 2 + l * NPH;
        const int mrows = (l == DEPTH - 1) ? ML : MT;
        if (RUNP(2, g0 + 0)) {
#undef PHTY
#define PHTY 2
            LAUNDER(P);
            { ProbPlain Pr{(const bf16_t*)(P.ws + WS_H), (const bf16_t*)(P.ws + WS_WIN) + (size_t)l * NZ * D, D, D};
              pg8::StaticOrder<1> S; S.init(MT / 256, NZ_BF / 256, P.G, P.bid);
              EpiInproj<false> E{(bf16_t*)(P.ws + WS_Z), P.in[IN_BIN] + (size_t)l * 5904, 0};
              pg8::gemm_phase(P.lds, P.tid, Pr, S, E); }
            __syncthreads();
            { ProbPlainF8 Pr{(const bf16_t*)(P.ws + WS_H8), (const bf16_t*)(P.ws + WS_WIN8 + (size_t)l * NZ_F8 * D), D / 2, D / 2};
              pg8::StaticOrder<1> S; S.init(MT / 256, NZ_F8 / 256, P.G, P.bid);
              EpiInproj<true> E{(bf16_t*)(P.ws + WS_Z), P.in[IN_BIN] + (size_t)l * 5904, NZ_BF / 256};
              pg8::gemm_phase(P.lds, P.tid, Pr, S, E); }
            SEAM(g0 + 0);
        }
        if (RUNP(3, g0 + 1)) { LAUNDER(P); for (int rep_ = 0; rep_ < NREP(3); ++rep_) { phase_mixers(P, l); __syncthreads(); } SEAM(g0 + 1); }
        if (RUNP(12, g0 + 2)) { LAUNDER(P); for (int rep_ = 0; rep_ < NREP(12); ++rep_) { phase_mlstm(P, l); __syncthreads(); } SEAM(g0 + 2); }
        if (RUNP(4, g0 + 3)) { LAUNDER(P); for (int rep_ = 0; rep_ < NREP(4); ++rep_) phase_finalize(P, l, mrows); SEAM(g0 + 3); }
        if (RUNP(5, g0 + 4)) {
#undef PHTY
#define PHTY 5
            LAUNDER(P);
            ProbPlain Pr{(const bf16_t*)(P.ws + WS_BRA), (const bf16_t*)(P.ws + WS_WBR) + (size_t)l * D * D, D, D};
            pg8::StaticOrder<1> S; S.init(mrows / 256, 4, P.G, P.bid);
            EpiBranch E{(const bf16_t*)(P.ws + WS_Z), (bf16_t*)(P.ws + WS_Y)};
            pg8::gemm_phase(P.lds, P.tid, Pr, S, E); if (NREP(PHTY) == 2) { __syncthreads(); pg8::gemm_phase(P.lds, P.tid, Pr, S, E); }
            SEAM(g0 + 4);
        }
        if (RUNP(6, g0 + 5)) {
#undef PHTY
#define PHTY 6
            LAUNDER(P);
            ProbPlain Pr{(const bf16_t*)(P.ws + WS_Y), (const bf16_t*)(P.ws + WS_WOUT) + (size_t)l * D * D, D, D};
            pg8::StaticOrder<1> S; S.init(mrows / 256, 4, P.G, P.bid);
            EpiOut E{(bf16_t*)(P.ws + WS_T)};
            pg8::gemm_phase(P.lds, P.tid, Pr, S, E); if (NREP(PHTY) == 2) { __syncthreads(); pg8::gemm_phase(P.lds, P.tid, Pr, S, E); }
            SEAM(g0 + 5);
        }
        if (RUNP(7, g0 + 6)) { LAUNDER(P); for (int rep_ = 0; rep_ < NREP(7); ++rep_) phase_ln1_router(P, l, mrows); SEAM(g0 + 6); }
        if (RUNP(8, g0 + 7)) { LAUNDER(P); for (int rep_ = 0; rep_ < NREP(8); ++rep_) phase_slots(P, mrows); SEAM(g0 + 7); }
        if (RUNP(9, g0 + 8)) {
#undef PHTY
#define PHTY 9
            LAUNDER(P);
            LAS int* seg = (LAS int*)(P.lds + TAB_OFF);
            const int ntile = moe_tables(P, seg);
            ProbMoe1 Pr{(const bf16_t*)(P.ws + WS_H2F8), (const bf16_t*)(P.ws + WS_WGU + (size_t)l * NEXP * 2048 * D), D / 2, D / 2, (const int*)(P.ws + WS_ROUTE + RT_TOK), seg};
            pg8::StaticOrder<1> S; S.init(ntile, 8, P.G, P.bid);
            EpiSwiglu E{(unsigned char*)(P.ws + WS_HID), P.in[IN_BGU] + (size_t)l * NEXP * 2048, seg};
            pg8::gemm_phase(P.lds, P.tid, Pr, S, E); if (NREP(PHTY) == 2) { __syncthreads(); pg8::gemm_phase(P.lds, P.tid, Pr, S, E); }
            SEAM(g0 + 8);
        }
        if (RUNP(10, g0 + 9)) {
#undef PHTY
#define PHTY 10
            LAUNDER(P);
            LAS int* seg = (LAS int*)(P.lds + TAB_OFF);
            const int ntile = moe_tables(P, seg);
            ProbMoe2 Pr{(const bf16_t*)(P.ws + WS_HID), (const bf16_t*)(P.ws + WS_WDN + (size_t)l * NEXP * D * D), D / 2, D / 2, seg};
            pg8::StaticOrder<1> S; S.init(ntile, 4, P.G, P.bid);
            EpiDown E{(unsigned char*)(P.ws + WS_FS), P.in[IN_BDN] + (size_t)l * NEXP * D, (const int*)(P.ws + WS_ROUTE + RT_DEST), (const float*)(P.ws + WS_ROUTE + RT_PSLOT), seg};
            pg8::gemm_phase(P.lds, P.tid, Pr, S, E); if (NREP(PHTY) == 2) { __syncthreads(); pg8::gemm_phase(P.lds, P.tid, Pr, S, E); }
            SEAM(g0 + 9);
        }
        if (RUNP(11, g0 + 10)) { LAUNDER(P); phase_combine_ln2(P, l, mrows); SEAM(g0 + 10); }
    }
#undef LAUNDER
#undef RUN
#undef RUNP
#undef SEAM
}

extern "C" void kernel_launch(void* const* d_in, const int* in_sizes, int n_in, void* d_out, int out_size, void* d_ws, size_t ws_size, hipStream_t stream) {
    static int grid = 0;
    if (grid == 0) {
        if (n_in != 31 || out_size != ML * D || ws_size < WS_END) { fprintf(stderr, "kernel_launch: unexpected problem (n_in %d, out %d, ws %zu, need %zu)\n", n_in, out_size, ws_size, (size_t)WS_END); grid = -1; return; }
        int dev = 0, cus = 0, per_cu = 0;
        if (hipGetDevice(&dev) != hipSuccess || hipDeviceGetAttribute(&cus, hipDeviceAttributeMultiprocessorCount, dev) != hipSuccess) { grid = -1; return; }
        if (hipFuncSetAttribute((const void*)fwd_kernel, hipFuncAttributeMaxDynamicSharedMemorySize, LDS_BYTES) != hipSuccess) { fprintf(stderr, "kernel_launch: hipFuncSetAttribute failed\n"); grid = -1; return; }
        if (hipOccupancyMaxActiveBlocksPerMultiprocessor(&per_cu, (const void*)fwd_kernel, NTHREADS, LDS_BYTES) != hipSuccess || per_cu < 1) fprintf(stderr, "kernel_launch: occupancy query reports %d\n", per_cu);
        (void)hipGetLastError();
        grid = cus;
    }
    if (grid < 0) return;
    (void)hipMemsetAsync((char*)d_ws + WS_CTL, 0, CTL_ZERO_BYTES, stream);
    Args a{};
    for (int i = 0; i < 31; ++i) a.in[i] = (const float*)d_in[i];
    a.out = (float*)d_out; a.ws = (unsigned char*)d_ws;
#if MK_N_LAUNCHES == 1
    a.g_lo = 0; a.g_hi = NGID;
    hipLaunchKernelGGL(fwd_kernel, dim3(grid), dim3(NTHREADS), LDS_BYTES, stream, a);
#else
    for (int g = 0; g < NGID; ++g) { a.g_lo = g; a.g_hi = g + 1; hipLaunchKernelGGL(fwd_kernel, dim3(grid), dim3(NTHREADS), LDS_BYTES, stream, a); }
#endif
}
```

```cpp
#include <hip/hip_runtime.h>
#include <cstdio>
#include <cstdint>

#ifndef MK_N_LAUNCHES
#define MK_N_LAUNCHES 1
#endif

#define LAS __attribute__((address_space(3)))
#define GAS __attribute__((address_space(1)))
typedef unsigned short bf16_t;
typedef short bf16x8 __attribute__((ext_vector_type(8)));
typedef short s16x4 __attribute__((ext_vector_type(4)));
typedef float f32x4 __attribute__((ext_vector_type(4)));
typedef float f32x2 __attribute__((ext_vector_type(2)));
typedef float f32x16 __attribute__((ext_vector_type(16)));
typedef unsigned u32x4 __attribute__((ext_vector_type(4)));
typedef unsigned u32x2 __attribute__((ext_vector_type(2)));
typedef int i32x4 __attribute__((ext_vector_type(4)));
typedef int i32x8 __attribute__((ext_vector_type(8)));

constexpr int D = 1024, NB = 16, SEQ = 4096, CTXL = 256, DEPTH = 4;
constexpr int ML = NB * SEQ;
constexpr int MC = NB * CTXL;
constexpr int MT = ML + MC;
constexpr int NZ = 5888;
constexpr int ZC_P = 0, ZC_QK = 256, ZC_V = 1280, ZC_O = 1792, ZC_UV = 2304, ZC_MG = 2816;
constexpr int NZ_BF = 256, NZ_F8 = 5632;
constexpr int ZG_COL = 2816;
constexpr int NEXP = 32, TOPK = 4;
constexpr int NS_MAX = MT * TOPK + NEXP * 256;
constexpr float LN_EPS = 1e-5f, HEAD_EPS = 1e-6f;
constexpr float DN_ALPHA = 1.6817928305074292f;
constexpr int NWAVES = 8, NTHREADS = 512;
constexpr float F8S_ACT = 4.0f, F8S_WGU = 64.0f, F8S_WDN = 64.0f; constexpr int F8E_ACT = 123, F8E_WGU = 123, F8E_WDN = 123;

constexpr size_t MiB = 1u << 20;
constexpr size_t WS_CTL = 0, CTL_ZERO_BYTES = 1 * MiB;
constexpr size_t WS_MOD = 1 * MiB;
constexpr size_t WS_WG = 3 * MiB;
constexpr size_t WS_WSGU = 4 * MiB;
constexpr size_t WS_WPOOL = WS_WSGU + 512 * 1024;
constexpr size_t WS_ROUTE = 5 * MiB;
constexpr size_t WS_WIN = 16 * MiB;
constexpr size_t WS_WBR = 62 * MiB;
constexpr size_t WS_WOUT = 70 * MiB;
constexpr size_t WS_WGU = 78 * MiB;
constexpr size_t WS_WDN = 590 * MiB;
constexpr size_t WS_X = 846 * MiB;
constexpr size_t WS_H = 1118 * MiB;
constexpr size_t WS_Z = 1254 * MiB;
constexpr size_t WS_FS = WS_Z;
constexpr float G8_SCALE = 255.0f;
constexpr float FS_SCALE = 32.0f, FS_CLAMP = 440.0f;
constexpr size_t WS_BRA = 2036 * MiB;
constexpr size_t WS_HFB = 2172 * MiB;
constexpr size_t WS_Y = 2444 * MiB;
constexpr size_t WS_T = 2580 * MiB;
constexpr size_t WS_H2 = 2852 * MiB;
constexpr size_t WS_HID = 2988 * MiB;
constexpr size_t WS_ZG = 3548 * MiB;
constexpr size_t WS_H2F8 = 3554 * MiB;
constexpr size_t WS_H8 = 3624 * MiB;
constexpr size_t WS_WIN8 = 3692 * MiB;
constexpr size_t WS_END = 3714 * MiB;
static_assert(WS_Z + (size_t)MT * NZ * 2 <= WS_BRA && WS_FS + (size_t)MT * 4 * 1024 * 2 <= WS_BRA, "Z/FS");
static_assert(WS_HID + (size_t)NS_MAX * 1024 * 2 <= WS_END, "HID");
constexpr size_t RT_EIDX = 0;
constexpr size_t RT_PROB = 2 * MiB;
constexpr size_t RT_TOK = 4 * MiB;
constexpr size_t RT_DEST = 6 * MiB;
constexpr size_t RT_PSLOT = 8 * MiB;
constexpr size_t RT_CNT = 10 * MiB;
constexpr size_t RT_SEG = 10 * MiB + 64 * 1024;
constexpr int CW_BAR = 4096;

constexpr int LDS_BYTES = 163840;
constexpr int MISC_OFF = LDS_BYTES - 256;
constexpr int TAB_OFF = 131072;
constexpr int NW_WT = 0;
constexpr int NW_LG = 66048;
constexpr int NW_END = 99840;
constexpr int NW_PV = NW_END + 256;

__device__ __forceinline__ unsigned f2bf(float f) { unsigned u = __builtin_bit_cast(unsigned, f); return (u + 0x7fffu + ((u >> 16) & 1u)) >> 16; }
__device__ __forceinline__ unsigned pk2(float lo, float hi) { unsigned r; asm volatile("v_cvt_pk_bf16_f32 %0, %1, %2" : "=v"(r) : "v"(lo), "v"(hi)); return r; }
__device__ __forceinline__ unsigned pk4_fp8(float a, float b, float c, float d) { int w = 0; w = __builtin_amdgcn_cvt_pk_fp8_f32(a, b, w, false); w = __builtin_amdgcn_cvt_pk_fp8_f32(c, d, w, true); return (unsigned)w; }
__device__ __forceinline__ unsigned pk4_u8(float a, float b, float c, float d) {
    const unsigned lo = __builtin_amdgcn_perm(__builtin_bit_cast(unsigned, b), __builtin_bit_cast(unsigned, a), 0x0c0c0400u), hi = __builtin_amdgcn_perm(__builtin_bit_cast(unsigned, d), __builtin_bit_cast(unsigned, c), 0x0c0c0400u);
    return lo | (hi << 16); }
__device__ __forceinline__ f32x4 u8x4_f32(unsigned w) { return (f32x4){(float)(w & 0xffu), (float)((w >> 8) & 0xffu), (float)((w >> 16) & 0xffu), (float)(w >> 24)}; }
__device__ __forceinline__ float bflo(unsigned w) { return __builtin_bit_cast(float, w << 16); }
__device__ __forceinline__ float bfhi(unsigned w) { return __builtin_bit_cast(float, w & 0xffff0000u); }
__device__ __forceinline__ float bf1(bf16_t h) { return __builtin_bit_cast(float, ((unsigned)h) << 16); }
__device__ __forceinline__ float bperm(int srclane, float v) { return __builtin_bit_cast(float, __builtin_amdgcn_ds_bpermute(srclane << 2, __builtin_bit_cast(int, v))); }
__device__ __forceinline__ float shx(float v, int o, int lane) { return bperm(lane ^ o, v); }
__device__ __forceinline__ float shup(float v, int o, int lane) { return bperm(lane >= o ? lane - o : lane, v); }
__device__ __forceinline__ float wave_sum(float v, int lane) {
#pragma unroll
    for (int o = 1; o < 64; o <<= 1) v += shx(v, o, lane);
    return v;
}
__device__ __forceinline__ float sigmoidf_(float x) { return __builtin_amdgcn_rcpf(1.0f + __builtin_amdgcn_exp2f(x * -1.4426950408889634f)); }
__device__ __forceinline__ float siluf_(float x) { return x * __builtin_amdgcn_rcpf(1.0f + __builtin_amdgcn_exp2f(x * -1.4426950408889634f)); }
__device__ __forceinline__ f32x4 sigmoid4(f32x4 x) {
    f32x4 t = x * -1.4426950408889634f;
#pragma unroll
    for (int i = 0; i < 4; ++i) t[i] = __builtin_amdgcn_exp2f(t[i]);
    t = t + 1.0f;
#pragma unroll
    for (int i = 0; i < 4; ++i) t[i] = __builtin_amdgcn_rcpf(t[i]);
    return t; }
#define LDS_WAIT() asm volatile("s_waitcnt lgkmcnt(0)" ::: "memory")
#define VM_WAIT() asm volatile("s_waitcnt vmcnt(0)" ::: "memory")

#define XB_TMO      128
#define XB_XCNT(j)  (256  + 64 * (j))
#define XB_XSUB(j)  (1280 + 64 * (j))
#define XB_XGEN(j)  (2304 + 64 * (j))
#define XB_TOP      3328
#define XB_TOPGEN   3392
#define XCD_BAR_WORDS 3456
#define XB_SPIN_CAP (1u << 18)
__device__ __forceinline__ unsigned xb_ld(unsigned* p)              { asm volatile("" : "+v"(p)); return __hip_atomic_load(p, __ATOMIC_RELAXED, __HIP_MEMORY_SCOPE_AGENT); }
__device__ __forceinline__ unsigned xb_add(unsigned* p, unsigned v) { asm volatile("" : "+v"(p), "+v"(v)); return __hip_atomic_fetch_add(p, v, __ATOMIC_RELAXED, __HIP_MEMORY_SCOPE_AGENT); }
__device__ __forceinline__ unsigned xb_xcc_id() { return (unsigned)__builtin_amdgcn_s_getreg((3 << 11) | 20) & 0xFu; }
#define XB_SPIN(cond, bar) do { unsigned _sp = 0; while (cond) { __builtin_amdgcn_s_sleep(1); \
    if ((++_sp & 255u) == 0u) { if (xb_ld(&(bar)[XB_TMO])) break; if (_sp > XB_SPIN_CAP) { atomicAdd(&(bar)[XB_TMO], 1u); break; } } } } while (0)
struct XcdBarrier { unsigned* bar; unsigned x; volatile LAS unsigned* st; };
__device__ __forceinline__ XcdBarrier xcd_barrier_post(unsigned* bar, volatile LAS unsigned* st) {
    XcdBarrier b; b.bar = bar; b.x = xb_xcc_id(); b.st = st;
    if (threadIdx.x == 0) (void)xb_add(&bar[XB_XCNT(b.x)], 1u);
    return b;
}
__device__ __forceinline__ void xcd_barrier_complete(unsigned* bar, unsigned x, unsigned& nloc, unsigned& nx) {
    const unsigned G = gridDim.x * gridDim.y * gridDim.z;
    unsigned sum, cnt, mine, sp = 0u;
    for (;;) {
        sum = 0u; cnt = 0u; mine = 0u;
#pragma unroll
        for (unsigned j = 0; j < 16; ++j) { const unsigned c = xb_ld(&bar[XB_XCNT(j)]); sum += c; cnt += (c > 0u) ? 1u : 0u; mine = (j == x) ? c : mine; }
        if (sum == G) break;
        __builtin_amdgcn_s_sleep(1);
        if ((++sp & 255u) == 0u) { if (xb_ld(&bar[XB_TMO])) break; if (sp > XB_SPIN_CAP) { atomicAdd(&bar[XB_TMO], 1u); break; } }
    }
    nloc = mine > 0u ? mine : 1u; nx = cnt > 0u ? cnt : 1u;
}
__device__ __forceinline__ void xcd_barrier(const XcdBarrier& b) {
    asm volatile("s_waitcnt vmcnt(0)" ::: "memory");
    __syncthreads();
    if (threadIdx.x == 0) {
        unsigned* bar = b.bar;
        __builtin_amdgcn_s_waitcnt(0);
        unsigned nloc = b.st[0], nx = b.st[1];
        if (nloc == 0u) { xcd_barrier_complete(bar, b.x, nloc, nx); b.st[0] = nloc; b.st[1] = nx; }
        const unsigned old = xb_add(&bar[XB_XSUB(b.x)], 1u);
        const unsigned gen = old / nloc;
        if (old + 1u == (gen + 1u) * nloc) {
            __builtin_amdgcn_fence(__ATOMIC_RELEASE, "agent");
            asm volatile("s_waitcnt vmcnt(0)" ::: "memory");
            const unsigned og = xb_add(&bar[XB_TOP], 1u);
            const unsigned tg = og / nx;
            if (og + 1u == (tg + 1u) * nx) xb_add(&bar[XB_TOPGEN], 1u);
            else XB_SPIN(xb_ld(&bar[XB_TOPGEN]) == tg, bar);
            __builtin_amdgcn_fence(__ATOMIC_ACQUIRE, "agent");
            xb_add(&bar[XB_XGEN(b.x)], 1u);
            asm volatile("s_waitcnt vmcnt(0)" ::: "memory");
        } else {
            XB_SPIN(xb_ld(&bar[XB_XGEN(b.x)]) == gen, bar);
            __builtin_amdgcn_fence(__ATOMIC_ACQUIRE, "agent");
            asm volatile("s_waitcnt vmcnt(0)" ::: "memory");
        }
    }
    __syncthreads();
}

namespace pg8 {
constexpr int BM = 256, BK = 64, HALF = 128, HTB = HALF * BK * 2, STAGE_BYTES = 8 * HTB, NXCD = 8, WGM = 8;
__host__ __device__ __forceinline__ int lds_byte(int r, int c) { const int st = (r >> 4) * 2 + (c >> 5), rr = r & 15, cc = c & 31, ob = rr * 64 + cc * 2; return st * 1024 + (ob ^ (((ob >> 9) & 1) << 5)); }
__host__ __device__ __forceinline__ void stage_rc(int b, int& R, int& C) { const int st = b / 1024, sb = b % 1024, swz = sb ^ (((sb >> 9) & 1) << 5); R = (st >> 1) * 16 + swz / 64; C = (st & 1) * 32 + (swz % 64) / 2; }
__host__ __device__ __forceinline__ int perm32(int rho) { const int n = rho >> 4, i = rho & 15; return 8 * (i >> 2) + 4 * n + (i & 3); }
struct Unit { int pm, pn, sub; };
__device__ __forceinline__ unsigned cvt_pk_bf16(float lo, float hi) { unsigned r; asm volatile("v_cvt_pk_bf16_f32 %0, %1, %2" : "=v"(r) : "v"(lo), "v"(hi)); return r; }
__device__ __forceinline__ f32x2 gelu_pk(f32x2 v) {
    const f32x2 av = __builtin_elementwise_abs(v), d = av * 0.2316418882f + 1.0f;
    f32x2 t; t.x = __builtin_amdgcn_rcpf(d.x); t.y = __builtin_amdgcn_rcpf(d.y);
    f32x2 q = t * 0.5307027145f + (-0.7265760135f); q = q * t + 0.7107068705f; q = q * t + (-0.142248368f); q = q * t + 0.127414796f; q = q * t;
    const f32x2 s = (v * v) * (-0.72134752044f);
    f32x2 e; e.x = __builtin_amdgcn_exp2f(s.x); e.y = __builtin_amdgcn_exp2f(s.y);
    const f32x2 m = v * (q * e), r = v - m;
    f32x2 o; o.x = v.x < 0.f ? m.x : r.x; o.y = v.y < 0.f ? m.y : r.y; return o;
}
template <int NSUB = 1> struct StaticOrder {
    int nM, nN, nwg, G, c;
    __device__ void init(int nM_, int nN_, int G_, int c_) { nM = nM_; nN = nN_; nwg = nM * nN; G = G_; c = c_; }
    __device__ bool next(int i, Unit& u) const {
        const int it = i / NSUB; u.sub = i - it * NSUB;
        const long L = (long)it * G + c; if (L >= nwg) return false;
        int wgid = (int)L; { const int q = nwg / NXCD, r = nwg % NXCD, xcd = wgid % NXCD, off = wgid / NXCD; wgid = (xcd < r ? xcd * (q + 1) : r * (q + 1) + (xcd - r) * q) + off; }
        const int nig = WGM * nN, gid = wgid / nig, fm = gid * WGM, gsz = (nM - fm) < WGM ? (nM - fm) : WGM;
        u.pm = fm + ((wgid % nig) % gsz); u.pn = (wgid % nig) / gsz; return true;
    }
};
constexpr int SIDE_TOK = 131072 + 2048;
constexpr int SIDE_SLOT = 131072 + 10240, SIDE_SLOT_BYTES = 3072;
__device__ __forceinline__ void dma16(unsigned voff, const void* sbase, unsigned ldsaddr) { asm volatile("s_mov_b32 m0, %2\n\tglobal_load_lds_dwordx4 %0, %1" :: "v"(voff), "s"(sbase), "s"(ldsaddr) : "memory", "m0"); }
__device__ __forceinline__ void dma4(unsigned voff, const void* sbase, unsigned ldsaddr) { asm volatile("s_mov_b32 m0, %2\n\tglobal_load_lds_dword %0, %1" :: "v"(voff), "s"(sbase), "s"(ldsaddr) : "memory", "m0"); }
template <class Prob, class Sched, class Epi>
__device__ __forceinline__ void gemm_phase(LAS unsigned char* lds, const int tid, const Prob& P, const Sched& S, const Epi& E) {
    const int wid = __builtin_amdgcn_readfirstlane(tid >> 6), lane = tid & 63, wr = wid >> 2, wc = wid & 3, fr = lane & 15, fq = lane >> 4;
    const int lda = P.lda, ldb = P.ldb;
    unsigned voffB[2], offA[2][2];
#define PG8_TOKSLOT(name) const LAS int* name; { PG8_TID(tl2_); name = (const LAS int*)(lds + SIDE_TOK) + (tl2_ >> 6) * 256 + (tl2_ & 63); }
#define PG8_TID(v_) int v_; asm volatile("v_mbcnt_lo_u32_b32 %0, -1, 0\n\tv_mbcnt_hi_u32_b32 %0, -1, %0" : "=v"(v_)); v_ |= (wid << 6)
#define PG8_RC(R_, C_) int R_[2], C_[2]; { PG8_TID(tl_); _Pragma("unroll") for (int i_ = 0; i_ < 2; ++i_) stage_rc(tl_ * 16 + i_ * 8192, R_[i_], C_[i_]); }
#pragma unroll
    for (int i = 0; i < 2; ++i) { int R, C; stage_rc(tid * 16 + i * 8192, R, C); const int Rb = Epi::PERM ? ((R & ~31) + perm32(R & 31)) : R;
        voffB[i] = (unsigned)(Rb * ldb + C) * 2u;
        offA[0][i] = (unsigned)(R * lda + C) * 2u; offA[1][i] = (unsigned)((R + HALF) * lda + C) * 2u; }
    const size_t kstep = (size_t)(BK * 2);
    const size_t hstep = (size_t)HALF * ldb * 2;
    const unsigned ldsw = (unsigned)wid * 1024u;
    const int aoff = lds_byte(wr * 64 + fr, fq * 8), boff = lds_byte(wc * 32 + fr, fq * 8);
#define PG8_SA(b, h) (((b) * 2 + (h)) * HTB)
#define PG8_SB(b, h) ((4 + (b) * 2 + (h)) * HTB)
    const unsigned ldsb = (unsigned)(size_t)lds;
#define PG8_STAGE(bufoff, gbase, voff) do { _Pragma("unroll") for (int _i = 0; _i < 2; ++_i) \
        asm volatile("s_mov_b32 m0, %2\n\tglobal_load_lds_dwordx4 %0, %1" :: "v"((voff)[_i]), "s"((const char*)(gbase)), "s"(ldsb + (unsigned)(bufoff) + ldsw + (unsigned)(_i * 8192)) : "memory", "m0"); } while (0)
#define PG8_CAT(x0, x1) __builtin_shufflevector(x0, x1, 0, 1, 2, 3, 4, 5, 6, 7)
#define PG8_LDA(dst, b, h) do { if constexpr (Prob::FP8) { _Pragma("unroll") for (int m = 0; m < 4; ++m) dst##8[m] = PG8_CAT(*(const LAS i32x4*)(lds + PG8_SA(b, h) + aoff + m * 2048), *(const LAS i32x4*)(lds + PG8_SA(b, h) + aoff + m * 2048 + 1024)); } \
        else { _Pragma("unroll") for (int m = 0; m < 4; ++m) _Pragma("unroll") for (int k = 0; k < 2; ++k) dst[m][k] = *(const LAS bf16x8*)(lds + PG8_SA(b, h) + aoff + m * 2048 + k * 1024); } } while (0)
#define PG8_LDB(dst, b, h) do { if constexpr (Prob::FP8) { _Pragma("unroll") for (int n = 0; n < 2; ++n) dst##8[n] = PG8_CAT(*(const LAS i32x4*)(lds + PG8_SB(b, h) + boff + n * 2048), *(const LAS i32x4*)(lds + PG8_SB(b, h) + boff + n * 2048 + 1024)); } \
        else { _Pragma("unroll") for (int n = 0; n < 2; ++n) _Pragma("unroll") for (int k = 0; k < 2; ++k) dst[n][k] = *(const LAS bf16x8*)(lds + PG8_SB(b, h) + boff + n * 2048 + k * 1024); } } while (0)
#define PG8_MMA(ai, bj, At, Bt) do { __builtin_amdgcn_s_setprio(1); \
        if constexpr (Prob::FP8) { _Pragma("unroll") for (int m = 0; m < 4; ++m) _Pragma("unroll") for (int n = 0; n < 2; ++n) \
            acc[ai][bj][m][n] = __builtin_amdgcn_mfma_scale_f32_16x16x128_f8f6f4(Bt##8[n], At##8[m], acc[ai][bj][m][n], 0, 0, 0, sc8_, 0, sc8_); } \
        else { _Pragma("unroll") for (int m = 0; m < 4; ++m) _Pragma("unroll") for (int n = 0; n < 2; ++n) _Pragma("unroll") for (int k = 0; k < 2; ++k) \
            acc[ai][bj][m][n] = __builtin_amdgcn_mfma_f32_16x16x32_bf16(Bt[n][k], At[m][k], acc[ai][bj][m][n], 0, 0, 0); } \
        __builtin_amdgcn_s_setprio(0); } while (0)
#define PG8_WAIT_V(n) asm volatile("s_waitcnt vmcnt(" #n ")" ::: "memory")
#define PG8_WAIT_L(n) asm volatile("s_waitcnt lgkmcnt(" #n ")" ::: "memory")
#define PG8_BAR __builtin_amdgcn_s_barrier()
#define PG8_SCHED __builtin_amdgcn_sched_barrier(0)
    Unit cur, nxt; int ui = 0;
    if (!S.next(0, cur)) return;
    static_assert(Prob::SCALE_A == Prob::SCALE_B, "one scale register serves both operands");
    int sc8_; asm volatile("v_mov_b32 %0, %1" : "=v"(sc8_) : "n"(Prob::SCALE_A));
    f32x4 acc[2][2][4][2];
    float zero_; asm volatile("v_mov_b32 %0, 0" : "=v"(zero_));
#pragma unroll
    for (int a = 0; a < 2; ++a)
#pragma unroll
        for (int b = 0; b < 2; ++b)
#pragma unroll
            for (int m = 0; m < 4; ++m)
#pragma unroll
                for (int n = 0; n < 2; ++n) acc[a][b][m][n] = (f32x4){zero_, zero_, zero_, zero_};
    bf16x8 At[4][2], B0[2][2], B1[2][2]; i32x8 At8[4], B08[2], B18[2];
    const char* cA = P.a_base(cur); const char* cB = P.b_base(cur); int nt = P.nt(cur);
    if constexpr (Prob::GATHER) { PG8_RC(Rr, Cc); P.a_rows(cur, Rr, Cc, offA); }
    if constexpr (Epi::SIDE) { PG8_TID(tl4_); E.side(cur, ldsb + SIDE_SLOT, wid, tl4_ & 63); }
    PG8_STAGE(PG8_SB(0, 0), cB, voffB); PG8_STAGE(PG8_SB(0, 1), cB + hstep, voffB); PG8_STAGE(PG8_SA(0, 0), cA, offA[0]); PG8_STAGE(PG8_SA(0, 1), cA, offA[1]);
    if (wr == 1) PG8_BAR;
    PG8_WAIT_V(2); PG8_BAR;
    PG8_STAGE(PG8_SB(1, 0), cB + kstep, voffB); PG8_STAGE(PG8_SA(1, 0), cA + kstep, offA[0]); PG8_STAGE(PG8_SB(1, 1), cB + hstep + kstep, voffB);
    PG8_WAIT_V(6); PG8_BAR;
    for (;;) {
        const bool has_next = S.next(ui + 1, nxt);
        const char* nA = has_next ? P.a_base(nxt) : cA; const char* nB = has_next ? P.b_base(nxt) : cB;
        if constexpr (Prob::GATHER) { if (has_next) { PG8_RC(Rr, Cc); (void)Cc;
#pragma unroll
            for (int h = 0; h < 2; ++h)
#pragma unroll
                for (int i = 0; i < 2; ++i) dma4((unsigned)(nxt.pm * 256 + h * 128 + Rr[i]) * 4u, P.tok, ldsb + SIDE_TOK + (unsigned)wid * 1024u + (unsigned)((h * 2 + i) * 256)); } }
        if constexpr (Epi::SIDE) { if (has_next) { PG8_TID(tl4_); E.side(nxt, ldsb + SIDE_SLOT + (unsigned)(((ui + 1) % 3) * SIDE_SLOT_BYTES), wid, tl4_ & 63); } }
        for (int t = 0; t < nt; t += 2) {
            const bool last = (t == nt - 2);
            if constexpr (Epi::KHOOK) { if (t == Epi::HOOK_T0 || t == Epi::HOOK_T1) {
                asm volatile("" ::: "memory"); PG8_TID(tlh_); const int lnh_ = tlh_ & 63; E.hook(acc, cur, t == Epi::HOOK_T0 ? 0 : 1, wr, wc, lnh_ & 15, lnh_ >> 4); asm volatile("" ::: "memory"); } }
            const char* a1 = cA + (size_t)(t + 1) * kstep;
            const char* a2 = last ? nA : cA + (size_t)(t + 2) * kstep; const char* b2 = last ? nB : cB + (size_t)(t + 2) * kstep;
            const char* a3 = a2 + kstep; const char* b3 = b2 + kstep;
            PG8_LDB(B0, 0, 0); PG8_LDB(B1, 0, 1); PG8_SCHED; PG8_LDA(At, 0, 0); PG8_STAGE(PG8_SA(1, 1), a1, offA[1]);
            PG8_WAIT_V(8); PG8_WAIT_L(0); PG8_BAR; PG8_MMA(0, 0, At, B0); PG8_MMA(0, 1, At, B1); PG8_BAR; PG8_SCHED;
            if constexpr (Prob::GATHER) { if (last && has_next) { PG8_RC(Rr, Cc); (void)Rr; PG8_TOKSLOT(tokslot); const int ntok[2][2] = {{tokslot[0], tokslot[64]}, {tokslot[128], tokslot[192]}}; P.a_off(ntok, Cc, offA); } }
            PG8_LDA(At, 0, 1); PG8_STAGE(PG8_SB(0, 0), b2, voffB); PG8_STAGE(PG8_SB(0, 1), b2 + hstep, voffB); PG8_STAGE(PG8_SA(0, 0), a2, offA[0]);
            PG8_WAIT_V(8); PG8_WAIT_L(0); PG8_BAR; PG8_MMA(1, 0, At, B0); PG8_MMA(1, 1, At, B1); PG8_BAR; PG8_SCHED;
            PG8_LDB(B0, 1, 0); PG8_LDB(B1, 1, 1); PG8_SCHED; PG8_LDA(At, 1, 0); PG8_STAGE(PG8_SA(0, 1), a2, offA[1]);
            PG8_WAIT_V(8); PG8_WAIT_L(0); PG8_BAR; PG8_MMA(0, 0, At, B0); PG8_MMA(0, 1, At, B1); PG8_BAR; PG8_SCHED;
            PG8_LDA(At, 1, 1); PG8_STAGE(PG8_SB(1, 0), b3, voffB); PG8_STAGE(PG8_SB(1, 1), b3 + hstep, voffB); PG8_STAGE(PG8_SA(1, 0), a3, offA[0]);
            PG8_WAIT_V(8); PG8_WAIT_L(0); PG8_BAR; PG8_MMA(1, 0, At, B0); PG8_MMA(1, 1, At, B1); PG8_BAR; PG8_SCHED;
        }
        if (wr == 0) PG8_BAR;
        { PG8_TID(tl3_); const int ln_ = tl3_ & 63; E(acc, cur, wr, wc, ln_ & 15, ln_ >> 4, lds + SIDE_SLOT + (ui % 3) * SIDE_SLOT_BYTES); }
        if (!has_next) break;
        bool keep = false;
        if constexpr (Epi::CHAIN) keep = E.keep(cur);
        if (!keep) {
            asm volatile("v_mov_b32 %0, 0" : "=v"(zero_));
#pragma unroll
            for (int a = 0; a < 2; ++a)
#pragma unroll
                for (int b = 0; b < 2; ++b)
#pragma unroll
                    for (int m = 0; m < 4; ++m)
#pragma unroll
                        for (int n = 0; n < 2; ++n) acc[a][b][m][n] = (f32x4){zero_, zero_, zero_, zero_};
        }
        cur = nxt; cA = nA; cB = nB; nt = P.nt(cur); ++ui;
        if (wr == 1) PG8_BAR;
    }
    PG8_WAIT_V(0);
    PG8_BAR;
#undef PG8_RC
#undef PG8_TID
#undef PG8_TOKSLOT
#undef PG8_SA
#undef PG8_SB
#undef PG8_STAGE
#undef PG8_LDA
#undef PG8_LDB
#undef PG8_MMA
#undef PG8_CAT
#undef PG8_WAIT_V
#undef PG8_WAIT_L
#undef PG8_BAR
#undef PG8_SCHED
}
}

typedef const float* cfp_t;
typedef const cfp_t __attribute__((address_space(4))) * InTab;
struct Frame {
    LAS unsigned char* lds;
    volatile LAS unsigned* MISC;
    unsigned char* ws;
    InTab in;
    float* out;
    int tid, lane, wave, G, bid;
};
enum { IN_X = 0, IN_C, IN_CTX, IN_CCTX, IN_WADA, IN_BADA, IN_WIN, IN_BIN, IN_POOLW, IN_POOLS, IN_CONVW, IN_CONVB, IN_MNG, IN_SLNG, IN_SLNB, IN_SGUW, IN_SGUB,
       IN_WBP, IN_WBM, IN_WBS, IN_WOUT, IN_LN1G, IN_LN1B, IN_WR, IN_BR, IN_WGU, IN_BGU, IN_WDN, IN_BDN, IN_LN2G, IN_LN2B };
__device__ __forceinline__ int mod_row(int row) { return row < ML ? (row >> 12) : NB; }
__device__ __forceinline__ const float* modp(const Frame& F, int l, int row, int part) { return (const float*)(F.ws + WS_MOD) + ((size_t)(l * 17 + mod_row(row)) * 6 + part) * 1024; }

__device__ __forceinline__ void transpose_item(const float* W, size_t ldw, int k0, int srccol0, bf16_t* dst, size_t ldk, int kd0, LAS float* scr, int lane) {
#pragma unroll 8
    for (int i = 0; i < 32; ++i) { const int kk = 2 * i + (lane >> 5); scr[kk * 33 + (lane & 31)] = __builtin_nontemporal_load(W + (size_t)(k0 + kk) * ldw + srccol0 + (lane & 31)); }
    LDS_WAIT(); asm volatile("" ::: "memory");
    const int c = lane & 7;
#pragma unroll
    for (int j = 0; j < 4; ++j) { const int n = (lane >> 3) + 8 * j; const LAS float* s = scr + (8 * c) * 33 + n;
        u32x4 o; o.x = pk2(s[0 * 33], s[1 * 33]); o.y = pk2(s[2 * 33], s[3 * 33]); o.z = pk2(s[4 * 33], s[5 * 33]); o.w = pk2(s[6 * 33], s[7 * 33]);
        *(u32x4*)(dst + (size_t)n * ldk + kd0 + 8 * c) = o; }
    LDS_WAIT(); asm volatile("" ::: "memory");
}
__device__ __forceinline__ void transpose_item_fp8(const float* W, size_t ldw, int k0, int srccol0, unsigned char* dst, size_t ldk, int kd0, float sc, LAS float* scr, int lane) {
#pragma unroll 8
    for (int i = 0; i < 32; ++i) { const int kk = 2 * i + (lane >> 5); scr[kk * 33 + (lane & 31)] = __builtin_nontemporal_load(W + (size_t)(k0 + kk) * ldw + srccol0 + (lane & 31)); }
    LDS_WAIT(); asm volatile("" ::: "memory");
    const int c = lane & 7;
#pragma unroll
    for (int j = 0; j < 4; ++j) { const int n = (lane >> 3) + 8 * j; const LAS float* s_ = scr + (8 * c) * 33 + n;
        u32x2 o; o.x = pk4_fp8(s_[0 * 33] * sc, s_[1 * 33] * sc, s_[2 * 33] * sc, s_[3 * 33] * sc); o.y = pk4_fp8(s_[4 * 33] * sc, s_[5 * 33] * sc, s_[6 * 33] * sc, s_[7 * 33] * sc);
        *(u32x2*)(dst + (size_t)n * ldk + kd0 + 8 * c) = o; }
    LDS_WAIT(); asm volatile("" ::: "memory");
}
__device__ __forceinline__ void phase_prologue(Frame& F) {
    LAS float* scr = (LAS float*)(F.lds + F.wave * 16384);
    const int gw = F.bid * NWAVES + F.wave, NGW = F.G * NWAVES;
    constexpr int I_IN = 16 * (NZ / 32);
    constexpr int I_BR = (4 + 8 + 4) * 32;
    constexpr int I_OUT = 16 * 32;
    constexpr int I_GU = 16 * 64;
    constexpr int I_DN = 16 * 32;
    constexpr int T_IN = DEPTH * I_IN, T_BR = DEPTH * I_BR, T_OUT = DEPTH * I_OUT, T_GU = DEPTH * NEXP * I_GU, T_DN = DEPTH * NEXP * I_DN;
    constexpr int NITEMS = T_IN + T_BR + T_OUT + T_GU + T_DN;
    for (int it = gw; it < NITEMS; it += NGW) {
        int r = it;
        if (r < T_IN) { const int l = r / I_IN; r %= I_IN; const int kb = r / (NZ / 32), nb = r % (NZ / 32); const int n0 = nb * 32, src = n0 < 2304 ? n0 : n0 + 16;
            if (n0 < NZ_BF) transpose_item(F.in[IN_WIN] + (size_t)l * D * 5904, 5904, kb * 64, src, (bf16_t*)(F.ws + WS_WIN) + ((size_t)l * NZ + n0) * D, D, kb * 64, scr, F.lane);
            else transpose_item_fp8(F.in[IN_WIN] + (size_t)l * D * 5904, 5904, kb * 64, src, (unsigned char*)(F.ws + WS_WIN8) + ((size_t)l * NZ_F8 + (n0 - NZ_BF)) * D, D, kb * 64, F8S_WGU, scr, F.lane);
            continue; }
        r -= T_IN;
        if (r < T_BR) { const int l = r / I_BR; r %= I_BR; const int kb = r / 32, nb = r % 32;
            const float* W; int ksrc;
            if (kb < 4) { W = F.in[IN_WBP] + (size_t)l * 256 * D; ksrc = kb * 64; } else if (kb < 12) { W = F.in[IN_WBM] + (size_t)l * 512 * D; ksrc = (kb - 4) * 64; } else { W = F.in[IN_WBS] + (size_t)l * 256 * D; ksrc = (kb - 12) * 64; }
            transpose_item(W, D, ksrc, nb * 32, (bf16_t*)(F.ws + WS_WBR) + ((size_t)l * D + nb * 32) * D, D, kb * 64, scr, F.lane); continue; }
        r -= T_BR;
        if (r < T_OUT) { const int l = r / I_OUT; r %= I_OUT; const int kb = r / 32, nb = r % 32;
            transpose_item(F.in[IN_WOUT] + (size_t)l * D * D, D, kb * 64, nb * 32, (bf16_t*)(F.ws + WS_WOUT) + ((size_t)l * D + nb * 32) * D, D, kb * 64, scr, F.lane); continue; }
        r -= T_OUT;
        if (r < T_GU) { const int le = r / I_GU; r %= I_GU; const int kb = r / 64, nb = r % 64; const int n0 = nb * 32;
            const int pn = n0 >> 8, c = n0 & 255; const int src = c < 128 ? (128 * pn + c) : (1024 + 128 * pn + c - 128);
            transpose_item_fp8(F.in[IN_WGU] + (size_t)le * D * 2048, 2048, kb * 64, src, (unsigned char*)(F.ws + WS_WGU) + ((size_t)le * 2048 + n0) * D, D, kb * 64, F8S_WGU, scr, F.lane); continue; }
        r -= T_GU;
        { const int le = r / I_DN; r %= I_DN; const int kb = r / 32, nb = r % 32;
            transpose_item_fp8(F.in[IN_WDN] + (size_t)le * D * D, D, kb * 64, nb * 32, (unsigned char*)(F.ws + WS_WDN) + ((size_t)le * D + nb * 32) * D, D, kb * 64, F8S_WDN, scr, F.lane); }
    }
    { const int gt = F.bid * NTHREADS + F.tid, NGT = F.G * NTHREADS;
      for (int i = gt; i < DEPTH * 16 * 1024; i += NGT) { const int l = i >> 14, g = (i >> 10) & 15, k = i & 1023; ((float*)(F.ws + WS_WG))[i] = F.in[IN_WIN][((size_t)l * D + k) * 5904 + 2304 + g]; }
      for (int i = gt; i < DEPTH * 4 * 128 * 128; i += NGT) ((bf16_t*)(F.ws + WS_WSGU))[i] = (bf16_t)f2bf(F.in[IN_SGUW][i]);
      for (int i = gt; i < DEPTH * 4 * 64 * 64; i += NGT) { const int lg = i >> 12, d = (i >> 6) & 63, c = i & 63; ((bf16_t*)(F.ws + WS_WPOOL))[i] = (bf16_t)f2bf(F.in[IN_POOLW][(size_t)lg * 4096 + c * 64 + d]); } }
    __syncthreads();
    { LAS float* sc = (LAS float*)F.lds;
      LAS float* part = (LAS float*)(F.lds + 71680);
      for (int i = F.tid; i < 17 * 1024; i += NTHREADS) { const int r = i >> 10, k = i & 1023; const float v = r < 16 ? F.in[IN_C][r * 1024 + k] : F.in[IN_CCTX][k]; sc[i] = siluf_(v); }
      __syncthreads();
      for (int u = F.bid; u < DEPTH * 48; u += F.G) {
          const int l = u / 48, n0 = (u % 48) * 128, col = F.tid & 127, ks = F.tid >> 7;
          float a[17];
#pragma unroll
          for (int r = 0; r < 17; ++r) a[r] = 0.f;
          const float* W = F.in[IN_WADA] + (size_t)l * D * 6144 + n0 + col;
          for (int k = ks * 256; k < ks * 256 + 256; ++k) { const float w = W[(size_t)k * 6144];
#pragma unroll
              for (int r = 0; r < 17; ++r) a[r] += sc[r * 1024 + k] * w; }
#pragma unroll
          for (int r = 0; r < 17; ++r) part[(ks * 17 + r) * 128 + col] = a[r];
          __syncthreads();
          for (int i = F.tid; i < 17 * 128; i += NTHREADS) { const int r = i >> 7, cc = i & 127;
              const float s = part[(0 * 17 + r) * 128 + cc] + part[(1 * 17 + r) * 128 + cc] + part[(2 * 17 + r) * 128 + cc] + part[(3 * 17 + r) * 128 + cc] + F.in[IN_BADA][l * 6144 + n0 + cc];
              ((float*)(F.ws + WS_MOD))[(size_t)(l * 17 + r) * 6144 + n0 + cc] = s; }
          __syncthreads();
      } }
}

struct RowV { f32x4 v[4]; };
#define RC(lane, j) (8 * (lane) + 512 * ((j) >> 1) + 4 * ((j) & 1))
__device__ __forceinline__ void row_load(RowV& r, const float* p, int lane) {
#pragma unroll
    for (int j = 0; j < 4; ++j) r.v[j] = __builtin_nontemporal_load((const f32x4*)(p + RC(lane, j)));
}
__device__ __forceinline__ void row_load_bf16(RowV& r, const bf16_t* p, int lane) {
#pragma unroll
    for (int h = 0; h < 2; ++h) { const u32x4 w = __builtin_nontemporal_load((const u32x4*)(p + 8 * lane + 512 * h)); r.v[2 * h] = (f32x4){bflo(w.x), bfhi(w.x), bflo(w.y), bfhi(w.y)}; r.v[2 * h + 1] = (f32x4){bflo(w.z), bfhi(w.z), bflo(w.w), bfhi(w.w)}; }
}
__device__ __forceinline__ void row_store(const RowV& r, float* p, int lane) {
#pragma unroll
    for (int j = 0; j < 4; ++j) *(f32x4*)(p + RC(lane, j)) = r.v[j];
}
__device__ __forceinline__ void row_store_nt(const RowV& r, float* p, int lane) {
#pragma unroll
    for (int j = 0; j < 4; ++j) __builtin_nontemporal_store(r.v[j], (f32x4*)(p + RC(lane, j)));
}
__device__ __forceinline__ void row_store_bf16_nt(const RowV& r, bf16_t* p, int lane) {
#pragma unroll
    for (int h = 0; h < 2; ++h) { u32x4 w; w.x = pk2(r.v[2 * h].x, r.v[2 * h].y); w.y = pk2(r.v[2 * h].z, r.v[2 * h].w); w.z = pk2(r.v[2 * h + 1].x, r.v[2 * h + 1].y); w.w = pk2(r.v[2 * h + 1].z, r.v[2 * h + 1].w); __builtin_nontemporal_store(w, (u32x4*)(p + 8 * lane + 512 * h)); }
}
__device__ __forceinline__ void row_store_bf16(const RowV& r, bf16_t* p, int lane) {
#pragma unroll
    for (int h = 0; h < 2; ++h) { u32x4 w; w.x = pk2(r.v[2 * h].x, r.v[2 * h].y); w.y = pk2(r.v[2 * h].z, r.v[2 * h].w); w.z = pk2(r.v[2 * h + 1].x, r.v[2 * h + 1].y); w.w = pk2(r.v[2 * h + 1].z, r.v[2 * h + 1].w); *(u32x4*)(p + 8 * lane + 512 * h) = w; }
}
__device__ __forceinline__ void row_ln_plain(RowV& r, int lane) {
    float s = 0.f;
#pragma unroll
    for (int j = 0; j < 4; ++j) s += (r.v[j].x + r.v[j].y) + (r.v[j].z + r.v[j].w);
    const float mean = wave_sum(s, lane) * (1.f / D); float s2 = 0.f;
#pragma unroll
    for (int j = 0; j < 4; ++j) { r.v[j] = r.v[j] - mean; s2 += (r.v[j].x * r.v[j].x + r.v[j].y * r.v[j].y) + (r.v[j].z * r.v[j].z + r.v[j].w * r.v[j].w); }
    const float rstd = 1.f / sqrtf(wave_sum(s2, lane) * (1.f / D) + LN_EPS);
#pragma unroll
    for (int j = 0; j < 4; ++j) r.v[j] = r.v[j] * rstd;
}
__device__ __forceinline__ void row_affine(RowV& r, const float* g, const float* b, int lane) {
#pragma unroll
    for (int j = 0; j < 4; ++j) { const f32x4 gg = *(const f32x4*)(g + RC(lane, j)), bb = *(const f32x4*)(b + RC(lane, j)); r.v[j] = r.v[j] * gg + bb; }
}
__device__ __forceinline__ void row_modulate(RowV& r, const float* sh, const float* sc, int lane) {
#pragma unroll
    for (int j = 0; j < 4; ++j) { const f32x4 s1 = *(const f32x4*)(sc + RC(lane, j)), s0 = *(const f32x4*)(sh + RC(lane, j)); r.v[j] = r.v[j] * (s1 + 1.0f) + s0; }
}
__device__ __forceinline__ LAS float* pv_slot(const Frame& F, int slot) { return (LAS float*)(F.lds + NW_PV) + slot * 1024; }
__device__ __forceinline__ void pv_fill(Frame& F, int slot, const float* src) { LAS f32x4* d = (LAS f32x4*)pv_slot(F, slot); for (int i = F.tid; i < 256; i += NTHREADS) d[i] = *(const f32x4*)(src + 4 * i); }
__device__ __forceinline__ void row_affine_l(RowV& r, const LAS float* g, const LAS float* b, int lane) {
#pragma unroll
    for (int j = 0; j < 4; ++j) { const f32x4 gg = *(const LAS f32x4*)(g + RC(lane, j)), bb = *(const LAS f32x4*)(b + RC(lane, j)); r.v[j] = r.v[j] * gg + bb; }
}
__device__ __forceinline__ void row_modulate_l(RowV& r, const LAS float* sh, const LAS float* sc, int lane) {
#pragma unroll
    for (int j = 0; j < 4; ++j) { const f32x4 s1 = *(const LAS f32x4*)(sc + RC(lane, j)), s0 = *(const LAS f32x4*)(sh + RC(lane, j)); r.v[j] = r.v[j] * (s1 + 1.0f) + s0; }
}
__device__ __forceinline__ void ln0_row(Frame& F, int row, RowV xr, const LAS float* sh, const LAS float* sc) {
    row_ln_plain(xr, F.lane);
    row_modulate_l(xr, sh, sc, F.lane);
    row_store_bf16(xr, (bf16_t*)(F.ws + WS_H) + (size_t)row * D, F.lane);
    { unsigned char* h8 = (unsigned char*)(F.ws + WS_H8) + (size_t)row * D + 8 * F.lane;
#pragma unroll
      for (int h = 0; h < 2; ++h) { u32x2 w; w.x = pk4_fp8(xr.v[2 * h].x * F8S_ACT, xr.v[2 * h].y * F8S_ACT, xr.v[2 * h].z * F8S_ACT, xr.v[2 * h].w * F8S_ACT); w.y = pk4_fp8(xr.v[2 * h + 1].x * F8S_ACT, xr.v[2 * h + 1].y * F8S_ACT, xr.v[2 * h + 1].z * F8S_ACT, xr.v[2 * h + 1].w * F8S_ACT); *(u32x2*)(h8 + 512 * h) = w; } }
}
__device__ __forceinline__ LAS float* narrow_tile_wave(Frame& F, const bf16_t* A) {
    const int r = F.lane & 31, h = F.lane >> 5;
    f32x16 acc;
#pragma unroll
    for (int i = 0; i < 16; ++i) acc[i] = 0.f;
    const bf16_t* ap = A + (size_t)r * D + 8 * h;
    const LAS unsigned char* bp = F.lds + NW_WT + r * 2064 + 16 * h;
    bf16x8 av[2][16];
#pragma unroll
    for (int ks = 0; ks < 16; ++ks) av[0][ks] = *(const bf16x8*)(ap + ks * 16);
#pragma unroll
    for (int kb = 0; kb < 4; ++kb) {
        if (kb < 3) {
#pragma unroll
            for (int ks = 0; ks < 16; ++ks) av[(kb + 1) & 1][ks] = *(const bf16x8*)(ap + ((kb + 1) * 16 + ks) * 16); }
        __builtin_amdgcn_sched_barrier(0);
#pragma unroll
        for (int ks = 0; ks < 16; ++ks) { const bf16x8 b = *(const LAS bf16x8*)(bp + (kb * 16 + ks) * 32); acc = __builtin_amdgcn_mfma_f32_32x32x16_bf16(av[kb & 1][ks], b, acc, 0, 0, 0); }
        __builtin_amdgcn_sched_barrier(0);
    }
    LAS float* lg = (LAS float*)(F.lds + NW_LG) + F.wave * 1056;
#pragma unroll
    for (int i = 0; i < 16; ++i) lg[((i & 3) + 8 * (i >> 2) + 4 * h) * 33 + r] = acc[i];
    asm volatile("s_waitcnt lgkmcnt(0)" ::: "memory");
    return lg;
}
__device__ __forceinline__ void tile_range(const Frame& F, int mrows, int& t_lo, int& t_hi) { const int nt = mrows / 32; t_lo = (int)(((long)F.bid * nt) / F.G); t_hi = (int)(((long)(F.bid + 1) * nt) / F.G); }
__device__ __forceinline__ void load_wg_lds(Frame& F, int l) {
    const float* src = (const float*)(F.ws + WS_WG) + (size_t)l * 16384;
    for (int i = F.tid; i < 32 * 128; i += NTHREADS) { const int g = i >> 7, c8 = i & 127; u32x4 w = (u32x4){0u, 0u, 0u, 0u};
        if (g < 16) { const f32x4 a = *(const f32x4*)(src + g * 1024 + c8 * 8), b = *(const f32x4*)(src + g * 1024 + c8 * 8 + 4); w.x = pk2(a.x, a.y); w.y = pk2(a.z, a.w); w.z = pk2(b.x, b.y); w.w = pk2(b.z, b.w); }
        *(LAS u32x4*)(F.lds + NW_WT + g * 2064 + c8 * 16) = w; }
    __syncthreads();
}
__device__ __forceinline__ void gates_tail(Frame& F, int l, int t_lo, int t_hi) {
    asm volatile("s_waitcnt vmcnt(0)" ::: "memory"); __syncthreads();
    const int g = F.lane & 15; const float bias = F.in[IN_BIN][l * 5904 + 2304 + g];
    for (int tile = t_lo + F.wave; tile < t_hi; tile += NWAVES) {
        const LAS float* lg = narrow_tile_wave(F, (const bf16_t*)(F.ws + WS_H) + (size_t)tile * 32 * D);
#pragma unroll
        for (int rr = 0; rr < 8; ++rr) { const int row = rr * 4 + (F.lane >> 4); ((float*)(F.ws + WS_ZG))[(size_t)(tile * 32 + row) * 16 + g] = lg[row * 33 + g] + bias; }
        asm volatile("s_waitcnt lgkmcnt(0)" ::: "memory");
    }
}

using pg8::Unit;
struct ProbPlain {
    static constexpr bool GATHER = false, FP8 = false; static constexpr int SCALE_A = 127, SCALE_B = 127; const bf16_t* A; const bf16_t* Bt; int lda, ldb;
    __device__ __forceinline__ int nt(const Unit&) const { return lda / 64; }
    __device__ __forceinline__ const char* a_base(const Unit& u) const { return (const char*)A + (size_t)u.pm * 256 * lda * 2; }
    __device__ __forceinline__ const char* b_base(const Unit& u) const { return (const char*)Bt + (size_t)u.pn * 256 * ldb * 2; }
    __device__ __forceinline__ void a_tok(const Unit&, const int (&)[2], int (&)[2][2]) const {}
    __device__ __forceinline__ void a_off(const int (&)[2][2], const int (&)[2], unsigned (&)[2][2]) const {}
    __device__ __forceinline__ void a_rows(const Unit&, const int (&)[2], const int (&)[2], unsigned (&)[2][2]) const {}
};
struct ProbPlainF8 {
    static constexpr bool GATHER = false, FP8 = true; static constexpr int SCALE_A = F8E_ACT, SCALE_B = F8E_WGU; const bf16_t* A; const bf16_t* Bt; int lda, ldb;
    __device__ __forceinline__ int nt(const Unit&) const { return lda / 64; }
    __device__ __forceinline__ const char* a_base(const Unit& u) const { return (const char*)A + (size_t)u.pm * 256 * lda * 2; }
    __device__ __forceinline__ const char* b_base(const Unit& u) const { return (const char*)Bt + (size_t)u.pn * 256 * ldb * 2; }
    __device__ __forceinline__ void a_tok(const Unit&, const int (&)[2], int (&)[2][2]) const {}
    __device__ __forceinline__ void a_off(const int (&)[2][2], const int (&)[2], unsigned (&)[2][2]) const {}
    __device__ __forceinline__ void a_rows(const Unit&, const int (&)[2], const int (&)[2], unsigned (&)[2][2]) const {}
};
struct ProbBranch {
    static constexpr bool GATHER = false, FP8 = false; static constexpr int SCALE_A = 127, SCALE_B = 127; const bf16_t* A; const bf16_t* Bt; int lda, ldb;
    __device__ __forceinline__ int nt(const Unit& u) const { return u.sub == 1 ? 8 : 4; }
    __device__ __forceinline__ int koff(const Unit& u) const { return u.sub == 0 ? 0 : (u.sub == 1 ? 256 : 768); }
    __device__ __forceinline__ const char* a_base(const Unit& u) const { return (const char*)A + ((size_t)u.pm * 256 * lda + koff(u)) * 2; }
    __device__ __forceinline__ const char* b_base(const Unit& u) const { return (const char*)Bt + ((size_t)u.pn * 256 * ldb + koff(u)) * 2; }
    __device__ __forceinline__ void a_tok(const Unit&, const int (&)[2], int (&)[2][2]) const {}
    __device__ __forceinline__ void a_off(const int (&)[2][2], const int (&)[2], unsigned (&)[2][2]) const {}
    __device__ __forceinline__ void a_rows(const Unit&, const int (&)[2], const int (&)[2], unsigned (&)[2][2]) const {}
};
__device__ __forceinline__ int expert_of(const LAS int* seg, int pm) { return __builtin_amdgcn_readfirstlane((int)((const LAS unsigned char*)(seg + 64))[pm]); }
__device__ __forceinline__ int moe_tables(Frame& F, LAS int* seg) {
    __syncthreads();
    if (F.tid <= NEXP) seg[F.tid] = ((const int*)(F.ws + WS_ROUTE + RT_SEG))[F.tid];
    __syncthreads();
    const int ntile = seg[NEXP] / 256;
    LAS unsigned char* texp = (LAS unsigned char*)(seg + 64);
    for (int t = F.tid; t < ntile; t += NTHREADS) { const int row = t * 256; int e = 0;
#pragma unroll
        for (int i = 1; i < NEXP; ++i) e += (seg[i] <= row) ? 1 : 0;
        texp[t] = (unsigned char)e; }
    __syncthreads();
    return ntile;
}
struct ProbMoe1 {
    static constexpr bool GATHER = true, FP8 = true; static constexpr int SCALE_A = F8E_ACT, SCALE_B = F8E_WGU; const bf16_t* A; const bf16_t* Bt; int lda, ldb; const int* tok; const LAS int* seg;
    __device__ __forceinline__ int nt(const Unit&) const { return lda / 64; }
    __device__ __forceinline__ const char* a_base(const Unit&) const { return (const char*)A; }
    __device__ __forceinline__ const char* b_base(const Unit& u) const { const int e = expert_of(seg, u.pm); return (const char*)Bt + ((size_t)e * 2048 + (size_t)u.pn * 256) * ldb * 2; }
    __device__ __forceinline__ void a_rows(const Unit& u, const int (&R)[2], const int (&C)[2], unsigned (&off)[2][2]) const {
#pragma unroll
        for (int h = 0; h < 2; ++h)
#pragma unroll
            for (int i = 0; i < 2; ++i) { const int t = tok[u.pm * 256 + h * 128 + R[i]]; off[h][i] = (unsigned)(t * lda + C[i]) * 2u; } }
    __device__ __forceinline__ void a_tok(const Unit& u, const int (&R)[2], int (&tk)[2][2]) const {
#pragma unroll
        for (int h = 0; h < 2; ++h)
#pragma unroll
            for (int i = 0; i < 2; ++i) tk[h][i] = tok[u.pm * 256 + h * 128 + R[i]]; }
    __device__ __forceinline__ void a_off(const int (&tk)[2][2], const int (&C)[2], unsigned (&off)[2][2]) const {
#pragma unroll
        for (int h = 0; h < 2; ++h)
#pragma unroll
            for (int i = 0; i < 2; ++i) off[h][i] = (unsigned)(tk[h][i] * lda + C[i]) * 2u; }
};
struct ProbMoe2 {
    static constexpr bool GATHER = false, FP8 = true; static constexpr int SCALE_A = F8E_ACT, SCALE_B = F8E_WDN; const bf16_t* A; const bf16_t* Bt; int lda, ldb; const LAS int* seg;
    __device__ __forceinline__ int nt(const Unit&) const { return lda / 64; }
    __device__ __forceinline__ const char* a_base(const Unit& u) const { return (const char*)A + (size_t)u.pm * 256 * lda * 2; }
    __device__ __forceinline__ const char* b_base(const Unit& u) const { const int e = expert_of(seg, u.pm); return (const char*)Bt + ((size_t)e * 1024 + (size_t)u.pn * 256) * ldb * 2; }
    __device__ __forceinline__ void a_tok(const Unit&, const int (&)[2], int (&)[2][2]) const {}
    __device__ __forceinline__ void a_off(const int (&)[2][2], const int (&)[2], unsigned (&)[2][2]) const {}
    __device__ __forceinline__ void a_rows(const Unit&, const int (&)[2], const int (&)[2], unsigned (&)[2][2]) const {}
};
using pg8::cvt_pk_bf16;
template <bool G8> struct EpiInproj {
    static constexpr bool PERM = true, CHAIN = false, SIDE = true, KHOOK = false; bf16_t* Z; const float* bias; int pn0;
    __device__ __forceinline__ void side(const Unit& u0, unsigned slot, int wid, int lane) const { const int pn = u0.pn + pn0; if (wid == 1) pg8::dma16((unsigned)lane * 16u, bias + pn * 256 + (pn >= 9 ? 16 : 0), slot); }
    __device__ __forceinline__ void operator()(const f32x4 (&acc)[2][2][4][2], const Unit& u0, int wr, int wc, int fr, int fq, const LAS unsigned char* sd) const {
        Unit u = u0; u.pn += pn0;
        int row0 = u.pm * 256 + wr * 64 + fr, col0 = u.pn * 256 + wc * 32 + 8 * fq; asm volatile("" : "+v"(row0), "+v"(col0));
        const int act = (u.pn <= 6) ? 0 : ((u.pn == 9 || u.pn == 10) ? 2 : 1);
        f32x4 bv[2][2];
#pragma unroll
        for (int bj = 0; bj < 2; ++bj)
#pragma unroll
            for (int n = 0; n < 2; ++n) bv[bj][n] = *(const LAS f32x4*)(sd + (bj * 128 + wc * 32 + 8 * fq + 4 * n) * 4);
#pragma unroll
        for (int ai = 0; ai < 2; ++ai)
#pragma unroll
            for (int m = 0; m < 4; ++m) { bf16_t* rowp = Z + (size_t)(row0 + ai * 128 + m * 16) * NZ + col0;
#pragma unroll
                for (int bj = 0; bj < 2; ++bj) { f32x4 v0 = acc[ai][bj][m][0] + bv[bj][0], v1 = acc[ai][bj][m][1] + bv[bj][1];
                    if (G8 && u.pn >= ZG_COL / 256) { u32x2 w8;
                        v0 = sigmoid4(v0) * G8_SCALE; v1 = sigmoid4(v1) * G8_SCALE;
#pragma unroll
                        for (int j = 0; j < 4; ++j) { v0[j] = fmaxf(v0[j], 1.0f); v1[j] = fmaxf(v1[j], 1.0f); }
                        v0 = v0 + 12582912.0f; v1 = v1 + 12582912.0f;
                        w8.x = pk4_u8(v0[0], v0[1], v0[2], v0[3]); w8.y = pk4_u8(v1[0], v1[1], v1[2], v1[3]);
                        *(u32x2*)((unsigned char*)(Z + (size_t)(row0 + ai * 128 + m * 16) * NZ + ZG_COL) + (col0 - ZG_COL) + bj * 128) = w8; continue; }
                    if (act == 2) { f32x2 a = pg8::gelu_pk((f32x2){v0[0], v0[1]}), b = pg8::gelu_pk((f32x2){v0[2], v0[3]}), c = pg8::gelu_pk((f32x2){v1[0], v1[1]}), d = pg8::gelu_pk((f32x2){v1[2], v1[3]});
                        v0 = (f32x4){a.x, a.y, b.x, b.y}; v1 = (f32x4){c.x, c.y, d.x, d.y}; }
                    if (act == 1) { v0 = sigmoid4(v0); v1 = sigmoid4(v1); }
                    u32x4 w; w.x = cvt_pk_bf16(v0[0], v0[1]); w.y = cvt_pk_bf16(v0[2], v0[3]); w.z = cvt_pk_bf16(v1[0], v1[1]); w.w = cvt_pk_bf16(v1[2], v1[3]);
                    *(u32x4*)(rowp + bj * 128) = w; }
                if constexpr (G8) asm volatile("" ::: "memory"); }
    }
};
struct EpiNull {
    static constexpr bool PERM = true, CHAIN = false; bf16_t* Z;
    __device__ __forceinline__ void operator()(const f32x4 (&acc)[2][2][4][2], const Unit& u, int wr, int wc, int fr, int fq) const {
        float sacc = 0.f;
#pragma unroll
        for (int ai = 0; ai < 2; ++ai)
#pragma unroll
            for (int bj = 0; bj < 2; ++bj)
#pragma unroll
                for (int m = 0; m < 4; ++m)
#pragma unroll
                    for (int n = 0; n < 2; ++n) sacc += (acc[ai][bj][m][n][0] + acc[ai][bj][m][n][1]) + (acc[ai][bj][m][n][2] + acc[ai][bj][m][n][3]);
        if (sacc == 1.2345e30f) Z[u.pm + wr + wc + fr + fq] = 0;
    }
};
struct EpiOut {
    static constexpr bool PERM = true, CHAIN = false, SIDE = false, KHOOK = false; bf16_t* T;
    __device__ __forceinline__ void operator()(const f32x4 (&acc)[2][2][4][2], const Unit& u, int wr, int wc, int fr, int fq, const LAS unsigned char*) const {
        int row0 = u.pm * 256 + wr * 64 + fr, col0 = u.pn * 256 + wc * 32 + 8 * fq; asm volatile("" : "+v"(row0), "+v"(col0));
#pragma unroll
        for (int ai = 0; ai < 2; ++ai)
#pragma unroll
            for (int m = 0; m < 4; ++m) { bf16_t* rowp = T + (size_t)(row0 + ai * 128 + m * 16) * D + col0;
#pragma unroll
                for (int bj = 0; bj < 2; ++bj) { const f32x4 v0 = acc[ai][bj][m][0], v1 = acc[ai][bj][m][1];
                    u32x4 w; w.x = cvt_pk_bf16(v0[0], v0[1]); w.y = cvt_pk_bf16(v0[2], v0[3]); w.z = cvt_pk_bf16(v1[0], v1[1]); w.w = cvt_pk_bf16(v1[2], v1[3]);
                    *(u32x4*)(rowp + bj * 128) = w; } }
    }
};
struct EpiBranch {
    static constexpr bool PERM = true, CHAIN = false, SIDE = false, KHOOK = true; static constexpr int HOOK_T0 = 4, HOOK_T1 = 12;
    const bf16_t* Z; bf16_t* Y;
    template <bool FIN> __device__ __forceinline__ void apply(f32x4 (&acc)[2][2][4][2], const Unit& u, int br, int wr, int wc, int fr, int fq) const {
        int row0 = u.pm * 256 + wr * 64 + fr, col0 = u.pn * 256 + wc * 32 + 8 * fq;
        asm volatile("" : "+v"(row0), "+v"(col0));
#pragma unroll
        for (int ai = 0; ai < 2; ++ai) {
            u32x2 ga[4][2], gb[4][2];
#pragma unroll
            for (int m = 0; m < 4; ++m) { const unsigned char* rowp = (const unsigned char*)(Z + (size_t)(row0 + ai * 128 + m * 16) * NZ + ZG_COL) + br * 1024 + col0;
#pragma unroll
                for (int bj = 0; bj < 2; ++bj) { ga[m][bj] = *(const u32x2*)(rowp + bj * 128); if (!FIN) gb[m][bj] = *(const u32x2*)(rowp + 1024 + bj * 128); } }
#pragma unroll
            for (int m = 0; m < 4; ++m) { const size_t row = (size_t)(row0 + ai * 128 + m * 16);
#pragma unroll
                for (int bj = 0; bj < 2; ++bj) { const u32x2 a = ga[m][bj];
                    f32x4 r0 = u8x4_f32(a.x), r1 = u8x4_f32(a.y);
                    if (FIN) { r0 = r0 * (1.0f / G8_SCALE); r1 = r1 * (1.0f / G8_SCALE); }
                    else { const u32x2 b = gb[m][bj]; f32x4 q0 = u8x4_f32(b.x), q1 = u8x4_f32(b.y);
#pragma unroll
                        for (int i = 0; i < 4; ++i) { q0[i] = __builtin_amdgcn_rcpf(q0[i]); q1[i] = __builtin_amdgcn_rcpf(q1[i]); }
                        r0 = r0 * q0; r1 = r1 * q1; }
                    acc[ai][bj][m][0] = acc[ai][bj][m][0] * r0; acc[ai][bj][m][1] = acc[ai][bj][m][1] * r1;
                    if (FIN) { const f32x4 v0 = acc[ai][bj][m][0], v1 = acc[ai][bj][m][1];
                        u32x4 w; w.x = cvt_pk_bf16(v0[0], v0[1]); w.y = cvt_pk_bf16(v0[2], v0[3]); w.z = cvt_pk_bf16(v1[0], v1[1]); w.w = cvt_pk_bf16(v1[2], v1[3]);
                        *(u32x4*)(Y + row * D + col0 + bj * 128) = w; } } }
            asm volatile("" ::: "memory"); }
    }
    __device__ __forceinline__ void hook(f32x4 (&acc)[2][2][4][2], const Unit& u, int br, int wr, int wc, int fr, int fq) const { apply<false>(acc, u, br, wr, wc, fr, fq); }
    __device__ __forceinline__ void operator()(f32x4 (&acc)[2][2][4][2], const Unit& u, int wr, int wc, int fr, int fq, const LAS unsigned char*) const { apply<true>(acc, u, 2, wr, wc, fr, fq); }
};
struct EpiSwiglu {
    static constexpr bool PERM = true, CHAIN = false, SIDE = true, KHOOK = false; unsigned char* HID; const float* bgu; const LAS int* seg;
    __device__ __forceinline__ void side(const Unit& u, unsigned slot, int wid, int lane) const {
        if (wid == 1) { const int e = expert_of(seg, u.pm); pg8::dma16(lane < 32 ? (unsigned)lane * 16u : 4096u + (unsigned)(lane - 32) * 16u, bgu + (size_t)e * 2048 + u.pn * 128, slot); } }
    __device__ __forceinline__ void operator()(const f32x4 (&acc)[2][2][4][2], const Unit& u, int wr, int wc, int fr, int fq, const LAS unsigned char* sd) const {
        int j0 = u.pn * 128 + wc * 32 + 8 * fq, slot0 = u.pm * 256 + wr * 64 + fr; asm volatile("" : "+v"(j0), "+v"(slot0));
        f32x4 bg[2], bu[2];
#pragma unroll
        for (int n = 0; n < 2; ++n) { bg[n] = *(const LAS f32x4*)(sd + (wc * 32 + 8 * fq + 4 * n) * 4); bu[n] = *(const LAS f32x4*)(sd + (128 + wc * 32 + 8 * fq + 4 * n) * 4); }
#pragma unroll
        for (int ai = 0; ai < 2; ++ai)
#pragma unroll
            for (int m = 0; m < 4; ++m) { const size_t slot = (size_t)(slot0 + ai * 128 + m * 16); f32x4 o[2];
#pragma unroll
                for (int n = 0; n < 2; ++n) { f32x4 g = acc[ai][0][m][n] + bg[n], up = acc[ai][1][m][n] + bu[n];
#pragma unroll
                    for (int i = 0; i < 4; ++i) { g[i] = fminf(g[i], 7.0f); up[i] = __builtin_amdgcn_fmed3f(up[i], -7.0f, 7.0f); }
                    f32x4 t = g * (-1.702f * 1.4426950408889634f);
#pragma unroll
                    for (int i = 0; i < 4; ++i) t[i] = __builtin_amdgcn_exp2f(t[i]);
                    t = t + 1.0f;
#pragma unroll
                    for (int i = 0; i < 4; ++i) t[i] = __builtin_amdgcn_rcpf(t[i]);
                    o[n] = (up * F8S_ACT + F8S_ACT) * (g * t); }
                u32x2 w; w.x = pk4_fp8(o[0][0], o[0][1], o[0][2], o[0][3]); w.y = pk4_fp8(o[1][0], o[1][1], o[1][2], o[1][3]);
                *(u32x2*)(HID + slot * 1024 + j0) = w; }
    }
};
struct EpiDown {
    static constexpr bool PERM = true, CHAIN = false, SIDE = true, KHOOK = false; unsigned char* FS; const float* bdn; const int* dest; const float* pslot; const LAS int* seg;
    __device__ __forceinline__ void side(const Unit& u, unsigned slot, int wid, int lane) const {
        if (wid == 1) { const int e = expert_of(seg, u.pm); pg8::dma16((unsigned)lane * 16u, bdn + (size_t)e * 1024 + u.pn * 256, slot); }
        if (wid == 2) pg8::dma16((unsigned)lane * 16u, dest + (size_t)u.pm * 256, slot + 1024u);
        if (wid == 3) pg8::dma16((unsigned)lane * 16u, pslot + (size_t)u.pm * 256, slot + 2048u); }
    __device__ __forceinline__ void operator()(const f32x4 (&acc)[2][2][4][2], const Unit& u, int wr, int wc, int fr, int fq, const LAS unsigned char* sd) const {
        int col0 = u.pn * 256 + wc * 32 + 8 * fq, slot0 = u.pm * 256 + wr * 64 + fr; asm volatile("" : "+v"(col0), "+v"(slot0));
        f32x4 bv[2][2];
#pragma unroll
        for (int bj = 0; bj < 2; ++bj)
#pragma unroll
            for (int n = 0; n < 2; ++n) bv[bj][n] = *(const LAS f32x4*)(sd + (bj * 128 + wc * 32 + 8 * fq + 4 * n) * 4);
#pragma unroll
        for (int ai = 0; ai < 2; ++ai)
#pragma unroll
            for (int m = 0; m < 4; ++m) { const int rt = ai * 128 + wr * 64 + m * 16 + fr; const int d = *(const LAS int*)(sd + 1024 + rt * 4); const float p = *(const LAS float*)(sd + 2048 + rt * 4) * FS_SCALE;
                if (d >= 0) {
#pragma unroll
                    for (int bj = 0; bj < 2; ++bj) { f32x4 v0 = (acc[ai][bj][m][0] + bv[bj][0]) * p, v1 = (acc[ai][bj][m][1] + bv[bj][1]) * p;
#pragma unroll
                        for (int i = 0; i < 4; ++i) { v0[i] = __builtin_amdgcn_fmed3f(v0[i], -FS_CLAMP, FS_CLAMP); v1[i] = __builtin_amdgcn_fmed3f(v1[i], -FS_CLAMP, FS_CLAMP); }
                        u32x2 w; w.x = pk4_fp8(v0[0], v0[1], v0[2], v0[3]); w.y = pk4_fp8(v1[0], v1[1], v1[2], v1[3]);
                        *(u32x2*)(FS + (size_t)d * 1024 + col0 + bj * 128) = w; } }
                asm volatile("" ::: "memory"); }
    }
};

__device__ __forceinline__ const float* xin_row(const Frame& F, int row) { return row < ML ? F.in[IN_X] + (size_t)row * D : F.in[IN_CTX] + (size_t)(row - ML) * D; }
__device__ __forceinline__ void phase_ln0_first(Frame& F) {
    int t_lo, t_hi; tile_range(F, MT, t_lo, t_hi);
    const int r_lo = 32 * t_lo, nrows = 32 * (t_hi - t_lo);
    const int mrA = mod_row(r_lo), mrB = mod_row(r_lo + (nrows > 0 ? nrows - 1 : 0));
    { const float* mb = (const float*)(F.ws + WS_MOD); pv_fill(F, 0, mb + ((size_t)(0 * 17 + mrA) * 6 + 0) * 1024); pv_fill(F, 1, mb + ((size_t)(0 * 17 + mrB) * 6 + 0) * 1024);
      pv_fill(F, 2, mb + ((size_t)(0 * 17 + mrA) * 6 + 1) * 1024); pv_fill(F, 3, mb + ((size_t)(0 * 17 + mrB) * 6 + 1) * 1024); }
    load_wg_lds(F, 0);
    for (int n = F.wave; n < nrows; n += 4 * NWAVES) {
        RowV rv[4];
#pragma unroll
        for (int u = 0; u < 4; ++u) if (n + u * NWAVES < nrows) row_load(rv[u], xin_row(F, r_lo + n + u * NWAVES), F.lane);
#pragma unroll
        for (int u = 0; u < 4; ++u) if (n + u * NWAVES < nrows) { const int row = r_lo + n + u * NWAVES;
            const int sel = (mod_row(row) == mrA) ? 0 : 1; ln0_row(F, row, rv[u], pv_slot(F, 0 + sel), pv_slot(F, 2 + sel)); }
    }
    gates_tail(F, 0, t_lo, t_hi);
    __syncthreads();
}
__device__ __forceinline__ void phase_finalize(Frame& F, int l, int mrows) {
    const int gw = F.bid * NWAVES + F.wave, NGW = F.G * NWAVES;
    const bf16_t* hf = (const bf16_t*)(F.ws + WS_HFB); const bf16_t* hb = hf + (size_t)MT * 512;
    const float* ng = F.in[IN_MNG] + l * 512 + 8 * F.lane;
    const f32x4 g0 = *(const f32x4*)ng, g1 = *(const f32x4*)(ng + 4);
    const bf16_t* zo = (const bf16_t*)(F.ws + WS_Z) + ZC_O + 8 * F.lane;
    u32x4 ha = (u32x4){0u, 0u, 0u, 0u}, hbv = ha, so = ha;
    if (gw < mrows) { ha = __builtin_nontemporal_load((const u32x4*)(hf + (size_t)gw * 512 + 8 * F.lane)); hbv = __builtin_nontemporal_load((const u32x4*)(hb + (size_t)gw * 512 + 8 * F.lane)); so = __builtin_nontemporal_load((const u32x4*)(zo + (size_t)gw * NZ)); }
    for (int row = gw; row < mrows; row += NGW) {
        u32x4 han = ha, hbn = hbv, son = so; const int rn = row + NGW;
        if (rn < mrows) { han = __builtin_nontemporal_load((const u32x4*)(hf + (size_t)rn * 512 + 8 * F.lane)); hbn = __builtin_nontemporal_load((const u32x4*)(hb + (size_t)rn * 512 + 8 * F.lane)); son = __builtin_nontemporal_load((const u32x4*)(zo + (size_t)rn * NZ)); }
        __builtin_amdgcn_sched_barrier(0);
        f32x4 v0 = (f32x4){bflo(ha.x) + bflo(hbv.x), bfhi(ha.x) + bfhi(hbv.x), bflo(ha.y) + bflo(hbv.y), bfhi(ha.y) + bfhi(hbv.y)}, v1 = (f32x4){bflo(ha.z) + bflo(hbv.z), bfhi(ha.z) + bfhi(hbv.z), bflo(ha.w) + bflo(hbv.w), bfhi(ha.w) + bfhi(hbv.w)};
        float s = (v0.x + v0.y) + (v0.z + v0.w) + (v1.x + v1.y) + (v1.z + v1.w);
#pragma unroll
        for (int o = 1; o < 16; o <<= 1) s += shx(s, o, F.lane);
        const float mu = s * (1.f / 128.f); v0 = v0 - mu; v1 = v1 - mu;
        float q = (v0.x * v0.x + v0.y * v0.y) + (v0.z * v0.z + v0.w * v0.w) + (v1.x * v1.x + v1.y * v1.y) + (v1.z * v1.z + v1.w * v1.w);
#pragma unroll
        for (int o = 1; o < 16; o <<= 1) q += shx(q, o, F.lane);
        const float rstd = 1.f / sqrtf(q * (1.f / 128.f) + HEAD_EPS);
        v0 = v0 * rstd * g0; v1 = v1 * rstd * g1;
        u32x4 w; w.x = pk2(v0.x * bflo(so.x), v0.y * bfhi(so.x)); w.y = pk2(v0.z * bflo(so.y), v0.w * bfhi(so.y)); w.z = pk2(v1.x * bflo(so.z), v1.y * bfhi(so.z)); w.w = pk2(v1.z * bflo(so.w), v1.w * bfhi(so.w));
        *(u32x4*)((bf16_t*)(F.ws + WS_BRA) + (size_t)row * D + 256 + 8 * F.lane) = w;
        ha = han; hbv = hbn; so = son;
    }
}
__device__ __forceinline__ void phase_ln1_router(Frame& F, int l, int mrows) {
    LAS int* cnt = (LAS int*)(F.lds + NW_END);
    { const float* wr = F.in[IN_WR] + (size_t)l * D * NEXP;
      for (int i = F.tid; i < NEXP * D; i += NTHREADS) { const int k = i >> 5, e = i & 31; *(LAS bf16_t*)(F.lds + NW_WT + e * 2064 + k * 2) = (bf16_t)f2bf(wr[i]); }
      if (F.tid < NEXP) cnt[F.tid] = 0; }
    const float* brt = F.in[IN_BR] + l * NEXP;
    int t_lo, t_hi; tile_range(F, mrows, t_lo, t_hi);
    const int r_lo = 32 * t_lo, nrows = 32 * (t_hi - t_lo);
    const int mrA = mod_row(r_lo), mrB = mod_row(r_lo + (nrows > 0 ? nrows - 1 : 0));
    { const float* mb = (const float*)(F.ws + WS_MOD); pv_fill(F, 0, F.in[IN_LN1G] + l * D); pv_fill(F, 1, F.in[IN_LN1B] + l * D);
      pv_fill(F, 2, mb + ((size_t)(l * 17 + mrA) * 6 + 2) * 1024); pv_fill(F, 3, mb + ((size_t)(l * 17 + mrB) * 6 + 2) * 1024);
      pv_fill(F, 4, mb + ((size_t)(l * 17 + mrA) * 6 + 3) * 1024); pv_fill(F, 5, mb + ((size_t)(l * 17 + mrB) * 6 + 3) * 1024);
      pv_fill(F, 6, mb + ((size_t)(l * 17 + mrA) * 6 + 4) * 1024); pv_fill(F, 7, mb + ((size_t)(l * 17 + mrB) * 6 + 4) * 1024); }
    __syncthreads();
    { const bf16_t* yb = (const bf16_t*)(F.ws + WS_T) + 8 * F.lane;
      RowV rv[2]; u32x4 yv2[2][2];
#pragma unroll
      for (int u = 0; u < 2; ++u) {
#pragma unroll
          for (int j = 0; j < 4; ++j) rv[u].v[j] = (f32x4){0.f, 0.f, 0.f, 0.f};
          yv2[u][0] = yv2[u][1] = (u32x4){0u, 0u, 0u, 0u}; }
#define RT_LOADPAIR(n_, rv_, yv_) do { _Pragma("unroll") for (int u = 0; u < 2; ++u) if ((n_) + u * NWAVES < nrows) { const int row = r_lo + (n_) + u * NWAVES; \
              if (l == 0) row_load(rv_[u], xin_row(F, row), F.lane); else row_load_bf16(rv_[u], (const bf16_t*)(F.ws + WS_X) + (size_t)row * D, F.lane); \
              _Pragma("unroll") for (int h = 0; h < 2; ++h) yv_[u][h] = __builtin_nontemporal_load((const u32x4*)(yb + (size_t)row * D + 512 * h)); } } while (0)
      RT_LOADPAIR(F.wave, rv, yv2);
      for (int n = F.wave; n < nrows; n += 2 * NWAVES) {
          RowV rvn[2]; u32x4 yvn[2][2];
#pragma unroll
          for (int u = 0; u < 2; ++u) { rvn[u] = rv[u]; yvn[u][0] = yv2[u][0]; yvn[u][1] = yv2[u][1]; }
          RT_LOADPAIR(n + 2 * NWAVES, rvn, yvn);
          __builtin_amdgcn_sched_barrier(0);
#pragma unroll
          for (int u = 0; u < 2; ++u) if (n + u * NWAVES < nrows) { const int row = r_lo + n + u * NWAVES; RowV cur = rv[u];
              const int sel = (mod_row(row) == mrA) ? 0 : 1;
              { const LAS float* g1 = pv_slot(F, 2 + sel);
#pragma unroll
                for (int j = 0; j < 4; ++j) { const f32x4 gg = *(const LAS f32x4*)(g1 + RC(F.lane, j)); const u32x4 yw = yv2[u][j >> 1]; const f32x4 yv = (j & 1) ? (f32x4){bflo(yw.z), bfhi(yw.z), bflo(yw.w), bfhi(yw.w)} : (f32x4){bflo(yw.x), bfhi(yw.x), bflo(yw.y), bfhi(yw.y)}; cur.v[j] = cur.v[j] * DN_ALPHA + gg * yv; } }
              row_ln_plain(cur, F.lane); row_affine_l(cur, pv_slot(F, 0), pv_slot(F, 1), F.lane);
              row_store_bf16_nt(cur, (bf16_t*)(F.ws + WS_X) + (size_t)row * D, F.lane);
              row_ln_plain(cur, F.lane); row_modulate_l(cur, pv_slot(F, 4 + sel), pv_slot(F, 6 + sel), F.lane);
              row_store_bf16(cur, (bf16_t*)(F.ws + WS_H2) + (size_t)row * D, F.lane);
              { unsigned char* h8 = (unsigned char*)(F.ws + WS_H2F8) + (size_t)row * D + 8 * F.lane;
#pragma unroll
                for (int h = 0; h < 2; ++h) { u32x2 w; w.x = pk4_fp8(cur.v[2 * h].x * F8S_ACT, cur.v[2 * h].y * F8S_ACT, cur.v[2 * h].z * F8S_ACT, cur.v[2 * h].w * F8S_ACT); w.y = pk4_fp8(cur.v[2 * h + 1].x * F8S_ACT, cur.v[2 * h + 1].y * F8S_ACT, cur.v[2 * h + 1].z * F8S_ACT, cur.v[2 * h + 1].w * F8S_ACT); *(u32x2*)(h8 + 512 * h) = w; } } }
#pragma unroll
          for (int u = 0; u < 2; ++u) { rv[u] = rvn[u]; yv2[u][0] = yvn[u][0]; yv2[u][1] = yvn[u][1]; }
      }
#undef RT_LOADPAIR
    }
    asm volatile("s_waitcnt vmcnt(0)" ::: "memory"); __syncthreads();
    for (int tile = t_lo + F.wave; tile < t_hi; tile += NWAVES) {
        const LAS float* lgw = narrow_tile_wave(F, (const bf16_t*)(F.ws + WS_H2) + (size_t)tile * 32 * D);
        if (F.lane < 32) {
            const LAS float* lgp = lgw + F.lane * 33; const int row = tile * 32 + F.lane;
            float lg[NEXP];
#pragma unroll
            for (int e = 0; e < NEXP; ++e) lg[e] = lgp[e] + brt[e];
            unsigned used = 0u; float bv[4]; int bi[4];
#pragma unroll
            for (int k = 0; k < 4; ++k) { float best = -3.0e38f; int idx = 0;
#pragma unroll
                for (int e = 0; e < NEXP; ++e) { const bool take = (((used >> e) & 1u) == 0u) && (lg[e] > best); best = take ? lg[e] : best; idx = take ? e : idx; }
                used |= 1u << idx; bv[k] = best; bi[k] = idx; }
            const float e1 = __expf(bv[1] - bv[0]), e2 = __expf(bv[2] - bv[0]), e3 = __expf(bv[3] - bv[0]); const float inv = __builtin_amdgcn_rcpf(1.0f + e1 + e2 + e3);
            int* ei = (int*)(F.ws + WS_ROUTE + RT_EIDX) + (size_t)row * 4; float* pr = (float*)(F.ws + WS_ROUTE + RT_PROB) + (size_t)row * 4;
            *(int4*)ei = make_int4(bi[0], bi[1], bi[2], bi[3]); *(f32x4*)pr = (f32x4){inv, e1 * inv, e2 * inv, e3 * inv};
            atomicAdd((int*)&cnt[bi[0]], 1); atomicAdd((int*)&cnt[bi[1]], 1); atomicAdd((int*)&cnt[bi[2]], 1); atomicAdd((int*)&cnt[bi[3]], 1);
        }
        asm volatile("s_waitcnt lgkmcnt(0)" ::: "memory");
    }
    __syncthreads();
    if (F.tid < NEXP) ((int*)(F.ws + WS_ROUTE + RT_CNT))[F.bid * NEXP + F.tid] = cnt[F.tid];
    __syncthreads();
}
__device__ __forceinline__ void phase_slots(Frame& F, int mrows) {
    LAS int* part = (LAS int*)F.lds;
    LAS int* pre = part + 1024;
    LAS int* tot = pre + 32;
    LAS int* seg = tot + 32;
    LAS int* gcnt = seg + 64;
    LAS int* eix = gcnt + 2048;
    LAS int* rnk = eix + 4096;
    const int* cntg = (const int*)(F.ws + WS_ROUTE + RT_CNT);
    int* tokg = (int*)(F.ws + WS_ROUTE + RT_TOK); int* destg = (int*)(F.ws + WS_ROUTE + RT_DEST); float* psl = (float*)(F.ws + WS_ROUTE + RT_PSLOT);
    int t_lo, t_hi; tile_range(F, mrows, t_lo, t_hi);
    const int row_base = t_lo * 32, nent = (t_hi - t_lo) * 128, ngrp = nent / 64;
    { const int e = F.tid & 31, pt = F.tid >> 5; int a = 0, b = 0;
      for (int c = pt; c < F.G; c += 16) { const int v = cntg[c * NEXP + e]; b += v; a += (c < F.bid) ? v : 0; }
      part[pt * 32 + e] = a; part[512 + pt * 32 + e] = b; }
    for (int i = F.tid; i < nent; i += NTHREADS) eix[i] = ((const int*)(F.ws + WS_ROUTE + RT_EIDX))[(size_t)row_base * 4 + i];
    __syncthreads();
    if (F.tid < NEXP) { int a = 0, b = 0;
#pragma unroll
        for (int pt = 0; pt < 16; ++pt) { a += part[pt * 32 + F.tid]; b += part[512 + pt * 32 + F.tid]; }
        pre[F.tid] = a; tot[F.tid] = b; }
    for (int g = F.wave; g < ngrp; g += NWAVES) {
        const int e = eix[g * 64 + F.lane]; int rank = 0, mycnt = 0;
#pragma unroll 4
        for (int ee = 0; ee < NEXP; ++ee) { const unsigned long long m = __ballot(e == ee); if (e == ee) rank = __popcll(m & ((1ull << F.lane) - 1ull)); if (F.lane == ee) mycnt = __popcll(m); }
        rnk[g * 64 + F.lane] = rank; if (F.lane < NEXP) gcnt[g * 32 + F.lane] = mycnt; }
    __syncthreads();
    if (F.tid == 0) { int s = 0; for (int e = 0; e < NEXP; ++e) { seg[e] = s; s += (tot[e] + 255) & ~255; } seg[NEXP] = s; }
    if (F.tid >= 64 && F.tid < 64 + NEXP) { const int e = F.tid - 64; int run = 0; for (int g = 0; g < ngrp; ++g) { const int c = gcnt[g * 32 + e]; gcnt[g * 32 + e] = run; run += c; } }
    __syncthreads();
    { const float* prg = (const float*)(F.ws + WS_ROUTE + RT_PROB) + (size_t)row_base * 4;
      for (int i = F.tid; i < nent; i += NTHREADS) { const int e = eix[i]; const int slot = seg[e] + pre[e] + gcnt[(i >> 6) * 32 + e] + rnk[i];
          tokg[slot] = row_base + (i >> 2); destg[slot] = row_base * 4 + i; psl[slot] = prg[i]; } }
    if (F.bid < NEXP) { const int e = F.bid; for (int sl = seg[e] + tot[e] + F.tid; sl < seg[e + 1]; sl += NTHREADS) { tokg[sl] = 0; destg[sl] = -1; psl[sl] = 0.f; } }
    if (F.bid == 0 && F.tid <= NEXP) ((int*)(F.ws + WS_ROUTE + RT_SEG))[F.tid] = seg[F.tid];
    __syncthreads();
}
struct CombRaw { u32x4 x[2]; u32x2 f[2][4]; };
__device__ __forceinline__ void comb_load(const Frame& F, int row, CombRaw& r) {
    { const bf16_t* xp = (const bf16_t*)(F.ws + WS_X) + (size_t)row * D + 8 * F.lane;
#pragma unroll
      for (int h = 0; h < 2; ++h) r.x[h] = __builtin_nontemporal_load((const u32x4*)(xp + 512 * h)); }
    const unsigned char* fs = (const unsigned char*)(F.ws + WS_FS) + (size_t)row * 4 * 1024 + 8 * F.lane;
#pragma unroll
    for (int h = 0; h < 2; ++h)
#pragma unroll
        for (int k = 0; k < 4; ++k) r.f[h][k] = __builtin_nontemporal_load((const u32x2*)(fs + k * 1024 + 512 * h));
}
__device__ __forceinline__ void phase_combine_ln2(Frame& F, int l, int mrows) {
    const bool lastl = (l == DEPTH - 1);
    int t_lo, t_hi; tile_range(F, mrows, t_lo, t_hi);
    const int r_lo = 32 * t_lo, nrows = 32 * (t_hi - t_lo);
    const int mrA = mod_row(r_lo), mrB = mod_row(r_lo + (nrows > 0 ? nrows - 1 : 0));
    { const float* mb = (const float*)(F.ws + WS_MOD); const int ln = lastl ? l : l + 1; pv_fill(F, 0, F.in[IN_LN2G] + l * D); pv_fill(F, 1, F.in[IN_LN2B] + l * D);
      pv_fill(F, 2, mb + ((size_t)(l * 17 + mrA) * 6 + 5) * 1024); pv_fill(F, 3, mb + ((size_t)(l * 17 + mrB) * 6 + 5) * 1024);
      pv_fill(F, 4, mb + ((size_t)(ln * 17 + mrA) * 6 + 0) * 1024); pv_fill(F, 5, mb + ((size_t)(ln * 17 + mrB) * 6 + 0) * 1024);
      pv_fill(F, 6, mb + ((size_t)(ln * 17 + mrA) * 6 + 1) * 1024); pv_fill(F, 7, mb + ((size_t)(ln * 17 + mrB) * 6 + 1) * 1024); }
    if (!lastl) load_wg_lds(F, l + 1); else __syncthreads();
    for (int n = F.wave; n < nrows; n += 2 * NWAVES) {
        CombRaw rw[2];
#pragma unroll
        for (int u = 0; u < 2; ++u) if (n + u * NWAVES < nrows) comb_load(F, r_lo + n + u * NWAVES, rw[u]);
#pragma unroll
        for (int u = 0; u < 2; ++u) if (n + u * NWAVES < nrows) { const int row = r_lo + n + u * NWAVES;
            const int sel = (mod_row(row) == mrA) ? 0 : 1;
            const LAS float* g2 = pv_slot(F, 2 + sel);
            RowV x;
#pragma unroll
            for (int h = 0; h < 2; ++h) { const u32x4 w = rw[u].x[h]; x.v[2 * h] = (f32x4){bflo(w.x), bfhi(w.x), bflo(w.y), bfhi(w.y)}; x.v[2 * h + 1] = (f32x4){bflo(w.z), bfhi(w.z), bflo(w.w), bfhi(w.w)}; }
#pragma unroll
            for (int j = 0; j < 4; ++j) { f32x4 f = (f32x4){0.f, 0.f, 0.f, 0.f};
#pragma unroll
                for (int k = 0; k < 4; ++k) { const u32x2 w2 = rw[u].f[j >> 1][k]; const int wd = (int)((j & 1) ? w2.y : w2.x);
                    const f32x2 lo = __builtin_amdgcn_cvt_pk_f32_fp8(wd, false), hi = __builtin_amdgcn_cvt_pk_f32_fp8(wd, true); f[0] += lo[0]; f[1] += lo[1]; f[2] += hi[0]; f[3] += hi[1]; }
                const f32x4 gg = *(const LAS f32x4*)(g2 + RC(F.lane, j)) * (1.0f / FS_SCALE);
                x.v[j] = x.v[j] * DN_ALPHA + gg * f; }
            row_ln_plain(x, F.lane); row_affine_l(x, pv_slot(F, 0), pv_slot(F, 1), F.lane);
            if (lastl) { row_store_nt(x, F.out + (size_t)row * D, F.lane); }
            else { row_store_bf16_nt(x, (bf16_t*)(F.ws + WS_X) + (size_t)row * D, F.lane); ln0_row(F, row, x, pv_slot(F, 4 + sel), pv_slot(F, 6 + sel)); } }
    }
    if (!lastl) gates_tail(F, l + 1, t_lo, t_hi);
    __syncthreads();
}

#define MFMA32(a, b, c) __builtin_amdgcn_mfma_f32_32x32x16_bf16((a), (b), (c), 0, 0, 0)
#define MFMA16(a, b, c) __builtin_amdgcn_mfma_f32_16x16x32_bf16((a), (b), (c), 0, 0, 0)
__device__ __forceinline__ f32x16 zero16() { f32x16 z;
#pragma unroll
    for (int i = 0; i < 16; ++i) z[i] = 0.f;
    return z; }
__device__ __forceinline__ void pool_tiles(Frame& F, int l, bool with_ctx) {
    LAS unsigned char* Pin = F.lds;
    LAS unsigned char* Dm = F.lds + 40960;
    const bf16_t* Z = (const bf16_t*)(F.ws + WS_Z);
    const bf16_t* Wp = (const bf16_t*)(F.ws + WS_WPOOL) + (size_t)l * 4 * 4096;
    const float* psc = F.in[IN_POOLS] + l * 256;
    bf16_t* BRA = (bf16_t*)(F.ws + WS_BRA);
    const int ntiles = with_ctx ? 1088 : 1024;
    const int r = F.lane & 31, h = F.lane >> 5;
    bf16x8 wa[2][4]; f32x4 scv[2][4];
#pragma unroll
    for (int qi = 0; qi < 2; ++qi) { const int q = F.wave + 8 * qi, g = q >> 2, td = (q >> 1) & 1;
#pragma unroll
        for (int ks = 0; ks < 4; ++ks) wa[qi][ks] = *(const bf16x8*)(Wp + ((size_t)g * 64 + td * 32 + r) * 64 + ks * 16 + 8 * h);
#pragma unroll
        for (int qq = 0; qq < 4; ++qq) scv[qi][qq] = *(const f32x4*)(psc + g * 64 + td * 32 + 8 * qq + 4 * h); }
    for (int tile = F.bid; tile < ntiles; tile += F.G) {
        int row0, seq_lo, seq_hi;
        if (tile < 1024) { row0 = tile * 64; seq_lo = row0; seq_hi = row0 + 64; }
        else { const int ct = tile - 1024; seq_lo = ML + (ct >> 2) * 256; seq_hi = seq_lo + 256; row0 = seq_lo + (ct & 3) * 64; }
        for (int idx = F.tid; idx < 80 * 32; idx += NTHREADS) { const int rr = idx >> 5, ck = idx & 31, grow = row0 - 8 + rr;
            if (grow >= seq_lo && grow < seq_hi) *(LAS u32x4*)(Pin + rr * 512 + ck * 16) = __builtin_nontemporal_load((const u32x4*)(Z + (size_t)grow * NZ + ZC_P + ck * 8)); }
        __syncthreads();
#pragma unroll
        for (int g = 0; g < 4; ++g) { constexpr int dummy_ = 0; (void)dummy_; const int hw = 1 << g, tok = F.tid >> 3, ck = g * 8 + (F.tid & 7), t = row0 + tok;
            const int lo = max(t - hw, seq_lo), hi = min(t + hw, seq_hi);
            float s[8];
#pragma unroll
            for (int e = 0; e < 8; ++e) s[e] = 0.f;
#pragma unroll
            for (int d = -hw; d < hw; ++d) { u32x4 v = *(const LAS u32x4*)(Pin + (tok + 8 + d) * 512 + ck * 16); const bool in = (t + d >= lo) && (t + d < hi);
                v.x = in ? v.x : 0u; v.y = in ? v.y : 0u; v.z = in ? v.z : 0u; v.w = in ? v.w : 0u;
                s[0] += bflo(v.x); s[1] += bfhi(v.x); s[2] += bflo(v.y); s[3] += bfhi(v.y); s[4] += bflo(v.z); s[5] += bfhi(v.z); s[6] += bflo(v.w); s[7] += bfhi(v.w); }
            const float inv = 1.0f / (float)(hi - lo);
            const u32x4 o = *(const LAS u32x4*)(Pin + (tok + 8) * 512 + ck * 16);
            u32x4 w; w.x = pk2(s[0] * inv - bflo(o.x), s[1] * inv - bfhi(o.x)); w.y = pk2(s[2] * inv - bflo(o.y), s[3] * inv - bfhi(o.y));
            w.z = pk2(s[4] * inv - bflo(o.z), s[5] * inv - bfhi(o.z)); w.w = pk2(s[6] * inv - bflo(o.w), s[7] * inv - bfhi(o.w));
            *(LAS u32x4*)(Dm + tok * 528 + ck * 16) = w; }
        __syncthreads();
#pragma unroll
        for (int qi = 0; qi < 2; ++qi) { const int q = F.wave + 8 * qi, g = q >> 2, td = (q >> 1) & 1, tt = q & 1;
            f32x16 acc = zero16();
#pragma unroll
            for (int ks = 0; ks < 4; ++ks) { const bf16x8 b = *(const LAS bf16x8*)(Dm + (tt * 32 + r) * 528 + (g * 64 + ks * 16 + 8 * h) * 2);
                acc = MFMA32(wa[qi][ks], b, acc); }
            const size_t orow = (size_t)(row0 + tt * 32 + r);
#pragma unroll
            for (int qq = 0; qq < 4; ++qq) { const int dcol = g * 64 + td * 32 + 8 * qq + 4 * h; const f32x4 sc = scv[qi][qq];
                u32x2 w; w.x = pk2(acc[4 * qq] * sc.x, acc[4 * qq + 1] * sc.y); w.y = pk2(acc[4 * qq + 2] * sc.z, acc[4 * qq + 3] * sc.w);
                *(u32x2*)(BRA + orow * D + dcol) = w; } }
        __syncthreads();
    }
}
__device__ __forceinline__ void sgu_chunks(Frame& F, int l, bool with_ctx) {
    LAS unsigned char* Vt = F.lds;
    const bf16_t* Z = (const bf16_t*)(F.ws + WS_Z);
    const bf16_t* Ws = (const bf16_t*)(F.ws + WS_WSGU) + (size_t)l * 4 * 16384;
    const float* lng = F.in[IN_SLNG] + l * 256; const float* lnb = F.in[IN_SLNB] + l * 256; const float* sb = F.in[IN_SGUB] + l * 512;
    bf16_t* BRA = (bf16_t*)(F.ws + WS_BRA);
    const int nchunks = with_ctx ? 544 : 512;
    const int r = F.lane & 31, h = F.lane >> 5;
    const int tc = F.wave & 1, tt = F.wave >> 1, t = tt * 32 + r;
    for (int ch = F.bid; ch < nchunks; ch += F.G) {
        const int row0 = ch * 128;
        u32x2 ug[4][4]; bf16x8 bcur[8];
#pragma unroll
        for (int g = 0; g < 4; ++g)
#pragma unroll
            for (int qq = 0; qq < 4; ++qq) ug[g][qq] = *(const u32x2*)(Z + (size_t)(row0 + t) * NZ + ZC_UV + g * 64 + tc * 32 + 8 * qq + 4 * h);
#pragma unroll
        for (int ks = 0; ks < 8; ++ks) bcur[ks] = *(const bf16x8*)(Ws + ((size_t)0 * 128 + t) * 128 + ks * 16 + 8 * h);
        { const int s = F.tid >> 2, q = F.tid & 3; const bf16_t* zp = Z + (size_t)(row0 + s) * NZ + ZC_UV + 256 + q * 64;
          float v[64]; float sum = 0.f;
#pragma unroll
          for (int i = 0; i < 8; ++i) { const u32x4 w = __builtin_nontemporal_load((const u32x4*)(zp + 8 * i));
              v[8 * i] = bflo(w.x); v[8 * i + 1] = bfhi(w.x); v[8 * i + 2] = bflo(w.y); v[8 * i + 3] = bfhi(w.y); v[8 * i + 4] = bflo(w.z); v[8 * i + 5] = bfhi(w.z); v[8 * i + 6] = bflo(w.w); v[8 * i + 7] = bfhi(w.w); }
#pragma unroll
          for (int i = 0; i < 64; ++i) sum += v[i];
          sum += shx(sum, 1, F.lane); sum += shx(sum, 2, F.lane);
          const float mean = sum * (1.f / 256.f); float sq = 0.f;
#pragma unroll
          for (int i = 0; i < 64; ++i) { v[i] -= mean; sq += v[i] * v[i]; }
          sq += shx(sq, 1, F.lane); sq += shx(sq, 2, F.lane);
          const float rstd = 1.f / sqrtf(sq * (1.f / 256.f) + LN_EPS);
#pragma unroll
          for (int i = 0; i < 64; ++i) { const int c = q * 64 + i; const float y = v[i] * rstd * lng[c] + lnb[c]; *(LAS bf16_t*)(Vt + c * 272 + s * 2) = (bf16_t)f2bf(y); } }
        __syncthreads();
#pragma unroll
        for (int g = 0; g < 4; ++g) {
            bf16x8 bnx[8];
#pragma unroll
            for (int ks = 0; ks < 8; ++ks) bnx[ks] = bcur[ks];
            if (g < 3) {
#pragma unroll
                for (int ks = 0; ks < 8; ++ks) bnx[ks] = *(const bf16x8*)(Ws + ((size_t)(g + 1) * 128 + t) * 128 + ks * 16 + 8 * h); }
            f32x16 acc = zero16();
#pragma unroll
            for (int ks = 0; ks < 8; ++ks) { const bf16x8 a = *(const LAS bf16x8*)(Vt + (g * 64 + tc * 32 + r) * 272 + (ks * 16 + 8 * h) * 2);
                acc = MFMA32(a, bcur[ks], acc); }
#pragma unroll
            for (int ks = 0; ks < 8; ++ks) bcur[ks] = bnx[ks];
            const float bias = sb[g * 128 + t];
#pragma unroll
            for (int qq = 0; qq < 4; ++qq) { const int c0 = g * 64 + tc * 32 + 8 * qq + 4 * h;
                const u32x2 u = ug[g][qq];
                u32x2 w; w.x = pk2(bflo(u.x) * (acc[4 * qq] + bias), bfhi(u.x) * (acc[4 * qq + 1] + bias)); w.y = pk2(bflo(u.y) * (acc[4 * qq + 2] + bias), bfhi(u.y) * (acc[4 * qq + 3] + bias));
                *(u32x2*)(BRA + (size_t)(row0 + t) * D + 768 + c0) = w; } }
        __syncthreads();
    }
}
__device__ __forceinline__ void qk_conv_pass(Frame& F, int l) {
    const bf16_t* Z = (const bf16_t*)(F.ws + WS_Z); bf16_t* QKC = (bf16_t*)(F.ws + WS_H);
    const int chunk = F.tid & 127, rsub = F.tid >> 7, ch0 = chunk * 8;
    float w0[8], w1[8], w2[8], cbv[8];
    { const float* cw = F.in[IN_CONVW] + (size_t)l * 3 * 1024 + ch0; const float* cb = F.in[IN_CONVB] + (size_t)l * 1024 + ch0;
#pragma unroll
      for (int e = 0; e < 8; ++e) { w0[e] = cw[e]; w1[e] = cw[1024 + e]; w2[e] = cw[2048 + e]; cbv[e] = cb[e]; } }
    const float scale = chunk >= 64 ? 0.08838834764831845f : 1.0f;
    const int ns = F.G * 4, sidx = F.bid * 4 + rsub;
    const int r0 = (int)(((long)sidx * MT) / ns), r1 = (int)(((long)(sidx + 1) * MT) / ns);
    const bf16_t* zb = Z + ZC_QK + ch0;
    const u32x4 zero4 = (u32x4){0u, 0u, 0u, 0u};
    u32x4 xm = zero4, xc = zero4, xn = zero4;
    if (r0 < r1) { xc = *(const u32x4*)(zb + (size_t)r0 * NZ); if (r0 > 0) xm = *(const u32x4*)(zb + (size_t)(r0 - 1) * NZ); if (r0 + 1 < MT) xn = *(const u32x4*)(zb + (size_t)(r0 + 1) * NZ); }
    for (int row = r0; row < r1; ++row) {
        u32x4 xn2 = zero4; if (row + 2 < MT) xn2 = *(const u32x4*)(zb + (size_t)(row + 2) * NZ);
        const int p = row < ML ? (row & 4095) : ((row - ML) & 255), len = row < ML ? 4096 : 256;
        const u32x4 x0 = (p > 0) ? xm : zero4, x1 = xc, x2 = (p + 1 < len) ? xn : zero4;
        const unsigned xa[4] = {x0.x, x0.y, x0.z, x0.w}, xb[4] = {x1.x, x1.y, x1.z, x1.w}, xcc[4] = {x2.x, x2.y, x2.z, x2.w};
        float y[8];
#pragma unroll
        for (int e2 = 0; e2 < 4; ++e2) { y[2 * e2] = cbv[2 * e2] + w0[2 * e2] * bflo(xa[e2]) + w1[2 * e2] * bflo(xb[e2]) + w2[2 * e2] * bflo(xcc[e2]);
            y[2 * e2 + 1] = cbv[2 * e2 + 1] + w0[2 * e2 + 1] * bfhi(xa[e2]) + w1[2 * e2 + 1] * bfhi(xb[e2]) + w2[2 * e2 + 1] * bfhi(xcc[e2]); }
#pragma unroll
        for (int e = 0; e < 8; ++e) y[e] = siluf_(y[e]) * scale;
        u32x4 w; w.x = pk2(y[0], y[1]); w.y = pk2(y[2], y[3]); w.z = pk2(y[4], y[5]); w.w = pk2(y[6], y[7]);
        *(u32x4*)(QKC + (size_t)row * D + ch0) = w;
        xm = xc; xc = xn; xn = xn2;
    }
}
constexpr int ML_QS = 0, ML_KS = 34816, ML_KW = 69632, ML_VT = 104448, ML_CB = 126208, ML_SC = 147968, ML_SCSZ = 2624;
__device__ __forceinline__ float logsigf_(float x) { return fminf(x, 0.f) - __logf(1.0f + __expf(-fabsf(x))); }
__device__ __forceinline__ unsigned swap16(unsigned u) { return __builtin_amdgcn_alignbit(u, u, 16); }
struct MlPre { u32x4 qk[8]; u32x2 v[4]; float g[4]; };
__device__ __forceinline__ void ml_geom(int j, int b, int dir, int& seqbase, int& seqlen, int& pbase) {
    const bool is_ctx = j < 2; int cj = is_ctx ? j : j - 2; const int ncs = is_ctx ? 2 : 32; if (dir) cj = ncs - 1 - cj;
    seqbase = is_ctx ? ML + b * 256 : b * 4096; seqlen = is_ctx ? 256 : 4096; pbase = cj * 128; }
#define ML_BAR() do { asm volatile("s_waitcnt lgkmcnt(0)" ::: "memory"); __builtin_amdgcn_s_barrier(); asm volatile("" ::: "memory"); } while (0)
__device__ __forceinline__ void mlstm_unit(Frame& F, int l, int unit) {
    const int bh = (unit & 7) + 8 * (unit >> 5), sub = (unit >> 3) & 3;
    const int b = bh >> 2, head = bh & 3, dir = sub >> 1, vh = sub & 1;
    LAS unsigned char* QS = F.lds + ML_QS; LAS unsigned char* KS = F.lds + ML_KS; LAS unsigned char* KW = F.lds + ML_KW; LAS unsigned char* VT = F.lds + ML_VT; LAS unsigned char* CB = F.lds + ML_CB;
    const bf16_t* Z = (const bf16_t*)(F.ws + WS_Z); const float* ZG = (const float*)(F.ws + WS_ZG); const bf16_t* QKC = (const bf16_t*)(F.ws + WS_H);
    bf16_t* HF = (bf16_t*)(F.ws + WS_HFB) + (size_t)dir * MT * 512;
    const int wave = F.wave;
    int tl = F.tid;
#define ML_ROLES() const int lane = tl & 63, fr = lane & 15, q4 = lane >> 4; const int isk = (tl >> 4) & 1, ck = tl & 15, i0 = 8 * (tl >> 5), chn = (isk ? 512 : 0) + head * 128 + ck * 8; \
    const int vi0 = 4 * (tl >> 4), vcq = tl & 15, vch = head * 128 + vh * 64 + vcq * 4; (void)fr; (void)q4; (void)vi0; (void)vcq; (void)vch; (void)i0; (void)chn; (void)ck; (void)isk;
    for (int idx = F.tid; idx < 16 * 136; idx += NTHREADS) *(LAS bf16_t*)(VT + (64 + idx / 136) * 272 + (idx % 136) * 2) = (idx < 136) ? (bf16_t)0x3F80 : (bf16_t)0;
    f32x4 cs[5];
#pragma unroll
    for (int vt = 0; vt < 5; ++vt) cs[vt] = (f32x4){0.f, 0.f, 0.f, 0.f};
    float m_state = 0.f;
    MlPre pre;
#define ML_PREFETCH(jj) do { int sb_, sl_, pb_; ml_geom((jj), b, dir, sb_, sl_, pb_); \
        { const int pmin = dir ? pb_ + 120 - i0 : pb_ + i0; const bf16_t* zr = QKC + (size_t)(sb_ + pmin) * D + chn; (void)sl_; \
          _Pragma("unroll") for (int k = 0; k < 8; ++k) pre.qk[k] = *(const u32x4*)(zr + (size_t)k * D); } \
        { const int pminv = dir ? pb_ + 124 - vi0 : pb_ + vi0; const bf16_t* zv = Z + (size_t)(sb_ + pminv) * NZ + ZC_V + vch; \
          _Pragma("unroll") for (int k = 0; k < 4; ++k) pre.v[k] = *(const u32x2*)(zv + (size_t)k * NZ); } \
        if (wave == 0) { const int p0 = dir ? pb_ + 127 - 2 * lane : pb_ + 2 * lane, p1 = dir ? p0 - 1 : p0 + 1; \
          pre.g[0] = ZG[(size_t)(sb_ + p0) * 16 + dir * 8 + head]; pre.g[1] = ZG[(size_t)(sb_ + p0) * 16 + dir * 8 + 4 + head]; \
          pre.g[2] = ZG[(size_t)(sb_ + p1) * 16 + dir * 8 + head]; pre.g[3] = ZG[(size_t)(sb_ + p1) * 16 + dir * 8 + 4 + head]; } } while (0)
#define ML_STEPA(sbuf) do { LAS float* sg_ = (LAS float*)(F.lds + ML_SC + (sbuf) * ML_SCSZ); const int i0g = 2 * lane, i1g = i0g + 1; \
        const float gi0 = pre.g[0], gf0 = pre.g[1], gi1 = pre.g[2], gf1 = pre.g[3]; \
        const float lf0 = logsigf_(gf0), lf1 = logsigf_(gf1); const float s1 = lf0 + lf1; float incl = s1; \
        _Pragma("unroll") for (int o = 1; o < 64; o <<= 1) { const float y_ = shup(incl, o, lane); incl += (lane >= o) ? y_ : 0.f; } \
        const float excl = incl - s1, bc0 = excl + lf0, bc1 = excl + s1; \
        const float g0 = gi0 - bc0, g1 = gi1 - bc1; const float mx1 = fmaxf(g0, g1); float im = mx1; \
        _Pragma("unroll") for (int o = 1; o < 64; o <<= 1) { const float y_ = shup(im, o, lane); im = (lane >= o) ? fmaxf(im, y_) : im; } \
        float em = shup(im, 1, lane); em = (lane == 0) ? -3.0e38f : em; \
        const float M0 = fmaxf(m_state, fmaxf(em, g0)), M1 = fmaxf(m_state, fmaxf(em, mx1)); \
        const float total = bperm(63, bc1), Mlast = bperm(63, M1); \
        sg_[i0g] = g0; sg_[i1g] = g1; sg_[128 + i0g] = M0; sg_[128 + i1g] = M1; \
        sg_[256 + i0g] = __expf(m_state - M0); sg_[256 + i1g] = __expf(m_state - M1); \
        sg_[384 + i0g] = __expf(-(bc0 + M0)); sg_[384 + i1g] = __expf(-(bc1 + M1)); \
        sg_[512 + i0g] = __expf(g0 - Mlast); sg_[512 + i1g] = __expf(g1 - Mlast); \
        if (lane == 0) sg_[640] = __expf(m_state - Mlast); \
        m_state = total + Mlast; } while (0)
    { ML_ROLES(); ML_PREFETCH(0); if (wave == 0) ML_STEPA(0); }
    ML_BAR();
#pragma unroll 1
    for (int j = 0; j < 34; ++j) {
        asm volatile("" : "+v"(tl));
        ML_ROLES();
        int seqbase, seqlen, pbase; ml_geom(j, b, dir, seqbase, seqlen, pbase);
        const LAS float* sc_g = (const LAS float*)(F.lds + ML_SC + (j & 1) * ML_SCSZ); const LAS float* sc_M = sc_g + 128; const LAS float* sc_dec = sc_g + 256; const LAS float* sc_emt = sc_g + 384; const LAS float* sc_wk = sc_g + 512;
        {
#pragma unroll
          for (int k = 0; k < 8; ++k) { const int i = dir ? i0 + 7 - k : i0 + k; *(LAS u32x4*)((isk ? KS : QS) + i * 272 + ck * 16) = pre.qk[k]; }
          if (isk) { u32x4 kt[8]; float ykeep[8];
#pragma unroll
              for (int e = 0; e < 8; ++e) { kt[e] = (u32x4){0u, 0u, 0u, 0u}; ykeep[e] = 0.f; }
#pragma unroll
              for (int k = 0; k < 8; ++k) { const int i = dir ? i0 + 7 - k : i0 + k; const float wk = sc_wk[i];
                  const unsigned xb[4] = {pre.qk[k].x, pre.qk[k].y, pre.qk[k].z, pre.qk[k].w};
#pragma unroll
                  for (int e = 0; e < 8; ++e) { const float yw = ((e & 1) ? bfhi(xb[e >> 1]) : bflo(xb[e >> 1])) * wk;
                      if (k & 1) { const unsigned pw_ = pk2(ykeep[e], yw); if ((k >> 1) == 0) kt[e].x = pw_; else if ((k >> 1) == 1) kt[e].y = pw_; else if ((k >> 1) == 2) kt[e].z = pw_; else kt[e].w = pw_; }
                      else ykeep[e] = yw; } }
#pragma unroll
              for (int e = 0; e < 8; ++e) { u32x4 o = kt[e]; if (dir) o = (u32x4){swap16(kt[e].w), swap16(kt[e].z), swap16(kt[e].y), swap16(kt[e].x)};
                  *(LAS u32x4*)(KW + (ck * 8 + e) * 272 + (((i0 >> 3) ^ (ck & 7)) * 16)) = o; } } }
        { unsigned vv[4][2];
#pragma unroll
          for (int k = 0; k < 4; ++k) { vv[k][0] = pre.v[k].x; vv[k][1] = pre.v[k].y; }
#pragma unroll
          for (int c = 0; c < 4; ++c) {
              unsigned h0 = (c & 1) ? (vv[0][c >> 1] >> 16) : (vv[0][c >> 1] & 0xffffu), h1 = (c & 1) ? (vv[1][c >> 1] >> 16) : (vv[1][c >> 1] & 0xffffu);
              unsigned h2 = (c & 1) ? (vv[2][c >> 1] >> 16) : (vv[2][c >> 1] & 0xffffu), h3 = (c & 1) ? (vv[3][c >> 1] >> 16) : (vv[3][c >> 1] & 0xffffu);
              u32x2 o; if (dir) { o.x = h3 | (h2 << 16); o.y = h1 | (h0 << 16); } else { o.x = h0 | (h1 << 16); o.y = h2 | (h3 << 16); }
              *(LAS u32x2*)(VT + (vcq * 4 + c) * 272 + vi0 * 2) = o; } }
#pragma unroll
        for (int vt = 0; vt < 5; ++vt)
#pragma unroll
            for (int rr = 0; rr < 4; rr += 2) { const unsigned pw_ = pk2(cs[vt][rr], cs[vt][rr + 1]);
                *(LAS bf16_t*)(CB + (16 * vt + 4 * q4 + rr) * 272 + (16 * wave + fr) * 2) = (bf16_t)(pw_ & 0xffffu); *(LAS bf16_t*)(CB + (16 * vt + 4 * q4 + rr + 1) * 272 + (16 * wave + fr) * 2) = (bf16_t)(pw_ >> 16); }
        ML_BAR();
        if (j + 1 < 34) ML_PREFETCH(j + 1);
        const int t = 16 * wave + fr;
        bf16x8 qf[4];
#pragma unroll
        for (int kc = 0; kc < 4; ++kc) qf[kc] = *(const LAS bf16x8*)(QS + t * 272 + (32 * kc + 8 * q4) * 2);
        const float Mt_t = sc_M[t], dec_t = sc_dec[t], emt_t = sc_emt[t];
        f32x4 ps[8];
#pragma unroll
        for (int jp = 0; jp < 4; ++jp) {
            ps[2 * jp] = (f32x4){0.f, 0.f, 0.f, 0.f}; ps[2 * jp + 1] = (f32x4){0.f, 0.f, 0.f, 0.f};
            if (2 * jp <= wave) {
                bf16x8 ka[4], kb[4];
#pragma unroll
                for (int kc = 0; kc < 4; ++kc) { ka[kc] = *(const LAS bf16x8*)(KS + (32 * jp + fr) * 272 + (32 * kc + 8 * q4) * 2); kb[kc] = *(const LAS bf16x8*)(KS + (32 * jp + 16 + fr) * 272 + (32 * kc + 8 * q4) * 2); }
                const f32x4 ga4 = *(const LAS f32x4*)(sc_g + 32 * jp + 4 * q4), gb4 = *(const LAS f32x4*)(sc_g + 32 * jp + 16 + 4 * q4);
                f32x4 acc0 = (f32x4){0.f, 0.f, 0.f, 0.f}, acc1 = (f32x4){0.f, 0.f, 0.f, 0.f};
#pragma unroll
                for (int kc = 0; kc < 4; ++kc) { acc0 = MFMA16(ka[kc], qf[kc], acc0); acc1 = MFMA16(kb[kc], qf[kc], acc1); }
#pragma unroll
                for (int rr = 0; rr < 4; ++rr) { const int s0 = 32 * jp + 4 * q4 + rr, s1 = s0 + 16;
                    ps[2 * jp][rr] = (s0 <= t) ? acc0[rr] * __expf(ga4[rr] - Mt_t) : 0.f; ps[2 * jp + 1][rr] = (s1 <= t) ? acc1[rr] * __expf(gb4[rr] - Mt_t) : 0.f; }
            }
        }
        f32x4 ao[5];
        {
#pragma unroll
          for (int vt = 0; vt < 5; ++vt) ao[vt] = (f32x4){0.f, 0.f, 0.f, 0.f};
#pragma unroll
          for (int kh = 0; kh < 4; kh += 2) { bf16x8 cf[2][5];
#pragma unroll
              for (int k2 = 0; k2 < 2; ++k2)
#pragma unroll
                  for (int vt = 0; vt < 5; ++vt) cf[k2][vt] = *(const LAS bf16x8*)(CB + (16 * vt + fr) * 272 + (32 * (kh + k2) + 8 * q4) * 2);
#pragma unroll
              for (int k2 = 0; k2 < 2; ++k2)
#pragma unroll
                  for (int vt = 0; vt < 5; ++vt) ao[vt] = MFMA16(cf[k2][vt], qf[kh + k2], ao[vt]); }
#pragma unroll
          for (int vt = 0; vt < 5; ++vt) ao[vt] = ao[vt] * dec_t; }
#pragma unroll
        for (int ks = 0; ks < 4; ++ks) {
            if (2 * ks <= wave) {
                s16x4 vlo[5], vhi[5];
#pragma unroll
                for (int vt = 0; vt < 5; ++vt) { vlo[vt] = *(const LAS s16x4*)(VT + (16 * vt + fr) * 272 + (32 * ks + 4 * q4) * 2); vhi[vt] = *(const LAS s16x4*)(VT + (16 * vt + fr) * 272 + (32 * ks + 16 + 4 * q4) * 2); }
                u32x4 pw; pw.x = cvt_pk_bf16(ps[2 * ks][0], ps[2 * ks][1]); pw.y = cvt_pk_bf16(ps[2 * ks][2], ps[2 * ks][3]); pw.z = cvt_pk_bf16(ps[2 * ks + 1][0], ps[2 * ks + 1][1]); pw.w = cvt_pk_bf16(ps[2 * ks + 1][2], ps[2 * ks + 1][3]);
                const bf16x8 pf = __builtin_bit_cast(bf16x8, pw);
#pragma unroll
                for (int vt = 0; vt < 5; ++vt) { const bf16x8 a = __builtin_shufflevector(vlo[vt], vhi[vt], 0, 1, 2, 3, 4, 5, 6, 7); ao[vt] = MFMA16(a, pf, ao[vt]); }
            }
        }
        { const float den = bperm(fr, ao[4][0]); const float inv = 1.0f / fmaxf(fabsf(den), emt_t);
          const int p = dir ? pbase + 127 - t : pbase + t; bf16_t* orow = HF + (size_t)(seqbase + p) * 512 + head * 128 + vh * 64 + 4 * q4;
#pragma unroll
          for (int vt = 0; vt < 4; ++vt) { const f32x4 o = ao[vt] * inv; u32x2 w; w.x = cvt_pk_bf16(o[0], o[1]); w.y = cvt_pk_bf16(o[2], o[3]); *(u32x2*)(orow + 16 * vt) = w; } }
        { const float a_s = sc_g[640];
#pragma unroll
          for (int vt = 0; vt < 5; ++vt) cs[vt] = cs[vt] * a_s;
#pragma unroll
          for (int ks = 0; ks < 4; ks += 2) { bf16x8 bb[2], va[2][5];
#pragma unroll
              for (int k2 = 0; k2 < 2; ++k2) { bb[k2] = *(const LAS bf16x8*)(KW + (16 * wave + fr) * 272 + (((4 * (ks + k2) + q4) ^ (((16 * wave + fr) >> 3) & 7)) * 16));
#pragma unroll
                  for (int vt = 0; vt < 5; ++vt) va[k2][vt] = *(const LAS bf16x8*)(VT + (16 * vt + fr) * 272 + (32 * (ks + k2) + 8 * q4) * 2); }
#pragma unroll
              for (int k2 = 0; k2 < 2; ++k2)
#pragma unroll
                  for (int vt = 0; vt < 5; ++vt) cs[vt] = MFMA16(va[k2][vt], bb[k2], cs[vt]); } }
        if (wave == 0 && j + 1 < 34) ML_STEPA((j + 1) & 1);
        ML_BAR();
    }
#undef ML_PREFETCH
#undef ML_STEPA
#undef ML_ROLES
    __syncthreads();
}
__device__ __forceinline__ void phase_mixers(Frame& F, int l) {
    const bool with_ctx = (l != DEPTH - 1);
#ifndef MIX_MASK
#define MIX_MASK 7
#endif
#ifndef MIXREP
#define MIXREP 0
#endif
    if (MIX_MASK & 1) pool_tiles(F, l, with_ctx);
    if (MIXREP & 1) { __syncthreads(); pool_tiles(F, l, with_ctx); }
    if (MIX_MASK & 2) sgu_chunks(F, l, with_ctx);
    if (MIXREP & 2) { __syncthreads(); sgu_chunks(F, l, with_ctx); }
    (void)0;
    qk_conv_pass(F, l);
}
__device__ __forceinline__ void phase_mlstm(Frame& F, int l) {
    for (int u = F.bid; u < 256; u += F.G) mlstm_unit(F, l, u);
}

struct Args { const float* in[31]; float* out; unsigned char* ws; int g_lo, g_hi, pad0, pad1; };
constexpr int NPH = 11, NGID = 2 + DEPTH * NPH;
__global__ void __launch_bounds__(NTHREADS, 2) fwd_kernel(Args args) {
    extern __shared__ __attribute__((aligned(16))) unsigned char lds_raw[];
    Frame F;
    F.lds = (LAS unsigned char*)lds_raw; F.MISC = (volatile LAS unsigned*)(F.lds + MISC_OFF);
    F.tid = threadIdx.x; F.lane = F.tid & 63; F.wave = __builtin_amdgcn_readfirstlane(F.tid >> 6); F.G = gridDim.x; F.bid = blockIdx.x;
    F.ws = args.ws; F.out = args.out;
    F.in = (InTab)__builtin_amdgcn_kernarg_segment_ptr();
    if (F.tid < 64) F.MISC[F.tid] = 0u;
    __syncthreads();
    const int lo = args.g_lo, hi = args.g_hi;
    const bool multi = (hi - lo) > 1;
    XcdBarrier bar; bar.bar = (unsigned*)(F.ws + WS_CTL) + CW_BAR; bar.x = 0; bar.st = nullptr;
    if (multi) bar = xcd_barrier_post((unsigned*)(F.ws + WS_CTL) + CW_BAR, F.MISC + 8);
#ifndef PHASE_MASK
#define PHASE_MASK 0xFFFF
#endif
#define RUN(g) (lo <= (g) && (g) < hi)
#define RUNP(ty, g) ((((PHASE_MASK) >> (ty)) & 1) && RUN(g))
#ifndef REPEAT_MASK
#define REPEAT_MASK 0
#endif
#define NREP(ty) ((((REPEAT_MASK) >> (ty)) & 1) ? 2 : 1)
#define SEAM(g) do { if (RUN((g) + 1)) xcd_barrier(bar); } while (0)
#define LAUNDER(P) Frame P = F; { int t_; asm volatile("v_mbcnt_lo_u32_b32 %0, -1, 0\n\tv_mbcnt_hi_u32_b32 %0, -1, %0" : "=v"(t_)); t_ |= (F.wave << 6); P.tid = t_; P.lane = t_ & 63; P.wave = __builtin_amdgcn_readfirstlane(t_ >> 6); GAS unsigned char* w_ = (GAS unsigned char*)F.ws; asm volatile("" : "+s"(w_)); P.ws = (unsigned char*)w_; InTab t2_ = F.in; asm volatile("" : "+s"(t2_)); P.in = t2_; }
    if (RUNP(0, 0)) { LAUNDER(P); for (int rep_ = 0; rep_ < NREP(0); ++rep_) { phase_prologue(P); __syncthreads(); } SEAM(0); }
    if (RUNP(1, 1)) { LAUNDER(P); for (int rep_ = 0; rep_ < NREP(1); ++rep_) { phase_ln0_first(P); __syncthreads(); } SEAM(1); }
#pragma unroll 1
    for (int l = 0; l < DEPTH; ++l) {
        const int g0 = 2 + l * NPH;
        const int mrows = (l == DEPTH - 1) ? ML : MT;
        if (RUNP(2, g0 + 0)) {
#undef PHTY
#define PHTY 2
            LAUNDER(P);
            { ProbPlain Pr{(const bf16_t*)(P.ws + WS_H), (const bf16_t*)(P.ws + WS_WIN) + (size_t)l * NZ * D, D, D};
              pg8::StaticOrder<1> S; S.init(MT / 256, NZ_BF / 256, P.G, P.bid);
              EpiInproj<false> E{(bf16_t*)(P.ws + WS_Z), P.in[IN_BIN] + (size_t)l * 5904, 0};
              pg8::gemm_phase(P.lds, P.tid, Pr, S, E); }
            __syncthreads();
            { ProbPlainF8 Pr{(const bf16_t*)(P.ws + WS_H8), (const bf16_t*)(P.ws + WS_WIN8 + (size_t)l * NZ_F8 * D), D / 2, D / 2};
              pg8::StaticOrder<1> S; S.init(MT / 256, NZ_F8 / 256, P.G, P.bid);
              EpiInproj<true> E{(bf16_t*)(P.ws + WS_Z), P.in[IN_BIN] + (size_t)l * 5904, NZ_BF / 256};
              pg8::gemm_phase(P.lds, P.tid, Pr, S, E); }
            SEAM(g0 + 0);
        }
        if (RUNP(3, g0 + 1)) { LAUNDER(P); for (int rep_ = 0; rep_ < NREP(3); ++rep_) { phase_mixers(P, l); __syncthreads(); } SEAM(g0 + 1); }
        if (RUNP(12, g0 + 2)) { LAUNDER(P); for (int rep_ = 0; rep_ < NREP(12); ++rep_) { phase_mlstm(P, l); __syncthreads(); } SEAM(g0 + 2); }
        if (RUNP(4, g0 + 3)) { LAUNDER(P); for (int rep_ = 0; rep_ < NREP(4); ++rep_) phase_finalize(P, l, mrows); SEAM(g0 + 3); }
        if (RUNP(5, g0 + 4)) {
#undef PHTY
#define PHTY 5
            LAUNDER(P);
            ProbPlain Pr{(const bf16_t*)(P.ws + WS_BRA), (const bf16_t*)(P.ws + WS_WBR) + (size_t)l * D * D, D, D};
            pg8::StaticOrder<1> S; S.init(mrows / 256, 4, P.G, P.bid);
            EpiBranch E{(const bf16_t*)(P.ws + WS_Z), (bf16_t*)(P.ws + WS_Y)};
            pg8::gemm_phase(P.lds, P.tid, Pr, S, E); if (NREP(PHTY) == 2) { __syncthreads(); pg8::gemm_phase(P.lds, P.tid, Pr, S, E); }
            SEAM(g0 + 4);
        }
        if (RUNP(6, g0 + 5)) {
#undef PHTY
#define PHTY 6
            LAUNDER(P);
            ProbPlain Pr{(const bf16_t*)(P.ws + WS_Y), (const bf16_t*)(P.ws + WS_WOUT) + (size_t)l * D * D, D, D};
            pg8::StaticOrder<1> S; S.init(mrows / 256, 4, P.G, P.bid);
            EpiOut E{(bf16_t*)(P.ws + WS_T)};
            pg8::gemm_phase(P.lds, P.tid, Pr, S, E); if (NREP(PHTY) == 2) { __syncthreads(); pg8::gemm_phase(P.lds, P.tid, Pr, S, E); }
            SEAM(g0 + 5);
        }
        if (RUNP(7, g0 + 6)) { LAUNDER(P); for (int rep_ = 0; rep_ < NREP(7); ++rep_) phase_ln1_router(P, l, mrows); SEAM(g0 + 6); }
        if (RUNP(8, g0 + 7)) { LAUNDER(P); for (int rep_ = 0; rep_ < NREP(8); ++rep_) phase_slots(P, mrows); SEAM(g0 + 7); }
        if (RUNP(9, g0 + 8)) {
#undef PHTY
#define PHTY 9
            LAUNDER(P);
            LAS int* seg = (LAS int*)(P.lds + TAB_OFF);
            const int ntile = moe_tables(P, seg);
            ProbMoe1 Pr{(const bf16_t*)(P.ws + WS_H2F8), (const bf16_t*)(P.ws + WS_WGU + (size_t)l * NEXP * 2048 * D), D / 2, D / 2, (const int*)(P.ws + WS_ROUTE + RT_TOK), seg};
            pg8::StaticOrder<1> S; S.init(ntile, 8, P.G, P.bid);
            EpiSwiglu E{(unsigned char*)(P.ws + WS_HID), P.in[IN_BGU] + (size_t)l * NEXP * 2048, seg};
            pg8::gemm_phase(P.lds, P.tid, Pr, S, E); if (NREP(PHTY) == 2) { __syncthreads(); pg8::gemm_phase(P.lds, P.tid, Pr, S, E); }
            SEAM(g0 + 8);
        }
        if (RUNP(10, g0 + 9)) {
#undef PHTY
#define PHTY 10
            LAUNDER(P);
            LAS int* seg = (LAS int*)(P.lds + TAB_OFF);
            const int ntile = moe_tables(P, seg);
            ProbMoe2 Pr{(const bf16_t*)(P.ws + WS_HID), (const bf16_t*)(P.ws + WS_WDN + (size_t)l * NEXP * D * D), D / 2, D / 2, seg};
            pg8::StaticOrder<1> S; S.init(ntile, 4, P.G, P.bid);
            EpiDown E{(unsigned char*)(P.ws + WS_FS), P.in[IN_BDN] + (size_t)l * NEXP * D, (const int*)(P.ws + WS_ROUTE + RT_DEST), (const float*)(P.ws + WS_ROUTE + RT_PSLOT), seg};
            pg8::gemm_phase(P.lds, P.tid, Pr, S, E); if (NREP(PHTY) == 2) { __syncthreads(); pg8::gemm_phase(P.lds, P.tid, Pr, S, E); }
            SEAM(g0 + 9);
        }
        if (RUNP(11, g0 + 10)) { LAUNDER(P); phase_combine_ln2(P, l, mrows); SEAM(g0 + 10); }
    }
#undef LAUNDER
#undef RUN
#undef RUNP
#undef SEAM
}

extern "C" void kernel_launch(void* const* d_in, const int* in_sizes, int n_in, void* d_out, int out_size, void* d_ws, size_t ws_size, hipStream_t stream) {
    static int grid = 0;
    if (grid == 0) {
        if (n_in != 31 || out_size != ML * D || ws_size < WS_END) { fprintf(stderr, "kernel_launch: unexpected problem (n_in %d, out %d, ws %zu, need %zu)\n", n_in, out_size, ws_size, (size_t)WS_END); grid = -1; return; }
        int dev = 0, cus = 0, per_cu = 0;
        if (hipGetDevice(&dev) != hipSuccess || hipDeviceGetAttribute(&cus, hipDeviceAttributeMultiprocessorCount, dev) != hipSuccess) { grid = -1; return; }
        if (hipFuncSetAttribute((const void*)fwd_kernel, hipFuncAttributeMaxDynamicSharedMemorySize, LDS_BYTES) != hipSuccess) { fprintf(stderr, "kernel_launch: hipFuncSetAttribute failed\n"); grid = -1; return; }
        if (hipOccupancyMaxActiveBlocksPerMultiprocessor(&per_cu, (const void*)fwd_kernel, NTHREADS, LDS_BYTES) != hipSuccess || per_cu < 1) fprintf(stderr, "kernel_launch: occupancy query reports %d\n", per_cu);
        (void)hipGetLastError();
        grid = cus;
    }
    if (grid < 0) return;
    (void)hipMemsetAsync((char*)d_ws + WS_CTL, 0, CTL_ZERO_BYTES, stream);
    Args a{};
    for (int i = 0; i < 31; ++i) a.in[i] = (const float*)d_in[i];
    a.out = (float*)d_out; a.ws = (unsigned char*)d_ws;
#if MK_N_LAUNCHES == 1
    a.g_lo = 0; a.g_hi = NGID;
    hipLaunchKernelGGL(fwd_kernel, dim3(grid), dim3(NTHREADS), LDS_BYTES, stream, a);
#else
    for (int g = 0; g < NGID; ++g) { a.g_lo = g; a.g_hi = g + 1; hipLaunchKernelGGL(fwd_kernel, dim3(grid), dim3(NTHREADS), LDS_BYTES, stream, a); }
#endif
}
```

```cpp
#include <hip/hip_runtime.h>
#include <cstdio>
#include <cstdint>

#ifndef MK_N_LAUNCHES
#define MK_N_LAUNCHES 1
#endif

#define LAS __attribute__((address_space(3)))
#define GAS __attribute__((address_space(1)))
typedef unsigned short bf16_t;
typedef short bf16x8 __attribute__((ext_vector_type(8)));
typedef short s16x4 __attribute__((ext_vector_type(4)));
typedef float f32x4 __attribute__((ext_vector_type(4)));
typedef float f32x2 __attribute__((ext_vector_type(2)));
typedef float f32x16 __attribute__((ext_vector_type(16)));
typedef unsigned u32x4 __attribute__((ext_vector_type(4)));
typedef unsigned u32x2 __attribute__((ext_vector_type(2)));
typedef int i32x4 __attribute__((ext_vector_type(4)));
typedef int i32x8 __attribute__((ext_vector_type(8)));

constexpr int D = 1024, NB = 16, SEQ = 4096, CTXL = 256, DEPTH = 4;
constexpr int ML = NB * SEQ;
constexpr int MC = NB * CTXL;
constexpr int MT = ML + MC;
constexpr int NZ = 5888;
constexpr int ZC_P = 0, ZC_QK = 256, ZC_V = 1280, ZC_O = 1792, ZC_UV = 2304, ZC_MG = 2816;
constexpr int NZ_BF = 256, NZ_F8 = 5632;
constexpr int ZG_COL = 2816;
constexpr int NEXP = 32, TOPK = 4;
constexpr int NS_MAX = MT * TOPK + NEXP * 256;
constexpr float LN_EPS = 1e-5f, HEAD_EPS = 1e-6f;
constexpr float DN_ALPHA = 1.6817928305074292f;
constexpr int NWAVES = 8, NTHREADS = 512;
constexpr float F8S_ACT = 4.0f, F8S_WGU = 64.0f, F8S_WDN = 64.0f; constexpr int F8E_ACT = 123, F8E_WGU = 123, F8E_WDN = 123;

constexpr size_t MiB = 1u << 20;
constexpr size_t WS_CTL = 0, CTL_ZERO_BYTES = 1 * MiB;
constexpr size_t WS_MOD = 1 * MiB;
constexpr size_t WS_WG = 3 * MiB;
constexpr size_t WS_WSGU = 4 * MiB;
constexpr size_t WS_WPOOL = WS_WSGU + 512 * 1024;
constexpr size_t WS_ROUTE = 5 * MiB;
constexpr size_t WS_WIN = 16 * MiB;
constexpr size_t WS_WBR = 62 * MiB;
constexpr size_t WS_WOUT = 70 * MiB;
constexpr size_t WS_WGU = 78 * MiB;
constexpr size_t WS_WDN = 590 * MiB;
constexpr size_t WS_X = 846 * MiB;
constexpr size_t WS_H = 1118 * MiB;
constexpr size_t WS_Z = 1254 * MiB;
constexpr size_t WS_FS = WS_Z;
constexpr float G8_SCALE = 255.0f;
constexpr float FS_SCALE = 32.0f, FS_CLAMP = 440.0f;
constexpr size_t WS_BRA = 2036 * MiB;
constexpr size_t WS_HFB = 2172 * MiB;
constexpr size_t WS_Y = 2444 * MiB;
constexpr size_t WS_T = 2580 * MiB;
constexpr size_t WS_H2 = 2852 * MiB;
constexpr size_t WS_HID = 2988 * MiB;
constexpr size_t WS_ZG = 3548 * MiB;
constexpr size_t WS_H2F8 = 3554 * MiB;
constexpr size_t WS_H8 = 3624 * MiB;
constexpr size_t WS_WIN8 = 3692 * MiB;
constexpr size_t WS_END = 3714 * MiB;
static_assert(WS_Z + (size_t)MT * NZ * 2 <= WS_BRA && WS_FS + (size_t)MT * 4 * 1024 * 2 <= WS_BRA, "Z/FS");
static_assert(WS_HID + (size_t)NS_MAX * 1024 * 2 <= WS_END, "HID");
constexpr size_t RT_EIDX = 0;
constexpr size_t RT_PROB = 2 * MiB;
constexpr size_t RT_TOK = 4 * MiB;
constexpr size_t RT_DEST = 6 * MiB;
constexpr size_t RT_PSLOT = 8 * MiB;
constexpr size_t RT_CNT = 10 * MiB;
constexpr size_t RT_SEG = 10 * MiB + 64 * 1024;
constexpr int CW_BAR = 4096;

constexpr int LDS_BYTES = 163840;
constexpr int MISC_OFF = LDS_BYTES - 256;
constexpr int TAB_OFF = 131072;
constexpr int NW_WT = 0;
constexpr int NW_LG = 66048;
constexpr int NW_END = 99840;
constexpr int NW_PV = NW_END + 256;

__device__ __forceinline__ unsigned f2bf(float f) { unsigned u = __builtin_bit_cast(unsigned, f); return (u + 0x7fffu + ((u >> 16) & 1u)) >> 16; }
__device__ __forceinline__ unsigned pk2(float lo, float hi) { unsigned r; asm volatile("v_cvt_pk_bf16_f32 %0, %1, %2" : "=v"(r) : "v"(lo), "v"(hi)); return r; }
__device__ __forceinline__ unsigned pk4_fp8(float a, float b, float c, float d) { int w = 0; w = __builtin_amdgcn_cvt_pk_fp8_f32(a, b, w, false); w = __builtin_amdgcn_cvt_pk_fp8_f32(c, d, w, true); return (unsigned)w; }
__device__ __forceinline__ unsigned pk4_u8(float a, float b, float c, float d) {
    const unsigned lo = __builtin_amdgcn_perm(__builtin_bit_cast(unsigned, b), __builtin_bit_cast(unsigned, a), 0x0c0c0400u), hi = __builtin_amdgcn_perm(__builtin_bit_cast(unsigned, d), __builtin_bit_cast(unsigned, c), 0x0c0c0400u);
    return lo | (hi << 16); }
__device__ __forceinline__ f32x4 u8x4_f32(unsigned w) { return (f32x4){(float)(w & 0xffu), (float)((w >> 8) & 0xffu), (float)((w >> 16) & 0xffu), (float)(w >> 24)}; }
__device__ __forceinline__ float bflo(unsigned w) { return __builtin_bit_cast(float, w << 16); }
__device__ __forceinline__ float bfhi(unsigned w) { return __builtin_bit_cast(float, w & 0xffff0000u); }
__device__ __forceinline__ float bf1(bf16_t h) { return __builtin_bit_cast(float, ((unsigned)h) << 16); }
__device__ __forceinline__ float bperm(int srclane, float v) { return __builtin_bit_cast(float, __builtin_amdgcn_ds_bpermute(srclane << 2, __builtin_bit_cast(int, v))); }
__device__ __forceinline__ float shx(float v, int o, int lane) { return bperm(lane ^ o, v); }
__device__ __forceinline__ float shup(float v, int o, int lane) { return bperm(lane >= o ? lane - o : lane, v); }
__device__ __forceinline__ float wave_sum(float v, int lane) {
#pragma unroll
    for (int o = 1; o < 64; o <<= 1) v += shx(v, o, lane);
    return v;
}
__device__ __forceinline__ float sigmoidf_(float x) { return __builtin_amdgcn_rcpf(1.0f + __builtin_amdgcn_exp2f(x * -1.4426950408889634f)); }
__device__ __forceinline__ float siluf_(float x) { return x * __builtin_amdgcn_rcpf(1.0f + __builtin_amdgcn_exp2f(x * -1.4426950408889634f)); }
__device__ __forceinline__ f32x4 sigmoid4(f32x4 x) {
    f32x4 t = x * -1.4426950408889634f;
#pragma unroll
    for (int i = 0; i < 4; ++i) t[i] = __builtin_amdgcn_exp2f(t[i]);
    t = t + 1.0f;
#pragma unroll
    for (int i = 0; i < 4; ++i) t[i] = __builtin_amdgcn_rcpf(t[i]);
    return t; }
#define LDS_WAIT() asm volatile("s_waitcnt lgkmcnt(0)" ::: "memory")
#define VM_WAIT() asm volatile("s_waitcnt vmcnt(0)" ::: "memory")

#define XB_TMO      128
#define XB_XCNT(j)  (256  + 64 * (j))
#define XB_XSUB(j)  (1280 + 64 * (j))
#define XB_XGEN(j)  (2304 + 64 * (j))
#define XB_TOP      3328
#define XB_TOPGEN   3392
#define XCD_BAR_WORDS 3456
#define XB_SPIN_CAP (1u << 18)
__device__ __forceinline__ unsigned xb_ld(unsigned* p)              { asm volatile("" : "+v"(p)); return __hip_atomic_load(p, __ATOMIC_RELAXED, __HIP_MEMORY_SCOPE_AGENT); }
__device__ __forceinline__ unsigned xb_add(unsigned* p, unsigned v) { asm volatile("" : "+v"(p), "+v"(v)); return __hip_atomic_fetch_add(p, v, __ATOMIC_RELAXED, __HIP_MEMORY_SCOPE_AGENT); }
__device__ __forceinline__ unsigned xb_xcc_id() { return (unsigned)__builtin_amdgcn_s_getreg((3 << 11) | 20) & 0xFu; }
#define XB_SPIN(cond, bar) do { unsigned _sp = 0; while (cond) { __builtin_amdgcn_s_sleep(1); \
    if ((++_sp & 255u) == 0u) { if (xb_ld(&(bar)[XB_TMO])) break; if (_sp > XB_SPIN_CAP) { atomicAdd(&(bar)[XB_TMO], 1u); break; } } } } while (0)
struct XcdBarrier { unsigned* bar; unsigned x; volatile LAS unsigned* st; };
__device__ __forceinline__ XcdBarrier xcd_barrier_post(unsigned* bar, volatile LAS unsigned* st) {
    XcdBarrier b; b.bar = bar; b.x = xb_xcc_id(); b.st = st;
    if (threadIdx.x == 0) (void)xb_add(&bar[XB_XCNT(b.x)], 1u);
    return b;
}
__device__ __forceinline__ void xcd_barrier_complete(unsigned* bar, unsigned x, unsigned& nloc, unsigned& nx) {
    const unsigned G = gridDim.x * gridDim.y * gridDim.z;
    unsigned sum, cnt, mine, sp = 0u;
    for (;;) {
        sum = 0u; cnt = 0u; mine = 0u;
#pragma unroll
        for (unsigned j = 0; j < 16; ++j) { const unsigned c = xb_ld(&bar[XB_XCNT(j)]); sum += c; cnt += (c > 0u) ? 1u : 0u; mine = (j == x) ? c : mine; }
        if (sum == G) break;
        __builtin_amdgcn_s_sleep(1);
        if ((++sp & 255u) == 0u) { if (xb_ld(&bar[XB_TMO])) break; if (sp > XB_SPIN_CAP) { atomicAdd(&bar[XB_TMO], 1u); break; } }
    }
    nloc = mine > 0u ? mine : 1u; nx = cnt > 0u ? cnt : 1u;
}
__device__ __forceinline__ void xcd_barrier(const XcdBarrier& b) {
    asm volatile("s_waitcnt vmcnt(0)" ::: "memory");
    __syncthreads();
    if (threadIdx.x == 0) {
        unsigned* bar = b.bar;
        __builtin_amdgcn_s_waitcnt(0);
        unsigned nloc = b.st[0], nx = b.st[1];
        if (nloc == 0u) { xcd_barrier_complete(bar, b.x, nloc, nx); b.st[0] = nloc; b.st[1] = nx; }
        const unsigned old = xb_add(&bar[XB_XSUB(b.x)], 1u);
        const unsigned gen = old / nloc;
        if (old + 1u == (gen + 1u) * nloc) {
            __builtin_amdgcn_fence(__ATOMIC_RELEASE, "agent");
            asm volatile("s_waitcnt vmcnt(0)" ::: "memory");
            const unsigned og = xb_add(&bar[XB_TOP], 1u);
            const unsigned tg = og / nx;
            if (og + 1u == (tg + 1u) * nx) xb_add(&bar[XB_TOPGEN], 1u);
            else XB_SPIN(xb_ld(&bar[XB_TOPGEN]) == tg, bar);
            __builtin_amdgcn_fence(__ATOMIC_ACQUIRE, "agent");
            xb_add(&bar[XB_XGEN(b.x)], 1u);
            asm volatile("s_waitcnt vmcnt(0)" ::: "memory");
        } else {
            XB_SPIN(xb_ld(&bar[XB_XGEN(b.x)]) == gen, bar);
            __builtin_amdgcn_fence(__ATOMIC_ACQUIRE, "agent");
            asm volatile("s_waitcnt vmcnt(0)" ::: "memory");
        }
    }
    __syncthreads();
}

namespace pg8 {
constexpr int BM = 256, BK = 64, HALF = 128, HTB = HALF * BK * 2, STAGE_BYTES = 8 * HTB, NXCD = 8, WGM = 8;
__host__ __device__ __forceinline__ int lds_byte(int r, int c) { const int st = (r >> 4) * 2 + (c >> 5), rr = r & 15, cc = c & 31, ob = rr * 64 + cc * 2; return st * 1024 + (ob ^ (((ob >> 9) & 1) << 5)); }
__host__ __device__ __forceinline__ void stage_rc(int b, int& R, int& C) { const int st = b / 1024, sb = b % 1024, swz = sb ^ (((sb >> 9) & 1) << 5); R = (st >> 1) * 16 + swz / 64; C = (st & 1) * 32 + (swz % 64) / 2; }
__host__ __device__ __forceinline__ int perm32(int rho) { const int n = rho >> 4, i = rho & 15; return 8 * (i >> 2) + 4 * n + (i & 3); }
struct Unit { int pm, pn, sub; };
__device__ __forceinline__ unsigned cvt_pk_bf16(float lo, float hi) { unsigned r; asm volatile("v_cvt_pk_bf16_f32 %0, %1, %2" : "=v"(r) : "v"(lo), "v"(hi)); return r; }
__device__ __forceinline__ f32x2 gelu_pk(f32x2 v) {
    const f32x2 av = __builtin_elementwise_abs(v), d = av * 0.2316418882f + 1.0f;
    f32x2 t; t.x = __builtin_amdgcn_rcpf(d.x); t.y = __builtin_amdgcn_rcpf(d.y);
    f32x2 q = t * 0.5307027145f + (-0.7265760135f); q = q * t + 0.7107068705f; q = q * t + (-0.142248368f); q = q * t + 0.127414796f; q = q * t;
    const f32x2 s = (v * v) * (-0.72134752044f);
    f32x2 e; e.x = __builtin_amdgcn_exp2f(s.x); e.y = __builtin_amdgcn_exp2f(s.y);
    const f32x2 m = v * (q * e), r = v - m;
    f32x2 o; o.x = v.x < 0.f ? m.x : r.x; o.y = v.y < 0.f ? m.y : r.y; return o;
}
template <int NSUB = 1> struct StaticOrder {
    int nM, nN, nwg, G, c;
    __device__ void init(int nM_, int nN_, int G_, int c_) { nM = nM_; nN = nN_; nwg = nM * nN; G = G_; c = c_; }
    __device__ bool next(int i, Unit& u) const {
        const int it = i / NSUB; u.sub = i - it * NSUB;
        const long L = (long)it * G + c; if (L >= nwg) return false;
        int wgid = (int)L; { const int q = nwg / NXCD, r = nwg % NXCD, xcd = wgid % NXCD, off = wgid / NXCD; wgid = (xcd < r ? xcd * (q + 1) : r * (q + 1) + (xcd - r) * q) + off; }
        const int nig = WGM * nN, gid = wgid / nig, fm = gid * WGM, gsz = (nM - fm) < WGM ? (nM - fm) : WGM;
        u.pm = fm + ((wgid % nig) % gsz); u.pn = (wgid % nig) / gsz; return true;
    }
};
constexpr int SIDE_TOK = 131072 + 2048;
constexpr int SIDE_SLOT = 131072 + 10240, SIDE_SLOT_BYTES = 3072;
__device__ __forceinline__ void dma16(unsigned voff, const void* sbase, unsigned ldsaddr) { asm volatile("s_mov_b32 m0, %2\n\tglobal_load_lds_dwordx4 %0, %1" :: "v"(voff), "s"(sbase), "s"(ldsaddr) : "memory", "m0"); }
__device__ __forceinline__ void dma4(unsigned voff, const void* sbase, unsigned ldsaddr) { asm volatile("s_mov_b32 m0, %2\n\tglobal_load_lds_dword %0, %1" :: "v"(voff), "s"(sbase), "s"(ldsaddr) : "memory", "m0"); }
template <class Prob, class Sched, class Epi>
__device__ __forceinline__ void gemm_phase(LAS unsigned char* lds, const int tid, const Prob& P, const Sched& S, const Epi& E) {
    const int wid = __builtin_amdgcn_readfirstlane(tid >> 6), lane = tid & 63, wr = wid >> 2, wc = wid & 3, fr = lane & 15, fq = lane >> 4;
    const int lda = P.lda, ldb = P.ldb;
    unsigned voffB[2], offA[2][2];
#define PG8_TOKSLOT(name) const LAS int* name; { PG8_TID(tl2_); name = (const LAS int*)(lds + SIDE_TOK) + (tl2_ >> 6) * 256 + (tl2_ & 63); }
#define PG8_TID(v_) int v_; asm volatile("v_mbcnt_lo_u32_b32 %0, -1, 0\n\tv_mbcnt_hi_u32_b32 %0, -1, %0" : "=v"(v_)); v_ |= (wid << 6)
#define PG8_RC(R_, C_) int R_[2], C_[2]; { PG8_TID(tl_); _Pragma("unroll") for (int i_ = 0; i_ < 2; ++i_) stage_rc(tl_ * 16 + i_ * 8192, R_[i_], C_[i_]); }
#pragma unroll
    for (int i = 0; i < 2; ++i) { int R, C; stage_rc(tid * 16 + i * 8192, R, C); const int Rb = Epi::PERM ? ((R & ~31) + perm32(R & 31)) : R;
        voffB[i] = (unsigned)(Rb * ldb + C) * 2u;
        offA[0][i] = (unsigned)(R * lda + C) * 2u; offA[1][i] = (unsigned)((R + HALF) * lda + C) * 2u; }
    const size_t kstep = (size_t)(BK * 2);
    const size_t hstep = (size_t)HALF * ldb * 2;
    const unsigned ldsw = (unsigned)wid * 1024u;
    const int aoff = lds_byte(wr * 64 + fr, fq * 8), boff = lds_byte(wc * 32 + fr, fq * 8);
#define PG8_SA(b, h) (((b) * 2 + (h)) * HTB)
#define PG8_SB(b, h) ((4 + (b) * 2 + (h)) * HTB)
    const unsigned ldsb = (unsigned)(size_t)lds;
#define PG8_STAGE(bufoff, gbase, voff) do { _Pragma("unroll") for (int _i = 0; _i < 2; ++_i) \
        asm volatile("s_mov_b32 m0, %2\n\tglobal_load_lds_dwordx4 %0, %1" :: "v"((voff)[_i]), "s"((const char*)(gbase)), "s"(ldsb + (unsigned)(bufoff) + ldsw + (unsigned)(_i * 8192)) : "memory", "m0"); } while (0)
#define PG8_CAT(x0, x1) __builtin_shufflevector(x0, x1, 0, 1, 2, 3, 4, 5, 6, 7)
#define PG8_LDA(dst, b, h) do { if constexpr (Prob::FP8) { _Pragma("unroll") for (int m = 0; m < 4; ++m) dst##8[m] = PG8_CAT(*(const LAS i32x4*)(lds + PG8_SA(b, h) + aoff + m * 2048), *(const LAS i32x4*)(lds + PG8_SA(b, h) + aoff + m * 2048 + 1024)); } \
        else { _Pragma("unroll") for (int m = 0; m < 4; ++m) _Pragma("unroll") for (int k = 0; k < 2; ++k) dst[m][k] = *(const LAS bf16x8*)(lds + PG8_SA(b, h) + aoff + m * 2048 + k * 1024); } } while (0)
#define PG8_LDB(dst, b, h) do { if constexpr (Prob::FP8) { _Pragma("unroll") for (int n = 0; n < 2; ++n) dst##8[n] = PG8_CAT(*(const LAS i32x4*)(lds + PG8_SB(b, h) + boff + n * 2048), *(const LAS i32x4*)(lds + PG8_SB(b, h) + boff + n * 2048 + 1024)); } \
        else { _Pragma("unroll") for (int n = 0; n < 2; ++n) _Pragma("unroll") for (int k = 0; k < 2; ++k) dst[n][k] = *(const LAS bf16x8*)(lds + PG8_SB(b, h) + boff + n * 2048 + k * 1024); } } while (0)
#define PG8_MMA(ai, bj, At, Bt) do { __builtin_amdgcn_s_setprio(1); \
        if constexpr (Prob::FP8) { _Pragma("unroll") for (int m = 0; m < 4; ++m) _Pragma("unroll") for (int n = 0; n < 2; ++n) \
            acc[ai][bj][m][n] = __builtin_amdgcn_mfma_scale_f32_16x16x128_f8f6f4(Bt##8[n], At##8[m], acc[ai][bj][m][n], 0, 0, 0, sc8_, 0, sc8_); } \
        else { _Pragma("unroll") for (int m = 0; m < 4; ++m) _Pragma("unroll") for (int n = 0; n < 2; ++n) _Pragma("unroll") for (int k = 0; k < 2; ++k) \
            acc[ai][bj][m][n] = __builtin_amdgcn_mfma_f32_16x16x32_bf16(Bt[n][k], At[m][k], acc[ai][bj][m][n], 0, 0, 0); } \
        __builtin_amdgcn_s_setprio(0); } while (0)
#define PG8_WAIT_V(n) asm volatile("s_waitcnt vmcnt(" #n ")" ::: "memory")
#define PG8_WAIT_L(n) asm volatile("s_waitcnt lgkmcnt(" #n ")" ::: "memory")
#define PG8_BAR __builtin_amdgcn_s_barrier()
#define PG8_SCHED __builtin_amdgcn_sched_barrier(0)
    Unit cur, nxt; int ui = 0;
    if (!S.next(0, cur)) return;
    static_assert(Prob::SCALE_A == Prob::SCALE_B, "one scale register serves both operands");
    int sc8_; asm volatile("v_mov_b32 %0, %1" : "=v"(sc8_) : "n"(Prob::SCALE_A));
    f32x4 acc[2][2][4][2];
    float zero_; asm volatile("v_mov_b32 %0, 0" : "=v"(zero_));
#pragma unroll
    for (int a = 0; a < 2; ++a)
#pragma unroll
        for (int b = 0; b < 2; ++b)
#pragma unroll
            for (int m = 0; m < 4; ++m)
#pragma unroll
                for (int n = 0; n < 2; ++n) acc[a][b][m][n] = (f32x4){zero_, zero_, zero_, zero_};
    bf16x8 At[4][2], B0[2][2], B1[2][2]; i32x8 At8[4], B08[2], B18[2];
    const char* cA = P.a_base(cur); const char* cB = P.b_base(cur); int nt = P.nt(cur);
    if constexpr (Prob::GATHER) { PG8_RC(Rr, Cc); P.a_rows(cur, Rr, Cc, offA); }
    if constexpr (Epi::SIDE) { PG8_TID(tl4_); E.side(cur, ldsb + SIDE_SLOT, wid, tl4_ & 63); }
    PG8_STAGE(PG8_SB(0, 0), cB, voffB); PG8_STAGE(PG8_SB(0, 1), cB + hstep, voffB); PG8_STAGE(PG8_SA(0, 0), cA, offA[0]); PG8_STAGE(PG8_SA(0, 1), cA, offA[1]);
    if (wr == 1) PG8_BAR;
    PG8_WAIT_V(2); PG8_BAR;
    PG8_STAGE(PG8_SB(1, 0), cB + kstep, voffB); PG8_STAGE(PG8_SA(1, 0), cA + kstep, offA[0]); PG8_STAGE(PG8_SB(1, 1), cB + hstep + kstep, voffB);
    PG8_WAIT_V(6); PG8_BAR;
    for (;;) {
        const bool has_next = S.next(ui + 1, nxt);
        const char* nA = has_next ? P.a_base(nxt) : cA; const char* nB = has_next ? P.b_base(nxt) : cB;
        if constexpr (Prob::GATHER) { if (has_next) { PG8_RC(Rr, Cc); (void)Cc;
#pragma unroll
            for (int h = 0; h < 2; ++h)
#pragma unroll
                for (int i = 0; i < 2; ++i) dma4((unsigned)(nxt.pm * 256 + h * 128 + Rr[i]) * 4u, P.tok, ldsb + SIDE_TOK + (unsigned)wid * 1024u + (unsigned)((h * 2 + i) * 256)); } }
        if constexpr (Epi::SIDE) { if (has_next) { PG8_TID(tl4_); E.side(nxt, ldsb + SIDE_SLOT + (unsigned)(((ui + 1) % 3) * SIDE_SLOT_BYTES), wid, tl4_ & 63); } }
        for (int t = 0; t < nt; t += 2) {
            const bool last = (t == nt - 2);
            if constexpr (Epi::KHOOK) { if (t == Epi::HOOK_T0 || t == Epi::HOOK_T1) {
                asm volatile("" ::: "memory"); PG8_TID(tlh_); const int lnh_ = tlh_ & 63; E.hook(acc, cur, t == Epi::HOOK_T0 ? 0 : 1, wr, wc, lnh_ & 15, lnh_ >> 4); asm volatile("" ::: "memory"); } }
            const char* a1 = cA + (size_t)(t + 1) * kstep;
            const char* a2 = last ? nA : cA + (size_t)(t + 2) * kstep; const char* b2 = last ? nB : cB + (size_t)(t + 2) * kstep;
            const char* a3 = a2 + kstep; const char* b3 = b2 + kstep;
            PG8_LDB(B0, 0, 0); PG8_LDB(B1, 0, 1); PG8_SCHED; PG8_LDA(At, 0, 0); PG8_STAGE(PG8_SA(1, 1), a1, offA[1]);
            PG8_WAIT_V(8); PG8_WAIT_L(0); PG8_BAR; PG8_MMA(0, 0, At, B0); PG8_MMA(0, 1, At, B1); PG8_BAR; PG8_SCHED;
            if constexpr (Prob::GATHER) { if (last && has_next) { PG8_RC(Rr, Cc); (void)Rr; PG8_TOKSLOT(tokslot); const int ntok[2][2] = {{tokslot[0], tokslot[64]}, {tokslot[128], tokslot[192]}}; P.a_off(ntok, Cc, offA); } }
            PG8_LDA(At, 0, 1); PG8_STAGE(PG8_SB(0, 0), b2, voffB); PG8_STAGE(PG8_SB(0, 1), b2 + hstep, voffB); PG8_STAGE(PG8_SA(0, 0), a2, offA[0]);
            PG8_WAIT_V(8); PG8_WAIT_L(0); PG8_BAR; PG8_MMA(1, 0, At, B0); PG8_MMA(1, 1, At, B1); PG8_BAR; PG8_SCHED;
            PG8_LDB(B0, 1, 0); PG8_LDB(B1, 1, 1); PG8_SCHED; PG8_LDA(At, 1, 0); PG8_STAGE(PG8_SA(0, 1), a2, offA[1]);
            PG8_WAIT_V(8); PG8_WAIT_L(0); PG8_BAR; PG8_MMA(0, 0, At, B0); PG8_MMA(0, 1, At, B1); PG8_BAR; PG8_SCHED;
            PG8_LDA(At, 1, 1); PG8_STAGE(PG8_SB(1, 0), b3, voffB); PG8_STAGE(PG8_SB(1, 1), b3 + hstep, voffB); PG8_STAGE(PG8_SA(1, 0), a3, offA[0]);
            PG8_WAIT_V(8); PG8_WAIT_L(0); PG8_BAR; PG8_MMA(1, 0, At, B0); PG8_MMA(1, 1, At, B1); PG8_BAR; PG8_SCHED;
        }
        if (wr == 0) PG8_BAR;
        { PG8_TID(tl3_); const int ln_ = tl3_ & 63; E(acc, cur, wr, wc, ln_ & 15, ln_ >> 4, lds + SIDE_SLOT + (ui % 3) * SIDE_SLOT_BYTES); }
        if (!has_next) break;
        bool keep = false;
        if constexpr (Epi::CHAIN) keep = E.keep(cur);
        if (!keep) {
            asm volatile("v_mov_b32 %0, 0" : "=v"(zero_));
#pragma unroll
            for (int a = 0; a < 2; ++a)
#pragma unroll
                for (int b = 0; b < 2; ++b)
#pragma unroll
                    for (int m = 0; m < 4; ++m)
#pragma unroll
                        for (int n = 0; n < 2; ++n) acc[a][b][m][n] = (f32x4){zero_, zero_, zero_, zero_};
        }
        cur = nxt; cA = nA; cB = nB; nt = P.nt(cur); ++ui;
        if (wr == 1) PG8_BAR;
    }
    PG8_WAIT_V(0);
    PG8_BAR;
#undef PG8_RC
#undef PG8_TID
#undef PG8_TOKSLOT
#undef PG8_SA
#undef PG8_SB
#undef PG8_STAGE
#undef PG8_LDA
#undef PG8_LDB
#undef PG8_MMA
#undef PG8_CAT
#undef PG8_WAIT_V
#undef PG8_WAIT_L
#undef PG8_BAR
#undef PG8_SCHED
}
}

typedef const float* cfp_t;
typedef const cfp_t __attribute__((address_space(4))) * InTab;
struct Frame {
    LAS unsigned char* lds;
    volatile LAS unsigned* MISC;
    unsigned char* ws;
    InTab in;
    float* out;
    int tid, lane, wave, G, bid;
};
enum { IN_X = 0, IN_C, IN_CTX, IN_CCTX, IN_WADA, IN_BADA, IN_WIN, IN_BIN, IN_POOLW, IN_POOLS, IN_CONVW, IN_CONVB, IN_MNG, IN_SLNG, IN_SLNB, IN_SGUW, IN_SGUB,
       IN_WBP, IN_WBM, IN_WBS, IN_WOUT, IN_LN1G, IN_LN1B, IN_WR, IN_BR, IN_WGU, IN_BGU, IN_WDN, IN_BDN, IN_LN2G, IN_LN2B };
__device__ __forceinline__ int mod_row(int row) { return row < ML ? (row >> 12) : NB; }
__device__ __forceinline__ const float* modp(const Frame& F, int l, int row, int part) { return (const float*)(F.ws + WS_MOD) + ((size_t)(l * 17 + mod_row(row)) * 6 + part) * 1024; }

__device__ __forceinline__ void transpose_item(const float* W, size_t ldw, int k0, int srccol0, bf16_t* dst, size_t ldk, int kd0, LAS float* scr, int lane) {
#pragma unroll 8
    for (int i = 0; i < 32; ++i) { const int kk = 2 * i + (lane >> 5); scr[kk * 33 + (lane & 31)] = __builtin_nontemporal_load(W + (size_t)(k0 + kk) * ldw + srccol0 + (lane & 31)); }
    LDS_WAIT(); asm volatile("" ::: "memory");
    const int c = lane & 7;
#pragma unroll
    for (int j = 0; j < 4; ++j) { const int n = (lane >> 3) + 8 * j; const LAS float* s = scr + (8 * c) * 33 + n;
        u32x4 o; o.x = pk2(s[0 * 33], s[1 * 33]); o.y = pk2(s[2 * 33], s[3 * 33]); o.z = pk2(s[4 * 33], s[5 * 33]); o.w = pk2(s[6 * 33], s[7 * 33]);
        *(u32x4*)(dst + (size_t)n * ldk + kd0 + 8 * c) = o; }
    LDS_WAIT(); asm volatile("" ::: "memory");
}
__device__ __forceinline__ void transpose_item_fp8(const float* W, size_t ldw, int k0, int srccol0, unsigned char* dst, size_t ldk, int kd0, float sc, LAS float* scr, int lane) {
#pragma unroll 8
    for (int i = 0; i < 32; ++i) { const int kk = 2 * i + (lane >> 5); scr[kk * 33 + (lane & 31)] = __builtin_nontemporal_load(W + (size_t)(k0 + kk) * ldw + srccol0 + (lane & 31)); }
    LDS_WAIT(); asm volatile("" ::: "memory");
    const int c = lane & 7;
#pragma unroll
    for (int j = 0; j < 4; ++j) { const int n = (lane >> 3) + 8 * j; const LAS float* s_ = scr + (8 * c) * 33 + n;
        u32x2 o; o.x = pk4_fp8(s_[0 * 33] * sc, s_[1 * 33] * sc, s_[2 * 33] * sc, s_[3 * 33] * sc); o.y = pk4_fp8(s_[4 * 33] * sc, s_[5 * 33] * sc, s_[6 * 33] * sc, s_[7 * 33] * sc);
        *(u32x2*)(dst + (size_t)n * ldk + kd0 + 8 * c) = o; }
    LDS_WAIT(); asm volatile("" ::: "memory");
}
__device__ __forceinline__ void phase_prologue(Frame& F) {
    LAS float* scr = (LAS float*)(F.lds + F.wave * 16384);
    const int gw = F.bid * NWAVES + F.wave, NGW = F.G * NWAVES;
    constexpr int I_IN = 16 * (NZ / 32);
    constexpr int I_BR = (4 + 8 + 4) * 32;
    constexpr int I_OUT = 16 * 32;
    constexpr int I_GU = 16 * 64;
    constexpr int I_DN = 16 * 32;
    constexpr int T_IN = DEPTH * I_IN, T_BR = DEPTH * I_BR, T_OUT = DEPTH * I_OUT, T_GU = DEPTH * NEXP * I_GU, T_DN = DEPTH * NEXP * I_DN;
    constexpr int NITEMS = T_IN + T_BR + T_OUT + T_GU + T_DN;
    for (int it = gw; it < NITEMS; it += NGW) {
        int r = it;
        if (r < T_IN) { const int l = r / I_IN; r %= I_IN; const int kb = r / (NZ / 32), nb = r % (NZ / 32); const int n0 = nb * 32, src = n0 < 2304 ? n0 : n0 + 16;
            if (n0 < NZ_BF) transpose_item(F.in[IN_WIN] + (size_t)l * D * 5904, 5904, kb * 64, src, (bf16_t*)(F.ws + WS_WIN) + ((size_t)l * NZ + n0) * D, D, kb * 64, scr, F.lane);
            else transpose_item_fp8(F.in[IN_WIN] + (size_t)l * D * 5904, 5904, kb * 64, src, (unsigned char*)(F.ws + WS_WIN8) + ((size_t)l * NZ_F8 + (n0 - NZ_BF)) * D, D, kb * 64, F8S_WGU, scr, F.lane);
            continue; }
        r -= T_IN;
        if (r < T_BR) { const int l = r / I_BR; r %= I_BR; const int kb = r / 32, nb = r % 32;
            const float* W; int ksrc;
            if (kb < 4) { W = F.in[IN_WBP] + (size_t)l * 256 * D; ksrc = kb * 64; } else if (kb < 12) { W = F.in[IN_WBM] + (size_t)l * 512 * D; ksrc = (kb - 4) * 64; } else { W = F.in[IN_WBS] + (size_t)l * 256 * D; ksrc = (kb - 12) * 64; }
            transpose_item(W, D, ksrc, nb * 32, (bf16_t*)(F.ws + WS_WBR) + ((size_t)l * D + nb * 32) * D, D, kb * 64, scr, F.lane); continue; }
        r -= T_BR;
        if (r < T_OUT) { const int l = r / I_OUT; r %= I_OUT; const int kb = r / 32, nb = r % 32;
            transpose_item(F.in[IN_WOUT] + (size_t)l * D * D, D, kb * 64, nb * 32, (bf16_t*)(F.ws + WS_WOUT) + ((size_t)l * D + nb * 32) * D, D, kb * 64, scr, F.lane); continue; }
        r -= T_OUT;
        if (r < T_GU) { const int le = r / I_GU; r %= I_GU; const int kb = r / 64, nb = r % 64; const int n0 = nb * 32;
            const int pn = n0 >> 8, c = n0 & 255; const int src = c < 128 ? (128 * pn + c) : (1024 + 128 * pn + c - 128);
            transpose_item_fp8(F.in[IN_WGU] + (size_t)le * D * 2048, 2048, kb * 64, src, (unsigned char*)(F.ws + WS_WGU) + ((size_t)le * 2048 + n0) * D, D, kb * 64, F8S_WGU, scr, F.lane); continue; }
        r -= T_GU;
        { const int le = r / I_DN; r %= I_DN; const int kb = r / 32, nb = r % 32;
            transpose_item_fp8(F.in[IN_WDN] + (size_t)le * D * D, D, kb * 64, nb * 32, (unsigned char*)(F.ws + WS_WDN) + ((size_t)le * D + nb * 32) * D, D, kb * 64, F8S_WDN, scr, F.lane); }
    }
    { const int gt = F.bid * NTHREADS + F.tid, NGT = F.G * NTHREADS;
      for (int i = gt; i < DEPTH * 16 * 1024; i += NGT) { const int l = i >> 14, g = (i >> 10) & 15, k = i & 1023; ((float*)(F.ws + WS_WG))[i] = F.in[IN_WIN][((size_t)l * D + k) * 5904 + 2304 + g]; }
      for (int i = gt; i < DEPTH * 4 * 128 * 128; i += NGT) ((bf16_t*)(F.ws + WS_WSGU))[i] = (bf16_t)f2bf(F.in[IN_SGUW][i]);
      for (int i = gt; i < DEPTH * 4 * 64 * 64; i += NGT) { const int lg = i >> 12, d = (i >> 6) & 63, c = i & 63; ((bf16_t*)(F.ws + WS_WPOOL))[i] = (bf16_t)f2bf(F.in[IN_POOLW][(size_t)lg * 4096 + c * 64 + d]); } }
    __syncthreads();
    { LAS float* sc = (LAS float*)F.lds;
      LAS float* part = (LAS float*)(F.lds + 71680);
      for (int i = F.tid; i < 17 * 1024; i += NTHREADS) { const int r = i >> 10, k = i & 1023; const float v = r < 16 ? F.in[IN_C][r * 1024 + k] : F.in[IN_CCTX][k]; sc[i] = siluf_(v); }
      __syncthreads();
      for (int u = F.bid; u < DEPTH * 48; u += F.G) {
          const int l = u / 48, n0 = (u % 48) * 128, col = F.tid & 127, ks = F.tid >> 7;
          float a[17];
#pragma unroll
          for (int r = 0; r < 17; ++r) a[r] = 0.f;
          const float* W = F.in[IN_WADA] + (size_t)l * D * 6144 + n0 + col;
          for (int k = ks * 256; k < ks * 256 + 256; ++k) { const float w = W[(size_t)k * 6144];
#pragma unroll
              for (int r = 0; r < 17; ++r) a[r] += sc[r * 1024 + k] * w; }
#pragma unroll
          for (int r = 0; r < 17; ++r) part[(ks * 17 + r) * 128 + col] = a[r];
          __syncthreads();
          for (int i = F.tid; i < 17 * 128; i += NTHREADS) { const int r = i >> 7, cc = i & 127;
              const float s = part[(0 * 17 + r) * 128 + cc] + part[(1 * 17 + r) * 128 + cc] + part[(2 * 17 + r) * 128 + cc] + part[(3 * 17 + r) * 128 + cc] + F.in[IN_BADA][l * 6144 + n0 + cc];
              ((float*)(F.ws + WS_MOD))[(size_t)(l * 17 + r) * 6144 + n0 + cc] = s; }
          __syncthreads();
      } }
}

struct RowV { f32x4 v[4]; };
#define RC(lane, j) (8 * (lane) + 512 * ((j) >> 1) + 4 * ((j) & 1))
__device__ __forceinline__ void row_load(RowV& r, const float* p, int lane) {
#pragma unroll
    for (int j = 0; j < 4; ++j) r.v[j] = __builtin_nontemporal_load((const f32x4*)(p + RC(lane, j)));
}
__device__ __forceinline__ void row_load_bf16(RowV& r, const bf16_t* p, int lane) {
#pragma unroll
    for (int h = 0; h < 2; ++h) { const u32x4 w = __builtin_nontemporal_load((const u32x4*)(p + 8 * lane + 512 * h)); r.v[2 * h] = (f32x4){bflo(w.x), bfhi(w.x), bflo(w.y), bfhi(w.y)}; r.v[2 * h + 1] = (f32x4){bflo(w.z), bfhi(w.z), bflo(w.w), bfhi(w.w)}; }
}
__device__ __forceinline__ void row_store(const RowV& r, float* p, int lane) {
#pragma unroll
    for (int j = 0; j < 4; ++j) *(f32x4*)(p + RC(lane, j)) = r.v[j];
}
__device__ __forceinline__ void row_store_nt(const RowV& r, float* p, int lane) {
#pragma unroll
    for (int j = 0; j < 4; ++j) __builtin_nontemporal_store(r.v[j], (f32x4*)(p + RC(lane, j)));
}
__device__ __forceinline__ void row_store_bf16_nt(const RowV& r, bf16_t* p, int lane) {
#pragma unroll
    for (int h = 0; h < 2; ++h) { u32x4 w; w.x = pk2(r.v[2 * h].x, r.v[2 * h].y); w.y = pk2(r.v[2 * h].z, r.v[2 * h].w); w.z = pk2(r.v[2 * h + 1].x, r.v[2 * h + 1].y); w.w = pk2(r.v[2 * h + 1].z, r.v[2 * h + 1].w); __builtin_nontemporal_store(w, (u32x4*)(p + 8 * lane + 512 * h)); }
}
__device__ __forceinline__ void row_store_bf16(const RowV& r, bf16_t* p, int lane) {
#pragma unroll
    for (int h = 0; h < 2; ++h) { u32x4 w; w.x = pk2(r.v[2 * h].x, r.v[2 * h].y); w.y = pk2(r.v[2 * h].z, r.v[2 * h].w); w.z = pk2(r.v[2 * h + 1].x, r.v[2 * h + 1].y); w.w = pk2(r.v[2 * h + 1].z, r.v[2 * h + 1].w); *(u32x4*)(p + 8 * lane + 512 * h) = w; }
}
__device__ __forceinline__ void row_ln_plain(RowV& r, int lane) {
    float s = 0.f;
#pragma unroll
    for (int j = 0; j < 4; ++j) s += (r.v[j].x + r.v[j].y) + (r.v[j].z + r.v[j].w);
    const float mean = wave_sum(s, lane) * (1.f / D); float s2 = 0.f;
#pragma unroll
    for (int j = 0; j < 4; ++j) { r.v[j] = r.v[j] - mean; s2 += (r.v[j].x * r.v[j].x + r.v[j].y * r.v[j].y) + (r.v[j].z * r.v[j].z + r.v[j].w * r.v[j].w); }
    const float rstd = 1.f / sqrtf(wave_sum(s2, lane) * (1.f / D) + LN_EPS);
#pragma unroll
    for (int j = 0; j < 4; ++j) r.v[j] = r.v[j] * rstd;
}
__device__ __forceinline__ void row_affine(RowV& r, const float* g, const float* b, int lane) {
#pragma unroll
    for (int j = 0; j < 4; ++j) { const f32x4 gg = *(const f32x4*)(g + RC(lane, j)), bb = *(const f32x4*)(b + RC(lane, j)); r.v[j] = r.v[j] * gg + bb; }
}
__device__ __forceinline__ void row_modulate(RowV& r, const float* sh, const float* sc, int lane) {
#pragma unroll
    for (int j = 0; j < 4; ++j) { const f32x4 s1 = *(const f32x4*)(sc + RC(lane, j)), s0 = *(const f32x4*)(sh + RC(lane, j)); r.v[j] = r.v[j] * (s1 + 1.0f) + s0; }
}
__device__ __forceinline__ LAS float* pv_slot(const Frame& F, int slot) { return (LAS float*)(F.lds + NW_PV) + slot * 1024; }
__device__ __forceinline__ void pv_fill(Frame& F, int slot, const float* src) { LAS f32x4* d = (LAS f32x4*)pv_slot(F, slot); for (int i = F.tid; i < 256; i += NTHREADS) d[i] = *(const f32x4*)(src + 4 * i); }
__device__ __forceinline__ void row_affine_l(RowV& r, const LAS float* g, const LAS float* b, int lane) {
#pragma unroll
    for (int j = 0; j < 4; ++j) { const f32x4 gg = *(const LAS f32x4*)(g + RC(lane, j)), bb = *(const LAS f32x4*)(b + RC(lane, j)); r.v[j] = r.v[j] * gg + bb; }
}
__device__ __forceinline__ void row_modulate_l(RowV& r, const LAS float* sh, const LAS float* sc, int lane) {
#pragma unroll
    for (int j = 0; j < 4; ++j) { const f32x4 s1 = *(const LAS f32x4*)(sc + RC(lane, j)), s0 = *(const LAS f32x4*)(sh + RC(lane, j)); r.v[j] = r.v[j] * (s1 + 1.0f) + s0; }
}
__device__ __forceinline__ void ln0_row(Frame& F, int row, RowV xr, const LAS float* sh, const LAS float* sc) {
    row_ln_plain(xr, F.lane);
    row_modulate_l(xr, sh, sc, F.lane);
    row_store_bf16(xr, (bf16_t*)(F.ws + WS_H) + (size_t)row * D, F.lane);
    { unsigned char* h8 = (unsigned char*)(F.ws + WS_H8) + (size_t)row * D + 8 * F.lane;
#pragma unroll
      for (int h = 0; h < 2; ++h) { u32x2 w; w.x = pk4_fp8(xr.v[2 * h].x * F8S_ACT, xr.v[2 * h].y * F8S_ACT, xr.v[2 * h].z * F8S_ACT, xr.v[2 * h].w * F8S_ACT); w.y = pk4_fp8(xr.v[2 * h + 1].x * F8S_ACT, xr.v[2 * h + 1].y * F8S_ACT, xr.v[2 * h + 1].z * F8S_ACT, xr.v[2 * h + 1].w * F8S_ACT); *(u32x2*)(h8 + 512 * h) = w; } }
}
__device__ __forceinline__ LAS float* narrow_tile_wave(Frame& F, const bf16_t* A) {
    const int r = F.lane & 31, h = F.lane >> 5;
    f32x16 acc;
#pragma unroll
    for (int i = 0; i < 16; ++i) acc[i] = 0.f;
    const bf16_t* ap = A + (size_t)r * D + 8 * h;
    const LAS unsigned char* bp = F.lds + NW_WT + r * 2064 + 16 * h;
    bf16x8 av[2][16];
#pragma unroll
    for (int ks = 0; ks < 16; ++ks) av[0][ks] = *(const bf16x8*)(ap + ks * 16);
#pragma unroll
    for (int kb = 0; kb < 4; ++kb) {
        if (kb < 3) {
#pragma unroll
            for (int ks = 0; ks < 16; ++ks) av[(kb + 1) & 1][ks] = *(const bf16x8*)(ap + ((kb + 1) * 16 + ks) * 16); }
        __builtin_amdgcn_sched_barrier(0);
#pragma unroll
        for (int ks = 0; ks < 16; ++ks) { const bf16x8 b = *(const LAS bf16x8*)(bp + (kb * 16 + ks) * 32); acc = __builtin_amdgcn_mfma_f32_32x32x16_bf16(av[kb & 1][ks], b, acc, 0, 0, 0); }
        __builtin_amdgcn_sched_barrier(0);
    }
    LAS float* lg = (LAS float*)(F.lds + NW_LG) + F.wave * 1056;
#pragma unroll
    for (int i = 0; i < 16; ++i) lg[((i & 3) + 8 * (i >> 2) + 4 * h) * 33 + r] = acc[i];
    asm volatile("s_waitcnt lgkmcnt(0)" ::: "memory");
    return lg;
}
__device__ __forceinline__ void tile_range(const Frame& F, int mrows, int& t_lo, int& t_hi) { const int nt = mrows / 32; t_lo = (int)(((long)F.bid * nt) / F.G); t_hi = (int)(((long)(F.bid + 1) * nt) / F.G); }
__device__ __forceinline__ void load_wg_lds(Frame& F, int l) {
    const float* src = (const float*)(F.ws + WS_WG) + (size_t)l * 16384;
    for (int i = F.tid; i < 32 * 128; i += NTHREADS) { const int g = i >> 7, c8 = i & 127; u32x4 w = (u32x4){0u, 0u, 0u, 0u};
        if (g < 16) { const f32x4 a = *(const f32x4*)(src + g * 1024 + c8 * 8), b = *(const f32x4*)(src + g * 1024 + c8 * 8 + 4); w.x = pk2(a.x, a.y); w.y = pk2(a.z, a.w); w.z = pk2(b.x, b.y); w.w = pk2(b.z, b.w); }
        *(LAS u32x4*)(F.lds + NW_WT + g * 2064 + c8 * 16) = w; }
    __syncthreads();
}
__device__ __forceinline__ void gates_tail(Frame& F, int l, int t_lo, int t_hi) {
    asm volatile("s_waitcnt vmcnt(0)" ::: "memory"); __syncthreads();
    const int g = F.lane & 15; const float bias = F.in[IN_BIN][l * 5904 + 2304 + g];
    for (int tile = t_lo + F.wave; tile < t_hi; tile += NWAVES) {
        const LAS float* lg = narrow_tile_wave(F, (const bf16_t*)(F.ws + WS_H) + (size_t)tile * 32 * D);
#pragma unroll
        for (int rr = 0; rr < 8; ++rr) { const int row = rr * 4 + (F.lane >> 4); ((float*)(F.ws + WS_ZG))[(size_t)(tile * 32 + row) * 16 + g] = lg[row * 33 + g] + bias; }
        asm volatile("s_waitcnt lgkmcnt(0)" ::: "memory");
    }
}

using pg8::Unit;
struct ProbPlain {
    static constexpr bool GATHER = false, FP8 = false; static constexpr int SCALE_A = 127, SCALE_B = 127; const bf16_t* A; const bf16_t* Bt; int lda, ldb;
    __device__ __forceinline__ int nt(const Unit&) const { return lda / 64; }
    __device__ __forceinline__ const char* a_base(const Unit& u) const { return (const char*)A + (size_t)u.pm * 256 * lda * 2; }
    __device__ __forceinline__ const char* b_base(const Unit& u) const { return (const char*)Bt + (size_t)u.pn * 256 * ldb * 2; }
    __device__ __forceinline__ void a_tok(const Unit&, const int (&)[2], int (&)[2][2]) const {}
    __device__ __forceinline__ void a_off(const int (&)[2][2], const int (&)[2], unsigned (&)[2][2]) const {}
    __device__ __forceinline__ void a_rows(const Unit&, const int (&)[2], const int (&)[2], unsigned (&)[2][2]) const {}
};
struct ProbPlainF8 {
    static constexpr bool GATHER = false, FP8 = true; static constexpr int SCALE_A = F8E_ACT, SCALE_B = F8E_WGU; const bf16_t* A; const bf16_t* Bt; int lda, ldb;
    __device__ __forceinline__ int nt(const Unit&) const { return lda / 64; }
    __device__ __forceinline__ const char* a_base(const Unit& u) const { return (const char*)A + (size_t)u.pm * 256 * lda * 2; }
    __device__ __forceinline__ const char* b_base(const Unit& u) const { return (const char*)Bt + (size_t)u.pn * 256 * ldb * 2; }
    __device__ __forceinline__ void a_tok(const Unit&, const int (&)[2], int (&)[2][2]) const {}
    __device__ __forceinline__ void a_off(const int (&)[2][2], const int (&)[2], unsigned (&)[2][2]) const {}
    __device__ __forceinline__ void a_rows(const Unit&, const int (&)[2], const int (&)[2], unsigned (&)[2][2]) const {}
};
struct ProbBranch {
    static constexpr bool GATHER = false, FP8 = false; static constexpr int SCALE_A = 127, SCALE_B = 127; const bf16_t* A; const bf16_t* Bt; int lda, ldb;
    __device__ __forceinline__ int nt(const Unit& u) const { return u.sub == 1 ? 8 : 4; }
    __device__ __forceinline__ int koff(const Unit& u) const { return u.sub == 0 ? 0 : (u.sub == 1 ? 256 : 768); }
    __device__ __forceinline__ const char* a_base(const Unit& u) const { return (const char*)A + ((size_t)u.pm * 256 * lda + koff(u)) * 2; }
    __device__ __forceinline__ const char* b_base(const Unit& u) const { return (const char*)Bt + ((size_t)u.pn * 256 * ldb + koff(u)) * 2; }
    __device__ __forceinline__ void a_tok(const Unit&, const int (&)[2], int (&)[2][2]) const {}
    __device__ __forceinline__ void a_off(const int (&)[2][2], const int (&)[2], unsigned (&)[2][2]) const {}
    __device__ __forceinline__ void a_rows(const Unit&, const int (&)[2], const int (&)[2], unsigned (&)[2][2]) const {}
};
__device__ __forceinline__ int expert_of(const LAS int* seg, int pm) { return __builtin_amdgcn_readfirstlane((int)((const LAS unsigned char*)(seg + 64))[pm]); }
__device__ __forceinline__ int moe_tables(Frame& F, LAS int* seg) {
    __syncthreads();
    if (F.tid <= NEXP) seg[F.tid] = ((const int*)(F.ws + WS_ROUTE + RT_SEG))[F.tid];
    __syncthreads();
    const int ntile = seg[NEXP] / 256;
    LAS unsigned char* texp = (LAS unsigned char*)(seg + 64);
    for (int t = F.tid; t < ntile; t += NTHREADS) { const int row = t * 256; int e = 0;
#pragma unroll
        for (int i = 1; i < NEXP; ++i) e += (seg[i] <= row) ? 1 : 0;
        texp[t] = (unsigned char)e; }
    __syncthreads();
    return ntile;
}
struct ProbMoe1 {
    static constexpr bool GATHER = true, FP8 = true; static constexpr int SCALE_A = F8E_ACT, SCALE_B = F8E_WGU; const bf16_t* A; const bf16_t* Bt; int lda, ldb; const int* tok; const LAS int* seg;
    __device__ __forceinline__ int nt(const Unit&) const { return lda / 64; }
    __device__ __forceinline__ const char* a_base(const Unit&) const { return (const char*)A; }
    __device__ __forceinline__ const char* b_base(const Unit& u) const { const int e = expert_of(seg, u.pm); return (const char*)Bt + ((size_t)e * 2048 + (size_t)u.pn * 256) * ldb * 2; }
    __device__ __forceinline__ void a_rows(const Unit& u, const int (&R)[2], const int (&C)[2], unsigned (&off)[2][2]) const {
#pragma unroll
        for (int h = 0; h < 2; ++h)
#pragma unroll
            for (int i = 0; i < 2; ++i) { const int t = tok[u.pm * 256 + h * 128 + R[i]]; off[h][i] = (unsigned)(t * lda + C[i]) * 2u; } }
    __device__ __forceinline__ void a_tok(const Unit& u, const int (&R)[2], int (&tk)[2][2]) const {
#pragma unroll
        for (int h = 0; h < 2; ++h)
#pragma unroll
            for (int i = 0; i < 2; ++i) tk[h][i] = tok[u.pm * 256 + h * 128 + R[i]]; }
    __device__ __forceinline__ void a_off(const int (&tk)[2][2], const int (&C)[2], unsigned (&off)[2][2]) const {
#pragma unroll
        for (int h = 0; h < 2; ++h)
#pragma unroll
            for (int i = 0; i < 2; ++i) off[h][i] = (unsigned)(tk[h][i] * lda + C[i]) * 2u; }
};
struct ProbMoe2 {
    static constexpr bool GATHER = false, FP8 = true; static constexpr int SCALE_A = F8E_ACT, SCALE_B = F8E_WDN; const bf16_t* A; const bf16_t* Bt; int lda, ldb; const LAS int* seg;
    __device__ __forceinline__ int nt(const Unit&) const { return lda / 64; }
    __device__ __forceinline__ const char* a_base(const Unit& u) const { return (const char*)A + (size_t)u.pm * 256 * lda * 2; }
    __device__ __forceinline__ const char* b_base(const Unit& u) const { const int e = expert_of(seg, u.pm); return (const char*)Bt + ((size_t)e * 1024 + (size_t)u.pn * 256) * ldb * 2; }
    __device__ __forceinline__ void a_tok(const Unit&, const int (&)[2], int (&)[2][2]) const {}
    __device__ __forceinline__ void a_off(const int (&)[2][2], const int (&)[2], unsigned (&)[2][2]) const {}
    __device__ __forceinline__ void a_rows(const Unit&, const int (&)[2], const int (&)[2], unsigned (&)[2][2]) const {}
};
using pg8::cvt_pk_bf16;
template <bool G8> struct EpiInproj {
    static constexpr bool PERM = true, CHAIN = false, SIDE = true, KHOOK = false; bf16_t* Z; const float* bias; int pn0;
    __device__ __forceinline__ void side(const Unit& u0, unsigned slot, int wid, int lane) const { const int pn = u0.pn + pn0; if (wid == 1) pg8::dma16((unsigned)lane * 16u, bias + pn * 256 + (pn >= 9 ? 16 : 0), slot); }
    __device__ __forceinline__ void operator()(const f32x4 (&acc)[2][2][4][2], const Unit& u0, int wr, int wc, int fr, int fq, const LAS unsigned char* sd) const {
        Unit u = u0; u.pn += pn0;
        int row0 = u.pm * 256 + wr * 64 + fr, col0 = u.pn * 256 + wc * 32 + 8 * fq; asm volatile("" : "+v"(row0), "+v"(col0));
        const int act = (u.pn <= 6) ? 0 : ((u.pn == 9 || u.pn == 10) ? 2 : 1);
        f32x4 bv[2][2];
#pragma unroll
        for (int bj = 0; bj < 2; ++bj)
#pragma unroll
            for (int n = 0; n < 2; ++n) bv[bj][n] = *(const LAS f32x4*)(sd + (bj * 128 + wc * 32 + 8 * fq + 4 * n) * 4);
#pragma unroll
        for (int ai = 0; ai < 2; ++ai)
#pragma unroll
            for (int m = 0; m < 4; ++m) { bf16_t* rowp = Z + (size_t)(row0 + ai * 128 + m * 16) * NZ + col0;
#pragma unroll
                for (int bj = 0; bj < 2; ++bj) { f32x4 v0 = acc[ai][bj][m][0] + bv[bj][0], v1 = acc[ai][bj][m][1] + bv[bj][1];
                    if (G8 && u.pn >= ZG_COL / 256) { u32x2 w8;
                        v0 = sigmoid4(v0) * G8_SCALE; v1 = sigmoid4(v1) * G8_SCALE;
#pragma unroll
                        for (int j = 0; j < 4; ++j) { v0[j] = fmaxf(v0[j], 1.0f); v1[j] = fmaxf(v1[j], 1.0f); }
                        v0 = v0 + 12582912.0f; v1 = v1 + 12582912.0f;
                        w8.x = pk4_u8(v0[0], v0[1], v0[2], v0[3]); w8.y = pk4_u8(v1[0], v1[1], v1[2], v1[3]);
                        *(u32x2*)((unsigned char*)(Z + (size_t)(row0 + ai * 128 + m * 16) * NZ + ZG_COL) + (col0 - ZG_COL) + bj * 128) = w8; continue; }
                    if (act == 2) { f32x2 a = pg8::gelu_pk((f32x2){v0[0], v0[1]}), b = pg8::gelu_pk((f32x2){v0[2], v0[3]}), c = pg8::gelu_pk((f32x2){v1[0], v1[1]}), d = pg8::gelu_pk((f32x2){v1[2], v1[3]});
                        v0 = (f32x4){a.x, a.y, b.x, b.y}; v1 = (f32x4){c.x, c.y, d.x, d.y}; }
                    if (act == 1) { v0 = sigmoid4(v0); v1 = sigmoid4(v1); }
                    u32x4 w; w.x = cvt_pk_bf16(v0[0], v0[1]); w.y = cvt_pk_bf16(v0[2], v0[3]); w.z = cvt_pk_bf16(v1[0], v1[1]); w.w = cvt_pk_bf16(v1[2], v1[3]);
                    *(u32x4*)(rowp + bj * 128) = w; }
                if constexpr (G8) asm volatile("" ::: "memory"); }
    }
};
struct EpiNull {
    static constexpr bool PERM = true, CHAIN = false; bf16_t* Z;
    __device__ __forceinline__ void operator()(const f32x4 (&acc)[2][2][4][2], const Unit& u, int wr, int wc, int fr, int fq) const {
        float sacc = 0.f;
#pragma unroll
        for (int ai = 0; ai < 2; ++ai)
#pragma unroll
            for (int bj = 0; bj < 2; ++bj)
#pragma unroll
                for (int m = 0; m < 4; ++m)
#pragma unroll
                    for (int n = 0; n < 2; ++n) sacc += (acc[ai][bj][m][n][0] + acc[ai][bj][m][n][1]) + (acc[ai][bj][m][n][2] + acc[ai][bj][m][n][3]);
        if (sacc == 1.2345e30f) Z[u.pm + wr + wc + fr + fq] = 0;
    }
};
struct EpiOut {
    static constexpr bool PERM = true, CHAIN = false, SIDE = false, KHOOK = false; bf16_t* T;
    __device__ __forceinline__ void operator()(const f32x4 (&acc)[2][2][4][2], const Unit& u, int wr, int wc, int fr, int fq, const LAS unsigned char*) const {
        int row0 = u.pm * 256 + wr * 64 + fr, col0 = u.pn * 256 + wc * 32 + 8 * fq; asm volatile("" : "+v"(row0), "+v"(col0));
#pragma unroll
        for (int ai = 0; ai < 2; ++ai)
#pragma unroll
            for (int m = 0; m < 4; ++m) { bf16_t* rowp = T + (size_t)(row0 + ai * 128 + m * 16) * D + col0;
#pragma unroll
                for (int bj = 0; bj < 2; ++bj) { const f32x4 v0 = acc[ai][bj][m][0], v1 = acc[ai][bj][m][1];
                    u32x4 w; w.x = cvt_pk_bf16(v0[0], v0[1]); w.y = cvt_pk_bf16(v0[2], v0[3]); w.z = cvt_pk_bf16(v1[0], v1[1]); w.w = cvt_pk_bf16(v1[2], v1[3]);
                    *(u32x4*)(rowp + bj * 128) = w; } }
    }
};
struct EpiBranch {
    static constexpr bool PERM = true, CHAIN = false, SIDE = false, KHOOK = true; static constexpr int HOOK_T0 = 4, HOOK_T1 = 12;
    const bf16_t* Z; bf16_t* Y;
    template <bool FIN> __device__ __forceinline__ void apply(f32x4 (&acc)[2][2][4][2], const Unit& u, int br, int wr, int wc, int fr, int fq) const {
        int row0 = u.pm * 256 + wr * 64 + fr, col0 = u.pn * 256 + wc * 32 + 8 * fq;
        asm volatile("" : "+v"(row0), "+v"(col0));
#pragma unroll
        for (int ai = 0; ai < 2; ++ai) {
            u32x2 ga[4][2], gb[4][2];
#pragma unroll
            for (int m = 0; m < 4; ++m) { const unsigned char* rowp = (const unsigned char*)(Z + (size_t)(row0 + ai * 128 + m * 16) * NZ + ZG_COL) + br * 1024 + col0;
#pragma unroll
                for (int bj = 0; bj < 2; ++bj) { ga[m][bj] = *(const u32x2*)(rowp + bj * 128); if (!FIN) gb[m][bj] = *(const u32x2*)(rowp + 1024 + bj * 128); } }
#pragma unroll
            for (int m = 0; m < 4; ++m) { const size_t row = (size_t)(row0 + ai * 128 + m * 16);
#pragma unroll
                for (int bj = 0; bj < 2; ++bj) { const u32x2 a = ga[m][bj];
                    f32x4 r0 = u8x4_f32(a.x), r1 = u8x4_f32(a.y);
                    if (FIN) { r0 = r0 * (1.0f / G8_SCALE); r1 = r1 * (1.0f / G8_SCALE); }
                    else { const u32x2 b = gb[m][bj]; f32x4 q0 = u8x4_f32(b.x), q1 = u8x4_f32(b.y);
#pragma unroll
                        for (int i = 0; i < 4; ++i) { q0[i] = __builtin_amdgcn_rcpf(q0[i]); q1[i] = __builtin_amdgcn_rcpf(q1[i]); }
                        r0 = r0 * q0; r1 = r1 * q1; }
                    acc[ai][bj][m][0] = acc[ai][bj][m][0] * r0; acc[ai][bj][m][1] = acc[ai][bj][m][1] * r1;
                    if (FIN) { const f32x4 v0 = acc[ai][bj][m][0], v1 = acc[ai][bj][m][1];
                        u32x4 w; w.x = cvt_pk_bf16(v0[0], v0[1]); w.y = cvt_pk_bf16(v0[2], v0[3]); w.z = cvt_pk_bf16(v1[0], v1[1]); w.w = cvt_pk_bf16(v1[2], v1[3]);
                        *(u32x4*)(Y + row * D + col0 + bj * 128) = w; } } }
            asm volatile("" ::: "memory"); }
    }
    __device__ __forceinline__ void hook(f32x4 (&acc)[2][2][4][2], const Unit& u, int br, int wr, int wc, int fr, int fq) const { apply<false>(acc, u, br, wr, wc, fr, fq); }
    __device__ __forceinline__ void operator()(f32x4 (&acc)[2][2][4][2], const Unit& u, int wr, int wc, int fr, int fq, const LAS unsigned char*) const { apply<true>(acc, u, 2, wr, wc, fr, fq); }
};
struct EpiSwiglu {
    static constexpr bool PERM = true, CHAIN = false, SIDE = true, KHOOK = false; unsigned char* HID; const float* bgu; const LAS int* seg;
    __device__ __forceinline__ void side(const Unit& u, unsigned slot, int wid, int lane) const {
        if (wid == 1) { const int e = expert_of(seg, u.pm); pg8::dma16(lane < 32 ? (unsigned)lane * 16u : 4096u + (unsigned)(lane - 32) * 16u, bgu + (size_t)e * 2048 + u.pn * 128, slot); } }
    __device__ __forceinline__ void operator()(const f32x4 (&acc)[2][2][4][2], const Unit& u, int wr, int wc, int fr, int fq, const LAS unsigned char* sd) const {
        int j0 = u.pn * 128 + wc * 32 + 8 * fq, slot0 = u.pm * 256 + wr * 64 + fr; asm volatile("" : "+v"(j0), "+v"(slot0));
        f32x4 bg[2], bu[2];
#pragma unroll
        for (int n = 0; n < 2; ++n) { bg[n] = *(const LAS f32x4*)(sd + (wc * 32 + 8 * fq + 4 * n) * 4); bu[n] = *(const LAS f32x4*)(sd + (128 + wc * 32 + 8 * fq + 4 * n) * 4); }
#pragma unroll
        for (int ai = 0; ai < 2; ++ai)
#pragma unroll
            for (int m = 0; m < 4; ++m) { const size_t slot = (size_t)(slot0 + ai * 128 + m * 16); f32x4 o[2];
#pragma unroll
                for (int n = 0; n < 2; ++n) { f32x4 g = acc[ai][0][m][n] + bg[n], up = acc[ai][1][m][n] + bu[n];
#pragma unroll
                    for (int i = 0; i < 4; ++i) { g[i] = fminf(g[i], 7.0f); up[i] = __builtin_amdgcn_fmed3f(up[i], -7.0f, 7.0f); }
                    f32x4 t = g * (-1.702f * 1.4426950408889634f);
#pragma unroll
                    for (int i = 0; i < 4; ++i) t[i] = __builtin_amdgcn_exp2f(t[i]);
                    t = t + 1.0f;
#pragma unroll
                    for (int i = 0; i < 4; ++i) t[i] = __builtin_amdgcn_rcpf(t[i]);
                    o[n] = (up * F8S_ACT + F8S_ACT) * (g * t); }
                u32x2 w; w.x = pk4_fp8(o[0][0], o[0][1], o[0][2], o[0][3]); w.y = pk4_fp8(o[1][0], o[1][1], o[1][2], o[1][3]);
                *(u32x2*)(HID + slot * 1024 + j0) = w; }
    }
};
struct EpiDown {
    static constexpr bool PERM = true, CHAIN = false, SIDE = true, KHOOK = false; unsigned char* FS; const float* bdn; const int* dest; const float* pslot; const LAS int* seg;
    __device__ __forceinline__ void side(const Unit& u, unsigned slot, int wid, int lane) const {
        if (wid == 1) { const int e = expert_of(seg, u.pm); pg8::dma16((unsigned)lane * 16u, bdn + (size_t)e * 1024 + u.pn * 256, slot); }
        if (wid == 2) pg8::dma16((unsigned)lane * 16u, dest + (size_t)u.pm * 256, slot + 1024u);
        if (wid == 3) pg8::dma16((unsigned)lane * 16u, pslot + (size_t)u.pm * 256, slot + 2048u); }
    __device__ __forceinline__ void operator()(const f32x4 (&acc)[2][2][4][2], const Unit& u, int wr, int wc, int fr, int fq, const LAS unsigned char* sd) const {
        int col0 = u.pn * 256 + wc * 32 + 8 * fq, slot0 = u.pm * 256 + wr * 64 + fr; asm volatile("" : "+v"(col0), "+v"(slot0));
        f32x4 bv[2][2];
#pragma unroll
        for (int bj = 0; bj < 2; ++bj)
#pragma unroll
            for (int n = 0; n < 2; ++n) bv[bj][n] = *(const LAS f32x4*)(sd + (bj * 128 + wc * 32 + 8 * fq + 4 * n) * 4);
#pragma unroll
        for (int ai = 0; ai < 2; ++ai)
#pragma unroll
            for (int m = 0; m < 4; ++m) { const int rt = ai * 128 + wr * 64 + m * 16 + fr; const int d = *(const LAS int*)(sd + 1024 + rt * 4); const float p = *(const LAS float*)(sd + 2048 + rt * 4) * FS_SCALE;
                if (d >= 0) {
#pragma unroll
                    for (int bj = 0; bj < 2; ++bj) { f32x4 v0 = (acc[ai][bj][m][0] + bv[bj][0]) * p, v1 = (acc[ai][bj][m][1] + bv[bj][1]) * p;
#pragma unroll
                        for (int i = 0; i < 4; ++i) { v0[i] = __builtin_amdgcn_fmed3f(v0[i], -FS_CLAMP, FS_CLAMP); v1[i] = __builtin_amdgcn_fmed3f(v1[i], -FS_CLAMP, FS_CLAMP); }
                        u32x2 w; w.x = pk4_fp8(v0[0], v0[1], v0[2], v0[3]); w.y = pk4_fp8(v1[0], v1[1], v1[2], v1[3]);
                        *(u32x2*)(FS + (size_t)d * 1024 + col0 + bj * 128) = w; } }
                asm volatile("" ::: "memory"); }
    }
};

__device__ __forceinline__ const float* xin_row(const Frame& F, int row) { return row < ML ? F.in[IN_X] + (size_t)row * D : F.in[IN_CTX] + (size_t)(row - ML) * D; }
__device__ __forceinline__ void phase_ln0_first(Frame& F) {
    int t_lo, t_hi; tile_range(F, MT, t_lo, t_hi);
    const int r_lo = 32 * t_lo, nrows = 32 * (t_hi - t_lo);
    const int mrA = mod_row(r_lo), mrB = mod_row(r_lo + (nrows > 0 ? nrows - 1 : 0));
    { const float* mb = (const float*)(F.ws + WS_MOD); pv_fill(F, 0, mb + ((size_t)(0 * 17 + mrA) * 6 + 0) * 1024); pv_fill(F, 1, mb + ((size_t)(0 * 17 + mrB) * 6 + 0) * 1024);
      pv_fill(F, 2, mb + ((size_t)(0 * 17 + mrA) * 6 + 1) * 1024); pv_fill(F, 3, mb + ((size_t)(0 * 17 + mrB) * 6 + 1) * 1024); }
    load_wg_lds(F, 0);
    for (int n = F.wave; n < nrows; n += 4 * NWAVES) {
        RowV rv[4];
#pragma unroll
        for (int u = 0; u < 4; ++u) if (n + u * NWAVES < nrows) row_load(rv[u], xin_row(F, r_lo + n + u * NWAVES), F.lane);
#pragma unroll
        for (int u = 0; u < 4; ++u) if (n + u * NWAVES < nrows) { const int row = r_lo + n + u * NWAVES;
            const int sel = (mod_row(row) == mrA) ? 0 : 1; ln0_row(F, row, rv[u], pv_slot(F, 0 + sel), pv_slot(F, 2 + sel)); }
    }
    gates_tail(F, 0, t_lo, t_hi);
    __syncthreads();
}
__device__ __forceinline__ void phase_finalize(Frame& F, int l, int mrows) {
    const int gw = F.bid * NWAVES + F.wave, NGW = F.G * NWAVES;
    const bf16_t* hf = (const bf16_t*)(F.ws + WS_HFB); const bf16_t* hb = hf + (size_t)MT * 512;
    const float* ng = F.in[IN_MNG] + l * 512 + 8 * F.lane;
    const f32x4 g0 = *(const f32x4*)ng, g1 = *(const f32x4*)(ng + 4);
    const bf16_t* zo = (const bf16_t*)(F.ws + WS_Z) + ZC_O + 8 * F.lane;
    u32x4 ha = (u32x4){0u, 0u, 0u, 0u}, hbv = ha, so = ha;
    if (gw < mrows) { ha = __builtin_nontemporal_load((const u32x4*)(hf + (size_t)gw * 512 + 8 * F.lane)); hbv = __builtin_nontemporal_load((const u32x4*)(hb + (size_t)gw * 512 + 8 * F.lane)); so = __builtin_nontemporal_load((const u32x4*)(zo + (size_t)gw * NZ)); }
    for (int row = gw; row < mrows; row += NGW) {
        u32x4 han = ha, hbn = hbv, son = so; const int rn = row + NGW;
        if (rn < mrows) { han = __builtin_nontemporal_load((const u32x4*)(hf + (size_t)rn * 512 + 8 * F.lane)); hbn = __builtin_nontemporal_load((const u32x4*)(hb + (size_t)rn * 512 + 8 * F.lane)); son = __builtin_nontemporal_load((const u32x4*)(zo + (size_t)rn * NZ)); }
        __builtin_amdgcn_sched_barrier(0);
        f32x4 v0 = (f32x4){bflo(ha.x) + bflo(hbv.x), bfhi(ha.x) + bfhi(hbv.x), bflo(ha.y) + bflo(hbv.y), bfhi(ha.y) + bfhi(hbv.y)}, v1 = (f32x4){bflo(ha.z) + bflo(hbv.z), bfhi(ha.z) + bfhi(hbv.z), bflo(ha.w) + bflo(hbv.w), bfhi(ha.w) + bfhi(hbv.w)};
        float s = (v0.x + v0.y) + (v0.z + v0.w) + (v1.x + v1.y) + (v1.z + v1.w);
#pragma unroll
        for (int o = 1; o < 16; o <<= 1) s += shx(s, o, F.lane);
        const float mu = s * (1.f / 128.f); v0 = v0 - mu; v1 = v1 - mu;
        float q = (v0.x * v0.x + v0.y * v0.y) + (v0.z * v0.z + v0.w * v0.w) + (v1.x * v1.x + v1.y * v1.y) + (v1.z * v1.z + v1.w * v1.w);
#pragma unroll
        for (int o = 1; o < 16; o <<= 1) q += shx(q, o, F.lane);
        const float rstd = 1.f / sqrtf(q * (1.f / 128.f) + HEAD_EPS);
        v0 = v0 * rstd * g0; v1 = v1 * rstd * g1;
        u32x4 w; w.x = pk2(v0.x * bflo(so.x), v0.y * bfhi(so.x)); w.y = pk2(v0.z * bflo(so.y), v0.w * bfhi(so.y)); w.z = pk2(v1.x * bflo(so.z), v1.y * bfhi(so.z)); w.w = pk2(v1.z * bflo(so.w), v1.w * bfhi(so.w));
        *(u32x4*)((bf16_t*)(F.ws + WS_BRA) + (size_t)row * D + 256 + 8 * F.lane) = w;
        ha = han; hbv = hbn; so = son;
    }
}
__device__ __forceinline__ void phase_ln1_router(Frame& F, int l, int mrows) {
    LAS int* cnt = (LAS int*)(F.lds + NW_END);
    { const float* wr = F.in[IN_WR] + (size_t)l * D * NEXP;
      for (int i = F.tid; i < NEXP * D; i += NTHREADS) { const int k = i >> 5, e = i & 31; *(LAS bf16_t*)(F.lds + NW_WT + e * 2064 + k * 2) = (bf16_t)f2bf(wr[i]); }
      if (F.tid < NEXP) cnt[F.tid] = 0; }
    const float* brt = F.in[IN_BR] + l * NEXP;
    int t_lo, t_hi; tile_range(F, mrows, t_lo, t_hi);
    const int r_lo = 32 * t_lo, nrows = 32 * (t_hi - t_lo);
    const int mrA = mod_row(r_lo), mrB = mod_row(r_lo + (nrows > 0 ? nrows - 1 : 0));
    { const float* mb = (const float*)(F.ws + WS_MOD); pv_fill(F, 0, F.in[IN_LN1G] + l * D); pv_fill(F, 1, F.in[IN_LN1B] + l * D);
      pv_fill(F, 2, mb + ((size_t)(l * 17 + mrA) * 6 + 2) * 1024); pv_fill(F, 3, mb + ((size_t)(l * 17 + mrB) * 6 + 2) * 1024);
      pv_fill(F, 4, mb + ((size_t)(l * 17 + mrA) * 6 + 3) * 1024); pv_fill(F, 5, mb + ((size_t)(l * 17 + mrB) * 6 + 3) * 1024);
      pv_fill(F, 6, mb + ((size_t)(l * 17 + mrA) * 6 + 4) * 1024); pv_fill(F, 7, mb + ((size_t)(l * 17 + mrB) * 6 + 4) * 1024); }
    __syncthreads();
    { const bf16_t* yb = (const bf16_t*)(F.ws + WS_T) + 8 * F.lane;
      RowV rv[2]; u32x4 yv2[2][2];
#pragma unroll
      for (int u = 0; u < 2; ++u) {
#pragma unroll
          for (int j = 0; j < 4; ++j) rv[u].v[j] = (f32x4){0.f, 0.f, 0.f, 0.f};
          yv2[u][0] = yv2[u][1] = (u32x4){0u, 0u, 0u, 0u}; }
#define RT_LOADPAIR(n_, rv_, yv_) do { _Pragma("unroll") for (int u = 0; u < 2; ++u) if ((n_) + u * NWAVES < nrows) { const int row = r_lo + (n_) + u * NWAVES; \
              if (l == 0) row_load(rv_[u], xin_row(F, row), F.lane); else row_load_bf16(rv_[u], (const bf16_t*)(F.ws + WS_X) + (size_t)row * D, F.lane); \
              _Pragma("unroll") for (int h = 0; h < 2; ++h) yv_[u][h] = __builtin_nontemporal_load((const u32x4*)(yb + (size_t)row * D + 512 * h)); } } while (0)
      RT_LOADPAIR(F.wave, rv, yv2);
      for (int n = F.wave; n < nrows; n += 2 * NWAVES) {
          RowV rvn[2]; u32x4 yvn[2][2];
#pragma unroll
          for (int u = 0; u < 2; ++u) { rvn[u] = rv[u]; yvn[u][0] = yv2[u][0]; yvn[u][1] = yv2[u][1]; }
          RT_LOADPAIR(n + 2 * NWAVES, rvn, yvn);
          __builtin_amdgcn_sched_barrier(0);
#pragma unroll
          for (int u = 0; u < 2; ++u) if (n + u * NWAVES < nrows) { const int row = r_lo + n + u * NWAVES; RowV cur = rv[u];
              const int sel = (mod_row(row) == mrA) ? 0 : 1;
              { const LAS float* g1 = pv_slot(F, 2 + sel);
#pragma unroll
                for (int j = 0; j < 4; ++j) { const f32x4 gg = *(const LAS f32x4*)(g1 + RC(F.lane, j)); const u32x4 yw = yv2[u][j >> 1]; const f32x4 yv = (j & 1) ? (f32x4){bflo(yw.z), bfhi(yw.z), bflo(yw.w), bfhi(yw.w)} : (f32x4){bflo(yw.x), bfhi(yw.x), bflo(yw.y), bfhi(yw.y)}; cur.v[j] = cur.v[j] * DN_ALPHA + gg * yv; } }
              row_ln_plain(cur, F.lane); row_affine_l(cur, pv_slot(F, 0), pv_slot(F, 1), F.lane);
              row_store_bf16_nt(cur, (bf16_t*)(F.ws + WS_X) + (size_t)row * D, F.lane);
              row_ln_plain(cur, F.lane); row_modulate_l(cur, pv_slot(F, 4 + sel), pv_slot(F, 6 + sel), F.lane);
              row_store_bf16(cur, (bf16_t*)(F.ws + WS_H2) + (size_t)row * D, F.lane);
              { unsigned char* h8 = (unsigned char*)(F.ws + WS_H2F8) + (size_t)row * D + 8 * F.lane;
#pragma unroll
                for (int h = 0; h < 2; ++h) { u32x2 w; w.x = pk4_fp8(cur.v[2 * h].x * F8S_ACT, cur.v[2 * h].y * F8S_ACT, cur.v[2 * h].z * F8S_ACT, cur.v[2 * h].w * F8S_ACT); w.y = pk4_fp8(cur.v[2 * h + 1].x * F8S_ACT, cur.v[2 * h + 1].y * F8S_ACT, cur.v[2 * h + 1].z * F8S_ACT, cur.v[2 * h + 1].w * F8S_ACT); *(u32x2*)(h8 + 512 * h) = w; } } }
#pragma unroll
          for (int u = 0; u < 2; ++u) { rv[u] = rvn[u]; yv2[u][0] = yvn[u][0]; yv2[u][1] = yvn[u][1]; }
      }
#undef RT_LOADPAIR
    }
    asm volatile("s_waitcnt vmcnt(0)" ::: "memory"); __syncthreads();
    for (int tile = t_lo + F.wave; tile < t_hi; tile += NWAVES) {
        const LAS float* lgw = narrow_tile_wave(F, (const bf16_t*)(F.ws + WS_H2) + (size_t)tile * 32 * D);
        if (F.lane < 32) {
            const LAS float* lgp = lgw + F.lane * 33; const int row = tile * 32 + F.lane;
            float lg[NEXP];
#pragma unroll
            for (int e = 0; e < NEXP; ++e) lg[e] = lgp[e] + brt[e];
            unsigned used = 0u; float bv[4]; int bi[4];
#pragma unroll
            for (int k = 0; k < 4; ++k) { float best = -3.0e38f; int idx = 0;
#pragma unroll
                for (int e = 0; e < NEXP; ++e) { const bool take = (((used >> e) & 1u) == 0u) && (lg[e] > best); best = take ? lg[e] : best; idx = take ? e : idx; }
                used |= 1u << idx; bv[k] = best; bi[k] = idx; }
            const float e1 = __expf(bv[1] - bv[0]), e2 = __expf(bv[2] - bv[0]), e3 = __expf(bv[3] - bv[0]); const float inv = __builtin_amdgcn_rcpf(1.0f + e1 + e2 + e3);
            int* ei = (int*)(F.ws + WS_ROUTE + RT_EIDX) + (size_t)row * 4; float* pr = (float*)(F.ws + WS_ROUTE + RT_PROB) + (size_t)row * 4;
            *(int4*)ei = make_int4(bi[0], bi[1], bi[2], bi[3]); *(f32x4*)pr = (f32x4){inv, e1 * inv, e2 * inv, e3 * inv};
            atomicAdd((int*)&cnt[bi[0]], 1); atomicAdd((int*)&cnt[bi[1]], 1); atomicAdd((int*)&cnt[bi[2]], 1); atomicAdd((int*)&cnt[bi[3]], 1);
        }
        asm volatile("s_waitcnt lgkmcnt(0)" ::: "memory");
    }
    __syncthreads();
    if (F.tid < NEXP) ((int*)(F.ws + WS_ROUTE + RT_CNT))[F.bid * NEXP + F.tid] = cnt[F.tid];
    __syncthreads();
}
__device__ __forceinline__ void phase_slots(Frame& F, int mrows) {
    LAS int* part = (LAS int*)F.lds;
    LAS int* pre = part + 1024;
    LAS int* tot = pre + 32;
    LAS int* seg = tot + 32;
    LAS int* gcnt = seg + 64;
    LAS int* eix = gcnt + 2048;
    LAS int* rnk = eix + 4096;
    const int* cntg = (const int*)(F.ws + WS_ROUTE + RT_CNT);
    int* tokg = (int*)(F.ws + WS_ROUTE + RT_TOK); int* destg = (int*)(F.ws + WS_ROUTE + RT_DEST); float* psl = (float*)(F.ws + WS_ROUTE + RT_PSLOT);
    int t_lo, t_hi; tile_range(F, mrows, t_lo, t_hi);
    const int row_base = t_lo * 32, nent = (t_hi - t_lo) * 128, ngrp = nent / 64;
    { const int e = F.tid & 31, pt = F.tid >> 5; int a = 0, b = 0;
      for (int c = pt; c < F.G; c += 16) { const int v = cntg[c * NEXP + e]; b += v; a += (c < F.bid) ? v : 0; }
      part[pt * 32 + e] = a; part[512 + pt * 32 + e] = b; }
    for (int i = F.tid; i < nent; i += NTHREADS) eix[i] = ((const int*)(F.ws + WS_ROUTE + RT_EIDX))[(size_t)row_base * 4 + i];
    __syncthreads();
    if (F.tid < NEXP) { int a = 0, b = 0;
#pragma unroll
        for (int pt = 0; pt < 16; ++pt) { a += part[pt * 32 + F.tid]; b += part[512 + pt * 32 + F.tid]; }
        pre[F.tid] = a; tot[F.tid] = b; }
    for (int g = F.wave; g < ngrp; g += NWAVES) {
        const int e = eix[g * 64 + F.lane]; int rank = 0, mycnt = 0;
#pragma unroll 4
        for (int ee = 0; ee < NEXP; ++ee) { const unsigned long long m = __ballot(e == ee); if (e == ee) rank = __popcll(m & ((1ull << F.lane) - 1ull)); if (F.lane == ee) mycnt = __popcll(m); }
        rnk[g * 64 + F.lane] = rank; if (F.lane < NEXP) gcnt[g * 32 + F.lane] = mycnt; }
    __syncthreads();
    if (F.tid == 0) { int s = 0; for (int e = 0; e < NEXP; ++e) { seg[e] = s; s += (tot[e] + 255) & ~255; } seg[NEXP] = s; }
    if (F.tid >= 64 && F.tid < 64 + NEXP) { const int e = F.tid - 64; int run = 0; for (int g = 0; g < ngrp; ++g) { const int c = gcnt[g * 32 + e]; gcnt[g * 32 + e] = run; run += c; } }
    __syncthreads();
    { const float* prg = (const float*)(F.ws + WS_ROUTE + RT_PROB) + (size_t)row_base * 4;
      for (int i = F.tid; i < nent; i += NTHREADS) { const int e = eix[i]; const int slot = seg[e] + pre[e] + gcnt[(i >> 6) * 32 + e] + rnk[i];
          tokg[slot] = row_base + (i >> 2); destg[slot] = row_base * 4 + i; psl[slot] = prg[i]; } }
    if (F.bid < NEXP) { const int e = F.bid; for (int sl = seg[e] + tot[e] + F.tid; sl < seg[e + 1]; sl += NTHREADS) { tokg[sl] = 0; destg[sl] = -1; psl[sl] = 0.f; } }
    if (F.bid == 0 && F.tid <= NEXP) ((int*)(F.ws + WS_ROUTE + RT_SEG))[F.tid] = seg[F.tid];
    __syncthreads();
}
struct CombRaw { u32x4 x[2]; u32x2 f[2][4]; };
__device__ __forceinline__ void comb_load(const Frame& F, int row, CombRaw& r) {
    { const bf16_t* xp = (const bf16_t*)(F.ws + WS_X) + (size_t)row * D + 8 * F.lane;
#pragma unroll
      for (int h = 0; h < 2; ++h) r.x[h] = __builtin_nontemporal_load((const u32x4*)(xp + 512 * h)); }
    const unsigned char* fs = (const unsigned char*)(F.ws + WS_FS) + (size_t)row * 4 * 1024 + 8 * F.lane;
#pragma unroll
    for (int h = 0; h < 2; ++h)
#pragma unroll
        for (int k = 0; k < 4; ++k) r.f[h][k] = __builtin_nontemporal_load((const u32x2*)(fs + k * 1024 + 512 * h));
}
__device__ __forceinline__ void phase_combine_ln2(Frame& F, int l, int mrows) {
    const bool lastl = (l == DEPTH - 1);
    int t_lo, t_hi; tile_range(F, mrows, t_lo, t_hi);
    const int r_lo = 32 * t_lo, nrows = 32 * (t_hi - t_lo);
    const int mrA = mod_row(r_lo), mrB = mod_row(r_lo + (nrows > 0 ? nrows - 1 : 0));
    { const float* mb = (const float*)(F.ws + WS_MOD); const int ln = lastl ? l : l + 1; pv_fill(F, 0, F.in[IN_LN2G] + l * D); pv_fill(F, 1, F.in[IN_LN2B] + l * D);
      pv_fill(F, 2, mb + ((size_t)(l * 17 + mrA) * 6 + 5) * 1024); pv_fill(F, 3, mb + ((size_t)(l * 17 + mrB) * 6 + 5) * 1024);
      pv_fill(F, 4, mb + ((size_t)(ln * 17 + mrA) * 6 + 0) * 1024); pv_fill(F, 5, mb + ((size_t)(ln * 17 + mrB) * 6 + 0) * 1024);
      pv_fill(F, 6, mb + ((size_t)(ln * 17 + mrA) * 6 + 1) * 1024); pv_fill(F, 7, mb + ((size_t)(ln * 17 + mrB) * 6 + 1) * 1024); }
    if (!lastl) load_wg_lds(F, l + 1); else __syncthreads();
    for (int n = F.wave; n < nrows; n += 2 * NWAVES) {
        CombRaw rw[2];
#pragma unroll
        for (int u = 0; u < 2; ++u) if (n + u * NWAVES < nrows) comb_load(F, r_lo + n + u * NWAVES, rw[u]);
#pragma unroll
        for (int u = 0; u < 2; ++u) if (n + u * NWAVES < nrows) { const int row = r_lo + n + u * NWAVES;
            const int sel = (mod_row(row) == mrA) ? 0 : 1;
            const LAS float* g2 = pv_slot(F, 2 + sel);
            RowV x;
#pragma unroll
            for (int h = 0; h < 2; ++h) { const u32x4 w = rw[u].x[h]; x.v[2 * h] = (f32x4){bflo(w.x), bfhi(w.x), bflo(w.y), bfhi(w.y)}; x.v[2 * h + 1] = (f32x4){bflo(w.z), bfhi(w.z), bflo(w.w), bfhi(w.w)}; }
#pragma unroll
            for (int j = 0; j < 4; ++j) { f32x4 f = (f32x4){0.f, 0.f, 0.f, 0.f};
#pragma unroll
                for (int k = 0; k < 4; ++k) { const u32x2 w2 = rw[u].f[j >> 1][k]; const int wd = (int)((j & 1) ? w2.y : w2.x);
                    const f32x2 lo = __builtin_amdgcn_cvt_pk_f32_fp8(wd, false), hi = __builtin_amdgcn_cvt_pk_f32_fp8(wd, true); f[0] += lo[0]; f[1] += lo[1]; f[2] += hi[0]; f[3] += hi[1]; }
                const f32x4 gg = *(const LAS f32x4*)(g2 + RC(F.lane, j)) * (1.0f / FS_SCALE);
                x.v[j] = x.v[j] * DN_ALPHA + gg * f; }
            row_ln_plain(x, F.lane); row_affine_l(x, pv_slot(F, 0), pv_slot(F, 1), F.lane);
            if (lastl) { row_store_nt(x, F.out + (size_t)row * D, F.lane); }
            else { row_store_bf16_nt(x, (bf16_t*)(F.ws + WS_X) + (size_t)row * D, F.lane); ln0_row(F, row, x, pv_slot(F, 4 + sel), pv_slot(F, 6 + sel)); } }
    }
    if (!lastl) gates_tail(F, l + 1, t_lo, t_hi);
    __syncthreads();
}

#define MFMA32(a, b, c) __builtin_amdgcn_mfma_f32_32x32x16_bf16((a), (b), (c), 0, 0, 0)
#define MFMA16(a, b, c) __builtin_amdgcn_mfma_f32_16x16x32_bf16((a), (b), (c), 0, 0, 0)
__device__ __forceinline__ f32x16 zero16() { f32x16 z;
#pragma unroll
    for (int i = 0; i < 16; ++i) z[i] = 0.f;
    return z; }
__device__ __forceinline__ void pool_tiles(Frame& F, int l, bool with_ctx) {
    LAS unsigned char* Pin = F.lds;
    LAS unsigned char* Dm = F.lds + 40960;
    const bf16_t* Z = (const bf16_t*)(F.ws + WS_Z);
    const bf16_t* Wp = (const bf16_t*)(F.ws + WS_WPOOL) + (size_t)l * 4 * 4096;
    const float* psc = F.in[IN_POOLS] + l * 256;
    bf16_t* BRA = (bf16_t*)(F.ws + WS_BRA);
    const int ntiles = with_ctx ? 1088 : 1024;
    const int r = F.lane & 31, h = F.lane >> 5;
    bf16x8 wa[2][4]; f32x4 scv[2][4];
#pragma unroll
    for (int qi = 0; qi < 2; ++qi) { const int q = F.wave + 8 * qi, g = q >> 2, td = (q >> 1) & 1;
#pragma unroll
        for (int ks = 0; ks < 4; ++ks) wa[qi][ks] = *(const bf16x8*)(Wp + ((size_t)g * 64 + td * 32 + r) * 64 + ks * 16 + 8 * h);
#pragma unroll
        for (int qq = 0; qq < 4; ++qq) scv[qi][qq] = *(const f32x4*)(psc + g * 64 + td * 32 + 8 * qq + 4 * h); }
    for (int tile = F.bid; tile < ntiles; tile += F.G) {
        int row0, seq_lo, seq_hi;
        if (tile < 1024) { row0 = tile * 64; seq_lo = row0; seq_hi = row0 + 64; }
        else { const int ct = tile - 1024; seq_lo = ML + (ct >> 2) * 256; seq_hi = seq_lo + 256; row0 = seq_lo + (ct & 3) * 64; }
        for (int idx = F.tid; idx < 80 * 32; idx += NTHREADS) { const int rr = idx >> 5, ck = idx & 31, grow = row0 - 8 + rr;
            if (grow >= seq_lo && grow < seq_hi) *(LAS u32x4*)(Pin + rr * 512 + ck * 16) = __builtin_nontemporal_load((const u32x4*)(Z + (size_t)grow * NZ + ZC_P + ck * 8)); }
        __syncthreads();
#pragma unroll
        for (int g = 0; g < 4; ++g) { constexpr int dummy_ = 0; (void)dummy_; const int hw = 1 << g, tok = F.tid >> 3, ck = g * 8 + (F.tid & 7), t = row0 + tok;
            const int lo = max(t - hw, seq_lo), hi = min(t + hw, seq_hi);
            float s[8];
#pragma unroll
            for (int e = 0; e < 8; ++e) s[e] = 0.f;
#pragma unroll
            for (int d = -hw; d < hw; ++d) { u32x4 v = *(const LAS u32x4*)(Pin + (tok + 8 + d) * 512 + ck * 16); const bool in = (t + d >= lo) && (t + d < hi);
                v.x = in ? v.x : 0u; v.y = in ? v.y : 0u; v.z = in ? v.z : 0u; v.w = in ? v.w : 0u;
                s[0] += bflo(v.x); s[1] += bfhi(v.x); s[2] += bflo(v.y); s[3] += bfhi(v.y); s[4] += bflo(v.z); s[5] += bfhi(v.z); s[6] += bflo(v.w); s[7] += bfhi(v.w); }
            const float inv = 1.0f / (float)(hi - lo);
            const u32x4 o = *(const LAS u32x4*)(Pin + (tok + 8) * 512 + ck * 16);
            u32x4 w; w.x = pk2(s[0] * inv - bflo(o.x), s[1] * inv - bfhi(o.x)); w.y = pk2(s[2] * inv - bflo(o.y), s[3] * inv - bfhi(o.y));
            w.z = pk2(s[4] * inv - bflo(o.z), s[5] * inv - bfhi(o.z)); w.w = pk2(s[6] * inv - bflo(o.w), s[7] * inv - bfhi(o.w));
            *(LAS u32x4*)(Dm + tok * 528 + ck * 16) = w; }
        __syncthreads();
#pragma unroll
        for (int qi = 0; qi < 2; ++qi) { const int q = F.wave + 8 * qi, g = q >> 2, td = (q >> 1) & 1, tt = q & 1;
            f32x16 acc = zero16();
#pragma unroll
            for (int ks = 0; ks < 4; ++ks) { const bf16x8 b = *(const LAS bf16x8*)(Dm + (tt * 32 + r) * 528 + (g * 64 + ks * 16 + 8 * h) * 2);
                acc = MFMA32(wa[qi][ks], b, acc); }
            const size_t orow = (size_t)(row0 + tt * 32 + r);
#pragma unroll
            for (int qq = 0; qq < 4; ++qq) { const int dcol = g * 64 + td * 32 + 8 * qq + 4 * h; const f32x4 sc = scv[qi][qq];
                u32x2 w; w.x = pk2(acc[4 * qq] * sc.x, acc[4 * qq + 1] * sc.y); w.y = pk2(acc[4 * qq + 2] * sc.z, acc[4 * qq + 3] * sc.w);
                *(u32x2*)(BRA + orow * D + dcol) = w; } }
        __syncthreads();
    }
}
__device__ __forceinline__ void sgu_chunks(Frame& F, int l, bool with_ctx) {
    LAS unsigned char* Vt = F.lds;
    const bf16_t* Z = (const bf16_t*)(F.ws + WS_Z);
    const bf16_t* Ws = (const bf16_t*)(F.ws + WS_WSGU) + (size_t)l * 4 * 16384;
    const float* lng = F.in[IN_SLNG] + l * 256; const float* lnb = F.in[IN_SLNB] + l * 256; const float* sb = F.in[IN_SGUB] + l * 512;
    bf16_t* BRA = (bf16_t*)(F.ws + WS_BRA);
    const int nchunks = with_ctx ? 544 : 512;
    const int r = F.lane & 31, h = F.lane >> 5;
    const int tc = F.wave & 1, tt = F.wave >> 1, t = tt * 32 + r;
    LAS float* lnt = (LAS float*)(F.lds + 69632);
    if (F.tid < 256) { lnt[F.tid] = lng[F.tid]; lnt[256 + F.tid] = lnb[F.tid]; }
    __syncthreads();
    for (int ch = F.bid; ch < nchunks; ch += F.G) {
        const int row0 = ch * 128;
        u32x2 ug[4][4]; bf16x8 bcur[8];
        { const int s2 = F.tid >> 3, cq = F.tid & 7; const bf16_t* zp = Z + (size_t)(row0 + 2 * s2) * NZ + ZC_UV + 256 + cq * 32;
          float v[2][32]; float sum[2] = {0.f, 0.f};
#pragma unroll
          for (int rr = 0; rr < 2; ++rr)
#pragma unroll
              for (int i = 0; i < 4; ++i) { const u32x4 w = __builtin_nontemporal_load((const u32x4*)(zp + (size_t)rr * NZ + 8 * i));
                  v[rr][8 * i] = bflo(w.x); v[rr][8 * i + 1] = bfhi(w.x); v[rr][8 * i + 2] = bflo(w.y); v[rr][8 * i + 3] = bfhi(w.y); v[rr][8 * i + 4] = bflo(w.z); v[rr][8 * i + 5] = bfhi(w.z); v[rr][8 * i + 6] = bflo(w.w); v[rr][8 * i + 7] = bfhi(w.w); }
          float rstd[2];
#pragma unroll
          for (int rr = 0; rr < 2; ++rr) {
#pragma unroll
              for (int i = 0; i < 32; ++i) sum[rr] += v[rr][i];
              sum[rr] += shx(sum[rr], 1, F.lane); sum[rr] += shx(sum[rr], 2, F.lane); sum[rr] += shx(sum[rr], 4, F.lane);
              const float mean = sum[rr] * (1.f / 256.f); float sq = 0.f;
#pragma unroll
              for (int i = 0; i < 32; ++i) { v[rr][i] -= mean; sq += v[rr][i] * v[rr][i]; }
              sq += shx(sq, 1, F.lane); sq += shx(sq, 2, F.lane); sq += shx(sq, 4, F.lane);
              rstd[rr] = 1.f / sqrtf(sq * (1.f / 256.f) + LN_EPS); }
#pragma unroll
        for (int g = 0; g < 4; ++g)
#pragma unroll
            for (int qq = 0; qq < 4; ++qq) ug[g][qq] = *(const u32x2*)(Z + (size_t)(row0 + t) * NZ + ZC_UV + g * 64 + tc * 32 + 8 * qq + 4 * h);
#pragma unroll
        for (int ks = 0; ks < 8; ++ks) bcur[ks] = *(const bf16x8*)(Ws + ((size_t)0 * 128 + t) * 128 + ks * 16 + 8 * h);
          LAS unsigned char* wp = Vt + (((s2 >> 2) ^ cq) << 4) + (s2 & 3) * 4;
#pragma unroll
          for (int i = 0; i < 32; ++i) { const int c = cq * 32 + i; const float gn = lnt[c], bn = lnt[256 + c];
              *(LAS unsigned*)(wp + c * 272) = pg8::cvt_pk_bf16(v[0][i] * rstd[0] * gn + bn, v[1][i] * rstd[1] * gn + bn); } }
        __syncthreads();
#pragma unroll
        for (int g = 0; g < 4; ++g) {
            bf16x8 bnx[8];
#pragma unroll
            for (int ks = 0; ks < 8; ++ks) bnx[ks] = bcur[ks];
            if (g < 3) {
#pragma unroll
                for (int ks = 0; ks < 8; ++ks) bnx[ks] = *(const bf16x8*)(Ws + ((size_t)(g + 1) * 128 + t) * 128 + ks * 16 + 8 * h); }
            f32x16 acc = zero16();
#pragma unroll
            for (int ks = 0; ks < 8; ++ks) { const bf16x8 a = *(const LAS bf16x8*)(Vt + (g * 64 + tc * 32 + r) * 272 + (((ks * 2 + h) ^ ((g * 2 + tc) & 7)) * 16));
                acc = MFMA32(a, bcur[ks], acc); }
#pragma unroll
            for (int ks = 0; ks < 8; ++ks) bcur[ks] = bnx[ks];
            const float bias = sb[g * 128 + t];
#pragma unroll
            for (int qq = 0; qq < 4; ++qq) { const int c0 = g * 64 + tc * 32 + 8 * qq + 4 * h;
                const u32x2 u = ug[g][qq];
                u32x2 w; w.x = pk2(bflo(u.x) * (acc[4 * qq] + bias), bfhi(u.x) * (acc[4 * qq + 1] + bias)); w.y = pk2(bflo(u.y) * (acc[4 * qq + 2] + bias), bfhi(u.y) * (acc[4 * qq + 3] + bias));
                *(u32x2*)(BRA + (size_t)(row0 + t) * D + 768 + c0) = w; } }
        __syncthreads();
    }
}
__device__ __forceinline__ void qk_conv_pass(Frame& F, int l) {
    const bf16_t* Z = (const bf16_t*)(F.ws + WS_Z); bf16_t* QKC = (bf16_t*)(F.ws + WS_H);
    const int chunk = F.tid & 127, rsub = F.tid >> 7, ch0 = chunk * 8;
    float w0[8], w1[8], w2[8], cbv[8];
    { const float* cw = F.in[IN_CONVW] + (size_t)l * 3 * 1024 + ch0; const float* cb = F.in[IN_CONVB] + (size_t)l * 1024 + ch0;
#pragma unroll
      for (int e = 0; e < 8; ++e) { w0[e] = cw[e]; w1[e] = cw[1024 + e]; w2[e] = cw[2048 + e]; cbv[e] = cb[e]; } }
    const float scale = chunk >= 64 ? 0.08838834764831845f : 1.0f;
    const int ns = F.G * 4, sidx = F.bid * 4 + rsub;
    const int r0 = (int)(((long)sidx * MT) / ns), r1 = (int)(((long)(sidx + 1) * MT) / ns);
    const bf16_t* zb = Z + ZC_QK + ch0;
    const u32x4 zero4 = (u32x4){0u, 0u, 0u, 0u};
    u32x4 xm = zero4, xc = zero4, xn = zero4;
    if (r0 < r1) { xc = *(const u32x4*)(zb + (size_t)r0 * NZ); if (r0 > 0) xm = *(const u32x4*)(zb + (size_t)(r0 - 1) * NZ); if (r0 + 1 < MT) xn = *(const u32x4*)(zb + (size_t)(r0 + 1) * NZ); }
    for (int row = r0; row < r1; ++row) {
        u32x4 xn2 = zero4; if (row + 2 < MT) xn2 = *(const u32x4*)(zb + (size_t)(row + 2) * NZ);
        const int p = row < ML ? (row & 4095) : ((row - ML) & 255), len = row < ML ? 4096 : 256;
        const u32x4 x0 = (p > 0) ? xm : zero4, x1 = xc, x2 = (p + 1 < len) ? xn : zero4;
        const unsigned xa[4] = {x0.x, x0.y, x0.z, x0.w}, xb[4] = {x1.x, x1.y, x1.z, x1.w}, xcc[4] = {x2.x, x2.y, x2.z, x2.w};
        float y[8];
#pragma unroll
        for (int e2 = 0; e2 < 4; ++e2) { y[2 * e2] = cbv[2 * e2] + w0[2 * e2] * bflo(xa[e2]) + w1[2 * e2] * bflo(xb[e2]) + w2[2 * e2] * bflo(xcc[e2]);
            y[2 * e2 + 1] = cbv[2 * e2 + 1] + w0[2 * e2 + 1] * bfhi(xa[e2]) + w1[2 * e2 + 1] * bfhi(xb[e2]) + w2[2 * e2 + 1] * bfhi(xcc[e2]); }
#pragma unroll
        for (int e = 0; e < 8; ++e) y[e] = siluf_(y[e]) * scale;
        u32x4 w; w.x = pk2(y[0], y[1]); w.y = pk2(y[2], y[3]); w.z = pk2(y[4], y[5]); w.w = pk2(y[6], y[7]);
        *(u32x4*)(QKC + (size_t)row * D + ch0) = w;
        xm = xc; xc = xn; xn = xn2;
    }
}
constexpr int ML_QS = 0, ML_KS = 34816, ML_KW = 69632, ML_VT = 104448, ML_CB = 126208, ML_SC = 147968, ML_SCSZ = 2624;
__device__ __forceinline__ float logsigf_(float x) { return fminf(x, 0.f) - __logf(1.0f + __expf(-fabsf(x))); }
__device__ __forceinline__ unsigned swap16(unsigned u) { return __builtin_amdgcn_alignbit(u, u, 16); }
struct MlPre { u32x4 qk[8]; u32x2 v[4]; float g[4]; };
__device__ __forceinline__ void ml_geom(int j, int b, int dir, int& seqbase, int& seqlen, int& pbase) {
    const bool is_ctx = j < 2; int cj = is_ctx ? j : j - 2; const int ncs = is_ctx ? 2 : 32; if (dir) cj = ncs - 1 - cj;
    seqbase = is_ctx ? ML + b * 256 : b * 4096; seqlen = is_ctx ? 256 : 4096; pbase = cj * 128; }
#define ML_BAR() do { asm volatile("s_waitcnt lgkmcnt(0)" ::: "memory"); __builtin_amdgcn_s_barrier(); asm volatile("" ::: "memory"); } while (0)
__device__ __forceinline__ void mlstm_unit(Frame& F, int l, int unit) {
    const int bh = (unit & 7) + 8 * (unit >> 5), sub = (unit >> 3) & 3;
    const int b = bh >> 2, head = bh & 3, dir = sub >> 1, vh = sub & 1;
    LAS unsigned char* QS = F.lds + ML_QS; LAS unsigned char* KS = F.lds + ML_KS; LAS unsigned char* KW = F.lds + ML_KW; LAS unsigned char* VT = F.lds + ML_VT; LAS unsigned char* CB = F.lds + ML_CB;
    const bf16_t* Z = (const bf16_t*)(F.ws + WS_Z); const float* ZG = (const float*)(F.ws + WS_ZG); const bf16_t* QKC = (const bf16_t*)(F.ws + WS_H);
    bf16_t* HF = (bf16_t*)(F.ws + WS_HFB) + (size_t)dir * MT * 512;
    const int wave = F.wave;
    int tl = F.tid;
#define ML_ROLES() const int lane = tl & 63, fr = lane & 15, q4 = lane >> 4; const int isk = (tl >> 4) & 1, ck = tl & 15, i0 = 8 * (tl >> 5), chn = (isk ? 512 : 0) + head * 128 + ck * 8; \
    const int vi0 = 4 * (tl >> 4), vcq = tl & 15, vch = head * 128 + vh * 64 + vcq * 4; (void)fr; (void)q4; (void)vi0; (void)vcq; (void)vch; (void)i0; (void)chn; (void)ck; (void)isk;
    for (int idx = F.tid; idx < 16 * 136; idx += NTHREADS) *(LAS bf16_t*)(VT + (64 + idx / 136) * 272 + (idx % 136) * 2) = (idx < 136) ? (bf16_t)0x3F80 : (bf16_t)0;
    f32x4 cs[5];
#pragma unroll
    for (int vt = 0; vt < 5; ++vt) cs[vt] = (f32x4){0.f, 0.f, 0.f, 0.f};
    float m_state = 0.f;
    MlPre pre;
#define ML_PREFETCH(jj) do { int sb_, sl_, pb_; ml_geom((jj), b, dir, sb_, sl_, pb_); \
        { const int pmin = dir ? pb_ + 120 - i0 : pb_ + i0; const bf16_t* zr = QKC + (size_t)(sb_ + pmin) * D + chn; (void)sl_; \
          _Pragma("unroll") for (int k = 0; k < 8; ++k) pre.qk[k] = *(const u32x4*)(zr + (size_t)k * D); } \
        { const int pminv = dir ? pb_ + 124 - vi0 : pb_ + vi0; const bf16_t* zv = Z + (size_t)(sb_ + pminv) * NZ + ZC_V + vch; \
          _Pragma("unroll") for (int k = 0; k < 4; ++k) pre.v[k] = *(const u32x2*)(zv + (size_t)k * NZ); } \
        if (wave == 0) { const int p0 = dir ? pb_ + 127 - 2 * lane : pb_ + 2 * lane, p1 = dir ? p0 - 1 : p0 + 1; \
          pre.g[0] = ZG[(size_t)(sb_ + p0) * 16 + dir * 8 + head]; pre.g[1] = ZG[(size_t)(sb_ + p0) * 16 + dir * 8 + 4 + head]; \
          pre.g[2] = ZG[(size_t)(sb_ + p1) * 16 + dir * 8 + head]; pre.g[3] = ZG[(size_t)(sb_ + p1) * 16 + dir * 8 + 4 + head]; } } while (0)
#define ML_STEPA(sbuf) do { LAS float* sg_ = (LAS float*)(F.lds + ML_SC + (sbuf) * ML_SCSZ); const int i0g = 2 * lane, i1g = i0g + 1; \
        const float gi0 = pre.g[0], gf0 = pre.g[1], gi1 = pre.g[2], gf1 = pre.g[3]; \
        const float lf0 = logsigf_(gf0), lf1 = logsigf_(gf1); const float s1 = lf0 + lf1; float incl = s1; \
        _Pragma("unroll") for (int o = 1; o < 64; o <<= 1) { const float y_ = shup(incl, o, lane); incl += (lane >= o) ? y_ : 0.f; } \
        const float excl = incl - s1, bc0 = excl + lf0, bc1 = excl + s1; \
        const float g0 = gi0 - bc0, g1 = gi1 - bc1; const float mx1 = fmaxf(g0, g1); float im = mx1; \
        _Pragma("unroll") for (int o = 1; o < 64; o <<= 1) { const float y_ = shup(im, o, lane); im = (lane >= o) ? fmaxf(im, y_) : im; } \
        float em = shup(im, 1, lane); em = (lane == 0) ? -3.0e38f : em; \
        const float M0 = fmaxf(m_state, fmaxf(em, g0)), M1 = fmaxf(m_state, fmaxf(em, mx1)); \
        const float total = bperm(63, bc1), Mlast = bperm(63, M1); \
        sg_[i0g] = g0; sg_[i1g] = g1; sg_[128 + i0g] = M0; sg_[128 + i1g] = M1; \
        sg_[256 + i0g] = __expf(m_state - M0); sg_[256 + i1g] = __expf(m_state - M1); \
        sg_[384 + i0g] = __expf(-(bc0 + M0)); sg_[384 + i1g] = __expf(-(bc1 + M1)); \
        sg_[512 + i0g] = __expf(g0 - Mlast); sg_[512 + i1g] = __expf(g1 - Mlast); \
        if (lane == 0) sg_[640] = __expf(m_state - Mlast); \
        m_state = total + Mlast; } while (0)
    { ML_ROLES(); ML_PREFETCH(0); if (wave == 0) ML_STEPA(0); }
    ML_BAR();
#pragma unroll 1
    for (int j = 0; j < 34; ++j) {
        asm volatile("" : "+v"(tl));
        ML_ROLES();
        int seqbase, seqlen, pbase; ml_geom(j, b, dir, seqbase, seqlen, pbase);
        const LAS float* sc_g = (const LAS float*)(F.lds + ML_SC + (j & 1) * ML_SCSZ); const LAS float* sc_M = sc_g + 128; const LAS float* sc_dec = sc_g + 256; const LAS float* sc_emt = sc_g + 384; const LAS float* sc_wk = sc_g + 512;
        {
#pragma unroll
          for (int k = 0; k < 8; ++k) { const int i = dir ? i0 + 7 - k : i0 + k; *(LAS u32x4*)((isk ? KS : QS) + i * 272 + ck * 16) = pre.qk[k]; }
          if (isk) { u32x4 kt[8]; float ykeep[8];
#pragma unroll
              for (int e = 0; e < 8; ++e) { kt[e] = (u32x4){0u, 0u, 0u, 0u}; ykeep[e] = 0.f; }
#pragma unroll
              for (int k = 0; k < 8; ++k) { const int i = dir ? i0 + 7 - k : i0 + k; const float wk = sc_wk[i];
                  const unsigned xb[4] = {pre.qk[k].x, pre.qk[k].y, pre.qk[k].z, pre.qk[k].w};
#pragma unroll
                  for (int e = 0; e < 8; ++e) { const float yw = ((e & 1) ? bfhi(xb[e >> 1]) : bflo(xb[e >> 1])) * wk;
                      if (k & 1) { const unsigned pw_ = pk2(ykeep[e], yw); if ((k >> 1) == 0) kt[e].x = pw_; else if ((k >> 1) == 1) kt[e].y = pw_; else if ((k >> 1) == 2) kt[e].z = pw_; else kt[e].w = pw_; }
                      else ykeep[e] = yw; } }
#pragma unroll
              for (int e = 0; e < 8; ++e) { u32x4 o = kt[e]; if (dir) o = (u32x4){swap16(kt[e].w), swap16(kt[e].z), swap16(kt[e].y), swap16(kt[e].x)};
                  *(LAS u32x4*)(KW + (ck * 8 + e) * 272 + (((i0 >> 3) ^ (ck & 7)) * 16)) = o; } } }
        { unsigned vv[4][2];
#pragma unroll
          for (int k = 0; k < 4; ++k) { vv[k][0] = pre.v[k].x; vv[k][1] = pre.v[k].y; }
#pragma unroll
          for (int c = 0; c < 4; ++c) {
              unsigned h0 = (c & 1) ? (vv[0][c >> 1] >> 16) : (vv[0][c >> 1] & 0xffffu), h1 = (c & 1) ? (vv[1][c >> 1] >> 16) : (vv[1][c >> 1] & 0xffffu);
              unsigned h2 = (c & 1) ? (vv[2][c >> 1] >> 16) : (vv[2][c >> 1] & 0xffffu), h3 = (c & 1) ? (vv[3][c >> 1] >> 16) : (vv[3][c >> 1] & 0xffffu);
              u32x2 o; if (dir) { o.x = h3 | (h2 << 16); o.y = h1 | (h0 << 16); } else { o.x = h0 | (h1 << 16); o.y = h2 | (h3 << 16); }
              *(LAS u32x2*)(VT + (vcq * 4 + c) * 272 + vi0 * 2) = o; } }
#pragma unroll
        for (int vt = 0; vt < 5; ++vt)
#pragma unroll
            for (int rr = 0; rr < 4; rr += 2) { const unsigned pw_ = pk2(cs[vt][rr], cs[vt][rr + 1]);
                *(LAS bf16_t*)(CB + (16 * vt + 4 * q4 + rr) * 272 + (16 * wave + fr) * 2) = (bf16_t)(pw_ & 0xffffu); *(LAS bf16_t*)(CB + (16 * vt + 4 * q4 + rr + 1) * 272 + (16 * wave + fr) * 2) = (bf16_t)(pw_ >> 16); }
        ML_BAR();
        if (j + 1 < 34) ML_PREFETCH(j + 1);
        const int t = 16 * wave + fr;
        bf16x8 qf[4];
#pragma unroll
        for (int kc = 0; kc < 4; ++kc) qf[kc] = *(const LAS bf16x8*)(QS + t * 272 + (32 * kc + 8 * q4) * 2);
        const float Mt_t = sc_M[t], dec_t = sc_dec[t], emt_t = sc_emt[t];
        f32x4 ps[8];
#pragma unroll
        for (int jp = 0; jp < 4; ++jp) {
            ps[2 * jp] = (f32x4){0.f, 0.f, 0.f, 0.f}; ps[2 * jp + 1] = (f32x4){0.f, 0.f, 0.f, 0.f};
            if (2 * jp <= wave) {
                bf16x8 ka[4], kb[4];
#pragma unroll
                for (int kc = 0; kc < 4; ++kc) { ka[kc] = *(const LAS bf16x8*)(KS + (32 * jp + fr) * 272 + (32 * kc + 8 * q4) * 2); kb[kc] = *(const LAS bf16x8*)(KS + (32 * jp + 16 + fr) * 272 + (32 * kc + 8 * q4) * 2); }
                const f32x4 ga4 = *(const LAS f32x4*)(sc_g + 32 * jp + 4 * q4), gb4 = *(const LAS f32x4*)(sc_g + 32 * jp + 16 + 4 * q4);
                f32x4 acc0 = (f32x4){0.f, 0.f, 0.f, 0.f}, acc1 = (f32x4){0.f, 0.f, 0.f, 0.f};
#pragma unroll
                for (int kc = 0; kc < 4; ++kc) { acc0 = MFMA16(ka[kc], qf[kc], acc0); acc1 = MFMA16(kb[kc], qf[kc], acc1); }
#pragma unroll
                for (int rr = 0; rr < 4; ++rr) { const int s0 = 32 * jp + 4 * q4 + rr, s1 = s0 + 16;
                    ps[2 * jp][rr] = (s0 <= t) ? acc0[rr] * __expf(ga4[rr] - Mt_t) : 0.f; ps[2 * jp + 1][rr] = (s1 <= t) ? acc1[rr] * __expf(gb4[rr] - Mt_t) : 0.f; }
            }
        }
        f32x4 ao[5];
        {
#pragma unroll
          for (int vt = 0; vt < 5; ++vt) ao[vt] = (f32x4){0.f, 0.f, 0.f, 0.f};
#pragma unroll
          for (int kh = 0; kh < 4; kh += 2) { bf16x8 cf[2][5];
#pragma unroll
              for (int k2 = 0; k2 < 2; ++k2)
#pragma unroll
                  for (int vt = 0; vt < 5; ++vt) cf[k2][vt] = *(const LAS bf16x8*)(CB + (16 * vt + fr) * 272 + (32 * (kh + k2) + 8 * q4) * 2);
#pragma unroll
              for (int k2 = 0; k2 < 2; ++k2)
#pragma unroll
                  for (int vt = 0; vt < 5; ++vt) ao[vt] = MFMA16(cf[k2][vt], qf[kh + k2], ao[vt]); }
#pragma unroll
          for (int vt = 0; vt < 5; ++vt) ao[vt] = ao[vt] * dec_t; }
#pragma unroll
        for (int ks = 0; ks < 4; ++ks) {
            if (2 * ks <= wave) {
                s16x4 vlo[5], vhi[5];
#pragma unroll
                for (int vt = 0; vt < 5; ++vt) { vlo[vt] = *(const LAS s16x4*)(VT + (16 * vt + fr) * 272 + (32 * ks + 4 * q4) * 2); vhi[vt] = *(const LAS s16x4*)(VT + (16 * vt + fr) * 272 + (32 * ks + 16 + 4 * q4) * 2); }
                u32x4 pw; pw.x = cvt_pk_bf16(ps[2 * ks][0], ps[2 * ks][1]); pw.y = cvt_pk_bf16(ps[2 * ks][2], ps[2 * ks][3]); pw.z = cvt_pk_bf16(ps[2 * ks + 1][0], ps[2 * ks + 1][1]); pw.w = cvt_pk_bf16(ps[2 * ks + 1][2], ps[2 * ks + 1][3]);
                const bf16x8 pf = __builtin_bit_cast(bf16x8, pw);
#pragma unroll
                for (int vt = 0; vt < 5; ++vt) { const bf16x8 a = __builtin_shufflevector(vlo[vt], vhi[vt], 0, 1, 2, 3, 4, 5, 6, 7); ao[vt] = MFMA16(a, pf, ao[vt]); }
            }
        }
        { const float den = bperm(fr, ao[4][0]); const float inv = 1.0f / fmaxf(fabsf(den), emt_t);
          const int p = dir ? pbase + 127 - t : pbase + t; bf16_t* orow = HF + (size_t)(seqbase + p) * 512 + head * 128 + vh * 64 + 4 * q4;
#pragma unroll
          for (int vt = 0; vt < 4; ++vt) { const f32x4 o = ao[vt] * inv; u32x2 w; w.x = cvt_pk_bf16(o[0], o[1]); w.y = cvt_pk_bf16(o[2], o[3]); *(u32x2*)(orow + 16 * vt) = w; } }
        { const float a_s = sc_g[640];
#pragma unroll
          for (int vt = 0; vt < 5; ++vt) cs[vt] = cs[vt] * a_s;
#pragma unroll
          for (int ks = 0; ks < 4; ks += 2) { bf16x8 bb[2], va[2][5];
#pragma unroll
              for (int k2 = 0; k2 < 2; ++k2) { bb[k2] = *(const LAS bf16x8*)(KW + (16 * wave + fr) * 272 + (((4 * (ks + k2) + q4) ^ (((16 * wave + fr) >> 3) & 7)) * 16));
#pragma unroll
                  for (int vt = 0; vt < 5; ++vt) va[k2][vt] = *(const LAS bf16x8*)(VT + (16 * vt + fr) * 272 + (32 * (ks + k2) + 8 * q4) * 2); }
#pragma unroll
              for (int k2 = 0; k2 < 2; ++k2)
#pragma unroll
                  for (int vt = 0; vt < 5; ++vt) cs[vt] = MFMA16(va[k2][vt], bb[k2], cs[vt]); } }
        if (wave == 0 && j + 1 < 34) ML_STEPA((j + 1) & 1);
        ML_BAR();
    }
#undef ML_PREFETCH
#undef ML_STEPA
#undef ML_ROLES
    __syncthreads();
}
__device__ __forceinline__ void phase_mixers(Frame& F, int l) {
    const bool with_ctx = (l != DEPTH - 1);
#ifndef MIX_MASK
#define MIX_MASK 7
#endif
#ifndef MIXREP
#define MIXREP 0
#endif
    if (MIX_MASK & 1) pool_tiles(F, l, with_ctx);
    if (MIXREP & 1) { __syncthreads(); pool_tiles(F, l, with_ctx); }
    if (MIX_MASK & 2) sgu_chunks(F, l, with_ctx);
    if (MIXREP & 2) { __syncthreads(); sgu_chunks(F, l, with_ctx); }
    (void)0;
    qk_conv_pass(F, l);
}
__device__ __forceinline__ void phase_mlstm(Frame& F, int l) {
    for (int u = F.bid; u < 256; u += F.G) mlstm_unit(F, l, u);
}

struct Args { const float* in[31]; float* out; unsigned char* ws; int g_lo, g_hi, pad0, pad1; };
constexpr int NPH = 11, NGID = 2 + DEPTH * NPH;
__global__ void __launch_bounds__(NTHREADS, 2) fwd_kernel(Args args) {
    extern __shared__ __attribute__((aligned(16))) unsigned char lds_raw[];
    Frame F;
    F.lds = (LAS unsigned char*)lds_raw; F.MISC = (volatile LAS unsigned*)(F.lds + MISC_OFF);
    F.tid = threadIdx.x; F.lane = F.tid & 63; F.wave = __builtin_amdgcn_readfirstlane(F.tid >> 6); F.G = gridDim.x; F.bid = blockIdx.x;
    F.ws = args.ws; F.out = args.out;
    F.in = (InTab)__builtin_amdgcn_kernarg_segment_ptr();
    if (F.tid < 64) F.MISC[F.tid] = 0u;
    __syncthreads();
    const int lo = args.g_lo, hi = args.g_hi;
    const bool multi = (hi - lo) > 1;
    XcdBarrier bar; bar.bar = (unsigned*)(F.ws + WS_CTL) + CW_BAR; bar.x = 0; bar.st = nullptr;
    if (multi) bar = xcd_barrier_post((unsigned*)(F.ws + WS_CTL) + CW_BAR, F.MISC + 8);
#ifndef PHASE_MASK
#define PHASE_MASK 0xFFFF
#endif
#define RUN(g) (lo <= (g) && (g) < hi)
#define RUNP(ty, g) ((((PHASE_MASK) >> (ty)) & 1) && RUN(g))
#ifndef REPEAT_MASK
#define REPEAT_MASK 0
#endif
#define NREP(ty) ((((REPEAT_MASK) >> (ty)) & 1) ? 2 : 1)
#define SEAM(g) do { if (RUN((g) + 1)) xcd_barrier(bar); } while (0)
#define LAUNDER(P) Frame P = F; { int t_; asm volatile("v_mbcnt_lo_u32_b32 %0, -1, 0\n\tv_mbcnt_hi_u32_b32 %0, -1, %0" : "=v"(t_)); t_ |= (F.wave << 6); P.tid = t_; P.lane = t_ & 63; P.wave = __builtin_amdgcn_readfirstlane(t_ >> 6); GAS unsigned char* w_ = (GAS unsigned char*)F.ws; asm volatile("" : "+s"(w_)); P.ws = (unsigned char*)w_; InTab t2_ = F.in; asm volatile("" : "+s"(t2_)); P.in = t2_; }
    if (RUNP(0, 0)) { LAUNDER(P); for (int rep_ = 0; rep_ < NREP(0); ++rep_) { phase_prologue(P); __syncthreads(); } SEAM(0); }
    if (RUNP(1, 1)) { LAUNDER(P); for (int rep_ = 0; rep_ < NREP(1); ++rep_) { phase_ln0_first(P); __syncthreads(); } SEAM(1); }
#pragma unroll 1
    for (int l = 0; l < DEPTH; ++l) {
        const int g0 = 2 + l * NPH;
        const int mrows = (l == DEPTH - 1) ? ML : MT;
        if (RUNP(2, g0 + 0)) {
#undef PHTY
#define PHTY 2
            LAUNDER(P);
            { ProbPlain Pr{(const bf16_t*)(P.ws + WS_H), (const bf16_t*)(P.ws + WS_WIN) + (size_t)l * NZ * D, D, D};
              pg8::StaticOrder<1> S; S.init(MT / 256, NZ_BF / 256, P.G, P.bid);
              EpiInproj<false> E{(bf16_t*)(P.ws + WS_Z), P.in[IN_BIN] + (size_t)l * 5904, 0};
              pg8::gemm_phase(P.lds, P.tid, Pr, S, E); }
            __syncthreads();
            { ProbPlainF8 Pr{(const bf16_t*)(P.ws + WS_H8), (const bf16_t*)(P.ws + WS_WIN8 + (size_t)l * NZ_F8 * D), D / 2, D / 2};
              pg8::StaticOrder<1> S; S.init(MT / 256, NZ_F8 / 256, P.G, P.bid);
              EpiInproj<true> E{(bf16_t*)(P.ws + WS_Z), P.in[IN_BIN] + (size_t)l * 5904, NZ_BF / 256};
              pg8::gemm_phase(P.lds, P.tid, Pr, S, E); }
            SEAM(g0 + 0);
        }
        if (RUNP(3, g0 + 1)) { LAUNDER(P); for (int rep_ = 0; rep_ < NREP(3); ++rep_) { phase_mixers(P, l); __syncthreads(); } SEAM(g0 + 1); }
        if (RUNP(12, g0 + 2)) { LAUNDER(P); for (int rep_ = 0; rep_ < NREP(12); ++rep_) { phase_mlstm(P, l); __syncthreads(); } SEAM(g0 + 2); }
        if (RUNP(4, g0 + 3)) { LAUNDER(P); for (int rep_ = 0; rep_ < NREP(4); ++rep_) phase_finalize(P, l, mrows); SEAM(g0 + 3); }
        if (RUNP(5, g0 + 4)) {
#undef PHTY
#define PHTY 5
            LAUNDER(P);
            ProbPlain Pr{(const bf16_t*)(P.ws + WS_BRA), (const bf16_t*)(P.ws + WS_WBR) + (size_t)l * D * D, D, D};
            pg8::StaticOrder<1> S; S.init(mrows / 256, 4, P.G, P.bid);
            EpiBranch E{(const bf16_t*)(P.ws + WS_Z), (bf16_t*)(P.ws + WS_Y)};
            pg8::gemm_phase(P.lds, P.tid, Pr, S, E); if (NREP(PHTY) == 2) { __syncthreads(); pg8::gemm_phase(P.lds, P.tid, Pr, S, E); }
            SEAM(g0 + 4);
        }
        if (RUNP(6, g0 + 5)) {
#undef PHTY
#define PHTY 6
            LAUNDER(P);
            ProbPlain Pr{(const bf16_t*)(P.ws + WS_Y), (const bf16_t*)(P.ws + WS_WOUT) + (size_t)l * D * D, D, D};
            pg8::StaticOrder<1> S; S.init(mrows / 256, 4, P.G, P.bid);
            EpiOut E{(bf16_t*)(P.ws + WS_T)};
            pg8::gemm_phase(P.lds, P.tid, Pr, S, E); if (NREP(PHTY) == 2) { __syncthreads(); pg8::gemm_phase(P.lds, P.tid, Pr, S, E); }
            SEAM(g0 + 5);
        }
        if (RUNP(7, g0 + 6)) { LAUNDER(P); for (int rep_ = 0; rep_ < NREP(7); ++rep_) phase_ln1_router(P, l, mrows); SEAM(g0 + 6); }
        if (RUNP(8, g0 + 7)) { LAUNDER(P); for (int rep_ = 0; rep_ < NREP(8); ++rep_) phase_slots(P, mrows); SEAM(g0 + 7); }
        if (RUNP(9, g0 + 8)) {
#undef PHTY
#define PHTY 9
            LAUNDER(P);
            LAS int* seg = (LAS int*)(P.lds + TAB_OFF);
            const int ntile = moe_tables(P, seg);
            ProbMoe1 Pr{(const bf16_t*)(P.ws + WS_H2F8), (const bf16_t*)(P.ws + WS_WGU + (size_t)l * NEXP * 2048 * D), D / 2, D / 2, (const int*)(P.ws + WS_ROUTE + RT_TOK), seg};
            pg8::StaticOrder<1> S; S.init(ntile, 8, P.G, P.bid);
            EpiSwiglu E{(unsigned char*)(P.ws + WS_HID), P.in[IN_BGU] + (size_t)l * NEXP * 2048, seg};
            pg8::gemm_phase(P.lds, P.tid, Pr, S, E); if (NREP(PHTY) == 2) { __syncthreads(); pg8::gemm_phase(P.lds, P.tid, Pr, S, E); }
            SEAM(g0 + 8);
        }
        if (RUNP(10, g0 + 9)) {
#undef PHTY
#define PHTY 10
            LAUNDER(P);
            LAS int* seg = (LAS int*)(P.lds + TAB_OFF);
            const int ntile = moe_tables(P, seg);
            ProbMoe2 Pr{(const bf16_t*)(P.ws + WS_HID), (const bf16_t*)(P.ws + WS_WDN + (size_t)l * NEXP * D * D), D / 2, D / 2, seg};
            pg8::StaticOrder<1> S; S.init(ntile, 4, P.G, P.bid);
            EpiDown E{(unsigned char*)(P.ws + WS_FS), P.in[IN_BDN] + (size_t)l * NEXP * D, (const int*)(P.ws + WS_ROUTE + RT_DEST), (const float*)(P.ws + WS_ROUTE + RT_PSLOT), seg};
            pg8::gemm_phase(P.lds, P.tid, Pr, S, E); if (NREP(PHTY) == 2) { __syncthreads(); pg8::gemm_phase(P.lds, P.tid, Pr, S, E); }
            SEAM(g0 + 9);
        }
        if (RUNP(11, g0 + 10)) { LAUNDER(P); phase_combine_ln2(P, l, mrows); SEAM(g0 + 10); }
    }
#undef LAUNDER
#undef RUN
#undef RUNP
#undef SEAM
}

extern "C" void kernel_launch(void* const* d_in, const int* in_sizes, int n_in, void* d_out, int out_size, void* d_ws, size_t ws_size, hipStream_t stream) {
    static int grid = 0;
    if (grid == 0) {
        if (n_in != 31 || out_size != ML * D || ws_size < WS_END) { fprintf(stderr, "kernel_launch: unexpected problem (n_in %d, out %d, ws %zu, need %zu)\n", n_in, out_size, ws_size, (size_t)WS_END); grid = -1; return; }
        int dev = 0, cus = 0, per_cu = 0;
        if (hipGetDevice(&dev) != hipSuccess || hipDeviceGetAttribute(&cus, hipDeviceAttributeMultiprocessorCount, dev) != hipSuccess) { grid = -1; return; }
        if (hipFuncSetAttribute((const void*)fwd_kernel, hipFuncAttributeMaxDynamicSharedMemorySize, LDS_BYTES) != hipSuccess) { fprintf(stderr, "kernel_launch: hipFuncSetAttribute failed\n"); grid = -1; return; }
        if (hipOccupancyMaxActiveBlocksPerMultiprocessor(&per_cu, (const void*)fwd_kernel, NTHREADS, LDS_BYTES) != hipSuccess || per_cu < 1) fprintf(stderr, "kernel_launch: occupancy query reports %d\n", per_cu);
        (void)hipGetLastError();
        grid = cus;
    }
    if (grid < 0) return;
    (void)hipMemsetAsync((char*)d_ws + WS_CTL, 0, CTL_ZERO_BYTES, stream);
    Args a{};
    for (int i = 0; i < 31; ++i) a.in[i] = (const float*)d_in[i];
    a.out = (float*)d_out; a.ws = (unsigned char*)d_ws;
#if MK_N_LAUNCHES == 1
    a.g_lo = 0; a.g_hi = NGID;
    hipLaunchKernelGGL(fwd_kernel, dim3(grid), dim3(NTHREADS), LDS_BYTES, stream, a);
#else
    for (int g = 0; g < NGID; ++g) { a.g_lo = g; a.g_hi = g + 1; hipLaunchKernelGGL(fwd_kernel, dim3(grid), dim3(NTHREADS), LDS_BYTES, stream, a); }
#endif
}
```

```cpp
#include <hip/hip_runtime.h>
#include <cstdio>
#include <cstdint>

#ifndef MK_N_LAUNCHES
#define MK_N_LAUNCHES 1
#endif

#define LAS __attribute__((address_space(3)))
#define GAS __attribute__((address_space(1)))
typedef unsigned short bf16_t;
typedef short bf16x8 __attribute__((ext_vector_type(8)));
typedef short s16x4 __attribute__((ext_vector_type(4)));
typedef float f32x4 __attribute__((ext_vector_type(4)));
typedef float f32x2 __attribute__((ext_vector_type(2)));
typedef float f32x16 __attribute__((ext_vector_type(16)));
typedef unsigned u32x4 __attribute__((ext_vector_type(4)));
typedef unsigned u32x2 __attribute__((ext_vector_type(2)));
typedef int i32x4 __attribute__((ext_vector_type(4)));
typedef int i32x8 __attribute__((ext_vector_type(8)));

constexpr int D = 1024, NB = 16, SEQ = 4096, CTXL = 256, DEPTH = 4;
constexpr int ML = NB * SEQ;
constexpr int MC = NB * CTXL;
constexpr int MT = ML + MC;
constexpr int NZ = 5888;
constexpr int ZC_P = 0, ZC_QK = 256, ZC_V = 1280, ZC_O = 1792, ZC_UV = 2304, ZC_MG = 2816;
constexpr int NZ_BF = 256, NZ_F8 = 5632;
constexpr int ZG_COL = 2816;
constexpr int NEXP = 32, TOPK = 4;
constexpr int NS_MAX = MT * TOPK + NEXP * 256;
constexpr float LN_EPS = 1e-5f, HEAD_EPS = 1e-6f;
constexpr float DN_ALPHA = 1.6817928305074292f;
constexpr int NWAVES = 8, NTHREADS = 512;
constexpr float F8S_ACT = 4.0f, F8S_WGU = 64.0f, F8S_WDN = 64.0f; constexpr int F8E_ACT = 123, F8E_WGU = 123, F8E_WDN = 123;

constexpr size_t MiB = 1u << 20;
constexpr size_t WS_CTL = 0, CTL_ZERO_BYTES = 1 * MiB;
constexpr size_t WS_MOD = 1 * MiB;
constexpr size_t WS_WG = 3 * MiB;
constexpr size_t WS_WSGU = 4 * MiB;
constexpr size_t WS_WPOOL = WS_WSGU + 512 * 1024;
constexpr size_t WS_ROUTE = 5 * MiB;
constexpr size_t WS_WIN = 16 * MiB;
constexpr size_t WS_WBR = 62 * MiB;
constexpr size_t WS_WOUT = 70 * MiB;
constexpr size_t WS_WGU = 78 * MiB;
constexpr size_t WS_WDN = 590 * MiB;
constexpr size_t WS_X = 846 * MiB;
constexpr size_t WS_H = 1118 * MiB;
constexpr size_t WS_Z = 1254 * MiB;
constexpr size_t WS_FS = WS_Z;
constexpr float G8_SCALE = 255.0f;
constexpr float FS_SCALE = 32.0f, FS_CLAMP = 440.0f;
constexpr size_t WS_BRA = 2036 * MiB;
constexpr size_t WS_HFB = 2172 * MiB;
constexpr size_t WS_Y = 2444 * MiB;
constexpr size_t WS_T = 2580 * MiB;
constexpr size_t WS_H2 = 2852 * MiB;
constexpr size_t WS_HID = 2988 * MiB;
constexpr size_t WS_ZG = 3548 * MiB;
constexpr size_t WS_H2F8 = 3554 * MiB;
constexpr size_t WS_H8 = 3624 * MiB;
constexpr size_t WS_WIN8 = 3692 * MiB;
constexpr size_t WS_END = 3714 * MiB;
static_assert(WS_Z + (size_t)MT * NZ * 2 <= WS_BRA && WS_FS + (size_t)MT * 4 * 1024 * 2 <= WS_BRA, "Z/FS");
static_assert(WS_HID + (size_t)NS_MAX * 1024 * 2 <= WS_END, "HID");
constexpr size_t RT_EIDX = 0;
constexpr size_t RT_PROB = 2 * MiB;
constexpr size_t RT_TOK = 4 * MiB;
constexpr size_t RT_DEST = 6 * MiB;
constexpr size_t RT_PSLOT = 8 * MiB;
constexpr size_t RT_CNT = 10 * MiB;
constexpr size_t RT_SEG = 10 * MiB + 64 * 1024;
constexpr int CW_BAR = 4096;

constexpr int LDS_BYTES = 163840;
constexpr int MISC_OFF = LDS_BYTES - 256;
constexpr int TAB_OFF = 131072;
constexpr int NW_WT = 0;
constexpr int NW_LG = 66048;
constexpr int NW_END = 99840;
constexpr int NW_PV = NW_END + 256;

__device__ __forceinline__ unsigned f2bf(float f) { unsigned u = __builtin_bit_cast(unsigned, f); return (u + 0x7fffu + ((u >> 16) & 1u)) >> 16; }
__device__ __forceinline__ unsigned pk2(float lo, float hi) { unsigned r; asm volatile("v_cvt_pk_bf16_f32 %0, %1, %2" : "=v"(r) : "v"(lo), "v"(hi)); return r; }
__device__ __forceinline__ unsigned pk4_fp8(float a, float b, float c, float d) { int w = 0; w = __builtin_amdgcn_cvt_pk_fp8_f32(a, b, w, false); w = __builtin_amdgcn_cvt_pk_fp8_f32(c, d, w, true); return (unsigned)w; }
__device__ __forceinline__ unsigned pk4_u8(float a, float b, float c, float d) {
    const unsigned lo = __builtin_amdgcn_perm(__builtin_bit_cast(unsigned, b), __builtin_bit_cast(unsigned, a), 0x0c0c0400u), hi = __builtin_amdgcn_perm(__builtin_bit_cast(unsigned, d), __builtin_bit_cast(unsigned, c), 0x0c0c0400u);
    return lo | (hi << 16); }
__device__ __forceinline__ f32x4 u8x4_f32(unsigned w) { return (f32x4){(float)(w & 0xffu), (float)((w >> 8) & 0xffu), (float)((w >> 16) & 0xffu), (float)(w >> 24)}; }
__device__ __forceinline__ float bflo(unsigned w) { return __builtin_bit_cast(float, w << 16); }
__device__ __forceinline__ float bfhi(unsigned w) { return __builtin_bit_cast(float, w & 0xffff0000u); }
__device__ __forceinline__ float bf1(bf16_t h) { return __builtin_bit_cast(float, ((unsigned)h) << 16); }
__device__ __forceinline__ float bperm(int srclane, float v) { return __builtin_bit_cast(float, __builtin_amdgcn_ds_bpermute(srclane << 2, __builtin_bit_cast(int, v))); }
__device__ __forceinline__ float shx(float v, int o, int lane) { return bperm(lane ^ o, v); }
__device__ __forceinline__ float shup(float v, int o, int lane) { return bperm(lane >= o ? lane - o : lane, v); }
template <int N> __device__ __forceinline__ float dpp_ror(float v) { return __builtin_bit_cast(float, __builtin_amdgcn_update_dpp(0, __builtin_bit_cast(int, v), 0x120 + N, 0xf, 0xf, false)); }
__device__ __forceinline__ float row16_sum(float v) { v += dpp_ror<8>(v); v += dpp_ror<4>(v); v += dpp_ror<2>(v); v += dpp_ror<1>(v); return v; }
__device__ __forceinline__ float wave_sum(float v, int) {
    v = row16_sum(v);
    { const unsigned u = __builtin_bit_cast(unsigned, v); const auto r = __builtin_amdgcn_permlane16_swap(u, u, false, false); v = __builtin_bit_cast(float, (unsigned)r[0]) + __builtin_bit_cast(float, (unsigned)r[1]); }
    { const unsigned u = __builtin_bit_cast(unsigned, v); const auto r = __builtin_amdgcn_permlane32_swap(u, u, false, false); v = __builtin_bit_cast(float, (unsigned)r[0]) + __builtin_bit_cast(float, (unsigned)r[1]); }
    return v;
}
__device__ __forceinline__ float sigmoidf_(float x) { return __builtin_amdgcn_rcpf(1.0f + __builtin_amdgcn_exp2f(x * -1.4426950408889634f)); }
__device__ __forceinline__ float siluf_(float x) { return x * __builtin_amdgcn_rcpf(1.0f + __builtin_amdgcn_exp2f(x * -1.4426950408889634f)); }
__device__ __forceinline__ f32x4 sigmoid4(f32x4 x) {
    f32x4 t = x * -1.4426950408889634f;
#pragma unroll
    for (int i = 0; i < 4; ++i) t[i] = __builtin_amdgcn_exp2f(t[i]);
    t = t + 1.0f;
#pragma unroll
    for (int i = 0; i < 4; ++i) t[i] = __builtin_amdgcn_rcpf(t[i]);
    return t; }
#define LDS_WAIT() asm volatile("s_waitcnt lgkmcnt(0)" ::: "memory")
#define VM_WAIT() asm volatile("s_waitcnt vmcnt(0)" ::: "memory")

#define XB_TMO      128
#define XB_XCNT(j)  (256  + 64 * (j))
#define XB_XSUB(j)  (1280 + 64 * (j))
#define XB_XGEN(j)  (2304 + 64 * (j))
#define XB_TOP      3328
#define XB_TOPGEN   3392
#define XCD_BAR_WORDS 3456
#define XB_SPIN_CAP (1u << 18)
__device__ __forceinline__ unsigned xb_ld(unsigned* p)              { asm volatile("" : "+v"(p)); return __hip_atomic_load(p, __ATOMIC_RELAXED, __HIP_MEMORY_SCOPE_AGENT); }
__device__ __forceinline__ unsigned xb_add(unsigned* p, unsigned v) { asm volatile("" : "+v"(p), "+v"(v)); return __hip_atomic_fetch_add(p, v, __ATOMIC_RELAXED, __HIP_MEMORY_SCOPE_AGENT); }
__device__ __forceinline__ unsigned xb_xcc_id() { return (unsigned)__builtin_amdgcn_s_getreg((3 << 11) | 20) & 0xFu; }
#define XB_SPIN(cond, bar) do { unsigned _sp = 0; while (cond) { __builtin_amdgcn_s_sleep(1); \
    if ((++_sp & 255u) == 0u) { if (xb_ld(&(bar)[XB_TMO])) break; if (_sp > XB_SPIN_CAP) { atomicAdd(&(bar)[XB_TMO], 1u); break; } } } } while (0)
struct XcdBarrier { unsigned* bar; unsigned x; volatile LAS unsigned* st; };
__device__ __forceinline__ XcdBarrier xcd_barrier_post(unsigned* bar, volatile LAS unsigned* st) {
    XcdBarrier b; b.bar = bar; b.x = xb_xcc_id(); b.st = st;
    if (threadIdx.x == 0) (void)xb_add(&bar[XB_XCNT(b.x)], 1u);
    return b;
}
__device__ __forceinline__ void xcd_barrier_complete(unsigned* bar, unsigned x, unsigned& nloc, unsigned& nx) {
    const unsigned G = gridDim.x * gridDim.y * gridDim.z;
    unsigned sum, cnt, mine, sp = 0u;
    for (;;) {
        sum = 0u; cnt = 0u; mine = 0u;
#pragma unroll
        for (unsigned j = 0; j < 16; ++j) { const unsigned c = xb_ld(&bar[XB_XCNT(j)]); sum += c; cnt += (c > 0u) ? 1u : 0u; mine = (j == x) ? c : mine; }
        if (sum == G) break;
        __builtin_amdgcn_s_sleep(1);
        if ((++sp & 255u) == 0u) { if (xb_ld(&bar[XB_TMO])) break; if (sp > XB_SPIN_CAP) { atomicAdd(&bar[XB_TMO], 1u); break; } }
    }
    nloc = mine > 0u ? mine : 1u; nx = cnt > 0u ? cnt : 1u;
}
__device__ __forceinline__ void xcd_barrier(const XcdBarrier& b) {
    asm volatile("s_waitcnt vmcnt(0)" ::: "memory");
    __syncthreads();
    if (threadIdx.x == 0) {
        unsigned* bar = b.bar;
        __builtin_amdgcn_s_waitcnt(0);
        unsigned nloc = b.st[0], nx = b.st[1];
        if (nloc == 0u) { xcd_barrier_complete(bar, b.x, nloc, nx); b.st[0] = nloc; b.st[1] = nx; }
        const unsigned old = xb_add(&bar[XB_XSUB(b.x)], 1u);
        const unsigned gen = old / nloc;
        if (old + 1u == (gen + 1u) * nloc) {
            __builtin_amdgcn_fence(__ATOMIC_RELEASE, "agent");
            asm volatile("s_waitcnt vmcnt(0)" ::: "memory");
            const unsigned og = xb_add(&bar[XB_TOP], 1u);
            const unsigned tg = og / nx;
            if (og + 1u == (tg + 1u) * nx) xb_add(&bar[XB_TOPGEN], 1u);
            else XB_SPIN(xb_ld(&bar[XB_TOPGEN]) == tg, bar);
            __builtin_amdgcn_fence(__ATOMIC_ACQUIRE, "agent");
            xb_add(&bar[XB_XGEN(b.x)], 1u);
            asm volatile("s_waitcnt vmcnt(0)" ::: "memory");
        } else {
            XB_SPIN(xb_ld(&bar[XB_XGEN(b.x)]) == gen, bar);
            __builtin_amdgcn_fence(__ATOMIC_ACQUIRE, "agent");
            asm volatile("s_waitcnt vmcnt(0)" ::: "memory");
        }
    }
    __syncthreads();
}

namespace pg8 {
constexpr int BM = 256, BK = 64, HALF = 128, HTB = HALF * BK * 2, STAGE_BYTES = 8 * HTB, NXCD = 8, WGM = 8;
__host__ __device__ __forceinline__ int lds_byte(int r, int c) { const int st = (r >> 4) * 2 + (c >> 5), rr = r & 15, cc = c & 31, ob = rr * 64 + cc * 2; return st * 1024 + (ob ^ (((ob >> 9) & 1) << 5)); }
__host__ __device__ __forceinline__ void stage_rc(int b, int& R, int& C) { const int st = b / 1024, sb = b % 1024, swz = sb ^ (((sb >> 9) & 1) << 5); R = (st >> 1) * 16 + swz / 64; C = (st & 1) * 32 + (swz % 64) / 2; }
__host__ __device__ __forceinline__ int perm32(int rho) { const int n = rho >> 4, i = rho & 15; return 8 * (i >> 2) + 4 * n + (i & 3); }
struct Unit { int pm, pn, sub; };
__device__ __forceinline__ unsigned cvt_pk_bf16(float lo, float hi) { unsigned r; asm volatile("v_cvt_pk_bf16_f32 %0, %1, %2" : "=v"(r) : "v"(lo), "v"(hi)); return r; }
__device__ __forceinline__ f32x2 gelu_pk(f32x2 v) {
    const f32x2 av = __builtin_elementwise_abs(v), d = av * 0.2316418882f + 1.0f;
    f32x2 t; t.x = __builtin_amdgcn_rcpf(d.x); t.y = __builtin_amdgcn_rcpf(d.y);
    f32x2 q = t * 0.5307027145f + (-0.7265760135f); q = q * t + 0.7107068705f; q = q * t + (-0.142248368f); q = q * t + 0.127414796f; q = q * t;
    const f32x2 s = (v * v) * (-0.72134752044f);
    f32x2 e; e.x = __builtin_amdgcn_exp2f(s.x); e.y = __builtin_amdgcn_exp2f(s.y);
    const f32x2 m = v * (q * e), r = v - m;
    f32x2 o; o.x = v.x < 0.f ? m.x : r.x; o.y = v.y < 0.f ? m.y : r.y; return o;
}
template <int NSUB = 1> struct StaticOrder {
    int nM, nN, nwg, G, c;
    __device__ void init(int nM_, int nN_, int G_, int c_) { nM = nM_; nN = nN_; nwg = nM * nN; G = G_; c = c_; }
    __device__ bool next(int i, Unit& u) const {
        const int it = i / NSUB; u.sub = i - it * NSUB;
        const long L = (long)it * G + c; if (L >= nwg) return false;
        int wgid = (int)L; { const int q = nwg / NXCD, r = nwg % NXCD, xcd = wgid % NXCD, off = wgid / NXCD; wgid = (xcd < r ? xcd * (q + 1) : r * (q + 1) + (xcd - r) * q) + off; }
        const int nig = WGM * nN, gid = wgid / nig, fm = gid * WGM, gsz = (nM - fm) < WGM ? (nM - fm) : WGM;
        u.pm = fm + ((wgid % nig) % gsz); u.pn = (wgid % nig) / gsz; return true;
    }
};
constexpr int SIDE_TOK = 131072 + 2048;
constexpr int SIDE_SLOT = 131072 + 10240, SIDE_SLOT_BYTES = 3072;
__device__ __forceinline__ void dma16(unsigned voff, const void* sbase, unsigned ldsaddr) { asm volatile("s_mov_b32 m0, %2\n\tglobal_load_lds_dwordx4 %0, %1" :: "v"(voff), "s"(sbase), "s"(ldsaddr) : "memory", "m0"); }
__device__ __forceinline__ void dma4(unsigned voff, const void* sbase, unsigned ldsaddr) { asm volatile("s_mov_b32 m0, %2\n\tglobal_load_lds_dword %0, %1" :: "v"(voff), "s"(sbase), "s"(ldsaddr) : "memory", "m0"); }
template <class Prob, class Sched, class Epi>
__device__ __forceinline__ void gemm_phase(LAS unsigned char* lds, const int tid, const Prob& P, const Sched& S, const Epi& E) {
    const int wid = __builtin_amdgcn_readfirstlane(tid >> 6), lane = tid & 63, wr = wid >> 2, wc = wid & 3, fr = lane & 15, fq = lane >> 4;
    const int lda = P.lda, ldb = P.ldb;
    unsigned voffB[2], offA[2][2];
#define PG8_TOKSLOT(name) const LAS int* name; { PG8_TID(tl2_); name = (const LAS int*)(lds + SIDE_TOK) + (tl2_ >> 6) * 256 + (tl2_ & 63); }
#define PG8_TID(v_) int v_; asm volatile("v_mbcnt_lo_u32_b32 %0, -1, 0\n\tv_mbcnt_hi_u32_b32 %0, -1, %0" : "=v"(v_)); v_ |= (wid << 6)
#define PG8_RC(R_, C_) int R_[2], C_[2]; { PG8_TID(tl_); _Pragma("unroll") for (int i_ = 0; i_ < 2; ++i_) stage_rc(tl_ * 16 + i_ * 8192, R_[i_], C_[i_]); }
#pragma unroll
    for (int i = 0; i < 2; ++i) { int R, C; stage_rc(tid * 16 + i * 8192, R, C); const int Rb = Epi::PERM ? ((R & ~31) + perm32(R & 31)) : R;
        voffB[i] = (unsigned)(Rb * ldb + C) * 2u;
        offA[0][i] = (unsigned)(R * lda + C) * 2u; offA[1][i] = (unsigned)((R + HALF) * lda + C) * 2u; }
    const size_t kstep = (size_t)(BK * 2);
    const size_t hstep = (size_t)HALF * ldb * 2;
    const unsigned ldsw = (unsigned)wid * 1024u;
    const int aoff = lds_byte(wr * 64 + fr, fq * 8), boff = lds_byte(wc * 32 + fr, fq * 8);
#define PG8_SA(b, h) (((b) * 2 + (h)) * HTB)
#define PG8_SB(b, h) ((4 + (b) * 2 + (h)) * HTB)
    const unsigned ldsb = (unsigned)(size_t)lds;
#define PG8_STAGE(bufoff, gbase, voff) do { _Pragma("unroll") for (int _i = 0; _i < 2; ++_i) \
        asm volatile("s_mov_b32 m0, %2\n\tglobal_load_lds_dwordx4 %0, %1" :: "v"((voff)[_i]), "s"((const char*)(gbase)), "s"(ldsb + (unsigned)(bufoff) + ldsw + (unsigned)(_i * 8192)) : "memory", "m0"); } while (0)
#define PG8_CAT(x0, x1) __builtin_shufflevector(x0, x1, 0, 1, 2, 3, 4, 5, 6, 7)
#define PG8_LDA(dst, b, h) do { if constexpr (Prob::FP8) { _Pragma("unroll") for (int m = 0; m < 4; ++m) dst##8[m] = PG8_CAT(*(const LAS i32x4*)(lds + PG8_SA(b, h) + aoff + m * 2048), *(const LAS i32x4*)(lds + PG8_SA(b, h) + aoff + m * 2048 + 1024)); } \
        else { _Pragma("unroll") for (int m = 0; m < 4; ++m) _Pragma("unroll") for (int k = 0; k < 2; ++k) dst[m][k] = *(const LAS bf16x8*)(lds + PG8_SA(b, h) + aoff + m * 2048 + k * 1024); } } while (0)
#define PG8_LDB(dst, b, h) do { if constexpr (Prob::FP8) { _Pragma("unroll") for (int n = 0; n < 2; ++n) dst##8[n] = PG8_CAT(*(const LAS i32x4*)(lds + PG8_SB(b, h) + boff + n * 2048), *(const LAS i32x4*)(lds + PG8_SB(b, h) + boff + n * 2048 + 1024)); } \
        else { _Pragma("unroll") for (int n = 0; n < 2; ++n) _Pragma("unroll") for (int k = 0; k < 2; ++k) dst[n][k] = *(const LAS bf16x8*)(lds + PG8_SB(b, h) + boff + n * 2048 + k * 1024); } } while (0)
#define PG8_MMA(ai, bj, At, Bt) do { __builtin_amdgcn_s_setprio(1); \
        if constexpr (Prob::FP8) { _Pragma("unroll") for (int m = 0; m < 4; ++m) _Pragma("unroll") for (int n = 0; n < 2; ++n) \
            acc[ai][bj][m][n] = __builtin_amdgcn_mfma_scale_f32_16x16x128_f8f6f4(Bt##8[n], At##8[m], acc[ai][bj][m][n], 0, 0, 0, sc8_, 0, sc8_); } \
        else { _Pragma("unroll") for (int m = 0; m < 4; ++m) _Pragma("unroll") for (int n = 0; n < 2; ++n) _Pragma("unroll") for (int k = 0; k < 2; ++k) \
            acc[ai][bj][m][n] = __builtin_amdgcn_mfma_f32_16x16x32_bf16(Bt[n][k], At[m][k], acc[ai][bj][m][n], 0, 0, 0); } \
        __builtin_amdgcn_s_setprio(0); } while (0)
#define PG8_WAIT_V(n) asm volatile("s_waitcnt vmcnt(" #n ")" ::: "memory")
#define PG8_WAIT_L(n) asm volatile("s_waitcnt lgkmcnt(" #n ")" ::: "memory")
#define PG8_BAR __builtin_amdgcn_s_barrier()
#define PG8_SCHED __builtin_amdgcn_sched_barrier(0)
    Unit cur, nxt; int ui = 0;
    if (!S.next(0, cur)) return;
    static_assert(Prob::SCALE_A == Prob::SCALE_B, "one scale register serves both operands");
    int sc8_; asm volatile("v_mov_b32 %0, %1" : "=v"(sc8_) : "n"(Prob::SCALE_A));
    f32x4 acc[2][2][4][2];
    float zero_; asm volatile("v_mov_b32 %0, 0" : "=v"(zero_));
#pragma unroll
    for (int a = 0; a < 2; ++a)
#pragma unroll
        for (int b = 0; b < 2; ++b)
#pragma unroll
            for (int m = 0; m < 4; ++m)
#pragma unroll
                for (int n = 0; n < 2; ++n) acc[a][b][m][n] = (f32x4){zero_, zero_, zero_, zero_};
    bf16x8 At[4][2], B0[2][2], B1[2][2]; i32x8 At8[4], B08[2], B18[2];
    const char* cA = P.a_base(cur); const char* cB = P.b_base(cur); int nt = P.nt(cur);
    if constexpr (Prob::GATHER) { PG8_RC(Rr, Cc); P.a_rows(cur, Rr, Cc, offA); }
    if constexpr (Epi::SIDE) { PG8_TID(tl4_); E.side(cur, ldsb + SIDE_SLOT, wid, tl4_ & 63); }
    PG8_STAGE(PG8_SB(0, 0), cB, voffB); PG8_STAGE(PG8_SB(0, 1), cB + hstep, voffB); PG8_STAGE(PG8_SA(0, 0), cA, offA[0]); PG8_STAGE(PG8_SA(0, 1), cA, offA[1]);
    if (wr == 1) PG8_BAR;
    PG8_WAIT_V(2); PG8_BAR;
    PG8_STAGE(PG8_SB(1, 0), cB + kstep, voffB); PG8_STAGE(PG8_SA(1, 0), cA + kstep, offA[0]); PG8_STAGE(PG8_SB(1, 1), cB + hstep + kstep, voffB);
    PG8_WAIT_V(6); PG8_BAR;
    for (;;) {
        const bool has_next = S.next(ui + 1, nxt);
        const char* nA = has_next ? P.a_base(nxt) : cA; const char* nB = has_next ? P.b_base(nxt) : cB;
        if constexpr (Prob::GATHER) { if (has_next) { PG8_RC(Rr, Cc); (void)Cc;
#pragma unroll
            for (int h = 0; h < 2; ++h)
#pragma unroll
                for (int i = 0; i < 2; ++i) dma4((unsigned)(nxt.pm * 256 + h * 128 + Rr[i]) * 4u, P.tok, ldsb + SIDE_TOK + (unsigned)wid * 1024u + (unsigned)((h * 2 + i) * 256)); } }
        if constexpr (Epi::SIDE) { if (has_next) { PG8_TID(tl4_); E.side(nxt, ldsb + SIDE_SLOT + (unsigned)(((ui + 1) % 3) * SIDE_SLOT_BYTES), wid, tl4_ & 63); } }
        for (int t = 0; t < nt; t += 2) {
            const bool last = (t == nt - 2);
            if constexpr (Epi::KHOOK) { if (t == Epi::HOOK_T0 || t == Epi::HOOK_T1) {
                asm volatile("" ::: "memory"); PG8_TID(tlh_); const int lnh_ = tlh_ & 63; E.hook(acc, cur, t == Epi::HOOK_T0 ? 0 : 1, wr, wc, lnh_ & 15, lnh_ >> 4); asm volatile("" ::: "memory"); } }
            const char* a1 = cA + (size_t)(t + 1) * kstep;
            const char* a2 = last ? nA : cA + (size_t)(t + 2) * kstep; const char* b2 = last ? nB : cB + (size_t)(t + 2) * kstep;
            const char* a3 = a2 + kstep; const char* b3 = b2 + kstep;
            PG8_LDB(B0, 0, 0); PG8_LDB(B1, 0, 1); PG8_SCHED; PG8_LDA(At, 0, 0); PG8_STAGE(PG8_SA(1, 1), a1, offA[1]);
            PG8_WAIT_V(8); PG8_WAIT_L(0); PG8_BAR; PG8_MMA(0, 0, At, B0); PG8_MMA(0, 1, At, B1); PG8_BAR; PG8_SCHED;
            if constexpr (Prob::GATHER) { if (last && has_next) { PG8_RC(Rr, Cc); (void)Rr; PG8_TOKSLOT(tokslot); const int ntok[2][2] = {{tokslot[0], tokslot[64]}, {tokslot[128], tokslot[192]}}; P.a_off(ntok, Cc, offA); } }
            PG8_LDA(At, 0, 1); PG8_STAGE(PG8_SB(0, 0), b2, voffB); PG8_STAGE(PG8_SB(0, 1), b2 + hstep, voffB); PG8_STAGE(PG8_SA(0, 0), a2, offA[0]);
            PG8_WAIT_V(8); PG8_WAIT_L(0); PG8_BAR; PG8_MMA(1, 0, At, B0); PG8_MMA(1, 1, At, B1); PG8_BAR; PG8_SCHED;
            PG8_LDB(B0, 1, 0); PG8_LDB(B1, 1, 1); PG8_SCHED; PG8_LDA(At, 1, 0); PG8_STAGE(PG8_SA(0, 1), a2, offA[1]);
            PG8_WAIT_V(8); PG8_WAIT_L(0); PG8_BAR; PG8_MMA(0, 0, At, B0); PG8_MMA(0, 1, At, B1); PG8_BAR; PG8_SCHED;
            PG8_LDA(At, 1, 1); PG8_STAGE(PG8_SB(1, 0), b3, voffB); PG8_STAGE(PG8_SB(1, 1), b3 + hstep, voffB); PG8_STAGE(PG8_SA(1, 0), a3, offA[0]);
            PG8_WAIT_V(8); PG8_WAIT_L(0); PG8_BAR; PG8_MMA(1, 0, At, B0); PG8_MMA(1, 1, At, B1); PG8_BAR; PG8_SCHED;
        }
        if (wr == 0) PG8_BAR;
        { PG8_TID(tl3_); const int ln_ = tl3_ & 63; E(acc, cur, wr, wc, ln_ & 15, ln_ >> 4, lds + SIDE_SLOT + (ui % 3) * SIDE_SLOT_BYTES); }
        if (!has_next) break;
        bool keep = false;
        if constexpr (Epi::CHAIN) keep = E.keep(cur);
        if (!keep) {
            asm volatile("v_mov_b32 %0, 0" : "=v"(zero_));
#pragma unroll
            for (int a = 0; a < 2; ++a)
#pragma unroll
                for (int b = 0; b < 2; ++b)
#pragma unroll
                    for (int m = 0; m < 4; ++m)
#pragma unroll
                        for (int n = 0; n < 2; ++n) acc[a][b][m][n] = (f32x4){zero_, zero_, zero_, zero_};
        }
        cur = nxt; cA = nA; cB = nB; nt = P.nt(cur); ++ui;
        if (wr == 1) PG8_BAR;
    }
    PG8_WAIT_V(0);
    PG8_BAR;
#undef PG8_RC
#undef PG8_TID
#undef PG8_TOKSLOT
#undef PG8_SA
#undef PG8_SB
#undef PG8_STAGE
#undef PG8_LDA
#undef PG8_LDB
#undef PG8_MMA
#undef PG8_CAT
#undef PG8_WAIT_V
#undef PG8_WAIT_L
#undef PG8_BAR
#undef PG8_SCHED
}
}

typedef const float* cfp_t;
typedef const cfp_t __attribute__((address_space(4))) * InTab;
struct Frame {
    LAS unsigned char* lds;
    volatile LAS unsigned* MISC;
    unsigned char* ws;
    InTab in;
    float* out;
    int tid, lane, wave, G, bid;
};
enum { IN_X = 0, IN_C, IN_CTX, IN_CCTX, IN_WADA, IN_BADA, IN_WIN, IN_BIN, IN_POOLW, IN_POOLS, IN_CONVW, IN_CONVB, IN_MNG, IN_SLNG, IN_SLNB, IN_SGUW, IN_SGUB,
       IN_WBP, IN_WBM, IN_WBS, IN_WOUT, IN_LN1G, IN_LN1B, IN_WR, IN_BR, IN_WGU, IN_BGU, IN_WDN, IN_BDN, IN_LN2G, IN_LN2B };
__device__ __forceinline__ int mod_row(int row) { return row < ML ? (row >> 12) : NB; }
__device__ __forceinline__ const float* modp(const Frame& F, int l, int row, int part) { return (const float*)(F.ws + WS_MOD) + ((size_t)(l * 17 + mod_row(row)) * 6 + part) * 1024; }

__device__ __forceinline__ void transpose_item(const float* W, size_t ldw, int k0, int srccol0, bf16_t* dst, size_t ldk, int kd0, LAS float* scr, int lane) {
#pragma unroll 8
    for (int i = 0; i < 32; ++i) { const int kk = 2 * i + (lane >> 5); scr[kk * 33 + (lane & 31)] = __builtin_nontemporal_load(W + (size_t)(k0 + kk) * ldw + srccol0 + (lane & 31)); }
    LDS_WAIT(); asm volatile("" ::: "memory");
    const int c = lane & 7;
#pragma unroll
    for (int j = 0; j < 4; ++j) { const int n = (lane >> 3) + 8 * j; const LAS float* s = scr + (8 * c) * 33 + n;
        u32x4 o; o.x = pk2(s[0 * 33], s[1 * 33]); o.y = pk2(s[2 * 33], s[3 * 33]); o.z = pk2(s[4 * 33], s[5 * 33]); o.w = pk2(s[6 * 33], s[7 * 33]);
        *(u32x4*)(dst + (size_t)n * ldk + kd0 + 8 * c) = o; }
    LDS_WAIT(); asm volatile("" ::: "memory");
}
__device__ __forceinline__ void transpose_item_fp8(const float* W, size_t ldw, int k0, int srccol0, unsigned char* dst, size_t ldk, int kd0, float sc, LAS float* scr, int lane) {
#pragma unroll 8
    for (int i = 0; i < 32; ++i) { const int kk = 2 * i + (lane >> 5); scr[kk * 33 + (lane & 31)] = __builtin_nontemporal_load(W + (size_t)(k0 + kk) * ldw + srccol0 + (lane & 31)); }
    LDS_WAIT(); asm volatile("" ::: "memory");
    const int c = lane & 7;
#pragma unroll
    for (int j = 0; j < 4; ++j) { const int n = (lane >> 3) + 8 * j; const LAS float* s_ = scr + (8 * c) * 33 + n;
        u32x2 o; o.x = pk4_fp8(s_[0 * 33] * sc, s_[1 * 33] * sc, s_[2 * 33] * sc, s_[3 * 33] * sc); o.y = pk4_fp8(s_[4 * 33] * sc, s_[5 * 33] * sc, s_[6 * 33] * sc, s_[7 * 33] * sc);
        *(u32x2*)(dst + (size_t)n * ldk + kd0 + 8 * c) = o; }
    LDS_WAIT(); asm volatile("" ::: "memory");
}
__device__ __forceinline__ void phase_prologue(Frame& F) {
    LAS float* scr = (LAS float*)(F.lds + F.wave * 16384);
    const int gw = F.bid * NWAVES + F.wave, NGW = F.G * NWAVES;
    constexpr int I_IN = 16 * (NZ / 32);
    constexpr int I_BR = (4 + 8 + 4) * 32;
    constexpr int I_OUT = 16 * 32;
    constexpr int I_GU = 16 * 64;
    constexpr int I_DN = 16 * 32;
    constexpr int T_IN = DEPTH * I_IN, T_BR = DEPTH * I_BR, T_OUT = DEPTH * I_OUT, T_GU = DEPTH * NEXP * I_GU, T_DN = DEPTH * NEXP * I_DN;
    constexpr int NITEMS = T_IN + T_BR + T_OUT + T_GU + T_DN;
    for (int it = gw; it < NITEMS; it += NGW) {
        int r = it;
        if (r < T_IN) { const int l = r / I_IN; r %= I_IN; const int kb = r / (NZ / 32), nb = r % (NZ / 32); const int n0 = nb * 32, src = n0 < 2304 ? n0 : n0 + 16;
            if (n0 < NZ_BF) transpose_item(F.in[IN_WIN] + (size_t)l * D * 5904, 5904, kb * 64, src, (bf16_t*)(F.ws + WS_WIN) + ((size_t)l * NZ + n0) * D, D, kb * 64, scr, F.lane);
            else transpose_item_fp8(F.in[IN_WIN] + (size_t)l * D * 5904, 5904, kb * 64, src, (unsigned char*)(F.ws + WS_WIN8) + ((size_t)l * NZ_F8 + (n0 - NZ_BF)) * D, D, kb * 64, F8S_WGU, scr, F.lane);
            continue; }
        r -= T_IN;
        if (r < T_BR) { const int l = r / I_BR; r %= I_BR; const int kb = r / 32, nb = r % 32;
            const float* W; int ksrc;
            if (kb < 4) { W = F.in[IN_WBP] + (size_t)l * 256 * D; ksrc = kb * 64; } else if (kb < 12) { W = F.in[IN_WBM] + (size_t)l * 512 * D; ksrc = (kb - 4) * 64; } else { W = F.in[IN_WBS] + (size_t)l * 256 * D; ksrc = (kb - 12) * 64; }
            transpose_item(W, D, ksrc, nb * 32, (bf16_t*)(F.ws + WS_WBR) + ((size_t)l * D + nb * 32) * D, D, kb * 64, scr, F.lane); continue; }
        r -= T_BR;
        if (r < T_OUT) { const int l = r / I_OUT; r %= I_OUT; const int kb = r / 32, nb = r % 32;
            transpose_item(F.in[IN_WOUT] + (size_t)l * D * D, D, kb * 64, nb * 32, (bf16_t*)(F.ws + WS_WOUT) + ((size_t)l * D + nb * 32) * D, D, kb * 64, scr, F.lane); continue; }
        r -= T_OUT;
        if (r < T_GU) { const int le = r / I_GU; r %= I_GU; const int kb = r / 64, nb = r % 64; const int n0 = nb * 32;
            const int pn = n0 >> 8, c = n0 & 255; const int src = c < 128 ? (128 * pn + c) : (1024 + 128 * pn + c - 128);
            transpose_item_fp8(F.in[IN_WGU] + (size_t)le * D * 2048, 2048, kb * 64, src, (unsigned char*)(F.ws + WS_WGU) + ((size_t)le * 2048 + n0) * D, D, kb * 64, F8S_WGU, scr, F.lane); continue; }
        r -= T_GU;
        { const int le = r / I_DN; r %= I_DN; const int kb = r / 32, nb = r % 32;
            transpose_item_fp8(F.in[IN_WDN] + (size_t)le * D * D, D, kb * 64, nb * 32, (unsigned char*)(F.ws + WS_WDN) + ((size_t)le * D + nb * 32) * D, D, kb * 64, F8S_WDN, scr, F.lane); }
    }
    { const int gt = F.bid * NTHREADS + F.tid, NGT = F.G * NTHREADS;
      for (int i = gt; i < DEPTH * 16 * 1024; i += NGT) { const int l = i >> 14, g = (i >> 10) & 15, k = i & 1023; ((float*)(F.ws + WS_WG))[i] = F.in[IN_WIN][((size_t)l * D + k) * 5904 + 2304 + g]; }
      for (int i = gt; i < DEPTH * 4 * 128 * 128; i += NGT) ((bf16_t*)(F.ws + WS_WSGU))[i] = (bf16_t)f2bf(F.in[IN_SGUW][i]);
      for (int i = gt; i < DEPTH * 4 * 64 * 64; i += NGT) { const int lg = i >> 12, d = (i >> 6) & 63, c = i & 63; ((bf16_t*)(F.ws + WS_WPOOL))[i] = (bf16_t)f2bf(F.in[IN_POOLW][(size_t)lg * 4096 + c * 64 + d]); } }
    __syncthreads();
    { LAS float* sc = (LAS float*)F.lds;
      LAS float* part = (LAS float*)(F.lds + 71680);
      for (int i = F.tid; i < 17 * 1024; i += NTHREADS) { const int r = i >> 10, k = i & 1023; const float v = r < 16 ? F.in[IN_C][r * 1024 + k] : F.in[IN_CCTX][k]; sc[i] = siluf_(v); }
      __syncthreads();
      for (int u = F.bid; u < DEPTH * 48; u += F.G) {
          const int l = u / 48, n0 = (u % 48) * 128, col = F.tid & 127, ks = F.tid >> 7;
          float a[17];
#pragma unroll
          for (int r = 0; r < 17; ++r) a[r] = 0.f;
          const float* W = F.in[IN_WADA] + (size_t)l * D * 6144 + n0 + col;
          for (int k = ks * 256; k < ks * 256 + 256; ++k) { const float w = W[(size_t)k * 6144];
#pragma unroll
              for (int r = 0; r < 17; ++r) a[r] += sc[r * 1024 + k] * w; }
#pragma unroll
          for (int r = 0; r < 17; ++r) part[(ks * 17 + r) * 128 + col] = a[r];
          __syncthreads();
          for (int i = F.tid; i < 17 * 128; i += NTHREADS) { const int r = i >> 7, cc = i & 127;
              const float s = part[(0 * 17 + r) * 128 + cc] + part[(1 * 17 + r) * 128 + cc] + part[(2 * 17 + r) * 128 + cc] + part[(3 * 17 + r) * 128 + cc] + F.in[IN_BADA][l * 6144 + n0 + cc];
              ((float*)(F.ws + WS_MOD))[(size_t)(l * 17 + r) * 6144 + n0 + cc] = s; }
          __syncthreads();
      } }
}

struct RowV { f32x4 v[4]; };
#define RC(lane, j) (8 * (lane) + 512 * ((j) >> 1) + 4 * ((j) & 1))
__device__ __forceinline__ void row_load(RowV& r, const float* p, int lane) {
#pragma unroll
    for (int j = 0; j < 4; ++j) r.v[j] = __builtin_nontemporal_load((const f32x4*)(p + RC(lane, j)));
}
__device__ __forceinline__ void row_load_bf16(RowV& r, const bf16_t* p, int lane) {
#pragma unroll
    for (int h = 0; h < 2; ++h) { const u32x4 w = __builtin_nontemporal_load((const u32x4*)(p + 8 * lane + 512 * h)); r.v[2 * h] = (f32x4){bflo(w.x), bfhi(w.x), bflo(w.y), bfhi(w.y)}; r.v[2 * h + 1] = (f32x4){bflo(w.z), bfhi(w.z), bflo(w.w), bfhi(w.w)}; }
}
__device__ __forceinline__ void row_store(const RowV& r, float* p, int lane) {
#pragma unroll
    for (int j = 0; j < 4; ++j) *(f32x4*)(p + RC(lane, j)) = r.v[j];
}
__device__ __forceinline__ void row_store_nt(const RowV& r, float* p, int lane) {
#pragma unroll
    for (int j = 0; j < 4; ++j) __builtin_nontemporal_store(r.v[j], (f32x4*)(p + RC(lane, j)));
}
__device__ __forceinline__ void row_store_bf16_nt(const RowV& r, bf16_t* p, int lane) {
#pragma unroll
    for (int h = 0; h < 2; ++h) { u32x4 w; w.x = pk2(r.v[2 * h].x, r.v[2 * h].y); w.y = pk2(r.v[2 * h].z, r.v[2 * h].w); w.z = pk2(r.v[2 * h + 1].x, r.v[2 * h + 1].y); w.w = pk2(r.v[2 * h + 1].z, r.v[2 * h + 1].w); __builtin_nontemporal_store(w, (u32x4*)(p + 8 * lane + 512 * h)); }
}
__device__ __forceinline__ void row_store_bf16(const RowV& r, bf16_t* p, int lane) {
#pragma unroll
    for (int h = 0; h < 2; ++h) { u32x4 w; w.x = pk2(r.v[2 * h].x, r.v[2 * h].y); w.y = pk2(r.v[2 * h].z, r.v[2 * h].w); w.z = pk2(r.v[2 * h + 1].x, r.v[2 * h + 1].y); w.w = pk2(r.v[2 * h + 1].z, r.v[2 * h + 1].w); *(u32x4*)(p + 8 * lane + 512 * h) = w; }
}
__device__ __forceinline__ void row_ln_plain(RowV& r, int lane) {
    float s = 0.f;
#pragma unroll
    for (int j = 0; j < 4; ++j) s += (r.v[j].x + r.v[j].y) + (r.v[j].z + r.v[j].w);
    const float mean = wave_sum(s, lane) * (1.f / D); float s2 = 0.f;
#pragma unroll
    for (int j = 0; j < 4; ++j) { r.v[j] = r.v[j] - mean; s2 += (r.v[j].x * r.v[j].x + r.v[j].y * r.v[j].y) + (r.v[j].z * r.v[j].z + r.v[j].w * r.v[j].w); }
    const float rstd = 1.f / sqrtf(wave_sum(s2, lane) * (1.f / D) + LN_EPS);
#pragma unroll
    for (int j = 0; j < 4; ++j) r.v[j] = r.v[j] * rstd;
}
__device__ __forceinline__ void row_affine(RowV& r, const float* g, const float* b, int lane) {
#pragma unroll
    for (int j = 0; j < 4; ++j) { const f32x4 gg = *(const f32x4*)(g + RC(lane, j)), bb = *(const f32x4*)(b + RC(lane, j)); r.v[j] = r.v[j] * gg + bb; }
}
__device__ __forceinline__ void row_modulate(RowV& r, const float* sh, const float* sc, int lane) {
#pragma unroll
    for (int j = 0; j < 4; ++j) { const f32x4 s1 = *(const f32x4*)(sc + RC(lane, j)), s0 = *(const f32x4*)(sh + RC(lane, j)); r.v[j] = r.v[j] * (s1 + 1.0f) + s0; }
}
__device__ __forceinline__ LAS float* pv_slot(const Frame& F, int slot) { return (LAS float*)(F.lds + NW_PV) + slot * 1024; }
__device__ __forceinline__ void pv_fill(Frame& F, int slot, const float* src) { LAS f32x4* d = (LAS f32x4*)pv_slot(F, slot); for (int i = F.tid; i < 256; i += NTHREADS) d[i] = *(const f32x4*)(src + 4 * i); }
__device__ __forceinline__ void row_affine_l(RowV& r, const LAS float* g, const LAS float* b, int lane) {
#pragma unroll
    for (int j = 0; j < 4; ++j) { const f32x4 gg = *(const LAS f32x4*)(g + RC(lane, j)), bb = *(const LAS f32x4*)(b + RC(lane, j)); r.v[j] = r.v[j] * gg + bb; }
}
__device__ __forceinline__ void row_modulate_l(RowV& r, const LAS float* sh, const LAS float* sc, int lane) {
#pragma unroll
    for (int j = 0; j < 4; ++j) { const f32x4 s1 = *(const LAS f32x4*)(sc + RC(lane, j)), s0 = *(const LAS f32x4*)(sh + RC(lane, j)); r.v[j] = r.v[j] * (s1 + 1.0f) + s0; }
}
__device__ __forceinline__ void ln0_row(Frame& F, int row, RowV xr, const LAS float* sh, const LAS float* sc) {
    row_ln_plain(xr, F.lane);
    row_modulate_l(xr, sh, sc, F.lane);
    row_store_bf16(xr, (bf16_t*)(F.ws + WS_H) + (size_t)row * D, F.lane);
    { unsigned char* h8 = (unsigned char*)(F.ws + WS_H8) + (size_t)row * D + 8 * F.lane;
#pragma unroll
      for (int h = 0; h < 2; ++h) { u32x2 w; w.x = pk4_fp8(xr.v[2 * h].x * F8S_ACT, xr.v[2 * h].y * F8S_ACT, xr.v[2 * h].z * F8S_ACT, xr.v[2 * h].w * F8S_ACT); w.y = pk4_fp8(xr.v[2 * h + 1].x * F8S_ACT, xr.v[2 * h + 1].y * F8S_ACT, xr.v[2 * h + 1].z * F8S_ACT, xr.v[2 * h + 1].w * F8S_ACT); *(u32x2*)(h8 + 512 * h) = w; } }
}
__device__ __forceinline__ LAS float* narrow_tile_wave(Frame& F, const bf16_t* A) {
    const int r = F.lane & 31, h = F.lane >> 5;
    f32x16 acc;
#pragma unroll
    for (int i = 0; i < 16; ++i) acc[i] = 0.f;
    const bf16_t* ap = A + (size_t)r * D + 8 * h;
    const LAS unsigned char* bp = F.lds + NW_WT + r * 2064 + 16 * h;
    bf16x8 av[2][16];
#pragma unroll
    for (int ks = 0; ks < 16; ++ks) av[0][ks] = *(const bf16x8*)(ap + ks * 16);
#pragma unroll
    for (int kb = 0; kb < 4; ++kb) {
        if (kb < 3) {
#pragma unroll
            for (int ks = 0; ks < 16; ++ks) av[(kb + 1) & 1][ks] = *(const bf16x8*)(ap + ((kb + 1) * 16 + ks) * 16); }
        __builtin_amdgcn_sched_barrier(0);
#pragma unroll
        for (int ks = 0; ks < 16; ++ks) { const bf16x8 b = *(const LAS bf16x8*)(bp + (kb * 16 + ks) * 32); acc = __builtin_amdgcn_mfma_f32_32x32x16_bf16(av[kb & 1][ks], b, acc, 0, 0, 0); }
        __builtin_amdgcn_sched_barrier(0);
    }
    LAS float* lg = (LAS float*)(F.lds + NW_LG) + F.wave * 1056;
#pragma unroll
    for (int i = 0; i < 16; ++i) lg[((i & 3) + 8 * (i >> 2) + 4 * h) * 33 + r] = acc[i];
    asm volatile("s_waitcnt lgkmcnt(0)" ::: "memory");
    return lg;
}
__device__ __forceinline__ void tile_range(const Frame& F, int mrows, int& t_lo, int& t_hi) { const int nt = mrows / 32; t_lo = (int)(((long)F.bid * nt) / F.G); t_hi = (int)(((long)(F.bid + 1) * nt) / F.G); }
__device__ __forceinline__ void load_wg_lds(Frame& F, int l) {
    const float* src = (const float*)(F.ws + WS_WG) + (size_t)l * 16384;
    for (int i = F.tid; i < 32 * 128; i += NTHREADS) { const int g = i >> 7, c8 = i & 127; u32x4 w = (u32x4){0u, 0u, 0u, 0u};
        if (g < 16) { const f32x4 a = *(const f32x4*)(src + g * 1024 + c8 * 8), b = *(const f32x4*)(src + g * 1024 + c8 * 8 + 4); w.x = pk2(a.x, a.y); w.y = pk2(a.z, a.w); w.z = pk2(b.x, b.y); w.w = pk2(b.z, b.w); }
        *(LAS u32x4*)(F.lds + NW_WT + g * 2064 + c8 * 16) = w; }
    __syncthreads();
}
__device__ __forceinline__ void gates_tail(Frame& F, int l, int t_lo, int t_hi) {
    asm volatile("s_waitcnt vmcnt(0)" ::: "memory"); __syncthreads();
    const int g = F.lane & 15; const float bias = F.in[IN_BIN][l * 5904 + 2304 + g];
    for (int tile = t_lo + F.wave; tile < t_hi; tile += NWAVES) {
        const LAS float* lg = narrow_tile_wave(F, (const bf16_t*)(F.ws + WS_H) + (size_t)tile * 32 * D);
#pragma unroll
        for (int rr = 0; rr < 8; ++rr) { const int row = rr * 4 + (F.lane >> 4); ((float*)(F.ws + WS_ZG))[(size_t)(tile * 32 + row) * 16 + g] = lg[row * 33 + g] + bias; }
        asm volatile("s_waitcnt lgkmcnt(0)" ::: "memory");
    }
}

using pg8::Unit;
struct ProbPlain {
    static constexpr bool GATHER = false, FP8 = false; static constexpr int SCALE_A = 127, SCALE_B = 127; const bf16_t* A; const bf16_t* Bt; int lda, ldb;
    __device__ __forceinline__ int nt(const Unit&) const { return lda / 64; }
    __device__ __forceinline__ const char* a_base(const Unit& u) const { return (const char*)A + (size_t)u.pm * 256 * lda * 2; }
    __device__ __forceinline__ const char* b_base(const Unit& u) const { return (const char*)Bt + (size_t)u.pn * 256 * ldb * 2; }
    __device__ __forceinline__ void a_tok(const Unit&, const int (&)[2], int (&)[2][2]) const {}
    __device__ __forceinline__ void a_off(const int (&)[2][2], const int (&)[2], unsigned (&)[2][2]) const {}
    __device__ __forceinline__ void a_rows(const Unit&, const int (&)[2], const int (&)[2], unsigned (&)[2][2]) const {}
};
struct ProbPlainF8 {
    static constexpr bool GATHER = false, FP8 = true; static constexpr int SCALE_A = F8E_ACT, SCALE_B = F8E_WGU; const bf16_t* A; const bf16_t* Bt; int lda, ldb;
    __device__ __forceinline__ int nt(const Unit&) const { return lda / 64; }
    __device__ __forceinline__ const char* a_base(const Unit& u) const { return (const char*)A + (size_t)u.pm * 256 * lda * 2; }
    __device__ __forceinline__ const char* b_base(const Unit& u) const { return (const char*)Bt + (size_t)u.pn * 256 * ldb * 2; }
    __device__ __forceinline__ void a_tok(const Unit&, const int (&)[2], int (&)[2][2]) const {}
    __device__ __forceinline__ void a_off(const int (&)[2][2], const int (&)[2], unsigned (&)[2][2]) const {}
    __device__ __forceinline__ void a_rows(const Unit&, const int (&)[2], const int (&)[2], unsigned (&)[2][2]) const {}
};
struct ProbBranch {
    static constexpr bool GATHER = false, FP8 = false; static constexpr int SCALE_A = 127, SCALE_B = 127; const bf16_t* A; const bf16_t* Bt; int lda, ldb;
    __device__ __forceinline__ int nt(const Unit& u) const { return u.sub == 1 ? 8 : 4; }
    __device__ __forceinline__ int koff(const Unit& u) const { return u.sub == 0 ? 0 : (u.sub == 1 ? 256 : 768); }
    __device__ __forceinline__ const char* a_base(const Unit& u) const { return (const char*)A + ((size_t)u.pm * 256 * lda + koff(u)) * 2; }
    __device__ __forceinline__ const char* b_base(const Unit& u) const { return (const char*)Bt + ((size_t)u.pn * 256 * ldb + koff(u)) * 2; }
    __device__ __forceinline__ void a_tok(const Unit&, const int (&)[2], int (&)[2][2]) const {}
    __device__ __forceinline__ void a_off(const int (&)[2][2], const int (&)[2], unsigned (&)[2][2]) const {}
    __device__ __forceinline__ void a_rows(const Unit&, const int (&)[2], const int (&)[2], unsigned (&)[2][2]) const {}
};
__device__ __forceinline__ int expert_of(const LAS int* seg, int pm) { return __builtin_amdgcn_readfirstlane((int)((const LAS unsigned char*)(seg + 64))[pm]); }
__device__ __forceinline__ int moe_tables(Frame& F, LAS int* seg) {
    __syncthreads();
    if (F.tid <= NEXP) seg[F.tid] = ((const int*)(F.ws + WS_ROUTE + RT_SEG))[F.tid];
    __syncthreads();
    const int ntile = seg[NEXP] / 256;
    LAS unsigned char* texp = (LAS unsigned char*)(seg + 64);
    for (int t = F.tid; t < ntile; t += NTHREADS) { const int row = t * 256; int e = 0;
#pragma unroll
        for (int i = 1; i < NEXP; ++i) e += (seg[i] <= row) ? 1 : 0;
        texp[t] = (unsigned char)e; }
    __syncthreads();
    return ntile;
}
struct ProbMoe1 {
    static constexpr bool GATHER = true, FP8 = true; static constexpr int SCALE_A = F8E_ACT, SCALE_B = F8E_WGU; const bf16_t* A; const bf16_t* Bt; int lda, ldb; const int* tok; const LAS int* seg;
    __device__ __forceinline__ int nt(const Unit&) const { return lda / 64; }
    __device__ __forceinline__ const char* a_base(const Unit&) const { return (const char*)A; }
    __device__ __forceinline__ const char* b_base(const Unit& u) const { const int e = expert_of(seg, u.pm); return (const char*)Bt + ((size_t)e * 2048 + (size_t)u.pn * 256) * ldb * 2; }
    __device__ __forceinline__ void a_rows(const Unit& u, const int (&R)[2], const int (&C)[2], unsigned (&off)[2][2]) const {
#pragma unroll
        for (int h = 0; h < 2; ++h)
#pragma unroll
            for (int i = 0; i < 2; ++i) { const int t = tok[u.pm * 256 + h * 128 + R[i]]; off[h][i] = (unsigned)(t * lda + C[i]) * 2u; } }
    __device__ __forceinline__ void a_tok(const Unit& u, const int (&R)[2], int (&tk)[2][2]) const {
#pragma unroll
        for (int h = 0; h < 2; ++h)
#pragma unroll
            for (int i = 0; i < 2; ++i) tk[h][i] = tok[u.pm * 256 + h * 128 + R[i]]; }
    __device__ __forceinline__ void a_off(const int (&tk)[2][2], const int (&C)[2], unsigned (&off)[2][2]) const {
#pragma unroll
        for (int h = 0; h < 2; ++h)
#pragma unroll
            for (int i = 0; i < 2; ++i) off[h][i] = (unsigned)(tk[h][i] * lda + C[i]) * 2u; }
};
struct ProbMoe2 {
    static constexpr bool GATHER = false, FP8 = true; static constexpr int SCALE_A = F8E_ACT, SCALE_B = F8E_WDN; const bf16_t* A; const bf16_t* Bt; int lda, ldb; const LAS int* seg;
    __device__ __forceinline__ int nt(const Unit&) const { return lda / 64; }
    __device__ __forceinline__ const char* a_base(const Unit& u) const { return (const char*)A + (size_t)u.pm * 256 * lda * 2; }
    __device__ __forceinline__ const char* b_base(const Unit& u) const { const int e = expert_of(seg, u.pm); return (const char*)Bt + ((size_t)e * 1024 + (size_t)u.pn * 256) * ldb * 2; }
    __device__ __forceinline__ void a_tok(const Unit&, const int (&)[2], int (&)[2][2]) const {}
    __device__ __forceinline__ void a_off(const int (&)[2][2], const int (&)[2], unsigned (&)[2][2]) const {}
    __device__ __forceinline__ void a_rows(const Unit&, const int (&)[2], const int (&)[2], unsigned (&)[2][2]) const {}
};
using pg8::cvt_pk_bf16;
template <bool G8> struct EpiInproj {
    static constexpr bool PERM = true, CHAIN = false, SIDE = true, KHOOK = false; bf16_t* Z; const float* bias; int pn0;
    __device__ __forceinline__ void side(const Unit& u0, unsigned slot, int wid, int lane) const { const int pn = u0.pn + pn0; if (wid == 1) pg8::dma16((unsigned)lane * 16u, bias + pn * 256 + (pn >= 9 ? 16 : 0), slot); }
    __device__ __forceinline__ void operator()(const f32x4 (&acc)[2][2][4][2], const Unit& u0, int wr, int wc, int fr, int fq, const LAS unsigned char* sd) const {
        Unit u = u0; u.pn += pn0;
        int row0 = u.pm * 256 + wr * 64 + fr, col0 = u.pn * 256 + wc * 32 + 8 * fq; asm volatile("" : "+v"(row0), "+v"(col0));
        const int act = (u.pn <= 6) ? 0 : ((u.pn == 9 || u.pn == 10) ? 2 : 1);
        f32x4 bv[2][2];
#pragma unroll
        for (int bj = 0; bj < 2; ++bj)
#pragma unroll
            for (int n = 0; n < 2; ++n) bv[bj][n] = *(const LAS f32x4*)(sd + (bj * 128 + wc * 32 + 8 * fq + 4 * n) * 4);
#pragma unroll
        for (int ai = 0; ai < 2; ++ai)
#pragma unroll
            for (int m = 0; m < 4; ++m) { bf16_t* rowp = Z + (size_t)(row0 + ai * 128 + m * 16) * NZ + col0;
#pragma unroll
                for (int bj = 0; bj < 2; ++bj) { f32x4 v0 = acc[ai][bj][m][0] + bv[bj][0], v1 = acc[ai][bj][m][1] + bv[bj][1];
                    if (G8 && u.pn >= ZG_COL / 256) { u32x2 w8;
                        v0 = sigmoid4(v0) * G8_SCALE; v1 = sigmoid4(v1) * G8_SCALE;
#pragma unroll
                        for (int j = 0; j < 4; ++j) { v0[j] = fmaxf(v0[j], 1.0f); v1[j] = fmaxf(v1[j], 1.0f); }
                        v0 = v0 + 12582912.0f; v1 = v1 + 12582912.0f;
                        w8.x = pk4_u8(v0[0], v0[1], v0[2], v0[3]); w8.y = pk4_u8(v1[0], v1[1], v1[2], v1[3]);
                        *(u32x2*)((unsigned char*)(Z + (size_t)(row0 + ai * 128 + m * 16) * NZ + ZG_COL) + (col0 - ZG_COL) + bj * 128) = w8; continue; }
                    if (act == 2) { f32x2 a = pg8::gelu_pk((f32x2){v0[0], v0[1]}), b = pg8::gelu_pk((f32x2){v0[2], v0[3]}), c = pg8::gelu_pk((f32x2){v1[0], v1[1]}), d = pg8::gelu_pk((f32x2){v1[2], v1[3]});
                        v0 = (f32x4){a.x, a.y, b.x, b.y}; v1 = (f32x4){c.x, c.y, d.x, d.y}; }
                    if (act == 1) { v0 = sigmoid4(v0); v1 = sigmoid4(v1); }
                    u32x4 w; w.x = cvt_pk_bf16(v0[0], v0[1]); w.y = cvt_pk_bf16(v0[2], v0[3]); w.z = cvt_pk_bf16(v1[0], v1[1]); w.w = cvt_pk_bf16(v1[2], v1[3]);
                    *(u32x4*)(rowp + bj * 128) = w; }
                if constexpr (G8) asm volatile("" ::: "memory"); }
    }
};
struct EpiNull {
    static constexpr bool PERM = true, CHAIN = false; bf16_t* Z;
    __device__ __forceinline__ void operator()(const f32x4 (&acc)[2][2][4][2], const Unit& u, int wr, int wc, int fr, int fq) const {
        float sacc = 0.f;
#pragma unroll
        for (int ai = 0; ai < 2; ++ai)
#pragma unroll
            for (int bj = 0; bj < 2; ++bj)
#pragma unroll
                for (int m = 0; m < 4; ++m)
#pragma unroll
                    for (int n = 0; n < 2; ++n) sacc += (acc[ai][bj][m][n][0] + acc[ai][bj][m][n][1]) + (acc[ai][bj][m][n][2] + acc[ai][bj][m][n][3]);
        if (sacc == 1.2345e30f) Z[u.pm + wr + wc + fr + fq] = 0;
    }
};
struct EpiOut {
    static constexpr bool PERM = true, CHAIN = false, SIDE = false, KHOOK = false; bf16_t* T;
    __device__ __forceinline__ void operator()(const f32x4 (&acc)[2][2][4][2], const Unit& u, int wr, int wc, int fr, int fq, const LAS unsigned char*) const {
        int row0 = u.pm * 256 + wr * 64 + fr, col0 = u.pn * 256 + wc * 32 + 8 * fq; asm volatile("" : "+v"(row0), "+v"(col0));
#pragma unroll
        for (int ai = 0; ai < 2; ++ai)
#pragma unroll
            for (int m = 0; m < 4; ++m) { bf16_t* rowp = T + (size_t)(row0 + ai * 128 + m * 16) * D + col0;
#pragma unroll
                for (int bj = 0; bj < 2; ++bj) { const f32x4 v0 = acc[ai][bj][m][0], v1 = acc[ai][bj][m][1];
                    u32x4 w; w.x = cvt_pk_bf16(v0[0], v0[1]); w.y = cvt_pk_bf16(v0[2], v0[3]); w.z = cvt_pk_bf16(v1[0], v1[1]); w.w = cvt_pk_bf16(v1[2], v1[3]);
                    *(u32x4*)(rowp + bj * 128) = w; } }
    }
};
struct EpiBranch {
    static constexpr bool PERM = true, CHAIN = false, SIDE = false, KHOOK = true; static constexpr int HOOK_T0 = 4, HOOK_T1 = 12;
    const bf16_t* Z; bf16_t* Y;
    template <bool FIN> __device__ __forceinline__ void apply(f32x4 (&acc)[2][2][4][2], const Unit& u, int br, int wr, int wc, int fr, int fq) const {
        int row0 = u.pm * 256 + wr * 64 + fr, col0 = u.pn * 256 + wc * 32 + 8 * fq;
        asm volatile("" : "+v"(row0), "+v"(col0));
#pragma unroll
        for (int ai = 0; ai < 2; ++ai) {
            u32x2 ga[4][2], gb[4][2];
#pragma unroll
            for (int m = 0; m < 4; ++m) { const unsigned char* rowp = (const unsigned char*)(Z + (size_t)(row0 + ai * 128 + m * 16) * NZ + ZG_COL) + br * 1024 + col0;
#pragma unroll
                for (int bj = 0; bj < 2; ++bj) { ga[m][bj] = *(const u32x2*)(rowp + bj * 128); if (!FIN) gb[m][bj] = *(const u32x2*)(rowp + 1024 + bj * 128); } }
#pragma unroll
            for (int m = 0; m < 4; ++m) { const size_t row = (size_t)(row0 + ai * 128 + m * 16);
#pragma unroll
                for (int bj = 0; bj < 2; ++bj) { const u32x2 a = ga[m][bj];
                    f32x4 r0 = u8x4_f32(a.x), r1 = u8x4_f32(a.y);
                    if (FIN) { r0 = r0 * (1.0f / G8_SCALE); r1 = r1 * (1.0f / G8_SCALE); }
                    else { const u32x2 b = gb[m][bj]; f32x4 q0 = u8x4_f32(b.x), q1 = u8x4_f32(b.y);
#pragma unroll
                        for (int i = 0; i < 4; ++i) { q0[i] = __builtin_amdgcn_rcpf(q0[i]); q1[i] = __builtin_amdgcn_rcpf(q1[i]); }
                        r0 = r0 * q0; r1 = r1 * q1; }
                    acc[ai][bj][m][0] = acc[ai][bj][m][0] * r0; acc[ai][bj][m][1] = acc[ai][bj][m][1] * r1;
                    if (FIN) { const f32x4 v0 = acc[ai][bj][m][0], v1 = acc[ai][bj][m][1];
                        u32x4 w; w.x = cvt_pk_bf16(v0[0], v0[1]); w.y = cvt_pk_bf16(v0[2], v0[3]); w.z = cvt_pk_bf16(v1[0], v1[1]); w.w = cvt_pk_bf16(v1[2], v1[3]);
                        *(u32x4*)(Y + row * D + col0 + bj * 128) = w; } } }
            asm volatile("" ::: "memory"); }
    }
    __device__ __forceinline__ void hook(f32x4 (&acc)[2][2][4][2], const Unit& u, int br, int wr, int wc, int fr, int fq) const { apply<false>(acc, u, br, wr, wc, fr, fq); }
    __device__ __forceinline__ void operator()(f32x4 (&acc)[2][2][4][2], const Unit& u, int wr, int wc, int fr, int fq, const LAS unsigned char*) const { apply<true>(acc, u, 2, wr, wc, fr, fq); }
};
struct EpiSwiglu {
    static constexpr bool PERM = true, CHAIN = false, SIDE = true, KHOOK = false; unsigned char* HID; const float* bgu; const LAS int* seg;
    __device__ __forceinline__ void side(const Unit& u, unsigned slot, int wid, int lane) const {
        if (wid == 1) { const int e = expert_of(seg, u.pm); pg8::dma16(lane < 32 ? (unsigned)lane * 16u : 4096u + (unsigned)(lane - 32) * 16u, bgu + (size_t)e * 2048 + u.pn * 128, slot); } }
    __device__ __forceinline__ void operator()(const f32x4 (&acc)[2][2][4][2], const Unit& u, int wr, int wc, int fr, int fq, const LAS unsigned char* sd) const {
        int j0 = u.pn * 128 + wc * 32 + 8 * fq, slot0 = u.pm * 256 + wr * 64 + fr; asm volatile("" : "+v"(j0), "+v"(slot0));
        f32x4 bg[2], bu[2];
#pragma unroll
        for (int n = 0; n < 2; ++n) { bg[n] = *(const LAS f32x4*)(sd + (wc * 32 + 8 * fq + 4 * n) * 4); bu[n] = *(const LAS f32x4*)(sd + (128 + wc * 32 + 8 * fq + 4 * n) * 4); }
#pragma unroll
        for (int ai = 0; ai < 2; ++ai)
#pragma unroll
            for (int m = 0; m < 4; ++m) { const size_t slot = (size_t)(slot0 + ai * 128 + m * 16); f32x4 o[2];
#pragma unroll
                for (int n = 0; n < 2; ++n) { f32x4 g = acc[ai][0][m][n] + bg[n], up = acc[ai][1][m][n] + bu[n];
#pragma unroll
                    for (int i = 0; i < 4; ++i) { g[i] = fminf(g[i], 7.0f); up[i] = __builtin_amdgcn_fmed3f(up[i], -7.0f, 7.0f); }
                    f32x4 t = g * (-1.702f * 1.4426950408889634f);
#pragma unroll
                    for (int i = 0; i < 4; ++i) t[i] = __builtin_amdgcn_exp2f(t[i]);
                    t = t + 1.0f;
#pragma unroll
                    for (int i = 0; i < 4; ++i) t[i] = __builtin_amdgcn_rcpf(t[i]);
                    o[n] = (up * F8S_ACT + F8S_ACT) * (g * t); }
                u32x2 w; w.x = pk4_fp8(o[0][0], o[0][1], o[0][2], o[0][3]); w.y = pk4_fp8(o[1][0], o[1][1], o[1][2], o[1][3]);
                *(u32x2*)(HID + slot * 1024 + j0) = w; }
    }
};
struct EpiDown {
    static constexpr bool PERM = true, CHAIN = false, SIDE = true, KHOOK = false; unsigned char* FS; const float* bdn; const int* dest; const float* pslot; const LAS int* seg;
    __device__ __forceinline__ void side(const Unit& u, unsigned slot, int wid, int lane) const {
        if (wid == 1) { const int e = expert_of(seg, u.pm); pg8::dma16((unsigned)lane * 16u, bdn + (size_t)e * 1024 + u.pn * 256, slot); }
        if (wid == 2) pg8::dma16((unsigned)lane * 16u, dest + (size_t)u.pm * 256, slot + 1024u);
        if (wid == 3) pg8::dma16((unsigned)lane * 16u, pslot + (size_t)u.pm * 256, slot + 2048u); }
    __device__ __forceinline__ void operator()(const f32x4 (&acc)[2][2][4][2], const Unit& u, int wr, int wc, int fr, int fq, const LAS unsigned char* sd) const {
        int col0 = u.pn * 256 + wc * 32 + 8 * fq, slot0 = u.pm * 256 + wr * 64 + fr; asm volatile("" : "+v"(col0), "+v"(slot0));
        f32x4 bv[2][2];
#pragma unroll
        for (int bj = 0; bj < 2; ++bj)
#pragma unroll
            for (int n = 0; n < 2; ++n) bv[bj][n] = *(const LAS f32x4*)(sd + (bj * 128 + wc * 32 + 8 * fq + 4 * n) * 4);
#pragma unroll
        for (int ai = 0; ai < 2; ++ai)
#pragma unroll
            for (int m = 0; m < 4; ++m) { const int rt = ai * 128 + wr * 64 + m * 16 + fr; const int d = *(const LAS int*)(sd + 1024 + rt * 4); const float p = *(const LAS float*)(sd + 2048 + rt * 4) * FS_SCALE;
                if (d >= 0) {
#pragma unroll
                    for (int bj = 0; bj < 2; ++bj) { f32x4 v0 = (acc[ai][bj][m][0] + bv[bj][0]) * p, v1 = (acc[ai][bj][m][1] + bv[bj][1]) * p;
#pragma unroll
                        for (int i = 0; i < 4; ++i) { v0[i] = __builtin_amdgcn_fmed3f(v0[i], -FS_CLAMP, FS_CLAMP); v1[i] = __builtin_amdgcn_fmed3f(v1[i], -FS_CLAMP, FS_CLAMP); }
                        u32x2 w; w.x = pk4_fp8(v0[0], v0[1], v0[2], v0[3]); w.y = pk4_fp8(v1[0], v1[1], v1[2], v1[3]);
                        *(u32x2*)(FS + (size_t)d * 1024 + col0 + bj * 128) = w; } }
                asm volatile("" ::: "memory"); }
    }
};

__device__ __forceinline__ const float* xin_row(const Frame& F, int row) { return row < ML ? F.in[IN_X] + (size_t)row * D : F.in[IN_CTX] + (size_t)(row - ML) * D; }
__device__ __forceinline__ void phase_ln0_first(Frame& F) {
    int t_lo, t_hi; tile_range(F, MT, t_lo, t_hi);
    const int r_lo = 32 * t_lo, nrows = 32 * (t_hi - t_lo);
    const int mrA = mod_row(r_lo), mrB = mod_row(r_lo + (nrows > 0 ? nrows - 1 : 0));
    { const float* mb = (const float*)(F.ws + WS_MOD); pv_fill(F, 0, mb + ((size_t)(0 * 17 + mrA) * 6 + 0) * 1024); pv_fill(F, 1, mb + ((size_t)(0 * 17 + mrB) * 6 + 0) * 1024);
      pv_fill(F, 2, mb + ((size_t)(0 * 17 + mrA) * 6 + 1) * 1024); pv_fill(F, 3, mb + ((size_t)(0 * 17 + mrB) * 6 + 1) * 1024); }
    load_wg_lds(F, 0);
    for (int n = F.wave; n < nrows; n += 4 * NWAVES) {
        RowV rv[4];
#pragma unroll
        for (int u = 0; u < 4; ++u) if (n + u * NWAVES < nrows) row_load(rv[u], xin_row(F, r_lo + n + u * NWAVES), F.lane);
#pragma unroll
        for (int u = 0; u < 4; ++u) if (n + u * NWAVES < nrows) { const int row = r_lo + n + u * NWAVES;
            const int sel = (mod_row(row) == mrA) ? 0 : 1; ln0_row(F, row, rv[u], pv_slot(F, 0 + sel), pv_slot(F, 2 + sel)); }
    }
    gates_tail(F, 0, t_lo, t_hi);
    __syncthreads();
}
__device__ __forceinline__ void phase_finalize(Frame& F, int l, int mrows) {
    const int gw = F.bid * NWAVES + F.wave, NGW = F.G * NWAVES;
    const bf16_t* hf = (const bf16_t*)(F.ws + WS_HFB); const bf16_t* hb = hf + (size_t)MT * 512;
    const float* ng = F.in[IN_MNG] + l * 512 + 8 * F.lane;
    const f32x4 g0 = *(const f32x4*)ng, g1 = *(const f32x4*)(ng + 4);
    const bf16_t* zo = (const bf16_t*)(F.ws + WS_Z) + ZC_O + 8 * F.lane;
    u32x4 ha = (u32x4){0u, 0u, 0u, 0u}, hbv = ha, so = ha;
    if (gw < mrows) { ha = __builtin_nontemporal_load((const u32x4*)(hf + (size_t)gw * 512 + 8 * F.lane)); hbv = __builtin_nontemporal_load((const u32x4*)(hb + (size_t)gw * 512 + 8 * F.lane)); so = __builtin_nontemporal_load((const u32x4*)(zo + (size_t)gw * NZ)); }
    for (int row = gw; row < mrows; row += NGW) {
        u32x4 han = ha, hbn = hbv, son = so; const int rn = row + NGW;
        if (rn < mrows) { han = __builtin_nontemporal_load((const u32x4*)(hf + (size_t)rn * 512 + 8 * F.lane)); hbn = __builtin_nontemporal_load((const u32x4*)(hb + (size_t)rn * 512 + 8 * F.lane)); son = __builtin_nontemporal_load((const u32x4*)(zo + (size_t)rn * NZ)); }
        __builtin_amdgcn_sched_barrier(0);
        f32x4 v0 = (f32x4){bflo(ha.x) + bflo(hbv.x), bfhi(ha.x) + bfhi(hbv.x), bflo(ha.y) + bflo(hbv.y), bfhi(ha.y) + bfhi(hbv.y)}, v1 = (f32x4){bflo(ha.z) + bflo(hbv.z), bfhi(ha.z) + bfhi(hbv.z), bflo(ha.w) + bflo(hbv.w), bfhi(ha.w) + bfhi(hbv.w)};
        float s = (v0.x + v0.y) + (v0.z + v0.w) + (v1.x + v1.y) + (v1.z + v1.w);
#pragma unroll
        for (int o = 0; o < 1; ++o) s = row16_sum(s);
        const float mu = s * (1.f / 128.f); v0 = v0 - mu; v1 = v1 - mu;
        float q = (v0.x * v0.x + v0.y * v0.y) + (v0.z * v0.z + v0.w * v0.w) + (v1.x * v1.x + v1.y * v1.y) + (v1.z * v1.z + v1.w * v1.w);
#pragma unroll
        for (int o = 0; o < 1; ++o) q = row16_sum(q);
        const float rstd = 1.f / sqrtf(q * (1.f / 128.f) + HEAD_EPS);
        v0 = v0 * rstd * g0; v1 = v1 * rstd * g1;
        u32x4 w; w.x = pk2(v0.x * bflo(so.x), v0.y * bfhi(so.x)); w.y = pk2(v0.z * bflo(so.y), v0.w * bfhi(so.y)); w.z = pk2(v1.x * bflo(so.z), v1.y * bfhi(so.z)); w.w = pk2(v1.z * bflo(so.w), v1.w * bfhi(so.w));
        *(u32x4*)((bf16_t*)(F.ws + WS_BRA) + (size_t)row * D + 256 + 8 * F.lane) = w;
        ha = han; hbv = hbn; so = son;
    }
}
__device__ __forceinline__ void phase_ln1_router(Frame& F, int l, int mrows) {
    LAS int* cnt = (LAS int*)(F.lds + NW_END);
    { const float* wr = F.in[IN_WR] + (size_t)l * D * NEXP;
      for (int i = F.tid; i < NEXP * D; i += NTHREADS) { const int k = i >> 5, e = i & 31; *(LAS bf16_t*)(F.lds + NW_WT + e * 2064 + k * 2) = (bf16_t)f2bf(wr[i]); }
      if (F.tid < NEXP) cnt[F.tid] = 0; }
    const float* brt = F.in[IN_BR] + l * NEXP;
    int t_lo, t_hi; tile_range(F, mrows, t_lo, t_hi);
    const int r_lo = 32 * t_lo, nrows = 32 * (t_hi - t_lo);
    const int mrA = mod_row(r_lo), mrB = mod_row(r_lo + (nrows > 0 ? nrows - 1 : 0));
    { const float* mb = (const float*)(F.ws + WS_MOD); pv_fill(F, 0, F.in[IN_LN1G] + l * D); pv_fill(F, 1, F.in[IN_LN1B] + l * D);
      pv_fill(F, 2, mb + ((size_t)(l * 17 + mrA) * 6 + 2) * 1024); pv_fill(F, 3, mb + ((size_t)(l * 17 + mrB) * 6 + 2) * 1024);
      pv_fill(F, 4, mb + ((size_t)(l * 17 + mrA) * 6 + 3) * 1024); pv_fill(F, 5, mb + ((size_t)(l * 17 + mrB) * 6 + 3) * 1024);
      pv_fill(F, 6, mb + ((size_t)(l * 17 + mrA) * 6 + 4) * 1024); pv_fill(F, 7, mb + ((size_t)(l * 17 + mrB) * 6 + 4) * 1024); }
    __syncthreads();
    { const bf16_t* yb = (const bf16_t*)(F.ws + WS_T) + 8 * F.lane;
      RowV rv[2]; u32x4 yv2[2][2];
#pragma unroll
      for (int u = 0; u < 2; ++u) {
#pragma unroll
          for (int j = 0; j < 4; ++j) rv[u].v[j] = (f32x4){0.f, 0.f, 0.f, 0.f};
          yv2[u][0] = yv2[u][1] = (u32x4){0u, 0u, 0u, 0u}; }
#define RT_LOADPAIR(n_, rv_, yv_) do { _Pragma("unroll") for (int u = 0; u < 2; ++u) if ((n_) + u * NWAVES < nrows) { const int row = r_lo + (n_) + u * NWAVES; \
              if (l == 0) row_load(rv_[u], xin_row(F, row), F.lane); else row_load_bf16(rv_[u], (const bf16_t*)(F.ws + WS_X) + (size_t)row * D, F.lane); \
              _Pragma("unroll") for (int h = 0; h < 2; ++h) yv_[u][h] = __builtin_nontemporal_load((const u32x4*)(yb + (size_t)row * D + 512 * h)); } } while (0)
      RT_LOADPAIR(F.wave, rv, yv2);
      for (int n = F.wave; n < nrows; n += 2 * NWAVES) {
          RowV rvn[2]; u32x4 yvn[2][2];
#pragma unroll
          for (int u = 0; u < 2; ++u) { rvn[u] = rv[u]; yvn[u][0] = yv2[u][0]; yvn[u][1] = yv2[u][1]; }
          RT_LOADPAIR(n + 2 * NWAVES, rvn, yvn);
          __builtin_amdgcn_sched_barrier(0);
#pragma unroll
          for (int u = 0; u < 2; ++u) if (n + u * NWAVES < nrows) { const int row = r_lo + n + u * NWAVES; RowV cur = rv[u];
              const int sel = (mod_row(row) == mrA) ? 0 : 1;
              { const LAS float* g1 = pv_slot(F, 2 + sel);
#pragma unroll
                for (int j = 0; j < 4; ++j) { const f32x4 gg = *(const LAS f32x4*)(g1 + RC(F.lane, j)); const u32x4 yw = yv2[u][j >> 1]; const f32x4 yv = (j & 1) ? (f32x4){bflo(yw.z), bfhi(yw.z), bflo(yw.w), bfhi(yw.w)} : (f32x4){bflo(yw.x), bfhi(yw.x), bflo(yw.y), bfhi(yw.y)}; cur.v[j] = cur.v[j] * DN_ALPHA + gg * yv; } }
              row_ln_plain(cur, F.lane); row_affine_l(cur, pv_slot(F, 0), pv_slot(F, 1), F.lane);
              row_store_bf16_nt(cur, (bf16_t*)(F.ws + WS_X) + (size_t)row * D, F.lane);
              row_ln_plain(cur, F.lane); row_modulate_l(cur, pv_slot(F, 4 + sel), pv_slot(F, 6 + sel), F.lane);
              row_store_bf16(cur, (bf16_t*)(F.ws + WS_H2) + (size_t)row * D, F.lane);
              { unsigned char* h8 = (unsigned char*)(F.ws + WS_H2F8) + (size_t)row * D + 8 * F.lane;
#pragma unroll
                for (int h = 0; h < 2; ++h) { u32x2 w; w.x = pk4_fp8(cur.v[2 * h].x * F8S_ACT, cur.v[2 * h].y * F8S_ACT, cur.v[2 * h].z * F8S_ACT, cur.v[2 * h].w * F8S_ACT); w.y = pk4_fp8(cur.v[2 * h + 1].x * F8S_ACT, cur.v[2 * h + 1].y * F8S_ACT, cur.v[2 * h + 1].z * F8S_ACT, cur.v[2 * h + 1].w * F8S_ACT); *(u32x2*)(h8 + 512 * h) = w; } } }
#pragma unroll
          for (int u = 0; u < 2; ++u) { rv[u] = rvn[u]; yv2[u][0] = yvn[u][0]; yv2[u][1] = yvn[u][1]; }
      }
#undef RT_LOADPAIR
    }
    asm volatile("s_waitcnt vmcnt(0)" ::: "memory"); __syncthreads();
    for (int tile = t_lo + F.wave; tile < t_hi; tile += NWAVES) {
        const LAS float* lgw = narrow_tile_wave(F, (const bf16_t*)(F.ws + WS_H2) + (size_t)tile * 32 * D);
        if (F.lane < 32) {
            const LAS float* lgp = lgw + F.lane * 33; const int row = tile * 32 + F.lane;
            float lg[NEXP];
#pragma unroll
            for (int e = 0; e < NEXP; ++e) lg[e] = lgp[e] + brt[e];
            unsigned used = 0u; float bv[4]; int bi[4];
#pragma unroll
            for (int k = 0; k < 4; ++k) { float best = -3.0e38f; int idx = 0;
#pragma unroll
                for (int e = 0; e < NEXP; ++e) { const bool take = (((used >> e) & 1u) == 0u) && (lg[e] > best); best = take ? lg[e] : best; idx = take ? e : idx; }
                used |= 1u << idx; bv[k] = best; bi[k] = idx; }
            const float e1 = __expf(bv[1] - bv[0]), e2 = __expf(bv[2] - bv[0]), e3 = __expf(bv[3] - bv[0]); const float inv = __builtin_amdgcn_rcpf(1.0f + e1 + e2 + e3);
            int* ei = (int*)(F.ws + WS_ROUTE + RT_EIDX) + (size_t)row * 4; float* pr = (float*)(F.ws + WS_ROUTE + RT_PROB) + (size_t)row * 4;
            *(int4*)ei = make_int4(bi[0], bi[1], bi[2], bi[3]); *(f32x4*)pr = (f32x4){inv, e1 * inv, e2 * inv, e3 * inv};
            atomicAdd((int*)&cnt[bi[0]], 1); atomicAdd((int*)&cnt[bi[1]], 1); atomicAdd((int*)&cnt[bi[2]], 1); atomicAdd((int*)&cnt[bi[3]], 1);
        }
        asm volatile("s_waitcnt lgkmcnt(0)" ::: "memory");
    }
    __syncthreads();
    if (F.tid < NEXP) ((int*)(F.ws + WS_ROUTE + RT_CNT))[F.bid * NEXP + F.tid] = cnt[F.tid];
    __syncthreads();
}
__device__ __forceinline__ void phase_slots(Frame& F, int mrows) {
    LAS int* part = (LAS int*)F.lds;
    LAS int* pre = part + 1024;
    LAS int* tot = pre + 32;
    LAS int* seg = tot + 32;
    LAS int* gcnt = seg + 64;
    LAS int* eix = gcnt + 2048;
    LAS int* rnk = eix + 4096;
    const int* cntg = (const int*)(F.ws + WS_ROUTE + RT_CNT);
    int* tokg = (int*)(F.ws + WS_ROUTE + RT_TOK); int* destg = (int*)(F.ws + WS_ROUTE + RT_DEST); float* psl = (float*)(F.ws + WS_ROUTE + RT_PSLOT);
    int t_lo, t_hi; tile_range(F, mrows, t_lo, t_hi);
    const int row_base = t_lo * 32, nent = (t_hi - t_lo) * 128, ngrp = nent / 64;
    { const int e = F.tid & 31, pt = F.tid >> 5; int a = 0, b = 0;
      for (int c = pt; c < F.G; c += 16) { const int v = cntg[c * NEXP + e]; b += v; a += (c < F.bid) ? v : 0; }
      part[pt * 32 + e] = a; part[512 + pt * 32 + e] = b; }
    for (int i = F.tid; i < nent; i += NTHREADS) eix[i] = ((const int*)(F.ws + WS_ROUTE + RT_EIDX))[(size_t)row_base * 4 + i];
    __syncthreads();
    if (F.tid < NEXP) { int a = 0, b = 0;
#pragma unroll
        for (int pt = 0; pt < 16; ++pt) { a += part[pt * 32 + F.tid]; b += part[512 + pt * 32 + F.tid]; }
        pre[F.tid] = a; tot[F.tid] = b; }
    for (int g = F.wave; g < ngrp; g += NWAVES) {
        const int e = eix[g * 64 + F.lane]; int rank = 0, mycnt = 0;
#pragma unroll 4
        for (int ee = 0; ee < NEXP; ++ee) { const unsigned long long m = __ballot(e == ee); if (e == ee) rank = __popcll(m & ((1ull << F.lane) - 1ull)); if (F.lane == ee) mycnt = __popcll(m); }
        rnk[g * 64 + F.lane] = rank; if (F.lane < NEXP) gcnt[g * 32 + F.lane] = mycnt; }
    __syncthreads();
    if (F.tid == 0) { int s = 0; for (int e = 0; e < NEXP; ++e) { seg[e] = s; s += (tot[e] + 255) & ~255; } seg[NEXP] = s; }
    if (F.tid >= 64 && F.tid < 64 + NEXP) { const int e = F.tid - 64; int run = 0; for (int g = 0; g < ngrp; ++g) { const int c = gcnt[g * 32 + e]; gcnt[g * 32 + e] = run; run += c; } }
    __syncthreads();
    { const float* prg = (const float*)(F.ws + WS_ROUTE + RT_PROB) + (size_t)row_base * 4;
      for (int i = F.tid; i < nent; i += NTHREADS) { const int e = eix[i]; const int slot = seg[e] + pre[e] + gcnt[(i >> 6) * 32 + e] + rnk[i];
          tokg[slot] = row_base + (i >> 2); destg[slot] = row_base * 4 + i; psl[slot] = prg[i]; } }
    if (F.bid < NEXP) { const int e = F.bid; for (int sl = seg[e] + tot[e] + F.tid; sl < seg[e + 1]; sl += NTHREADS) { tokg[sl] = 0; destg[sl] = -1; psl[sl] = 0.f; } }
    if (F.bid == 0 && F.tid <= NEXP) ((int*)(F.ws + WS_ROUTE + RT_SEG))[F.tid] = seg[F.tid];
    __syncthreads();
}
struct CombRaw { u32x4 x[2]; u32x2 f[2][4]; };
__device__ __forceinline__ void comb_load(const Frame& F, int row, CombRaw& r) {
    { const bf16_t* xp = (const bf16_t*)(F.ws + WS_X) + (size_t)row * D + 8 * F.lane;
#pragma unroll
      for (int h = 0; h < 2; ++h) r.x[h] = __builtin_nontemporal_load((const u32x4*)(xp + 512 * h)); }
    const unsigned char* fs = (const unsigned char*)(F.ws + WS_FS) + (size_t)row * 4 * 1024 + 8 * F.lane;
#pragma unroll
    for (int h = 0; h < 2; ++h)
#pragma unroll
        for (int k = 0; k < 4; ++k) r.f[h][k] = __builtin_nontemporal_load((const u32x2*)(fs + k * 1024 + 512 * h));
}
__device__ __forceinline__ void phase_combine_ln2(Frame& F, int l, int mrows) {
    const bool lastl = (l == DEPTH - 1);
    int t_lo, t_hi; tile_range(F, mrows, t_lo, t_hi);
    const int r_lo = 32 * t_lo, nrows = 32 * (t_hi - t_lo);
    const int mrA = mod_row(r_lo), mrB = mod_row(r_lo + (nrows > 0 ? nrows - 1 : 0));
    { const float* mb = (const float*)(F.ws + WS_MOD); const int ln = lastl ? l : l + 1; pv_fill(F, 0, F.in[IN_LN2G] + l * D); pv_fill(F, 1, F.in[IN_LN2B] + l * D);
      pv_fill(F, 2, mb + ((size_t)(l * 17 + mrA) * 6 + 5) * 1024); pv_fill(F, 3, mb + ((size_t)(l * 17 + mrB) * 6 + 5) * 1024);
      pv_fill(F, 4, mb + ((size_t)(ln * 17 + mrA) * 6 + 0) * 1024); pv_fill(F, 5, mb + ((size_t)(ln * 17 + mrB) * 6 + 0) * 1024);
      pv_fill(F, 6, mb + ((size_t)(ln * 17 + mrA) * 6 + 1) * 1024); pv_fill(F, 7, mb + ((size_t)(ln * 17 + mrB) * 6 + 1) * 1024); }
    if (!lastl) load_wg_lds(F, l + 1); else __syncthreads();
    for (int n = F.wave; n < nrows; n += 2 * NWAVES) {
        CombRaw rw[2];
#pragma unroll
        for (int u = 0; u < 2; ++u) if (n + u * NWAVES < nrows) comb_load(F, r_lo + n + u * NWAVES, rw[u]);
#pragma unroll
        for (int u = 0; u < 2; ++u) if (n + u * NWAVES < nrows) { const int row = r_lo + n + u * NWAVES;
            const int sel = (mod_row(row) == mrA) ? 0 : 1;
            const LAS float* g2 = pv_slot(F, 2 + sel);
            RowV x;
#pragma unroll
            for (int h = 0; h < 2; ++h) { const u32x4 w = rw[u].x[h]; x.v[2 * h] = (f32x4){bflo(w.x), bfhi(w.x), bflo(w.y), bfhi(w.y)}; x.v[2 * h + 1] = (f32x4){bflo(w.z), bfhi(w.z), bflo(w.w), bfhi(w.w)}; }
#pragma unroll
            for (int j = 0; j < 4; ++j) { f32x4 f = (f32x4){0.f, 0.f, 0.f, 0.f};
#pragma unroll
                for (int k = 0; k < 4; ++k) { const u32x2 w2 = rw[u].f[j >> 1][k]; const int wd = (int)((j & 1) ? w2.y : w2.x);
                    const f32x2 lo = __builtin_amdgcn_cvt_pk_f32_fp8(wd, false), hi = __builtin_amdgcn_cvt_pk_f32_fp8(wd, true); f[0] += lo[0]; f[1] += lo[1]; f[2] += hi[0]; f[3] += hi[1]; }
                const f32x4 gg = *(const LAS f32x4*)(g2 + RC(F.lane, j)) * (1.0f / FS_SCALE);
                x.v[j] = x.v[j] * DN_ALPHA + gg * f; }
            row_ln_plain(x, F.lane); row_affine_l(x, pv_slot(F, 0), pv_slot(F, 1), F.lane);
            if (lastl) { row_store_nt(x, F.out + (size_t)row * D, F.lane); }
            else { row_store_bf16_nt(x, (bf16_t*)(F.ws + WS_X) + (size_t)row * D, F.lane); ln0_row(F, row, x, pv_slot(F, 4 + sel), pv_slot(F, 6 + sel)); } }
    }
    if (!lastl) gates_tail(F, l + 1, t_lo, t_hi);
    __syncthreads();
}

#define MFMA32(a, b, c) __builtin_amdgcn_mfma_f32_32x32x16_bf16((a), (b), (c), 0, 0, 0)
#define MFMA16(a, b, c) __builtin_amdgcn_mfma_f32_16x16x32_bf16((a), (b), (c), 0, 0, 0)
__device__ __forceinline__ f32x16 zero16() { f32x16 z;
#pragma unroll
    for (int i = 0; i < 16; ++i) z[i] = 0.f;
    return z; }
__device__ __forceinline__ void pool_tiles(Frame& F, int l, bool with_ctx) {
    LAS unsigned char* Pin = F.lds;
    LAS unsigned char* Dm = F.lds + 40960;
    const bf16_t* Z = (const bf16_t*)(F.ws + WS_Z);
    const bf16_t* Wp = (const bf16_t*)(F.ws + WS_WPOOL) + (size_t)l * 4 * 4096;
    const float* psc = F.in[IN_POOLS] + l * 256;
    bf16_t* BRA = (bf16_t*)(F.ws + WS_BRA);
    const int ntiles = with_ctx ? 1088 : 1024;
    const int r = F.lane & 31, h = F.lane >> 5;
    bf16x8 wa[2][4]; f32x4 scv[2][4];
#pragma unroll
    for (int qi = 0; qi < 2; ++qi) { const int q = F.wave + 8 * qi, g = q >> 2, td = (q >> 1) & 1;
#pragma unroll
        for (int ks = 0; ks < 4; ++ks) wa[qi][ks] = *(const bf16x8*)(Wp + ((size_t)g * 64 + td * 32 + r) * 64 + ks * 16 + 8 * h);
#pragma unroll
        for (int qq = 0; qq < 4; ++qq) scv[qi][qq] = *(const f32x4*)(psc + g * 64 + td * 32 + 8 * qq + 4 * h); }
    for (int tile = F.bid; tile < ntiles; tile += F.G) {
        int row0, seq_lo, seq_hi;
        if (tile < 1024) { row0 = tile * 64; seq_lo = row0; seq_hi = row0 + 64; }
        else { const int ct = tile - 1024; seq_lo = ML + (ct >> 2) * 256; seq_hi = seq_lo + 256; row0 = seq_lo + (ct & 3) * 64; }
        for (int idx = F.tid; idx < 80 * 32; idx += NTHREADS) { const int rr = idx >> 5, ck = idx & 31, grow = row0 - 8 + rr;
            if (grow >= seq_lo && grow < seq_hi) *(LAS u32x4*)(Pin + rr * 512 + ck * 16) = __builtin_nontemporal_load((const u32x4*)(Z + (size_t)grow * NZ + ZC_P + ck * 8)); }
        __syncthreads();
#pragma unroll
        for (int g = 0; g < 4; ++g) { constexpr int dummy_ = 0; (void)dummy_; const int hw = 1 << g, tok = F.tid >> 3, ck = g * 8 + (F.tid & 7), t = row0 + tok;
            const int lo = max(t - hw, seq_lo), hi = min(t + hw, seq_hi);
            float s[8];
#pragma unroll
            for (int e = 0; e < 8; ++e) s[e] = 0.f;
#pragma unroll
            for (int d = -hw; d < hw; ++d) { u32x4 v = *(const LAS u32x4*)(Pin + (tok + 8 + d) * 512 + ck * 16); const bool in = (t + d >= lo) && (t + d < hi);
                v.x = in ? v.x : 0u; v.y = in ? v.y : 0u; v.z = in ? v.z : 0u; v.w = in ? v.w : 0u;
                s[0] += bflo(v.x); s[1] += bfhi(v.x); s[2] += bflo(v.y); s[3] += bfhi(v.y); s[4] += bflo(v.z); s[5] += bfhi(v.z); s[6] += bflo(v.w); s[7] += bfhi(v.w); }
            const float inv = 1.0f / (float)(hi - lo);
            const u32x4 o = *(const LAS u32x4*)(Pin + (tok + 8) * 512 + ck * 16);
            u32x4 w; w.x = pk2(s[0] * inv - bflo(o.x), s[1] * inv - bfhi(o.x)); w.y = pk2(s[2] * inv - bflo(o.y), s[3] * inv - bfhi(o.y));
            w.z = pk2(s[4] * inv - bflo(o.z), s[5] * inv - bfhi(o.z)); w.w = pk2(s[6] * inv - bflo(o.w), s[7] * inv - bfhi(o.w));
            *(LAS u32x4*)(Dm + tok * 528 + ck * 16) = w; }
        __syncthreads();
#pragma unroll
        for (int qi = 0; qi < 2; ++qi) { const int q = F.wave + 8 * qi, g = q >> 2, td = (q >> 1) & 1, tt = q & 1;
            f32x16 acc = zero16();
#pragma unroll
            for (int ks = 0; ks < 4; ++ks) { const bf16x8 b = *(const LAS bf16x8*)(Dm + (tt * 32 + r) * 528 + (g * 64 + ks * 16 + 8 * h) * 2);
                acc = MFMA32(wa[qi][ks], b, acc); }
            const size_t orow = (size_t)(row0 + tt * 32 + r);
#pragma unroll
            for (int qq = 0; qq < 4; ++qq) { const int dcol = g * 64 + td * 32 + 8 * qq + 4 * h; const f32x4 sc = scv[qi][qq];
                u32x2 w; w.x = pk2(acc[4 * qq] * sc.x, acc[4 * qq + 1] * sc.y); w.y = pk2(acc[4 * qq + 2] * sc.z, acc[4 * qq + 3] * sc.w);
                *(u32x2*)(BRA + orow * D + dcol) = w; } }
        __syncthreads();
    }
}
__device__ __forceinline__ void sgu_chunks(Frame& F, int l, bool with_ctx) {
    LAS unsigned char* Vt = F.lds;
    const bf16_t* Z = (const bf16_t*)(F.ws + WS_Z);
    const bf16_t* Ws = (const bf16_t*)(F.ws + WS_WSGU) + (size_t)l * 4 * 16384;
    const float* lng = F.in[IN_SLNG] + l * 256; const float* lnb = F.in[IN_SLNB] + l * 256; const float* sb = F.in[IN_SGUB] + l * 512;
    bf16_t* BRA = (bf16_t*)(F.ws + WS_BRA);
    const int nchunks = with_ctx ? 544 : 512;
    const int r = F.lane & 31, h = F.lane >> 5;
    const int tc = F.wave & 1, tt = F.wave >> 1, t = tt * 32 + r;
    LAS float* lnt = (LAS float*)(F.lds + 69632);
    if (F.tid < 256) { lnt[F.tid] = lng[F.tid]; lnt[256 + F.tid] = lnb[F.tid]; }
    __syncthreads();
    for (int ch = F.bid; ch < nchunks; ch += F.G) {
        const int row0 = ch * 128;
        u32x2 ug[4][4]; bf16x8 bcur[8];
        { const int s2 = F.tid >> 3, cq = F.tid & 7; const bf16_t* zp = Z + (size_t)(row0 + 2 * s2) * NZ + ZC_UV + 256 + cq * 32;
          float v[2][32]; float sum[2] = {0.f, 0.f};
#pragma unroll
          for (int rr = 0; rr < 2; ++rr)
#pragma unroll
              for (int i = 0; i < 4; ++i) { const u32x4 w = __builtin_nontemporal_load((const u32x4*)(zp + (size_t)rr * NZ + 8 * i));
                  v[rr][8 * i] = bflo(w.x); v[rr][8 * i + 1] = bfhi(w.x); v[rr][8 * i + 2] = bflo(w.y); v[rr][8 * i + 3] = bfhi(w.y); v[rr][8 * i + 4] = bflo(w.z); v[rr][8 * i + 5] = bfhi(w.z); v[rr][8 * i + 6] = bflo(w.w); v[rr][8 * i + 7] = bfhi(w.w); }
          float rstd[2];
#pragma unroll
          for (int rr = 0; rr < 2; ++rr) {
#pragma unroll
              for (int i = 0; i < 32; ++i) sum[rr] += v[rr][i];
              sum[rr] += shx(sum[rr], 1, F.lane); sum[rr] += shx(sum[rr], 2, F.lane); sum[rr] += shx(sum[rr], 4, F.lane);
              const float mean = sum[rr] * (1.f / 256.f); float sq = 0.f;
#pragma unroll
              for (int i = 0; i < 32; ++i) { v[rr][i] -= mean; sq += v[rr][i] * v[rr][i]; }
              sq += shx(sq, 1, F.lane); sq += shx(sq, 2, F.lane); sq += shx(sq, 4, F.lane);
              rstd[rr] = 1.f / sqrtf(sq * (1.f / 256.f) + LN_EPS); }
#pragma unroll
        for (int g = 0; g < 4; ++g)
#pragma unroll
            for (int qq = 0; qq < 4; ++qq) ug[g][qq] = *(const u32x2*)(Z + (size_t)(row0 + t) * NZ + ZC_UV + g * 64 + tc * 32 + 8 * qq + 4 * h);
#pragma unroll
        for (int ks = 0; ks < 8; ++ks) bcur[ks] = *(const bf16x8*)(Ws + ((size_t)0 * 128 + t) * 128 + ks * 16 + 8 * h);
          LAS unsigned char* wp = Vt + (((s2 >> 2) ^ cq) << 4) + (s2 & 3) * 4;
#pragma unroll
          for (int i = 0; i < 32; ++i) { const int c = cq * 32 + i; const float gn = lnt[c], bn = lnt[256 + c];
              *(LAS unsigned*)(wp + c * 272) = pg8::cvt_pk_bf16(v[0][i] * rstd[0] * gn + bn, v[1][i] * rstd[1] * gn + bn); } }
        __syncthreads();
#pragma unroll
        for (int g = 0; g < 4; ++g) {
            bf16x8 bnx[8];
#pragma unroll
            for (int ks = 0; ks < 8; ++ks) bnx[ks] = bcur[ks];
            if (g < 3) {
#pragma unroll
                for (int ks = 0; ks < 8; ++ks) bnx[ks] = *(const bf16x8*)(Ws + ((size_t)(g + 1) * 128 + t) * 128 + ks * 16 + 8 * h); }
            f32x16 acc = zero16();
#pragma unroll
            for (int ks = 0; ks < 8; ++ks) { const bf16x8 a = *(const LAS bf16x8*)(Vt + (g * 64 + tc * 32 + r) * 272 + (((ks * 2 + h) ^ ((g * 2 + tc) & 7)) * 16));
                acc = MFMA32(a, bcur[ks], acc); }
#pragma unroll
            for (int ks = 0; ks < 8; ++ks) bcur[ks] = bnx[ks];
            const float bias = sb[g * 128 + t];
#pragma unroll
            for (int qq = 0; qq < 4; ++qq) { const int c0 = g * 64 + tc * 32 + 8 * qq + 4 * h;
                const u32x2 u = ug[g][qq];
                u32x2 w; w.x = pk2(bflo(u.x) * (acc[4 * qq] + bias), bfhi(u.x) * (acc[4 * qq + 1] + bias)); w.y = pk2(bflo(u.y) * (acc[4 * qq + 2] + bias), bfhi(u.y) * (acc[4 * qq + 3] + bias));
                *(u32x2*)(BRA + (size_t)(row0 + t) * D + 768 + c0) = w; } }
        __syncthreads();
    }
}
__device__ __forceinline__ void qk_conv_pass(Frame& F, int l) {
    const bf16_t* Z = (const bf16_t*)(F.ws + WS_Z); bf16_t* QKC = (bf16_t*)(F.ws + WS_H);
    const int chunk = F.tid & 127, rsub = F.tid >> 7, ch0 = chunk * 8;
    float w0[8], w1[8], w2[8], cbv[8];
    { const float* cw = F.in[IN_CONVW] + (size_t)l * 3 * 1024 + ch0; const float* cb = F.in[IN_CONVB] + (size_t)l * 1024 + ch0;
#pragma unroll
      for (int e = 0; e < 8; ++e) { w0[e] = cw[e]; w1[e] = cw[1024 + e]; w2[e] = cw[2048 + e]; cbv[e] = cb[e]; } }
    const float scale = chunk >= 64 ? 0.08838834764831845f : 1.0f;
    const int ns = F.G * 4, sidx = F.bid * 4 + rsub;
    const int r0 = (int)(((long)sidx * MT) / ns), r1 = (int)(((long)(sidx + 1) * MT) / ns);
    const bf16_t* zb = Z + ZC_QK + ch0;
    const u32x4 zero4 = (u32x4){0u, 0u, 0u, 0u};
    u32x4 xm = zero4, xc = zero4, xn = zero4;
    if (r0 < r1) { xc = *(const u32x4*)(zb + (size_t)r0 * NZ); if (r0 > 0) xm = *(const u32x4*)(zb + (size_t)(r0 - 1) * NZ); if (r0 + 1 < MT) xn = *(const u32x4*)(zb + (size_t)(r0 + 1) * NZ); }
    for (int row = r0; row < r1; ++row) {
        u32x4 xn2 = zero4; if (row + 2 < MT) xn2 = *(const u32x4*)(zb + (size_t)(row + 2) * NZ);
        const int p = row < ML ? (row & 4095) : ((row - ML) & 255), len = row < ML ? 4096 : 256;
        const u32x4 x0 = (p > 0) ? xm : zero4, x1 = xc, x2 = (p + 1 < len) ? xn : zero4;
        const unsigned xa[4] = {x0.x, x0.y, x0.z, x0.w}, xb[4] = {x1.x, x1.y, x1.z, x1.w}, xcc[4] = {x2.x, x2.y, x2.z, x2.w};
        float y[8];
#pragma unroll
        for (int e2 = 0; e2 < 4; ++e2) { y[2 * e2] = cbv[2 * e2] + w0[2 * e2] * bflo(xa[e2]) + w1[2 * e2] * bflo(xb[e2]) + w2[2 * e2] * bflo(xcc[e2]);
            y[2 * e2 + 1] = cbv[2 * e2 + 1] + w0[2 * e2 + 1] * bfhi(xa[e2]) + w1[2 * e2 + 1] * bfhi(xb[e2]) + w2[2 * e2 + 1] * bfhi(xcc[e2]); }
#pragma unroll
        for (int e = 0; e < 8; ++e) y[e] = siluf_(y[e]) * scale;
        u32x4 w; w.x = pk2(y[0], y[1]); w.y = pk2(y[2], y[3]); w.z = pk2(y[4], y[5]); w.w = pk2(y[6], y[7]);
        *(u32x4*)(QKC + (size_t)row * D + ch0) = w;
        xm = xc; xc = xn; xn = xn2;
    }
}
constexpr int ML_QS = 0, ML_KS = 34816, ML_KW = 69632, ML_VT = 104448, ML_CB = 126208, ML_SC = 147968, ML_SCSZ = 2624;
__device__ __forceinline__ float logsigf_(float x) { return fminf(x, 0.f) - __logf(1.0f + __expf(-fabsf(x))); }
__device__ __forceinline__ unsigned swap16(unsigned u) { return __builtin_amdgcn_alignbit(u, u, 16); }
struct MlPre { u32x4 qk[8]; u32x2 v[4]; float g[4]; };
__device__ __forceinline__ void ml_geom(int j, int b, int dir, int& seqbase, int& seqlen, int& pbase) {
    const bool is_ctx = j < 2; int cj = is_ctx ? j : j - 2; const int ncs = is_ctx ? 2 : 32; if (dir) cj = ncs - 1 - cj;
    seqbase = is_ctx ? ML + b * 256 : b * 4096; seqlen = is_ctx ? 256 : 4096; pbase = cj * 128; }
#define ML_BAR() do { asm volatile("s_waitcnt lgkmcnt(0)" ::: "memory"); __builtin_amdgcn_s_barrier(); asm volatile("" ::: "memory"); } while (0)
__device__ __forceinline__ void mlstm_unit(Frame& F, int l, int unit) {
    const int bh = (unit & 7) + 8 * (unit >> 5), sub = (unit >> 3) & 3;
    const int b = bh >> 2, head = bh & 3, dir = sub >> 1, vh = sub & 1;
    LAS unsigned char* QS = F.lds + ML_QS; LAS unsigned char* KS = F.lds + ML_KS; LAS unsigned char* KW = F.lds + ML_KW; LAS unsigned char* VT = F.lds + ML_VT; LAS unsigned char* CB = F.lds + ML_CB;
    const bf16_t* Z = (const bf16_t*)(F.ws + WS_Z); const float* ZG = (const float*)(F.ws + WS_ZG); const bf16_t* QKC = (const bf16_t*)(F.ws + WS_H);
    bf16_t* HF = (bf16_t*)(F.ws + WS_HFB) + (size_t)dir * MT * 512;
    const int wave = F.wave;
    int tl = F.tid;
#define ML_ROLES() const int lane = tl & 63, fr = lane & 15, q4 = lane >> 4; const int isk = (tl >> 4) & 1, ck = tl & 15, i0 = 8 * (tl >> 5), chn = (isk ? 512 : 0) + head * 128 + ck * 8; \
    const int vi0 = 4 * (tl >> 4), vcq = tl & 15, vch = head * 128 + vh * 64 + vcq * 4; (void)fr; (void)q4; (void)vi0; (void)vcq; (void)vch; (void)i0; (void)chn; (void)ck; (void)isk;
    for (int idx = F.tid; idx < 16 * 136; idx += NTHREADS) *(LAS bf16_t*)(VT + (64 + idx / 136) * 272 + (idx % 136) * 2) = (idx < 136) ? (bf16_t)0x3F80 : (bf16_t)0;
    f32x4 cs[5];
#pragma unroll
    for (int vt = 0; vt < 5; ++vt) cs[vt] = (f32x4){0.f, 0.f, 0.f, 0.f};
    float m_state = 0.f;
    MlPre pre;
#define ML_PREFETCH(jj) do { int sb_, sl_, pb_; ml_geom((jj), b, dir, sb_, sl_, pb_); \
        { const int pmin = dir ? pb_ + 120 - i0 : pb_ + i0; const bf16_t* zr = QKC + (size_t)(sb_ + pmin) * D + chn; (void)sl_; \
          _Pragma("unroll") for (int k = 0; k < 8; ++k) pre.qk[k] = *(const u32x4*)(zr + (size_t)k * D); } \
        { const int pminv = dir ? pb_ + 124 - vi0 : pb_ + vi0; const bf16_t* zv = Z + (size_t)(sb_ + pminv) * NZ + ZC_V + vch; \
          _Pragma("unroll") for (int k = 0; k < 4; ++k) pre.v[k] = *(const u32x2*)(zv + (size_t)k * NZ); } \
        if (wave == 0) { const int p0 = dir ? pb_ + 127 - 2 * lane : pb_ + 2 * lane, p1 = dir ? p0 - 1 : p0 + 1; \
          pre.g[0] = ZG[(size_t)(sb_ + p0) * 16 + dir * 8 + head]; pre.g[1] = ZG[(size_t)(sb_ + p0) * 16 + dir * 8 + 4 + head]; \
          pre.g[2] = ZG[(size_t)(sb_ + p1) * 16 + dir * 8 + head]; pre.g[3] = ZG[(size_t)(sb_ + p1) * 16 + dir * 8 + 4 + head]; } } while (0)
#define ML_STEPA(sbuf) do { LAS float* sg_ = (LAS float*)(F.lds + ML_SC + (sbuf) * ML_SCSZ); const int i0g = 2 * lane, i1g = i0g + 1; \
        const float gi0 = pre.g[0], gf0 = pre.g[1], gi1 = pre.g[2], gf1 = pre.g[3]; \
        const float lf0 = logsigf_(gf0), lf1 = logsigf_(gf1); const float s1 = lf0 + lf1; float incl = s1; \
        _Pragma("unroll") for (int o = 1; o < 64; o <<= 1) { const float y_ = shup(incl, o, lane); incl += (lane >= o) ? y_ : 0.f; } \
        const float excl = incl - s1, bc0 = excl + lf0, bc1 = excl + s1; \
        const float g0 = gi0 - bc0, g1 = gi1 - bc1; const float mx1 = fmaxf(g0, g1); float im = mx1; \
        _Pragma("unroll") for (int o = 1; o < 64; o <<= 1) { const float y_ = shup(im, o, lane); im = (lane >= o) ? fmaxf(im, y_) : im; } \
        float em = shup(im, 1, lane); em = (lane == 0) ? -3.0e38f : em; \
        const float M0 = fmaxf(m_state, fmaxf(em, g0)), M1 = fmaxf(m_state, fmaxf(em, mx1)); \
        const float total = bperm(63, bc1), Mlast = bperm(63, M1); \
        sg_[i0g] = g0; sg_[i1g] = g1; sg_[128 + i0g] = M0; sg_[128 + i1g] = M1; \
        sg_[256 + i0g] = __expf(m_state - M0); sg_[256 + i1g] = __expf(m_state - M1); \
        sg_[384 + i0g] = __expf(-(bc0 + M0)); sg_[384 + i1g] = __expf(-(bc1 + M1)); \
        sg_[512 + i0g] = __expf(g0 - Mlast); sg_[512 + i1g] = __expf(g1 - Mlast); \
        if (lane == 0) sg_[640] = __expf(m_state - Mlast); \
        m_state = total + Mlast; } while (0)
    { ML_ROLES(); ML_PREFETCH(0); if (wave == 0) ML_STEPA(0); }
    ML_BAR();
#pragma unroll 1
    for (int j = 0; j < 34; ++j) {
        asm volatile("" : "+v"(tl));
        ML_ROLES();
        int seqbase, seqlen, pbase; ml_geom(j, b, dir, seqbase, seqlen, pbase);
        const LAS float* sc_g = (const LAS float*)(F.lds + ML_SC + (j & 1) * ML_SCSZ); const LAS float* sc_M = sc_g + 128; const LAS float* sc_dec = sc_g + 256; const LAS float* sc_emt = sc_g + 384; const LAS float* sc_wk = sc_g + 512;
        {
#pragma unroll
          for (int k = 0; k < 8; ++k) { const int i = dir ? i0 + 7 - k : i0 + k; *(LAS u32x4*)((isk ? KS : QS) + i * 272 + ck * 16) = pre.qk[k]; }
          if (isk) { u32x4 kt[8]; float ykeep[8];
#pragma unroll
              for (int e = 0; e < 8; ++e) { kt[e] = (u32x4){0u, 0u, 0u, 0u}; ykeep[e] = 0.f; }
#pragma unroll
              for (int k = 0; k < 8; ++k) { const int i = dir ? i0 + 7 - k : i0 + k; const float wk = sc_wk[i];
                  const unsigned xb[4] = {pre.qk[k].x, pre.qk[k].y, pre.qk[k].z, pre.qk[k].w};
#pragma unroll
                  for (int e = 0; e < 8; ++e) { const float yw = ((e & 1) ? bfhi(xb[e >> 1]) : bflo(xb[e >> 1])) * wk;
                      if (k & 1) { const unsigned pw_ = pk2(ykeep[e], yw); if ((k >> 1) == 0) kt[e].x = pw_; else if ((k >> 1) == 1) kt[e].y = pw_; else if ((k >> 1) == 2) kt[e].z = pw_; else kt[e].w = pw_; }
                      else ykeep[e] = yw; } }
#pragma unroll
              for (int e = 0; e < 8; ++e) { u32x4 o = kt[e]; if (dir) o = (u32x4){swap16(kt[e].w), swap16(kt[e].z), swap16(kt[e].y), swap16(kt[e].x)};
                  *(LAS u32x4*)(KW + (ck * 8 + e) * 272 + (((i0 >> 3) ^ (ck & 7)) * 16)) = o; } } }
        { unsigned vv[4][2];
#pragma unroll
          for (int k = 0; k < 4; ++k) { vv[k][0] = pre.v[k].x; vv[k][1] = pre.v[k].y; }
#pragma unroll
          for (int c = 0; c < 4; ++c) {
              unsigned h0 = (c & 1) ? (vv[0][c >> 1] >> 16) : (vv[0][c >> 1] & 0xffffu), h1 = (c & 1) ? (vv[1][c >> 1] >> 16) : (vv[1][c >> 1] & 0xffffu);
              unsigned h2 = (c & 1) ? (vv[2][c >> 1] >> 16) : (vv[2][c >> 1] & 0xffffu), h3 = (c & 1) ? (vv[3][c >> 1] >> 16) : (vv[3][c >> 1] & 0xffffu);
              u32x2 o; if (dir) { o.x = h3 | (h2 << 16); o.y = h1 | (h0 << 16); } else { o.x = h0 | (h1 << 16); o.y = h2 | (h3 << 16); }
              *(LAS u32x2*)(VT + (vcq * 4 + c) * 272 + vi0 * 2) = o; } }
#pragma unroll
        for (int vt = 0; vt < 5; ++vt)
#pragma unroll
            for (int rr = 0; rr < 4; rr += 2) { const unsigned pw_ = pk2(cs[vt][rr], cs[vt][rr + 1]);
                *(LAS bf16_t*)(CB + (16 * vt + 4 * q4 + rr) * 272 + (16 * wave + fr) * 2) = (bf16_t)(pw_ & 0xffffu); *(LAS bf16_t*)(CB + (16 * vt + 4 * q4 + rr + 1) * 272 + (16 * wave + fr) * 2) = (bf16_t)(pw_ >> 16); }
        ML_BAR();
        if (j + 1 < 34) ML_PREFETCH(j + 1);
        const int t = 16 * wave + fr;
        bf16x8 qf[4];
#pragma unroll
        for (int kc = 0; kc < 4; ++kc) qf[kc] = *(const LAS bf16x8*)(QS + t * 272 + (32 * kc + 8 * q4) * 2);
        const float Mt_t = sc_M[t], dec_t = sc_dec[t], emt_t = sc_emt[t];
        f32x4 ps[8];
#pragma unroll
        for (int jp = 0; jp < 4; ++jp) {
            ps[2 * jp] = (f32x4){0.f, 0.f, 0.f, 0.f}; ps[2 * jp + 1] = (f32x4){0.f, 0.f, 0.f, 0.f};
            if (2 * jp <= wave) {
                bf16x8 ka[4], kb[4];
#pragma unroll
                for (int kc = 0; kc < 4; ++kc) { ka[kc] = *(const LAS bf16x8*)(KS + (32 * jp + fr) * 272 + (32 * kc + 8 * q4) * 2); kb[kc] = *(const LAS bf16x8*)(KS + (32 * jp + 16 + fr) * 272 + (32 * kc + 8 * q4) * 2); }
                const f32x4 ga4 = *(const LAS f32x4*)(sc_g + 32 * jp + 4 * q4), gb4 = *(const LAS f32x4*)(sc_g + 32 * jp + 16 + 4 * q4);
                f32x4 acc0 = (f32x4){0.f, 0.f, 0.f, 0.f}, acc1 = (f32x4){0.f, 0.f, 0.f, 0.f};
#pragma unroll
                for (int kc = 0; kc < 4; ++kc) { acc0 = MFMA16(ka[kc], qf[kc], acc0); acc1 = MFMA16(kb[kc], qf[kc], acc1); }
#pragma unroll
                for (int rr = 0; rr < 4; ++rr) { const int s0 = 32 * jp + 4 * q4 + rr, s1 = s0 + 16;
                    ps[2 * jp][rr] = (s0 <= t) ? acc0[rr] * __expf(ga4[rr] - Mt_t) : 0.f; ps[2 * jp + 1][rr] = (s1 <= t) ? acc1[rr] * __expf(gb4[rr] - Mt_t) : 0.f; }
            }
        }
        f32x4 ao[5];
        {
#pragma unroll
          for (int vt = 0; vt < 5; ++vt) ao[vt] = (f32x4){0.f, 0.f, 0.f, 0.f};
#pragma unroll
          for (int kh = 0; kh < 4; kh += 2) { bf16x8 cf[2][5];
#pragma unroll
              for (int k2 = 0; k2 < 2; ++k2)
#pragma unroll
                  for (int vt = 0; vt < 5; ++vt) cf[k2][vt] = *(const LAS bf16x8*)(CB + (16 * vt + fr) * 272 + (32 * (kh + k2) + 8 * q4) * 2);
#pragma unroll
              for (int k2 = 0; k2 < 2; ++k2)
#pragma unroll
                  for (int vt = 0; vt < 5; ++vt) ao[vt] = MFMA16(cf[k2][vt], qf[kh + k2], ao[vt]); }
#pragma unroll
          for (int vt = 0; vt < 5; ++vt) ao[vt] = ao[vt] * dec_t; }
#pragma unroll
        for (int ks = 0; ks < 4; ++ks) {
            if (2 * ks <= wave) {
                s16x4 vlo[5], vhi[5];
#pragma unroll
                for (int vt = 0; vt < 5; ++vt) { vlo[vt] = *(const LAS s16x4*)(VT + (16 * vt + fr) * 272 + (32 * ks + 4 * q4) * 2); vhi[vt] = *(const LAS s16x4*)(VT + (16 * vt + fr) * 272 + (32 * ks + 16 + 4 * q4) * 2); }
                u32x4 pw; pw.x = cvt_pk_bf16(ps[2 * ks][0], ps[2 * ks][1]); pw.y = cvt_pk_bf16(ps[2 * ks][2], ps[2 * ks][3]); pw.z = cvt_pk_bf16(ps[2 * ks + 1][0], ps[2 * ks + 1][1]); pw.w = cvt_pk_bf16(ps[2 * ks + 1][2], ps[2 * ks + 1][3]);
                const bf16x8 pf = __builtin_bit_cast(bf16x8, pw);
#pragma unroll
                for (int vt = 0; vt < 5; ++vt) { const bf16x8 a = __builtin_shufflevector(vlo[vt], vhi[vt], 0, 1, 2, 3, 4, 5, 6, 7); ao[vt] = MFMA16(a, pf, ao[vt]); }
            }
        }
        { const float den = bperm(fr, ao[4][0]); const float inv = 1.0f / fmaxf(fabsf(den), emt_t);
          const int p = dir ? pbase + 127 - t : pbase + t; bf16_t* orow = HF + (size_t)(seqbase + p) * 512 + head * 128 + vh * 64 + 4 * q4;
#pragma unroll
          for (int vt = 0; vt < 4; ++vt) { const f32x4 o = ao[vt] * inv; u32x2 w; w.x = cvt_pk_bf16(o[0], o[1]); w.y = cvt_pk_bf16(o[2], o[3]); *(u32x2*)(orow + 16 * vt) = w; } }
        { const float a_s = sc_g[640];
#pragma unroll
          for (int vt = 0; vt < 5; ++vt) cs[vt] = cs[vt] * a_s;
#pragma unroll
          for (int ks = 0; ks < 4; ks += 2) { bf16x8 bb[2], va[2][5];
#pragma unroll
              for (int k2 = 0; k2 < 2; ++k2) { bb[k2] = *(const LAS bf16x8*)(KW + (16 * wave + fr) * 272 + (((4 * (ks + k2) + q4) ^ (((16 * wave + fr) >> 3) & 7)) * 16));
#pragma unroll
                  for (int vt = 0; vt < 5; ++vt) va[k2][vt] = *(const LAS bf16x8*)(VT + (16 * vt + fr) * 272 + (32 * (ks + k2) + 8 * q4) * 2); }
#pragma unroll
              for (int k2 = 0; k2 < 2; ++k2)
#pragma unroll
                  for (int vt = 0; vt < 5; ++vt) cs[vt] = MFMA16(va[k2][vt], bb[k2], cs[vt]); } }
        if (wave == 0 && j + 1 < 34) ML_STEPA((j + 1) & 1);
        ML_BAR();
    }
#undef ML_PREFETCH
#undef ML_STEPA
#undef ML_ROLES
    __syncthreads();
}
__device__ __forceinline__ void phase_mixers(Frame& F, int l) {
    const bool with_ctx = (l != DEPTH - 1);
#ifndef MIX_MASK
#define MIX_MASK 7
#endif
#ifndef MIXREP
#define MIXREP 0
#endif
    if (MIX_MASK & 1) pool_tiles(F, l, with_ctx);
    if (MIXREP & 1) { __syncthreads(); pool_tiles(F, l, with_ctx); }
    if (MIX_MASK & 2) sgu_chunks(F, l, with_ctx);
    if (MIXREP & 2) { __syncthreads(); sgu_chunks(F, l, with_ctx); }
    (void)0;
    qk_conv_pass(F, l);
}
__device__ __forceinline__ void phase_mlstm(Frame& F, int l) {
    for (int u = F.bid; u < 256; u += F.G) mlstm_unit(F, l, u);
}

struct Args { const float* in[31]; float* out; unsigned char* ws; int g_lo, g_hi, pad0, pad1; };
constexpr int NPH = 11, NGID = 2 + DEPTH * NPH;
__global__ void __launch_bounds__(NTHREADS, 2) fwd_kernel(Args args) {
    extern __shared__ __attribute__((aligned(16))) unsigned char lds_raw[];
    Frame F;
    F.lds = (LAS unsigned char*)lds_raw; F.MISC = (volatile LAS unsigned*)(F.lds + MISC_OFF);
    F.tid = threadIdx.x; F.lane = F.tid & 63; F.wave = __builtin_amdgcn_readfirstlane(F.tid >> 6); F.G = gridDim.x; F.bid = blockIdx.x;
    F.ws = args.ws; F.out = args.out;
    F.in = (InTab)__builtin_amdgcn_kernarg_segment_ptr();
    if (F.tid < 64) F.MISC[F.tid] = 0u;
    __syncthreads();
    const int lo = args.g_lo, hi = args.g_hi;
    const bool multi = (hi - lo) > 1;
    XcdBarrier bar; bar.bar = (unsigned*)(F.ws + WS_CTL) + CW_BAR; bar.x = 0; bar.st = nullptr;
    if (multi) bar = xcd_barrier_post((unsigned*)(F.ws + WS_CTL) + CW_BAR, F.MISC + 8);
#ifndef PHASE_MASK
#define PHASE_MASK 0xFFFF
#endif
#define RUN(g) (lo <= (g) && (g) < hi)
#define RUNP(ty, g) ((((PHASE_MASK) >> (ty)) & 1) && RUN(g))
#ifndef REPEAT_MASK
#define REPEAT_MASK 0
#endif
#define NREP(ty) ((((REPEAT_MASK) >> (ty)) & 1) ? 2 : 1)
#define SEAM(g) do { if (RUN((g) + 1)) xcd_barrier(bar); } while (0)
#define LAUNDER(P) Frame P = F; { int t_; asm volatile("v_mbcnt_lo_u32_b32 %0, -1, 0\n\tv_mbcnt_hi_u32_b32 %0, -1, %0" : "=v"(t_)); t_ |= (F.wave << 6); P.tid = t_; P.lane = t_ & 63; P.wave = __builtin_amdgcn_readfirstlane(t_ >> 6); GAS unsigned char* w_ = (GAS unsigned char*)F.ws; asm volatile("" : "+s"(w_)); P.ws = (unsigned char*)w_; InTab t2_ = F.in; asm volatile("" : "+s"(t2_)); P.in = t2_; }
    if (RUNP(0, 0)) { LAUNDER(P); for (int rep_ = 0; rep_ < NREP(0); ++rep_) { phase_prologue(P); __syncthreads(); } SEAM(0); }
    if (RUNP(1, 1)) { LAUNDER(P); for (int rep_ = 0; rep_ < NREP(1); ++rep_) { phase_ln0_first(P); __syncthreads(); } SEAM(1); }
#pragma unroll 1
    for (int l = 0; l < DEPTH; ++l) {
        const int g0 = 2 + l * NPH;
        const int mrows = (l == DEPTH - 1) ? ML : MT;
        if (RUNP(2, g0 + 0)) {
#undef PHTY
#define PHTY 2
            LAUNDER(P);
            { ProbPlain Pr{(const bf16_t*)(P.ws + WS_H), (const bf16_t*)(P.ws + WS_WIN) + (size_t)l * NZ * D, D, D};
              pg8::StaticOrder<1> S; S.init(MT / 256, NZ_BF / 256, P.G, P.bid);
              EpiInproj<false> E{(bf16_t*)(P.ws + WS_Z), P.in[IN_BIN] + (size_t)l * 5904, 0};
              pg8::gemm_phase(P.lds, P.tid, Pr, S, E); }
            __syncthreads();
            { ProbPlainF8 Pr{(const bf16_t*)(P.ws + WS_H8), (const bf16_t*)(P.ws + WS_WIN8 + (size_t)l * NZ_F8 * D), D / 2, D / 2};
              pg8::StaticOrder<1> S; S.init(MT / 256, NZ_F8 / 256, P.G, P.bid);
              EpiInproj<true> E{(bf16_t*)(P.ws + WS_Z), P.in[IN_BIN] + (size_t)l * 5904, NZ_BF / 256};
              pg8::gemm_phase(P.lds, P.tid, Pr, S, E); }
            SEAM(g0 + 0);
        }
        if (RUNP(3, g0 + 1)) { LAUNDER(P); for (int rep_ = 0; rep_ < NREP(3); ++rep_) { phase_mixers(P, l); __syncthreads(); } SEAM(g0 + 1); }
        if (RUNP(12, g0 + 2)) { LAUNDER(P); for (int rep_ = 0; rep_ < NREP(12); ++rep_) { phase_mlstm(P, l); __syncthreads(); } SEAM(g0 + 2); }
        if (RUNP(4, g0 + 3)) { LAUNDER(P); for (int rep_ = 0; rep_ < NREP(4); ++rep_) phase_finalize(P, l, mrows); SEAM(g0 + 3); }
        if (RUNP(5, g0 + 4)) {
#undef PHTY
#define PHTY 5
            LAUNDER(P);
            ProbPlain Pr{(const bf16_t*)(P.ws + WS_BRA), (const bf16_t*)(P.ws + WS_WBR) + (size_t)l * D * D, D, D};
            pg8::StaticOrder<1> S; S.init(mrows / 256, 4, P.G, P.bid);
            EpiBranch E{(const bf16_t*)(P.ws + WS_Z), (bf16_t*)(P.ws + WS_Y)};
            pg8::gemm_phase(P.lds, P.tid, Pr, S, E); if (NREP(PHTY) == 2) { __syncthreads(); pg8::gemm_phase(P.lds, P.tid, Pr, S, E); }
            SEAM(g0 + 4);
        }
        if (RUNP(6, g0 + 5)) {
#undef PHTY
#define PHTY 6
            LAUNDER(P);
            ProbPlain Pr{(const bf16_t*)(P.ws + WS_Y), (const bf16_t*)(P.ws + WS_WOUT) + (size_t)l * D * D, D, D};
            pg8::StaticOrder<1> S; S.init(mrows / 256, 4, P.G, P.bid);
            EpiOut E{(bf16_t*)(P.ws + WS_T)};
            pg8::gemm_phase(P.lds, P.tid, Pr, S, E); if (NREP(PHTY) == 2) { __syncthreads(); pg8::gemm_phase(P.lds, P.tid, Pr, S, E); }
            SEAM(g0 + 5);
        }
        if (RUNP(7, g0 + 6)) { LAUNDER(P); for (int rep_ = 0; rep_ < NREP(7); ++rep_) phase_ln1_router(P, l, mrows); SEAM(g0 + 6); }
        if (RUNP(8, g0 + 7)) { LAUNDER(P); for (int rep_ = 0; rep_ < NREP(8); ++rep_) phase_slots(P, mrows); SEAM(g0 + 7); }
        if (RUNP(9, g0 + 8)) {
#undef PHTY
#define PHTY 9
            LAUNDER(P);
            LAS int* seg = (LAS int*)(P.lds + TAB_OFF);
            const int ntile = moe_tables(P, seg);
            ProbMoe1 Pr{(const bf16_t*)(P.ws + WS_H2F8), (const bf16_t*)(P.ws + WS_WGU + (size_t)l * NEXP * 2048 * D), D / 2, D / 2, (const int*)(P.ws + WS_ROUTE + RT_TOK), seg};
            pg8::StaticOrder<1> S; S.init(ntile, 8, P.G, P.bid);
            EpiSwiglu E{(unsigned char*)(P.ws + WS_HID), P.in[IN_BGU] + (size_t)l * NEXP * 2048, seg};
            pg8::gemm_phase(P.lds, P.tid, Pr, S, E); if (NREP(PHTY) == 2) { __syncthreads(); pg8::gemm_phase(P.lds, P.tid, Pr, S, E); }
            SEAM(g0 + 8);
        }
        if (RUNP(10, g0 + 9)) {
#undef PHTY
#define PHTY 10
            LAUNDER(P);
            LAS int* seg = (LAS int*)(P.lds + TAB_OFF);
            const int ntile = moe_tables(P, seg);
            ProbMoe2 Pr{(const bf16_t*)(P.ws + WS_HID), (const bf16_t*)(P.ws + WS_WDN + (size_t)l * NEXP * D * D), D / 2, D / 2, seg};
            pg8::StaticOrder<1> S; S.init(ntile, 4, P.G, P.bid);
            EpiDown E{(unsigned char*)(P.ws + WS_FS), P.in[IN_BDN] + (size_t)l * NEXP * D, (const int*)(P.ws + WS_ROUTE + RT_DEST), (const float*)(P.ws + WS_ROUTE + RT_PSLOT), seg};
            pg8::gemm_phase(P.lds, P.tid, Pr, S, E); if (NREP(PHTY) == 2) { __syncthreads(); pg8::gemm_phase(P.lds, P.tid, Pr, S, E); }
            SEAM(g0 + 9);
        }
        if (RUNP(11, g0 + 10)) { LAUNDER(P); phase_combine_ln2(P, l, mrows); SEAM(g0 + 10); }
    }
#undef LAUNDER
#undef RUN
#undef RUNP
#undef SEAM
}

extern "C" void kernel_launch(void* const* d_in, const int* in_sizes, int n_in, void* d_out, int out_size, void* d_ws, size_t ws_size, hipStream_t stream) {
    static int grid = 0;
    if (grid == 0) {
        if (n_in != 31 || out_size != ML * D || ws_size < WS_END) { fprintf(stderr, "kernel_launch: unexpected problem (n_in %d, out %d, ws %zu, need %zu)\n", n_in, out_size, ws_size, (size_t)WS_END); grid = -1; return; }
        int dev = 0, cus = 0, per_cu = 0;
        if (hipGetDevice(&dev) != hipSuccess || hipDeviceGetAttribute(&cus, hipDeviceAttributeMultiprocessorCount, dev) != hipSuccess) { grid = -1; return; }
        if (hipFuncSetAttribute((const void*)fwd_kernel, hipFuncAttributeMaxDynamicSharedMemorySize, LDS_BYTES) != hipSuccess) { fprintf(stderr, "kernel_launch: hipFuncSetAttribute failed\n"); grid = -1; return; }
        if (hipOccupancyMaxActiveBlocksPerMultiprocessor(&per_cu, (const void*)fwd_kernel, NTHREADS, LDS_BYTES) != hipSuccess || per_cu < 1) fprintf(stderr, "kernel_launch: occupancy query reports %d\n", per_cu);
        (void)hipGetLastError();
        grid = cus;
    }
    if (grid < 0) return;
    (void)hipMemsetAsync((char*)d_ws + WS_CTL, 0, CTL_ZERO_BYTES, stream);
    Args a{};
    for (int i = 0; i < 31; ++i) a.in[i] = (const float*)d_in[i];
    a.out = (float*)d_out; a.ws = (unsigned char*)d_ws;
#if MK_N_LAUNCHES == 1
    a.g_lo = 0; a.g_hi = NGID;
    hipLaunchKernelGGL(fwd_kernel, dim3(grid), dim3(NTHREADS), LDS_BYTES, stream, a);
#else
    for (int g = 0; g < NGID; ++g) { a.g_lo = g; a.g_hi = g + 1; hipLaunchKernelGGL(fwd_kernel, dim3(grid), dim3(NTHREADS), LDS_BYTES, stream, a); }
#endif
}
```

```cpp
#include <hip/hip_runtime.h>
#include <cstdio>
#include <cstdint>

#ifndef MK_N_LAUNCHES
#define MK_N_LAUNCHES 1
#endif

#define LAS __attribute__((address_space(3)))
#define GAS __attribute__((address_space(1)))
typedef unsigned short bf16_t;
typedef short bf16x8 __attribute__((ext_vector_type(8)));
typedef short s16x4 __attribute__((ext_vector_type(4)));
typedef float f32x4 __attribute__((ext_vector_type(4)));
typedef float f32x2 __attribute__((ext_vector_type(2)));
typedef float f32x16 __attribute__((ext_vector_type(16)));
typedef unsigned u32x4 __attribute__((ext_vector_type(4)));
typedef unsigned u32x2 __attribute__((ext_vector_type(2)));
typedef int i32x4 __attribute__((ext_vector_type(4)));
typedef int i32x8 __attribute__((ext_vector_type(8)));

constexpr int D = 1024, NB = 16, SEQ = 4096, CTXL = 256, DEPTH = 4;
constexpr int ML = NB * SEQ;
constexpr int MC = NB * CTXL;
constexpr int MT = ML + MC;
constexpr int NZ = 5888;
constexpr int ZC_P = 0, ZC_QK = 256, ZC_V = 1280, ZC_O = 1792, ZC_UV = 2304, ZC_MG = 2816;
constexpr int NZ_BF = 256, NZ_F8 = 5632;
constexpr int ZG_COL = 2816;
constexpr int NEXP = 32, TOPK = 4;
constexpr int NS_MAX = MT * TOPK + NEXP * 256;
constexpr float LN_EPS = 1e-5f, HEAD_EPS = 1e-6f;
constexpr float DN_ALPHA = 1.6817928305074292f;
constexpr int NWAVES = 8, NTHREADS = 512;
constexpr float F8S_ACT = 4.0f, F8S_WGU = 64.0f, F8S_WDN = 64.0f; constexpr int F8E_ACT = 123, F8E_WGU = 123, F8E_WDN = 123;

constexpr size_t MiB = 1u << 20;
constexpr size_t WS_CTL = 0, CTL_ZERO_BYTES = 1 * MiB;
constexpr size_t WS_MOD = 1 * MiB;
constexpr size_t WS_WG = 3 * MiB;
constexpr size_t WS_WSGU = 4 * MiB;
constexpr size_t WS_WPOOL = WS_WSGU + 512 * 1024;
constexpr size_t WS_ROUTE = 5 * MiB;
constexpr size_t WS_WIN = 16 * MiB;
constexpr size_t WS_WBR = 62 * MiB;
constexpr size_t WS_WOUT = 70 * MiB;
constexpr size_t WS_WGU = 78 * MiB;
constexpr size_t WS_WDN = 590 * MiB;
constexpr size_t WS_X = 846 * MiB;
constexpr size_t WS_H = 1118 * MiB;
constexpr size_t WS_Z = 1254 * MiB;
constexpr size_t WS_FS = WS_Z;
constexpr float G8_SCALE = 255.0f;
constexpr float FS_SCALE = 32.0f, FS_CLAMP = 440.0f;
constexpr size_t WS_BRA = 2036 * MiB;
constexpr size_t WS_HFB = 2172 * MiB;
constexpr size_t WS_Y = 2444 * MiB;
constexpr size_t WS_T = 2580 * MiB;
constexpr size_t WS_H2 = 2852 * MiB;
constexpr size_t WS_HID = 2988 * MiB;
constexpr size_t WS_ZG = 3548 * MiB;
constexpr size_t WS_H2F8 = 3554 * MiB;
constexpr size_t WS_H8 = 3624 * MiB;
constexpr size_t WS_WIN8 = 3692 * MiB;
constexpr size_t WS_END = 3714 * MiB;
static_assert(WS_Z + (size_t)MT * NZ * 2 <= WS_BRA && WS_FS + (size_t)MT * 4 * 1024 * 2 <= WS_BRA, "Z/FS");
static_assert(WS_HID + (size_t)NS_MAX * 1024 * 2 <= WS_END, "HID");
constexpr size_t RT_EIDX = 0;
constexpr size_t RT_PROB = 2 * MiB;
constexpr size_t RT_TOK = 4 * MiB;
constexpr size_t RT_DEST = 6 * MiB;
constexpr size_t RT_PSLOT = 8 * MiB;
constexpr size_t RT_CNT = 10 * MiB;
constexpr size_t RT_SEG = 10 * MiB + 64 * 1024;
constexpr int CW_BAR = 4096;

constexpr int LDS_BYTES = 163840;
constexpr int MISC_OFF = LDS_BYTES - 256;
constexpr int TAB_OFF = 131072;
constexpr int NW_WT = 0;
constexpr int NW_LG = 66048;
constexpr int NW_END = 99840;
constexpr int NW_PV = NW_END + 256;

__device__ __forceinline__ unsigned f2bf(float f) { unsigned u = __builtin_bit_cast(unsigned, f); return (u + 0x7fffu + ((u >> 16) & 1u)) >> 16; }
__device__ __forceinline__ unsigned pk2(float lo, float hi) { unsigned r; asm volatile("v_cvt_pk_bf16_f32 %0, %1, %2" : "=v"(r) : "v"(lo), "v"(hi)); return r; }
__device__ __forceinline__ unsigned pk4_fp8(float a, float b, float c, float d) { int w = 0; w = __builtin_amdgcn_cvt_pk_fp8_f32(a, b, w, false); w = __builtin_amdgcn_cvt_pk_fp8_f32(c, d, w, true); return (unsigned)w; }
__device__ __forceinline__ unsigned pk4_u8(float a, float b, float c, float d) {
    const unsigned lo = __builtin_amdgcn_perm(__builtin_bit_cast(unsigned, b), __builtin_bit_cast(unsigned, a), 0x0c0c0400u), hi = __builtin_amdgcn_perm(__builtin_bit_cast(unsigned, d), __builtin_bit_cast(unsigned, c), 0x0c0c0400u);
    return lo | (hi << 16); }
__device__ __forceinline__ f32x4 u8x4_f32(unsigned w) { return (f32x4){(float)(w & 0xffu), (float)((w >> 8) & 0xffu), (float)((w >> 16) & 0xffu), (float)(w >> 24)}; }
__device__ __forceinline__ float bflo(unsigned w) { return __builtin_bit_cast(float, w << 16); }
__device__ __forceinline__ float bfhi(unsigned w) { return __builtin_bit_cast(float, w & 0xffff0000u); }
__device__ __forceinline__ float bf1(bf16_t h) { return __builtin_bit_cast(float, ((unsigned)h) << 16); }
__device__ __forceinline__ float bperm(int srclane, float v) { return __builtin_bit_cast(float, __builtin_amdgcn_ds_bpermute(srclane << 2, __builtin_bit_cast(int, v))); }
__device__ __forceinline__ float shx(float v, int o, int lane) { return bperm(lane ^ o, v); }
__device__ __forceinline__ float shup(float v, int o, int lane) { return bperm(lane >= o ? lane - o : lane, v); }
template <int N> __device__ __forceinline__ float dpp_ror(float v) { return __builtin_bit_cast(float, __builtin_amdgcn_update_dpp(0, __builtin_bit_cast(int, v), 0x120 + N, 0xf, 0xf, false)); }
__device__ __forceinline__ float row16_sum(float v) { v += dpp_ror<8>(v); v += dpp_ror<4>(v); v += dpp_ror<2>(v); v += dpp_ror<1>(v); return v; }
__device__ __forceinline__ float wave_sum(float v, int) {
    v = row16_sum(v);
    { const unsigned u = __builtin_bit_cast(unsigned, v); const auto r = __builtin_amdgcn_permlane16_swap(u, u, false, false); v = __builtin_bit_cast(float, (unsigned)r[0]) + __builtin_bit_cast(float, (unsigned)r[1]); }
    { const unsigned u = __builtin_bit_cast(unsigned, v); const auto r = __builtin_amdgcn_permlane32_swap(u, u, false, false); v = __builtin_bit_cast(float, (unsigned)r[0]) + __builtin_bit_cast(float, (unsigned)r[1]); }
    return v;
}
__device__ __forceinline__ float sigmoidf_(float x) { return __builtin_amdgcn_rcpf(1.0f + __builtin_amdgcn_exp2f(x * -1.4426950408889634f)); }
__device__ __forceinline__ float siluf_(float x) { return x * __builtin_amdgcn_rcpf(1.0f + __builtin_amdgcn_exp2f(x * -1.4426950408889634f)); }
__device__ __forceinline__ f32x4 sigmoid4(f32x4 x) {
    f32x4 t = x * -1.4426950408889634f;
#pragma unroll
    for (int i = 0; i < 4; ++i) t[i] = __builtin_amdgcn_exp2f(t[i]);
    t = t + 1.0f;
#pragma unroll
    for (int i = 0; i < 4; ++i) t[i] = __builtin_amdgcn_rcpf(t[i]);
    return t; }
#define LDS_WAIT() asm volatile("s_waitcnt lgkmcnt(0)" ::: "memory")
#define VM_WAIT() asm volatile("s_waitcnt vmcnt(0)" ::: "memory")

#define XB_TMO      128
#define XB_XCNT(j)  (256  + 64 * (j))
#define XB_XSUB(j)  (1280 + 64 * (j))
#define XB_XGEN(j)  (2304 + 64 * (j))
#define XB_TOP      3328
#define XB_TOPGEN   3392
#define XCD_BAR_WORDS 3456
#define XB_SPIN_CAP (1u << 18)
__device__ __forceinline__ unsigned xb_ld(unsigned* p)              { asm volatile("" : "+v"(p)); return __hip_atomic_load(p, __ATOMIC_RELAXED, __HIP_MEMORY_SCOPE_AGENT); }
__device__ __forceinline__ unsigned xb_add(unsigned* p, unsigned v) { asm volatile("" : "+v"(p), "+v"(v)); return __hip_atomic_fetch_add(p, v, __ATOMIC_RELAXED, __HIP_MEMORY_SCOPE_AGENT); }
__device__ __forceinline__ unsigned xb_xcc_id() { return (unsigned)__builtin_amdgcn_s_getreg((3 << 11) | 20) & 0xFu; }
#define XB_SPIN(cond, bar) do { unsigned _sp = 0; while (cond) { __builtin_amdgcn_s_sleep(1); \
    if ((++_sp & 255u) == 0u) { if (xb_ld(&(bar)[XB_TMO])) break; if (_sp > XB_SPIN_CAP) { atomicAdd(&(bar)[XB_TMO], 1u); break; } } } } while (0)
struct XcdBarrier { unsigned* bar; unsigned x; volatile LAS unsigned* st; };
__device__ __forceinline__ XcdBarrier xcd_barrier_post(unsigned* bar, volatile LAS unsigned* st) {
    XcdBarrier b; b.bar = bar; b.x = xb_xcc_id(); b.st = st;
    if (threadIdx.x == 0) (void)xb_add(&bar[XB_XCNT(b.x)], 1u);
    return b;
}
__device__ __forceinline__ void xcd_barrier_complete(unsigned* bar, unsigned x, unsigned& nloc, unsigned& nx) {
    const unsigned G = gridDim.x * gridDim.y * gridDim.z;
    unsigned sum, cnt, mine, sp = 0u;
    for (;;) {
        sum = 0u; cnt = 0u; mine = 0u;
#pragma unroll
        for (unsigned j = 0; j < 16; ++j) { const unsigned c = xb_ld(&bar[XB_XCNT(j)]); sum += c; cnt += (c > 0u) ? 1u : 0u; mine = (j == x) ? c : mine; }
        if (sum == G) break;
        __builtin_amdgcn_s_sleep(1);
        if ((++sp & 255u) == 0u) { if (xb_ld(&bar[XB_TMO])) break; if (sp > XB_SPIN_CAP) { atomicAdd(&bar[XB_TMO], 1u); break; } }
    }
    nloc = mine > 0u ? mine : 1u; nx = cnt > 0u ? cnt : 1u;
}
__device__ __forceinline__ void xcd_barrier(const XcdBarrier& b) {
    asm volatile("s_waitcnt vmcnt(0)" ::: "memory");
    __syncthreads();
    if (threadIdx.x == 0) {
        unsigned* bar = b.bar;
        __builtin_amdgcn_s_waitcnt(0);
        unsigned nloc = b.st[0], nx = b.st[1];
        if (nloc == 0u) { xcd_barrier_complete(bar, b.x, nloc, nx); b.st[0] = nloc; b.st[1] = nx; }
        const unsigned old = xb_add(&bar[XB_XSUB(b.x)], 1u);
        const unsigned gen = old / nloc;
        if (old + 1u == (gen + 1u) * nloc) {
            __builtin_amdgcn_fence(__ATOMIC_RELEASE, "agent");
            asm volatile("s_waitcnt vmcnt(0)" ::: "memory");
            const unsigned og = xb_add(&bar[XB_TOP], 1u);
            const unsigned tg = og / nx;
            if (og + 1u == (tg + 1u) * nx) xb_add(&bar[XB_TOPGEN], 1u);
            else XB_SPIN(xb_ld(&bar[XB_TOPGEN]) == tg, bar);
            __builtin_amdgcn_fence(__ATOMIC_ACQUIRE, "agent");
            xb_add(&bar[XB_XGEN(b.x)], 1u);
            asm volatile("s_waitcnt vmcnt(0)" ::: "memory");
        } else {
            XB_SPIN(xb_ld(&bar[XB_XGEN(b.x)]) == gen, bar);
            __builtin_amdgcn_fence(__ATOMIC_ACQUIRE, "agent");
            asm volatile("s_waitcnt vmcnt(0)" ::: "memory");
        }
    }
    __syncthreads();
}

namespace pg8 {
constexpr int BM = 256, BK = 64, HALF = 128, HTB = HALF * BK * 2, STAGE_BYTES = 8 * HTB, NXCD = 8, WGM = 8;
__host__ __device__ __forceinline__ int lds_byte(int r, int c) { const int st = (r >> 4) * 2 + (c >> 5), rr = r & 15, cc = c & 31, ob = rr * 64 + cc * 2; return st * 1024 + (ob ^ (((ob >> 9) & 1) << 5)); }
__host__ __device__ __forceinline__ void stage_rc(int b, int& R, int& C) { const int st = b / 1024, sb = b % 1024, swz = sb ^ (((sb >> 9) & 1) << 5); R = (st >> 1) * 16 + swz / 64; C = (st & 1) * 32 + (swz % 64) / 2; }
__host__ __device__ __forceinline__ int perm32(int rho) { const int n = rho >> 4, i = rho & 15; return 8 * (i >> 2) + 4 * n + (i & 3); }
struct Unit { int pm, pn, sub; };
__device__ __forceinline__ unsigned cvt_pk_bf16(float lo, float hi) { unsigned r; asm volatile("v_cvt_pk_bf16_f32 %0, %1, %2" : "=v"(r) : "v"(lo), "v"(hi)); return r; }
__device__ __forceinline__ f32x2 gelu_pk(f32x2 v) {
    const f32x2 av = __builtin_elementwise_abs(v), d = av * 0.2316418882f + 1.0f;
    f32x2 t; t.x = __builtin_amdgcn_rcpf(d.x); t.y = __builtin_amdgcn_rcpf(d.y);
    f32x2 q = t * 0.5307027145f + (-0.7265760135f); q = q * t + 0.7107068705f; q = q * t + (-0.142248368f); q = q * t + 0.127414796f; q = q * t;
    const f32x2 s = (v * v) * (-0.72134752044f);
    f32x2 e; e.x = __builtin_amdgcn_exp2f(s.x); e.y = __builtin_amdgcn_exp2f(s.y);
    const f32x2 m = v * (q * e), r = v - m;
    f32x2 o; o.x = v.x < 0.f ? m.x : r.x; o.y = v.y < 0.f ? m.y : r.y; return o;
}
template <int NSUB = 1> struct StaticOrder {
    int nM, nN, nwg, G, c;
    __device__ void init(int nM_, int nN_, int G_, int c_) { nM = nM_; nN = nN_; nwg = nM * nN; G = G_; c = c_; }
    __device__ bool next(int i, Unit& u) const {
        const int it = i / NSUB; u.sub = i - it * NSUB;
        const long L = (long)it * G + c; if (L >= nwg) return false;
        int wgid = (int)L; { const int q = nwg / NXCD, r = nwg % NXCD, xcd = wgid % NXCD, off = wgid / NXCD; wgid = (xcd < r ? xcd * (q + 1) : r * (q + 1) + (xcd - r) * q) + off; }
        const int nig = WGM * nN, gid = wgid / nig, fm = gid * WGM, gsz = (nM - fm) < WGM ? (nM - fm) : WGM;
        u.pm = fm + ((wgid % nig) % gsz); u.pn = (wgid % nig) / gsz; return true;
    }
};
constexpr int SIDE_TOK = 131072 + 2048;
constexpr int SIDE_SLOT = 131072 + 10240, SIDE_SLOT_BYTES = 3072;
__device__ __forceinline__ void dma16(unsigned voff, const void* sbase, unsigned ldsaddr) { asm volatile("s_mov_b32 m0, %2\n\tglobal_load_lds_dwordx4 %0, %1" :: "v"(voff), "s"(sbase), "s"(ldsaddr) : "memory", "m0"); }
__device__ __forceinline__ void dma4(unsigned voff, const void* sbase, unsigned ldsaddr) { asm volatile("s_mov_b32 m0, %2\n\tglobal_load_lds_dword %0, %1" :: "v"(voff), "s"(sbase), "s"(ldsaddr) : "memory", "m0"); }
template <class Prob, class Sched, class Epi>
__device__ __forceinline__ void gemm_phase(LAS unsigned char* lds, const int tid, const Prob& P, const Sched& S, const Epi& E) {
    const int wid = __builtin_amdgcn_readfirstlane(tid >> 6), lane = tid & 63, wr = wid >> 2, wc = wid & 3, fr = lane & 15, fq = lane >> 4;
    const int lda = P.lda, ldb = P.ldb;
    unsigned voffB[2], offA[2][2];
#define PG8_TOKSLOT(name) const LAS int* name; { PG8_TID(tl2_); name = (const LAS int*)(lds + SIDE_TOK) + (tl2_ >> 6) * 256 + (tl2_ & 63); }
#define PG8_TID(v_) int v_; asm volatile("v_mbcnt_lo_u32_b32 %0, -1, 0\n\tv_mbcnt_hi_u32_b32 %0, -1, %0" : "=v"(v_)); v_ |= (wid << 6)
#define PG8_RC(R_, C_) int R_[2], C_[2]; { PG8_TID(tl_); _Pragma("unroll") for (int i_ = 0; i_ < 2; ++i_) stage_rc(tl_ * 16 + i_ * 8192, R_[i_], C_[i_]); }
#pragma unroll
    for (int i = 0; i < 2; ++i) { int R, C; stage_rc(tid * 16 + i * 8192, R, C); const int Rb = Epi::PERM ? ((R & ~31) + perm32(R & 31)) : R;
        voffB[i] = (unsigned)(Rb * ldb + C) * 2u;
        offA[0][i] = (unsigned)(R * lda + C) * 2u; offA[1][i] = (unsigned)((R + HALF) * lda + C) * 2u; }
    const size_t kstep = (size_t)(BK * 2);
    const size_t hstep = (size_t)HALF * ldb * 2;
    const unsigned ldsw = (unsigned)wid * 1024u;
    const int aoff = lds_byte(wr * 64 + fr, fq * 8), boff = lds_byte(wc * 32 + fr, fq * 8);
#define PG8_SA(b, h) (((b) * 2 + (h)) * HTB)
#define PG8_SB(b, h) ((4 + (b) * 2 + (h)) * HTB)
    const unsigned ldsb = (unsigned)(size_t)lds;
#define PG8_STAGE(bufoff, gbase, voff) do { _Pragma("unroll") for (int _i = 0; _i < 2; ++_i) \
        asm volatile("s_mov_b32 m0, %2\n\tglobal_load_lds_dwordx4 %0, %1" :: "v"((voff)[_i]), "s"((const char*)(gbase)), "s"(ldsb + (unsigned)(bufoff) + ldsw + (unsigned)(_i * 8192)) : "memory", "m0"); } while (0)
#define PG8_CAT(x0, x1) __builtin_shufflevector(x0, x1, 0, 1, 2, 3, 4, 5, 6, 7)
#define PG8_LDA(dst, b, h) do { if constexpr (Prob::FP8) { _Pragma("unroll") for (int m = 0; m < 4; ++m) dst##8[m] = PG8_CAT(*(const LAS i32x4*)(lds + PG8_SA(b, h) + aoff + m * 2048), *(const LAS i32x4*)(lds + PG8_SA(b, h) + aoff + m * 2048 + 1024)); } \
        else { _Pragma("unroll") for (int m = 0; m < 4; ++m) _Pragma("unroll") for (int k = 0; k < 2; ++k) dst[m][k] = *(const LAS bf16x8*)(lds + PG8_SA(b, h) + aoff + m * 2048 + k * 1024); } } while (0)
#define PG8_LDB(dst, b, h) do { if constexpr (Prob::FP8) { _Pragma("unroll") for (int n = 0; n < 2; ++n) dst##8[n] = PG8_CAT(*(const LAS i32x4*)(lds + PG8_SB(b, h) + boff + n * 2048), *(const LAS i32x4*)(lds + PG8_SB(b, h) + boff + n * 2048 + 1024)); } \
        else { _Pragma("unroll") for (int n = 0; n < 2; ++n) _Pragma("unroll") for (int k = 0; k < 2; ++k) dst[n][k] = *(const LAS bf16x8*)(lds + PG8_SB(b, h) + boff + n * 2048 + k * 1024); } } while (0)
#define PG8_MMA(ai, bj, At, Bt) do { __builtin_amdgcn_s_setprio(1); \
        if constexpr (Prob::FP8) { _Pragma("unroll") for (int m = 0; m < 4; ++m) _Pragma("unroll") for (int n = 0; n < 2; ++n) \
            acc[ai][bj][m][n] = __builtin_amdgcn_mfma_scale_f32_16x16x128_f8f6f4(Bt##8[n], At##8[m], acc[ai][bj][m][n], 0, 0, 0, sc8_, 0, sc8_); } \
        else { _Pragma("unroll") for (int m = 0; m < 4; ++m) _Pragma("unroll") for (int n = 0; n < 2; ++n) _Pragma("unroll") for (int k = 0; k < 2; ++k) \
            acc[ai][bj][m][n] = __builtin_amdgcn_mfma_f32_16x16x32_bf16(Bt[n][k], At[m][k], acc[ai][bj][m][n], 0, 0, 0); } \
        __builtin_amdgcn_s_setprio(0); } while (0)
#define PG8_WAIT_V(n) asm volatile("s_waitcnt vmcnt(" #n ")" ::: "memory")
#define PG8_WAIT_L(n) asm volatile("s_waitcnt lgkmcnt(" #n ")" ::: "memory")
#define PG8_BAR __builtin_amdgcn_s_barrier()
#define PG8_SCHED __builtin_amdgcn_sched_barrier(0)
    Unit cur, nxt; int ui = 0;
    if (!S.next(0, cur)) return;
    static_assert(Prob::SCALE_A == Prob::SCALE_B, "one scale register serves both operands");
    int sc8_; asm volatile("v_mov_b32 %0, %1" : "=v"(sc8_) : "n"(Prob::SCALE_A));
    f32x4 acc[2][2][4][2];
    float zero_; asm volatile("v_mov_b32 %0, 0" : "=v"(zero_));
#pragma unroll
    for (int a = 0; a < 2; ++a)
#pragma unroll
        for (int b = 0; b < 2; ++b)
#pragma unroll
            for (int m = 0; m < 4; ++m)
#pragma unroll
                for (int n = 0; n < 2; ++n) acc[a][b][m][n] = (f32x4){zero_, zero_, zero_, zero_};
    bf16x8 At[4][2], B0[2][2], B1[2][2]; i32x8 At8[4], B08[2], B18[2];
    const char* cA = P.a_base(cur); const char* cB = P.b_base(cur); int nt = P.nt(cur);
    if constexpr (Prob::GATHER) { PG8_RC(Rr, Cc); P.a_rows(cur, Rr, Cc, offA); }
    if constexpr (Epi::SIDE) { PG8_TID(tl4_); E.side(cur, ldsb + SIDE_SLOT, wid, tl4_ & 63); }
    PG8_STAGE(PG8_SB(0, 0), cB, voffB); PG8_STAGE(PG8_SB(0, 1), cB + hstep, voffB); PG8_STAGE(PG8_SA(0, 0), cA, offA[0]); PG8_STAGE(PG8_SA(0, 1), cA, offA[1]);
    if (wr == 1) PG8_BAR;
    PG8_WAIT_V(2); PG8_BAR;
    PG8_STAGE(PG8_SB(1, 0), cB + kstep, voffB); PG8_STAGE(PG8_SA(1, 0), cA + kstep, offA[0]); PG8_STAGE(PG8_SB(1, 1), cB + hstep + kstep, voffB);
    PG8_WAIT_V(6); PG8_BAR;
    for (;;) {
        const bool has_next = S.next(ui + 1, nxt);
        const char* nA = has_next ? P.a_base(nxt) : cA; const char* nB = has_next ? P.b_base(nxt) : cB;
        if constexpr (Prob::GATHER) { if (has_next) { PG8_RC(Rr, Cc); (void)Cc;
#pragma unroll
            for (int h = 0; h < 2; ++h)
#pragma unroll
                for (int i = 0; i < 2; ++i) dma4((unsigned)(nxt.pm * 256 + h * 128 + Rr[i]) * 4u, P.tok, ldsb + SIDE_TOK + (unsigned)wid * 1024u + (unsigned)((h * 2 + i) * 256)); } }
        if constexpr (Epi::SIDE) { if (has_next) { PG8_TID(tl4_); E.side(nxt, ldsb + SIDE_SLOT + (unsigned)(((ui + 1) % 3) * SIDE_SLOT_BYTES), wid, tl4_ & 63); } }
        for (int t = 0; t < nt; t += 2) {
            const bool last = (t == nt - 2);
            if constexpr (Epi::KHOOK) { if (t == Epi::HOOK_T0 || t == Epi::HOOK_T1) {
                asm volatile("" ::: "memory"); PG8_TID(tlh_); const int lnh_ = tlh_ & 63; E.hook(acc, cur, t == Epi::HOOK_T0 ? 0 : 1, wr, wc, lnh_ & 15, lnh_ >> 4); asm volatile("" ::: "memory"); } }
            const char* a1 = cA + (size_t)(t + 1) * kstep;
            const char* a2 = last ? nA : cA + (size_t)(t + 2) * kstep; const char* b2 = last ? nB : cB + (size_t)(t + 2) * kstep;
            const char* a3 = a2 + kstep; const char* b3 = b2 + kstep;
            PG8_LDB(B0, 0, 0); PG8_LDB(B1, 0, 1); PG8_SCHED; PG8_LDA(At, 0, 0); PG8_STAGE(PG8_SA(1, 1), a1, offA[1]);
            PG8_WAIT_V(8); PG8_WAIT_L(0); PG8_BAR; PG8_MMA(0, 0, At, B0); PG8_MMA(0, 1, At, B1); PG8_BAR; PG8_SCHED;
            if constexpr (Prob::GATHER) { if (last && has_next) { PG8_RC(Rr, Cc); (void)Rr; PG8_TOKSLOT(tokslot); const int ntok[2][2] = {{tokslot[0], tokslot[64]}, {tokslot[128], tokslot[192]}}; P.a_off(ntok, Cc, offA); } }
            PG8_LDA(At, 0, 1); PG8_STAGE(PG8_SB(0, 0), b2, voffB); PG8_STAGE(PG8_SB(0, 1), b2 + hstep, voffB); PG8_STAGE(PG8_SA(0, 0), a2, offA[0]);
            PG8_WAIT_V(8); PG8_WAIT_L(0); PG8_BAR; PG8_MMA(1, 0, At, B0); PG8_MMA(1, 1, At, B1); PG8_BAR; PG8_SCHED;
            PG8_LDB(B0, 1, 0); PG8_LDB(B1, 1, 1); PG8_SCHED; PG8_LDA(At, 1, 0); PG8_STAGE(PG8_SA(0, 1), a2, offA[1]);
            PG8_WAIT_V(8); PG8_WAIT_L(0); PG8_BAR; PG8_MMA(0, 0, At, B0); PG8_MMA(0, 1, At, B1); PG8_BAR; PG8_SCHED;
            PG8_LDA(At, 1, 1); PG8_STAGE(PG8_SB(1, 0), b3, voffB); PG8_STAGE(PG8_SB(1, 1), b3 + hstep, voffB); PG8_STAGE(PG8_SA(1, 0), a3, offA[0]);
            PG8_WAIT_V(8); PG8_WAIT_L(0); PG8_BAR; PG8_MMA(1, 0, At, B0); PG8_MMA(1, 1, At, B1); PG8_BAR; PG8_SCHED;
        }
        if (wr == 0) PG8_BAR;
        { PG8_TID(tl3_); const int ln_ = tl3_ & 63; E(acc, cur, wr, wc, ln_ & 15, ln_ >> 4, lds + SIDE_SLOT + (ui % 3) * SIDE_SLOT_BYTES); }
        if (!has_next) break;
        bool keep = false;
        if constexpr (Epi::CHAIN) keep = E.keep(cur);
        if (!keep) {
            asm volatile("v_mov_b32 %0, 0" : "=v"(zero_));
#pragma unroll
            for (int a = 0; a < 2; ++a)
#pragma unroll
                for (int b = 0; b < 2; ++b)
#pragma unroll
                    for (int m = 0; m < 4; ++m)
#pragma unroll
                        for (int n = 0; n < 2; ++n) acc[a][b][m][n] = (f32x4){zero_, zero_, zero_, zero_};
        }
        cur = nxt; cA = nA; cB = nB; nt = P.nt(cur); ++ui;
        if (wr == 1) PG8_BAR;
    }
    PG8_WAIT_V(0);
    PG8_BAR;
#undef PG8_RC
#undef PG8_TID
#undef PG8_TOKSLOT
#undef PG8_SA
#undef PG8_SB
#undef PG8_STAGE
#undef PG8_LDA
#undef PG8_LDB
#undef PG8_MMA
#undef PG8_CAT
#undef PG8_WAIT_V
#undef PG8_WAIT_L
#undef PG8_BAR
#undef PG8_SCHED
}
}

typedef const float* cfp_t;
typedef const cfp_t __attribute__((address_space(4))) * InTab;
struct Frame {
    LAS unsigned char* lds;
    volatile LAS unsigned* MISC;
    unsigned char* ws;
    InTab in;
    float* out;
    int tid, lane, wave, G, bid;
};
enum { IN_X = 0, IN_C, IN_CTX, IN_CCTX, IN_WADA, IN_BADA, IN_WIN, IN_BIN, IN_POOLW, IN_POOLS, IN_CONVW, IN_CONVB, IN_MNG, IN_SLNG, IN_SLNB, IN_SGUW, IN_SGUB,
       IN_WBP, IN_WBM, IN_WBS, IN_WOUT, IN_LN1G, IN_LN1B, IN_WR, IN_BR, IN_WGU, IN_BGU, IN_WDN, IN_BDN, IN_LN2G, IN_LN2B };
__device__ __forceinline__ int mod_row(int row) { return row < ML ? (row >> 12) : NB; }
__device__ __forceinline__ const float* modp(const Frame& F, int l, int row, int part) { return (const float*)(F.ws + WS_MOD) + ((size_t)(l * 17 + mod_row(row)) * 6 + part) * 1024; }

__device__ __forceinline__ void transpose_item(const float* W, size_t ldw, int k0, int srccol0, bf16_t* dst, size_t ldk, int kd0, LAS float* scr, int lane) {
#pragma unroll 8
    for (int i = 0; i < 32; ++i) { const int kk = 2 * i + (lane >> 5); scr[kk * 33 + (lane & 31)] = __builtin_nontemporal_load(W + (size_t)(k0 + kk) * ldw + srccol0 + (lane & 31)); }
    LDS_WAIT(); asm volatile("" ::: "memory");
    const int c = lane & 7;
#pragma unroll
    for (int j = 0; j < 4; ++j) { const int n = (lane >> 3) + 8 * j; const LAS float* s = scr + (8 * c) * 33 + n;
        u32x4 o; o.x = pk2(s[0 * 33], s[1 * 33]); o.y = pk2(s[2 * 33], s[3 * 33]); o.z = pk2(s[4 * 33], s[5 * 33]); o.w = pk2(s[6 * 33], s[7 * 33]);
        *(u32x4*)(dst + (size_t)n * ldk + kd0 + 8 * c) = o; }
    LDS_WAIT(); asm volatile("" ::: "memory");
}
__device__ __forceinline__ void transpose_item_fp8(const float* W, size_t ldw, int k0, int srccol0, unsigned char* dst, size_t ldk, int kd0, float sc, LAS float* scr, int lane) {
#pragma unroll 8
    for (int i = 0; i < 32; ++i) { const int kk = 2 * i + (lane >> 5); scr[kk * 33 + (lane & 31)] = __builtin_nontemporal_load(W + (size_t)(k0 + kk) * ldw + srccol0 + (lane & 31)); }
    LDS_WAIT(); asm volatile("" ::: "memory");
    const int c = lane & 7;
#pragma unroll
    for (int j = 0; j < 4; ++j) { const int n = (lane >> 3) + 8 * j; const LAS float* s_ = scr + (8 * c) * 33 + n;
        u32x2 o; o.x = pk4_fp8(s_[0 * 33] * sc, s_[1 * 33] * sc, s_[2 * 33] * sc, s_[3 * 33] * sc); o.y = pk4_fp8(s_[4 * 33] * sc, s_[5 * 33] * sc, s_[6 * 33] * sc, s_[7 * 33] * sc);
        *(u32x2*)(dst + (size_t)n * ldk + kd0 + 8 * c) = o; }
    LDS_WAIT(); asm volatile("" ::: "memory");
}
__device__ __forceinline__ void phase_prologue(Frame& F) {
    LAS float* scr = (LAS float*)(F.lds + F.wave * 16384);
    const int gw = F.bid * NWAVES + F.wave, NGW = F.G * NWAVES;
    constexpr int I_IN = 16 * (NZ / 32);
    constexpr int I_BR = (4 + 8 + 4) * 32;
    constexpr int I_OUT = 16 * 32;
    constexpr int I_GU = 16 * 64;
    constexpr int I_DN = 16 * 32;
    constexpr int T_IN = DEPTH * I_IN, T_BR = DEPTH * I_BR, T_OUT = DEPTH * I_OUT, T_GU = DEPTH * NEXP * I_GU, T_DN = DEPTH * NEXP * I_DN;
    constexpr int NITEMS = T_IN + T_BR + T_OUT + T_GU + T_DN;
    for (int it = gw; it < NITEMS; it += NGW) {
        int r = it;
        if (r < T_IN) { const int l = r / I_IN; r %= I_IN; const int kb = r / (NZ / 32), nb = r % (NZ / 32); const int n0 = nb * 32, src = n0 < 2304 ? n0 : n0 + 16;
            if (n0 < NZ_BF) transpose_item(F.in[IN_WIN] + (size_t)l * D * 5904, 5904, kb * 64, src, (bf16_t*)(F.ws + WS_WIN) + ((size_t)l * NZ + n0) * D, D, kb * 64, scr, F.lane);
            else transpose_item_fp8(F.in[IN_WIN] + (size_t)l * D * 5904, 5904, kb * 64, src, (unsigned char*)(F.ws + WS_WIN8) + ((size_t)l * NZ_F8 + (n0 - NZ_BF)) * D, D, kb * 64, F8S_WGU, scr, F.lane);
            continue; }
        r -= T_IN;
        if (r < T_BR) { const int l = r / I_BR; r %= I_BR; const int kb = r / 32, nb = r % 32;
            const float* W; int ksrc;
            if (kb < 4) { W = F.in[IN_WBP] + (size_t)l * 256 * D; ksrc = kb * 64; } else if (kb < 12) { W = F.in[IN_WBM] + (size_t)l * 512 * D; ksrc = (kb - 4) * 64; } else { W = F.in[IN_WBS] + (size_t)l * 256 * D; ksrc = (kb - 12) * 64; }
            transpose_item(W, D, ksrc, nb * 32, (bf16_t*)(F.ws + WS_WBR) + ((size_t)l * D + nb * 32) * D, D, kb * 64, scr, F.lane); continue; }
        r -= T_BR;
        if (r < T_OUT) { const int l = r / I_OUT; r %= I_OUT; const int kb = r / 32, nb = r % 32;
            transpose_item(F.in[IN_WOUT] + (size_t)l * D * D, D, kb * 64, nb * 32, (bf16_t*)(F.ws + WS_WOUT) + ((size_t)l * D + nb * 32) * D, D, kb * 64, scr, F.lane); continue; }
        r -= T_OUT;
        if (r < T_GU) { const int le = r / I_GU; r %= I_GU; const int kb = r / 64, nb = r % 64; const int n0 = nb * 32;
            const int pn = n0 >> 8, c = n0 & 255; const int src = c < 128 ? (128 * pn + c) : (1024 + 128 * pn + c - 128);
            transpose_item_fp8(F.in[IN_WGU] + (size_t)le * D * 2048, 2048, kb * 64, src, (unsigned char*)(F.ws + WS_WGU) + ((size_t)le * 2048 + n0) * D, D, kb * 64, F8S_WGU, scr, F.lane); continue; }
        r -= T_GU;
        { const int le = r / I_DN; r %= I_DN; const int kb = r / 32, nb = r % 32;
            transpose_item_fp8(F.in[IN_WDN] + (size_t)le * D * D, D, kb * 64, nb * 32, (unsigned char*)(F.ws + WS_WDN) + ((size_t)le * D + nb * 32) * D, D, kb * 64, F8S_WDN, scr, F.lane); }
    }
    { const int gt = F.bid * NTHREADS + F.tid, NGT = F.G * NTHREADS;
      for (int i = gt; i < DEPTH * 16 * 1024; i += NGT) { const int l = i >> 14, g = (i >> 10) & 15, k = i & 1023; ((float*)(F.ws + WS_WG))[i] = F.in[IN_WIN][((size_t)l * D + k) * 5904 + 2304 + g]; }
      for (int i = gt; i < DEPTH * 4 * 128 * 128; i += NGT) ((bf16_t*)(F.ws + WS_WSGU))[i] = (bf16_t)f2bf(F.in[IN_SGUW][i]);
      for (int i = gt; i < DEPTH * 4 * 64 * 64; i += NGT) { const int lg = i >> 12, d = (i >> 6) & 63, c = i & 63; ((bf16_t*)(F.ws + WS_WPOOL))[i] = (bf16_t)f2bf(F.in[IN_POOLW][(size_t)lg * 4096 + c * 64 + d]); } }
    __syncthreads();
    { LAS float* sc = (LAS float*)F.lds;
      LAS float* part = (LAS float*)(F.lds + 71680);
      for (int i = F.tid; i < 17 * 1024; i += NTHREADS) { const int r = i >> 10, k = i & 1023; const float v = r < 16 ? F.in[IN_C][r * 1024 + k] : F.in[IN_CCTX][k]; sc[i] = siluf_(v); }
      __syncthreads();
      for (int u = F.bid; u < DEPTH * 48; u += F.G) {
          const int l = u / 48, n0 = (u % 48) * 128, col = F.tid & 127, ks = F.tid >> 7;
          float a[17];
#pragma unroll
          for (int r = 0; r < 17; ++r) a[r] = 0.f;
          const float* W = F.in[IN_WADA] + (size_t)l * D * 6144 + n0 + col;
          for (int k = ks * 256; k < ks * 256 + 256; ++k) { const float w = W[(size_t)k * 6144];
#pragma unroll
              for (int r = 0; r < 17; ++r) a[r] += sc[r * 1024 + k] * w; }
#pragma unroll
          for (int r = 0; r < 17; ++r) part[(ks * 17 + r) * 128 + col] = a[r];
          __syncthreads();
          for (int i = F.tid; i < 17 * 128; i += NTHREADS) { const int r = i >> 7, cc = i & 127;
              const float s = part[(0 * 17 + r) * 128 + cc] + part[(1 * 17 + r) * 128 + cc] + part[(2 * 17 + r) * 128 + cc] + part[(3 * 17 + r) * 128 + cc] + F.in[IN_BADA][l * 6144 + n0 + cc];
              ((float*)(F.ws + WS_MOD))[(size_t)(l * 17 + r) * 6144 + n0 + cc] = s; }
          __syncthreads();
      } }
}

struct RowV { f32x4 v[4]; };
#define RC(lane, j) (8 * (lane) + 512 * ((j) >> 1) + 4 * ((j) & 1))
__device__ __forceinline__ void row_load(RowV& r, const float* p, int lane) {
#pragma unroll
    for (int j = 0; j < 4; ++j) r.v[j] = __builtin_nontemporal_load((const f32x4*)(p + RC(lane, j)));
}
__device__ __forceinline__ void row_load_bf16(RowV& r, const bf16_t* p, int lane) {
#pragma unroll
    for (int h = 0; h < 2; ++h) { const u32x4 w = __builtin_nontemporal_load((const u32x4*)(p + 8 * lane + 512 * h)); r.v[2 * h] = (f32x4){bflo(w.x), bfhi(w.x), bflo(w.y), bfhi(w.y)}; r.v[2 * h + 1] = (f32x4){bflo(w.z), bfhi(w.z), bflo(w.w), bfhi(w.w)}; }
}
__device__ __forceinline__ void row_store(const RowV& r, float* p, int lane) {
#pragma unroll
    for (int j = 0; j < 4; ++j) *(f32x4*)(p + RC(lane, j)) = r.v[j];
}
__device__ __forceinline__ void row_store_nt(const RowV& r, float* p, int lane) {
#pragma unroll
    for (int j = 0; j < 4; ++j) __builtin_nontemporal_store(r.v[j], (f32x4*)(p + RC(lane, j)));
}
__device__ __forceinline__ void row_store_bf16_nt(const RowV& r, bf16_t* p, int lane) {
#pragma unroll
    for (int h = 0; h < 2; ++h) { u32x4 w; w.x = pk2(r.v[2 * h].x, r.v[2 * h].y); w.y = pk2(r.v[2 * h].z, r.v[2 * h].w); w.z = pk2(r.v[2 * h + 1].x, r.v[2 * h + 1].y); w.w = pk2(r.v[2 * h + 1].z, r.v[2 * h + 1].w); __builtin_nontemporal_store(w, (u32x4*)(p + 8 * lane + 512 * h)); }
}
__device__ __forceinline__ void row_store_bf16(const RowV& r, bf16_t* p, int lane) {
#pragma unroll
    for (int h = 0; h < 2; ++h) { u32x4 w; w.x = pk2(r.v[2 * h].x, r.v[2 * h].y); w.y = pk2(r.v[2 * h].z, r.v[2 * h].w); w.z = pk2(r.v[2 * h + 1].x, r.v[2 * h + 1].y); w.w = pk2(r.v[2 * h + 1].z, r.v[2 * h + 1].w); *(u32x4*)(p + 8 * lane + 512 * h) = w; }
}
__device__ __forceinline__ void row_ln_plain(RowV& r, int lane) {
    float s = 0.f;
#pragma unroll
    for (int j = 0; j < 4; ++j) s += (r.v[j].x + r.v[j].y) + (r.v[j].z + r.v[j].w);
    const float mean = wave_sum(s, lane) * (1.f / D); float s2 = 0.f;
#pragma unroll
    for (int j = 0; j < 4; ++j) { r.v[j] = r.v[j] - mean; s2 += (r.v[j].x * r.v[j].x + r.v[j].y * r.v[j].y) + (r.v[j].z * r.v[j].z + r.v[j].w * r.v[j].w); }
    const float rstd = __builtin_amdgcn_rsqf(wave_sum(s2, lane) * (1.f / D) + LN_EPS);
#pragma unroll
    for (int j = 0; j < 4; ++j) r.v[j] = r.v[j] * rstd;
}
__device__ __forceinline__ void row_affine(RowV& r, const float* g, const float* b, int lane) {
#pragma unroll
    for (int j = 0; j < 4; ++j) { const f32x4 gg = *(const f32x4*)(g + RC(lane, j)), bb = *(const f32x4*)(b + RC(lane, j)); r.v[j] = r.v[j] * gg + bb; }
}
__device__ __forceinline__ void row_modulate(RowV& r, const float* sh, const float* sc, int lane) {
#pragma unroll
    for (int j = 0; j < 4; ++j) { const f32x4 s1 = *(const f32x4*)(sc + RC(lane, j)), s0 = *(const f32x4*)(sh + RC(lane, j)); r.v[j] = r.v[j] * (s1 + 1.0f) + s0; }
}
__device__ __forceinline__ LAS float* pv_slot(const Frame& F, int slot) { return (LAS float*)(F.lds + NW_PV) + slot * 1024; }
__device__ __forceinline__ void pv_fill(Frame& F, int slot, const float* src) { LAS f32x4* d = (LAS f32x4*)pv_slot(F, slot); for (int i = F.tid; i < 256; i += NTHREADS) d[i] = *(const f32x4*)(src + 4 * i); }
__device__ __forceinline__ void row_affine_l(RowV& r, const LAS float* g, const LAS float* b, int lane) {
#pragma unroll
    for (int j = 0; j < 4; ++j) { const f32x4 gg = *(const LAS f32x4*)(g + RC(lane, j)), bb = *(const LAS f32x4*)(b + RC(lane, j)); r.v[j] = r.v[j] * gg + bb; }
}
__device__ __forceinline__ void row_modulate_l(RowV& r, const LAS float* sh, const LAS float* sc, int lane) {
#pragma unroll
    for (int j = 0; j < 4; ++j) { const f32x4 s1 = *(const LAS f32x4*)(sc + RC(lane, j)), s0 = *(const LAS f32x4*)(sh + RC(lane, j)); r.v[j] = r.v[j] * (s1 + 1.0f) + s0; }
}
__device__ __forceinline__ void ln0_row(Frame& F, int row, RowV xr, const LAS float* sh, const LAS float* sc) {
    row_ln_plain(xr, F.lane);
    row_modulate_l(xr, sh, sc, F.lane);
    row_store_bf16(xr, (bf16_t*)(F.ws + WS_H) + (size_t)row * D, F.lane);
    { unsigned char* h8 = (unsigned char*)(F.ws + WS_H8) + (size_t)row * D + 8 * F.lane;
#pragma unroll
      for (int h = 0; h < 2; ++h) { u32x2 w; w.x = pk4_fp8(xr.v[2 * h].x * F8S_ACT, xr.v[2 * h].y * F8S_ACT, xr.v[2 * h].z * F8S_ACT, xr.v[2 * h].w * F8S_ACT); w.y = pk4_fp8(xr.v[2 * h + 1].x * F8S_ACT, xr.v[2 * h + 1].y * F8S_ACT, xr.v[2 * h + 1].z * F8S_ACT, xr.v[2 * h + 1].w * F8S_ACT); *(u32x2*)(h8 + 512 * h) = w; } }
}
__device__ __forceinline__ LAS float* narrow_tile_wave(Frame& F, const bf16_t* A) {
    const int r = F.lane & 31, h = F.lane >> 5;
    f32x16 acc;
#pragma unroll
    for (int i = 0; i < 16; ++i) acc[i] = 0.f;
    const bf16_t* ap = A + (size_t)r * D + 8 * h;
    const LAS unsigned char* bp = F.lds + NW_WT + r * 2064 + 16 * h;
    bf16x8 av[2][16];
#pragma unroll
    for (int ks = 0; ks < 16; ++ks) av[0][ks] = *(const bf16x8*)(ap + ks * 16);
#pragma unroll
    for (int kb = 0; kb < 4; ++kb) {
        if (kb < 3) {
#pragma unroll
            for (int ks = 0; ks < 16; ++ks) av[(kb + 1) & 1][ks] = *(const bf16x8*)(ap + ((kb + 1) * 16 + ks) * 16); }
        __builtin_amdgcn_sched_barrier(0);
#pragma unroll
        for (int ks = 0; ks < 16; ++ks) { const bf16x8 b = *(const LAS bf16x8*)(bp + (kb * 16 + ks) * 32); acc = __builtin_amdgcn_mfma_f32_32x32x16_bf16(av[kb & 1][ks], b, acc, 0, 0, 0); }
        __builtin_amdgcn_sched_barrier(0);
    }
    LAS float* lg = (LAS float*)(F.lds + NW_LG) + F.wave * 1056;
#pragma unroll
    for (int i = 0; i < 16; ++i) lg[((i & 3) + 8 * (i >> 2) + 4 * h) * 33 + r] = acc[i];
    asm volatile("s_waitcnt lgkmcnt(0)" ::: "memory");
    return lg;
}
__device__ __forceinline__ void tile_range(const Frame& F, int mrows, int& t_lo, int& t_hi) { const int nt = mrows / 32; t_lo = (int)(((long)F.bid * nt) / F.G); t_hi = (int)(((long)(F.bid + 1) * nt) / F.G); }
__device__ __forceinline__ void load_wg_lds(Frame& F, int l) {
    const float* src = (const float*)(F.ws + WS_WG) + (size_t)l * 16384;
    for (int i = F.tid; i < 32 * 128; i += NTHREADS) { const int g = i >> 7, c8 = i & 127; u32x4 w = (u32x4){0u, 0u, 0u, 0u};
        if (g < 16) { const f32x4 a = *(const f32x4*)(src + g * 1024 + c8 * 8), b = *(const f32x4*)(src + g * 1024 + c8 * 8 + 4); w.x = pk2(a.x, a.y); w.y = pk2(a.z, a.w); w.z = pk2(b.x, b.y); w.w = pk2(b.z, b.w); }
        *(LAS u32x4*)(F.lds + NW_WT + g * 2064 + c8 * 16) = w; }
    __syncthreads();
}
__device__ __forceinline__ void gates_tail(Frame& F, int l, int t_lo, int t_hi) {
    asm volatile("s_waitcnt vmcnt(0)" ::: "memory"); __syncthreads();
    const int g = F.lane & 15; const float bias = F.in[IN_BIN][l * 5904 + 2304 + g];
    for (int tile = t_lo + F.wave; tile < t_hi; tile += NWAVES) {
        const LAS float* lg = narrow_tile_wave(F, (const bf16_t*)(F.ws + WS_H) + (size_t)tile * 32 * D);
#pragma unroll
        for (int rr = 0; rr < 8; ++rr) { const int row = rr * 4 + (F.lane >> 4); ((float*)(F.ws + WS_ZG))[(size_t)(tile * 32 + row) * 16 + g] = lg[row * 33 + g] + bias; }
        asm volatile("s_waitcnt lgkmcnt(0)" ::: "memory");
    }
}

using pg8::Unit;
struct ProbPlain {
    static constexpr bool GATHER = false, FP8 = false; static constexpr int SCALE_A = 127, SCALE_B = 127; const bf16_t* A; const bf16_t* Bt; int lda, ldb;
    __device__ __forceinline__ int nt(const Unit&) const { return lda / 64; }
    __device__ __forceinline__ const char* a_base(const Unit& u) const { return (const char*)A + (size_t)u.pm * 256 * lda * 2; }
    __device__ __forceinline__ const char* b_base(const Unit& u) const { return (const char*)Bt + (size_t)u.pn * 256 * ldb * 2; }
    __device__ __forceinline__ void a_tok(const Unit&, const int (&)[2], int (&)[2][2]) const {}
    __device__ __forceinline__ void a_off(const int (&)[2][2], const int (&)[2], unsigned (&)[2][2]) const {}
    __device__ __forceinline__ void a_rows(const Unit&, const int (&)[2], const int (&)[2], unsigned (&)[2][2]) const {}
};
struct ProbPlainF8 {
    static constexpr bool GATHER = false, FP8 = true; static constexpr int SCALE_A = F8E_ACT, SCALE_B = F8E_WGU; const bf16_t* A; const bf16_t* Bt; int lda, ldb;
    __device__ __forceinline__ int nt(const Unit&) const { return lda / 64; }
    __device__ __forceinline__ const char* a_base(const Unit& u) const { return (const char*)A + (size_t)u.pm * 256 * lda * 2; }
    __device__ __forceinline__ const char* b_base(const Unit& u) const { return (const char*)Bt + (size_t)u.pn * 256 * ldb * 2; }
    __device__ __forceinline__ void a_tok(const Unit&, const int (&)[2], int (&)[2][2]) const {}
    __device__ __forceinline__ void a_off(const int (&)[2][2], const int (&)[2], unsigned (&)[2][2]) const {}
    __device__ __forceinline__ void a_rows(const Unit&, const int (&)[2], const int (&)[2], unsigned (&)[2][2]) const {}
};
struct ProbBranch {
    static constexpr bool GATHER = false, FP8 = false; static constexpr int SCALE_A = 127, SCALE_B = 127; const bf16_t* A; const bf16_t* Bt; int lda, ldb;
    __device__ __forceinline__ int nt(const Unit& u) const { return u.sub == 1 ? 8 : 4; }
    __device__ __forceinline__ int koff(const Unit& u) const { return u.sub == 0 ? 0 : (u.sub == 1 ? 256 : 768); }
    __device__ __forceinline__ const char* a_base(const Unit& u) const { return (const char*)A + ((size_t)u.pm * 256 * lda + koff(u)) * 2; }
    __device__ __forceinline__ const char* b_base(const Unit& u) const { return (const char*)Bt + ((size_t)u.pn * 256 * ldb + koff(u)) * 2; }
    __device__ __forceinline__ void a_tok(const Unit&, const int (&)[2], int (&)[2][2]) const {}
    __device__ __forceinline__ void a_off(const int (&)[2][2], const int (&)[2], unsigned (&)[2][2]) const {}
    __device__ __forceinline__ void a_rows(const Unit&, const int (&)[2], const int (&)[2], unsigned (&)[2][2]) const {}
};
__device__ __forceinline__ int expert_of(const LAS int* seg, int pm) { return __builtin_amdgcn_readfirstlane((int)((const LAS unsigned char*)(seg + 64))[pm]); }
__device__ __forceinline__ int moe_tables(Frame& F, LAS int* seg) {
    __syncthreads();
    if (F.tid <= NEXP) seg[F.tid] = ((const int*)(F.ws + WS_ROUTE + RT_SEG))[F.tid];
    __syncthreads();
    const int ntile = seg[NEXP] / 256;
    LAS unsigned char* texp = (LAS unsigned char*)(seg + 64);
    for (int t = F.tid; t < ntile; t += NTHREADS) { const int row = t * 256; int e = 0;
#pragma unroll
        for (int i = 1; i < NEXP; ++i) e += (seg[i] <= row) ? 1 : 0;
        texp[t] = (unsigned char)e; }
    __syncthreads();
    return ntile;
}
struct ProbMoe1 {
    static constexpr bool GATHER = true, FP8 = true; static constexpr int SCALE_A = F8E_ACT, SCALE_B = F8E_WGU; const bf16_t* A; const bf16_t* Bt; int lda, ldb; const int* tok; const LAS int* seg;
    __device__ __forceinline__ int nt(const Unit&) const { return lda / 64; }
    __device__ __forceinline__ const char* a_base(const Unit&) const { return (const char*)A; }
    __device__ __forceinline__ const char* b_base(const Unit& u) const { const int e = expert_of(seg, u.pm); return (const char*)Bt + ((size_t)e * 2048 + (size_t)u.pn * 256) * ldb * 2; }
    __device__ __forceinline__ void a_rows(const Unit& u, const int (&R)[2], const int (&C)[2], unsigned (&off)[2][2]) const {
#pragma unroll
        for (int h = 0; h < 2; ++h)
#pragma unroll
            for (int i = 0; i < 2; ++i) { const int t = tok[u.pm * 256 + h * 128 + R[i]]; off[h][i] = (unsigned)(t * lda + C[i]) * 2u; } }
    __device__ __forceinline__ void a_tok(const Unit& u, const int (&R)[2], int (&tk)[2][2]) const {
#pragma unroll
        for (int h = 0; h < 2; ++h)
#pragma unroll
            for (int i = 0; i < 2; ++i) tk[h][i] = tok[u.pm * 256 + h * 128 + R[i]]; }
    __device__ __forceinline__ void a_off(const int (&tk)[2][2], const int (&C)[2], unsigned (&off)[2][2]) const {
#pragma unroll
        for (int h = 0; h < 2; ++h)
#pragma unroll
            for (int i = 0; i < 2; ++i) off[h][i] = (unsigned)(tk[h][i] * lda + C[i]) * 2u; }
};
struct ProbMoe2 {
    static constexpr bool GATHER = false, FP8 = true; static constexpr int SCALE_A = F8E_ACT, SCALE_B = F8E_WDN; const bf16_t* A; const bf16_t* Bt; int lda, ldb; const LAS int* seg;
    __device__ __forceinline__ int nt(const Unit&) const { return lda / 64; }
    __device__ __forceinline__ const char* a_base(const Unit& u) const { return (const char*)A + (size_t)u.pm * 256 * lda * 2; }
    __device__ __forceinline__ const char* b_base(const Unit& u) const { const int e = expert_of(seg, u.pm); return (const char*)Bt + ((size_t)e * 1024 + (size_t)u.pn * 256) * ldb * 2; }
    __device__ __forceinline__ void a_tok(const Unit&, const int (&)[2], int (&)[2][2]) const {}
    __device__ __forceinline__ void a_off(const int (&)[2][2], const int (&)[2], unsigned (&)[2][2]) const {}
    __device__ __forceinline__ void a_rows(const Unit&, const int (&)[2], const int (&)[2], unsigned (&)[2][2]) const {}
};
using pg8::cvt_pk_bf16;
template <bool G8> struct EpiInproj {
    static constexpr bool PERM = true, CHAIN = false, SIDE = true, KHOOK = false; bf16_t* Z; const float* bias; int pn0;
    __device__ __forceinline__ void side(const Unit& u0, unsigned slot, int wid, int lane) const { const int pn = u0.pn + pn0; if (wid == 1) pg8::dma16((unsigned)lane * 16u, bias + pn * 256 + (pn >= 9 ? 16 : 0), slot); }
    __device__ __forceinline__ void operator()(const f32x4 (&acc)[2][2][4][2], const Unit& u0, int wr, int wc, int fr, int fq, const LAS unsigned char* sd) const {
        Unit u = u0; u.pn += pn0;
        int row0 = u.pm * 256 + wr * 64 + fr, col0 = u.pn * 256 + wc * 32 + 8 * fq; asm volatile("" : "+v"(row0), "+v"(col0));
        const int act = (u.pn <= 6) ? 0 : ((u.pn == 9 || u.pn == 10) ? 2 : 1);
        f32x4 bv[2][2];
#pragma unroll
        for (int bj = 0; bj < 2; ++bj)
#pragma unroll
            for (int n = 0; n < 2; ++n) bv[bj][n] = *(const LAS f32x4*)(sd + (bj * 128 + wc * 32 + 8 * fq + 4 * n) * 4);
#pragma unroll
        for (int ai = 0; ai < 2; ++ai)
#pragma unroll
            for (int m = 0; m < 4; ++m) { bf16_t* rowp = Z + (size_t)(row0 + ai * 128 + m * 16) * NZ + col0;
#pragma unroll
                for (int bj = 0; bj < 2; ++bj) { f32x4 v0 = acc[ai][bj][m][0] + bv[bj][0], v1 = acc[ai][bj][m][1] + bv[bj][1];
                    if (G8 && u.pn >= ZG_COL / 256) { u32x2 w8;
                        v0 = sigmoid4(v0) * G8_SCALE; v1 = sigmoid4(v1) * G8_SCALE;
#pragma unroll
                        for (int j = 0; j < 4; ++j) { v0[j] = fmaxf(v0[j], 1.0f); v1[j] = fmaxf(v1[j], 1.0f); }
                        v0 = v0 + 12582912.0f; v1 = v1 + 12582912.0f;
                        w8.x = pk4_u8(v0[0], v0[1], v0[2], v0[3]); w8.y = pk4_u8(v1[0], v1[1], v1[2], v1[3]);
                        *(u32x2*)((unsigned char*)(Z + (size_t)(row0 + ai * 128 + m * 16) * NZ + ZG_COL) + (col0 - ZG_COL) + bj * 128) = w8; continue; }
                    if (act == 2) { f32x2 a = pg8::gelu_pk((f32x2){v0[0], v0[1]}), b = pg8::gelu_pk((f32x2){v0[2], v0[3]}), c = pg8::gelu_pk((f32x2){v1[0], v1[1]}), d = pg8::gelu_pk((f32x2){v1[2], v1[3]});
                        v0 = (f32x4){a.x, a.y, b.x, b.y}; v1 = (f32x4){c.x, c.y, d.x, d.y}; }
                    if (act == 1) { v0 = sigmoid4(v0); v1 = sigmoid4(v1); }
                    u32x4 w; w.x = cvt_pk_bf16(v0[0], v0[1]); w.y = cvt_pk_bf16(v0[2], v0[3]); w.z = cvt_pk_bf16(v1[0], v1[1]); w.w = cvt_pk_bf16(v1[2], v1[3]);
                    *(u32x4*)(rowp + bj * 128) = w; }
                if constexpr (G8) asm volatile("" ::: "memory"); }
    }
};
struct EpiNull {
    static constexpr bool PERM = true, CHAIN = false; bf16_t* Z;
    __device__ __forceinline__ void operator()(const f32x4 (&acc)[2][2][4][2], const Unit& u, int wr, int wc, int fr, int fq) const {
        float sacc = 0.f;
#pragma unroll
        for (int ai = 0; ai < 2; ++ai)
#pragma unroll
            for (int bj = 0; bj < 2; ++bj)
#pragma unroll
                for (int m = 0; m < 4; ++m)
#pragma unroll
                    for (int n = 0; n < 2; ++n) sacc += (acc[ai][bj][m][n][0] + acc[ai][bj][m][n][1]) + (acc[ai][bj][m][n][2] + acc[ai][bj][m][n][3]);
        if (sacc == 1.2345e30f) Z[u.pm + wr + wc + fr + fq] = 0;
    }
};
struct EpiOut {
    static constexpr bool PERM = true, CHAIN = false, SIDE = false, KHOOK = false; bf16_t* T;
    __device__ __forceinline__ void operator()(const f32x4 (&acc)[2][2][4][2], const Unit& u, int wr, int wc, int fr, int fq, const LAS unsigned char*) const {
        int row0 = u.pm * 256 + wr * 64 + fr, col0 = u.pn * 256 + wc * 32 + 8 * fq; asm volatile("" : "+v"(row0), "+v"(col0));
#pragma unroll
        for (int ai = 0; ai < 2; ++ai)
#pragma unroll
            for (int m = 0; m < 4; ++m) { bf16_t* rowp = T + (size_t)(row0 + ai * 128 + m * 16) * D + col0;
#pragma unroll
                for (int bj = 0; bj < 2; ++bj) { const f32x4 v0 = acc[ai][bj][m][0], v1 = acc[ai][bj][m][1];
                    u32x4 w; w.x = cvt_pk_bf16(v0[0], v0[1]); w.y = cvt_pk_bf16(v0[2], v0[3]); w.z = cvt_pk_bf16(v1[0], v1[1]); w.w = cvt_pk_bf16(v1[2], v1[3]);
                    *(u32x4*)(rowp + bj * 128) = w; } }
    }
};
struct EpiBranch {
    static constexpr bool PERM = true, CHAIN = false, SIDE = false, KHOOK = true; static constexpr int HOOK_T0 = 4, HOOK_T1 = 12;
    const bf16_t* Z; bf16_t* Y;
    template <bool FIN> __device__ __forceinline__ void apply(f32x4 (&acc)[2][2][4][2], const Unit& u, int br, int wr, int wc, int fr, int fq) const {
        int row0 = u.pm * 256 + wr * 64 + fr, col0 = u.pn * 256 + wc * 32 + 8 * fq;
        asm volatile("" : "+v"(row0), "+v"(col0));
#pragma unroll
        for (int ai = 0; ai < 2; ++ai) {
            u32x2 ga[4][2], gb[4][2];
#pragma unroll
            for (int m = 0; m < 4; ++m) { const unsigned char* rowp = (const unsigned char*)(Z + (size_t)(row0 + ai * 128 + m * 16) * NZ + ZG_COL) + br * 1024 + col0;
#pragma unroll
                for (int bj = 0; bj < 2; ++bj) { ga[m][bj] = *(const u32x2*)(rowp + bj * 128); if (!FIN) gb[m][bj] = *(const u32x2*)(rowp + 1024 + bj * 128); } }
#pragma unroll
            for (int m = 0; m < 4; ++m) { const size_t row = (size_t)(row0 + ai * 128 + m * 16);
#pragma unroll
                for (int bj = 0; bj < 2; ++bj) { const u32x2 a = ga[m][bj];
                    f32x4 r0 = u8x4_f32(a.x), r1 = u8x4_f32(a.y);
                    if (FIN) { r0 = r0 * (1.0f / G8_SCALE); r1 = r1 * (1.0f / G8_SCALE); }
                    else { const u32x2 b = gb[m][bj]; f32x4 q0 = u8x4_f32(b.x), q1 = u8x4_f32(b.y);
#pragma unroll
                        for (int i = 0; i < 4; ++i) { q0[i] = __builtin_amdgcn_rcpf(q0[i]); q1[i] = __builtin_amdgcn_rcpf(q1[i]); }
                        r0 = r0 * q0; r1 = r1 * q1; }
                    acc[ai][bj][m][0] = acc[ai][bj][m][0] * r0; acc[ai][bj][m][1] = acc[ai][bj][m][1] * r1;
                    if (FIN) { const f32x4 v0 = acc[ai][bj][m][0], v1 = acc[ai][bj][m][1];
                        u32x4 w; w.x = cvt_pk_bf16(v0[0], v0[1]); w.y = cvt_pk_bf16(v0[2], v0[3]); w.z = cvt_pk_bf16(v1[0], v1[1]); w.w = cvt_pk_bf16(v1[2], v1[3]);
                        *(u32x4*)(Y + row * D + col0 + bj * 128) = w; } } }
            asm volatile("" ::: "memory"); }
    }
    __device__ __forceinline__ void hook(f32x4 (&acc)[2][2][4][2], const Unit& u, int br, int wr, int wc, int fr, int fq) const { apply<false>(acc, u, br, wr, wc, fr, fq); }
    __device__ __forceinline__ void operator()(f32x4 (&acc)[2][2][4][2], const Unit& u, int wr, int wc, int fr, int fq, const LAS unsigned char*) const { apply<true>(acc, u, 2, wr, wc, fr, fq); }
};
struct EpiSwiglu {
    static constexpr bool PERM = true, CHAIN = false, SIDE = true, KHOOK = false; unsigned char* HID; const float* bgu; const LAS int* seg;
    __device__ __forceinline__ void side(const Unit& u, unsigned slot, int wid, int lane) const {
        if (wid == 1) { const int e = expert_of(seg, u.pm); pg8::dma16(lane < 32 ? (unsigned)lane * 16u : 4096u + (unsigned)(lane - 32) * 16u, bgu + (size_t)e * 2048 + u.pn * 128, slot); } }
    __device__ __forceinline__ void operator()(const f32x4 (&acc)[2][2][4][2], const Unit& u, int wr, int wc, int fr, int fq, const LAS unsigned char* sd) const {
        int j0 = u.pn * 128 + wc * 32 + 8 * fq, slot0 = u.pm * 256 + wr * 64 + fr; asm volatile("" : "+v"(j0), "+v"(slot0));
        f32x4 bg[2], bu[2];
#pragma unroll
        for (int n = 0; n < 2; ++n) { bg[n] = *(const LAS f32x4*)(sd + (wc * 32 + 8 * fq + 4 * n) * 4); bu[n] = *(const LAS f32x4*)(sd + (128 + wc * 32 + 8 * fq + 4 * n) * 4); }
#pragma unroll
        for (int ai = 0; ai < 2; ++ai)
#pragma unroll
            for (int m = 0; m < 4; ++m) { const size_t slot = (size_t)(slot0 + ai * 128 + m * 16); f32x4 o[2];
#pragma unroll
                for (int n = 0; n < 2; ++n) { f32x4 g = acc[ai][0][m][n] + bg[n], up = acc[ai][1][m][n] + bu[n];
#pragma unroll
                    for (int i = 0; i < 4; ++i) { g[i] = fminf(g[i], 7.0f); up[i] = __builtin_amdgcn_fmed3f(up[i], -7.0f, 7.0f); }
                    f32x4 t = g * (-1.702f * 1.4426950408889634f);
#pragma unroll
                    for (int i = 0; i < 4; ++i) t[i] = __builtin_amdgcn_exp2f(t[i]);
                    t = t + 1.0f;
#pragma unroll
                    for (int i = 0; i < 4; ++i) t[i] = __builtin_amdgcn_rcpf(t[i]);
                    o[n] = (up * F8S_ACT + F8S_ACT) * (g * t); }
                u32x2 w; w.x = pk4_fp8(o[0][0], o[0][1], o[0][2], o[0][3]); w.y = pk4_fp8(o[1][0], o[1][1], o[1][2], o[1][3]);
                *(u32x2*)(HID + slot * 1024 + j0) = w; }
    }
};
struct EpiDown {
    static constexpr bool PERM = true, CHAIN = false, SIDE = true, KHOOK = false; unsigned char* FS; const float* bdn; const int* dest; const float* pslot; const LAS int* seg;
    __device__ __forceinline__ void side(const Unit& u, unsigned slot, int wid, int lane) const {
        if (wid == 1) { const int e = expert_of(seg, u.pm); pg8::dma16((unsigned)lane * 16u, bdn + (size_t)e * 1024 + u.pn * 256, slot); }
        if (wid == 2) pg8::dma16((unsigned)lane * 16u, dest + (size_t)u.pm * 256, slot + 1024u);
        if (wid == 3) pg8::dma16((unsigned)lane * 16u, pslot + (size_t)u.pm * 256, slot + 2048u); }
    __device__ __forceinline__ void operator()(const f32x4 (&acc)[2][2][4][2], const Unit& u, int wr, int wc, int fr, int fq, const LAS unsigned char* sd) const {
        int col0 = u.pn * 256 + wc * 32 + 8 * fq, slot0 = u.pm * 256 + wr * 64 + fr; asm volatile("" : "+v"(col0), "+v"(slot0));
        f32x4 bv[2][2];
#pragma unroll
        for (int bj = 0; bj < 2; ++bj)
#pragma unroll
            for (int n = 0; n < 2; ++n) bv[bj][n] = *(const LAS f32x4*)(sd + (bj * 128 + wc * 32 + 8 * fq + 4 * n) * 4);
#pragma unroll
        for (int ai = 0; ai < 2; ++ai)
#pragma unroll
            for (int m = 0; m < 4; ++m) { const int rt = ai * 128 + wr * 64 + m * 16 + fr; const int d = *(const LAS int*)(sd + 1024 + rt * 4); const float p = *(const LAS float*)(sd + 2048 + rt * 4) * FS_SCALE;
                if (d >= 0) {
#pragma unroll
                    for (int bj = 0; bj < 2; ++bj) { f32x4 v0 = (acc[ai][bj][m][0] + bv[bj][0]) * p, v1 = (acc[ai][bj][m][1] + bv[bj][1]) * p;
#pragma unroll
                        for (int i = 0; i < 4; ++i) { v0[i] = __builtin_amdgcn_fmed3f(v0[i], -FS_CLAMP, FS_CLAMP); v1[i] = __builtin_amdgcn_fmed3f(v1[i], -FS_CLAMP, FS_CLAMP); }
                        u32x2 w; w.x = pk4_fp8(v0[0], v0[1], v0[2], v0[3]); w.y = pk4_fp8(v1[0], v1[1], v1[2], v1[3]);
                        *(u32x2*)(FS + (size_t)d * 1024 + col0 + bj * 128) = w; } }
                asm volatile("" ::: "memory"); }
    }
};

__device__ __forceinline__ const float* xin_row(const Frame& F, int row) { return row < ML ? F.in[IN_X] + (size_t)row * D : F.in[IN_CTX] + (size_t)(row - ML) * D; }
__device__ __forceinline__ void phase_ln0_first(Frame& F) {
    int t_lo, t_hi; tile_range(F, MT, t_lo, t_hi);
    const int r_lo = 32 * t_lo, nrows = 32 * (t_hi - t_lo);
    const int mrA = mod_row(r_lo), mrB = mod_row(r_lo + (nrows > 0 ? nrows - 1 : 0));
    { const float* mb = (const float*)(F.ws + WS_MOD); pv_fill(F, 0, mb + ((size_t)(0 * 17 + mrA) * 6 + 0) * 1024); pv_fill(F, 1, mb + ((size_t)(0 * 17 + mrB) * 6 + 0) * 1024);
      pv_fill(F, 2, mb + ((size_t)(0 * 17 + mrA) * 6 + 1) * 1024); pv_fill(F, 3, mb + ((size_t)(0 * 17 + mrB) * 6 + 1) * 1024); }
    load_wg_lds(F, 0);
    for (int n = F.wave; n < nrows; n += 4 * NWAVES) {
        RowV rv[4];
#pragma unroll
        for (int u = 0; u < 4; ++u) if (n + u * NWAVES < nrows) row_load(rv[u], xin_row(F, r_lo + n + u * NWAVES), F.lane);
#pragma unroll
        for (int u = 0; u < 4; ++u) if (n + u * NWAVES < nrows) { const int row = r_lo + n + u * NWAVES;
            const int sel = (mod_row(row) == mrA) ? 0 : 1; ln0_row(F, row, rv[u], pv_slot(F, 0 + sel), pv_slot(F, 2 + sel)); }
    }
    gates_tail(F, 0, t_lo, t_hi);
    __syncthreads();
}
__device__ __forceinline__ void phase_finalize(Frame& F, int l, int mrows) {
    const int gw = F.bid * NWAVES + F.wave, NGW = F.G * NWAVES;
    const bf16_t* hf = (const bf16_t*)(F.ws + WS_HFB); const bf16_t* hb = hf + (size_t)MT * 512;
    const float* ng = F.in[IN_MNG] + l * 512 + 8 * F.lane;
    const f32x4 g0 = *(const f32x4*)ng, g1 = *(const f32x4*)(ng + 4);
    const bf16_t* zo = (const bf16_t*)(F.ws + WS_Z) + ZC_O + 8 * F.lane;
    u32x4 ha = (u32x4){0u, 0u, 0u, 0u}, hbv = ha, so = ha;
    if (gw < mrows) { ha = __builtin_nontemporal_load((const u32x4*)(hf + (size_t)gw * 512 + 8 * F.lane)); hbv = __builtin_nontemporal_load((const u32x4*)(hb + (size_t)gw * 512 + 8 * F.lane)); so = __builtin_nontemporal_load((const u32x4*)(zo + (size_t)gw * NZ)); }
    for (int row = gw; row < mrows; row += NGW) {
        u32x4 han = ha, hbn = hbv, son = so; const int rn = row + NGW;
        if (rn < mrows) { han = __builtin_nontemporal_load((const u32x4*)(hf + (size_t)rn * 512 + 8 * F.lane)); hbn = __builtin_nontemporal_load((const u32x4*)(hb + (size_t)rn * 512 + 8 * F.lane)); son = __builtin_nontemporal_load((const u32x4*)(zo + (size_t)rn * NZ)); }
        __builtin_amdgcn_sched_barrier(0);
        f32x4 v0 = (f32x4){bflo(ha.x) + bflo(hbv.x), bfhi(ha.x) + bfhi(hbv.x), bflo(ha.y) + bflo(hbv.y), bfhi(ha.y) + bfhi(hbv.y)}, v1 = (f32x4){bflo(ha.z) + bflo(hbv.z), bfhi(ha.z) + bfhi(hbv.z), bflo(ha.w) + bflo(hbv.w), bfhi(ha.w) + bfhi(hbv.w)};
        float s = (v0.x + v0.y) + (v0.z + v0.w) + (v1.x + v1.y) + (v1.z + v1.w);
#pragma unroll
        for (int o = 0; o < 1; ++o) s = row16_sum(s);
        const float mu = s * (1.f / 128.f); v0 = v0 - mu; v1 = v1 - mu;
        float q = (v0.x * v0.x + v0.y * v0.y) + (v0.z * v0.z + v0.w * v0.w) + (v1.x * v1.x + v1.y * v1.y) + (v1.z * v1.z + v1.w * v1.w);
#pragma unroll
        for (int o = 0; o < 1; ++o) q = row16_sum(q);
        const float rstd = __builtin_amdgcn_rsqf(q * (1.f / 128.f) + HEAD_EPS);
        v0 = v0 * rstd * g0; v1 = v1 * rstd * g1;
        u32x4 w; w.x = pk2(v0.x * bflo(so.x), v0.y * bfhi(so.x)); w.y = pk2(v0.z * bflo(so.y), v0.w * bfhi(so.y)); w.z = pk2(v1.x * bflo(so.z), v1.y * bfhi(so.z)); w.w = pk2(v1.z * bflo(so.w), v1.w * bfhi(so.w));
        *(u32x4*)((bf16_t*)(F.ws + WS_BRA) + (size_t)row * D + 256 + 8 * F.lane) = w;
        ha = han; hbv = hbn; so = son;
    }
}
__device__ __forceinline__ void phase_ln1_router(Frame& F, int l, int mrows) {
    LAS int* cnt = (LAS int*)(F.lds + NW_END);
    { const float* wr = F.in[IN_WR] + (size_t)l * D * NEXP;
      for (int i = F.tid; i < NEXP * D; i += NTHREADS) { const int k = i >> 5, e = i & 31; *(LAS bf16_t*)(F.lds + NW_WT + e * 2064 + k * 2) = (bf16_t)f2bf(wr[i]); }
      if (F.tid < NEXP) cnt[F.tid] = 0; }
    const float* brt = F.in[IN_BR] + l * NEXP;
    int t_lo, t_hi; tile_range(F, mrows, t_lo, t_hi);
    const int r_lo = 32 * t_lo, nrows = 32 * (t_hi - t_lo);
    const int mrA = mod_row(r_lo), mrB = mod_row(r_lo + (nrows > 0 ? nrows - 1 : 0));
    { const float* mb = (const float*)(F.ws + WS_MOD); pv_fill(F, 0, F.in[IN_LN1G] + l * D); pv_fill(F, 1, F.in[IN_LN1B] + l * D);
      pv_fill(F, 2, mb + ((size_t)(l * 17 + mrA) * 6 + 2) * 1024); pv_fill(F, 3, mb + ((size_t)(l * 17 + mrB) * 6 + 2) * 1024);
      pv_fill(F, 4, mb + ((size_t)(l * 17 + mrA) * 6 + 3) * 1024); pv_fill(F, 5, mb + ((size_t)(l * 17 + mrB) * 6 + 3) * 1024);
      pv_fill(F, 6, mb + ((size_t)(l * 17 + mrA) * 6 + 4) * 1024); pv_fill(F, 7, mb + ((size_t)(l * 17 + mrB) * 6 + 4) * 1024); }
    __syncthreads();
    { const bf16_t* yb = (const bf16_t*)(F.ws + WS_T) + 8 * F.lane;
      RowV rv[2]; u32x4 yv2[2][2];
#pragma unroll
      for (int u = 0; u < 2; ++u) {
#pragma unroll
          for (int j = 0; j < 4; ++j) rv[u].v[j] = (f32x4){0.f, 0.f, 0.f, 0.f};
          yv2[u][0] = yv2[u][1] = (u32x4){0u, 0u, 0u, 0u}; }
#define RT_LOADPAIR(n_, rv_, yv_) do { _Pragma("unroll") for (int u = 0; u < 2; ++u) if ((n_) + u * NWAVES < nrows) { const int row = r_lo + (n_) + u * NWAVES; \
              if (l == 0) row_load(rv_[u], xin_row(F, row), F.lane); else row_load_bf16(rv_[u], (const bf16_t*)(F.ws + WS_X) + (size_t)row * D, F.lane); \
              _Pragma("unroll") for (int h = 0; h < 2; ++h) yv_[u][h] = __builtin_nontemporal_load((const u32x4*)(yb + (size_t)row * D + 512 * h)); } } while (0)
      RT_LOADPAIR(F.wave, rv, yv2);
      for (int n = F.wave; n < nrows; n += 2 * NWAVES) {
          RowV rvn[2]; u32x4 yvn[2][2];
#pragma unroll
          for (int u = 0; u < 2; ++u) { rvn[u] = rv[u]; yvn[u][0] = yv2[u][0]; yvn[u][1] = yv2[u][1]; }
          RT_LOADPAIR(n + 2 * NWAVES, rvn, yvn);
          __builtin_amdgcn_sched_barrier(0);
#pragma unroll
          for (int u = 0; u < 2; ++u) if (n + u * NWAVES < nrows) { const int row = r_lo + n + u * NWAVES; RowV cur = rv[u];
              const int sel = (mod_row(row) == mrA) ? 0 : 1;
              { const LAS float* g1 = pv_slot(F, 2 + sel);
#pragma unroll
                for (int j = 0; j < 4; ++j) { const f32x4 gg = *(const LAS f32x4*)(g1 + RC(F.lane, j)); const u32x4 yw = yv2[u][j >> 1]; const f32x4 yv = (j & 1) ? (f32x4){bflo(yw.z), bfhi(yw.z), bflo(yw.w), bfhi(yw.w)} : (f32x4){bflo(yw.x), bfhi(yw.x), bflo(yw.y), bfhi(yw.y)}; cur.v[j] = cur.v[j] * DN_ALPHA + gg * yv; } }
              row_ln_plain(cur, F.lane); row_affine_l(cur, pv_slot(F, 0), pv_slot(F, 1), F.lane);
              row_store_bf16_nt(cur, (bf16_t*)(F.ws + WS_X) + (size_t)row * D, F.lane);
              row_ln_plain(cur, F.lane); row_modulate_l(cur, pv_slot(F, 4 + sel), pv_slot(F, 6 + sel), F.lane);
              row_store_bf16(cur, (bf16_t*)(F.ws + WS_H2) + (size_t)row * D, F.lane);
              { unsigned char* h8 = (unsigned char*)(F.ws + WS_H2F8) + (size_t)row * D + 8 * F.lane;
#pragma unroll
                for (int h = 0; h < 2; ++h) { u32x2 w; w.x = pk4_fp8(cur.v[2 * h].x * F8S_ACT, cur.v[2 * h].y * F8S_ACT, cur.v[2 * h].z * F8S_ACT, cur.v[2 * h].w * F8S_ACT); w.y = pk4_fp8(cur.v[2 * h + 1].x * F8S_ACT, cur.v[2 * h + 1].y * F8S_ACT, cur.v[2 * h + 1].z * F8S_ACT, cur.v[2 * h + 1].w * F8S_ACT); *(u32x2*)(h8 + 512 * h) = w; } } }
#pragma unroll
          for (int u = 0; u < 2; ++u) { rv[u] = rvn[u]; yv2[u][0] = yvn[u][0]; yv2[u][1] = yvn[u][1]; }
      }
#undef RT_LOADPAIR
    }
    asm volatile("s_waitcnt vmcnt(0)" ::: "memory"); __syncthreads();
    for (int tile = t_lo + F.wave; tile < t_hi; tile += NWAVES) {
        const LAS float* lgw = narrow_tile_wave(F, (const bf16_t*)(F.ws + WS_H2) + (size_t)tile * 32 * D);
        if (F.lane < 32) {
            const LAS float* lgp = lgw + F.lane * 33; const int row = tile * 32 + F.lane;
            float lg[NEXP];
#pragma unroll
            for (int e = 0; e < NEXP; ++e) lg[e] = lgp[e] + brt[e];
            unsigned used = 0u; float bv[4]; int bi[4];
#pragma unroll
            for (int k = 0; k < 4; ++k) { float best = -3.0e38f; int idx = 0;
#pragma unroll
                for (int e = 0; e < NEXP; ++e) { const bool take = (((used >> e) & 1u) == 0u) && (lg[e] > best); best = take ? lg[e] : best; idx = take ? e : idx; }
                used |= 1u << idx; bv[k] = best; bi[k] = idx; }
            const float e1 = __expf(bv[1] - bv[0]), e2 = __expf(bv[2] - bv[0]), e3 = __expf(bv[3] - bv[0]); const float inv = __builtin_amdgcn_rcpf(1.0f + e1 + e2 + e3);
            int* ei = (int*)(F.ws + WS_ROUTE + RT_EIDX) + (size_t)row * 4; float* pr = (float*)(F.ws + WS_ROUTE + RT_PROB) + (size_t)row * 4;
            *(int4*)ei = make_int4(bi[0], bi[1], bi[2], bi[3]); *(f32x4*)pr = (f32x4){inv, e1 * inv, e2 * inv, e3 * inv};
            atomicAdd((int*)&cnt[bi[0]], 1); atomicAdd((int*)&cnt[bi[1]], 1); atomicAdd((int*)&cnt[bi[2]], 1); atomicAdd((int*)&cnt[bi[3]], 1);
        }
        asm volatile("s_waitcnt lgkmcnt(0)" ::: "memory");
    }
    __syncthreads();
    if (F.tid < NEXP) ((int*)(F.ws + WS_ROUTE + RT_CNT))[F.bid * NEXP + F.tid] = cnt[F.tid];
    __syncthreads();
}
__device__ __forceinline__ void phase_slots(Frame& F, int mrows) {
    LAS int* part = (LAS int*)F.lds;
    LAS int* pre = part + 1024;
    LAS int* tot = pre + 32;
    LAS int* seg = tot + 32;
    LAS int* gcnt = seg + 64;
    LAS int* eix = gcnt + 2048;
    LAS int* rnk = eix + 4096;
    const int* cntg = (const int*)(F.ws + WS_ROUTE + RT_CNT);
    int* tokg = (int*)(F.ws + WS_ROUTE + RT_TOK); int* destg = (int*)(F.ws + WS_ROUTE + RT_DEST); float* psl = (float*)(F.ws + WS_ROUTE + RT_PSLOT);
    int t_lo, t_hi; tile_range(F, mrows, t_lo, t_hi);
    const int row_base = t_lo * 32, nent = (t_hi - t_lo) * 128, ngrp = nent / 64;
    { const int e = F.tid & 31, pt = F.tid >> 5; int a = 0, b = 0;
      for (int c = pt; c < F.G; c += 16) { const int v = cntg[c * NEXP + e]; b += v; a += (c < F.bid) ? v : 0; }
      part[pt * 32 + e] = a; part[512 + pt * 32 + e] = b; }
    for (int i = F.tid; i < nent; i += NTHREADS) eix[i] = ((const int*)(F.ws + WS_ROUTE + RT_EIDX))[(size_t)row_base * 4 + i];
    __syncthreads();
    if (F.tid < NEXP) { int a = 0, b = 0;
#pragma unroll
        for (int pt = 0; pt < 16; ++pt) { a += part[pt * 32 + F.tid]; b += part[512 + pt * 32 + F.tid]; }
        pre[F.tid] = a; tot[F.tid] = b; }
    for (int g = F.wave; g < ngrp; g += NWAVES) {
        const int e = eix[g * 64 + F.lane]; int rank = 0, mycnt = 0;
#pragma unroll 4
        for (int ee = 0; ee < NEXP; ++ee) { const unsigned long long m = __ballot(e == ee); if (e == ee) rank = __popcll(m & ((1ull << F.lane) - 1ull)); if (F.lane == ee) mycnt = __popcll(m); }
        rnk[g * 64 + F.lane] = rank; if (F.lane < NEXP) gcnt[g * 32 + F.lane] = mycnt; }
    __syncthreads();
    if (F.tid == 0) { int s = 0; for (int e = 0; e < NEXP; ++e) { seg[e] = s; s += (tot[e] + 255) & ~255; } seg[NEXP] = s; }
    if (F.tid >= 64 && F.tid < 64 + NEXP) { const int e = F.tid - 64; int run = 0; for (int g = 0; g < ngrp; ++g) { const int c = gcnt[g * 32 + e]; gcnt[g * 32 + e] = run; run += c; } }
    __syncthreads();
    { const float* prg = (const float*)(F.ws + WS_ROUTE + RT_PROB) + (size_t)row_base * 4;
      for (int i = F.tid; i < nent; i += NTHREADS) { const int e = eix[i]; const int slot = seg[e] + pre[e] + gcnt[(i >> 6) * 32 + e] + rnk[i];
          tokg[slot] = row_base + (i >> 2); destg[slot] = row_base * 4 + i; psl[slot] = prg[i]; } }
    if (F.bid < NEXP) { const int e = F.bid; for (int sl = seg[e] + tot[e] + F.tid; sl < seg[e + 1]; sl += NTHREADS) { tokg[sl] = 0; destg[sl] = -1; psl[sl] = 0.f; } }
    if (F.bid == 0 && F.tid <= NEXP) ((int*)(F.ws + WS_ROUTE + RT_SEG))[F.tid] = seg[F.tid];
    __syncthreads();
}
struct CombRaw { u32x4 x[2]; u32x2 f[2][4]; };
__device__ __forceinline__ void comb_load(const Frame& F, int row, CombRaw& r) {
    { const bf16_t* xp = (const bf16_t*)(F.ws + WS_X) + (size_t)row * D + 8 * F.lane;
#pragma unroll
      for (int h = 0; h < 2; ++h) r.x[h] = __builtin_nontemporal_load((const u32x4*)(xp + 512 * h)); }
    const unsigned char* fs = (const unsigned char*)(F.ws + WS_FS) + (size_t)row * 4 * 1024 + 8 * F.lane;
#pragma unroll
    for (int h = 0; h < 2; ++h)
#pragma unroll
        for (int k = 0; k < 4; ++k) r.f[h][k] = __builtin_nontemporal_load((const u32x2*)(fs + k * 1024 + 512 * h));
}
__device__ __forceinline__ void phase_combine_ln2(Frame& F, int l, int mrows) {
    const bool lastl = (l == DEPTH - 1);
    int t_lo, t_hi; tile_range(F, mrows, t_lo, t_hi);
    const int r_lo = 32 * t_lo, nrows = 32 * (t_hi - t_lo);
    const int mrA = mod_row(r_lo), mrB = mod_row(r_lo + (nrows > 0 ? nrows - 1 : 0));
    { const float* mb = (const float*)(F.ws + WS_MOD); const int ln = lastl ? l : l + 1; pv_fill(F, 0, F.in[IN_LN2G] + l * D); pv_fill(F, 1, F.in[IN_LN2B] + l * D);
      pv_fill(F, 2, mb + ((size_t)(l * 17 + mrA) * 6 + 5) * 1024); pv_fill(F, 3, mb + ((size_t)(l * 17 + mrB) * 6 + 5) * 1024);
      pv_fill(F, 4, mb + ((size_t)(ln * 17 + mrA) * 6 + 0) * 1024); pv_fill(F, 5, mb + ((size_t)(ln * 17 + mrB) * 6 + 0) * 1024);
      pv_fill(F, 6, mb + ((size_t)(ln * 17 + mrA) * 6 + 1) * 1024); pv_fill(F, 7, mb + ((size_t)(ln * 17 + mrB) * 6 + 1) * 1024); }
    if (!lastl) load_wg_lds(F, l + 1); else __syncthreads();
    CombRaw rw[2];
#pragma unroll
    for (int u = 0; u < 2; ++u) { rw[u].x[0] = rw[u].x[1] = (u32x4){0u, 0u, 0u, 0u};
#pragma unroll
        for (int k = 0; k < 4; ++k) rw[u].f[0][k] = rw[u].f[1][k] = (u32x2){0u, 0u}; }
#pragma unroll
    for (int u = 0; u < 2; ++u) if (F.wave + u * NWAVES < nrows) comb_load(F, r_lo + F.wave + u * NWAVES, rw[u]);
    for (int n = F.wave; n < nrows; n += 2 * NWAVES) {
        CombRaw rwn[2];
#pragma unroll
        for (int u = 0; u < 2; ++u) rwn[u] = rw[u];
#pragma unroll
        for (int u = 0; u < 2; ++u) if (n + (2 + u) * NWAVES < nrows) comb_load(F, r_lo + n + (2 + u) * NWAVES, rwn[u]);
        __builtin_amdgcn_sched_barrier(0);
#pragma unroll
        for (int u = 0; u < 2; ++u) if (n + u * NWAVES < nrows) { const int row = r_lo + n + u * NWAVES;
            const int sel = (mod_row(row) == mrA) ? 0 : 1;
            const LAS float* g2 = pv_slot(F, 2 + sel);
            RowV x;
#pragma unroll
            for (int h = 0; h < 2; ++h) { const u32x4 w = rw[u].x[h]; x.v[2 * h] = (f32x4){bflo(w.x), bfhi(w.x), bflo(w.y), bfhi(w.y)}; x.v[2 * h + 1] = (f32x4){bflo(w.z), bfhi(w.z), bflo(w.w), bfhi(w.w)}; }
#pragma unroll
            for (int j = 0; j < 4; ++j) { f32x4 f = (f32x4){0.f, 0.f, 0.f, 0.f};
#pragma unroll
                for (int k = 0; k < 4; ++k) { const u32x2 w2 = rw[u].f[j >> 1][k]; const int wd = (int)((j & 1) ? w2.y : w2.x);
                    const f32x2 lo = __builtin_amdgcn_cvt_pk_f32_fp8(wd, false), hi = __builtin_amdgcn_cvt_pk_f32_fp8(wd, true); f[0] += lo[0]; f[1] += lo[1]; f[2] += hi[0]; f[3] += hi[1]; }
                const f32x4 gg = *(const LAS f32x4*)(g2 + RC(F.lane, j)) * (1.0f / FS_SCALE);
                x.v[j] = x.v[j] * DN_ALPHA + gg * f; }
            row_ln_plain(x, F.lane); row_affine_l(x, pv_slot(F, 0), pv_slot(F, 1), F.lane);
            if (lastl) { row_store_nt(x, F.out + (size_t)row * D, F.lane); }
            else { row_store_bf16_nt(x, (bf16_t*)(F.ws + WS_X) + (size_t)row * D, F.lane); ln0_row(F, row, x, pv_slot(F, 4 + sel), pv_slot(F, 6 + sel)); } }
#pragma unroll
        for (int u = 0; u < 2; ++u) rw[u] = rwn[u];
    }
    if (!lastl) gates_tail(F, l + 1, t_lo, t_hi);
    __syncthreads();
}

#define MFMA32(a, b, c) __builtin_amdgcn_mfma_f32_32x32x16_bf16((a), (b), (c), 0, 0, 0)
#define MFMA16(a, b, c) __builtin_amdgcn_mfma_f32_16x16x32_bf16((a), (b), (c), 0, 0, 0)
__device__ __forceinline__ f32x16 zero16() { f32x16 z;
#pragma unroll
    for (int i = 0; i < 16; ++i) z[i] = 0.f;
    return z; }
__device__ __forceinline__ void pool_tiles(Frame& F, int l, bool with_ctx) {
    LAS unsigned char* Pin = F.lds;
    LAS unsigned char* Dm = F.lds + 40960;
    const bf16_t* Z = (const bf16_t*)(F.ws + WS_Z);
    const bf16_t* Wp = (const bf16_t*)(F.ws + WS_WPOOL) + (size_t)l * 4 * 4096;
    const float* psc = F.in[IN_POOLS] + l * 256;
    bf16_t* BRA = (bf16_t*)(F.ws + WS_BRA);
    const int ntiles = with_ctx ? 1088 : 1024;
    const int r = F.lane & 31, h = F.lane >> 5;
    bf16x8 wa[2][4]; f32x4 scv[2][4];
#pragma unroll
    for (int qi = 0; qi < 2; ++qi) { const int q = F.wave + 8 * qi, g = q >> 2, td = (q >> 1) & 1;
#pragma unroll
        for (int ks = 0; ks < 4; ++ks) wa[qi][ks] = *(const bf16x8*)(Wp + ((size_t)g * 64 + td * 32 + r) * 64 + ks * 16 + 8 * h);
#pragma unroll
        for (int qq = 0; qq < 4; ++qq) scv[qi][qq] = *(const f32x4*)(psc + g * 64 + td * 32 + 8 * qq + 4 * h); }
    for (int tile = F.bid; tile < ntiles; tile += F.G) {
        int row0, seq_lo, seq_hi;
        if (tile < 1024) { row0 = tile * 64; seq_lo = row0; seq_hi = row0 + 64; }
        else { const int ct = tile - 1024; seq_lo = ML + (ct >> 2) * 256; seq_hi = seq_lo + 256; row0 = seq_lo + (ct & 3) * 64; }
        for (int idx = F.tid; idx < 80 * 32; idx += NTHREADS) { const int rr = idx >> 5, ck = idx & 31, grow = row0 - 8 + rr;
            if (grow >= seq_lo && grow < seq_hi) *(LAS u32x4*)(Pin + rr * 512 + ck * 16) = __builtin_nontemporal_load((const u32x4*)(Z + (size_t)grow * NZ + ZC_P + ck * 8)); }
        __syncthreads();
#pragma unroll
        for (int g = 0; g < 4; ++g) { constexpr int dummy_ = 0; (void)dummy_; const int hw = 1 << g, tok = F.tid >> 3, ck = g * 8 + (F.tid & 7), t = row0 + tok;
            const int lo = max(t - hw, seq_lo), hi = min(t + hw, seq_hi);
            float s[8];
#pragma unroll
            for (int e = 0; e < 8; ++e) s[e] = 0.f;
#pragma unroll
            for (int d = -hw; d < hw; ++d) { u32x4 v = *(const LAS u32x4*)(Pin + (tok + 8 + d) * 512 + ck * 16); const bool in = (t + d >= lo) && (t + d < hi);
                v.x = in ? v.x : 0u; v.y = in ? v.y : 0u; v.z = in ? v.z : 0u; v.w = in ? v.w : 0u;
                s[0] += bflo(v.x); s[1] += bfhi(v.x); s[2] += bflo(v.y); s[3] += bfhi(v.y); s[4] += bflo(v.z); s[5] += bfhi(v.z); s[6] += bflo(v.w); s[7] += bfhi(v.w); }
            const float inv = __builtin_amdgcn_rcpf((float)(hi - lo));
            const u32x4 o = *(const LAS u32x4*)(Pin + (tok + 8) * 512 + ck * 16);
            u32x4 w; w.x = pk2(s[0] * inv - bflo(o.x), s[1] * inv - bfhi(o.x)); w.y = pk2(s[2] * inv - bflo(o.y), s[3] * inv - bfhi(o.y));
            w.z = pk2(s[4] * inv - bflo(o.z), s[5] * inv - bfhi(o.z)); w.w = pk2(s[6] * inv - bflo(o.w), s[7] * inv - bfhi(o.w));
            *(LAS u32x4*)(Dm + tok * 528 + ck * 16) = w; }
        __syncthreads();
#pragma unroll
        for (int qi = 0; qi < 2; ++qi) { const int q = F.wave + 8 * qi, g = q >> 2, td = (q >> 1) & 1, tt = q & 1;
            f32x16 acc = zero16();
#pragma unroll
            for (int ks = 0; ks < 4; ++ks) { const bf16x8 b = *(const LAS bf16x8*)(Dm + (tt * 32 + r) * 528 + (g * 64 + ks * 16 + 8 * h) * 2);
                acc = MFMA32(wa[qi][ks], b, acc); }
            const size_t orow = (size_t)(row0 + tt * 32 + r);
#pragma unroll
            for (int qq = 0; qq < 4; ++qq) { const int dcol = g * 64 + td * 32 + 8 * qq + 4 * h; const f32x4 sc = scv[qi][qq];
                u32x2 w; w.x = pk2(acc[4 * qq] * sc.x, acc[4 * qq + 1] * sc.y); w.y = pk2(acc[4 * qq + 2] * sc.z, acc[4 * qq + 3] * sc.w);
                *(u32x2*)(BRA + orow * D + dcol) = w; } }
        __syncthreads();
    }
}
__device__ __forceinline__ void sgu_chunks(Frame& F, int l, bool with_ctx) {
    LAS unsigned char* Vt = F.lds;
    const bf16_t* Z = (const bf16_t*)(F.ws + WS_Z);
    const bf16_t* Ws = (const bf16_t*)(F.ws + WS_WSGU) + (size_t)l * 4 * 16384;
    const float* lng = F.in[IN_SLNG] + l * 256; const float* lnb = F.in[IN_SLNB] + l * 256; const float* sb = F.in[IN_SGUB] + l * 512;
    bf16_t* BRA = (bf16_t*)(F.ws + WS_BRA);
    const int nchunks = with_ctx ? 544 : 512;
    const int r = F.lane & 31, h = F.lane >> 5;
    const int tc = F.wave & 1, tt = F.wave >> 1, t = tt * 32 + r;
    LAS float* lnt = (LAS float*)(F.lds + 69632);
    if (F.tid < 256) { lnt[F.tid] = lng[F.tid]; lnt[256 + F.tid] = lnb[F.tid]; }
    __syncthreads();
    for (int ch = F.bid; ch < nchunks; ch += F.G) {
        const int row0 = ch * 128;
        u32x2 ug[4][4]; bf16x8 bcur[8];
        { const int s2 = F.tid >> 3, cq = F.tid & 7; const bf16_t* zp = Z + (size_t)(row0 + 2 * s2) * NZ + ZC_UV + 256 + cq * 32;
          float v[2][32]; float sum[2] = {0.f, 0.f};
#pragma unroll
          for (int rr = 0; rr < 2; ++rr)
#pragma unroll
              for (int i = 0; i < 4; ++i) { const u32x4 w = __builtin_nontemporal_load((const u32x4*)(zp + (size_t)rr * NZ + 8 * i));
                  v[rr][8 * i] = bflo(w.x); v[rr][8 * i + 1] = bfhi(w.x); v[rr][8 * i + 2] = bflo(w.y); v[rr][8 * i + 3] = bfhi(w.y); v[rr][8 * i + 4] = bflo(w.z); v[rr][8 * i + 5] = bfhi(w.z); v[rr][8 * i + 6] = bflo(w.w); v[rr][8 * i + 7] = bfhi(w.w); }
          float rstd[2];
#pragma unroll
          for (int rr = 0; rr < 2; ++rr) {
#pragma unroll
              for (int i = 0; i < 32; ++i) sum[rr] += v[rr][i];
              sum[rr] += shx(sum[rr], 1, F.lane); sum[rr] += shx(sum[rr], 2, F.lane); sum[rr] += shx(sum[rr], 4, F.lane);
              const float mean = sum[rr] * (1.f / 256.f); float sq = 0.f;
#pragma unroll
              for (int i = 0; i < 32; ++i) { v[rr][i] -= mean; sq += v[rr][i] * v[rr][i]; }
              sq += shx(sq, 1, F.lane); sq += shx(sq, 2, F.lane); sq += shx(sq, 4, F.lane);
              rstd[rr] = __builtin_amdgcn_rsqf(sq * (1.f / 256.f) + LN_EPS); }
#pragma unroll
        for (int g = 0; g < 4; ++g)
#pragma unroll
            for (int qq = 0; qq < 4; ++qq) ug[g][qq] = *(const u32x2*)(Z + (size_t)(row0 + t) * NZ + ZC_UV + g * 64 + tc * 32 + 8 * qq + 4 * h);
#pragma unroll
        for (int ks = 0; ks < 8; ++ks) bcur[ks] = *(const bf16x8*)(Ws + ((size_t)0 * 128 + t) * 128 + ks * 16 + 8 * h);
          LAS unsigned char* wp = Vt + (((s2 >> 2) ^ cq) << 4) + (s2 & 3) * 4;
#pragma unroll
          for (int i = 0; i < 32; ++i) { const int c = cq * 32 + i; const float gn = lnt[c], bn = lnt[256 + c];
              *(LAS unsigned*)(wp + c * 272) = pg8::cvt_pk_bf16(v[0][i] * rstd[0] * gn + bn, v[1][i] * rstd[1] * gn + bn); } }
        __syncthreads();
#pragma unroll
        for (int g = 0; g < 4; ++g) {
            bf16x8 bnx[8];
#pragma unroll
            for (int ks = 0; ks < 8; ++ks) bnx[ks] = bcur[ks];
            if (g < 3) {
#pragma unroll
                for (int ks = 0; ks < 8; ++ks) bnx[ks] = *(const bf16x8*)(Ws + ((size_t)(g + 1) * 128 + t) * 128 + ks * 16 + 8 * h); }
            f32x16 acc = zero16();
#pragma unroll
            for (int ks = 0; ks < 8; ++ks) { const bf16x8 a = *(const LAS bf16x8*)(Vt + (g * 64 + tc * 32 + r) * 272 + (((ks * 2 + h) ^ ((g * 2 + tc) & 7)) * 16));
                acc = MFMA32(a, bcur[ks], acc); }
#pragma unroll
            for (int ks = 0; ks < 8; ++ks) bcur[ks] = bnx[ks];
            const float bias = sb[g * 128 + t];
#pragma unroll
            for (int qq = 0; qq < 4; ++qq) { const int c0 = g * 64 + tc * 32 + 8 * qq + 4 * h;
                const u32x2 u = ug[g][qq];
                u32x2 w; w.x = pk2(bflo(u.x) * (acc[4 * qq] + bias), bfhi(u.x) * (acc[4 * qq + 1] + bias)); w.y = pk2(bflo(u.y) * (acc[4 * qq + 2] + bias), bfhi(u.y) * (acc[4 * qq + 3] + bias));
                *(u32x2*)(BRA + (size_t)(row0 + t) * D + 768 + c0) = w; } }
        __syncthreads();
    }
}
__device__ __forceinline__ void qk_conv_pass(Frame& F, int l) {
    const bf16_t* Z = (const bf16_t*)(F.ws + WS_Z); bf16_t* QKC = (bf16_t*)(F.ws + WS_H);
    const int chunk = F.tid & 127, rsub = F.tid >> 7, ch0 = chunk * 8;
    float w0[8], w1[8], w2[8], cbv[8];
    { const float* cw = F.in[IN_CONVW] + (size_t)l * 3 * 1024 + ch0; const float* cb = F.in[IN_CONVB] + (size_t)l * 1024 + ch0;
#pragma unroll
      for (int e = 0; e < 8; ++e) { w0[e] = cw[e]; w1[e] = cw[1024 + e]; w2[e] = cw[2048 + e]; cbv[e] = cb[e]; } }
    const float scale = chunk >= 64 ? 0.08838834764831845f : 1.0f;
    const int ns = F.G * 4, sidx = F.bid * 4 + rsub;
    const int r0 = (int)(((long)sidx * MT) / ns), r1 = (int)(((long)(sidx + 1) * MT) / ns);
    const bf16_t* zb = Z + ZC_QK + ch0;
    const u32x4 zero4 = (u32x4){0u, 0u, 0u, 0u};
    u32x4 xm = zero4, xc = zero4, xn = zero4;
    if (r0 < r1) { xc = *(const u32x4*)(zb + (size_t)r0 * NZ); if (r0 > 0) xm = *(const u32x4*)(zb + (size_t)(r0 - 1) * NZ); if (r0 + 1 < MT) xn = *(const u32x4*)(zb + (size_t)(r0 + 1) * NZ); }
    for (int row = r0; row < r1; ++row) {
        u32x4 xn2 = zero4; if (row + 2 < MT) xn2 = *(const u32x4*)(zb + (size_t)(row + 2) * NZ);
        const int p = row < ML ? (row & 4095) : ((row - ML) & 255), len = row < ML ? 4096 : 256;
        const u32x4 x0 = (p > 0) ? xm : zero4, x1 = xc, x2 = (p + 1 < len) ? xn : zero4;
        const unsigned xa[4] = {x0.x, x0.y, x0.z, x0.w}, xb[4] = {x1.x, x1.y, x1.z, x1.w}, xcc[4] = {x2.x, x2.y, x2.z, x2.w};
        float y[8];
#pragma unroll
        for (int e2 = 0; e2 < 4; ++e2) { y[2 * e2] = cbv[2 * e2] + w0[2 * e2] * bflo(xa[e2]) + w1[2 * e2] * bflo(xb[e2]) + w2[2 * e2] * bflo(xcc[e2]);
            y[2 * e2 + 1] = cbv[2 * e2 + 1] + w0[2 * e2 + 1] * bfhi(xa[e2]) + w1[2 * e2 + 1] * bfhi(xb[e2]) + w2[2 * e2 + 1] * bfhi(xcc[e2]); }
#pragma unroll
        for (int e = 0; e < 8; ++e) y[e] = siluf_(y[e]) * scale;
        u32x4 w; w.x = pk2(y[0], y[1]); w.y = pk2(y[2], y[3]); w.z = pk2(y[4], y[5]); w.w = pk2(y[6], y[7]);
        *(u32x4*)(QKC + (size_t)row * D + ch0) = w;
        xm = xc; xc = xn; xn = xn2;
    }
}
constexpr int ML_QS = 0, ML_KS = 34816, ML_KW = 69632, ML_VT = 104448, ML_CB = 126208, ML_SC = 147968, ML_SCSZ = 2624;
__device__ __forceinline__ float logsigf_(float x) { return fminf(x, 0.f) - __logf(1.0f + __expf(-fabsf(x))); }
__device__ __forceinline__ unsigned swap16(unsigned u) { return __builtin_amdgcn_alignbit(u, u, 16); }
struct MlPre { u32x4 qk[8]; u32x2 v[4]; float g[4]; };
__device__ __forceinline__ void ml_geom(int j, int b, int dir, int& seqbase, int& seqlen, int& pbase) {
    const bool is_ctx = j < 2; int cj = is_ctx ? j : j - 2; const int ncs = is_ctx ? 2 : 32; if (dir) cj = ncs - 1 - cj;
    seqbase = is_ctx ? ML + b * 256 : b * 4096; seqlen = is_ctx ? 256 : 4096; pbase = cj * 128; }
#define ML_BAR() do { asm volatile("s_waitcnt lgkmcnt(0)" ::: "memory"); __builtin_amdgcn_s_barrier(); asm volatile("" ::: "memory"); } while (0)
__device__ __forceinline__ void mlstm_unit(Frame& F, int l, int unit) {
    const int bh = (unit & 7) + 8 * (unit >> 5), sub = (unit >> 3) & 3;
    const int b = bh >> 2, head = bh & 3, dir = sub >> 1, vh = sub & 1;
    LAS unsigned char* QS = F.lds + ML_QS; LAS unsigned char* KS = F.lds + ML_KS; LAS unsigned char* KW = F.lds + ML_KW; LAS unsigned char* VT = F.lds + ML_VT; LAS unsigned char* CB = F.lds + ML_CB;
    const bf16_t* Z = (const bf16_t*)(F.ws + WS_Z); const float* ZG = (const float*)(F.ws + WS_ZG); const bf16_t* QKC = (const bf16_t*)(F.ws + WS_H);
    bf16_t* HF = (bf16_t*)(F.ws + WS_HFB) + (size_t)dir * MT * 512;
    const int wave = F.wave;
    int tl = F.tid;
#define ML_ROLES() const int lane = tl & 63, fr = lane & 15, q4 = lane >> 4; const int isk = (tl >> 4) & 1, ck = tl & 15, i0 = 8 * (tl >> 5), chn = (isk ? 512 : 0) + head * 128 + ck * 8; \
    const int vi0 = 4 * (tl >> 4), vcq = tl & 15, vch = head * 128 + vh * 64 + vcq * 4; (void)fr; (void)q4; (void)vi0; (void)vcq; (void)vch; (void)i0; (void)chn; (void)ck; (void)isk;
    for (int idx = F.tid; idx < 16 * 136; idx += NTHREADS) *(LAS bf16_t*)(VT + (64 + idx / 136) * 272 + (idx % 136) * 2) = (idx < 136) ? (bf16_t)0x3F80 : (bf16_t)0;
    f32x4 cs[5];
#pragma unroll
    for (int vt = 0; vt < 5; ++vt) cs[vt] = (f32x4){0.f, 0.f, 0.f, 0.f};
    float m_state = 0.f;
    MlPre pre;
#define ML_PREFETCH(jj) do { int sb_, sl_, pb_; ml_geom((jj), b, dir, sb_, sl_, pb_); \
        { const int pmin = dir ? pb_ + 120 - i0 : pb_ + i0; const bf16_t* zr = QKC + (size_t)(sb_ + pmin) * D + chn; (void)sl_; \
          _Pragma("unroll") for (int k = 0; k < 8; ++k) pre.qk[k] = *(const u32x4*)(zr + (size_t)k * D); } \
        { const int pminv = dir ? pb_ + 124 - vi0 : pb_ + vi0; const bf16_t* zv = Z + (size_t)(sb_ + pminv) * NZ + ZC_V + vch; \
          _Pragma("unroll") for (int k = 0; k < 4; ++k) pre.v[k] = *(const u32x2*)(zv + (size_t)k * NZ); } \
        if (wave == 0) { const int p0 = dir ? pb_ + 127 - 2 * lane : pb_ + 2 * lane, p1 = dir ? p0 - 1 : p0 + 1; \
          pre.g[0] = ZG[(size_t)(sb_ + p0) * 16 + dir * 8 + head]; pre.g[1] = ZG[(size_t)(sb_ + p0) * 16 + dir * 8 + 4 + head]; \
          pre.g[2] = ZG[(size_t)(sb_ + p1) * 16 + dir * 8 + head]; pre.g[3] = ZG[(size_t)(sb_ + p1) * 16 + dir * 8 + 4 + head]; } } while (0)
#define ML_STEPA(sbuf) do { LAS float* sg_ = (LAS float*)(F.lds + ML_SC + (sbuf) * ML_SCSZ); const int i0g = 2 * lane, i1g = i0g + 1; \
        const float gi0 = pre.g[0], gf0 = pre.g[1], gi1 = pre.g[2], gf1 = pre.g[3]; \
        const float lf0 = logsigf_(gf0), lf1 = logsigf_(gf1); const float s1 = lf0 + lf1; float incl = s1; \
        _Pragma("unroll") for (int o = 1; o < 64; o <<= 1) { const float y_ = shup(incl, o, lane); incl += (lane >= o) ? y_ : 0.f; } \
        const float excl = incl - s1, bc0 = excl + lf0, bc1 = excl + s1; \
        const float g0 = gi0 - bc0, g1 = gi1 - bc1; const float mx1 = fmaxf(g0, g1); float im = mx1; \
        _Pragma("unroll") for (int o = 1; o < 64; o <<= 1) { const float y_ = shup(im, o, lane); im = (lane >= o) ? fmaxf(im, y_) : im; } \
        float em = shup(im, 1, lane); em = (lane == 0) ? -3.0e38f : em; \
        const float M0 = fmaxf(m_state, fmaxf(em, g0)), M1 = fmaxf(m_state, fmaxf(em, mx1)); \
        const float total = bperm(63, bc1), Mlast = bperm(63, M1); \
        sg_[i0g] = g0; sg_[i1g] = g1; sg_[128 + i0g] = M0; sg_[128 + i1g] = M1; \
        sg_[256 + i0g] = __expf(m_state - M0); sg_[256 + i1g] = __expf(m_state - M1); \
        sg_[384 + i0g] = __expf(-(bc0 + M0)); sg_[384 + i1g] = __expf(-(bc1 + M1)); \
        sg_[512 + i0g] = __expf(g0 - Mlast); sg_[512 + i1g] = __expf(g1 - Mlast); \
        if (lane == 0) sg_[640] = __expf(m_state - Mlast); \
        m_state = total + Mlast; } while (0)
    { ML_ROLES(); ML_PREFETCH(0); if (wave == 0) ML_STEPA(0); }
    ML_BAR();
#pragma unroll 1
    for (int j = 0; j < 34; ++j) {
        asm volatile("" : "+v"(tl));
        ML_ROLES();
        int seqbase, seqlen, pbase; ml_geom(j, b, dir, seqbase, seqlen, pbase);
        const LAS float* sc_g = (const LAS float*)(F.lds + ML_SC + (j & 1) * ML_SCSZ); const LAS float* sc_M = sc_g + 128; const LAS float* sc_dec = sc_g + 256; const LAS float* sc_emt = sc_g + 384; const LAS float* sc_wk = sc_g + 512;
        {
#pragma unroll
          for (int k = 0; k < 8; ++k) { const int i = dir ? i0 + 7 - k : i0 + k; *(LAS u32x4*)((isk ? KS : QS) + i * 272 + ck * 16) = pre.qk[k]; }
          if (isk) { u32x4 kt[8]; float ykeep[8];
#pragma unroll
              for (int e = 0; e < 8; ++e) { kt[e] = (u32x4){0u, 0u, 0u, 0u}; ykeep[e] = 0.f; }
#pragma unroll
              for (int k = 0; k < 8; ++k) { const int i = dir ? i0 + 7 - k : i0 + k; const float wk = sc_wk[i];
                  const unsigned xb[4] = {pre.qk[k].x, pre.qk[k].y, pre.qk[k].z, pre.qk[k].w};
#pragma unroll
                  for (int e = 0; e < 8; ++e) { const float yw = ((e & 1) ? bfhi(xb[e >> 1]) : bflo(xb[e >> 1])) * wk;
                      if (k & 1) { const unsigned pw_ = pk2(ykeep[e], yw); if ((k >> 1) == 0) kt[e].x = pw_; else if ((k >> 1) == 1) kt[e].y = pw_; else if ((k >> 1) == 2) kt[e].z = pw_; else kt[e].w = pw_; }
                      else ykeep[e] = yw; } }
#pragma unroll
              for (int e = 0; e < 8; ++e) { u32x4 o = kt[e]; if (dir) o = (u32x4){swap16(kt[e].w), swap16(kt[e].z), swap16(kt[e].y), swap16(kt[e].x)};
                  *(LAS u32x4*)(KW + (ck * 8 + e) * 272 + (((i0 >> 3) ^ (ck & 7)) * 16)) = o; } } }
        { unsigned vv[4][2];
#pragma unroll
          for (int k = 0; k < 4; ++k) { vv[k][0] = pre.v[k].x; vv[k][1] = pre.v[k].y; }
#pragma unroll
          for (int c = 0; c < 4; ++c) {
              unsigned h0 = (c & 1) ? (vv[0][c >> 1] >> 16) : (vv[0][c >> 1] & 0xffffu), h1 = (c & 1) ? (vv[1][c >> 1] >> 16) : (vv[1][c >> 1] & 0xffffu);
              unsigned h2 = (c & 1) ? (vv[2][c >> 1] >> 16) : (vv[2][c >> 1] & 0xffffu), h3 = (c & 1) ? (vv[3][c >> 1] >> 16) : (vv[3][c >> 1] & 0xffffu);
              u32x2 o; if (dir) { o.x = h3 | (h2 << 16); o.y = h1 | (h0 << 16); } else { o.x = h0 | (h1 << 16); o.y = h2 | (h3 << 16); }
              *(LAS u32x2*)(VT + (vcq * 4 + c) * 272 + vi0 * 2) = o; } }
#pragma unroll
        for (int vt = 0; vt < 5; ++vt)
#pragma unroll
            for (int rr = 0; rr < 4; rr += 2) { const unsigned pw_ = pk2(cs[vt][rr], cs[vt][rr + 1]);
                *(LAS bf16_t*)(CB + (16 * vt + 4 * q4 + rr) * 272 + (16 * wave + fr) * 2) = (bf16_t)(pw_ & 0xffffu); *(LAS bf16_t*)(CB + (16 * vt + 4 * q4 + rr + 1) * 272 + (16 * wave + fr) * 2) = (bf16_t)(pw_ >> 16); }
        ML_BAR();
        if (j + 1 < 34) ML_PREFETCH(j + 1);
        const int t = 16 * wave + fr;
        bf16x8 qf[4];
#pragma unroll
        for (int kc = 0; kc < 4; ++kc) qf[kc] = *(const LAS bf16x8*)(QS + t * 272 + (32 * kc + 8 * q4) * 2);
        const float Mt_t = sc_M[t], dec_t = sc_dec[t], emt_t = sc_emt[t];
        f32x4 ps[8];
#pragma unroll
        for (int jp = 0; jp < 4; ++jp) {
            ps[2 * jp] = (f32x4){0.f, 0.f, 0.f, 0.f}; ps[2 * jp + 1] = (f32x4){0.f, 0.f, 0.f, 0.f};
            if (2 * jp <= wave) {
                bf16x8 ka[4], kb[4];
#pragma unroll
                for (int kc = 0; kc < 4; ++kc) { ka[kc] = *(const LAS bf16x8*)(KS + (32 * jp + fr) * 272 + (32 * kc + 8 * q4) * 2); kb[kc] = *(const LAS bf16x8*)(KS + (32 * jp + 16 + fr) * 272 + (32 * kc + 8 * q4) * 2); }
                const f32x4 ga4 = *(const LAS f32x4*)(sc_g + 32 * jp + 4 * q4), gb4 = *(const LAS f32x4*)(sc_g + 32 * jp + 16 + 4 * q4);
                f32x4 acc0 = (f32x4){0.f, 0.f, 0.f, 0.f}, acc1 = (f32x4){0.f, 0.f, 0.f, 0.f};
#pragma unroll
                for (int kc = 0; kc < 4; ++kc) { acc0 = MFMA16(ka[kc], qf[kc], acc0); acc1 = MFMA16(kb[kc], qf[kc], acc1); }
#pragma unroll
                for (int rr = 0; rr < 4; ++rr) { const int s0 = 32 * jp + 4 * q4 + rr, s1 = s0 + 16;
                    ps[2 * jp][rr] = (s0 <= t) ? acc0[rr] * __expf(ga4[rr] - Mt_t) : 0.f; ps[2 * jp + 1][rr] = (s1 <= t) ? acc1[rr] * __expf(gb4[rr] - Mt_t) : 0.f; }
            }
        }
        f32x4 ao[5];
        {
#pragma unroll
          for (int vt = 0; vt < 5; ++vt) ao[vt] = (f32x4){0.f, 0.f, 0.f, 0.f};
#pragma unroll
          for (int kh = 0; kh < 4; kh += 2) { bf16x8 cf[2][5];
#pragma unroll
              for (int k2 = 0; k2 < 2; ++k2)
#pragma unroll
                  for (int vt = 0; vt < 5; ++vt) cf[k2][vt] = *(const LAS bf16x8*)(CB + (16 * vt + fr) * 272 + (32 * (kh + k2) + 8 * q4) * 2);
#pragma unroll
              for (int k2 = 0; k2 < 2; ++k2)
#pragma unroll
                  for (int vt = 0; vt < 5; ++vt) ao[vt] = MFMA16(cf[k2][vt], qf[kh + k2], ao[vt]); }
#pragma unroll
          for (int vt = 0; vt < 5; ++vt) ao[vt] = ao[vt] * dec_t; }
#pragma unroll
        for (int ks = 0; ks < 4; ++ks) {
            if (2 * ks <= wave) {
                s16x4 vlo[5], vhi[5];
#pragma unroll
                for (int vt = 0; vt < 5; ++vt) { vlo[vt] = *(const LAS s16x4*)(VT + (16 * vt + fr) * 272 + (32 * ks + 4 * q4) * 2); vhi[vt] = *(const LAS s16x4*)(VT + (16 * vt + fr) * 272 + (32 * ks + 16 + 4 * q4) * 2); }
                u32x4 pw; pw.x = cvt_pk_bf16(ps[2 * ks][0], ps[2 * ks][1]); pw.y = cvt_pk_bf16(ps[2 * ks][2], ps[2 * ks][3]); pw.z = cvt_pk_bf16(ps[2 * ks + 1][0], ps[2 * ks + 1][1]); pw.w = cvt_pk_bf16(ps[2 * ks + 1][2], ps[2 * ks + 1][3]);
                const bf16x8 pf = __builtin_bit_cast(bf16x8, pw);
#pragma unroll
                for (int vt = 0; vt < 5; ++vt) { const bf16x8 a = __builtin_shufflevector(vlo[vt], vhi[vt], 0, 1, 2, 3, 4, 5, 6, 7); ao[vt] = MFMA16(a, pf, ao[vt]); }
            }
        }
        { const float den = bperm(fr, ao[4][0]); const float inv = __builtin_amdgcn_rcpf(fmaxf(fabsf(den), emt_t));
          const int p = dir ? pbase + 127 - t : pbase + t; bf16_t* orow = HF + (size_t)(seqbase + p) * 512 + head * 128 + vh * 64 + 4 * q4;
#pragma unroll
          for (int vt = 0; vt < 4; ++vt) { const f32x4 o = ao[vt] * inv; u32x2 w; w.x = cvt_pk_bf16(o[0], o[1]); w.y = cvt_pk_bf16(o[2], o[3]); *(u32x2*)(orow + 16 * vt) = w; } }
        { const float a_s = sc_g[640];
#pragma unroll
          for (int vt = 0; vt < 5; ++vt) cs[vt] = cs[vt] * a_s;
#pragma unroll
          for (int ks = 0; ks < 4; ks += 2) { bf16x8 bb[2], va[2][5];
#pragma unroll
              for (int k2 = 0; k2 < 2; ++k2) { bb[k2] = *(const LAS bf16x8*)(KW + (16 * wave + fr) * 272 + (((4 * (ks + k2) + q4) ^ (((16 * wave + fr) >> 3) & 7)) * 16));
#pragma unroll
                  for (int vt = 0; vt < 5; ++vt) va[k2][vt] = *(const LAS bf16x8*)(VT + (16 * vt + fr) * 272 + (32 * (ks + k2) + 8 * q4) * 2); }
#pragma unroll
              for (int k2 = 0; k2 < 2; ++k2)
#pragma unroll
                  for (int vt = 0; vt < 5; ++vt) cs[vt] = MFMA16(va[k2][vt], bb[k2], cs[vt]); } }
        if (wave == 0 && j + 1 < 34) ML_STEPA((j + 1) & 1);
        ML_BAR();
    }
#undef ML_PREFETCH
#undef ML_STEPA
#undef ML_ROLES
    __syncthreads();
}
__device__ __forceinline__ void phase_mixers(Frame& F, int l) {
    const bool with_ctx = (l != DEPTH - 1);
#ifndef MIX_MASK
#define MIX_MASK 7
#endif
#ifndef MIXREP
#define MIXREP 0
#endif
    if (MIX_MASK & 1) pool_tiles(F, l, with_ctx);
    if (MIXREP & 1) { __syncthreads(); pool_tiles(F, l, with_ctx); }
    if (MIX_MASK & 2) sgu_chunks(F, l, with_ctx);
    if (MIXREP & 2) { __syncthreads(); sgu_chunks(F, l, with_ctx); }
    (void)0;
    qk_conv_pass(F, l);
}
__device__ __forceinline__ void phase_mlstm(Frame& F, int l) {
    for (int u = F.bid; u < 256; u += F.G) mlstm_unit(F, l, u);
}

struct Args { const float* in[31]; float* out; unsigned char* ws; int g_lo, g_hi, pad0, pad1; };
constexpr int NPH = 11, NGID = 2 + DEPTH * NPH;
__global__ void __launch_bounds__(NTHREADS, 2) fwd_kernel(Args args) {
    extern __shared__ __attribute__((aligned(16))) unsigned char lds_raw[];
    Frame F;
    F.lds = (LAS unsigned char*)lds_raw; F.MISC = (volatile LAS unsigned*)(F.lds + MISC_OFF);
    F.tid = threadIdx.x; F.lane = F.tid & 63; F.wave = __builtin_amdgcn_readfirstlane(F.tid >> 6); F.G = gridDim.x; F.bid = blockIdx.x;
    F.ws = args.ws; F.out = args.out;
    F.in = (InTab)__builtin_amdgcn_kernarg_segment_ptr();
    if (F.tid < 64) F.MISC[F.tid] = 0u;
    __syncthreads();
    const int lo = args.g_lo, hi = args.g_hi;
    const bool multi = (hi - lo) > 1;
    XcdBarrier bar; bar.bar = (unsigned*)(F.ws + WS_CTL) + CW_BAR; bar.x = 0; bar.st = nullptr;
    if (multi) bar = xcd_barrier_post((unsigned*)(F.ws + WS_CTL) + CW_BAR, F.MISC + 8);
#ifndef PHASE_MASK
#define PHASE_MASK 0xFFFF
#endif
#define RUN(g) (lo <= (g) && (g) < hi)
#define RUNP(ty, g) ((((PHASE_MASK) >> (ty)) & 1) && RUN(g))
#ifndef REPEAT_MASK
#define REPEAT_MASK 0
#endif
#define NREP(ty) ((((REPEAT_MASK) >> (ty)) & 1) ? 2 : 1)
#define SEAM(g) do { if (RUN((g) + 1)) xcd_barrier(bar); } while (0)
#define LAUNDER(P) Frame P = F; { int t_; asm volatile("v_mbcnt_lo_u32_b32 %0, -1, 0\n\tv_mbcnt_hi_u32_b32 %0, -1, %0" : "=v"(t_)); t_ |= (F.wave << 6); P.tid = t_; P.lane = t_ & 63; P.wave = __builtin_amdgcn_readfirstlane(t_ >> 6); GAS unsigned char* w_ = (GAS unsigned char*)F.ws; asm volatile("" : "+s"(w_)); P.ws = (unsigned char*)w_; InTab t2_ = F.in; asm volatile("" : "+s"(t2_)); P.in = t2_; }
    if (RUNP(0, 0)) { LAUNDER(P); for (int rep_ = 0; rep_ < NREP(0); ++rep_) { phase_prologue(P); __syncthreads(); } SEAM(0); }
    if (RUNP(1, 1)) { LAUNDER(P); for (int rep_ = 0; rep_ < NREP(1); ++rep_) { phase_ln0_first(P); __syncthreads(); } SEAM(1); }
#pragma unroll 1
    for (int l = 0; l < DEPTH; ++l) {
        const int g0 = 2 + l * NPH;
        const int mrows = (l == DEPTH - 1) ? ML : MT;
        if (RUNP(2, g0 + 0)) {
#undef PHTY
#define PHTY 2
            LAUNDER(P);
            { ProbPlain Pr{(const bf16_t*)(P.ws + WS_H), (const bf16_t*)(P.ws + WS_WIN) + (size_t)l * NZ * D, D, D};
              pg8::StaticOrder<1> S; S.init(MT / 256, NZ_BF / 256, P.G, P.bid);
              EpiInproj<false> E{(bf16_t*)(P.ws + WS_Z), P.in[IN_BIN] + (size_t)l * 5904, 0};
              pg8::gemm_phase(P.lds, P.tid, Pr, S, E); }
            __syncthreads();
            { ProbPlainF8 Pr{(const bf16_t*)(P.ws + WS_H8), (const bf16_t*)(P.ws + WS_WIN8 + (size_t)l * NZ_F8 * D), D / 2, D / 2};
              pg8::StaticOrder<1> S; S.init(MT / 256, NZ_F8 / 256, P.G, P.bid);
              EpiInproj<true> E{(bf16_t*)(P.ws + WS_Z), P.in[IN_BIN] + (size_t)l * 5904, NZ_BF / 256};
              pg8::gemm_phase(P.lds, P.tid, Pr, S, E); }
            SEAM(g0 + 0);
        }
        if (RUNP(3, g0 + 1)) { LAUNDER(P); for (int rep_ = 0; rep_ < NREP(3); ++rep_) { phase_mixers(P, l); __syncthreads(); } SEAM(g0 + 1); }
        if (RUNP(12, g0 + 2)) { LAUNDER(P); for (int rep_ = 0; rep_ < NREP(12); ++rep_) { phase_mlstm(P, l); __syncthreads(); } SEAM(g0 + 2); }
        if (RUNP(4, g0 + 3)) { LAUNDER(P); for (int rep_ = 0; rep_ < NREP(4); ++rep_) phase_finalize(P, l, mrows); SEAM(g0 + 3); }
        if (RUNP(5, g0 + 4)) {
#undef PHTY
#define PHTY 5
            LAUNDER(P);
            ProbPlain Pr{(const bf16_t*)(P.ws + WS_BRA), (const bf16_t*)(P.ws + WS_WBR) + (size_t)l * D * D, D, D};
            pg8::StaticOrder<1> S; S.init(mrows / 256, 4, P.G, P.bid);
            EpiBranch E{(const bf16_t*)(P.ws + WS_Z), (bf16_t*)(P.ws + WS_Y)};
            pg8::gemm_phase(P.lds, P.tid, Pr, S, E); if (NREP(PHTY) == 2) { __syncthreads(); pg8::gemm_phase(P.lds, P.tid, Pr, S, E); }
            SEAM(g0 + 4);
        }
        if (RUNP(6, g0 + 5)) {
#undef PHTY
#define PHTY 6
            LAUNDER(P);
            ProbPlain Pr{(const bf16_t*)(P.ws + WS_Y), (const bf16_t*)(P.ws + WS_WOUT) + (size_t)l * D * D, D, D};
            pg8::StaticOrder<1> S; S.init(mrows / 256, 4, P.G, P.bid);
            EpiOut E{(bf16_t*)(P.ws + WS_T)};
            pg8::gemm_phase(P.lds, P.tid, Pr, S, E); if (NREP(PHTY) == 2) { __syncthreads(); pg8::gemm_phase(P.lds, P.tid, Pr, S, E); }
            SEAM(g0 + 5);
        }
        if (RUNP(7, g0 + 6)) { LAUNDER(P); for (int rep_ = 0; rep_ < NREP(7); ++rep_) phase_ln1_router(P, l, mrows); SEAM(g0 + 6); }
        if (RUNP(8, g0 + 7)) { LAUNDER(P); for (int rep_ = 0; rep_ < NREP(8); ++rep_) phase_slots(P, mrows); SEAM(g0 + 7); }
        if (RUNP(9, g0 + 8)) {
#undef PHTY
#define PHTY 9
            LAUNDER(P);
            LAS int* seg = (LAS int*)(P.lds + TAB_OFF);
            const int ntile = moe_tables(P, seg);
            ProbMoe1 Pr{(const bf16_t*)(P.ws + WS_H2F8), (const bf16_t*)(P.ws + WS_WGU + (size_t)l * NEXP * 2048 * D), D / 2, D / 2, (const int*)(P.ws + WS_ROUTE + RT_TOK), seg};
            pg8::StaticOrder<1> S; S.init(ntile, 8, P.G, P.bid);
            EpiSwiglu E{(unsigned char*)(P.ws + WS_HID), P.in[IN_BGU] + (size_t)l * NEXP * 2048, seg};
            pg8::gemm_phase(P.lds, P.tid, Pr, S, E); if (NREP(PHTY) == 2) { __syncthreads(); pg8::gemm_phase(P.lds, P.tid, Pr, S, E); }
            SEAM(g0 + 8);
        }
        if (RUNP(10, g0 + 9)) {
#undef PHTY
#define PHTY 10
            LAUNDER(P);
            LAS int* seg = (LAS int*)(P.lds + TAB_OFF);
            const int ntile = moe_tables(P, seg);
            ProbMoe2 Pr{(const bf16_t*)(P.ws + WS_HID), (const bf16_t*)(P.ws + WS_WDN + (size_t)l * NEXP * D * D), D / 2, D / 2, seg};
            pg8::StaticOrder<1> S; S.init(ntile, 4, P.G, P.bid);
            EpiDown E{(unsigned char*)(P.ws + WS_FS), P.in[IN_BDN] + (size_t)l * NEXP * D, (const int*)(P.ws + WS_ROUTE + RT_DEST), (const float*)(P.ws + WS_ROUTE + RT_PSLOT), seg};
            pg8::gemm_phase(P.lds, P.tid, Pr, S, E); if (NREP(PHTY) == 2) { __syncthreads(); pg8::gemm_phase(P.lds, P.tid, Pr, S, E); }
            SEAM(g0 + 9);
        }
        if (RUNP(11, g0 + 10)) { LAUNDER(P); phase_combine_ln2(P, l, mrows); SEAM(g0 + 10); }
    }
#undef LAUNDER
#undef RUN
#undef RUNP
#undef SEAM
}

extern "C" void kernel_launch(void* const* d_in, const int* in_sizes, int n_in, void* d_out, int out_size, void* d_ws, size_t ws_size, hipStream_t stream) {
    static int grid = 0;
    if (grid == 0) {
        if (n_in != 31 || out_size != ML * D || ws_size < WS_END) { fprintf(stderr, "kernel_launch: unexpected problem (n_in %d, out %d, ws %zu, need %zu)\n", n_in, out_size, ws_size, (size_t)WS_END); grid = -1; return; }
        int dev = 0, cus = 0, per_cu = 0;
        if (hipGetDevice(&dev) != hipSuccess || hipDeviceGetAttribute(&cus, hipDeviceAttributeMultiprocessorCount, dev) != hipSuccess) { grid = -1; return; }
        if (hipFuncSetAttribute((const void*)fwd_kernel, hipFuncAttributeMaxDynamicSharedMemorySize, LDS_BYTES) != hipSuccess) { fprintf(stderr, "kernel_launch: hipFuncSetAttribute failed\n"); grid = -1; return; }
        if (hipOccupancyMaxActiveBlocksPerMultiprocessor(&per_cu, (const void*)fwd_kernel, NTHREADS, LDS_BYTES) != hipSuccess || per_cu < 1) fprintf(stderr, "kernel_launch: occupancy query reports %d\n", per_cu);
        (void)hipGetLastError();
        grid = cus;
    }
    if (grid < 0) return;
    (void)hipMemsetAsync((char*)d_ws + WS_CTL, 0, CTL_ZERO_BYTES, stream);
    Args a{};
    for (int i = 0; i < 31; ++i) a.in[i] = (const float*)d_in[i];
    a.out = (float*)d_out; a.ws = (unsigned char*)d_ws;
#if MK_N_LAUNCHES == 1
    a.g_lo = 0; a.g_hi = NGID;
    hipLaunchKernelGGL(fwd_kernel, dim3(grid), dim3(NTHREADS), LDS_BYTES, stream, a);
#else
    for (int g = 0; g < NGID; ++g) { a.g_lo = g; a.g_hi = g + 1; hipLaunchKernelGGL(fwd_kernel, dim3(grid), dim3(NTHREADS), LDS_BYTES, stream, a); }
#endif
}
```

```cpp
#include <hip/hip_runtime.h>
#include <cstdio>
#include <cstdint>

#ifndef MK_N_LAUNCHES
#define MK_N_LAUNCHES 1
#endif

#define LAS __attribute__((address_space(3)))
#define GAS __attribute__((address_space(1)))
typedef unsigned short bf16_t;
typedef short bf16x8 __attribute__((ext_vector_type(8)));
typedef short s16x4 __attribute__((ext_vector_type(4)));
typedef float f32x4 __attribute__((ext_vector_type(4)));
typedef float f32x2 __attribute__((ext_vector_type(2)));
typedef float f32x16 __attribute__((ext_vector_type(16)));
typedef unsigned u32x4 __attribute__((ext_vector_type(4)));
typedef unsigned u32x2 __attribute__((ext_vector_type(2)));
typedef int i32x4 __attribute__((ext_vector_type(4)));
typedef int i32x8 __attribute__((ext_vector_type(8)));

constexpr int D = 1024, NB = 16, SEQ = 4096, CTXL = 256, DEPTH = 4;
constexpr int ML = NB * SEQ;
constexpr int MC = NB * CTXL;
constexpr int MT = ML + MC;
constexpr int NZ = 5888;
constexpr int ZC_P = 0, ZC_QK = 256, ZC_V = 1280, ZC_O = 1792, ZC_UV = 2304, ZC_MG = 2816;
constexpr int NZ_BF = 256, NZ_F8 = 5632;
constexpr int ZG_COL = 2816;
constexpr int NEXP = 32, TOPK = 4;
constexpr int NS_MAX = MT * TOPK + NEXP * 256;
constexpr float LN_EPS = 1e-5f, HEAD_EPS = 1e-6f;
constexpr float DN_ALPHA = 1.6817928305074292f;
constexpr int NWAVES = 8, NTHREADS = 512;
constexpr float F8S_ACT = 4.0f, F8S_WGU = 64.0f, F8S_WDN = 64.0f; constexpr int F8E_ACT = 123, F8E_WGU = 123, F8E_WDN = 123;

constexpr size_t MiB = 1u << 20;
constexpr size_t WS_CTL = 0, CTL_ZERO_BYTES = 1 * MiB;
constexpr size_t WS_MOD = 1 * MiB;
constexpr size_t WS_WG = 3 * MiB;
constexpr size_t WS_WSGU = 4 * MiB;
constexpr size_t WS_WPOOL = WS_WSGU + 512 * 1024;
constexpr size_t WS_ROUTE = 5 * MiB;
constexpr size_t WS_WIN = 16 * MiB;
constexpr size_t WS_WBR = 62 * MiB;
constexpr size_t WS_WOUT = 70 * MiB;
constexpr size_t WS_WGU = 78 * MiB;
constexpr size_t WS_WDN = 590 * MiB;
constexpr size_t WS_X = 846 * MiB;
constexpr size_t WS_H = 1118 * MiB;
constexpr size_t WS_Z = 1254 * MiB;
constexpr size_t WS_FS = WS_Z;
constexpr float G8_SCALE = 255.0f;
constexpr float FS_SCALE = 32.0f, FS_CLAMP = 440.0f;
constexpr size_t WS_BRA = 2036 * MiB;
constexpr size_t WS_HFB = 2172 * MiB;
constexpr size_t WS_Y = 2444 * MiB;
constexpr size_t WS_T = 2580 * MiB;
constexpr size_t WS_H2 = 2852 * MiB;
constexpr size_t WS_HID = 2988 * MiB;
constexpr size_t WS_ZG = 3548 * MiB;
constexpr size_t WS_H2F8 = 3554 * MiB;
constexpr size_t WS_H8 = 3624 * MiB;
constexpr size_t WS_WIN8 = 3692 * MiB;
constexpr size_t WS_END = 3714 * MiB;
static_assert(WS_Z + (size_t)MT * NZ * 2 <= WS_BRA && WS_FS + (size_t)MT * 4 * 1024 * 2 <= WS_BRA, "Z/FS");
static_assert(WS_HID + (size_t)NS_MAX * 1024 * 2 <= WS_END, "HID");
constexpr size_t RT_EIDX = 0;
constexpr size_t RT_PROB = 2 * MiB;
constexpr size_t RT_TOK = 4 * MiB;
constexpr size_t RT_DEST = 6 * MiB;
constexpr size_t RT_PSLOT = 8 * MiB;
constexpr size_t RT_CNT = 10 * MiB;
constexpr size_t RT_SEG = 10 * MiB + 64 * 1024;
constexpr int CW_BAR = 4096;

constexpr int LDS_BYTES = 163840;
constexpr int MISC_OFF = LDS_BYTES - 256;
constexpr int TAB_OFF = 131072;
constexpr int NW_WT = 0;
constexpr int NW_LG = 66048;
constexpr int NW_END = 99840;
constexpr int NW_PV = NW_END + 256;

__device__ __forceinline__ unsigned f2bf(float f) { unsigned u = __builtin_bit_cast(unsigned, f); return (u + 0x7fffu + ((u >> 16) & 1u)) >> 16; }
__device__ __forceinline__ unsigned pk2(float lo, float hi) { unsigned r; asm volatile("v_cvt_pk_bf16_f32 %0, %1, %2" : "=v"(r) : "v"(lo), "v"(hi)); return r; }
__device__ __forceinline__ unsigned pk4_fp8(float a, float b, float c, float d) { int w = 0; w = __builtin_amdgcn_cvt_pk_fp8_f32(a, b, w, false); w = __builtin_amdgcn_cvt_pk_fp8_f32(c, d, w, true); return (unsigned)w; }
__device__ __forceinline__ unsigned pk4_u8(float a, float b, float c, float d) {
    const unsigned lo = __builtin_amdgcn_perm(__builtin_bit_cast(unsigned, b), __builtin_bit_cast(unsigned, a), 0x0c0c0400u), hi = __builtin_amdgcn_perm(__builtin_bit_cast(unsigned, d), __builtin_bit_cast(unsigned, c), 0x0c0c0400u);
    return lo | (hi << 16); }
__device__ __forceinline__ f32x4 u8x4_f32(unsigned w) { return (f32x4){(float)(w & 0xffu), (float)((w >> 8) & 0xffu), (float)((w >> 16) & 0xffu), (float)(w >> 24)}; }
__device__ __forceinline__ float bflo(unsigned w) { return __builtin_bit_cast(float, w << 16); }
__device__ __forceinline__ float bfhi(unsigned w) { return __builtin_bit_cast(float, w & 0xffff0000u); }
__device__ __forceinline__ float bf1(bf16_t h) { return __builtin_bit_cast(float, ((unsigned)h) << 16); }
__device__ __forceinline__ float bperm(int srclane, float v) { return __builtin_bit_cast(float, __builtin_amdgcn_ds_bpermute(srclane << 2, __builtin_bit_cast(int, v))); }
__device__ __forceinline__ float shx(float v, int o, int lane) { return bperm(lane ^ o, v); }
__device__ __forceinline__ float shup(float v, int o, int lane) { return bperm(lane >= o ? lane - o : lane, v); }
template <int N> __device__ __forceinline__ float dpp_ror(float v) { return __builtin_bit_cast(float, __builtin_amdgcn_update_dpp(0, __builtin_bit_cast(int, v), 0x120 + N, 0xf, 0xf, false)); }
template <int CTRL, int ROWMASK> __device__ __forceinline__ float dpp_id(float ident, float v) { return __builtin_bit_cast(float, __builtin_amdgcn_update_dpp(__builtin_bit_cast(int, ident), __builtin_bit_cast(int, v), CTRL, ROWMASK, 0xf, false)); }
__device__ __forceinline__ float wave_scan_sum(float v) {
    v += dpp_id<0x111, 0xf>(0.f, v); v += dpp_id<0x112, 0xf>(0.f, v); v += dpp_id<0x114, 0xf>(0.f, v); v += dpp_id<0x118, 0xf>(0.f, v);
    v += dpp_id<0x142, 0xa>(0.f, v); v += dpp_id<0x143, 0xc>(0.f, v); return v; }
__device__ __forceinline__ float wave_scan_max(float v) { const float NI = -3.0e38f;
    v = fmaxf(v, dpp_id<0x111, 0xf>(NI, v)); v = fmaxf(v, dpp_id<0x112, 0xf>(NI, v)); v = fmaxf(v, dpp_id<0x114, 0xf>(NI, v)); v = fmaxf(v, dpp_id<0x118, 0xf>(NI, v));
    v = fmaxf(v, dpp_id<0x142, 0xa>(NI, v)); v = fmaxf(v, dpp_id<0x143, 0xc>(NI, v)); return v; }
template <int CTRL> __device__ __forceinline__ float dpp_mv(float v) { return __builtin_bit_cast(float, __builtin_amdgcn_update_dpp(0, __builtin_bit_cast(int, v), CTRL, 0xf, 0xf, false)); }
__device__ __forceinline__ float oct_sum(float v) { v += dpp_mv<0xB1>(v); v += dpp_mv<0x4E>(v); v += dpp_mv<0x141>(v); return v; }
__device__ __forceinline__ float row16_sum(float v) { v += dpp_ror<8>(v); v += dpp_ror<4>(v); v += dpp_ror<2>(v); v += dpp_ror<1>(v); return v; }
__device__ __forceinline__ float wave_sum(float v, int) {
    v = row16_sum(v);
    { const unsigned u = __builtin_bit_cast(unsigned, v); const auto r = __builtin_amdgcn_permlane16_swap(u, u, false, false); v = __builtin_bit_cast(float, (unsigned)r[0]) + __builtin_bit_cast(float, (unsigned)r[1]); }
    { const unsigned u = __builtin_bit_cast(unsigned, v); const auto r = __builtin_amdgcn_permlane32_swap(u, u, false, false); v = __builtin_bit_cast(float, (unsigned)r[0]) + __builtin_bit_cast(float, (unsigned)r[1]); }
    return v;
}
__device__ __forceinline__ float sigmoidf_(float x) { return __builtin_amdgcn_rcpf(1.0f + __builtin_amdgcn_exp2f(x * -1.4426950408889634f)); }
__device__ __forceinline__ float siluf_(float x) { return x * __builtin_amdgcn_rcpf(1.0f + __builtin_amdgcn_exp2f(x * -1.4426950408889634f)); }
__device__ __forceinline__ f32x4 sigmoid4(f32x4 x) {
    f32x4 t = x * -1.4426950408889634f;
#pragma unroll
    for (int i = 0; i < 4; ++i) t[i] = __builtin_amdgcn_exp2f(t[i]);
    t = t + 1.0f;
#pragma unroll
    for (int i = 0; i < 4; ++i) t[i] = __builtin_amdgcn_rcpf(t[i]);
    return t; }
#define LDS_WAIT() asm volatile("s_waitcnt lgkmcnt(0)" ::: "memory")
#define VM_WAIT() asm volatile("s_waitcnt vmcnt(0)" ::: "memory")

#define XB_TMO      128
#define XB_XCNT(j)  (256  + 64 * (j))
#define XB_XSUB(j)  (1280 + 64 * (j))
#define XB_XGEN(j)  (2304 + 64 * (j))
#define XB_TOP      3328
#define XB_TOPGEN   3392
#define XCD_BAR_WORDS 3456
#define XB_SPIN_CAP (1u << 18)
__device__ __forceinline__ unsigned xb_ld(unsigned* p)              { asm volatile("" : "+v"(p)); return __hip_atomic_load(p, __ATOMIC_RELAXED, __HIP_MEMORY_SCOPE_AGENT); }
__device__ __forceinline__ unsigned xb_add(unsigned* p, unsigned v) { asm volatile("" : "+v"(p), "+v"(v)); return __hip_atomic_fetch_add(p, v, __ATOMIC_RELAXED, __HIP_MEMORY_SCOPE_AGENT); }
__device__ __forceinline__ unsigned xb_xcc_id() { return (unsigned)__builtin_amdgcn_s_getreg((3 << 11) | 20) & 0xFu; }
#define XB_SPIN(cond, bar) do { unsigned _sp = 0; while (cond) { __builtin_amdgcn_s_sleep(1); \
    if ((++_sp & 255u) == 0u) { if (xb_ld(&(bar)[XB_TMO])) break; if (_sp > XB_SPIN_CAP) { atomicAdd(&(bar)[XB_TMO], 1u); break; } } } } while (0)
struct XcdBarrier { unsigned* bar; unsigned x; volatile LAS unsigned* st; };
__device__ __forceinline__ XcdBarrier xcd_barrier_post(unsigned* bar, volatile LAS unsigned* st) {
    XcdBarrier b; b.bar = bar; b.x = xb_xcc_id(); b.st = st;
    if (threadIdx.x == 0) (void)xb_add(&bar[XB_XCNT(b.x)], 1u);
    return b;
}
__device__ __forceinline__ void xcd_barrier_complete(unsigned* bar, unsigned x, unsigned& nloc, unsigned& nx) {
    const unsigned G = gridDim.x * gridDim.y * gridDim.z;
    unsigned sum, cnt, mine, sp = 0u;
    for (;;) {
        sum = 0u; cnt = 0u; mine = 0u;
#pragma unroll
        for (unsigned j = 0; j < 16; ++j) { const unsigned c = xb_ld(&bar[XB_XCNT(j)]); sum += c; cnt += (c > 0u) ? 1u : 0u; mine = (j == x) ? c : mine; }
        if (sum == G) break;
        __builtin_amdgcn_s_sleep(1);
        if ((++sp & 255u) == 0u) { if (xb_ld(&bar[XB_TMO])) break; if (sp > XB_SPIN_CAP) { atomicAdd(&bar[XB_TMO], 1u); break; } }
    }
    nloc = mine > 0u ? mine : 1u; nx = cnt > 0u ? cnt : 1u;
}
__device__ __forceinline__ void xcd_barrier(const XcdBarrier& b) {
    asm volatile("s_waitcnt vmcnt(0)" ::: "memory");
    __syncthreads();
    if (threadIdx.x == 0) {
        unsigned* bar = b.bar;
        __builtin_amdgcn_s_waitcnt(0);
        unsigned nloc = b.st[0], nx = b.st[1];
        if (nloc == 0u) { xcd_barrier_complete(bar, b.x, nloc, nx); b.st[0] = nloc; b.st[1] = nx; }
        const unsigned old = xb_add(&bar[XB_XSUB(b.x)], 1u);
        const unsigned gen = old / nloc;
        if (old + 1u == (gen + 1u) * nloc) {
            __builtin_amdgcn_fence(__ATOMIC_RELEASE, "agent");
            asm volatile("s_waitcnt vmcnt(0)" ::: "memory");
            const unsigned og = xb_add(&bar[XB_TOP], 1u);
            const unsigned tg = og / nx;
            if (og + 1u == (tg + 1u) * nx) xb_add(&bar[XB_TOPGEN], 1u);
            else XB_SPIN(xb_ld(&bar[XB_TOPGEN]) == tg, bar);
            __builtin_amdgcn_fence(__ATOMIC_ACQUIRE, "agent");
            xb_add(&bar[XB_XGEN(b.x)], 1u);
            asm volatile("s_waitcnt vmcnt(0)" ::: "memory");
        } else {
            XB_SPIN(xb_ld(&bar[XB_XGEN(b.x)]) == gen, bar);
            __builtin_amdgcn_fence(__ATOMIC_ACQUIRE, "agent");
            asm volatile("s_waitcnt vmcnt(0)" ::: "memory");
        }
    }
    __syncthreads();
}

namespace pg8 {
constexpr int BM = 256, BK = 64, HALF = 128, HTB = HALF * BK * 2, STAGE_BYTES = 8 * HTB, NXCD = 8, WGM = 8;
__host__ __device__ __forceinline__ int lds_byte(int r, int c) { const int st = (r >> 4) * 2 + (c >> 5), rr = r & 15, cc = c & 31, ob = rr * 64 + cc * 2; return st * 1024 + (ob ^ (((ob >> 9) & 1) << 5)); }
__host__ __device__ __forceinline__ void stage_rc(int b, int& R, int& C) { const int st = b / 1024, sb = b % 1024, swz = sb ^ (((sb >> 9) & 1) << 5); R = (st >> 1) * 16 + swz / 64; C = (st & 1) * 32 + (swz % 64) / 2; }
__host__ __device__ __forceinline__ int perm32(int rho) { const int n = rho >> 4, i = rho & 15; return 8 * (i >> 2) + 4 * n + (i & 3); }
struct Unit { int pm, pn, sub; };
__device__ __forceinline__ unsigned cvt_pk_bf16(float lo, float hi) { unsigned r; asm volatile("v_cvt_pk_bf16_f32 %0, %1, %2" : "=v"(r) : "v"(lo), "v"(hi)); return r; }
__device__ __forceinline__ f32x2 gelu_pk(f32x2 v) {
    const f32x2 av = __builtin_elementwise_abs(v), d = av * 0.2316418882f + 1.0f;
    f32x2 t; t.x = __builtin_amdgcn_rcpf(d.x); t.y = __builtin_amdgcn_rcpf(d.y);
    f32x2 q = t * 0.5307027145f + (-0.7265760135f); q = q * t + 0.7107068705f; q = q * t + (-0.142248368f); q = q * t + 0.127414796f; q = q * t;
    const f32x2 s = (v * v) * (-0.72134752044f);
    f32x2 e; e.x = __builtin_amdgcn_exp2f(s.x); e.y = __builtin_amdgcn_exp2f(s.y);
    const f32x2 m = v * (q * e), r = v - m;
    f32x2 o; o.x = v.x < 0.f ? m.x : r.x; o.y = v.y < 0.f ? m.y : r.y; return o;
}
template <int NSUB = 1> struct StaticOrder {
    int nM, nN, nwg, G, c;
    __device__ void init(int nM_, int nN_, int G_, int c_) { nM = nM_; nN = nN_; nwg = nM * nN; G = G_; c = c_; }
    __device__ bool next(int i, Unit& u) const {
        const int it = i / NSUB; u.sub = i - it * NSUB;
        const long L = (long)it * G + c; if (L >= nwg) return false;
        int wgid = (int)L; { const int q = nwg / NXCD, r = nwg % NXCD, xcd = wgid % NXCD, off = wgid / NXCD; wgid = (xcd < r ? xcd * (q + 1) : r * (q + 1) + (xcd - r) * q) + off; }
        const int nig = WGM * nN, gid = wgid / nig, fm = gid * WGM, gsz = (nM - fm) < WGM ? (nM - fm) : WGM;
        u.pm = fm + ((wgid % nig) % gsz); u.pn = (wgid % nig) / gsz; return true;
    }
};
constexpr int SIDE_TOK = 131072 + 2048;
constexpr int SIDE_SLOT = 131072 + 10240, SIDE_SLOT_BYTES = 3072;
__device__ __forceinline__ void dma16(unsigned voff, const void* sbase, unsigned ldsaddr) { asm volatile("s_mov_b32 m0, %2\n\tglobal_load_lds_dwordx4 %0, %1" :: "v"(voff), "s"(sbase), "s"(ldsaddr) : "memory", "m0"); }
__device__ __forceinline__ void dma4(unsigned voff, const void* sbase, unsigned ldsaddr) { asm volatile("s_mov_b32 m0, %2\n\tglobal_load_lds_dword %0, %1" :: "v"(voff), "s"(sbase), "s"(ldsaddr) : "memory", "m0"); }
template <class Prob, class Sched, class Epi>
__device__ __forceinline__ void gemm_phase(LAS unsigned char* lds, const int tid, const Prob& P, const Sched& S, const Epi& E) {
    const int wid = __builtin_amdgcn_readfirstlane(tid >> 6), lane = tid & 63, wr = wid >> 2, wc = wid & 3, fr = lane & 15, fq = lane >> 4;
    const int lda = P.lda, ldb = P.ldb;
    unsigned voffB[2], offA[2][2];
#define PG8_TOKSLOT(name) const LAS int* name; { PG8_TID(tl2_); name = (const LAS int*)(lds + SIDE_TOK) + (tl2_ >> 6) * 256 + (tl2_ & 63); }
#define PG8_TID(v_) int v_; asm volatile("v_mbcnt_lo_u32_b32 %0, -1, 0\n\tv_mbcnt_hi_u32_b32 %0, -1, %0" : "=v"(v_)); v_ |= (wid << 6)
#define PG8_RC(R_, C_) int R_[2], C_[2]; { PG8_TID(tl_); _Pragma("unroll") for (int i_ = 0; i_ < 2; ++i_) stage_rc(tl_ * 16 + i_ * 8192, R_[i_], C_[i_]); }
#pragma unroll
    for (int i = 0; i < 2; ++i) { int R, C; stage_rc(tid * 16 + i * 8192, R, C); const int Rb = Epi::PERM ? ((R & ~31) + perm32(R & 31)) : R;
        voffB[i] = (unsigned)(Rb * ldb + C) * 2u;
        offA[0][i] = (unsigned)(R * lda + C) * 2u; offA[1][i] = (unsigned)((R + HALF) * lda + C) * 2u; }
    const size_t kstep = (size_t)(BK * 2);
    const size_t hstep = (size_t)HALF * ldb * 2;
    const unsigned ldsw = (unsigned)wid * 1024u;
    const int aoff = lds_byte(wr * 64 + fr, fq * 8), boff = lds_byte(wc * 32 + fr, fq * 8);
#define PG8_SA(b, h) (((b) * 2 + (h)) * HTB)
#define PG8_SB(b, h) ((4 + (b) * 2 + (h)) * HTB)
    const unsigned ldsb = (unsigned)(size_t)lds;
#define PG8_STAGE(bufoff, gbase, voff) do { _Pragma("unroll") for (int _i = 0; _i < 2; ++_i) \
        asm volatile("s_mov_b32 m0, %2\n\tglobal_load_lds_dwordx4 %0, %1" :: "v"((voff)[_i]), "s"((const char*)(gbase)), "s"(ldsb + (unsigned)(bufoff) + ldsw + (unsigned)(_i * 8192)) : "memory", "m0"); } while (0)
#define PG8_CAT(x0, x1) __builtin_shufflevector(x0, x1, 0, 1, 2, 3, 4, 5, 6, 7)
#define PG8_LDA(dst, b, h) do { if constexpr (Prob::FP8) { _Pragma("unroll") for (int m = 0; m < 4; ++m) dst##8[m] = PG8_CAT(*(const LAS i32x4*)(lds + PG8_SA(b, h) + aoff + m * 2048), *(const LAS i32x4*)(lds + PG8_SA(b, h) + aoff + m * 2048 + 1024)); } \
        else { _Pragma("unroll") for (int m = 0; m < 4; ++m) _Pragma("unroll") for (int k = 0; k < 2; ++k) dst[m][k] = *(const LAS bf16x8*)(lds + PG8_SA(b, h) + aoff + m * 2048 + k * 1024); } } while (0)
#define PG8_LDB(dst, b, h) do { if constexpr (Prob::FP8) { _Pragma("unroll") for (int n = 0; n < 2; ++n) dst##8[n] = PG8_CAT(*(const LAS i32x4*)(lds + PG8_SB(b, h) + boff + n * 2048), *(const LAS i32x4*)(lds + PG8_SB(b, h) + boff + n * 2048 + 1024)); } \
        else { _Pragma("unroll") for (int n = 0; n < 2; ++n) _Pragma("unroll") for (int k = 0; k < 2; ++k) dst[n][k] = *(const LAS bf16x8*)(lds + PG8_SB(b, h) + boff + n * 2048 + k * 1024); } } while (0)
#define PG8_MMA(ai, bj, At, Bt) do { __builtin_amdgcn_s_setprio(1); \
        if constexpr (Prob::FP8) { _Pragma("unroll") for (int m = 0; m < 4; ++m) _Pragma("unroll") for (int n = 0; n < 2; ++n) \
            acc[ai][bj][m][n] = __builtin_amdgcn_mfma_scale_f32_16x16x128_f8f6f4(Bt##8[n], At##8[m], acc[ai][bj][m][n], 0, 0, 0, sc8_, 0, sc8_); } \
        else { _Pragma("unroll") for (int m = 0; m < 4; ++m) _Pragma("unroll") for (int n = 0; n < 2; ++n) _Pragma("unroll") for (int k = 0; k < 2; ++k) \
            acc[ai][bj][m][n] = __builtin_amdgcn_mfma_f32_16x16x32_bf16(Bt[n][k], At[m][k], acc[ai][bj][m][n], 0, 0, 0); } \
        __builtin_amdgcn_s_setprio(0); } while (0)
#define PG8_WAIT_V(n) asm volatile("s_waitcnt vmcnt(" #n ")" ::: "memory")
#define PG8_WAIT_L(n) asm volatile("s_waitcnt lgkmcnt(" #n ")" ::: "memory")
#define PG8_BAR __builtin_amdgcn_s_barrier()
#define PG8_SCHED __builtin_amdgcn_sched_barrier(0)
    Unit cur, nxt; int ui = 0;
    if (!S.next(0, cur)) return;
    static_assert(Prob::SCALE_A == Prob::SCALE_B, "one scale register serves both operands");
    int sc8_; asm volatile("v_mov_b32 %0, %1" : "=v"(sc8_) : "n"(Prob::SCALE_A));
    f32x4 acc[2][2][4][2];
    float zero_; asm volatile("v_mov_b32 %0, 0" : "=v"(zero_));
#pragma unroll
    for (int a = 0; a < 2; ++a)
#pragma unroll
        for (int b = 0; b < 2; ++b)
#pragma unroll
            for (int m = 0; m < 4; ++m)
#pragma unroll
                for (int n = 0; n < 2; ++n) acc[a][b][m][n] = (f32x4){zero_, zero_, zero_, zero_};
    bf16x8 At[4][2], B0[2][2], B1[2][2]; i32x8 At8[4], B08[2], B18[2];
    const char* cA = P.a_base(cur); const char* cB = P.b_base(cur); int nt = P.nt(cur);
    if constexpr (Prob::GATHER) { PG8_RC(Rr, Cc); P.a_rows(cur, Rr, Cc, offA); }
    if constexpr (Epi::SIDE) { PG8_TID(tl4_); E.side(cur, ldsb + SIDE_SLOT, wid, tl4_ & 63); }
    PG8_STAGE(PG8_SB(0, 0), cB, voffB); PG8_STAGE(PG8_SB(0, 1), cB + hstep, voffB); PG8_STAGE(PG8_SA(0, 0), cA, offA[0]); PG8_STAGE(PG8_SA(0, 1), cA, offA[1]);
    if (wr == 1) PG8_BAR;
    PG8_WAIT_V(2); PG8_BAR;
    PG8_STAGE(PG8_SB(1, 0), cB + kstep, voffB); PG8_STAGE(PG8_SA(1, 0), cA + kstep, offA[0]); PG8_STAGE(PG8_SB(1, 1), cB + hstep + kstep, voffB);
    PG8_WAIT_V(6); PG8_BAR;
    for (;;) {
        const bool has_next = S.next(ui + 1, nxt);
        const char* nA = has_next ? P.a_base(nxt) : cA; const char* nB = has_next ? P.b_base(nxt) : cB;
        if constexpr (Prob::GATHER) { if (has_next) { PG8_RC(Rr, Cc); (void)Cc;
#pragma unroll
            for (int h = 0; h < 2; ++h)
#pragma unroll
                for (int i = 0; i < 2; ++i) dma4((unsigned)(nxt.pm * 256 + h * 128 + Rr[i]) * 4u, P.tok, ldsb + SIDE_TOK + (unsigned)wid * 1024u + (unsigned)((h * 2 + i) * 256)); } }
        if constexpr (Epi::SIDE) { if (has_next) { PG8_TID(tl4_); E.side(nxt, ldsb + SIDE_SLOT + (unsigned)(((ui + 1) % 3) * SIDE_SLOT_BYTES), wid, tl4_ & 63); } }
        for (int t = 0; t < nt; t += 2) {
            const bool last = (t == nt - 2);
            if constexpr (Epi::KHOOK) { if (t == Epi::HOOK_T0 || t == Epi::HOOK_T1) {
                asm volatile("" ::: "memory"); PG8_TID(tlh_); const int lnh_ = tlh_ & 63; E.hook(acc, cur, t == Epi::HOOK_T0 ? 0 : 1, wr, wc, lnh_ & 15, lnh_ >> 4); asm volatile("" ::: "memory"); } }
            const char* a1 = cA + (size_t)(t + 1) * kstep;
            const char* a2 = last ? nA : cA + (size_t)(t + 2) * kstep; const char* b2 = last ? nB : cB + (size_t)(t + 2) * kstep;
            const char* a3 = a2 + kstep; const char* b3 = b2 + kstep;
            PG8_LDB(B0, 0, 0); PG8_LDB(B1, 0, 1); PG8_SCHED; PG8_LDA(At, 0, 0); PG8_STAGE(PG8_SA(1, 1), a1, offA[1]);
            PG8_WAIT_V(8); PG8_WAIT_L(0); PG8_BAR; PG8_MMA(0, 0, At, B0); PG8_MMA(0, 1, At, B1); PG8_BAR; PG8_SCHED;
            if constexpr (Prob::GATHER) { if (last && has_next) { PG8_RC(Rr, Cc); (void)Rr; PG8_TOKSLOT(tokslot); const int ntok[2][2] = {{tokslot[0], tokslot[64]}, {tokslot[128], tokslot[192]}}; P.a_off(ntok, Cc, offA); } }
            PG8_LDA(At, 0, 1); PG8_STAGE(PG8_SB(0, 0), b2, voffB); PG8_STAGE(PG8_SB(0, 1), b2 + hstep, voffB); PG8_STAGE(PG8_SA(0, 0), a2, offA[0]);
            PG8_WAIT_V(8); PG8_WAIT_L(0); PG8_BAR; PG8_MMA(1, 0, At, B0); PG8_MMA(1, 1, At, B1); PG8_BAR; PG8_SCHED;
            PG8_LDB(B0, 1, 0); PG8_LDB(B1, 1, 1); PG8_SCHED; PG8_LDA(At, 1, 0); PG8_STAGE(PG8_SA(0, 1), a2, offA[1]);
            PG8_WAIT_V(8); PG8_WAIT_L(0); PG8_BAR; PG8_MMA(0, 0, At, B0); PG8_MMA(0, 1, At, B1); PG8_BAR; PG8_SCHED;
            PG8_LDA(At, 1, 1); PG8_STAGE(PG8_SB(1, 0), b3, voffB); PG8_STAGE(PG8_SB(1, 1), b3 + hstep, voffB); PG8_STAGE(PG8_SA(1, 0), a3, offA[0]);
            PG8_WAIT_V(8); PG8_WAIT_L(0); PG8_BAR; PG8_MMA(1, 0, At, B0); PG8_MMA(1, 1, At, B1); PG8_BAR; PG8_SCHED;
        }
        if (wr == 0) PG8_BAR;
        { PG8_TID(tl3_); const int ln_ = tl3_ & 63; E(acc, cur, wr, wc, ln_ & 15, ln_ >> 4, lds + SIDE_SLOT + (ui % 3) * SIDE_SLOT_BYTES); }
        if (!has_next) break;
        bool keep = false;
        if constexpr (Epi::CHAIN) keep = E.keep(cur);
        if (!keep) {
            asm volatile("v_mov_b32 %0, 0" : "=v"(zero_));
#pragma unroll
            for (int a = 0; a < 2; ++a)
#pragma unroll
                for (int b = 0; b < 2; ++b)
#pragma unroll
                    for (int m = 0; m < 4; ++m)
#pragma unroll
                        for (int n = 0; n < 2; ++n) acc[a][b][m][n] = (f32x4){zero_, zero_, zero_, zero_};
        }
        cur = nxt; cA = nA; cB = nB; nt = P.nt(cur); ++ui;
        if (wr == 1) PG8_BAR;
    }
    PG8_WAIT_V(0);
    PG8_BAR;
#undef PG8_RC
#undef PG8_TID
#undef PG8_TOKSLOT
#undef PG8_SA
#undef PG8_SB
#undef PG8_STAGE
#undef PG8_LDA
#undef PG8_LDB
#undef PG8_MMA
#undef PG8_CAT
#undef PG8_WAIT_V
#undef PG8_WAIT_L
#undef PG8_BAR
#undef PG8_SCHED
}
}

typedef const float* cfp_t;
typedef const cfp_t __attribute__((address_space(4))) * InTab;
struct Frame {
    LAS unsigned char* lds;
    volatile LAS unsigned* MISC;
    unsigned char* ws;
    InTab in;
    float* out;
    int tid, lane, wave, G, bid;
};
enum { IN_X = 0, IN_C, IN_CTX, IN_CCTX, IN_WADA, IN_BADA, IN_WIN, IN_BIN, IN_POOLW, IN_POOLS, IN_CONVW, IN_CONVB, IN_MNG, IN_SLNG, IN_SLNB, IN_SGUW, IN_SGUB,
       IN_WBP, IN_WBM, IN_WBS, IN_WOUT, IN_LN1G, IN_LN1B, IN_WR, IN_BR, IN_WGU, IN_BGU, IN_WDN, IN_BDN, IN_LN2G, IN_LN2B };
__device__ __forceinline__ int mod_row(int row) { return row < ML ? (row >> 12) : NB; }
__device__ __forceinline__ const float* modp(const Frame& F, int l, int row, int part) { return (const float*)(F.ws + WS_MOD) + ((size_t)(l * 17 + mod_row(row)) * 6 + part) * 1024; }

__device__ __forceinline__ void transpose_item(const float* W, size_t ldw, int k0, int srccol0, bf16_t* dst, size_t ldk, int kd0, LAS float* scr, int lane) {
#pragma unroll 8
    for (int i = 0; i < 32; ++i) { const int kk = 2 * i + (lane >> 5); scr[kk * 33 + (lane & 31)] = __builtin_nontemporal_load(W + (size_t)(k0 + kk) * ldw + srccol0 + (lane & 31)); }
    LDS_WAIT(); asm volatile("" ::: "memory");
    const int c = lane & 7;
#pragma unroll
    for (int j = 0; j < 4; ++j) { const int n = (lane >> 3) + 8 * j; const LAS float* s = scr + (8 * c) * 33 + n;
        u32x4 o; o.x = pk2(s[0 * 33], s[1 * 33]); o.y = pk2(s[2 * 33], s[3 * 33]); o.z = pk2(s[4 * 33], s[5 * 33]); o.w = pk2(s[6 * 33], s[7 * 33]);
        *(u32x4*)(dst + (size_t)n * ldk + kd0 + 8 * c) = o; }
    LDS_WAIT(); asm volatile("" ::: "memory");
}
__device__ __forceinline__ void transpose_item_fp8(const float* W, size_t ldw, int k0, int srccol0, unsigned char* dst, size_t ldk, int kd0, float sc, LAS float* scr, int lane) {
#pragma unroll 8
    for (int i = 0; i < 32; ++i) { const int kk = 2 * i + (lane >> 5); scr[kk * 33 + (lane & 31)] = __builtin_nontemporal_load(W + (size_t)(k0 + kk) * ldw + srccol0 + (lane & 31)); }
    LDS_WAIT(); asm volatile("" ::: "memory");
    const int c = lane & 7;
#pragma unroll
    for (int j = 0; j < 4; ++j) { const int n = (lane >> 3) + 8 * j; const LAS float* s_ = scr + (8 * c) * 33 + n;
        u32x2 o; o.x = pk4_fp8(s_[0 * 33] * sc, s_[1 * 33] * sc, s_[2 * 33] * sc, s_[3 * 33] * sc); o.y = pk4_fp8(s_[4 * 33] * sc, s_[5 * 33] * sc, s_[6 * 33] * sc, s_[7 * 33] * sc);
        *(u32x2*)(dst + (size_t)n * ldk + kd0 + 8 * c) = o; }
    LDS_WAIT(); asm volatile("" ::: "memory");
}
__device__ __forceinline__ void phase_prologue(Frame& F) {
    LAS float* scr = (LAS float*)(F.lds + F.wave * 16384);
    const int gw = F.bid * NWAVES + F.wave, NGW = F.G * NWAVES;
    constexpr int I_IN = 16 * (NZ / 32);
    constexpr int I_BR = (4 + 8 + 4) * 32;
    constexpr int I_OUT = 16 * 32;
    constexpr int I_GU = 16 * 64;
    constexpr int I_DN = 16 * 32;
    constexpr int T_IN = DEPTH * I_IN, T_BR = DEPTH * I_BR, T_OUT = DEPTH * I_OUT, T_GU = DEPTH * NEXP * I_GU, T_DN = DEPTH * NEXP * I_DN;
    constexpr int NITEMS = T_IN + T_BR + T_OUT + T_GU + T_DN;
    for (int it = gw; it < NITEMS; it += NGW) {
        int r = it;
        if (r < T_IN) { const int l = r / I_IN; r %= I_IN; const int kb = r / (NZ / 32), nb = r % (NZ / 32); const int n0 = nb * 32, src = n0 < 2304 ? n0 : n0 + 16;
            if (n0 < NZ_BF) transpose_item(F.in[IN_WIN] + (size_t)l * D * 5904, 5904, kb * 64, src, (bf16_t*)(F.ws + WS_WIN) + ((size_t)l * NZ + n0) * D, D, kb * 64, scr, F.lane);
            else transpose_item_fp8(F.in[IN_WIN] + (size_t)l * D * 5904, 5904, kb * 64, src, (unsigned char*)(F.ws + WS_WIN8) + ((size_t)l * NZ_F8 + (n0 - NZ_BF)) * D, D, kb * 64, F8S_WGU, scr, F.lane);
            continue; }
        r -= T_IN;
        if (r < T_BR) { const int l = r / I_BR; r %= I_BR; const int kb = r / 32, nb = r % 32;
            const float* W; int ksrc;
            if (kb < 4) { W = F.in[IN_WBP] + (size_t)l * 256 * D; ksrc = kb * 64; } else if (kb < 12) { W = F.in[IN_WBM] + (size_t)l * 512 * D; ksrc = (kb - 4) * 64; } else { W = F.in[IN_WBS] + (size_t)l * 256 * D; ksrc = (kb - 12) * 64; }
            transpose_item(W, D, ksrc, nb * 32, (bf16_t*)(F.ws + WS_WBR) + ((size_t)l * D + nb * 32) * D, D, kb * 64, scr, F.lane); continue; }
        r -= T_BR;
        if (r < T_OUT) { const int l = r / I_OUT; r %= I_OUT; const int kb = r / 32, nb = r % 32;
            transpose_item(F.in[IN_WOUT] + (size_t)l * D * D, D, kb * 64, nb * 32, (bf16_t*)(F.ws + WS_WOUT) + ((size_t)l * D + nb * 32) * D, D, kb * 64, scr, F.lane); continue; }
        r -= T_OUT;
        if (r < T_GU) { const int le = r / I_GU; r %= I_GU; const int kb = r / 64, nb = r % 64; const int n0 = nb * 32;
            const int pn = n0 >> 8, c = n0 & 255; const int src = c < 128 ? (128 * pn + c) : (1024 + 128 * pn + c - 128);
            transpose_item_fp8(F.in[IN_WGU] + (size_t)le * D * 2048, 2048, kb * 64, src, (unsigned char*)(F.ws + WS_WGU) + ((size_t)le * 2048 + n0) * D, D, kb * 64, F8S_WGU, scr, F.lane); continue; }
        r -= T_GU;
        { const int le = r / I_DN; r %= I_DN; const int kb = r / 32, nb = r % 32;
            transpose_item_fp8(F.in[IN_WDN] + (size_t)le * D * D, D, kb * 64, nb * 32, (unsigned char*)(F.ws + WS_WDN) + ((size_t)le * D + nb * 32) * D, D, kb * 64, F8S_WDN, scr, F.lane); }
    }
    { const int gt = F.bid * NTHREADS + F.tid, NGT = F.G * NTHREADS;
      for (int i = gt; i < DEPTH * 16 * 1024; i += NGT) { const int l = i >> 14, g = (i >> 10) & 15, k = i & 1023; ((float*)(F.ws + WS_WG))[i] = F.in[IN_WIN][((size_t)l * D + k) * 5904 + 2304 + g]; }
      for (int i = gt; i < DEPTH * 4 * 128 * 128; i += NGT) ((bf16_t*)(F.ws + WS_WSGU))[i] = (bf16_t)f2bf(F.in[IN_SGUW][i]);
      for (int i = gt; i < DEPTH * 4 * 64 * 64; i += NGT) { const int lg = i >> 12, d = (i >> 6) & 63, c = i & 63; ((bf16_t*)(F.ws + WS_WPOOL))[i] = (bf16_t)f2bf(F.in[IN_POOLW][(size_t)lg * 4096 + c * 64 + d]); } }
    __syncthreads();
    { LAS float* sc = (LAS float*)F.lds;
      LAS float* part = (LAS float*)(F.lds + 71680);
      for (int i = F.tid; i < 17 * 1024; i += NTHREADS) { const int r = i >> 10, k = i & 1023; const float v = r < 16 ? F.in[IN_C][r * 1024 + k] : F.in[IN_CCTX][k]; sc[i] = siluf_(v); }
      __syncthreads();
      for (int u = F.bid; u < DEPTH * 48; u += F.G) {
          const int l = u / 48, n0 = (u % 48) * 128, col = F.tid & 127, ks = F.tid >> 7;
          float a[17];
#pragma unroll
          for (int r = 0; r < 17; ++r) a[r] = 0.f;
          const float* W = F.in[IN_WADA] + (size_t)l * D * 6144 + n0 + col;
          for (int k = ks * 256; k < ks * 256 + 256; ++k) { const float w = W[(size_t)k * 6144];
#pragma unroll
              for (int r = 0; r < 17; ++r) a[r] += sc[r * 1024 + k] * w; }
#pragma unroll
          for (int r = 0; r < 17; ++r) part[(ks * 17 + r) * 128 + col] = a[r];
          __syncthreads();
          for (int i = F.tid; i < 17 * 128; i += NTHREADS) { const int r = i >> 7, cc = i & 127;
              const float s = part[(0 * 17 + r) * 128 + cc] + part[(1 * 17 + r) * 128 + cc] + part[(2 * 17 + r) * 128 + cc] + part[(3 * 17 + r) * 128 + cc] + F.in[IN_BADA][l * 6144 + n0 + cc];
              ((float*)(F.ws + WS_MOD))[(size_t)(l * 17 + r) * 6144 + n0 + cc] = s; }
          __syncthreads();
      } }
}

struct RowV { f32x4 v[4]; };
#define RC(lane, j) (8 * (lane) + 512 * ((j) >> 1) + 4 * ((j) & 1))
__device__ __forceinline__ void row_load(RowV& r, const float* p, int lane) {
#pragma unroll
    for (int j = 0; j < 4; ++j) r.v[j] = __builtin_nontemporal_load((const f32x4*)(p + RC(lane, j)));
}
__device__ __forceinline__ void row_load_bf16(RowV& r, const bf16_t* p, int lane) {
#pragma unroll
    for (int h = 0; h < 2; ++h) { const u32x4 w = __builtin_nontemporal_load((const u32x4*)(p + 8 * lane + 512 * h)); r.v[2 * h] = (f32x4){bflo(w.x), bfhi(w.x), bflo(w.y), bfhi(w.y)}; r.v[2 * h + 1] = (f32x4){bflo(w.z), bfhi(w.z), bflo(w.w), bfhi(w.w)}; }
}
__device__ __forceinline__ void row_store(const RowV& r, float* p, int lane) {
#pragma unroll
    for (int j = 0; j < 4; ++j) *(f32x4*)(p + RC(lane, j)) = r.v[j];
}
__device__ __forceinline__ void row_store_nt(const RowV& r, float* p, int lane) {
#pragma unroll
    for (int j = 0; j < 4; ++j) __builtin_nontemporal_store(r.v[j], (f32x4*)(p + RC(lane, j)));
}
__device__ __forceinline__ void row_store_bf16_nt(const RowV& r, bf16_t* p, int lane) {
#pragma unroll
    for (int h = 0; h < 2; ++h) { u32x4 w; w.x = pk2(r.v[2 * h].x, r.v[2 * h].y); w.y = pk2(r.v[2 * h].z, r.v[2 * h].w); w.z = pk2(r.v[2 * h + 1].x, r.v[2 * h + 1].y); w.w = pk2(r.v[2 * h + 1].z, r.v[2 * h + 1].w); __builtin_nontemporal_store(w, (u32x4*)(p + 8 * lane + 512 * h)); }
}
__device__ __forceinline__ void row_store_bf16(const RowV& r, bf16_t* p, int lane) {
#pragma unroll
    for (int h = 0; h < 2; ++h) { u32x4 w; w.x = pk2(r.v[2 * h].x, r.v[2 * h].y); w.y = pk2(r.v[2 * h].z, r.v[2 * h].w); w.z = pk2(r.v[2 * h + 1].x, r.v[2 * h + 1].y); w.w = pk2(r.v[2 * h + 1].z, r.v[2 * h + 1].w); *(u32x4*)(p + 8 * lane + 512 * h) = w; }
}
__device__ __forceinline__ void row_ln_plain(RowV& r, int lane) {
    float s = 0.f;
#pragma unroll
    for (int j = 0; j < 4; ++j) s += (r.v[j].x + r.v[j].y) + (r.v[j].z + r.v[j].w);
    const float mean = wave_sum(s, lane) * (1.f / D); float s2 = 0.f;
#pragma unroll
    for (int j = 0; j < 4; ++j) { r.v[j] = r.v[j] - mean; s2 += (r.v[j].x * r.v[j].x + r.v[j].y * r.v[j].y) + (r.v[j].z * r.v[j].z + r.v[j].w * r.v[j].w); }
    const float rstd = __builtin_amdgcn_rsqf(wave_sum(s2, lane) * (1.f / D) + LN_EPS);
#pragma unroll
    for (int j = 0; j < 4; ++j) r.v[j] = r.v[j] * rstd;
}
__device__ __forceinline__ void row_affine(RowV& r, const float* g, const float* b, int lane) {
#pragma unroll
    for (int j = 0; j < 4; ++j) { const f32x4 gg = *(const f32x4*)(g + RC(lane, j)), bb = *(const f32x4*)(b + RC(lane, j)); r.v[j] = r.v[j] * gg + bb; }
}
__device__ __forceinline__ void row_modulate(RowV& r, const float* sh, const float* sc, int lane) {
#pragma unroll
    for (int j = 0; j < 4; ++j) { const f32x4 s1 = *(const f32x4*)(sc + RC(lane, j)), s0 = *(const f32x4*)(sh + RC(lane, j)); r.v[j] = r.v[j] * (s1 + 1.0f) + s0; }
}
__device__ __forceinline__ LAS float* pv_slot(const Frame& F, int slot) { return (LAS float*)(F.lds + NW_PV) + slot * 1024; }
__device__ __forceinline__ void pv_fill(Frame& F, int slot, const float* src) { LAS f32x4* d = (LAS f32x4*)pv_slot(F, slot); for (int i = F.tid; i < 256; i += NTHREADS) d[i] = *(const f32x4*)(src + 4 * i); }
__device__ __forceinline__ void row_affine_l(RowV& r, const LAS float* g, const LAS float* b, int lane) {
#pragma unroll
    for (int j = 0; j < 4; ++j) { const f32x4 gg = *(const LAS f32x4*)(g + RC(lane, j)), bb = *(const LAS f32x4*)(b + RC(lane, j)); r.v[j] = r.v[j] * gg + bb; }
}
__device__ __forceinline__ void row_modulate_l(RowV& r, const LAS float* sh, const LAS float* sc, int lane) {
#pragma unroll
    for (int j = 0; j < 4; ++j) { const f32x4 s1 = *(const LAS f32x4*)(sc + RC(lane, j)), s0 = *(const LAS f32x4*)(sh + RC(lane, j)); r.v[j] = r.v[j] * (s1 + 1.0f) + s0; }
}
__device__ __forceinline__ void ln0_row(Frame& F, int row, RowV xr, const LAS float* sh, const LAS float* sc) {
    row_ln_plain(xr, F.lane);
    row_modulate_l(xr, sh, sc, F.lane);
    row_store_bf16(xr, (bf16_t*)(F.ws + WS_H) + (size_t)row * D, F.lane);
    { unsigned char* h8 = (unsigned char*)(F.ws + WS_H8) + (size_t)row * D + 8 * F.lane;
#pragma unroll
      for (int h = 0; h < 2; ++h) { u32x2 w; w.x = pk4_fp8(xr.v[2 * h].x * F8S_ACT, xr.v[2 * h].y * F8S_ACT, xr.v[2 * h].z * F8S_ACT, xr.v[2 * h].w * F8S_ACT); w.y = pk4_fp8(xr.v[2 * h + 1].x * F8S_ACT, xr.v[2 * h + 1].y * F8S_ACT, xr.v[2 * h + 1].z * F8S_ACT, xr.v[2 * h + 1].w * F8S_ACT); *(u32x2*)(h8 + 512 * h) = w; } }
}
__device__ __forceinline__ LAS float* narrow_tile_wave(Frame& F, const bf16_t* A) {
    const int r = F.lane & 31, h = F.lane >> 5;
    f32x16 acc;
#pragma unroll
    for (int i = 0; i < 16; ++i) acc[i] = 0.f;
    const bf16_t* ap = A + (size_t)r * D + 8 * h;
    const LAS unsigned char* bp = F.lds + NW_WT + r * 2064 + 16 * h;
    bf16x8 av[2][16];
#pragma unroll
    for (int ks = 0; ks < 16; ++ks) av[0][ks] = *(const bf16x8*)(ap + ks * 16);
#pragma unroll
    for (int kb = 0; kb < 4; ++kb) {
        if (kb < 3) {
#pragma unroll
            for (int ks = 0; ks < 16; ++ks) av[(kb + 1) & 1][ks] = *(const bf16x8*)(ap + ((kb + 1) * 16 + ks) * 16); }
        __builtin_amdgcn_sched_barrier(0);
#pragma unroll
        for (int ks = 0; ks < 16; ++ks) { const bf16x8 b = *(const LAS bf16x8*)(bp + (kb * 16 + ks) * 32); acc = __builtin_amdgcn_mfma_f32_32x32x16_bf16(av[kb & 1][ks], b, acc, 0, 0, 0); }
        __builtin_amdgcn_sched_barrier(0);
    }
    LAS float* lg = (LAS float*)(F.lds + NW_LG) + F.wave * 1056;
#pragma unroll
    for (int i = 0; i < 16; ++i) lg[((i & 3) + 8 * (i >> 2) + 4 * h) * 33 + r] = acc[i];
    asm volatile("s_waitcnt lgkmcnt(0)" ::: "memory");
    return lg;
}
__device__ __forceinline__ void tile_range(const Frame& F, int mrows, int& t_lo, int& t_hi) { const int nt = mrows / 32; t_lo = (int)(((long)F.bid * nt) / F.G); t_hi = (int)(((long)(F.bid + 1) * nt) / F.G); }
__device__ __forceinline__ void load_wg_lds(Frame& F, int l) {
    const float* src = (const float*)(F.ws + WS_WG) + (size_t)l * 16384;
    for (int i = F.tid; i < 32 * 128; i += NTHREADS) { const int g = i >> 7, c8 = i & 127; u32x4 w = (u32x4){0u, 0u, 0u, 0u};
        if (g < 16) { const f32x4 a = *(const f32x4*)(src + g * 1024 + c8 * 8), b = *(const f32x4*)(src + g * 1024 + c8 * 8 + 4); w.x = pk2(a.x, a.y); w.y = pk2(a.z, a.w); w.z = pk2(b.x, b.y); w.w = pk2(b.z, b.w); }
        *(LAS u32x4*)(F.lds + NW_WT + g * 2064 + c8 * 16) = w; }
    __syncthreads();
}
__device__ __forceinline__ void gates_tail(Frame& F, int l, int t_lo, int t_hi) {
    asm volatile("s_waitcnt vmcnt(0)" ::: "memory"); __syncthreads();
    const int g = F.lane & 15; const float bias = F.in[IN_BIN][l * 5904 + 2304 + g];
    for (int tile = t_lo + F.wave; tile < t_hi; tile += NWAVES) {
        const LAS float* lg = narrow_tile_wave(F, (const bf16_t*)(F.ws + WS_H) + (size_t)tile * 32 * D);
#pragma unroll
        for (int rr = 0; rr < 8; ++rr) { const int row = rr * 4 + (F.lane >> 4); ((float*)(F.ws + WS_ZG))[(size_t)(tile * 32 + row) * 16 + g] = lg[row * 33 + g] + bias; }
        asm volatile("s_waitcnt lgkmcnt(0)" ::: "memory");
    }
}

using pg8::Unit;
struct ProbPlain {
    static constexpr bool GATHER = false, FP8 = false; static constexpr int SCALE_A = 127, SCALE_B = 127; const bf16_t* A; const bf16_t* Bt; int lda, ldb;
    __device__ __forceinline__ int nt(const Unit&) const { return lda / 64; }
    __device__ __forceinline__ const char* a_base(const Unit& u) const { return (const char*)A + (size_t)u.pm * 256 * lda * 2; }
    __device__ __forceinline__ const char* b_base(const Unit& u) const { return (const char*)Bt + (size_t)u.pn * 256 * ldb * 2; }
    __device__ __forceinline__ void a_tok(const Unit&, const int (&)[2], int (&)[2][2]) const {}
    __device__ __forceinline__ void a_off(const int (&)[2][2], const int (&)[2], unsigned (&)[2][2]) const {}
    __device__ __forceinline__ void a_rows(const Unit&, const int (&)[2], const int (&)[2], unsigned (&)[2][2]) const {}
};
struct ProbPlainF8 {
    static constexpr bool GATHER = false, FP8 = true; static constexpr int SCALE_A = F8E_ACT, SCALE_B = F8E_WGU; const bf16_t* A; const bf16_t* Bt; int lda, ldb;
    __device__ __forceinline__ int nt(const Unit&) const { return lda / 64; }
    __device__ __forceinline__ const char* a_base(const Unit& u) const { return (const char*)A + (size_t)u.pm * 256 * lda * 2; }
    __device__ __forceinline__ const char* b_base(const Unit& u) const { return (const char*)Bt + (size_t)u.pn * 256 * ldb * 2; }
    __device__ __forceinline__ void a_tok(const Unit&, const int (&)[2], int (&)[2][2]) const {}
    __device__ __forceinline__ void a_off(const int (&)[2][2], const int (&)[2], unsigned (&)[2][2]) const {}
    __device__ __forceinline__ void a_rows(const Unit&, const int (&)[2], const int (&)[2], unsigned (&)[2][2]) const {}
};
struct ProbBranch {
    static constexpr bool GATHER = false, FP8 = false; static constexpr int SCALE_A = 127, SCALE_B = 127; const bf16_t* A; const bf16_t* Bt; int lda, ldb;
    __device__ __forceinline__ int nt(const Unit& u) const { return u.sub == 1 ? 8 : 4; }
    __device__ __forceinline__ int koff(const Unit& u) const { return u.sub == 0 ? 0 : (u.sub == 1 ? 256 : 768); }
    __device__ __forceinline__ const char* a_base(const Unit& u) const { return (const char*)A + ((size_t)u.pm * 256 * lda + koff(u)) * 2; }
    __device__ __forceinline__ const char* b_base(const Unit& u) const { return (const char*)Bt + ((size_t)u.pn * 256 * ldb + koff(u)) * 2; }
    __device__ __forceinline__ void a_tok(const Unit&, const int (&)[2], int (&)[2][2]) const {}
    __device__ __forceinline__ void a_off(const int (&)[2][2], const int (&)[2], unsigned (&)[2][2]) const {}
    __device__ __forceinline__ void a_rows(const Unit&, const int (&)[2], const int (&)[2], unsigned (&)[2][2]) const {}
};
__device__ __forceinline__ int expert_of(const LAS int* seg, int pm) { return __builtin_amdgcn_readfirstlane((int)((const LAS unsigned char*)(seg + 64))[pm]); }
__device__ __forceinline__ int moe_tables(Frame& F, LAS int* seg) {
    __syncthreads();
    if (F.tid <= NEXP) seg[F.tid] = ((const int*)(F.ws + WS_ROUTE + RT_SEG))[F.tid];
    __syncthreads();
    const int ntile = seg[NEXP] / 256;
    LAS unsigned char* texp = (LAS unsigned char*)(seg + 64);
    for (int t = F.tid; t < ntile; t += NTHREADS) { const int row = t * 256; int e = 0;
#pragma unroll
        for (int i = 1; i < NEXP; ++i) e += (seg[i] <= row) ? 1 : 0;
        texp[t] = (unsigned char)e; }
    __syncthreads();
    return ntile;
}
struct ProbMoe1 {
    static constexpr bool GATHER = true, FP8 = true; static constexpr int SCALE_A = F8E_ACT, SCALE_B = F8E_WGU; const bf16_t* A; const bf16_t* Bt; int lda, ldb; const int* tok; const LAS int* seg;
    __device__ __forceinline__ int nt(const Unit&) const { return lda / 64; }
    __device__ __forceinline__ const char* a_base(const Unit&) const { return (const char*)A; }
    __device__ __forceinline__ const char* b_base(const Unit& u) const { const int e = expert_of(seg, u.pm); return (const char*)Bt + ((size_t)e * 2048 + (size_t)u.pn * 256) * ldb * 2; }
    __device__ __forceinline__ void a_rows(const Unit& u, const int (&R)[2], const int (&C)[2], unsigned (&off)[2][2]) const {
#pragma unroll
        for (int h = 0; h < 2; ++h)
#pragma unroll
            for (int i = 0; i < 2; ++i) { const int t = tok[u.pm * 256 + h * 128 + R[i]]; off[h][i] = (unsigned)(t * lda + C[i]) * 2u; } }
    __device__ __forceinline__ void a_tok(const Unit& u, const int (&R)[2], int (&tk)[2][2]) const {
#pragma unroll
        for (int h = 0; h < 2; ++h)
#pragma unroll
            for (int i = 0; i < 2; ++i) tk[h][i] = tok[u.pm * 256 + h * 128 + R[i]]; }
    __device__ __forceinline__ void a_off(const int (&tk)[2][2], const int (&C)[2], unsigned (&off)[2][2]) const {
#pragma unroll
        for (int h = 0; h < 2; ++h)
#pragma unroll
            for (int i = 0; i < 2; ++i) off[h][i] = (unsigned)(tk[h][i] * lda + C[i]) * 2u; }
};
struct ProbMoe2 {
    static constexpr bool GATHER = false, FP8 = true; static constexpr int SCALE_A = F8E_ACT, SCALE_B = F8E_WDN; const bf16_t* A; const bf16_t* Bt; int lda, ldb; const LAS int* seg;
    __device__ __forceinline__ int nt(const Unit&) const { return lda / 64; }
    __device__ __forceinline__ const char* a_base(const Unit& u) const { return (const char*)A + (size_t)u.pm * 256 * lda * 2; }
    __device__ __forceinline__ const char* b_base(const Unit& u) const { const int e = expert_of(seg, u.pm); return (const char*)Bt + ((size_t)e * 1024 + (size_t)u.pn * 256) * ldb * 2; }
    __device__ __forceinline__ void a_tok(const Unit&, const int (&)[2], int (&)[2][2]) const {}
    __device__ __forceinline__ void a_off(const int (&)[2][2], const int (&)[2], unsigned (&)[2][2]) const {}
    __device__ __forceinline__ void a_rows(const Unit&, const int (&)[2], const int (&)[2], unsigned (&)[2][2]) const {}
};
using pg8::cvt_pk_bf16;
template <bool G8> struct EpiInproj {
    static constexpr bool PERM = true, CHAIN = false, SIDE = true, KHOOK = false; bf16_t* Z; const float* bias; int pn0;
    __device__ __forceinline__ void side(const Unit& u0, unsigned slot, int wid, int lane) const { const int pn = u0.pn + pn0; if (wid == 1) pg8::dma16((unsigned)lane * 16u, bias + pn * 256 + (pn >= 9 ? 16 : 0), slot); }
    __device__ __forceinline__ void operator()(const f32x4 (&acc)[2][2][4][2], const Unit& u0, int wr, int wc, int fr, int fq, const LAS unsigned char* sd) const {
        Unit u = u0; u.pn += pn0;
        int row0 = u.pm * 256 + wr * 64 + fr, col0 = u.pn * 256 + wc * 32 + 8 * fq; asm volatile("" : "+v"(row0), "+v"(col0));
        const int act = (u.pn <= 6) ? 0 : ((u.pn == 9 || u.pn == 10) ? 2 : 1);
        f32x4 bv[2][2];
#pragma unroll
        for (int bj = 0; bj < 2; ++bj)
#pragma unroll
            for (int n = 0; n < 2; ++n) bv[bj][n] = *(const LAS f32x4*)(sd + (bj * 128 + wc * 32 + 8 * fq + 4 * n) * 4);
#pragma unroll
        for (int ai = 0; ai < 2; ++ai)
#pragma unroll
            for (int m = 0; m < 4; ++m) { bf16_t* rowp = Z + (size_t)(row0 + ai * 128 + m * 16) * NZ + col0;
#pragma unroll
                for (int bj = 0; bj < 2; ++bj) { f32x4 v0 = acc[ai][bj][m][0] + bv[bj][0], v1 = acc[ai][bj][m][1] + bv[bj][1];
                    if (G8 && u.pn >= ZG_COL / 256) { u32x2 w8;
                        v0 = sigmoid4(v0) * G8_SCALE; v1 = sigmoid4(v1) * G8_SCALE;
#pragma unroll
                        for (int j = 0; j < 4; ++j) { v0[j] = fmaxf(v0[j], 1.0f); v1[j] = fmaxf(v1[j], 1.0f); }
                        v0 = v0 + 12582912.0f; v1 = v1 + 12582912.0f;
                        w8.x = pk4_u8(v0[0], v0[1], v0[2], v0[3]); w8.y = pk4_u8(v1[0], v1[1], v1[2], v1[3]);
                        *(u32x2*)((unsigned char*)(Z + (size_t)(row0 + ai * 128 + m * 16) * NZ + ZG_COL) + (col0 - ZG_COL) + bj * 128) = w8; continue; }
                    if (act == 2) { f32x2 a = pg8::gelu_pk((f32x2){v0[0], v0[1]}), b = pg8::gelu_pk((f32x2){v0[2], v0[3]}), c = pg8::gelu_pk((f32x2){v1[0], v1[1]}), d = pg8::gelu_pk((f32x2){v1[2], v1[3]});
                        v0 = (f32x4){a.x, a.y, b.x, b.y}; v1 = (f32x4){c.x, c.y, d.x, d.y}; }
                    if (act == 1) { v0 = sigmoid4(v0); v1 = sigmoid4(v1); }
                    u32x4 w; w.x = cvt_pk_bf16(v0[0], v0[1]); w.y = cvt_pk_bf16(v0[2], v0[3]); w.z = cvt_pk_bf16(v1[0], v1[1]); w.w = cvt_pk_bf16(v1[2], v1[3]);
                    *(u32x4*)(rowp + bj * 128) = w; }
                if constexpr (G8) asm volatile("" ::: "memory"); }
    }
};
struct EpiNull {
    static constexpr bool PERM = true, CHAIN = false; bf16_t* Z;
    __device__ __forceinline__ void operator()(const f32x4 (&acc)[2][2][4][2], const Unit& u, int wr, int wc, int fr, int fq) const {
        float sacc = 0.f;
#pragma unroll
        for (int ai = 0; ai < 2; ++ai)
#pragma unroll
            for (int bj = 0; bj < 2; ++bj)
#pragma unroll
                for (int m = 0; m < 4; ++m)
#pragma unroll
                    for (int n = 0; n < 2; ++n) sacc += (acc[ai][bj][m][n][0] + acc[ai][bj][m][n][1]) + (acc[ai][bj][m][n][2] + acc[ai][bj][m][n][3]);
        if (sacc == 1.2345e30f) Z[u.pm + wr + wc + fr + fq] = 0;
    }
};
struct EpiOut {
    static constexpr bool PERM = true, CHAIN = false, SIDE = false, KHOOK = false; bf16_t* T;
    __device__ __forceinline__ void operator()(const f32x4 (&acc)[2][2][4][2], const Unit& u, int wr, int wc, int fr, int fq, const LAS unsigned char*) const {
        int row0 = u.pm * 256 + wr * 64 + fr, col0 = u.pn * 256 + wc * 32 + 8 * fq; asm volatile("" : "+v"(row0), "+v"(col0));
#pragma unroll
        for (int ai = 0; ai < 2; ++ai)
#pragma unroll
            for (int m = 0; m < 4; ++m) { bf16_t* rowp = T + (size_t)(row0 + ai * 128 + m * 16) * D + col0;
#pragma unroll
                for (int bj = 0; bj < 2; ++bj) { const f32x4 v0 = acc[ai][bj][m][0], v1 = acc[ai][bj][m][1];
                    u32x4 w; w.x = cvt_pk_bf16(v0[0], v0[1]); w.y = cvt_pk_bf16(v0[2], v0[3]); w.z = cvt_pk_bf16(v1[0], v1[1]); w.w = cvt_pk_bf16(v1[2], v1[3]);
                    *(u32x4*)(rowp + bj * 128) = w; } }
    }
};
struct EpiBranch {
    static constexpr bool PERM = true, CHAIN = false, SIDE = false, KHOOK = true; static constexpr int HOOK_T0 = 4, HOOK_T1 = 12;
    const bf16_t* Z; bf16_t* Y;
    template <bool FIN> __device__ __forceinline__ void apply(f32x4 (&acc)[2][2][4][2], const Unit& u, int br, int wr, int wc, int fr, int fq) const {
        int row0 = u.pm * 256 + wr * 64 + fr, col0 = u.pn * 256 + wc * 32 + 8 * fq;
        asm volatile("" : "+v"(row0), "+v"(col0));
#pragma unroll
        for (int ai = 0; ai < 2; ++ai) {
            u32x2 ga[4][2], gb[4][2];
#pragma unroll
            for (int m = 0; m < 4; ++m) { const unsigned char* rowp = (const unsigned char*)(Z + (size_t)(row0 + ai * 128 + m * 16) * NZ + ZG_COL) + br * 1024 + col0;
#pragma unroll
                for (int bj = 0; bj < 2; ++bj) { ga[m][bj] = *(const u32x2*)(rowp + bj * 128); if (!FIN) gb[m][bj] = *(const u32x2*)(rowp + 1024 + bj * 128); } }
#pragma unroll
            for (int m = 0; m < 4; ++m) { const size_t row = (size_t)(row0 + ai * 128 + m * 16);
#pragma unroll
                for (int bj = 0; bj < 2; ++bj) { const u32x2 a = ga[m][bj];
                    f32x4 r0 = u8x4_f32(a.x), r1 = u8x4_f32(a.y);
                    if (FIN) { r0 = r0 * (1.0f / G8_SCALE); r1 = r1 * (1.0f / G8_SCALE); }
                    else { const u32x2 b = gb[m][bj]; f32x4 q0 = u8x4_f32(b.x), q1 = u8x4_f32(b.y);
#pragma unroll
                        for (int i = 0; i < 4; ++i) { q0[i] = __builtin_amdgcn_rcpf(q0[i]); q1[i] = __builtin_amdgcn_rcpf(q1[i]); }
                        r0 = r0 * q0; r1 = r1 * q1; }
                    acc[ai][bj][m][0] = acc[ai][bj][m][0] * r0; acc[ai][bj][m][1] = acc[ai][bj][m][1] * r1;
                    if (FIN) { const f32x4 v0 = acc[ai][bj][m][0], v1 = acc[ai][bj][m][1];
                        u32x4 w; w.x = cvt_pk_bf16(v0[0], v0[1]); w.y = cvt_pk_bf16(v0[2], v0[3]); w.z = cvt_pk_bf16(v1[0], v1[1]); w.w = cvt_pk_bf16(v1[2], v1[3]);
                        *(u32x4*)(Y + row * D + col0 + bj * 128) = w; } } }
            asm volatile("" ::: "memory"); }
    }
    __device__ __forceinline__ void hook(f32x4 (&acc)[2][2][4][2], const Unit& u, int br, int wr, int wc, int fr, int fq) const { apply<false>(acc, u, br, wr, wc, fr, fq); }
    __device__ __forceinline__ void operator()(f32x4 (&acc)[2][2][4][2], const Unit& u, int wr, int wc, int fr, int fq, const LAS unsigned char*) const { apply<true>(acc, u, 2, wr, wc, fr, fq); }
};
struct EpiSwiglu {
    static constexpr bool PERM = true, CHAIN = false, SIDE = true, KHOOK = false; unsigned char* HID; const float* bgu; const LAS int* seg;
    __device__ __forceinline__ void side(const Unit& u, unsigned slot, int wid, int lane) const {
        if (wid == 1) { const int e = expert_of(seg, u.pm); pg8::dma16(lane < 32 ? (unsigned)lane * 16u : 4096u + (unsigned)(lane - 32) * 16u, bgu + (size_t)e * 2048 + u.pn * 128, slot); } }
    __device__ __forceinline__ void operator()(const f32x4 (&acc)[2][2][4][2], const Unit& u, int wr, int wc, int fr, int fq, const LAS unsigned char* sd) const {
        int j0 = u.pn * 128 + wc * 32 + 8 * fq, slot0 = u.pm * 256 + wr * 64 + fr; asm volatile("" : "+v"(j0), "+v"(slot0));
        f32x4 bg[2], bu[2];
#pragma unroll
        for (int n = 0; n < 2; ++n) { bg[n] = *(const LAS f32x4*)(sd + (wc * 32 + 8 * fq + 4 * n) * 4); bu[n] = *(const LAS f32x4*)(sd + (128 + wc * 32 + 8 * fq + 4 * n) * 4); }
#pragma unroll
        for (int ai = 0; ai < 2; ++ai)
#pragma unroll
            for (int m = 0; m < 4; ++m) { const size_t slot = (size_t)(slot0 + ai * 128 + m * 16); f32x4 o[2];
#pragma unroll
                for (int n = 0; n < 2; ++n) { f32x4 g = acc[ai][0][m][n] + bg[n], up = acc[ai][1][m][n] + bu[n];
#pragma unroll
                    for (int i = 0; i < 4; ++i) { g[i] = fminf(g[i], 7.0f); up[i] = __builtin_amdgcn_fmed3f(up[i], -7.0f, 7.0f); }
                    f32x4 t = g * (-1.702f * 1.4426950408889634f);
#pragma unroll
                    for (int i = 0; i < 4; ++i) t[i] = __builtin_amdgcn_exp2f(t[i]);
                    t = t + 1.0f;
#pragma unroll
                    for (int i = 0; i < 4; ++i) t[i] = __builtin_amdgcn_rcpf(t[i]);
                    o[n] = (up * F8S_ACT + F8S_ACT) * (g * t); }
                u32x2 w; w.x = pk4_fp8(o[0][0], o[0][1], o[0][2], o[0][3]); w.y = pk4_fp8(o[1][0], o[1][1], o[1][2], o[1][3]);
                *(u32x2*)(HID + slot * 1024 + j0) = w; }
    }
};
struct EpiDown {
    static constexpr bool PERM = true, CHAIN = false, SIDE = true, KHOOK = false; unsigned char* FS; const float* bdn; const int* dest; const float* pslot; const LAS int* seg;
    __device__ __forceinline__ void side(const Unit& u, unsigned slot, int wid, int lane) const {
        if (wid == 1) { const int e = expert_of(seg, u.pm); pg8::dma16((unsigned)lane * 16u, bdn + (size_t)e * 1024 + u.pn * 256, slot); }
        if (wid == 2) pg8::dma16((unsigned)lane * 16u, dest + (size_t)u.pm * 256, slot + 1024u);
        if (wid == 3) pg8::dma16((unsigned)lane * 16u, pslot + (size_t)u.pm * 256, slot + 2048u); }
    __device__ __forceinline__ void operator()(const f32x4 (&acc)[2][2][4][2], const Unit& u, int wr, int wc, int fr, int fq, const LAS unsigned char* sd) const {
        int col0 = u.pn * 256 + wc * 32 + 8 * fq, slot0 = u.pm * 256 + wr * 64 + fr; asm volatile("" : "+v"(col0), "+v"(slot0));
        f32x4 bv[2][2];
#pragma unroll
        for (int bj = 0; bj < 2; ++bj)
#pragma unroll
            for (int n = 0; n < 2; ++n) bv[bj][n] = *(const LAS f32x4*)(sd + (bj * 128 + wc * 32 + 8 * fq + 4 * n) * 4);
#pragma unroll
        for (int ai = 0; ai < 2; ++ai)
#pragma unroll
            for (int m = 0; m < 4; ++m) { const int rt = ai * 128 + wr * 64 + m * 16 + fr; const int d = *(const LAS int*)(sd + 1024 + rt * 4); const float p = *(const LAS float*)(sd + 2048 + rt * 4) * FS_SCALE;
                if (d >= 0) {
#pragma unroll
                    for (int bj = 0; bj < 2; ++bj) { f32x4 v0 = (acc[ai][bj][m][0] + bv[bj][0]) * p, v1 = (acc[ai][bj][m][1] + bv[bj][1]) * p;
#pragma unroll
                        for (int i = 0; i < 4; ++i) { v0[i] = __builtin_amdgcn_fmed3f(v0[i], -FS_CLAMP, FS_CLAMP); v1[i] = __builtin_amdgcn_fmed3f(v1[i], -FS_CLAMP, FS_CLAMP); }
                        u32x2 w; w.x = pk4_fp8(v0[0], v0[1], v0[2], v0[3]); w.y = pk4_fp8(v1[0], v1[1], v1[2], v1[3]);
                        *(u32x2*)(FS + (size_t)d * 1024 + col0 + bj * 128) = w; } }
                asm volatile("" ::: "memory"); }
    }
};

__device__ __forceinline__ const float* xin_row(const Frame& F, int row) { return row < ML ? F.in[IN_X] + (size_t)row * D : F.in[IN_CTX] + (size_t)(row - ML) * D; }
__device__ __forceinline__ void phase_ln0_first(Frame& F) {
    int t_lo, t_hi; tile_range(F, MT, t_lo, t_hi);
    const int r_lo = 32 * t_lo, nrows = 32 * (t_hi - t_lo);
    const int mrA = mod_row(r_lo), mrB = mod_row(r_lo + (nrows > 0 ? nrows - 1 : 0));
    { const float* mb = (const float*)(F.ws + WS_MOD); pv_fill(F, 0, mb + ((size_t)(0 * 17 + mrA) * 6 + 0) * 1024); pv_fill(F, 1, mb + ((size_t)(0 * 17 + mrB) * 6 + 0) * 1024);
      pv_fill(F, 2, mb + ((size_t)(0 * 17 + mrA) * 6 + 1) * 1024); pv_fill(F, 3, mb + ((size_t)(0 * 17 + mrB) * 6 + 1) * 1024); }
    load_wg_lds(F, 0);
    for (int n = F.wave; n < nrows; n += 4 * NWAVES) {
        RowV rv[4];
#pragma unroll
        for (int u = 0; u < 4; ++u) if (n + u * NWAVES < nrows) row_load(rv[u], xin_row(F, r_lo + n + u * NWAVES), F.lane);
#pragma unroll
        for (int u = 0; u < 4; ++u) if (n + u * NWAVES < nrows) { const int row = r_lo + n + u * NWAVES;
            const int sel = (mod_row(row) == mrA) ? 0 : 1; ln0_row(F, row, rv[u], pv_slot(F, 0 + sel), pv_slot(F, 2 + sel)); }
    }
    gates_tail(F, 0, t_lo, t_hi);
    __syncthreads();
}
__device__ __forceinline__ void phase_finalize(Frame& F, int l, int mrows) {
    const int gw = F.bid * NWAVES + F.wave, NGW = F.G * NWAVES;
    const bf16_t* hf = (const bf16_t*)(F.ws + WS_HFB); const bf16_t* hb = hf + (size_t)MT * 512;
    const float* ng = F.in[IN_MNG] + l * 512 + 8 * F.lane;
    const f32x4 g0 = *(const f32x4*)ng, g1 = *(const f32x4*)(ng + 4);
    const bf16_t* zo = (const bf16_t*)(F.ws + WS_Z) + ZC_O + 8 * F.lane;
    u32x4 ha = (u32x4){0u, 0u, 0u, 0u}, hbv = ha, so = ha;
    if (gw < mrows) { ha = __builtin_nontemporal_load((const u32x4*)(hf + (size_t)gw * 512 + 8 * F.lane)); hbv = __builtin_nontemporal_load((const u32x4*)(hb + (size_t)gw * 512 + 8 * F.lane)); so = __builtin_nontemporal_load((const u32x4*)(zo + (size_t)gw * NZ)); }
    for (int row = gw; row < mrows; row += NGW) {
        u32x4 han = ha, hbn = hbv, son = so; const int rn = row + NGW;
        if (rn < mrows) { han = __builtin_nontemporal_load((const u32x4*)(hf + (size_t)rn * 512 + 8 * F.lane)); hbn = __builtin_nontemporal_load((const u32x4*)(hb + (size_t)rn * 512 + 8 * F.lane)); son = __builtin_nontemporal_load((const u32x4*)(zo + (size_t)rn * NZ)); }
        __builtin_amdgcn_sched_barrier(0);
        f32x4 v0 = (f32x4){bflo(ha.x) + bflo(hbv.x), bfhi(ha.x) + bfhi(hbv.x), bflo(ha.y) + bflo(hbv.y), bfhi(ha.y) + bfhi(hbv.y)}, v1 = (f32x4){bflo(ha.z) + bflo(hbv.z), bfhi(ha.z) + bfhi(hbv.z), bflo(ha.w) + bflo(hbv.w), bfhi(ha.w) + bfhi(hbv.w)};
        float s = (v0.x + v0.y) + (v0.z + v0.w) + (v1.x + v1.y) + (v1.z + v1.w);
#pragma unroll
        for (int o = 0; o < 1; ++o) s = row16_sum(s);
        const float mu = s * (1.f / 128.f); v0 = v0 - mu; v1 = v1 - mu;
        float q = (v0.x * v0.x + v0.y * v0.y) + (v0.z * v0.z + v0.w * v0.w) + (v1.x * v1.x + v1.y * v1.y) + (v1.z * v1.z + v1.w * v1.w);
#pragma unroll
        for (int o = 0; o < 1; ++o) q = row16_sum(q);
        const float rstd = __builtin_amdgcn_rsqf(q * (1.f / 128.f) + HEAD_EPS);
        v0 = v0 * rstd * g0; v1 = v1 * rstd * g1;
        u32x4 w; w.x = pk2(v0.x * bflo(so.x), v0.y * bfhi(so.x)); w.y = pk2(v0.z * bflo(so.y), v0.w * bfhi(so.y)); w.z = pk2(v1.x * bflo(so.z), v1.y * bfhi(so.z)); w.w = pk2(v1.z * bflo(so.w), v1.w * bfhi(so.w));
        *(u32x4*)((bf16_t*)(F.ws + WS_BRA) + (size_t)row * D + 256 + 8 * F.lane) = w;
        ha = han; hbv = hbn; so = son;
    }
}
__device__ __forceinline__ void phase_ln1_router(Frame& F, int l, int mrows) {
    LAS int* cnt = (LAS int*)(F.lds + NW_END);
    { const float* wr = F.in[IN_WR] + (size_t)l * D * NEXP;
      for (int i = F.tid; i < NEXP * D; i += NTHREADS) { const int k = i >> 5, e = i & 31; *(LAS bf16_t*)(F.lds + NW_WT + e * 2064 + k * 2) = (bf16_t)f2bf(wr[i]); }
      if (F.tid < NEXP) cnt[F.tid] = 0; }
    const float* brt = F.in[IN_BR] + l * NEXP;
    int t_lo, t_hi; tile_range(F, mrows, t_lo, t_hi);
    const int r_lo = 32 * t_lo, nrows = 32 * (t_hi - t_lo);
    const int mrA = mod_row(r_lo), mrB = mod_row(r_lo + (nrows > 0 ? nrows - 1 : 0));
    { const float* mb = (const float*)(F.ws + WS_MOD); pv_fill(F, 0, F.in[IN_LN1G] + l * D); pv_fill(F, 1, F.in[IN_LN1B] + l * D);
      pv_fill(F, 2, mb + ((size_t)(l * 17 + mrA) * 6 + 2) * 1024); pv_fill(F, 3, mb + ((size_t)(l * 17 + mrB) * 6 + 2) * 1024);
      pv_fill(F, 4, mb + ((size_t)(l * 17 + mrA) * 6 + 3) * 1024); pv_fill(F, 5, mb + ((size_t)(l * 17 + mrB) * 6 + 3) * 1024);
      pv_fill(F, 6, mb + ((size_t)(l * 17 + mrA) * 6 + 4) * 1024); pv_fill(F, 7, mb + ((size_t)(l * 17 + mrB) * 6 + 4) * 1024); }
    __syncthreads();
    { const bf16_t* yb = (const bf16_t*)(F.ws + WS_T) + 8 * F.lane;
      RowV rv[2]; u32x4 yv2[2][2];
#pragma unroll
      for (int u = 0; u < 2; ++u) {
#pragma unroll
          for (int j = 0; j < 4; ++j) rv[u].v[j] = (f32x4){0.f, 0.f, 0.f, 0.f};
          yv2[u][0] = yv2[u][1] = (u32x4){0u, 0u, 0u, 0u}; }
#define RT_LOADPAIR(n_, rv_, yv_) do { _Pragma("unroll") for (int u = 0; u < 2; ++u) if ((n_) + u * NWAVES < nrows) { const int row = r_lo + (n_) + u * NWAVES; \
              if (l == 0) row_load(rv_[u], xin_row(F, row), F.lane); else row_load_bf16(rv_[u], (const bf16_t*)(F.ws + WS_X) + (size_t)row * D, F.lane); \
              _Pragma("unroll") for (int h = 0; h < 2; ++h) yv_[u][h] = __builtin_nontemporal_load((const u32x4*)(yb + (size_t)row * D + 512 * h)); } } while (0)
      RT_LOADPAIR(F.wave, rv, yv2);
      for (int n = F.wave; n < nrows; n += 2 * NWAVES) {
          RowV rvn[2]; u32x4 yvn[2][2];
#pragma unroll
          for (int u = 0; u < 2; ++u) { rvn[u] = rv[u]; yvn[u][0] = yv2[u][0]; yvn[u][1] = yv2[u][1]; }
          RT_LOADPAIR(n + 2 * NWAVES, rvn, yvn);
          __builtin_amdgcn_sched_barrier(0);
#pragma unroll
          for (int u = 0; u < 2; ++u) if (n + u * NWAVES < nrows) { const int row = r_lo + n + u * NWAVES; RowV cur = rv[u];
              const int sel = (mod_row(row) == mrA) ? 0 : 1;
              { const LAS float* g1 = pv_slot(F, 2 + sel);
#pragma unroll
                for (int j = 0; j < 4; ++j) { const f32x4 gg = *(const LAS f32x4*)(g1 + RC(F.lane, j)); const u32x4 yw = yv2[u][j >> 1]; const f32x4 yv = (j & 1) ? (f32x4){bflo(yw.z), bfhi(yw.z), bflo(yw.w), bfhi(yw.w)} : (f32x4){bflo(yw.x), bfhi(yw.x), bflo(yw.y), bfhi(yw.y)}; cur.v[j] = cur.v[j] * DN_ALPHA + gg * yv; } }
              row_ln_plain(cur, F.lane); row_affine_l(cur, pv_slot(F, 0), pv_slot(F, 1), F.lane);
              row_store_bf16_nt(cur, (bf16_t*)(F.ws + WS_X) + (size_t)row * D, F.lane);
              row_ln_plain(cur, F.lane); row_modulate_l(cur, pv_slot(F, 4 + sel), pv_slot(F, 6 + sel), F.lane);
              row_store_bf16(cur, (bf16_t*)(F.ws + WS_H2) + (size_t)row * D, F.lane);
              { unsigned char* h8 = (unsigned char*)(F.ws + WS_H2F8) + (size_t)row * D + 8 * F.lane;
#pragma unroll
                for (int h = 0; h < 2; ++h) { u32x2 w; w.x = pk4_fp8(cur.v[2 * h].x * F8S_ACT, cur.v[2 * h].y * F8S_ACT, cur.v[2 * h].z * F8S_ACT, cur.v[2 * h].w * F8S_ACT); w.y = pk4_fp8(cur.v[2 * h + 1].x * F8S_ACT, cur.v[2 * h + 1].y * F8S_ACT, cur.v[2 * h + 1].z * F8S_ACT, cur.v[2 * h + 1].w * F8S_ACT); *(u32x2*)(h8 + 512 * h) = w; } } }
#pragma unroll
          for (int u = 0; u < 2; ++u) { rv[u] = rvn[u]; yv2[u][0] = yvn[u][0]; yv2[u][1] = yvn[u][1]; }
      }
#undef RT_LOADPAIR
    }
    asm volatile("s_waitcnt vmcnt(0)" ::: "memory"); __syncthreads();
    for (int tile = t_lo + F.wave; tile < t_hi; tile += NWAVES) {
        const LAS float* lgw = narrow_tile_wave(F, (const bf16_t*)(F.ws + WS_H2) + (size_t)tile * 32 * D);
        if (F.lane < 32) {
            const LAS float* lgp = lgw + F.lane * 33; const int row = tile * 32 + F.lane;
            float lg[NEXP];
#pragma unroll
            for (int e = 0; e < NEXP; ++e) lg[e] = lgp[e] + brt[e];
            unsigned used = 0u; float bv[4]; int bi[4];
#pragma unroll
            for (int k = 0; k < 4; ++k) { float best = -3.0e38f; int idx = 0;
#pragma unroll
                for (int e = 0; e < NEXP; ++e) { const bool take = (((used >> e) & 1u) == 0u) && (lg[e] > best); best = take ? lg[e] : best; idx = take ? e : idx; }
                used |= 1u << idx; bv[k] = best; bi[k] = idx; }
            const float e1 = __expf(bv[1] - bv[0]), e2 = __expf(bv[2] - bv[0]), e3 = __expf(bv[3] - bv[0]); const float inv = __builtin_amdgcn_rcpf(1.0f + e1 + e2 + e3);
            int* ei = (int*)(F.ws + WS_ROUTE + RT_EIDX) + (size_t)row * 4; float* pr = (float*)(F.ws + WS_ROUTE + RT_PROB) + (size_t)row * 4;
            *(int4*)ei = make_int4(bi[0], bi[1], bi[2], bi[3]); *(f32x4*)pr = (f32x4){inv, e1 * inv, e2 * inv, e3 * inv};
            atomicAdd((int*)&cnt[bi[0]], 1); atomicAdd((int*)&cnt[bi[1]], 1); atomicAdd((int*)&cnt[bi[2]], 1); atomicAdd((int*)&cnt[bi[3]], 1);
        }
        asm volatile("s_waitcnt lgkmcnt(0)" ::: "memory");
    }
    __syncthreads();
    if (F.tid < NEXP) ((int*)(F.ws + WS_ROUTE + RT_CNT))[F.bid * NEXP + F.tid] = cnt[F.tid];
    __syncthreads();
}
__device__ __forceinline__ void phase_slots(Frame& F, int mrows) {
    LAS int* part = (LAS int*)F.lds;
    LAS int* pre = part + 1024;
    LAS int* tot = pre + 32;
    LAS int* seg = tot + 32;
    LAS int* gcnt = seg + 64;
    LAS int* eix = gcnt + 2048;
    LAS int* rnk = eix + 4096;
    const int* cntg = (const int*)(F.ws + WS_ROUTE + RT_CNT);
    int* tokg = (int*)(F.ws + WS_ROUTE + RT_TOK); int* destg = (int*)(F.ws + WS_ROUTE + RT_DEST); float* psl = (float*)(F.ws + WS_ROUTE + RT_PSLOT);
    int t_lo, t_hi; tile_range(F, mrows, t_lo, t_hi);
    const int row_base = t_lo * 32, nent = (t_hi - t_lo) * 128, ngrp = nent / 64;
    { const int e = F.tid & 31, pt = F.tid >> 5; int a = 0, b = 0;
      for (int c = pt; c < F.G; c += 16) { const int v = cntg[c * NEXP + e]; b += v; a += (c < F.bid) ? v : 0; }
      part[pt * 32 + e] = a; part[512 + pt * 32 + e] = b; }
    for (int i = F.tid; i < nent; i += NTHREADS) eix[i] = ((const int*)(F.ws + WS_ROUTE + RT_EIDX))[(size_t)row_base * 4 + i];
    __syncthreads();
    if (F.tid < NEXP) { int a = 0, b = 0;
#pragma unroll
        for (int pt = 0; pt < 16; ++pt) { a += part[pt * 32 + F.tid]; b += part[512 + pt * 32 + F.tid]; }
        pre[F.tid] = a; tot[F.tid] = b; }
    for (int g = F.wave; g < ngrp; g += NWAVES) {
        const int e = eix[g * 64 + F.lane]; int rank = 0, mycnt = 0;
#pragma unroll 4
        for (int ee = 0; ee < NEXP; ++ee) { const unsigned long long m = __ballot(e == ee); if (e == ee) rank = __popcll(m & ((1ull << F.lane) - 1ull)); if (F.lane == ee) mycnt = __popcll(m); }
        rnk[g * 64 + F.lane] = rank; if (F.lane < NEXP) gcnt[g * 32 + F.lane] = mycnt; }
    __syncthreads();
    if (F.tid == 0) { int s = 0; for (int e = 0; e < NEXP; ++e) { seg[e] = s; s += (tot[e] + 255) & ~255; } seg[NEXP] = s; }
    if (F.tid >= 64 && F.tid < 64 + NEXP) { const int e = F.tid - 64; int run = 0; for (int g = 0; g < ngrp; ++g) { const int c = gcnt[g * 32 + e]; gcnt[g * 32 + e] = run; run += c; } }
    __syncthreads();
    { const float* prg = (const float*)(F.ws + WS_ROUTE + RT_PROB) + (size_t)row_base * 4;
      for (int i = F.tid; i < nent; i += NTHREADS) { const int e = eix[i]; const int slot = seg[e] + pre[e] + gcnt[(i >> 6) * 32 + e] + rnk[i];
          tokg[slot] = row_base + (i >> 2); destg[slot] = row_base * 4 + i; psl[slot] = prg[i]; } }
    if (F.bid < NEXP) { const int e = F.bid; for (int sl = seg[e] + tot[e] + F.tid; sl < seg[e + 1]; sl += NTHREADS) { tokg[sl] = 0; destg[sl] = -1; psl[sl] = 0.f; } }
    if (F.bid == 0 && F.tid <= NEXP) ((int*)(F.ws + WS_ROUTE + RT_SEG))[F.tid] = seg[F.tid];
    __syncthreads();
}
struct CombRaw { u32x4 x[2]; u32x2 f[2][4]; };
__device__ __forceinline__ void comb_load(const Frame& F, int row, CombRaw& r) {
    { const bf16_t* xp = (const bf16_t*)(F.ws + WS_X) + (size_t)row * D + 8 * F.lane;
#pragma unroll
      for (int h = 0; h < 2; ++h) r.x[h] = __builtin_nontemporal_load((const u32x4*)(xp + 512 * h)); }
    const unsigned char* fs = (const unsigned char*)(F.ws + WS_FS) + (size_t)row * 4 * 1024 + 8 * F.lane;
#pragma unroll
    for (int h = 0; h < 2; ++h)
#pragma unroll
        for (int k = 0; k < 4; ++k) r.f[h][k] = __builtin_nontemporal_load((const u32x2*)(fs + k * 1024 + 512 * h));
}
__device__ __forceinline__ void phase_combine_ln2(Frame& F, int l, int mrows) {
    const bool lastl = (l == DEPTH - 1);
    int t_lo, t_hi; tile_range(F, mrows, t_lo, t_hi);
    const int r_lo = 32 * t_lo, nrows = 32 * (t_hi - t_lo);
    const int mrA = mod_row(r_lo), mrB = mod_row(r_lo + (nrows > 0 ? nrows - 1 : 0));
    { const float* mb = (const float*)(F.ws + WS_MOD); const int ln = lastl ? l : l + 1; pv_fill(F, 0, F.in[IN_LN2G] + l * D); pv_fill(F, 1, F.in[IN_LN2B] + l * D);
      pv_fill(F, 2, mb + ((size_t)(l * 17 + mrA) * 6 + 5) * 1024); pv_fill(F, 3, mb + ((size_t)(l * 17 + mrB) * 6 + 5) * 1024);
      pv_fill(F, 4, mb + ((size_t)(ln * 17 + mrA) * 6 + 0) * 1024); pv_fill(F, 5, mb + ((size_t)(ln * 17 + mrB) * 6 + 0) * 1024);
      pv_fill(F, 6, mb + ((size_t)(ln * 17 + mrA) * 6 + 1) * 1024); pv_fill(F, 7, mb + ((size_t)(ln * 17 + mrB) * 6 + 1) * 1024); }
    if (!lastl) load_wg_lds(F, l + 1); else __syncthreads();
    CombRaw rw[2];
#pragma unroll
    for (int u = 0; u < 2; ++u) { rw[u].x[0] = rw[u].x[1] = (u32x4){0u, 0u, 0u, 0u};
#pragma unroll
        for (int k = 0; k < 4; ++k) rw[u].f[0][k] = rw[u].f[1][k] = (u32x2){0u, 0u}; }
#pragma unroll
    for (int u = 0; u < 2; ++u) if (F.wave + u * NWAVES < nrows) comb_load(F, r_lo + F.wave + u * NWAVES, rw[u]);
    for (int n = F.wave; n < nrows; n += 2 * NWAVES) {
        CombRaw rwn[2];
#pragma unroll
        for (int u = 0; u < 2; ++u) rwn[u] = rw[u];
#pragma unroll
        for (int u = 0; u < 2; ++u) if (n + (2 + u) * NWAVES < nrows) comb_load(F, r_lo + n + (2 + u) * NWAVES, rwn[u]);
        __builtin_amdgcn_sched_barrier(0);
#pragma unroll
        for (int u = 0; u < 2; ++u) if (n + u * NWAVES < nrows) { const int row = r_lo + n + u * NWAVES;
            const int sel = (mod_row(row) == mrA) ? 0 : 1;
            const LAS float* g2 = pv_slot(F, 2 + sel);
            RowV x;
#pragma unroll
            for (int h = 0; h < 2; ++h) { const u32x4 w = rw[u].x[h]; x.v[2 * h] = (f32x4){bflo(w.x), bfhi(w.x), bflo(w.y), bfhi(w.y)}; x.v[2 * h + 1] = (f32x4){bflo(w.z), bfhi(w.z), bflo(w.w), bfhi(w.w)}; }
#pragma unroll
            for (int j = 0; j < 4; ++j) { f32x4 f = (f32x4){0.f, 0.f, 0.f, 0.f};
#pragma unroll
                for (int k = 0; k < 4; ++k) { const u32x2 w2 = rw[u].f[j >> 1][k]; const int wd = (int)((j & 1) ? w2.y : w2.x);
                    const f32x2 lo = __builtin_amdgcn_cvt_pk_f32_fp8(wd, false), hi = __builtin_amdgcn_cvt_pk_f32_fp8(wd, true); f[0] += lo[0]; f[1] += lo[1]; f[2] += hi[0]; f[3] += hi[1]; }
                const f32x4 gg = *(const LAS f32x4*)(g2 + RC(F.lane, j)) * (1.0f / FS_SCALE);
                x.v[j] = x.v[j] * DN_ALPHA + gg * f; }
            row_ln_plain(x, F.lane); row_affine_l(x, pv_slot(F, 0), pv_slot(F, 1), F.lane);
            if (lastl) { row_store_nt(x, F.out + (size_t)row * D, F.lane); }
            else { row_store_bf16_nt(x, (bf16_t*)(F.ws + WS_X) + (size_t)row * D, F.lane); ln0_row(F, row, x, pv_slot(F, 4 + sel), pv_slot(F, 6 + sel)); } }
#pragma unroll
        for (int u = 0; u < 2; ++u) rw[u] = rwn[u];
    }
    if (!lastl) gates_tail(F, l + 1, t_lo, t_hi);
    __syncthreads();
}

#define MFMA32(a, b, c) __builtin_amdgcn_mfma_f32_32x32x16_bf16((a), (b), (c), 0, 0, 0)
#define MFMA16(a, b, c) __builtin_amdgcn_mfma_f32_16x16x32_bf16((a), (b), (c), 0, 0, 0)
__device__ __forceinline__ f32x16 zero16() { f32x16 z;
#pragma unroll
    for (int i = 0; i < 16; ++i) z[i] = 0.f;
    return z; }
__device__ __forceinline__ void pool_tiles(Frame& F, int l, bool with_ctx) {
    LAS unsigned char* Pin = F.lds;
    LAS unsigned char* Dm = F.lds + 40960;
    const bf16_t* Z = (const bf16_t*)(F.ws + WS_Z);
    const bf16_t* Wp = (const bf16_t*)(F.ws + WS_WPOOL) + (size_t)l * 4 * 4096;
    const float* psc = F.in[IN_POOLS] + l * 256;
    bf16_t* BRA = (bf16_t*)(F.ws + WS_BRA);
    const int ntiles = with_ctx ? 1088 : 1024;
    const int r = F.lane & 31, h = F.lane >> 5;
    bf16x8 wa[2][4]; f32x4 scv[2][4];
#pragma unroll
    for (int qi = 0; qi < 2; ++qi) { const int q = F.wave + 8 * qi, g = q >> 2, td = (q >> 1) & 1;
#pragma unroll
        for (int ks = 0; ks < 4; ++ks) wa[qi][ks] = *(const bf16x8*)(Wp + ((size_t)g * 64 + td * 32 + r) * 64 + ks * 16 + 8 * h);
#pragma unroll
        for (int qq = 0; qq < 4; ++qq) scv[qi][qq] = *(const f32x4*)(psc + g * 64 + td * 32 + 8 * qq + 4 * h); }
    for (int tile = F.bid; tile < ntiles; tile += F.G) {
        int row0, seq_lo, seq_hi;
        if (tile < 1024) { row0 = tile * 64; seq_lo = row0; seq_hi = row0 + 64; }
        else { const int ct = tile - 1024; seq_lo = ML + (ct >> 2) * 256; seq_hi = seq_lo + 256; row0 = seq_lo + (ct & 3) * 64; }
        for (int idx = F.tid; idx < 80 * 32; idx += NTHREADS) { const int rr = idx >> 5, ck = idx & 31, grow = row0 - 8 + rr;
            if (grow >= seq_lo && grow < seq_hi) *(LAS u32x4*)(Pin + rr * 512 + ck * 16) = __builtin_nontemporal_load((const u32x4*)(Z + (size_t)grow * NZ + ZC_P + ck * 8)); }
        __syncthreads();
#pragma unroll
        for (int g = 0; g < 4; ++g) { constexpr int dummy_ = 0; (void)dummy_; const int hw = 1 << g, tok = F.tid >> 3, ck = g * 8 + (F.tid & 7), t = row0 + tok;
            const int lo = max(t - hw, seq_lo), hi = min(t + hw, seq_hi);
            float s[8];
#pragma unroll
            for (int e = 0; e < 8; ++e) s[e] = 0.f;
#pragma unroll
            for (int d = -hw; d < hw; ++d) { u32x4 v = *(const LAS u32x4*)(Pin + (tok + 8 + d) * 512 + ck * 16); const bool in = (t + d >= lo) && (t + d < hi);
                v.x = in ? v.x : 0u; v.y = in ? v.y : 0u; v.z = in ? v.z : 0u; v.w = in ? v.w : 0u;
                s[0] += bflo(v.x); s[1] += bfhi(v.x); s[2] += bflo(v.y); s[3] += bfhi(v.y); s[4] += bflo(v.z); s[5] += bfhi(v.z); s[6] += bflo(v.w); s[7] += bfhi(v.w); }
            const float inv = __builtin_amdgcn_rcpf((float)(hi - lo));
            const u32x4 o = *(const LAS u32x4*)(Pin + (tok + 8) * 512 + ck * 16);
            u32x4 w; w.x = pk2(s[0] * inv - bflo(o.x), s[1] * inv - bfhi(o.x)); w.y = pk2(s[2] * inv - bflo(o.y), s[3] * inv - bfhi(o.y));
            w.z = pk2(s[4] * inv - bflo(o.z), s[5] * inv - bfhi(o.z)); w.w = pk2(s[6] * inv - bflo(o.w), s[7] * inv - bfhi(o.w));
            *(LAS u32x4*)(Dm + tok * 528 + ck * 16) = w; }
        __syncthreads();
#pragma unroll
        for (int qi = 0; qi < 2; ++qi) { const int q = F.wave + 8 * qi, g = q >> 2, td = (q >> 1) & 1, tt = q & 1;
            f32x16 acc = zero16();
#pragma unroll
            for (int ks = 0; ks < 4; ++ks) { const bf16x8 b = *(const LAS bf16x8*)(Dm + (tt * 32 + r) * 528 + (g * 64 + ks * 16 + 8 * h) * 2);
                acc = MFMA32(wa[qi][ks], b, acc); }
            const size_t orow = (size_t)(row0 + tt * 32 + r);
#pragma unroll
            for (int qq = 0; qq < 4; ++qq) { const int dcol = g * 64 + td * 32 + 8 * qq + 4 * h; const f32x4 sc = scv[qi][qq];
                u32x2 w; w.x = pk2(acc[4 * qq] * sc.x, acc[4 * qq + 1] * sc.y); w.y = pk2(acc[4 * qq + 2] * sc.z, acc[4 * qq + 3] * sc.w);
                *(u32x2*)(BRA + orow * D + dcol) = w; } }
        __syncthreads();
    }
}
__device__ __forceinline__ void sgu_chunks(Frame& F, int l, bool with_ctx) {
    LAS unsigned char* Vt = F.lds;
    const bf16_t* Z = (const bf16_t*)(F.ws + WS_Z);
    const bf16_t* Ws = (const bf16_t*)(F.ws + WS_WSGU) + (size_t)l * 4 * 16384;
    const float* lng = F.in[IN_SLNG] + l * 256; const float* lnb = F.in[IN_SLNB] + l * 256; const float* sb = F.in[IN_SGUB] + l * 512;
    bf16_t* BRA = (bf16_t*)(F.ws + WS_BRA);
    const int nchunks = with_ctx ? 544 : 512;
    const int r = F.lane & 31, h = F.lane >> 5;
    const int tc = F.wave & 1, tt = F.wave >> 1, t = tt * 32 + r;
    LAS float* lnt = (LAS float*)(F.lds + 69632);
    if (F.tid < 256) { lnt[F.tid] = lng[F.tid]; lnt[256 + F.tid] = lnb[F.tid]; }
    __syncthreads();
    for (int ch = F.bid; ch < nchunks; ch += F.G) {
        const int row0 = ch * 128;
        u32x2 ug[4][4]; bf16x8 bcur[8];
        { const int s2 = F.tid >> 3, cq = F.tid & 7; const bf16_t* zp = Z + (size_t)(row0 + 2 * s2) * NZ + ZC_UV + 256 + cq * 32;
          float v[2][32]; float sum[2] = {0.f, 0.f};
#pragma unroll
          for (int rr = 0; rr < 2; ++rr)
#pragma unroll
              for (int i = 0; i < 4; ++i) { const u32x4 w = __builtin_nontemporal_load((const u32x4*)(zp + (size_t)rr * NZ + 8 * i));
                  v[rr][8 * i] = bflo(w.x); v[rr][8 * i + 1] = bfhi(w.x); v[rr][8 * i + 2] = bflo(w.y); v[rr][8 * i + 3] = bfhi(w.y); v[rr][8 * i + 4] = bflo(w.z); v[rr][8 * i + 5] = bfhi(w.z); v[rr][8 * i + 6] = bflo(w.w); v[rr][8 * i + 7] = bfhi(w.w); }
          float rstd[2];
#pragma unroll
          for (int rr = 0; rr < 2; ++rr) {
#pragma unroll
              for (int i = 0; i < 32; ++i) sum[rr] += v[rr][i];
              sum[rr] = oct_sum(sum[rr]);
              const float mean = sum[rr] * (1.f / 256.f); float sq = 0.f;
#pragma unroll
              for (int i = 0; i < 32; ++i) { v[rr][i] -= mean; sq += v[rr][i] * v[rr][i]; }
              sq = oct_sum(sq);
              rstd[rr] = __builtin_amdgcn_rsqf(sq * (1.f / 256.f) + LN_EPS); }
#pragma unroll
        for (int g = 0; g < 4; ++g)
#pragma unroll
            for (int qq = 0; qq < 4; ++qq) ug[g][qq] = *(const u32x2*)(Z + (size_t)(row0 + t) * NZ + ZC_UV + g * 64 + tc * 32 + 8 * qq + 4 * h);
#pragma unroll
        for (int ks = 0; ks < 8; ++ks) bcur[ks] = *(const bf16x8*)(Ws + ((size_t)0 * 128 + t) * 128 + ks * 16 + 8 * h);
          LAS unsigned char* wp = Vt + (((s2 >> 2) ^ cq) << 4) + (s2 & 3) * 4;
#pragma unroll
          for (int i = 0; i < 32; ++i) { const int c = cq * 32 + i; const float gn = lnt[c], bn = lnt[256 + c];
              *(LAS unsigned*)(wp + c * 272) = pg8::cvt_pk_bf16(v[0][i] * rstd[0] * gn + bn, v[1][i] * rstd[1] * gn + bn); } }
        __syncthreads();
#pragma unroll
        for (int g = 0; g < 4; ++g) {
            bf16x8 bnx[8];
#pragma unroll
            for (int ks = 0; ks < 8; ++ks) bnx[ks] = bcur[ks];
            if (g < 3) {
#pragma unroll
                for (int ks = 0; ks < 8; ++ks) bnx[ks] = *(const bf16x8*)(Ws + ((size_t)(g + 1) * 128 + t) * 128 + ks * 16 + 8 * h); }
            f32x16 acc = zero16();
#pragma unroll
            for (int ks = 0; ks < 8; ++ks) { const bf16x8 a = *(const LAS bf16x8*)(Vt + (g * 64 + tc * 32 + r) * 272 + (((ks * 2 + h) ^ ((g * 2 + tc) & 7)) * 16));
                acc = MFMA32(a, bcur[ks], acc); }
#pragma unroll
            for (int ks = 0; ks < 8; ++ks) bcur[ks] = bnx[ks];
            const float bias = sb[g * 128 + t];
#pragma unroll
            for (int qq = 0; qq < 4; ++qq) { const int c0 = g * 64 + tc * 32 + 8 * qq + 4 * h;
                const u32x2 u = ug[g][qq];
                u32x2 w; w.x = pk2(bflo(u.x) * (acc[4 * qq] + bias), bfhi(u.x) * (acc[4 * qq + 1] + bias)); w.y = pk2(bflo(u.y) * (acc[4 * qq + 2] + bias), bfhi(u.y) * (acc[4 * qq + 3] + bias));
                *(u32x2*)(BRA + (size_t)(row0 + t) * D + 768 + c0) = w; } }
        __syncthreads();
    }
}
__device__ __forceinline__ void qk_conv_pass(Frame& F, int l) {
    const bf16_t* Z = (const bf16_t*)(F.ws + WS_Z); bf16_t* QKC = (bf16_t*)(F.ws + WS_H);
    const int chunk = F.tid & 127, rsub = F.tid >> 7, ch0 = chunk * 8;
    float w0[8], w1[8], w2[8], cbv[8];
    { const float* cw = F.in[IN_CONVW] + (size_t)l * 3 * 1024 + ch0; const float* cb = F.in[IN_CONVB] + (size_t)l * 1024 + ch0;
#pragma unroll
      for (int e = 0; e < 8; ++e) { w0[e] = cw[e]; w1[e] = cw[1024 + e]; w2[e] = cw[2048 + e]; cbv[e] = cb[e]; } }
    const float scale = chunk >= 64 ? 0.08838834764831845f : 1.0f;
    const int ns = F.G * 4, sidx = F.bid * 4 + rsub;
    const int r0 = (int)(((long)sidx * MT) / ns), r1 = (int)(((long)(sidx + 1) * MT) / ns);
    const bf16_t* zb = Z + ZC_QK + ch0;
    const u32x4 zero4 = (u32x4){0u, 0u, 0u, 0u};
    u32x4 xm = zero4, xc = zero4, xn = zero4;
    if (r0 < r1) { xc = *(const u32x4*)(zb + (size_t)r0 * NZ); if (r0 > 0) xm = *(const u32x4*)(zb + (size_t)(r0 - 1) * NZ); if (r0 + 1 < MT) xn = *(const u32x4*)(zb + (size_t)(r0 + 1) * NZ); }
    for (int row = r0; row < r1; ++row) {
        u32x4 xn2 = zero4; if (row + 2 < MT) xn2 = *(const u32x4*)(zb + (size_t)(row + 2) * NZ);
        const int p = row < ML ? (row & 4095) : ((row - ML) & 255), len = row < ML ? 4096 : 256;
        const u32x4 x0 = (p > 0) ? xm : zero4, x1 = xc, x2 = (p + 1 < len) ? xn : zero4;
        const unsigned xa[4] = {x0.x, x0.y, x0.z, x0.w}, xb[4] = {x1.x, x1.y, x1.z, x1.w}, xcc[4] = {x2.x, x2.y, x2.z, x2.w};
        float y[8];
#pragma unroll
        for (int e2 = 0; e2 < 4; ++e2) { y[2 * e2] = cbv[2 * e2] + w0[2 * e2] * bflo(xa[e2]) + w1[2 * e2] * bflo(xb[e2]) + w2[2 * e2] * bflo(xcc[e2]);
            y[2 * e2 + 1] = cbv[2 * e2 + 1] + w0[2 * e2 + 1] * bfhi(xa[e2]) + w1[2 * e2 + 1] * bfhi(xb[e2]) + w2[2 * e2 + 1] * bfhi(xcc[e2]); }
#pragma unroll
        for (int e = 0; e < 8; ++e) y[e] = siluf_(y[e]) * scale;
        u32x4 w; w.x = pk2(y[0], y[1]); w.y = pk2(y[2], y[3]); w.z = pk2(y[4], y[5]); w.w = pk2(y[6], y[7]);
        *(u32x4*)(QKC + (size_t)row * D + ch0) = w;
        xm = xc; xc = xn; xn = xn2;
    }
}
constexpr int ML_QS = 0, ML_KS = 34816, ML_KW = 69632, ML_VT = 104448, ML_CB = 126208, ML_SC = 147968, ML_SCSZ = 2624;
__device__ __forceinline__ float logsigf_(float x) { return fminf(x, 0.f) - __logf(1.0f + __expf(-fabsf(x))); }
__device__ __forceinline__ unsigned swap16(unsigned u) { return __builtin_amdgcn_alignbit(u, u, 16); }
struct MlPre { u32x4 qk[8]; u32x2 v[4]; float g[4]; };
__device__ __forceinline__ void ml_geom(int j, int b, int dir, int& seqbase, int& seqlen, int& pbase) {
    const bool is_ctx = j < 2; int cj = is_ctx ? j : j - 2; const int ncs = is_ctx ? 2 : 32; if (dir) cj = ncs - 1 - cj;
    seqbase = is_ctx ? ML + b * 256 : b * 4096; seqlen = is_ctx ? 256 : 4096; pbase = cj * 128; }
#define ML_BAR() do { asm volatile("s_waitcnt lgkmcnt(0)" ::: "memory"); __builtin_amdgcn_s_barrier(); asm volatile("" ::: "memory"); } while (0)
__device__ __forceinline__ void mlstm_unit(Frame& F, int l, int unit) {
    const int bh = (unit & 7) + 8 * (unit >> 5), sub = (unit >> 3) & 3;
    const int b = bh >> 2, head = bh & 3, dir = sub >> 1, vh = sub & 1;
    LAS unsigned char* QS = F.lds + ML_QS; LAS unsigned char* KS = F.lds + ML_KS; LAS unsigned char* KW = F.lds + ML_KW; LAS unsigned char* VT = F.lds + ML_VT; LAS unsigned char* CB = F.lds + ML_CB;
    const bf16_t* Z = (const bf16_t*)(F.ws + WS_Z); const float* ZG = (const float*)(F.ws + WS_ZG); const bf16_t* QKC = (const bf16_t*)(F.ws + WS_H);
    bf16_t* HF = (bf16_t*)(F.ws + WS_HFB) + (size_t)dir * MT * 512;
    const int wave = F.wave;
    int tl = F.tid;
#define ML_ROLES() const int lane = tl & 63, fr = lane & 15, q4 = lane >> 4; const int isk = (tl >> 4) & 1, ck = tl & 15, i0 = 8 * (tl >> 5), chn = (isk ? 512 : 0) + head * 128 + ck * 8; \
    const int vi0 = 4 * (tl >> 4), vcq = tl & 15, vch = head * 128 + vh * 64 + vcq * 4; (void)fr; (void)q4; (void)vi0; (void)vcq; (void)vch; (void)i0; (void)chn; (void)ck; (void)isk;
    for (int idx = F.tid; idx < 16 * 136; idx += NTHREADS) *(LAS bf16_t*)(VT + (64 + idx / 136) * 272 + (idx % 136) * 2) = (idx < 136) ? (bf16_t)0x3F80 : (bf16_t)0;
    f32x4 cs[5];
#pragma unroll
    for (int vt = 0; vt < 5; ++vt) cs[vt] = (f32x4){0.f, 0.f, 0.f, 0.f};
    float m_state = 0.f;
    MlPre pre;
#define ML_PREFETCH(jj) do { int sb_, sl_, pb_; ml_geom((jj), b, dir, sb_, sl_, pb_); \
        { const int pmin = dir ? pb_ + 120 - i0 : pb_ + i0; const bf16_t* zr = QKC + (size_t)(sb_ + pmin) * D + chn; (void)sl_; \
          _Pragma("unroll") for (int k = 0; k < 8; ++k) pre.qk[k] = *(const u32x4*)(zr + (size_t)k * D); } \
        { const int pminv = dir ? pb_ + 124 - vi0 : pb_ + vi0; const bf16_t* zv = Z + (size_t)(sb_ + pminv) * NZ + ZC_V + vch; \
          _Pragma("unroll") for (int k = 0; k < 4; ++k) pre.v[k] = *(const u32x2*)(zv + (size_t)k * NZ); } \
        if (wave == 0) { const int p0 = dir ? pb_ + 127 - 2 * lane : pb_ + 2 * lane, p1 = dir ? p0 - 1 : p0 + 1; \
          pre.g[0] = ZG[(size_t)(sb_ + p0) * 16 + dir * 8 + head]; pre.g[1] = ZG[(size_t)(sb_ + p0) * 16 + dir * 8 + 4 + head]; \
          pre.g[2] = ZG[(size_t)(sb_ + p1) * 16 + dir * 8 + head]; pre.g[3] = ZG[(size_t)(sb_ + p1) * 16 + dir * 8 + 4 + head]; } } while (0)
#define ML_STEPA(sbuf) do { LAS float* sg_ = (LAS float*)(F.lds + ML_SC + (sbuf) * ML_SCSZ); const int i0g = 2 * lane, i1g = i0g + 1; \
        const float gi0 = pre.g[0], gf0 = pre.g[1], gi1 = pre.g[2], gf1 = pre.g[3]; \
        const float lf0 = logsigf_(gf0), lf1 = logsigf_(gf1); const float s1 = lf0 + lf1; const float incl = wave_scan_sum(s1); \
        const float excl = incl - s1, bc0 = excl + lf0, bc1 = excl + s1; \
        const float g0 = gi0 - bc0, g1 = gi1 - bc1; const float mx1 = fmaxf(g0, g1); const float im = wave_scan_max(mx1); \
        const float em = dpp_id<0x138, 0xf>(-3.0e38f, im);                   \
        const float M0 = fmaxf(m_state, fmaxf(em, g0)), M1 = fmaxf(m_state, fmaxf(em, mx1)); \
        const float total = __builtin_bit_cast(float, __builtin_amdgcn_readlane(__builtin_bit_cast(int, bc1), 63)), Mlast = __builtin_bit_cast(float, __builtin_amdgcn_readlane(__builtin_bit_cast(int, M1), 63)); \
        sg_[i0g] = g0; sg_[i1g] = g1; sg_[128 + i0g] = M0; sg_[128 + i1g] = M1; \
        sg_[256 + i0g] = __expf(m_state - M0); sg_[256 + i1g] = __expf(m_state - M1); \
        sg_[384 + i0g] = __expf(-(bc0 + M0)); sg_[384 + i1g] = __expf(-(bc1 + M1)); \
        sg_[512 + i0g] = __expf(g0 - Mlast); sg_[512 + i1g] = __expf(g1 - Mlast); \
        if (lane == 0) sg_[640] = __expf(m_state - Mlast); \
        m_state = total + Mlast; } while (0)
    { ML_ROLES(); ML_PREFETCH(0); if (wave == 0) ML_STEPA(0); }
    ML_BAR();
#pragma unroll 1
    for (int j = 0; j < 34; ++j) {
        asm volatile("" : "+v"(tl));
        ML_ROLES();
        int seqbase, seqlen, pbase; ml_geom(j, b, dir, seqbase, seqlen, pbase);
        const LAS float* sc_g = (const LAS float*)(F.lds + ML_SC + (j & 1) * ML_SCSZ); const LAS float* sc_M = sc_g + 128; const LAS float* sc_dec = sc_g + 256; const LAS float* sc_emt = sc_g + 384; const LAS float* sc_wk = sc_g + 512;
        {
#pragma unroll
          for (int k = 0; k < 8; ++k) { const int i = dir ? i0 + 7 - k : i0 + k; *(LAS u32x4*)((isk ? KS : QS) + i * 272 + ck * 16) = pre.qk[k]; }
          if (isk) { u32x4 kt[8]; float ykeep[8];
#pragma unroll
              for (int e = 0; e < 8; ++e) { kt[e] = (u32x4){0u, 0u, 0u, 0u}; ykeep[e] = 0.f; }
#pragma unroll
              for (int k = 0; k < 8; ++k) { const int i = dir ? i0 + 7 - k : i0 + k; const float wk = sc_wk[i];
                  const unsigned xb[4] = {pre.qk[k].x, pre.qk[k].y, pre.qk[k].z, pre.qk[k].w};
#pragma unroll
                  for (int e = 0; e < 8; ++e) { const float yw = ((e & 1) ? bfhi(xb[e >> 1]) : bflo(xb[e >> 1])) * wk;
                      if (k & 1) { const unsigned pw_ = pk2(ykeep[e], yw); if ((k >> 1) == 0) kt[e].x = pw_; else if ((k >> 1) == 1) kt[e].y = pw_; else if ((k >> 1) == 2) kt[e].z = pw_; else kt[e].w = pw_; }
                      else ykeep[e] = yw; } }
#pragma unroll
              for (int e = 0; e < 8; ++e) { u32x4 o = kt[e]; if (dir) o = (u32x4){swap16(kt[e].w), swap16(kt[e].z), swap16(kt[e].y), swap16(kt[e].x)};
                  *(LAS u32x4*)(KW + (ck * 8 + e) * 272 + (((i0 >> 3) ^ (ck & 7)) * 16)) = o; } } }
        { unsigned vv[4][2];
#pragma unroll
          for (int k = 0; k < 4; ++k) { vv[k][0] = pre.v[k].x; vv[k][1] = pre.v[k].y; }
#pragma unroll
          for (int c = 0; c < 4; ++c) {
              unsigned h0 = (c & 1) ? (vv[0][c >> 1] >> 16) : (vv[0][c >> 1] & 0xffffu), h1 = (c & 1) ? (vv[1][c >> 1] >> 16) : (vv[1][c >> 1] & 0xffffu);
              unsigned h2 = (c & 1) ? (vv[2][c >> 1] >> 16) : (vv[2][c >> 1] & 0xffffu), h3 = (c & 1) ? (vv[3][c >> 1] >> 16) : (vv[3][c >> 1] & 0xffffu);
              u32x2 o; if (dir) { o.x = h3 | (h2 << 16); o.y = h1 | (h0 << 16); } else { o.x = h0 | (h1 << 16); o.y = h2 | (h3 << 16); }
              *(LAS u32x2*)(VT + (vcq * 4 + c) * 272 + vi0 * 2) = o; } }
#pragma unroll
        for (int vt = 0; vt < 5; ++vt)
#pragma unroll
            for (int rr = 0; rr < 4; rr += 2) { const unsigned pw_ = pk2(cs[vt][rr], cs[vt][rr + 1]);
                *(LAS bf16_t*)(CB + (16 * vt + 4 * q4 + rr) * 272 + (16 * wave + fr) * 2) = (bf16_t)(pw_ & 0xffffu); *(LAS bf16_t*)(CB + (16 * vt + 4 * q4 + rr + 1) * 272 + (16 * wave + fr) * 2) = (bf16_t)(pw_ >> 16); }
        ML_BAR();
        if (j + 1 < 34) ML_PREFETCH(j + 1);
        const int t = 16 * wave + fr;
        bf16x8 qf[4];
#pragma unroll
        for (int kc = 0; kc < 4; ++kc) qf[kc] = *(const LAS bf16x8*)(QS + t * 272 + (32 * kc + 8 * q4) * 2);
        const float Mt_t = sc_M[t], dec_t = sc_dec[t], emt_t = sc_emt[t];
        f32x4 ps[8];
#pragma unroll
        for (int jp = 0; jp < 4; ++jp) {
            ps[2 * jp] = (f32x4){0.f, 0.f, 0.f, 0.f}; ps[2 * jp + 1] = (f32x4){0.f, 0.f, 0.f, 0.f};
            if (2 * jp <= wave) {
                bf16x8 ka[4], kb[4];
#pragma unroll
                for (int kc = 0; kc < 4; ++kc) { ka[kc] = *(const LAS bf16x8*)(KS + (32 * jp + fr) * 272 + (32 * kc + 8 * q4) * 2); kb[kc] = *(const LAS bf16x8*)(KS + (32 * jp + 16 + fr) * 272 + (32 * kc + 8 * q4) * 2); }
                const f32x4 ga4 = *(const LAS f32x4*)(sc_g + 32 * jp + 4 * q4), gb4 = *(const LAS f32x4*)(sc_g + 32 * jp + 16 + 4 * q4);
                f32x4 acc0 = (f32x4){0.f, 0.f, 0.f, 0.f}, acc1 = (f32x4){0.f, 0.f, 0.f, 0.f};
#pragma unroll
                for (int kc = 0; kc < 4; ++kc) { acc0 = MFMA16(ka[kc], qf[kc], acc0); acc1 = MFMA16(kb[kc], qf[kc], acc1); }
#pragma unroll
                for (int rr = 0; rr < 4; ++rr) { const int s0 = 32 * jp + 4 * q4 + rr, s1 = s0 + 16;
                    ps[2 * jp][rr] = (s0 <= t) ? acc0[rr] * __expf(ga4[rr] - Mt_t) : 0.f; ps[2 * jp + 1][rr] = (s1 <= t) ? acc1[rr] * __expf(gb4[rr] - Mt_t) : 0.f; }
            }
        }
        f32x4 ao[5];
        {
#pragma unroll
          for (int vt = 0; vt < 5; ++vt) ao[vt] = (f32x4){0.f, 0.f, 0.f, 0.f};
#pragma unroll
          for (int kh = 0; kh < 4; kh += 2) { bf16x8 cf[2][5];
#pragma unroll
              for (int k2 = 0; k2 < 2; ++k2)
#pragma unroll
                  for (int vt = 0; vt < 5; ++vt) cf[k2][vt] = *(const LAS bf16x8*)(CB + (16 * vt + fr) * 272 + (32 * (kh + k2) + 8 * q4) * 2);
#pragma unroll
              for (int k2 = 0; k2 < 2; ++k2)
#pragma unroll
                  for (int vt = 0; vt < 5; ++vt) ao[vt] = MFMA16(cf[k2][vt], qf[kh + k2], ao[vt]); }
#pragma unroll
          for (int vt = 0; vt < 5; ++vt) ao[vt] = ao[vt] * dec_t; }
#pragma unroll
        for (int ks = 0; ks < 4; ++ks) {
            if (2 * ks <= wave) {
                s16x4 vlo[5], vhi[5];
#pragma unroll
                for (int vt = 0; vt < 5; ++vt) { vlo[vt] = *(const LAS s16x4*)(VT + (16 * vt + fr) * 272 + (32 * ks + 4 * q4) * 2); vhi[vt] = *(const LAS s16x4*)(VT + (16 * vt + fr) * 272 + (32 * ks + 16 + 4 * q4) * 2); }
                u32x4 pw; pw.x = cvt_pk_bf16(ps[2 * ks][0], ps[2 * ks][1]); pw.y = cvt_pk_bf16(ps[2 * ks][2], ps[2 * ks][3]); pw.z = cvt_pk_bf16(ps[2 * ks + 1][0], ps[2 * ks + 1][1]); pw.w = cvt_pk_bf16(ps[2 * ks + 1][2], ps[2 * ks + 1][3]);
                const bf16x8 pf = __builtin_bit_cast(bf16x8, pw);
#pragma unroll
                for (int vt = 0; vt < 5; ++vt) { const bf16x8 a = __builtin_shufflevector(vlo[vt], vhi[vt], 0, 1, 2, 3, 4, 5, 6, 7); ao[vt] = MFMA16(a, pf, ao[vt]); }
            }
        }
        { const float den = bperm(fr, ao[4][0]); const float inv = __builtin_amdgcn_rcpf(fmaxf(fabsf(den), emt_t));
          const int p = dir ? pbase + 127 - t : pbase + t; bf16_t* orow = HF + (size_t)(seqbase + p) * 512 + head * 128 + vh * 64 + 4 * q4;
#pragma unroll
          for (int vt = 0; vt < 4; ++vt) { const f32x4 o = ao[vt] * inv; u32x2 w; w.x = cvt_pk_bf16(o[0], o[1]); w.y = cvt_pk_bf16(o[2], o[3]); *(u32x2*)(orow + 16 * vt) = w; } }
        { const float a_s = sc_g[640];
#pragma unroll
          for (int vt = 0; vt < 5; ++vt) cs[vt] = cs[vt] * a_s;
#pragma unroll
          for (int ks = 0; ks < 4; ks += 2) { bf16x8 bb[2], va[2][5];
#pragma unroll
              for (int k2 = 0; k2 < 2; ++k2) { bb[k2] = *(const LAS bf16x8*)(KW + (16 * wave + fr) * 272 + (((4 * (ks + k2) + q4) ^ (((16 * wave + fr) >> 3) & 7)) * 16));
#pragma unroll
                  for (int vt = 0; vt < 5; ++vt) va[k2][vt] = *(const LAS bf16x8*)(VT + (16 * vt + fr) * 272 + (32 * (ks + k2) + 8 * q4) * 2); }
#pragma unroll
              for (int k2 = 0; k2 < 2; ++k2)
#pragma unroll
                  for (int vt = 0; vt < 5; ++vt) cs[vt] = MFMA16(va[k2][vt], bb[k2], cs[vt]); } }
        if (wave == 0 && j + 1 < 34) ML_STEPA((j + 1) & 1);
        ML_BAR();
    }
#undef ML_PREFETCH
#undef ML_STEPA
#undef ML_ROLES
    __syncthreads();
}
__device__ __forceinline__ void phase_mixers(Frame& F, int l) {
    const bool with_ctx = (l != DEPTH - 1);
#ifndef MIX_MASK
#define MIX_MASK 7
#endif
#ifndef MIXREP
#define MIXREP 0
#endif
    if (MIX_MASK & 1) pool_tiles(F, l, with_ctx);
    if (MIXREP & 1) { __syncthreads(); pool_tiles(F, l, with_ctx); }
    if (MIX_MASK & 2) sgu_chunks(F, l, with_ctx);
    if (MIXREP & 2) { __syncthreads(); sgu_chunks(F, l, with_ctx); }
    (void)0;
    qk_conv_pass(F, l);
}
__device__ __forceinline__ void phase_mlstm(Frame& F, int l) {
    for (int u = F.bid; u < 256; u += F.G) mlstm_unit(F, l, u);
}

struct Args { const float* in[31]; float* out; unsigned char* ws; int g_lo, g_hi, pad0, pad1; };
constexpr int NPH = 11, NGID = 2 + DEPTH * NPH;
__global__ void __launch_bounds__(NTHREADS, 2) fwd_kernel(Args args) {
    extern __shared__ __attribute__((aligned(16))) unsigned char lds_raw[];
    Frame F;
    F.lds = (LAS unsigned char*)lds_raw; F.MISC = (volatile LAS unsigned*)(F.lds + MISC_OFF);
    F.tid = threadIdx.x; F.lane = F.tid & 63; F.wave = __builtin_amdgcn_readfirstlane(F.tid >> 6); F.G = gridDim.x; F.bid = blockIdx.x;
    F.ws = args.ws; F.out = args.out;
    F.in = (InTab)__builtin_amdgcn_kernarg_segment_ptr();
    if (F.tid < 64) F.MISC[F.tid] = 0u;
    __syncthreads();
    const int lo = args.g_lo, hi = args.g_hi;
    const bool multi = (hi - lo) > 1;
    XcdBarrier bar; bar.bar = (unsigned*)(F.ws + WS_CTL) + CW_BAR; bar.x = 0; bar.st = nullptr;
    if (multi) bar = xcd_barrier_post((unsigned*)(F.ws + WS_CTL) + CW_BAR, F.MISC + 8);
#ifndef PHASE_MASK
#define PHASE_MASK 0xFFFF
#endif
#define RUN(g) (lo <= (g) && (g) < hi)
#define RUNP(ty, g) ((((PHASE_MASK) >> (ty)) & 1) && RUN(g))
#ifndef REPEAT_MASK
#define REPEAT_MASK 0
#endif
#define NREP(ty) ((((REPEAT_MASK) >> (ty)) & 1) ? 2 : 1)
#define SEAM(g) do { if (RUN((g) + 1)) xcd_barrier(bar); } while (0)
#define LAUNDER(P) Frame P = F; { int t_; asm volatile("v_mbcnt_lo_u32_b32 %0, -1, 0\n\tv_mbcnt_hi_u32_b32 %0, -1, %0" : "=v"(t_)); t_ |= (F.wave << 6); P.tid = t_; P.lane = t_ & 63; P.wave = __builtin_amdgcn_readfirstlane(t_ >> 6); GAS unsigned char* w_ = (GAS unsigned char*)F.ws; asm volatile("" : "+s"(w_)); P.ws = (unsigned char*)w_; InTab t2_ = F.in; asm volatile("" : "+s"(t2_)); P.in = t2_; }
    if (RUNP(0, 0)) { LAUNDER(P); for (int rep_ = 0; rep_ < NREP(0); ++rep_) { phase_prologue(P); __syncthreads(); } SEAM(0); }
    if (RUNP(1, 1)) { LAUNDER(P); for (int rep_ = 0; rep_ < NREP(1); ++rep_) { phase_ln0_first(P); __syncthreads(); } SEAM(1); }
#pragma unroll 1
    for (int l = 0; l < DEPTH; ++l) {
        const int g0 = 2 + l * NPH;
        const int mrows = (l == DEPTH - 1) ? ML : MT;
        if (RUNP(2, g0 + 0)) {
#undef PHTY
#define PHTY 2
            LAUNDER(P);
            { ProbPlain Pr{(const bf16_t*)(P.ws + WS_H), (const bf16_t*)(P.ws + WS_WIN) + (size_t)l * NZ * D, D, D};
              pg8::StaticOrder<1> S; S.init(MT / 256, NZ_BF / 256, P.G, P.bid);
              EpiInproj<false> E{(bf16_t*)(P.ws + WS_Z), P.in[IN_BIN] + (size_t)l * 5904, 0};
              pg8::gemm_phase(P.lds, P.tid, Pr, S, E); }
            __syncthreads();
            { ProbPlainF8 Pr{(const bf16_t*)(P.ws + WS_H8), (const bf16_t*)(P.ws + WS_WIN8 + (size_t)l * NZ_F8 * D), D / 2, D / 2};
              pg8::StaticOrder<1> S; S.init(MT / 256, NZ_F8 / 256, P.G, P.bid);
              EpiInproj<true> E{(bf16_t*)(P.ws + WS_Z), P.in[IN_BIN] + (size_t)l * 5904, NZ_BF / 256};
              pg8::gemm_phase(P.lds, P.tid, Pr, S, E); }
            SEAM(g0 + 0);
        }
        if (RUNP(3, g0 + 1)) { LAUNDER(P); for (int rep_ = 0; rep_ < NREP(3); ++rep_) { phase_mixers(P, l); __syncthreads(); } SEAM(g0 + 1); }
        if (RUNP(12, g0 + 2)) { LAUNDER(P); for (int rep_ = 0; rep_ < NREP(12); ++rep_) { phase_mlstm(P, l); __syncthreads(); } SEAM(g0 + 2); }
        if (RUNP(4, g0 + 3)) { LAUNDER(P); for (int rep_ = 0; rep_ < NREP(4); ++rep_) phase_finalize(P, l, mrows); SEAM(g0 + 3); }
        if (RUNP(5, g0 + 4)) {
#undef PHTY
#define PHTY 5
            LAUNDER(P);
            ProbPlain Pr{(const bf16_t*)(P.ws + WS_BRA), (const bf16_t*)(P.ws + WS_WBR) + (size_t)l * D * D, D, D};
            pg8::StaticOrder<1> S; S.init(mrows / 256, 4, P.G, P.bid);
            EpiBranch E{(const bf16_t*)(P.ws + WS_Z), (bf16_t*)(P.ws + WS_Y)};
            pg8::gemm_phase(P.lds, P.tid, Pr, S, E); if (NREP(PHTY) == 2) { __syncthreads(); pg8::gemm_phase(P.lds, P.tid, Pr, S, E); }
            SEAM(g0 + 4);
        }
        if (RUNP(6, g0 + 5)) {
#undef PHTY
#define PHTY 6
            LAUNDER(P);
            ProbPlain Pr{(const bf16_t*)(P.ws + WS_Y), (const bf16_t*)(P.ws + WS_WOUT) + (size_t)l * D * D, D, D};
            pg8::StaticOrder<1> S; S.init(mrows / 256, 4, P.G, P.bid);
            EpiOut E{(bf16_t*)(P.ws + WS_T)};
            pg8::gemm_phase(P.lds, P.tid, Pr, S, E); if (NREP(PHTY) == 2) { __syncthreads(); pg8::gemm_phase(P.lds, P.tid, Pr, S, E); }
            SEAM(g0 + 5);
        }
        if (RUNP(7, g0 + 6)) { LAUNDER(P); for (int rep_ = 0; rep_ < NREP(7); ++rep_) phase_ln1_router(P, l, mrows); SEAM(g0 + 6); }
        if (RUNP(8, g0 + 7)) { LAUNDER(P); for (int rep_ = 0; rep_ < NREP(8); ++rep_) phase_slots(P, mrows); SEAM(g0 + 7); }
        if (RUNP(9, g0 + 8)) {
#undef PHTY
#define PHTY 9
            LAUNDER(P);
            LAS int* seg = (LAS int*)(P.lds + TAB_OFF);
            const int ntile = moe_tables(P, seg);
            ProbMoe1 Pr{(const bf16_t*)(P.ws + WS_H2F8), (const bf16_t*)(P.ws + WS_WGU + (size_t)l * NEXP * 2048 * D), D / 2, D / 2, (const int*)(P.ws + WS_ROUTE + RT_TOK), seg};
            pg8::StaticOrder<1> S; S.init(ntile, 8, P.G, P.bid);
            EpiSwiglu E{(unsigned char*)(P.ws + WS_HID), P.in[IN_BGU] + (size_t)l * NEXP * 2048, seg};
            pg8::gemm_phase(P.lds, P.tid, Pr, S, E); if (NREP(PHTY) == 2) { __syncthreads(); pg8::gemm_phase(P.lds, P.tid, Pr, S, E); }
            SEAM(g0 + 8);
        }
        if (RUNP(10, g0 + 9)) {
#undef PHTY
#define PHTY 10
            LAUNDER(P);
            LAS int* seg = (LAS int*)(P.lds + TAB_OFF);
            const int ntile = moe_tables(P, seg);
            ProbMoe2 Pr{(const bf16_t*)(P.ws + WS_HID), (const bf16_t*)(P.ws + WS_WDN + (size_t)l * NEXP * D * D), D / 2, D / 2, seg};
            pg8::StaticOrder<1> S; S.init(ntile, 4, P.G, P.bid);
            EpiDown E{(unsigned char*)(P.ws + WS_FS), P.in[IN_BDN] + (size_t)l * NEXP * D, (const int*)(P.ws + WS_ROUTE + RT_DEST), (const float*)(P.ws + WS_ROUTE + RT_PSLOT), seg};
            pg8::gemm_phase(P.lds, P.tid, Pr, S, E); if (NREP(PHTY) == 2) { __syncthreads(); pg8::gemm_phase(P.lds, P.tid, Pr, S, E); }
            SEAM(g0 + 9);
        }
        if (RUNP(11, g0 + 10)) { LAUNDER(P); phase_combine_ln2(P, l, mrows); SEAM(g0 + 10); }
    }
#undef LAUNDER
#undef RUN
#undef RUNP
#undef SEAM
}

extern "C" void kernel_launch(void* const* d_in, const int* in_sizes, int n_in, void* d_out, int out_size, void* d_ws, size_t ws_size, hipStream_t stream) {
    static int grid = 0;
    if (grid == 0) {
        if (n_in != 31 || out_size != ML * D || ws_size < WS_END) { fprintf(stderr, "kernel_launch: unexpected problem (n_in %d, out %d, ws %zu, need %zu)\n", n_in, out_size, ws_size, (size_t)WS_END); grid = -1; return; }
        int dev = 0, cus = 0, per_cu = 0;
        if (hipGetDevice(&dev) != hipSuccess || hipDeviceGetAttribute(&cus, hipDeviceAttributeMultiprocessorCount, dev) != hipSuccess) { grid = -1; return; }
        if (hipFuncSetAttribute((const void*)fwd_kernel, hipFuncAttributeMaxDynamicSharedMemorySize, LDS_BYTES) != hipSuccess) { fprintf(stderr, "kernel_launch: hipFuncSetAttribute failed\n"); grid = -1; return; }
        if (hipOccupancyMaxActiveBlocksPerMultiprocessor(&per_cu, (const void*)fwd_kernel, NTHREADS, LDS_BYTES) != hipSuccess || per_cu < 1) fprintf(stderr, "kernel_launch: occupancy query reports %d\n", per_cu);
        (void)hipGetLastError();
        grid = cus;
    }
    if (grid < 0) return;
    (void)hipMemsetAsync((char*)d_ws + WS_CTL, 0, CTL_ZERO_BYTES, stream);
    Args a{};
    for (int i = 0; i < 31; ++i) a.in[i] = (const float*)d_in[i];
    a.out = (float*)d_out; a.ws = (unsigned char*)d_ws;
#if MK_N_LAUNCHES == 1
    a.g_lo = 0; a.g_hi = NGID;
    hipLaunchKernelGGL(fwd_kernel, dim3(grid), dim3(NTHREADS), LDS_BYTES, stream, a);
#else
    for (int g = 0; g < NGID; ++g) { a.g_lo = g; a.g_hi = g + 1; hipLaunchKernelGGL(fwd_kernel, dim3(grid), dim3(NTHREADS), LDS_BYTES, stream, a); }
#endif
}
```

```cpp
#include <hip/hip_runtime.h>
#include <cstdio>
#include <cstdint>

#ifndef MK_N_LAUNCHES
#define MK_N_LAUNCHES 1
#endif

#define LAS __attribute__((address_space(3)))
#define GAS __attribute__((address_space(1)))
typedef unsigned short bf16_t;
typedef short bf16x8 __attribute__((ext_vector_type(8)));
typedef short s16x4 __attribute__((ext_vector_type(4)));
typedef float f32x4 __attribute__((ext_vector_type(4)));
typedef float f32x2 __attribute__((ext_vector_type(2)));
typedef float f32x16 __attribute__((ext_vector_type(16)));
typedef unsigned u32x4 __attribute__((ext_vector_type(4)));
typedef unsigned u32x2 __attribute__((ext_vector_type(2)));
typedef int i32x4 __attribute__((ext_vector_type(4)));
typedef int i32x8 __attribute__((ext_vector_type(8)));

constexpr int D = 1024, NB = 16, SEQ = 4096, CTXL = 256, DEPTH = 4;
constexpr int ML = NB * SEQ;
constexpr int MC = NB * CTXL;
constexpr int MT = ML + MC;
constexpr int NZ = 5888;
constexpr int ZC_P = 0, ZC_QK = 256, ZC_V = 1280, ZC_O = 1792, ZC_UV = 2304, ZC_MG = 2816;
constexpr int NZ_BF = 256, NZ_F8 = 5632;
constexpr int ZG_COL = 2816;
constexpr int NEXP = 32, TOPK = 4;
constexpr int NS_MAX = MT * TOPK + NEXP * 256;
constexpr float LN_EPS = 1e-5f, HEAD_EPS = 1e-6f;
constexpr float DN_ALPHA = 1.6817928305074292f;
constexpr int NWAVES = 8, NTHREADS = 512;
constexpr float F8_DESCALE = 1.0f / 256.0f;
constexpr float F8S_ACT = 4.0f, F8S_WGU = 64.0f, F8S_WDN = 64.0f; constexpr int F8E_ACT = 123, F8E_WGU = 123, F8E_WDN = 123;

constexpr size_t MiB = 1u << 20;
constexpr size_t WS_CTL = 0, CTL_ZERO_BYTES = 1 * MiB;
constexpr size_t WS_MOD = 1 * MiB;
constexpr size_t WS_WG = 3 * MiB;
constexpr size_t WS_WSGU = 4 * MiB;
constexpr size_t WS_WPOOL = WS_WSGU + 512 * 1024;
constexpr size_t WS_ROUTE = 5 * MiB;
constexpr size_t WS_WIN = 16 * MiB;
constexpr size_t WS_WBR = 62 * MiB;
constexpr size_t WS_WOUT = 70 * MiB;
constexpr size_t WS_WGU = 78 * MiB;
constexpr size_t WS_WDN = 590 * MiB;
constexpr size_t WS_X = 846 * MiB;
constexpr size_t WS_H = 1118 * MiB;
constexpr size_t WS_Z = 1254 * MiB;
constexpr size_t WS_FS = WS_Z;
constexpr float G8_SCALE = 255.0f;
constexpr float FS_SCALE = 32.0f, FS_CLAMP = 440.0f;
constexpr size_t WS_BRA = 2036 * MiB;
constexpr size_t WS_HFB = 2172 * MiB;
constexpr size_t WS_Y = 2444 * MiB;
constexpr size_t WS_T = 2580 * MiB;
constexpr size_t WS_H2 = 2852 * MiB;
constexpr size_t WS_HID = 2988 * MiB;
constexpr size_t WS_ZG = 3548 * MiB;
constexpr size_t WS_H2F8 = 3554 * MiB;
constexpr size_t WS_H8 = 3624 * MiB;
constexpr size_t WS_WIN8 = 3692 * MiB;
constexpr size_t WS_END = 3714 * MiB;
static_assert(WS_Z + (size_t)MT * NZ * 2 <= WS_BRA && WS_FS + (size_t)MT * 4 * 1024 * 2 <= WS_BRA, "Z/FS");
static_assert(WS_HID + (size_t)NS_MAX * 1024 * 2 <= WS_END, "HID");
constexpr size_t RT_EIDX = 0;
constexpr size_t RT_PROB = 2 * MiB;
constexpr size_t RT_TOK = 4 * MiB;
constexpr size_t RT_DEST = 6 * MiB;
constexpr size_t RT_PSLOT = 8 * MiB;
constexpr size_t RT_CNT = 10 * MiB;
constexpr size_t RT_SEG = 10 * MiB + 64 * 1024;
constexpr int CW_BAR = 4096;

constexpr int LDS_BYTES = 163840;
constexpr int MISC_OFF = LDS_BYTES - 256;
constexpr int TAB_OFF = 131072;
constexpr int NW_WT = 0;
constexpr int NW_LG = 66048;
constexpr int NW_END = 99840;
constexpr int NW_PV = NW_END + 256;

__device__ __forceinline__ unsigned f2bf(float f) { unsigned u = __builtin_bit_cast(unsigned, f); return (u + 0x7fffu + ((u >> 16) & 1u)) >> 16; }
__device__ __forceinline__ unsigned pk2(float lo, float hi) { unsigned r; asm volatile("v_cvt_pk_bf16_f32 %0, %1, %2" : "=v"(r) : "v"(lo), "v"(hi)); return r; }
__device__ __forceinline__ unsigned pk4_fp8(float a, float b, float c, float d) { int w = 0; w = __builtin_amdgcn_cvt_pk_fp8_f32(a, b, w, false); w = __builtin_amdgcn_cvt_pk_fp8_f32(c, d, w, true); return (unsigned)w; }
__device__ __forceinline__ unsigned pk4_u8(float a, float b, float c, float d) {
    const unsigned lo = __builtin_amdgcn_perm(__builtin_bit_cast(unsigned, b), __builtin_bit_cast(unsigned, a), 0x0c0c0400u), hi = __builtin_amdgcn_perm(__builtin_bit_cast(unsigned, d), __builtin_bit_cast(unsigned, c), 0x0c0c0400u);
    return lo | (hi << 16); }
__device__ __forceinline__ f32x4 u8x4_f32(unsigned w) { return (f32x4){(float)(w & 0xffu), (float)((w >> 8) & 0xffu), (float)((w >> 16) & 0xffu), (float)(w >> 24)}; }
__device__ __forceinline__ float bflo(unsigned w) { return __builtin_bit_cast(float, w << 16); }
__device__ __forceinline__ float bfhi(unsigned w) { return __builtin_bit_cast(float, w & 0xffff0000u); }
__device__ __forceinline__ float bf1(bf16_t h) { return __builtin_bit_cast(float, ((unsigned)h) << 16); }
__device__ __forceinline__ float bperm(int srclane, float v) { return __builtin_bit_cast(float, __builtin_amdgcn_ds_bpermute(srclane << 2, __builtin_bit_cast(int, v))); }
__device__ __forceinline__ float shx(float v, int o, int lane) { return bperm(lane ^ o, v); }
__device__ __forceinline__ float shup(float v, int o, int lane) { return bperm(lane >= o ? lane - o : lane, v); }
template <int N> __device__ __forceinline__ float dpp_ror(float v) { return __builtin_bit_cast(float, __builtin_amdgcn_update_dpp(0, __builtin_bit_cast(int, v), 0x120 + N, 0xf, 0xf, false)); }
template <int CTRL, int ROWMASK> __device__ __forceinline__ float dpp_id(float ident, float v) { return __builtin_bit_cast(float, __builtin_amdgcn_update_dpp(__builtin_bit_cast(int, ident), __builtin_bit_cast(int, v), CTRL, ROWMASK, 0xf, false)); }
__device__ __forceinline__ float wave_scan_sum(float v) {
    v += dpp_id<0x111, 0xf>(0.f, v); v += dpp_id<0x112, 0xf>(0.f, v); v += dpp_id<0x114, 0xf>(0.f, v); v += dpp_id<0x118, 0xf>(0.f, v);
    v += dpp_id<0x142, 0xa>(0.f, v); v += dpp_id<0x143, 0xc>(0.f, v); return v; }
__device__ __forceinline__ float wave_scan_max(float v) { const float NI = -3.0e38f;
    v = fmaxf(v, dpp_id<0x111, 0xf>(NI, v)); v = fmaxf(v, dpp_id<0x112, 0xf>(NI, v)); v = fmaxf(v, dpp_id<0x114, 0xf>(NI, v)); v = fmaxf(v, dpp_id<0x118, 0xf>(NI, v));
    v = fmaxf(v, dpp_id<0x142, 0xa>(NI, v)); v = fmaxf(v, dpp_id<0x143, 0xc>(NI, v)); return v; }
template <int CTRL> __device__ __forceinline__ float dpp_mv(float v) { return __builtin_bit_cast(float, __builtin_amdgcn_update_dpp(0, __builtin_bit_cast(int, v), CTRL, 0xf, 0xf, false)); }
__device__ __forceinline__ float oct_sum(float v) { v += dpp_mv<0xB1>(v); v += dpp_mv<0x4E>(v); v += dpp_mv<0x141>(v); return v; }
__device__ __forceinline__ float row16_sum(float v) { v += dpp_ror<8>(v); v += dpp_ror<4>(v); v += dpp_ror<2>(v); v += dpp_ror<1>(v); return v; }
__device__ __forceinline__ float wave_sum(float v, int) {
    v = row16_sum(v);
    { const unsigned u = __builtin_bit_cast(unsigned, v); const auto r = __builtin_amdgcn_permlane16_swap(u, u, false, false); v = __builtin_bit_cast(float, (unsigned)r[0]) + __builtin_bit_cast(float, (unsigned)r[1]); }
    { const unsigned u = __builtin_bit_cast(unsigned, v); const auto r = __builtin_amdgcn_permlane32_swap(u, u, false, false); v = __builtin_bit_cast(float, (unsigned)r[0]) + __builtin_bit_cast(float, (unsigned)r[1]); }
    return v;
}
__device__ __forceinline__ float sigmoidf_(float x) { return __builtin_amdgcn_rcpf(1.0f + __builtin_amdgcn_exp2f(x * -1.4426950408889634f)); }
__device__ __forceinline__ float siluf_(float x) { return x * __builtin_amdgcn_rcpf(1.0f + __builtin_amdgcn_exp2f(x * -1.4426950408889634f)); }
__device__ __forceinline__ f32x4 sigmoid4(f32x4 x) {
    f32x4 t = x * -1.4426950408889634f;
#pragma unroll
    for (int i = 0; i < 4; ++i) t[i] = __builtin_amdgcn_exp2f(t[i]);
    t = t + 1.0f;
#pragma unroll
    for (int i = 0; i < 4; ++i) t[i] = __builtin_amdgcn_rcpf(t[i]);
    return t; }
#define LDS_WAIT() asm volatile("s_waitcnt lgkmcnt(0)" ::: "memory")
#define VM_WAIT() asm volatile("s_waitcnt vmcnt(0)" ::: "memory")

#define XB_TMO      128
#define XB_XCNT(j)  (256  + 64 * (j))
#define XB_XSUB(j)  (1280 + 64 * (j))
#define XB_XGEN(j)  (2304 + 64 * (j))
#define XB_TOP      3328
#define XB_TOPGEN   3392
#define XCD_BAR_WORDS 3456
#define XB_SPIN_CAP (1u << 18)
__device__ __forceinline__ unsigned xb_ld(unsigned* p)              { asm volatile("" : "+v"(p)); return __hip_atomic_load(p, __ATOMIC_RELAXED, __HIP_MEMORY_SCOPE_AGENT); }
__device__ __forceinline__ unsigned xb_add(unsigned* p, unsigned v) { asm volatile("" : "+v"(p), "+v"(v)); return __hip_atomic_fetch_add(p, v, __ATOMIC_RELAXED, __HIP_MEMORY_SCOPE_AGENT); }
__device__ __forceinline__ unsigned xb_xcc_id() { return (unsigned)__builtin_amdgcn_s_getreg((3 << 11) | 20) & 0xFu; }
#define XB_SPIN(cond, bar) do { unsigned _sp = 0; while (cond) { __builtin_amdgcn_s_sleep(1); \
    if ((++_sp & 255u) == 0u) { if (xb_ld(&(bar)[XB_TMO])) break; if (_sp > XB_SPIN_CAP) { atomicAdd(&(bar)[XB_TMO], 1u); break; } } } } while (0)
struct XcdBarrier { unsigned* bar; unsigned x; volatile LAS unsigned* st; };
__device__ __forceinline__ XcdBarrier xcd_barrier_post(unsigned* bar, volatile LAS unsigned* st) {
    XcdBarrier b; b.bar = bar; b.x = xb_xcc_id(); b.st = st;
    if (threadIdx.x == 0) (void)xb_add(&bar[XB_XCNT(b.x)], 1u);
    return b;
}
__device__ __forceinline__ void xcd_barrier_complete(unsigned* bar, unsigned x, unsigned& nloc, unsigned& nx) {
    const unsigned G = gridDim.x * gridDim.y * gridDim.z;
    unsigned sum, cnt, mine, sp = 0u;
    for (;;) {
        sum = 0u; cnt = 0u; mine = 0u;
#pragma unroll
        for (unsigned j = 0; j < 16; ++j) { const unsigned c = xb_ld(&bar[XB_XCNT(j)]); sum += c; cnt += (c > 0u) ? 1u : 0u; mine = (j == x) ? c : mine; }
        if (sum == G) break;
        __builtin_amdgcn_s_sleep(1);
        if ((++sp & 255u) == 0u) { if (xb_ld(&bar[XB_TMO])) break; if (sp > XB_SPIN_CAP) { atomicAdd(&bar[XB_TMO], 1u); break; } }
    }
    nloc = mine > 0u ? mine : 1u; nx = cnt > 0u ? cnt : 1u;
}
__device__ __forceinline__ void xcd_barrier(const XcdBarrier& b) {
    asm volatile("s_waitcnt vmcnt(0)" ::: "memory");
    __syncthreads();
    if (threadIdx.x == 0) {
        unsigned* bar = b.bar;
        __builtin_amdgcn_s_waitcnt(0);
        unsigned nloc = b.st[0], nx = b.st[1];
        if (nloc == 0u) { xcd_barrier_complete(bar, b.x, nloc, nx); b.st[0] = nloc; b.st[1] = nx; }
        const unsigned old = xb_add(&bar[XB_XSUB(b.x)], 1u);
        const unsigned gen = old / nloc;
        if (old + 1u == (gen + 1u) * nloc) {
            __builtin_amdgcn_fence(__ATOMIC_RELEASE, "agent");
            asm volatile("s_waitcnt vmcnt(0)" ::: "memory");
            const unsigned og = xb_add(&bar[XB_TOP], 1u);
            const unsigned tg = og / nx;
            if (og + 1u == (tg + 1u) * nx) xb_add(&bar[XB_TOPGEN], 1u);
            else XB_SPIN(xb_ld(&bar[XB_TOPGEN]) == tg, bar);
            __builtin_amdgcn_fence(__ATOMIC_ACQUIRE, "agent");
            xb_add(&bar[XB_XGEN(b.x)], 1u);
            asm volatile("s_waitcnt vmcnt(0)" ::: "memory");
        } else {
            XB_SPIN(xb_ld(&bar[XB_XGEN(b.x)]) == gen, bar);
            __builtin_amdgcn_fence(__ATOMIC_ACQUIRE, "agent");
            asm volatile("s_waitcnt vmcnt(0)" ::: "memory");
        }
    }
    __syncthreads();
}

namespace pg8 {
constexpr int BM = 256, BK = 64, HALF = 128, HTB = HALF * BK * 2, STAGE_BYTES = 8 * HTB, NXCD = 8, WGM = 8;
__host__ __device__ __forceinline__ int lds_byte(int r, int c) { const int st = (r >> 4) * 2 + (c >> 5), rr = r & 15, cc = c & 31, ob = rr * 64 + cc * 2; return st * 1024 + (ob ^ (((ob >> 9) & 1) << 5)); }
__host__ __device__ __forceinline__ void stage_rc(int b, int& R, int& C) { const int st = b / 1024, sb = b % 1024, swz = sb ^ (((sb >> 9) & 1) << 5); R = (st >> 1) * 16 + swz / 64; C = (st & 1) * 32 + (swz % 64) / 2; }
__host__ __device__ __forceinline__ int perm32(int rho) { const int n = rho >> 4, i = rho & 15; return 8 * (i >> 2) + 4 * n + (i & 3); }
struct Unit { int pm, pn, sub; };
__device__ __forceinline__ unsigned cvt_pk_bf16(float lo, float hi) { unsigned r; asm volatile("v_cvt_pk_bf16_f32 %0, %1, %2" : "=v"(r) : "v"(lo), "v"(hi)); return r; }
__device__ __forceinline__ f32x2 gelu_pk(f32x2 v) {
    const f32x2 av = __builtin_elementwise_abs(v), d = av * 0.2316418882f + 1.0f;
    f32x2 t; t.x = __builtin_amdgcn_rcpf(d.x); t.y = __builtin_amdgcn_rcpf(d.y);
    f32x2 q = t * 0.5307027145f + (-0.7265760135f); q = q * t + 0.7107068705f; q = q * t + (-0.142248368f); q = q * t + 0.127414796f; q = q * t;
    const f32x2 s = (v * v) * (-0.72134752044f);
    f32x2 e; e.x = __builtin_amdgcn_exp2f(s.x); e.y = __builtin_amdgcn_exp2f(s.y);
    const f32x2 m = v * (q * e), r = v - m;
    f32x2 o; o.x = v.x < 0.f ? m.x : r.x; o.y = v.y < 0.f ? m.y : r.y; return o;
}
template <int NSUB = 1> struct StaticOrder {
    int nM, nN, nwg, G, c;
    __device__ void init(int nM_, int nN_, int G_, int c_) { nM = nM_; nN = nN_; nwg = nM * nN; G = G_; c = c_; }
    __device__ bool next(int i, Unit& u) const {
        const int it = i / NSUB; u.sub = i - it * NSUB;
        const long L = (long)it * G + c; if (L >= nwg) return false;
        int wgid = (int)L; { const int q = nwg / NXCD, r = nwg % NXCD, xcd = wgid % NXCD, off = wgid / NXCD; wgid = (xcd < r ? xcd * (q + 1) : r * (q + 1) + (xcd - r) * q) + off; }
        const int nig = WGM * nN, gid = wgid / nig, fm = gid * WGM, gsz = (nM - fm) < WGM ? (nM - fm) : WGM;
        u.pm = fm + ((wgid % nig) % gsz); u.pn = (wgid % nig) / gsz; return true;
    }
};
constexpr int SIDE_TOK = 131072 + 2048;
constexpr int SIDE_SLOT = 131072 + 10240, SIDE_SLOT_BYTES = 3072;
__device__ __forceinline__ void dma16(unsigned voff, const void* sbase, unsigned ldsaddr) { asm volatile("s_mov_b32 m0, %2\n\tglobal_load_lds_dwordx4 %0, %1" :: "v"(voff), "s"(sbase), "s"(ldsaddr) : "memory", "m0"); }
__device__ __forceinline__ void dma4(unsigned voff, const void* sbase, unsigned ldsaddr) { asm volatile("s_mov_b32 m0, %2\n\tglobal_load_lds_dword %0, %1" :: "v"(voff), "s"(sbase), "s"(ldsaddr) : "memory", "m0"); }
template <class Prob, class Sched, class Epi>
__device__ __forceinline__ void gemm_phase(LAS unsigned char* lds, const int tid, const Prob& P, const Sched& S, const Epi& E) {
    const int wid = __builtin_amdgcn_readfirstlane(tid >> 6), lane = tid & 63, wr = wid >> 2, wc = wid & 3, fr = lane & 15, fq = lane >> 4;
    const int lda = P.lda, ldb = P.ldb;
    unsigned voffB[2], offA[2][2];
#define PG8_TOKSLOT(name) const LAS int* name; { PG8_TID(tl2_); name = (const LAS int*)(lds + SIDE_TOK) + (tl2_ >> 6) * 256 + (tl2_ & 63); }
#define PG8_TID(v_) int v_; asm volatile("v_mbcnt_lo_u32_b32 %0, -1, 0\n\tv_mbcnt_hi_u32_b32 %0, -1, %0" : "=v"(v_)); v_ |= (wid << 6)
#define PG8_RC(R_, C_) int R_[2], C_[2]; { PG8_TID(tl_); _Pragma("unroll") for (int i_ = 0; i_ < 2; ++i_) stage_rc(tl_ * 16 + i_ * 8192, R_[i_], C_[i_]); }
#pragma unroll
    for (int i = 0; i < 2; ++i) { int R, C; stage_rc(tid * 16 + i * 8192, R, C); const int Rb = Epi::PERM ? ((R & ~31) + perm32(R & 31)) : R;
        voffB[i] = (unsigned)(Rb * ldb + C) * 2u;
        offA[0][i] = (unsigned)(R * lda + C) * 2u; offA[1][i] = (unsigned)((R + HALF) * lda + C) * 2u; }
    const size_t kstep = (size_t)(BK * 2);
    const size_t hstep = (size_t)HALF * ldb * 2;
    const unsigned ldsw = (unsigned)wid * 1024u;
    const int aoff = lds_byte(wr * 64 + fr, fq * 8), boff = lds_byte(wc * 32 + fr, fq * 8);
#define PG8_SA(b, h) (((b) * 2 + (h)) * HTB)
#define PG8_SB(b, h) ((4 + (b) * 2 + (h)) * HTB)
    const unsigned ldsb = (unsigned)(size_t)lds;
#define PG8_STAGE(bufoff, gbase, voff) do { _Pragma("unroll") for (int _i = 0; _i < 2; ++_i) \
        asm volatile("s_mov_b32 m0, %2\n\tglobal_load_lds_dwordx4 %0, %1" :: "v"((voff)[_i]), "s"((const char*)(gbase)), "s"(ldsb + (unsigned)(bufoff) + ldsw + (unsigned)(_i * 8192)) : "memory", "m0"); } while (0)
#define PG8_CAT(x0, x1) __builtin_shufflevector(x0, x1, 0, 1, 2, 3, 4, 5, 6, 7)
#define PG8_LDA(dst, b, h) do { if constexpr (Prob::FP8) { _Pragma("unroll") for (int m = 0; m < 4; ++m) dst##8[m] = PG8_CAT(*(const LAS i32x4*)(lds + PG8_SA(b, h) + aoff + m * 2048), *(const LAS i32x4*)(lds + PG8_SA(b, h) + aoff + m * 2048 + 1024)); } \
        else { _Pragma("unroll") for (int m = 0; m < 4; ++m) _Pragma("unroll") for (int k = 0; k < 2; ++k) dst[m][k] = *(const LAS bf16x8*)(lds + PG8_SA(b, h) + aoff + m * 2048 + k * 1024); } } while (0)
#define PG8_LDB(dst, b, h) do { if constexpr (Prob::FP8) { _Pragma("unroll") for (int n = 0; n < 2; ++n) dst##8[n] = PG8_CAT(*(const LAS i32x4*)(lds + PG8_SB(b, h) + boff + n * 2048), *(const LAS i32x4*)(lds + PG8_SB(b, h) + boff + n * 2048 + 1024)); } \
        else { _Pragma("unroll") for (int n = 0; n < 2; ++n) _Pragma("unroll") for (int k = 0; k < 2; ++k) dst[n][k] = *(const LAS bf16x8*)(lds + PG8_SB(b, h) + boff + n * 2048 + k * 1024); } } while (0)
#define PG8_MMA(ai, bj, At, Bt) do { __builtin_amdgcn_s_setprio(1); \
        if constexpr (Prob::FP8) { _Pragma("unroll") for (int m = 0; m < 4; ++m) _Pragma("unroll") for (int n = 0; n < 2; ++n) \
            acc[ai][bj][m][n] = __builtin_amdgcn_mfma_scale_f32_16x16x128_f8f6f4(Bt##8[n], At##8[m], acc[ai][bj][m][n], 0, 0, 0, 0, 0, 0); } \
        else { _Pragma("unroll") for (int m = 0; m < 4; ++m) _Pragma("unroll") for (int n = 0; n < 2; ++n) _Pragma("unroll") for (int k = 0; k < 2; ++k) \
            acc[ai][bj][m][n] = __builtin_amdgcn_mfma_f32_16x16x32_bf16(Bt[n][k], At[m][k], acc[ai][bj][m][n], 0, 0, 0); } \
        __builtin_amdgcn_s_setprio(0); } while (0)
#define PG8_WAIT_V(n) asm volatile("s_waitcnt vmcnt(" #n ")" ::: "memory")
#define PG8_WAIT_L(n) asm volatile("s_waitcnt lgkmcnt(" #n ")" ::: "memory")
#define PG8_BAR __builtin_amdgcn_s_barrier()
#define PG8_SCHED __builtin_amdgcn_sched_barrier(0)
    Unit cur, nxt; int ui = 0;
    if (!S.next(0, cur)) return;
    f32x4 acc[2][2][4][2];
    float zero_; asm volatile("v_mov_b32 %0, 0" : "=v"(zero_));
#pragma unroll
    for (int a = 0; a < 2; ++a)
#pragma unroll
        for (int b = 0; b < 2; ++b)
#pragma unroll
            for (int m = 0; m < 4; ++m)
#pragma unroll
                for (int n = 0; n < 2; ++n) acc[a][b][m][n] = (f32x4){zero_, zero_, zero_, zero_};
    bf16x8 At[4][2], B0[2][2], B1[2][2]; i32x8 At8[4], B08[2], B18[2];
    const char* cA = P.a_base(cur); const char* cB = P.b_base(cur); int nt = P.nt(cur);
    if constexpr (Prob::GATHER) { PG8_RC(Rr, Cc); P.a_rows(cur, Rr, Cc, offA); }
    if constexpr (Epi::SIDE) { PG8_TID(tl4_); E.side(cur, ldsb + SIDE_SLOT, wid, tl4_ & 63); }
    PG8_STAGE(PG8_SB(0, 0), cB, voffB); PG8_STAGE(PG8_SB(0, 1), cB + hstep, voffB); PG8_STAGE(PG8_SA(0, 0), cA, offA[0]); PG8_STAGE(PG8_SA(0, 1), cA, offA[1]);
    if (wr == 1) PG8_BAR;
    PG8_WAIT_V(2); PG8_BAR;
    PG8_STAGE(PG8_SB(1, 0), cB + kstep, voffB); PG8_STAGE(PG8_SA(1, 0), cA + kstep, offA[0]); PG8_STAGE(PG8_SB(1, 1), cB + hstep + kstep, voffB);
    PG8_WAIT_V(6); PG8_BAR;
    for (;;) {
        const bool has_next = S.next(ui + 1, nxt);
        const char* nA = has_next ? P.a_base(nxt) : cA; const char* nB = has_next ? P.b_base(nxt) : cB;
        if constexpr (Prob::GATHER) { if (has_next) { PG8_RC(Rr, Cc); (void)Cc;
#pragma unroll
            for (int h = 0; h < 2; ++h)
#pragma unroll
                for (int i = 0; i < 2; ++i) dma4((unsigned)(nxt.pm * 256 + h * 128 + Rr[i]) * 4u, P.tok, ldsb + SIDE_TOK + (unsigned)wid * 1024u + (unsigned)((h * 2 + i) * 256)); } }
        if constexpr (Epi::SIDE) { if (has_next) { PG8_TID(tl4_); E.side(nxt, ldsb + SIDE_SLOT + (unsigned)(((ui + 1) % 3) * SIDE_SLOT_BYTES), wid, tl4_ & 63); } }
        for (int t = 0; t < nt; t += 2) {
            const bool last = (t == nt - 2);
            if constexpr (Epi::KHOOK) { if (t == Epi::HOOK_T0 || t == Epi::HOOK_T1) {
                asm volatile("" ::: "memory"); PG8_TID(tlh_); const int lnh_ = tlh_ & 63; E.hook(acc, cur, t == Epi::HOOK_T0 ? 0 : 1, wr, wc, lnh_ & 15, lnh_ >> 4); asm volatile("" ::: "memory"); } }
            const char* a1 = cA + (size_t)(t + 1) * kstep;
            const char* a2 = last ? nA : cA + (size_t)(t + 2) * kstep; const char* b2 = last ? nB : cB + (size_t)(t + 2) * kstep;
            const char* a3 = a2 + kstep; const char* b3 = b2 + kstep;
            PG8_LDB(B0, 0, 0); PG8_LDB(B1, 0, 1); PG8_SCHED; PG8_LDA(At, 0, 0); PG8_STAGE(PG8_SA(1, 1), a1, offA[1]);
            PG8_WAIT_V(8); PG8_WAIT_L(0); PG8_BAR; PG8_MMA(0, 0, At, B0); PG8_MMA(0, 1, At, B1); PG8_BAR; PG8_SCHED;
            if constexpr (Prob::GATHER) { if (last && has_next) { PG8_RC(Rr, Cc); (void)Rr; PG8_TOKSLOT(tokslot); const int ntok[2][2] = {{tokslot[0], tokslot[64]}, {tokslot[128], tokslot[192]}}; P.a_off(ntok, Cc, offA); } }
            PG8_LDA(At, 0, 1); PG8_STAGE(PG8_SB(0, 0), b2, voffB); PG8_STAGE(PG8_SB(0, 1), b2 + hstep, voffB); PG8_STAGE(PG8_SA(0, 0), a2, offA[0]);
            PG8_WAIT_V(8); PG8_WAIT_L(0); PG8_BAR; PG8_MMA(1, 0, At, B0); PG8_MMA(1, 1, At, B1); PG8_BAR; PG8_SCHED;
            PG8_LDB(B0, 1, 0); PG8_LDB(B1, 1, 1); PG8_SCHED; PG8_LDA(At, 1, 0); PG8_STAGE(PG8_SA(0, 1), a2, offA[1]);
            PG8_WAIT_V(8); PG8_WAIT_L(0); PG8_BAR; PG8_MMA(0, 0, At, B0); PG8_MMA(0, 1, At, B1); PG8_BAR; PG8_SCHED;
            PG8_LDA(At, 1, 1); PG8_STAGE(PG8_SB(1, 0), b3, voffB); PG8_STAGE(PG8_SB(1, 1), b3 + hstep, voffB); PG8_STAGE(PG8_SA(1, 0), a3, offA[0]);
            PG8_WAIT_V(8); PG8_WAIT_L(0); PG8_BAR; PG8_MMA(1, 0, At, B0); PG8_MMA(1, 1, At, B1); PG8_BAR; PG8_SCHED;
        }
        if (wr == 0) PG8_BAR;
        { PG8_TID(tl3_); const int ln_ = tl3_ & 63; E(acc, cur, wr, wc, ln_ & 15, ln_ >> 4, lds + SIDE_SLOT + (ui % 3) * SIDE_SLOT_BYTES); }
        if (!has_next) break;
        bool keep = false;
        if constexpr (Epi::CHAIN) keep = E.keep(cur);
        if (!keep) {
            asm volatile("v_mov_b32 %0, 0" : "=v"(zero_));
#pragma unroll
            for (int a = 0; a < 2; ++a)
#pragma unroll
                for (int b = 0; b < 2; ++b)
#pragma unroll
                    for (int m = 0; m < 4; ++m)
#pragma unroll
                        for (int n = 0; n < 2; ++n) acc[a][b][m][n] = (f32x4){zero_, zero_, zero_, zero_};
        }
        cur = nxt; cA = nA; cB = nB; nt = P.nt(cur); ++ui;
        if (wr == 1) PG8_BAR;
    }
    PG8_WAIT_V(0);
    PG8_BAR;
#undef PG8_RC
#undef PG8_TID
#undef PG8_TOKSLOT
#undef PG8_SA
#undef PG8_SB
#undef PG8_STAGE
#undef PG8_LDA
#undef PG8_LDB
#undef PG8_MMA
#undef PG8_CAT
#undef PG8_WAIT_V
#undef PG8_WAIT_L
#undef PG8_BAR
#undef PG8_SCHED
}
}

typedef const float* cfp_t;
typedef const cfp_t __attribute__((address_space(4))) * InTab;
struct Frame {
    LAS unsigned char* lds;
    volatile LAS unsigned* MISC;
    unsigned char* ws;
    InTab in;
    float* out;
    int tid, lane, wave, G, bid;
};
enum { IN_X = 0, IN_C, IN_CTX, IN_CCTX, IN_WADA, IN_BADA, IN_WIN, IN_BIN, IN_POOLW, IN_POOLS, IN_CONVW, IN_CONVB, IN_MNG, IN_SLNG, IN_SLNB, IN_SGUW, IN_SGUB,
       IN_WBP, IN_WBM, IN_WBS, IN_WOUT, IN_LN1G, IN_LN1B, IN_WR, IN_BR, IN_WGU, IN_BGU, IN_WDN, IN_BDN, IN_LN2G, IN_LN2B };
__device__ __forceinline__ int mod_row(int row) { return row < ML ? (row >> 12) : NB; }
__device__ __forceinline__ const float* modp(const Frame& F, int l, int row, int part) { return (const float*)(F.ws + WS_MOD) + ((size_t)(l * 17 + mod_row(row)) * 6 + part) * 1024; }

__device__ __forceinline__ void transpose_item(const float* W, size_t ldw, int k0, int srccol0, bf16_t* dst, size_t ldk, int kd0, LAS float* scr, int lane) {
#pragma unroll 8
    for (int i = 0; i < 32; ++i) { const int kk = 2 * i + (lane >> 5); scr[kk * 33 + (lane & 31)] = __builtin_nontemporal_load(W + (size_t)(k0 + kk) * ldw + srccol0 + (lane & 31)); }
    LDS_WAIT(); asm volatile("" ::: "memory");
    const int c = lane & 7;
#pragma unroll
    for (int j = 0; j < 4; ++j) { const int n = (lane >> 3) + 8 * j; const LAS float* s = scr + (8 * c) * 33 + n;
        u32x4 o; o.x = pk2(s[0 * 33], s[1 * 33]); o.y = pk2(s[2 * 33], s[3 * 33]); o.z = pk2(s[4 * 33], s[5 * 33]); o.w = pk2(s[6 * 33], s[7 * 33]);
        *(u32x4*)(dst + (size_t)n * ldk + kd0 + 8 * c) = o; }
    LDS_WAIT(); asm volatile("" ::: "memory");
}
__device__ __forceinline__ void transpose_item_fp8(const float* W, size_t ldw, int k0, int srccol0, unsigned char* dst, size_t ldk, int kd0, float sc, LAS float* scr, int lane) {
#pragma unroll 8
    for (int i = 0; i < 32; ++i) { const int kk = 2 * i + (lane >> 5); scr[kk * 33 + (lane & 31)] = __builtin_nontemporal_load(W + (size_t)(k0 + kk) * ldw + srccol0 + (lane & 31)); }
    LDS_WAIT(); asm volatile("" ::: "memory");
    const int c = lane & 7;
#pragma unroll
    for (int j = 0; j < 4; ++j) { const int n = (lane >> 3) + 8 * j; const LAS float* s_ = scr + (8 * c) * 33 + n;
        u32x2 o; o.x = pk4_fp8(s_[0 * 33] * sc, s_[1 * 33] * sc, s_[2 * 33] * sc, s_[3 * 33] * sc); o.y = pk4_fp8(s_[4 * 33] * sc, s_[5 * 33] * sc, s_[6 * 33] * sc, s_[7 * 33] * sc);
        *(u32x2*)(dst + (size_t)n * ldk + kd0 + 8 * c) = o; }
    LDS_WAIT(); asm volatile("" ::: "memory");
}
__device__ __forceinline__ void phase_prologue(Frame& F) {
    LAS float* scr = (LAS float*)(F.lds + F.wave * 16384);
    const int gw = F.bid * NWAVES + F.wave, NGW = F.G * NWAVES;
    constexpr int I_IN = 16 * (NZ / 32);
    constexpr int I_BR = (4 + 8 + 4) * 32;
    constexpr int I_OUT = 16 * 32;
    constexpr int I_GU = 16 * 64;
    constexpr int I_DN = 16 * 32;
    constexpr int T_IN = DEPTH * I_IN, T_BR = DEPTH * I_BR, T_OUT = DEPTH * I_OUT, T_GU = DEPTH * NEXP * I_GU, T_DN = DEPTH * NEXP * I_DN;
    constexpr int NITEMS = T_IN + T_BR + T_OUT + T_GU + T_DN;
    for (int it = gw; it < NITEMS; it += NGW) {
        int r = it;
        if (r < T_IN) { const int l = r / I_IN; r %= I_IN; const int kb = r / (NZ / 32), nb = r % (NZ / 32); const int n0 = nb * 32, src = n0 < 2304 ? n0 : n0 + 16;
            if (n0 < NZ_BF) transpose_item(F.in[IN_WIN] + (size_t)l * D * 5904, 5904, kb * 64, src, (bf16_t*)(F.ws + WS_WIN) + ((size_t)l * NZ + n0) * D, D, kb * 64, scr, F.lane);
            else transpose_item_fp8(F.in[IN_WIN] + (size_t)l * D * 5904, 5904, kb * 64, src, (unsigned char*)(F.ws + WS_WIN8) + ((size_t)l * NZ_F8 + (n0 - NZ_BF)) * D, D, kb * 64, F8S_WGU, scr, F.lane);
            continue; }
        r -= T_IN;
        if (r < T_BR) { const int l = r / I_BR; r %= I_BR; const int kb = r / 32, nb = r % 32;
            const float* W; int ksrc;
            if (kb < 4) { W = F.in[IN_WBP] + (size_t)l * 256 * D; ksrc = kb * 64; } else if (kb < 12) { W = F.in[IN_WBM] + (size_t)l * 512 * D; ksrc = (kb - 4) * 64; } else { W = F.in[IN_WBS] + (size_t)l * 256 * D; ksrc = (kb - 12) * 64; }
            transpose_item(W, D, ksrc, nb * 32, (bf16_t*)(F.ws + WS_WBR) + ((size_t)l * D + nb * 32) * D, D, kb * 64, scr, F.lane); continue; }
        r -= T_BR;
        if (r < T_OUT) { const int l = r / I_OUT; r %= I_OUT; const int kb = r / 32, nb = r % 32;
            transpose_item(F.in[IN_WOUT] + (size_t)l * D * D, D, kb * 64, nb * 32, (bf16_t*)(F.ws + WS_WOUT) + ((size_t)l * D + nb * 32) * D, D, kb * 64, scr, F.lane); continue; }
        r -= T_OUT;
        if (r < T_GU) { const int le = r / I_GU; r %= I_GU; const int kb = r / 64, nb = r % 64; const int n0 = nb * 32;
            const int pn = n0 >> 8, c = n0 & 255; const int src = c < 128 ? (128 * pn + c) : (1024 + 128 * pn + c - 128);
            transpose_item_fp8(F.in[IN_WGU] + (size_t)le * D * 2048, 2048, kb * 64, src, (unsigned char*)(F.ws + WS_WGU) + ((size_t)le * 2048 + n0) * D, D, kb * 64, F8S_WGU, scr, F.lane); continue; }
        r -= T_GU;
        { const int le = r / I_DN; r %= I_DN; const int kb = r / 32, nb = r % 32;
            transpose_item_fp8(F.in[IN_WDN] + (size_t)le * D * D, D, kb * 64, nb * 32, (unsigned char*)(F.ws + WS_WDN) + ((size_t)le * D + nb * 32) * D, D, kb * 64, F8S_WDN, scr, F.lane); }
    }
    { const int gt = F.bid * NTHREADS + F.tid, NGT = F.G * NTHREADS;
      for (int i = gt; i < DEPTH * 16 * 1024; i += NGT) { const int l = i >> 14, g = (i >> 10) & 15, k = i & 1023; ((float*)(F.ws + WS_WG))[i] = F.in[IN_WIN][((size_t)l * D + k) * 5904 + 2304 + g]; }
      for (int i = gt; i < DEPTH * 4 * 128 * 128; i += NGT) ((bf16_t*)(F.ws + WS_WSGU))[i] = (bf16_t)f2bf(F.in[IN_SGUW][i]);
      for (int i = gt; i < DEPTH * 4 * 64 * 64; i += NGT) { const int lg = i >> 12, d = (i >> 6) & 63, c = i & 63; ((bf16_t*)(F.ws + WS_WPOOL))[i] = (bf16_t)f2bf(F.in[IN_POOLW][(size_t)lg * 4096 + c * 64 + d]); } }
    __syncthreads();
    { LAS float* sc = (LAS float*)F.lds;
      LAS float* part = (LAS float*)(F.lds + 71680);
      for (int i = F.tid; i < 17 * 1024; i += NTHREADS) { const int r = i >> 10, k = i & 1023; const float v = r < 16 ? F.in[IN_C][r * 1024 + k] : F.in[IN_CCTX][k]; sc[i] = siluf_(v); }
      __syncthreads();
      for (int u = F.bid; u < DEPTH * 48; u += F.G) {
          const int l = u / 48, n0 = (u % 48) * 128, col = F.tid & 127, ks = F.tid >> 7;
          float a[17];
#pragma unroll
          for (int r = 0; r < 17; ++r) a[r] = 0.f;
          const float* W = F.in[IN_WADA] + (size_t)l * D * 6144 + n0 + col;
          for (int k = ks * 256; k < ks * 256 + 256; ++k) { const float w = W[(size_t)k * 6144];
#pragma unroll
              for (int r = 0; r < 17; ++r) a[r] += sc[r * 1024 + k] * w; }
#pragma unroll
          for (int r = 0; r < 17; ++r) part[(ks * 17 + r) * 128 + col] = a[r];
          __syncthreads();
          for (int i = F.tid; i < 17 * 128; i += NTHREADS) { const int r = i >> 7, cc = i & 127;
              const float s = part[(0 * 17 + r) * 128 + cc] + part[(1 * 17 + r) * 128 + cc] + part[(2 * 17 + r) * 128 + cc] + part[(3 * 17 + r) * 128 + cc] + F.in[IN_BADA][l * 6144 + n0 + cc];
              ((float*)(F.ws + WS_MOD))[(size_t)(l * 17 + r) * 6144 + n0 + cc] = s; }
          __syncthreads();
      } }
}

struct RowV { f32x4 v[4]; };
#define RC(lane, j) (8 * (lane) + 512 * ((j) >> 1) + 4 * ((j) & 1))
__device__ __forceinline__ void row_load(RowV& r, const float* p, int lane) {
#pragma unroll
    for (int j = 0; j < 4; ++j) r.v[j] = __builtin_nontemporal_load((const f32x4*)(p + RC(lane, j)));
}
__device__ __forceinline__ void row_load_bf16(RowV& r, const bf16_t* p, int lane) {
#pragma unroll
    for (int h = 0; h < 2; ++h) { const u32x4 w = __builtin_nontemporal_load((const u32x4*)(p + 8 * lane + 512 * h)); r.v[2 * h] = (f32x4){bflo(w.x), bfhi(w.x), bflo(w.y), bfhi(w.y)}; r.v[2 * h + 1] = (f32x4){bflo(w.z), bfhi(w.z), bflo(w.w), bfhi(w.w)}; }
}
__device__ __forceinline__ void row_store(const RowV& r, float* p, int lane) {
#pragma unroll
    for (int j = 0; j < 4; ++j) *(f32x4*)(p + RC(lane, j)) = r.v[j];
}
__device__ __forceinline__ void row_store_nt(const RowV& r, float* p, int lane) {
#pragma unroll
    for (int j = 0; j < 4; ++j) __builtin_nontemporal_store(r.v[j], (f32x4*)(p + RC(lane, j)));
}
__device__ __forceinline__ void row_store_bf16_nt(const RowV& r, bf16_t* p, int lane) {
#pragma unroll
    for (int h = 0; h < 2; ++h) { u32x4 w; w.x = pk2(r.v[2 * h].x, r.v[2 * h].y); w.y = pk2(r.v[2 * h].z, r.v[2 * h].w); w.z = pk2(r.v[2 * h + 1].x, r.v[2 * h + 1].y); w.w = pk2(r.v[2 * h + 1].z, r.v[2 * h + 1].w); __builtin_nontemporal_store(w, (u32x4*)(p + 8 * lane + 512 * h)); }
}
__device__ __forceinline__ void row_store_bf16(const RowV& r, bf16_t* p, int lane) {
#pragma unroll
    for (int h = 0; h < 2; ++h) { u32x4 w; w.x = pk2(r.v[2 * h].x, r.v[2 * h].y); w.y = pk2(r.v[2 * h].z, r.v[2 * h].w); w.z = pk2(r.v[2 * h + 1].x, r.v[2 * h + 1].y); w.w = pk2(r.v[2 * h + 1].z, r.v[2 * h + 1].w); *(u32x4*)(p + 8 * lane + 512 * h) = w; }
}
__device__ __forceinline__ void row_ln_plain(RowV& r, int lane) {
    float s = 0.f;
#pragma unroll
    for (int j = 0; j < 4; ++j) s += (r.v[j].x + r.v[j].y) + (r.v[j].z + r.v[j].w);
    const float mean = wave_sum(s, lane) * (1.f / D); float s2 = 0.f;
#pragma unroll
    for (int j = 0; j < 4; ++j) { r.v[j] = r.v[j] - mean; s2 += (r.v[j].x * r.v[j].x + r.v[j].y * r.v[j].y) + (r.v[j].z * r.v[j].z + r.v[j].w * r.v[j].w); }
    const float rstd = __builtin_amdgcn_rsqf(wave_sum(s2, lane) * (1.f / D) + LN_EPS);
#pragma unroll
    for (int j = 0; j < 4; ++j) r.v[j] = r.v[j] * rstd;
}
__device__ __forceinline__ void row_affine(RowV& r, const float* g, const float* b, int lane) {
#pragma unroll
    for (int j = 0; j < 4; ++j) { const f32x4 gg = *(const f32x4*)(g + RC(lane, j)), bb = *(const f32x4*)(b + RC(lane, j)); r.v[j] = r.v[j] * gg + bb; }
}
__device__ __forceinline__ void row_modulate(RowV& r, const float* sh, const float* sc, int lane) {
#pragma unroll
    for (int j = 0; j < 4; ++j) { const f32x4 s1 = *(const f32x4*)(sc + RC(lane, j)), s0 = *(const f32x4*)(sh + RC(lane, j)); r.v[j] = r.v[j] * (s1 + 1.0f) + s0; }
}
__device__ __forceinline__ LAS float* pv_slot(const Frame& F, int slot) { return (LAS float*)(F.lds + NW_PV) + slot * 1024; }
__device__ __forceinline__ void pv_fill(Frame& F, int slot, const float* src) { LAS f32x4* d = (LAS f32x4*)pv_slot(F, slot); for (int i = F.tid; i < 256; i += NTHREADS) d[i] = *(const f32x4*)(src + 4 * i); }
__device__ __forceinline__ void row_affine_l(RowV& r, const LAS float* g, const LAS float* b, int lane) {
#pragma unroll
    for (int j = 0; j < 4; ++j) { const f32x4 gg = *(const LAS f32x4*)(g + RC(lane, j)), bb = *(const LAS f32x4*)(b + RC(lane, j)); r.v[j] = r.v[j] * gg + bb; }
}
__device__ __forceinline__ void row_modulate_l(RowV& r, const LAS float* sh, const LAS float* sc, int lane) {
#pragma unroll
    for (int j = 0; j < 4; ++j) { const f32x4 s1 = *(const LAS f32x4*)(sc + RC(lane, j)), s0 = *(const LAS f32x4*)(sh + RC(lane, j)); r.v[j] = r.v[j] * (s1 + 1.0f) + s0; }
}
__device__ __forceinline__ void ln0_row(Frame& F, int row, RowV xr, const LAS float* sh, const LAS float* sc) {
    row_ln_plain(xr, F.lane);
    row_modulate_l(xr, sh, sc, F.lane);
    row_store_bf16(xr, (bf16_t*)(F.ws + WS_H) + (size_t)row * D, F.lane);
    { unsigned char* h8 = (unsigned char*)(F.ws + WS_H8) + (size_t)row * D + 8 * F.lane;
#pragma unroll
      for (int h = 0; h < 2; ++h) { u32x2 w; w.x = pk4_fp8(xr.v[2 * h].x * F8S_ACT, xr.v[2 * h].y * F8S_ACT, xr.v[2 * h].z * F8S_ACT, xr.v[2 * h].w * F8S_ACT); w.y = pk4_fp8(xr.v[2 * h + 1].x * F8S_ACT, xr.v[2 * h + 1].y * F8S_ACT, xr.v[2 * h + 1].z * F8S_ACT, xr.v[2 * h + 1].w * F8S_ACT); *(u32x2*)(h8 + 512 * h) = w; } }
}
__device__ __forceinline__ LAS float* narrow_tile_wave(Frame& F, const bf16_t* A) {
    const int r = F.lane & 31, h = F.lane >> 5;
    f32x16 acc;
#pragma unroll
    for (int i = 0; i < 16; ++i) acc[i] = 0.f;
    const bf16_t* ap = A + (size_t)r * D + 8 * h;
    const LAS unsigned char* bp = F.lds + NW_WT + r * 2064 + 16 * h;
    bf16x8 av[2][16];
#pragma unroll
    for (int ks = 0; ks < 16; ++ks) av[0][ks] = *(const bf16x8*)(ap + ks * 16);
#pragma unroll
    for (int kb = 0; kb < 4; ++kb) {
        if (kb < 3) {
#pragma unroll
            for (int ks = 0; ks < 16; ++ks) av[(kb + 1) & 1][ks] = *(const bf16x8*)(ap + ((kb + 1) * 16 + ks) * 16); }
        __builtin_amdgcn_sched_barrier(0);
#pragma unroll
        for (int ks = 0; ks < 16; ++ks) { const bf16x8 b = *(const LAS bf16x8*)(bp + (kb * 16 + ks) * 32); acc = __builtin_amdgcn_mfma_f32_32x32x16_bf16(av[kb & 1][ks], b, acc, 0, 0, 0); }
        __builtin_amdgcn_sched_barrier(0);
    }
    LAS float* lg = (LAS float*)(F.lds + NW_LG) + F.wave * 1056;
#pragma unroll
    for (int i = 0; i < 16; ++i) lg[((i & 3) + 8 * (i >> 2) + 4 * h) * 33 + r] = acc[i];
    asm volatile("s_waitcnt lgkmcnt(0)" ::: "memory");
    return lg;
}
__device__ __forceinline__ void tile_range(const Frame& F, int mrows, int& t_lo, int& t_hi) { const int nt = mrows / 32; t_lo = (int)(((long)F.bid * nt) / F.G); t_hi = (int)(((long)(F.bid + 1) * nt) / F.G); }
__device__ __forceinline__ void load_wg_lds(Frame& F, int l) {
    const float* src = (const float*)(F.ws + WS_WG) + (size_t)l * 16384;
    for (int i = F.tid; i < 32 * 128; i += NTHREADS) { const int g = i >> 7, c8 = i & 127; u32x4 w = (u32x4){0u, 0u, 0u, 0u};
        if (g < 16) { const f32x4 a = *(const f32x4*)(src + g * 1024 + c8 * 8), b = *(const f32x4*)(src + g * 1024 + c8 * 8 + 4); w.x = pk2(a.x, a.y); w.y = pk2(a.z, a.w); w.z = pk2(b.x, b.y); w.w = pk2(b.z, b.w); }
        *(LAS u32x4*)(F.lds + NW_WT + g * 2064 + c8 * 16) = w; }
    __syncthreads();
}
__device__ __forceinline__ void gates_tail(Frame& F, int l, int t_lo, int t_hi) {
    asm volatile("s_waitcnt vmcnt(0)" ::: "memory"); __syncthreads();
    const int g = F.lane & 15; const float bias = F.in[IN_BIN][l * 5904 + 2304 + g];
    for (int tile = t_lo + F.wave; tile < t_hi; tile += NWAVES) {
        const LAS float* lg = narrow_tile_wave(F, (const bf16_t*)(F.ws + WS_H) + (size_t)tile * 32 * D);
#pragma unroll
        for (int rr = 0; rr < 8; ++rr) { const int row = rr * 4 + (F.lane >> 4); ((float*)(F.ws + WS_ZG))[(size_t)(tile * 32 + row) * 16 + g] = lg[row * 33 + g] + bias; }
        asm volatile("s_waitcnt lgkmcnt(0)" ::: "memory");
    }
}

using pg8::Unit;
struct ProbPlain {
    static constexpr bool GATHER = false, FP8 = false; static constexpr int SCALE_A = 127, SCALE_B = 127; const bf16_t* A; const bf16_t* Bt; int lda, ldb;
    __device__ __forceinline__ int nt(const Unit&) const { return lda / 64; }
    __device__ __forceinline__ const char* a_base(const Unit& u) const { return (const char*)A + (size_t)u.pm * 256 * lda * 2; }
    __device__ __forceinline__ const char* b_base(const Unit& u) const { return (const char*)Bt + (size_t)u.pn * 256 * ldb * 2; }
    __device__ __forceinline__ void a_tok(const Unit&, const int (&)[2], int (&)[2][2]) const {}
    __device__ __forceinline__ void a_off(const int (&)[2][2], const int (&)[2], unsigned (&)[2][2]) const {}
    __device__ __forceinline__ void a_rows(const Unit&, const int (&)[2], const int (&)[2], unsigned (&)[2][2]) const {}
};
struct ProbPlainF8 {
    static constexpr bool GATHER = false, FP8 = true; static constexpr int SCALE_A = F8E_ACT, SCALE_B = F8E_WGU; const bf16_t* A; const bf16_t* Bt; int lda, ldb;
    __device__ __forceinline__ int nt(const Unit&) const { return lda / 64; }
    __device__ __forceinline__ const char* a_base(const Unit& u) const { return (const char*)A + (size_t)u.pm * 256 * lda * 2; }
    __device__ __forceinline__ const char* b_base(const Unit& u) const { return (const char*)Bt + (size_t)u.pn * 256 * ldb * 2; }
    __device__ __forceinline__ void a_tok(const Unit&, const int (&)[2], int (&)[2][2]) const {}
    __device__ __forceinline__ void a_off(const int (&)[2][2], const int (&)[2], unsigned (&)[2][2]) const {}
    __device__ __forceinline__ void a_rows(const Unit&, const int (&)[2], const int (&)[2], unsigned (&)[2][2]) const {}
};
struct ProbBranch {
    static constexpr bool GATHER = false, FP8 = false; static constexpr int SCALE_A = 127, SCALE_B = 127; const bf16_t* A; const bf16_t* Bt; int lda, ldb;
    __device__ __forceinline__ int nt(const Unit& u) const { return u.sub == 1 ? 8 : 4; }
    __device__ __forceinline__ int koff(const Unit& u) const { return u.sub == 0 ? 0 : (u.sub == 1 ? 256 : 768); }
    __device__ __forceinline__ const char* a_base(const Unit& u) const { return (const char*)A + ((size_t)u.pm * 256 * lda + koff(u)) * 2; }
    __device__ __forceinline__ const char* b_base(const Unit& u) const { return (const char*)Bt + ((size_t)u.pn * 256 * ldb + koff(u)) * 2; }
    __device__ __forceinline__ void a_tok(const Unit&, const int (&)[2], int (&)[2][2]) const {}
    __device__ __forceinline__ void a_off(const int (&)[2][2], const int (&)[2], unsigned (&)[2][2]) const {}
    __device__ __forceinline__ void a_rows(const Unit&, const int (&)[2], const int (&)[2], unsigned (&)[2][2]) const {}
};
__device__ __forceinline__ int expert_of(const LAS int* seg, int pm) { return __builtin_amdgcn_readfirstlane((int)((const LAS unsigned char*)(seg + 64))[pm]); }
__device__ __forceinline__ int moe_tables(Frame& F, LAS int* seg) {
    __syncthreads();
    if (F.tid <= NEXP) seg[F.tid] = ((const int*)(F.ws + WS_ROUTE + RT_SEG))[F.tid];
    __syncthreads();
    const int ntile = seg[NEXP] / 256;
    LAS unsigned char* texp = (LAS unsigned char*)(seg + 64);
    for (int t = F.tid; t < ntile; t += NTHREADS) { const int row = t * 256; int e = 0;
#pragma unroll
        for (int i = 1; i < NEXP; ++i) e += (seg[i] <= row) ? 1 : 0;
        texp[t] = (unsigned char)e; }
    __syncthreads();
    return ntile;
}
struct ProbMoe1 {
    static constexpr bool GATHER = true, FP8 = true; static constexpr int SCALE_A = F8E_ACT, SCALE_B = F8E_WGU; const bf16_t* A; const bf16_t* Bt; int lda, ldb; const int* tok; const LAS int* seg;
    __device__ __forceinline__ int nt(const Unit&) const { return lda / 64; }
    __device__ __forceinline__ const char* a_base(const Unit&) const { return (const char*)A; }
    __device__ __forceinline__ const char* b_base(const Unit& u) const { const int e = expert_of(seg, u.pm); return (const char*)Bt + ((size_t)e * 2048 + (size_t)u.pn * 256) * ldb * 2; }
    __device__ __forceinline__ void a_rows(const Unit& u, const int (&R)[2], const int (&C)[2], unsigned (&off)[2][2]) const {
#pragma unroll
        for (int h = 0; h < 2; ++h)
#pragma unroll
            for (int i = 0; i < 2; ++i) { const int t = tok[u.pm * 256 + h * 128 + R[i]]; off[h][i] = (unsigned)(t * lda + C[i]) * 2u; } }
    __device__ __forceinline__ void a_tok(const Unit& u, const int (&R)[2], int (&tk)[2][2]) const {
#pragma unroll
        for (int h = 0; h < 2; ++h)
#pragma unroll
            for (int i = 0; i < 2; ++i) tk[h][i] = tok[u.pm * 256 + h * 128 + R[i]]; }
    __device__ __forceinline__ void a_off(const int (&tk)[2][2], const int (&C)[2], unsigned (&off)[2][2]) const {
#pragma unroll
        for (int h = 0; h < 2; ++h)
#pragma unroll
            for (int i = 0; i < 2; ++i) off[h][i] = (unsigned)(tk[h][i] * lda + C[i]) * 2u; }
};
struct ProbMoe2 {
    static constexpr bool GATHER = false, FP8 = true; static constexpr int SCALE_A = F8E_ACT, SCALE_B = F8E_WDN; const bf16_t* A; const bf16_t* Bt; int lda, ldb; const LAS int* seg;
    __device__ __forceinline__ int nt(const Unit&) const { return lda / 64; }
    __device__ __forceinline__ const char* a_base(const Unit& u) const { return (const char*)A + (size_t)u.pm * 256 * lda * 2; }
    __device__ __forceinline__ const char* b_base(const Unit& u) const { const int e = expert_of(seg, u.pm); return (const char*)Bt + ((size_t)e * 1024 + (size_t)u.pn * 256) * ldb * 2; }
    __device__ __forceinline__ void a_tok(const Unit&, const int (&)[2], int (&)[2][2]) const {}
    __device__ __forceinline__ void a_off(const int (&)[2][2], const int (&)[2], unsigned (&)[2][2]) const {}
    __device__ __forceinline__ void a_rows(const Unit&, const int (&)[2], const int (&)[2], unsigned (&)[2][2]) const {}
};
using pg8::cvt_pk_bf16;
template <bool G8> struct EpiInproj {
    static constexpr bool PERM = true, CHAIN = false, SIDE = true, KHOOK = false; bf16_t* Z; const float* bias; int pn0;
    __device__ __forceinline__ void side(const Unit& u0, unsigned slot, int wid, int lane) const { const int pn = u0.pn + pn0; if (wid == 1) pg8::dma16((unsigned)lane * 16u, bias + pn * 256 + (pn >= 9 ? 16 : 0), slot); }
    __device__ __forceinline__ void operator()(const f32x4 (&acc)[2][2][4][2], const Unit& u0, int wr, int wc, int fr, int fq, const LAS unsigned char* sd) const {
        Unit u = u0; u.pn += pn0;
        int row0 = u.pm * 256 + wr * 64 + fr, col0 = u.pn * 256 + wc * 32 + 8 * fq; asm volatile("" : "+v"(row0), "+v"(col0));
        const int act = (u.pn <= 6) ? 0 : ((u.pn == 9 || u.pn == 10) ? 2 : 1);
        f32x4 bv[2][2];
#pragma unroll
        for (int bj = 0; bj < 2; ++bj)
#pragma unroll
            for (int n = 0; n < 2; ++n) bv[bj][n] = *(const LAS f32x4*)(sd + (bj * 128 + wc * 32 + 8 * fq + 4 * n) * 4);
#pragma unroll
        for (int ai = 0; ai < 2; ++ai)
#pragma unroll
            for (int m = 0; m < 4; ++m) { bf16_t* rowp = Z + (size_t)(row0 + ai * 128 + m * 16) * NZ + col0;
#pragma unroll
                for (int bj = 0; bj < 2; ++bj) { f32x4 v0, v1;
                    if constexpr (G8) { v0 = acc[ai][bj][m][0] * F8_DESCALE + bv[bj][0]; v1 = acc[ai][bj][m][1] * F8_DESCALE + bv[bj][1]; } else { v0 = acc[ai][bj][m][0] + bv[bj][0]; v1 = acc[ai][bj][m][1] + bv[bj][1]; }
                    if (G8 && u.pn >= ZG_COL / 256) { u32x2 w8;
                        v0 = sigmoid4(v0) * G8_SCALE; v1 = sigmoid4(v1) * G8_SCALE;
#pragma unroll
                        for (int j = 0; j < 4; ++j) { v0[j] = fmaxf(v0[j], 1.0f); v1[j] = fmaxf(v1[j], 1.0f); }
                        v0 = v0 + 12582912.0f; v1 = v1 + 12582912.0f;
                        w8.x = pk4_u8(v0[0], v0[1], v0[2], v0[3]); w8.y = pk4_u8(v1[0], v1[1], v1[2], v1[3]);
                        *(u32x2*)((unsigned char*)(Z + (size_t)(row0 + ai * 128 + m * 16) * NZ + ZG_COL) + (col0 - ZG_COL) + bj * 128) = w8; continue; }
                    if (act == 2) { f32x2 a = pg8::gelu_pk((f32x2){v0[0], v0[1]}), b = pg8::gelu_pk((f32x2){v0[2], v0[3]}), c = pg8::gelu_pk((f32x2){v1[0], v1[1]}), d = pg8::gelu_pk((f32x2){v1[2], v1[3]});
                        v0 = (f32x4){a.x, a.y, b.x, b.y}; v1 = (f32x4){c.x, c.y, d.x, d.y}; }
                    if (act == 1) { v0 = sigmoid4(v0); v1 = sigmoid4(v1); }
                    u32x4 w; w.x = cvt_pk_bf16(v0[0], v0[1]); w.y = cvt_pk_bf16(v0[2], v0[3]); w.z = cvt_pk_bf16(v1[0], v1[1]); w.w = cvt_pk_bf16(v1[2], v1[3]);
                    *(u32x4*)(rowp + bj * 128) = w; }
                if constexpr (G8) asm volatile("" ::: "memory"); }
    }
};
struct EpiNull {
    static constexpr bool PERM = true, CHAIN = false; bf16_t* Z;
    __device__ __forceinline__ void operator()(const f32x4 (&acc)[2][2][4][2], const Unit& u, int wr, int wc, int fr, int fq) const {
        float sacc = 0.f;
#pragma unroll
        for (int ai = 0; ai < 2; ++ai)
#pragma unroll
            for (int bj = 0; bj < 2; ++bj)
#pragma unroll
                for (int m = 0; m < 4; ++m)
#pragma unroll
                    for (int n = 0; n < 2; ++n) sacc += (acc[ai][bj][m][n][0] + acc[ai][bj][m][n][1]) + (acc[ai][bj][m][n][2] + acc[ai][bj][m][n][3]);
        if (sacc == 1.2345e30f) Z[u.pm + wr + wc + fr + fq] = 0;
    }
};
struct EpiOut {
    static constexpr bool PERM = true, CHAIN = false, SIDE = false, KHOOK = false; bf16_t* T;
    __device__ __forceinline__ void operator()(const f32x4 (&acc)[2][2][4][2], const Unit& u, int wr, int wc, int fr, int fq, const LAS unsigned char*) const {
        int row0 = u.pm * 256 + wr * 64 + fr, col0 = u.pn * 256 + wc * 32 + 8 * fq; asm volatile("" : "+v"(row0), "+v"(col0));
#pragma unroll
        for (int ai = 0; ai < 2; ++ai)
#pragma unroll
            for (int m = 0; m < 4; ++m) { bf16_t* rowp = T + (size_t)(row0 + ai * 128 + m * 16) * D + col0;
#pragma unroll
                for (int bj = 0; bj < 2; ++bj) { const f32x4 v0 = acc[ai][bj][m][0], v1 = acc[ai][bj][m][1];
                    u32x4 w; w.x = cvt_pk_bf16(v0[0], v0[1]); w.y = cvt_pk_bf16(v0[2], v0[3]); w.z = cvt_pk_bf16(v1[0], v1[1]); w.w = cvt_pk_bf16(v1[2], v1[3]);
                    *(u32x4*)(rowp + bj * 128) = w; } }
    }
};
struct EpiBranch {
    static constexpr bool PERM = true, CHAIN = false, SIDE = false, KHOOK = true; static constexpr int HOOK_T0 = 4, HOOK_T1 = 12;
    const bf16_t* Z; bf16_t* Y;
    template <bool FIN> __device__ __forceinline__ void apply(f32x4 (&acc)[2][2][4][2], const Unit& u, int br, int wr, int wc, int fr, int fq) const {
        int row0 = u.pm * 256 + wr * 64 + fr, col0 = u.pn * 256 + wc * 32 + 8 * fq;
        asm volatile("" : "+v"(row0), "+v"(col0));
#pragma unroll
        for (int ai = 0; ai < 2; ++ai) {
            u32x2 ga[4][2], gb[4][2];
#pragma unroll
            for (int m = 0; m < 4; ++m) { const unsigned char* rowp = (const unsigned char*)(Z + (size_t)(row0 + ai * 128 + m * 16) * NZ + ZG_COL) + br * 1024 + col0;
#pragma unroll
                for (int bj = 0; bj < 2; ++bj) { ga[m][bj] = *(const u32x2*)(rowp + bj * 128); if (!FIN) gb[m][bj] = *(const u32x2*)(rowp + 1024 + bj * 128); } }
#pragma unroll
            for (int m = 0; m < 4; ++m) { const size_t row = (size_t)(row0 + ai * 128 + m * 16);
#pragma unroll
                for (int bj = 0; bj < 2; ++bj) { const u32x2 a = ga[m][bj];
                    f32x4 r0 = u8x4_f32(a.x), r1 = u8x4_f32(a.y);
                    if (FIN) { r0 = r0 * (1.0f / G8_SCALE); r1 = r1 * (1.0f / G8_SCALE); }
                    else { const u32x2 b = gb[m][bj]; f32x4 q0 = u8x4_f32(b.x), q1 = u8x4_f32(b.y);
#pragma unroll
                        for (int i = 0; i < 4; ++i) { q0[i] = __builtin_amdgcn_rcpf(q0[i]); q1[i] = __builtin_amdgcn_rcpf(q1[i]); }
                        r0 = r0 * q0; r1 = r1 * q1; }
                    acc[ai][bj][m][0] = acc[ai][bj][m][0] * r0; acc[ai][bj][m][1] = acc[ai][bj][m][1] * r1;
                    if (FIN) { const f32x4 v0 = acc[ai][bj][m][0], v1 = acc[ai][bj][m][1];
                        u32x4 w; w.x = cvt_pk_bf16(v0[0], v0[1]); w.y = cvt_pk_bf16(v0[2], v0[3]); w.z = cvt_pk_bf16(v1[0], v1[1]); w.w = cvt_pk_bf16(v1[2], v1[3]);
                        *(u32x4*)(Y + row * D + col0 + bj * 128) = w; } } }
            asm volatile("" ::: "memory"); }
    }
    __device__ __forceinline__ void hook(f32x4 (&acc)[2][2][4][2], const Unit& u, int br, int wr, int wc, int fr, int fq) const { apply<false>(acc, u, br, wr, wc, fr, fq); }
    __device__ __forceinline__ void operator()(f32x4 (&acc)[2][2][4][2], const Unit& u, int wr, int wc, int fr, int fq, const LAS unsigned char*) const { apply<true>(acc, u, 2, wr, wc, fr, fq); }
};
struct EpiSwiglu {
    static constexpr bool PERM = true, CHAIN = false, SIDE = true, KHOOK = false; unsigned char* HID; const float* bgu; const LAS int* seg;
    __device__ __forceinline__ void side(const Unit& u, unsigned slot, int wid, int lane) const {
        if (wid == 1) { const int e = expert_of(seg, u.pm); pg8::dma16(lane < 32 ? (unsigned)lane * 16u : 4096u + (unsigned)(lane - 32) * 16u, bgu + (size_t)e * 2048 + u.pn * 128, slot); } }
    __device__ __forceinline__ void operator()(const f32x4 (&acc)[2][2][4][2], const Unit& u, int wr, int wc, int fr, int fq, const LAS unsigned char* sd) const {
        int j0 = u.pn * 128 + wc * 32 + 8 * fq, slot0 = u.pm * 256 + wr * 64 + fr; asm volatile("" : "+v"(j0), "+v"(slot0));
        f32x4 bg[2], bu[2];
#pragma unroll
        for (int n = 0; n < 2; ++n) { bg[n] = *(const LAS f32x4*)(sd + (wc * 32 + 8 * fq + 4 * n) * 4); bu[n] = *(const LAS f32x4*)(sd + (128 + wc * 32 + 8 * fq + 4 * n) * 4); }
#pragma unroll
        for (int ai = 0; ai < 2; ++ai)
#pragma unroll
            for (int m = 0; m < 4; ++m) { const size_t slot = (size_t)(slot0 + ai * 128 + m * 16); f32x4 o[2];
#pragma unroll
                for (int n = 0; n < 2; ++n) { f32x4 g = acc[ai][0][m][n] * F8_DESCALE + bg[n], up = acc[ai][1][m][n] * F8_DESCALE + bu[n];
#pragma unroll
                    for (int i = 0; i < 4; ++i) { g[i] = fminf(g[i], 7.0f); up[i] = __builtin_amdgcn_fmed3f(up[i], -7.0f, 7.0f); }
                    f32x4 t = g * (-1.702f * 1.4426950408889634f);
#pragma unroll
                    for (int i = 0; i < 4; ++i) t[i] = __builtin_amdgcn_exp2f(t[i]);
                    t = t + 1.0f;
#pragma unroll
                    for (int i = 0; i < 4; ++i) t[i] = __builtin_amdgcn_rcpf(t[i]);
                    o[n] = (up * F8S_ACT + F8S_ACT) * (g * t); }
                u32x2 w; w.x = pk4_fp8(o[0][0], o[0][1], o[0][2], o[0][3]); w.y = pk4_fp8(o[1][0], o[1][1], o[1][2], o[1][3]);
                *(u32x2*)(HID + slot * 1024 + j0) = w; }
    }
};
struct EpiDown {
    static constexpr bool PERM = true, CHAIN = false, SIDE = true, KHOOK = false; unsigned char* FS; const float* bdn; const int* dest; const float* pslot; const LAS int* seg;
    __device__ __forceinline__ void side(const Unit& u, unsigned slot, int wid, int lane) const {
        if (wid == 1) { const int e = expert_of(seg, u.pm); pg8::dma16((unsigned)lane * 16u, bdn + (size_t)e * 1024 + u.pn * 256, slot); }
        if (wid == 2) pg8::dma16((unsigned)lane * 16u, dest + (size_t)u.pm * 256, slot + 1024u);
        if (wid == 3) pg8::dma16((unsigned)lane * 16u, pslot + (size_t)u.pm * 256, slot + 2048u); }
    __device__ __forceinline__ void operator()(const f32x4 (&acc)[2][2][4][2], const Unit& u, int wr, int wc, int fr, int fq, const LAS unsigned char* sd) const {
        int col0 = u.pn * 256 + wc * 32 + 8 * fq, slot0 = u.pm * 256 + wr * 64 + fr; asm volatile("" : "+v"(col0), "+v"(slot0));
        f32x4 bv[2][2];
#pragma unroll
        for (int bj = 0; bj < 2; ++bj)
#pragma unroll
            for (int n = 0; n < 2; ++n) bv[bj][n] = *(const LAS f32x4*)(sd + (bj * 128 + wc * 32 + 8 * fq + 4 * n) * 4);
#pragma unroll
        for (int ai = 0; ai < 2; ++ai)
#pragma unroll
            for (int m = 0; m < 4; ++m) { const int rt = ai * 128 + wr * 64 + m * 16 + fr; const int d = *(const LAS int*)(sd + 1024 + rt * 4); const float p = *(const LAS float*)(sd + 2048 + rt * 4) * FS_SCALE;
                if (d >= 0) {
#pragma unroll
                    for (int bj = 0; bj < 2; ++bj) { f32x4 v0 = (acc[ai][bj][m][0] * F8_DESCALE + bv[bj][0]) * p, v1 = (acc[ai][bj][m][1] * F8_DESCALE + bv[bj][1]) * p;
#pragma unroll
                        for (int i = 0; i < 4; ++i) { v0[i] = __builtin_amdgcn_fmed3f(v0[i], -FS_CLAMP, FS_CLAMP); v1[i] = __builtin_amdgcn_fmed3f(v1[i], -FS_CLAMP, FS_CLAMP); }
                        u32x2 w; w.x = pk4_fp8(v0[0], v0[1], v0[2], v0[3]); w.y = pk4_fp8(v1[0], v1[1], v1[2], v1[3]);
                        *(u32x2*)(FS + (size_t)d * 1024 + col0 + bj * 128) = w; } }
                asm volatile("" ::: "memory"); }
    }
};

__device__ __forceinline__ const float* xin_row(const Frame& F, int row) { return row < ML ? F.in[IN_X] + (size_t)row * D : F.in[IN_CTX] + (size_t)(row - ML) * D; }
__device__ __forceinline__ void phase_ln0_first(Frame& F) {
    int t_lo, t_hi; tile_range(F, MT, t_lo, t_hi);
    const int r_lo = 32 * t_lo, nrows = 32 * (t_hi - t_lo);
    const int mrA = mod_row(r_lo), mrB = mod_row(r_lo + (nrows > 0 ? nrows - 1 : 0));
    { const float* mb = (const float*)(F.ws + WS_MOD); pv_fill(F, 0, mb + ((size_t)(0 * 17 + mrA) * 6 + 0) * 1024); pv_fill(F, 1, mb + ((size_t)(0 * 17 + mrB) * 6 + 0) * 1024);
      pv_fill(F, 2, mb + ((size_t)(0 * 17 + mrA) * 6 + 1) * 1024); pv_fill(F, 3, mb + ((size_t)(0 * 17 + mrB) * 6 + 1) * 1024); }
    load_wg_lds(F, 0);
    for (int n = F.wave; n < nrows; n += 4 * NWAVES) {
        RowV rv[4];
#pragma unroll
        for (int u = 0; u < 4; ++u) if (n + u * NWAVES < nrows) row_load(rv[u], xin_row(F, r_lo + n + u * NWAVES), F.lane);
#pragma unroll
        for (int u = 0; u < 4; ++u) if (n + u * NWAVES < nrows) { const int row = r_lo + n + u * NWAVES;
            const int sel = (mod_row(row) == mrA) ? 0 : 1; ln0_row(F, row, rv[u], pv_slot(F, 0 + sel), pv_slot(F, 2 + sel)); }
    }
    gates_tail(F, 0, t_lo, t_hi);
    __syncthreads();
}
__device__ __forceinline__ void phase_finalize(Frame& F, int l, int mrows) {
    const int gw = F.bid * NWAVES + F.wave, NGW = F.G * NWAVES;
    const bf16_t* hf = (const bf16_t*)(F.ws + WS_HFB); const bf16_t* hb = hf + (size_t)MT * 512;
    const float* ng = F.in[IN_MNG] + l * 512 + 8 * F.lane;
    const f32x4 g0 = *(const f32x4*)ng, g1 = *(const f32x4*)(ng + 4);
    const bf16_t* zo = (const bf16_t*)(F.ws + WS_Z) + ZC_O + 8 * F.lane;
    u32x4 ha = (u32x4){0u, 0u, 0u, 0u}, hbv = ha, so = ha;
    if (gw < mrows) { ha = __builtin_nontemporal_load((const u32x4*)(hf + (size_t)gw * 512 + 8 * F.lane)); hbv = __builtin_nontemporal_load((const u32x4*)(hb + (size_t)gw * 512 + 8 * F.lane)); so = __builtin_nontemporal_load((const u32x4*)(zo + (size_t)gw * NZ)); }
    for (int row = gw; row < mrows; row += NGW) {
        u32x4 han = ha, hbn = hbv, son = so; const int rn = row + NGW;
        if (rn < mrows) { han = __builtin_nontemporal_load((const u32x4*)(hf + (size_t)rn * 512 + 8 * F.lane)); hbn = __builtin_nontemporal_load((const u32x4*)(hb + (size_t)rn * 512 + 8 * F.lane)); son = __builtin_nontemporal_load((const u32x4*)(zo + (size_t)rn * NZ)); }
        __builtin_amdgcn_sched_barrier(0);
        f32x4 v0 = (f32x4){bflo(ha.x) + bflo(hbv.x), bfhi(ha.x) + bfhi(hbv.x), bflo(ha.y) + bflo(hbv.y), bfhi(ha.y) + bfhi(hbv.y)}, v1 = (f32x4){bflo(ha.z) + bflo(hbv.z), bfhi(ha.z) + bfhi(hbv.z), bflo(ha.w) + bflo(hbv.w), bfhi(ha.w) + bfhi(hbv.w)};
        float s = (v0.x + v0.y) + (v0.z + v0.w) + (v1.x + v1.y) + (v1.z + v1.w);
#pragma unroll
        for (int o = 0; o < 1; ++o) s = row16_sum(s);
        const float mu = s * (1.f / 128.f); v0 = v0 - mu; v1 = v1 - mu;
        float q = (v0.x * v0.x + v0.y * v0.y) + (v0.z * v0.z + v0.w * v0.w) + (v1.x * v1.x + v1.y * v1.y) + (v1.z * v1.z + v1.w * v1.w);
#pragma unroll
        for (int o = 0; o < 1; ++o) q = row16_sum(q);
        const float rstd = __builtin_amdgcn_rsqf(q * (1.f / 128.f) + HEAD_EPS);
        v0 = v0 * rstd * g0; v1 = v1 * rstd * g1;
        u32x4 w; w.x = pk2(v0.x * bflo(so.x), v0.y * bfhi(so.x)); w.y = pk2(v0.z * bflo(so.y), v0.w * bfhi(so.y)); w.z = pk2(v1.x * bflo(so.z), v1.y * bfhi(so.z)); w.w = pk2(v1.z * bflo(so.w), v1.w * bfhi(so.w));
        *(u32x4*)((bf16_t*)(F.ws + WS_BRA) + (size_t)row * D + 256 + 8 * F.lane) = w;
        ha = han; hbv = hbn; so = son;
    }
}
__device__ __forceinline__ void phase_ln1_router(Frame& F, int l, int mrows) {
    LAS int* cnt = (LAS int*)(F.lds + NW_END);
    { const float* wr = F.in[IN_WR] + (size_t)l * D * NEXP;
      for (int i = F.tid; i < NEXP * D; i += NTHREADS) { const int k = i >> 5, e = i & 31; *(LAS bf16_t*)(F.lds + NW_WT + e * 2064 + k * 2) = (bf16_t)f2bf(wr[i]); }
      if (F.tid < NEXP) cnt[F.tid] = 0; }
    const float* brt = F.in[IN_BR] + l * NEXP;
    int t_lo, t_hi; tile_range(F, mrows, t_lo, t_hi);
    const int r_lo = 32 * t_lo, nrows = 32 * (t_hi - t_lo);
    const int mrA = mod_row(r_lo), mrB = mod_row(r_lo + (nrows > 0 ? nrows - 1 : 0));
    { const float* mb = (const float*)(F.ws + WS_MOD); pv_fill(F, 0, F.in[IN_LN1G] + l * D); pv_fill(F, 1, F.in[IN_LN1B] + l * D);
      pv_fill(F, 2, mb + ((size_t)(l * 17 + mrA) * 6 + 2) * 1024); pv_fill(F, 3, mb + ((size_t)(l * 17 + mrB) * 6 + 2) * 1024);
      pv_fill(F, 4, mb + ((size_t)(l * 17 + mrA) * 6 + 3) * 1024); pv_fill(F, 5, mb + ((size_t)(l * 17 + mrB) * 6 + 3) * 1024);
      pv_fill(F, 6, mb + ((size_t)(l * 17 + mrA) * 6 + 4) * 1024); pv_fill(F, 7, mb + ((size_t)(l * 17 + mrB) * 6 + 4) * 1024); }
    __syncthreads();
    { const bf16_t* yb = (const bf16_t*)(F.ws + WS_T) + 8 * F.lane;
      RowV rv[2]; u32x4 yv2[2][2];
#pragma unroll
      for (int u = 0; u < 2; ++u) {
#pragma unroll
          for (int j = 0; j < 4; ++j) rv[u].v[j] = (f32x4){0.f, 0.f, 0.f, 0.f};
          yv2[u][0] = yv2[u][1] = (u32x4){0u, 0u, 0u, 0u}; }
#define RT_LOADPAIR(n_, rv_, yv_) do { _Pragma("unroll") for (int u = 0; u < 2; ++u) if ((n_) + u * NWAVES < nrows) { const int row = r_lo + (n_) + u * NWAVES; \
              if (l == 0) row_load(rv_[u], xin_row(F, row), F.lane); else row_load_bf16(rv_[u], (const bf16_t*)(F.ws + WS_X) + (size_t)row * D, F.lane); \
              _Pragma("unroll") for (int h = 0; h < 2; ++h) yv_[u][h] = __builtin_nontemporal_load((const u32x4*)(yb + (size_t)row * D + 512 * h)); } } while (0)
      RT_LOADPAIR(F.wave, rv, yv2);
      for (int n = F.wave; n < nrows; n += 2 * NWAVES) {
          RowV rvn[2]; u32x4 yvn[2][2];
#pragma unroll
          for (int u = 0; u < 2; ++u) { rvn[u] = rv[u]; yvn[u][0] = yv2[u][0]; yvn[u][1] = yv2[u][1]; }
          RT_LOADPAIR(n + 2 * NWAVES, rvn, yvn);
          __builtin_amdgcn_sched_barrier(0);
#pragma unroll
          for (int u = 0; u < 2; ++u) if (n + u * NWAVES < nrows) { const int row = r_lo + n + u * NWAVES; RowV cur = rv[u];
              const int sel = (mod_row(row) == mrA) ? 0 : 1;
              { const LAS float* g1 = pv_slot(F, 2 + sel);
#pragma unroll
                for (int j = 0; j < 4; ++j) { const f32x4 gg = *(const LAS f32x4*)(g1 + RC(F.lane, j)); const u32x4 yw = yv2[u][j >> 1]; const f32x4 yv = (j & 1) ? (f32x4){bflo(yw.z), bfhi(yw.z), bflo(yw.w), bfhi(yw.w)} : (f32x4){bflo(yw.x), bfhi(yw.x), bflo(yw.y), bfhi(yw.y)}; cur.v[j] = cur.v[j] * DN_ALPHA + gg * yv; } }
              row_ln_plain(cur, F.lane); row_affine_l(cur, pv_slot(F, 0), pv_slot(F, 1), F.lane);
              row_store_bf16_nt(cur, (bf16_t*)(F.ws + WS_X) + (size_t)row * D, F.lane);
              row_ln_plain(cur, F.lane); row_modulate_l(cur, pv_slot(F, 4 + sel), pv_slot(F, 6 + sel), F.lane);
              row_store_bf16(cur, (bf16_t*)(F.ws + WS_H2) + (size_t)row * D, F.lane);
              { unsigned char* h8 = (unsigned char*)(F.ws + WS_H2F8) + (size_t)row * D + 8 * F.lane;
#pragma unroll
                for (int h = 0; h < 2; ++h) { u32x2 w; w.x = pk4_fp8(cur.v[2 * h].x * F8S_ACT, cur.v[2 * h].y * F8S_ACT, cur.v[2 * h].z * F8S_ACT, cur.v[2 * h].w * F8S_ACT); w.y = pk4_fp8(cur.v[2 * h + 1].x * F8S_ACT, cur.v[2 * h + 1].y * F8S_ACT, cur.v[2 * h + 1].z * F8S_ACT, cur.v[2 * h + 1].w * F8S_ACT); *(u32x2*)(h8 + 512 * h) = w; } } }
#pragma unroll
          for (int u = 0; u < 2; ++u) { rv[u] = rvn[u]; yv2[u][0] = yvn[u][0]; yv2[u][1] = yvn[u][1]; }
      }
#undef RT_LOADPAIR
    }
    asm volatile("s_waitcnt vmcnt(0)" ::: "memory"); __syncthreads();
    for (int tile = t_lo + F.wave; tile < t_hi; tile += NWAVES) {
        const LAS float* lgw = narrow_tile_wave(F, (const bf16_t*)(F.ws + WS_H2) + (size_t)tile * 32 * D);
        if (F.lane < 32) {
            const LAS float* lgp = lgw + F.lane * 33; const int row = tile * 32 + F.lane;
            float lg[NEXP];
#pragma unroll
            for (int e = 0; e < NEXP; ++e) lg[e] = lgp[e] + brt[e];
            unsigned used = 0u; float bv[4]; int bi[4];
#pragma unroll
            for (int k = 0; k < 4; ++k) { float best = -3.0e38f; int idx = 0;
#pragma unroll
                for (int e = 0; e < NEXP; ++e) { const bool take = (((used >> e) & 1u) == 0u) && (lg[e] > best); best = take ? lg[e] : best; idx = take ? e : idx; }
                used |= 1u << idx; bv[k] = best; bi[k] = idx; }
            const float e1 = __expf(bv[1] - bv[0]), e2 = __expf(bv[2] - bv[0]), e3 = __expf(bv[3] - bv[0]); const float inv = __builtin_amdgcn_rcpf(1.0f + e1 + e2 + e3);
            int* ei = (int*)(F.ws + WS_ROUTE + RT_EIDX) + (size_t)row * 4; float* pr = (float*)(F.ws + WS_ROUTE + RT_PROB) + (size_t)row * 4;
            *(int4*)ei = make_int4(bi[0], bi[1], bi[2], bi[3]); *(f32x4*)pr = (f32x4){inv, e1 * inv, e2 * inv, e3 * inv};
            atomicAdd((int*)&cnt[bi[0]], 1); atomicAdd((int*)&cnt[bi[1]], 1); atomicAdd((int*)&cnt[bi[2]], 1); atomicAdd((int*)&cnt[bi[3]], 1);
        }
        asm volatile("s_waitcnt lgkmcnt(0)" ::: "memory");
    }
    __syncthreads();
    if (F.tid < NEXP) ((int*)(F.ws + WS_ROUTE + RT_CNT))[F.bid * NEXP + F.tid] = cnt[F.tid];
    __syncthreads();
}
__device__ __forceinline__ void phase_slots(Frame& F, int mrows) {
    LAS int* part = (LAS int*)F.lds;
    LAS int* pre = part + 1024;
    LAS int* tot = pre + 32;
    LAS int* seg = tot + 32;
    LAS int* gcnt = seg + 64;
    LAS int* eix = gcnt + 2048;
    LAS int* rnk = eix + 4096;
    const int* cntg = (const int*)(F.ws + WS_ROUTE + RT_CNT);
    int* tokg = (int*)(F.ws + WS_ROUTE + RT_TOK); int* destg = (int*)(F.ws + WS_ROUTE + RT_DEST); float* psl = (float*)(F.ws + WS_ROUTE + RT_PSLOT);
    int t_lo, t_hi; tile_range(F, mrows, t_lo, t_hi);
    const int row_base = t_lo * 32, nent = (t_hi - t_lo) * 128, ngrp = nent / 64;
    { const int e = F.tid & 31, pt = F.tid >> 5; int a = 0, b = 0;
      for (int c = pt; c < F.G; c += 16) { const int v = cntg[c * NEXP + e]; b += v; a += (c < F.bid) ? v : 0; }
      part[pt * 32 + e] = a; part[512 + pt * 32 + e] = b; }
    for (int i = F.tid; i < nent; i += NTHREADS) eix[i] = ((const int*)(F.ws + WS_ROUTE + RT_EIDX))[(size_t)row_base * 4 + i];
    __syncthreads();
    if (F.tid < NEXP) { int a = 0, b = 0;
#pragma unroll
        for (int pt = 0; pt < 16; ++pt) { a += part[pt * 32 + F.tid]; b += part[512 + pt * 32 + F.tid]; }
        pre[F.tid] = a; tot[F.tid] = b; }
    for (int g = F.wave; g < ngrp; g += NWAVES) {
        const int e = eix[g * 64 + F.lane]; int rank = 0, mycnt = 0;
#pragma unroll 4
        for (int ee = 0; ee < NEXP; ++ee) { const unsigned long long m = __ballot(e == ee); if (e == ee) rank = __popcll(m & ((1ull << F.lane) - 1ull)); if (F.lane == ee) mycnt = __popcll(m); }
        rnk[g * 64 + F.lane] = rank; if (F.lane < NEXP) gcnt[g * 32 + F.lane] = mycnt; }
    __syncthreads();
    if (F.tid == 0) { int s = 0; for (int e = 0; e < NEXP; ++e) { seg[e] = s; s += (tot[e] + 255) & ~255; } seg[NEXP] = s; }
    if (F.tid >= 64 && F.tid < 64 + NEXP) { const int e = F.tid - 64; int run = 0; for (int g = 0; g < ngrp; ++g) { const int c = gcnt[g * 32 + e]; gcnt[g * 32 + e] = run; run += c; } }
    __syncthreads();
    { const float* prg = (const float*)(F.ws + WS_ROUTE + RT_PROB) + (size_t)row_base * 4;
      for (int i = F.tid; i < nent; i += NTHREADS) { const int e = eix[i]; const int slot = seg[e] + pre[e] + gcnt[(i >> 6) * 32 + e] + rnk[i];
          tokg[slot] = row_base + (i >> 2); destg[slot] = row_base * 4 + i; psl[slot] = prg[i]; } }
    if (F.bid < NEXP) { const int e = F.bid; for (int sl = seg[e] + tot[e] + F.tid; sl < seg[e + 1]; sl += NTHREADS) { tokg[sl] = 0; destg[sl] = -1; psl[sl] = 0.f; } }
    if (F.bid == 0 && F.tid <= NEXP) ((int*)(F.ws + WS_ROUTE + RT_SEG))[F.tid] = seg[F.tid];
    __syncthreads();
}
struct CombRaw { u32x4 x[2]; u32x2 f[2][4]; };
__device__ __forceinline__ void comb_load(const Frame& F, int row, CombRaw& r) {
    { const bf16_t* xp = (const bf16_t*)(F.ws + WS_X) + (size_t)row * D + 8 * F.lane;
#pragma unroll
      for (int h = 0; h < 2; ++h) r.x[h] = __builtin_nontemporal_load((const u32x4*)(xp + 512 * h)); }
    const unsigned char* fs = (const unsigned char*)(F.ws + WS_FS) + (size_t)row * 4 * 1024 + 8 * F.lane;
#pragma unroll
    for (int h = 0; h < 2; ++h)
#pragma unroll
        for (int k = 0; k < 4; ++k) r.f[h][k] = __builtin_nontemporal_load((const u32x2*)(fs + k * 1024 + 512 * h));
}
__device__ __forceinline__ void phase_combine_ln2(Frame& F, int l, int mrows) {
    const bool lastl = (l == DEPTH - 1);
    int t_lo, t_hi; tile_range(F, mrows, t_lo, t_hi);
    const int r_lo = 32 * t_lo, nrows = 32 * (t_hi - t_lo);
    const int mrA = mod_row(r_lo), mrB = mod_row(r_lo + (nrows > 0 ? nrows - 1 : 0));
    { const float* mb = (const float*)(F.ws + WS_MOD); const int ln = lastl ? l : l + 1; pv_fill(F, 0, F.in[IN_LN2G] + l * D); pv_fill(F, 1, F.in[IN_LN2B] + l * D);
      pv_fill(F, 2, mb + ((size_t)(l * 17 + mrA) * 6 + 5) * 1024); pv_fill(F, 3, mb + ((size_t)(l * 17 + mrB) * 6 + 5) * 1024);
      pv_fill(F, 4, mb + ((size_t)(ln * 17 + mrA) * 6 + 0) * 1024); pv_fill(F, 5, mb + ((size_t)(ln * 17 + mrB) * 6 + 0) * 1024);
      pv_fill(F, 6, mb + ((size_t)(ln * 17 + mrA) * 6 + 1) * 1024); pv_fill(F, 7, mb + ((size_t)(ln * 17 + mrB) * 6 + 1) * 1024); }
    if (!lastl) load_wg_lds(F, l + 1); else __syncthreads();
    CombRaw rw[2];
#pragma unroll
    for (int u = 0; u < 2; ++u) { rw[u].x[0] = rw[u].x[1] = (u32x4){0u, 0u, 0u, 0u};
#pragma unroll
        for (int k = 0; k < 4; ++k) rw[u].f[0][k] = rw[u].f[1][k] = (u32x2){0u, 0u}; }
#pragma unroll
    for (int u = 0; u < 2; ++u) if (F.wave + u * NWAVES < nrows) comb_load(F, r_lo + F.wave + u * NWAVES, rw[u]);
    for (int n = F.wave; n < nrows; n += 2 * NWAVES) {
        CombRaw rwn[2];
#pragma unroll
        for (int u = 0; u < 2; ++u) rwn[u] = rw[u];
#pragma unroll
        for (int u = 0; u < 2; ++u) if (n + (2 + u) * NWAVES < nrows) comb_load(F, r_lo + n + (2 + u) * NWAVES, rwn[u]);
        __builtin_amdgcn_sched_barrier(0);
#pragma unroll
        for (int u = 0; u < 2; ++u) if (n + u * NWAVES < nrows) { const int row = r_lo + n + u * NWAVES;
            const int sel = (mod_row(row) == mrA) ? 0 : 1;
            const LAS float* g2 = pv_slot(F, 2 + sel);
            RowV x;
#pragma unroll
            for (int h = 0; h < 2; ++h) { const u32x4 w = rw[u].x[h]; x.v[2 * h] = (f32x4){bflo(w.x), bfhi(w.x), bflo(w.y), bfhi(w.y)}; x.v[2 * h + 1] = (f32x4){bflo(w.z), bfhi(w.z), bflo(w.w), bfhi(w.w)}; }
#pragma unroll
            for (int j = 0; j < 4; ++j) { f32x4 f = (f32x4){0.f, 0.f, 0.f, 0.f};
#pragma unroll
                for (int k = 0; k < 4; ++k) { const u32x2 w2 = rw[u].f[j >> 1][k]; const int wd = (int)((j & 1) ? w2.y : w2.x);
                    const f32x2 lo = __builtin_amdgcn_cvt_pk_f32_fp8(wd, false), hi = __builtin_amdgcn_cvt_pk_f32_fp8(wd, true); f[0] += lo[0]; f[1] += lo[1]; f[2] += hi[0]; f[3] += hi[1]; }
                const f32x4 gg = *(const LAS f32x4*)(g2 + RC(F.lane, j)) * (1.0f / FS_SCALE);
                x.v[j] = x.v[j] * DN_ALPHA + gg * f; }
            row_ln_plain(x, F.lane); row_affine_l(x, pv_slot(F, 0), pv_slot(F, 1), F.lane);
            if (lastl) { row_store_nt(x, F.out + (size_t)row * D, F.lane); }
            else { row_store_bf16_nt(x, (bf16_t*)(F.ws + WS_X) + (size_t)row * D, F.lane); ln0_row(F, row, x, pv_slot(F, 4 + sel), pv_slot(F, 6 + sel)); } }
#pragma unroll
        for (int u = 0; u < 2; ++u) rw[u] = rwn[u];
    }
    if (!lastl) gates_tail(F, l + 1, t_lo, t_hi);
    __syncthreads();
}

#define MFMA32(a, b, c) __builtin_amdgcn_mfma_f32_32x32x16_bf16((a), (b), (c), 0, 0, 0)
#define MFMA16(a, b, c) __builtin_amdgcn_mfma_f32_16x16x32_bf16((a), (b), (c), 0, 0, 0)
__device__ __forceinline__ f32x16 zero16() { f32x16 z;
#pragma unroll
    for (int i = 0; i < 16; ++i) z[i] = 0.f;
    return z; }
__device__ __forceinline__ void pool_tiles(Frame& F, int l, bool with_ctx) {
    LAS unsigned char* Pin = F.lds;
    LAS unsigned char* Dm = F.lds + 40960;
    const bf16_t* Z = (const bf16_t*)(F.ws + WS_Z);
    const bf16_t* Wp = (const bf16_t*)(F.ws + WS_WPOOL) + (size_t)l * 4 * 4096;
    const float* psc = F.in[IN_POOLS] + l * 256;
    bf16_t* BRA = (bf16_t*)(F.ws + WS_BRA);
    const int ntiles = with_ctx ? 1088 : 1024;
    const int r = F.lane & 31, h = F.lane >> 5;
    bf16x8 wa[2][4]; f32x4 scv[2][4];
#pragma unroll
    for (int qi = 0; qi < 2; ++qi) { const int q = F.wave + 8 * qi, g = q >> 2, td = (q >> 1) & 1;
#pragma unroll
        for (int ks = 0; ks < 4; ++ks) wa[qi][ks] = *(const bf16x8*)(Wp + ((size_t)g * 64 + td * 32 + r) * 64 + ks * 16 + 8 * h);
#pragma unroll
        for (int qq = 0; qq < 4; ++qq) scv[qi][qq] = *(const f32x4*)(psc + g * 64 + td * 32 + 8 * qq + 4 * h); }
    for (int tile = F.bid; tile < ntiles; tile += F.G) {
        int row0, seq_lo, seq_hi;
        if (tile < 1024) { row0 = tile * 64; seq_lo = row0; seq_hi = row0 + 64; }
        else { const int ct = tile - 1024; seq_lo = ML + (ct >> 2) * 256; seq_hi = seq_lo + 256; row0 = seq_lo + (ct & 3) * 64; }
        for (int idx = F.tid; idx < 80 * 32; idx += NTHREADS) { const int rr = idx >> 5, ck = idx & 31, grow = row0 - 8 + rr;
            if (grow >= seq_lo && grow < seq_hi) *(LAS u32x4*)(Pin + rr * 512 + ck * 16) = __builtin_nontemporal_load((const u32x4*)(Z + (size_t)grow * NZ + ZC_P + ck * 8)); }
        __syncthreads();
#pragma unroll
        for (int g = 0; g < 4; ++g) { constexpr int dummy_ = 0; (void)dummy_; const int hw = 1 << g, tok = F.tid >> 3, ck = g * 8 + (F.tid & 7), t = row0 + tok;
            const int lo = max(t - hw, seq_lo), hi = min(t + hw, seq_hi);
            float s[8];
#pragma unroll
            for (int e = 0; e < 8; ++e) s[e] = 0.f;
#pragma unroll
            for (int d = -hw; d < hw; ++d) { u32x4 v = *(const LAS u32x4*)(Pin + (tok + 8 + d) * 512 + ck * 16); const bool in = (t + d >= lo) && (t + d < hi);
                v.x = in ? v.x : 0u; v.y = in ? v.y : 0u; v.z = in ? v.z : 0u; v.w = in ? v.w : 0u;
                s[0] += bflo(v.x); s[1] += bfhi(v.x); s[2] += bflo(v.y); s[3] += bfhi(v.y); s[4] += bflo(v.z); s[5] += bfhi(v.z); s[6] += bflo(v.w); s[7] += bfhi(v.w); }
            const float inv = __builtin_amdgcn_rcpf((float)(hi - lo));
            const u32x4 o = *(const LAS u32x4*)(Pin + (tok + 8) * 512 + ck * 16);
            u32x4 w; w.x = pk2(s[0] * inv - bflo(o.x), s[1] * inv - bfhi(o.x)); w.y = pk2(s[2] * inv - bflo(o.y), s[3] * inv - bfhi(o.y));
            w.z = pk2(s[4] * inv - bflo(o.z), s[5] * inv - bfhi(o.z)); w.w = pk2(s[6] * inv - bflo(o.w), s[7] * inv - bfhi(o.w));
            *(LAS u32x4*)(Dm + tok * 528 + ck * 16) = w; }
        __syncthreads();
#pragma unroll
        for (int qi = 0; qi < 2; ++qi) { const int q = F.wave + 8 * qi, g = q >> 2, td = (q >> 1) & 1, tt = q & 1;
            f32x16 acc = zero16();
#pragma unroll
            for (int ks = 0; ks < 4; ++ks) { const bf16x8 b = *(const LAS bf16x8*)(Dm + (tt * 32 + r) * 528 + (g * 64 + ks * 16 + 8 * h) * 2);
                acc = MFMA32(wa[qi][ks], b, acc); }
            const size_t orow = (size_t)(row0 + tt * 32 + r);
#pragma unroll
            for (int qq = 0; qq < 4; ++qq) { const int dcol = g * 64 + td * 32 + 8 * qq + 4 * h; const f32x4 sc = scv[qi][qq];
                u32x2 w; w.x = pk2(acc[4 * qq] * sc.x, acc[4 * qq + 1] * sc.y); w.y = pk2(acc[4 * qq + 2] * sc.z, acc[4 * qq + 3] * sc.w);
                *(u32x2*)(BRA + orow * D + dcol) = w; } }
        __syncthreads();
    }
}
__device__ __forceinline__ void sgu_chunks(Frame& F, int l, bool with_ctx) {
    LAS unsigned char* Vt = F.lds;
    const bf16_t* Z = (const bf16_t*)(F.ws + WS_Z);
    const bf16_t* Ws = (const bf16_t*)(F.ws + WS_WSGU) + (size_t)l * 4 * 16384;
    const float* lng = F.in[IN_SLNG] + l * 256; const float* lnb = F.in[IN_SLNB] + l * 256; const float* sb = F.in[IN_SGUB] + l * 512;
    bf16_t* BRA = (bf16_t*)(F.ws + WS_BRA);
    const int nchunks = with_ctx ? 544 : 512;
    const int r = F.lane & 31, h = F.lane >> 5;
    const int tc = F.wave & 1, tt = F.wave >> 1, t = tt * 32 + r;
    LAS float* lnt = (LAS float*)(F.lds + 69632);
    if (F.tid < 256) { lnt[F.tid] = lng[F.tid]; lnt[256 + F.tid] = lnb[F.tid]; }
    __syncthreads();
    for (int ch = F.bid; ch < nchunks; ch += F.G) {
        const int row0 = ch * 128;
        u32x2 ug[4][4]; bf16x8 bcur[8];
        { const int s2 = F.tid >> 3, cq = F.tid & 7; const bf16_t* zp = Z + (size_t)(row0 + 2 * s2) * NZ + ZC_UV + 256 + cq * 32;
          float v[2][32]; float sum[2] = {0.f, 0.f};
#pragma unroll
          for (int rr = 0; rr < 2; ++rr)
#pragma unroll
              for (int i = 0; i < 4; ++i) { const u32x4 w = __builtin_nontemporal_load((const u32x4*)(zp + (size_t)rr * NZ + 8 * i));
                  v[rr][8 * i] = bflo(w.x); v[rr][8 * i + 1] = bfhi(w.x); v[rr][8 * i + 2] = bflo(w.y); v[rr][8 * i + 3] = bfhi(w.y); v[rr][8 * i + 4] = bflo(w.z); v[rr][8 * i + 5] = bfhi(w.z); v[rr][8 * i + 6] = bflo(w.w); v[rr][8 * i + 7] = bfhi(w.w); }
          float rstd[2];
#pragma unroll
          for (int rr = 0; rr < 2; ++rr) {
#pragma unroll
              for (int i = 0; i < 32; ++i) sum[rr] += v[rr][i];
              sum[rr] = oct_sum(sum[rr]);
              const float mean = sum[rr] * (1.f / 256.f); float sq = 0.f;
#pragma unroll
              for (int i = 0; i < 32; ++i) { v[rr][i] -= mean; sq += v[rr][i] * v[rr][i]; }
              sq = oct_sum(sq);
              rstd[rr] = __builtin_amdgcn_rsqf(sq * (1.f / 256.f) + LN_EPS); }
#pragma unroll
        for (int g = 0; g < 4; ++g)
#pragma unroll
            for (int qq = 0; qq < 4; ++qq) ug[g][qq] = *(const u32x2*)(Z + (size_t)(row0 + t) * NZ + ZC_UV + g * 64 + tc * 32 + 8 * qq + 4 * h);
#pragma unroll
        for (int ks = 0; ks < 8; ++ks) bcur[ks] = *(const bf16x8*)(Ws + ((size_t)0 * 128 + t) * 128 + ks * 16 + 8 * h);
          LAS unsigned char* wp = Vt + (((s2 >> 2) ^ cq) << 4) + (s2 & 3) * 4;
#pragma unroll
          for (int i = 0; i < 32; ++i) { const int c = cq * 32 + i; const float gn = lnt[c], bn = lnt[256 + c];
              *(LAS unsigned*)(wp + c * 272) = pg8::cvt_pk_bf16(v[0][i] * rstd[0] * gn + bn, v[1][i] * rstd[1] * gn + bn); } }
        __syncthreads();
#pragma unroll
        for (int g = 0; g < 4; ++g) {
            bf16x8 bnx[8];
#pragma unroll
            for (int ks = 0; ks < 8; ++ks) bnx[ks] = bcur[ks];
            if (g < 3) {
#pragma unroll
                for (int ks = 0; ks < 8; ++ks) bnx[ks] = *(const bf16x8*)(Ws + ((size_t)(g + 1) * 128 + t) * 128 + ks * 16 + 8 * h); }
            f32x16 acc = zero16();
#pragma unroll
            for (int ks = 0; ks < 8; ++ks) { const bf16x8 a = *(const LAS bf16x8*)(Vt + (g * 64 + tc * 32 + r) * 272 + (((ks * 2 + h) ^ ((g * 2 + tc) & 7)) * 16));
                acc = MFMA32(a, bcur[ks], acc); }
#pragma unroll
            for (int ks = 0; ks < 8; ++ks) bcur[ks] = bnx[ks];
            const float bias = sb[g * 128 + t];
#pragma unroll
            for (int qq = 0; qq < 4; ++qq) { const int c0 = g * 64 + tc * 32 + 8 * qq + 4 * h;
                const u32x2 u = ug[g][qq];
                u32x2 w; w.x = pk2(bflo(u.x) * (acc[4 * qq] + bias), bfhi(u.x) * (acc[4 * qq + 1] + bias)); w.y = pk2(bflo(u.y) * (acc[4 * qq + 2] + bias), bfhi(u.y) * (acc[4 * qq + 3] + bias));
                *(u32x2*)(BRA + (size_t)(row0 + t) * D + 768 + c0) = w; } }
        __syncthreads();
    }
}
__device__ __forceinline__ void qk_conv_pass(Frame& F, int l) {
    const bf16_t* Z = (const bf16_t*)(F.ws + WS_Z); bf16_t* QKC = (bf16_t*)(F.ws + WS_H);
    const int chunk = F.tid & 127, rsub = F.tid >> 7, ch0 = chunk * 8;
    float w0[8], w1[8], w2[8], cbv[8];
    { const float* cw = F.in[IN_CONVW] + (size_t)l * 3 * 1024 + ch0; const float* cb = F.in[IN_CONVB] + (size_t)l * 1024 + ch0;
#pragma unroll
      for (int e = 0; e < 8; ++e) { w0[e] = cw[e]; w1[e] = cw[1024 + e]; w2[e] = cw[2048 + e]; cbv[e] = cb[e]; } }
    const float scale = chunk >= 64 ? 0.08838834764831845f : 1.0f;
    const int ns = F.G * 4, sidx = F.bid * 4 + rsub;
    const int r0 = (int)(((long)sidx * MT) / ns), r1 = (int)(((long)(sidx + 1) * MT) / ns);
    const bf16_t* zb = Z + ZC_QK + ch0;
    const u32x4 zero4 = (u32x4){0u, 0u, 0u, 0u};
    u32x4 xm = zero4, xc = zero4, xn = zero4;
    if (r0 < r1) { xc = *(const u32x4*)(zb + (size_t)r0 * NZ); if (r0 > 0) xm = *(const u32x4*)(zb + (size_t)(r0 - 1) * NZ); if (r0 + 1 < MT) xn = *(const u32x4*)(zb + (size_t)(r0 + 1) * NZ); }
    for (int row = r0; row < r1; ++row) {
        u32x4 xn2 = zero4; if (row + 2 < MT) xn2 = *(const u32x4*)(zb + (size_t)(row + 2) * NZ);
        const int p = row < ML ? (row & 4095) : ((row - ML) & 255), len = row < ML ? 4096 : 256;
        const u32x4 x0 = (p > 0) ? xm : zero4, x1 = xc, x2 = (p + 1 < len) ? xn : zero4;
        const unsigned xa[4] = {x0.x, x0.y, x0.z, x0.w}, xb[4] = {x1.x, x1.y, x1.z, x1.w}, xcc[4] = {x2.x, x2.y, x2.z, x2.w};
        float y[8];
#pragma unroll
        for (int e2 = 0; e2 < 4; ++e2) { y[2 * e2] = cbv[2 * e2] + w0[2 * e2] * bflo(xa[e2]) + w1[2 * e2] * bflo(xb[e2]) + w2[2 * e2] * bflo(xcc[e2]);
            y[2 * e2 + 1] = cbv[2 * e2 + 1] + w0[2 * e2 + 1] * bfhi(xa[e2]) + w1[2 * e2 + 1] * bfhi(xb[e2]) + w2[2 * e2 + 1] * bfhi(xcc[e2]); }
#pragma unroll
        for (int e = 0; e < 8; ++e) y[e] = siluf_(y[e]) * scale;
        u32x4 w; w.x = pk2(y[0], y[1]); w.y = pk2(y[2], y[3]); w.z = pk2(y[4], y[5]); w.w = pk2(y[6], y[7]);
        *(u32x4*)(QKC + (size_t)row * D + ch0) = w;
        xm = xc; xc = xn; xn = xn2;
    }
}
constexpr int ML_QS = 0, ML_KS = 34816, ML_KW = 69632, ML_VT = 104448, ML_CB = 126208, ML_SC = 147968, ML_SCSZ = 2624;
__device__ __forceinline__ float logsigf_(float x) { return fminf(x, 0.f) - __logf(1.0f + __expf(-fabsf(x))); }
__device__ __forceinline__ unsigned swap16(unsigned u) { return __builtin_amdgcn_alignbit(u, u, 16); }
struct MlPre { u32x4 qk[8]; u32x2 v[4]; float g[4]; };
__device__ __forceinline__ void ml_geom(int j, int b, int dir, int& seqbase, int& seqlen, int& pbase) {
    const bool is_ctx = j < 2; int cj = is_ctx ? j : j - 2; const int ncs = is_ctx ? 2 : 32; if (dir) cj = ncs - 1 - cj;
    seqbase = is_ctx ? ML + b * 256 : b * 4096; seqlen = is_ctx ? 256 : 4096; pbase = cj * 128; }
#define ML_BAR() do { asm volatile("s_waitcnt lgkmcnt(0)" ::: "memory"); __builtin_amdgcn_s_barrier(); asm volatile("" ::: "memory"); } while (0)
__device__ __forceinline__ void mlstm_unit(Frame& F, int l, int unit) {
    const int bh = (unit & 7) + 8 * (unit >> 5), sub = (unit >> 3) & 3;
    const int b = bh >> 2, head = bh & 3, dir = sub >> 1, vh = sub & 1;
    LAS unsigned char* QS = F.lds + ML_QS; LAS unsigned char* KS = F.lds + ML_KS; LAS unsigned char* KW = F.lds + ML_KW; LAS unsigned char* VT = F.lds + ML_VT; LAS unsigned char* CB = F.lds + ML_CB;
    const bf16_t* Z = (const bf16_t*)(F.ws + WS_Z); const float* ZG = (const float*)(F.ws + WS_ZG); const bf16_t* QKC = (const bf16_t*)(F.ws + WS_H);
    bf16_t* HF = (bf16_t*)(F.ws + WS_HFB) + (size_t)dir * MT * 512;
    const int wave = F.wave;
    int tl = F.tid;
#define ML_ROLES() const int lane = tl & 63, fr = lane & 15, q4 = lane >> 4; const int isk = (tl >> 4) & 1, ck = tl & 15, i0 = 8 * (tl >> 5), chn = (isk ? 512 : 0) + head * 128 + ck * 8; \
    const int vi0 = 4 * (tl >> 4), vcq = tl & 15, vch = head * 128 + vh * 64 + vcq * 4; (void)fr; (void)q4; (void)vi0; (void)vcq; (void)vch; (void)i0; (void)chn; (void)ck; (void)isk;
    for (int idx = F.tid; idx < 16 * 136; idx += NTHREADS) *(LAS bf16_t*)(VT + (64 + idx / 136) * 272 + (idx % 136) * 2) = (idx < 136) ? (bf16_t)0x3F80 : (bf16_t)0;
    f32x4 cs[5];
#pragma unroll
    for (int vt = 0; vt < 5; ++vt) cs[vt] = (f32x4){0.f, 0.f, 0.f, 0.f};
    float m_state = 0.f;
    MlPre pre;
#define ML_PREFETCH(jj) do { int sb_, sl_, pb_; ml_geom((jj), b, dir, sb_, sl_, pb_); \
        { const int pmin = dir ? pb_ + 120 - i0 : pb_ + i0; const bf16_t* zr = QKC + (size_t)(sb_ + pmin) * D + chn; (void)sl_; \
          _Pragma("unroll") for (int k = 0; k < 8; ++k) pre.qk[k] = *(const u32x4*)(zr + (size_t)k * D); } \
        { const int pminv = dir ? pb_ + 124 - vi0 : pb_ + vi0; const bf16_t* zv = Z + (size_t)(sb_ + pminv) * NZ + ZC_V + vch; \
          _Pragma("unroll") for (int k = 0; k < 4; ++k) pre.v[k] = *(const u32x2*)(zv + (size_t)k * NZ); } \
        if (wave == 0) { const int p0 = dir ? pb_ + 127 - 2 * lane : pb_ + 2 * lane, p1 = dir ? p0 - 1 : p0 + 1; \
          pre.g[0] = ZG[(size_t)(sb_ + p0) * 16 + dir * 8 + head]; pre.g[1] = ZG[(size_t)(sb_ + p0) * 16 + dir * 8 + 4 + head]; \
          pre.g[2] = ZG[(size_t)(sb_ + p1) * 16 + dir * 8 + head]; pre.g[3] = ZG[(size_t)(sb_ + p1) * 16 + dir * 8 + 4 + head]; } } while (0)
#define ML_STEPA(sbuf) do { LAS float* sg_ = (LAS float*)(F.lds + ML_SC + (sbuf) * ML_SCSZ); const int i0g = 2 * lane, i1g = i0g + 1; \
        const float gi0 = pre.g[0], gf0 = pre.g[1], gi1 = pre.g[2], gf1 = pre.g[3]; \
        const float lf0 = logsigf_(gf0), lf1 = logsigf_(gf1); const float s1 = lf0 + lf1; const float incl = wave_scan_sum(s1); \
        const float excl = incl - s1, bc0 = excl + lf0, bc1 = excl + s1; \
        const float g0 = gi0 - bc0, g1 = gi1 - bc1; const float mx1 = fmaxf(g0, g1); const float im = wave_scan_max(mx1); \
        const float em = dpp_id<0x138, 0xf>(-3.0e38f, im);                   \
        const float M0 = fmaxf(m_state, fmaxf(em, g0)), M1 = fmaxf(m_state, fmaxf(em, mx1)); \
        const float total = __builtin_bit_cast(float, __builtin_amdgcn_readlane(__builtin_bit_cast(int, bc1), 63)), Mlast = __builtin_bit_cast(float, __builtin_amdgcn_readlane(__builtin_bit_cast(int, M1), 63)); \
        sg_[i0g] = g0; sg_[i1g] = g1; sg_[128 + i0g] = M0; sg_[128 + i1g] = M1; \
        sg_[256 + i0g] = __expf(m_state - M0); sg_[256 + i1g] = __expf(m_state - M1); \
        sg_[384 + i0g] = __expf(-(bc0 + M0)); sg_[384 + i1g] = __expf(-(bc1 + M1)); \
        sg_[512 + i0g] = __expf(g0 - Mlast); sg_[512 + i1g] = __expf(g1 - Mlast); \
        if (lane == 0) sg_[640] = __expf(m_state - Mlast); \
        m_state = total + Mlast; } while (0)
    { ML_ROLES(); ML_PREFETCH(0); if (wave == 0) ML_STEPA(0); }
    ML_BAR();
#pragma unroll 1
    for (int j = 0; j < 34; ++j) {
        asm volatile("" : "+v"(tl));
        ML_ROLES();
        int seqbase, seqlen, pbase; ml_geom(j, b, dir, seqbase, seqlen, pbase);
        const LAS float* sc_g = (const LAS float*)(F.lds + ML_SC + (j & 1) * ML_SCSZ); const LAS float* sc_M = sc_g + 128; const LAS float* sc_dec = sc_g + 256; const LAS float* sc_emt = sc_g + 384; const LAS float* sc_wk = sc_g + 512;
        {
#pragma unroll
          for (int k = 0; k < 8; ++k) { const int i = dir ? i0 + 7 - k : i0 + k; *(LAS u32x4*)((isk ? KS : QS) + i * 272 + ck * 16) = pre.qk[k]; }
          if (isk) { u32x4 kt[8]; float ykeep[8];
#pragma unroll
              for (int e = 0; e < 8; ++e) { kt[e] = (u32x4){0u, 0u, 0u, 0u}; ykeep[e] = 0.f; }
#pragma unroll
              for (int k = 0; k < 8; ++k) { const int i = dir ? i0 + 7 - k : i0 + k; const float wk = sc_wk[i];
                  const unsigned xb[4] = {pre.qk[k].x, pre.qk[k].y, pre.qk[k].z, pre.qk[k].w};
#pragma unroll
                  for (int e = 0; e < 8; ++e) { const float yw = ((e & 1) ? bfhi(xb[e >> 1]) : bflo(xb[e >> 1])) * wk;
                      if (k & 1) { const unsigned pw_ = pk2(ykeep[e], yw); if ((k >> 1) == 0) kt[e].x = pw_; else if ((k >> 1) == 1) kt[e].y = pw_; else if ((k >> 1) == 2) kt[e].z = pw_; else kt[e].w = pw_; }
                      else ykeep[e] = yw; } }
#pragma unroll
              for (int e = 0; e < 8; ++e) { u32x4 o = kt[e]; if (dir) o = (u32x4){swap16(kt[e].w), swap16(kt[e].z), swap16(kt[e].y), swap16(kt[e].x)};
                  *(LAS u32x4*)(KW + (ck * 8 + e) * 272 + (((i0 >> 3) ^ (ck & 7)) * 16)) = o; } } }
        { unsigned vv[4][2];
#pragma unroll
          for (int k = 0; k < 4; ++k) { vv[k][0] = pre.v[k].x; vv[k][1] = pre.v[k].y; }
#pragma unroll
          for (int c = 0; c < 4; ++c) {
              unsigned h0 = (c & 1) ? (vv[0][c >> 1] >> 16) : (vv[0][c >> 1] & 0xffffu), h1 = (c & 1) ? (vv[1][c >> 1] >> 16) : (vv[1][c >> 1] & 0xffffu);
              unsigned h2 = (c & 1) ? (vv[2][c >> 1] >> 16) : (vv[2][c >> 1] & 0xffffu), h3 = (c & 1) ? (vv[3][c >> 1] >> 16) : (vv[3][c >> 1] & 0xffffu);
              u32x2 o; if (dir) { o.x = h3 | (h2 << 16); o.y = h1 | (h0 << 16); } else { o.x = h0 | (h1 << 16); o.y = h2 | (h3 << 16); }
              *(LAS u32x2*)(VT + (vcq * 4 + c) * 272 + vi0 * 2) = o; } }
#pragma unroll
        for (int vt = 0; vt < 5; ++vt)
#pragma unroll
            for (int rr = 0; rr < 4; rr += 2) { const unsigned pw_ = pk2(cs[vt][rr], cs[vt][rr + 1]);
                *(LAS bf16_t*)(CB + (16 * vt + 4 * q4 + rr) * 272 + (16 * wave + fr) * 2) = (bf16_t)(pw_ & 0xffffu); *(LAS bf16_t*)(CB + (16 * vt + 4 * q4 + rr + 1) * 272 + (16 * wave + fr) * 2) = (bf16_t)(pw_ >> 16); }
        ML_BAR();
        if (j + 1 < 34) ML_PREFETCH(j + 1);
        const int t = 16 * wave + fr;
        bf16x8 qf[4];
#pragma unroll
        for (int kc = 0; kc < 4; ++kc) qf[kc] = *(const LAS bf16x8*)(QS + t * 272 + (32 * kc + 8 * q4) * 2);
        const float Mt_t = sc_M[t], dec_t = sc_dec[t], emt_t = sc_emt[t];
        f32x4 ps[8];
#pragma unroll
        for (int jp = 0; jp < 4; ++jp) {
            ps[2 * jp] = (f32x4){0.f, 0.f, 0.f, 0.f}; ps[2 * jp + 1] = (f32x4){0.f, 0.f, 0.f, 0.f};
            if (2 * jp <= wave) {
                bf16x8 ka[4], kb[4];
#pragma unroll
                for (int kc = 0; kc < 4; ++kc) { ka[kc] = *(const LAS bf16x8*)(KS + (32 * jp + fr) * 272 + (32 * kc + 8 * q4) * 2); kb[kc] = *(const LAS bf16x8*)(KS + (32 * jp + 16 + fr) * 272 + (32 * kc + 8 * q4) * 2); }
                const f32x4 ga4 = *(const LAS f32x4*)(sc_g + 32 * jp + 4 * q4), gb4 = *(const LAS f32x4*)(sc_g + 32 * jp + 16 + 4 * q4);
                f32x4 acc0 = (f32x4){0.f, 0.f, 0.f, 0.f}, acc1 = (f32x4){0.f, 0.f, 0.f, 0.f};
#pragma unroll
                for (int kc = 0; kc < 4; ++kc) { acc0 = MFMA16(ka[kc], qf[kc], acc0); acc1 = MFMA16(kb[kc], qf[kc], acc1); }
#pragma unroll
                for (int rr = 0; rr < 4; ++rr) { const int s0 = 32 * jp + 4 * q4 + rr, s1 = s0 + 16;
                    ps[2 * jp][rr] = (s0 <= t) ? acc0[rr] * __expf(ga4[rr] - Mt_t) : 0.f; ps[2 * jp + 1][rr] = (s1 <= t) ? acc1[rr] * __expf(gb4[rr] - Mt_t) : 0.f; }
            }
        }
        f32x4 ao[5];
        {
#pragma unroll
          for (int vt = 0; vt < 5; ++vt) ao[vt] = (f32x4){0.f, 0.f, 0.f, 0.f};
#pragma unroll
          for (int kh = 0; kh < 4; kh += 2) { bf16x8 cf[2][5];
#pragma unroll
              for (int k2 = 0; k2 < 2; ++k2)
#pragma unroll
                  for (int vt = 0; vt < 5; ++vt) cf[k2][vt] = *(const LAS bf16x8*)(CB + (16 * vt + fr) * 272 + (32 * (kh + k2) + 8 * q4) * 2);
#pragma unroll
              for (int k2 = 0; k2 < 2; ++k2)
#pragma unroll
                  for (int vt = 0; vt < 5; ++vt) ao[vt] = MFMA16(cf[k2][vt], qf[kh + k2], ao[vt]); }
#pragma unroll
          for (int vt = 0; vt < 5; ++vt) ao[vt] = ao[vt] * dec_t; }
#pragma unroll
        for (int ks = 0; ks < 4; ++ks) {
            if (2 * ks <= wave) {
                s16x4 vlo[5], vhi[5];
#pragma unroll
                for (int vt = 0; vt < 5; ++vt) { vlo[vt] = *(const LAS s16x4*)(VT + (16 * vt + fr) * 272 + (32 * ks + 4 * q4) * 2); vhi[vt] = *(const LAS s16x4*)(VT + (16 * vt + fr) * 272 + (32 * ks + 16 + 4 * q4) * 2); }
                u32x4 pw; pw.x = cvt_pk_bf16(ps[2 * ks][0], ps[2 * ks][1]); pw.y = cvt_pk_bf16(ps[2 * ks][2], ps[2 * ks][3]); pw.z = cvt_pk_bf16(ps[2 * ks + 1][0], ps[2 * ks + 1][1]); pw.w = cvt_pk_bf16(ps[2 * ks + 1][2], ps[2 * ks + 1][3]);
                const bf16x8 pf = __builtin_bit_cast(bf16x8, pw);
#pragma unroll
                for (int vt = 0; vt < 5; ++vt) { const bf16x8 a = __builtin_shufflevector(vlo[vt], vhi[vt], 0, 1, 2, 3, 4, 5, 6, 7); ao[vt] = MFMA16(a, pf, ao[vt]); }
            }
        }
        { const float den = bperm(fr, ao[4][0]); const float inv = __builtin_amdgcn_rcpf(fmaxf(fabsf(den), emt_t));
          const int p = dir ? pbase + 127 - t : pbase + t; bf16_t* orow = HF + (size_t)(seqbase + p) * 512 + head * 128 + vh * 64 + 4 * q4;
#pragma unroll
          for (int vt = 0; vt < 4; ++vt) { const f32x4 o = ao[vt] * inv; u32x2 w; w.x = cvt_pk_bf16(o[0], o[1]); w.y = cvt_pk_bf16(o[2], o[3]); *(u32x2*)(orow + 16 * vt) = w; } }
        { const float a_s = sc_g[640];
#pragma unroll
          for (int vt = 0; vt < 5; ++vt) cs[vt] = cs[vt] * a_s;
#pragma unroll
          for (int ks = 0; ks < 4; ks += 2) { bf16x8 bb[2], va[2][5];
#pragma unroll
              for (int k2 = 0; k2 < 2; ++k2) { bb[k2] = *(const LAS bf16x8*)(KW + (16 * wave + fr) * 272 + (((4 * (ks + k2) + q4) ^ (((16 * wave + fr) >> 3) & 7)) * 16));
#pragma unroll
                  for (int vt = 0; vt < 5; ++vt) va[k2][vt] = *(const LAS bf16x8*)(VT + (16 * vt + fr) * 272 + (32 * (ks + k2) + 8 * q4) * 2); }
#pragma unroll
              for (int k2 = 0; k2 < 2; ++k2)
#pragma unroll
                  for (int vt = 0; vt < 5; ++vt) cs[vt] = MFMA16(va[k2][vt], bb[k2], cs[vt]); } }
        if (wave == 0 && j + 1 < 34) ML_STEPA((j + 1) & 1);
        ML_BAR();
    }
#undef ML_PREFETCH
#undef ML_STEPA
#undef ML_ROLES
    __syncthreads();
}
__device__ __forceinline__ void phase_mixers(Frame& F, int l) {
    const bool with_ctx = (l != DEPTH - 1);
#ifndef MIX_MASK
#define MIX_MASK 7
#endif
#ifndef MIXREP
#define MIXREP 0
#endif
    if (MIX_MASK & 1) pool_tiles(F, l, with_ctx);
    if (MIXREP & 1) { __syncthreads(); pool_tiles(F, l, with_ctx); }
    if (MIX_MASK & 2) sgu_chunks(F, l, with_ctx);
    if (MIXREP & 2) { __syncthreads(); sgu_chunks(F, l, with_ctx); }
    (void)0;
    qk_conv_pass(F, l);
}
__device__ __forceinline__ void phase_mlstm(Frame& F, int l) {
    for (int u = F.bid; u < 256; u += F.G) mlstm_unit(F, l, u);
}

struct Args { const float* in[31]; float* out; unsigned char* ws; int g_lo, g_hi, pad0, pad1; };
constexpr int NPH = 11, NGID = 2 + DEPTH * NPH;
__global__ void __launch_bounds__(NTHREADS, 2) fwd_kernel(Args args) {
    extern __shared__ __attribute__((aligned(16))) unsigned char lds_raw[];
    Frame F;
    F.lds = (LAS unsigned char*)lds_raw; F.MISC = (volatile LAS unsigned*)(F.lds + MISC_OFF);
    F.tid = threadIdx.x; F.lane = F.tid & 63; F.wave = __builtin_amdgcn_readfirstlane(F.tid >> 6); F.G = gridDim.x; F.bid = blockIdx.x;
    F.ws = args.ws; F.out = args.out;
    F.in = (InTab)__builtin_amdgcn_kernarg_segment_ptr();
    if (F.tid < 64) F.MISC[F.tid] = 0u;
    __syncthreads();
    const int lo = args.g_lo, hi = args.g_hi;
    const bool multi = (hi - lo) > 1;
    XcdBarrier bar; bar.bar = (unsigned*)(F.ws + WS_CTL) + CW_BAR; bar.x = 0; bar.st = nullptr;
    if (multi) bar = xcd_barrier_post((unsigned*)(F.ws + WS_CTL) + CW_BAR, F.MISC + 8);
#ifndef PHASE_MASK
#define PHASE_MASK 0xFFFF
#endif
#define RUN(g) (lo <= (g) && (g) < hi)
#define RUNP(ty, g) ((((PHASE_MASK) >> (ty)) & 1) && RUN(g))
#ifndef REPEAT_MASK
#define REPEAT_MASK 0
#endif
#define NREP(ty) ((((REPEAT_MASK) >> (ty)) & 1) ? 2 : 1)
#define SEAM(g) do { if (RUN((g) + 1)) xcd_barrier(bar); } while (0)
#define LAUNDER(P) Frame P = F; { int t_; asm volatile("v_mbcnt_lo_u32_b32 %0, -1, 0\n\tv_mbcnt_hi_u32_b32 %0, -1, %0" : "=v"(t_)); t_ |= (F.wave << 6); P.tid = t_; P.lane = t_ & 63; P.wave = __builtin_amdgcn_readfirstlane(t_ >> 6); GAS unsigned char* w_ = (GAS unsigned char*)F.ws; asm volatile("" : "+s"(w_)); P.ws = (unsigned char*)w_; InTab t2_ = F.in; asm volatile("" : "+s"(t2_)); P.in = t2_; }
    if (RUNP(0, 0)) { LAUNDER(P); for (int rep_ = 0; rep_ < NREP(0); ++rep_) { phase_prologue(P); __syncthreads(); } SEAM(0); }
    if (RUNP(1, 1)) { LAUNDER(P); for (int rep_ = 0; rep_ < NREP(1); ++rep_) { phase_ln0_first(P); __syncthreads(); } SEAM(1); }
#pragma unroll 1
    for (int l = 0; l < DEPTH; ++l) {
        const int g0 = 2 + l * NPH;
        const int mrows = (l == DEPTH - 1) ? ML : MT;
        if (RUNP(2, g0 + 0)) {
#undef PHTY
#define PHTY 2
            LAUNDER(P);
            { ProbPlain Pr{(const bf16_t*)(P.ws + WS_H), (const bf16_t*)(P.ws + WS_WIN) + (size_t)l * NZ * D, D, D};
              pg8::StaticOrder<1> S; S.init(MT / 256, NZ_BF / 256, P.G, P.bid);
              EpiInproj<false> E{(bf16_t*)(P.ws + WS_Z), P.in[IN_BIN] + (size_t)l * 5904, 0};
              pg8::gemm_phase(P.lds, P.tid, Pr, S, E); }
            __syncthreads();
            { ProbPlainF8 Pr{(const bf16_t*)(P.ws + WS_H8), (const bf16_t*)(P.ws + WS_WIN8 + (size_t)l * NZ_F8 * D), D / 2, D / 2};
              pg8::StaticOrder<1> S; S.init(MT / 256, NZ_F8 / 256, P.G, P.bid);
              EpiInproj<true> E{(bf16_t*)(P.ws + WS_Z), P.in[IN_BIN] + (size_t)l * 5904, NZ_BF / 256};
              pg8::gemm_phase(P.lds, P.tid, Pr, S, E); }
            SEAM(g0 + 0);
        }
        if (RUNP(3, g0 + 1)) { LAUNDER(P); for (int rep_ = 0; rep_ < NREP(3); ++rep_) { phase_mixers(P, l); __syncthreads(); } SEAM(g0 + 1); }
        if (RUNP(12, g0 + 2)) { LAUNDER(P); for (int rep_ = 0; rep_ < NREP(12); ++rep_) { phase_mlstm(P, l); __syncthreads(); } SEAM(g0 + 2); }
        if (RUNP(4, g0 + 3)) { LAUNDER(P); for (int rep_ = 0; rep_ < NREP(4); ++rep_) phase_finalize(P, l, mrows); SEAM(g0 + 3); }
        if (RUNP(5, g0 + 4)) {
#undef PHTY
#define PHTY 5
            LAUNDER(P);
            ProbPlain Pr{(const bf16_t*)(P.ws + WS_BRA), (const bf16_t*)(P.ws + WS_WBR) + (size_t)l * D * D, D, D};
            pg8::StaticOrder<1> S; S.init(mrows / 256, 4, P.G, P.bid);
            EpiBranch E{(const bf16_t*)(P.ws + WS_Z), (bf16_t*)(P.ws + WS_Y)};
            pg8::gemm_phase(P.lds, P.tid, Pr, S, E); if (NREP(PHTY) == 2) { __syncthreads(); pg8::gemm_phase(P.lds, P.tid, Pr, S, E); }
            SEAM(g0 + 4);
        }
        if (RUNP(6, g0 + 5)) {
#undef PHTY
#define PHTY 6
            LAUNDER(P);
            ProbPlain Pr{(const bf16_t*)(P.ws + WS_Y), (const bf16_t*)(P.ws + WS_WOUT) + (size_t)l * D * D, D, D};
            pg8::StaticOrder<1> S; S.init(mrows / 256, 4, P.G, P.bid);
            EpiOut E{(bf16_t*)(P.ws + WS_T)};
            pg8::gemm_phase(P.lds, P.tid, Pr, S, E); if (NREP(PHTY) == 2) { __syncthreads(); pg8::gemm_phase(P.lds, P.tid, Pr, S, E); }
            SEAM(g0 + 5);
        }
        if (RUNP(7, g0 + 6)) { LAUNDER(P); for (int rep_ = 0; rep_ < NREP(7); ++rep_) phase_ln1_router(P, l, mrows); SEAM(g0 + 6); }
        if (RUNP(8, g0 + 7)) { LAUNDER(P); for (int rep_ = 0; rep_ < NREP(8); ++rep_) phase_slots(P, mrows); SEAM(g0 + 7); }
        if (RUNP(9, g0 + 8)) {
#undef PHTY
#define PHTY 9
            LAUNDER(P);
            LAS int* seg = (LAS int*)(P.lds + TAB_OFF);
            const int ntile = moe_tables(P, seg);
            ProbMoe1 Pr{(const bf16_t*)(P.ws + WS_H2F8), (const bf16_t*)(P.ws + WS_WGU + (size_t)l * NEXP * 2048 * D), D / 2, D / 2, (const int*)(P.ws + WS_ROUTE + RT_TOK), seg};
            pg8::StaticOrder<1> S; S.init(ntile, 8, P.G, P.bid);
            EpiSwiglu E{(unsigned char*)(P.ws + WS_HID), P.in[IN_BGU] + (size_t)l * NEXP * 2048, seg};
            pg8::gemm_phase(P.lds, P.tid, Pr, S, E); if (NREP(PHTY) == 2) { __syncthreads(); pg8::gemm_phase(P.lds, P.tid, Pr, S, E); }
            SEAM(g0 + 8);
        }
        if (RUNP(10, g0 + 9)) {
#undef PHTY
#define PHTY 10
            LAUNDER(P);
            LAS int* seg = (LAS int*)(P.lds + TAB_OFF);
            const int ntile = moe_tables(P, seg);
            ProbMoe2 Pr{(const bf16_t*)(P.ws + WS_HID), (const bf16_t*)(P.ws + WS_WDN + (size_t)l * NEXP * D * D), D / 2, D / 2, seg};
            pg8::StaticOrder<1> S; S.init(ntile, 4, P.G, P.bid);
            EpiDown E{(unsigned char*)(P.ws + WS_FS), P.in[IN_BDN] + (size_t)l * NEXP * D, (const int*)(P.ws + WS_ROUTE + RT_DEST), (const float*)(P.ws + WS_ROUTE + RT_PSLOT), seg};
            pg8::gemm_phase(P.lds, P.tid, Pr, S, E); if (NREP(PHTY) == 2) { __syncthreads(); pg8::gemm_phase(P.lds, P.tid, Pr, S, E); }
            SEAM(g0 + 9);
        }
        if (RUNP(11, g0 + 10)) { LAUNDER(P); phase_combine_ln2(P, l, mrows); SEAM(g0 + 10); }
    }
#undef LAUNDER
#undef RUN
#undef RUNP
#undef SEAM
}

extern "C" void kernel_launch(void* const* d_in, const int* in_sizes, int n_in, void* d_out, int out_size, void* d_ws, size_t ws_size, hipStream_t stream) {
    static int grid = 0;
    if (grid == 0) {
        if (n_in != 31 || out_size != ML * D || ws_size < WS_END) { fprintf(stderr, "kernel_launch: unexpected problem (n_in %d, out %d, ws %zu, need %zu)\n", n_in, out_size, ws_size, (size_t)WS_END); grid = -1; return; }
        int dev = 0, cus = 0, per_cu = 0;
        if (hipGetDevice(&dev) != hipSuccess || hipDeviceGetAttribute(&cus, hipDeviceAttributeMultiprocessorCount, dev) != hipSuccess) { grid = -1; return; }
        if (hipFuncSetAttribute((const void*)fwd_kernel, hipFuncAttributeMaxDynamicSharedMemorySize, LDS_BYTES) != hipSuccess) { fprintf(stderr, "kernel_launch: hipFuncSetAttribute failed\n"); grid = -1; return; }
        if (hipOccupancyMaxActiveBlocksPerMultiprocessor(&per_cu, (const void*)fwd_kernel, NTHREADS, LDS_BYTES) != hipSuccess || per_cu < 1) fprintf(stderr, "kernel_launch: occupancy query reports %d\n", per_cu);
        (void)hipGetLastError();
        grid = cus;
    }
    if (grid < 0) return;
    (void)hipMemsetAsync((char*)d_ws + WS_CTL, 0, CTL_ZERO_BYTES, stream);
    Args a{};
    for (int i = 0; i < 31; ++i) a.in[i] = (const float*)d_in[i];
    a.out = (float*)d_out; a.ws = (unsigned char*)d_ws;
#if MK_N_LAUNCHES == 1
    a.g_lo = 0; a.g_hi = NGID;
    hipLaunchKernelGGL(fwd_kernel, dim3(grid), dim3(NTHREADS), LDS_BYTES, stream, a);
#else
    for (int g = 0; g < NGID; ++g) { a.g_lo = g; a.g_hi = g + 1; hipLaunchKernelGGL(fwd_kernel, dim3(grid), dim3(NTHREADS), LDS_BYTES, stream, a); }
#endif
}
```

```cpp
#include <hip/hip_runtime.h>
#include <cstdio>
#include <cstdint>

#ifndef MK_N_LAUNCHES
#define MK_N_LAUNCHES 1
#endif

#define LAS __attribute__((address_space(3)))
#define GAS __attribute__((address_space(1)))
typedef unsigned short bf16_t;
typedef short bf16x8 __attribute__((ext_vector_type(8)));
typedef short s16x4 __attribute__((ext_vector_type(4)));
typedef float f32x4 __attribute__((ext_vector_type(4)));
typedef float f32x2 __attribute__((ext_vector_type(2)));
typedef float f32x16 __attribute__((ext_vector_type(16)));
typedef unsigned u32x4 __attribute__((ext_vector_type(4)));
typedef unsigned u32x2 __attribute__((ext_vector_type(2)));
typedef int i32x4 __attribute__((ext_vector_type(4)));
typedef int i32x8 __attribute__((ext_vector_type(8)));

constexpr int D = 1024, NB = 16, SEQ = 4096, CTXL = 256, DEPTH = 4;
constexpr int ML = NB * SEQ;
constexpr int MC = NB * CTXL;
constexpr int MT = ML + MC;
constexpr int NZ = 5888;
constexpr int ZC_P = 0, ZC_QK = 256, ZC_V = 1280, ZC_O = 1792, ZC_UV = 2304, ZC_MG = 2816;
constexpr int NZ_BF = 256, NZ_F8 = 5632;
constexpr int ZG_COL = 2816;
constexpr int NEXP = 32, TOPK = 4;
constexpr int NS_MAX = MT * TOPK + NEXP * 256;
constexpr float LN_EPS = 1e-5f, HEAD_EPS = 1e-6f;
constexpr float DN_ALPHA = 1.6817928305074292f;
constexpr int NWAVES = 8, NTHREADS = 512;
constexpr float F8_DESCALE = 1.0f / 256.0f;
constexpr float F8S_ACT = 4.0f, F8S_WGU = 64.0f, F8S_WDN = 64.0f; constexpr int F8E_ACT = 123, F8E_WGU = 123, F8E_WDN = 123;

constexpr size_t MiB = 1u << 20;
constexpr size_t WS_CTL = 0, CTL_ZERO_BYTES = 1 * MiB;
constexpr size_t WS_MOD = 1 * MiB;
constexpr size_t WS_WG = 3 * MiB;
constexpr size_t WS_WSGU = 4 * MiB;
constexpr size_t WS_WPOOL = WS_WSGU + 512 * 1024;
constexpr size_t WS_ROUTE = 5 * MiB;
constexpr size_t WS_WIN = 16 * MiB;
constexpr size_t WS_WBR = 62 * MiB;
constexpr size_t WS_WOUT = 70 * MiB;
constexpr size_t WS_WGU = 78 * MiB;
constexpr size_t WS_WDN = 590 * MiB;
constexpr size_t WS_X = 846 * MiB;
constexpr size_t WS_H = 1118 * MiB;
constexpr size_t WS_Z = 1254 * MiB;
constexpr size_t WS_FS = WS_Z;
constexpr float G8_SCALE = 255.0f;
constexpr float FS_SCALE = 32.0f, FS_CLAMP = 440.0f;
constexpr size_t WS_BRA = 2036 * MiB;
constexpr size_t WS_HFB = 2172 * MiB;
constexpr size_t WS_Y = 2444 * MiB;
constexpr size_t WS_T = 2580 * MiB;
constexpr size_t WS_H2 = 2852 * MiB;
constexpr size_t WS_HID = 2988 * MiB;
constexpr size_t WS_ZG = 3548 * MiB;
constexpr size_t WS_H2F8 = 3554 * MiB;
constexpr size_t WS_H8 = 3624 * MiB;
constexpr size_t WS_WIN8 = 3692 * MiB;
constexpr size_t WS_END = 3714 * MiB;
static_assert(WS_Z + (size_t)MT * NZ * 2 <= WS_BRA && WS_FS + (size_t)MT * 4 * 1024 * 2 <= WS_BRA, "Z/FS");
static_assert(WS_HID + (size_t)NS_MAX * 1024 * 2 <= WS_END, "HID");
constexpr size_t RT_EIDX = 0;
constexpr size_t RT_PROB = 2 * MiB;
constexpr size_t RT_TOK = 4 * MiB;
constexpr size_t RT_DEST = 6 * MiB;
constexpr size_t RT_PSLOT = 8 * MiB;
constexpr size_t RT_CNT = 10 * MiB;
constexpr size_t RT_SEG = 10 * MiB + 64 * 1024;
constexpr int CW_BAR = 4096;

constexpr int LDS_BYTES = 163840;
constexpr int MISC_OFF = LDS_BYTES - 256;
constexpr int TAB_OFF = 131072;
constexpr int NW_WT = 0;
constexpr int NW_LG = 66048;
constexpr int NW_END = 99840;
constexpr int NW_PV = NW_END + 256;

__device__ __forceinline__ unsigned f2bf(float f) { unsigned u = __builtin_bit_cast(unsigned, f); return (u + 0x7fffu + ((u >> 16) & 1u)) >> 16; }
__device__ __forceinline__ unsigned pk2(float lo, float hi) { unsigned r; asm volatile("v_cvt_pk_bf16_f32 %0, %1, %2" : "=v"(r) : "v"(lo), "v"(hi)); return r; }
__device__ __forceinline__ unsigned pk4_fp8(float a, float b, float c, float d) { int w = 0; w = __builtin_amdgcn_cvt_pk_fp8_f32(a, b, w, false); w = __builtin_amdgcn_cvt_pk_fp8_f32(c, d, w, true); return (unsigned)w; }
__device__ __forceinline__ unsigned pk4_u8(float a, float b, float c, float d) {
    const unsigned lo = __builtin_amdgcn_perm(__builtin_bit_cast(unsigned, b), __builtin_bit_cast(unsigned, a), 0x0c0c0400u), hi = __builtin_amdgcn_perm(__builtin_bit_cast(unsigned, d), __builtin_bit_cast(unsigned, c), 0x0c0c0400u);
    return lo | (hi << 16); }
__device__ __forceinline__ f32x4 u8x4_f32(unsigned w) { return (f32x4){(float)(w & 0xffu), (float)((w >> 8) & 0xffu), (float)((w >> 16) & 0xffu), (float)(w >> 24)}; }
__device__ __forceinline__ float bflo(unsigned w) { return __builtin_bit_cast(float, w << 16); }
__device__ __forceinline__ float bfhi(unsigned w) { return __builtin_bit_cast(float, w & 0xffff0000u); }
__device__ __forceinline__ float bf1(bf16_t h) { return __builtin_bit_cast(float, ((unsigned)h) << 16); }
__device__ __forceinline__ float bperm(int srclane, float v) { return __builtin_bit_cast(float, __builtin_amdgcn_ds_bpermute(srclane << 2, __builtin_bit_cast(int, v))); }
__device__ __forceinline__ float shx(float v, int o, int lane) { return bperm(lane ^ o, v); }
__device__ __forceinline__ float shup(float v, int o, int lane) { return bperm(lane >= o ? lane - o : lane, v); }
template <int N> __device__ __forceinline__ float dpp_ror(float v) { return __builtin_bit_cast(float, __builtin_amdgcn_update_dpp(0, __builtin_bit_cast(int, v), 0x120 + N, 0xf, 0xf, false)); }
template <int CTRL, int ROWMASK> __device__ __forceinline__ float dpp_id(float ident, float v) { return __builtin_bit_cast(float, __builtin_amdgcn_update_dpp(__builtin_bit_cast(int, ident), __builtin_bit_cast(int, v), CTRL, ROWMASK, 0xf, false)); }
__device__ __forceinline__ float wave_scan_sum(float v) {
    v += dpp_id<0x111, 0xf>(0.f, v); v += dpp_id<0x112, 0xf>(0.f, v); v += dpp_id<0x114, 0xf>(0.f, v); v += dpp_id<0x118, 0xf>(0.f, v);
    v += dpp_id<0x142, 0xa>(0.f, v); v += dpp_id<0x143, 0xc>(0.f, v); return v; }
__device__ __forceinline__ float wave_scan_max(float v) { const float NI = -3.0e38f;
    v = fmaxf(v, dpp_id<0x111, 0xf>(NI, v)); v = fmaxf(v, dpp_id<0x112, 0xf>(NI, v)); v = fmaxf(v, dpp_id<0x114, 0xf>(NI, v)); v = fmaxf(v, dpp_id<0x118, 0xf>(NI, v));
    v = fmaxf(v, dpp_id<0x142, 0xa>(NI, v)); v = fmaxf(v, dpp_id<0x143, 0xc>(NI, v)); return v; }
template <int CTRL> __device__ __forceinline__ float dpp_mv(float v) { return __builtin_bit_cast(float, __builtin_amdgcn_update_dpp(0, __builtin_bit_cast(int, v), CTRL, 0xf, 0xf, false)); }
__device__ __forceinline__ float oct_sum(float v) { v += dpp_mv<0xB1>(v); v += dpp_mv<0x4E>(v); v += dpp_mv<0x141>(v); return v; }
__device__ __forceinline__ float row16_sum(float v) { v += dpp_ror<8>(v); v += dpp_ror<4>(v); v += dpp_ror<2>(v); v += dpp_ror<1>(v); return v; }
__device__ __forceinline__ float wave_sum(float v, int) {
    v = row16_sum(v);
    { const unsigned u = __builtin_bit_cast(unsigned, v); const auto r = __builtin_amdgcn_permlane16_swap(u, u, false, false); v = __builtin_bit_cast(float, (unsigned)r[0]) + __builtin_bit_cast(float, (unsigned)r[1]); }
    { const unsigned u = __builtin_bit_cast(unsigned, v); const auto r = __builtin_amdgcn_permlane32_swap(u, u, false, false); v = __builtin_bit_cast(float, (unsigned)r[0]) + __builtin_bit_cast(float, (unsigned)r[1]); }
    return v;
}
__device__ __forceinline__ float sigmoidf_(float x) { return __builtin_amdgcn_rcpf(1.0f + __builtin_amdgcn_exp2f(x * -1.4426950408889634f)); }
__device__ __forceinline__ float siluf_(float x) { return x * __builtin_amdgcn_rcpf(1.0f + __builtin_amdgcn_exp2f(x * -1.4426950408889634f)); }
__device__ __forceinline__ f32x4 sigmoid4(f32x4 x) {
    f32x4 t = x * -1.4426950408889634f;
#pragma unroll
    for (int i = 0; i < 4; ++i) t[i] = __builtin_amdgcn_exp2f(t[i]);
    t = t + 1.0f;
#pragma unroll
    for (int i = 0; i < 4; ++i) t[i] = __builtin_amdgcn_rcpf(t[i]);
    return t; }
#define LDS_WAIT() asm volatile("s_waitcnt lgkmcnt(0)" ::: "memory")
#define VM_WAIT() asm volatile("s_waitcnt vmcnt(0)" ::: "memory")

#define XB_TMO      128
#define XB_XCNT(j)  (256  + 64 * (j))
#define XB_XSUB(j)  (1280 + 64 * (j))
#define XB_XGEN(j)  (2304 + 64 * (j))
#define XB_TOP      3328
#define XB_TOPGEN   3392
#define XCD_BAR_WORDS 3456
#define XB_SPIN_CAP (1u << 18)
__device__ __forceinline__ unsigned xb_ld(unsigned* p)              { asm volatile("" : "+v"(p)); return __hip_atomic_load(p, __ATOMIC_RELAXED, __HIP_MEMORY_SCOPE_AGENT); }
__device__ __forceinline__ unsigned xb_add(unsigned* p, unsigned v) { asm volatile("" : "+v"(p), "+v"(v)); return __hip_atomic_fetch_add(p, v, __ATOMIC_RELAXED, __HIP_MEMORY_SCOPE_AGENT); }
__device__ __forceinline__ unsigned xb_xcc_id() { return (unsigned)__builtin_amdgcn_s_getreg((3 << 11) | 20) & 0xFu; }
#define XB_SPIN(cond, bar) do { unsigned _sp = 0; while (cond) { __builtin_amdgcn_s_sleep(1); \
    if ((++_sp & 255u) == 0u) { if (xb_ld(&(bar)[XB_TMO])) break; if (_sp > XB_SPIN_CAP) { atomicAdd(&(bar)[XB_TMO], 1u); break; } } } } while (0)
struct XcdBarrier { unsigned* bar; unsigned x; volatile LAS unsigned* st; };
__device__ __forceinline__ XcdBarrier xcd_barrier_post(unsigned* bar, volatile LAS unsigned* st) {
    XcdBarrier b; b.bar = bar; b.x = xb_xcc_id(); b.st = st;
    if (threadIdx.x == 0) (void)xb_add(&bar[XB_XCNT(b.x)], 1u);
    return b;
}
__device__ __forceinline__ void xcd_barrier_complete(unsigned* bar, unsigned x, unsigned& nloc, unsigned& nx) {
    const unsigned G = gridDim.x * gridDim.y * gridDim.z;
    unsigned sum, cnt, mine, sp = 0u;
    for (;;) {
        sum = 0u; cnt = 0u; mine = 0u;
#pragma unroll
        for (unsigned j = 0; j < 16; ++j) { const unsigned c = xb_ld(&bar[XB_XCNT(j)]); sum += c; cnt += (c > 0u) ? 1u : 0u; mine = (j == x) ? c : mine; }
        if (sum == G) break;
        __builtin_amdgcn_s_sleep(1);
        if ((++sp & 255u) == 0u) { if (xb_ld(&bar[XB_TMO])) break; if (sp > XB_SPIN_CAP) { atomicAdd(&bar[XB_TMO], 1u); break; } }
    }
    nloc = mine > 0u ? mine : 1u; nx = cnt > 0u ? cnt : 1u;
}
__device__ __forceinline__ void xcd_barrier(const XcdBarrier& b) {
    asm volatile("s_waitcnt vmcnt(0)" ::: "memory");
    __syncthreads();
    if (threadIdx.x == 0) {
        unsigned* bar = b.bar;
        __builtin_amdgcn_s_waitcnt(0);
        unsigned nloc = b.st[0], nx = b.st[1];
        if (nloc == 0u) { xcd_barrier_complete(bar, b.x, nloc, nx); b.st[0] = nloc; b.st[1] = nx; }
        const unsigned old = xb_add(&bar[XB_XSUB(b.x)], 1u);
        const unsigned gen = old / nloc;
        if (old + 1u == (gen + 1u) * nloc) {
            __builtin_amdgcn_fence(__ATOMIC_RELEASE, "agent");
            asm volatile("s_waitcnt vmcnt(0)" ::: "memory");
            const unsigned og = xb_add(&bar[XB_TOP], 1u);
            const unsigned tg = og / nx;
            if (og + 1u == (tg + 1u) * nx) xb_add(&bar[XB_TOPGEN], 1u);
            else XB_SPIN(xb_ld(&bar[XB_TOPGEN]) == tg, bar);
            __builtin_amdgcn_fence(__ATOMIC_ACQUIRE, "agent");
            xb_add(&bar[XB_XGEN(b.x)], 1u);
            asm volatile("s_waitcnt vmcnt(0)" ::: "memory");
        } else {
            XB_SPIN(xb_ld(&bar[XB_XGEN(b.x)]) == gen, bar);
            __builtin_amdgcn_fence(__ATOMIC_ACQUIRE, "agent");
            asm volatile("s_waitcnt vmcnt(0)" ::: "memory");
        }
    }
    __syncthreads();
}

namespace pg8 {
constexpr int BM = 256, BK = 64, HALF = 128, HTB = HALF * BK * 2, STAGE_BYTES = 8 * HTB, NXCD = 8, WGM = 8;
__host__ __device__ __forceinline__ int lds_byte(int r, int c) { const int st = (r >> 4) * 2 + (c >> 5), rr = r & 15, cc = c & 31, ob = rr * 64 + cc * 2; return st * 1024 + (ob ^ (((ob >> 9) & 1) << 5)); }
__host__ __device__ __forceinline__ void stage_rc(int b, int& R, int& C) { const int st = b / 1024, sb = b % 1024, swz = sb ^ (((sb >> 9) & 1) << 5); R = (st >> 1) * 16 + swz / 64; C = (st & 1) * 32 + (swz % 64) / 2; }
__host__ __device__ __forceinline__ int perm32(int rho) { const int n = rho >> 4, i = rho & 15; return 8 * (i >> 2) + 4 * n + (i & 3); }
struct Unit { int pm, pn, sub; };
__device__ __forceinline__ unsigned cvt_pk_bf16(float lo, float hi) { unsigned r; asm volatile("v_cvt_pk_bf16_f32 %0, %1, %2" : "=v"(r) : "v"(lo), "v"(hi)); return r; }
__device__ __forceinline__ f32x2 gelu_pk(f32x2 v) {
    const f32x2 av = __builtin_elementwise_abs(v), d = av * 0.2316418882f + 1.0f;
    f32x2 t; t.x = __builtin_amdgcn_rcpf(d.x); t.y = __builtin_amdgcn_rcpf(d.y);
    f32x2 q = t * 0.5307027145f + (-0.7265760135f); q = q * t + 0.7107068705f; q = q * t + (-0.142248368f); q = q * t + 0.127414796f; q = q * t;
    const f32x2 s = (v * v) * (-0.72134752044f);
    f32x2 e; e.x = __builtin_amdgcn_exp2f(s.x); e.y = __builtin_amdgcn_exp2f(s.y);
    const f32x2 m = v * (q * e), r = v - m;
    f32x2 o; o.x = v.x < 0.f ? m.x : r.x; o.y = v.y < 0.f ? m.y : r.y; return o;
}
template <int NSUB = 1> struct StaticOrder {
    int nM, nN, nwg, G, c, pm0;
    __device__ void init(int nM_, int nN_, int G_, int c_, int pm0_ = 0) { nM = nM_; nN = nN_; nwg = nM * nN; G = G_; c = c_; pm0 = pm0_; }
    __device__ bool next(int i, Unit& u) const {
        const int it = i / NSUB; u.sub = i - it * NSUB;
        const long L = (long)it * G + c; if (L >= nwg) return false;
        int wgid = (int)L; { const int q = nwg / NXCD, r = nwg % NXCD, xcd = wgid % NXCD, off = wgid / NXCD; wgid = (xcd < r ? xcd * (q + 1) : r * (q + 1) + (xcd - r) * q) + off; }
        const int nig = WGM * nN, gid = wgid / nig, fm = gid * WGM, gsz = (nM - fm) < WGM ? (nM - fm) : WGM;
        u.pm = pm0 + fm + ((wgid % nig) % gsz); u.pn = (wgid % nig) / gsz; return true;
    }
};
constexpr int SIDE_TOK = 131072 + 2048;
constexpr int SIDE_SLOT = 131072 + 10240, SIDE_SLOT_BYTES = 3072;
__device__ __forceinline__ void dma16(unsigned voff, const void* sbase, unsigned ldsaddr) { asm volatile("s_mov_b32 m0, %2\n\tglobal_load_lds_dwordx4 %0, %1" :: "v"(voff), "s"(sbase), "s"(ldsaddr) : "memory", "m0"); }
__device__ __forceinline__ void dma4(unsigned voff, const void* sbase, unsigned ldsaddr) { asm volatile("s_mov_b32 m0, %2\n\tglobal_load_lds_dword %0, %1" :: "v"(voff), "s"(sbase), "s"(ldsaddr) : "memory", "m0"); }
template <class Prob, class Sched, class Epi>
__device__ __forceinline__ void gemm_phase(LAS unsigned char* lds, const int tid, const Prob& P, const Sched& S, const Epi& E) {
    const int wid = __builtin_amdgcn_readfirstlane(tid >> 6), lane = tid & 63, wr = wid >> 2, wc = wid & 3, fr = lane & 15, fq = lane >> 4;
    const int lda = P.lda, ldb = P.ldb;
    unsigned voffB[2], offA[2][2];
#define PG8_TOKSLOT(name) const LAS int* name; { PG8_TID(tl2_); name = (const LAS int*)(lds + SIDE_TOK) + (tl2_ >> 6) * 256 + (tl2_ & 63); }
#define PG8_TID(v_) int v_; asm volatile("v_mbcnt_lo_u32_b32 %0, -1, 0\n\tv_mbcnt_hi_u32_b32 %0, -1, %0" : "=v"(v_)); v_ |= (wid << 6)
#define PG8_RC(R_, C_) int R_[2], C_[2]; { PG8_TID(tl_); _Pragma("unroll") for (int i_ = 0; i_ < 2; ++i_) stage_rc(tl_ * 16 + i_ * 8192, R_[i_], C_[i_]); }
#pragma unroll
    for (int i = 0; i < 2; ++i) { int R, C; stage_rc(tid * 16 + i * 8192, R, C); const int Rb = Epi::PERM ? ((R & ~31) + perm32(R & 31)) : R;
        voffB[i] = (unsigned)(Rb * ldb + C) * 2u;
        offA[0][i] = (unsigned)(R * lda + C) * 2u; offA[1][i] = (unsigned)((R + HALF) * lda + C) * 2u; }
    const size_t kstep = (size_t)(BK * 2);
    const size_t hstep = (size_t)HALF * ldb * 2;
    const unsigned ldsw = (unsigned)wid * 1024u;
    const int aoff = lds_byte(wr * 64 + fr, fq * 8), boff = lds_byte(wc * 32 + fr, fq * 8);
#define PG8_SA(b, h) (((b) * 2 + (h)) * HTB)
#define PG8_SB(b, h) ((4 + (b) * 2 + (h)) * HTB)
    const unsigned ldsb = (unsigned)(size_t)lds;
#define PG8_STAGE(bufoff, gbase, voff) do { _Pragma("unroll") for (int _i = 0; _i < 2; ++_i) \
        asm volatile("s_mov_b32 m0, %2\n\tglobal_load_lds_dwordx4 %0, %1" :: "v"((voff)[_i]), "s"((const char*)(gbase)), "s"(ldsb + (unsigned)(bufoff) + ldsw + (unsigned)(_i * 8192)) : "memory", "m0"); } while (0)
#define PG8_CAT(x0, x1) __builtin_shufflevector(x0, x1, 0, 1, 2, 3, 4, 5, 6, 7)
#define PG8_LDA(dst, b, h) do { if constexpr (Prob::FP8) { _Pragma("unroll") for (int m = 0; m < 4; ++m) dst##8[m] = PG8_CAT(*(const LAS i32x4*)(lds + PG8_SA(b, h) + aoff + m * 2048), *(const LAS i32x4*)(lds + PG8_SA(b, h) + aoff + m * 2048 + 1024)); } \
        else { _Pragma("unroll") for (int m = 0; m < 4; ++m) _Pragma("unroll") for (int k = 0; k < 2; ++k) dst[m][k] = *(const LAS bf16x8*)(lds + PG8_SA(b, h) + aoff + m * 2048 + k * 1024); } } while (0)
#define PG8_LDB(dst, b, h) do { if constexpr (Prob::FP8) { _Pragma("unroll") for (int n = 0; n < 2; ++n) dst##8[n] = PG8_CAT(*(const LAS i32x4*)(lds + PG8_SB(b, h) + boff + n * 2048), *(const LAS i32x4*)(lds + PG8_SB(b, h) + boff + n * 2048 + 1024)); } \
        else { _Pragma("unroll") for (int n = 0; n < 2; ++n) _Pragma("unroll") for (int k = 0; k < 2; ++k) dst[n][k] = *(const LAS bf16x8*)(lds + PG8_SB(b, h) + boff + n * 2048 + k * 1024); } } while (0)
#define PG8_MMA(ai, bj, At, Bt) do { __builtin_amdgcn_s_setprio(1); \
        if constexpr (Prob::FP8) { _Pragma("unroll") for (int m = 0; m < 4; ++m) _Pragma("unroll") for (int n = 0; n < 2; ++n) \
            acc[ai][bj][m][n] = __builtin_amdgcn_mfma_scale_f32_16x16x128_f8f6f4(Bt##8[n], At##8[m], acc[ai][bj][m][n], 0, 0, 0, 0, 0, 0); } \
        else { _Pragma("unroll") for (int m = 0; m < 4; ++m) _Pragma("unroll") for (int n = 0; n < 2; ++n) _Pragma("unroll") for (int k = 0; k < 2; ++k) \
            acc[ai][bj][m][n] = __builtin_amdgcn_mfma_f32_16x16x32_bf16(Bt[n][k], At[m][k], acc[ai][bj][m][n], 0, 0, 0); } \
        __builtin_amdgcn_s_setprio(0); } while (0)
#define PG8_WAIT_V(n) asm volatile("s_waitcnt vmcnt(" #n ")" ::: "memory")
#define PG8_WAIT_L(n) asm volatile("s_waitcnt lgkmcnt(" #n ")" ::: "memory")
#define PG8_BAR __builtin_amdgcn_s_barrier()
#define PG8_SCHED __builtin_amdgcn_sched_barrier(0)
    Unit cur, nxt; int ui = 0;
    if (!S.next(0, cur)) return;
    f32x4 acc[2][2][4][2];
    float zero_; asm volatile("v_mov_b32 %0, 0" : "=v"(zero_));
#pragma unroll
    for (int a = 0; a < 2; ++a)
#pragma unroll
        for (int b = 0; b < 2; ++b)
#pragma unroll
            for (int m = 0; m < 4; ++m)
#pragma unroll
                for (int n = 0; n < 2; ++n) acc[a][b][m][n] = (f32x4){zero_, zero_, zero_, zero_};
    bf16x8 At[4][2], B0[2][2], B1[2][2]; i32x8 At8[4], B08[2], B18[2];
    const char* cA = P.a_base(cur); const char* cB = P.b_base(cur); int nt = P.nt(cur);
    if constexpr (Prob::GATHER) { PG8_RC(Rr, Cc); P.a_rows(cur, Rr, Cc, offA); }
    if constexpr (Epi::SIDE) { PG8_TID(tl4_); E.side(cur, ldsb + SIDE_SLOT, wid, tl4_ & 63); }
    PG8_STAGE(PG8_SB(0, 0), cB, voffB); PG8_STAGE(PG8_SB(0, 1), cB + hstep, voffB); PG8_STAGE(PG8_SA(0, 0), cA, offA[0]); PG8_STAGE(PG8_SA(0, 1), cA, offA[1]);
    if (wr == 1) PG8_BAR;
    PG8_WAIT_V(2); PG8_BAR;
    PG8_STAGE(PG8_SB(1, 0), cB + kstep, voffB); PG8_STAGE(PG8_SA(1, 0), cA + kstep, offA[0]); PG8_STAGE(PG8_SB(1, 1), cB + hstep + kstep, voffB);
    PG8_WAIT_V(6); PG8_BAR;
    for (;;) {
        const bool has_next = S.next(ui + 1, nxt);
        const char* nA = has_next ? P.a_base(nxt) : cA; const char* nB = has_next ? P.b_base(nxt) : cB;
        if constexpr (Prob::GATHER) { if (has_next) { PG8_RC(Rr, Cc); (void)Cc;
#pragma unroll
            for (int h = 0; h < 2; ++h)
#pragma unroll
                for (int i = 0; i < 2; ++i) dma4((unsigned)(nxt.pm * 256 + h * 128 + Rr[i]) * 4u, P.tok, ldsb + SIDE_TOK + (unsigned)wid * 1024u + (unsigned)((h * 2 + i) * 256)); } }
        if constexpr (Epi::SIDE) { if (has_next) { PG8_TID(tl4_); E.side(nxt, ldsb + SIDE_SLOT + (unsigned)(((ui + 1) % 3) * SIDE_SLOT_BYTES), wid, tl4_ & 63); } }
        for (int t = 0; t < nt; t += 2) {
            const bool last = (t == nt - 2);
            if constexpr (Epi::KHOOK) { if (t == Epi::HOOK_T0 || t == Epi::HOOK_T1) {
                asm volatile("" ::: "memory"); PG8_TID(tlh_); const int lnh_ = tlh_ & 63; E.hook(acc, cur, t == Epi::HOOK_T0 ? 0 : 1, wr, wc, lnh_ & 15, lnh_ >> 4); asm volatile("" ::: "memory"); } }
            const char* a1 = cA + (size_t)(t + 1) * kstep;
            const char* a2 = last ? nA : cA + (size_t)(t + 2) * kstep; const char* b2 = last ? nB : cB + (size_t)(t + 2) * kstep;
            const char* a3 = a2 + kstep; const char* b3 = b2 + kstep;
            PG8_LDB(B0, 0, 0); PG8_LDB(B1, 0, 1); PG8_SCHED; PG8_LDA(At, 0, 0); PG8_STAGE(PG8_SA(1, 1), a1, offA[1]);
            PG8_WAIT_V(8); PG8_WAIT_L(0); PG8_BAR; PG8_MMA(0, 0, At, B0); PG8_MMA(0, 1, At, B1); PG8_BAR; PG8_SCHED;
            if constexpr (Prob::GATHER) { if (last && has_next) { PG8_RC(Rr, Cc); (void)Rr; PG8_TOKSLOT(tokslot); const int ntok[2][2] = {{tokslot[0], tokslot[64]}, {tokslot[128], tokslot[192]}}; P.a_off(ntok, Cc, offA); } }
            PG8_LDA(At, 0, 1); PG8_STAGE(PG8_SB(0, 0), b2, voffB); PG8_STAGE(PG8_SB(0, 1), b2 + hstep, voffB); PG8_STAGE(PG8_SA(0, 0), a2, offA[0]);
            PG8_WAIT_V(8); PG8_WAIT_L(0); PG8_BAR; PG8_MMA(1, 0, At, B0); PG8_MMA(1, 1, At, B1); PG8_BAR; PG8_SCHED;
            PG8_LDB(B0, 1, 0); PG8_LDB(B1, 1, 1); PG8_SCHED; PG8_LDA(At, 1, 0); PG8_STAGE(PG8_SA(0, 1), a2, offA[1]);
            PG8_WAIT_V(8); PG8_WAIT_L(0); PG8_BAR; PG8_MMA(0, 0, At, B0); PG8_MMA(0, 1, At, B1); PG8_BAR; PG8_SCHED;
            PG8_LDA(At, 1, 1); PG8_STAGE(PG8_SB(1, 0), b3, voffB); PG8_STAGE(PG8_SB(1, 1), b3 + hstep, voffB); PG8_STAGE(PG8_SA(1, 0), a3, offA[0]);
            PG8_WAIT_V(8); PG8_WAIT_L(0); PG8_BAR; PG8_MMA(1, 0, At, B0); PG8_MMA(1, 1, At, B1); PG8_BAR; PG8_SCHED;
        }
        if (wr == 0) PG8_BAR;
        { PG8_TID(tl3_); const int ln_ = tl3_ & 63; E(acc, cur, wr, wc, ln_ & 15, ln_ >> 4, lds + SIDE_SLOT + (ui % 3) * SIDE_SLOT_BYTES); }
        if (!has_next) break;
        bool keep = false;
        if constexpr (Epi::CHAIN) keep = E.keep(cur);
        if (!keep) {
            asm volatile("v_mov_b32 %0, 0" : "=v"(zero_));
#pragma unroll
            for (int a = 0; a < 2; ++a)
#pragma unroll
                for (int b = 0; b < 2; ++b)
#pragma unroll
                    for (int m = 0; m < 4; ++m)
#pragma unroll
                        for (int n = 0; n < 2; ++n) acc[a][b][m][n] = (f32x4){zero_, zero_, zero_, zero_};
        }
        cur = nxt; cA = nA; cB = nB; nt = P.nt(cur); ++ui;
        if (wr == 1) PG8_BAR;
    }
    PG8_WAIT_V(0);
    PG8_BAR;
#undef PG8_RC
#undef PG8_TID
#undef PG8_TOKSLOT
#undef PG8_SA
#undef PG8_SB
#undef PG8_STAGE
#undef PG8_LDA
#undef PG8_LDB
#undef PG8_MMA
#undef PG8_CAT
#undef PG8_WAIT_V
#undef PG8_WAIT_L
#undef PG8_BAR
#undef PG8_SCHED
}
}

typedef const float* cfp_t;
typedef const cfp_t __attribute__((address_space(4))) * InTab;
struct Frame {
    LAS unsigned char* lds;
    volatile LAS unsigned* MISC;
    unsigned char* ws;
    InTab in;
    float* out;
    int tid, lane, wave, G, bid;
};
enum { IN_X = 0, IN_C, IN_CTX, IN_CCTX, IN_WADA, IN_BADA, IN_WIN, IN_BIN, IN_POOLW, IN_POOLS, IN_CONVW, IN_CONVB, IN_MNG, IN_SLNG, IN_SLNB, IN_SGUW, IN_SGUB,
       IN_WBP, IN_WBM, IN_WBS, IN_WOUT, IN_LN1G, IN_LN1B, IN_WR, IN_BR, IN_WGU, IN_BGU, IN_WDN, IN_BDN, IN_LN2G, IN_LN2B };
__device__ __forceinline__ int mod_row(int row) { return row < ML ? (row >> 12) : NB; }
__device__ __forceinline__ const float* modp(const Frame& F, int l, int row, int part) { return (const float*)(F.ws + WS_MOD) + ((size_t)(l * 17 + mod_row(row)) * 6 + part) * 1024; }

__device__ __forceinline__ void transpose_item(const float* W, size_t ldw, int k0, int srccol0, bf16_t* dst, size_t ldk, int kd0, LAS float* scr, int lane) {
#pragma unroll 8
    for (int i = 0; i < 32; ++i) { const int kk = 2 * i + (lane >> 5); scr[kk * 33 + (lane & 31)] = __builtin_nontemporal_load(W + (size_t)(k0 + kk) * ldw + srccol0 + (lane & 31)); }
    LDS_WAIT(); asm volatile("" ::: "memory");
    const int c = lane & 7;
#pragma unroll
    for (int j = 0; j < 4; ++j) { const int n = (lane >> 3) + 8 * j; const LAS float* s = scr + (8 * c) * 33 + n;
        u32x4 o; o.x = pk2(s[0 * 33], s[1 * 33]); o.y = pk2(s[2 * 33], s[3 * 33]); o.z = pk2(s[4 * 33], s[5 * 33]); o.w = pk2(s[6 * 33], s[7 * 33]);
        *(u32x4*)(dst + (size_t)n * ldk + kd0 + 8 * c) = o; }
    LDS_WAIT(); asm volatile("" ::: "memory");
}
__device__ __forceinline__ void transpose_item_fp8(const float* W, size_t ldw, int k0, int srccol0, unsigned char* dst, size_t ldk, int kd0, float sc, LAS float* scr, int lane) {
#pragma unroll 8
    for (int i = 0; i < 32; ++i) { const int kk = 2 * i + (lane >> 5); scr[kk * 33 + (lane & 31)] = __builtin_nontemporal_load(W + (size_t)(k0 + kk) * ldw + srccol0 + (lane & 31)); }
    LDS_WAIT(); asm volatile("" ::: "memory");
    const int c = lane & 7;
#pragma unroll
    for (int j = 0; j < 4; ++j) { const int n = (lane >> 3) + 8 * j; const LAS float* s_ = scr + (8 * c) * 33 + n;
        u32x2 o; o.x = pk4_fp8(s_[0 * 33] * sc, s_[1 * 33] * sc, s_[2 * 33] * sc, s_[3 * 33] * sc); o.y = pk4_fp8(s_[4 * 33] * sc, s_[5 * 33] * sc, s_[6 * 33] * sc, s_[7 * 33] * sc);
        *(u32x2*)(dst + (size_t)n * ldk + kd0 + 8 * c) = o; }
    LDS_WAIT(); asm volatile("" ::: "memory");
}
__device__ __forceinline__ void phase_prologue(Frame& F) {
    LAS float* scr = (LAS float*)(F.lds + F.wave * 16384);
    const int gw = F.bid * NWAVES + F.wave, NGW = F.G * NWAVES;
    constexpr int I_IN = 16 * (NZ / 32);
    constexpr int I_BR = (4 + 8 + 4) * 32;
    constexpr int I_OUT = 16 * 32;
    constexpr int I_GU = 16 * 64;
    constexpr int I_DN = 16 * 32;
    constexpr int T_IN = DEPTH * I_IN, T_BR = DEPTH * I_BR, T_OUT = DEPTH * I_OUT, T_GU = DEPTH * NEXP * I_GU, T_DN = DEPTH * NEXP * I_DN;
    constexpr int NITEMS = T_IN + T_BR + T_OUT + T_GU + T_DN;
    for (int it = gw; it < NITEMS; it += NGW) {
        int r = it;
        if (r < T_IN) { const int l = r / I_IN; r %= I_IN; const int kb = r / (NZ / 32), nb = r % (NZ / 32); const int n0 = nb * 32, src = n0 < 2304 ? n0 : n0 + 16;
            if (n0 < NZ_BF) transpose_item(F.in[IN_WIN] + (size_t)l * D * 5904, 5904, kb * 64, src, (bf16_t*)(F.ws + WS_WIN) + ((size_t)l * NZ + n0) * D, D, kb * 64, scr, F.lane);
            else transpose_item_fp8(F.in[IN_WIN] + (size_t)l * D * 5904, 5904, kb * 64, src, (unsigned char*)(F.ws + WS_WIN8) + ((size_t)l * NZ_F8 + (n0 - NZ_BF)) * D, D, kb * 64, F8S_WGU, scr, F.lane);
            continue; }
        r -= T_IN;
        if (r < T_BR) { const int l = r / I_BR; r %= I_BR; const int kb = r / 32, nb = r % 32;
            const float* W; int ksrc;
            if (kb < 4) { W = F.in[IN_WBP] + (size_t)l * 256 * D; ksrc = kb * 64; } else if (kb < 12) { W = F.in[IN_WBM] + (size_t)l * 512 * D; ksrc = (kb - 4) * 64; } else { W = F.in[IN_WBS] + (size_t)l * 256 * D; ksrc = (kb - 12) * 64; }
            transpose_item(W, D, ksrc, nb * 32, (bf16_t*)(F.ws + WS_WBR) + ((size_t)l * D + nb * 32) * D, D, kb * 64, scr, F.lane); continue; }
        r -= T_BR;
        if (r < T_OUT) { const int l = r / I_OUT; r %= I_OUT; const int kb = r / 32, nb = r % 32;
            transpose_item(F.in[IN_WOUT] + (size_t)l * D * D, D, kb * 64, nb * 32, (bf16_t*)(F.ws + WS_WOUT) + ((size_t)l * D + nb * 32) * D, D, kb * 64, scr, F.lane); continue; }
        r -= T_OUT;
        if (r < T_GU) { const int le = r / I_GU; r %= I_GU; const int kb = r / 64, nb = r % 64; const int n0 = nb * 32;
            const int pn = n0 >> 8, c = n0 & 255; const int src = c < 128 ? (128 * pn + c) : (1024 + 128 * pn + c - 128);
            transpose_item_fp8(F.in[IN_WGU] + (size_t)le * D * 2048, 2048, kb * 64, src, (unsigned char*)(F.ws + WS_WGU) + ((size_t)le * 2048 + n0) * D, D, kb * 64, F8S_WGU, scr, F.lane); continue; }
        r -= T_GU;
        { const int le = r / I_DN; r %= I_DN; const int kb = r / 32, nb = r % 32;
            transpose_item_fp8(F.in[IN_WDN] + (size_t)le * D * D, D, kb * 64, nb * 32, (unsigned char*)(F.ws + WS_WDN) + ((size_t)le * D + nb * 32) * D, D, kb * 64, F8S_WDN, scr, F.lane); }
    }
    { const int gt = F.bid * NTHREADS + F.tid, NGT = F.G * NTHREADS;
      for (int i = gt; i < DEPTH * 16 * 1024; i += NGT) { const int l = i >> 14, g = (i >> 10) & 15, k = i & 1023; ((float*)(F.ws + WS_WG))[i] = F.in[IN_WIN][((size_t)l * D + k) * 5904 + 2304 + g]; }
      for (int i = gt; i < DEPTH * 4 * 128 * 128; i += NGT) ((bf16_t*)(F.ws + WS_WSGU))[i] = (bf16_t)f2bf(F.in[IN_SGUW][i]);
      for (int i = gt; i < DEPTH * 4 * 64 * 64; i += NGT) { const int lg = i >> 12, d = (i >> 6) & 63, c = i & 63; ((bf16_t*)(F.ws + WS_WPOOL))[i] = (bf16_t)f2bf(F.in[IN_POOLW][(size_t)lg * 4096 + c * 64 + d]); } }
    __syncthreads();
    { LAS float* sc = (LAS float*)F.lds;
      LAS float* part = (LAS float*)(F.lds + 71680);
      for (int i = F.tid; i < 17 * 1024; i += NTHREADS) { const int r = i >> 10, k = i & 1023; const float v = r < 16 ? F.in[IN_C][r * 1024 + k] : F.in[IN_CCTX][k]; sc[i] = siluf_(v); }
      __syncthreads();
      for (int u = F.bid; u < DEPTH * 48; u += F.G) {
          const int l = u / 48, n0 = (u % 48) * 128, col = F.tid & 127, ks = F.tid >> 7;
          float a[17];
#pragma unroll
          for (int r = 0; r < 17; ++r) a[r] = 0.f;
          const float* W = F.in[IN_WADA] + (size_t)l * D * 6144 + n0 + col;
          for (int k = ks * 256; k < ks * 256 + 256; ++k) { const float w = W[(size_t)k * 6144];
#pragma unroll
              for (int r = 0; r < 17; ++r) a[r] += sc[r * 1024 + k] * w; }
#pragma unroll
          for (int r = 0; r < 17; ++r) part[(ks * 17 + r) * 128 + col] = a[r];
          __syncthreads();
          for (int i = F.tid; i < 17 * 128; i += NTHREADS) { const int r = i >> 7, cc = i & 127;
              const float s = part[(0 * 17 + r) * 128 + cc] + part[(1 * 17 + r) * 128 + cc] + part[(2 * 17 + r) * 128 + cc] + part[(3 * 17 + r) * 128 + cc] + F.in[IN_BADA][l * 6144 + n0 + cc];
              ((float*)(F.ws + WS_MOD))[(size_t)(l * 17 + r) * 6144 + n0 + cc] = s; }
          __syncthreads();
      } }
}

struct RowV { f32x4 v[4]; };
#define RC(lane, j) (8 * (lane) + 512 * ((j) >> 1) + 4 * ((j) & 1))
__device__ __forceinline__ void row_load(RowV& r, const float* p, int lane) {
#pragma unroll
    for (int j = 0; j < 4; ++j) r.v[j] = __builtin_nontemporal_load((const f32x4*)(p + RC(lane, j)));
}
__device__ __forceinline__ void row_load_bf16(RowV& r, const bf16_t* p, int lane) {
#pragma unroll
    for (int h = 0; h < 2; ++h) { const u32x4 w = __builtin_nontemporal_load((const u32x4*)(p + 8 * lane + 512 * h)); r.v[2 * h] = (f32x4){bflo(w.x), bfhi(w.x), bflo(w.y), bfhi(w.y)}; r.v[2 * h + 1] = (f32x4){bflo(w.z), bfhi(w.z), bflo(w.w), bfhi(w.w)}; }
}
__device__ __forceinline__ void row_store(const RowV& r, float* p, int lane) {
#pragma unroll
    for (int j = 0; j < 4; ++j) *(f32x4*)(p + RC(lane, j)) = r.v[j];
}
__device__ __forceinline__ void row_store_nt(const RowV& r, float* p, int lane) {
#pragma unroll
    for (int j = 0; j < 4; ++j) __builtin_nontemporal_store(r.v[j], (f32x4*)(p + RC(lane, j)));
}
__device__ __forceinline__ void row_store_bf16_nt(const RowV& r, bf16_t* p, int lane) {
#pragma unroll
    for (int h = 0; h < 2; ++h) { u32x4 w; w.x = pk2(r.v[2 * h].x, r.v[2 * h].y); w.y = pk2(r.v[2 * h].z, r.v[2 * h].w); w.z = pk2(r.v[2 * h + 1].x, r.v[2 * h + 1].y); w.w = pk2(r.v[2 * h + 1].z, r.v[2 * h + 1].w); __builtin_nontemporal_store(w, (u32x4*)(p + 8 * lane + 512 * h)); }
}
__device__ __forceinline__ void row_store_bf16(const RowV& r, bf16_t* p, int lane) {
#pragma unroll
    for (int h = 0; h < 2; ++h) { u32x4 w; w.x = pk2(r.v[2 * h].x, r.v[2 * h].y); w.y = pk2(r.v[2 * h].z, r.v[2 * h].w); w.z = pk2(r.v[2 * h + 1].x, r.v[2 * h + 1].y); w.w = pk2(r.v[2 * h + 1].z, r.v[2 * h + 1].w); *(u32x4*)(p + 8 * lane + 512 * h) = w; }
}
__device__ __forceinline__ void row_ln_plain(RowV& r, int lane) {
    float s = 0.f;
#pragma unroll
    for (int j = 0; j < 4; ++j) s += (r.v[j].x + r.v[j].y) + (r.v[j].z + r.v[j].w);
    const float mean = wave_sum(s, lane) * (1.f / D); float s2 = 0.f;
#pragma unroll
    for (int j = 0; j < 4; ++j) { r.v[j] = r.v[j] - mean; s2 += (r.v[j].x * r.v[j].x + r.v[j].y * r.v[j].y) + (r.v[j].z * r.v[j].z + r.v[j].w * r.v[j].w); }
    const float rstd = __builtin_amdgcn_rsqf(wave_sum(s2, lane) * (1.f / D) + LN_EPS);
#pragma unroll
    for (int j = 0; j < 4; ++j) r.v[j] = r.v[j] * rstd;
}
__device__ __forceinline__ void row_affine(RowV& r, const float* g, const float* b, int lane) {
#pragma unroll
    for (int j = 0; j < 4; ++j) { const f32x4 gg = *(const f32x4*)(g + RC(lane, j)), bb = *(const f32x4*)(b + RC(lane, j)); r.v[j] = r.v[j] * gg + bb; }
}
__device__ __forceinline__ void row_modulate(RowV& r, const float* sh, const float* sc, int lane) {
#pragma unroll
    for (int j = 0; j < 4; ++j) { const f32x4 s1 = *(const f32x4*)(sc + RC(lane, j)), s0 = *(const f32x4*)(sh + RC(lane, j)); r.v[j] = r.v[j] * (s1 + 1.0f) + s0; }
}
__device__ __forceinline__ LAS float* pv_slot(const Frame& F, int slot) { return (LAS float*)(F.lds + NW_PV) + slot * 1024; }
__device__ __forceinline__ void pv_fill(Frame& F, int slot, const float* src) { LAS f32x4* d = (LAS f32x4*)pv_slot(F, slot); for (int i = F.tid; i < 256; i += NTHREADS) d[i] = *(const f32x4*)(src + 4 * i); }
__device__ __forceinline__ void row_affine_l(RowV& r, const LAS float* g, const LAS float* b, int lane) {
#pragma unroll
    for (int j = 0; j < 4; ++j) { const f32x4 gg = *(const LAS f32x4*)(g + RC(lane, j)), bb = *(const LAS f32x4*)(b + RC(lane, j)); r.v[j] = r.v[j] * gg + bb; }
}
__device__ __forceinline__ void row_modulate_l(RowV& r, const LAS float* sh, const LAS float* sc, int lane) {
#pragma unroll
    for (int j = 0; j < 4; ++j) { const f32x4 s1 = *(const LAS f32x4*)(sc + RC(lane, j)), s0 = *(const LAS f32x4*)(sh + RC(lane, j)); r.v[j] = r.v[j] * (s1 + 1.0f) + s0; }
}
__device__ __forceinline__ void ln0_row(Frame& F, int row, RowV xr, const LAS float* sh, const LAS float* sc) {
    row_ln_plain(xr, F.lane);
    row_modulate_l(xr, sh, sc, F.lane);
    row_store_bf16(xr, (bf16_t*)(F.ws + WS_H) + (size_t)row * D, F.lane);
    { unsigned char* h8 = (unsigned char*)(F.ws + WS_H8) + (size_t)row * D + 8 * F.lane;
#pragma unroll
      for (int h = 0; h < 2; ++h) { u32x2 w; w.x = pk4_fp8(xr.v[2 * h].x * F8S_ACT, xr.v[2 * h].y * F8S_ACT, xr.v[2 * h].z * F8S_ACT, xr.v[2 * h].w * F8S_ACT); w.y = pk4_fp8(xr.v[2 * h + 1].x * F8S_ACT, xr.v[2 * h + 1].y * F8S_ACT, xr.v[2 * h + 1].z * F8S_ACT, xr.v[2 * h + 1].w * F8S_ACT); *(u32x2*)(h8 + 512 * h) = w; } }
}
__device__ __forceinline__ LAS float* narrow_tile_wave(Frame& F, const bf16_t* A) {
    const int r = F.lane & 31, h = F.lane >> 5;
    f32x16 acc;
#pragma unroll
    for (int i = 0; i < 16; ++i) acc[i] = 0.f;
    const bf16_t* ap = A + (size_t)r * D + 8 * h;
    const LAS unsigned char* bp = F.lds + NW_WT + r * 2064 + 16 * h;
    bf16x8 av[2][16];
#pragma unroll
    for (int ks = 0; ks < 16; ++ks) av[0][ks] = *(const bf16x8*)(ap + ks * 16);
#pragma unroll
    for (int kb = 0; kb < 4; ++kb) {
        if (kb < 3) {
#pragma unroll
            for (int ks = 0; ks < 16; ++ks) av[(kb + 1) & 1][ks] = *(const bf16x8*)(ap + ((kb + 1) * 16 + ks) * 16); }
        __builtin_amdgcn_sched_barrier(0);
#pragma unroll
        for (int ks = 0; ks < 16; ++ks) { const bf16x8 b = *(const LAS bf16x8*)(bp + (kb * 16 + ks) * 32); acc = __builtin_amdgcn_mfma_f32_32x32x16_bf16(av[kb & 1][ks], b, acc, 0, 0, 0); }
        __builtin_amdgcn_sched_barrier(0);
    }
    LAS float* lg = (LAS float*)(F.lds + NW_LG) + F.wave * 1056;
#pragma unroll
    for (int i = 0; i < 16; ++i) lg[((i & 3) + 8 * (i >> 2) + 4 * h) * 33 + r] = acc[i];
    asm volatile("s_waitcnt lgkmcnt(0)" ::: "memory");
    return lg;
}
__device__ __forceinline__ void tile_range(const Frame& F, int mrows, int& t_lo, int& t_hi) { const int nt = mrows / 32; t_lo = (int)(((long)F.bid * nt) / F.G); t_hi = (int)(((long)(F.bid + 1) * nt) / F.G); }
__device__ __forceinline__ void load_wg_lds(Frame& F, int l) {
    const float* src = (const float*)(F.ws + WS_WG) + (size_t)l * 16384;
    for (int i = F.tid; i < 32 * 128; i += NTHREADS) { const int g = i >> 7, c8 = i & 127; u32x4 w = (u32x4){0u, 0u, 0u, 0u};
        if (g < 16) { const f32x4 a = *(const f32x4*)(src + g * 1024 + c8 * 8), b = *(const f32x4*)(src + g * 1024 + c8 * 8 + 4); w.x = pk2(a.x, a.y); w.y = pk2(a.z, a.w); w.z = pk2(b.x, b.y); w.w = pk2(b.z, b.w); }
        *(LAS u32x4*)(F.lds + NW_WT + g * 2064 + c8 * 16) = w; }
    __syncthreads();
}
__device__ __forceinline__ void gates_tail(Frame& F, int l, int t_lo, int t_hi) {
    asm volatile("s_waitcnt vmcnt(0)" ::: "memory"); __syncthreads();
    const int g = F.lane & 15; const float bias = F.in[IN_BIN][l * 5904 + 2304 + g];
    for (int tile = t_lo + F.wave; tile < t_hi; tile += NWAVES) {
        const LAS float* lg = narrow_tile_wave(F, (const bf16_t*)(F.ws + WS_H) + (size_t)tile * 32 * D);
#pragma unroll
        for (int rr = 0; rr < 8; ++rr) { const int row = rr * 4 + (F.lane >> 4); ((float*)(F.ws + WS_ZG))[(size_t)(tile * 32 + row) * 16 + g] = lg[row * 33 + g] + bias; }
        asm volatile("s_waitcnt lgkmcnt(0)" ::: "memory");
    }
}

using pg8::Unit;
struct ProbPlain {
    static constexpr bool GATHER = false, FP8 = false; static constexpr int SCALE_A = 127, SCALE_B = 127; const bf16_t* A; const bf16_t* Bt; int lda, ldb;
    __device__ __forceinline__ int nt(const Unit&) const { return lda / 64; }
    __device__ __forceinline__ const char* a_base(const Unit& u) const { return (const char*)A + (size_t)u.pm * 256 * lda * 2; }
    __device__ __forceinline__ const char* b_base(const Unit& u) const { return (const char*)Bt + (size_t)u.pn * 256 * ldb * 2; }
    __device__ __forceinline__ void a_tok(const Unit&, const int (&)[2], int (&)[2][2]) const {}
    __device__ __forceinline__ void a_off(const int (&)[2][2], const int (&)[2], unsigned (&)[2][2]) const {}
    __device__ __forceinline__ void a_rows(const Unit&, const int (&)[2], const int (&)[2], unsigned (&)[2][2]) const {}
};
struct ProbPlainF8 {
    static constexpr bool GATHER = false, FP8 = true; static constexpr int SCALE_A = F8E_ACT, SCALE_B = F8E_WGU; const bf16_t* A; const bf16_t* Bt; int lda, ldb;
    __device__ __forceinline__ int nt(const Unit&) const { return lda / 64; }
    __device__ __forceinline__ const char* a_base(const Unit& u) const { return (const char*)A + (size_t)u.pm * 256 * lda * 2; }
    __device__ __forceinline__ const char* b_base(const Unit& u) const { return (const char*)Bt + (size_t)u.pn * 256 * ldb * 2; }
    __device__ __forceinline__ void a_tok(const Unit&, const int (&)[2], int (&)[2][2]) const {}
    __device__ __forceinline__ void a_off(const int (&)[2][2], const int (&)[2], unsigned (&)[2][2]) const {}
    __device__ __forceinline__ void a_rows(const Unit&, const int (&)[2], const int (&)[2], unsigned (&)[2][2]) const {}
};
struct ProbBranch {
    static constexpr bool GATHER = false, FP8 = false; static constexpr int SCALE_A = 127, SCALE_B = 127; const bf16_t* A; const bf16_t* Bt; int lda, ldb;
    __device__ __forceinline__ int nt(const Unit& u) const { return u.sub == 1 ? 8 : 4; }
    __device__ __forceinline__ int koff(const Unit& u) const { return u.sub == 0 ? 0 : (u.sub == 1 ? 256 : 768); }
    __device__ __forceinline__ const char* a_base(const Unit& u) const { return (const char*)A + ((size_t)u.pm * 256 * lda + koff(u)) * 2; }
    __device__ __forceinline__ const char* b_base(const Unit& u) const { return (const char*)Bt + ((size_t)u.pn * 256 * ldb + koff(u)) * 2; }
    __device__ __forceinline__ void a_tok(const Unit&, const int (&)[2], int (&)[2][2]) const {}
    __device__ __forceinline__ void a_off(const int (&)[2][2], const int (&)[2], unsigned (&)[2][2]) const {}
    __device__ __forceinline__ void a_rows(const Unit&, const int (&)[2], const int (&)[2], unsigned (&)[2][2]) const {}
};
__device__ __forceinline__ int expert_of(const LAS int* seg, int pm) { return __builtin_amdgcn_readfirstlane((int)((const LAS unsigned char*)(seg + 64))[pm]); }
__device__ __forceinline__ int moe_tables(Frame& F, LAS int* seg) {
    __syncthreads();
    if (F.tid <= NEXP) seg[F.tid] = ((const int*)(F.ws + WS_ROUTE + RT_SEG))[F.tid];
    __syncthreads();
    const int ntile = seg[NEXP] / 256;
    LAS unsigned char* texp = (LAS unsigned char*)(seg + 64);
    for (int t = F.tid; t < ntile; t += NTHREADS) { const int row = t * 256; int e = 0;
#pragma unroll
        for (int i = 1; i < NEXP; ++i) e += (seg[i] <= row) ? 1 : 0;
        texp[t] = (unsigned char)e; }
    __syncthreads();
    return ntile;
}
struct ProbMoe1 {
    static constexpr bool GATHER = true, FP8 = true; static constexpr int SCALE_A = F8E_ACT, SCALE_B = F8E_WGU; const bf16_t* A; const bf16_t* Bt; int lda, ldb; const int* tok; const LAS int* seg;
    __device__ __forceinline__ int nt(const Unit&) const { return lda / 64; }
    __device__ __forceinline__ const char* a_base(const Unit&) const { return (const char*)A; }
    __device__ __forceinline__ const char* b_base(const Unit& u) const { const int e = expert_of(seg, u.pm); return (const char*)Bt + ((size_t)e * 2048 + (size_t)u.pn * 256) * ldb * 2; }
    __device__ __forceinline__ void a_rows(const Unit& u, const int (&R)[2], const int (&C)[2], unsigned (&off)[2][2]) const {
#pragma unroll
        for (int h = 0; h < 2; ++h)
#pragma unroll
            for (int i = 0; i < 2; ++i) { const int t = tok[u.pm * 256 + h * 128 + R[i]]; off[h][i] = (unsigned)(t * lda + C[i]) * 2u; } }
    __device__ __forceinline__ void a_tok(const Unit& u, const int (&R)[2], int (&tk)[2][2]) const {
#pragma unroll
        for (int h = 0; h < 2; ++h)
#pragma unroll
            for (int i = 0; i < 2; ++i) tk[h][i] = tok[u.pm * 256 + h * 128 + R[i]]; }
    __device__ __forceinline__ void a_off(const int (&tk)[2][2], const int (&C)[2], unsigned (&off)[2][2]) const {
#pragma unroll
        for (int h = 0; h < 2; ++h)
#pragma unroll
            for (int i = 0; i < 2; ++i) off[h][i] = (unsigned)(tk[h][i] * lda + C[i]) * 2u; }
};
struct ProbMoe2 {
    static constexpr bool GATHER = false, FP8 = true; static constexpr int SCALE_A = F8E_ACT, SCALE_B = F8E_WDN; const bf16_t* A; const bf16_t* Bt; int lda, ldb; const LAS int* seg;
    __device__ __forceinline__ int nt(const Unit&) const { return lda / 64; }
    __device__ __forceinline__ const char* a_base(const Unit& u) const { return (const char*)A + (size_t)u.pm * 256 * lda * 2; }
    __device__ __forceinline__ const char* b_base(const Unit& u) const { const int e = expert_of(seg, u.pm); return (const char*)Bt + ((size_t)e * 1024 + (size_t)u.pn * 256) * ldb * 2; }
    __device__ __forceinline__ void a_tok(const Unit&, const int (&)[2], int (&)[2][2]) const {}
    __device__ __forceinline__ void a_off(const int (&)[2][2], const int (&)[2], unsigned (&)[2][2]) const {}
    __device__ __forceinline__ void a_rows(const Unit&, const int (&)[2], const int (&)[2], unsigned (&)[2][2]) const {}
};
using pg8::cvt_pk_bf16;
template <bool G8> struct EpiInproj {
    static constexpr bool PERM = true, CHAIN = false, SIDE = true, KHOOK = false; bf16_t* Z; const float* bias; int pn0;
    __device__ __forceinline__ void side(const Unit& u0, unsigned slot, int wid, int lane) const { const int pn = u0.pn + pn0; if (wid == 1) pg8::dma16((unsigned)lane * 16u, bias + pn * 256 + (pn >= 9 ? 16 : 0), slot); }
    __device__ __forceinline__ void operator()(const f32x4 (&acc)[2][2][4][2], const Unit& u0, int wr, int wc, int fr, int fq, const LAS unsigned char* sd) const {
        Unit u = u0; u.pn += pn0;
        int row0 = u.pm * 256 + wr * 64 + fr, col0 = u.pn * 256 + wc * 32 + 8 * fq; asm volatile("" : "+v"(row0), "+v"(col0));
        const int act = (u.pn <= 6) ? 0 : ((u.pn == 9 || u.pn == 10) ? 2 : 1);
        f32x4 bv[2][2];
#pragma unroll
        for (int bj = 0; bj < 2; ++bj)
#pragma unroll
            for (int n = 0; n < 2; ++n) bv[bj][n] = *(const LAS f32x4*)(sd + (bj * 128 + wc * 32 + 8 * fq + 4 * n) * 4);
#pragma unroll
        for (int ai = 0; ai < 2; ++ai)
#pragma unroll
            for (int m = 0; m < 4; ++m) { bf16_t* rowp = Z + (size_t)(row0 + ai * 128 + m * 16) * NZ + col0;
#pragma unroll
                for (int bj = 0; bj < 2; ++bj) { f32x4 v0, v1;
                    if constexpr (G8) { v0 = acc[ai][bj][m][0] * F8_DESCALE + bv[bj][0]; v1 = acc[ai][bj][m][1] * F8_DESCALE + bv[bj][1]; } else { v0 = acc[ai][bj][m][0] + bv[bj][0]; v1 = acc[ai][bj][m][1] + bv[bj][1]; }
                    if (G8 && u.pn >= ZG_COL / 256) { u32x2 w8;
                        v0 = sigmoid4(v0) * G8_SCALE; v1 = sigmoid4(v1) * G8_SCALE;
#pragma unroll
                        for (int j = 0; j < 4; ++j) { v0[j] = fmaxf(v0[j], 1.0f); v1[j] = fmaxf(v1[j], 1.0f); }
                        v0 = v0 + 12582912.0f; v1 = v1 + 12582912.0f;
                        w8.x = pk4_u8(v0[0], v0[1], v0[2], v0[3]); w8.y = pk4_u8(v1[0], v1[1], v1[2], v1[3]);
                        *(u32x2*)((unsigned char*)(Z + (size_t)(row0 + ai * 128 + m * 16) * NZ + ZG_COL) + (col0 - ZG_COL) + bj * 128) = w8; continue; }
                    if (act == 2) { f32x2 a = pg8::gelu_pk((f32x2){v0[0], v0[1]}), b = pg8::gelu_pk((f32x2){v0[2], v0[3]}), c = pg8::gelu_pk((f32x2){v1[0], v1[1]}), d = pg8::gelu_pk((f32x2){v1[2], v1[3]});
                        v0 = (f32x4){a.x, a.y, b.x, b.y}; v1 = (f32x4){c.x, c.y, d.x, d.y}; }
                    if (act == 1) { v0 = sigmoid4(v0); v1 = sigmoid4(v1); }
                    u32x4 w; w.x = cvt_pk_bf16(v0[0], v0[1]); w.y = cvt_pk_bf16(v0[2], v0[3]); w.z = cvt_pk_bf16(v1[0], v1[1]); w.w = cvt_pk_bf16(v1[2], v1[3]);
                    *(u32x4*)(rowp + bj * 128) = w; }
                if constexpr (G8) asm volatile("" ::: "memory"); }
    }
};
struct EpiNull {
    static constexpr bool PERM = true, CHAIN = false; bf16_t* Z;
    __device__ __forceinline__ void operator()(const f32x4 (&acc)[2][2][4][2], const Unit& u, int wr, int wc, int fr, int fq) const {
        float sacc = 0.f;
#pragma unroll
        for (int ai = 0; ai < 2; ++ai)
#pragma unroll
            for (int bj = 0; bj < 2; ++bj)
#pragma unroll
                for (int m = 0; m < 4; ++m)
#pragma unroll
                    for (int n = 0; n < 2; ++n) sacc += (acc[ai][bj][m][n][0] + acc[ai][bj][m][n][1]) + (acc[ai][bj][m][n][2] + acc[ai][bj][m][n][3]);
        if (sacc == 1.2345e30f) Z[u.pm + wr + wc + fr + fq] = 0;
    }
};
struct EpiOut {
    static constexpr bool PERM = true, CHAIN = false, SIDE = false, KHOOK = false; bf16_t* T;
    __device__ __forceinline__ void operator()(const f32x4 (&acc)[2][2][4][2], const Unit& u, int wr, int wc, int fr, int fq, const LAS unsigned char*) const {
        int row0 = u.pm * 256 + wr * 64 + fr, col0 = u.pn * 256 + wc * 32 + 8 * fq; asm volatile("" : "+v"(row0), "+v"(col0));
#pragma unroll
        for (int ai = 0; ai < 2; ++ai)
#pragma unroll
            for (int m = 0; m < 4; ++m) { bf16_t* rowp = T + (size_t)(row0 + ai * 128 + m * 16) * D + col0;
#pragma unroll
                for (int bj = 0; bj < 2; ++bj) { const f32x4 v0 = acc[ai][bj][m][0], v1 = acc[ai][bj][m][1];
                    u32x4 w; w.x = cvt_pk_bf16(v0[0], v0[1]); w.y = cvt_pk_bf16(v0[2], v0[3]); w.z = cvt_pk_bf16(v1[0], v1[1]); w.w = cvt_pk_bf16(v1[2], v1[3]);
                    *(u32x4*)(rowp + bj * 128) = w; } }
    }
};
struct EpiBranch {
    static constexpr bool PERM = true, CHAIN = false, SIDE = false, KHOOK = true; static constexpr int HOOK_T0 = 4, HOOK_T1 = 12;
    const bf16_t* Z; bf16_t* Y;
    template <bool FIN> __device__ __forceinline__ void apply(f32x4 (&acc)[2][2][4][2], const Unit& u, int br, int wr, int wc, int fr, int fq) const {
        int row0 = u.pm * 256 + wr * 64 + fr, col0 = u.pn * 256 + wc * 32 + 8 * fq;
        asm volatile("" : "+v"(row0), "+v"(col0));
#pragma unroll
        for (int ai = 0; ai < 2; ++ai) {
            u32x2 ga[4][2], gb[4][2];
#pragma unroll
            for (int m = 0; m < 4; ++m) { const unsigned char* rowp = (const unsigned char*)(Z + (size_t)(row0 + ai * 128 + m * 16) * NZ + ZG_COL) + br * 1024 + col0;
#pragma unroll
                for (int bj = 0; bj < 2; ++bj) { ga[m][bj] = *(const u32x2*)(rowp + bj * 128); if (!FIN) gb[m][bj] = *(const u32x2*)(rowp + 1024 + bj * 128); } }
#pragma unroll
            for (int m = 0; m < 4; ++m) { const size_t row = (size_t)(row0 + ai * 128 + m * 16);
#pragma unroll
                for (int bj = 0; bj < 2; ++bj) { const u32x2 a = ga[m][bj];
                    f32x4 r0 = u8x4_f32(a.x), r1 = u8x4_f32(a.y);
                    if (FIN) { r0 = r0 * (1.0f / G8_SCALE); r1 = r1 * (1.0f / G8_SCALE); }
                    else { const u32x2 b = gb[m][bj]; f32x4 q0 = u8x4_f32(b.x), q1 = u8x4_f32(b.y);
#pragma unroll
                        for (int i = 0; i < 4; ++i) { q0[i] = __builtin_amdgcn_rcpf(q0[i]); q1[i] = __builtin_amdgcn_rcpf(q1[i]); }
                        r0 = r0 * q0; r1 = r1 * q1; }
                    acc[ai][bj][m][0] = acc[ai][bj][m][0] * r0; acc[ai][bj][m][1] = acc[ai][bj][m][1] * r1;
                    if (FIN) { const f32x4 v0 = acc[ai][bj][m][0], v1 = acc[ai][bj][m][1];
                        u32x4 w; w.x = cvt_pk_bf16(v0[0], v0[1]); w.y = cvt_pk_bf16(v0[2], v0[3]); w.z = cvt_pk_bf16(v1[0], v1[1]); w.w = cvt_pk_bf16(v1[2], v1[3]);
                        *(u32x4*)(Y + row * D + col0 + bj * 128) = w; } } }
            asm volatile("" ::: "memory"); }
    }
    __device__ __forceinline__ void hook(f32x4 (&acc)[2][2][4][2], const Unit& u, int br, int wr, int wc, int fr, int fq) const { apply<false>(acc, u, br, wr, wc, fr, fq); }
    __device__ __forceinline__ void operator()(f32x4 (&acc)[2][2][4][2], const Unit& u, int wr, int wc, int fr, int fq, const LAS unsigned char*) const { apply<true>(acc, u, 2, wr, wc, fr, fq); }
};
struct EpiSwiglu {
    static constexpr bool PERM = true, CHAIN = false, SIDE = true, KHOOK = false; unsigned char* HID; const float* bgu; const LAS int* seg;
    __device__ __forceinline__ void side(const Unit& u, unsigned slot, int wid, int lane) const {
        if (wid == 1) { const int e = expert_of(seg, u.pm); pg8::dma16(lane < 32 ? (unsigned)lane * 16u : 4096u + (unsigned)(lane - 32) * 16u, bgu + (size_t)e * 2048 + u.pn * 128, slot); } }
    __device__ __forceinline__ void operator()(const f32x4 (&acc)[2][2][4][2], const Unit& u, int wr, int wc, int fr, int fq, const LAS unsigned char* sd) const {
        int j0 = u.pn * 128 + wc * 32 + 8 * fq, slot0 = u.pm * 256 + wr * 64 + fr; asm volatile("" : "+v"(j0), "+v"(slot0));
        f32x4 bg[2], bu[2];
#pragma unroll
        for (int n = 0; n < 2; ++n) { bg[n] = *(const LAS f32x4*)(sd + (wc * 32 + 8 * fq + 4 * n) * 4); bu[n] = *(const LAS f32x4*)(sd + (128 + wc * 32 + 8 * fq + 4 * n) * 4); }
#pragma unroll
        for (int ai = 0; ai < 2; ++ai)
#pragma unroll
            for (int m = 0; m < 4; ++m) { const size_t slot = (size_t)(slot0 + ai * 128 + m * 16); f32x4 o[2];
#pragma unroll
                for (int n = 0; n < 2; ++n) { f32x4 g = acc[ai][0][m][n] * F8_DESCALE + bg[n], up = acc[ai][1][m][n] * F8_DESCALE + bu[n];
#pragma unroll
                    for (int i = 0; i < 4; ++i) { g[i] = fminf(g[i], 7.0f); up[i] = __builtin_amdgcn_fmed3f(up[i], -7.0f, 7.0f); }
                    f32x4 t = g * (-1.702f * 1.4426950408889634f);
#pragma unroll
                    for (int i = 0; i < 4; ++i) t[i] = __builtin_amdgcn_exp2f(t[i]);
                    t = t + 1.0f;
#pragma unroll
                    for (int i = 0; i < 4; ++i) t[i] = __builtin_amdgcn_rcpf(t[i]);
                    o[n] = (up * F8S_ACT + F8S_ACT) * (g * t); }
                u32x2 w; w.x = pk4_fp8(o[0][0], o[0][1], o[0][2], o[0][3]); w.y = pk4_fp8(o[1][0], o[1][1], o[1][2], o[1][3]);
                *(u32x2*)(HID + slot * 1024 + j0) = w; }
    }
};
struct EpiDown {
    static constexpr bool PERM = true, CHAIN = false, SIDE = true, KHOOK = false; unsigned char* FS; const float* bdn; const int* dest; const float* pslot; const LAS int* seg;
    __device__ __forceinline__ void side(const Unit& u, unsigned slot, int wid, int lane) const {
        if (wid == 1) { const int e = expert_of(seg, u.pm); pg8::dma16((unsigned)lane * 16u, bdn + (size_t)e * 1024 + u.pn * 256, slot); }
        if (wid == 2) pg8::dma16((unsigned)lane * 16u, dest + (size_t)u.pm * 256, slot + 1024u);
        if (wid == 3) pg8::dma16((unsigned)lane * 16u, pslot + (size_t)u.pm * 256, slot + 2048u); }
    __device__ __forceinline__ void operator()(const f32x4 (&acc)[2][2][4][2], const Unit& u, int wr, int wc, int fr, int fq, const LAS unsigned char* sd) const {
        int col0 = u.pn * 256 + wc * 32 + 8 * fq, slot0 = u.pm * 256 + wr * 64 + fr; asm volatile("" : "+v"(col0), "+v"(slot0));
        f32x4 bv[2][2];
#pragma unroll
        for (int bj = 0; bj < 2; ++bj)
#pragma unroll
            for (int n = 0; n < 2; ++n) bv[bj][n] = *(const LAS f32x4*)(sd + (bj * 128 + wc * 32 + 8 * fq + 4 * n) * 4);
#pragma unroll
        for (int ai = 0; ai < 2; ++ai)
#pragma unroll
            for (int m = 0; m < 4; ++m) { const int rt = ai * 128 + wr * 64 + m * 16 + fr; const int d = *(const LAS int*)(sd + 1024 + rt * 4); const float p = *(const LAS float*)(sd + 2048 + rt * 4) * FS_SCALE;
                if (d >= 0) {
#pragma unroll
                    for (int bj = 0; bj < 2; ++bj) { f32x4 v0 = (acc[ai][bj][m][0] * F8_DESCALE + bv[bj][0]) * p, v1 = (acc[ai][bj][m][1] * F8_DESCALE + bv[bj][1]) * p;
#pragma unroll
                        for (int i = 0; i < 4; ++i) { v0[i] = __builtin_amdgcn_fmed3f(v0[i], -FS_CLAMP, FS_CLAMP); v1[i] = __builtin_amdgcn_fmed3f(v1[i], -FS_CLAMP, FS_CLAMP); }
                        u32x2 w; w.x = pk4_fp8(v0[0], v0[1], v0[2], v0[3]); w.y = pk4_fp8(v1[0], v1[1], v1[2], v1[3]);
                        *(u32x2*)(FS + (size_t)d * 1024 + col0 + bj * 128) = w; } }
                asm volatile("" ::: "memory"); }
    }
};

__device__ __forceinline__ const float* xin_row(const Frame& F, int row) { return row < ML ? F.in[IN_X] + (size_t)row * D : F.in[IN_CTX] + (size_t)(row - ML) * D; }
__device__ __forceinline__ void phase_ln0_first(Frame& F) {
    int t_lo, t_hi; tile_range(F, MT, t_lo, t_hi);
    const int r_lo = 32 * t_lo, nrows = 32 * (t_hi - t_lo);
    const int mrA = mod_row(r_lo), mrB = mod_row(r_lo + (nrows > 0 ? nrows - 1 : 0));
    { const float* mb = (const float*)(F.ws + WS_MOD); pv_fill(F, 0, mb + ((size_t)(0 * 17 + mrA) * 6 + 0) * 1024); pv_fill(F, 1, mb + ((size_t)(0 * 17 + mrB) * 6 + 0) * 1024);
      pv_fill(F, 2, mb + ((size_t)(0 * 17 + mrA) * 6 + 1) * 1024); pv_fill(F, 3, mb + ((size_t)(0 * 17 + mrB) * 6 + 1) * 1024); }
    load_wg_lds(F, 0);
    for (int n = F.wave; n < nrows; n += 4 * NWAVES) {
        RowV rv[4];
#pragma unroll
        for (int u = 0; u < 4; ++u) if (n + u * NWAVES < nrows) row_load(rv[u], xin_row(F, r_lo + n + u * NWAVES), F.lane);
#pragma unroll
        for (int u = 0; u < 4; ++u) if (n + u * NWAVES < nrows) { const int row = r_lo + n + u * NWAVES;
            const int sel = (mod_row(row) == mrA) ? 0 : 1; ln0_row(F, row, rv[u], pv_slot(F, 0 + sel), pv_slot(F, 2 + sel)); }
    }
    gates_tail(F, 0, t_lo, t_hi);
    __syncthreads();
}
__device__ __forceinline__ void phase_finalize(Frame& F, int l, int mrows) {
    const int gw = F.bid * NWAVES + F.wave, NGW = F.G * NWAVES;
    const bf16_t* hf = (const bf16_t*)(F.ws + WS_HFB); const bf16_t* hb = hf + (size_t)MT * 512;
    const float* ng = F.in[IN_MNG] + l * 512 + 8 * F.lane;
    const f32x4 g0 = *(const f32x4*)ng, g1 = *(const f32x4*)(ng + 4);
    const bf16_t* zo = (const bf16_t*)(F.ws + WS_Z) + ZC_O + 8 * F.lane;
    u32x4 ha = (u32x4){0u, 0u, 0u, 0u}, hbv = ha, so = ha;
    if (gw < mrows) { ha = __builtin_nontemporal_load((const u32x4*)(hf + (size_t)gw * 512 + 8 * F.lane)); hbv = __builtin_nontemporal_load((const u32x4*)(hb + (size_t)gw * 512 + 8 * F.lane)); so = __builtin_nontemporal_load((const u32x4*)(zo + (size_t)gw * NZ)); }
    for (int row = gw; row < mrows; row += NGW) {
        u32x4 han = ha, hbn = hbv, son = so; const int rn = row + NGW;
        if (rn < mrows) { han = __builtin_nontemporal_load((const u32x4*)(hf + (size_t)rn * 512 + 8 * F.lane)); hbn = __builtin_nontemporal_load((const u32x4*)(hb + (size_t)rn * 512 + 8 * F.lane)); son = __builtin_nontemporal_load((const u32x4*)(zo + (size_t)rn * NZ)); }
        __builtin_amdgcn_sched_barrier(0);
        f32x4 v0 = (f32x4){bflo(ha.x) + bflo(hbv.x), bfhi(ha.x) + bfhi(hbv.x), bflo(ha.y) + bflo(hbv.y), bfhi(ha.y) + bfhi(hbv.y)}, v1 = (f32x4){bflo(ha.z) + bflo(hbv.z), bfhi(ha.z) + bfhi(hbv.z), bflo(ha.w) + bflo(hbv.w), bfhi(ha.w) + bfhi(hbv.w)};
        float s = (v0.x + v0.y) + (v0.z + v0.w) + (v1.x + v1.y) + (v1.z + v1.w);
#pragma unroll
        for (int o = 0; o < 1; ++o) s = row16_sum(s);
        const float mu = s * (1.f / 128.f); v0 = v0 - mu; v1 = v1 - mu;
        float q = (v0.x * v0.x + v0.y * v0.y) + (v0.z * v0.z + v0.w * v0.w) + (v1.x * v1.x + v1.y * v1.y) + (v1.z * v1.z + v1.w * v1.w);
#pragma unroll
        for (int o = 0; o < 1; ++o) q = row16_sum(q);
        const float rstd = __builtin_amdgcn_rsqf(q * (1.f / 128.f) + HEAD_EPS);
        v0 = v0 * rstd * g0; v1 = v1 * rstd * g1;
        u32x4 w; w.x = pk2(v0.x * bflo(so.x), v0.y * bfhi(so.x)); w.y = pk2(v0.z * bflo(so.y), v0.w * bfhi(so.y)); w.z = pk2(v1.x * bflo(so.z), v1.y * bfhi(so.z)); w.w = pk2(v1.z * bflo(so.w), v1.w * bfhi(so.w));
        *(u32x4*)((bf16_t*)(F.ws + WS_BRA) + (size_t)row * D + 256 + 8 * F.lane) = w;
        ha = han; hbv = hbn; so = son;
    }
}
__device__ __forceinline__ void phase_ln1_router(Frame& F, int l, int mrows) {
    LAS int* cnt = (LAS int*)(F.lds + NW_END);
    { const float* wr = F.in[IN_WR] + (size_t)l * D * NEXP;
      for (int i = F.tid; i < NEXP * D; i += NTHREADS) { const int k = i >> 5, e = i & 31; *(LAS bf16_t*)(F.lds + NW_WT + e * 2064 + k * 2) = (bf16_t)f2bf(wr[i]); }
      if (F.tid < NEXP) cnt[F.tid] = 0; }
    const float* brt = F.in[IN_BR] + l * NEXP;
    int t_lo, t_hi; tile_range(F, mrows, t_lo, t_hi);
    const int r_lo = 32 * t_lo, nrows = 32 * (t_hi - t_lo);
    const int mrA = mod_row(r_lo), mrB = mod_row(r_lo + (nrows > 0 ? nrows - 1 : 0));
    { const float* mb = (const float*)(F.ws + WS_MOD); pv_fill(F, 0, F.in[IN_LN1G] + l * D); pv_fill(F, 1, F.in[IN_LN1B] + l * D);
      pv_fill(F, 2, mb + ((size_t)(l * 17 + mrA) * 6 + 2) * 1024); pv_fill(F, 3, mb + ((size_t)(l * 17 + mrB) * 6 + 2) * 1024);
      pv_fill(F, 4, mb + ((size_t)(l * 17 + mrA) * 6 + 3) * 1024); pv_fill(F, 5, mb + ((size_t)(l * 17 + mrB) * 6 + 3) * 1024);
      pv_fill(F, 6, mb + ((size_t)(l * 17 + mrA) * 6 + 4) * 1024); pv_fill(F, 7, mb + ((size_t)(l * 17 + mrB) * 6 + 4) * 1024); }
    __syncthreads();
    { const bf16_t* yb = (const bf16_t*)(F.ws + WS_T) + 8 * F.lane;
      RowV rv[2]; u32x4 yv2[2][2];
#pragma unroll
      for (int u = 0; u < 2; ++u) {
#pragma unroll
          for (int j = 0; j < 4; ++j) rv[u].v[j] = (f32x4){0.f, 0.f, 0.f, 0.f};
          yv2[u][0] = yv2[u][1] = (u32x4){0u, 0u, 0u, 0u}; }
#define RT_LOADPAIR(n_, rv_, yv_) do { _Pragma("unroll") for (int u = 0; u < 2; ++u) if ((n_) + u * NWAVES < nrows) { const int row = r_lo + (n_) + u * NWAVES; \
              if (l == 0) row_load(rv_[u], xin_row(F, row), F.lane); else row_load_bf16(rv_[u], (const bf16_t*)(F.ws + WS_X) + (size_t)row * D, F.lane); \
              _Pragma("unroll") for (int h = 0; h < 2; ++h) yv_[u][h] = __builtin_nontemporal_load((const u32x4*)(yb + (size_t)row * D + 512 * h)); } } while (0)
      RT_LOADPAIR(F.wave, rv, yv2);
      for (int n = F.wave; n < nrows; n += 2 * NWAVES) {
          RowV rvn[2]; u32x4 yvn[2][2];
#pragma unroll
          for (int u = 0; u < 2; ++u) { rvn[u] = rv[u]; yvn[u][0] = yv2[u][0]; yvn[u][1] = yv2[u][1]; }
          RT_LOADPAIR(n + 2 * NWAVES, rvn, yvn);
          __builtin_amdgcn_sched_barrier(0);
#pragma unroll
          for (int u = 0; u < 2; ++u) if (n + u * NWAVES < nrows) { const int row = r_lo + n + u * NWAVES; RowV cur = rv[u];
              const int sel = (mod_row(row) == mrA) ? 0 : 1;
              { const LAS float* g1 = pv_slot(F, 2 + sel);
#pragma unroll
                for (int j = 0; j < 4; ++j) { const f32x4 gg = *(const LAS f32x4*)(g1 + RC(F.lane, j)); const u32x4 yw = yv2[u][j >> 1]; const f32x4 yv = (j & 1) ? (f32x4){bflo(yw.z), bfhi(yw.z), bflo(yw.w), bfhi(yw.w)} : (f32x4){bflo(yw.x), bfhi(yw.x), bflo(yw.y), bfhi(yw.y)}; cur.v[j] = cur.v[j] * DN_ALPHA + gg * yv; } }
              row_ln_plain(cur, F.lane); row_affine_l(cur, pv_slot(F, 0), pv_slot(F, 1), F.lane);
              row_store_bf16_nt(cur, (bf16_t*)(F.ws + WS_X) + (size_t)row * D, F.lane);
              row_ln_plain(cur, F.lane); row_modulate_l(cur, pv_slot(F, 4 + sel), pv_slot(F, 6 + sel), F.lane);
              row_store_bf16(cur, (bf16_t*)(F.ws + WS_H2) + (size_t)row * D, F.lane);
              { unsigned char* h8 = (unsigned char*)(F.ws + WS_H2F8) + (size_t)row * D + 8 * F.lane;
#pragma unroll
                for (int h = 0; h < 2; ++h) { u32x2 w; w.x = pk4_fp8(cur.v[2 * h].x * F8S_ACT, cur.v[2 * h].y * F8S_ACT, cur.v[2 * h].z * F8S_ACT, cur.v[2 * h].w * F8S_ACT); w.y = pk4_fp8(cur.v[2 * h + 1].x * F8S_ACT, cur.v[2 * h + 1].y * F8S_ACT, cur.v[2 * h + 1].z * F8S_ACT, cur.v[2 * h + 1].w * F8S_ACT); *(u32x2*)(h8 + 512 * h) = w; } } }
#pragma unroll
          for (int u = 0; u < 2; ++u) { rv[u] = rvn[u]; yv2[u][0] = yvn[u][0]; yv2[u][1] = yvn[u][1]; }
      }
#undef RT_LOADPAIR
    }
    asm volatile("s_waitcnt vmcnt(0)" ::: "memory"); __syncthreads();
    for (int tile = t_lo + F.wave; tile < t_hi; tile += NWAVES) {
        const LAS float* lgw = narrow_tile_wave(F, (const bf16_t*)(F.ws + WS_H2) + (size_t)tile * 32 * D);
        if (F.lane < 32) {
            const LAS float* lgp = lgw + F.lane * 33; const int row = tile * 32 + F.lane;
            float lg[NEXP];
#pragma unroll
            for (int e = 0; e < NEXP; ++e) lg[e] = lgp[e] + brt[e];
            unsigned used = 0u; float bv[4]; int bi[4];
#pragma unroll
            for (int k = 0; k < 4; ++k) { float best = -3.0e38f; int idx = 0;
#pragma unroll
                for (int e = 0; e < NEXP; ++e) { const bool take = (((used >> e) & 1u) == 0u) && (lg[e] > best); best = take ? lg[e] : best; idx = take ? e : idx; }
                used |= 1u << idx; bv[k] = best; bi[k] = idx; }
            const float e1 = __expf(bv[1] - bv[0]), e2 = __expf(bv[2] - bv[0]), e3 = __expf(bv[3] - bv[0]); const float inv = __builtin_amdgcn_rcpf(1.0f + e1 + e2 + e3);
            int* ei = (int*)(F.ws + WS_ROUTE + RT_EIDX) + (size_t)row * 4; float* pr = (float*)(F.ws + WS_ROUTE + RT_PROB) + (size_t)row * 4;
            *(int4*)ei = make_int4(bi[0], bi[1], bi[2], bi[3]); *(f32x4*)pr = (f32x4){inv, e1 * inv, e2 * inv, e3 * inv};
            atomicAdd((int*)&cnt[bi[0]], 1); atomicAdd((int*)&cnt[bi[1]], 1); atomicAdd((int*)&cnt[bi[2]], 1); atomicAdd((int*)&cnt[bi[3]], 1);
        }
        asm volatile("s_waitcnt lgkmcnt(0)" ::: "memory");
    }
    __syncthreads();
    if (F.tid < NEXP) ((int*)(F.ws + WS_ROUTE + RT_CNT))[F.bid * NEXP + F.tid] = cnt[F.tid];
    __syncthreads();
}
__device__ __forceinline__ void phase_slots(Frame& F, int mrows) {
    LAS int* part = (LAS int*)F.lds;
    LAS int* pre = part + 1024;
    LAS int* tot = pre + 32;
    LAS int* seg = tot + 32;
    LAS int* gcnt = seg + 64;
    LAS int* eix = gcnt + 2048;
    LAS int* rnk = eix + 4096;
    const int* cntg = (const int*)(F.ws + WS_ROUTE + RT_CNT);
    int* tokg = (int*)(F.ws + WS_ROUTE + RT_TOK); int* destg = (int*)(F.ws + WS_ROUTE + RT_DEST); float* psl = (float*)(F.ws + WS_ROUTE + RT_PSLOT);
    int t_lo, t_hi; tile_range(F, mrows, t_lo, t_hi);
    const int row_base = t_lo * 32, nent = (t_hi - t_lo) * 128, ngrp = nent / 64;
    { const int e = F.tid & 31, pt = F.tid >> 5; int a = 0, b = 0;
      for (int c = pt; c < F.G; c += 16) { const int v = cntg[c * NEXP + e]; b += v; a += (c < F.bid) ? v : 0; }
      part[pt * 32 + e] = a; part[512 + pt * 32 + e] = b; }
    for (int i = F.tid; i < nent; i += NTHREADS) eix[i] = ((const int*)(F.ws + WS_ROUTE + RT_EIDX))[(size_t)row_base * 4 + i];
    __syncthreads();
    if (F.tid < NEXP) { int a = 0, b = 0;
#pragma unroll
        for (int pt = 0; pt < 16; ++pt) { a += part[pt * 32 + F.tid]; b += part[512 + pt * 32 + F.tid]; }
        pre[F.tid] = a; tot[F.tid] = b; }
    for (int g = F.wave; g < ngrp; g += NWAVES) {
        const int e = eix[g * 64 + F.lane]; int rank = 0, mycnt = 0;
#pragma unroll 4
        for (int ee = 0; ee < NEXP; ++ee) { const unsigned long long m = __ballot(e == ee); if (e == ee) rank = __popcll(m & ((1ull << F.lane) - 1ull)); if (F.lane == ee) mycnt = __popcll(m); }
        rnk[g * 64 + F.lane] = rank; if (F.lane < NEXP) gcnt[g * 32 + F.lane] = mycnt; }
    __syncthreads();
    if (F.tid == 0) { int s = 0; for (int e = 0; e < NEXP; ++e) { seg[e] = s; s += (tot[e] + 255) & ~255; } seg[NEXP] = s; }
    if (F.tid >= 64 && F.tid < 64 + NEXP) { const int e = F.tid - 64; int run = 0; for (int g = 0; g < ngrp; ++g) { const int c = gcnt[g * 32 + e]; gcnt[g * 32 + e] = run; run += c; } }
    __syncthreads();
    { const float* prg = (const float*)(F.ws + WS_ROUTE + RT_PROB) + (size_t)row_base * 4;
      for (int i = F.tid; i < nent; i += NTHREADS) { const int e = eix[i]; const int slot = seg[e] + pre[e] + gcnt[(i >> 6) * 32 + e] + rnk[i];
          tokg[slot] = row_base + (i >> 2); destg[slot] = row_base * 4 + i; psl[slot] = prg[i]; } }
    if (F.bid < NEXP) { const int e = F.bid; for (int sl = seg[e] + tot[e] + F.tid; sl < seg[e + 1]; sl += NTHREADS) { tokg[sl] = 0; destg[sl] = -1; psl[sl] = 0.f; } }
    if (F.bid == 0 && F.tid <= NEXP) ((int*)(F.ws + WS_ROUTE + RT_SEG))[F.tid] = seg[F.tid];
    __syncthreads();
}
struct CombRaw { u32x4 x[2]; u32x2 f[2][4]; };
__device__ __forceinline__ void comb_load(const Frame& F, int row, CombRaw& r) {
    { const bf16_t* xp = (const bf16_t*)(F.ws + WS_X) + (size_t)row * D + 8 * F.lane;
#pragma unroll
      for (int h = 0; h < 2; ++h) r.x[h] = __builtin_nontemporal_load((const u32x4*)(xp + 512 * h)); }
    const unsigned char* fs = (const unsigned char*)(F.ws + WS_FS) + (size_t)row * 4 * 1024 + 8 * F.lane;
#pragma unroll
    for (int h = 0; h < 2; ++h)
#pragma unroll
        for (int k = 0; k < 4; ++k) r.f[h][k] = __builtin_nontemporal_load((const u32x2*)(fs + k * 1024 + 512 * h));
}
__device__ __forceinline__ void phase_combine_ln2(Frame& F, int l, int mrows) {
    const bool lastl = (l == DEPTH - 1);
    int t_lo, t_hi; tile_range(F, mrows, t_lo, t_hi);
    const int r_lo = 32 * t_lo, nrows = 32 * (t_hi - t_lo);
    const int mrA = mod_row(r_lo), mrB = mod_row(r_lo + (nrows > 0 ? nrows - 1 : 0));
    { const float* mb = (const float*)(F.ws + WS_MOD); const int ln = lastl ? l : l + 1; pv_fill(F, 0, F.in[IN_LN2G] + l * D); pv_fill(F, 1, F.in[IN_LN2B] + l * D);
      pv_fill(F, 2, mb + ((size_t)(l * 17 + mrA) * 6 + 5) * 1024); pv_fill(F, 3, mb + ((size_t)(l * 17 + mrB) * 6 + 5) * 1024);
      pv_fill(F, 4, mb + ((size_t)(ln * 17 + mrA) * 6 + 0) * 1024); pv_fill(F, 5, mb + ((size_t)(ln * 17 + mrB) * 6 + 0) * 1024);
      pv_fill(F, 6, mb + ((size_t)(ln * 17 + mrA) * 6 + 1) * 1024); pv_fill(F, 7, mb + ((size_t)(ln * 17 + mrB) * 6 + 1) * 1024); }
    if (!lastl) load_wg_lds(F, l + 1); else __syncthreads();
    CombRaw rw[2];
#pragma unroll
    for (int u = 0; u < 2; ++u) { rw[u].x[0] = rw[u].x[1] = (u32x4){0u, 0u, 0u, 0u};
#pragma unroll
        for (int k = 0; k < 4; ++k) rw[u].f[0][k] = rw[u].f[1][k] = (u32x2){0u, 0u}; }
#pragma unroll
    for (int u = 0; u < 2; ++u) if (F.wave + u * NWAVES < nrows) comb_load(F, r_lo + F.wave + u * NWAVES, rw[u]);
    for (int n = F.wave; n < nrows; n += 2 * NWAVES) {
        CombRaw rwn[2];
#pragma unroll
        for (int u = 0; u < 2; ++u) rwn[u] = rw[u];
#pragma unroll
        for (int u = 0; u < 2; ++u) if (n + (2 + u) * NWAVES < nrows) comb_load(F, r_lo + n + (2 + u) * NWAVES, rwn[u]);
        __builtin_amdgcn_sched_barrier(0);
#pragma unroll
        for (int u = 0; u < 2; ++u) if (n + u * NWAVES < nrows) { const int row = r_lo + n + u * NWAVES;
            const int sel = (mod_row(row) == mrA) ? 0 : 1;
            const LAS float* g2 = pv_slot(F, 2 + sel);
            RowV x;
#pragma unroll
            for (int h = 0; h < 2; ++h) { const u32x4 w = rw[u].x[h]; x.v[2 * h] = (f32x4){bflo(w.x), bfhi(w.x), bflo(w.y), bfhi(w.y)}; x.v[2 * h + 1] = (f32x4){bflo(w.z), bfhi(w.z), bflo(w.w), bfhi(w.w)}; }
#pragma unroll
            for (int j = 0; j < 4; ++j) { f32x4 f = (f32x4){0.f, 0.f, 0.f, 0.f};
#pragma unroll
                for (int k = 0; k < 4; ++k) { const u32x2 w2 = rw[u].f[j >> 1][k]; const int wd = (int)((j & 1) ? w2.y : w2.x);
                    const f32x2 lo = __builtin_amdgcn_cvt_pk_f32_fp8(wd, false), hi = __builtin_amdgcn_cvt_pk_f32_fp8(wd, true); f[0] += lo[0]; f[1] += lo[1]; f[2] += hi[0]; f[3] += hi[1]; }
                const f32x4 gg = *(const LAS f32x4*)(g2 + RC(F.lane, j)) * (1.0f / FS_SCALE);
                x.v[j] = x.v[j] * DN_ALPHA + gg * f; }
            row_ln_plain(x, F.lane); row_affine_l(x, pv_slot(F, 0), pv_slot(F, 1), F.lane);
            if (lastl) { row_store_nt(x, F.out + (size_t)row * D, F.lane); }
            else { row_store_bf16_nt(x, (bf16_t*)(F.ws + WS_X) + (size_t)row * D, F.lane); ln0_row(F, row, x, pv_slot(F, 4 + sel), pv_slot(F, 6 + sel)); } }
#pragma unroll
        for (int u = 0; u < 2; ++u) rw[u] = rwn[u];
    }
    if (!lastl) gates_tail(F, l + 1, t_lo, t_hi);
    __syncthreads();
}

#define MFMA32(a, b, c) __builtin_amdgcn_mfma_f32_32x32x16_bf16((a), (b), (c), 0, 0, 0)
#define MFMA16(a, b, c) __builtin_amdgcn_mfma_f32_16x16x32_bf16((a), (b), (c), 0, 0, 0)
__device__ __forceinline__ f32x16 zero16() { f32x16 z;
#pragma unroll
    for (int i = 0; i < 16; ++i) z[i] = 0.f;
    return z; }
__device__ __forceinline__ void pool_tiles(Frame& F, int l, bool with_ctx) {
    LAS unsigned char* Pin = F.lds;
    LAS unsigned char* Dm = F.lds + 40960;
    const bf16_t* Z = (const bf16_t*)(F.ws + WS_Z);
    const bf16_t* Wp = (const bf16_t*)(F.ws + WS_WPOOL) + (size_t)l * 4 * 4096;
    const float* psc = F.in[IN_POOLS] + l * 256;
    bf16_t* BRA = (bf16_t*)(F.ws + WS_BRA);
    const int ntiles = with_ctx ? 1088 : 1024;
    const int r = F.lane & 31, h = F.lane >> 5;
    bf16x8 wa[2][4]; f32x4 scv[2][4];
#pragma unroll
    for (int qi = 0; qi < 2; ++qi) { const int q = F.wave + 8 * qi, g = q >> 2, td = (q >> 1) & 1;
#pragma unroll
        for (int ks = 0; ks < 4; ++ks) wa[qi][ks] = *(const bf16x8*)(Wp + ((size_t)g * 64 + td * 32 + r) * 64 + ks * 16 + 8 * h);
#pragma unroll
        for (int qq = 0; qq < 4; ++qq) scv[qi][qq] = *(const f32x4*)(psc + g * 64 + td * 32 + 8 * qq + 4 * h); }
    for (int tile = F.bid; tile < ntiles; tile += F.G) {
        int row0, seq_lo, seq_hi;
        if (tile < 1024) { row0 = tile * 64; seq_lo = row0; seq_hi = row0 + 64; }
        else { const int ct = tile - 1024; seq_lo = ML + (ct >> 2) * 256; seq_hi = seq_lo + 256; row0 = seq_lo + (ct & 3) * 64; }
        for (int idx = F.tid; idx < 80 * 32; idx += NTHREADS) { const int rr = idx >> 5, ck = idx & 31, grow = row0 - 8 + rr;
            if (grow >= seq_lo && grow < seq_hi) *(LAS u32x4*)(Pin + rr * 512 + ck * 16) = __builtin_nontemporal_load((const u32x4*)(Z + (size_t)grow * NZ + ZC_P + ck * 8)); }
        __syncthreads();
#pragma unroll
        for (int g = 0; g < 4; ++g) { constexpr int dummy_ = 0; (void)dummy_; const int hw = 1 << g, tok = F.tid >> 3, ck = g * 8 + (F.tid & 7), t = row0 + tok;
            const int lo = max(t - hw, seq_lo), hi = min(t + hw, seq_hi);
            float s[8];
#pragma unroll
            for (int e = 0; e < 8; ++e) s[e] = 0.f;
#pragma unroll
            for (int d = -hw; d < hw; ++d) { u32x4 v = *(const LAS u32x4*)(Pin + (tok + 8 + d) * 512 + ck * 16); const bool in = (t + d >= lo) && (t + d < hi);
                v.x = in ? v.x : 0u; v.y = in ? v.y : 0u; v.z = in ? v.z : 0u; v.w = in ? v.w : 0u;
                s[0] += bflo(v.x); s[1] += bfhi(v.x); s[2] += bflo(v.y); s[3] += bfhi(v.y); s[4] += bflo(v.z); s[5] += bfhi(v.z); s[6] += bflo(v.w); s[7] += bfhi(v.w); }
            const float inv = __builtin_amdgcn_rcpf((float)(hi - lo));
            const u32x4 o = *(const LAS u32x4*)(Pin + (tok + 8) * 512 + ck * 16);
            u32x4 w; w.x = pk2(s[0] * inv - bflo(o.x), s[1] * inv - bfhi(o.x)); w.y = pk2(s[2] * inv - bflo(o.y), s[3] * inv - bfhi(o.y));
            w.z = pk2(s[4] * inv - bflo(o.z), s[5] * inv - bfhi(o.z)); w.w = pk2(s[6] * inv - bflo(o.w), s[7] * inv - bfhi(o.w));
            *(LAS u32x4*)(Dm + tok * 528 + ck * 16) = w; }
        __syncthreads();
#pragma unroll
        for (int qi = 0; qi < 2; ++qi) { const int q = F.wave + 8 * qi, g = q >> 2, td = (q >> 1) & 1, tt = q & 1;
            f32x16 acc = zero16();
#pragma unroll
            for (int ks = 0; ks < 4; ++ks) { const bf16x8 b = *(const LAS bf16x8*)(Dm + (tt * 32 + r) * 528 + (g * 64 + ks * 16 + 8 * h) * 2);
                acc = MFMA32(wa[qi][ks], b, acc); }
            const size_t orow = (size_t)(row0 + tt * 32 + r);
#pragma unroll
            for (int qq = 0; qq < 4; ++qq) { const int dcol = g * 64 + td * 32 + 8 * qq + 4 * h; const f32x4 sc = scv[qi][qq];
                u32x2 w; w.x = pk2(acc[4 * qq] * sc.x, acc[4 * qq + 1] * sc.y); w.y = pk2(acc[4 * qq + 2] * sc.z, acc[4 * qq + 3] * sc.w);
                *(u32x2*)(BRA + orow * D + dcol) = w; } }
        __syncthreads();
    }
}
__device__ __forceinline__ void sgu_chunks(Frame& F, int l, bool with_ctx) {
    LAS unsigned char* Vt = F.lds;
    const bf16_t* Z = (const bf16_t*)(F.ws + WS_Z);
    const bf16_t* Ws = (const bf16_t*)(F.ws + WS_WSGU) + (size_t)l * 4 * 16384;
    const float* lng = F.in[IN_SLNG] + l * 256; const float* lnb = F.in[IN_SLNB] + l * 256; const float* sb = F.in[IN_SGUB] + l * 512;
    bf16_t* BRA = (bf16_t*)(F.ws + WS_BRA);
    const int nchunks = with_ctx ? 544 : 512;
    const int r = F.lane & 31, h = F.lane >> 5;
    const int tc = F.wave & 1, tt = F.wave >> 1, t = tt * 32 + r;
    LAS float* lnt = (LAS float*)(F.lds + 69632);
    if (F.tid < 256) { lnt[F.tid] = lng[F.tid]; lnt[256 + F.tid] = lnb[F.tid]; }
    __syncthreads();
    for (int ch = F.bid; ch < nchunks; ch += F.G) {
        const int row0 = ch * 128;
        u32x2 ug[4][4]; bf16x8 bcur[8];
        { const int s2 = F.tid >> 3, cq = F.tid & 7; const bf16_t* zp = Z + (size_t)(row0 + 2 * s2) * NZ + ZC_UV + 256 + cq * 32;
          float v[2][32]; float sum[2] = {0.f, 0.f};
#pragma unroll
          for (int rr = 0; rr < 2; ++rr)
#pragma unroll
              for (int i = 0; i < 4; ++i) { const u32x4 w = __builtin_nontemporal_load((const u32x4*)(zp + (size_t)rr * NZ + 8 * i));
                  v[rr][8 * i] = bflo(w.x); v[rr][8 * i + 1] = bfhi(w.x); v[rr][8 * i + 2] = bflo(w.y); v[rr][8 * i + 3] = bfhi(w.y); v[rr][8 * i + 4] = bflo(w.z); v[rr][8 * i + 5] = bfhi(w.z); v[rr][8 * i + 6] = bflo(w.w); v[rr][8 * i + 7] = bfhi(w.w); }
          float rstd[2];
#pragma unroll
          for (int rr = 0; rr < 2; ++rr) {
#pragma unroll
              for (int i = 0; i < 32; ++i) sum[rr] += v[rr][i];
              sum[rr] = oct_sum(sum[rr]);
              const float mean = sum[rr] * (1.f / 256.f); float sq = 0.f;
#pragma unroll
              for (int i = 0; i < 32; ++i) { v[rr][i] -= mean; sq += v[rr][i] * v[rr][i]; }
              sq = oct_sum(sq);
              rstd[rr] = __builtin_amdgcn_rsqf(sq * (1.f / 256.f) + LN_EPS); }
#pragma unroll
        for (int g = 0; g < 4; ++g)
#pragma unroll
            for (int qq = 0; qq < 4; ++qq) ug[g][qq] = *(const u32x2*)(Z + (size_t)(row0 + t) * NZ + ZC_UV + g * 64 + tc * 32 + 8 * qq + 4 * h);
#pragma unroll
        for (int ks = 0; ks < 8; ++ks) bcur[ks] = *(const bf16x8*)(Ws + ((size_t)0 * 128 + t) * 128 + ks * 16 + 8 * h);
          LAS unsigned char* wp = Vt + (((s2 >> 2) ^ cq) << 4) + (s2 & 3) * 4;
#pragma unroll
          for (int i = 0; i < 32; ++i) { const int c = cq * 32 + i; const float gn = lnt[c], bn = lnt[256 + c];
              *(LAS unsigned*)(wp + c * 272) = pg8::cvt_pk_bf16(v[0][i] * rstd[0] * gn + bn, v[1][i] * rstd[1] * gn + bn); } }
        __syncthreads();
#pragma unroll
        for (int g = 0; g < 4; ++g) {
            bf16x8 bnx[8];
#pragma unroll
            for (int ks = 0; ks < 8; ++ks) bnx[ks] = bcur[ks];
            if (g < 3) {
#pragma unroll
                for (int ks = 0; ks < 8; ++ks) bnx[ks] = *(const bf16x8*)(Ws + ((size_t)(g + 1) * 128 + t) * 128 + ks * 16 + 8 * h); }
            f32x16 acc = zero16();
#pragma unroll
            for (int ks = 0; ks < 8; ++ks) { const bf16x8 a = *(const LAS bf16x8*)(Vt + (g * 64 + tc * 32 + r) * 272 + (((ks * 2 + h) ^ ((g * 2 + tc) & 7)) * 16));
                acc = MFMA32(a, bcur[ks], acc); }
#pragma unroll
            for (int ks = 0; ks < 8; ++ks) bcur[ks] = bnx[ks];
            const float bias = sb[g * 128 + t];
#pragma unroll
            for (int qq = 0; qq < 4; ++qq) { const int c0 = g * 64 + tc * 32 + 8 * qq + 4 * h;
                const u32x2 u = ug[g][qq];
                u32x2 w; w.x = pk2(bflo(u.x) * (acc[4 * qq] + bias), bfhi(u.x) * (acc[4 * qq + 1] + bias)); w.y = pk2(bflo(u.y) * (acc[4 * qq + 2] + bias), bfhi(u.y) * (acc[4 * qq + 3] + bias));
                *(u32x2*)(BRA + (size_t)(row0 + t) * D + 768 + c0) = w; } }
        __syncthreads();
    }
}
__device__ __forceinline__ void qk_conv_pass(Frame& F, int l) {
    const bf16_t* Z = (const bf16_t*)(F.ws + WS_Z); bf16_t* QKC = (bf16_t*)(F.ws + WS_H);
    const int chunk = F.tid & 127, rsub = F.tid >> 7, ch0 = chunk * 8;
    float w0[8], w1[8], w2[8], cbv[8];
    { const float* cw = F.in[IN_CONVW] + (size_t)l * 3 * 1024 + ch0; const float* cb = F.in[IN_CONVB] + (size_t)l * 1024 + ch0;
#pragma unroll
      for (int e = 0; e < 8; ++e) { w0[e] = cw[e]; w1[e] = cw[1024 + e]; w2[e] = cw[2048 + e]; cbv[e] = cb[e]; } }
    const float scale = chunk >= 64 ? 0.08838834764831845f : 1.0f;
    const int ns = F.G * 4, sidx = F.bid * 4 + rsub;
    const int r0 = (int)(((long)sidx * MT) / ns), r1 = (int)(((long)(sidx + 1) * MT) / ns);
    const bf16_t* zb = Z + ZC_QK + ch0;
    const u32x4 zero4 = (u32x4){0u, 0u, 0u, 0u};
    u32x4 xm = zero4, xc = zero4, xn = zero4;
    if (r0 < r1) { xc = *(const u32x4*)(zb + (size_t)r0 * NZ); if (r0 > 0) xm = *(const u32x4*)(zb + (size_t)(r0 - 1) * NZ); if (r0 + 1 < MT) xn = *(const u32x4*)(zb + (size_t)(r0 + 1) * NZ); }
    for (int row = r0; row < r1; ++row) {
        u32x4 xn2 = zero4; if (row + 2 < MT) xn2 = *(const u32x4*)(zb + (size_t)(row + 2) * NZ);
        const int p = row < ML ? (row & 4095) : ((row - ML) & 255), len = row < ML ? 4096 : 256;
        const u32x4 x0 = (p > 0) ? xm : zero4, x1 = xc, x2 = (p + 1 < len) ? xn : zero4;
        const unsigned xa[4] = {x0.x, x0.y, x0.z, x0.w}, xb[4] = {x1.x, x1.y, x1.z, x1.w}, xcc[4] = {x2.x, x2.y, x2.z, x2.w};
        float y[8];
#pragma unroll
        for (int e2 = 0; e2 < 4; ++e2) { y[2 * e2] = cbv[2 * e2] + w0[2 * e2] * bflo(xa[e2]) + w1[2 * e2] * bflo(xb[e2]) + w2[2 * e2] * bflo(xcc[e2]);
            y[2 * e2 + 1] = cbv[2 * e2 + 1] + w0[2 * e2 + 1] * bfhi(xa[e2]) + w1[2 * e2 + 1] * bfhi(xb[e2]) + w2[2 * e2 + 1] * bfhi(xcc[e2]); }
#pragma unroll
        for (int e = 0; e < 8; ++e) y[e] = siluf_(y[e]) * scale;
        u32x4 w; w.x = pk2(y[0], y[1]); w.y = pk2(y[2], y[3]); w.z = pk2(y[4], y[5]); w.w = pk2(y[6], y[7]);
        *(u32x4*)(QKC + (size_t)row * D + ch0) = w;
        xm = xc; xc = xn; xn = xn2;
    }
}
constexpr int ML_QS = 0, ML_KS = 34816, ML_KW = 69632, ML_VT = 104448, ML_CB = 126208, ML_SC = 147968, ML_SCSZ = 2624;
__device__ __forceinline__ float logsigf_(float x) { return fminf(x, 0.f) - __logf(1.0f + __expf(-fabsf(x))); }
__device__ __forceinline__ unsigned swap16(unsigned u) { return __builtin_amdgcn_alignbit(u, u, 16); }
struct MlPre { u32x4 qk[8]; u32x2 v[4]; float g[4]; };
__device__ __forceinline__ void ml_geom(int j, int b, int dir, int& seqbase, int& seqlen, int& pbase) {
    const bool is_ctx = j < 2; int cj = is_ctx ? j : j - 2; const int ncs = is_ctx ? 2 : 32; if (dir) cj = ncs - 1 - cj;
    seqbase = is_ctx ? ML + b * 256 : b * 4096; seqlen = is_ctx ? 256 : 4096; pbase = cj * 128; }
#define ML_BAR() do { asm volatile("s_waitcnt lgkmcnt(0)" ::: "memory"); __builtin_amdgcn_s_barrier(); asm volatile("" ::: "memory"); } while (0)
__device__ __forceinline__ void mlstm_unit(Frame& F, int l, int unit) {
    const int bh = (unit & 7) + 8 * (unit >> 5), sub = (unit >> 3) & 3;
    const int b = bh >> 2, head = bh & 3, dir = sub >> 1, vh = sub & 1;
    LAS unsigned char* QS = F.lds + ML_QS; LAS unsigned char* KS = F.lds + ML_KS; LAS unsigned char* KW = F.lds + ML_KW; LAS unsigned char* VT = F.lds + ML_VT; LAS unsigned char* CB = F.lds + ML_CB;
    const bf16_t* Z = (const bf16_t*)(F.ws + WS_Z); const float* ZG = (const float*)(F.ws + WS_ZG); const bf16_t* QKC = (const bf16_t*)(F.ws + WS_H);
    bf16_t* HF = (bf16_t*)(F.ws + WS_HFB) + (size_t)dir * MT * 512;
    const int wave = F.wave;
    int tl = F.tid;
#define ML_ROLES() const int lane = tl & 63, fr = lane & 15, q4 = lane >> 4; const int isk = (tl >> 4) & 1, ck = tl & 15, i0 = 8 * (tl >> 5), chn = (isk ? 512 : 0) + head * 128 + ck * 8; \
    const int vi0 = 4 * (tl >> 4), vcq = tl & 15, vch = head * 128 + vh * 64 + vcq * 4; (void)fr; (void)q4; (void)vi0; (void)vcq; (void)vch; (void)i0; (void)chn; (void)ck; (void)isk;
    for (int idx = F.tid; idx < 16 * 136; idx += NTHREADS) *(LAS bf16_t*)(VT + (64 + idx / 136) * 272 + (idx % 136) * 2) = (idx < 136) ? (bf16_t)0x3F80 : (bf16_t)0;
    f32x4 cs[5];
#pragma unroll
    for (int vt = 0; vt < 5; ++vt) cs[vt] = (f32x4){0.f, 0.f, 0.f, 0.f};
    float m_state = 0.f;
    MlPre pre;
#define ML_PREFETCH(jj) do { int sb_, sl_, pb_; ml_geom((jj), b, dir, sb_, sl_, pb_); \
        { const int pmin = dir ? pb_ + 120 - i0 : pb_ + i0; const bf16_t* zr = QKC + (size_t)(sb_ + pmin) * D + chn; (void)sl_; \
          _Pragma("unroll") for (int k = 0; k < 8; ++k) pre.qk[k] = *(const u32x4*)(zr + (size_t)k * D); } \
        { const int pminv = dir ? pb_ + 124 - vi0 : pb_ + vi0; const bf16_t* zv = Z + (size_t)(sb_ + pminv) * NZ + ZC_V + vch; \
          _Pragma("unroll") for (int k = 0; k < 4; ++k) pre.v[k] = *(const u32x2*)(zv + (size_t)k * NZ); } \
        if (wave == 0) { const int p0 = dir ? pb_ + 127 - 2 * lane : pb_ + 2 * lane, p1 = dir ? p0 - 1 : p0 + 1; \
          pre.g[0] = ZG[(size_t)(sb_ + p0) * 16 + dir * 8 + head]; pre.g[1] = ZG[(size_t)(sb_ + p0) * 16 + dir * 8 + 4 + head]; \
          pre.g[2] = ZG[(size_t)(sb_ + p1) * 16 + dir * 8 + head]; pre.g[3] = ZG[(size_t)(sb_ + p1) * 16 + dir * 8 + 4 + head]; } } while (0)
#define ML_STEPA(sbuf) do { LAS float* sg_ = (LAS float*)(F.lds + ML_SC + (sbuf) * ML_SCSZ); const int i0g = 2 * lane, i1g = i0g + 1; \
        const float gi0 = pre.g[0], gf0 = pre.g[1], gi1 = pre.g[2], gf1 = pre.g[3]; \
        const float lf0 = logsigf_(gf0), lf1 = logsigf_(gf1); const float s1 = lf0 + lf1; const float incl = wave_scan_sum(s1); \
        const float excl = incl - s1, bc0 = excl + lf0, bc1 = excl + s1; \
        const float g0 = gi0 - bc0, g1 = gi1 - bc1; const float mx1 = fmaxf(g0, g1); const float im = wave_scan_max(mx1); \
        const float em = dpp_id<0x138, 0xf>(-3.0e38f, im);                   \
        const float M0 = fmaxf(m_state, fmaxf(em, g0)), M1 = fmaxf(m_state, fmaxf(em, mx1)); \
        const float total = __builtin_bit_cast(float, __builtin_amdgcn_readlane(__builtin_bit_cast(int, bc1), 63)), Mlast = __builtin_bit_cast(float, __builtin_amdgcn_readlane(__builtin_bit_cast(int, M1), 63)); \
        sg_[i0g] = g0; sg_[i1g] = g1; sg_[128 + i0g] = M0; sg_[128 + i1g] = M1; \
        sg_[256 + i0g] = __expf(m_state - M0); sg_[256 + i1g] = __expf(m_state - M1); \
        sg_[384 + i0g] = __expf(-(bc0 + M0)); sg_[384 + i1g] = __expf(-(bc1 + M1)); \
        sg_[512 + i0g] = __expf(g0 - Mlast); sg_[512 + i1g] = __expf(g1 - Mlast); \
        if (lane == 0) sg_[640] = __expf(m_state - Mlast); \
        m_state = total + Mlast; } while (0)
    { ML_ROLES(); ML_PREFETCH(0); if (wave == 0) ML_STEPA(0); }
    ML_BAR();
#pragma unroll 1
    for (int j = 0; j < 34; ++j) {
        asm volatile("" : "+v"(tl));
        ML_ROLES();
        int seqbase, seqlen, pbase; ml_geom(j, b, dir, seqbase, seqlen, pbase);
        const LAS float* sc_g = (const LAS float*)(F.lds + ML_SC + (j & 1) * ML_SCSZ); const LAS float* sc_M = sc_g + 128; const LAS float* sc_dec = sc_g + 256; const LAS float* sc_emt = sc_g + 384; const LAS float* sc_wk = sc_g + 512;
        {
#pragma unroll
          for (int k = 0; k < 8; ++k) { const int i = dir ? i0 + 7 - k : i0 + k; *(LAS u32x4*)((isk ? KS : QS) + i * 272 + ck * 16) = pre.qk[k]; }
          if (isk) { u32x4 kt[8]; float ykeep[8];
#pragma unroll
              for (int e = 0; e < 8; ++e) { kt[e] = (u32x4){0u, 0u, 0u, 0u}; ykeep[e] = 0.f; }
#pragma unroll
              for (int k = 0; k < 8; ++k) { const int i = dir ? i0 + 7 - k : i0 + k; const float wk = sc_wk[i];
                  const unsigned xb[4] = {pre.qk[k].x, pre.qk[k].y, pre.qk[k].z, pre.qk[k].w};
#pragma unroll
                  for (int e = 0; e < 8; ++e) { const float yw = ((e & 1) ? bfhi(xb[e >> 1]) : bflo(xb[e >> 1])) * wk;
                      if (k & 1) { const unsigned pw_ = pk2(ykeep[e], yw); if ((k >> 1) == 0) kt[e].x = pw_; else if ((k >> 1) == 1) kt[e].y = pw_; else if ((k >> 1) == 2) kt[e].z = pw_; else kt[e].w = pw_; }
                      else ykeep[e] = yw; } }
#pragma unroll
              for (int e = 0; e < 8; ++e) { u32x4 o = kt[e]; if (dir) o = (u32x4){swap16(kt[e].w), swap16(kt[e].z), swap16(kt[e].y), swap16(kt[e].x)};
                  *(LAS u32x4*)(KW + (ck * 8 + e) * 272 + (((i0 >> 3) ^ (ck & 7)) * 16)) = o; } } }
        { unsigned vv[4][2];
#pragma unroll
          for (int k = 0; k < 4; ++k) { vv[k][0] = pre.v[k].x; vv[k][1] = pre.v[k].y; }
#pragma unroll
          for (int c = 0; c < 4; ++c) {
              unsigned h0 = (c & 1) ? (vv[0][c >> 1] >> 16) : (vv[0][c >> 1] & 0xffffu), h1 = (c & 1) ? (vv[1][c >> 1] >> 16) : (vv[1][c >> 1] & 0xffffu);
              unsigned h2 = (c & 1) ? (vv[2][c >> 1] >> 16) : (vv[2][c >> 1] & 0xffffu), h3 = (c & 1) ? (vv[3][c >> 1] >> 16) : (vv[3][c >> 1] & 0xffffu);
              u32x2 o; if (dir) { o.x = h3 | (h2 << 16); o.y = h1 | (h0 << 16); } else { o.x = h0 | (h1 << 16); o.y = h2 | (h3 << 16); }
              *(LAS u32x2*)(VT + (vcq * 4 + c) * 272 + vi0 * 2) = o; } }
#pragma unroll
        for (int vt = 0; vt < 5; ++vt)
#pragma unroll
            for (int rr = 0; rr < 4; rr += 2) { const unsigned pw_ = pk2(cs[vt][rr], cs[vt][rr + 1]);
                *(LAS bf16_t*)(CB + (16 * vt + 4 * q4 + rr) * 272 + (16 * wave + fr) * 2) = (bf16_t)(pw_ & 0xffffu); *(LAS bf16_t*)(CB + (16 * vt + 4 * q4 + rr + 1) * 272 + (16 * wave + fr) * 2) = (bf16_t)(pw_ >> 16); }
        ML_BAR();
        if (j + 1 < 34) ML_PREFETCH(j + 1);
        const int t = 16 * wave + fr;
        bf16x8 qf[4];
#pragma unroll
        for (int kc = 0; kc < 4; ++kc) qf[kc] = *(const LAS bf16x8*)(QS + t * 272 + (32 * kc + 8 * q4) * 2);
        const float Mt_t = sc_M[t], dec_t = sc_dec[t], emt_t = sc_emt[t];
        f32x4 ps[8];
#pragma unroll
        for (int jp = 0; jp < 4; ++jp) {
            ps[2 * jp] = (f32x4){0.f, 0.f, 0.f, 0.f}; ps[2 * jp + 1] = (f32x4){0.f, 0.f, 0.f, 0.f};
            if (2 * jp <= wave) {
                bf16x8 ka[4], kb[4];
#pragma unroll
                for (int kc = 0; kc < 4; ++kc) { ka[kc] = *(const LAS bf16x8*)(KS + (32 * jp + fr) * 272 + (32 * kc + 8 * q4) * 2); kb[kc] = *(const LAS bf16x8*)(KS + (32 * jp + 16 + fr) * 272 + (32 * kc + 8 * q4) * 2); }
                const f32x4 ga4 = *(const LAS f32x4*)(sc_g + 32 * jp + 4 * q4), gb4 = *(const LAS f32x4*)(sc_g + 32 * jp + 16 + 4 * q4);
                f32x4 acc0 = (f32x4){0.f, 0.f, 0.f, 0.f}, acc1 = (f32x4){0.f, 0.f, 0.f, 0.f};
#pragma unroll
                for (int kc = 0; kc < 4; ++kc) { acc0 = MFMA16(ka[kc], qf[kc], acc0); acc1 = MFMA16(kb[kc], qf[kc], acc1); }
#pragma unroll
                for (int rr = 0; rr < 4; ++rr) { const int s0 = 32 * jp + 4 * q4 + rr, s1 = s0 + 16;
                    ps[2 * jp][rr] = (s0 <= t) ? acc0[rr] * __expf(ga4[rr] - Mt_t) : 0.f; ps[2 * jp + 1][rr] = (s1 <= t) ? acc1[rr] * __expf(gb4[rr] - Mt_t) : 0.f; }
            }
        }
        f32x4 ao[5];
        {
#pragma unroll
          for (int vt = 0; vt < 5; ++vt) ao[vt] = (f32x4){0.f, 0.f, 0.f, 0.f};
#pragma unroll
          for (int kh = 0; kh < 4; kh += 2) { bf16x8 cf[2][5];
#pragma unroll
              for (int k2 = 0; k2 < 2; ++k2)
#pragma unroll
                  for (int vt = 0; vt < 5; ++vt) cf[k2][vt] = *(const LAS bf16x8*)(CB + (16 * vt + fr) * 272 + (32 * (kh + k2) + 8 * q4) * 2);
#pragma unroll
              for (int k2 = 0; k2 < 2; ++k2)
#pragma unroll
                  for (int vt = 0; vt < 5; ++vt) ao[vt] = MFMA16(cf[k2][vt], qf[kh + k2], ao[vt]); }
#pragma unroll
          for (int vt = 0; vt < 5; ++vt) ao[vt] = ao[vt] * dec_t; }
#pragma unroll
        for (int ks = 0; ks < 4; ++ks) {
            if (2 * ks <= wave) {
                s16x4 vlo[5], vhi[5];
#pragma unroll
                for (int vt = 0; vt < 5; ++vt) { vlo[vt] = *(const LAS s16x4*)(VT + (16 * vt + fr) * 272 + (32 * ks + 4 * q4) * 2); vhi[vt] = *(const LAS s16x4*)(VT + (16 * vt + fr) * 272 + (32 * ks + 16 + 4 * q4) * 2); }
                u32x4 pw; pw.x = cvt_pk_bf16(ps[2 * ks][0], ps[2 * ks][1]); pw.y = cvt_pk_bf16(ps[2 * ks][2], ps[2 * ks][3]); pw.z = cvt_pk_bf16(ps[2 * ks + 1][0], ps[2 * ks + 1][1]); pw.w = cvt_pk_bf16(ps[2 * ks + 1][2], ps[2 * ks + 1][3]);
                const bf16x8 pf = __builtin_bit_cast(bf16x8, pw);
#pragma unroll
                for (int vt = 0; vt < 5; ++vt) { const bf16x8 a = __builtin_shufflevector(vlo[vt], vhi[vt], 0, 1, 2, 3, 4, 5, 6, 7); ao[vt] = MFMA16(a, pf, ao[vt]); }
            }
        }
        { const float den = bperm(fr, ao[4][0]); const float inv = __builtin_amdgcn_rcpf(fmaxf(fabsf(den), emt_t));
          const int p = dir ? pbase + 127 - t : pbase + t; bf16_t* orow = HF + (size_t)(seqbase + p) * 512 + head * 128 + vh * 64 + 4 * q4;
#pragma unroll
          for (int vt = 0; vt < 4; ++vt) { const f32x4 o = ao[vt] * inv; u32x2 w; w.x = cvt_pk_bf16(o[0], o[1]); w.y = cvt_pk_bf16(o[2], o[3]); *(u32x2*)(orow + 16 * vt) = w; } }
        { const float a_s = sc_g[640];
#pragma unroll
          for (int vt = 0; vt < 5; ++vt) cs[vt] = cs[vt] * a_s;
#pragma unroll
          for (int ks = 0; ks < 4; ks += 2) { bf16x8 bb[2], va[2][5];
#pragma unroll
              for (int k2 = 0; k2 < 2; ++k2) { bb[k2] = *(const LAS bf16x8*)(KW + (16 * wave + fr) * 272 + (((4 * (ks + k2) + q4) ^ (((16 * wave + fr) >> 3) & 7)) * 16));
#pragma unroll
                  for (int vt = 0; vt < 5; ++vt) va[k2][vt] = *(const LAS bf16x8*)(VT + (16 * vt + fr) * 272 + (32 * (ks + k2) + 8 * q4) * 2); }
#pragma unroll
              for (int k2 = 0; k2 < 2; ++k2)
#pragma unroll
                  for (int vt = 0; vt < 5; ++vt) cs[vt] = MFMA16(va[k2][vt], bb[k2], cs[vt]); } }
        if (wave == 0 && j + 1 < 34) ML_STEPA((j + 1) & 1);
        ML_BAR();
    }
#undef ML_PREFETCH
#undef ML_STEPA
#undef ML_ROLES
    __syncthreads();
}
__device__ __forceinline__ void phase_mixers(Frame& F, int l) {
    const bool with_ctx = (l != DEPTH - 1);
#ifndef MIX_MASK
#define MIX_MASK 7
#endif
#ifndef MIXREP
#define MIXREP 0
#endif
    if (MIX_MASK & 1) pool_tiles(F, l, with_ctx);
    if (MIXREP & 1) { __syncthreads(); pool_tiles(F, l, with_ctx); }
    if (MIX_MASK & 2) sgu_chunks(F, l, with_ctx);
    if (MIXREP & 2) { __syncthreads(); sgu_chunks(F, l, with_ctx); }
    (void)0;
    qk_conv_pass(F, l);
}
__device__ __forceinline__ void phase_mlstm(Frame& F, int l) {
    for (int u = F.bid; u < 256; u += F.G) mlstm_unit(F, l, u);
}

struct Args { const float* in[31]; float* out; unsigned char* ws; int g_lo, g_hi, pad0, pad1; };
constexpr int NPH = 11, NGID = 2 + DEPTH * NPH;
__global__ void __launch_bounds__(NTHREADS, 2) fwd_kernel(Args args) {
    extern __shared__ __attribute__((aligned(16))) unsigned char lds_raw[];
    Frame F;
    F.lds = (LAS unsigned char*)lds_raw; F.MISC = (volatile LAS unsigned*)(F.lds + MISC_OFF);
    F.tid = threadIdx.x; F.lane = F.tid & 63; F.wave = __builtin_amdgcn_readfirstlane(F.tid >> 6); F.G = gridDim.x; F.bid = blockIdx.x;
    F.ws = args.ws; F.out = args.out;
    F.in = (InTab)__builtin_amdgcn_kernarg_segment_ptr();
    if (F.tid < 64) F.MISC[F.tid] = 0u;
    __syncthreads();
    const int lo = args.g_lo, hi = args.g_hi;
    const bool multi = (hi - lo) > 1;
    XcdBarrier bar; bar.bar = (unsigned*)(F.ws + WS_CTL) + CW_BAR; bar.x = 0; bar.st = nullptr;
    if (multi) bar = xcd_barrier_post((unsigned*)(F.ws + WS_CTL) + CW_BAR, F.MISC + 8);
#ifndef PHASE_MASK
#define PHASE_MASK 0xFFFF
#endif
#define RUN(g) (lo <= (g) && (g) < hi)
#define RUNP(ty, g) ((((PHASE_MASK) >> (ty)) & 1) && RUN(g))
#ifndef REPEAT_MASK
#define REPEAT_MASK 0
#endif
#define NREP(ty) ((((REPEAT_MASK) >> (ty)) & 1) ? 2 : 1)
#define SEAM(g) do { if (RUN((g) + 1)) xcd_barrier(bar); } while (0)
#define LAUNDER(P) Frame P = F; { int t_; asm volatile("v_mbcnt_lo_u32_b32 %0, -1, 0\n\tv_mbcnt_hi_u32_b32 %0, -1, %0" : "=v"(t_)); t_ |= (F.wave << 6); P.tid = t_; P.lane = t_ & 63; P.wave = __builtin_amdgcn_readfirstlane(t_ >> 6); GAS unsigned char* w_ = (GAS unsigned char*)F.ws; asm volatile("" : "+s"(w_)); P.ws = (unsigned char*)w_; InTab t2_ = F.in; asm volatile("" : "+s"(t2_)); P.in = t2_; }
    if (RUNP(0, 0)) { LAUNDER(P); for (int rep_ = 0; rep_ < NREP(0); ++rep_) { phase_prologue(P); __syncthreads(); } SEAM(0); }
    if (RUNP(1, 1)) { LAUNDER(P); for (int rep_ = 0; rep_ < NREP(1); ++rep_) { phase_ln0_first(P); __syncthreads(); } SEAM(1); }
#pragma unroll 1
    for (int l = 0; l < DEPTH; ++l) {
        const int g0 = 2 + l * NPH;
        const int mrows = (l == DEPTH - 1) ? ML : MT;
        if (RUNP(2, g0 + 0)) {
#undef PHTY
#define PHTY 2
            LAUNDER(P);
            { ProbPlain Pr{(const bf16_t*)(P.ws + WS_H), (const bf16_t*)(P.ws + WS_WIN) + (size_t)l * NZ * D, D, D};
              pg8::StaticOrder<1> S; S.init(MT / 256, NZ_BF / 256, P.G, P.bid);
              EpiInproj<false> E{(bf16_t*)(P.ws + WS_Z), P.in[IN_BIN] + (size_t)l * 5904, 0};
              pg8::gemm_phase(P.lds, P.tid, Pr, S, E); }
            __syncthreads();
            { ProbPlainF8 Pr{(const bf16_t*)(P.ws + WS_H8), (const bf16_t*)(P.ws + WS_WIN8 + (size_t)l * NZ_F8 * D), D / 2, D / 2};
              pg8::StaticOrder<1> S; S.init(MT / 256, NZ_F8 / 256, P.G, P.bid);
              EpiInproj<true> E{(bf16_t*)(P.ws + WS_Z), P.in[IN_BIN] + (size_t)l * 5904, NZ_BF / 256};
              pg8::gemm_phase(P.lds, P.tid, Pr, S, E); }
            SEAM(g0 + 0);
        }
        if (RUNP(3, g0 + 1)) { LAUNDER(P); for (int rep_ = 0; rep_ < NREP(3); ++rep_) { phase_mixers(P, l); __syncthreads(); } SEAM(g0 + 1); }
        if (RUNP(12, g0 + 2)) { LAUNDER(P); for (int rep_ = 0; rep_ < NREP(12); ++rep_) { phase_mlstm(P, l); __syncthreads(); } SEAM(g0 + 2); }
        if (RUNP(4, g0 + 3)) { LAUNDER(P); for (int rep_ = 0; rep_ < NREP(4); ++rep_) phase_finalize(P, l, mrows); SEAM(g0 + 3); }
        if (RUN(g0 + 4) || RUN(g0 + 5)) {
            LAUNDER(P);
            const int nMt = mrows / 256, units = nMt * 4, tailU = units % P.G;
            const bool split = multi && RUN(g0 + 4) && RUN(g0 + 5) && tailU != 0 && (tailU % 4) == 0 && (((P.G - tailU) * 2) % 4) == 0 && ((P.G - tailU) * 2 <= units - tailU);
            const int nMA = split ? (units - tailU) / 4 : nMt, nMB = split ? ((P.G - tailU) * 2) / 4 : nMt;
#pragma unroll 1
            for (int part = 0; part < (split ? 3 : 2); ++part) {
                const bool run = (part == 0) ? RUN(g0 + 4) : RUN(g0 + 5);
                const bool do_branch = (part == 0) || (split && part == 1 && P.bid < tailU);
                if (run) {
                    if (do_branch) {
                        ProbPlain Pr{(const bf16_t*)(P.ws + WS_BRA), (const bf16_t*)(P.ws + WS_WBR) + (size_t)l * D * D, D, D};
                        pg8::StaticOrder<1> S; if (part == 0) S.init(nMA, 4, P.G, P.bid, 0); else S.init(tailU / 4, 4, tailU, P.bid, nMA);
                        EpiBranch E{(const bf16_t*)(P.ws + WS_Z), (bf16_t*)(P.ws + WS_Y)};
                        pg8::gemm_phase(P.lds, P.tid, Pr, S, E);
                    } else {
                        ProbPlain Pr{(const bf16_t*)(P.ws + WS_Y), (const bf16_t*)(P.ws + WS_WOUT) + (size_t)l * D * D, D, D};
                        pg8::StaticOrder<1> S;
                        if (!split) S.init(nMt, 4, P.G, P.bid, 0); else if (part == 1) S.init(nMB, 4, P.G - tailU, P.bid - tailU, 0); else S.init(nMt - nMB, 4, P.G, P.bid, nMB);
                        EpiOut E{(bf16_t*)(P.ws + WS_T)};
                        pg8::gemm_phase(P.lds, P.tid, Pr, S, E);
                    }
                }
                if (part == 0) SEAM(g0 + 4); else if (part == (split ? 2 : 1)) SEAM(g0 + 5); else xcd_barrier(bar);
            }
        }
        if (RUNP(7, g0 + 6)) { LAUNDER(P); for (int rep_ = 0; rep_ < NREP(7); ++rep_) phase_ln1_router(P, l, mrows); SEAM(g0 + 6); }
        if (RUNP(8, g0 + 7)) { LAUNDER(P); for (int rep_ = 0; rep_ < NREP(8); ++rep_) phase_slots(P, mrows); SEAM(g0 + 7); }
        if (RUNP(9, g0 + 8)) {
#undef PHTY
#define PHTY 9
            LAUNDER(P);
            LAS int* seg = (LAS int*)(P.lds + TAB_OFF);
            const int ntile = moe_tables(P, seg);
            ProbMoe1 Pr{(const bf16_t*)(P.ws + WS_H2F8), (const bf16_t*)(P.ws + WS_WGU + (size_t)l * NEXP * 2048 * D), D / 2, D / 2, (const int*)(P.ws + WS_ROUTE + RT_TOK), seg};
            pg8::StaticOrder<1> S; S.init(ntile, 8, P.G, P.bid);
            EpiSwiglu E{(unsigned char*)(P.ws + WS_HID), P.in[IN_BGU] + (size_t)l * NEXP * 2048, seg};
            pg8::gemm_phase(P.lds, P.tid, Pr, S, E); if (NREP(PHTY) == 2) { __syncthreads(); pg8::gemm_phase(P.lds, P.tid, Pr, S, E); }
            SEAM(g0 + 8);
        }
        if (RUNP(10, g0 + 9)) {
#undef PHTY
#define PHTY 10
            LAUNDER(P);
            LAS int* seg = (LAS int*)(P.lds + TAB_OFF);
            const int ntile = moe_tables(P, seg);
            ProbMoe2 Pr{(const bf16_t*)(P.ws + WS_HID), (const bf16_t*)(P.ws + WS_WDN + (size_t)l * NEXP * D * D), D / 2, D / 2, seg};
            pg8::StaticOrder<1> S; S.init(ntile, 4, P.G, P.bid);
            EpiDown E{(unsigned char*)(P.ws + WS_FS), P.in[IN_BDN] + (size_t)l * NEXP * D, (const int*)(P.ws + WS_ROUTE + RT_DEST), (const float*)(P.ws + WS_ROUTE + RT_PSLOT), seg};
            pg8::gemm_phase(P.lds, P.tid, Pr, S, E); if (NREP(PHTY) == 2) { __syncthreads(); pg8::gemm_phase(P.lds, P.tid, Pr, S, E); }
            SEAM(g0 + 9);
        }
        if (RUNP(11, g0 + 10)) { LAUNDER(P); phase_combine_ln2(P, l, mrows); SEAM(g0 + 10); }
    }
#undef LAUNDER
#undef RUN
#undef RUNP
#undef SEAM
}

extern "C" void kernel_launch(void* const* d_in, const int* in_sizes, int n_in, void* d_out, int out_size, void* d_ws, size_t ws_size, hipStream_t stream) {
    static int grid = 0;
    if (grid == 0) {
        if (n_in != 31 || out_size != ML * D || ws_size < WS_END) { fprintf(stderr, "kernel_launch: unexpected problem (n_in %d, out %d, ws %zu, need %zu)\n", n_in, out_size, ws_size, (size_t)WS_END); grid = -1; return; }
        int dev = 0, cus = 0, per_cu = 0;
        if (hipGetDevice(&dev) != hipSuccess || hipDeviceGetAttribute(&cus, hipDeviceAttributeMultiprocessorCount, dev) != hipSuccess) { grid = -1; return; }
        if (hipFuncSetAttribute((const void*)fwd_kernel, hipFuncAttributeMaxDynamicSharedMemorySize, LDS_BYTES) != hipSuccess) { fprintf(stderr, "kernel_launch: hipFuncSetAttribute failed\n"); grid = -1; return; }
        if (hipOccupancyMaxActiveBlocksPerMultiprocessor(&per_cu, (const void*)fwd_kernel, NTHREADS, LDS_BYTES) != hipSuccess || per_cu < 1) fprintf(stderr, "kernel_launch: occupancy query reports %d\n", per_cu);
        (void)hipGetLastError();
        grid = cus;
    }
    if (grid < 0) return;
    (void)hipMemsetAsync((char*)d_ws + WS_CTL, 0, CTL_ZERO_BYTES, stream);
    Args a{};
    for (int i = 0; i < 31; ++i) a.in[i] = (const float*)d_in[i];
    a.out = (float*)d_out; a.ws = (unsigned char*)d_ws;
#if MK_N_LAUNCHES == 1
    a.g_lo = 0; a.g_hi = NGID;
    hipLaunchKernelGGL(fwd_kernel, dim3(grid), dim3(NTHREADS), LDS_BYTES, stream, a);
#else
    for (int g = 0; g < NGID; ++g) { a.g_lo = g; a.g_hi = g + 1; hipLaunchKernelGGL(fwd_kernel, dim3(grid), dim3(NTHREADS), LDS_BYTES, stream, a); }
#endif
}
```

```cpp
#include <hip/hip_runtime.h>
#include <cstdio>
#include <cstdint>

#ifndef MK_N_LAUNCHES
#define MK_N_LAUNCHES 1
#endif

#define LAS __attribute__((address_space(3)))
#define GAS __attribute__((address_space(1)))
typedef unsigned short bf16_t;
typedef short bf16x8 __attribute__((ext_vector_type(8)));
typedef short s16x4 __attribute__((ext_vector_type(4)));
typedef float f32x4 __attribute__((ext_vector_type(4)));
typedef float f32x2 __attribute__((ext_vector_type(2)));
typedef float f32x16 __attribute__((ext_vector_type(16)));
typedef unsigned u32x4 __attribute__((ext_vector_type(4)));
typedef unsigned u32x2 __attribute__((ext_vector_type(2)));
typedef int i32x4 __attribute__((ext_vector_type(4)));
typedef int i32x8 __attribute__((ext_vector_type(8)));

constexpr int D = 1024, NB = 16, SEQ = 4096, CTXL = 256, DEPTH = 4;
constexpr int ML = NB * SEQ;
constexpr int MC = NB * CTXL;
constexpr int MT = ML + MC;
constexpr int NZ = 5888;
constexpr int ZC_P = 0, ZC_QK = 256, ZC_V = 1280, ZC_O = 1792, ZC_UV = 2304, ZC_MG = 2816;
constexpr int NZ_BF = 256, NZ_F8 = 5632;
constexpr int ZG_COL = 2816;
constexpr int NEXP = 32, TOPK = 4;
constexpr int NS_MAX = MT * TOPK + NEXP * 256;
constexpr float LN_EPS = 1e-5f, HEAD_EPS = 1e-6f;
constexpr float DN_ALPHA = 1.6817928305074292f;
constexpr int NWAVES = 8, NTHREADS = 512;
constexpr float F8_DESCALE = 1.0f / 256.0f;
constexpr float F8S_ACT = 4.0f, F8S_WGU = 64.0f, F8S_WDN = 64.0f; constexpr int F8E_ACT = 123, F8E_WGU = 123, F8E_WDN = 123;

constexpr size_t MiB = 1u << 20;
constexpr size_t WS_CTL = 0, CTL_ZERO_BYTES = 1 * MiB;
constexpr size_t WS_MOD = 1 * MiB;
constexpr size_t WS_WG = 3 * MiB;
constexpr size_t WS_WSGU = 4 * MiB;
constexpr size_t WS_WPOOL = WS_WSGU + 512 * 1024;
constexpr size_t WS_ROUTE = 5 * MiB;
constexpr size_t WS_WIN = 16 * MiB;
constexpr size_t WS_WBR = 62 * MiB;
constexpr size_t WS_WOUT = 70 * MiB;
constexpr size_t WS_WGU = 78 * MiB;
constexpr size_t WS_WDN = 590 * MiB;
constexpr size_t WS_X = 846 * MiB;
constexpr size_t WS_H = 1118 * MiB;
constexpr size_t WS_Z = 1254 * MiB;
constexpr size_t WS_FS = WS_Z;
constexpr float G8_SCALE = 255.0f;
constexpr float FS_SCALE = 32.0f, FS_CLAMP = 440.0f;
constexpr size_t WS_BRA = 2036 * MiB;
constexpr size_t WS_HFB = 2172 * MiB;
constexpr size_t WS_Y = 2444 * MiB;
constexpr size_t WS_T = 2580 * MiB;
constexpr size_t WS_H2 = 2852 * MiB;
constexpr size_t WS_HID = 2988 * MiB;
constexpr size_t WS_ZG = 3548 * MiB;
constexpr size_t WS_H2F8 = 3554 * MiB;
constexpr size_t WS_H8 = 3624 * MiB;
constexpr size_t WS_WIN8 = 3692 * MiB;
constexpr size_t WS_END = 3714 * MiB;
static_assert(WS_Z + (size_t)MT * NZ * 2 <= WS_BRA && WS_FS + (size_t)MT * 4 * 1024 * 2 <= WS_BRA, "Z/FS");
static_assert(WS_HID + (size_t)NS_MAX * 1024 * 2 <= WS_END, "HID");
constexpr size_t RT_EIDX = 0;
constexpr size_t RT_PROB = 2 * MiB;
constexpr size_t RT_TOK = 4 * MiB;
constexpr size_t RT_DEST = 6 * MiB;
constexpr size_t RT_PSLOT = 8 * MiB;
constexpr size_t RT_CNT = 10 * MiB;
constexpr size_t RT_SEG = 10 * MiB + 64 * 1024;
constexpr int CW_BAR = 4096;

constexpr int LDS_BYTES = 163840;
constexpr int MISC_OFF = LDS_BYTES - 256;
constexpr int TAB_OFF = 131072;
constexpr int NW_WT = 0;
constexpr int NW_LG = 66048;
constexpr int NW_END = 99840;
constexpr int NW_PV = NW_END + 256;

__device__ __forceinline__ unsigned f2bf(float f) { unsigned u = __builtin_bit_cast(unsigned, f); return (u + 0x7fffu + ((u >> 16) & 1u)) >> 16; }
__device__ __forceinline__ unsigned pk2(float lo, float hi) { unsigned r; asm volatile("v_cvt_pk_bf16_f32 %0, %1, %2" : "=v"(r) : "v"(lo), "v"(hi)); return r; }
__device__ __forceinline__ unsigned pk4_fp8(float a, float b, float c, float d) { int w = 0; w = __builtin_amdgcn_cvt_pk_fp8_f32(a, b, w, false); w = __builtin_amdgcn_cvt_pk_fp8_f32(c, d, w, true); return (unsigned)w; }
__device__ __forceinline__ unsigned pk4_u8(float a, float b, float c, float d) {
    const unsigned lo = __builtin_amdgcn_perm(__builtin_bit_cast(unsigned, b), __builtin_bit_cast(unsigned, a), 0x0c0c0400u), hi = __builtin_amdgcn_perm(__builtin_bit_cast(unsigned, d), __builtin_bit_cast(unsigned, c), 0x0c0c0400u);
    return lo | (hi << 16); }
__device__ __forceinline__ f32x4 u8x4_f32(unsigned w) { return (f32x4){(float)(w & 0xffu), (float)((w >> 8) & 0xffu), (float)((w >> 16) & 0xffu), (float)(w >> 24)}; }
__device__ __forceinline__ float bflo(unsigned w) { return __builtin_bit_cast(float, w << 16); }
__device__ __forceinline__ float bfhi(unsigned w) { return __builtin_bit_cast(float, w & 0xffff0000u); }
__device__ __forceinline__ float bf1(bf16_t h) { return __builtin_bit_cast(float, ((unsigned)h) << 16); }
__device__ __forceinline__ float bperm(int srclane, float v) { return __builtin_bit_cast(float, __builtin_amdgcn_ds_bpermute(srclane << 2, __builtin_bit_cast(int, v))); }
__device__ __forceinline__ float shx(float v, int o, int lane) { return bperm(lane ^ o, v); }
__device__ __forceinline__ float shup(float v, int o, int lane) { return bperm(lane >= o ? lane - o : lane, v); }
template <int N> __device__ __forceinline__ float dpp_ror(float v) { return __builtin_bit_cast(float, __builtin_amdgcn_update_dpp(0, __builtin_bit_cast(int, v), 0x120 + N, 0xf, 0xf, false)); }
template <int CTRL, int ROWMASK> __device__ __forceinline__ float dpp_id(float ident, float v) { return __builtin_bit_cast(float, __builtin_amdgcn_update_dpp(__builtin_bit_cast(int, ident), __builtin_bit_cast(int, v), CTRL, ROWMASK, 0xf, false)); }
__device__ __forceinline__ float wave_scan_sum(float v) {
    v += dpp_id<0x111, 0xf>(0.f, v); v += dpp_id<0x112, 0xf>(0.f, v); v += dpp_id<0x114, 0xf>(0.f, v); v += dpp_id<0x118, 0xf>(0.f, v);
    v += dpp_id<0x142, 0xa>(0.f, v); v += dpp_id<0x143, 0xc>(0.f, v); return v; }
__device__ __forceinline__ float wave_scan_max(float v) { const float NI = -3.0e38f;
    v = fmaxf(v, dpp_id<0x111, 0xf>(NI, v)); v = fmaxf(v, dpp_id<0x112, 0xf>(NI, v)); v = fmaxf(v, dpp_id<0x114, 0xf>(NI, v)); v = fmaxf(v, dpp_id<0x118, 0xf>(NI, v));
    v = fmaxf(v, dpp_id<0x142, 0xa>(NI, v)); v = fmaxf(v, dpp_id<0x143, 0xc>(NI, v)); return v; }
template <int CTRL> __device__ __forceinline__ float dpp_mv(float v) { return __builtin_bit_cast(float, __builtin_amdgcn_update_dpp(0, __builtin_bit_cast(int, v), CTRL, 0xf, 0xf, false)); }
__device__ __forceinline__ float oct_sum(float v) { v += dpp_mv<0xB1>(v); v += dpp_mv<0x4E>(v); v += dpp_mv<0x141>(v); return v; }
__device__ __forceinline__ float row16_sum(float v) { v += dpp_ror<8>(v); v += dpp_ror<4>(v); v += dpp_ror<2>(v); v += dpp_ror<1>(v); return v; }
__device__ __forceinline__ float wave_sum(float v, int) {
    v = row16_sum(v);
    { const unsigned u = __builtin_bit_cast(unsigned, v); const auto r = __builtin_amdgcn_permlane16_swap(u, u, false, false); v = __builtin_bit_cast(float, (unsigned)r[0]) + __builtin_bit_cast(float, (unsigned)r[1]); }
    { const unsigned u = __builtin_bit_cast(unsigned, v); const auto r = __builtin_amdgcn_permlane32_swap(u, u, false, false); v = __builtin_bit_cast(float, (unsigned)r[0]) + __builtin_bit_cast(float, (unsigned)r[1]); }
    return v;
}
__device__ __forceinline__ float sigmoidf_(float x) { return __builtin_amdgcn_rcpf(1.0f + __builtin_amdgcn_exp2f(x * -1.4426950408889634f)); }
__device__ __forceinline__ float siluf_(float x) { return x * __builtin_amdgcn_rcpf(1.0f + __builtin_amdgcn_exp2f(x * -1.4426950408889634f)); }
__device__ __forceinline__ f32x4 sigmoid4(f32x4 x) {
    f32x4 t = x * -1.4426950408889634f;
#pragma unroll
    for (int i = 0; i < 4; ++i) t[i] = __builtin_amdgcn_exp2f(t[i]);
    t = t + 1.0f;
#pragma unroll
    for (int i = 0; i < 4; ++i) t[i] = __builtin_amdgcn_rcpf(t[i]);
    return t; }
#define LDS_WAIT() asm volatile("s_waitcnt lgkmcnt(0)" ::: "memory")
#define VM_WAIT() asm volatile("s_waitcnt vmcnt(0)" ::: "memory")

#define XB_TMO      128
#define XB_XCNT(j)  (256  + 64 * (j))
#define XB_XSUB(j)  (1280 + 64 * (j))
#define XB_XGEN(j)  (2304 + 64 * (j))
#define XB_TOP      3328
#define XB_TOPGEN   3392
#define XCD_BAR_WORDS 3456
#define XB_SPIN_CAP (1u << 18)
__device__ __forceinline__ unsigned xb_ld(unsigned* p)              { asm volatile("" : "+v"(p)); return __hip_atomic_load(p, __ATOMIC_RELAXED, __HIP_MEMORY_SCOPE_AGENT); }
__device__ __forceinline__ unsigned xb_add(unsigned* p, unsigned v) { asm volatile("" : "+v"(p), "+v"(v)); return __hip_atomic_fetch_add(p, v, __ATOMIC_RELAXED, __HIP_MEMORY_SCOPE_AGENT); }
__device__ __forceinline__ unsigned xb_xcc_id() { return (unsigned)__builtin_amdgcn_s_getreg((3 << 11) | 20) & 0xFu; }
#define XB_SPIN(cond, bar) do { unsigned _sp = 0; while (cond) { __builtin_amdgcn_s_sleep(1); \
    if ((++_sp & 255u) == 0u) { if (xb_ld(&(bar)[XB_TMO])) break; if (_sp > XB_SPIN_CAP) { atomicAdd(&(bar)[XB_TMO], 1u); break; } } } } while (0)
struct XcdBarrier { unsigned* bar; unsigned x; volatile LAS unsigned* st; };
__device__ __forceinline__ XcdBarrier xcd_barrier_post(unsigned* bar, volatile LAS unsigned* st) {
    XcdBarrier b; b.bar = bar; b.x = xb_xcc_id(); b.st = st;
    if (threadIdx.x == 0) (void)xb_add(&bar[XB_XCNT(b.x)], 1u);
    return b;
}
__device__ __forceinline__ void xcd_barrier_complete(unsigned* bar, unsigned x, unsigned& nloc, unsigned& nx) {
    const unsigned G = gridDim.x * gridDim.y * gridDim.z;
    unsigned sum, cnt, mine, sp = 0u;
    for (;;) {
        sum = 0u; cnt = 0u; mine = 0u;
#pragma unroll
        for (unsigned j = 0; j < 16; ++j) { const unsigned c = xb_ld(&bar[XB_XCNT(j)]); sum += c; cnt += (c > 0u) ? 1u : 0u; mine = (j == x) ? c : mine; }
        if (sum == G) break;
        __builtin_amdgcn_s_sleep(1);
        if ((++sp & 255u) == 0u) { if (xb_ld(&bar[XB_TMO])) break; if (sp > XB_SPIN_CAP) { atomicAdd(&bar[XB_TMO], 1u); break; } }
    }
    nloc = mine > 0u ? mine : 1u; nx = cnt > 0u ? cnt : 1u;
}
__device__ __forceinline__ void xcd_barrier(const XcdBarrier& b) {
    asm volatile("s_waitcnt vmcnt(0)" ::: "memory");
    __syncthreads();
    if (threadIdx.x == 0) {
        unsigned* bar = b.bar;
        __builtin_amdgcn_s_waitcnt(0);
        unsigned nloc = b.st[0], nx = b.st[1];
        if (nloc == 0u) { xcd_barrier_complete(bar, b.x, nloc, nx); b.st[0] = nloc; b.st[1] = nx; }
        const unsigned old = xb_add(&bar[XB_XSUB(b.x)], 1u);
        const unsigned gen = old / nloc;
        if (old + 1u == (gen + 1u) * nloc) {
            __builtin_amdgcn_fence(__ATOMIC_RELEASE, "agent");
            asm volatile("s_waitcnt vmcnt(0)" ::: "memory");
            const unsigned og = xb_add(&bar[XB_TOP], 1u);
            const unsigned tg = og / nx;
            if (og + 1u == (tg + 1u) * nx) xb_add(&bar[XB_TOPGEN], 1u);
            else XB_SPIN(xb_ld(&bar[XB_TOPGEN]) == tg, bar);
            __builtin_amdgcn_fence(__ATOMIC_ACQUIRE, "agent");
            xb_add(&bar[XB_XGEN(b.x)], 1u);
            asm volatile("s_waitcnt vmcnt(0)" ::: "memory");
        } else {
            XB_SPIN(xb_ld(&bar[XB_XGEN(b.x)]) == gen, bar);
            __builtin_amdgcn_fence(__ATOMIC_ACQUIRE, "agent");
            asm volatile("s_waitcnt vmcnt(0)" ::: "memory");
        }
    }
    __syncthreads();
}

namespace pg8 {
constexpr int BM = 256, BK = 64, HALF = 128, HTB = HALF * BK * 2, STAGE_BYTES = 8 * HTB, NXCD = 8, WGM = 8;
__host__ __device__ __forceinline__ int lds_byte(int r, int c) { const int st = (r >> 4) * 2 + (c >> 5), rr = r & 15, cc = c & 31, ob = rr * 64 + cc * 2; return st * 1024 + (ob ^ (((ob >> 9) & 1) << 5)); }
__host__ __device__ __forceinline__ void stage_rc(int b, int& R, int& C) { const int st = b / 1024, sb = b % 1024, swz = sb ^ (((sb >> 9) & 1) << 5); R = (st >> 1) * 16 + swz / 64; C = (st & 1) * 32 + (swz % 64) / 2; }
__host__ __device__ __forceinline__ int perm32(int rho) { const int n = rho >> 4, i = rho & 15; return 8 * (i >> 2) + 4 * n + (i & 3); }
struct Unit { int pm, pn, sub; };
__device__ __forceinline__ unsigned cvt_pk_bf16(float lo, float hi) { unsigned r; asm volatile("v_cvt_pk_bf16_f32 %0, %1, %2" : "=v"(r) : "v"(lo), "v"(hi)); return r; }
__device__ __forceinline__ f32x2 gelu_pk(f32x2 v) {
    const f32x2 av = __builtin_elementwise_abs(v), d = av * 0.2316418882f + 1.0f;
    f32x2 t; t.x = __builtin_amdgcn_rcpf(d.x); t.y = __builtin_amdgcn_rcpf(d.y);
    f32x2 q = t * 0.5307027145f + (-0.7265760135f); q = q * t + 0.7107068705f; q = q * t + (-0.142248368f); q = q * t + 0.127414796f; q = q * t;
    const f32x2 s = (v * v) * (-0.72134752044f);
    f32x2 e; e.x = __builtin_amdgcn_exp2f(s.x); e.y = __builtin_amdgcn_exp2f(s.y);
    const f32x2 m = v * (q * e), r = v - m;
    f32x2 o; o.x = v.x < 0.f ? m.x : r.x; o.y = v.y < 0.f ? m.y : r.y; return o;
}
template <int NSUB = 1> struct StaticOrder {
    int nM, nN, nwg, G, c, pm0;
    __device__ void init(int nM_, int nN_, int G_, int c_, int pm0_ = 0) { nM = nM_; nN = nN_; nwg = nM * nN; G = G_; c = c_; pm0 = pm0_; }
    __device__ bool next(int i, Unit& u) const {
        const int it = i / NSUB; u.sub = i - it * NSUB;
        const long L = (long)it * G + c; if (L >= nwg) return false;
        int wgid = (int)L; { const int q = nwg / NXCD, r = nwg % NXCD, xcd = wgid % NXCD, off = wgid / NXCD; wgid = (xcd < r ? xcd * (q + 1) : r * (q + 1) + (xcd - r) * q) + off; }
        const int nig = WGM * nN, gid = wgid / nig, fm = gid * WGM, gsz = (nM - fm) < WGM ? (nM - fm) : WGM;
        u.pm = pm0 + fm + ((wgid % nig) % gsz); u.pn = (wgid % nig) / gsz; return true;
    }
};
constexpr int SIDE_TOK = 131072 + 2048;
constexpr int SIDE_SLOT = 131072 + 10240, SIDE_SLOT_BYTES = 3072;
__device__ __forceinline__ void dma16(unsigned voff, const void* sbase, unsigned ldsaddr) { asm volatile("s_mov_b32 m0, %2\n\tglobal_load_lds_dwordx4 %0, %1" :: "v"(voff), "s"(sbase), "s"(ldsaddr) : "memory", "m0"); }
__device__ __forceinline__ void dma4(unsigned voff, const void* sbase, unsigned ldsaddr) { asm volatile("s_mov_b32 m0, %2\n\tglobal_load_lds_dword %0, %1" :: "v"(voff), "s"(sbase), "s"(ldsaddr) : "memory", "m0"); }
template <class Prob, class Sched, class Epi>
__device__ __forceinline__ void gemm_phase(LAS unsigned char* lds, const int tid, const Prob& P, const Sched& S, const Epi& E) {
    const int wid = __builtin_amdgcn_readfirstlane(tid >> 6), lane = tid & 63, wr = wid >> 2, wc = wid & 3, fr = lane & 15, fq = lane >> 4;
    const int lda = P.lda, ldb = P.ldb;
    unsigned voffB[2], offA[2][2];
#define PG8_TOKSLOT(name) const LAS int* name; { PG8_TID(tl2_); name = (const LAS int*)(lds + SIDE_TOK) + (tl2_ >> 6) * 256 + (tl2_ & 63); }
#define PG8_TID(v_) int v_; asm volatile("v_mbcnt_lo_u32_b32 %0, -1, 0\n\tv_mbcnt_hi_u32_b32 %0, -1, %0" : "=v"(v_)); v_ |= (wid << 6)
#define PG8_RC(R_, C_) int R_[2], C_[2]; { PG8_TID(tl_); _Pragma("unroll") for (int i_ = 0; i_ < 2; ++i_) stage_rc(tl_ * 16 + i_ * 8192, R_[i_], C_[i_]); }
#pragma unroll
    for (int i = 0; i < 2; ++i) { int R, C; stage_rc(tid * 16 + i * 8192, R, C); const int Rb = Epi::PERM ? ((R & ~31) + perm32(R & 31)) : R;
        voffB[i] = (unsigned)(Rb * ldb + C) * 2u;
        offA[0][i] = (unsigned)(R * lda + C) * 2u; offA[1][i] = (unsigned)((R + HALF) * lda + C) * 2u; }
    const size_t kstep = (size_t)(BK * 2);
    const size_t hstep = (size_t)HALF * ldb * 2;
    const unsigned ldsw = (unsigned)wid * 1024u;
    const int aoff = lds_byte(wr * 64 + fr, fq * 8), boff = lds_byte(wc * 32 + fr, fq * 8);
#define PG8_SA(b, h) (((b) * 2 + (h)) * HTB)
#define PG8_SB(b, h) ((4 + (b) * 2 + (h)) * HTB)
    const unsigned ldsb = (unsigned)(size_t)lds;
#define PG8_STAGE(bufoff, gbase, voff) do { _Pragma("unroll") for (int _i = 0; _i < 2; ++_i) \
        asm volatile("s_mov_b32 m0, %2\n\tglobal_load_lds_dwordx4 %0, %1" :: "v"((voff)[_i]), "s"((const char*)(gbase)), "s"(ldsb + (unsigned)(bufoff) + ldsw + (unsigned)(_i * 8192)) : "memory", "m0"); } while (0)
#define PG8_CAT(x0, x1) __builtin_shufflevector(x0, x1, 0, 1, 2, 3, 4, 5, 6, 7)
#define PG8_LDA(dst, b, h) do { if constexpr (Prob::FP8) { _Pragma("unroll") for (int m = 0; m < 4; ++m) dst##8[m] = PG8_CAT(*(const LAS i32x4*)(lds + PG8_SA(b, h) + aoff + m * 2048), *(const LAS i32x4*)(lds + PG8_SA(b, h) + aoff + m * 2048 + 1024)); } \
        else { _Pragma("unroll") for (int m = 0; m < 4; ++m) _Pragma("unroll") for (int k = 0; k < 2; ++k) dst[m][k] = *(const LAS bf16x8*)(lds + PG8_SA(b, h) + aoff + m * 2048 + k * 1024); } } while (0)
#define PG8_LDB(dst, b, h) do { if constexpr (Prob::FP8) { _Pragma("unroll") for (int n = 0; n < 2; ++n) dst##8[n] = PG8_CAT(*(const LAS i32x4*)(lds + PG8_SB(b, h) + boff + n * 2048), *(const LAS i32x4*)(lds + PG8_SB(b, h) + boff + n * 2048 + 1024)); } \
        else { _Pragma("unroll") for (int n = 0; n < 2; ++n) _Pragma("unroll") for (int k = 0; k < 2; ++k) dst[n][k] = *(const LAS bf16x8*)(lds + PG8_SB(b, h) + boff + n * 2048 + k * 1024); } } while (0)
#define PG8_MMA(ai, bj, At, Bt) do { __builtin_amdgcn_s_setprio(1); \
        if constexpr (Prob::FP8) { _Pragma("unroll") for (int m = 0; m < 4; ++m) _Pragma("unroll") for (int n = 0; n < 2; ++n) \
            acc[ai][bj][m][n] = __builtin_amdgcn_mfma_scale_f32_16x16x128_f8f6f4(Bt##8[n], At##8[m], acc[ai][bj][m][n], 0, 0, 0, 0, 0, 0); } \
        else { _Pragma("unroll") for (int m = 0; m < 4; ++m) _Pragma("unroll") for (int n = 0; n < 2; ++n) _Pragma("unroll") for (int k = 0; k < 2; ++k) \
            acc[ai][bj][m][n] = __builtin_amdgcn_mfma_f32_16x16x32_bf16(Bt[n][k], At[m][k], acc[ai][bj][m][n], 0, 0, 0); } \
        __builtin_amdgcn_s_setprio(0); } while (0)
#define PG8_WAIT_V(n) asm volatile("s_waitcnt vmcnt(" #n ")" ::: "memory")
#define PG8_WAIT_L(n) asm volatile("s_waitcnt lgkmcnt(" #n ")" ::: "memory")
#define PG8_BAR __builtin_amdgcn_s_barrier()
#define PG8_SCHED __builtin_amdgcn_sched_barrier(0)
    Unit cur, nxt; int ui = 0;
    if (!S.next(0, cur)) return;
    f32x4 acc[2][2][4][2];
    float zero_; asm volatile("v_mov_b32 %0, 0" : "=v"(zero_));
#pragma unroll
    for (int a = 0; a < 2; ++a)
#pragma unroll
        for (int b = 0; b < 2; ++b)
#pragma unroll
            for (int m = 0; m < 4; ++m)
#pragma unroll
                for (int n = 0; n < 2; ++n) acc[a][b][m][n] = (f32x4){zero_, zero_, zero_, zero_};
    bf16x8 At[4][2], B0[2][2], B1[2][2]; i32x8 At8[4], B08[2], B18[2];
    const char* cA = P.a_base(cur); const char* cB = P.b_base(cur); int nt = P.nt(cur);
    if constexpr (Prob::GATHER) { PG8_RC(Rr, Cc); P.a_rows(cur, Rr, Cc, offA); }
    if constexpr (Epi::SIDE) { PG8_TID(tl4_); E.side(cur, ldsb + SIDE_SLOT, wid, tl4_ & 63); }
    PG8_STAGE(PG8_SB(0, 0), cB, voffB); PG8_STAGE(PG8_SB(0, 1), cB + hstep, voffB); PG8_STAGE(PG8_SA(0, 0), cA, offA[0]); PG8_STAGE(PG8_SA(0, 1), cA, offA[1]);
    if (wr == 1) PG8_BAR;
    PG8_WAIT_V(2); PG8_BAR;
    PG8_STAGE(PG8_SB(1, 0), cB + kstep, voffB); PG8_STAGE(PG8_SA(1, 0), cA + kstep, offA[0]); PG8_STAGE(PG8_SB(1, 1), cB + hstep + kstep, voffB);
    PG8_WAIT_V(6); PG8_BAR;
    for (;;) {
        const bool has_next = S.next(ui + 1, nxt);
        const char* nA = has_next ? P.a_base(nxt) : cA; const char* nB = has_next ? P.b_base(nxt) : cB;
        if constexpr (Prob::GATHER) { if (has_next) { PG8_RC(Rr, Cc); (void)Cc;
#pragma unroll
            for (int h = 0; h < 2; ++h)
#pragma unroll
                for (int i = 0; i < 2; ++i) dma4((unsigned)(nxt.pm * 256 + h * 128 + Rr[i]) * 4u, P.tok, ldsb + SIDE_TOK + (unsigned)wid * 1024u + (unsigned)((h * 2 + i) * 256)); } }
        if constexpr (Epi::SIDE) { if (has_next) { PG8_TID(tl4_); E.side(nxt, ldsb + SIDE_SLOT + (unsigned)(((ui + 1) % 3) * SIDE_SLOT_BYTES), wid, tl4_ & 63); } }
        for (int t = 0; t < nt; t += 2) {
            const bool last = (t == nt - 2);
            if constexpr (Epi::KHOOK) { if (t == Epi::HOOK_T0 || t == Epi::HOOK_T1) {
                asm volatile("" ::: "memory"); PG8_TID(tlh_); const int lnh_ = tlh_ & 63; E.hook(acc, cur, t == Epi::HOOK_T0 ? 0 : 1, wr, wc, lnh_ & 15, lnh_ >> 4); asm volatile("" ::: "memory"); } }
            const char* a1 = cA + (size_t)(t + 1) * kstep;
            const char* a2 = last ? nA : cA + (size_t)(t + 2) * kstep; const char* b2 = last ? nB : cB + (size_t)(t + 2) * kstep;
            const char* a3 = a2 + kstep; const char* b3 = b2 + kstep;
            PG8_LDB(B0, 0, 0); PG8_LDB(B1, 0, 1); PG8_SCHED; PG8_LDA(At, 0, 0); PG8_STAGE(PG8_SA(1, 1), a1, offA[1]);
            PG8_WAIT_V(8); PG8_WAIT_L(0); PG8_BAR; PG8_MMA(0, 0, At, B0); PG8_MMA(0, 1, At, B1); PG8_BAR; PG8_SCHED;
            if constexpr (Prob::GATHER) { if (last && has_next) { PG8_RC(Rr, Cc); (void)Rr; PG8_TOKSLOT(tokslot); const int ntok[2][2] = {{tokslot[0], tokslot[64]}, {tokslot[128], tokslot[192]}}; P.a_off(ntok, Cc, offA); } }
            PG8_LDA(At, 0, 1); PG8_STAGE(PG8_SB(0, 0), b2, voffB); PG8_STAGE(PG8_SB(0, 1), b2 + hstep, voffB); PG8_STAGE(PG8_SA(0, 0), a2, offA[0]);
            PG8_WAIT_V(8); PG8_WAIT_L(0); PG8_BAR; PG8_MMA(1, 0, At, B0); PG8_MMA(1, 1, At, B1); PG8_BAR; PG8_SCHED;
            PG8_LDB(B0, 1, 0); PG8_LDB(B1, 1, 1); PG8_SCHED; PG8_LDA(At, 1, 0); PG8_STAGE(PG8_SA(0, 1), a2, offA[1]);
            PG8_WAIT_V(8); PG8_WAIT_L(0); PG8_BAR; PG8_MMA(0, 0, At, B0); PG8_MMA(0, 1, At, B1); PG8_BAR; PG8_SCHED;
            PG8_LDA(At, 1, 1); PG8_STAGE(PG8_SB(1, 0), b3, voffB); PG8_STAGE(PG8_SB(1, 1), b3 + hstep, voffB); PG8_STAGE(PG8_SA(1, 0), a3, offA[0]);
            PG8_WAIT_V(8); PG8_WAIT_L(0); PG8_BAR; PG8_MMA(1, 0, At, B0); PG8_MMA(1, 1, At, B1); PG8_BAR; PG8_SCHED;
        }
        if (wr == 0) PG8_BAR;
        { PG8_TID(tl3_); const int ln_ = tl3_ & 63; E(acc, cur, wr, wc, ln_ & 15, ln_ >> 4, lds + SIDE_SLOT + (ui % 3) * SIDE_SLOT_BYTES); }
        if (!has_next) break;
        bool keep = false;
        if constexpr (Epi::CHAIN) keep = E.keep(cur);
        if (!keep) {
            asm volatile("v_mov_b32 %0, 0" : "=v"(zero_));
#pragma unroll
            for (int a = 0; a < 2; ++a)
#pragma unroll
                for (int b = 0; b < 2; ++b)
#pragma unroll
                    for (int m = 0; m < 4; ++m)
#pragma unroll
                        for (int n = 0; n < 2; ++n) acc[a][b][m][n] = (f32x4){zero_, zero_, zero_, zero_};
        }
        cur = nxt; cA = nA; cB = nB; nt = P.nt(cur); ++ui;
        if (wr == 1) PG8_BAR;
    }
    PG8_WAIT_V(0);
    PG8_BAR;
#undef PG8_RC
#undef PG8_TID
#undef PG8_TOKSLOT
#undef PG8_SA
#undef PG8_SB
#undef PG8_STAGE
#undef PG8_LDA
#undef PG8_LDB
#undef PG8_MMA
#undef PG8_CAT
#undef PG8_WAIT_V
#undef PG8_WAIT_L
#undef PG8_BAR
#undef PG8_SCHED
}
}

typedef const float* cfp_t;
typedef const cfp_t __attribute__((address_space(4))) * InTab;
struct Frame {
    LAS unsigned char* lds;
    volatile LAS unsigned* MISC;
    unsigned char* ws;
    InTab in;
    float* out;
    int tid, lane, wave, G, bid;
};
enum { IN_X = 0, IN_C, IN_CTX, IN_CCTX, IN_WADA, IN_BADA, IN_WIN, IN_BIN, IN_POOLW, IN_POOLS, IN_CONVW, IN_CONVB, IN_MNG, IN_SLNG, IN_SLNB, IN_SGUW, IN_SGUB,
       IN_WBP, IN_WBM, IN_WBS, IN_WOUT, IN_LN1G, IN_LN1B, IN_WR, IN_BR, IN_WGU, IN_BGU, IN_WDN, IN_BDN, IN_LN2G, IN_LN2B };
__device__ __forceinline__ int mod_row(int row) { return row < ML ? (row >> 12) : NB; }
__device__ __forceinline__ const float* modp(const Frame& F, int l, int row, int part) { return (const float*)(F.ws + WS_MOD) + ((size_t)(l * 17 + mod_row(row)) * 6 + part) * 1024; }

__device__ __forceinline__ void transpose_item(const float* W, size_t ldw, int k0, int srccol0, bf16_t* dst, size_t ldk, int kd0, LAS float* scr, int lane) {
#pragma unroll 8
    for (int i = 0; i < 32; ++i) { const int kk = 2 * i + (lane >> 5); scr[kk * 33 + (lane & 31)] = __builtin_nontemporal_load(W + (size_t)(k0 + kk) * ldw + srccol0 + (lane & 31)); }
    LDS_WAIT(); asm volatile("" ::: "memory");
    const int c = lane & 7;
#pragma unroll
    for (int j = 0; j < 4; ++j) { const int n = (lane >> 3) + 8 * j; const LAS float* s = scr + (8 * c) * 33 + n;
        u32x4 o; o.x = pk2(s[0 * 33], s[1 * 33]); o.y = pk2(s[2 * 33], s[3 * 33]); o.z = pk2(s[4 * 33], s[5 * 33]); o.w = pk2(s[6 * 33], s[7 * 33]);
        *(u32x4*)(dst + (size_t)n * ldk + kd0 + 8 * c) = o; }
    LDS_WAIT(); asm volatile("" ::: "memory");
}
__device__ __forceinline__ void transpose_item_fp8(const float* W, size_t ldw, int k0, int srccol0, unsigned char* dst, size_t ldk, int kd0, float sc, LAS float* scr, int lane) {
#pragma unroll 8
    for (int i = 0; i < 32; ++i) { const int kk = 2 * i + (lane >> 5); scr[kk * 33 + (lane & 31)] = __builtin_nontemporal_load(W + (size_t)(k0 + kk) * ldw + srccol0 + (lane & 31)); }
    LDS_WAIT(); asm volatile("" ::: "memory");
    const int c = lane & 7;
#pragma unroll
    for (int j = 0; j < 4; ++j) { const int n = (lane >> 3) + 8 * j; const LAS float* s_ = scr + (8 * c) * 33 + n;
        u32x2 o; o.x = pk4_fp8(s_[0 * 33] * sc, s_[1 * 33] * sc, s_[2 * 33] * sc, s_[3 * 33] * sc); o.y = pk4_fp8(s_[4 * 33] * sc, s_[5 * 33] * sc, s_[6 * 33] * sc, s_[7 * 33] * sc);
        *(u32x2*)(dst + (size_t)n * ldk + kd0 + 8 * c) = o; }
    LDS_WAIT(); asm volatile("" ::: "memory");
}
__device__ __forceinline__ void phase_prologue(Frame& F) {
    LAS float* scr = (LAS float*)(F.lds + F.wave * 16384);
    const int gw = F.bid * NWAVES + F.wave, NGW = F.G * NWAVES;
    constexpr int I_IN = 16 * (NZ / 32);
    constexpr int I_BR = (4 + 8 + 4) * 32;
    constexpr int I_OUT = 16 * 32;
    constexpr int I_GU = 16 * 64;
    constexpr int I_DN = 16 * 32;
    constexpr int T_IN = DEPTH * I_IN, T_BR = DEPTH * I_BR, T_OUT = DEPTH * I_OUT, T_GU = DEPTH * NEXP * I_GU, T_DN = DEPTH * NEXP * I_DN;
    constexpr int NITEMS = T_IN + T_BR + T_OUT + T_GU + T_DN;
    for (int it = gw; it < NITEMS; it += NGW) {
        int r = it;
        if (r < T_IN) { const int l = r / I_IN; r %= I_IN; const int kb = r / (NZ / 32), nb = r % (NZ / 32); const int n0 = nb * 32, src = n0 < 2304 ? n0 : n0 + 16;
            if (n0 < NZ_BF) transpose_item(F.in[IN_WIN] + (size_t)l * D * 5904, 5904, kb * 64, src, (bf16_t*)(F.ws + WS_WIN) + ((size_t)l * NZ + n0) * D, D, kb * 64, scr, F.lane);
            else transpose_item_fp8(F.in[IN_WIN] + (size_t)l * D * 5904, 5904, kb * 64, src, (unsigned char*)(F.ws + WS_WIN8) + ((size_t)l * NZ_F8 + (n0 - NZ_BF)) * D, D, kb * 64, F8S_WGU, scr, F.lane);
            continue; }
        r -= T_IN;
        if (r < T_BR) { const int l = r / I_BR; r %= I_BR; const int kb = r / 32, nb = r % 32;
            const float* W; int ksrc;
            if (kb < 4) { W = F.in[IN_WBP] + (size_t)l * 256 * D; ksrc = kb * 64; } else if (kb < 12) { W = F.in[IN_WBM] + (size_t)l * 512 * D; ksrc = (kb - 4) * 64; } else { W = F.in[IN_WBS] + (size_t)l * 256 * D; ksrc = (kb - 12) * 64; }
            transpose_item(W, D, ksrc, nb * 32, (bf16_t*)(F.ws + WS_WBR) + ((size_t)l * D + nb * 32) * D, D, kb * 64, scr, F.lane); continue; }
        r -= T_BR;
        if (r < T_OUT) { const int l = r / I_OUT; r %= I_OUT; const int kb = r / 32, nb = r % 32;
            transpose_item(F.in[IN_WOUT] + (size_t)l * D * D, D, kb * 64, nb * 32, (bf16_t*)(F.ws + WS_WOUT) + ((size_t)l * D + nb * 32) * D, D, kb * 64, scr, F.lane); continue; }
        r -= T_OUT;
        if (r < T_GU) { const int le = r / I_GU; r %= I_GU; const int kb = r / 64, nb = r % 64; const int n0 = nb * 32;
            const int pn = n0 >> 8, c = n0 & 255; const int src = c < 128 ? (128 * pn + c) : (1024 + 128 * pn + c - 128);
            transpose_item_fp8(F.in[IN_WGU] + (size_t)le * D * 2048, 2048, kb * 64, src, (unsigned char*)(F.ws + WS_WGU) + ((size_t)le * 2048 + n0) * D, D, kb * 64, F8S_WGU, scr, F.lane); continue; }
        r -= T_GU;
        { const int le = r / I_DN; r %= I_DN; const int kb = r / 32, nb = r % 32;
            transpose_item_fp8(F.in[IN_WDN] + (size_t)le * D * D, D, kb * 64, nb * 32, (unsigned char*)(F.ws + WS_WDN) + ((size_t)le * D + nb * 32) * D, D, kb * 64, F8S_WDN, scr, F.lane); }
    }
    { const int gt = F.bid * NTHREADS + F.tid, NGT = F.G * NTHREADS;
      for (int i = gt; i < DEPTH * 16 * 1024; i += NGT) { const int l = i >> 14, g = (i >> 10) & 15, k = i & 1023; ((float*)(F.ws + WS_WG))[i] = F.in[IN_WIN][((size_t)l * D + k) * 5904 + 2304 + g]; }
      for (int i = gt; i < DEPTH * 4 * 128 * 128; i += NGT) ((bf16_t*)(F.ws + WS_WSGU))[i] = (bf16_t)f2bf(F.in[IN_SGUW][i]);
      for (int i = gt; i < DEPTH * 4 * 64 * 64; i += NGT) { const int lg = i >> 12, d = (i >> 6) & 63, c = i & 63; ((bf16_t*)(F.ws + WS_WPOOL))[i] = (bf16_t)f2bf(F.in[IN_POOLW][(size_t)lg * 4096 + c * 64 + d]); } }
    __syncthreads();
    { LAS float* sc = (LAS float*)F.lds;
      LAS float* part = (LAS float*)(F.lds + 71680);
      for (int i = F.tid; i < 17 * 1024; i += NTHREADS) { const int r = i >> 10, k = i & 1023; const float v = r < 16 ? F.in[IN_C][r * 1024 + k] : F.in[IN_CCTX][k]; sc[i] = siluf_(v); }
      __syncthreads();
      for (int u = F.bid; u < DEPTH * 48; u += F.G) {
          const int l = u / 48, n0 = (u % 48) * 128, col = F.tid & 127, ks = F.tid >> 7;
          float a[17];
#pragma unroll
          for (int r = 0; r < 17; ++r) a[r] = 0.f;
          const float* W = F.in[IN_WADA] + (size_t)l * D * 6144 + n0 + col;
          for (int k = ks * 256; k < ks * 256 + 256; ++k) { const float w = W[(size_t)k * 6144];
#pragma unroll
              for (int r = 0; r < 17; ++r) a[r] += sc[r * 1024 + k] * w; }
#pragma unroll
          for (int r = 0; r < 17; ++r) part[(ks * 17 + r) * 128 + col] = a[r];
          __syncthreads();
          for (int i = F.tid; i < 17 * 128; i += NTHREADS) { const int r = i >> 7, cc = i & 127;
              const float s = part[(0 * 17 + r) * 128 + cc] + part[(1 * 17 + r) * 128 + cc] + part[(2 * 17 + r) * 128 + cc] + part[(3 * 17 + r) * 128 + cc] + F.in[IN_BADA][l * 6144 + n0 + cc];
              ((float*)(F.ws + WS_MOD))[(size_t)(l * 17 + r) * 6144 + n0 + cc] = s; }
          __syncthreads();
      } }
}

struct RowV { f32x4 v[4]; };
#define RC(lane, j) (8 * (lane) + 512 * ((j) >> 1) + 4 * ((j) & 1))
__device__ __forceinline__ void row_load(RowV& r, const float* p, int lane) {
#pragma unroll
    for (int j = 0; j < 4; ++j) r.v[j] = __builtin_nontemporal_load((const f32x4*)(p + RC(lane, j)));
}
__device__ __forceinline__ void row_load_bf16(RowV& r, const bf16_t* p, int lane) {
#pragma unroll
    for (int h = 0; h < 2; ++h) { const u32x4 w = __builtin_nontemporal_load((const u32x4*)(p + 8 * lane + 512 * h)); r.v[2 * h] = (f32x4){bflo(w.x), bfhi(w.x), bflo(w.y), bfhi(w.y)}; r.v[2 * h + 1] = (f32x4){bflo(w.z), bfhi(w.z), bflo(w.w), bfhi(w.w)}; }
}
__device__ __forceinline__ void row_store(const RowV& r, float* p, int lane) {
#pragma unroll
    for (int j = 0; j < 4; ++j) *(f32x4*)(p + RC(lane, j)) = r.v[j];
}
__device__ __forceinline__ void row_store_nt(const RowV& r, float* p, int lane) {
#pragma unroll
    for (int j = 0; j < 4; ++j) __builtin_nontemporal_store(r.v[j], (f32x4*)(p + RC(lane, j)));
}
__device__ __forceinline__ void row_store_bf16_nt(const RowV& r, bf16_t* p, int lane) {
#pragma unroll
    for (int h = 0; h < 2; ++h) { u32x4 w; w.x = pk2(r.v[2 * h].x, r.v[2 * h].y); w.y = pk2(r.v[2 * h].z, r.v[2 * h].w); w.z = pk2(r.v[2 * h + 1].x, r.v[2 * h + 1].y); w.w = pk2(r.v[2 * h + 1].z, r.v[2 * h + 1].w); __builtin_nontemporal_store(w, (u32x4*)(p + 8 * lane + 512 * h)); }
}
__device__ __forceinline__ void row_store_bf16(const RowV& r, bf16_t* p, int lane) {
#pragma unroll
    for (int h = 0; h < 2; ++h) { u32x4 w; w.x = pk2(r.v[2 * h].x, r.v[2 * h].y); w.y = pk2(r.v[2 * h].z, r.v[2 * h].w); w.z = pk2(r.v[2 * h + 1].x, r.v[2 * h + 1].y); w.w = pk2(r.v[2 * h + 1].z, r.v[2 * h + 1].w); *(u32x4*)(p + 8 * lane + 512 * h) = w; }
}
__device__ __forceinline__ void row_ln_plain(RowV& r, int lane) {
    float s = 0.f;
#pragma unroll
    for (int j = 0; j < 4; ++j) s += (r.v[j].x + r.v[j].y) + (r.v[j].z + r.v[j].w);
    const float mean = wave_sum(s, lane) * (1.f / D); float s2 = 0.f;
#pragma unroll
    for (int j = 0; j < 4; ++j) { r.v[j] = r.v[j] - mean; s2 += (r.v[j].x * r.v[j].x + r.v[j].y * r.v[j].y) + (r.v[j].z * r.v[j].z + r.v[j].w * r.v[j].w); }
    const float rstd = __builtin_amdgcn_rsqf(wave_sum(s2, lane) * (1.f / D) + LN_EPS);
#pragma unroll
    for (int j = 0; j < 4; ++j) r.v[j] = r.v[j] * rstd;
}
__device__ __forceinline__ void row_affine(RowV& r, const float* g, const float* b, int lane) {
#pragma unroll
    for (int j = 0; j < 4; ++j) { const f32x4 gg = *(const f32x4*)(g + RC(lane, j)), bb = *(const f32x4*)(b + RC(lane, j)); r.v[j] = r.v[j] * gg + bb; }
}
__device__ __forceinline__ void row_modulate(RowV& r, const float* sh, const float* sc, int lane) {
#pragma unroll
    for (int j = 0; j < 4; ++j) { const f32x4 s1 = *(const f32x4*)(sc + RC(lane, j)), s0 = *(const f32x4*)(sh + RC(lane, j)); r.v[j] = r.v[j] * (s1 + 1.0f) + s0; }
}
__device__ __forceinline__ LAS float* pv_slot(const Frame& F, int slot) { return (LAS float*)(F.lds + NW_PV) + slot * 1024; }
__device__ __forceinline__ void pv_fill(Frame& F, int slot, const float* src) { LAS f32x4* d = (LAS f32x4*)pv_slot(F, slot); for (int i = F.tid; i < 256; i += NTHREADS) d[i] = *(const f32x4*)(src + 4 * i); }
__device__ __forceinline__ void row_affine_l(RowV& r, const LAS float* g, const LAS float* b, int lane) {
#pragma unroll
    for (int j = 0; j < 4; ++j) { const f32x4 gg = *(const LAS f32x4*)(g + RC(lane, j)), bb = *(const LAS f32x4*)(b + RC(lane, j)); r.v[j] = r.v[j] * gg + bb; }
}
__device__ __forceinline__ void row_modulate_l(RowV& r, const LAS float* sh, const LAS float* sc, int lane) {
#pragma unroll
    for (int j = 0; j < 4; ++j) { const f32x4 s1 = *(const LAS f32x4*)(sc + RC(lane, j)), s0 = *(const LAS f32x4*)(sh + RC(lane, j)); r.v[j] = r.v[j] * (s1 + 1.0f) + s0; }
}
__device__ __forceinline__ void ln0_row(Frame& F, int row, RowV xr, const LAS float* sh, const LAS float* sc) {
    row_ln_plain(xr, F.lane);
    row_modulate_l(xr, sh, sc, F.lane);
    row_store_bf16(xr, (bf16_t*)(F.ws + WS_H) + (size_t)row * D, F.lane);
    { unsigned char* h8 = (unsigned char*)(F.ws + WS_H8) + (size_t)row * D + 8 * F.lane;
#pragma unroll
      for (int h = 0; h < 2; ++h) { u32x2 w; w.x = pk4_fp8(xr.v[2 * h].x * F8S_ACT, xr.v[2 * h].y * F8S_ACT, xr.v[2 * h].z * F8S_ACT, xr.v[2 * h].w * F8S_ACT); w.y = pk4_fp8(xr.v[2 * h + 1].x * F8S_ACT, xr.v[2 * h + 1].y * F8S_ACT, xr.v[2 * h + 1].z * F8S_ACT, xr.v[2 * h + 1].w * F8S_ACT); *(u32x2*)(h8 + 512 * h) = w; } }
}
__device__ __forceinline__ LAS float* narrow_tile_wave(Frame& F, const bf16_t* A) {
    const int r = F.lane & 31, h = F.lane >> 5;
    f32x16 acc;
#pragma unroll
    for (int i = 0; i < 16; ++i) acc[i] = 0.f;
    const bf16_t* ap = A + (size_t)r * D + 8 * h;
    const LAS unsigned char* bp = F.lds + NW_WT + r * 2064 + 16 * h;
    bf16x8 av[2][16];
#pragma unroll
    for (int ks = 0; ks < 16; ++ks) av[0][ks] = *(const bf16x8*)(ap + ks * 16);
#pragma unroll
    for (int kb = 0; kb < 4; ++kb) {
        if (kb < 3) {
#pragma unroll
            for (int ks = 0; ks < 16; ++ks) av[(kb + 1) & 1][ks] = *(const bf16x8*)(ap + ((kb + 1) * 16 + ks) * 16); }
        __builtin_amdgcn_sched_barrier(0);
#pragma unroll
        for (int ks = 0; ks < 16; ++ks) { const bf16x8 b = *(const LAS bf16x8*)(bp + (kb * 16 + ks) * 32); acc = __builtin_amdgcn_mfma_f32_32x32x16_bf16(av[kb & 1][ks], b, acc, 0, 0, 0); }
        __builtin_amdgcn_sched_barrier(0);
    }
    LAS float* lg = (LAS float*)(F.lds + NW_LG) + F.wave * 1056;
#pragma unroll
    for (int i = 0; i < 16; ++i) lg[((i & 3) + 8 * (i >> 2) + 4 * h) * 33 + r] = acc[i];
    asm volatile("s_waitcnt lgkmcnt(0)" ::: "memory");
    return lg;
}
__device__ __forceinline__ void tile_range(const Frame& F, int mrows, int& t_lo, int& t_hi) { const int nt = mrows / 32; t_lo = (int)(((long)F.bid * nt) / F.G); t_hi = (int)(((long)(F.bid + 1) * nt) / F.G); }
__device__ __forceinline__ void load_wg_lds(Frame& F, int l) {
    const float* src = (const float*)(F.ws + WS_WG) + (size_t)l * 16384;
    for (int i = F.tid; i < 32 * 128; i += NTHREADS) { const int g = i >> 7, c8 = i & 127; u32x4 w = (u32x4){0u, 0u, 0u, 0u};
        if (g < 16) { const f32x4 a = *(const f32x4*)(src + g * 1024 + c8 * 8), b = *(const f32x4*)(src + g * 1024 + c8 * 8 + 4); w.x = pk2(a.x, a.y); w.y = pk2(a.z, a.w); w.z = pk2(b.x, b.y); w.w = pk2(b.z, b.w); }
        *(LAS u32x4*)(F.lds + NW_WT + g * 2064 + c8 * 16) = w; }
    __syncthreads();
}
__device__ __forceinline__ void gates_tail(Frame& F, int l, int t_lo, int t_hi) {
    asm volatile("s_waitcnt vmcnt(0)" ::: "memory"); __syncthreads();
    const int g = F.lane & 15; const float bias = F.in[IN_BIN][l * 5904 + 2304 + g];
    for (int tile = t_lo + F.wave; tile < t_hi; tile += NWAVES) {
        const LAS float* lg = narrow_tile_wave(F, (const bf16_t*)(F.ws + WS_H) + (size_t)tile * 32 * D);
#pragma unroll
        for (int rr = 0; rr < 8; ++rr) { const int row = rr * 4 + (F.lane >> 4); ((float*)(F.ws + WS_ZG))[(size_t)(tile * 32 + row) * 16 + g] = lg[row * 33 + g] + bias; }
        asm volatile("s_waitcnt lgkmcnt(0)" ::: "memory");
    }
}

using pg8::Unit;
struct ProbPlain {
    static constexpr bool GATHER = false, FP8 = false; static constexpr int SCALE_A = 127, SCALE_B = 127; const bf16_t* A; const bf16_t* Bt; int lda, ldb;
    __device__ __forceinline__ int nt(const Unit&) const { return lda / 64; }
    __device__ __forceinline__ const char* a_base(const Unit& u) const { return (const char*)A + (size_t)u.pm * 256 * lda * 2; }
    __device__ __forceinline__ const char* b_base(const Unit& u) const { return (const char*)Bt + (size_t)u.pn * 256 * ldb * 2; }
    __device__ __forceinline__ void a_tok(const Unit&, const int (&)[2], int (&)[2][2]) const {}
    __device__ __forceinline__ void a_off(const int (&)[2][2], const int (&)[2], unsigned (&)[2][2]) const {}
    __device__ __forceinline__ void a_rows(const Unit&, const int (&)[2], const int (&)[2], unsigned (&)[2][2]) const {}
};
struct ProbPlainF8 {
    static constexpr bool GATHER = false, FP8 = true; static constexpr int SCALE_A = F8E_ACT, SCALE_B = F8E_WGU; const bf16_t* A; const bf16_t* Bt; int lda, ldb;
    __device__ __forceinline__ int nt(const Unit&) const { return lda / 64; }
    __device__ __forceinline__ const char* a_base(const Unit& u) const { return (const char*)A + (size_t)u.pm * 256 * lda * 2; }
    __device__ __forceinline__ const char* b_base(const Unit& u) const { return (const char*)Bt + (size_t)u.pn * 256 * ldb * 2; }
    __device__ __forceinline__ void a_tok(const Unit&, const int (&)[2], int (&)[2][2]) const {}
    __device__ __forceinline__ void a_off(const int (&)[2][2], const int (&)[2], unsigned (&)[2][2]) const {}
    __device__ __forceinline__ void a_rows(const Unit&, const int (&)[2], const int (&)[2], unsigned (&)[2][2]) const {}
};
struct ProbBranch {
    static constexpr bool GATHER = false, FP8 = false; static constexpr int SCALE_A = 127, SCALE_B = 127; const bf16_t* A; const bf16_t* Bt; int lda, ldb;
    __device__ __forceinline__ int nt(const Unit& u) const { return u.sub == 1 ? 8 : 4; }
    __device__ __forceinline__ int koff(const Unit& u) const { return u.sub == 0 ? 0 : (u.sub == 1 ? 256 : 768); }
    __device__ __forceinline__ const char* a_base(const Unit& u) const { return (const char*)A + ((size_t)u.pm * 256 * lda + koff(u)) * 2; }
    __device__ __forceinline__ const char* b_base(const Unit& u) const { return (const char*)Bt + ((size_t)u.pn * 256 * ldb + koff(u)) * 2; }
    __device__ __forceinline__ void a_tok(const Unit&, const int (&)[2], int (&)[2][2]) const {}
    __device__ __forceinline__ void a_off(const int (&)[2][2], const int (&)[2], unsigned (&)[2][2]) const {}
    __device__ __forceinline__ void a_rows(const Unit&, const int (&)[2], const int (&)[2], unsigned (&)[2][2]) const {}
};
__device__ __forceinline__ int expert_of(const LAS int* seg, int pm) { return __builtin_amdgcn_readfirstlane((int)((const LAS unsigned char*)(seg + 64))[pm]); }
__device__ __forceinline__ int moe_tables(Frame& F, LAS int* seg) {
    __syncthreads();
    if (F.tid <= NEXP) seg[F.tid] = ((const int*)(F.ws + WS_ROUTE + RT_SEG))[F.tid];
    __syncthreads();
    const int ntile = seg[NEXP] / 256;
    LAS unsigned char* texp = (LAS unsigned char*)(seg + 64);
    for (int t = F.tid; t < ntile; t += NTHREADS) { const int row = t * 256; int e = 0;
#pragma unroll
        for (int i = 1; i < NEXP; ++i) e += (seg[i] <= row) ? 1 : 0;
        texp[t] = (unsigned char)e; }
    __syncthreads();
    return ntile;
}
struct ProbMoe1 {
    static constexpr bool GATHER = true, FP8 = true; static constexpr int SCALE_A = F8E_ACT, SCALE_B = F8E_WGU; const bf16_t* A; const bf16_t* Bt; int lda, ldb; const int* tok; const LAS int* seg;
    __device__ __forceinline__ int nt(const Unit&) const { return lda / 64; }
    __device__ __forceinline__ const char* a_base(const Unit&) const { return (const char*)A; }
    __device__ __forceinline__ const char* b_base(const Unit& u) const { const int e = expert_of(seg, u.pm); return (const char*)Bt + ((size_t)e * 2048 + (size_t)u.pn * 256) * ldb * 2; }
    __device__ __forceinline__ void a_rows(const Unit& u, const int (&R)[2], const int (&C)[2], unsigned (&off)[2][2]) const {
#pragma unroll
        for (int h = 0; h < 2; ++h)
#pragma unroll
            for (int i = 0; i < 2; ++i) { const int t = tok[u.pm * 256 + h * 128 + R[i]]; off[h][i] = (unsigned)(t * lda + C[i]) * 2u; } }
    __device__ __forceinline__ void a_tok(const Unit& u, const int (&R)[2], int (&tk)[2][2]) const {
#pragma unroll
        for (int h = 0; h < 2; ++h)
#pragma unroll
            for (int i = 0; i < 2; ++i) tk[h][i] = tok[u.pm * 256 + h * 128 + R[i]]; }
    __device__ __forceinline__ void a_off(const int (&tk)[2][2], const int (&C)[2], unsigned (&off)[2][2]) const {
#pragma unroll
        for (int h = 0; h < 2; ++h)
#pragma unroll
            for (int i = 0; i < 2; ++i) off[h][i] = (unsigned)(tk[h][i] * lda + C[i]) * 2u; }
};
struct ProbMoe2 {
    static constexpr bool GATHER = false, FP8 = true; static constexpr int SCALE_A = F8E_ACT, SCALE_B = F8E_WDN; const bf16_t* A; const bf16_t* Bt; int lda, ldb; const LAS int* seg;
    __device__ __forceinline__ int nt(const Unit&) const { return lda / 64; }
    __device__ __forceinline__ const char* a_base(const Unit& u) const { return (const char*)A + (size_t)u.pm * 256 * lda * 2; }
    __device__ __forceinline__ const char* b_base(const Unit& u) const { const int e = expert_of(seg, u.pm); return (const char*)Bt + ((size_t)e * 1024 + (size_t)u.pn * 256) * ldb * 2; }
    __device__ __forceinline__ void a_tok(const Unit&, const int (&)[2], int (&)[2][2]) const {}
    __device__ __forceinline__ void a_off(const int (&)[2][2], const int (&)[2], unsigned (&)[2][2]) const {}
    __device__ __forceinline__ void a_rows(const Unit&, const int (&)[2], const int (&)[2], unsigned (&)[2][2]) const {}
};
using pg8::cvt_pk_bf16;
template <bool G8> struct EpiInproj {
    static constexpr bool PERM = true, CHAIN = false, SIDE = true, KHOOK = false; bf16_t* Z; const float* bias; int pn0;
    __device__ __forceinline__ void side(const Unit& u0, unsigned slot, int wid, int lane) const { const int pn = u0.pn + pn0; if (wid == 1) pg8::dma16((unsigned)lane * 16u, bias + pn * 256 + (pn >= 9 ? 16 : 0), slot); }
    __device__ __forceinline__ void operator()(const f32x4 (&acc)[2][2][4][2], const Unit& u0, int wr, int wc, int fr, int fq, const LAS unsigned char* sd) const {
        Unit u = u0; u.pn += pn0;
        int row0 = u.pm * 256 + wr * 64 + fr, col0 = u.pn * 256 + wc * 32 + 8 * fq; asm volatile("" : "+v"(row0), "+v"(col0));
        const int act = (u.pn <= 6) ? 0 : ((u.pn == 9 || u.pn == 10) ? 2 : 1);
        f32x4 bv[2][2];
#pragma unroll
        for (int bj = 0; bj < 2; ++bj)
#pragma unroll
            for (int n = 0; n < 2; ++n) bv[bj][n] = *(const LAS f32x4*)(sd + (bj * 128 + wc * 32 + 8 * fq + 4 * n) * 4);
#pragma unroll
        for (int ai = 0; ai < 2; ++ai)
#pragma unroll
            for (int m = 0; m < 4; ++m) { bf16_t* rowp = Z + (size_t)(row0 + ai * 128 + m * 16) * NZ + col0;
#pragma unroll
                for (int bj = 0; bj < 2; ++bj) { f32x4 v0, v1;
                    if constexpr (G8) { v0 = acc[ai][bj][m][0] * F8_DESCALE + bv[bj][0]; v1 = acc[ai][bj][m][1] * F8_DESCALE + bv[bj][1]; } else { v0 = acc[ai][bj][m][0] + bv[bj][0]; v1 = acc[ai][bj][m][1] + bv[bj][1]; }
                    if (G8 && u.pn >= ZG_COL / 256) { u32x2 w8;
                        v0 = sigmoid4(v0) * G8_SCALE; v1 = sigmoid4(v1) * G8_SCALE;
#pragma unroll
                        for (int j = 0; j < 4; ++j) { v0[j] = fmaxf(v0[j], 1.0f); v1[j] = fmaxf(v1[j], 1.0f); }
                        v0 = v0 + 12582912.0f; v1 = v1 + 12582912.0f;
                        w8.x = pk4_u8(v0[0], v0[1], v0[2], v0[3]); w8.y = pk4_u8(v1[0], v1[1], v1[2], v1[3]);
                        *(u32x2*)((unsigned char*)(Z + (size_t)(row0 + ai * 128 + m * 16) * NZ + ZG_COL) + (col0 - ZG_COL) + bj * 128) = w8; continue; }
                    if (act == 2) { f32x2 a = pg8::gelu_pk((f32x2){v0[0], v0[1]}), b = pg8::gelu_pk((f32x2){v0[2], v0[3]}), c = pg8::gelu_pk((f32x2){v1[0], v1[1]}), d = pg8::gelu_pk((f32x2){v1[2], v1[3]});
                        v0 = (f32x4){a.x, a.y, b.x, b.y}; v1 = (f32x4){c.x, c.y, d.x, d.y}; }
                    if (act == 1) { v0 = sigmoid4(v0); v1 = sigmoid4(v1); }
                    u32x4 w; w.x = cvt_pk_bf16(v0[0], v0[1]); w.y = cvt_pk_bf16(v0[2], v0[3]); w.z = cvt_pk_bf16(v1[0], v1[1]); w.w = cvt_pk_bf16(v1[2], v1[3]);
                    *(u32x4*)(rowp + bj * 128) = w; }
                if constexpr (G8) asm volatile("" ::: "memory"); }
    }
};
struct EpiNull {
    static constexpr bool PERM = true, CHAIN = false; bf16_t* Z;
    __device__ __forceinline__ void operator()(const f32x4 (&acc)[2][2][4][2], const Unit& u, int wr, int wc, int fr, int fq) const {
        float sacc = 0.f;
#pragma unroll
        for (int ai = 0; ai < 2; ++ai)
#pragma unroll
            for (int bj = 0; bj < 2; ++bj)
#pragma unroll
                for (int m = 0; m < 4; ++m)
#pragma unroll
                    for (int n = 0; n < 2; ++n) sacc += (acc[ai][bj][m][n][0] + acc[ai][bj][m][n][1]) + (acc[ai][bj][m][n][2] + acc[ai][bj][m][n][3]);
        if (sacc == 1.2345e30f) Z[u.pm + wr + wc + fr + fq] = 0;
    }
};
struct EpiOut {
    static constexpr bool PERM = true, CHAIN = false, SIDE = false, KHOOK = false; bf16_t* T;
    __device__ __forceinline__ void operator()(const f32x4 (&acc)[2][2][4][2], const Unit& u, int wr, int wc, int fr, int fq, const LAS unsigned char*) const {
        int row0 = u.pm * 256 + wr * 64 + fr, col0 = u.pn * 256 + wc * 32 + 8 * fq; asm volatile("" : "+v"(row0), "+v"(col0));
#pragma unroll
        for (int ai = 0; ai < 2; ++ai)
#pragma unroll
            for (int m = 0; m < 4; ++m) { bf16_t* rowp = T + (size_t)(row0 + ai * 128 + m * 16) * D + col0;
#pragma unroll
                for (int bj = 0; bj < 2; ++bj) { const f32x4 v0 = acc[ai][bj][m][0], v1 = acc[ai][bj][m][1];
                    u32x4 w; w.x = cvt_pk_bf16(v0[0], v0[1]); w.y = cvt_pk_bf16(v0[2], v0[3]); w.z = cvt_pk_bf16(v1[0], v1[1]); w.w = cvt_pk_bf16(v1[2], v1[3]);
                    *(u32x4*)(rowp + bj * 128) = w; } }
    }
};
struct EpiBranch {
    static constexpr bool PERM = true, CHAIN = false, SIDE = false, KHOOK = true; static constexpr int HOOK_T0 = 4, HOOK_T1 = 12;
    const bf16_t* Z; bf16_t* Y;
    template <bool FIN> __device__ __forceinline__ void apply(f32x4 (&acc)[2][2][4][2], const Unit& u, int br, int wr, int wc, int fr, int fq) const {
        int row0 = u.pm * 256 + wr * 64 + fr, col0 = u.pn * 256 + wc * 32 + 8 * fq;
        asm volatile("" : "+v"(row0), "+v"(col0));
#pragma unroll
        for (int ai = 0; ai < 2; ++ai) {
            u32x2 ga[4][2], gb[4][2];
#pragma unroll
            for (int m = 0; m < 4; ++m) { const unsigned char* rowp = (const unsigned char*)(Z + (size_t)(row0 + ai * 128 + m * 16) * NZ + ZG_COL) + br * 1024 + col0;
#pragma unroll
                for (int bj = 0; bj < 2; ++bj) { ga[m][bj] = *(const u32x2*)(rowp + bj * 128); if (!FIN) gb[m][bj] = *(const u32x2*)(rowp + 1024 + bj * 128); } }
#pragma unroll
            for (int m = 0; m < 4; ++m) { const size_t row = (size_t)(row0 + ai * 128 + m * 16);
#pragma unroll
                for (int bj = 0; bj < 2; ++bj) { const u32x2 a = ga[m][bj];
                    f32x4 r0 = u8x4_f32(a.x), r1 = u8x4_f32(a.y);
                    if (FIN) { r0 = r0 * (1.0f / G8_SCALE); r1 = r1 * (1.0f / G8_SCALE); }
                    else { const u32x2 b = gb[m][bj]; f32x4 q0 = u8x4_f32(b.x), q1 = u8x4_f32(b.y);
#pragma unroll
                        for (int i = 0; i < 4; ++i) { q0[i] = __builtin_amdgcn_rcpf(q0[i]); q1[i] = __builtin_amdgcn_rcpf(q1[i]); }
                        r0 = r0 * q0; r1 = r1 * q1; }
                    acc[ai][bj][m][0] = acc[ai][bj][m][0] * r0; acc[ai][bj][m][1] = acc[ai][bj][m][1] * r1;
                    if (FIN) { const f32x4 v0 = acc[ai][bj][m][0], v1 = acc[ai][bj][m][1];
                        u32x4 w; w.x = cvt_pk_bf16(v0[0], v0[1]); w.y = cvt_pk_bf16(v0[2], v0[3]); w.z = cvt_pk_bf16(v1[0], v1[1]); w.w = cvt_pk_bf16(v1[2], v1[3]);
                        *(u32x4*)(Y + row * D + col0 + bj * 128) = w; } } }
            asm volatile("" ::: "memory"); }
    }
    __device__ __forceinline__ void hook(f32x4 (&acc)[2][2][4][2], const Unit& u, int br, int wr, int wc, int fr, int fq) const { apply<false>(acc, u, br, wr, wc, fr, fq); }
    __device__ __forceinline__ void operator()(f32x4 (&acc)[2][2][4][2], const Unit& u, int wr, int wc, int fr, int fq, const LAS unsigned char*) const { apply<true>(acc, u, 2, wr, wc, fr, fq); }
};
struct EpiSwiglu {
    static constexpr bool PERM = true, CHAIN = false, SIDE = true, KHOOK = false; unsigned char* HID; const float* bgu; const LAS int* seg;
    __device__ __forceinline__ void side(const Unit& u, unsigned slot, int wid, int lane) const {
        if (wid == 1) { const int e = expert_of(seg, u.pm); pg8::dma16(lane < 32 ? (unsigned)lane * 16u : 4096u + (unsigned)(lane - 32) * 16u, bgu + (size_t)e * 2048 + u.pn * 128, slot); } }
    __device__ __forceinline__ void operator()(const f32x4 (&acc)[2][2][4][2], const Unit& u, int wr, int wc, int fr, int fq, const LAS unsigned char* sd) const {
        int j0 = u.pn * 128 + wc * 32 + 8 * fq, slot0 = u.pm * 256 + wr * 64 + fr; asm volatile("" : "+v"(j0), "+v"(slot0));
        f32x4 bg[2], bu[2];
#pragma unroll
        for (int n = 0; n < 2; ++n) { bg[n] = *(const LAS f32x4*)(sd + (wc * 32 + 8 * fq + 4 * n) * 4); bu[n] = *(const LAS f32x4*)(sd + (128 + wc * 32 + 8 * fq + 4 * n) * 4); }
#pragma unroll
        for (int ai = 0; ai < 2; ++ai)
#pragma unroll
            for (int m = 0; m < 4; ++m) { const size_t slot = (size_t)(slot0 + ai * 128 + m * 16); f32x4 o[2];
#pragma unroll
                for (int n = 0; n < 2; ++n) { f32x4 g = acc[ai][0][m][n] * F8_DESCALE + bg[n], up = acc[ai][1][m][n] * F8_DESCALE + bu[n];
#pragma unroll
                    for (int i = 0; i < 4; ++i) { g[i] = fminf(g[i], 7.0f); up[i] = __builtin_amdgcn_fmed3f(up[i], -7.0f, 7.0f); }
                    f32x4 t = g * (-1.702f * 1.4426950408889634f);
#pragma unroll
                    for (int i = 0; i < 4; ++i) t[i] = __builtin_amdgcn_exp2f(t[i]);
                    t = t + 1.0f;
#pragma unroll
                    for (int i = 0; i < 4; ++i) t[i] = __builtin_amdgcn_rcpf(t[i]);
                    o[n] = (up * F8S_ACT + F8S_ACT) * (g * t); }
                u32x2 w; w.x = pk4_fp8(o[0][0], o[0][1], o[0][2], o[0][3]); w.y = pk4_fp8(o[1][0], o[1][1], o[1][2], o[1][3]);
                *(u32x2*)(HID + slot * 1024 + j0) = w; }
    }
};
struct EpiDown {
    static constexpr bool PERM = true, CHAIN = false, SIDE = true, KHOOK = false; unsigned char* FS; const float* bdn; const int* dest; const float* pslot; const LAS int* seg;
    __device__ __forceinline__ void side(const Unit& u, unsigned slot, int wid, int lane) const {
        if (wid == 1) { const int e = expert_of(seg, u.pm); pg8::dma16((unsigned)lane * 16u, bdn + (size_t)e * 1024 + u.pn * 256, slot); }
        if (wid == 2) pg8::dma16((unsigned)lane * 16u, dest + (size_t)u.pm * 256, slot + 1024u);
        if (wid == 3) pg8::dma16((unsigned)lane * 16u, pslot + (size_t)u.pm * 256, slot + 2048u); }
    __device__ __forceinline__ void operator()(const f32x4 (&acc)[2][2][4][2], const Unit& u, int wr, int wc, int fr, int fq, const LAS unsigned char* sd) const {
        int col0 = u.pn * 256 + wc * 32 + 8 * fq, slot0 = u.pm * 256 + wr * 64 + fr; asm volatile("" : "+v"(col0), "+v"(slot0));
        f32x4 bv[2][2];
#pragma unroll
        for (int bj = 0; bj < 2; ++bj)
#pragma unroll
            for (int n = 0; n < 2; ++n) bv[bj][n] = *(const LAS f32x4*)(sd + (bj * 128 + wc * 32 + 8 * fq + 4 * n) * 4);
#pragma unroll
        for (int ai = 0; ai < 2; ++ai)
#pragma unroll
            for (int m = 0; m < 4; ++m) { const int rt = ai * 128 + wr * 64 + m * 16 + fr; const int d = *(const LAS int*)(sd + 1024 + rt * 4); const float p = *(const LAS float*)(sd + 2048 + rt * 4) * FS_SCALE;
                if (d >= 0) {
#pragma unroll
                    for (int bj = 0; bj < 2; ++bj) { f32x4 v0 = (acc[ai][bj][m][0] * F8_DESCALE + bv[bj][0]) * p, v1 = (acc[ai][bj][m][1] * F8_DESCALE + bv[bj][1]) * p;
#pragma unroll
                        for (int i = 0; i < 4; ++i) { v0[i] = __builtin_amdgcn_fmed3f(v0[i], -FS_CLAMP, FS_CLAMP); v1[i] = __builtin_amdgcn_fmed3f(v1[i], -FS_CLAMP, FS_CLAMP); }
                        u32x2 w; w.x = pk4_fp8(v0[0], v0[1], v0[2], v0[3]); w.y = pk4_fp8(v1[0], v1[1], v1[2], v1[3]);
                        *(u32x2*)(FS + (size_t)d * 1024 + col0 + bj * 128) = w; } }
                asm volatile("" ::: "memory"); }
    }
};

__device__ __forceinline__ const float* xin_row(const Frame& F, int row) { return row < ML ? F.in[IN_X] + (size_t)row * D : F.in[IN_CTX] + (size_t)(row - ML) * D; }
__device__ __forceinline__ void phase_ln0_first(Frame& F) {
    int t_lo, t_hi; tile_range(F, MT, t_lo, t_hi);
    const int r_lo = 32 * t_lo, nrows = 32 * (t_hi - t_lo);
    const int mrA = mod_row(r_lo), mrB = mod_row(r_lo + (nrows > 0 ? nrows - 1 : 0));
    { const float* mb = (const float*)(F.ws + WS_MOD); pv_fill(F, 0, mb + ((size_t)(0 * 17 + mrA) * 6 + 0) * 1024); pv_fill(F, 1, mb + ((size_t)(0 * 17 + mrB) * 6 + 0) * 1024);
      pv_fill(F, 2, mb + ((size_t)(0 * 17 + mrA) * 6 + 1) * 1024); pv_fill(F, 3, mb + ((size_t)(0 * 17 + mrB) * 6 + 1) * 1024); }
    load_wg_lds(F, 0);
    for (int n = F.wave; n < nrows; n += 4 * NWAVES) {
        RowV rv[4];
#pragma unroll
        for (int u = 0; u < 4; ++u) if (n + u * NWAVES < nrows) row_load(rv[u], xin_row(F, r_lo + n + u * NWAVES), F.lane);
#pragma unroll
        for (int u = 0; u < 4; ++u) if (n + u * NWAVES < nrows) { const int row = r_lo + n + u * NWAVES;
            const int sel = (mod_row(row) == mrA) ? 0 : 1; ln0_row(F, row, rv[u], pv_slot(F, 0 + sel), pv_slot(F, 2 + sel)); }
    }
    gates_tail(F, 0, t_lo, t_hi);
    __syncthreads();
}
__device__ __forceinline__ void phase_finalize(Frame& F, int l, int mrows) {
    const int gw = F.bid * NWAVES + F.wave, NGW = F.G * NWAVES;
    const bf16_t* hf = (const bf16_t*)(F.ws + WS_HFB); const bf16_t* hb = hf + (size_t)MT * 512;
    const float* ng = F.in[IN_MNG] + l * 512 + 8 * F.lane;
    const f32x4 g0 = *(const f32x4*)ng, g1 = *(const f32x4*)(ng + 4);
    const bf16_t* zo = (const bf16_t*)(F.ws + WS_Z) + ZC_O + 8 * F.lane;
    u32x4 ha = (u32x4){0u, 0u, 0u, 0u}, hbv = ha, so = ha;
    if (gw < mrows) { ha = __builtin_nontemporal_load((const u32x4*)(hf + (size_t)gw * 512 + 8 * F.lane)); hbv = __builtin_nontemporal_load((const u32x4*)(hb + (size_t)gw * 512 + 8 * F.lane)); so = __builtin_nontemporal_load((const u32x4*)(zo + (size_t)gw * NZ)); }
    for (int row = gw; row < mrows; row += NGW) {
        u32x4 han = ha, hbn = hbv, son = so; const int rn = row + NGW;
        if (rn < mrows) { han = __builtin_nontemporal_load((const u32x4*)(hf + (size_t)rn * 512 + 8 * F.lane)); hbn = __builtin_nontemporal_load((const u32x4*)(hb + (size_t)rn * 512 + 8 * F.lane)); son = __builtin_nontemporal_load((const u32x4*)(zo + (size_t)rn * NZ)); }
        __builtin_amdgcn_sched_barrier(0);
        f32x4 v0 = (f32x4){bflo(ha.x) + bflo(hbv.x), bfhi(ha.x) + bfhi(hbv.x), bflo(ha.y) + bflo(hbv.y), bfhi(ha.y) + bfhi(hbv.y)}, v1 = (f32x4){bflo(ha.z) + bflo(hbv.z), bfhi(ha.z) + bfhi(hbv.z), bflo(ha.w) + bflo(hbv.w), bfhi(ha.w) + bfhi(hbv.w)};
        float s = (v0.x + v0.y) + (v0.z + v0.w) + (v1.x + v1.y) + (v1.z + v1.w);
#pragma unroll
        for (int o = 0; o < 1; ++o) s = row16_sum(s);
        const float mu = s * (1.f / 128.f); v0 = v0 - mu; v1 = v1 - mu;
        float q = (v0.x * v0.x + v0.y * v0.y) + (v0.z * v0.z + v0.w * v0.w) + (v1.x * v1.x + v1.y * v1.y) + (v1.z * v1.z + v1.w * v1.w);
#pragma unroll
        for (int o = 0; o < 1; ++o) q = row16_sum(q);
        const float rstd = __builtin_amdgcn_rsqf(q * (1.f / 128.f) + HEAD_EPS);
        v0 = v0 * rstd * g0; v1 = v1 * rstd * g1;
        u32x4 w; w.x = pk2(v0.x * bflo(so.x), v0.y * bfhi(so.x)); w.y = pk2(v0.z * bflo(so.y), v0.w * bfhi(so.y)); w.z = pk2(v1.x * bflo(so.z), v1.y * bfhi(so.z)); w.w = pk2(v1.z * bflo(so.w), v1.w * bfhi(so.w));
        *(u32x4*)((bf16_t*)(F.ws + WS_BRA) + (size_t)row * D + 256 + 8 * F.lane) = w;
        ha = han; hbv = hbn; so = son;
    }
}
__device__ __forceinline__ void phase_ln1_router(Frame& F, int l, int mrows) {
    LAS int* cnt = (LAS int*)(F.lds + NW_END);
    { const float* wr = F.in[IN_WR] + (size_t)l * D * NEXP;
      for (int i = F.tid; i < NEXP * D; i += NTHREADS) { const int k = i >> 5, e = i & 31; *(LAS bf16_t*)(F.lds + NW_WT + e * 2064 + k * 2) = (bf16_t)f2bf(wr[i]); }
      if (F.tid < NEXP) cnt[F.tid] = 0; }
    const float* brt = F.in[IN_BR] + l * NEXP;
    int t_lo, t_hi; tile_range(F, mrows, t_lo, t_hi);
    const int r_lo = 32 * t_lo, nrows = 32 * (t_hi - t_lo);
    const int mrA = mod_row(r_lo), mrB = mod_row(r_lo + (nrows > 0 ? nrows - 1 : 0));
    { const float* mb = (const float*)(F.ws + WS_MOD); pv_fill(F, 0, F.in[IN_LN1G] + l * D); pv_fill(F, 1, F.in[IN_LN1B] + l * D);
      pv_fill(F, 2, mb + ((size_t)(l * 17 + mrA) * 6 + 2) * 1024); pv_fill(F, 3, mb + ((size_t)(l * 17 + mrB) * 6 + 2) * 1024);
      pv_fill(F, 4, mb + ((size_t)(l * 17 + mrA) * 6 + 3) * 1024); pv_fill(F, 5, mb + ((size_t)(l * 17 + mrB) * 6 + 3) * 1024);
      pv_fill(F, 6, mb + ((size_t)(l * 17 + mrA) * 6 + 4) * 1024); pv_fill(F, 7, mb + ((size_t)(l * 17 + mrB) * 6 + 4) * 1024); }
    __syncthreads();
    { const bf16_t* yb = (const bf16_t*)(F.ws + WS_T) + 8 * F.lane;
      RowV rv[2]; u32x4 yv2[2][2];
#pragma unroll
      for (int u = 0; u < 2; ++u) {
#pragma unroll
          for (int j = 0; j < 4; ++j) rv[u].v[j] = (f32x4){0.f, 0.f, 0.f, 0.f};
          yv2[u][0] = yv2[u][1] = (u32x4){0u, 0u, 0u, 0u}; }
#define RT_LOADPAIR(n_, rv_, yv_) do { _Pragma("unroll") for (int u = 0; u < 2; ++u) if ((n_) + u * NWAVES < nrows) { const int row = r_lo + (n_) + u * NWAVES; \
              if (l == 0) row_load(rv_[u], xin_row(F, row), F.lane); else row_load_bf16(rv_[u], (const bf16_t*)(F.ws + WS_X) + (size_t)row * D, F.lane); \
              _Pragma("unroll") for (int h = 0; h < 2; ++h) yv_[u][h] = __builtin_nontemporal_load((const u32x4*)(yb + (size_t)row * D + 512 * h)); } } while (0)
      RT_LOADPAIR(F.wave, rv, yv2);
      for (int n = F.wave; n < nrows; n += 2 * NWAVES) {
          RowV rvn[2]; u32x4 yvn[2][2];
#pragma unroll
          for (int u = 0; u < 2; ++u) { rvn[u] = rv[u]; yvn[u][0] = yv2[u][0]; yvn[u][1] = yv2[u][1]; }
          RT_LOADPAIR(n + 2 * NWAVES, rvn, yvn);
          __builtin_amdgcn_sched_barrier(0);
#pragma unroll
          for (int u = 0; u < 2; ++u) if (n + u * NWAVES < nrows) { const int row = r_lo + n + u * NWAVES; RowV cur = rv[u];
              const int sel = (mod_row(row) == mrA) ? 0 : 1;
              { const LAS float* g1 = pv_slot(F, 2 + sel);
#pragma unroll
                for (int j = 0; j < 4; ++j) { const f32x4 gg = *(const LAS f32x4*)(g1 + RC(F.lane, j)); const u32x4 yw = yv2[u][j >> 1]; const f32x4 yv = (j & 1) ? (f32x4){bflo(yw.z), bfhi(yw.z), bflo(yw.w), bfhi(yw.w)} : (f32x4){bflo(yw.x), bfhi(yw.x), bflo(yw.y), bfhi(yw.y)}; cur.v[j] = cur.v[j] * DN_ALPHA + gg * yv; } }
              row_ln_plain(cur, F.lane); row_affine_l(cur, pv_slot(F, 0), pv_slot(F, 1), F.lane);
              row_store_bf16_nt(cur, (bf16_t*)(F.ws + WS_X) + (size_t)row * D, F.lane);
              row_ln_plain(cur, F.lane); row_modulate_l(cur, pv_slot(F, 4 + sel), pv_slot(F, 6 + sel), F.lane);
              row_store_bf16(cur, (bf16_t*)(F.ws + WS_H2) + (size_t)row * D, F.lane);
              { unsigned char* h8 = (unsigned char*)(F.ws + WS_H2F8) + (size_t)row * D + 8 * F.lane;
#pragma unroll
                for (int h = 0; h < 2; ++h) { u32x2 w; w.x = pk4_fp8(cur.v[2 * h].x * F8S_ACT, cur.v[2 * h].y * F8S_ACT, cur.v[2 * h].z * F8S_ACT, cur.v[2 * h].w * F8S_ACT); w.y = pk4_fp8(cur.v[2 * h + 1].x * F8S_ACT, cur.v[2 * h + 1].y * F8S_ACT, cur.v[2 * h + 1].z * F8S_ACT, cur.v[2 * h + 1].w * F8S_ACT); *(u32x2*)(h8 + 512 * h) = w; } } }
#pragma unroll
          for (int u = 0; u < 2; ++u) { rv[u] = rvn[u]; yv2[u][0] = yvn[u][0]; yv2[u][1] = yvn[u][1]; }
      }
#undef RT_LOADPAIR
    }
    asm volatile("s_waitcnt vmcnt(0)" ::: "memory"); __syncthreads();
    for (int tile = t_lo + F.wave; tile < t_hi; tile += NWAVES) {
        const LAS float* lgw = narrow_tile_wave(F, (const bf16_t*)(F.ws + WS_H2) + (size_t)tile * 32 * D);
        if (F.lane < 32) {
            const LAS float* lgp = lgw + F.lane * 33; const int row = tile * 32 + F.lane;
            float lg[NEXP];
#pragma unroll
            for (int e = 0; e < NEXP; ++e) lg[e] = lgp[e] + brt[e];
            unsigned used = 0u; float bv[4]; int bi[4];
#pragma unroll
            for (int k = 0; k < 4; ++k) { float best = -3.0e38f; int idx = 0;
#pragma unroll
                for (int e = 0; e < NEXP; ++e) { const bool take = (((used >> e) & 1u) == 0u) && (lg[e] > best); best = take ? lg[e] : best; idx = take ? e : idx; }
                used |= 1u << idx; bv[k] = best; bi[k] = idx; }
            const float e1 = __expf(bv[1] - bv[0]), e2 = __expf(bv[2] - bv[0]), e3 = __expf(bv[3] - bv[0]); const float inv = __builtin_amdgcn_rcpf(1.0f + e1 + e2 + e3);
            int* ei = (int*)(F.ws + WS_ROUTE + RT_EIDX) + (size_t)row * 4; float* pr = (float*)(F.ws + WS_ROUTE + RT_PROB) + (size_t)row * 4;
            *(int4*)ei = make_int4(bi[0], bi[1], bi[2], bi[3]); *(f32x4*)pr = (f32x4){inv, e1 * inv, e2 * inv, e3 * inv};
            atomicAdd((int*)&cnt[bi[0]], 1); atomicAdd((int*)&cnt[bi[1]], 1); atomicAdd((int*)&cnt[bi[2]], 1); atomicAdd((int*)&cnt[bi[3]], 1);
        }
        asm volatile("s_waitcnt lgkmcnt(0)" ::: "memory");
    }
    __syncthreads();
    if (F.tid < NEXP) ((int*)(F.ws + WS_ROUTE + RT_CNT))[F.bid * NEXP + F.tid] = cnt[F.tid];
    __syncthreads();
}
__device__ __forceinline__ void phase_slots(Frame& F, int mrows) {
    LAS int* part = (LAS int*)F.lds;
    LAS int* pre = part + 1024;
    LAS int* tot = pre + 32;
    LAS int* seg = tot + 32;
    LAS int* gcnt = seg + 64;
    LAS int* eix = gcnt + 2048;
    LAS int* rnk = eix + 4096;
    const int* cntg = (const int*)(F.ws + WS_ROUTE + RT_CNT);
    int* tokg = (int*)(F.ws + WS_ROUTE + RT_TOK); int* destg = (int*)(F.ws + WS_ROUTE + RT_DEST); float* psl = (float*)(F.ws + WS_ROUTE + RT_PSLOT);
    int t_lo, t_hi; tile_range(F, mrows, t_lo, t_hi);
    const int row_base = t_lo * 32, nent = (t_hi - t_lo) * 128, ngrp = nent / 64;
    { const int e = F.tid & 31, pt = F.tid >> 5; int a = 0, b = 0;
      for (int c = pt; c < F.G; c += 16) { const int v = cntg[c * NEXP + e]; b += v; a += (c < F.bid) ? v : 0; }
      part[pt * 32 + e] = a; part[512 + pt * 32 + e] = b; }
    for (int i = F.tid; i < nent; i += NTHREADS) eix[i] = ((const int*)(F.ws + WS_ROUTE + RT_EIDX))[(size_t)row_base * 4 + i];
    __syncthreads();
    if (F.tid < NEXP) { int a = 0, b = 0;
#pragma unroll
        for (int pt = 0; pt < 16; ++pt) { a += part[pt * 32 + F.tid]; b += part[512 + pt * 32 + F.tid]; }
        pre[F.tid] = a; tot[F.tid] = b; }
    for (int g = F.wave; g < ngrp; g += NWAVES) {
        const int e = eix[g * 64 + F.lane]; int rank = 0, mycnt = 0;
#pragma unroll 4
        for (int ee = 0; ee < NEXP; ++ee) { const unsigned long long m = __ballot(e == ee); if (e == ee) rank = __popcll(m & ((1ull << F.lane) - 1ull)); if (F.lane == ee) mycnt = __popcll(m); }
        rnk[g * 64 + F.lane] = rank; if (F.lane < NEXP) gcnt[g * 32 + F.lane] = mycnt; }
    __syncthreads();
    if (F.tid == 0) { int s = 0; for (int e = 0; e < NEXP; ++e) { seg[e] = s; s += (tot[e] + 255) & ~255; } seg[NEXP] = s; }
    if (F.tid >= 64 && F.tid < 64 + NEXP) { const int e = F.tid - 64; int run = 0; for (int g = 0; g < ngrp; ++g) { const int c = gcnt[g * 32 + e]; gcnt[g * 32 + e] = run; run += c; } }
    __syncthreads();
    { const float* prg = (const float*)(F.ws + WS_ROUTE + RT_PROB) + (size_t)row_base * 4;
      for (int i = F.tid; i < nent; i += NTHREADS) { const int e = eix[i]; const int slot = seg[e] + pre[e] + gcnt[(i >> 6) * 32 + e] + rnk[i];
          tokg[slot] = row_base + (i >> 2); destg[slot] = row_base * 4 + i; psl[slot] = prg[i]; } }
    if (F.bid < NEXP) { const int e = F.bid; for (int sl = seg[e] + tot[e] + F.tid; sl < seg[e + 1]; sl += NTHREADS) { tokg[sl] = 0; destg[sl] = -1; psl[sl] = 0.f; } }
    if (F.bid == 0 && F.tid <= NEXP) ((int*)(F.ws + WS_ROUTE + RT_SEG))[F.tid] = seg[F.tid];
    __syncthreads();
}
struct CombRaw { u32x4 x[2]; u32x2 f[2][4]; };
__device__ __forceinline__ void comb_load(const Frame& F, int row, CombRaw& r) {
    { const bf16_t* xp = (const bf16_t*)(F.ws + WS_X) + (size_t)row * D + 8 * F.lane;
#pragma unroll
      for (int h = 0; h < 2; ++h) r.x[h] = __builtin_nontemporal_load((const u32x4*)(xp + 512 * h)); }
    const unsigned char* fs = (const unsigned char*)(F.ws + WS_FS) + (size_t)row * 4 * 1024 + 8 * F.lane;
#pragma unroll
    for (int h = 0; h < 2; ++h)
#pragma unroll
        for (int k = 0; k < 4; ++k) r.f[h][k] = __builtin_nontemporal_load((const u32x2*)(fs + k * 1024 + 512 * h));
}
__device__ __forceinline__ void phase_combine_ln2(Frame& F, int l, int mrows) {
    const bool lastl = (l == DEPTH - 1);
    int t_lo, t_hi; tile_range(F, mrows, t_lo, t_hi);
    const int r_lo = 32 * t_lo, nrows = 32 * (t_hi - t_lo);
    const int mrA = mod_row(r_lo), mrB = mod_row(r_lo + (nrows > 0 ? nrows - 1 : 0));
    { const float* mb = (const float*)(F.ws + WS_MOD); const int ln = lastl ? l : l + 1; pv_fill(F, 0, F.in[IN_LN2G] + l * D); pv_fill(F, 1, F.in[IN_LN2B] + l * D);
      pv_fill(F, 2, mb + ((size_t)(l * 17 + mrA) * 6 + 5) * 1024); pv_fill(F, 3, mb + ((size_t)(l * 17 + mrB) * 6 + 5) * 1024);
      pv_fill(F, 4, mb + ((size_t)(ln * 17 + mrA) * 6 + 0) * 1024); pv_fill(F, 5, mb + ((size_t)(ln * 17 + mrB) * 6 + 0) * 1024);
      pv_fill(F, 6, mb + ((size_t)(ln * 17 + mrA) * 6 + 1) * 1024); pv_fill(F, 7, mb + ((size_t)(ln * 17 + mrB) * 6 + 1) * 1024); }
    if (!lastl) load_wg_lds(F, l + 1); else __syncthreads();
    CombRaw rw[2];
#pragma unroll
    for (int u = 0; u < 2; ++u) { rw[u].x[0] = rw[u].x[1] = (u32x4){0u, 0u, 0u, 0u};
#pragma unroll
        for (int k = 0; k < 4; ++k) rw[u].f[0][k] = rw[u].f[1][k] = (u32x2){0u, 0u}; }
#pragma unroll
    for (int u = 0; u < 2; ++u) if (F.wave + u * NWAVES < nrows) comb_load(F, r_lo + F.wave + u * NWAVES, rw[u]);
    for (int n = F.wave; n < nrows; n += 2 * NWAVES) {
        CombRaw rwn[2];
#pragma unroll
        for (int u = 0; u < 2; ++u) rwn[u] = rw[u];
#pragma unroll
        for (int u = 0; u < 2; ++u) if (n + (2 + u) * NWAVES < nrows) comb_load(F, r_lo + n + (2 + u) * NWAVES, rwn[u]);
        __builtin_amdgcn_sched_barrier(0);
#pragma unroll
        for (int u = 0; u < 2; ++u) if (n + u * NWAVES < nrows) { const int row = r_lo + n + u * NWAVES;
            const int sel = (mod_row(row) == mrA) ? 0 : 1;
            const LAS float* g2 = pv_slot(F, 2 + sel);
            RowV x;
#pragma unroll
            for (int h = 0; h < 2; ++h) { const u32x4 w = rw[u].x[h]; x.v[2 * h] = (f32x4){bflo(w.x), bfhi(w.x), bflo(w.y), bfhi(w.y)}; x.v[2 * h + 1] = (f32x4){bflo(w.z), bfhi(w.z), bflo(w.w), bfhi(w.w)}; }
#pragma unroll
            for (int j = 0; j < 4; ++j) { f32x4 f = (f32x4){0.f, 0.f, 0.f, 0.f};
#pragma unroll
                for (int k = 0; k < 4; ++k) { const u32x2 w2 = rw[u].f[j >> 1][k]; const int wd = (int)((j & 1) ? w2.y : w2.x);
                    const f32x2 lo = __builtin_amdgcn_cvt_pk_f32_fp8(wd, false), hi = __builtin_amdgcn_cvt_pk_f32_fp8(wd, true); f[0] += lo[0]; f[1] += lo[1]; f[2] += hi[0]; f[3] += hi[1]; }
                const f32x4 gg = *(const LAS f32x4*)(g2 + RC(F.lane, j)) * (1.0f / FS_SCALE);
                x.v[j] = x.v[j] * DN_ALPHA + gg * f; }
            row_ln_plain(x, F.lane); row_affine_l(x, pv_slot(F, 0), pv_slot(F, 1), F.lane);
            if (lastl) { row_store_nt(x, F.out + (size_t)row * D, F.lane); }
            else { row_store_bf16_nt(x, (bf16_t*)(F.ws + WS_X) + (size_t)row * D, F.lane); ln0_row(F, row, x, pv_slot(F, 4 + sel), pv_slot(F, 6 + sel)); } }
#pragma unroll
        for (int u = 0; u < 2; ++u) rw[u] = rwn[u];
    }
    if (!lastl) gates_tail(F, l + 1, t_lo, t_hi);
    __syncthreads();
}

#define MFMA32(a, b, c) __builtin_amdgcn_mfma_f32_32x32x16_bf16((a), (b), (c), 0, 0, 0)
#define MFMA16(a, b, c) __builtin_amdgcn_mfma_f32_16x16x32_bf16((a), (b), (c), 0, 0, 0)
__device__ __forceinline__ f32x16 zero16() { f32x16 z;
#pragma unroll
    for (int i = 0; i < 16; ++i) z[i] = 0.f;
    return z; }
__device__ __forceinline__ void pool_tiles(Frame& F, int l, bool with_ctx) {
    LAS unsigned char* Pin = F.lds;
    LAS unsigned char* Dm = F.lds + 40960;
    const bf16_t* Z = (const bf16_t*)(F.ws + WS_Z);
    const bf16_t* Wp = (const bf16_t*)(F.ws + WS_WPOOL) + (size_t)l * 4 * 4096;
    const float* psc = F.in[IN_POOLS] + l * 256;
    bf16_t* BRA = (bf16_t*)(F.ws + WS_BRA);
    const int ntiles = with_ctx ? 1088 : 1024;
    const int r = F.lane & 31, h = F.lane >> 5;
    bf16x8 wa[2][4]; f32x4 scv[2][4];
#pragma unroll
    for (int qi = 0; qi < 2; ++qi) { const int q = F.wave + 8 * qi, g = q >> 2, td = (q >> 1) & 1;
#pragma unroll
        for (int ks = 0; ks < 4; ++ks) wa[qi][ks] = *(const bf16x8*)(Wp + ((size_t)g * 64 + td * 32 + r) * 64 + ks * 16 + 8 * h);
#pragma unroll
        for (int qq = 0; qq < 4; ++qq) scv[qi][qq] = *(const f32x4*)(psc + g * 64 + td * 32 + 8 * qq + 4 * h); }
    for (int tile = F.bid; tile < ntiles; tile += F.G) {
        int row0, seq_lo, seq_hi;
        if (tile < 1024) { row0 = tile * 64; seq_lo = row0; seq_hi = row0 + 64; }
        else { const int ct = tile - 1024; seq_lo = ML + (ct >> 2) * 256; seq_hi = seq_lo + 256; row0 = seq_lo + (ct & 3) * 64; }
        for (int idx = F.tid; idx < 80 * 32; idx += NTHREADS) { const int rr = idx >> 5, ck = idx & 31, grow = row0 - 8 + rr;
            if (grow >= seq_lo && grow < seq_hi) *(LAS u32x4*)(Pin + rr * 512 + ck * 16) = __builtin_nontemporal_load((const u32x4*)(Z + (size_t)grow * NZ + ZC_P + ck * 8)); }
        __syncthreads();
#pragma unroll
        for (int g = 0; g < 4; ++g) { constexpr int dummy_ = 0; (void)dummy_; const int hw = 1 << g, tok = F.tid >> 3, ck = g * 8 + (F.tid & 7), t = row0 + tok;
            const int lo = max(t - hw, seq_lo), hi = min(t + hw, seq_hi);
            float s[8];
#pragma unroll
            for (int e = 0; e < 8; ++e) s[e] = 0.f;
#pragma unroll
            for (int d = -hw; d < hw; ++d) { u32x4 v = *(const LAS u32x4*)(Pin + (tok + 8 + d) * 512 + ck * 16); const bool in = (t + d >= lo) && (t + d < hi);
                v.x = in ? v.x : 0u; v.y = in ? v.y : 0u; v.z = in ? v.z : 0u; v.w = in ? v.w : 0u;
                s[0] += bflo(v.x); s[1] += bfhi(v.x); s[2] += bflo(v.y); s[3] += bfhi(v.y); s[4] += bflo(v.z); s[5] += bfhi(v.z); s[6] += bflo(v.w); s[7] += bfhi(v.w); }
            const float inv = __builtin_amdgcn_rcpf((float)(hi - lo));
            const u32x4 o = *(const LAS u32x4*)(Pin + (tok + 8) * 512 + ck * 16);
            u32x4 w; w.x = pk2(s[0] * inv - bflo(o.x), s[1] * inv - bfhi(o.x)); w.y = pk2(s[2] * inv - bflo(o.y), s[3] * inv - bfhi(o.y));
            w.z = pk2(s[4] * inv - bflo(o.z), s[5] * inv - bfhi(o.z)); w.w = pk2(s[6] * inv - bflo(o.w), s[7] * inv - bfhi(o.w));
            *(LAS u32x4*)(Dm + tok * 528 + ck * 16) = w; }
        __syncthreads();
#pragma unroll
        for (int qi = 0; qi < 2; ++qi) { const int q = F.wave + 8 * qi, g = q >> 2, td = (q >> 1) & 1, tt = q & 1;
            f32x16 acc = zero16();
#pragma unroll
            for (int ks = 0; ks < 4; ++ks) { const bf16x8 b = *(const LAS bf16x8*)(Dm + (tt * 32 + r) * 528 + (g * 64 + ks * 16 + 8 * h) * 2);
                acc = MFMA32(wa[qi][ks], b, acc); }
            const size_t orow = (size_t)(row0 + tt * 32 + r);
#pragma unroll
            for (int qq = 0; qq < 4; ++qq) { const int dcol = g * 64 + td * 32 + 8 * qq + 4 * h; const f32x4 sc = scv[qi][qq];
                u32x2 w; w.x = pk2(acc[4 * qq] * sc.x, acc[4 * qq + 1] * sc.y); w.y = pk2(acc[4 * qq + 2] * sc.z, acc[4 * qq + 3] * sc.w);
                *(u32x2*)(BRA + orow * D + dcol) = w; } }
        __syncthreads();
    }
}
__device__ __forceinline__ void sgu_chunks(Frame& F, int l, bool with_ctx) {
    LAS unsigned char* Vt = F.lds;
    const bf16_t* Z = (const bf16_t*)(F.ws + WS_Z);
    const bf16_t* Ws = (const bf16_t*)(F.ws + WS_WSGU) + (size_t)l * 4 * 16384;
    const float* lng = F.in[IN_SLNG] + l * 256; const float* lnb = F.in[IN_SLNB] + l * 256; const float* sb = F.in[IN_SGUB] + l * 512;
    bf16_t* BRA = (bf16_t*)(F.ws + WS_BRA);
    const int nchunks = with_ctx ? 544 : 512;
    const int r = F.lane & 31, h = F.lane >> 5;
    const int tc = F.wave & 1, tt = F.wave >> 1, t = tt * 32 + r;
    LAS float* lnt = (LAS float*)(F.lds + 69632);
    if (F.tid < 256) { lnt[F.tid] = lng[F.tid]; lnt[256 + F.tid] = lnb[F.tid]; }
    __syncthreads();
    for (int ch = F.bid; ch < nchunks; ch += F.G) {
        const int row0 = ch * 128;
        u32x2 ug[4][4]; bf16x8 bcur[8];
        { const int s2 = F.tid >> 3, cq = F.tid & 7; const bf16_t* zp = Z + (size_t)(row0 + 2 * s2) * NZ + ZC_UV + 256 + cq * 32;
          float v[2][32]; float sum[2] = {0.f, 0.f};
#pragma unroll
          for (int rr = 0; rr < 2; ++rr)
#pragma unroll
              for (int i = 0; i < 4; ++i) { const u32x4 w = __builtin_nontemporal_load((const u32x4*)(zp + (size_t)rr * NZ + 8 * i));
                  v[rr][8 * i] = bflo(w.x); v[rr][8 * i + 1] = bfhi(w.x); v[rr][8 * i + 2] = bflo(w.y); v[rr][8 * i + 3] = bfhi(w.y); v[rr][8 * i + 4] = bflo(w.z); v[rr][8 * i + 5] = bfhi(w.z); v[rr][8 * i + 6] = bflo(w.w); v[rr][8 * i + 7] = bfhi(w.w); }
          float rstd[2];
#pragma unroll
          for (int rr = 0; rr < 2; ++rr) {
#pragma unroll
              for (int i = 0; i < 32; ++i) sum[rr] += v[rr][i];
              sum[rr] = oct_sum(sum[rr]);
              const float mean = sum[rr] * (1.f / 256.f); float sq = 0.f;
#pragma unroll
              for (int i = 0; i < 32; ++i) { v[rr][i] -= mean; sq += v[rr][i] * v[rr][i]; }
              sq = oct_sum(sq);
              rstd[rr] = __builtin_amdgcn_rsqf(sq * (1.f / 256.f) + LN_EPS); }
#pragma unroll
        for (int g = 0; g < 4; ++g)
#pragma unroll
            for (int qq = 0; qq < 4; ++qq) ug[g][qq] = *(const u32x2*)(Z + (size_t)(row0 + t) * NZ + ZC_UV + g * 64 + tc * 32 + 8 * qq + 4 * h);
#pragma unroll
        for (int ks = 0; ks < 8; ++ks) bcur[ks] = *(const bf16x8*)(Ws + ((size_t)0 * 128 + t) * 128 + ks * 16 + 8 * h);
          LAS unsigned char* wp = Vt + (((s2 >> 2) ^ cq) << 4) + (s2 & 3) * 4;
#pragma unroll
          for (int i = 0; i < 32; ++i) { const int c = cq * 32 + i; const float gn = lnt[c], bn = lnt[256 + c];
              *(LAS unsigned*)(wp + c * 272) = pg8::cvt_pk_bf16(v[0][i] * rstd[0] * gn + bn, v[1][i] * rstd[1] * gn + bn); } }
        __syncthreads();
#pragma unroll
        for (int g = 0; g < 4; ++g) {
            bf16x8 bnx[8];
#pragma unroll
            for (int ks = 0; ks < 8; ++ks) bnx[ks] = bcur[ks];
            if (g < 3) {
#pragma unroll
                for (int ks = 0; ks < 8; ++ks) bnx[ks] = *(const bf16x8*)(Ws + ((size_t)(g + 1) * 128 + t) * 128 + ks * 16 + 8 * h); }
            f32x16 acc = zero16();
#pragma unroll
            for (int ks = 0; ks < 8; ++ks) { const bf16x8 a = *(const LAS bf16x8*)(Vt + (g * 64 + tc * 32 + r) * 272 + (((ks * 2 + h) ^ ((g * 2 + tc) & 7)) * 16));
                acc = MFMA32(a, bcur[ks], acc); }
#pragma unroll
            for (int ks = 0; ks < 8; ++ks) bcur[ks] = bnx[ks];
            const float bias = sb[g * 128 + t];
#pragma unroll
            for (int qq = 0; qq < 4; ++qq) { const int c0 = g * 64 + tc * 32 + 8 * qq + 4 * h;
                const u32x2 u = ug[g][qq];
                u32x2 w; w.x = pk2(bflo(u.x) * (acc[4 * qq] + bias), bfhi(u.x) * (acc[4 * qq + 1] + bias)); w.y = pk2(bflo(u.y) * (acc[4 * qq + 2] + bias), bfhi(u.y) * (acc[4 * qq + 3] + bias));
                *(u32x2*)(BRA + (size_t)(row0 + t) * D + 768 + c0) = w; } }
        __syncthreads();
    }
}
__device__ __forceinline__ void qk_conv_pass(Frame& F, int l) {
    const bf16_t* Z = (const bf16_t*)(F.ws + WS_Z); bf16_t* QKC = (bf16_t*)(F.ws + WS_H);
    const int chunk = F.tid & 127, rsub = F.tid >> 7, ch0 = chunk * 8;
    float w0[8], w1[8], w2[8], cbv[8];
    { const float* cw = F.in[IN_CONVW] + (size_t)l * 3 * 1024 + ch0; const float* cb = F.in[IN_CONVB] + (size_t)l * 1024 + ch0;
#pragma unroll
      for (int e = 0; e < 8; ++e) { w0[e] = cw[e]; w1[e] = cw[1024 + e]; w2[e] = cw[2048 + e]; cbv[e] = cb[e]; } }
    const float scale = chunk >= 64 ? 0.08838834764831845f : 1.0f;
    const int ns = F.G * 4, sidx = F.bid * 4 + rsub;
    const int r0 = (int)(((long)sidx * MT) / ns), r1 = (int)(((long)(sidx + 1) * MT) / ns);
    const bf16_t* zb = Z + ZC_QK + ch0;
    const u32x4 zero4 = (u32x4){0u, 0u, 0u, 0u};
    constexpr int CQ = 5;
    u32x4 xm = zero4, xc = zero4, xn = zero4, xq[CQ];
    if (r0 < r1) { xc = *(const u32x4*)(zb + (size_t)r0 * NZ); if (r0 > 0) xm = *(const u32x4*)(zb + (size_t)(r0 - 1) * NZ); if (r0 + 1 < MT) xn = *(const u32x4*)(zb + (size_t)(r0 + 1) * NZ); }
#pragma unroll
    for (int k = 0; k < CQ; ++k) { xq[k] = zero4; if (r0 < r1 && r0 + 2 + k < MT) xq[k] = *(const u32x4*)(zb + (size_t)(r0 + 2 + k) * NZ); }
    for (int row = r0; row < r1; ++row) {
        u32x4 xnew = zero4; if (row + 2 + CQ < MT) xnew = *(const u32x4*)(zb + (size_t)(row + 2 + CQ) * NZ);
        const u32x4 xn2 = xq[0];
#pragma unroll
        for (int k = 0; k + 1 < CQ; ++k) xq[k] = xq[k + 1];
        xq[CQ - 1] = xnew;
        const int p = row < ML ? (row & 4095) : ((row - ML) & 255), len = row < ML ? 4096 : 256;
        const u32x4 x0 = (p > 0) ? xm : zero4, x1 = xc, x2 = (p + 1 < len) ? xn : zero4;
        const unsigned xa[4] = {x0.x, x0.y, x0.z, x0.w}, xb[4] = {x1.x, x1.y, x1.z, x1.w}, xcc[4] = {x2.x, x2.y, x2.z, x2.w};
        float y[8];
#pragma unroll
        for (int e2 = 0; e2 < 4; ++e2) { y[2 * e2] = cbv[2 * e2] + w0[2 * e2] * bflo(xa[e2]) + w1[2 * e2] * bflo(xb[e2]) + w2[2 * e2] * bflo(xcc[e2]);
            y[2 * e2 + 1] = cbv[2 * e2 + 1] + w0[2 * e2 + 1] * bfhi(xa[e2]) + w1[2 * e2 + 1] * bfhi(xb[e2]) + w2[2 * e2 + 1] * bfhi(xcc[e2]); }
#pragma unroll
        for (int e = 0; e < 8; ++e) y[e] = siluf_(y[e]) * scale;
        u32x4 w; w.x = pk2(y[0], y[1]); w.y = pk2(y[2], y[3]); w.z = pk2(y[4], y[5]); w.w = pk2(y[6], y[7]);
        *(u32x4*)(QKC + (size_t)row * D + ch0) = w;
        xm = xc; xc = xn; xn = xn2;
    }
}
constexpr int ML_QS = 0, ML_KS = 34816, ML_KW = 69632, ML_VT = 104448, ML_CB = 126208, ML_SC = 147968, ML_SCSZ = 2624;
__device__ __forceinline__ float logsigf_(float x) { return fminf(x, 0.f) - __logf(1.0f + __expf(-fabsf(x))); }
__device__ __forceinline__ unsigned swap16(unsigned u) { return __builtin_amdgcn_alignbit(u, u, 16); }
struct MlPre { u32x4 qk[8]; u32x2 v[4]; float g[4]; };
__device__ __forceinline__ void ml_geom(int j, int b, int dir, int& seqbase, int& seqlen, int& pbase) {
    const bool is_ctx = j < 2; int cj = is_ctx ? j : j - 2; const int ncs = is_ctx ? 2 : 32; if (dir) cj = ncs - 1 - cj;
    seqbase = is_ctx ? ML + b * 256 : b * 4096; seqlen = is_ctx ? 256 : 4096; pbase = cj * 128; }
#define ML_BAR() do { asm volatile("s_waitcnt lgkmcnt(0)" ::: "memory"); __builtin_amdgcn_s_barrier(); asm volatile("" ::: "memory"); } while (0)
__device__ __forceinline__ void mlstm_unit(Frame& F, int l, int unit) {
    const int bh = (unit & 7) + 8 * (unit >> 5), sub = (unit >> 3) & 3;
    const int b = bh >> 2, head = bh & 3, dir = sub >> 1, vh = sub & 1;
    LAS unsigned char* QS = F.lds + ML_QS; LAS unsigned char* KS = F.lds + ML_KS; LAS unsigned char* KW = F.lds + ML_KW; LAS unsigned char* VT = F.lds + ML_VT; LAS unsigned char* CB = F.lds + ML_CB;
    const bf16_t* Z = (const bf16_t*)(F.ws + WS_Z); const float* ZG = (const float*)(F.ws + WS_ZG); const bf16_t* QKC = (const bf16_t*)(F.ws + WS_H);
    bf16_t* HF = (bf16_t*)(F.ws + WS_HFB) + (size_t)dir * MT * 512;
    const int wave = F.wave;
    int tl = F.tid;
#define ML_ROLES() const int lane = tl & 63, fr = lane & 15, q4 = lane >> 4; const int isk = (tl >> 4) & 1, ck = tl & 15, i0 = 8 * (tl >> 5), chn = (isk ? 512 : 0) + head * 128 + ck * 8; \
    const int vi0 = 4 * (tl >> 4), vcq = tl & 15, vch = head * 128 + vh * 64 + vcq * 4; (void)fr; (void)q4; (void)vi0; (void)vcq; (void)vch; (void)i0; (void)chn; (void)ck; (void)isk;
    for (int idx = F.tid; idx < 16 * 136; idx += NTHREADS) *(LAS bf16_t*)(VT + (64 + idx / 136) * 272 + (idx % 136) * 2) = (idx < 136) ? (bf16_t)0x3F80 : (bf16_t)0;
    f32x4 cs[5];
#pragma unroll
    for (int vt = 0; vt < 5; ++vt) cs[vt] = (f32x4){0.f, 0.f, 0.f, 0.f};
    float m_state = 0.f;
    MlPre pre;
#define ML_PREFETCH(jj) do { int sb_, sl_, pb_; ml_geom((jj), b, dir, sb_, sl_, pb_); \
        { const int pmin = dir ? pb_ + 120 - i0 : pb_ + i0; const bf16_t* zr = QKC + (size_t)(sb_ + pmin) * D + chn; (void)sl_; \
          _Pragma("unroll") for (int k = 0; k < 8; ++k) pre.qk[k] = *(const u32x4*)(zr + (size_t)k * D); } \
        { const int pminv = dir ? pb_ + 124 - vi0 : pb_ + vi0; const bf16_t* zv = Z + (size_t)(sb_ + pminv) * NZ + ZC_V + vch; \
          _Pragma("unroll") for (int k = 0; k < 4; ++k) pre.v[k] = *(const u32x2*)(zv + (size_t)k * NZ); } \
        if (wave == 0) { const int p0 = dir ? pb_ + 127 - 2 * lane : pb_ + 2 * lane, p1 = dir ? p0 - 1 : p0 + 1; \
          pre.g[0] = ZG[(size_t)(sb_ + p0) * 16 + dir * 8 + head]; pre.g[1] = ZG[(size_t)(sb_ + p0) * 16 + dir * 8 + 4 + head]; \
          pre.g[2] = ZG[(size_t)(sb_ + p1) * 16 + dir * 8 + head]; pre.g[3] = ZG[(size_t)(sb_ + p1) * 16 + dir * 8 + 4 + head]; } } while (0)
#define ML_STEPA(sbuf) do { LAS float* sg_ = (LAS float*)(F.lds + ML_SC + (sbuf) * ML_SCSZ); const int i0g = 2 * lane, i1g = i0g + 1; \
        const float gi0 = pre.g[0], gf0 = pre.g[1], gi1 = pre.g[2], gf1 = pre.g[3]; \
        const float lf0 = logsigf_(gf0), lf1 = logsigf_(gf1); const float s1 = lf0 + lf1; const float incl = wave_scan_sum(s1); \
        const float excl = incl - s1, bc0 = excl + lf0, bc1 = excl + s1; \
        const float g0 = gi0 - bc0, g1 = gi1 - bc1; const float mx1 = fmaxf(g0, g1); const float im = wave_scan_max(mx1); \
        const float em = dpp_id<0x138, 0xf>(-3.0e38f, im);                   \
        const float M0 = fmaxf(m_state, fmaxf(em, g0)), M1 = fmaxf(m_state, fmaxf(em, mx1)); \
        const float total = __builtin_bit_cast(float, __builtin_amdgcn_readlane(__builtin_bit_cast(int, bc1), 63)), Mlast = __builtin_bit_cast(float, __builtin_amdgcn_readlane(__builtin_bit_cast(int, M1), 63)); \
        sg_[i0g] = g0; sg_[i1g] = g1; sg_[128 + i0g] = M0; sg_[128 + i1g] = M1; \
        sg_[256 + i0g] = __expf(m_state - M0); sg_[256 + i1g] = __expf(m_state - M1); \
        sg_[384 + i0g] = __expf(-(bc0 + M0)); sg_[384 + i1g] = __expf(-(bc1 + M1)); \
        sg_[512 + i0g] = __expf(g0 - Mlast); sg_[512 + i1g] = __expf(g1 - Mlast); \
        if (lane == 0) sg_[640] = __expf(m_state - Mlast); \
        m_state = total + Mlast; } while (0)
    { ML_ROLES(); ML_PREFETCH(0); if (wave == 0) ML_STEPA(0); }
    ML_BAR();
#pragma unroll 1
    for (int j = 0; j < 34; ++j) {
        asm volatile("" : "+v"(tl));
        ML_ROLES();
        int seqbase, seqlen, pbase; ml_geom(j, b, dir, seqbase, seqlen, pbase);
        const LAS float* sc_g = (const LAS float*)(F.lds + ML_SC + (j & 1) * ML_SCSZ); const LAS float* sc_M = sc_g + 128; const LAS float* sc_dec = sc_g + 256; const LAS float* sc_emt = sc_g + 384; const LAS float* sc_wk = sc_g + 512;
        {
#pragma unroll
          for (int k = 0; k < 8; ++k) { const int i = dir ? i0 + 7 - k : i0 + k; *(LAS u32x4*)((isk ? KS : QS) + i * 272 + ck * 16) = pre.qk[k]; }
          if (isk) { u32x4 kt[8]; float ykeep[8];
#pragma unroll
              for (int e = 0; e < 8; ++e) { kt[e] = (u32x4){0u, 0u, 0u, 0u}; ykeep[e] = 0.f; }
#pragma unroll
              for (int k = 0; k < 8; ++k) { const int i = dir ? i0 + 7 - k : i0 + k; const float wk = sc_wk[i];
                  const unsigned xb[4] = {pre.qk[k].x, pre.qk[k].y, pre.qk[k].z, pre.qk[k].w};
#pragma unroll
                  for (int e = 0; e < 8; ++e) { const float yw = ((e & 1) ? bfhi(xb[e >> 1]) : bflo(xb[e >> 1])) * wk;
                      if (k & 1) { const unsigned pw_ = pk2(ykeep[e], yw); if ((k >> 1) == 0) kt[e].x = pw_; else if ((k >> 1) == 1) kt[e].y = pw_; else if ((k >> 1) == 2) kt[e].z = pw_; else kt[e].w = pw_; }
                      else ykeep[e] = yw; } }
#pragma unroll
              for (int e = 0; e < 8; ++e) { u32x4 o = kt[e]; if (dir) o = (u32x4){swap16(kt[e].w), swap16(kt[e].z), swap16(kt[e].y), swap16(kt[e].x)};
                  *(LAS u32x4*)(KW + (ck * 8 + e) * 272 + (((i0 >> 3) ^ (ck & 7)) * 16)) = o; } } }
        { unsigned vv[4][2];
#pragma unroll
          for (int k = 0; k < 4; ++k) { vv[k][0] = pre.v[k].x; vv[k][1] = pre.v[k].y; }
#pragma unroll
          for (int c = 0; c < 4; ++c) {
              unsigned h0 = (c & 1) ? (vv[0][c >> 1] >> 16) : (vv[0][c >> 1] & 0xffffu), h1 = (c & 1) ? (vv[1][c >> 1] >> 16) : (vv[1][c >> 1] & 0xffffu);
              unsigned h2 = (c & 1) ? (vv[2][c >> 1] >> 16) : (vv[2][c >> 1] & 0xffffu), h3 = (c & 1) ? (vv[3][c >> 1] >> 16) : (vv[3][c >> 1] & 0xffffu);
              u32x2 o; if (dir) { o.x = h3 | (h2 << 16); o.y = h1 | (h0 << 16); } else { o.x = h0 | (h1 << 16); o.y = h2 | (h3 << 16); }
              *(LAS u32x2*)(VT + (vcq * 4 + c) * 272 + vi0 * 2) = o; } }
#pragma unroll
        for (int vt = 0; vt < 5; ++vt)
#pragma unroll
            for (int rr = 0; rr < 4; rr += 2) { const unsigned pw_ = pk2(cs[vt][rr], cs[vt][rr + 1]);
                *(LAS bf16_t*)(CB + (16 * vt + 4 * q4 + rr) * 272 + (16 * wave + fr) * 2) = (bf16_t)(pw_ & 0xffffu); *(LAS bf16_t*)(CB + (16 * vt + 4 * q4 + rr + 1) * 272 + (16 * wave + fr) * 2) = (bf16_t)(pw_ >> 16); }
        ML_BAR();
        if (j + 1 < 34) ML_PREFETCH(j + 1);
        const int t = 16 * wave + fr;
        bf16x8 qf[4];
#pragma unroll
        for (int kc = 0; kc < 4; ++kc) qf[kc] = *(const LAS bf16x8*)(QS + t * 272 + (32 * kc + 8 * q4) * 2);
        const float Mt_t = sc_M[t], dec_t = sc_dec[t], emt_t = sc_emt[t];
        f32x4 ps[8];
#pragma unroll
        for (int jp = 0; jp < 4; ++jp) {
            ps[2 * jp] = (f32x4){0.f, 0.f, 0.f, 0.f}; ps[2 * jp + 1] = (f32x4){0.f, 0.f, 0.f, 0.f};
            if (2 * jp <= wave) {
                bf16x8 ka[4], kb[4];
#pragma unroll
                for (int kc = 0; kc < 4; ++kc) { ka[kc] = *(const LAS bf16x8*)(KS + (32 * jp + fr) * 272 + (32 * kc + 8 * q4) * 2); kb[kc] = *(const LAS bf16x8*)(KS + (32 * jp + 16 + fr) * 272 + (32 * kc + 8 * q4) * 2); }
                const f32x4 ga4 = *(const LAS f32x4*)(sc_g + 32 * jp + 4 * q4), gb4 = *(const LAS f32x4*)(sc_g + 32 * jp + 16 + 4 * q4);
                f32x4 acc0 = (f32x4){0.f, 0.f, 0.f, 0.f}, acc1 = (f32x4){0.f, 0.f, 0.f, 0.f};
#pragma unroll
                for (int kc = 0; kc < 4; ++kc) { acc0 = MFMA16(ka[kc], qf[kc], acc0); acc1 = MFMA16(kb[kc], qf[kc], acc1); }
#pragma unroll
                for (int rr = 0; rr < 4; ++rr) { const int s0 = 32 * jp + 4 * q4 + rr, s1 = s0 + 16;
                    ps[2 * jp][rr] = (s0 <= t) ? acc0[rr] * __expf(ga4[rr] - Mt_t) : 0.f; ps[2 * jp + 1][rr] = (s1 <= t) ? acc1[rr] * __expf(gb4[rr] - Mt_t) : 0.f; }
            }
        }
        f32x4 ao[5];
        {
#pragma unroll
          for (int vt = 0; vt < 5; ++vt) ao[vt] = (f32x4){0.f, 0.f, 0.f, 0.f};
#pragma unroll
          for (int kh = 0; kh < 4; kh += 2) { bf16x8 cf[2][5];
#pragma unroll
              for (int k2 = 0; k2 < 2; ++k2)
#pragma unroll
                  for (int vt = 0; vt < 5; ++vt) cf[k2][vt] = *(const LAS bf16x8*)(CB + (16 * vt + fr) * 272 + (32 * (kh + k2) + 8 * q4) * 2);
#pragma unroll
              for (int k2 = 0; k2 < 2; ++k2)
#pragma unroll
                  for (int vt = 0; vt < 5; ++vt) ao[vt] = MFMA16(cf[k2][vt], qf[kh + k2], ao[vt]); }
#pragma unroll
          for (int vt = 0; vt < 5; ++vt) ao[vt] = ao[vt] * dec_t; }
#pragma unroll
        for (int ks = 0; ks < 4; ++ks) {
            if (2 * ks <= wave) {
                s16x4 vlo[5], vhi[5];
#pragma unroll
                for (int vt = 0; vt < 5; ++vt) { vlo[vt] = *(const LAS s16x4*)(VT + (16 * vt + fr) * 272 + (32 * ks + 4 * q4) * 2); vhi[vt] = *(const LAS s16x4*)(VT + (16 * vt + fr) * 272 + (32 * ks + 16 + 4 * q4) * 2); }
                u32x4 pw; pw.x = cvt_pk_bf16(ps[2 * ks][0], ps[2 * ks][1]); pw.y = cvt_pk_bf16(ps[2 * ks][2], ps[2 * ks][3]); pw.z = cvt_pk_bf16(ps[2 * ks + 1][0], ps[2 * ks + 1][1]); pw.w = cvt_pk_bf16(ps[2 * ks + 1][2], ps[2 * ks + 1][3]);
                const bf16x8 pf = __builtin_bit_cast(bf16x8, pw);
#pragma unroll
                for (int vt = 0; vt < 5; ++vt) { const bf16x8 a = __builtin_shufflevector(vlo[vt], vhi[vt], 0, 1, 2, 3, 4, 5, 6, 7); ao[vt] = MFMA16(a, pf, ao[vt]); }
            }
        }
        { const float den = bperm(fr, ao[4][0]); const float inv = __builtin_amdgcn_rcpf(fmaxf(fabsf(den), emt_t));
          const int p = dir ? pbase + 127 - t : pbase + t; bf16_t* orow = HF + (size_t)(seqbase + p) * 512 + head * 128 + vh * 64 + 4 * q4;
#pragma unroll
          for (int vt = 0; vt < 4; ++vt) { const f32x4 o = ao[vt] * inv; u32x2 w; w.x = cvt_pk_bf16(o[0], o[1]); w.y = cvt_pk_bf16(o[2], o[3]); *(u32x2*)(orow + 16 * vt) = w; } }
        { const float a_s = sc_g[640];
#pragma unroll
          for (int vt = 0; vt < 5; ++vt) cs[vt] = cs[vt] * a_s;
#pragma unroll
          for (int ks = 0; ks < 4; ks += 2) { bf16x8 bb[2], va[2][5];
#pragma unroll
              for (int k2 = 0; k2 < 2; ++k2) { bb[k2] = *(const LAS bf16x8*)(KW + (16 * wave + fr) * 272 + (((4 * (ks + k2) + q4) ^ (((16 * wave + fr) >> 3) & 7)) * 16));
#pragma unroll
                  for (int vt = 0; vt < 5; ++vt) va[k2][vt] = *(const LAS bf16x8*)(VT + (16 * vt + fr) * 272 + (32 * (ks + k2) + 8 * q4) * 2); }
#pragma unroll
              for (int k2 = 0; k2 < 2; ++k2)
#pragma unroll
                  for (int vt = 0; vt < 5; ++vt) cs[vt] = MFMA16(va[k2][vt], bb[k2], cs[vt]); } }
        if (wave == 0 && j + 1 < 34) ML_STEPA((j + 1) & 1);
        ML_BAR();
    }
#undef ML_PREFETCH
#undef ML_STEPA
#undef ML_ROLES
    __syncthreads();
}
__device__ __forceinline__ void phase_mixers(Frame& F, int l) {
    const bool with_ctx = (l != DEPTH - 1);
#ifndef MIX_MASK
#define MIX_MASK 7
#endif
#ifndef MIXREP
#define MIXREP 0
#endif
    if (MIX_MASK & 1) pool_tiles(F, l, with_ctx);
    if (MIXREP & 1) { __syncthreads(); pool_tiles(F, l, with_ctx); }
    if (MIX_MASK & 2) sgu_chunks(F, l, with_ctx);
    if (MIXREP & 2) { __syncthreads(); sgu_chunks(F, l, with_ctx); }
    (void)0;
    qk_conv_pass(F, l);
}
__device__ __forceinline__ void phase_mlstm(Frame& F, int l) {
    for (int u = F.bid; u < 256; u += F.G) mlstm_unit(F, l, u);
}

struct Args { const float* in[31]; float* out; unsigned char* ws; int g_lo, g_hi, pad0, pad1; };
constexpr int NPH = 11, NGID = 2 + DEPTH * NPH;
__global__ void __launch_bounds__(NTHREADS, 2) fwd_kernel(Args args) {
    extern __shared__ __attribute__((aligned(16))) unsigned char lds_raw[];
    Frame F;
    F.lds = (LAS unsigned char*)lds_raw; F.MISC = (volatile LAS unsigned*)(F.lds + MISC_OFF);
    F.tid = threadIdx.x; F.lane = F.tid & 63; F.wave = __builtin_amdgcn_readfirstlane(F.tid >> 6); F.G = gridDim.x; F.bid = blockIdx.x;
    F.ws = args.ws; F.out = args.out;
    F.in = (InTab)__builtin_amdgcn_kernarg_segment_ptr();
    if (F.tid < 64) F.MISC[F.tid] = 0u;
    __syncthreads();
    const int lo = args.g_lo, hi = args.g_hi;
    const bool multi = (hi - lo) > 1;
    XcdBarrier bar; bar.bar = (unsigned*)(F.ws + WS_CTL) + CW_BAR; bar.x = 0; bar.st = nullptr;
    if (multi) bar = xcd_barrier_post((unsigned*)(F.ws + WS_CTL) + CW_BAR, F.MISC + 8);
#ifndef PHASE_MASK
#define PHASE_MASK 0xFFFF
#endif
#define RUN(g) (lo <= (g) && (g) < hi)
#define RUNP(ty, g) ((((PHASE_MASK) >> (ty)) & 1) && RUN(g))
#ifndef REPEAT_MASK
#define REPEAT_MASK 0
#endif
#define NREP(ty) ((((REPEAT_MASK) >> (ty)) & 1) ? 2 : 1)
#define SEAM(g) do { if (RUN((g) + 1)) xcd_barrier(bar); } while (0)
#define LAUNDER(P) Frame P = F; { int t_; asm volatile("v_mbcnt_lo_u32_b32 %0, -1, 0\n\tv_mbcnt_hi_u32_b32 %0, -1, %0" : "=v"(t_)); t_ |= (F.wave << 6); P.tid = t_; P.lane = t_ & 63; P.wave = __builtin_amdgcn_readfirstlane(t_ >> 6); GAS unsigned char* w_ = (GAS unsigned char*)F.ws; asm volatile("" : "+s"(w_)); P.ws = (unsigned char*)w_; InTab t2_ = F.in; asm volatile("" : "+s"(t2_)); P.in = t2_; }
    if (RUNP(0, 0)) { LAUNDER(P); for (int rep_ = 0; rep_ < NREP(0); ++rep_) { phase_prologue(P); __syncthreads(); } SEAM(0); }
    if (RUNP(1, 1)) { LAUNDER(P); for (int rep_ = 0; rep_ < NREP(1); ++rep_) { phase_ln0_first(P); __syncthreads(); } SEAM(1); }
#pragma unroll 1
    for (int l = 0; l < DEPTH; ++l) {
        const int g0 = 2 + l * NPH;
        const int mrows = (l == DEPTH - 1) ? ML : MT;
        if (RUNP(2, g0 + 0)) {
#undef PHTY
#define PHTY 2
            LAUNDER(P);
            { ProbPlain Pr{(const bf16_t*)(P.ws + WS_H), (const bf16_t*)(P.ws + WS_WIN) + (size_t)l * NZ * D, D, D};
              pg8::StaticOrder<1> S; S.init(MT / 256, NZ_BF / 256, P.G, P.bid);
              EpiInproj<false> E{(bf16_t*)(P.ws + WS_Z), P.in[IN_BIN] + (size_t)l * 5904, 0};
              pg8::gemm_phase(P.lds, P.tid, Pr, S, E); }
            __syncthreads();
            { ProbPlainF8 Pr{(const bf16_t*)(P.ws + WS_H8), (const bf16_t*)(P.ws + WS_WIN8 + (size_t)l * NZ_F8 * D), D / 2, D / 2};
              pg8::StaticOrder<1> S; S.init(MT / 256, NZ_F8 / 256, P.G, P.bid);
              EpiInproj<true> E{(bf16_t*)(P.ws + WS_Z), P.in[IN_BIN] + (size_t)l * 5904, NZ_BF / 256};
              pg8::gemm_phase(P.lds, P.tid, Pr, S, E); }
            SEAM(g0 + 0);
        }
        if (RUNP(3, g0 + 1)) { LAUNDER(P); for (int rep_ = 0; rep_ < NREP(3); ++rep_) { phase_mixers(P, l); __syncthreads(); } SEAM(g0 + 1); }
        if (RUNP(12, g0 + 2)) { LAUNDER(P); for (int rep_ = 0; rep_ < NREP(12); ++rep_) { phase_mlstm(P, l); __syncthreads(); } SEAM(g0 + 2); }
        if (RUNP(4, g0 + 3)) { LAUNDER(P); for (int rep_ = 0; rep_ < NREP(4); ++rep_) phase_finalize(P, l, mrows); SEAM(g0 + 3); }
        if (RUN(g0 + 4) || RUN(g0 + 5)) {
            LAUNDER(P);
            const int nMt = mrows / 256, units = nMt * 4, tailU = units % P.G;
            const bool split = multi && RUN(g0 + 4) && RUN(g0 + 5) && tailU != 0 && (tailU % 4) == 0 && (((P.G - tailU) * 2) % 4) == 0 && ((P.G - tailU) * 2 <= units - tailU);
            const int nMA = split ? (units - tailU) / 4 : nMt, nMB = split ? ((P.G - tailU) * 2) / 4 : nMt;
#pragma unroll 1
            for (int part = 0; part < (split ? 3 : 2); ++part) {
                const bool run = (part == 0) ? RUN(g0 + 4) : RUN(g0 + 5);
                const bool do_branch = (part == 0) || (split && part == 1 && P.bid < tailU);
                if (run) {
                    if (do_branch) {
                        ProbPlain Pr{(const bf16_t*)(P.ws + WS_BRA), (const bf16_t*)(P.ws + WS_WBR) + (size_t)l * D * D, D, D};
                        pg8::StaticOrder<1> S; if (part == 0) S.init(nMA, 4, P.G, P.bid, 0); else S.init(tailU / 4, 4, tailU, P.bid, nMA);
                        EpiBranch E{(const bf16_t*)(P.ws + WS_Z), (bf16_t*)(P.ws + WS_Y)};
                        pg8::gemm_phase(P.lds, P.tid, Pr, S, E);
                    } else {
                        ProbPlain Pr{(const bf16_t*)(P.ws + WS_Y), (const bf16_t*)(P.ws + WS_WOUT) + (size_t)l * D * D, D, D};
                        pg8::StaticOrder<1> S;
                        if (!split) S.init(nMt, 4, P.G, P.bid, 0); else if (part == 1) S.init(nMB, 4, P.G - tailU, P.bid - tailU, 0); else S.init(nMt - nMB, 4, P.G, P.bid, nMB);
                        EpiOut E{(bf16_t*)(P.ws + WS_T)};
                        pg8::gemm_phase(P.lds, P.tid, Pr, S, E);
                    }
                }
                if (part == 0) SEAM(g0 + 4); else if (part == (split ? 2 : 1)) SEAM(g0 + 5); else xcd_barrier(bar);
            }
        }
        if (RUNP(7, g0 + 6)) { LAUNDER(P); for (int rep_ = 0; rep_ < NREP(7); ++rep_) phase_ln1_router(P, l, mrows); SEAM(g0 + 6); }
        if (RUNP(8, g0 + 7)) { LAUNDER(P); for (int rep_ = 0; rep_ < NREP(8); ++rep_) phase_slots(P, mrows); SEAM(g0 + 7); }
        if (RUNP(9, g0 + 8)) {
#undef PHTY
#define PHTY 9
            LAUNDER(P);
            LAS int* seg = (LAS int*)(P.lds + TAB_OFF);
            const int ntile = moe_tables(P, seg);
            ProbMoe1 Pr{(const bf16_t*)(P.ws + WS_H2F8), (const bf16_t*)(P.ws + WS_WGU + (size_t)l * NEXP * 2048 * D), D / 2, D / 2, (const int*)(P.ws + WS_ROUTE + RT_TOK), seg};
            pg8::StaticOrder<1> S; S.init(ntile, 8, P.G, P.bid);
            EpiSwiglu E{(unsigned char*)(P.ws + WS_HID), P.in[IN_BGU] + (size_t)l * NEXP * 2048, seg};
            pg8::gemm_phase(P.lds, P.tid, Pr, S, E); if (NREP(PHTY) == 2) { __syncthreads(); pg8::gemm_phase(P.lds, P.tid, Pr, S, E); }
            SEAM(g0 + 8);
        }
        if (RUNP(10, g0 + 9)) {
#undef PHTY
#define PHTY 10
            LAUNDER(P);
            LAS int* seg = (LAS int*)(P.lds + TAB_OFF);
            const int ntile = moe_tables(P, seg);
            ProbMoe2 Pr{(const bf16_t*)(P.ws + WS_HID), (const bf16_t*)(P.ws + WS_WDN + (size_t)l * NEXP * D * D), D / 2, D / 2, seg};
            pg8::StaticOrder<1> S; S.init(ntile, 4, P.G, P.bid);
            EpiDown E{(unsigned char*)(P.ws + WS_FS), P.in[IN_BDN] + (size_t)l * NEXP * D, (const int*)(P.ws + WS_ROUTE + RT_DEST), (const float*)(P.ws + WS_ROUTE + RT_PSLOT), seg};
            pg8::gemm_phase(P.lds, P.tid, Pr, S, E); if (NREP(PHTY) == 2) { __syncthreads(); pg8::gemm_phase(P.lds, P.tid, Pr, S, E); }
            SEAM(g0 + 9);
        }
        if (RUNP(11, g0 + 10)) { LAUNDER(P); phase_combine_ln2(P, l, mrows); SEAM(g0 + 10); }
    }
#undef LAUNDER
#undef RUN
#undef RUNP
#undef SEAM
}

extern "C" void kernel_launch(void* const* d_in, const int* in_sizes, int n_in, void* d_out, int out_size, void* d_ws, size_t ws_size, hipStream_t stream) {
    static int grid = 0;
    if (grid == 0) {
        if (n_in != 31 || out_size != ML * D || ws_size < WS_END) { fprintf(stderr, "kernel_launch: unexpected problem (n_in %d, out %d, ws %zu, need %zu)\n", n_in, out_size, ws_size, (size_t)WS_END); grid = -1; return; }
        int dev = 0, cus = 0, per_cu = 0;
        if (hipGetDevice(&dev) != hipSuccess || hipDeviceGetAttribute(&cus, hipDeviceAttributeMultiprocessorCount, dev) != hipSuccess) { grid = -1; return; }
        if (hipFuncSetAttribute((const void*)fwd_kernel, hipFuncAttributeMaxDynamicSharedMemorySize, LDS_BYTES) != hipSuccess) { fprintf(stderr, "kernel_launch: hipFuncSetAttribute failed\n"); grid = -1; return; }
        if (hipOccupancyMaxActiveBlocksPerMultiprocessor(&per_cu, (const void*)fwd_kernel, NTHREADS, LDS_BYTES) != hipSuccess || per_cu < 1) fprintf(stderr, "kernel_launch: occupancy query reports %d\n", per_cu);
        (void)hipGetLastError();
        grid = cus;
    }
    if (grid < 0) return;
    (void)hipMemsetAsync((char*)d_ws + WS_CTL, 0, CTL_ZERO_BYTES, stream);
    Args a{};
    for (int i = 0; i < 31; ++i) a.in[i] = (const float*)d_in[i];
    a.out = (float*)d_out; a.ws = (unsigned char*)d_ws;
#if MK_N_LAUNCHES == 1
    a.g_lo = 0; a.g_hi = NGID;
    hipLaunchKernelGGL(fwd_kernel, dim3(grid), dim3(NTHREADS), LDS_BYTES, stream, a);
#else
    for (int g = 0; g < NGID; ++g) { a.g_lo = g; a.g_hi = g + 1; hipLaunchKernelGGL(fwd_kernel, dim3(grid), dim3(NTHREADS), LDS_BYTES, stream, a); }
#endif
}
```
